# Optimizing an MI355X kernel written in HIP

```python
import math
import jax, jax.numpy as jnp
from jax import lax
import numpy as np

D_MODEL = 1024
BATCH = 8
SEQ = 4096
DEPTH = 1

CHUNK = 64
N_META = 16
Q_BLOCK = 128
HEAD_DIM = 64
ROPE_DIM = HEAD_DIM // 4
ROPE_THETA = 500000.0
SB_HEADS = 8
DSA_HEADS = 8
KV_LATENT = 128
NOPE_DIM = HEAD_DIM - ROPE_DIM
IDX_HEADS = 8
IDX_DIM = 64
TOPK_MAX = 256
N_GROUPS = 4
EXP_PER_GROUP = 8
N_EXPERTS = N_GROUPS * EXP_PER_GROUP
TOP_E = 2
D_EXPERT = 512
EXPERT_BLOCK = 128
NORM_EPS = 1e-6
SB_W = SB_HEADS * HEAD_DIM
DSA_W = DSA_HEADS * HEAD_DIM
SPLITS = (SB_W, SB_W, SB_W, DSA_W, KV_LATENT, ROPE_DIM, IDX_HEADS * IDX_DIM, IDX_DIM, IDX_HEADS, D_MODEL, D_MODEL)
IN_WIDTH = 3 * SB_W + DSA_W + KV_LATENT + ROPE_DIM + IDX_HEADS * IDX_DIM + IDX_DIM + IDX_HEADS + 2 * D_MODEL

kernel_name = "hybrid_sb_dsa_hmoe_meta"


def rmsnorm(x, g):
    xf = x.astype(jnp.float32)
    y = xf * lax.rsqrt(jnp.mean(xf * xf, axis=-1, keepdims=True) + NORM_EPS)
    return (y * g.astype(jnp.float32)).astype(x.dtype)


def partial_rope(x, pos):
    half = ROPE_DIM // 2
    inv = ROPE_THETA ** (-jnp.arange(half, dtype=jnp.float32) / half)
    ang = pos.astype(jnp.float32)[:, None] * inv[None, :]
    cos = jnp.cos(ang)[None, :, None, :]
    sin = jnp.sin(ang)[None, :, None, :]
    x1 = x[..., :half].astype(jnp.float32)
    x2 = x[..., half:ROPE_DIM].astype(jnp.float32)
    rot = jnp.concatenate([x1 * cos - x2 * sin, x2 * cos + x1 * sin], axis=-1).astype(x.dtype)
    return jnp.concatenate([rot, x[..., ROPE_DIM:]], axis=-1)


def chunk_ids(pos):
    return jnp.where(pos < N_META, 0, 1 + (pos - N_META) // CHUNK)


def to_blocks(a, t_pad):
    b, t = a.shape[0], a.shape[1]
    pad = [(0, 0), (0, t_pad - t)] + [(0, 0)] * (a.ndim - 2)
    a = jnp.pad(a, pad).reshape((b, t_pad // Q_BLOCK, Q_BLOCK) + a.shape[2:])
    return jnp.moveaxis(a, 1, 0)


def from_blocks(a, t):
    a = jnp.moveaxis(a, 0, 1)
    return a.reshape((a.shape[0], a.shape[1] * a.shape[2]) + a.shape[3:])[:, :t]


def stick_breaking(q, k, v, pos):
    t = q.shape[1]
    t_pad = -(-t // Q_BLOCK) * Q_BLOCK
    scale = 1.0 / math.sqrt(HEAD_DIM)
    qpos = jnp.arange(t_pad).reshape(t_pad // Q_BLOCK, Q_BLOCK)

    def block(args):
        qb, qp = args
        z = jnp.einsum('bqhd,bkhd->bhqk', qb, k).astype(jnp.float32) * scale
        strict = pos[None, :] < qp[:, None]
        log_keep = jnp.where(strict, jax.nn.log_sigmoid(-z), 0.0)
        later = lax.cumsum(log_keep, axis=3, reverse=True) - log_keep
        a = jnp.where(strict, jnp.exp(jax.nn.log_sigmoid(z) + later), 0.0)
        return jnp.einsum('bhqk,bkhd->bqhd', a.astype(v.dtype), v)

    out = lax.map(block, (to_blocks(q, t_pad), qpos))
    return from_blocks(out, t)


def dsa_attention(q_full, kv_all, q_idx, w_idx, k_idx, pos, topk):
    t = q_full.shape[1]
    t_pad = -(-t // Q_BLOCK) * Q_BLOCK
    scale = 1.0 / math.sqrt(HEAD_DIM)
    cid = chunk_ids(pos)
    qcid = chunk_ids(jnp.arange(t_pad)).reshape(t_pad // Q_BLOCK, Q_BLOCK)

    def block(args):
        qf, qi, wi, qc = args
        s_idx = jax.nn.relu(jnp.einsum('bqhd,bkd->bqhk', qi, k_idx))
        score = jnp.einsum('bqh,bqhk->bqk', wi, s_idx).astype(jnp.float32)
        adm = cid[None, :] <= qc[:, None]
        score = jnp.where(adm[None], score, -jnp.inf)
        _, sel = lax.top_k(score, topk)
        valid = cid[sel] <= qc[None, :, None]
        kv_sel = jax.vmap(lambda kv, i: kv[i])(kv_all, sel)
        logits = jnp.einsum('bqhc,bqkc->bqhk', qf, kv_sel).astype(jnp.float32) * scale
        logits = jnp.where(valid[:, :, None, :], logits, -1e30)
        p = jax.nn.softmax(logits, axis=-1)
        return jnp.einsum('bqhk,bqkc->bqhc', p.astype(kv_sel.dtype), kv_sel[..., ROPE_DIM:])

    out = lax.map(block, (to_blocks(q_full, t_pad), to_blocks(q_idx, t_pad), to_blocks(w_idx, t_pad), qcid))
    return from_blocks(out, t)


def mixer(u, w_in, w_uk, w_uv, w_up_a, w_up_b, w_o, pos, topk):
    b, t, _ = u.shape
    proj = u @ w_in
    qa, ka, va, qb, ckv, krope, qi, ki, wi, ga, gb = jnp.split(proj, list(np.cumsum(SPLITS)[:-1]), axis=-1)
    y_a = stick_breaking(qa.reshape(b, t, SB_HEADS, HEAD_DIM), ka.reshape(b, t, SB_HEADS, HEAD_DIM),
                         va.reshape(b, t, SB_HEADS, HEAD_DIM), pos).reshape(b, t, SB_W)
    qb = partial_rope(qb.reshape(b, t, DSA_HEADS, HEAD_DIM), pos)
    q_lat = jnp.einsum('bthn,hcn->bthc', qb[..., ROPE_DIM:], w_uk)
    q_full = jnp.concatenate([qb[..., :ROPE_DIM], q_lat], axis=-1)
    krope = partial_rope(krope[:, :, None, :], pos)[:, :, 0]
    kv_all = jnp.concatenate([krope, ckv], axis=-1)
    qi = partial_rope(qi.reshape(b, t, IDX_HEADS, IDX_DIM), pos)
    ki = partial_rope(ki[:, :, None, :], pos)[:, :, 0]
    o_lat = dsa_attention(q_full, kv_all, qi, wi, ki, pos, topk)
    y_b = jnp.einsum('bthc,hcd->bthd', o_lat, w_uv).reshape(b, t, DSA_W)
    z = jax.nn.sigmoid(ga) * (y_a @ w_up_a) + jax.nn.sigmoid(gb) * (y_b @ w_up_b)
    return z @ w_o


def hier_moe(u, w_group, b_group, w_router, b_router, w1, w3, w2):
    n, d = u.shape
    g_logits = (u @ w_group).astype(jnp.float32) + b_group.astype(jnp.float32)
    g_prob = jax.nn.softmax(g_logits, axis=-1)
    p_grp, g_sel = lax.top_k(g_prob, 1)
    e_logits = ((u @ w_router).astype(jnp.float32) + b_router.astype(jnp.float32)).reshape(n, N_GROUPS, EXP_PER_GROUP)
    gidx = jnp.broadcast_to(g_sel[:, :, None], (n, 1, EXP_PER_GROUP))
    in_grp = jnp.take_along_axis(e_logits, gidx, axis=1)[:, 0]
    e_prob = jax.nn.softmax(in_grp, axis=-1)
    p_exp, e_sel = lax.top_k(e_prob, TOP_E)
    gate = p_grp * p_exp / jnp.sum(p_exp, axis=-1, keepdims=True)
    expert = g_sel * EXP_PER_GROUP + e_sel
    m = n * TOP_E
    e_flat = expert.reshape(m).astype(jnp.int32)
    tok = jnp.repeat(jnp.arange(n, dtype=jnp.int32), TOP_E)
    w_flat = gate.reshape(m)
    order = jnp.argsort(e_flat)
    e_s = e_flat[order]
    counts = jnp.zeros((N_EXPERTS,), jnp.int32).at[e_flat].add(1)
    padded = (counts + EXPERT_BLOCK - 1) // EXPERT_BLOCK * EXPERT_BLOCK
    p_end = jnp.cumsum(padded)
    p_start = p_end - padded
    start = jnp.cumsum(counts) - counts
    dest = p_start[e_s] + jnp.arange(m, dtype=jnp.int32) - start[e_s]
    n_blk = -(-m // EXPERT_BLOCK) + N_EXPERTS
    p_tot = n_blk * EXPERT_BLOCK
    buf_tok = jnp.full((p_tot,), n, jnp.int32).at[dest].set(tok[order])
    buf_w = jnp.zeros((p_tot,), jnp.float32).at[dest].set(w_flat[order])
    blk_e = jnp.minimum(jnp.searchsorted(p_end, jnp.arange(n_blk, dtype=jnp.int32) * EXPERT_BLOCK, side='right'), N_EXPERTS - 1)
    u_pad = jnp.concatenate([u, jnp.zeros((1, d), u.dtype)], axis=0)
    xb = u_pad[buf_tok].reshape(n_blk, EXPERT_BLOCK, d)

    def expert_block(args):
        xe, e = args
        hid = jax.nn.silu(xe @ w1[e]) * (xe @ w3[e])
        return hid @ w2[e]

    yb = lax.map(expert_block, (xb, blk_e)).reshape(p_tot, d)
    out = jnp.zeros((n + 1, d), u.dtype).at[buf_tok].add(yb * buf_w[:, None].astype(yb.dtype))
    return out[:n]


def setup_inputs(seed: int = 0) -> dict:
    key = jax.random.key(seed)
    ks = jax.random.split(key, 20)
    f32 = jnp.float32
    nrm = lambda k, shape, s: jax.random.normal(k, shape, f32) * s
    return {
        "x": nrm(ks[0], (BATCH, SEQ, D_MODEL), 1.0),
        "meta_tokens": nrm(ks[1], (N_META, D_MODEL), 1.0),
        "norm_mix_g": 1.0 + nrm(ks[2], (DEPTH, D_MODEL), 0.02),
        "w_in": nrm(ks[3], (DEPTH, D_MODEL, IN_WIDTH), D_MODEL ** -0.5),
        "w_uk": nrm(ks[4], (DEPTH, DSA_HEADS, KV_LATENT, NOPE_DIM), KV_LATENT ** -0.5),
        "w_uv": nrm(ks[5], (DEPTH, DSA_HEADS, KV_LATENT, HEAD_DIM), KV_LATENT ** -0.5),
        "w_up_a": nrm(ks[6], (DEPTH, SB_W, D_MODEL), SB_W ** -0.5),
        "w_up_b": nrm(ks[7], (DEPTH, DSA_W, D_MODEL), DSA_W ** -0.5),
        "w_o": nrm(ks[8], (DEPTH, D_MODEL, D_MODEL), D_MODEL ** -0.5),
        "norm_ffn_g": 1.0 + nrm(ks[9], (DEPTH, D_MODEL), 0.02),
        "w_group": nrm(ks[10], (DEPTH, D_MODEL, N_GROUPS), D_MODEL ** -0.5),
        "b_group": nrm(ks[11], (DEPTH, N_GROUPS), 0.01),
        "w_router": nrm(ks[12], (DEPTH, D_MODEL, N_EXPERTS), D_MODEL ** -0.5),
        "b_router": nrm(ks[13], (DEPTH, N_EXPERTS), 0.01),
        "w1": nrm(ks[14], (DEPTH, N_EXPERTS, D_MODEL, D_EXPERT), D_MODEL ** -0.5),
        "w3": nrm(ks[15], (DEPTH, N_EXPERTS, D_MODEL, D_EXPERT), D_MODEL ** -0.5),
        "w2": nrm(ks[16], (DEPTH, N_EXPERTS, D_EXPERT, D_MODEL), D_EXPERT ** -0.5),
        "norm_final_g": 1.0 + nrm(ks[17], (D_MODEL,), 0.02),
    }


def reference(x, meta_tokens, norm_mix_g, w_in, w_uk, w_uv, w_up_a, w_up_b, w_o, norm_ffn_g,
              w_group, b_group, w_router, b_router, w1, w3, w2, norm_final_g):
    b, s, d = x.shape
    topk = min(TOPK_MAX, s // 4)
    meta = jnp.broadcast_to(meta_tokens[None].astype(x.dtype), (b, N_META, d))
    h = jnp.concatenate([meta, x], axis=1)
    t = s + N_META
    pos = jnp.arange(t)
    for l in range(DEPTH):
        h = h + mixer(rmsnorm(h, norm_mix_g[l]), w_in[l], w_uk[l], w_uv[l], w_up_a[l], w_up_b[l], w_o[l], pos, topk)
        u = rmsnorm(h, norm_ffn_g[l]).reshape(b * t, d)
        h = h + hier_moe(u, w_group[l], b_group[l], w_router[l], b_router[l], w1[l], w3[l], w2[l]).reshape(b, t, d)
    return rmsnorm(h, norm_final_g)[:, N_META:]
```

```cpp
#include <hip/hip_runtime.h>
#include <hip/hip_cooperative_groups.h>
#include <cstdio>
#include <cstdint>
namespace cg = cooperative_groups;

constexpr int BATCH = 8, SEQ = 4096, NMETA = 16, T = SEQ + NMETA, D = 1024, NTOK = BATCH * T;
constexpr int INW = 4824;
constexpr int NEXP = 32, DEXP = 512;
constexpr float NORM_EPS = 1e-6f;
constexpr float LOG2E = 1.4426950408889634f;
constexpr float QSCALE = 0.125f * LOG2E;
constexpr int PW = 3456;
constexpr int C_QA = 0, C_KA = 512, C_VA = 1024, C_QF = 1536, C_KV = 2688, C_QI = 2832, C_KI = 3344, C_WI = 3408, C_END = 3416;
constexpr int QFW = 144;

constexpr size_t MiB = 1u << 20;
constexpr size_t WS_CTL = 0, CTL_BYTES = 1 * MiB;
constexpr size_t WS_CS = 1 * MiB;
constexpr size_t WS_WP = 2 * MiB;
constexpr size_t WS_WGA = 9 * MiB, WS_WGB = 11 * MiB, WS_WUA = 13 * MiB, WS_WBP = 14 * MiB, WS_WO = 16 * MiB;
constexpr size_t WS_W2 = 18 * MiB;
constexpr size_t WS_W13 = 50 * MiB;
constexpr size_t WS_U = 114 * MiB;
constexpr size_t WS_P = 179 * MiB;
constexpr size_t WS_Z = 179 * MiB;
constexpr size_t WS_H1 = 244 * MiB;
constexpr size_t WS_LIST = 373 * MiB;
constexpr size_t WS_GATE = 378 * MiB;
constexpr size_t WS_YA = 396 * MiB;
constexpr size_t WS_OLAT = 429 * MiB;
constexpr size_t WS_HID = 396 * MiB;
constexpr size_t WS_MO = 50 * MiB;
constexpr size_t WS_END = 494 * MiB;
constexpr int CW_CNT = 1024;

typedef unsigned short bf16_t;
typedef short bf16x8 __attribute__((ext_vector_type(8)));
typedef float f32x4 __attribute__((ext_vector_type(4)));
typedef unsigned u32x2 __attribute__((ext_vector_type(2)));
typedef unsigned u32x4 __attribute__((ext_vector_type(4)));

__device__ __forceinline__ unsigned f2bf(float f) { unsigned u = __float_as_uint(f); return (u + 0x7fffu + ((u >> 16) & 1u)) >> 16; }
__device__ __forceinline__ unsigned pk2(float lo, float hi) { return f2bf(lo) | (f2bf(hi) << 16); }
__device__ __forceinline__ float bflo(unsigned w) { return __uint_as_float(w << 16); }
__device__ __forceinline__ float bfhi(unsigned w) { return __uint_as_float(w & 0xffff0000u); }
__device__ __forceinline__ float bf2f(bf16_t b) { return __uint_as_float((unsigned)b << 16); }
__device__ __forceinline__ float wave_sum(float v) {
#pragma unroll
    for (int o = 1; o < 64; o <<= 1) v += __shfl_xor(v, o);
    return v;
}
__device__ __forceinline__ float wave_max(float v) {
#pragma unroll
    for (int o = 1; o < 64; o <<= 1) v = fmaxf(v, __shfl_xor(v, o));
    return v;
}
__device__ __forceinline__ float sigmoidf(float x) { return 1.0f / (1.0f + __expf(-x)); }

struct Params {
    const float* in[18];
    float* out;
    unsigned char* ws;
    int ph_lo, ph_hi;
};
enum { I_X = 0, I_META, I_GMIX, I_WIN, I_WUK, I_WUV, I_WUPA, I_WUPB, I_WO, I_GFFN, I_WGRP, I_BGRP, I_WRT, I_BRT, I_W1, I_W3, I_W2, I_GFIN };

__device__ __forceinline__ const float* h0_row(const Params& p, int row) {
    const int b = row / T, t = row - b * T;
    return t < NMETA ? p.in[I_META] + (size_t)t * D : p.in[I_X] + ((size_t)b * SEQ + (t - NMETA)) * D;
}

template <class F>
__device__ __forceinline__ void tr_item(F val, bf16_t* dst, int ldd, int row0, int k0, float* scr, int lane) {
#pragma unroll 4
    for (int i = 0; i < 32; ++i) { const int kk = 2 * i + (lane >> 5); scr[kk * 33 + (lane & 31)] = val(k0 + kk, lane & 31); }
    __builtin_amdgcn_s_waitcnt(0xC07F);
    asm volatile("" ::: "memory");
    const int c = lane & 7;
#pragma unroll
    for (int j = 0; j < 4; ++j) {
        const int n = (lane >> 3) + 8 * j; const float* s = scr + (8 * c) * 33 + n;
        u32x4 o; o.x = pk2(s[0], s[33]); o.y = pk2(s[66], s[99]); o.z = pk2(s[132], s[165]); o.w = pk2(s[198], s[231]);
        *(u32x4*)(dst + (size_t)(row0 + n) * ldd + k0 + 8 * c) = o;
    }
    __builtin_amdgcn_s_waitcnt(0xC07F);
    asm volatile("" ::: "memory");
}

__device__ __forceinline__ void wp_src(int c, int& kind, int& col, int& aux, float& scale) {
    kind = 1; aux = 0; scale = 1.f; col = 0;
    if (c < 512) { col = c; scale = QSCALE; }
    else if (c < C_QF) { col = c; }
    else if (c < C_KV) { const int r = c - C_QF, h = r / QFW, j = r % QFW; scale = QSCALE;
        if (j < 128) { kind = 2; col = h; aux = j; } else { const int i = j - 128; col = 1536 + 64 * h + (i >> 1) + 8 * (i & 1); } }
    else if (c < C_QI) { const int j = c - C_KV; if (j < 128) col = 2048 + j; else { const int i = j - 128; col = 2176 + (i >> 1) + 8 * (i & 1); } }
    else if (c < C_KI) { const int r = c - C_QI, h = r >> 6, j = r & 63; col = 2192 + 64 * h + (j < 16 ? (j >> 1) + 8 * (j & 1) : j); }
    else if (c < C_WI) { const int j = c - C_KI; col = 2704 + (j < 16 ? (j >> 1) + 8 * (j & 1) : j); }
    else if (c < C_END) { col = 2768 + (c - C_WI); }
    else kind = 0;
}

constexpr int IT_WP = (PW / 32) * 16;
constexpr int IT_WG = 32 * 16;
constexpr int IT_WUA = 32 * 8;
constexpr int IT_WBP = 32 * 16, IT_WO = 32 * 16;
constexpr int IT_W13 = NEXP * 32 * 16;
constexpr int IT_W2 = NEXP * 32 * 8;
constexpr int IT_TOTAL = IT_WP + 2 * IT_WG + IT_WUA + IT_WBP + IT_WO + IT_W13 + IT_W2;

__device__ __forceinline__ void phase_prologue(const Params& p, char* lds) {
    const int tid = threadIdx.x, lane = tid & 63, wave = tid >> 6;
    const int gw = blockIdx.x * 4 + wave, NGW = gridDim.x * 4;
    float* scr = (float*)lds + wave * (64 * 33);
    unsigned char* ws = p.ws;
    const float* w_in = p.in[I_WIN];
    {
        float2* cs = (float2*)(ws + WS_CS);
        for (int i = blockIdx.x * 256 + tid; i < T * 8; i += gridDim.x * 256) {
            const int pos = i >> 3, f = i & 7;
            const float inv = powf(500000.0f, -(float)f / 8.0f);
            const float ang = (float)pos * inv;
            cs[i] = make_float2(cosf(ang), sinf(ang));
        }
    }
    for (int it = gw; it < IT_TOTAL; it += NGW) {
        int r = it;
        if (r < IT_WP) {
            const int rg = r / 16, kb = r % 16, c = rg * 32 + (lane & 31);
            int kind, col, aux; float scale; wp_src(c, kind, col, aux, scale);
            const float* w_uk = p.in[I_WUK];
            tr_item([&](int k, int) -> float {
                if (kind == 0) return 0.f;
                if (kind == 1) return scale * w_in[(size_t)k * INW + col];
                const float* wi = w_in + (size_t)k * INW + 1536 + 64 * col + 16; const float* wu = w_uk + ((size_t)col * 128 + aux) * 48;
                float s = 0.f;
#pragma unroll 8
                for (int n = 0; n < 48; ++n) s += wi[n] * wu[n];
                return scale * s; }, (bf16_t*)(ws + WS_WP), 1024, rg * 32, kb * 64, scr, lane);
            continue; }
        r -= IT_WP;
        if (r < 2 * IT_WG) {
            const int which = r / IT_WG; r %= IT_WG; const int rg = r / 16, kb = r % 16; const int col0 = (which ? 3800 : 2776) + rg * 32;
            tr_item([&](int k, int n) -> float { return w_in[(size_t)k * INW + col0 + n]; }, (bf16_t*)(ws + (which ? WS_WGB : WS_WGA)), 1024, rg * 32, kb * 64, scr, lane);
            continue; }
        r -= 2 * IT_WG;
        if (r < IT_WUA) {
            const int rg = r / 8, kb = r % 8; const float* w = p.in[I_WUPA];
            tr_item([&](int k, int n) -> float { return w[(size_t)k * 1024 + rg * 32 + n]; }, (bf16_t*)(ws + WS_WUA), 512, rg * 32, kb * 64, scr, lane);
            continue; }
        r -= IT_WUA;
        if (r < IT_WBP) {
            const int rg = r / 16, kb = r % 16; const float* wuv = p.in[I_WUV]; const float* wub = p.in[I_WUPB];
            tr_item([&](int kk, int n) -> float {
                const int h = kk >> 7; const float* a = wuv + (size_t)kk * 64; const float* b = wub + (size_t)(64 * h) * 1024 + rg * 32 + n;
                float s = 0.f;
#pragma unroll 8
                for (int d = 0; d < 64; ++d) s += a[d] * b[(size_t)d * 1024];
                return s; }, (bf16_t*)(ws + WS_WBP), 1024, rg * 32, kb * 64, scr, lane);
            continue; }
        r -= IT_WBP;
        if (r < IT_WO) {
            const int rg = r / 16, kb = r % 16; const float* w = p.in[I_WO];
            tr_item([&](int k, int n) -> float { return w[(size_t)k * 1024 + rg * 32 + n]; }, (bf16_t*)(ws + WS_WO), 1024, rg * 32, kb * 64, scr, lane);
            continue; }
        r -= IT_WO;
        if (r < IT_W13) {
            const int e = r / 512; r %= 512; const int rg = r / 16, kb = r % 16;
            const float* w1 = p.in[I_W1] + (size_t)e * 1024 * 512; const float* w3 = p.in[I_W3] + (size_t)e * 1024 * 512;
            tr_item([&](int k, int n) -> float { const int rr = rg * 32 + n; const float* w = (rr & 1) ? w3 : w1; return w[(size_t)k * 512 + (rr >> 1)]; },
                    (bf16_t*)(ws + WS_W13) + (size_t)e * 1024 * 1024, 1024, rg * 32, kb * 64, scr, lane);
            continue; }
        r -= IT_W13;
        {
            const int e = r / 256; r %= 256; const int rg = r / 8, kb = r % 8;
            const float* w2 = p.in[I_W2] + (size_t)e * 512 * 1024;
            tr_item([&](int k, int n) -> float { return w2[(size_t)k * 1024 + rg * 32 + n]; }, (bf16_t*)(ws + WS_W2) + (size_t)e * 1024 * 512, 512, rg * 32, kb * 64, scr, lane);
        }
    }
    {
        const float* g = p.in[I_GMIX]; bf16_t* U = (bf16_t*)(ws + WS_U);
        for (int row = gw; row < NTOK; row += NGW) {
            const f32x4* xr = (const f32x4*)h0_row(p, row) + lane;
            f32x4 v[4]; float s = 0.f;
#pragma unroll
            for (int j = 0; j < 4; ++j) { v[j] = xr[64 * j]; s += (v[j].x * v[j].x + v[j].y * v[j].y) + (v[j].z * v[j].z + v[j].w * v[j].w); }
            const float rstd = rsqrtf(wave_sum(s) * (1.f / D) + NORM_EPS);
            u32x2* o = (u32x2*)(U + (size_t)row * D) + lane;
#pragma unroll
            for (int j = 0; j < 4; ++j) { const f32x4 gg = ((const f32x4*)g)[lane + 64 * j];
                u32x2 w; w.x = pk2(v[j].x * rstd * gg.x, v[j].y * rstd * gg.y); w.y = pk2(v[j].z * rstd * gg.z, v[j].w * rstd * gg.w); o[64 * j] = w; }
        }
    }
}

struct MLNaive {
    static constexpr int TM = 64, TN = 64, NF = 4, NR = 1, LDS_BYTES = 2 * 64 * 33 * 4;
    static __device__ __forceinline__ void pos(int tid, int f, int& r, int& c) { r = (tid >> 4) * 4 + f; c = (tid & 15) * 4; }
    static __device__ __forceinline__ void run(char* lds, const bf16_t* const* ap, const bf16_t* const* bp, int K, f32x4* acc) {
        const int tid = threadIdx.x; float* As = (float*)lds; float* Bs = As + 64 * 33;
        const int lr = tid >> 2, lc = (tid & 3) * 8, ty = tid >> 4, tx = tid & 15;
#pragma unroll
        for (int f = 0; f < 4; ++f) acc[f] = (f32x4){0.f, 0.f, 0.f, 0.f};
        for (int kt = 0; kt < K; kt += 32) {
            const u32x4 av = *(const u32x4*)(ap[0] + kt), bv = *(const u32x4*)(bp[0] + kt);
            __syncthreads();
            float* a = As + lr * 33 + lc; float* b = Bs + lr * 33 + lc;
            a[0] = bflo(av.x); a[1] = bfhi(av.x); a[2] = bflo(av.y); a[3] = bfhi(av.y); a[4] = bflo(av.z); a[5] = bfhi(av.z); a[6] = bflo(av.w); a[7] = bfhi(av.w);
            b[0] = bflo(bv.x); b[1] = bfhi(bv.x); b[2] = bflo(bv.y); b[3] = bfhi(bv.y); b[4] = bflo(bv.z); b[5] = bfhi(bv.z); b[6] = bflo(bv.w); b[7] = bfhi(bv.w);
            __syncthreads();
#pragma unroll 8
            for (int k = 0; k < 32; ++k) {
                float aa[4], bb[4];
#pragma unroll
                for (int i = 0; i < 4; ++i) { aa[i] = As[(ty * 4 + i) * 33 + k]; bb[i] = Bs[(tx * 4 + i) * 33 + k]; }
#pragma unroll
                for (int i = 0; i < 4; ++i) { acc[i].x += aa[i] * bb[0]; acc[i].y += aa[i] * bb[1]; acc[i].z += aa[i] * bb[2]; acc[i].w += aa[i] * bb[3]; }
            }
        }
        __syncthreads();
    }
};

#define LAS __attribute__((address_space(3)))
struct MLFast {
    static constexpr int TM = 128, TN = 128, NF = 16, NR = 2, LDS_BYTES = 2 * 128 * 32 * 2;
    static __device__ __forceinline__ void pos(int tid, int f, int& r, int& c) {
        const int wid = tid >> 6, lane = tid & 63, wr = wid >> 1, wc = wid & 1, fr = lane & 15, fq = lane >> 4, m = f >> 2, n = f & 3;
        r = wr * 64 + m * 16 + fr; c = wc * 64 + n * 16 + 4 * fq; }
    static __device__ __forceinline__ void run(char* lds, const bf16_t* const* ap, const bf16_t* const* bp, int K, f32x4* acc) {
        const int tid = threadIdx.x, wid = __builtin_amdgcn_readfirstlane(tid >> 6), lane = tid & 63, wr = wid >> 1, wc = wid & 1, fr = lane & 15, fq = lane >> 4;
        char* SA = lds; char* SB = lds + 8192;
#pragma unroll
        for (int f = 0; f < 16; ++f) acc[f] = (f32x4){0.f, 0.f, 0.f, 0.f};
        for (int kt = 0; kt < K; kt += 32) {
#pragma unroll
            for (int i = 0; i < 2; ++i) {
                __builtin_amdgcn_global_load_lds((const unsigned*)(ap[i] + kt), (LAS unsigned*)(SA + wid * 1024 + i * 4096), 16, 0, 0);
                __builtin_amdgcn_global_load_lds((const unsigned*)(bp[i] + kt), (LAS unsigned*)(SB + wid * 1024 + i * 4096), 16, 0, 0);
            }
            asm volatile("s_waitcnt vmcnt(0)" ::: "memory");
            __syncthreads();
            bf16x8 At[4], Bt[4];
#pragma unroll
            for (int m = 0; m < 4; ++m) { At[m] = *(const bf16x8*)(SA + (wr * 64 + m * 16 + fr) * 64 + fq * 16); Bt[m] = *(const bf16x8*)(SB + (wc * 64 + m * 16 + fr) * 64 + fq * 16); }
#pragma unroll
            for (int m = 0; m < 4; ++m)
#pragma unroll
                for (int n = 0; n < 4; ++n) acc[m * 4 + n] = __builtin_amdgcn_mfma_f32_16x16x32_bf16(Bt[n], At[m], acc[m * 4 + n], 0, 0, 0);
            __syncthreads();
        }
    }
};

template <class ML, class Epi>
__device__ __forceinline__ void gemm_dense(char* lds, const bf16_t* A, int lda, int M, const bf16_t* Bt, int ldb, int N, int K, Epi epi) {
    const int tid = threadIdx.x, ntn = N / ML::TN, ntiles = (M / ML::TM) * ntn;
    for (int tile = blockIdx.x; tile < ntiles; tile += gridDim.x) {
        const int m0 = (tile / ntn) * ML::TM, n0 = (tile % ntn) * ML::TN;
        const bf16_t* ap[2]; const bf16_t* bp[2];
#pragma unroll
        for (int i = 0; i < ML::NR; ++i) { const int r = (tid >> 2) + 64 * i, c = (tid & 3) * 8; ap[i] = A + (size_t)(m0 + r) * lda + c; bp[i] = Bt + (size_t)(n0 + r) * ldb + c; }
        f32x4 acc[ML::NF];
        ML::run(lds, ap, bp, K, acc);
#pragma unroll
        for (int f = 0; f < ML::NF; ++f) { int r, c; ML::pos(tid, f, r, c); epi(m0 + r, n0 + c, acc[f]); }
    }
}

__device__ __forceinline__ bool rope_off(int c, int& o) {
    if (c < C_QF) return false;
    if (c < C_KV) { const int j = (c - C_QF) % QFW; o = j - 128; return j >= 128; }
    if (c < C_QI) { const int j = c - C_KV; o = j - 128; return j >= 128; }
    if (c < C_KI) { const int j = (c - C_QI) & 63; o = j; return j < 16; }
    if (c < C_WI) { const int j = c - C_KI; o = j; return j < 16; }
    return false;
}
template <class ML>
__device__ __forceinline__ void phase_inproj(const Params& p, char* lds) {
    unsigned char* ws = p.ws; bf16_t* P = (bf16_t*)(ws + WS_P); const float2* cs = (const float2*)(ws + WS_CS);
    gemm_dense<ML>(lds, (const bf16_t*)(ws + WS_U), D, NTOK, (const bf16_t*)(ws + WS_WP), D, PW, D,
        [&](int row, int col, f32x4 v) {
            int o;
            if (rope_off(col, o)) {
                const int pos = row % T; const float2 c0 = cs[pos * 8 + (o >> 1)], c1 = cs[pos * 8 + (o >> 1) + 1];
                const float a0 = v.x * c0.x - v.y * c0.y, b0 = v.y * c0.x + v.x * c0.y, a1 = v.z * c1.x - v.w * c1.y, b1 = v.w * c1.x + v.z * c1.y;
                v = (f32x4){a0, b0, a1, b1};
            }
            u32x2 w; w.x = pk2(v.x, v.y); w.y = pk2(v.z, v.w);
            *(u32x2*)(P + (size_t)row * PW + col) = w;
        });
}

__device__ __forceinline__ void phase_sb_gold(const Params& p) {
    const bf16_t* P = (const bf16_t*)(p.ws + WS_P); bf16_t* YA = (bf16_t*)(p.ws + WS_YA);
    const int total = BATCH * 8 * T;
    for (int idx = blockIdx.x * 256 + threadIdx.x; idx < total; idx += gridDim.x * 256) {
        const int i = idx % T, bh = idx / T, h = bh & 7, b = bh >> 3;
        const size_t rowq = (size_t)b * T + i;
        float q[64], o[64];
        { const u32x4* qp = (const u32x4*)(P + rowq * PW + C_QA + h * 64);
#pragma unroll
          for (int c = 0; c < 8; ++c) { const u32x4 w = qp[c]; q[8 * c] = bflo(w.x); q[8 * c + 1] = bfhi(w.x); q[8 * c + 2] = bflo(w.y); q[8 * c + 3] = bfhi(w.y); q[8 * c + 4] = bflo(w.z); q[8 * c + 5] = bfhi(w.z); q[8 * c + 6] = bflo(w.w); q[8 * c + 7] = bfhi(w.w); } }
#pragma unroll
        for (int d = 0; d < 64; ++d) o[d] = 0.f;
        float L = 0.f;
        for (int j = i - 1; j >= 0; --j) {
            const size_t rowk = (size_t)b * T + j;
            const u32x4* kp = (const u32x4*)(P + rowk * PW + C_KA + h * 64);
            float s = 0.f;
#pragma unroll
            for (int c = 0; c < 8; ++c) { const u32x4 w = kp[c];
                s += q[8 * c] * bflo(w.x) + q[8 * c + 1] * bfhi(w.x) + q[8 * c + 2] * bflo(w.y) + q[8 * c + 3] * bfhi(w.y) + q[8 * c + 4] * bflo(w.z) + q[8 * c + 5] * bfhi(w.z) + q[8 * c + 6] * bflo(w.w) + q[8 * c + 7] * bfhi(w.w); }
            s = fminf(s, 80.f);
            const float lk = -__log2f(1.f + exp2f(s));
            const float a = exp2f(s + lk + L);
            L += lk;
            const u32x4* vp = (const u32x4*)(P + rowk * PW + C_VA + h * 64);
#pragma unroll
            for (int c = 0; c < 8; ++c) { const u32x4 w = vp[c];
                o[8 * c] += a * bflo(w.x); o[8 * c + 1] += a * bfhi(w.x); o[8 * c + 2] += a * bflo(w.y); o[8 * c + 3] += a * bfhi(w.y); o[8 * c + 4] += a * bflo(w.z); o[8 * c + 5] += a * bfhi(w.z); o[8 * c + 6] += a * bflo(w.w); o[8 * c + 7] += a * bfhi(w.w); }
        }
        u32x4* yp = (u32x4*)(YA + rowq * 512 + h * 64);
#pragma unroll
        for (int c = 0; c < 8; ++c) { u32x4 w; w.x = pk2(o[8 * c], o[8 * c + 1]); w.y = pk2(o[8 * c + 2], o[8 * c + 3]); w.z = pk2(o[8 * c + 4], o[8 * c + 5]); w.w = pk2(o[8 * c + 6], o[8 * c + 7]); yp[c] = w; }
    }
}

__device__ __forceinline__ unsigned fkey(float f) { const unsigned u = __float_as_uint(f); return (u & 0x80000000u) ? ~u : (u | 0x80000000u); }
__device__ __forceinline__ void phase_dsa_gold(const Params& p, char* lds) {
    const bf16_t* P = (const bf16_t*)(p.ws + WS_P); bf16_t* OL = (bf16_t*)(p.ws + WS_OLAT);
    const int tid = threadIdx.x, lane = tid & 63, wave = tid >> 6;
    unsigned* sc = (unsigned*)lds;
    float* qi = (float*)(lds + 16512);
    float* qf = qi + 512;
    float* lg = qf + 8 * QFW;
    float* wq = lg + 2048;
    int* list = (int*)(wq + 8);
    int* ctr = list + 256;
    for (int row = blockIdx.x; row < NTOK; row += gridDim.x) {
        const int b = row / T, t = row - b * T;
        const int cid = t < NMETA ? 0 : 1 + (t - NMETA) / 64;
        const int n = NMETA + 64 * cid;
        const bf16_t* prow = P + (size_t)row * PW;
        __syncthreads();
        for (int i = tid; i < 512; i += 256) qi[i] = bf2f(prow[C_QI + i]);
        for (int i = tid; i < 8 * QFW; i += 256) qf[i] = bf2f(prow[C_QF + i]);
        if (tid < 8) wq[tid] = bf2f(prow[C_WI + tid]);
        if (tid < 8) ctr[tid] = 0;
        __syncthreads();
        for (int k = tid; k < n; k += 256) {
            const u32x4* kp = (const u32x4*)(P + ((size_t)b * T + k) * PW + C_KI);
            float kk[64];
#pragma unroll
            for (int c = 0; c < 8; ++c) { const u32x4 w = kp[c]; kk[8 * c] = bflo(w.x); kk[8 * c + 1] = bfhi(w.x); kk[8 * c + 2] = bflo(w.y); kk[8 * c + 3] = bfhi(w.y); kk[8 * c + 4] = bflo(w.z); kk[8 * c + 5] = bfhi(w.z); kk[8 * c + 6] = bflo(w.w); kk[8 * c + 7] = bfhi(w.w); }
            float s = 0.f;
            for (int h = 0; h < 8; ++h) { float d = 0.f;
#pragma unroll
                for (int e = 0; e < 64; ++e) d += qi[h * 64 + e] * kk[e];
                s += wq[h] * fmaxf(d, 0.f); }
            sc[k] = fkey(s);
        }
        __syncthreads();
        unsigned prefix = 0;
        for (int bit = 31; bit >= 0; --bit) {
            const unsigned cand = prefix | (1u << bit);
            int c = 0; for (int k = tid; k < n; k += 256) c += (sc[k] >= cand) ? 1 : 0;
            c = (int)wave_sum((float)c);
            if (lane == 0) atomicAdd(&ctr[2 + (bit & 1)], c);
            __syncthreads();
            const int tot = ctr[2 + (bit & 1)];
            if (tid == 0) ctr[2 + ((bit + 1) & 1)] = 0;
            if (tot >= 256) prefix = cand;
            __syncthreads();
        }
        {
            int cgt = 0, ceq = 0;
            for (int k = tid; k < n; k += 256) { const unsigned u = sc[k]; cgt += u > prefix; ceq += u == prefix; }
            cgt = (int)wave_sum((float)cgt); ceq = (int)wave_sum((float)ceq);
            if (lane == 0) { atomicAdd(&ctr[4], cgt); atomicAdd(&ctr[5], ceq); }
            __syncthreads();
            const int ngt = ctr[4], neq = ctr[5]; int need = 256 - ngt; if (need > neq) need = neq;
            for (int k = tid; k < n; k += 256) { const unsigned u = sc[k]; if (u > prefix || (u == prefix && neq == need)) { const int s = atomicAdd(&ctr[0], 1); list[s] = k; } }
            __syncthreads();
            if (neq != need && tid == 0) { int s = ctr[0], got = 0; for (int k = 0; k < n && got < need; ++k) if (sc[k] == prefix) { list[s++] = k; ++got; } ctr[0] = s; }
            __syncthreads();
        }
        const int nsel = ctr[0];
        for (int idx = tid; idx < 8 * 256; idx += 256) {
            const int h = idx >> 8, s = idx & 255; float l = -1e30f;
            if (s < nsel) { const u32x2* kp = (const u32x2*)(P + ((size_t)b * T + list[s]) * PW + C_KV); const float* q = qf + h * QFW; float d = 0.f;
#pragma unroll 4
                for (int c = 0; c < QFW / 4; ++c) { const u32x2 w = kp[c]; d += q[4 * c] * bflo(w.x) + q[4 * c + 1] * bfhi(w.x) + q[4 * c + 2] * bflo(w.y) + q[4 * c + 3] * bfhi(w.y); }
                l = d; }
            lg[idx] = l;
        }
        __syncthreads();
        for (int h = wave * 2; h < wave * 2 + 2; ++h) {
            float v[4]; float m = -3e38f;
#pragma unroll
            for (int j = 0; j < 4; ++j) { v[j] = lg[h * 256 + lane + 64 * j]; m = fmaxf(m, v[j]); }
            m = wave_max(m); float s = 0.f;
#pragma unroll
            for (int j = 0; j < 4; ++j) { v[j] = exp2f(v[j] - m); s += v[j]; }
            s = wave_sum(s); const float inv = 1.f / s;
#pragma unroll
            for (int j = 0; j < 4; ++j) lg[h * 256 + lane + 64 * j] = v[j] * inv;
        }
        __syncthreads();
        for (int idx = tid; idx < 1024; idx += 256) {
            const int h = idx >> 7, c = idx & 127; float o = 0.f;
            for (int s = 0; s < nsel; ++s) o += lg[h * 256 + s] * bf2f(P[((size_t)b * T + list[s]) * PW + C_KV + c]);
            OL[(size_t)row * 1024 + idx] = (bf16_t)f2bf(o);
        }
    }
}

template <class ML>
__device__ __forceinline__ void phase_c1(const Params& p, char* lds) {
    unsigned char* ws = p.ws; const int tid = threadIdx.x;
    const bf16_t* U = (const bf16_t*)(ws + WS_U); const bf16_t* YA = (const bf16_t*)(ws + WS_YA); const bf16_t* OL = (const bf16_t*)(ws + WS_OLAT);
    const bf16_t* WGA = (const bf16_t*)(ws + WS_WGA); const bf16_t* WGB = (const bf16_t*)(ws + WS_WGB); const bf16_t* WUA = (const bf16_t*)(ws + WS_WUA); const bf16_t* WBP = (const bf16_t*)(ws + WS_WBP);
    bf16_t* Z = (bf16_t*)(ws + WS_Z);
    const int ntn = D / ML::TN, ntiles = (NTOK / ML::TM) * ntn;
    for (int tile = blockIdx.x; tile < ntiles; tile += gridDim.x) {
        const int m0 = (tile / ntn) * ML::TM, n0 = (tile % ntn) * ML::TN;
        const int lr = tid >> 2, lc = (tid & 3) * 8;
        const bf16_t* ap[2]; const bf16_t* bp[2];
        f32x4 acc[ML::NF], z[ML::NF]; u32x2 sg[ML::NF];
#define C1_PTRS(Ab, lda_, Bb, ldb_) _Pragma("unroll") for (int i = 0; i < ML::NR; ++i) { ap[i] = (Ab) + (size_t)(m0 + lr + 64 * i) * (lda_) + lc; bp[i] = (Bb) + (size_t)(n0 + lr + 64 * i) * (ldb_) + lc; }
        C1_PTRS(U, D, WGA, D); ML::run(lds, ap, bp, D, acc);
#pragma unroll
        for (int f = 0; f < ML::NF; ++f) { sg[f].x = pk2(sigmoidf(acc[f].x), sigmoidf(acc[f].y)); sg[f].y = pk2(sigmoidf(acc[f].z), sigmoidf(acc[f].w)); }
        C1_PTRS(YA, 512, WUA, 512); ML::run(lds, ap, bp, 512, acc);
#pragma unroll
        for (int f = 0; f < ML::NF; ++f) z[f] = (f32x4){bflo(sg[f].x) * acc[f].x, bfhi(sg[f].x) * acc[f].y, bflo(sg[f].y) * acc[f].z, bfhi(sg[f].y) * acc[f].w};
        C1_PTRS(U, D, WGB, D); ML::run(lds, ap, bp, D, acc);
#pragma unroll
        for (int f = 0; f < ML::NF; ++f) { sg[f].x = pk2(sigmoidf(acc[f].x), sigmoidf(acc[f].y)); sg[f].y = pk2(sigmoidf(acc[f].z), sigmoidf(acc[f].w)); }
        C1_PTRS(OL, D, WBP, D); ML::run(lds, ap, bp, D, acc);
#pragma unroll
        for (int f = 0; f < ML::NF; ++f) {
            const f32x4 v = (f32x4){z[f].x + bflo(sg[f].x) * acc[f].x, z[f].y + bfhi(sg[f].x) * acc[f].y, z[f].z + bflo(sg[f].y) * acc[f].z, z[f].w + bfhi(sg[f].y) * acc[f].w};
            int r, c; ML::pos(tid, f, r, c); u32x2 w; w.x = pk2(v.x, v.y); w.y = pk2(v.z, v.w);
            *(u32x2*)(Z + (size_t)(m0 + r) * D + n0 + c) = w;
        }
#undef C1_PTRS
    }
}

template <class ML>
__device__ __forceinline__ void phase_c2(const Params& p, char* lds) {
    unsigned char* ws = p.ws; float* H1 = (float*)(ws + WS_H1);
    gemm_dense<ML>(lds, (const bf16_t*)(ws + WS_Z), D, NTOK, (const bf16_t*)(ws + WS_WO), D, D, D,
        [&](int row, int col, f32x4 v) { const f32x4 h = *(const f32x4*)(h0_row(p, row) + col); *(f32x4*)(H1 + (size_t)row * D + col) = h + v; });
}

__device__ __forceinline__ void phase_c3(const Params& p, char* lds) {
    unsigned char* ws = p.ws; const int tid = threadIdx.x, lane = tid & 63, wave = tid >> 6;
    const float* H1 = (const float*)(ws + WS_H1); const float* g = p.in[I_GFFN];
    {
        bf16_t* U2 = (bf16_t*)(ws + WS_U); const int gw = blockIdx.x * 4 + wave, NGW = gridDim.x * 4;
        for (int row = gw; row < NTOK; row += NGW) {
            const f32x4* xr = (const f32x4*)(H1 + (size_t)row * D) + lane;
            f32x4 v[4]; float s = 0.f;
#pragma unroll
            for (int j = 0; j < 4; ++j) { v[j] = xr[64 * j]; s += (v[j].x * v[j].x + v[j].y * v[j].y) + (v[j].z * v[j].z + v[j].w * v[j].w); }
            const float rstd = rsqrtf(wave_sum(s) * (1.f / D) + NORM_EPS);
            u32x2* o = (u32x2*)(U2 + (size_t)row * D) + lane;
#pragma unroll
            for (int j = 0; j < 4; ++j) { const f32x4 gg = ((const f32x4*)g)[lane + 64 * j];
                u32x2 w; w.x = pk2(v[j].x * rstd * gg.x, v[j].y * rstd * gg.y); w.y = pk2(v[j].z * rstd * gg.z, v[j].w * rstd * gg.w); o[64 * j] = w; }
        }
    }
    {
        float* Tl = (float*)lds;
        const float* wg = p.in[I_WGRP]; const float* wr = p.in[I_WRT]; const float* bg = p.in[I_BGRP]; const float* br = p.in[I_BRT];
        unsigned* ctl = (unsigned*)(ws + WS_CTL); int* LIST = (int*)(ws + WS_LIST); float* GATE = (float*)(ws + WS_GATE);
        const int ngroups = (NTOK + 255) / 256;
        for (int grp = blockIdx.x; grp < ngroups; grp += gridDim.x) {
            const int tok0 = grp * 256, tok = tok0 + tid;
            float acc[36]; float ss = 0.f;
#pragma unroll
            for (int o = 0; o < 36; ++o) acc[o] = 0.f;
            for (int k0 = 0; k0 < D; k0 += 32) {
                __syncthreads();
#pragma unroll
                for (int i = 0; i < 8; ++i) { const int idx = tid + 256 * i, tk = idx >> 3, kc = idx & 7; const int rr = tok0 + tk < NTOK ? tok0 + tk : NTOK - 1;
                    const f32x4 v = *(const f32x4*)(H1 + (size_t)rr * D + k0 + kc * 4);
                    Tl[(kc * 4 + 0) * 257 + tk] = v.x; Tl[(kc * 4 + 1) * 257 + tk] = v.y; Tl[(kc * 4 + 2) * 257 + tk] = v.z; Tl[(kc * 4 + 3) * 257 + tk] = v.w; }
                __syncthreads();
#pragma unroll 4
                for (int k = 0; k < 32; ++k) {
                    const float h = Tl[k * 257 + tid]; ss += h * h; const float hg = h * g[k0 + k];
                    const float* w4 = wg + (size_t)(k0 + k) * 4; const float* w32 = wr + (size_t)(k0 + k) * 32;
#pragma unroll
                    for (int o = 0; o < 4; ++o) acc[o] += hg * w4[o];
#pragma unroll
                    for (int o = 0; o < 32; ++o) acc[4 + o] += hg * w32[o];
                }
            }
            if (tok < NTOK) {
                const float rstd = rsqrtf(ss * (1.f / D) + NORM_EPS);
                float gl[4]; int gs = 0; float gm;
#pragma unroll
                for (int o = 0; o < 4; ++o) gl[o] = acc[o] * rstd + bg[o];
                gm = gl[0];
#pragma unroll
                for (int o = 1; o < 4; ++o) if (gl[o] > gm) { gm = gl[o]; gs = o; }
                float gsum = 0.f;
#pragma unroll
                for (int o = 0; o < 4; ++o) gsum += __expf(gl[o] - gm);
                const float pgrp = 1.f / gsum;
                float el[8];
#pragma unroll
                for (int j = 0; j < 8; ++j) { float a = acc[4 + j]; float bb = br[j];
                    a = gs == 1 ? acc[12 + j] : a; bb = gs == 1 ? br[8 + j] : bb; a = gs == 2 ? acc[20 + j] : a; bb = gs == 2 ? br[16 + j] : bb; a = gs == 3 ? acc[28 + j] : a; bb = gs == 3 ? br[24 + j] : bb;
                    el[j] = a * rstd + bb; }
                int e0 = 0; float m0 = el[0];
#pragma unroll
                for (int j = 1; j < 8; ++j) if (el[j] > m0) { m0 = el[j]; e0 = j; }
                int e1 = -1; float m1 = -3e38f;
#pragma unroll
                for (int j = 0; j < 8; ++j) if (j != e0 && el[j] > m1) { m1 = el[j]; e1 = j; }
                const float x1 = __expf(m1 - m0); const float g0 = pgrp / (1.f + x1), g1 = pgrp * x1 / (1.f + x1);
                const int ex0 = gs * 8 + e0, ex1 = gs * 8 + e1;
                const int s0 = (int)atomicAdd(ctl + CW_CNT + 64 * ex0, 1u); LIST[(size_t)ex0 * NTOK + s0] = tok * 2;
                const int s1 = (int)atomicAdd(ctl + CW_CNT + 64 * ex1, 1u); LIST[(size_t)ex1 * NTOK + s1] = tok * 2 + 1;
                GATE[tok * 2] = g0; GATE[tok * 2 + 1] = g1;
            }
        }
    }
}

template <class ML, int WHICH>
__device__ __forceinline__ void phase_moe(const Params& p, char* lds) {
    unsigned char* ws = p.ws; const int tid = threadIdx.x;
    const unsigned* ctl = (const unsigned*)(ws + WS_CTL); const int* LIST = (const int*)(ws + WS_LIST); const float* GATE = (const float*)(ws + WS_GATE);
    const bf16_t* U2 = (const bf16_t*)(ws + WS_U); bf16_t* HID = (bf16_t*)(ws + WS_HID); bf16_t* MO = (bf16_t*)(ws + WS_MO);
    const bf16_t* W13 = (const bf16_t*)(ws + WS_W13); const bf16_t* W2 = (const bf16_t*)(ws + WS_W2);
    constexpr int NOUT = 1024, KK = WHICH == 0 ? 1024 : 512, ntn = NOUT / ML::TN;
    int tile_base = 0, rowoff = 0; int total = 0;
    for (int e = 0; e < NEXP; ++e) total += (((int)ctl[CW_CNT + 64 * e] + ML::TM - 1) / ML::TM) * ntn;
    int e = 0, cnt_e = (int)ctl[CW_CNT], nt_e = ((cnt_e + ML::TM - 1) / ML::TM) * ntn;
    for (int tile = blockIdx.x; tile < total; tile += gridDim.x) {
        while (tile >= tile_base + nt_e) { tile_base += nt_e; rowoff += (cnt_e + 127) / 128 * 128; ++e; cnt_e = (int)ctl[CW_CNT + 64 * e]; nt_e = ((cnt_e + ML::TM - 1) / ML::TM) * ntn; }
        const int lt = tile - tile_base, mt = lt / ntn, n0 = (lt % ntn) * ML::TN, s0 = mt * ML::TM;
        const bf16_t* ap[2]; const bf16_t* bp[2]; const int lr = tid >> 2, lc = (tid & 3) * 8;
#pragma unroll
        for (int i = 0; i < ML::NR; ++i) {
            const int s = s0 + lr + 64 * i;
            if (WHICH == 0) { const int tok = s < cnt_e ? (LIST[(size_t)e * NTOK + s] >> 1) : 0; ap[i] = U2 + (size_t)tok * D + lc; bp[i] = W13 + ((size_t)e * 1024 + n0 + lr + 64 * i) * 1024 + lc; }
            else { ap[i] = HID + (size_t)(rowoff + s) * DEXP + lc; bp[i] = W2 + ((size_t)e * 1024 + n0 + lr + 64 * i) * 512 + lc; }
        }
        f32x4 acc[ML::NF];
        ML::run(lds, ap, bp, KK, acc);
#pragma unroll
        for (int f = 0; f < ML::NF; ++f) {
            int r, c; ML::pos(tid, f, r, c); const int s = s0 + r; const f32x4 v = acc[f];
            if (WHICH == 0) {
                const float h0 = v.x / (1.f + __expf(-v.x)) * v.y, h1 = v.z / (1.f + __expf(-v.z)) * v.w;
                *(unsigned*)(HID + (size_t)(rowoff + s) * DEXP + ((n0 + c) >> 1)) = pk2(h0, h1);
            } else if (s < cnt_e) {
                const int ent = LIST[(size_t)e * NTOK + s]; const float gt = GATE[ent];
                u32x2 w; w.x = pk2(v.x * gt, v.y * gt); w.y = pk2(v.z * gt, v.w * gt);
                *(u32x2*)(MO + (size_t)ent * D + n0 + c) = w;
            }
        }
    }
}

__device__ __forceinline__ void phase_final(const Params& p) {
    unsigned char* ws = p.ws; const int tid = threadIdx.x, lane = tid & 63, wave = tid >> 6;
    const float* H1 = (const float*)(ws + WS_H1); const bf16_t* MO = (const bf16_t*)(ws + WS_MO); const float* g = p.in[I_GFIN];
    const int gw = blockIdx.x * 4 + wave, NGW = gridDim.x * 4;
    for (int orow = gw; orow < BATCH * SEQ; orow += NGW) {
        const int b = orow / SEQ, s = orow - b * SEQ; const size_t row = (size_t)b * T + NMETA + s;
        const f32x4* xr = (const f32x4*)(H1 + row * D) + lane; const u32x2* m0 = (const u32x2*)(MO + row * 2 * D) + lane; const u32x2* m1 = m0 + 256;
        f32x4 v[4]; float ss = 0.f;
#pragma unroll
        for (int j = 0; j < 4; ++j) { const u32x2 a = m0[64 * j], c = m1[64 * j]; v[j] = xr[64 * j];
            v[j].x += bflo(a.x) + bflo(c.x); v[j].y += bfhi(a.x) + bfhi(c.x); v[j].z += bflo(a.y) + bflo(c.y); v[j].w += bfhi(a.y) + bfhi(c.y);
            ss += (v[j].x * v[j].x + v[j].y * v[j].y) + (v[j].z * v[j].z + v[j].w * v[j].w); }
        const float rstd = rsqrtf(wave_sum(ss) * (1.f / D) + NORM_EPS);
        f32x4* o = (f32x4*)(p.out + (size_t)orow * D) + lane;
#pragma unroll
        for (int j = 0; j < 4; ++j) { const f32x4 gg = ((const f32x4*)g)[lane + 64 * j]; o[64 * j] = v[j] * rstd * gg; }
    }
}

#ifndef GOLD_GEMM
#define GOLD_GEMM 1
#endif
#if GOLD_GEMM
typedef MLNaive MLX;
#else
typedef MLFast MLX;
#endif
constexpr int LDS_BYTES = 40960;

template <bool COOP>
__global__ void __launch_bounds__(256, 2) mega(Params p) {
    extern __shared__ __attribute__((aligned(16))) char lds[];
    const int lo = p.ph_lo, hi = p.ph_hi;
#define IN(k) (lo <= (k) && (k) < hi)
#define SEAM(k) do { if constexpr (COOP) { if (IN(k) && IN((k) + 1)) cg::this_grid().sync(); } } while (0)
    if (IN(0)) phase_prologue(p, lds);
    SEAM(0);
    if (IN(1)) phase_inproj<MLX>(p, lds);
    SEAM(1);
    if (IN(2)) { phase_sb_gold(p); phase_dsa_gold(p, lds); }
    SEAM(2);
    if (IN(3)) phase_c1<MLX>(p, lds);
    SEAM(3);
    if (IN(4)) phase_c2<MLX>(p, lds);
    SEAM(4);
    if (IN(5)) phase_c3(p, lds);
    SEAM(5);
    if (IN(6)) phase_moe<MLX, 0>(p, lds);
    SEAM(6);
    if (IN(7)) phase_moe<MLX, 1>(p, lds);
    SEAM(7);
    if (IN(8)) phase_final(p);
}

extern "C" void kernel_launch(void* const* d_in, const int* in_sizes, int n_in, void* d_out, int out_size, void* d_ws, size_t ws_size, hipStream_t stream) {
    if (n_in != 18 || ws_size < WS_END) { fprintf(stderr, "kernel_launch: unexpected n_in %d / ws_size %zu\n", n_in, ws_size); return; }
    static int grid = 0;
    if (grid == 0) {
        int dev = 0, cus = 0, per_cu = 0;
        (void)hipGetDevice(&dev);
        (void)hipDeviceGetAttribute(&cus, hipDeviceAttributeMultiprocessorCount, dev);
        (void)hipOccupancyMaxActiveBlocksPerMultiprocessor(&per_cu, (const void*)mega<true>, 256, LDS_BYTES);
        if (per_cu > 2) per_cu = 2;
        if (per_cu < 1) per_cu = 1;
        grid = cus * per_cu;
    }
    (void)hipMemsetAsync((char*)d_ws + WS_CTL, 0, CTL_BYTES, stream);
    Params p{};
    for (int i = 0; i < 18; ++i) p.in[i] = (const float*)d_in[i];
    p.out = (float*)d_out; p.ws = (unsigned char*)d_ws;
    p.ph_lo = 0; p.ph_hi = 9;
    void* args[] = {&p};
    hipError_t e = hipLaunchCooperativeKernel((const void*)mega<true>, dim3(grid), dim3(256), args, LDS_BYTES, stream);
    if (e != hipSuccess) fprintf(stderr, "cooperative launch failed: %s (grid %d)\n", hipGetErrorString(e), grid);
}
```

```cpp
#include <hip/hip_runtime.h>
#include <hip/hip_cooperative_groups.h>
#include <cstdio>
#include <cstdint>
namespace cg = cooperative_groups;

constexpr int BATCH = 8, SEQ = 4096, NMETA = 16, T = SEQ + NMETA, D = 1024, NTOK = BATCH * T;
constexpr int INW = 4824;
constexpr int NEXP = 32, DEXP = 512;
constexpr float NORM_EPS = 1e-6f;
constexpr float LOG2E = 1.4426950408889634f;
constexpr float QSCALE = 0.125f * LOG2E;
constexpr int PW = 3456;
constexpr int C_QA = 0, C_KA = 512, C_VA = 1024, C_QF = 1536, C_KV = 2688, C_QI = 2832, C_KI = 3344, C_WI = 3408, C_END = 3416;
constexpr int QFW = 144;

constexpr size_t MiB = 1u << 20;
constexpr size_t WS_CTL = 0, CTL_BYTES = 1 * MiB;
constexpr size_t WS_CS = 1 * MiB;
constexpr size_t WS_WP = 2 * MiB;
constexpr size_t WS_WGA = 9 * MiB, WS_WGB = 11 * MiB, WS_WUA = 13 * MiB, WS_WBP = 14 * MiB, WS_WO = 16 * MiB;
constexpr size_t WS_W2 = 18 * MiB;
constexpr size_t WS_W13 = 50 * MiB;
constexpr size_t WS_U = 114 * MiB;
constexpr size_t WS_P = 179 * MiB;
constexpr size_t WS_Z = 179 * MiB;
constexpr size_t WS_H1 = 244 * MiB;
constexpr size_t WS_LIST = 373 * MiB;
constexpr size_t WS_GATE = 378 * MiB;
constexpr size_t WS_YA = 396 * MiB;
constexpr size_t WS_OLAT = 429 * MiB;
constexpr size_t WS_HID = 396 * MiB;
constexpr size_t WS_MO = 50 * MiB;
constexpr size_t WS_END = 494 * MiB;
constexpr int CW_CNT = 1024;

typedef unsigned short bf16_t;
typedef short bf16x8 __attribute__((ext_vector_type(8)));
typedef float f32x4 __attribute__((ext_vector_type(4)));
typedef unsigned u32x2 __attribute__((ext_vector_type(2)));
typedef unsigned u32x4 __attribute__((ext_vector_type(4)));

__device__ __forceinline__ unsigned f2bf(float f) { unsigned u = __float_as_uint(f); return (u + 0x7fffu + ((u >> 16) & 1u)) >> 16; }
__device__ __forceinline__ unsigned pk2(float lo, float hi) { return f2bf(lo) | (f2bf(hi) << 16); }
__device__ __forceinline__ float bflo(unsigned w) { return __uint_as_float(w << 16); }
__device__ __forceinline__ float bfhi(unsigned w) { return __uint_as_float(w & 0xffff0000u); }
__device__ __forceinline__ float bf2f(bf16_t b) { return __uint_as_float((unsigned)b << 16); }
__device__ __forceinline__ float wave_sum(float v) {
#pragma unroll
    for (int o = 1; o < 64; o <<= 1) v += __shfl_xor(v, o);
    return v;
}
__device__ __forceinline__ float wave_max(float v) {
#pragma unroll
    for (int o = 1; o < 64; o <<= 1) v = fmaxf(v, __shfl_xor(v, o));
    return v;
}
__device__ __forceinline__ float sigmoidf(float x) { return 1.0f / (1.0f + __expf(-x)); }

struct Params {
    const float* in[18];
    float* out;
    unsigned char* ws;
    int ph_lo, ph_hi;
};
enum { I_X = 0, I_META, I_GMIX, I_WIN, I_WUK, I_WUV, I_WUPA, I_WUPB, I_WO, I_GFFN, I_WGRP, I_BGRP, I_WRT, I_BRT, I_W1, I_W3, I_W2, I_GFIN };

__device__ __forceinline__ const float* h0_row(const Params& p, int row) {
    const int b = row / T, t = row - b * T;
    return t < NMETA ? p.in[I_META] + (size_t)t * D : p.in[I_X] + ((size_t)b * SEQ + (t - NMETA)) * D;
}

template <class F>
__device__ __forceinline__ void tr_item(F val, bf16_t* dst, int ldd, int row0, int k0, float* scr, int lane) {
#pragma unroll 4
    for (int i = 0; i < 32; ++i) { const int kk = 2 * i + (lane >> 5); scr[kk * 33 + (lane & 31)] = val(k0 + kk, lane & 31); }
    __builtin_amdgcn_s_waitcnt(0xC07F);
    asm volatile("" ::: "memory");
    const int c = lane & 7;
#pragma unroll
    for (int j = 0; j < 4; ++j) {
        const int n = (lane >> 3) + 8 * j; const float* s = scr + (8 * c) * 33 + n;
        u32x4 o; o.x = pk2(s[0], s[33]); o.y = pk2(s[66], s[99]); o.z = pk2(s[132], s[165]); o.w = pk2(s[198], s[231]);
        *(u32x4*)(dst + (size_t)(row0 + n) * ldd + k0 + 8 * c) = o;
    }
    __builtin_amdgcn_s_waitcnt(0xC07F);
    asm volatile("" ::: "memory");
}

__device__ __forceinline__ void wp_src(int c, int& kind, int& col, int& aux, float& scale) {
    kind = 1; aux = 0; scale = 1.f; col = 0;
    if (c < 512) { col = c; scale = QSCALE; }
    else if (c < C_QF) { col = c; }
    else if (c < C_KV) { const int r = c - C_QF, h = r / QFW, j = r % QFW; scale = QSCALE;
        if (j < 128) { kind = 2; col = h; aux = j; } else { const int i = j - 128; col = 1536 + 64 * h + (i >> 1) + 8 * (i & 1); } }
    else if (c < C_QI) { const int j = c - C_KV; if (j < 128) col = 2048 + j; else { const int i = j - 128; col = 2176 + (i >> 1) + 8 * (i & 1); } }
    else if (c < C_KI) { const int r = c - C_QI, h = r >> 6, j = r & 63; col = 2192 + 64 * h + (j < 16 ? (j >> 1) + 8 * (j & 1) : j); }
    else if (c < C_WI) { const int j = c - C_KI; col = 2704 + (j < 16 ? (j >> 1) + 8 * (j & 1) : j); }
    else if (c < C_END) { col = 2768 + (c - C_WI); }
    else kind = 0;
}

constexpr int IT_WP = (PW / 32) * 16;
constexpr int IT_WG = 32 * 16;
constexpr int IT_WUA = 32 * 8;
constexpr int IT_WBP = 32 * 16, IT_WO = 32 * 16;
constexpr int IT_W13 = NEXP * 32 * 16;
constexpr int IT_W2 = NEXP * 32 * 8;
constexpr int IT_TOTAL = IT_WP + 2 * IT_WG + IT_WUA + IT_WBP + IT_WO + IT_W13 + IT_W2;

__device__ __forceinline__ void phase_prologue(const Params& p, char* lds) {
    const int tid = threadIdx.x, lane = tid & 63, wave = tid >> 6;
    const int gw = blockIdx.x * 4 + wave, NGW = gridDim.x * 4;
    float* scr = (float*)lds + wave * (64 * 33);
    unsigned char* ws = p.ws;
    const float* w_in = p.in[I_WIN];
    {
        float2* cs = (float2*)(ws + WS_CS);
        for (int i = blockIdx.x * 256 + tid; i < T * 8; i += gridDim.x * 256) {
            const int pos = i >> 3, f = i & 7;
            const float inv = powf(500000.0f, -(float)f / 8.0f);
            const float ang = (float)pos * inv;
            cs[i] = make_float2(cosf(ang), sinf(ang));
        }
    }
    for (int it = gw; it < IT_TOTAL; it += NGW) {
        int r = it;
        if (r < IT_WP) {
            const int rg = r / 16, kb = r % 16, c = rg * 32 + (lane & 31);
            int kind, col, aux; float scale; wp_src(c, kind, col, aux, scale);
            const float* w_uk = p.in[I_WUK];
            tr_item([&](int k, int) -> float {
                if (kind == 0) return 0.f;
                if (kind == 1) return scale * w_in[(size_t)k * INW + col];
                const float* wi = w_in + (size_t)k * INW + 1536 + 64 * col + 16; const float* wu = w_uk + ((size_t)col * 128 + aux) * 48;
                float s = 0.f;
#pragma unroll 8
                for (int n = 0; n < 48; ++n) s += wi[n] * wu[n];
                return scale * s; }, (bf16_t*)(ws + WS_WP), 1024, rg * 32, kb * 64, scr, lane);
            continue; }
        r -= IT_WP;
        if (r < 2 * IT_WG) {
            const int which = r / IT_WG; r %= IT_WG; const int rg = r / 16, kb = r % 16; const int col0 = (which ? 3800 : 2776) + rg * 32;
            tr_item([&](int k, int n) -> float { return w_in[(size_t)k * INW + col0 + n]; }, (bf16_t*)(ws + (which ? WS_WGB : WS_WGA)), 1024, rg * 32, kb * 64, scr, lane);
            continue; }
        r -= 2 * IT_WG;
        if (r < IT_WUA) {
            const int rg = r / 8, kb = r % 8; const float* w = p.in[I_WUPA];
            tr_item([&](int k, int n) -> float { return w[(size_t)k * 1024 + rg * 32 + n]; }, (bf16_t*)(ws + WS_WUA), 512, rg * 32, kb * 64, scr, lane);
            continue; }
        r -= IT_WUA;
        if (r < IT_WBP) {
            const int rg = r / 16, kb = r % 16; const float* wuv = p.in[I_WUV]; const float* wub = p.in[I_WUPB];
            tr_item([&](int kk, int n) -> float {
                const int h = kk >> 7; const float* a = wuv + (size_t)kk * 64; const float* b = wub + (size_t)(64 * h) * 1024 + rg * 32 + n;
                float s = 0.f;
#pragma unroll 8
                for (int d = 0; d < 64; ++d) s += a[d] * b[(size_t)d * 1024];
                return s; }, (bf16_t*)(ws + WS_WBP), 1024, rg * 32, kb * 64, scr, lane);
            continue; }
        r -= IT_WBP;
        if (r < IT_WO) {
            const int rg = r / 16, kb = r % 16; const float* w = p.in[I_WO];
            tr_item([&](int k, int n) -> float { return w[(size_t)k * 1024 + rg * 32 + n]; }, (bf16_t*)(ws + WS_WO), 1024, rg * 32, kb * 64, scr, lane);
            continue; }
        r -= IT_WO;
        if (r < IT_W13) {
            const int e = r / 512; r %= 512; const int rg = r / 16, kb = r % 16;
            const float* w1 = p.in[I_W1] + (size_t)e * 1024 * 512; const float* w3 = p.in[I_W3] + (size_t)e * 1024 * 512;
            tr_item([&](int k, int n) -> float { const int rr = rg * 32 + n; const float* w = (rr & 1) ? w3 : w1; return w[(size_t)k * 512 + (rr >> 1)]; },
                    (bf16_t*)(ws + WS_W13) + (size_t)e * 1024 * 1024, 1024, rg * 32, kb * 64, scr, lane);
            continue; }
        r -= IT_W13;
        {
            const int e = r / 256; r %= 256; const int rg = r / 8, kb = r % 8;
            const float* w2 = p.in[I_W2] + (size_t)e * 512 * 1024;
            tr_item([&](int k, int n) -> float { return w2[(size_t)k * 1024 + rg * 32 + n]; }, (bf16_t*)(ws + WS_W2) + (size_t)e * 1024 * 512, 512, rg * 32, kb * 64, scr, lane);
        }
    }
    {
        const float* g = p.in[I_GMIX]; bf16_t* U = (bf16_t*)(ws + WS_U);
        for (int row = gw; row < NTOK; row += NGW) {
            const f32x4* xr = (const f32x4*)h0_row(p, row) + lane;
            f32x4 v[4]; float s = 0.f;
#pragma unroll
            for (int j = 0; j < 4; ++j) { v[j] = xr[64 * j]; s += (v[j].x * v[j].x + v[j].y * v[j].y) + (v[j].z * v[j].z + v[j].w * v[j].w); }
            const float rstd = rsqrtf(wave_sum(s) * (1.f / D) + NORM_EPS);
            u32x2* o = (u32x2*)(U + (size_t)row * D) + lane;
#pragma unroll
            for (int j = 0; j < 4; ++j) { const f32x4 gg = ((const f32x4*)g)[lane + 64 * j];
                u32x2 w; w.x = pk2(v[j].x * rstd * gg.x, v[j].y * rstd * gg.y); w.y = pk2(v[j].z * rstd * gg.z, v[j].w * rstd * gg.w); o[64 * j] = w; }
        }
    }
}

struct MLNaive {
    static constexpr int TM = 64, TN = 64, NF = 4, NR = 1, LDS_BYTES = 2 * 64 * 33 * 4;
    static __device__ __forceinline__ void pos(int tid, int f, int& r, int& c) { r = (tid >> 4) * 4 + f; c = (tid & 15) * 4; }
    static __device__ __forceinline__ void run(char* lds, const bf16_t* const* ap, const bf16_t* const* bp, int K, f32x4* acc) {
        const int tid = threadIdx.x; float* As = (float*)lds; float* Bs = As + 64 * 33;
        const int lr = tid >> 2, lc = (tid & 3) * 8, ty = tid >> 4, tx = tid & 15;
#pragma unroll
        for (int f = 0; f < 4; ++f) acc[f] = (f32x4){0.f, 0.f, 0.f, 0.f};
        for (int kt = 0; kt < K; kt += 32) {
            const u32x4 av = *(const u32x4*)(ap[0] + kt), bv = *(const u32x4*)(bp[0] + kt);
            __syncthreads();
            float* a = As + lr * 33 + lc; float* b = Bs + lr * 33 + lc;
            a[0] = bflo(av.x); a[1] = bfhi(av.x); a[2] = bflo(av.y); a[3] = bfhi(av.y); a[4] = bflo(av.z); a[5] = bfhi(av.z); a[6] = bflo(av.w); a[7] = bfhi(av.w);
            b[0] = bflo(bv.x); b[1] = bfhi(bv.x); b[2] = bflo(bv.y); b[3] = bfhi(bv.y); b[4] = bflo(bv.z); b[5] = bfhi(bv.z); b[6] = bflo(bv.w); b[7] = bfhi(bv.w);
            __syncthreads();
#pragma unroll 8
            for (int k = 0; k < 32; ++k) {
                float aa[4], bb[4];
#pragma unroll
                for (int i = 0; i < 4; ++i) { aa[i] = As[(ty * 4 + i) * 33 + k]; bb[i] = Bs[(tx * 4 + i) * 33 + k]; }
#pragma unroll
                for (int i = 0; i < 4; ++i) { acc[i].x += aa[i] * bb[0]; acc[i].y += aa[i] * bb[1]; acc[i].z += aa[i] * bb[2]; acc[i].w += aa[i] * bb[3]; }
            }
        }
        __syncthreads();
    }
};

#define LAS __attribute__((address_space(3)))
struct MLFast {
    static constexpr int TM = 128, TN = 128, NF = 16, NR = 2, LDS_BYTES = 2 * 128 * 32 * 2;
    static __device__ __forceinline__ void pos(int tid, int f, int& r, int& c) {
        const int wid = tid >> 6, lane = tid & 63, wr = wid >> 1, wc = wid & 1, fr = lane & 15, fq = lane >> 4, m = f >> 2, n = f & 3;
        r = wr * 64 + m * 16 + fr; c = wc * 64 + n * 16 + 4 * fq; }
    static __device__ __forceinline__ void run(char* lds, const bf16_t* const* ap, const bf16_t* const* bp, int K, f32x4* acc) {
        const int tid = threadIdx.x, wid = __builtin_amdgcn_readfirstlane(tid >> 6), lane = tid & 63, wr = wid >> 1, wc = wid & 1, fr = lane & 15, fq = lane >> 4;
        char* SA = lds; char* SB = lds + 8192;
#pragma unroll
        for (int f = 0; f < 16; ++f) acc[f] = (f32x4){0.f, 0.f, 0.f, 0.f};
        for (int kt = 0; kt < K; kt += 32) {
#pragma unroll
            for (int i = 0; i < 2; ++i) {
                __builtin_amdgcn_global_load_lds((const unsigned*)(ap[i] + kt), (LAS unsigned*)(SA + wid * 1024 + i * 4096), 16, 0, 0);
                __builtin_amdgcn_global_load_lds((const unsigned*)(bp[i] + kt), (LAS unsigned*)(SB + wid * 1024 + i * 4096), 16, 0, 0);
            }
            asm volatile("s_waitcnt vmcnt(0)" ::: "memory");
            __syncthreads();
            bf16x8 At[4], Bt[4];
#pragma unroll
            for (int m = 0; m < 4; ++m) { At[m] = *(const bf16x8*)(SA + (wr * 64 + m * 16 + fr) * 64 + fq * 16); Bt[m] = *(const bf16x8*)(SB + (wc * 64 + m * 16 + fr) * 64 + fq * 16); }
#pragma unroll
            for (int m = 0; m < 4; ++m)
#pragma unroll
                for (int n = 0; n < 4; ++n) acc[m * 4 + n] = __builtin_amdgcn_mfma_f32_16x16x32_bf16(Bt[n], At[m], acc[m * 4 + n], 0, 0, 0);
            __syncthreads();
        }
    }
};

template <class ML, class Epi>
__device__ __forceinline__ void gemm_dense(char* lds, const bf16_t* A, int lda, int M, const bf16_t* Bt, int ldb, int N, int K, Epi epi) {
    const int tid = threadIdx.x, ntn = N / ML::TN, ntiles = (M / ML::TM) * ntn;
    for (int tile = blockIdx.x; tile < ntiles; tile += gridDim.x) {
        const int m0 = (tile / ntn) * ML::TM, n0 = (tile % ntn) * ML::TN;
        const bf16_t* ap[2]; const bf16_t* bp[2];
#pragma unroll
        for (int i = 0; i < ML::NR; ++i) { const int r = (tid >> 2) + 64 * i, c = (tid & 3) * 8; ap[i] = A + (size_t)(m0 + r) * lda + c; bp[i] = Bt + (size_t)(n0 + r) * ldb + c; }
        f32x4 acc[ML::NF];
        ML::run(lds, ap, bp, K, acc);
#pragma unroll
        for (int f = 0; f < ML::NF; ++f) { int r, c; ML::pos(tid, f, r, c); epi(m0 + r, n0 + c, acc[f]); }
    }
}

__device__ __forceinline__ bool rope_off(int c, int& o) {
    if (c < C_QF) return false;
    if (c < C_KV) { const int j = (c - C_QF) % QFW; o = j - 128; return j >= 128; }
    if (c < C_QI) { const int j = c - C_KV; o = j - 128; return j >= 128; }
    if (c < C_KI) { const int j = (c - C_QI) & 63; o = j; return j < 16; }
    if (c < C_WI) { const int j = c - C_KI; o = j; return j < 16; }
    return false;
}
template <class ML>
__device__ __forceinline__ void phase_inproj(const Params& p, char* lds) {
    unsigned char* ws = p.ws; bf16_t* P = (bf16_t*)(ws + WS_P); const float2* cs = (const float2*)(ws + WS_CS);
    gemm_dense<ML>(lds, (const bf16_t*)(ws + WS_U), D, NTOK, (const bf16_t*)(ws + WS_WP), D, PW, D,
        [&](int row, int col, f32x4 v) {
            int o;
            if (rope_off(col, o)) {
                const int pos = row % T; const float2 c0 = cs[pos * 8 + (o >> 1)], c1 = cs[pos * 8 + (o >> 1) + 1];
                const float a0 = v.x * c0.x - v.y * c0.y, b0 = v.y * c0.x + v.x * c0.y, a1 = v.z * c1.x - v.w * c1.y, b1 = v.w * c1.x + v.z * c1.y;
                v = (f32x4){a0, b0, a1, b1};
            }
            u32x2 w; w.x = pk2(v.x, v.y); w.y = pk2(v.z, v.w);
            *(u32x2*)(P + (size_t)row * PW + col) = w;
        });
}

__device__ __forceinline__ void phase_sb_gold(const Params& p) {
    const bf16_t* P = (const bf16_t*)(p.ws + WS_P); bf16_t* YA = (bf16_t*)(p.ws + WS_YA);
    const int total = BATCH * 8 * T;
    for (int idx = blockIdx.x * 256 + threadIdx.x; idx < total; idx += gridDim.x * 256) {
        const int i = idx % T, bh = idx / T, h = bh & 7, b = bh >> 3;
        const size_t rowq = (size_t)b * T + i;
        float q[64], o[64];
        { const u32x4* qp = (const u32x4*)(P + rowq * PW + C_QA + h * 64);
#pragma unroll
          for (int c = 0; c < 8; ++c) { const u32x4 w = qp[c]; q[8 * c] = bflo(w.x); q[8 * c + 1] = bfhi(w.x); q[8 * c + 2] = bflo(w.y); q[8 * c + 3] = bfhi(w.y); q[8 * c + 4] = bflo(w.z); q[8 * c + 5] = bfhi(w.z); q[8 * c + 6] = bflo(w.w); q[8 * c + 7] = bfhi(w.w); } }
#pragma unroll
        for (int d = 0; d < 64; ++d) o[d] = 0.f;
        float L = 0.f;
        for (int j = i - 1; j >= 0; --j) {
            const size_t rowk = (size_t)b * T + j;
            const u32x4* kp = (const u32x4*)(P + rowk * PW + C_KA + h * 64);
            float s = 0.f;
#pragma unroll
            for (int c = 0; c < 8; ++c) { const u32x4 w = kp[c];
                s += q[8 * c] * bflo(w.x) + q[8 * c + 1] * bfhi(w.x) + q[8 * c + 2] * bflo(w.y) + q[8 * c + 3] * bfhi(w.y) + q[8 * c + 4] * bflo(w.z) + q[8 * c + 5] * bfhi(w.z) + q[8 * c + 6] * bflo(w.w) + q[8 * c + 7] * bfhi(w.w); }
            s = fminf(s, 80.f);
            const float lk = -__log2f(1.f + exp2f(s));
            const float a = exp2f(s + lk + L);
            L += lk;
            const u32x4* vp = (const u32x4*)(P + rowk * PW + C_VA + h * 64);
#pragma unroll
            for (int c = 0; c < 8; ++c) { const u32x4 w = vp[c];
                o[8 * c] += a * bflo(w.x); o[8 * c + 1] += a * bfhi(w.x); o[8 * c + 2] += a * bflo(w.y); o[8 * c + 3] += a * bfhi(w.y); o[8 * c + 4] += a * bflo(w.z); o[8 * c + 5] += a * bfhi(w.z); o[8 * c + 6] += a * bflo(w.w); o[8 * c + 7] += a * bfhi(w.w); }
        }
        u32x4* yp = (u32x4*)(YA + rowq * 512 + h * 64);
#pragma unroll
        for (int c = 0; c < 8; ++c) { u32x4 w; w.x = pk2(o[8 * c], o[8 * c + 1]); w.y = pk2(o[8 * c + 2], o[8 * c + 3]); w.z = pk2(o[8 * c + 4], o[8 * c + 5]); w.w = pk2(o[8 * c + 6], o[8 * c + 7]); yp[c] = w; }
    }
}

__device__ __forceinline__ unsigned fkey(float f) { const unsigned u = __float_as_uint(f); return (u & 0x80000000u) ? ~u : (u | 0x80000000u); }
__device__ __forceinline__ void phase_dsa_gold(const Params& p, char* lds) {
    const bf16_t* P = (const bf16_t*)(p.ws + WS_P); bf16_t* OL = (bf16_t*)(p.ws + WS_OLAT);
    const int tid = threadIdx.x, lane = tid & 63, wave = tid >> 6;
    unsigned* sc = (unsigned*)lds;
    float* qi = (float*)(lds + 16512);
    float* qf = qi + 512;
    float* lg = qf + 8 * QFW;
    float* wq = lg + 2048;
    int* list = (int*)(wq + 8);
    int* ctr = list + 256;
    for (int row = blockIdx.x; row < NTOK; row += gridDim.x) {
        const int b = row / T, t = row - b * T;
        const int cid = t < NMETA ? 0 : 1 + (t - NMETA) / 64;
        const int n = NMETA + 64 * cid;
        const bf16_t* prow = P + (size_t)row * PW;
        __syncthreads();
        for (int i = tid; i < 512; i += 256) qi[i] = bf2f(prow[C_QI + i]);
        for (int i = tid; i < 8 * QFW; i += 256) qf[i] = bf2f(prow[C_QF + i]);
        if (tid < 8) wq[tid] = bf2f(prow[C_WI + tid]);
        if (tid < 8) ctr[tid] = 0;
        __syncthreads();
        for (int k = tid; k < n; k += 256) {
            const u32x4* kp = (const u32x4*)(P + ((size_t)b * T + k) * PW + C_KI);
            float kk[64];
#pragma unroll
            for (int c = 0; c < 8; ++c) { const u32x4 w = kp[c]; kk[8 * c] = bflo(w.x); kk[8 * c + 1] = bfhi(w.x); kk[8 * c + 2] = bflo(w.y); kk[8 * c + 3] = bfhi(w.y); kk[8 * c + 4] = bflo(w.z); kk[8 * c + 5] = bfhi(w.z); kk[8 * c + 6] = bflo(w.w); kk[8 * c + 7] = bfhi(w.w); }
            float s = 0.f;
            for (int h = 0; h < 8; ++h) { float d = 0.f;
#pragma unroll
                for (int e = 0; e < 64; ++e) d += qi[h * 64 + e] * kk[e];
                s += wq[h] * fmaxf(d, 0.f); }
            sc[k] = fkey(s);
        }
        __syncthreads();
        unsigned prefix = 0;
        for (int bit = 31; bit >= 0; --bit) {
            const unsigned cand = prefix | (1u << bit);
            int c = 0; for (int k = tid; k < n; k += 256) c += (sc[k] >= cand) ? 1 : 0;
            c = (int)wave_sum((float)c);
            if (lane == 0) atomicAdd(&ctr[2 + (bit & 1)], c);
            __syncthreads();
            const int tot = ctr[2 + (bit & 1)];
            if (tid == 0) ctr[2 + ((bit + 1) & 1)] = 0;
            if (tot >= 256) prefix = cand;
            __syncthreads();
        }
        {
            int cgt = 0, ceq = 0;
            for (int k = tid; k < n; k += 256) { const unsigned u = sc[k]; cgt += u > prefix; ceq += u == prefix; }
            cgt = (int)wave_sum((float)cgt); ceq = (int)wave_sum((float)ceq);
            if (lane == 0) { atomicAdd(&ctr[4], cgt); atomicAdd(&ctr[5], ceq); }
            __syncthreads();
            const int ngt = ctr[4], neq = ctr[5]; int need = 256 - ngt; if (need > neq) need = neq;
            for (int k = tid; k < n; k += 256) { const unsigned u = sc[k]; if (u > prefix || (u == prefix && neq == need)) { const int s = atomicAdd(&ctr[0], 1); list[s] = k; } }
            __syncthreads();
            if (neq != need && tid == 0) { int s = ctr[0], got = 0; for (int k = 0; k < n && got < need; ++k) if (sc[k] == prefix) { list[s++] = k; ++got; } ctr[0] = s; }
            __syncthreads();
        }
        const int nsel = ctr[0];
        for (int idx = tid; idx < 8 * 256; idx += 256) {
            const int h = idx >> 8, s = idx & 255; float l = -1e30f;
            if (s < nsel) { const u32x2* kp = (const u32x2*)(P + ((size_t)b * T + list[s]) * PW + C_KV); const float* q = qf + h * QFW; float d = 0.f;
#pragma unroll 4
                for (int c = 0; c < QFW / 4; ++c) { const u32x2 w = kp[c]; d += q[4 * c] * bflo(w.x) + q[4 * c + 1] * bfhi(w.x) + q[4 * c + 2] * bflo(w.y) + q[4 * c + 3] * bfhi(w.y); }
                l = d; }
            lg[idx] = l;
        }
        __syncthreads();
        for (int h = wave * 2; h < wave * 2 + 2; ++h) {
            float v[4]; float m = -3e38f;
#pragma unroll
            for (int j = 0; j < 4; ++j) { v[j] = lg[h * 256 + lane + 64 * j]; m = fmaxf(m, v[j]); }
            m = wave_max(m); float s = 0.f;
#pragma unroll
            for (int j = 0; j < 4; ++j) { v[j] = exp2f(v[j] - m); s += v[j]; }
            s = wave_sum(s); const float inv = 1.f / s;
#pragma unroll
            for (int j = 0; j < 4; ++j) lg[h * 256 + lane + 64 * j] = v[j] * inv;
        }
        __syncthreads();
        for (int idx = tid; idx < 1024; idx += 256) {
            const int h = idx >> 7, c = idx & 127; float o = 0.f;
            for (int s = 0; s < nsel; ++s) o += lg[h * 256 + s] * bf2f(P[((size_t)b * T + list[s]) * PW + C_KV + c]);
            OL[(size_t)row * 1024 + idx] = (bf16_t)f2bf(o);
        }
    }
}

typedef float f32x16 __attribute__((ext_vector_type(16)));
constexpr int SB_NQT = (T + 31) / 32;
constexpr int SB_VT_STRIDE = 40;
__device__ __forceinline__ void phase_sb_fast(const Params& p, char* lds) {
    const bf16_t* P = (const bf16_t*)(p.ws + WS_P); bf16_t* YA = (bf16_t*)(p.ws + WS_YA);
    const int tid = threadIdx.x, lane = tid & 63, wave = tid >> 6, n = lane & 31, hh = lane >> 5;
    bf16_t* VT = (bf16_t*)(lds + wave * (64 * SB_VT_STRIDE * 2));
    const int gw = blockIdx.x * 4 + wave, NGW = gridDim.x * 4;
    for (int unit = gw; unit < 64 * SB_NQT; unit += NGW) {
        const int qt = SB_NQT - 1 - unit / 64, bh = unit % 64, h = bh & 7, b = bh >> 3;
        const int i0 = qt * 32, qi = i0 + n, qrow = qi < T ? qi : T - 1;
        const bf16_t* Pb = P + (size_t)b * T * PW;
        bf16x8 qf[4];
#pragma unroll
        for (int s = 0; s < 4; ++s) qf[s] = *(const bf16x8*)(Pb + (size_t)qrow * PW + C_QA + h * 64 + 16 * s + 8 * hh);
        f32x16 o0, o1;
#pragma unroll
        for (int r = 0; r < 16; ++r) { o0[r] = 0.f; o1[r] = 0.f; }
        float L = 0.f;
        for (int kt = qt; kt >= 0; --kt) {
            const int j0 = kt * 32, krow = (j0 + n) < T ? (j0 + n) : T - 1;
            bf16x8 kf[4];
#pragma unroll
            for (int s = 0; s < 4; ++s) kf[s] = *(const bf16x8*)(Pb + (size_t)krow * PW + C_KA + h * 64 + 16 * s + 8 * hh);
#pragma unroll
            for (int i = 0; i < 4; ++i) {
                const int c = lane + 64 * i, key = c >> 3, d0 = (c & 7) * 8, vrow = (j0 + key) < T ? (j0 + key) : T - 1;
                const u32x4 w = *(const u32x4*)(Pb + (size_t)vrow * PW + C_VA + h * 64 + d0);
                bf16_t* vp = VT + d0 * SB_VT_STRIDE + key;
                vp[0] = (bf16_t)(w.x & 0xffff); vp[SB_VT_STRIDE] = (bf16_t)(w.x >> 16); vp[2 * SB_VT_STRIDE] = (bf16_t)(w.y & 0xffff); vp[3 * SB_VT_STRIDE] = (bf16_t)(w.y >> 16);
                vp[4 * SB_VT_STRIDE] = (bf16_t)(w.z & 0xffff); vp[5 * SB_VT_STRIDE] = (bf16_t)(w.z >> 16); vp[6 * SB_VT_STRIDE] = (bf16_t)(w.w & 0xffff); vp[7 * SB_VT_STRIDE] = (bf16_t)(w.w >> 16);
            }
            f32x16 sa;
#pragma unroll
            for (int r = 0; r < 16; ++r) sa[r] = 0.f;
#pragma unroll
            for (int s = 0; s < 4; ++s) sa = __builtin_amdgcn_mfma_f32_32x32x16_bf16(kf[s], qf[s], sa, 0, 0, 0);
            float lk[16], z[16];
#pragma unroll
            for (int r = 0; r < 16; ++r) {
                const int kk = (r & 3) + 8 * (r >> 2) + 4 * hh; const bool valid = (j0 + kk) < qi;
                const float zz = fminf(sa[r], 80.f); const float l = -__log2f(1.f + exp2f(zz));
                z[r] = zz; lk[r] = valid ? l : 0.f;
            }
            const float gs0 = (lk[0] + lk[1]) + (lk[2] + lk[3]), gs1 = (lk[4] + lk[5]) + (lk[6] + lk[7]), gs2 = (lk[8] + lk[9]) + (lk[10] + lk[11]), gs3 = (lk[12] + lk[13]) + (lk[14] + lk[15]);
            const float ps0 = __shfl_xor(gs0, 32), ps1 = __shfl_xor(gs1, 32), ps2 = __shfl_xor(gs2, 32), ps3 = __shfl_xor(gs3, 32);
            const float pc3 = ps3, pc2 = pc3 + ps2, pc1 = pc2 + ps1, pc0 = pc1 + ps0;
            float base[4];
            base[3] = L + (hh ? 0.f : pc3);
            base[2] = L + gs3 + (hh ? pc3 : pc2);
            base[1] = L + (gs3 + gs2) + (hh ? pc2 : pc1);
            base[0] = L + (gs3 + gs2 + gs1) + (hh ? pc1 : pc0);
            float a[16];
#pragma unroll
            for (int g = 0; g < 4; ++g) {
                float c = base[g];
#pragma unroll
                for (int e = 3; e >= 0; --e) {
                    const int r = 4 * g + e; c += lk[r];
                    const int kk = e + 8 * g + 4 * hh; const bool valid = (j0 + kk) < qi;
                    a[r] = valid ? exp2f(z[r] + c) : 0.f;
                }
            }
            L += (gs0 + gs1 + gs2 + gs3) + pc0;
            u32x4 pw0, pw1;
            pw0.x = pk2(a[0], a[1]); pw0.y = pk2(a[2], a[3]); pw0.z = pk2(a[4], a[5]); pw0.w = pk2(a[6], a[7]);
            pw1.x = pk2(a[8], a[9]); pw1.y = pk2(a[10], a[11]); pw1.z = pk2(a[12], a[13]); pw1.w = pk2(a[14], a[15]);
            const bf16x8 pf0 = __builtin_bit_cast(bf16x8, pw0), pf1 = __builtin_bit_cast(bf16x8, pw1);
#pragma unroll
            for (int mt = 0; mt < 2; ++mt) {
                const bf16_t* vr = VT + (32 * mt + n) * SB_VT_STRIDE + 4 * hh;
                u32x4 v0, v1;
                { const u32x2 x = *(const u32x2*)(vr), y = *(const u32x2*)(vr + 8); v0.x = x.x; v0.y = x.y; v0.z = y.x; v0.w = y.y; }
                { const u32x2 x = *(const u32x2*)(vr + 16), y = *(const u32x2*)(vr + 24); v1.x = x.x; v1.y = x.y; v1.z = y.x; v1.w = y.y; }
                if (mt == 0) { o0 = __builtin_amdgcn_mfma_f32_32x32x16_bf16(__builtin_bit_cast(bf16x8, v0), pf0, o0, 0, 0, 0); o0 = __builtin_amdgcn_mfma_f32_32x32x16_bf16(__builtin_bit_cast(bf16x8, v1), pf1, o0, 0, 0, 0); }
                else { o1 = __builtin_amdgcn_mfma_f32_32x32x16_bf16(__builtin_bit_cast(bf16x8, v0), pf0, o1, 0, 0, 0); o1 = __builtin_amdgcn_mfma_f32_32x32x16_bf16(__builtin_bit_cast(bf16x8, v1), pf1, o1, 0, 0, 0); }
            }
            const bool done = (L < -152.f) || (qi >= T);
            if (__all(done)) break;
        }
        if (qi < T) {
            bf16_t* yp = YA + ((size_t)b * T + qi) * 512 + h * 64 + 4 * hh;
#pragma unroll
            for (int g = 0; g < 4; ++g) {
                u32x2 w; w.x = pk2(o0[4 * g], o0[4 * g + 1]); w.y = pk2(o0[4 * g + 2], o0[4 * g + 3]); *(u32x2*)(yp + 8 * g) = w;
                w.x = pk2(o1[4 * g], o1[4 * g + 1]); w.y = pk2(o1[4 * g + 2], o1[4 * g + 3]); *(u32x2*)(yp + 32 + 8 * g) = w;
            }
        }
    }
}

constexpr int DSA_SCS = 4128;
constexpr int DSA_KVB = 0, DSA_IDX = 73728, DSA_MISC = 75776, DSA_LDS = 76288;
typedef unsigned short u16x4 __attribute__((ext_vector_type(4)));
__device__ __forceinline__ u16x4 tr_read(unsigned lds_addr) { u16x4 r; asm volatile("ds_read_b64_tr_b16 %0, %1\n\ts_waitcnt lgkmcnt(0)" : "=&v"(r) : "v"(lds_addr) : "memory"); return r; }
__device__ __forceinline__ int wave_sum_i32(int v) {
    v += __builtin_amdgcn_update_dpp(0, v, 0xB1, 0xF, 0xF, false);
    v += __builtin_amdgcn_update_dpp(0, v, 0x4E, 0xF, 0xF, false);
    v += __builtin_amdgcn_update_dpp(0, v, 0x141, 0xF, 0xF, false);
    v += __builtin_amdgcn_update_dpp(0, v, 0x140, 0xF, 0xF, false);
    return __builtin_amdgcn_readlane(v, 0) + __builtin_amdgcn_readlane(v, 16) + __builtin_amdgcn_readlane(v, 32) + __builtin_amdgcn_readlane(v, 48);
}
__device__ __forceinline__ int mbcnt64(unsigned long long m) { return (int)__builtin_amdgcn_mbcnt_hi((unsigned)(m >> 32), __builtin_amdgcn_mbcnt_lo((unsigned)m, 0u)); }
__device__ __forceinline__ void phase_dsa_fast(const Params& p, char* lds) {
    const bf16_t* P = (const bf16_t*)(p.ws + WS_P); bf16_t* OL = (bf16_t*)(p.ws + WS_OLAT);
    const int tid = threadIdx.x, lane = tid & 63, wave = __builtin_amdgcn_readfirstlane(tid >> 6);
    unsigned* SC = (unsigned*)(lds + DSA_KVB);
    unsigned short* IDX = (unsigned short*)(lds + DSA_IDX);
    int* MISC = (int*)(lds + DSA_MISC);
    const unsigned lds_base = (unsigned)(size_t)lds;
    constexpr int NU4 = T / 4;
    for (int unit = blockIdx.x; unit < BATCH * NU4; unit += gridDim.x) {
        const int u4 = NU4 - 1 - unit / BATCH, b = unit % BATCH, t0 = u4 * 4;
        const int cid = t0 < NMETA ? 0 : 1 + (t0 - NMETA) / 64, n = NMETA + 64 * cid;
        const bf16_t* Pb = P + (size_t)b * T * PW;
        __syncthreads();
        {
            const int m = lane & 31, hh = lane >> 5;
            bf16x8 aq[4];
#pragma unroll
            for (int s = 0; s < 4; ++s) aq[s] = *(const bf16x8*)(Pb + (size_t)(t0 + (m >> 3)) * PW + C_QI + (m & 7) * 64 + 16 * s + 8 * hh);
            float wv[16];
#pragma unroll
            for (int r = 0; r < 16; ++r) wv[r] = bf2f(Pb[(size_t)(t0 + (r >> 2)) * PW + C_WI + (r & 3) + 4 * hh]);
            const int ntile = (n + 31) / 32;
            for (int kt = wave; kt < ntile; kt += 4) {
                const int j0 = kt * 32, key = j0 + m, krow = key < T ? key : T - 1;
                f32x16 acc;
#pragma unroll
                for (int r = 0; r < 16; ++r) acc[r] = 0.f;
#pragma unroll
                for (int s = 0; s < 4; ++s) { const bf16x8 bk = *(const bf16x8*)(Pb + (size_t)krow * PW + C_KI + 16 * s + 8 * hh); acc = __builtin_amdgcn_mfma_f32_32x32x16_bf16(aq[s], bk, acc, 0, 0, 0); }
                float tq[4];
#pragma unroll
                for (int q = 0; q < 4; ++q) {
                    float s = wv[4 * q] * fmaxf(acc[4 * q], 0.f); s += wv[4 * q + 1] * fmaxf(acc[4 * q + 1], 0.f); s += wv[4 * q + 2] * fmaxf(acc[4 * q + 2], 0.f); s += wv[4 * q + 3] * fmaxf(acc[4 * q + 3], 0.f);
                    tq[q] = s + __shfl_xor(s, 32);
                }
                const bool ok = key < n;
                const float s0 = hh ? tq[2] : tq[0], s1 = hh ? tq[3] : tq[1];
                SC[(2 * hh) * DSA_SCS + key] = ok ? fkey(s0) : 0u;
                SC[(2 * hh + 1) * DSA_SCS + key] = ok ? fkey(s1) : 0u;
            }
        }
        __syncthreads();
        {
            const unsigned* sc = SC + wave * DSA_SCS;
            unsigned v[65];
#pragma unroll
            for (int i = 0; i < 65; ++i) { const int k = i * 64 + lane; v[i] = (k < n) ? sc[k] : 0u; }
            unsigned prefix = 0u;
            for (int bit = 31; bit >= -1; --bit) {
                const unsigned cand = bit >= 0 ? (prefix | (1u << bit)) : prefix + 1u; int c = 0;
#pragma unroll
                for (int gi = 0; gi < 5; ++gi) if (gi * 832 < n) {
#pragma unroll
                    for (int i = 13 * gi; i < 13 * gi + 13; ++i) c += (v[i] >= cand) ? 1 : 0;
                }
                c = wave_sum_i32(c);
                if (bit >= 0) { if (c >= 256) prefix = cand; } else MISC[8 + wave] = c;
            }
            const int ngt = MISC[8 + wave];
            const int need = 256 - ngt; int base = 0, eqb = 0;
            unsigned short* idx = IDX + wave * 256;
            for (int k0 = 0; k0 < n; k0 += 64) {
                const int k = k0 + lane; const bool valid = k < n; const unsigned u = valid ? sc[k] : 0u;
                const bool eq = valid && (u == prefix); const unsigned long long meq = __ballot(eq);
                const bool take = valid && ((u > prefix) || (eq && (eqb + mbcnt64(meq)) < need));
                const unsigned long long mt = __ballot(take);
                if (take) idx[base + mbcnt64(mt)] = (unsigned short)k;
                base += __popcll(mt); eqb += __popcll(meq);
            }
            for (int pos = base + lane; pos < 256; pos += 64) idx[pos] = 0;
            if (lane == 0) MISC[wave] = base;
        }
        __syncthreads();
        for (int q = 0; q < 4; ++q) {
            const int nsel = MISC[q];
            const size_t qrow = (size_t)(t0 + q);
            int ln = lane; asm volatile("" : "+v"(ln));
            const int tl = wave * 64 + ln;
#pragma unroll 2
            for (int i = 0; i < 18; ++i) {
                const int c = tl + 256 * i, s = c / 18, part = c - s * 18;
                const bf16_t* src = Pb + (size_t)IDX[q * 256 + s] * PW + C_KV + part * 8;
                __builtin_amdgcn_global_load_lds((const unsigned*)src, (LAS unsigned*)(lds + DSA_KVB + wave * 1024 + i * 4096), 16, 0, 0);
            }
            const int hd = ln & 15, g = ln >> 4;
            bf16x8 qf[5];
#pragma unroll
            for (int ks = 0; ks < 5; ++ks) {
                u32x4 w = (u32x4){0u, 0u, 0u, 0u};
                if (hd < 8 && (ks < 4 || g < 2)) w = *(const u32x4*)(Pb + qrow * PW + C_QF + hd * QFW + 32 * ks + 8 * g);
                qf[ks] = __builtin_bit_cast(bf16x8, w);
            }
            asm volatile("s_waitcnt vmcnt(0)" ::: "memory");
            __syncthreads();
            f32x4 S[16];
            float mx = -3e38f;
#pragma unroll
            for (int kt = 0; kt < 16; ++kt) {
                const char* kr = lds + DSA_KVB + (16 * kt + hd) * 288 + 16 * g;
                f32x4 acc = (f32x4){0.f, 0.f, 0.f, 0.f};
#pragma unroll
                for (int ks = 0; ks < 4; ++ks) acc = __builtin_amdgcn_mfma_f32_16x16x32_bf16(*(const bf16x8*)(kr + 64 * ks), qf[ks], acc, 0, 0, 0);
                { u32x4 w = (u32x4){0u, 0u, 0u, 0u}; if (g < 2) w = *(const u32x4*)(kr + 256); acc = __builtin_amdgcn_mfma_f32_16x16x32_bf16(__builtin_bit_cast(bf16x8, w), qf[4], acc, 0, 0, 0); }
#pragma unroll
                for (int r = 0; r < 4; ++r) { const int slot = 16 * kt + 4 * g + r; const float x = slot < nsel ? acc[r] : -1e30f; acc[r] = x; mx = fmaxf(mx, x); }
                S[kt] = acc;
                __builtin_amdgcn_sched_barrier(0);
            }
            mx = fmaxf(mx, __shfl_xor(mx, 16)); mx = fmaxf(mx, __shfl_xor(mx, 32));
            float sum = 0.f;
#pragma unroll
            for (int kt = 0; kt < 16; ++kt)
#pragma unroll
                for (int r = 0; r < 4; ++r) { const float e = exp2f(S[kt][r] - mx); S[kt][r] = e; sum += e; }
            sum += __shfl_xor(sum, 16); sum += __shfl_xor(sum, 32);
            const float inv = 1.f / sum;
            f32x4 O[2] = {(f32x4){0.f, 0.f, 0.f, 0.f}, (f32x4){0.f, 0.f, 0.f, 0.f}};
            const int qd = (ln & 15) >> 2, pp = ln & 3;
#pragma unroll
            for (int kp = 0; kp < 8; ++kp) {
                u32x4 pw;
                pw.x = pk2(S[2 * kp][0] * inv, S[2 * kp][1] * inv); pw.y = pk2(S[2 * kp][2] * inv, S[2 * kp][3] * inv);
                pw.z = pk2(S[2 * kp + 1][0] * inv, S[2 * kp + 1][1] * inv); pw.w = pk2(S[2 * kp + 1][2] * inv, S[2 * kp + 1][3] * inv);
                const bf16x8 pf = __builtin_bit_cast(bf16x8, pw);
#pragma unroll
                for (int nt = 0; nt < 2; ++nt) {
                    const unsigned a0 = lds_base + DSA_KVB + (unsigned)((32 * kp + 4 * g + qd) * 288 + (32 * wave + 16 * nt + 4 * pp) * 2);
                    const u16x4 x = tr_read(a0), y = tr_read(a0 + 16 * 288);
                    bf16x8 vf; vf[0] = (short)x[0]; vf[1] = (short)x[1]; vf[2] = (short)x[2]; vf[3] = (short)x[3]; vf[4] = (short)y[0]; vf[5] = (short)y[1]; vf[6] = (short)y[2]; vf[7] = (short)y[3];
                    O[nt] = __builtin_amdgcn_mfma_f32_16x16x32_bf16(pf, vf, O[nt], 0, 0, 0);
                }
            }
            if (g < 2) {
#pragma unroll
                for (int nt = 0; nt < 2; ++nt)
#pragma unroll
                    for (int r = 0; r < 4; ++r) OL[((size_t)b * T + qrow) * 1024 + (4 * g + r) * 128 + 32 * wave + 16 * nt + hd] = (bf16_t)f2bf(O[nt][r]);
            }
            __syncthreads();
        }
    }
}

template <class ML>
__device__ __forceinline__ void phase_c1(const Params& p, char* lds) {
    unsigned char* ws = p.ws; const int tid = threadIdx.x;
    const bf16_t* U = (const bf16_t*)(ws + WS_U); const bf16_t* YA = (const bf16_t*)(ws + WS_YA); const bf16_t* OL = (const bf16_t*)(ws + WS_OLAT);
    const bf16_t* WGA = (const bf16_t*)(ws + WS_WGA); const bf16_t* WGB = (const bf16_t*)(ws + WS_WGB); const bf16_t* WUA = (const bf16_t*)(ws + WS_WUA); const bf16_t* WBP = (const bf16_t*)(ws + WS_WBP);
    bf16_t* Z = (bf16_t*)(ws + WS_Z);
    const int ntn = D / ML::TN, ntiles = (NTOK / ML::TM) * ntn;
    for (int tile = blockIdx.x; tile < ntiles; tile += gridDim.x) {
        const int m0 = (tile / ntn) * ML::TM, n0 = (tile % ntn) * ML::TN;
        const int lr = tid >> 2, lc = (tid & 3) * 8;
        const bf16_t* ap[2]; const bf16_t* bp[2];
        f32x4 acc[ML::NF]; u32x2 sg[ML::NF], zp[ML::NF];
#define C1_PTRS(Ab, lda_, Bb, ldb_) _Pragma("unroll") for (int i = 0; i < ML::NR; ++i) { ap[i] = (Ab) + (size_t)(m0 + lr + 64 * i) * (lda_) + lc; bp[i] = (Bb) + (size_t)(n0 + lr + 64 * i) * (ldb_) + lc; }
        C1_PTRS(U, D, WGA, D); ML::run(lds, ap, bp, D, acc);
#pragma unroll
        for (int f = 0; f < ML::NF; ++f) { sg[f].x = pk2(sigmoidf(acc[f].x), sigmoidf(acc[f].y)); sg[f].y = pk2(sigmoidf(acc[f].z), sigmoidf(acc[f].w)); asm volatile("" : "+v"(sg[f].x), "+v"(sg[f].y)); }
        C1_PTRS(YA, 512, WUA, 512); ML::run(lds, ap, bp, 512, acc);
#pragma unroll
        for (int f = 0; f < ML::NF; ++f) { zp[f].x = pk2(bflo(sg[f].x) * acc[f].x, bfhi(sg[f].x) * acc[f].y); zp[f].y = pk2(bflo(sg[f].y) * acc[f].z, bfhi(sg[f].y) * acc[f].w); asm volatile("" : "+v"(zp[f].x), "+v"(zp[f].y)); }
        C1_PTRS(U, D, WGB, D); ML::run(lds, ap, bp, D, acc);
#pragma unroll
        for (int f = 0; f < ML::NF; ++f) { sg[f].x = pk2(sigmoidf(acc[f].x), sigmoidf(acc[f].y)); sg[f].y = pk2(sigmoidf(acc[f].z), sigmoidf(acc[f].w)); asm volatile("" : "+v"(sg[f].x), "+v"(sg[f].y)); }
        C1_PTRS(OL, D, WBP, D); ML::run(lds, ap, bp, D, acc);
#pragma unroll
        for (int f = 0; f < ML::NF; ++f) {
            const f32x4 v = (f32x4){bflo(zp[f].x) + bflo(sg[f].x) * acc[f].x, bfhi(zp[f].x) + bfhi(sg[f].x) * acc[f].y, bflo(zp[f].y) + bflo(sg[f].y) * acc[f].z, bfhi(zp[f].y) + bfhi(sg[f].y) * acc[f].w};
            int r, c; ML::pos(tid, f, r, c); u32x2 w; w.x = pk2(v.x, v.y); w.y = pk2(v.z, v.w);
            *(u32x2*)(Z + (size_t)(m0 + r) * D + n0 + c) = w;
        }
#undef C1_PTRS
    }
}

template <class ML>
__device__ __forceinline__ void phase_c2(const Params& p, char* lds) {
    unsigned char* ws = p.ws; float* H1 = (float*)(ws + WS_H1);
    gemm_dense<ML>(lds, (const bf16_t*)(ws + WS_Z), D, NTOK, (const bf16_t*)(ws + WS_WO), D, D, D,
        [&](int row, int col, f32x4 v) { const f32x4 h = *(const f32x4*)(h0_row(p, row) + col); *(f32x4*)(H1 + (size_t)row * D + col) = h + v; });
}

__device__ __forceinline__ void phase_c3(const Params& p, char* lds) {
    unsigned char* ws = p.ws; const int tid = threadIdx.x, lane = tid & 63, wave = tid >> 6;
    const float* H1 = (const float*)(ws + WS_H1); const float* g = p.in[I_GFFN];
    {
        bf16_t* U2 = (bf16_t*)(ws + WS_U); const int gw = blockIdx.x * 4 + wave, NGW = gridDim.x * 4;
        for (int row = gw; row < NTOK; row += NGW) {
            const f32x4* xr = (const f32x4*)(H1 + (size_t)row * D) + lane;
            f32x4 v[4]; float s = 0.f;
#pragma unroll
            for (int j = 0; j < 4; ++j) { v[j] = xr[64 * j]; s += (v[j].x * v[j].x + v[j].y * v[j].y) + (v[j].z * v[j].z + v[j].w * v[j].w); }
            const float rstd = rsqrtf(wave_sum(s) * (1.f / D) + NORM_EPS);
            u32x2* o = (u32x2*)(U2 + (size_t)row * D) + lane;
#pragma unroll
            for (int j = 0; j < 4; ++j) { const f32x4 gg = ((const f32x4*)g)[lane + 64 * j];
                u32x2 w; w.x = pk2(v[j].x * rstd * gg.x, v[j].y * rstd * gg.y); w.y = pk2(v[j].z * rstd * gg.z, v[j].w * rstd * gg.w); o[64 * j] = w; }
        }
    }
    {
        float* Tl = (float*)lds;
        const float* wg = p.in[I_WGRP]; const float* wr = p.in[I_WRT]; const float* bg = p.in[I_BGRP]; const float* br = p.in[I_BRT];
        unsigned* ctl = (unsigned*)(ws + WS_CTL); int* LIST = (int*)(ws + WS_LIST); float* GATE = (float*)(ws + WS_GATE);
        const int ngroups = (NTOK + 255) / 256;
        for (int grp = blockIdx.x; grp < ngroups; grp += gridDim.x) {
            const int tok0 = grp * 256, tok = tok0 + tid;
            float acc[36]; float ss = 0.f;
#pragma unroll
            for (int o = 0; o < 36; ++o) acc[o] = 0.f;
            for (int k0 = 0; k0 < D; k0 += 32) {
                __syncthreads();
#pragma unroll
                for (int i = 0; i < 8; ++i) { const int idx = tid + 256 * i, tk = idx >> 3, kc = idx & 7; const int rr = tok0 + tk < NTOK ? tok0 + tk : NTOK - 1;
                    const f32x4 v = *(const f32x4*)(H1 + (size_t)rr * D + k0 + kc * 4);
                    Tl[(kc * 4 + 0) * 257 + tk] = v.x; Tl[(kc * 4 + 1) * 257 + tk] = v.y; Tl[(kc * 4 + 2) * 257 + tk] = v.z; Tl[(kc * 4 + 3) * 257 + tk] = v.w; }
                __syncthreads();
#pragma unroll 4
                for (int k = 0; k < 32; ++k) {
                    const float h = Tl[k * 257 + tid]; ss += h * h; const float hg = h * g[k0 + k];
                    const float* w4 = wg + (size_t)(k0 + k) * 4; const float* w32 = wr + (size_t)(k0 + k) * 32;
#pragma unroll
                    for (int o = 0; o < 4; ++o) acc[o] += hg * w4[o];
#pragma unroll
                    for (int o = 0; o < 32; ++o) acc[4 + o] += hg * w32[o];
                }
            }
            if (tok < NTOK) {
                const float rstd = rsqrtf(ss * (1.f / D) + NORM_EPS);
                float gl[4]; int gs = 0; float gm;
#pragma unroll
                for (int o = 0; o < 4; ++o) gl[o] = acc[o] * rstd + bg[o];
                gm = gl[0];
#pragma unroll
                for (int o = 1; o < 4; ++o) if (gl[o] > gm) { gm = gl[o]; gs = o; }
                float gsum = 0.f;
#pragma unroll
                for (int o = 0; o < 4; ++o) gsum += __expf(gl[o] - gm);
                const float pgrp = 1.f / gsum;
                float el[8];
#pragma unroll
                for (int j = 0; j < 8; ++j) { float a = acc[4 + j]; float bb = br[j];
                    a = gs == 1 ? acc[12 + j] : a; bb = gs == 1 ? br[8 + j] : bb; a = gs == 2 ? acc[20 + j] : a; bb = gs == 2 ? br[16 + j] : bb; a = gs == 3 ? acc[28 + j] : a; bb = gs == 3 ? br[24 + j] : bb;
                    el[j] = a * rstd + bb; }
                int e0 = 0; float m0 = el[0];
#pragma unroll
                for (int j = 1; j < 8; ++j) if (el[j] > m0) { m0 = el[j]; e0 = j; }
                int e1 = -1; float m1 = -3e38f;
#pragma unroll
                for (int j = 0; j < 8; ++j) if (j != e0 && el[j] > m1) { m1 = el[j]; e1 = j; }
                const float x1 = __expf(m1 - m0); const float g0 = pgrp / (1.f + x1), g1 = pgrp * x1 / (1.f + x1);
                const int ex0 = gs * 8 + e0, ex1 = gs * 8 + e1;
                const int s0 = (int)atomicAdd(ctl + CW_CNT + 64 * ex0, 1u); LIST[(size_t)ex0 * NTOK + s0] = tok * 2;
                const int s1 = (int)atomicAdd(ctl + CW_CNT + 64 * ex1, 1u); LIST[(size_t)ex1 * NTOK + s1] = tok * 2 + 1;
                GATE[tok * 2] = g0; GATE[tok * 2 + 1] = g1;
            }
        }
    }
}

template <class ML, int WHICH>
__device__ __forceinline__ void phase_moe(const Params& p, char* lds) {
    unsigned char* ws = p.ws; const int tid = threadIdx.x;
    const unsigned* ctl = (const unsigned*)(ws + WS_CTL); const int* LIST = (const int*)(ws + WS_LIST); const float* GATE = (const float*)(ws + WS_GATE);
    const bf16_t* U2 = (const bf16_t*)(ws + WS_U); bf16_t* HID = (bf16_t*)(ws + WS_HID); bf16_t* MO = (bf16_t*)(ws + WS_MO);
    const bf16_t* W13 = (const bf16_t*)(ws + WS_W13); const bf16_t* W2 = (const bf16_t*)(ws + WS_W2);
    constexpr int NOUT = 1024, KK = WHICH == 0 ? 1024 : 512, ntn = NOUT / ML::TN;
    int tile_base = 0, rowoff = 0; int total = 0;
    for (int e = 0; e < NEXP; ++e) total += (((int)ctl[CW_CNT + 64 * e] + ML::TM - 1) / ML::TM) * ntn;
    int e = 0, cnt_e = (int)ctl[CW_CNT], nt_e = ((cnt_e + ML::TM - 1) / ML::TM) * ntn;
    for (int tile = blockIdx.x; tile < total; tile += gridDim.x) {
        while (tile >= tile_base + nt_e) { tile_base += nt_e; rowoff += (cnt_e + 127) / 128 * 128; ++e; cnt_e = (int)ctl[CW_CNT + 64 * e]; nt_e = ((cnt_e + ML::TM - 1) / ML::TM) * ntn; }
        const int lt = tile - tile_base, mt = lt / ntn, n0 = (lt % ntn) * ML::TN, s0 = mt * ML::TM;
        const bf16_t* ap[2]; const bf16_t* bp[2]; const int lr = tid >> 2, lc = (tid & 3) * 8;
#pragma unroll
        for (int i = 0; i < ML::NR; ++i) {
            const int s = s0 + lr + 64 * i;
            if (WHICH == 0) { const int tok = s < cnt_e ? (LIST[(size_t)e * NTOK + s] >> 1) : 0; ap[i] = U2 + (size_t)tok * D + lc; bp[i] = W13 + ((size_t)e * 1024 + n0 + lr + 64 * i) * 1024 + lc; }
            else { ap[i] = HID + (size_t)(rowoff + s) * DEXP + lc; bp[i] = W2 + ((size_t)e * 1024 + n0 + lr + 64 * i) * 512 + lc; }
        }
        f32x4 acc[ML::NF];
        ML::run(lds, ap, bp, KK, acc);
#pragma unroll
        for (int f = 0; f < ML::NF; ++f) {
            int r, c; ML::pos(tid, f, r, c); const int s = s0 + r; const f32x4 v = acc[f];
            if (WHICH == 0) {
                const float h0 = v.x / (1.f + __expf(-v.x)) * v.y, h1 = v.z / (1.f + __expf(-v.z)) * v.w;
                *(unsigned*)(HID + (size_t)(rowoff + s) * DEXP + ((n0 + c) >> 1)) = pk2(h0, h1);
            } else if (s < cnt_e) {
                const int ent = LIST[(size_t)e * NTOK + s]; const float gt = GATE[ent];
                u32x2 w; w.x = pk2(v.x * gt, v.y * gt); w.y = pk2(v.z * gt, v.w * gt);
                *(u32x2*)(MO + (size_t)ent * D + n0 + c) = w;
            }
        }
    }
}

__device__ __forceinline__ void phase_final(const Params& p) {
    unsigned char* ws = p.ws; const int tid = threadIdx.x, lane = tid & 63, wave = tid >> 6;
    const float* H1 = (const float*)(ws + WS_H1); const bf16_t* MO = (const bf16_t*)(ws + WS_MO); const float* g = p.in[I_GFIN];
    const int gw = blockIdx.x * 4 + wave, NGW = gridDim.x * 4;
    for (int orow = gw; orow < BATCH * SEQ; orow += NGW) {
        const int b = orow / SEQ, s = orow - b * SEQ; const size_t row = (size_t)b * T + NMETA + s;
        const f32x4* xr = (const f32x4*)(H1 + row * D) + lane; const u32x2* m0 = (const u32x2*)(MO + row * 2 * D) + lane; const u32x2* m1 = m0 + 256;
        f32x4 v[4]; float ss = 0.f;
#pragma unroll
        for (int j = 0; j < 4; ++j) { const u32x2 a = m0[64 * j], c = m1[64 * j]; v[j] = xr[64 * j];
            v[j].x += bflo(a.x) + bflo(c.x); v[j].y += bfhi(a.x) + bfhi(c.x); v[j].z += bflo(a.y) + bflo(c.y); v[j].w += bfhi(a.y) + bfhi(c.y);
            ss += (v[j].x * v[j].x + v[j].y * v[j].y) + (v[j].z * v[j].z + v[j].w * v[j].w); }
        const float rstd = rsqrtf(wave_sum(ss) * (1.f / D) + NORM_EPS);
        f32x4* o = (f32x4*)(p.out + (size_t)orow * D) + lane;
#pragma unroll
        for (int j = 0; j < 4; ++j) { const f32x4 gg = ((const f32x4*)g)[lane + 64 * j]; o[64 * j] = v[j] * rstd * gg; }
    }
}

#ifndef GOLD_GEMM
#define GOLD_GEMM 0
#endif
#if GOLD_GEMM
typedef MLNaive MLX;
#else
typedef MLFast MLX;
#endif
#ifndef GOLD_SB
#define GOLD_SB 0
#endif
#ifndef GOLD_DSA
#define GOLD_DSA 0
#endif
constexpr int LDS_BYTES = 76288;

template <bool COOP>
__global__ void __launch_bounds__(256, 2) mega(Params p) {
    extern __shared__ __attribute__((aligned(16))) char lds[];
    const int lo = p.ph_lo, hi = p.ph_hi;
#define IN(k) (lo <= (k) && (k) < hi)
#define SEAM(k) do { if constexpr (COOP) { if (IN(k) && IN((k) + 1)) cg::this_grid().sync(); } } while (0)
    if (IN(0)) phase_prologue(p, lds);
    SEAM(0);
    if (IN(1)) phase_inproj<MLX>(p, lds);
    SEAM(1);
    if (IN(2)) {
#if GOLD_DSA
        phase_dsa_gold(p, lds);
#else
        phase_dsa_fast(p, lds);
#endif
#if GOLD_SB
        phase_sb_gold(p);
#else
        __syncthreads(); phase_sb_fast(p, lds);
#endif
    }
    SEAM(2);
    if (IN(3)) phase_c1<MLX>(p, lds);
    SEAM(3);
    if (IN(4)) phase_c2<MLX>(p, lds);
    SEAM(4);
    if (IN(5)) phase_c3(p, lds);
    SEAM(5);
    if (IN(6)) phase_moe<MLX, 0>(p, lds);
    SEAM(6);
    if (IN(7)) phase_moe<MLX, 1>(p, lds);
    SEAM(7);
    if (IN(8)) phase_final(p);
}

extern "C" void kernel_launch(void* const* d_in, const int* in_sizes, int n_in, void* d_out, int out_size, void* d_ws, size_t ws_size, hipStream_t stream) {
    if (n_in != 18 || ws_size < WS_END) { fprintf(stderr, "kernel_launch: unexpected n_in %d / ws_size %zu\n", n_in, ws_size); return; }
    static int grid = 0;
    if (grid == 0) {
        int dev = 0, cus = 0, per_cu = 0;
        (void)hipGetDevice(&dev);
        (void)hipDeviceGetAttribute(&cus, hipDeviceAttributeMultiprocessorCount, dev);
        (void)hipFuncSetAttribute((const void*)mega<true>, hipFuncAttributeMaxDynamicSharedMemorySize, LDS_BYTES);
        (void)hipOccupancyMaxActiveBlocksPerMultiprocessor(&per_cu, (const void*)mega<true>, 256, LDS_BYTES);
        if (per_cu > 2) per_cu = 2;
        if (per_cu < 1) per_cu = 1;
        grid = cus * per_cu;
    }
    (void)hipMemsetAsync((char*)d_ws + WS_CTL, 0, CTL_BYTES, stream);
    Params p{};
    for (int i = 0; i < 18; ++i) p.in[i] = (const float*)d_in[i];
    p.out = (float*)d_out; p.ws = (unsigned char*)d_ws;
    p.ph_lo = 0; p.ph_hi = 9;
    void* args[] = {&p};
    hipError_t e = hipLaunchCooperativeKernel((const void*)mega<true>, dim3(grid), dim3(256), args, LDS_BYTES, stream);
    if (e != hipSuccess) fprintf(stderr, "cooperative launch failed: %s (grid %d)\n", hipGetErrorString(e), grid);
}
```

```cpp
#include <hip/hip_runtime.h>
#include <cstdio>
#include <cstdint>
#ifndef PROBE_PH
#define PROBE_PH -1
#endif

constexpr int BATCH = 8, SEQ = 4096, NMETA = 16, T = SEQ + NMETA, D = 1024, NTOK = BATCH * T;
constexpr int MROWS = 33024;
constexpr int INW = 4824;
constexpr int NEXP = 32, DEXP = 512;
constexpr int NWAVES = 8, NTHREADS = 512;
constexpr float NORM_EPS = 1e-6f;
constexpr float LOG2E = 1.4426950408889634f;
constexpr float QSCALE = 0.125f * LOG2E;
constexpr int PW = 3456, PWN = 3584;
constexpr int C_QA = 0, C_KA = 512, C_VA = 1024, C_QF = 1536, C_KV = 2688, C_QI = 2832, C_KI = 3344, C_WI = 3408, C_END = 3416;
constexpr int QFW = 144;

constexpr size_t MiB = 1u << 20;
constexpr size_t WS_CTL = 0, CTL_BYTES = 1 * MiB;
constexpr size_t WS_CS = 1 * MiB;
constexpr size_t WS_WP = 2 * MiB;
constexpr size_t WS_WG = 9 * MiB;
constexpr size_t WS_WUA = 13 * MiB, WS_WBP = 14 * MiB, WS_WO = 16 * MiB;
constexpr size_t WS_W2 = 18 * MiB;
constexpr size_t WS_W13 = 50 * MiB;
constexpr size_t WS_U = 114 * MiB;
constexpr size_t WS_P = 179 * MiB;
constexpr size_t WS_Z = 179 * MiB;
constexpr size_t WS_G = 244 * MiB;
constexpr size_t WS_H1 = 244 * MiB;
constexpr size_t WS_LIST = 374 * MiB;
constexpr size_t WS_GATE = 379 * MiB;
constexpr size_t WS_YA = 397 * MiB;
constexpr size_t WS_OLAT = 430 * MiB;
constexpr size_t WS_HID = 397 * MiB;
constexpr size_t WS_MO = 50 * MiB;
constexpr size_t WS_END = 495 * MiB;
static_assert(WS_P + (size_t)MROWS * PW * 2 <= WS_YA && WS_G + (size_t)MROWS * 2048 * 2 <= WS_LIST && WS_Z + (size_t)MROWS * 1024 * 2 <= WS_G, "ws map");
static_assert(WS_OLAT + (size_t)MROWS * 1024 * 2 <= WS_END && WS_U + (size_t)MROWS * 1024 * 2 <= WS_P && WS_MO + (size_t)NTOK * 2048 * 2 <= WS_P, "ws map");
constexpr int CW_CNT = 1024;
constexpr int CW_BAR = 4096;

typedef unsigned short bf16_t;
typedef short bf16x8 __attribute__((ext_vector_type(8)));
typedef float f32x4 __attribute__((ext_vector_type(4)));
typedef float f32x16 __attribute__((ext_vector_type(16)));
typedef unsigned u32x2 __attribute__((ext_vector_type(2)));
typedef unsigned u32x4 __attribute__((ext_vector_type(4)));
typedef unsigned short u16x4 __attribute__((ext_vector_type(4)));
#define LAS __attribute__((address_space(3)))

__device__ __forceinline__ unsigned f2bf(float f) { unsigned u = __float_as_uint(f); return (u + 0x7fffu + ((u >> 16) & 1u)) >> 16; }
__device__ __forceinline__ unsigned pk2(float lo, float hi) { return f2bf(lo) | (f2bf(hi) << 16); }
__device__ __forceinline__ float bflo(unsigned w) { return __uint_as_float(w << 16); }
__device__ __forceinline__ float bfhi(unsigned w) { return __uint_as_float(w & 0xffff0000u); }
__device__ __forceinline__ float bf2f(bf16_t b) { return __uint_as_float((unsigned)b << 16); }
__device__ __forceinline__ float wave_sum(float v) {
#pragma unroll
    for (int o = 1; o < 64; o <<= 1) v += __shfl_xor(v, o);
    return v;
}
__device__ __forceinline__ float sigmoidf(float x) { return 1.0f / (1.0f + __expf(-x)); }

struct Params {
    const float* in[18];
    float* out;
    unsigned char* ws;
    int ph_lo, ph_hi;
};
enum { I_X = 0, I_META, I_GMIX, I_WIN, I_WUK, I_WUV, I_WUPA, I_WUPB, I_WO, I_GFFN, I_WGRP, I_BGRP, I_WRT, I_BRT, I_W1, I_W3, I_W2, I_GFIN };

__device__ __forceinline__ const float* h0_row(const Params& p, int row) {
    const int b = row / T, t = row - b * T;
    return t < NMETA ? p.in[I_META] + (size_t)t * D : p.in[I_X] + ((size_t)b * SEQ + (t - NMETA)) * D;
}
template <class F>
__device__ __forceinline__ void tr_item(F val, bf16_t* dst, int ldd, int row0, int k0, float* scr, int lane, int rstep = 1) {
    float tv[32];
#pragma unroll
    for (int i = 0; i < 32; ++i) tv[i] = val(k0 + 2 * i + (lane >> 5), lane & 31);
#pragma unroll
    for (int i = 0; i < 32; ++i) scr[(2 * i + (lane >> 5)) * 33 + (lane & 31)] = tv[i];
    __builtin_amdgcn_s_waitcnt(0xC07F);
    asm volatile("" ::: "memory");
    const int c = lane & 7;
#pragma unroll
    for (int j = 0; j < 4; ++j) {
        const int n = (lane >> 3) + 8 * j; const float* s = scr + (8 * c) * 33 + n;
        u32x4 o; o.x = pk2(s[0], s[33]); o.y = pk2(s[66], s[99]); o.z = pk2(s[132], s[165]); o.w = pk2(s[198], s[231]);
        *(u32x4*)(dst + (size_t)(row0 + n * rstep) * ldd + k0 + 8 * c) = o;
    }
    __builtin_amdgcn_s_waitcnt(0xC07F);
    asm volatile("" ::: "memory");
}

__device__ __forceinline__ void wp_src(int c, int& kind, int& col, int& aux, float& scale) {
    kind = 1; aux = 0; scale = 1.f; col = 0;
    if (c < 512) { col = c; scale = QSCALE; }
    else if (c < C_QF) { col = c; }
    else if (c < C_KV) { const int r = c - C_QF, h = r / QFW, j = r % QFW; scale = QSCALE;
        if (j < 128) { kind = 2; col = h; aux = j; } else { const int i = j - 128; col = 1536 + 64 * h + (i >> 1) + 8 * (i & 1); } }
    else if (c < C_QI) { const int j = c - C_KV; if (j < 128) col = 2048 + j; else { const int i = j - 128; col = 2176 + (i >> 1) + 8 * (i & 1); } }
    else if (c < C_KI) { const int r = c - C_QI, h = r >> 6, j = r & 63; col = 2192 + 64 * h + (j < 16 ? (j >> 1) + 8 * (j & 1) : j); }
    else if (c < C_WI) { const int j = c - C_KI; col = 2704 + (j < 16 ? (j >> 1) + 8 * (j & 1) : j); }
    else if (c < C_END) { col = 2768 + (c - C_WI); }
    else kind = 0;
}

constexpr int IT_WP = (PWN / 32) * 16;
constexpr int IT_WG = 32 * 16;
constexpr int IT_WUA = 32 * 8;
constexpr int IT_WBP = 32 * 16, IT_WO = 32 * 16;
constexpr int IT_W13 = NEXP * 32 * 16;
constexpr int IT_W2 = NEXP * 32 * 8;
constexpr int IT_TOTAL = IT_WP + 2 * IT_WG + IT_WUA + IT_WBP + IT_WO + IT_W13 + IT_W2;

__device__ __forceinline__ void phase_prologue(const Params& p, char* lds) {
    const int tid = threadIdx.x, lane = tid & 63, wave = tid >> 6;
    const int gw = blockIdx.x * NWAVES + wave, NGW = gridDim.x * NWAVES;
    float* scr = (float*)lds + wave * (64 * 33);
    unsigned char* ws = p.ws;
    const float* w_in = p.in[I_WIN];
    {
        float2* cs = (float2*)(ws + WS_CS);
        for (int i = blockIdx.x * NTHREADS + tid; i < T * 8; i += gridDim.x * NTHREADS) {
            const int pos = i >> 3, f = i & 7;
            const float inv = powf(500000.0f, -(float)f / 8.0f);
            const float ang = (float)pos * inv;
            cs[i] = make_float2(cosf(ang), sinf(ang));
        }
    }
    for (int it = gw; it < IT_TOTAL; it += NGW) {
        int r = it;
        if (r < IT_WP) {
            const int rg = r / 16, kb = r % 16, c = rg * 32 + (lane & 31);
            int kind, col, aux; float scale; wp_src(c, kind, col, aux, scale);
            const float* w_uk = p.in[I_WUK];
            float wu[48];
#pragma unroll
            for (int n4 = 0; n4 < 12; ++n4) { f32x4 t = (f32x4){0.f, 0.f, 0.f, 0.f}; if (kind == 2) t = *(const f32x4*)(w_uk + ((size_t)col * 128 + aux) * 48 + 4 * n4); wu[4 * n4] = t.x; wu[4 * n4 + 1] = t.y; wu[4 * n4 + 2] = t.z; wu[4 * n4 + 3] = t.w; }
            tr_item([&](int k, int) -> float {
                if (kind == 0) return 0.f;
                if (kind == 1) return scale * w_in[(size_t)k * INW + col];
                const f32x4* wi = (const f32x4*)(w_in + (size_t)k * INW + 1536 + 64 * col + 16);
                float s = 0.f;
#pragma unroll
                for (int n4 = 0; n4 < 12; ++n4) { const f32x4 t = wi[n4]; s += t.x * wu[4 * n4] + t.y * wu[4 * n4 + 1] + t.z * wu[4 * n4 + 2] + t.w * wu[4 * n4 + 3]; }
                return scale * s; }, (bf16_t*)(ws + WS_WP), 1024, rg * 32, kb * 64, scr, lane);
            continue; }
        r -= IT_WP;
        if (r < 2 * IT_WG) {
            const int which = r / IT_WG; r %= IT_WG; const int rg = r / 16, kb = r % 16; const int col0 = (which ? 3800 : 2776) + rg * 32;
            tr_item([&](int k, int n) -> float { return w_in[(size_t)k * INW + col0 + n]; }, (bf16_t*)(ws + WS_WG) + (size_t)which * 1024 * 1024, 1024, rg * 32, kb * 64, scr, lane);
            continue; }
        r -= 2 * IT_WG;
        if (r < IT_WUA) {
            const int rg = r / 8, kb = r % 8; const float* w = p.in[I_WUPA];
            tr_item([&](int k, int n) -> float { return w[(size_t)k * 1024 + rg * 32 + n]; }, (bf16_t*)(ws + WS_WUA), 512, rg * 32, kb * 64, scr, lane);
            continue; }
        r -= IT_WUA;
        if (r < IT_WBP) {
            const int rg = r / 16, kb = r % 16; const float* wuv = p.in[I_WUV]; const float* wub = p.in[I_WUPB];
            const int hB = kb >> 1;
            float bc[64];
#pragma unroll
            for (int d = 0; d < 64; ++d) bc[d] = wub[(size_t)(64 * hB + d) * 1024 + rg * 32 + (lane & 31)];
            tr_item([&](int kk, int) -> float {
                const f32x4* a = (const f32x4*)(wuv + (size_t)kk * 64);
                float s = 0.f;
#pragma unroll
                for (int d4 = 0; d4 < 16; ++d4) { const f32x4 t = a[d4]; s += t.x * bc[4 * d4] + t.y * bc[4 * d4 + 1] + t.z * bc[4 * d4 + 2] + t.w * bc[4 * d4 + 3]; }
                return s; }, (bf16_t*)(ws + WS_WBP), 1024, rg * 32, kb * 64, scr, lane);
            continue; }
        r -= IT_WBP;
        if (r < IT_WO) {
            const int rg = r / 16, kb = r % 16; const float* w = p.in[I_WO];
            tr_item([&](int k, int n) -> float { return w[(size_t)k * 1024 + rg * 32 + n]; }, (bf16_t*)(ws + WS_WO), 1024, rg * 32, kb * 64, scr, lane);
            continue; }
        r -= IT_WO;
        if (r < IT_W13) {
            const int e = r / 512; r %= 512; const int which = r & 1, cg = (r >> 1) & 15, kb = r >> 5;
            const float* w = (which ? p.in[I_W3] : p.in[I_W1]) + (size_t)e * 1024 * 512 + cg * 32;
            tr_item([&](int k, int n) -> float { return w[(size_t)k * 512 + n]; },
                    (bf16_t*)(ws + WS_W13) + (size_t)e * 1024 * 1024, 1024, 2 * cg * 32 + which, kb * 64, scr, lane, 2);
            continue; }
        r -= IT_W13;
        {
            const int e = r / 256; r %= 256; const int rg = r / 8, kb = r % 8;
            const float* w2 = p.in[I_W2] + (size_t)e * 512 * 1024;
            tr_item([&](int k, int n) -> float { return w2[(size_t)k * 1024 + rg * 32 + n]; }, (bf16_t*)(ws + WS_W2) + (size_t)e * 1024 * 512, 512, rg * 32, kb * 64, scr, lane);
        }
    }
    {
        const float* g = p.in[I_GMIX]; bf16_t* U = (bf16_t*)(ws + WS_U);
        for (int row = gw; row < NTOK; row += NGW) {
            const f32x4* xr = (const f32x4*)h0_row(p, row) + lane;
            f32x4 v[4]; float s = 0.f;
#pragma unroll
            for (int j = 0; j < 4; ++j) { v[j] = xr[64 * j]; s += (v[j].x * v[j].x + v[j].y * v[j].y) + (v[j].z * v[j].z + v[j].w * v[j].w); }
            const float rstd = rsqrtf(wave_sum(s) * (1.f / D) + NORM_EPS);
            u32x2* o = (u32x2*)(U + (size_t)row * D) + lane;
#pragma unroll
            for (int j = 0; j < 4; ++j) { const f32x4 gg = ((const f32x4*)g)[lane + 64 * j];
                u32x2 w; w.x = pk2(v[j].x * rstd * gg.x, v[j].y * rstd * gg.y); w.y = pk2(v[j].z * rstd * gg.z, v[j].w * rstd * gg.w); o[64 * j] = w; }
        }
    }
}

namespace pg8 {
#define PG8_LAS __attribute__((address_space(3)))
typedef unsigned short bf16_t;
typedef short bf16x8 __attribute__((ext_vector_type(8)));
typedef float f32x4 __attribute__((ext_vector_type(4)));
typedef unsigned u32x4 __attribute__((ext_vector_type(4)));
constexpr int BM = 256, BK = 64, HALF = 128, HTB = HALF * BK * 2  , STAGE_BYTES = 8 * HTB, NXCD = 8, WGM = 8;

__host__ __device__ __forceinline__ int lds_byte(int r, int c) { const int st = (r >> 4) * 2 + (c >> 5), rr = r & 15, cc = c & 31, ob = rr * 64 + cc * 2; return st * 1024 + (ob ^ (((ob >> 9) & 1) << 5)); }
__host__ __device__ __forceinline__ void stage_rc(int b, int& R, int& C) { const int st = b / 1024, sb = b % 1024, swz = sb ^ (((sb >> 9) & 1) << 5); R = (st >> 1) * 16 + swz / 64; C = (st & 1) * 32 + (swz % 64) / 2; }
__host__ __device__ __forceinline__ int perm32(int rho) { const int n = rho >> 4, i = rho & 15; return 8 * (i >> 2) + 4 * n + (i & 3); }

struct Unit { int pm, pn; };
struct Gemm { const bf16_t* A; const bf16_t* Bt; int M, N, K; };

struct StaticOrder {
    int nM, nN, nwg, G, c;
    __host__ __device__ void init(int M, int N, int G_, int c_) { nM = M / BM; nN = N / BM; nwg = nM * nN; G = G_; c = c_; }
    __host__ __device__ bool next(int i, Unit& u) const {
        const long L = (long)i * G + c; if (L >= nwg) return false;
        int wgid = (int)L; { const int q = nwg / NXCD, r = nwg % NXCD, xcd = wgid % NXCD, off = wgid / NXCD; wgid = (xcd < r ? xcd * (q + 1) : r * (q + 1) + (xcd - r) * q) + off; }
        const int nig = WGM * nN, gid = wgid / nig, fm = gid * WGM, gsz = (nM - fm) < WGM ? (nM - fm) : WGM;
        u.pm = fm + ((wgid % nig) % gsz); u.pn = (wgid % nig) / gsz; return true;
    }
    __device__ __forceinline__ void a_ready(const Unit&) const {}
    __device__ __forceinline__ void done(const Unit&) const {}
};


#define PG8_FOR_FRAGS(...) _Pragma("unroll") for (int ai = 0; ai < 2; ++ai) _Pragma("unroll") for (int m = 0; m < 4; ++m) { const int row = u.pm * BM + ai * HALF + wr * 64 + m * 16 + fr; \
    _Pragma("unroll") for (int bj = 0; bj < 2; ++bj) _Pragma("unroll") for (int n = 0; n < 2; ++n) { const int col = u.pn * BM + bj * HALF + wc * 32 + n * 16 + 4 * fq; ::f32x4 v = acc[ai][bj][m][n]; __VA_ARGS__ } }
__device__ __forceinline__ bool rope_off(int c, int& o) {
    if (c < C_QF) return false;
    if (c < C_KV) { const int j = (c - C_QF) % QFW; o = j - 128; return j >= 128; }
    if (c < C_QI) { const int j = c - C_KV; o = j - 128; return j >= 128; }
    if (c < C_KI) { const int j = (c - C_QI) & 63; o = j; return j < 16; }
    if (c < C_WI) { const int j = c - C_KI; o = j; return j < 16; }
    return false;
}
struct EpiInproj {
    static constexpr bool PERM = false, AFTER_DRAIN = false;
    bf16_t* P; const float2* cs;
    __device__ __forceinline__ void operator()(const f32x4 (&acc)[2][2][4][2], const Unit& u, int wr, int wc, int fr, int fq) const {
        PG8_FOR_FRAGS(
            if (col < PW) {
                int o;
                if (rope_off(col, o)) {
                    const int pos = row % T; const float2 c0 = cs[pos * 8 + (o >> 1)], c1 = cs[pos * 8 + (o >> 1) + 1];
                    v = (::f32x4){v.x * c0.x - v.y * c0.y, v.y * c0.x + v.x * c0.y, v.z * c1.x - v.w * c1.y, v.w * c1.x + v.z * c1.y};
                }
                ::u32x2 w; w.x = pk2(v.x, v.y); w.y = pk2(v.z, v.w);
                *(::u32x2*)(P + (size_t)row * PW + col) = w;
            })
    }
};
struct EpiGate {
    static constexpr bool PERM = false, AFTER_DRAIN = false;
    bf16_t* G;
    __device__ __forceinline__ void operator()(const f32x4 (&acc)[2][2][4][2], const Unit& u, int wr, int wc, int fr, int fq) const {
        PG8_FOR_FRAGS( ::u32x2 w; w.x = pk2(sigmoidf(v.x), sigmoidf(v.y)); w.y = pk2(sigmoidf(v.z), sigmoidf(v.w)); *(::u32x2*)(G + (size_t)row * 2048 + col) = w; )
    }
};
template <bool ACCUM> struct EpiZ {
    static constexpr bool PERM = false, AFTER_DRAIN = false;
    bf16_t* Z; const bf16_t* G; int goff;
    __device__ __forceinline__ void operator()(const f32x4 (&acc)[2][2][4][2], const Unit& u, int wr, int wc, int fr, int fq) const {
        PG8_FOR_FRAGS(
            const ::u32x2 g = *(const ::u32x2*)(G + (size_t)row * 2048 + goff + col);
            ::f32x4 z = (::f32x4){bflo(g.x) * v.x, bfhi(g.x) * v.y, bflo(g.y) * v.z, bfhi(g.y) * v.w};
            ::u32x2* zp = (::u32x2*)(Z + (size_t)row * D + col);
            if (ACCUM) { const ::u32x2 o = *zp; z.x += bflo(o.x); z.y += bfhi(o.x); z.z += bflo(o.y); z.w += bfhi(o.y); }
            ::u32x2 w; w.x = pk2(z.x, z.y); w.y = pk2(z.z, z.w); *zp = w; )
    }
};
struct EpiH1 {
    static constexpr bool PERM = false, AFTER_DRAIN = false;
    float* H1; const float* meta; const float* x;
    __device__ __forceinline__ void operator()(const f32x4 (&acc)[2][2][4][2], const Unit& u, int wr, int wc, int fr, int fq) const {
        PG8_FOR_FRAGS( if (row < NTOK) { const int b = row / T, t = row - b * T; const float* hr = t < NMETA ? meta + (size_t)t * D : x + ((size_t)b * SEQ + (t - NMETA)) * D;
            const ::f32x4 h = *(const ::f32x4*)(hr + col); *(::f32x4*)(H1 + (size_t)row * D + col) = h + v; } )
    }
};
#undef PG8_FOR_FRAGS

template <class Epi, class Sched, bool ALIGN_EPI = false, bool SP2 = false>
__device__ __forceinline__ void gemm_phase(PG8_LAS unsigned char* lds, const Gemm g, const Sched& S, const Epi& E) {
    const int tid = threadIdx.x, wid = __builtin_amdgcn_readfirstlane(tid >> 6), lane = tid & 63, wr = wid >> 2, wc = wid & 3, fr = lane & 15, fq = lane >> 4;
    const int K = g.K, nt = K / BK;
    unsigned voffA[2], voffB[2];
#pragma unroll
    for (int i = 0; i < 2; ++i) { int R, C; stage_rc(tid * 16 + i * 8192, R, C); const int Rb = Epi::PERM ? ((R & ~31) + perm32(R & 31)) : R;
        voffA[i] = (unsigned)(R * K + C) * 2u; voffB[i] = (unsigned)(Rb * K + C) * 2u; }
    const size_t kstep = (size_t)(BK * 2);
    const size_t hstep = (size_t)HALF * K * 2;
    const size_t tstep = 2 * hstep;
    const unsigned ldsw = (unsigned)wid * 1024u;
    const int aoff = lds_byte(wr * 64 + fr, fq * 8), boff = lds_byte(wc * 32 + fr, fq * 8);
#define PG8_SA(b, h) (((b) * 2 + (h)) * HTB)
#define PG8_SB(b, h) ((4 + (b) * 2 + (h)) * HTB)
#define PG8_STAGE(bufoff, gbase, voff) do { _Pragma("unroll") for (int _i = 0; _i < 2; ++_i) \
        __builtin_amdgcn_global_load_lds((const unsigned*)((const char*)(gbase) + (voff)[_i]), (PG8_LAS unsigned*)(lds + (bufoff) + ldsw + _i * 8192), 16, 0, 0); } while (0)
#define PG8_LDA(dst, b, h) do { _Pragma("unroll") for (int m = 0; m < 4; ++m) _Pragma("unroll") for (int k = 0; k < 2; ++k) dst[m][k] = *(const PG8_LAS bf16x8*)(lds + PG8_SA(b, h) + aoff + m * 2048 + k * 1024); } while (0)
#define PG8_LDB(dst, b, h) do { _Pragma("unroll") for (int n = 0; n < 2; ++n) _Pragma("unroll") for (int k = 0; k < 2; ++k) dst[n][k] = *(const PG8_LAS bf16x8*)(lds + PG8_SB(b, h) + boff + n * 2048 + k * 1024); } while (0)
#define PG8_MMA(ai, bj, At, Bt) do { __builtin_amdgcn_s_setprio(1); _Pragma("unroll") for (int m = 0; m < 4; ++m) _Pragma("unroll") for (int n = 0; n < 2; ++n) _Pragma("unroll") for (int k = 0; k < 2; ++k) \
        acc[ai][bj][m][n] = __builtin_amdgcn_mfma_f32_16x16x32_bf16(Bt[n][k], At[m][k], acc[ai][bj][m][n], 0, 0, 0); __builtin_amdgcn_s_setprio(0); } while (0)
#define PG8_WAIT_V(n) asm volatile("s_waitcnt vmcnt(" #n ")" ::: "memory")
#define PG8_WAIT_L(n) asm volatile("s_waitcnt lgkmcnt(" #n ")" ::: "memory")
#define PG8_BAR __builtin_amdgcn_s_barrier()
#define PG8_SCHED __builtin_amdgcn_sched_barrier(0)
    Unit cur, nxt; int ui = 0;
    if (!S.next(0, cur)) return;
    f32x4 acc[2][2][4][2];
#pragma unroll
    for (int a = 0; a < 2; ++a)
#pragma unroll
        for (int b = 0; b < 2; ++b)
#pragma unroll
            for (int m = 0; m < 4; ++m)
#pragma unroll
                for (int n = 0; n < 2; ++n) acc[a][b][m][n] = (f32x4){0.f, 0.f, 0.f, 0.f};
    bf16x8 At[4][2], B0[2][2], B1[2][2];
    const char* cA = (const char*)g.A + (size_t)cur.pm * tstep; const char* cB = (const char*)g.Bt + (size_t)cur.pn * tstep;
    S.a_ready(cur);
    if constexpr (SP2) {
        PG8_STAGE(PG8_SB(0, 0), cB, voffB); PG8_STAGE(PG8_SB(0, 1), cB + hstep, voffB); PG8_STAGE(PG8_SA(0, 0), cA, voffA); PG8_STAGE(PG8_SA(0, 1), cA + hstep, voffA);
        if (wr == 1) PG8_BAR;
        PG8_WAIT_V(2); PG8_BAR;
        PG8_STAGE(PG8_SB(1, 0), cB + kstep, voffB); PG8_STAGE(PG8_SA(1, 0), cA + kstep, voffA); PG8_STAGE(PG8_SB(1, 1), cB + hstep + kstep, voffB);
        PG8_WAIT_V(6); PG8_BAR;
    } else {
        PG8_STAGE(PG8_SB(0, 0), cB, voffB); PG8_STAGE(PG8_SA(0, 0), cA, voffA); PG8_STAGE(PG8_SB(0, 1), cB + hstep, voffB); PG8_STAGE(PG8_SA(0, 1), cA + hstep, voffA);
        if (wr == 1) PG8_BAR;
        PG8_WAIT_V(4); PG8_BAR;
        PG8_STAGE(PG8_SB(1, 0), cB + kstep, voffB); PG8_STAGE(PG8_SA(1, 0), cA + kstep, voffA); PG8_STAGE(PG8_SB(1, 1), cB + hstep + kstep, voffB);
        PG8_WAIT_V(6); PG8_BAR;
    }
    for (;;) {
        const bool has_next = S.next(ui + 1, nxt);
        const char* nA = has_next ? (const char*)g.A + (size_t)nxt.pm * tstep : cA; const char* nB = has_next ? (const char*)g.Bt + (size_t)nxt.pn * tstep : cB;
        for (int t = 0; t < nt; t += 2) {
            const bool last = (t == nt - 2);
            const char* a1 = cA + (size_t)(t + 1) * kstep;
            const char* a2 = last ? nA : cA + (size_t)(t + 2) * kstep; const char* b2 = last ? nB : cB + (size_t)(t + 2) * kstep;
            const char* a3 = a2 + kstep; const char* b3 = b2 + kstep;
            if (last && has_next) S.a_ready(nxt);
            if constexpr (SP2) {
            PG8_LDB(B0, 0, 0); PG8_LDB(B1, 0, 1); PG8_SCHED; PG8_LDA(At, 0, 0); PG8_STAGE(PG8_SA(1, 1), a1 + hstep, voffA);
            PG8_WAIT_V(8); PG8_WAIT_L(0); PG8_BAR; PG8_MMA(0, 0, At, B0); PG8_MMA(0, 1, At, B1); PG8_BAR; PG8_SCHED;
            PG8_LDA(At, 0, 1); PG8_STAGE(PG8_SB(0, 0), b2, voffB); PG8_STAGE(PG8_SB(0, 1), b2 + hstep, voffB); PG8_STAGE(PG8_SA(0, 0), a2, voffA);
            PG8_WAIT_V(8); PG8_WAIT_L(0); PG8_BAR; PG8_MMA(1, 0, At, B0); PG8_MMA(1, 1, At, B1); PG8_BAR; PG8_SCHED;
            PG8_LDB(B0, 1, 0); PG8_LDB(B1, 1, 1); PG8_SCHED; PG8_LDA(At, 1, 0); PG8_STAGE(PG8_SA(0, 1), a2 + hstep, voffA);
            PG8_WAIT_V(8); PG8_WAIT_L(0); PG8_BAR; PG8_MMA(0, 0, At, B0); PG8_MMA(0, 1, At, B1); PG8_BAR; PG8_SCHED;
            PG8_LDA(At, 1, 1); PG8_STAGE(PG8_SB(1, 0), b3, voffB); PG8_STAGE(PG8_SB(1, 1), b3 + hstep, voffB); PG8_STAGE(PG8_SA(1, 0), a3, voffA);
            PG8_WAIT_V(8); PG8_WAIT_L(0); PG8_BAR; PG8_MMA(1, 0, At, B0); PG8_MMA(1, 1, At, B1); PG8_BAR; PG8_SCHED;
            } else {
            PG8_LDB(B0, 0, 0); PG8_SCHED; PG8_LDA(At, 0, 0); PG8_STAGE(PG8_SA(1, 1), a1 + hstep, voffA);
            PG8_WAIT_L(8); PG8_BAR; PG8_WAIT_L(0); PG8_MMA(0, 0, At, B0); PG8_BAR; PG8_SCHED;
            PG8_LDB(B1, 0, 1); PG8_STAGE(PG8_SB(0, 0), b2, voffB);
            PG8_BAR; PG8_WAIT_L(0); PG8_MMA(0, 1, At, B1); PG8_BAR;
            PG8_LDA(At, 0, 1); PG8_STAGE(PG8_SA(0, 0), a2, voffA);
            PG8_BAR; PG8_WAIT_L(0); PG8_MMA(1, 0, At, B0); PG8_BAR; PG8_SCHED;
            PG8_STAGE(PG8_SB(0, 1), b2 + hstep, voffB);
            PG8_WAIT_V(6); PG8_BAR; PG8_MMA(1, 1, At, B1); PG8_BAR;
            PG8_LDB(B0, 1, 0); PG8_SCHED; PG8_LDA(At, 1, 0); PG8_STAGE(PG8_SA(0, 1), a2 + hstep, voffA);
            PG8_WAIT_L(8); PG8_BAR; PG8_WAIT_L(0); PG8_MMA(0, 0, At, B0); PG8_BAR; PG8_SCHED;
            PG8_LDB(B1, 1, 1); PG8_STAGE(PG8_SB(1, 0), b3, voffB);
            PG8_BAR; PG8_WAIT_L(0); PG8_MMA(0, 1, At, B1); PG8_BAR;
            PG8_LDA(At, 1, 1); PG8_STAGE(PG8_SA(1, 0), a3, voffA);
            PG8_BAR; PG8_WAIT_L(0); PG8_MMA(1, 0, At, B0); PG8_BAR; PG8_SCHED;
            PG8_STAGE(PG8_SB(1, 1), b3 + hstep, voffB);
            PG8_WAIT_V(6); PG8_BAR; PG8_MMA(1, 1, At, B1); PG8_BAR;
            }
        }
        if constexpr (ALIGN_EPI) { if (wr == 0) PG8_BAR; }
        if constexpr (!Epi::AFTER_DRAIN) { E(acc, cur, wr, wc, fr, fq); S.done(cur); }
        if (!has_next) break;
#pragma unroll
        for (int a = 0; a < 2; ++a)
#pragma unroll
            for (int b = 0; b < 2; ++b)
#pragma unroll
                for (int m = 0; m < 4; ++m)
#pragma unroll
                    for (int n = 0; n < 2; ++n) acc[a][b][m][n] = (f32x4){0.f, 0.f, 0.f, 0.f};
        cur = nxt; cA = nA; cB = nB; ++ui;
        if constexpr (ALIGN_EPI) { if (wr == 1) PG8_BAR; }
    }
    PG8_WAIT_V(0);
    if constexpr (!ALIGN_EPI) { if (wr == 0) PG8_BAR; }
    PG8_BAR;
    if constexpr (Epi::AFTER_DRAIN) { E.fused(acc, cur, wr, wc, fr, fq, lds, wid, lane); S.done(cur); }
#undef PG8_SA
#undef PG8_SB
#undef PG8_STAGE
#undef PG8_LDA
#undef PG8_LDB
#undef PG8_MMA
#undef PG8_WAIT_V
#undef PG8_WAIT_L
#undef PG8_BAR
#undef PG8_SCHED
}
}
struct MLFast {
    static constexpr int TM = 128, TN = 128, NF = 16, NR = 2, STAGE = 16384, LDS_BYTES = 3 * STAGE;
    static __device__ __forceinline__ void pos(int tid, int f, int& r, int& c) {
        const int wid = tid >> 6, lane = tid & 63, wr = wid >> 1, wc = wid & 1, fr = lane & 15, fq = lane >> 4, m = f >> 2, n = f & 3;
        r = wr * 64 + m * 16 + fr; c = wc * 64 + n * 16 + 4 * fq; }
    static __device__ __forceinline__ void issue(char* buf, int wid, const bf16_t* const* ap, const bf16_t* const* bp, int k) {
#pragma unroll
        for (int i = 0; i < 2; ++i) {
            __builtin_amdgcn_global_load_lds((const unsigned*)(ap[i] + k), (LAS unsigned*)(buf + wid * 1024 + i * 4096), 16, 0, 0);
            __builtin_amdgcn_global_load_lds((const unsigned*)(bp[i] + k), (LAS unsigned*)(buf + 8192 + wid * 1024 + i * 4096), 16, 0, 0);
        }
    }
    static __device__ __forceinline__ void run(char* lds, int tid, int wid, const bf16_t* const* ap, const bf16_t* const* bp, int K, f32x4* acc) {
        const int lane = tid & 63, wr = wid >> 1, wc = wid & 1, fr = lane & 15, fq = lane >> 4;
#pragma unroll
        for (int f = 0; f < 16; ++f) acc[f] = (f32x4){0.f, 0.f, 0.f, 0.f};
        const int nk = K / 32;
        asm volatile("s_waitcnt vmcnt(0)" ::: "memory");
        issue(lds, wid, ap, bp, 0);
        issue(lds + STAGE, wid, ap, bp, 32);
        int cur = 0, nxt = 2;
        for (int kt = 0; kt < nk; ++kt) {
            if (kt + 1 < nk) asm volatile("s_waitcnt vmcnt(4)" ::: "memory"); else asm volatile("s_waitcnt vmcnt(0)" ::: "memory");
            asm volatile("s_waitcnt lgkmcnt(0)" ::: "memory");
            __builtin_amdgcn_s_barrier();
            asm volatile("" ::: "memory");
            if (kt + 2 < nk) issue(lds + nxt * STAGE, wid, ap, bp, (kt + 2) * 32);
            const char* SA = lds + cur * STAGE; const char* SB = SA + 8192;
            bf16x8 At[4], Bt[4];
#pragma unroll
            for (int m = 0; m < 4; ++m) { At[m] = *(const bf16x8*)(SA + (wr * 64 + m * 16 + fr) * 64 + fq * 16); Bt[m] = *(const bf16x8*)(SB + (wc * 64 + m * 16 + fr) * 64 + fq * 16); }
#pragma unroll
            for (int m = 0; m < 4; ++m)
#pragma unroll
                for (int n = 0; n < 4; ++n) acc[m * 4 + n] = __builtin_amdgcn_mfma_f32_16x16x32_bf16(Bt[n], At[m], acc[m * 4 + n], 0, 0, 0);
            cur = cur == 2 ? 0 : cur + 1; nxt = nxt == 2 ? 0 : nxt + 1;
        }
        asm volatile("s_waitcnt lgkmcnt(0)" ::: "memory");
        __builtin_amdgcn_s_barrier();
        asm volatile("" ::: "memory");
    }
};

constexpr int SB_NQT = (T + 31) / 32;
constexpr int SB_VT_STRIDE = 40;
__device__ __forceinline__ void phase_sb_fast(const Params& p, char* lds) {
    const bf16_t* P = (const bf16_t*)(p.ws + WS_P); bf16_t* YA = (bf16_t*)(p.ws + WS_YA);
    const int tid = threadIdx.x, lane = tid & 63, wave = tid >> 6, n = lane & 31, hh = lane >> 5;
    bf16_t* VT = (bf16_t*)(lds + wave * (64 * SB_VT_STRIDE * 2));
    const int gw = blockIdx.x * NWAVES + wave, NGW = gridDim.x * NWAVES;
    for (int unit = gw; unit < 64 * SB_NQT; unit += NGW) {
        const int qt = SB_NQT - 1 - unit / 64, bh = unit % 64, h = bh & 7, b = bh >> 3;
        const int i0 = qt * 32, qi = i0 + n, qrow = qi < T ? qi : T - 1;
        const bf16_t* Pb = P + (size_t)b * T * PW;
        bf16x8 qf[4];
#pragma unroll
        for (int s = 0; s < 4; ++s) qf[s] = *(const bf16x8*)(Pb + (size_t)qrow * PW + C_QA + h * 64 + 16 * s + 8 * hh);
        f32x16 o0, o1;
#pragma unroll
        for (int r = 0; r < 16; ++r) { o0[r] = 0.f; o1[r] = 0.f; }
        float L = 0.f;
        for (int kt = qt; kt >= 0; --kt) {
            const int j0 = kt * 32, krow = (j0 + n) < T ? (j0 + n) : T - 1;
            bf16x8 kf[4];
#pragma unroll
            for (int s = 0; s < 4; ++s) kf[s] = *(const bf16x8*)(Pb + (size_t)krow * PW + C_KA + h * 64 + 16 * s + 8 * hh);
#pragma unroll
            for (int i = 0; i < 4; ++i) {
                const int c = lane + 64 * i, key = c >> 3, d0 = (c & 7) * 8, vrow = (j0 + key) < T ? (j0 + key) : T - 1;
                const u32x4 w = *(const u32x4*)(Pb + (size_t)vrow * PW + C_VA + h * 64 + d0);
                bf16_t* vp = VT + d0 * SB_VT_STRIDE + key;
                vp[0] = (bf16_t)(w.x & 0xffff); vp[SB_VT_STRIDE] = (bf16_t)(w.x >> 16); vp[2 * SB_VT_STRIDE] = (bf16_t)(w.y & 0xffff); vp[3 * SB_VT_STRIDE] = (bf16_t)(w.y >> 16);
                vp[4 * SB_VT_STRIDE] = (bf16_t)(w.z & 0xffff); vp[5 * SB_VT_STRIDE] = (bf16_t)(w.z >> 16); vp[6 * SB_VT_STRIDE] = (bf16_t)(w.w & 0xffff); vp[7 * SB_VT_STRIDE] = (bf16_t)(w.w >> 16);
            }
            f32x16 sa;
#pragma unroll
            for (int r = 0; r < 16; ++r) sa[r] = 0.f;
#pragma unroll
            for (int s = 0; s < 4; ++s) sa = __builtin_amdgcn_mfma_f32_32x32x16_bf16(kf[s], qf[s], sa, 0, 0, 0);
            float lk[16], z[16];
#pragma unroll
            for (int r = 0; r < 16; ++r) {
                const int kk = (r & 3) + 8 * (r >> 2) + 4 * hh; const bool valid = (j0 + kk) < qi;
                const float zz = fminf(sa[r], 80.f); const float l = -__log2f(1.f + exp2f(zz));
                z[r] = zz; lk[r] = valid ? l : 0.f;
            }
            const float gs0 = (lk[0] + lk[1]) + (lk[2] + lk[3]), gs1 = (lk[4] + lk[5]) + (lk[6] + lk[7]), gs2 = (lk[8] + lk[9]) + (lk[10] + lk[11]), gs3 = (lk[12] + lk[13]) + (lk[14] + lk[15]);
            const float ps0 = __shfl_xor(gs0, 32), ps1 = __shfl_xor(gs1, 32), ps2 = __shfl_xor(gs2, 32), ps3 = __shfl_xor(gs3, 32);
            const float pc3 = ps3, pc2 = pc3 + ps2, pc1 = pc2 + ps1, pc0 = pc1 + ps0;
            float base[4];
            base[3] = L + (hh ? 0.f : pc3);
            base[2] = L + gs3 + (hh ? pc3 : pc2);
            base[1] = L + (gs3 + gs2) + (hh ? pc2 : pc1);
            base[0] = L + (gs3 + gs2 + gs1) + (hh ? pc1 : pc0);
            float a[16];
#pragma unroll
            for (int g = 0; g < 4; ++g) {
                float c = base[g];
#pragma unroll
                for (int e = 3; e >= 0; --e) {
                    const int r = 4 * g + e; c += lk[r];
                    const int kk = e + 8 * g + 4 * hh; const bool valid = (j0 + kk) < qi;
                    a[r] = valid ? exp2f(z[r] + c) : 0.f;
                }
            }
            L += (gs0 + gs1 + gs2 + gs3) + pc0;
            u32x4 pw0, pw1;
            pw0.x = pk2(a[0], a[1]); pw0.y = pk2(a[2], a[3]); pw0.z = pk2(a[4], a[5]); pw0.w = pk2(a[6], a[7]);
            pw1.x = pk2(a[8], a[9]); pw1.y = pk2(a[10], a[11]); pw1.z = pk2(a[12], a[13]); pw1.w = pk2(a[14], a[15]);
            const bf16x8 pf0 = __builtin_bit_cast(bf16x8, pw0), pf1 = __builtin_bit_cast(bf16x8, pw1);
#pragma unroll
            for (int mt = 0; mt < 2; ++mt) {
                const bf16_t* vr = VT + (32 * mt + n) * SB_VT_STRIDE + 4 * hh;
                u32x4 v0, v1;
                { const u32x2 x = *(const u32x2*)(vr), y = *(const u32x2*)(vr + 8); v0.x = x.x; v0.y = x.y; v0.z = y.x; v0.w = y.y; }
                { const u32x2 x = *(const u32x2*)(vr + 16), y = *(const u32x2*)(vr + 24); v1.x = x.x; v1.y = x.y; v1.z = y.x; v1.w = y.y; }
                if (mt == 0) { o0 = __builtin_amdgcn_mfma_f32_32x32x16_bf16(__builtin_bit_cast(bf16x8, v0), pf0, o0, 0, 0, 0); o0 = __builtin_amdgcn_mfma_f32_32x32x16_bf16(__builtin_bit_cast(bf16x8, v1), pf1, o0, 0, 0, 0); }
                else { o1 = __builtin_amdgcn_mfma_f32_32x32x16_bf16(__builtin_bit_cast(bf16x8, v0), pf0, o1, 0, 0, 0); o1 = __builtin_amdgcn_mfma_f32_32x32x16_bf16(__builtin_bit_cast(bf16x8, v1), pf1, o1, 0, 0, 0); }
            }
            const bool done = (L < -152.f) || (qi >= T);
            if (__all(done)) break;
        }
        if (qi < T) {
            bf16_t* yp = YA + ((size_t)b * T + qi) * 512 + h * 64 + 4 * hh;
#pragma unroll
            for (int g = 0; g < 4; ++g) {
                u32x2 w; w.x = pk2(o0[4 * g], o0[4 * g + 1]); w.y = pk2(o0[4 * g + 2], o0[4 * g + 3]); *(u32x2*)(yp + 8 * g) = w;
                w.x = pk2(o1[4 * g], o1[4 * g + 1]); w.y = pk2(o1[4 * g + 2], o1[4 * g + 3]); *(u32x2*)(yp + 32 + 8 * g) = w;
            }
        }
    }
}

constexpr int DSA_NQ = 8;
constexpr int DSA_SCS = 4128;
constexpr int DSA_KVB = 0, DSA_RING = 18432, DSA_IDX = DSA_NQ * DSA_RING, DSA_MISC = DSA_IDX + DSA_NQ * 512, DSA_LDS = DSA_MISC + 512;
static_assert(DSA_NQ * DSA_SCS * 4 <= DSA_IDX, "score rows fit under the index lists");
__device__ __forceinline__ unsigned fkey(float f) { const unsigned u = __float_as_uint(f); return (u & 0x80000000u) ? ~u : (u | 0x80000000u); }
__device__ __forceinline__ int mbcnt64(unsigned long long m) { return (int)__builtin_amdgcn_mbcnt_hi((unsigned)(m >> 32), __builtin_amdgcn_mbcnt_lo((unsigned)m, 0u)); }
__device__ __forceinline__ void phase_dsa(const Params& p, char* lds) {
    const bf16_t* P = (const bf16_t*)(p.ws + WS_P); bf16_t* OL = (bf16_t*)(p.ws + WS_OLAT);
    const int tid = threadIdx.x, lane = tid & 63, wave = __builtin_amdgcn_readfirstlane(tid >> 6);
    unsigned* SC = (unsigned*)(lds + DSA_KVB);
    unsigned short* IDX = (unsigned short*)(lds + DSA_IDX);
    int* MISC = (int*)(lds + DSA_MISC);
    const unsigned lds_base = (unsigned)(size_t)lds;
    constexpr int NU = T / DSA_NQ;
    for (int unit = blockIdx.x; unit < BATCH * NU; unit += gridDim.x) {
        const int u8 = NU - 1 - unit / BATCH, b = unit % BATCH, t0 = u8 * DSA_NQ;
        const int cid = t0 < NMETA ? 0 : 1 + (t0 - NMETA) / 64, n = NMETA + 64 * cid;
        const bf16_t* Pb = P + (size_t)b * T * PW;
        __syncthreads();
        {
            const int m = lane & 31, hh = lane >> 5;
            bf16x8 aq[2][4]; float wv[2][16];
#pragma unroll
            for (int rt = 0; rt < 2; ++rt) {
#pragma unroll
                for (int s = 0; s < 4; ++s) aq[rt][s] = *(const bf16x8*)(Pb + (size_t)(t0 + 4 * rt + (m >> 3)) * PW + C_QI + (m & 7) * 64 + 16 * s + 8 * hh);
#pragma unroll
                for (int r = 0; r < 16; ++r) wv[rt][r] = bf2f(Pb[(size_t)(t0 + 4 * rt + (r >> 2)) * PW + C_WI + (r & 3) + 4 * hh]);
            }
            const int ntile = (n + 31) / 32;
            bf16x8 bk[4];
            { const int key = wave * 32 + m, krow = key < T ? key : T - 1;
#pragma unroll
              for (int s = 0; s < 4; ++s) bk[s] = *(const bf16x8*)(Pb + (size_t)krow * PW + C_KI + 16 * s + 8 * hh); }
            for (int kt = wave; kt < ntile; kt += NWAVES) {
                const int j0 = kt * 32, key = j0 + m;
                bf16x8 bn[4];
                { const int keyn = key + 32 * NWAVES, krow = keyn < T ? keyn : T - 1;
#pragma unroll
                  for (int s = 0; s < 4; ++s) bn[s] = *(const bf16x8*)(Pb + (size_t)krow * PW + C_KI + 16 * s + 8 * hh); }
                const bool ok = key < n;
#pragma unroll
                for (int rt = 0; rt < 2; ++rt) {
                    f32x16 acc;
#pragma unroll
                    for (int r = 0; r < 16; ++r) acc[r] = 0.f;
#pragma unroll
                    for (int s = 0; s < 4; ++s) acc = __builtin_amdgcn_mfma_f32_32x32x16_bf16(aq[rt][s], bk[s], acc, 0, 0, 0);
                    float tq[4];
#pragma unroll
                    for (int q = 0; q < 4; ++q) {
                        float s = wv[rt][4 * q] * fmaxf(acc[4 * q], 0.f); s += wv[rt][4 * q + 1] * fmaxf(acc[4 * q + 1], 0.f); s += wv[rt][4 * q + 2] * fmaxf(acc[4 * q + 2], 0.f); s += wv[rt][4 * q + 3] * fmaxf(acc[4 * q + 3], 0.f);
                        tq[q] = s + __shfl_xor(s, 32);
                    }
                    const float s0 = hh ? tq[2] : tq[0], s1 = hh ? tq[3] : tq[1];
                    SC[(4 * rt + 2 * hh) * DSA_SCS + key] = ok ? fkey(s0) : 0u;
                    SC[(4 * rt + 2 * hh + 1) * DSA_SCS + key] = ok ? fkey(s1) : 0u;
                }
#pragma unroll
                for (int s = 0; s < 4; ++s) bk[s] = bn[s];
            }
        }
        __syncthreads();
        {
            const unsigned* sc = SC + wave * DSA_SCS;
            unsigned v[65];
#pragma unroll
            for (int i = 0; i < 65; ++i) { const int k = i * 64 + lane; v[i] = (k < n) ? sc[k] : 0u; }
            unsigned prefix = 0u;
            for (int bit = 31; bit >= -1; --bit) {
                const unsigned cand = bit >= 0 ? (prefix | (1u << bit)) : prefix + 1u; int c = 0;
#pragma unroll
                for (int gi = 0; gi < 5; ++gi) if (gi * 832 < n) {
#pragma unroll
                    for (int i = 13 * gi; i < 13 * gi + 13; ++i) { c += __popcll(__ballot(v[i] >= cand)); if ((i & 3) == 3) __builtin_amdgcn_sched_barrier(0); }
                    __builtin_amdgcn_sched_barrier(0);
                }
                if (bit >= 0) { if (c >= 256) prefix = cand; } else MISC[16 + wave] = c;
            }
            const int ngt = MISC[16 + wave];
            const int need = 256 - ngt; int base = 0, eqb = 0;
            unsigned short* idx = IDX + wave * 256;
            for (int k0 = 0; k0 < n; k0 += 64) {
                const int k = k0 + lane; const bool valid = k < n; const unsigned u = valid ? sc[k] : 0u;
                const bool eq = valid && (u == prefix); const unsigned long long meq = __ballot(eq);
                const bool take = valid && ((u > prefix) || (eq && (eqb + mbcnt64(meq)) < need));
                const unsigned long long mt = __ballot(take);
                if (take) idx[base + mbcnt64(mt)] = (unsigned short)k;
                base += __popcll(mt); eqb += __popcll(meq);
            }
            for (int pos = base + lane; pos < 256; pos += 64) idx[pos] = 0;
            if (lane == 0) MISC[wave] = base;
        }
        __syncthreads();
        {
            const int q = wave; const int nsel = MISC[q];
            const size_t qrow = (size_t)(t0 + q);
            int ln = lane; asm volatile("" : "+v"(ln));
            const int hd = ln & 15, g = ln >> 4, qd = (ln & 15) >> 2, pp = ln & 3;
            char* ring = lds + DSA_KVB + wave * DSA_RING;
            const unsigned ring_a = lds_base + DSA_KVB + wave * DSA_RING;
            const unsigned short* idx = IDX + q * 256;
            bf16x8 qf[5];
#pragma unroll
            for (int ks = 0; ks < 5; ++ks) {
                u32x4 w = (u32x4){0u, 0u, 0u, 0u};
                if (hd < 8 && (ks < 4 || g < 2)) w = *(const u32x4*)(Pb + qrow * PW + C_QF + hd * QFW + 32 * ks + 8 * g);
                qf[ks] = __builtin_bit_cast(bf16x8, w);
            }
            asm volatile("s_waitcnt vmcnt(0)" ::: "memory");
#define DSA_ISSUE(c) do { _Pragma("unroll") for (int i_ = 0; i_ < 9; ++i_) { const int pid_ = ln + 64 * i_, row_ = pid_ / 18, part_ = pid_ - row_ * 18; \
                const bf16_t* src_ = Pb + (size_t)idx[32 * (c) + row_] * PW + C_KV + part_ * 8; \
                __builtin_amdgcn_global_load_lds((const unsigned*)src_, (LAS unsigned*)(ring + ((c) & 1) * 9216 + i_ * 1024), 16, 0, 0); } } while (0)
            DSA_ISSUE(0); DSA_ISSUE(1);
            f32x4 O[8];
#pragma unroll
            for (int nt = 0; nt < 8; ++nt) O[nt] = (f32x4){0.f, 0.f, 0.f, 0.f};
            float mrun = -3e38f, lrun = 0.f;
            for (int c = 0; c < 8; ++c) {
                if (c < 7) asm volatile("s_waitcnt vmcnt(9)" ::: "memory"); else asm volatile("s_waitcnt vmcnt(0)" ::: "memory");
                const char* buf = ring + (c & 1) * 9216;
                f32x4 S0 = (f32x4){0.f, 0.f, 0.f, 0.f}, S1 = S0;
                {
                    const char* kr = buf + hd * 288 + 16 * g;
#pragma unroll
                    for (int ks = 0; ks < 4; ++ks) { S0 = __builtin_amdgcn_mfma_f32_16x16x32_bf16(*(const bf16x8*)(kr + 64 * ks), qf[ks], S0, 0, 0, 0); S1 = __builtin_amdgcn_mfma_f32_16x16x32_bf16(*(const bf16x8*)(kr + 16 * 288 + 64 * ks), qf[ks], S1, 0, 0, 0); }
                    u32x4 w0 = (u32x4){0u, 0u, 0u, 0u}, w1 = w0; if (g < 2) { w0 = *(const u32x4*)(kr + 256); w1 = *(const u32x4*)(kr + 16 * 288 + 256); }
                    S0 = __builtin_amdgcn_mfma_f32_16x16x32_bf16(__builtin_bit_cast(bf16x8, w0), qf[4], S0, 0, 0, 0); S1 = __builtin_amdgcn_mfma_f32_16x16x32_bf16(__builtin_bit_cast(bf16x8, w1), qf[4], S1, 0, 0, 0);
                }
                float cm = -3e38f;
#pragma unroll
                for (int r = 0; r < 4; ++r) { const int sl = 32 * c + 4 * g + r; S0[r] = sl < nsel ? S0[r] : -1e30f; S1[r] = (sl + 16) < nsel ? S1[r] : -1e30f; cm = fmaxf(cm, fmaxf(S0[r], S1[r])); }
                cm = fmaxf(cm, __shfl_xor(cm, 16)); cm = fmaxf(cm, __shfl_xor(cm, 32));
                const float mnew = fmaxf(mrun, cm), alpha = exp2f(mrun - mnew);
                float ps = 0.f;
#pragma unroll
                for (int r = 0; r < 4; ++r) { S0[r] = exp2f(S0[r] - mnew); S1[r] = exp2f(S1[r] - mnew); ps += S0[r] + S1[r]; }
                ps += __shfl_xor(ps, 16); ps += __shfl_xor(ps, 32);
                lrun = lrun * alpha + ps; mrun = mnew;
                const float a0 = __shfl(alpha, 4 * g), a1 = __shfl(alpha, 4 * g + 1), a2 = __shfl(alpha, 4 * g + 2), a3 = __shfl(alpha, 4 * g + 3);
#pragma unroll
                for (int nt = 0; nt < 8; ++nt) { O[nt][0] *= a0; O[nt][1] *= a1; O[nt][2] *= a2; O[nt][3] *= a3; }
                u32x4 pw; pw.x = pk2(S0[0], S0[1]); pw.y = pk2(S0[2], S0[3]); pw.z = pk2(S1[0], S1[1]); pw.w = pk2(S1[2], S1[3]);
                const bf16x8 pf = __builtin_bit_cast(bf16x8, pw);
                const unsigned va = ring_a + (unsigned)((c & 1) * 9216 + (4 * g + qd) * 288 + 8 * pp);
#pragma unroll
                for (int h2 = 0; h2 < 2; ++h2) {
                    u16x4 x0, x1, x2, x3, y0, y1, y2, y3;
                    asm volatile("ds_read_b64_tr_b16 %0, %8 offset:%9\n\tds_read_b64_tr_b16 %1, %8 offset:%10\n\tds_read_b64_tr_b16 %2, %8 offset:%11\n\tds_read_b64_tr_b16 %3, %8 offset:%12\n\t"
                                 "ds_read_b64_tr_b16 %4, %8 offset:%13\n\tds_read_b64_tr_b16 %5, %8 offset:%14\n\tds_read_b64_tr_b16 %6, %8 offset:%15\n\tds_read_b64_tr_b16 %7, %8 offset:%16\n\ts_waitcnt lgkmcnt(0)"
                                 : "=&v"(x0), "=&v"(x1), "=&v"(x2), "=&v"(x3), "=&v"(y0), "=&v"(y1), "=&v"(y2), "=&v"(y3)
                                 : "v"(va), "i"(128 * h2), "i"(128 * h2 + 32), "i"(128 * h2 + 64), "i"(128 * h2 + 96), "i"(128 * h2 + 4608), "i"(128 * h2 + 4640), "i"(128 * h2 + 4672), "i"(128 * h2 + 4704) : "memory");
#define DSA_PV(nt_, x_, y_) do { bf16x8 vf_; vf_[0] = (short)x_[0]; vf_[1] = (short)x_[1]; vf_[2] = (short)x_[2]; vf_[3] = (short)x_[3]; vf_[4] = (short)y_[0]; vf_[5] = (short)y_[1]; vf_[6] = (short)y_[2]; vf_[7] = (short)y_[3]; \
                    O[nt_] = __builtin_amdgcn_mfma_f32_16x16x32_bf16(pf, vf_, O[nt_], 0, 0, 0); } while (0)
                    DSA_PV(4 * h2 + 0, x0, y0); DSA_PV(4 * h2 + 1, x1, y1); DSA_PV(4 * h2 + 2, x2, y2); DSA_PV(4 * h2 + 3, x3, y3);
                }
                asm volatile("s_waitcnt lgkmcnt(0)" ::: "memory");
                if (c + 2 < 8) DSA_ISSUE(c + 2);
            }
#undef DSA_PV
#undef DSA_ISSUE
            const float inv = 1.f / lrun;
            const float i0 = __shfl(inv, 4 * g), i1 = __shfl(inv, 4 * g + 1), i2 = __shfl(inv, 4 * g + 2), i3 = __shfl(inv, 4 * g + 3);
            if (g < 2) {
                bf16_t* op = OL + ((size_t)b * T + qrow) * 1024 + (4 * g) * 128 + hd;
#pragma unroll
                for (int nt = 0; nt < 8; ++nt) { op[16 * nt] = (bf16_t)f2bf(O[nt][0] * i0); op[128 + 16 * nt] = (bf16_t)f2bf(O[nt][1] * i1); op[256 + 16 * nt] = (bf16_t)f2bf(O[nt][2] * i2); op[384 + 16 * nt] = (bf16_t)f2bf(O[nt][3] * i3); }
            }
        }
    }
}

__device__ __forceinline__ void phase_c3(const Params& p, char* lds) {
    unsigned char* ws = p.ws; const int tid = threadIdx.x, lane = tid & 63, wave = __builtin_amdgcn_readfirstlane(tid >> 6);
    const float* H1 = (const float*)(ws + WS_H1); const float* g = p.in[I_GFFN];
    {
        bf16_t* U2 = (bf16_t*)(ws + WS_U); const int gw = blockIdx.x * NWAVES + wave, NGW = gridDim.x * NWAVES;
        for (int row = gw; row < NTOK; row += NGW) {
            const f32x4* xr = (const f32x4*)(H1 + (size_t)row * D) + lane;
            f32x4 v[4]; float s = 0.f;
#pragma unroll
            for (int j = 0; j < 4; ++j) { v[j] = xr[64 * j]; s += (v[j].x * v[j].x + v[j].y * v[j].y) + (v[j].z * v[j].z + v[j].w * v[j].w); }
            const float rstd = rsqrtf(wave_sum(s) * (1.f / D) + NORM_EPS);
            u32x2* o = (u32x2*)(U2 + (size_t)row * D) + lane;
#pragma unroll
            for (int j = 0; j < 4; ++j) { const f32x4 gg = ((const f32x4*)g)[lane + 64 * j];
                u32x2 w; w.x = pk2(v[j].x * rstd * gg.x, v[j].y * rstd * gg.y); w.y = pk2(v[j].z * rstd * gg.z, v[j].w * rstd * gg.w); o[64 * j] = w; }
        }
    }
    {
        float* Tl = (float*)lds;
        float* RED = (float*)lds;
        const float* wg = p.in[I_WGRP]; const float* wr = p.in[I_WRT]; const float* bg = p.in[I_BGRP]; const float* br = p.in[I_BRT];
        unsigned* ctl = (unsigned*)(ws + WS_CTL); int* LIST = (int*)(ws + WS_LIST); float* GATE = (float*)(ws + WS_GATE);
        const int tk = tid & 127, kq = wave >> 1;
        for (int grp = blockIdx.x; grp < NTOK / 128; grp += gridDim.x) {
            const int tok0 = grp * 128;
            float acc[36]; float ss = 0.f;
#pragma unroll
            for (int o = 0; o < 36; ++o) acc[o] = 0.f;
            for (int step = 0; step < 8; ++step) {
                __syncthreads();
#pragma unroll
                for (int i = 0; i < 8; ++i) { const int idx = tid + NTHREADS * i, qq = idx >> 10, rem = idx & 1023, t2 = rem >> 3, kc = rem & 7;
                    const f32x4 v = *(const f32x4*)(H1 + (size_t)(tok0 + t2) * D + qq * 256 + step * 32 + kc * 4);
                    float* d = Tl + qq * (32 * 129) + (kc * 4) * 129 + t2; d[0] = v.x; d[129] = v.y; d[258] = v.z; d[387] = v.w; }
                __syncthreads();
                const int kb = kq * 256 + step * 32;
#pragma unroll 4
                for (int k = 0; k < 32; ++k) {
                    const float h = Tl[kq * (32 * 129) + k * 129 + tk]; ss += h * h; const float hg = h * g[kb + k];
                    const float* w4 = wg + (size_t)(kb + k) * 4; const float* w32 = wr + (size_t)(kb + k) * 32;
#pragma unroll
                    for (int o = 0; o < 4; ++o) acc[o] += hg * w4[o];
#pragma unroll
                    for (int o = 0; o < 32; ++o) acc[4 + o] += hg * w32[o];
                }
            }
            __syncthreads();
#pragma unroll
            for (int o = 0; o < 36; ++o) RED[(kq * 37 + o) * 128 + tk] = acc[o];
            RED[(kq * 37 + 36) * 128 + tk] = ss;
            __syncthreads();
            if (tid < 128) {
                const int tok = tok0 + tk;
#pragma unroll
                for (int o = 0; o < 36; ++o) acc[o] = (RED[o * 128 + tk] + RED[(37 + o) * 128 + tk]) + (RED[(74 + o) * 128 + tk] + RED[(111 + o) * 128 + tk]);
                ss = (RED[36 * 128 + tk] + RED[(37 + 36) * 128 + tk]) + (RED[(74 + 36) * 128 + tk] + RED[(111 + 36) * 128 + tk]);
                const float rstd = rsqrtf(ss * (1.f / D) + NORM_EPS);
                float gl[4]; int gs = 0; float gm;
#pragma unroll
                for (int o = 0; o < 4; ++o) gl[o] = acc[o] * rstd + bg[o];
                gm = gl[0];
#pragma unroll
                for (int o = 1; o < 4; ++o) if (gl[o] > gm) { gm = gl[o]; gs = o; }
                float gsum = 0.f;
#pragma unroll
                for (int o = 0; o < 4; ++o) gsum += __expf(gl[o] - gm);
                const float pgrp = 1.f / gsum;
                float el[8];
#pragma unroll
                for (int j = 0; j < 8; ++j) { float a = acc[4 + j]; float bb = br[j];
                    a = gs == 1 ? acc[12 + j] : a; bb = gs == 1 ? br[8 + j] : bb; a = gs == 2 ? acc[20 + j] : a; bb = gs == 2 ? br[16 + j] : bb; a = gs == 3 ? acc[28 + j] : a; bb = gs == 3 ? br[24 + j] : bb;
                    el[j] = a * rstd + bb; }
                int e0 = 0; float m0 = el[0];
#pragma unroll
                for (int j = 1; j < 8; ++j) if (el[j] > m0) { m0 = el[j]; e0 = j; }
                int e1 = -1; float m1 = -3e38f;
#pragma unroll
                for (int j = 0; j < 8; ++j) if (j != e0 && el[j] > m1) { m1 = el[j]; e1 = j; }
                const float x1 = __expf(m1 - m0); const float g0 = pgrp / (1.f + x1), g1 = pgrp * x1 / (1.f + x1);
                const int ex0 = gs * 8 + e0, ex1 = gs * 8 + e1;
                const int s0 = (int)atomicAdd(ctl + CW_CNT + 64 * ex0, 1u); LIST[(size_t)ex0 * NTOK + s0] = tok * 2;
                const int s1 = (int)atomicAdd(ctl + CW_CNT + 64 * ex1, 1u); LIST[(size_t)ex1 * NTOK + s1] = tok * 2 + 1;
                GATE[tok * 2] = g0; GATE[tok * 2 + 1] = g1;
            }
        }
    }
}

template <int WHICH>
__device__ __forceinline__ void phase_moe(const Params& p, char* lds) {
    unsigned char* ws = p.ws; const int tid = threadIdx.x, wave = __builtin_amdgcn_readfirstlane(tid >> 6), half = wave >> 2, tid4 = tid & 255, wid4 = wave & 3;
    const unsigned* ctl = (const unsigned*)(ws + WS_CTL); const int* LIST = (const int*)(ws + WS_LIST); const float* GATE = (const float*)(ws + WS_GATE);
    const bf16_t* U2 = (const bf16_t*)(ws + WS_U); bf16_t* HID = (bf16_t*)(ws + WS_HID); bf16_t* MO = (bf16_t*)(ws + WS_MO);
    const bf16_t* W13 = (const bf16_t*)(ws + WS_W13); const bf16_t* W2 = (const bf16_t*)(ws + WS_W2);
    constexpr int KK = WHICH == 0 ? 1024 : 512, ntn = 8;
    char* ldsh = lds + half * MLFast::LDS_BYTES;
    int* TP = (int*)(lds + 2 * MLFast::LDS_BYTES);
    __syncthreads();
    if (tid == 0) { int tp = 0, ro = 0; for (int e = 0; e < NEXP; ++e) { const int c = (int)ctl[CW_CNT + 64 * e]; TP[e] = tp; TP[64 + e] = ro; TP[128 + e] = c; tp += ((c + 127) / 128) * ntn; ro += (c + 127) / 128 * 128; } TP[NEXP] = tp; }
    __syncthreads();
    const int total = TP[NEXP], nvb = gridDim.x * 2, vb = blockIdx.x * 2 + half;
    for (int base = 0; base < total; base += nvb) {
        const bool act = base + vb < total; const int tile = act ? base + vb : 0;
        int e = 0;
#pragma unroll 1
        for (int j = 16; j >= 1; j >>= 1) if (TP[e + j] <= tile) e += j;
        const int cnt_e = TP[128 + e], rowoff = TP[64 + e];
        const int lt = tile - TP[e], mt = lt / ntn, n0 = (lt % ntn) * 128, s0 = mt * 128;
        const bf16_t* ap[2]; const bf16_t* bp[2]; const int lr = tid4 >> 2, lc = (tid4 & 3) * 8;
#pragma unroll
        for (int i = 0; i < 2; ++i) {
            const int s = s0 + lr + 64 * i;
            if (WHICH == 0) { const int tok = s < cnt_e ? (LIST[(size_t)e * NTOK + s] >> 1) : 0; ap[i] = U2 + (size_t)tok * D + lc; bp[i] = W13 + ((size_t)e * 1024 + n0 + lr + 64 * i) * 1024 + lc; }
            else { ap[i] = HID + (size_t)(rowoff + s) * DEXP + lc; bp[i] = W2 + ((size_t)e * 1024 + n0 + lr + 64 * i) * 512 + lc; }
        }
        f32x4 acc[16];
        MLFast::run(ldsh, tid4, wid4, ap, bp, KK, acc);
        if (act) {
#pragma unroll
            for (int f = 0; f < 16; ++f) {
                int r, c; MLFast::pos(tid4, f, r, c); const int s = s0 + r; const f32x4 v = acc[f];
                if (WHICH == 0) {
                    const float h0 = v.x / (1.f + __expf(-v.x)) * v.y, h1 = v.z / (1.f + __expf(-v.z)) * v.w;
                    *(unsigned*)(HID + (size_t)(rowoff + s) * DEXP + ((n0 + c) >> 1)) = pk2(h0, h1);
                } else if (s < cnt_e) {
                    const int ent = LIST[(size_t)e * NTOK + s]; const float gt = GATE[ent];
                    u32x2 w; w.x = pk2(v.x * gt, v.y * gt); w.y = pk2(v.z * gt, v.w * gt);
                    *(u32x2*)(MO + (size_t)ent * D + n0 + c) = w;
                }
            }
        }
    }
}

__device__ __forceinline__ void phase_final(const Params& p) {
    unsigned char* ws = p.ws; const int tid = threadIdx.x, lane = tid & 63, wave = tid >> 6;
    const float* H1 = (const float*)(ws + WS_H1); const bf16_t* MO = (const bf16_t*)(ws + WS_MO); const float* g = p.in[I_GFIN];
    const int gw = blockIdx.x * NWAVES + wave, NGW = gridDim.x * NWAVES;
    for (int orow = gw; orow < BATCH * SEQ; orow += NGW) {
        const int b = orow / SEQ, s = orow - b * SEQ; const size_t row = (size_t)b * T + NMETA + s;
        const f32x4* xr = (const f32x4*)(H1 + row * D) + lane; const u32x2* m0 = (const u32x2*)(MO + row * 2 * D) + lane; const u32x2* m1 = m0 + 256;
        f32x4 v[4]; float ss = 0.f;
#pragma unroll
        for (int j = 0; j < 4; ++j) { const u32x2 a = m0[64 * j], c = m1[64 * j]; v[j] = xr[64 * j];
            v[j].x += bflo(a.x) + bflo(c.x); v[j].y += bfhi(a.x) + bfhi(c.x); v[j].z += bflo(a.y) + bflo(c.y); v[j].w += bfhi(a.y) + bfhi(c.y);
            ss += (v[j].x * v[j].x + v[j].y * v[j].y) + (v[j].z * v[j].z + v[j].w * v[j].w); }
        const float rstd = rsqrtf(wave_sum(ss) * (1.f / D) + NORM_EPS);
        f32x4* o = (f32x4*)(p.out + (size_t)orow * D) + lane;
#pragma unroll
        for (int j = 0; j < 4; ++j) { const f32x4 gg = ((const f32x4*)g)[lane + 64 * j]; o[64 * j] = v[j] * rstd * gg; }
    }
}

#define XB_TMO      128
#define XB_XCNT(j)  (256  + 64 * (j))
#define XB_XSUB(j)  (1280 + 64 * (j))
#define XB_XGEN(j)  (2304 + 64 * (j))
#define XB_TOP      3328
#define XB_TOPGEN   3392
#define XCD_BAR_WORDS 3456
#define XB_SPIN_CAP (1u << 18)
__device__ __forceinline__ unsigned xb_ld(unsigned* p)              { return __hip_atomic_load(p, __ATOMIC_RELAXED, __HIP_MEMORY_SCOPE_AGENT); }
__device__ __forceinline__ unsigned xb_add(unsigned* p, unsigned v) { return __hip_atomic_fetch_add(p, v, __ATOMIC_RELAXED, __HIP_MEMORY_SCOPE_AGENT); }
__device__ __forceinline__ unsigned xb_xcc_id() { return (unsigned)__builtin_amdgcn_s_getreg((3 << 11) | 20) & 0xFu; }
#define XB_SPIN(cond, bar) do { unsigned _sp = 0; while (cond) { __builtin_amdgcn_s_sleep(1); \
    if ((++_sp & 255u) == 0u) { if (xb_ld(&(bar)[XB_TMO])) break; if (_sp > XB_SPIN_CAP) { atomicAdd(&(bar)[XB_TMO], 1u); break; } } } } while (0)
struct XcdBarrier { unsigned* bar; unsigned x; volatile LAS unsigned* st; };
__device__ __forceinline__ XcdBarrier xcd_barrier_post(unsigned* bar, volatile LAS unsigned* st) {
    XcdBarrier b; b.bar = bar; b.x = xb_xcc_id(); b.st = st;
    if (threadIdx.x == 0) (void)xb_add(&bar[XB_XCNT(b.x)], 1u);
    return b;
}
__device__ __forceinline__ void xcd_barrier_complete(unsigned* bar, unsigned x, unsigned& nloc, unsigned& nx) {
    const unsigned G = gridDim.x * gridDim.y * gridDim.z;
    unsigned sum, cnt, mine, sp = 0u;
    for (;;) {
        sum = 0u; cnt = 0u; mine = 0u;
#pragma unroll
        for (unsigned j = 0; j < 16; ++j) { const unsigned c = xb_ld(&bar[XB_XCNT(j)]); sum += c; cnt += (c > 0u) ? 1u : 0u; mine = (j == x) ? c : mine; }
        if (sum == G) break;
        __builtin_amdgcn_s_sleep(1);
        if ((++sp & 255u) == 0u) { if (xb_ld(&bar[XB_TMO])) break; if (sp > XB_SPIN_CAP) { atomicAdd(&bar[XB_TMO], 1u); break; } }
    }
    nloc = mine > 0u ? mine : 1u; nx = cnt > 0u ? cnt : 1u;
}
__device__ __forceinline__ void xcd_barrier(const XcdBarrier& b) {
    asm volatile("s_waitcnt vmcnt(0)" ::: "memory");
    __syncthreads();
    if (threadIdx.x == 0) {
        unsigned* bar = b.bar;
        __builtin_amdgcn_s_waitcnt(0);
        unsigned nloc = b.st[0], nx = b.st[1];
        if (nloc == 0u) { xcd_barrier_complete(bar, b.x, nloc, nx); b.st[0] = nloc; b.st[1] = nx; }
        const unsigned old = xb_add(&bar[XB_XSUB(b.x)], 1u);
        const unsigned gen = old / nloc;
        if (old + 1u == (gen + 1u) * nloc) {
            __builtin_amdgcn_fence(__ATOMIC_RELEASE, "agent");
            asm volatile("s_waitcnt vmcnt(0)" ::: "memory");
            const unsigned og = xb_add(&bar[XB_TOP], 1u);
            const unsigned tg = og / nx;
            if (og + 1u == (tg + 1u) * nx) xb_add(&bar[XB_TOPGEN], 1u);
            else XB_SPIN(xb_ld(&bar[XB_TOPGEN]) == tg, bar);
            __builtin_amdgcn_fence(__ATOMIC_ACQUIRE, "agent");
            xb_add(&bar[XB_XGEN(b.x)], 1u);
            asm volatile("s_waitcnt vmcnt(0)" ::: "memory");
        } else {
            XB_SPIN(xb_ld(&bar[XB_XGEN(b.x)]) == gen, bar);
            __builtin_amdgcn_fence(__ATOMIC_ACQUIRE, "agent");
            asm volatile("s_waitcnt vmcnt(0)" ::: "memory");
        }
    }
    __syncthreads();
}

constexpr int LDS_XB = DSA_LDS;
constexpr int LDS_BYTES = DSA_LDS + 256;
static_assert(pg8::STAGE_BYTES <= LDS_XB && 2 * MLFast::LDS_BYTES + 1024 <= LDS_XB && NWAVES * 64 * 33 * 4 <= LDS_XB && NWAVES * 64 * SB_VT_STRIDE * 2 <= LDS_XB && 4 * 37 * 128 * 4 <= LDS_XB, "LDS map");

__global__ void __launch_bounds__(NTHREADS, 2) mega(Params p) {
    extern __shared__ __attribute__((aligned(16))) char lds[];
    const int lo = p.ph_lo, hi = p.ph_hi;
    unsigned char* ws = p.ws;
    XcdBarrier xb;
    {
        volatile LAS unsigned* st = (volatile LAS unsigned*)(lds + LDS_XB);
        if (threadIdx.x < 4) st[threadIdx.x] = 0u;
        __syncthreads();
        xb = xcd_barrier_post((unsigned*)(ws + WS_CTL) + CW_BAR, st);
    }
#define IN(k) (lo <= (k) && (k) < hi)
#define GSYNC() xcd_barrier(xb)
#define SEAM(k) do { if (IN(k) && IN((k) + 1)) GSYNC(); } while (0)
#define REP(k, ...) do { if (IN(k)) { __VA_ARGS__; if (PROBE_PH == (k)) { GSYNC(); __VA_ARGS__; } } } while (0)
    LAS unsigned char* ldsl = (LAS unsigned char*)lds;
    REP(0, phase_prologue(p, lds));
    SEAM(0);
    REP(1, { pg8::Gemm g{(const bf16_t*)(ws + WS_U), (const bf16_t*)(ws + WS_WP), MROWS, PWN, D}; pg8::StaticOrder S; S.init(MROWS, PWN, gridDim.x, blockIdx.x);
             pg8::EpiInproj E{(bf16_t*)(ws + WS_P), (const float2*)(ws + WS_CS)}; pg8::gemm_phase<pg8::EpiInproj, pg8::StaticOrder, true, true>(ldsl, g, S, E); });
    SEAM(1);
    if (IN(2)) {
        phase_dsa(p, lds);
        if (PROBE_PH == 20) { GSYNC(); phase_dsa(p, lds); }
        __syncthreads(); phase_sb_fast(p, lds);
        if (PROBE_PH == 21) { GSYNC(); phase_sb_fast(p, lds); }
    }
    SEAM(2);
    REP(3, { pg8::Gemm g{(const bf16_t*)(ws + WS_U), (const bf16_t*)(ws + WS_WG), MROWS, 2048, D}; pg8::StaticOrder S; S.init(MROWS, 2048, gridDim.x, blockIdx.x);
             pg8::EpiGate E{(bf16_t*)(ws + WS_G)}; pg8::gemm_phase<pg8::EpiGate, pg8::StaticOrder, true, true>(ldsl, g, S, E); });
    SEAM(3);
    REP(4, { { pg8::Gemm g{(const bf16_t*)(ws + WS_YA), (const bf16_t*)(ws + WS_WUA), MROWS, D, 512}; pg8::StaticOrder S; S.init(MROWS, D, gridDim.x, blockIdx.x);
               pg8::EpiZ<false> E{(bf16_t*)(ws + WS_Z), (const bf16_t*)(ws + WS_G), 0}; pg8::gemm_phase<pg8::EpiZ<false>, pg8::StaticOrder, true, true>(ldsl, g, S, E); }
             asm volatile("s_waitcnt vmcnt(0)" ::: "memory"); __syncthreads();
             { pg8::Gemm g{(const bf16_t*)(ws + WS_OLAT), (const bf16_t*)(ws + WS_WBP), MROWS, D, D}; pg8::StaticOrder S; S.init(MROWS, D, gridDim.x, blockIdx.x);
               pg8::EpiZ<true> E{(bf16_t*)(ws + WS_Z), (const bf16_t*)(ws + WS_G), 1024}; pg8::gemm_phase<pg8::EpiZ<true>, pg8::StaticOrder, true, true>(ldsl, g, S, E); } });
    SEAM(4);
    REP(5, { pg8::Gemm g{(const bf16_t*)(ws + WS_Z), (const bf16_t*)(ws + WS_WO), MROWS, D, D}; pg8::StaticOrder S; S.init(MROWS, D, gridDim.x, blockIdx.x);
             pg8::EpiH1 E{(float*)(ws + WS_H1), p.in[I_META], p.in[I_X]}; pg8::gemm_phase<pg8::EpiH1, pg8::StaticOrder, true, true>(ldsl, g, S, E); });
    SEAM(5);
    if (IN(6)) phase_c3(p, lds);
    SEAM(6);
    REP(7, phase_moe<0>(p, lds));
    SEAM(7);
    REP(8, phase_moe<1>(p, lds));
    SEAM(8);
    REP(9, phase_final(p));
}

extern "C" void kernel_launch(void* const* d_in, const int* in_sizes, int n_in, void* d_out, int out_size, void* d_ws, size_t ws_size, hipStream_t stream) {
    if (n_in != 18 || ws_size < WS_END) { fprintf(stderr, "kernel_launch: unexpected n_in %d / ws_size %zu\n", n_in, ws_size); return; }
    static int grid = 0;
    if (grid == 0) {
        int dev = 0, cus = 0, per_cu = 0;
        (void)hipGetDevice(&dev);
        (void)hipDeviceGetAttribute(&cus, hipDeviceAttributeMultiprocessorCount, dev);
        (void)hipFuncSetAttribute((const void*)mega, hipFuncAttributeMaxDynamicSharedMemorySize, LDS_BYTES);
        (void)hipOccupancyMaxActiveBlocksPerMultiprocessor(&per_cu, (const void*)mega, NTHREADS, LDS_BYTES);
        if (per_cu < 1) fprintf(stderr, "kernel_launch: occupancy query reports %d workgroups per CU\n", per_cu);
        grid = cus;
    }
    (void)hipMemsetAsync((char*)d_ws + WS_CTL, 0, CTL_BYTES, stream);
    Params p{};
    for (int i = 0; i < 18; ++i) p.in[i] = (const float*)d_in[i];
    p.out = (float*)d_out; p.ws = (unsigned char*)d_ws;
    p.ph_lo = 0; p.ph_hi = 10;
    void* args[] = {&p};
    hipError_t e = hipLaunchCooperativeKernel((const void*)mega, dim3(grid), dim3(NTHREADS), args, LDS_BYTES, stream);
    if (e != hipSuccess) fprintf(stderr, "cooperative launch failed: %s (grid %d)\n", hipGetErrorString(e), grid);
}
```

```cpp
#include <hip/hip_runtime.h>
#include <cstdio>
#include <cstdint>
#ifndef PROBE_PH
#define PROBE_PH -1
#endif

constexpr int BATCH = 8, SEQ = 4096, NMETA = 16, T = SEQ + NMETA, D = 1024, NTOK = BATCH * T;
constexpr int MROWS = 33024;
constexpr int INW = 4824;
constexpr int NEXP = 32, DEXP = 512;
constexpr int NWAVES = 8, NTHREADS = 512;
constexpr float NORM_EPS = 1e-6f;
constexpr float LOG2E = 1.4426950408889634f;
constexpr float QSCALE = 0.125f * LOG2E;
constexpr int PW = 3456, PWN = 3584;
constexpr int C_QA = 0, C_KA = 512, C_VA = 1024, C_QF = 1536, C_KV = 2688, C_QI = 2832, C_KI = 3344, C_WI = 3408, C_END = 3416;
constexpr int QFW = 144;

constexpr size_t MiB = 1u << 20;
constexpr size_t WS_CTL = 0, CTL_BYTES = 1 * MiB;
constexpr size_t WS_CS = 1 * MiB;
constexpr size_t WS_WP = 2 * MiB;
constexpr size_t WS_WG = 9 * MiB;
constexpr size_t WS_WUA = 13 * MiB, WS_WBP = 14 * MiB, WS_WO = 16 * MiB;
constexpr size_t WS_W2 = 18 * MiB;
constexpr size_t WS_W13 = 50 * MiB;
constexpr size_t WS_U = 114 * MiB;
constexpr size_t WS_P = 179 * MiB;
constexpr size_t WS_Z = 179 * MiB;
constexpr size_t WS_G = 244 * MiB;
constexpr size_t WS_H1 = 244 * MiB;
constexpr size_t WS_LIST = 374 * MiB;
constexpr size_t WS_GATE = 379 * MiB;
constexpr size_t WS_YA = 397 * MiB;
constexpr size_t WS_OLAT = 430 * MiB;
constexpr size_t WS_HID = 397 * MiB;
constexpr size_t WS_MO = 50 * MiB;
constexpr size_t WS_END = 495 * MiB;
static_assert(WS_P + (size_t)MROWS * PW * 2 <= WS_YA && WS_G + (size_t)MROWS * 2048 * 2 <= WS_LIST && WS_Z + (size_t)MROWS * 1024 * 2 <= WS_G, "ws map");
static_assert(WS_OLAT + (size_t)MROWS * 1024 * 2 <= WS_END && WS_U + (size_t)MROWS * 1024 * 2 <= WS_P && WS_MO + (size_t)NTOK * 2048 * 2 <= WS_P, "ws map");
constexpr int CW_CNT = 1024;
constexpr int CW_BAR = 4096;

typedef unsigned short bf16_t;
typedef short bf16x8 __attribute__((ext_vector_type(8)));
typedef float f32x4 __attribute__((ext_vector_type(4)));
typedef float f32x16 __attribute__((ext_vector_type(16)));
typedef unsigned u32x2 __attribute__((ext_vector_type(2)));
typedef unsigned u32x4 __attribute__((ext_vector_type(4)));
typedef unsigned short u16x4 __attribute__((ext_vector_type(4)));
#define LAS __attribute__((address_space(3)))

__device__ __forceinline__ unsigned f2bf(float f) { unsigned u = __float_as_uint(f); return (u + 0x7fffu + ((u >> 16) & 1u)) >> 16; }
__device__ __forceinline__ unsigned pk2(float lo, float hi) { return f2bf(lo) | (f2bf(hi) << 16); }
__device__ __forceinline__ float bflo(unsigned w) { return __uint_as_float(w << 16); }
__device__ __forceinline__ float bfhi(unsigned w) { return __uint_as_float(w & 0xffff0000u); }
__device__ __forceinline__ float bf2f(bf16_t b) { return __uint_as_float((unsigned)b << 16); }
__device__ __forceinline__ float wave_sum(float v) {
#pragma unroll
    for (int o = 1; o < 64; o <<= 1) v += __shfl_xor(v, o);
    return v;
}
__device__ __forceinline__ float sigmoidf(float x) { return 1.0f / (1.0f + __expf(-x)); }

struct Params {
    const float* in[18];
    float* out;
    unsigned char* ws;
    int ph_lo, ph_hi;
};
enum { I_X = 0, I_META, I_GMIX, I_WIN, I_WUK, I_WUV, I_WUPA, I_WUPB, I_WO, I_GFFN, I_WGRP, I_BGRP, I_WRT, I_BRT, I_W1, I_W3, I_W2, I_GFIN };

__device__ __forceinline__ const float* h0_row(const Params& p, int row) {
    const int b = row / T, t = row - b * T;
    return t < NMETA ? p.in[I_META] + (size_t)t * D : p.in[I_X] + ((size_t)b * SEQ + (t - NMETA)) * D;
}
template <class F>
__device__ __forceinline__ void tr_item(F val, bf16_t* dst, int ldd, int row0, int k0, float* scr, int lane, int rstep = 1) {
    float tv[32];
#pragma unroll
    for (int i = 0; i < 32; ++i) tv[i] = val(k0 + 2 * i + (lane >> 5), lane & 31);
#pragma unroll
    for (int i = 0; i < 32; ++i) scr[(2 * i + (lane >> 5)) * 33 + (lane & 31)] = tv[i];
    __builtin_amdgcn_s_waitcnt(0xC07F);
    asm volatile("" ::: "memory");
    const int c = lane & 7;
#pragma unroll
    for (int j = 0; j < 4; ++j) {
        const int n = (lane >> 3) + 8 * j; const float* s = scr + (8 * c) * 33 + n;
        u32x4 o; o.x = pk2(s[0], s[33]); o.y = pk2(s[66], s[99]); o.z = pk2(s[132], s[165]); o.w = pk2(s[198], s[231]);
        *(u32x4*)(dst + (size_t)(row0 + n * rstep) * ldd + k0 + 8 * c) = o;
    }
    __builtin_amdgcn_s_waitcnt(0xC07F);
    asm volatile("" ::: "memory");
}

__device__ __forceinline__ void wp_src(int c, int& kind, int& col, int& aux, float& scale) {
    kind = 1; aux = 0; scale = 1.f; col = 0;
    if (c < 512) { col = c; scale = QSCALE; }
    else if (c < C_QF) { col = c; }
    else if (c < C_KV) { const int r = c - C_QF, h = r / QFW, j = r % QFW; scale = QSCALE;
        if (j < 128) { kind = 2; col = h; aux = j; } else { const int i = j - 128; col = 1536 + 64 * h + (i >> 1) + 8 * (i & 1); } }
    else if (c < C_QI) { const int j = c - C_KV; if (j < 128) col = 2048 + j; else { const int i = j - 128; col = 2176 + (i >> 1) + 8 * (i & 1); } }
    else if (c < C_KI) { const int r = c - C_QI, h = r >> 6, j = r & 63; col = 2192 + 64 * h + (j < 16 ? (j >> 1) + 8 * (j & 1) : j); }
    else if (c < C_WI) { const int j = c - C_KI; col = 2704 + (j < 16 ? (j >> 1) + 8 * (j & 1) : j); }
    else if (c < C_END) { col = 2768 + (c - C_WI); }
    else kind = 0;
}

constexpr int IT_WP = (PWN / 32) * 16;
constexpr int IT_WG = 32 * 16;
constexpr int IT_WUA = 32 * 8;
constexpr int IT_WBP = 32 * 16, IT_WO = 32 * 16;
constexpr int IT_W13 = NEXP * 32 * 16;
constexpr int IT_W2 = NEXP * 32 * 8;
constexpr int IT_TOTAL = IT_WP + 2 * IT_WG + IT_WUA + IT_WBP + IT_WO + IT_W13 + IT_W2;

__device__ __forceinline__ void phase_prologue(const Params& p, char* lds) {
    const int tid = threadIdx.x, lane = tid & 63, wave = tid >> 6;
    const int gw = blockIdx.x * NWAVES + wave, NGW = gridDim.x * NWAVES;
    float* scr = (float*)lds + wave * (64 * 33);
    unsigned char* ws = p.ws;
    const float* w_in = p.in[I_WIN];
    {
        float2* cs = (float2*)(ws + WS_CS);
        for (int i = blockIdx.x * NTHREADS + tid; i < T * 8; i += gridDim.x * NTHREADS) {
            const int pos = i >> 3, f = i & 7;
            const float inv = powf(500000.0f, -(float)f / 8.0f);
            const float ang = (float)pos * inv;
            cs[i] = make_float2(cosf(ang), sinf(ang));
        }
    }
    for (int it = gw; it < IT_TOTAL; it += NGW) {
        int r = it;
        if (r < IT_WP) {
            const int rg = r / 16, kb = r % 16, c = rg * 32 + (lane & 31);
            int kind, col, aux; float scale; wp_src(c, kind, col, aux, scale);
            const float* w_uk = p.in[I_WUK];
            float wu[48];
#pragma unroll
            for (int n4 = 0; n4 < 12; ++n4) { f32x4 t = (f32x4){0.f, 0.f, 0.f, 0.f}; if (kind == 2) t = *(const f32x4*)(w_uk + ((size_t)col * 128 + aux) * 48 + 4 * n4); wu[4 * n4] = t.x; wu[4 * n4 + 1] = t.y; wu[4 * n4 + 2] = t.z; wu[4 * n4 + 3] = t.w; }
            tr_item([&](int k, int) -> float {
                if (kind == 0) return 0.f;
                if (kind == 1) return scale * w_in[(size_t)k * INW + col];
                const f32x4* wi = (const f32x4*)(w_in + (size_t)k * INW + 1536 + 64 * col + 16);
                float s = 0.f;
#pragma unroll
                for (int n4 = 0; n4 < 12; ++n4) { const f32x4 t = wi[n4]; s += t.x * wu[4 * n4] + t.y * wu[4 * n4 + 1] + t.z * wu[4 * n4 + 2] + t.w * wu[4 * n4 + 3]; }
                return scale * s; }, (bf16_t*)(ws + WS_WP), 1024, rg * 32, kb * 64, scr, lane);
            continue; }
        r -= IT_WP;
        if (r < 2 * IT_WG) {
            const int which = r / IT_WG; r %= IT_WG; const int rg = r / 16, kb = r % 16; const int col0 = (which ? 3800 : 2776) + rg * 32;
            tr_item([&](int k, int n) -> float { return w_in[(size_t)k * INW + col0 + n]; }, (bf16_t*)(ws + WS_WG) + (size_t)which * 1024 * 1024, 1024, rg * 32, kb * 64, scr, lane);
            continue; }
        r -= 2 * IT_WG;
        if (r < IT_WUA) {
            const int rg = r / 8, kb = r % 8; const float* w = p.in[I_WUPA];
            tr_item([&](int k, int n) -> float { return w[(size_t)k * 1024 + rg * 32 + n]; }, (bf16_t*)(ws + WS_WUA), 512, rg * 32, kb * 64, scr, lane);
            continue; }
        r -= IT_WUA;
        if (r < IT_WBP) {
            const int rg = r / 16, kb = r % 16; const float* wuv = p.in[I_WUV]; const float* wub = p.in[I_WUPB];
            const int hB = kb >> 1;
            float bc[64];
#pragma unroll
            for (int d = 0; d < 64; ++d) bc[d] = wub[(size_t)(64 * hB + d) * 1024 + rg * 32 + (lane & 31)];
            tr_item([&](int kk, int) -> float {
                const f32x4* a = (const f32x4*)(wuv + (size_t)kk * 64);
                float s = 0.f;
#pragma unroll
                for (int d4 = 0; d4 < 16; ++d4) { const f32x4 t = a[d4]; s += t.x * bc[4 * d4] + t.y * bc[4 * d4 + 1] + t.z * bc[4 * d4 + 2] + t.w * bc[4 * d4 + 3]; }
                return s; }, (bf16_t*)(ws + WS_WBP), 1024, rg * 32, kb * 64, scr, lane);
            continue; }
        r -= IT_WBP;
        if (r < IT_WO) {
            const int rg = r / 16, kb = r % 16; const float* w = p.in[I_WO];
            tr_item([&](int k, int n) -> float { return w[(size_t)k * 1024 + rg * 32 + n]; }, (bf16_t*)(ws + WS_WO), 1024, rg * 32, kb * 64, scr, lane);
            continue; }
        r -= IT_WO;
        if (r < IT_W13) {
            const int e = r / 512; r %= 512; const int which = r & 1, cg = (r >> 1) & 15, kb = r >> 5;
            const float* w = (which ? p.in[I_W3] : p.in[I_W1]) + (size_t)e * 1024 * 512 + cg * 32;
            tr_item([&](int k, int n) -> float { return w[(size_t)k * 512 + n]; },
                    (bf16_t*)(ws + WS_W13) + (size_t)e * 1024 * 1024, 1024, 2 * cg * 32 + which, kb * 64, scr, lane, 2);
            continue; }
        r -= IT_W13;
        {
            const int e = r / 256; r %= 256; const int rg = r / 8, kb = r % 8;
            const float* w2 = p.in[I_W2] + (size_t)e * 512 * 1024;
            tr_item([&](int k, int n) -> float { return w2[(size_t)k * 1024 + rg * 32 + n]; }, (bf16_t*)(ws + WS_W2) + (size_t)e * 1024 * 512, 512, rg * 32, kb * 64, scr, lane);
        }
    }
    {
        const float* g = p.in[I_GMIX]; bf16_t* U = (bf16_t*)(ws + WS_U);
        for (int row = gw; row < NTOK; row += NGW) {
            const f32x4* xr = (const f32x4*)h0_row(p, row) + lane;
            f32x4 v[4]; float s = 0.f;
#pragma unroll
            for (int j = 0; j < 4; ++j) { v[j] = xr[64 * j]; s += (v[j].x * v[j].x + v[j].y * v[j].y) + (v[j].z * v[j].z + v[j].w * v[j].w); }
            const float rstd = rsqrtf(wave_sum(s) * (1.f / D) + NORM_EPS);
            u32x2* o = (u32x2*)(U + (size_t)row * D) + lane;
#pragma unroll
            for (int j = 0; j < 4; ++j) { const f32x4 gg = ((const f32x4*)g)[lane + 64 * j];
                u32x2 w; w.x = pk2(v[j].x * rstd * gg.x, v[j].y * rstd * gg.y); w.y = pk2(v[j].z * rstd * gg.z, v[j].w * rstd * gg.w); o[64 * j] = w; }
        }
    }
}

namespace pg8 {
#define PG8_LAS __attribute__((address_space(3)))
typedef unsigned short bf16_t;
typedef short bf16x8 __attribute__((ext_vector_type(8)));
typedef float f32x4 __attribute__((ext_vector_type(4)));
typedef unsigned u32x4 __attribute__((ext_vector_type(4)));
constexpr int BM = 256, BK = 64, HALF = 128, HTB = HALF * BK * 2  , STAGE_BYTES = 8 * HTB, NXCD = 8, WGM = 8;

__host__ __device__ __forceinline__ int lds_byte(int r, int c) { const int st = (r >> 4) * 2 + (c >> 5), rr = r & 15, cc = c & 31, ob = rr * 64 + cc * 2; return st * 1024 + (ob ^ (((ob >> 9) & 1) << 5)); }
__host__ __device__ __forceinline__ void stage_rc(int b, int& R, int& C) { const int st = b / 1024, sb = b % 1024, swz = sb ^ (((sb >> 9) & 1) << 5); R = (st >> 1) * 16 + swz / 64; C = (st & 1) * 32 + (swz % 64) / 2; }
__host__ __device__ __forceinline__ int perm32(int rho) { const int n = rho >> 4, i = rho & 15; return 8 * (i >> 2) + 4 * n + (i & 3); }

struct Unit { int pm, pn; };
struct Gemm { const bf16_t* A; const bf16_t* Bt; int M, N, K; };

struct StaticOrder {
    int nM, nN, nwg, G, c;
    __host__ __device__ void init(int M, int N, int G_, int c_) { nM = M / BM; nN = N / BM; nwg = nM * nN; G = G_; c = c_; }
    __host__ __device__ bool next(int i, Unit& u) const {
        const long L = (long)i * G + c; if (L >= nwg) return false;
        int wgid = (int)L; { const int q = nwg / NXCD, r = nwg % NXCD, xcd = wgid % NXCD, off = wgid / NXCD; wgid = (xcd < r ? xcd * (q + 1) : r * (q + 1) + (xcd - r) * q) + off; }
        const int nig = WGM * nN, gid = wgid / nig, fm = gid * WGM, gsz = (nM - fm) < WGM ? (nM - fm) : WGM;
        u.pm = fm + ((wgid % nig) % gsz); u.pn = (wgid % nig) / gsz; return true;
    }
    __device__ __forceinline__ void a_ready(const Unit&) const {}
    __device__ __forceinline__ void done(const Unit&) const {}
};


#define PG8_FOR_FRAGS(...) _Pragma("unroll") for (int ai = 0; ai < 2; ++ai) _Pragma("unroll") for (int m = 0; m < 4; ++m) { const int row = u.pm * BM + ai * HALF + wr * 64 + m * 16 + fr; \
    _Pragma("unroll") for (int bj = 0; bj < 2; ++bj) _Pragma("unroll") for (int n = 0; n < 2; ++n) { const int col = u.pn * BM + bj * HALF + wc * 32 + n * 16 + 4 * fq; ::f32x4 v = acc[ai][bj][m][n]; __VA_ARGS__ } }
__device__ __forceinline__ bool rope_off(int c, int& o) {
    if (c < C_QF) return false;
    if (c < C_KV) { const int j = (c - C_QF) % QFW; o = j - 128; return j >= 128; }
    if (c < C_QI) { const int j = c - C_KV; o = j - 128; return j >= 128; }
    if (c < C_KI) { const int j = (c - C_QI) & 63; o = j; return j < 16; }
    if (c < C_WI) { const int j = c - C_KI; o = j; return j < 16; }
    return false;
}
struct EpiInproj {
    static constexpr bool PERM = false, AFTER_DRAIN = false;
    bf16_t* P; const float2* cs;
    __device__ __forceinline__ void operator()(const f32x4 (&acc)[2][2][4][2], const Unit& u, int wr, int wc, int fr, int fq) const {
        PG8_FOR_FRAGS(
            if (col < PW) {
                int o;
                if (rope_off(col, o)) {
                    const int pos = row % T; const float2 c0 = cs[pos * 8 + (o >> 1)], c1 = cs[pos * 8 + (o >> 1) + 1];
                    v = (::f32x4){v.x * c0.x - v.y * c0.y, v.y * c0.x + v.x * c0.y, v.z * c1.x - v.w * c1.y, v.w * c1.x + v.z * c1.y};
                }
                ::u32x2 w; w.x = pk2(v.x, v.y); w.y = pk2(v.z, v.w);
                *(::u32x2*)(P + (size_t)row * PW + col) = w;
            })
    }
};
struct EpiGate {
    static constexpr bool PERM = false, AFTER_DRAIN = false;
    bf16_t* G;
    __device__ __forceinline__ void operator()(const f32x4 (&acc)[2][2][4][2], const Unit& u, int wr, int wc, int fr, int fq) const {
        PG8_FOR_FRAGS( ::u32x2 w; w.x = pk2(sigmoidf(v.x), sigmoidf(v.y)); w.y = pk2(sigmoidf(v.z), sigmoidf(v.w)); *(::u32x2*)(G + (size_t)row * 2048 + col) = w; )
    }
};
template <bool ACCUM> struct EpiZ {
    static constexpr bool PERM = false, AFTER_DRAIN = false;
    bf16_t* Z; const bf16_t* G; int goff;
    __device__ __forceinline__ void operator()(const f32x4 (&acc)[2][2][4][2], const Unit& u, int wr, int wc, int fr, int fq) const {
        PG8_FOR_FRAGS(
            const ::u32x2 g = *(const ::u32x2*)(G + (size_t)row * 2048 + goff + col);
            ::f32x4 z = (::f32x4){bflo(g.x) * v.x, bfhi(g.x) * v.y, bflo(g.y) * v.z, bfhi(g.y) * v.w};
            ::u32x2* zp = (::u32x2*)(Z + (size_t)row * D + col);
            if (ACCUM) { const ::u32x2 o = *zp; z.x += bflo(o.x); z.y += bfhi(o.x); z.z += bflo(o.y); z.w += bfhi(o.y); }
            ::u32x2 w; w.x = pk2(z.x, z.y); w.y = pk2(z.z, z.w); *zp = w; )
    }
};
struct EpiH1 {
    static constexpr bool PERM = false, AFTER_DRAIN = false;
    float* H1; const float* meta; const float* x;
    __device__ __forceinline__ void operator()(const f32x4 (&acc)[2][2][4][2], const Unit& u, int wr, int wc, int fr, int fq) const {
        PG8_FOR_FRAGS( if (row < NTOK) { const int b = row / T, t = row - b * T; const float* hr = t < NMETA ? meta + (size_t)t * D : x + ((size_t)b * SEQ + (t - NMETA)) * D;
            const ::f32x4 h = *(const ::f32x4*)(hr + col); *(::f32x4*)(H1 + (size_t)row * D + col) = h + v; } )
    }
};
#undef PG8_FOR_FRAGS

template <class Epi, class Sched, bool ALIGN_EPI = false, bool SP2 = false>
__device__ __forceinline__ void gemm_phase(PG8_LAS unsigned char* lds, const Gemm g, const Sched& S, const Epi& E) {
    const int tid = threadIdx.x, wid = __builtin_amdgcn_readfirstlane(tid >> 6), lane = tid & 63, wr = wid >> 2, wc = wid & 3, fr = lane & 15, fq = lane >> 4;
    const int K = g.K, nt = K / BK;
    unsigned voffA[2], voffB[2];
#pragma unroll
    for (int i = 0; i < 2; ++i) { int R, C; stage_rc(tid * 16 + i * 8192, R, C); const int Rb = Epi::PERM ? ((R & ~31) + perm32(R & 31)) : R;
        voffA[i] = (unsigned)(R * K + C) * 2u; voffB[i] = (unsigned)(Rb * K + C) * 2u; }
    const size_t kstep = (size_t)(BK * 2);
    const size_t hstep = (size_t)HALF * K * 2;
    const size_t tstep = 2 * hstep;
    const unsigned ldsw = (unsigned)wid * 1024u;
    const int aoff = lds_byte(wr * 64 + fr, fq * 8), boff = lds_byte(wc * 32 + fr, fq * 8);
#define PG8_SA(b, h) (((b) * 2 + (h)) * HTB)
#define PG8_SB(b, h) ((4 + (b) * 2 + (h)) * HTB)
#define PG8_STAGE(bufoff, gbase, voff) do { _Pragma("unroll") for (int _i = 0; _i < 2; ++_i) \
        __builtin_amdgcn_global_load_lds((const unsigned*)((const char*)(gbase) + (voff)[_i]), (PG8_LAS unsigned*)(lds + (bufoff) + ldsw + _i * 8192), 16, 0, 0); } while (0)
#define PG8_LDA(dst, b, h) do { _Pragma("unroll") for (int m = 0; m < 4; ++m) _Pragma("unroll") for (int k = 0; k < 2; ++k) dst[m][k] = *(const PG8_LAS bf16x8*)(lds + PG8_SA(b, h) + aoff + m * 2048 + k * 1024); } while (0)
#define PG8_LDB(dst, b, h) do { _Pragma("unroll") for (int n = 0; n < 2; ++n) _Pragma("unroll") for (int k = 0; k < 2; ++k) dst[n][k] = *(const PG8_LAS bf16x8*)(lds + PG8_SB(b, h) + boff + n * 2048 + k * 1024); } while (0)
#define PG8_MMA(ai, bj, At, Bt) do { __builtin_amdgcn_s_setprio(1); _Pragma("unroll") for (int m = 0; m < 4; ++m) _Pragma("unroll") for (int n = 0; n < 2; ++n) _Pragma("unroll") for (int k = 0; k < 2; ++k) \
        acc[ai][bj][m][n] = __builtin_amdgcn_mfma_f32_16x16x32_bf16(Bt[n][k], At[m][k], acc[ai][bj][m][n], 0, 0, 0); __builtin_amdgcn_s_setprio(0); } while (0)
#define PG8_WAIT_V(n) asm volatile("s_waitcnt vmcnt(" #n ")" ::: "memory")
#define PG8_WAIT_L(n) asm volatile("s_waitcnt lgkmcnt(" #n ")" ::: "memory")
#define PG8_BAR __builtin_amdgcn_s_barrier()
#define PG8_SCHED __builtin_amdgcn_sched_barrier(0)
    Unit cur, nxt; int ui = 0;
    if (!S.next(0, cur)) return;
    f32x4 acc[2][2][4][2];
#pragma unroll
    for (int a = 0; a < 2; ++a)
#pragma unroll
        for (int b = 0; b < 2; ++b)
#pragma unroll
            for (int m = 0; m < 4; ++m)
#pragma unroll
                for (int n = 0; n < 2; ++n) acc[a][b][m][n] = (f32x4){0.f, 0.f, 0.f, 0.f};
    bf16x8 At[4][2], B0[2][2], B1[2][2];
    const char* cA = (const char*)g.A + (size_t)cur.pm * tstep; const char* cB = (const char*)g.Bt + (size_t)cur.pn * tstep;
    S.a_ready(cur);
    if constexpr (SP2) {
        PG8_STAGE(PG8_SB(0, 0), cB, voffB); PG8_STAGE(PG8_SB(0, 1), cB + hstep, voffB); PG8_STAGE(PG8_SA(0, 0), cA, voffA); PG8_STAGE(PG8_SA(0, 1), cA + hstep, voffA);
        if (wr == 1) PG8_BAR;
        PG8_WAIT_V(2); PG8_BAR;
        PG8_STAGE(PG8_SB(1, 0), cB + kstep, voffB); PG8_STAGE(PG8_SA(1, 0), cA + kstep, voffA); PG8_STAGE(PG8_SB(1, 1), cB + hstep + kstep, voffB);
        PG8_WAIT_V(6); PG8_BAR;
    } else {
        PG8_STAGE(PG8_SB(0, 0), cB, voffB); PG8_STAGE(PG8_SA(0, 0), cA, voffA); PG8_STAGE(PG8_SB(0, 1), cB + hstep, voffB); PG8_STAGE(PG8_SA(0, 1), cA + hstep, voffA);
        if (wr == 1) PG8_BAR;
        PG8_WAIT_V(4); PG8_BAR;
        PG8_STAGE(PG8_SB(1, 0), cB + kstep, voffB); PG8_STAGE(PG8_SA(1, 0), cA + kstep, voffA); PG8_STAGE(PG8_SB(1, 1), cB + hstep + kstep, voffB);
        PG8_WAIT_V(6); PG8_BAR;
    }
    for (;;) {
        const bool has_next = S.next(ui + 1, nxt);
        const char* nA = has_next ? (const char*)g.A + (size_t)nxt.pm * tstep : cA; const char* nB = has_next ? (const char*)g.Bt + (size_t)nxt.pn * tstep : cB;
        for (int t = 0; t < nt; t += 2) {
            const bool last = (t == nt - 2);
            const char* a1 = cA + (size_t)(t + 1) * kstep;
            const char* a2 = last ? nA : cA + (size_t)(t + 2) * kstep; const char* b2 = last ? nB : cB + (size_t)(t + 2) * kstep;
            const char* a3 = a2 + kstep; const char* b3 = b2 + kstep;
            if (last && has_next) S.a_ready(nxt);
            if constexpr (SP2) {
            PG8_LDB(B0, 0, 0); PG8_LDB(B1, 0, 1); PG8_SCHED; PG8_LDA(At, 0, 0); PG8_STAGE(PG8_SA(1, 1), a1 + hstep, voffA);
            PG8_WAIT_V(8); PG8_WAIT_L(0); PG8_BAR; PG8_MMA(0, 0, At, B0); PG8_MMA(0, 1, At, B1); PG8_BAR; PG8_SCHED;
            PG8_LDA(At, 0, 1); PG8_STAGE(PG8_SB(0, 0), b2, voffB); PG8_STAGE(PG8_SB(0, 1), b2 + hstep, voffB); PG8_STAGE(PG8_SA(0, 0), a2, voffA);
            PG8_WAIT_V(8); PG8_WAIT_L(0); PG8_BAR; PG8_MMA(1, 0, At, B0); PG8_MMA(1, 1, At, B1); PG8_BAR; PG8_SCHED;
            PG8_LDB(B0, 1, 0); PG8_LDB(B1, 1, 1); PG8_SCHED; PG8_LDA(At, 1, 0); PG8_STAGE(PG8_SA(0, 1), a2 + hstep, voffA);
            PG8_WAIT_V(8); PG8_WAIT_L(0); PG8_BAR; PG8_MMA(0, 0, At, B0); PG8_MMA(0, 1, At, B1); PG8_BAR; PG8_SCHED;
            PG8_LDA(At, 1, 1); PG8_STAGE(PG8_SB(1, 0), b3, voffB); PG8_STAGE(PG8_SB(1, 1), b3 + hstep, voffB); PG8_STAGE(PG8_SA(1, 0), a3, voffA);
            PG8_WAIT_V(8); PG8_WAIT_L(0); PG8_BAR; PG8_MMA(1, 0, At, B0); PG8_MMA(1, 1, At, B1); PG8_BAR; PG8_SCHED;
            } else {
            PG8_LDB(B0, 0, 0); PG8_SCHED; PG8_LDA(At, 0, 0); PG8_STAGE(PG8_SA(1, 1), a1 + hstep, voffA);
            PG8_WAIT_L(8); PG8_BAR; PG8_WAIT_L(0); PG8_MMA(0, 0, At, B0); PG8_BAR; PG8_SCHED;
            PG8_LDB(B1, 0, 1); PG8_STAGE(PG8_SB(0, 0), b2, voffB);
            PG8_BAR; PG8_WAIT_L(0); PG8_MMA(0, 1, At, B1); PG8_BAR;
            PG8_LDA(At, 0, 1); PG8_STAGE(PG8_SA(0, 0), a2, voffA);
            PG8_BAR; PG8_WAIT_L(0); PG8_MMA(1, 0, At, B0); PG8_BAR; PG8_SCHED;
            PG8_STAGE(PG8_SB(0, 1), b2 + hstep, voffB);
            PG8_WAIT_V(6); PG8_BAR; PG8_MMA(1, 1, At, B1); PG8_BAR;
            PG8_LDB(B0, 1, 0); PG8_SCHED; PG8_LDA(At, 1, 0); PG8_STAGE(PG8_SA(0, 1), a2 + hstep, voffA);
            PG8_WAIT_L(8); PG8_BAR; PG8_WAIT_L(0); PG8_MMA(0, 0, At, B0); PG8_BAR; PG8_SCHED;
            PG8_LDB(B1, 1, 1); PG8_STAGE(PG8_SB(1, 0), b3, voffB);
            PG8_BAR; PG8_WAIT_L(0); PG8_MMA(0, 1, At, B1); PG8_BAR;
            PG8_LDA(At, 1, 1); PG8_STAGE(PG8_SA(1, 0), a3, voffA);
            PG8_BAR; PG8_WAIT_L(0); PG8_MMA(1, 0, At, B0); PG8_BAR; PG8_SCHED;
            PG8_STAGE(PG8_SB(1, 1), b3 + hstep, voffB);
            PG8_WAIT_V(6); PG8_BAR; PG8_MMA(1, 1, At, B1); PG8_BAR;
            }
        }
        if constexpr (ALIGN_EPI) { if (wr == 0) PG8_BAR; }
        if constexpr (!Epi::AFTER_DRAIN) { E(acc, cur, wr, wc, fr, fq); S.done(cur); }
        if (!has_next) break;
#pragma unroll
        for (int a = 0; a < 2; ++a)
#pragma unroll
            for (int b = 0; b < 2; ++b)
#pragma unroll
                for (int m = 0; m < 4; ++m)
#pragma unroll
                    for (int n = 0; n < 2; ++n) acc[a][b][m][n] = (f32x4){0.f, 0.f, 0.f, 0.f};
        cur = nxt; cA = nA; cB = nB; ++ui;
        if constexpr (ALIGN_EPI) { if (wr == 1) PG8_BAR; }
    }
    PG8_WAIT_V(0);
    if constexpr (!ALIGN_EPI) { if (wr == 0) PG8_BAR; }
    PG8_BAR;
    if constexpr (Epi::AFTER_DRAIN) { E.fused(acc, cur, wr, wc, fr, fq, lds, wid, lane); S.done(cur); }
#undef PG8_SA
#undef PG8_SB
#undef PG8_STAGE
#undef PG8_LDA
#undef PG8_LDB
#undef PG8_MMA
#undef PG8_WAIT_V
#undef PG8_WAIT_L
#undef PG8_BAR
#undef PG8_SCHED
}
}
struct MLFast {
    static constexpr int TM = 128, TN = 128, NF = 16, NR = 2, STAGE = 16384, LDS_BYTES = 3 * STAGE;
    static __device__ __forceinline__ void pos(int tid, int f, int& r, int& c) {
        const int wid = tid >> 6, lane = tid & 63, wr = wid >> 1, wc = wid & 1, fr = lane & 15, fq = lane >> 4, m = f >> 2, n = f & 3;
        r = wr * 64 + m * 16 + fr; c = wc * 64 + n * 16 + 4 * fq; }
    static __device__ __forceinline__ void issue(char* buf, int wid, const bf16_t* const* ap, const bf16_t* const* bp, int k) {
#pragma unroll
        for (int i = 0; i < 2; ++i) {
            __builtin_amdgcn_global_load_lds((const unsigned*)(ap[i] + k), (LAS unsigned*)(buf + wid * 1024 + i * 4096), 16, 0, 0);
            __builtin_amdgcn_global_load_lds((const unsigned*)(bp[i] + k), (LAS unsigned*)(buf + 8192 + wid * 1024 + i * 4096), 16, 0, 0);
        }
    }
    static __device__ __forceinline__ void run(char* lds, int tid, int wid, const bf16_t* const* ap, const bf16_t* const* bp, int K, f32x4* acc) {
        const int lane = tid & 63, wr = wid >> 1, wc = wid & 1, fr = lane & 15, fq = lane >> 4;
#pragma unroll
        for (int f = 0; f < 16; ++f) acc[f] = (f32x4){0.f, 0.f, 0.f, 0.f};
        const int nk = K / 32;
        asm volatile("s_waitcnt vmcnt(0)" ::: "memory");
        issue(lds, wid, ap, bp, 0);
        issue(lds + STAGE, wid, ap, bp, 32);
        int cur = 0, nxt = 2;
        for (int kt = 0; kt < nk; ++kt) {
            if (kt + 1 < nk) asm volatile("s_waitcnt vmcnt(4)" ::: "memory"); else asm volatile("s_waitcnt vmcnt(0)" ::: "memory");
            asm volatile("s_waitcnt lgkmcnt(0)" ::: "memory");
            __builtin_amdgcn_s_barrier();
            asm volatile("" ::: "memory");
            if (kt + 2 < nk) issue(lds + nxt * STAGE, wid, ap, bp, (kt + 2) * 32);
            const char* SA = lds + cur * STAGE; const char* SB = SA + 8192;
            bf16x8 At[4], Bt[4];
#pragma unroll
            for (int m = 0; m < 4; ++m) { At[m] = *(const bf16x8*)(SA + (wr * 64 + m * 16 + fr) * 64 + fq * 16); Bt[m] = *(const bf16x8*)(SB + (wc * 64 + m * 16 + fr) * 64 + fq * 16); }
#pragma unroll
            for (int m = 0; m < 4; ++m)
#pragma unroll
                for (int n = 0; n < 4; ++n) acc[m * 4 + n] = __builtin_amdgcn_mfma_f32_16x16x32_bf16(Bt[n], At[m], acc[m * 4 + n], 0, 0, 0);
            cur = cur == 2 ? 0 : cur + 1; nxt = nxt == 2 ? 0 : nxt + 1;
        }
        asm volatile("s_waitcnt lgkmcnt(0)" ::: "memory");
        __builtin_amdgcn_s_barrier();
        asm volatile("" ::: "memory");
    }
};

constexpr int SB_NQT = (T + 31) / 32;
constexpr int SB_VT_STRIDE = 40;
__device__ __forceinline__ void phase_sb_fast(const Params& p, char* lds) {
    const bf16_t* P = (const bf16_t*)(p.ws + WS_P); bf16_t* YA = (bf16_t*)(p.ws + WS_YA);
    const int tid = threadIdx.x, lane = tid & 63, wave = tid >> 6, n = lane & 31, hh = lane >> 5;
    bf16_t* VT = (bf16_t*)(lds + wave * (64 * SB_VT_STRIDE * 2));
    const int gw = blockIdx.x * NWAVES + wave, NGW = gridDim.x * NWAVES;
    for (int unit = gw; unit < 64 * SB_NQT; unit += NGW) {
        const int qt = SB_NQT - 1 - unit / 64, bh = unit % 64, h = bh & 7, b = bh >> 3;
        const int i0 = qt * 32, qi = i0 + n, qrow = qi < T ? qi : T - 1;
        const bf16_t* Pb = P + (size_t)b * T * PW;
        bf16x8 qf[4];
#pragma unroll
        for (int s = 0; s < 4; ++s) qf[s] = *(const bf16x8*)(Pb + (size_t)qrow * PW + C_QA + h * 64 + 16 * s + 8 * hh);
        f32x16 o0, o1;
#pragma unroll
        for (int r = 0; r < 16; ++r) { o0[r] = 0.f; o1[r] = 0.f; }
        float L = 0.f;
        for (int kt = qt; kt >= 0; --kt) {
            const int j0 = kt * 32, krow = (j0 + n) < T ? (j0 + n) : T - 1;
            bf16x8 kf[4];
#pragma unroll
            for (int s = 0; s < 4; ++s) kf[s] = *(const bf16x8*)(Pb + (size_t)krow * PW + C_KA + h * 64 + 16 * s + 8 * hh);
#pragma unroll
            for (int i = 0; i < 4; ++i) {
                const int c = lane + 64 * i, key = c >> 3, d0 = (c & 7) * 8, vrow = (j0 + key) < T ? (j0 + key) : T - 1;
                const u32x4 w = *(const u32x4*)(Pb + (size_t)vrow * PW + C_VA + h * 64 + d0);
                bf16_t* vp = VT + d0 * SB_VT_STRIDE + key;
                vp[0] = (bf16_t)(w.x & 0xffff); vp[SB_VT_STRIDE] = (bf16_t)(w.x >> 16); vp[2 * SB_VT_STRIDE] = (bf16_t)(w.y & 0xffff); vp[3 * SB_VT_STRIDE] = (bf16_t)(w.y >> 16);
                vp[4 * SB_VT_STRIDE] = (bf16_t)(w.z & 0xffff); vp[5 * SB_VT_STRIDE] = (bf16_t)(w.z >> 16); vp[6 * SB_VT_STRIDE] = (bf16_t)(w.w & 0xffff); vp[7 * SB_VT_STRIDE] = (bf16_t)(w.w >> 16);
            }
            f32x16 sa;
#pragma unroll
            for (int r = 0; r < 16; ++r) sa[r] = 0.f;
#pragma unroll
            for (int s = 0; s < 4; ++s) sa = __builtin_amdgcn_mfma_f32_32x32x16_bf16(kf[s], qf[s], sa, 0, 0, 0);
            float lk[16], z[16];
#pragma unroll
            for (int r = 0; r < 16; ++r) {
                const int kk = (r & 3) + 8 * (r >> 2) + 4 * hh; const bool valid = (j0 + kk) < qi;
                const float zz = fminf(sa[r], 80.f); const float l = -__log2f(1.f + exp2f(zz));
                z[r] = zz; lk[r] = valid ? l : 0.f;
            }
            const float gs0 = (lk[0] + lk[1]) + (lk[2] + lk[3]), gs1 = (lk[4] + lk[5]) + (lk[6] + lk[7]), gs2 = (lk[8] + lk[9]) + (lk[10] + lk[11]), gs3 = (lk[12] + lk[13]) + (lk[14] + lk[15]);
            const float ps0 = __shfl_xor(gs0, 32), ps1 = __shfl_xor(gs1, 32), ps2 = __shfl_xor(gs2, 32), ps3 = __shfl_xor(gs3, 32);
            const float pc3 = ps3, pc2 = pc3 + ps2, pc1 = pc2 + ps1, pc0 = pc1 + ps0;
            float base[4];
            base[3] = L + (hh ? 0.f : pc3);
            base[2] = L + gs3 + (hh ? pc3 : pc2);
            base[1] = L + (gs3 + gs2) + (hh ? pc2 : pc1);
            base[0] = L + (gs3 + gs2 + gs1) + (hh ? pc1 : pc0);
            float a[16];
#pragma unroll
            for (int g = 0; g < 4; ++g) {
                float c = base[g];
#pragma unroll
                for (int e = 3; e >= 0; --e) {
                    const int r = 4 * g + e; c += lk[r];
                    const int kk = e + 8 * g + 4 * hh; const bool valid = (j0 + kk) < qi;
                    a[r] = valid ? exp2f(z[r] + c) : 0.f;
                }
            }
            L += (gs0 + gs1 + gs2 + gs3) + pc0;
            u32x4 pw0, pw1;
            pw0.x = pk2(a[0], a[1]); pw0.y = pk2(a[2], a[3]); pw0.z = pk2(a[4], a[5]); pw0.w = pk2(a[6], a[7]);
            pw1.x = pk2(a[8], a[9]); pw1.y = pk2(a[10], a[11]); pw1.z = pk2(a[12], a[13]); pw1.w = pk2(a[14], a[15]);
            const bf16x8 pf0 = __builtin_bit_cast(bf16x8, pw0), pf1 = __builtin_bit_cast(bf16x8, pw1);
#pragma unroll
            for (int mt = 0; mt < 2; ++mt) {
                const bf16_t* vr = VT + (32 * mt + n) * SB_VT_STRIDE + 4 * hh;
                u32x4 v0, v1;
                { const u32x2 x = *(const u32x2*)(vr), y = *(const u32x2*)(vr + 8); v0.x = x.x; v0.y = x.y; v0.z = y.x; v0.w = y.y; }
                { const u32x2 x = *(const u32x2*)(vr + 16), y = *(const u32x2*)(vr + 24); v1.x = x.x; v1.y = x.y; v1.z = y.x; v1.w = y.y; }
                if (mt == 0) { o0 = __builtin_amdgcn_mfma_f32_32x32x16_bf16(__builtin_bit_cast(bf16x8, v0), pf0, o0, 0, 0, 0); o0 = __builtin_amdgcn_mfma_f32_32x32x16_bf16(__builtin_bit_cast(bf16x8, v1), pf1, o0, 0, 0, 0); }
                else { o1 = __builtin_amdgcn_mfma_f32_32x32x16_bf16(__builtin_bit_cast(bf16x8, v0), pf0, o1, 0, 0, 0); o1 = __builtin_amdgcn_mfma_f32_32x32x16_bf16(__builtin_bit_cast(bf16x8, v1), pf1, o1, 0, 0, 0); }
            }
            const bool done = (L < -152.f) || (qi >= T);
            if (__all(done)) break;
        }
        if (qi < T) {
            bf16_t* yp = YA + ((size_t)b * T + qi) * 512 + h * 64 + 4 * hh;
#pragma unroll
            for (int g = 0; g < 4; ++g) {
                u32x2 w; w.x = pk2(o0[4 * g], o0[4 * g + 1]); w.y = pk2(o0[4 * g + 2], o0[4 * g + 3]); *(u32x2*)(yp + 8 * g) = w;
                w.x = pk2(o1[4 * g], o1[4 * g + 1]); w.y = pk2(o1[4 * g + 2], o1[4 * g + 3]); *(u32x2*)(yp + 32 + 8 * g) = w;
            }
        }
    }
}

constexpr int DSA_NQ = 8;
constexpr int DSA_SCS = 4128;
constexpr int DSA_KVB = 0, DSA_RING = 18432, DSA_IDX = DSA_NQ * DSA_RING, DSA_MISC = DSA_IDX + DSA_NQ * 1024, DSA_LDS = DSA_MISC + 512;
static_assert(DSA_NQ * DSA_SCS * 4 <= DSA_IDX, "score rows fit under the index lists");
__device__ __forceinline__ unsigned fkey(float f) { const unsigned u = __float_as_uint(f); return (u & 0x80000000u) ? ~u : (u | 0x80000000u); }
__device__ __forceinline__ int mbcnt64(unsigned long long m) { return (int)__builtin_amdgcn_mbcnt_hi((unsigned)(m >> 32), __builtin_amdgcn_mbcnt_lo((unsigned)m, 0u)); }
__device__ __forceinline__ void phase_dsa(const Params& p, char* lds) {
    const bf16_t* P = (const bf16_t*)(p.ws + WS_P); bf16_t* OL = (bf16_t*)(p.ws + WS_OLAT);
    const int tid = threadIdx.x, lane = tid & 63, wave = __builtin_amdgcn_readfirstlane(tid >> 6);
    unsigned* SC = (unsigned*)(lds + DSA_KVB);
    unsigned short* IDX = (unsigned short*)(lds + DSA_IDX);
    int* MISC = (int*)(lds + DSA_MISC);
    const unsigned lds_base = (unsigned)(size_t)lds;
    constexpr int NU = T / DSA_NQ;
    for (int unit = blockIdx.x; unit < BATCH * NU; unit += gridDim.x) {
        const int u8 = NU - 1 - unit / BATCH, b = unit % BATCH, t0 = u8 * DSA_NQ;
        const int cid = t0 < NMETA ? 0 : 1 + (t0 - NMETA) / 64, n = NMETA + 64 * cid;
        const bf16_t* Pb = P + (size_t)b * T * PW;
        __syncthreads();
        {
            const int m = lane & 31, hh = lane >> 5;
            bf16x8 aq[2][4]; float wv[2][16];
#pragma unroll
            for (int rt = 0; rt < 2; ++rt) {
#pragma unroll
                for (int s = 0; s < 4; ++s) aq[rt][s] = *(const bf16x8*)(Pb + (size_t)(t0 + 4 * rt + (m >> 3)) * PW + C_QI + (m & 7) * 64 + 16 * s + 8 * hh);
#pragma unroll
                for (int r = 0; r < 16; ++r) wv[rt][r] = bf2f(Pb[(size_t)(t0 + 4 * rt + (r >> 2)) * PW + C_WI + (r & 3) + 4 * hh]);
            }
            const int ntile = (n + 31) / 32;
            bf16x8 bk[4];
            { const int key = wave * 32 + m, krow = key < T ? key : T - 1;
#pragma unroll
              for (int s = 0; s < 4; ++s) bk[s] = *(const bf16x8*)(Pb + (size_t)krow * PW + C_KI + 16 * s + 8 * hh); }
            for (int kt = wave; kt < ntile; kt += NWAVES) {
                const int j0 = kt * 32, key = j0 + m;
                bf16x8 bn[4];
                { const int keyn = key + 32 * NWAVES, krow = keyn < T ? keyn : T - 1;
#pragma unroll
                  for (int s = 0; s < 4; ++s) bn[s] = *(const bf16x8*)(Pb + (size_t)krow * PW + C_KI + 16 * s + 8 * hh); }
                const bool ok = key < n;
#pragma unroll
                for (int rt = 0; rt < 2; ++rt) {
                    f32x16 acc;
#pragma unroll
                    for (int r = 0; r < 16; ++r) acc[r] = 0.f;
#pragma unroll
                    for (int s = 0; s < 4; ++s) acc = __builtin_amdgcn_mfma_f32_32x32x16_bf16(aq[rt][s], bk[s], acc, 0, 0, 0);
                    float tq[4];
#pragma unroll
                    for (int q = 0; q < 4; ++q) {
                        float s = wv[rt][4 * q] * fmaxf(acc[4 * q], 0.f); s += wv[rt][4 * q + 1] * fmaxf(acc[4 * q + 1], 0.f); s += wv[rt][4 * q + 2] * fmaxf(acc[4 * q + 2], 0.f); s += wv[rt][4 * q + 3] * fmaxf(acc[4 * q + 3], 0.f);
                        tq[q] = s + __shfl_xor(s, 32);
                    }
                    const float s0 = hh ? tq[2] : tq[0], s1 = hh ? tq[3] : tq[1];
                    SC[(4 * rt + 2 * hh) * DSA_SCS + key] = ok ? fkey(s0) : 0u;
                    SC[(4 * rt + 2 * hh + 1) * DSA_SCS + key] = ok ? fkey(s1) : 0u;
                }
#pragma unroll
                for (int s = 0; s < 4; ++s) bk[s] = bn[s];
            }
        }
        __syncthreads();
        {
            unsigned* sc = SC + wave * DSA_SCS;
            unsigned v[65];
#pragma unroll
            for (int i = 0; i < 65; ++i) { const int k = i * 64 + lane; v[i] = (k < n) ? sc[k] : 0u; }
            unsigned prefix = 0u; int cge = n, bit = 31;
            if (n >= 256) {
                for (; bit >= 0 && cge > 512; --bit) {
                    const unsigned cand = prefix | (1u << bit); int c = 0;
#pragma unroll
                    for (int gi = 0; gi < 5; ++gi) if (gi * 832 < n) {
#pragma unroll
                        for (int i = 13 * gi; i < 13 * gi + 13; ++i) { c += __popcll(__ballot(v[i] >= cand)); if ((i & 3) == 3) __builtin_amdgcn_sched_barrier(0); }
                        __builtin_amdgcn_sched_barrier(0);
                    }
                    if (c >= 256) { prefix = cand; cge = c; }
                }
            }
            int ngt = n;
            if (n >= 256) {
                asm volatile("s_waitcnt lgkmcnt(0)" ::: "memory");
                int cb = 0;
                if (bit >= 0) {
#pragma unroll
                    for (int gi = 0; gi < 5; ++gi) if (gi * 832 < n) {
#pragma unroll
                        for (int i = 13 * gi; i < 13 * gi + 13; ++i) {
                            const unsigned u = v[i]; const bool in = u >= prefix && u != 0u; const unsigned long long mk = __ballot(in);
                            sc[in ? cb + mbcnt64(mk) : 4096 + (lane & 15)] = u;
                            cb += __popcll(mk);
                            __builtin_amdgcn_sched_barrier(0);
                        }
                    }
                    asm volatile("s_waitcnt lgkmcnt(0)" ::: "memory");
                    unsigned w[8];
#pragma unroll
                    for (int j = 0; j < 8; ++j) { const int k = j * 64 + lane; w[j] = (k < cb) ? sc[k] : 0u; }
                    for (; bit >= 0; --bit) {
                        const unsigned cand = prefix | (1u << bit); int c = 0;
#pragma unroll
                        for (int j = 0; j < 8; ++j) c += __popcll(__ballot(w[j] >= cand));
                        if (c >= 256) prefix = cand;
                    }
                    int c = 0;
#pragma unroll
                    for (int j = 0; j < 8; ++j) c += __popcll(__ballot(w[j] > prefix));
                    ngt = c;
                } else {
                    int c = 0;
#pragma unroll
                    for (int i = 0; i < 65; ++i) { c += __popcll(__ballot(v[i] > prefix)); if ((i & 3) == 3) __builtin_amdgcn_sched_barrier(0); }
                    ngt = c;
                }
            }
            const unsigned tau = prefix;
            const int need_eq = n >= 256 ? 256 - ngt : 0; int base = 0, eqb = 0;
            unsigned short* idx = IDX + wave * 512;
#pragma unroll
            for (int gi = 0; gi < 5; ++gi) if (gi * 832 < n) {
#pragma unroll
                for (int i = 13 * gi; i < 13 * gi + 13; ++i) {
                    const int k = i * 64 + lane; const unsigned u = v[i];
                    const bool eq = (u == tau); const unsigned long long meq = __ballot(eq);
                    const bool take = (u > tau) || (eq && (eqb + mbcnt64(meq)) < need_eq);
                    const unsigned long long mt = __ballot(take);
                    idx[take ? base + mbcnt64(mt) : 256 + lane] = (unsigned short)k;
                    base += __popcll(mt); eqb += __popcll(meq);
                    __builtin_amdgcn_sched_barrier(0);
                }
            }
            for (int pos = base + lane; pos < 256; pos += 64) idx[pos] = 0;
            if (lane == 0) MISC[wave] = base;
        }
        __syncthreads();
        {
            const int q = wave; const int nsel = MISC[q];
            const size_t qrow = (size_t)(t0 + q);
            int ln = lane; asm volatile("" : "+v"(ln));
            const int hd = ln & 15, g = ln >> 4, qd = (ln & 15) >> 2, pp = ln & 3;
            char* ring = lds + DSA_KVB + wave * DSA_RING;
            const unsigned ring_a = lds_base + DSA_KVB + wave * DSA_RING;
            const unsigned short* idx = IDX + q * 512;
            bf16x8 qf[5];
#pragma unroll
            for (int ks = 0; ks < 5; ++ks) {
                u32x4 w = (u32x4){0u, 0u, 0u, 0u};
                if (hd < 8 && (ks < 4 || g < 2)) w = *(const u32x4*)(Pb + qrow * PW + C_QF + hd * QFW + 32 * ks + 8 * g);
                qf[ks] = __builtin_bit_cast(bf16x8, w);
            }
            asm volatile("s_waitcnt vmcnt(0)" ::: "memory");
#define DSA_ISSUE(c) do { _Pragma("unroll") for (int i_ = 0; i_ < 9; ++i_) { const int pid_ = ln + 64 * i_, row_ = pid_ / 18, part_ = pid_ - row_ * 18; \
                const bf16_t* src_ = Pb + (size_t)idx[32 * (c) + row_] * PW + C_KV + part_ * 8; \
                __builtin_amdgcn_global_load_lds((const unsigned*)src_, (LAS unsigned*)(ring + ((c) & 1) * 9216 + i_ * 1024), 16, 0, 0); } } while (0)
            DSA_ISSUE(0); DSA_ISSUE(1);
            f32x4 O[8];
#pragma unroll
            for (int nt = 0; nt < 8; ++nt) O[nt] = (f32x4){0.f, 0.f, 0.f, 0.f};
            float mrun = -3e38f, lrun = 0.f;
            for (int c = 0; c < 8; ++c) {
                if (c < 7) asm volatile("s_waitcnt vmcnt(9)" ::: "memory"); else asm volatile("s_waitcnt vmcnt(0)" ::: "memory");
                const char* buf = ring + (c & 1) * 9216;
                f32x4 S0 = (f32x4){0.f, 0.f, 0.f, 0.f}, S1 = S0;
                {
                    const char* kr = buf + hd * 288 + 16 * g;
#pragma unroll
                    for (int ks = 0; ks < 4; ++ks) { S0 = __builtin_amdgcn_mfma_f32_16x16x32_bf16(*(const bf16x8*)(kr + 64 * ks), qf[ks], S0, 0, 0, 0); S1 = __builtin_amdgcn_mfma_f32_16x16x32_bf16(*(const bf16x8*)(kr + 16 * 288 + 64 * ks), qf[ks], S1, 0, 0, 0); }
                    u32x4 w0 = (u32x4){0u, 0u, 0u, 0u}, w1 = w0; if (g < 2) { w0 = *(const u32x4*)(kr + 256); w1 = *(const u32x4*)(kr + 16 * 288 + 256); }
                    S0 = __builtin_amdgcn_mfma_f32_16x16x32_bf16(__builtin_bit_cast(bf16x8, w0), qf[4], S0, 0, 0, 0); S1 = __builtin_amdgcn_mfma_f32_16x16x32_bf16(__builtin_bit_cast(bf16x8, w1), qf[4], S1, 0, 0, 0);
                }
                float cm = -3e38f;
#pragma unroll
                for (int r = 0; r < 4; ++r) { const int sl = 32 * c + 4 * g + r; S0[r] = sl < nsel ? S0[r] : -1e30f; S1[r] = (sl + 16) < nsel ? S1[r] : -1e30f; cm = fmaxf(cm, fmaxf(S0[r], S1[r])); }
                cm = fmaxf(cm, __shfl_xor(cm, 16)); cm = fmaxf(cm, __shfl_xor(cm, 32));
                const float mnew = fmaxf(mrun, cm), alpha = exp2f(mrun - mnew);
                float ps = 0.f;
#pragma unroll
                for (int r = 0; r < 4; ++r) { S0[r] = exp2f(S0[r] - mnew); S1[r] = exp2f(S1[r] - mnew); ps += S0[r] + S1[r]; }
                ps += __shfl_xor(ps, 16); ps += __shfl_xor(ps, 32);
                lrun = lrun * alpha + ps; mrun = mnew;
                const float a0 = __shfl(alpha, 4 * g), a1 = __shfl(alpha, 4 * g + 1), a2 = __shfl(alpha, 4 * g + 2), a3 = __shfl(alpha, 4 * g + 3);
#pragma unroll
                for (int nt = 0; nt < 8; ++nt) { O[nt][0] *= a0; O[nt][1] *= a1; O[nt][2] *= a2; O[nt][3] *= a3; }
                u32x4 pw; pw.x = pk2(S0[0], S0[1]); pw.y = pk2(S0[2], S0[3]); pw.z = pk2(S1[0], S1[1]); pw.w = pk2(S1[2], S1[3]);
                const bf16x8 pf = __builtin_bit_cast(bf16x8, pw);
                const unsigned va = ring_a + (unsigned)((c & 1) * 9216 + (4 * g + qd) * 288 + 8 * pp);
#pragma unroll
                for (int h2 = 0; h2 < 2; ++h2) {
                    u16x4 x0, x1, x2, x3, y0, y1, y2, y3;
                    asm volatile("ds_read_b64_tr_b16 %0, %8 offset:%9\n\tds_read_b64_tr_b16 %1, %8 offset:%10\n\tds_read_b64_tr_b16 %2, %8 offset:%11\n\tds_read_b64_tr_b16 %3, %8 offset:%12\n\t"
                                 "ds_read_b64_tr_b16 %4, %8 offset:%13\n\tds_read_b64_tr_b16 %5, %8 offset:%14\n\tds_read_b64_tr_b16 %6, %8 offset:%15\n\tds_read_b64_tr_b16 %7, %8 offset:%16\n\ts_waitcnt lgkmcnt(0)"
                                 : "=&v"(x0), "=&v"(x1), "=&v"(x2), "=&v"(x3), "=&v"(y0), "=&v"(y1), "=&v"(y2), "=&v"(y3)
                                 : "v"(va), "i"(128 * h2), "i"(128 * h2 + 32), "i"(128 * h2 + 64), "i"(128 * h2 + 96), "i"(128 * h2 + 4608), "i"(128 * h2 + 4640), "i"(128 * h2 + 4672), "i"(128 * h2 + 4704) : "memory");
#define DSA_PV(nt_, x_, y_) do { bf16x8 vf_; vf_[0] = (short)x_[0]; vf_[1] = (short)x_[1]; vf_[2] = (short)x_[2]; vf_[3] = (short)x_[3]; vf_[4] = (short)y_[0]; vf_[5] = (short)y_[1]; vf_[6] = (short)y_[2]; vf_[7] = (short)y_[3]; \
                    O[nt_] = __builtin_amdgcn_mfma_f32_16x16x32_bf16(pf, vf_, O[nt_], 0, 0, 0); } while (0)
                    DSA_PV(4 * h2 + 0, x0, y0); DSA_PV(4 * h2 + 1, x1, y1); DSA_PV(4 * h2 + 2, x2, y2); DSA_PV(4 * h2 + 3, x3, y3);
                }
                asm volatile("s_waitcnt lgkmcnt(0)" ::: "memory");
                if (c + 2 < 8) DSA_ISSUE(c + 2);
            }
#undef DSA_PV
#undef DSA_ISSUE
            const float inv = 1.f / lrun;
            const float i0 = __shfl(inv, 4 * g), i1 = __shfl(inv, 4 * g + 1), i2 = __shfl(inv, 4 * g + 2), i3 = __shfl(inv, 4 * g + 3);
            if (g < 2) {
                bf16_t* op = OL + ((size_t)b * T + qrow) * 1024 + (4 * g) * 128 + hd;
#pragma unroll
                for (int nt = 0; nt < 8; ++nt) { op[16 * nt] = (bf16_t)f2bf(O[nt][0] * i0); op[128 + 16 * nt] = (bf16_t)f2bf(O[nt][1] * i1); op[256 + 16 * nt] = (bf16_t)f2bf(O[nt][2] * i2); op[384 + 16 * nt] = (bf16_t)f2bf(O[nt][3] * i3); }
            }
        }
    }
}

__device__ __forceinline__ void phase_c3(const Params& p, char* lds) {
    unsigned char* ws = p.ws; const int tid = threadIdx.x, lane = tid & 63, wave = __builtin_amdgcn_readfirstlane(tid >> 6);
    const float* H1 = (const float*)(ws + WS_H1); const float* g = p.in[I_GFFN];
    {
        bf16_t* U2 = (bf16_t*)(ws + WS_U); const int gw = blockIdx.x * NWAVES + wave, NGW = gridDim.x * NWAVES;
        for (int row = gw; row < NTOK; row += NGW) {
            const f32x4* xr = (const f32x4*)(H1 + (size_t)row * D) + lane;
            f32x4 v[4]; float s = 0.f;
#pragma unroll
            for (int j = 0; j < 4; ++j) { v[j] = xr[64 * j]; s += (v[j].x * v[j].x + v[j].y * v[j].y) + (v[j].z * v[j].z + v[j].w * v[j].w); }
            const float rstd = rsqrtf(wave_sum(s) * (1.f / D) + NORM_EPS);
            u32x2* o = (u32x2*)(U2 + (size_t)row * D) + lane;
#pragma unroll
            for (int j = 0; j < 4; ++j) { const f32x4 gg = ((const f32x4*)g)[lane + 64 * j];
                u32x2 w; w.x = pk2(v[j].x * rstd * gg.x, v[j].y * rstd * gg.y); w.y = pk2(v[j].z * rstd * gg.z, v[j].w * rstd * gg.w); o[64 * j] = w; }
        }
    }
    {
        float* Tl = (float*)lds;
        float* RED = (float*)lds;
        const float* wg = p.in[I_WGRP]; const float* wr = p.in[I_WRT]; const float* bg = p.in[I_BGRP]; const float* br = p.in[I_BRT];
        unsigned* ctl = (unsigned*)(ws + WS_CTL); int* LIST = (int*)(ws + WS_LIST); float* GATE = (float*)(ws + WS_GATE);
        const int tk = tid & 127, kq = wave >> 1;
        for (int grp = blockIdx.x; grp < NTOK / 128; grp += gridDim.x) {
            const int tok0 = grp * 128;
            float acc[36]; float ss = 0.f;
#pragma unroll
            for (int o = 0; o < 36; ++o) acc[o] = 0.f;
            for (int step = 0; step < 8; ++step) {
                __syncthreads();
#pragma unroll
                for (int i = 0; i < 8; ++i) { const int idx = tid + NTHREADS * i, qq = idx >> 10, rem = idx & 1023, t2 = rem >> 3, kc = rem & 7;
                    const f32x4 v = *(const f32x4*)(H1 + (size_t)(tok0 + t2) * D + qq * 256 + step * 32 + kc * 4);
                    float* d = Tl + qq * (32 * 129) + (kc * 4) * 129 + t2; d[0] = v.x; d[129] = v.y; d[258] = v.z; d[387] = v.w; }
                __syncthreads();
                const int kb = kq * 256 + step * 32;
#pragma unroll 4
                for (int k = 0; k < 32; ++k) {
                    const float h = Tl[kq * (32 * 129) + k * 129 + tk]; ss += h * h; const float hg = h * g[kb + k];
                    const float* w4 = wg + (size_t)(kb + k) * 4; const float* w32 = wr + (size_t)(kb + k) * 32;
#pragma unroll
                    for (int o = 0; o < 4; ++o) acc[o] += hg * w4[o];
#pragma unroll
                    for (int o = 0; o < 32; ++o) acc[4 + o] += hg * w32[o];
                }
            }
            __syncthreads();
#pragma unroll
            for (int o = 0; o < 36; ++o) RED[(kq * 37 + o) * 128 + tk] = acc[o];
            RED[(kq * 37 + 36) * 128 + tk] = ss;
            __syncthreads();
            if (tid < 128) {
                const int tok = tok0 + tk;
#pragma unroll
                for (int o = 0; o < 36; ++o) acc[o] = (RED[o * 128 + tk] + RED[(37 + o) * 128 + tk]) + (RED[(74 + o) * 128 + tk] + RED[(111 + o) * 128 + tk]);
                ss = (RED[36 * 128 + tk] + RED[(37 + 36) * 128 + tk]) + (RED[(74 + 36) * 128 + tk] + RED[(111 + 36) * 128 + tk]);
                const float rstd = rsqrtf(ss * (1.f / D) + NORM_EPS);
                float gl[4]; int gs = 0; float gm;
#pragma unroll
                for (int o = 0; o < 4; ++o) gl[o] = acc[o] * rstd + bg[o];
                gm = gl[0];
#pragma unroll
                for (int o = 1; o < 4; ++o) if (gl[o] > gm) { gm = gl[o]; gs = o; }
                float gsum = 0.f;
#pragma unroll
                for (int o = 0; o < 4; ++o) gsum += __expf(gl[o] - gm);
                const float pgrp = 1.f / gsum;
                float el[8];
#pragma unroll
                for (int j = 0; j < 8; ++j) { float a = acc[4 + j]; float bb = br[j];
                    a = gs == 1 ? acc[12 + j] : a; bb = gs == 1 ? br[8 + j] : bb; a = gs == 2 ? acc[20 + j] : a; bb = gs == 2 ? br[16 + j] : bb; a = gs == 3 ? acc[28 + j] : a; bb = gs == 3 ? br[24 + j] : bb;
                    el[j] = a * rstd + bb; }
                int e0 = 0; float m0 = el[0];
#pragma unroll
                for (int j = 1; j < 8; ++j) if (el[j] > m0) { m0 = el[j]; e0 = j; }
                int e1 = -1; float m1 = -3e38f;
#pragma unroll
                for (int j = 0; j < 8; ++j) if (j != e0 && el[j] > m1) { m1 = el[j]; e1 = j; }
                const float x1 = __expf(m1 - m0); const float g0 = pgrp / (1.f + x1), g1 = pgrp * x1 / (1.f + x1);
                const int ex0 = gs * 8 + e0, ex1 = gs * 8 + e1;
                const int s0 = (int)atomicAdd(ctl + CW_CNT + 64 * ex0, 1u); LIST[(size_t)ex0 * NTOK + s0] = tok * 2;
                const int s1 = (int)atomicAdd(ctl + CW_CNT + 64 * ex1, 1u); LIST[(size_t)ex1 * NTOK + s1] = tok * 2 + 1;
                GATE[tok * 2] = g0; GATE[tok * 2 + 1] = g1;
            }
        }
    }
}

template <int WHICH>
__device__ __forceinline__ void phase_moe(const Params& p, char* lds) {
    unsigned char* ws = p.ws; const int tid = threadIdx.x, wave = __builtin_amdgcn_readfirstlane(tid >> 6), half = wave >> 2, tid4 = tid & 255, wid4 = wave & 3;
    const unsigned* ctl = (const unsigned*)(ws + WS_CTL); const int* LIST = (const int*)(ws + WS_LIST); const float* GATE = (const float*)(ws + WS_GATE);
    const bf16_t* U2 = (const bf16_t*)(ws + WS_U); bf16_t* HID = (bf16_t*)(ws + WS_HID); bf16_t* MO = (bf16_t*)(ws + WS_MO);
    const bf16_t* W13 = (const bf16_t*)(ws + WS_W13); const bf16_t* W2 = (const bf16_t*)(ws + WS_W2);
    constexpr int KK = WHICH == 0 ? 1024 : 512, ntn = 8;
    char* ldsh = lds + half * MLFast::LDS_BYTES;
    int* TP = (int*)(lds + 2 * MLFast::LDS_BYTES);
    __syncthreads();
    if (tid == 0) { int tp = 0, ro = 0; for (int e = 0; e < NEXP; ++e) { const int c = (int)ctl[CW_CNT + 64 * e]; TP[e] = tp; TP[64 + e] = ro; TP[128 + e] = c; tp += ((c + 127) / 128) * ntn; ro += (c + 127) / 128 * 128; } TP[NEXP] = tp; }
    __syncthreads();
    const int total = TP[NEXP], nvb = gridDim.x * 2, vb = blockIdx.x * 2 + half;
    for (int base = 0; base < total; base += nvb) {
        const bool act = base + vb < total; const int tile = act ? base + vb : 0;
        int e = 0;
#pragma unroll 1
        for (int j = 16; j >= 1; j >>= 1) if (TP[e + j] <= tile) e += j;
        const int cnt_e = TP[128 + e], rowoff = TP[64 + e];
        const int lt = tile - TP[e], mt = lt / ntn, n0 = (lt % ntn) * 128, s0 = mt * 128;
        const bf16_t* ap[2]; const bf16_t* bp[2]; const int lr = tid4 >> 2, lc = (tid4 & 3) * 8;
#pragma unroll
        for (int i = 0; i < 2; ++i) {
            const int s = s0 + lr + 64 * i;
            if (WHICH == 0) { const int tok = s < cnt_e ? (LIST[(size_t)e * NTOK + s] >> 1) : 0; ap[i] = U2 + (size_t)tok * D + lc; bp[i] = W13 + ((size_t)e * 1024 + n0 + lr + 64 * i) * 1024 + lc; }
            else { ap[i] = HID + (size_t)(rowoff + s) * DEXP + lc; bp[i] = W2 + ((size_t)e * 1024 + n0 + lr + 64 * i) * 512 + lc; }
        }
        f32x4 acc[16];
        MLFast::run(ldsh, tid4, wid4, ap, bp, KK, acc);
        if (act) {
#pragma unroll
            for (int f = 0; f < 16; ++f) {
                int r, c; MLFast::pos(tid4, f, r, c); const int s = s0 + r; const f32x4 v = acc[f];
                if (WHICH == 0) {
                    const float h0 = v.x / (1.f + __expf(-v.x)) * v.y, h1 = v.z / (1.f + __expf(-v.z)) * v.w;
                    *(unsigned*)(HID + (size_t)(rowoff + s) * DEXP + ((n0 + c) >> 1)) = pk2(h0, h1);
                } else if (s < cnt_e) {
                    const int ent = LIST[(size_t)e * NTOK + s]; const float gt = GATE[ent];
                    u32x2 w; w.x = pk2(v.x * gt, v.y * gt); w.y = pk2(v.z * gt, v.w * gt);
                    *(u32x2*)(MO + (size_t)ent * D + n0 + c) = w;
                }
            }
        }
    }
}

__device__ __forceinline__ void phase_final(const Params& p) {
    unsigned char* ws = p.ws; const int tid = threadIdx.x, lane = tid & 63, wave = tid >> 6;
    const float* H1 = (const float*)(ws + WS_H1); const bf16_t* MO = (const bf16_t*)(ws + WS_MO); const float* g = p.in[I_GFIN];
    const int gw = blockIdx.x * NWAVES + wave, NGW = gridDim.x * NWAVES;
    for (int orow = gw; orow < BATCH * SEQ; orow += NGW) {
        const int b = orow / SEQ, s = orow - b * SEQ; const size_t row = (size_t)b * T + NMETA + s;
        const f32x4* xr = (const f32x4*)(H1 + row * D) + lane; const u32x2* m0 = (const u32x2*)(MO + row * 2 * D) + lane; const u32x2* m1 = m0 + 256;
        f32x4 v[4]; float ss = 0.f;
#pragma unroll
        for (int j = 0; j < 4; ++j) { const u32x2 a = m0[64 * j], c = m1[64 * j]; v[j] = xr[64 * j];
            v[j].x += bflo(a.x) + bflo(c.x); v[j].y += bfhi(a.x) + bfhi(c.x); v[j].z += bflo(a.y) + bflo(c.y); v[j].w += bfhi(a.y) + bfhi(c.y);
            ss += (v[j].x * v[j].x + v[j].y * v[j].y) + (v[j].z * v[j].z + v[j].w * v[j].w); }
        const float rstd = rsqrtf(wave_sum(ss) * (1.f / D) + NORM_EPS);
        f32x4* o = (f32x4*)(p.out + (size_t)orow * D) + lane;
#pragma unroll
        for (int j = 0; j < 4; ++j) { const f32x4 gg = ((const f32x4*)g)[lane + 64 * j]; o[64 * j] = v[j] * rstd * gg; }
    }
}

#define XB_TMO      128
#define XB_XCNT(j)  (256  + 64 * (j))
#define XB_XSUB(j)  (1280 + 64 * (j))
#define XB_XGEN(j)  (2304 + 64 * (j))
#define XB_TOP      3328
#define XB_TOPGEN   3392
#define XCD_BAR_WORDS 3456
#define XB_SPIN_CAP (1u << 18)
__device__ __forceinline__ unsigned xb_ld(unsigned* p)              { return __hip_atomic_load(p, __ATOMIC_RELAXED, __HIP_MEMORY_SCOPE_AGENT); }
__device__ __forceinline__ unsigned xb_add(unsigned* p, unsigned v) { return __hip_atomic_fetch_add(p, v, __ATOMIC_RELAXED, __HIP_MEMORY_SCOPE_AGENT); }
__device__ __forceinline__ unsigned xb_xcc_id() { return (unsigned)__builtin_amdgcn_s_getreg((3 << 11) | 20) & 0xFu; }
#define XB_SPIN(cond, bar) do { unsigned _sp = 0; while (cond) { __builtin_amdgcn_s_sleep(1); \
    if ((++_sp & 255u) == 0u) { if (xb_ld(&(bar)[XB_TMO])) break; if (_sp > XB_SPIN_CAP) { atomicAdd(&(bar)[XB_TMO], 1u); break; } } } } while (0)
struct XcdBarrier { unsigned* bar; unsigned x; volatile LAS unsigned* st; };
__device__ __forceinline__ XcdBarrier xcd_barrier_post(unsigned* bar, volatile LAS unsigned* st) {
    XcdBarrier b; b.bar = bar; b.x = xb_xcc_id(); b.st = st;
    if (threadIdx.x == 0) (void)xb_add(&bar[XB_XCNT(b.x)], 1u);
    return b;
}
__device__ __forceinline__ void xcd_barrier_complete(unsigned* bar, unsigned x, unsigned& nloc, unsigned& nx) {
    const unsigned G = gridDim.x * gridDim.y * gridDim.z;
    unsigned sum, cnt, mine, sp = 0u;
    for (;;) {
        sum = 0u; cnt = 0u; mine = 0u;
#pragma unroll
        for (unsigned j = 0; j < 16; ++j) { const unsigned c = xb_ld(&bar[XB_XCNT(j)]); sum += c; cnt += (c > 0u) ? 1u : 0u; mine = (j == x) ? c : mine; }
        if (sum == G) break;
        __builtin_amdgcn_s_sleep(1);
        if ((++sp & 255u) == 0u) { if (xb_ld(&bar[XB_TMO])) break; if (sp > XB_SPIN_CAP) { atomicAdd(&bar[XB_TMO], 1u); break; } }
    }
    nloc = mine > 0u ? mine : 1u; nx = cnt > 0u ? cnt : 1u;
}
__device__ __forceinline__ void xcd_barrier(const XcdBarrier& b) {
    asm volatile("s_waitcnt vmcnt(0)" ::: "memory");
    __syncthreads();
    if (threadIdx.x == 0) {
        unsigned* bar = b.bar;
        __builtin_amdgcn_s_waitcnt(0);
        unsigned nloc = b.st[0], nx = b.st[1];
        if (nloc == 0u) { xcd_barrier_complete(bar, b.x, nloc, nx); b.st[0] = nloc; b.st[1] = nx; }
        const unsigned old = xb_add(&bar[XB_XSUB(b.x)], 1u);
        const unsigned gen = old / nloc;
        if (old + 1u == (gen + 1u) * nloc) {
            __builtin_amdgcn_fence(__ATOMIC_RELEASE, "agent");
            asm volatile("s_waitcnt vmcnt(0)" ::: "memory");
            const unsigned og = xb_add(&bar[XB_TOP], 1u);
            const unsigned tg = og / nx;
            if (og + 1u == (tg + 1u) * nx) xb_add(&bar[XB_TOPGEN], 1u);
            else XB_SPIN(xb_ld(&bar[XB_TOPGEN]) == tg, bar);
            __builtin_amdgcn_fence(__ATOMIC_ACQUIRE, "agent");
            xb_add(&bar[XB_XGEN(b.x)], 1u);
            asm volatile("s_waitcnt vmcnt(0)" ::: "memory");
        } else {
            XB_SPIN(xb_ld(&bar[XB_XGEN(b.x)]) == gen, bar);
            __builtin_amdgcn_fence(__ATOMIC_ACQUIRE, "agent");
            asm volatile("s_waitcnt vmcnt(0)" ::: "memory");
        }
    }
    __syncthreads();
}

constexpr int LDS_XB = DSA_LDS;
constexpr int LDS_BYTES = DSA_LDS + 256;
static_assert(pg8::STAGE_BYTES <= LDS_XB && 2 * MLFast::LDS_BYTES + 1024 <= LDS_XB && NWAVES * 64 * 33 * 4 <= LDS_XB && NWAVES * 64 * SB_VT_STRIDE * 2 <= LDS_XB && 4 * 37 * 128 * 4 <= LDS_XB, "LDS map");

__global__ void __launch_bounds__(NTHREADS, 2) mega(Params p) {
    extern __shared__ __attribute__((aligned(16))) char lds[];
    const int lo = p.ph_lo, hi = p.ph_hi;
    unsigned char* ws = p.ws;
    XcdBarrier xb;
    {
        volatile LAS unsigned* st = (volatile LAS unsigned*)(lds + LDS_XB);
        if (threadIdx.x < 4) st[threadIdx.x] = 0u;
        __syncthreads();
        xb = xcd_barrier_post((unsigned*)(ws + WS_CTL) + CW_BAR, st);
    }
#define IN(k) (lo <= (k) && (k) < hi)
#define GSYNC() xcd_barrier(xb)
#define SEAM(k) do { if (IN(k) && IN((k) + 1)) GSYNC(); } while (0)
#define REP(k, ...) do { if (IN(k)) { __VA_ARGS__; if (PROBE_PH == (k)) { GSYNC(); __VA_ARGS__; } } } while (0)
    LAS unsigned char* ldsl = (LAS unsigned char*)lds;
    REP(0, phase_prologue(p, lds));
    SEAM(0);
    REP(1, { pg8::Gemm g{(const bf16_t*)(ws + WS_U), (const bf16_t*)(ws + WS_WP), MROWS, PWN, D}; pg8::StaticOrder S; S.init(MROWS, PWN, gridDim.x, blockIdx.x);
             pg8::EpiInproj E{(bf16_t*)(ws + WS_P), (const float2*)(ws + WS_CS)}; pg8::gemm_phase<pg8::EpiInproj, pg8::StaticOrder, true, true>(ldsl, g, S, E); });
    SEAM(1);
    if (IN(2)) {
        phase_dsa(p, lds);
        if (PROBE_PH == 20) { GSYNC(); phase_dsa(p, lds); }
        __syncthreads(); phase_sb_fast(p, lds);
        if (PROBE_PH == 21) { GSYNC(); phase_sb_fast(p, lds); }
    }
    SEAM(2);
    REP(3, { pg8::Gemm g{(const bf16_t*)(ws + WS_U), (const bf16_t*)(ws + WS_WG), MROWS, 2048, D}; pg8::StaticOrder S; S.init(MROWS, 2048, gridDim.x, blockIdx.x);
             pg8::EpiGate E{(bf16_t*)(ws + WS_G)}; pg8::gemm_phase<pg8::EpiGate, pg8::StaticOrder, true, true>(ldsl, g, S, E); });
    SEAM(3);
    REP(4, { { pg8::Gemm g{(const bf16_t*)(ws + WS_YA), (const bf16_t*)(ws + WS_WUA), MROWS, D, 512}; pg8::StaticOrder S; S.init(MROWS, D, gridDim.x, blockIdx.x);
               pg8::EpiZ<false> E{(bf16_t*)(ws + WS_Z), (const bf16_t*)(ws + WS_G), 0}; pg8::gemm_phase<pg8::EpiZ<false>, pg8::StaticOrder, true, true>(ldsl, g, S, E); }
             asm volatile("s_waitcnt vmcnt(0)" ::: "memory"); __syncthreads();
             { pg8::Gemm g{(const bf16_t*)(ws + WS_OLAT), (const bf16_t*)(ws + WS_WBP), MROWS, D, D}; pg8::StaticOrder S; S.init(MROWS, D, gridDim.x, blockIdx.x);
               pg8::EpiZ<true> E{(bf16_t*)(ws + WS_Z), (const bf16_t*)(ws + WS_G), 1024}; pg8::gemm_phase<pg8::EpiZ<true>, pg8::StaticOrder, true, true>(ldsl, g, S, E); } });
    SEAM(4);
    REP(5, { pg8::Gemm g{(const bf16_t*)(ws + WS_Z), (const bf16_t*)(ws + WS_WO), MROWS, D, D}; pg8::StaticOrder S; S.init(MROWS, D, gridDim.x, blockIdx.x);
             pg8::EpiH1 E{(float*)(ws + WS_H1), p.in[I_META], p.in[I_X]}; pg8::gemm_phase<pg8::EpiH1, pg8::StaticOrder, true, true>(ldsl, g, S, E); });
    SEAM(5);
    if (IN(6)) phase_c3(p, lds);
    SEAM(6);
    REP(7, phase_moe<0>(p, lds));
    SEAM(7);
    REP(8, phase_moe<1>(p, lds));
    SEAM(8);
    REP(9, phase_final(p));
}

extern "C" void kernel_launch(void* const* d_in, const int* in_sizes, int n_in, void* d_out, int out_size, void* d_ws, size_t ws_size, hipStream_t stream) {
    if (n_in != 18 || ws_size < WS_END) { fprintf(stderr, "kernel_launch: unexpected n_in %d / ws_size %zu\n", n_in, ws_size); return; }
    static int grid = 0;
    if (grid == 0) {
        int dev = 0, cus = 0, per_cu = 0;
        (void)hipGetDevice(&dev);
        (void)hipDeviceGetAttribute(&cus, hipDeviceAttributeMultiprocessorCount, dev);
        (void)hipFuncSetAttribute((const void*)mega, hipFuncAttributeMaxDynamicSharedMemorySize, LDS_BYTES);
        (void)hipOccupancyMaxActiveBlocksPerMultiprocessor(&per_cu, (const void*)mega, NTHREADS, LDS_BYTES);
        if (per_cu < 1) fprintf(stderr, "kernel_launch: occupancy query reports %d workgroups per CU\n", per_cu);
        grid = cus;
    }
    (void)hipMemsetAsync((char*)d_ws + WS_CTL, 0, CTL_BYTES, stream);
    Params p{};
    for (int i = 0; i < 18; ++i) p.in[i] = (const float*)d_in[i];
    p.out = (float*)d_out; p.ws = (unsigned char*)d_ws;
    p.ph_lo = 0; p.ph_hi = 10;
    void* args[] = {&p};
    hipError_t e = hipLaunchCooperativeKernel((const void*)mega, dim3(grid), dim3(NTHREADS), args, LDS_BYTES, stream);
    if (e != hipSuccess) fprintf(stderr, "cooperative launch failed: %s (grid %d)\n", hipGetErrorString(e), grid);
}
```

```cpp
#include <hip/hip_runtime.h>
#include <cstdio>
#include <cstdint>
#ifndef PROBE_PH
#define PROBE_PH -1
#endif

constexpr int BATCH = 8, SEQ = 4096, NMETA = 16, T = SEQ + NMETA, D = 1024, NTOK = BATCH * T;
constexpr int MROWS = 33024;
constexpr int NR = BATCH * SEQ;
__device__ __forceinline__ int tokrow(int cr) { return cr + NMETA * (cr / SEQ + 1); }
constexpr int INW = 4824;
constexpr int NEXP = 32, DEXP = 512;
constexpr int NWAVES = 8, NTHREADS = 512;
constexpr float NORM_EPS = 1e-6f;
constexpr float LOG2E = 1.4426950408889634f;
constexpr float QSCALE = 0.125f * LOG2E;
constexpr int PW = 3456, PWN = 3584;
constexpr int C_QA = 0, C_KA = 512, C_VA = 1024, C_QF = 1536, C_KV = 2688, C_QI = 2832, C_KI = 3344, C_WI = 3408, C_END = 3416;
constexpr int QFW = 144;

constexpr size_t MiB = 1u << 20;
constexpr size_t WS_CTL = 0, CTL_BYTES = 1 * MiB;
constexpr size_t WS_CS = 1 * MiB;
constexpr size_t WS_WP = 2 * MiB;
constexpr size_t WS_WG = 9 * MiB;
constexpr size_t WS_WUA = 13 * MiB, WS_WBP = 14 * MiB, WS_WO = 16 * MiB;
constexpr size_t WS_W2 = 18 * MiB;
constexpr size_t WS_W13 = 50 * MiB;
constexpr size_t WS_U = 114 * MiB;
constexpr size_t WS_P = 179 * MiB;
constexpr size_t WS_Z = 179 * MiB;
constexpr size_t WS_G = 244 * MiB;
constexpr size_t WS_H1 = 244 * MiB;
constexpr size_t WS_LIST = 374 * MiB;
constexpr size_t WS_GATE = 379 * MiB;
constexpr size_t WS_YA = 397 * MiB;
constexpr size_t WS_OLAT = 430 * MiB;
constexpr size_t WS_HID = 397 * MiB;
constexpr size_t WS_MO = 50 * MiB;
constexpr size_t WS_KIP = 495 * MiB;
constexpr size_t KIP_BATCH = 129 * 4096;
constexpr size_t WS_END = 500 * MiB;
static_assert(WS_P + (size_t)MROWS * PW * 2 <= WS_YA && WS_G + (size_t)MROWS * 2048 * 2 <= WS_LIST && WS_Z + (size_t)MROWS * 1024 * 2 <= WS_G, "ws map");
static_assert(WS_OLAT + (size_t)MROWS * 1024 * 2 <= WS_END && WS_U + (size_t)MROWS * 1024 * 2 <= WS_P && WS_MO + (size_t)NTOK * 2048 * 2 <= WS_P, "ws map");
constexpr int CW_CNT = 1024;
constexpr int CW_BAR = 4096;

typedef unsigned short bf16_t;
typedef short bf16x8 __attribute__((ext_vector_type(8)));
typedef float f32x4 __attribute__((ext_vector_type(4)));
typedef float f32x16 __attribute__((ext_vector_type(16)));
typedef unsigned u32x2 __attribute__((ext_vector_type(2)));
typedef unsigned u32x4 __attribute__((ext_vector_type(4)));
typedef unsigned short u16x4 __attribute__((ext_vector_type(4)));
#define LAS __attribute__((address_space(3)))

__device__ __forceinline__ unsigned f2bf(float f) { unsigned u = __float_as_uint(f); return (u + 0x7fffu + ((u >> 16) & 1u)) >> 16; }
typedef __bf16 bf16v2_t __attribute__((ext_vector_type(2)));
typedef float f32v2_t __attribute__((ext_vector_type(2)));
__device__ __forceinline__ unsigned pk2(float lo, float hi) { const f32v2_t v = {lo, hi}; const bf16v2_t r = __builtin_convertvector(v, bf16v2_t); return __builtin_bit_cast(unsigned, r); }
__device__ __forceinline__ float bflo(unsigned w) { return __uint_as_float(w << 16); }
__device__ __forceinline__ float bfhi(unsigned w) { return __uint_as_float(w & 0xffff0000u); }
__device__ __forceinline__ float bf2f(bf16_t b) { return __uint_as_float((unsigned)b << 16); }
__device__ __forceinline__ float wave_sum(float v) {
#pragma unroll
    for (int o = 1; o < 64; o <<= 1) v += __shfl_xor(v, o);
    return v;
}
__device__ __forceinline__ float sigmoidf(float x) { return 1.0f / (1.0f + __expf(-x)); }

struct Params {
    const float* in[18];
    float* out;
    unsigned char* ws;
    int ph_lo, ph_hi;
};
enum { I_X = 0, I_META, I_GMIX, I_WIN, I_WUK, I_WUV, I_WUPA, I_WUPB, I_WO, I_GFFN, I_WGRP, I_BGRP, I_WRT, I_BRT, I_W1, I_W3, I_W2, I_GFIN };

__device__ __forceinline__ const float* h0_row(const Params& p, int row) {
    const int b = row / T, t = row - b * T;
    return t < NMETA ? p.in[I_META] + (size_t)t * D : p.in[I_X] + ((size_t)b * SEQ + (t - NMETA)) * D;
}
template <class F>
__device__ __forceinline__ void tr_item(F val, bf16_t* dst, int ldd, int row0, int k0, float* scr, int lane, int rstep = 1) {
    float tv[32];
#pragma unroll
    for (int i = 0; i < 32; ++i) tv[i] = val(k0 + 2 * i + (lane >> 5), lane & 31);
#pragma unroll
    for (int i = 0; i < 32; ++i) scr[(2 * i + (lane >> 5)) * 33 + (lane & 31)] = tv[i];
    __builtin_amdgcn_s_waitcnt(0xC07F);
    asm volatile("" ::: "memory");
    const int c = lane & 7;
#pragma unroll
    for (int j = 0; j < 4; ++j) {
        const int n = (lane >> 3) + 8 * j; const float* s = scr + (8 * c) * 33 + n;
        u32x4 o; o.x = pk2(s[0], s[33]); o.y = pk2(s[66], s[99]); o.z = pk2(s[132], s[165]); o.w = pk2(s[198], s[231]);
        *(u32x4*)(dst + (size_t)(row0 + n * rstep) * ldd + k0 + 8 * c) = o;
    }
    __builtin_amdgcn_s_waitcnt(0xC07F);
    asm volatile("" ::: "memory");
}

__device__ __forceinline__ void wp_src(int c, int& kind, int& col, int& aux, float& scale) {
    kind = 1; aux = 0; scale = 1.f; col = 0;
    if (c < 512) { col = c; scale = QSCALE; }
    else if (c < C_QF) { col = c; }
    else if (c < C_KV) { const int r = c - C_QF, h = r / QFW, j = r % QFW; scale = QSCALE;
        if (j < 128) { kind = 2; col = h; aux = j; } else { const int i = j - 128; col = 1536 + 64 * h + (i >> 1) + 8 * (i & 1); } }
    else if (c < C_QI) { const int j = c - C_KV; if (j < 128) col = 2048 + j; else { const int i = j - 128; col = 2176 + (i >> 1) + 8 * (i & 1); } }
    else if (c < C_KI) { const int r = c - C_QI, h = r >> 6, j = r & 63; col = 2192 + 64 * h + (j < 16 ? (j >> 1) + 8 * (j & 1) : j); }
    else if (c < C_WI) { const int j = c - C_KI; col = 2704 + (j < 16 ? (j >> 1) + 8 * (j & 1) : j); }
    else if (c < C_END) { col = 2768 + (c - C_WI); }
    else kind = 0;
}

constexpr int IT_WP = (PWN / 32) * 16;
constexpr int IT_WG = 32 * 16;
constexpr int IT_WUA = 32 * 8;
constexpr int IT_WBP = 32 * 16, IT_WO = 32 * 16;
constexpr int IT_W13 = NEXP * 32 * 16;
constexpr int IT_W2 = NEXP * 32 * 8;
constexpr int IT_TOTAL = IT_WP + 2 * IT_WG + IT_WUA + IT_WBP + IT_WO + IT_W13 + IT_W2;

__device__ __forceinline__ void phase_prologue(const Params& p, char* lds) {
    const int tid = threadIdx.x, lane = tid & 63, wave = tid >> 6;
    const int gw = blockIdx.x * NWAVES + wave, NGW = gridDim.x * NWAVES;
    float* scr = (float*)lds + wave * (64 * 33);
    unsigned char* ws = p.ws;
    const float* w_in = p.in[I_WIN];
    {
        float2* cs = (float2*)(ws + WS_CS);
        for (int i = blockIdx.x * NTHREADS + tid; i < T * 8; i += gridDim.x * NTHREADS) {
            const int pos = i >> 3, f = i & 7;
            const float inv = powf(500000.0f, -(float)f / 8.0f);
            const float ang = (float)pos * inv;
            cs[i] = make_float2(cosf(ang), sinf(ang));
        }
    }
    for (int it = gw; it < IT_TOTAL; it += NGW) {
        int r = it;
        if (r < IT_WP) {
            const int rg = r / 16, kb = r % 16, c = rg * 32 + (lane & 31);
            int kind, col, aux; float scale; wp_src(c, kind, col, aux, scale);
            const float* w_uk = p.in[I_WUK];
            float wu[48];
#pragma unroll
            for (int n4 = 0; n4 < 12; ++n4) { f32x4 t = (f32x4){0.f, 0.f, 0.f, 0.f}; if (kind == 2) t = *(const f32x4*)(w_uk + ((size_t)col * 128 + aux) * 48 + 4 * n4); wu[4 * n4] = t.x; wu[4 * n4 + 1] = t.y; wu[4 * n4 + 2] = t.z; wu[4 * n4 + 3] = t.w; }
            tr_item([&](int k, int) -> float {
                if (kind == 0) return 0.f;
                if (kind == 1) return scale * w_in[(size_t)k * INW + col];
                const f32x4* wi = (const f32x4*)(w_in + (size_t)k * INW + 1536 + 64 * col + 16);
                float s = 0.f;
#pragma unroll
                for (int n4 = 0; n4 < 12; ++n4) { const f32x4 t = wi[n4]; s += t.x * wu[4 * n4] + t.y * wu[4 * n4 + 1] + t.z * wu[4 * n4 + 2] + t.w * wu[4 * n4 + 3]; }
                return scale * s; }, (bf16_t*)(ws + WS_WP), 1024, rg * 32, kb * 64, scr, lane);
            continue; }
        r -= IT_WP;
        if (r < 2 * IT_WG) {
            const int which = r / IT_WG; r %= IT_WG; const int rg = r / 16, kb = r % 16; const int col0 = (which ? 3800 : 2776) + rg * 32;
            tr_item([&](int k, int n) -> float { return w_in[(size_t)k * INW + col0 + n]; }, (bf16_t*)(ws + WS_WG) + (size_t)which * 1024 * 1024, 1024, rg * 32, kb * 64, scr, lane);
            continue; }
        r -= 2 * IT_WG;
        if (r < IT_WUA) {
            const int rg = r / 8, kb = r % 8; const float* w = p.in[I_WUPA];
            tr_item([&](int k, int n) -> float { return w[(size_t)k * 1024 + rg * 32 + n]; }, (bf16_t*)(ws + WS_WUA), 512, rg * 32, kb * 64, scr, lane);
            continue; }
        r -= IT_WUA;
        if (r < IT_WBP) {
            const int rg = r / 16, kb = r % 16; const float* wuv = p.in[I_WUV]; const float* wub = p.in[I_WUPB];
            const int hB = kb >> 1;
            float bc[64];
#pragma unroll
            for (int d = 0; d < 64; ++d) bc[d] = wub[(size_t)(64 * hB + d) * 1024 + rg * 32 + (lane & 31)];
            tr_item([&](int kk, int) -> float {
                const f32x4* a = (const f32x4*)(wuv + (size_t)kk * 64);
                float s = 0.f;
#pragma unroll
                for (int d4 = 0; d4 < 16; ++d4) { const f32x4 t = a[d4]; s += t.x * bc[4 * d4] + t.y * bc[4 * d4 + 1] + t.z * bc[4 * d4 + 2] + t.w * bc[4 * d4 + 3]; }
                return s; }, (bf16_t*)(ws + WS_WBP), 1024, rg * 32, kb * 64, scr, lane);
            continue; }
        r -= IT_WBP;
        if (r < IT_WO) {
            const int rg = r / 16, kb = r % 16; const float* w = p.in[I_WO];
            tr_item([&](int k, int n) -> float { return w[(size_t)k * 1024 + rg * 32 + n]; }, (bf16_t*)(ws + WS_WO), 1024, rg * 32, kb * 64, scr, lane);
            continue; }
        r -= IT_WO;
        if (r < IT_W13) {
            const int e = r / 512; r %= 512; const int which = r & 1, cg = (r >> 1) & 15, kb = r >> 5;
            const float* w = (which ? p.in[I_W3] : p.in[I_W1]) + (size_t)e * 1024 * 512 + cg * 32;
            tr_item([&](int k, int n) -> float { return w[(size_t)k * 512 + n]; },
                    (bf16_t*)(ws + WS_W13) + (size_t)e * 1024 * 1024, 1024, 2 * cg * 32 + which, kb * 64, scr, lane, 2);
            continue; }
        r -= IT_W13;
        {
            const int e = r / 256; r %= 256; const int rg = r / 8, kb = r % 8;
            const float* w2 = p.in[I_W2] + (size_t)e * 512 * 1024;
            tr_item([&](int k, int n) -> float { return w2[(size_t)k * 1024 + rg * 32 + n]; }, (bf16_t*)(ws + WS_W2) + (size_t)e * 1024 * 512, 512, rg * 32, kb * 64, scr, lane);
        }
    }
    {
        const float* g = p.in[I_GMIX]; bf16_t* U = (bf16_t*)(ws + WS_U);
        for (int row = gw; row < NTOK; row += NGW) {
            const f32x4* xr = (const f32x4*)h0_row(p, row) + lane;
            f32x4 v[4]; float s = 0.f;
#pragma unroll
            for (int j = 0; j < 4; ++j) { v[j] = xr[64 * j]; s += (v[j].x * v[j].x + v[j].y * v[j].y) + (v[j].z * v[j].z + v[j].w * v[j].w); }
            const float rstd = rsqrtf(wave_sum(s) * (1.f / D) + NORM_EPS);
            u32x2* o = (u32x2*)(U + (size_t)row * D) + lane;
#pragma unroll
            for (int j = 0; j < 4; ++j) { const f32x4 gg = ((const f32x4*)g)[lane + 64 * j];
                u32x2 w; w.x = pk2(v[j].x * rstd * gg.x, v[j].y * rstd * gg.y); w.y = pk2(v[j].z * rstd * gg.z, v[j].w * rstd * gg.w); o[64 * j] = w; }
        }
    }
}

namespace pg8 {
#define PG8_LAS __attribute__((address_space(3)))
typedef unsigned short bf16_t;
typedef short bf16x8 __attribute__((ext_vector_type(8)));
typedef float f32x4 __attribute__((ext_vector_type(4)));
typedef unsigned u32x4 __attribute__((ext_vector_type(4)));
constexpr int BM = 256, BK = 64, HALF = 128, HTB = HALF * BK * 2  , STAGE_BYTES = 8 * HTB, NXCD = 8, WGM = 8;

__host__ __device__ __forceinline__ int lds_byte(int r, int c) { const int st = (r >> 4) * 2 + (c >> 5), rr = r & 15, cc = c & 31, ob = rr * 64 + cc * 2; return st * 1024 + (ob ^ (((ob >> 9) & 1) << 5)); }
__host__ __device__ __forceinline__ void stage_rc(int b, int& R, int& C) { const int st = b / 1024, sb = b % 1024, swz = sb ^ (((sb >> 9) & 1) << 5); R = (st >> 1) * 16 + swz / 64; C = (st & 1) * 32 + (swz % 64) / 2; }
__host__ __device__ __forceinline__ int perm32(int rho) { const int n = rho >> 4, i = rho & 15; return 8 * (i >> 2) + 4 * n + (i & 3); }

struct Unit { int pm, pn; };
struct Gemm { const bf16_t* A; const bf16_t* Bt; int M, N, K; };

struct StaticOrder {
    int nM, nN, nwg, G, c;
    __host__ __device__ void init(int M, int N, int G_, int c_) { nM = M / BM; nN = N / BM; nwg = nM * nN; G = G_; c = c_; }
    __host__ __device__ bool next(int i, Unit& u) const {
        const long L = (long)i * G + c; if (L >= nwg) return false;
        int wgid = (int)L; { const int q = nwg / NXCD, r = nwg % NXCD, xcd = wgid % NXCD, off = wgid / NXCD; wgid = (xcd < r ? xcd * (q + 1) : r * (q + 1) + (xcd - r) * q) + off; }
        const int nig = WGM * nN, gid = wgid / nig, fm = gid * WGM, gsz = (nM - fm) < WGM ? (nM - fm) : WGM;
        u.pm = fm + ((wgid % nig) % gsz); u.pn = (wgid % nig) / gsz; return true;
    }
    __device__ __forceinline__ void a_ready(const Unit&) const {}
    __device__ __forceinline__ void done(const Unit&) const {}
};


#define PG8_FOR_FRAGS(...) _Pragma("unroll") for (int ai = 0; ai < 2; ++ai) _Pragma("unroll") for (int m = 0; m < 4; ++m) { const int row = u.pm * BM + ai * HALF + wr * 64 + m * 16 + fr; \
    _Pragma("unroll") for (int bj = 0; bj < 2; ++bj) _Pragma("unroll") for (int n = 0; n < 2; ++n) { const int col = u.pn * BM + bj * HALF + wc * 32 + n * 16 + 4 * fq; ::f32x4 v = acc[ai][bj][m][n]; __VA_ARGS__ } }
__device__ __forceinline__ bool rope_off(int c, int& o) {
    if (c < C_QF) return false;
    if (c < C_KV) { const int j = (c - C_QF) % QFW; o = j - 128; return j >= 128; }
    if (c < C_QI) { const int j = c - C_KV; o = j - 128; return j >= 128; }
    if (c < C_KI) { const int j = (c - C_QI) & 63; o = j; return j < 16; }
    if (c < C_WI) { const int j = c - C_KI; o = j; return j < 16; }
    return false;
}
struct EpiInproj {
    static constexpr bool PERM = false, AFTER_DRAIN = false;
    bf16_t* P; const float2* cs; unsigned char* KIP;
    __device__ __forceinline__ void operator()(const f32x4 (&acc)[2][2][4][2], const Unit& u, int wr, int wc, int fr, int fq) const {
        PG8_FOR_FRAGS(
            if (col < PW) {
                int o; const int trow = tokrow(row);
                if (rope_off(col, o)) {
                    const int pos = (row % SEQ) + NMETA; const float2 c0 = cs[pos * 8 + (o >> 1)], c1 = cs[pos * 8 + (o >> 1) + 1];
                    v = (::f32x4){v.x * c0.x - v.y * c0.y, v.y * c0.x + v.x * c0.y, v.z * c1.x - v.w * c1.y, v.w * c1.x + v.z * c1.y};
                }
                ::u32x2 w; w.x = pk2(v.x, v.y); w.y = pk2(v.z, v.w);
                if (col >= C_KI && col < C_WI) {
                    { const int b = row / SEQ, t = row - b * SEQ + NMETA, d0 = col - C_KI;
                        *(::u32x2*)(KIP + (size_t)b * KIP_BATCH + (size_t)((((t >> 5) * 4 + (d0 >> 4)) * 2 + ((d0 >> 3) & 1)) * 512 + (t & 31) * 16 + (d0 & 7) * 2)) = w; }
                } else *(::u32x2*)(P + (size_t)trow * PW + col) = w;
            })
    }
};
struct EpiGate {
    static constexpr bool PERM = false, AFTER_DRAIN = false;
    bf16_t* G;
    __device__ __forceinline__ void operator()(const f32x4 (&acc)[2][2][4][2], const Unit& u, int wr, int wc, int fr, int fq) const {
        PG8_FOR_FRAGS( ::u32x2 w; w.x = pk2(sigmoidf(v.x), sigmoidf(v.y)); w.y = pk2(sigmoidf(v.z), sigmoidf(v.w)); *(::u32x2*)(G + (size_t)row * 2048 + col) = w; )
    }
};
template <bool ACCUM> struct EpiZ {
    static constexpr bool PERM = false, AFTER_DRAIN = false;
    bf16_t* Z; const bf16_t* G; int goff;
    __device__ __forceinline__ void operator()(const f32x4 (&acc)[2][2][4][2], const Unit& u, int wr, int wc, int fr, int fq) const {
        PG8_FOR_FRAGS(
            const ::u32x2 g = *(const ::u32x2*)(G + (size_t)row * 2048 + goff + col);
            ::f32x4 z = (::f32x4){bflo(g.x) * v.x, bfhi(g.x) * v.y, bflo(g.y) * v.z, bfhi(g.y) * v.w};
            ::u32x2* zp = (::u32x2*)(Z + (size_t)row * D + col);
            if (ACCUM) { const ::u32x2 o = *zp; z.x += bflo(o.x); z.y += bfhi(o.x); z.z += bflo(o.y); z.w += bfhi(o.y); }
            ::u32x2 w; w.x = pk2(z.x, z.y); w.y = pk2(z.z, z.w); *zp = w; )
    }
};
struct EpiH1 {
    static constexpr bool PERM = false, AFTER_DRAIN = false;
    float* H1; const float* meta; const float* x;
    __device__ __forceinline__ void operator()(const f32x4 (&acc)[2][2][4][2], const Unit& u, int wr, int wc, int fr, int fq) const {
        PG8_FOR_FRAGS( const ::f32x4 h = *(const ::f32x4*)(x + (size_t)row * D + col); *(::f32x4*)(H1 + (size_t)row * D + col) = h + v; )
    }
};
#undef PG8_FOR_FRAGS

template <class Epi, class Sched, bool ALIGN_EPI = false, bool SP2 = false>
__device__ __forceinline__ void gemm_phase(PG8_LAS unsigned char* lds, const Gemm g, const Sched& S, const Epi& E) {
    const int tid = threadIdx.x, wid = __builtin_amdgcn_readfirstlane(tid >> 6), lane = tid & 63, wr = wid >> 2, wc = wid & 3, fr = lane & 15, fq = lane >> 4;
    const int K = g.K, nt = K / BK;
    unsigned voffA[2], voffB[2];
#pragma unroll
    for (int i = 0; i < 2; ++i) { int R, C; stage_rc(tid * 16 + i * 8192, R, C); const int Rb = Epi::PERM ? ((R & ~31) + perm32(R & 31)) : R;
        voffA[i] = (unsigned)(R * K + C) * 2u; voffB[i] = (unsigned)(Rb * K + C) * 2u; }
    const size_t kstep = (size_t)(BK * 2);
    const size_t hstep = (size_t)HALF * K * 2;
    const size_t tstep = 2 * hstep;
    const unsigned ldsw = (unsigned)wid * 1024u;
    const int aoff = lds_byte(wr * 64 + fr, fq * 8), boff = lds_byte(wc * 32 + fr, fq * 8);
#define PG8_SA(b, h) (((b) * 2 + (h)) * HTB)
#define PG8_SB(b, h) ((4 + (b) * 2 + (h)) * HTB)
#define PG8_STAGE(bufoff, gbase, voff) do { _Pragma("unroll") for (int _i = 0; _i < 2; ++_i) \
        __builtin_amdgcn_global_load_lds((const unsigned*)((const char*)(gbase) + (voff)[_i]), (PG8_LAS unsigned*)(lds + (bufoff) + ldsw + _i * 8192), 16, 0, 0); } while (0)
#define PG8_LDA(dst, b, h) do { _Pragma("unroll") for (int m = 0; m < 4; ++m) _Pragma("unroll") for (int k = 0; k < 2; ++k) dst[m][k] = *(const PG8_LAS bf16x8*)(lds + PG8_SA(b, h) + aoff + m * 2048 + k * 1024); } while (0)
#define PG8_LDB(dst, b, h) do { _Pragma("unroll") for (int n = 0; n < 2; ++n) _Pragma("unroll") for (int k = 0; k < 2; ++k) dst[n][k] = *(const PG8_LAS bf16x8*)(lds + PG8_SB(b, h) + boff + n * 2048 + k * 1024); } while (0)
#define PG8_MMA(ai, bj, At, Bt) do { __builtin_amdgcn_s_setprio(1); _Pragma("unroll") for (int m = 0; m < 4; ++m) _Pragma("unroll") for (int n = 0; n < 2; ++n) _Pragma("unroll") for (int k = 0; k < 2; ++k) \
        acc[ai][bj][m][n] = __builtin_amdgcn_mfma_f32_16x16x32_bf16(Bt[n][k], At[m][k], acc[ai][bj][m][n], 0, 0, 0); __builtin_amdgcn_s_setprio(0); } while (0)
#define PG8_WAIT_V(n) asm volatile("s_waitcnt vmcnt(" #n ")" ::: "memory")
#define PG8_WAIT_L(n) asm volatile("s_waitcnt lgkmcnt(" #n ")" ::: "memory")
#define PG8_BAR __builtin_amdgcn_s_barrier()
#define PG8_SCHED __builtin_amdgcn_sched_barrier(0)
    Unit cur, nxt; int ui = 0;
    if (!S.next(0, cur)) return;
    f32x4 acc[2][2][4][2];
#pragma unroll
    for (int a = 0; a < 2; ++a)
#pragma unroll
        for (int b = 0; b < 2; ++b)
#pragma unroll
            for (int m = 0; m < 4; ++m)
#pragma unroll
                for (int n = 0; n < 2; ++n) acc[a][b][m][n] = (f32x4){0.f, 0.f, 0.f, 0.f};
    bf16x8 At[4][2], B0[2][2], B1[2][2];
    const char* cA = (const char*)g.A + (size_t)cur.pm * tstep; const char* cB = (const char*)g.Bt + (size_t)cur.pn * tstep;
    S.a_ready(cur);
    if constexpr (SP2) {
        PG8_STAGE(PG8_SB(0, 0), cB, voffB); PG8_STAGE(PG8_SB(0, 1), cB + hstep, voffB); PG8_STAGE(PG8_SA(0, 0), cA, voffA); PG8_STAGE(PG8_SA(0, 1), cA + hstep, voffA);
        if (wr == 1) PG8_BAR;
        PG8_WAIT_V(2); PG8_BAR;
        PG8_STAGE(PG8_SB(1, 0), cB + kstep, voffB); PG8_STAGE(PG8_SA(1, 0), cA + kstep, voffA); PG8_STAGE(PG8_SB(1, 1), cB + hstep + kstep, voffB);
        PG8_WAIT_V(6); PG8_BAR;
    } else {
        PG8_STAGE(PG8_SB(0, 0), cB, voffB); PG8_STAGE(PG8_SA(0, 0), cA, voffA); PG8_STAGE(PG8_SB(0, 1), cB + hstep, voffB); PG8_STAGE(PG8_SA(0, 1), cA + hstep, voffA);
        if (wr == 1) PG8_BAR;
        PG8_WAIT_V(4); PG8_BAR;
        PG8_STAGE(PG8_SB(1, 0), cB + kstep, voffB); PG8_STAGE(PG8_SA(1, 0), cA + kstep, voffA); PG8_STAGE(PG8_SB(1, 1), cB + hstep + kstep, voffB);
        PG8_WAIT_V(6); PG8_BAR;
    }
    for (;;) {
        const bool has_next = S.next(ui + 1, nxt);
        const char* nA = has_next ? (const char*)g.A + (size_t)nxt.pm * tstep : cA; const char* nB = has_next ? (const char*)g.Bt + (size_t)nxt.pn * tstep : cB;
        for (int t = 0; t < nt; t += 2) {
            const bool last = (t == nt - 2);
            const char* a1 = cA + (size_t)(t + 1) * kstep;
            const char* a2 = last ? nA : cA + (size_t)(t + 2) * kstep; const char* b2 = last ? nB : cB + (size_t)(t + 2) * kstep;
            const char* a3 = a2 + kstep; const char* b3 = b2 + kstep;
            if (last && has_next) S.a_ready(nxt);
            if constexpr (SP2) {
            PG8_LDB(B0, 0, 0); PG8_LDB(B1, 0, 1); PG8_SCHED; PG8_LDA(At, 0, 0); PG8_STAGE(PG8_SA(1, 1), a1 + hstep, voffA);
            PG8_WAIT_V(8); PG8_WAIT_L(0); PG8_BAR; PG8_MMA(0, 0, At, B0); PG8_MMA(0, 1, At, B1); PG8_BAR; PG8_SCHED;
            PG8_LDA(At, 0, 1); PG8_STAGE(PG8_SB(0, 0), b2, voffB); PG8_STAGE(PG8_SB(0, 1), b2 + hstep, voffB); PG8_STAGE(PG8_SA(0, 0), a2, voffA);
            PG8_WAIT_V(8); PG8_WAIT_L(0); PG8_BAR; PG8_MMA(1, 0, At, B0); PG8_MMA(1, 1, At, B1); PG8_BAR; PG8_SCHED;
            PG8_LDB(B0, 1, 0); PG8_LDB(B1, 1, 1); PG8_SCHED; PG8_LDA(At, 1, 0); PG8_STAGE(PG8_SA(0, 1), a2 + hstep, voffA);
            PG8_WAIT_V(8); PG8_WAIT_L(0); PG8_BAR; PG8_MMA(0, 0, At, B0); PG8_MMA(0, 1, At, B1); PG8_BAR; PG8_SCHED;
            PG8_LDA(At, 1, 1); PG8_STAGE(PG8_SB(1, 0), b3, voffB); PG8_STAGE(PG8_SB(1, 1), b3 + hstep, voffB); PG8_STAGE(PG8_SA(1, 0), a3, voffA);
            PG8_WAIT_V(8); PG8_WAIT_L(0); PG8_BAR; PG8_MMA(1, 0, At, B0); PG8_MMA(1, 1, At, B1); PG8_BAR; PG8_SCHED;
            } else {
            PG8_LDB(B0, 0, 0); PG8_SCHED; PG8_LDA(At, 0, 0); PG8_STAGE(PG8_SA(1, 1), a1 + hstep, voffA);
            PG8_WAIT_L(8); PG8_BAR; PG8_WAIT_L(0); PG8_MMA(0, 0, At, B0); PG8_BAR; PG8_SCHED;
            PG8_LDB(B1, 0, 1); PG8_STAGE(PG8_SB(0, 0), b2, voffB);
            PG8_BAR; PG8_WAIT_L(0); PG8_MMA(0, 1, At, B1); PG8_BAR;
            PG8_LDA(At, 0, 1); PG8_STAGE(PG8_SA(0, 0), a2, voffA);
            PG8_BAR; PG8_WAIT_L(0); PG8_MMA(1, 0, At, B0); PG8_BAR; PG8_SCHED;
            PG8_STAGE(PG8_SB(0, 1), b2 + hstep, voffB);
            PG8_WAIT_V(6); PG8_BAR; PG8_MMA(1, 1, At, B1); PG8_BAR;
            PG8_LDB(B0, 1, 0); PG8_SCHED; PG8_LDA(At, 1, 0); PG8_STAGE(PG8_SA(0, 1), a2 + hstep, voffA);
            PG8_WAIT_L(8); PG8_BAR; PG8_WAIT_L(0); PG8_MMA(0, 0, At, B0); PG8_BAR; PG8_SCHED;
            PG8_LDB(B1, 1, 1); PG8_STAGE(PG8_SB(1, 0), b3, voffB);
            PG8_BAR; PG8_WAIT_L(0); PG8_MMA(0, 1, At, B1); PG8_BAR;
            PG8_LDA(At, 1, 1); PG8_STAGE(PG8_SA(1, 0), a3, voffA);
            PG8_BAR; PG8_WAIT_L(0); PG8_MMA(1, 0, At, B0); PG8_BAR; PG8_SCHED;
            PG8_STAGE(PG8_SB(1, 1), b3 + hstep, voffB);
            PG8_WAIT_V(6); PG8_BAR; PG8_MMA(1, 1, At, B1); PG8_BAR;
            }
        }
        if constexpr (ALIGN_EPI) { if (wr == 0) PG8_BAR; }
        if constexpr (!Epi::AFTER_DRAIN) { E(acc, cur, wr, wc, fr, fq); S.done(cur); }
        if (!has_next) break;
#pragma unroll
        for (int a = 0; a < 2; ++a)
#pragma unroll
            for (int b = 0; b < 2; ++b)
#pragma unroll
                for (int m = 0; m < 4; ++m)
#pragma unroll
                    for (int n = 0; n < 2; ++n) acc[a][b][m][n] = (f32x4){0.f, 0.f, 0.f, 0.f};
        cur = nxt; cA = nA; cB = nB; ++ui;
        if constexpr (ALIGN_EPI) { if (wr == 1) PG8_BAR; }
    }
    PG8_WAIT_V(0);
    if constexpr (!ALIGN_EPI) { if (wr == 0) PG8_BAR; }
    PG8_BAR;
    if constexpr (Epi::AFTER_DRAIN) { E.fused(acc, cur, wr, wc, fr, fq, lds, wid, lane); S.done(cur); }
#undef PG8_SA
#undef PG8_SB
#undef PG8_STAGE
#undef PG8_LDA
#undef PG8_LDB
#undef PG8_MMA
#undef PG8_WAIT_V
#undef PG8_WAIT_L
#undef PG8_BAR
#undef PG8_SCHED
}
template <class Epi, class Sched, bool ALIGN_EPI = false, bool SP2 = false>
__device__ __forceinline__ void gemm_phase_x(PG8_LAS unsigned char* lds, const int K, const Sched& S, const Epi& E) {
    const int tid = threadIdx.x, wid = __builtin_amdgcn_readfirstlane(tid >> 6), lane = tid & 63, wr = wid >> 2, wc = wid & 3, fr = lane & 15, fq = lane >> 4;
    const int nt = K / BK;
    unsigned vcA[2][2], vnA[2][2], voffB[2];
#pragma unroll
    for (int i = 0; i < 2; ++i) { int R, C; stage_rc(tid * 16 + i * 8192, R, C); const int Rb = Epi::PERM ? ((R & ~31) + perm32(R & 31)) : R;
        voffB[i] = (unsigned)(Rb * K + C) * 2u; }
    const size_t kstep = (size_t)(BK * 2);
    const size_t hstep = (size_t)HALF * K * 2;
    const unsigned ldsw = (unsigned)wid * 1024u;
    const int aoff = lds_byte(wr * 64 + fr, fq * 8), boff = lds_byte(wc * 32 + fr, fq * 8);
#define PG8_SA(b, h) (((b) * 2 + (h)) * HTB)
#define PG8_SB(b, h) ((4 + (b) * 2 + (h)) * HTB)
#define PG8_STAGE(bufoff, gbase, voff) do { _Pragma("unroll") for (int _i = 0; _i < 2; ++_i) \
        __builtin_amdgcn_global_load_lds((const unsigned*)((const char*)(gbase) + (voff)[_i]), (PG8_LAS unsigned*)(lds + (bufoff) + ldsw + _i * 8192), 16, 0, 0); } while (0)
#define PG8_STAGEA(bufoff, gbase, V, h) do { _Pragma("unroll") for (int _i = 0; _i < 2; ++_i) \
        __builtin_amdgcn_global_load_lds((const unsigned*)((const char*)(gbase) + (V)[h][_i]), (PG8_LAS unsigned*)(lds + (bufoff) + ldsw + _i * 8192), 16, 0, 0); } while (0)
#define PG8_STAGEA2(bufoff, gbase, h) do { _Pragma("unroll") for (int _i = 0; _i < 2; ++_i) \
        __builtin_amdgcn_global_load_lds((const unsigned*)((const char*)(gbase) + (last ? vnA[h][_i] : vcA[h][_i])), (PG8_LAS unsigned*)(lds + (bufoff) + ldsw + _i * 8192), 16, 0, 0); } while (0)
#define PG8_AOFF(V, u) do { _Pragma("unroll") for (int _h = 0; _h < 2; ++_h) _Pragma("unroll") for (int _i = 0; _i < 2; ++_i) { int R_, C_; stage_rc(tid * 16 + _i * 8192, R_, C_); (V)[_h][_i] = S.a_off(u, _h * HALF + R_, C_); } } while (0)
#define PG8_LDA(dst, b, h) do { _Pragma("unroll") for (int m = 0; m < 4; ++m) _Pragma("unroll") for (int k = 0; k < 2; ++k) dst[m][k] = *(const PG8_LAS bf16x8*)(lds + PG8_SA(b, h) + aoff + m * 2048 + k * 1024); } while (0)
#define PG8_LDB(dst, b, h) do { _Pragma("unroll") for (int n = 0; n < 2; ++n) _Pragma("unroll") for (int k = 0; k < 2; ++k) dst[n][k] = *(const PG8_LAS bf16x8*)(lds + PG8_SB(b, h) + boff + n * 2048 + k * 1024); } while (0)
#define PG8_MMA(ai, bj, At, Bt) do { __builtin_amdgcn_s_setprio(1); _Pragma("unroll") for (int m = 0; m < 4; ++m) _Pragma("unroll") for (int n = 0; n < 2; ++n) _Pragma("unroll") for (int k = 0; k < 2; ++k) \
        acc[ai][bj][m][n] = __builtin_amdgcn_mfma_f32_16x16x32_bf16(Bt[n][k], At[m][k], acc[ai][bj][m][n], 0, 0, 0); __builtin_amdgcn_s_setprio(0); } while (0)
#define PG8_WAIT_V(n) asm volatile("s_waitcnt vmcnt(" #n ")" ::: "memory")
#define PG8_WAIT_L(n) asm volatile("s_waitcnt lgkmcnt(" #n ")" ::: "memory")
#define PG8_BAR __builtin_amdgcn_s_barrier()
#define PG8_SCHED __builtin_amdgcn_sched_barrier(0)
    Unit cur, nxt; int ui = 0;
    if (!S.next(0, cur)) return;
    f32x4 acc[2][2][4][2];
#pragma unroll
    for (int a = 0; a < 2; ++a)
#pragma unroll
        for (int b = 0; b < 2; ++b)
#pragma unroll
            for (int m = 0; m < 4; ++m)
#pragma unroll
                for (int n = 0; n < 2; ++n) acc[a][b][m][n] = (f32x4){0.f, 0.f, 0.f, 0.f};
    bf16x8 At[4][2], B0[2][2], B1[2][2];
    const char* cA = S.a_base(cur); const char* cB = S.b_base(cur);
    PG8_AOFF(vcA, cur);
    S.a_ready(cur);
    if constexpr (SP2) {
        PG8_STAGE(PG8_SB(0, 0), cB, voffB); PG8_STAGE(PG8_SB(0, 1), cB + hstep, voffB); PG8_STAGEA(PG8_SA(0, 0), cA, vcA, 0); PG8_STAGEA(PG8_SA(0, 1), cA, vcA, 1);
        if (wr == 1) PG8_BAR;
        PG8_WAIT_V(2); PG8_BAR;
        PG8_STAGE(PG8_SB(1, 0), cB + kstep, voffB); PG8_STAGEA(PG8_SA(1, 0), cA + kstep, vcA, 0); PG8_STAGE(PG8_SB(1, 1), cB + hstep + kstep, voffB);
        PG8_WAIT_V(6); PG8_BAR;
    } else {
        PG8_STAGE(PG8_SB(0, 0), cB, voffB); PG8_STAGEA(PG8_SA(0, 0), cA, vcA, 0); PG8_STAGE(PG8_SB(0, 1), cB + hstep, voffB); PG8_STAGEA(PG8_SA(0, 1), cA, vcA, 1);
        if (wr == 1) PG8_BAR;
        PG8_WAIT_V(4); PG8_BAR;
        PG8_STAGE(PG8_SB(1, 0), cB + kstep, voffB); PG8_STAGEA(PG8_SA(1, 0), cA + kstep, vcA, 0); PG8_STAGE(PG8_SB(1, 1), cB + hstep + kstep, voffB);
        PG8_WAIT_V(6); PG8_BAR;
    }
    for (;;) {
        const bool has_next = S.next(ui + 1, nxt);
        const char* nA = has_next ? S.a_base(nxt) : cA; const char* nB = has_next ? S.b_base(nxt) : cB;
        if (has_next) { PG8_AOFF(vnA, nxt); } else { _Pragma("unroll") for (int _h = 0; _h < 2; ++_h) _Pragma("unroll") for (int _i = 0; _i < 2; ++_i) vnA[_h][_i] = vcA[_h][_i]; }
        for (int t = 0; t < nt; t += 2) {
            const bool last = (t == nt - 2);
            const char* a1 = cA + (size_t)(t + 1) * kstep;
            const char* a2 = last ? nA : cA + (size_t)(t + 2) * kstep; const char* b2 = last ? nB : cB + (size_t)(t + 2) * kstep;
            const char* a3 = a2 + kstep; const char* b3 = b2 + kstep;
            if (last && has_next) S.a_ready(nxt);
            if constexpr (SP2) {
            PG8_LDB(B0, 0, 0); PG8_LDB(B1, 0, 1); PG8_SCHED; PG8_LDA(At, 0, 0); PG8_STAGEA(PG8_SA(1, 1), a1, vcA, 1);
            PG8_WAIT_V(8); PG8_WAIT_L(0); PG8_BAR; PG8_MMA(0, 0, At, B0); PG8_MMA(0, 1, At, B1); PG8_BAR; PG8_SCHED;
            PG8_LDA(At, 0, 1); PG8_STAGE(PG8_SB(0, 0), b2, voffB); PG8_STAGE(PG8_SB(0, 1), b2 + hstep, voffB); PG8_STAGEA2(PG8_SA(0, 0), a2, 0);
            PG8_WAIT_V(8); PG8_WAIT_L(0); PG8_BAR; PG8_MMA(1, 0, At, B0); PG8_MMA(1, 1, At, B1); PG8_BAR; PG8_SCHED;
            PG8_LDB(B0, 1, 0); PG8_LDB(B1, 1, 1); PG8_SCHED; PG8_LDA(At, 1, 0); PG8_STAGEA2(PG8_SA(0, 1), a2, 1);
            PG8_WAIT_V(8); PG8_WAIT_L(0); PG8_BAR; PG8_MMA(0, 0, At, B0); PG8_MMA(0, 1, At, B1); PG8_BAR; PG8_SCHED;
            PG8_LDA(At, 1, 1); PG8_STAGE(PG8_SB(1, 0), b3, voffB); PG8_STAGE(PG8_SB(1, 1), b3 + hstep, voffB); PG8_STAGEA2(PG8_SA(1, 0), a3, 0);
            PG8_WAIT_V(8); PG8_WAIT_L(0); PG8_BAR; PG8_MMA(1, 0, At, B0); PG8_MMA(1, 1, At, B1); PG8_BAR; PG8_SCHED;
            } else {
            PG8_LDB(B0, 0, 0); PG8_SCHED; PG8_LDA(At, 0, 0); PG8_STAGEA(PG8_SA(1, 1), a1, vcA, 1);
            PG8_WAIT_L(8); PG8_BAR; PG8_WAIT_L(0); PG8_MMA(0, 0, At, B0); PG8_BAR; PG8_SCHED;
            PG8_LDB(B1, 0, 1); PG8_STAGE(PG8_SB(0, 0), b2, voffB);
            PG8_BAR; PG8_WAIT_L(0); PG8_MMA(0, 1, At, B1); PG8_BAR;
            PG8_LDA(At, 0, 1); PG8_STAGEA2(PG8_SA(0, 0), a2, 0);
            PG8_BAR; PG8_WAIT_L(0); PG8_MMA(1, 0, At, B0); PG8_BAR; PG8_SCHED;
            PG8_STAGE(PG8_SB(0, 1), b2 + hstep, voffB);
            PG8_WAIT_V(6); PG8_BAR; PG8_MMA(1, 1, At, B1); PG8_BAR;
            PG8_LDB(B0, 1, 0); PG8_SCHED; PG8_LDA(At, 1, 0); PG8_STAGEA2(PG8_SA(0, 1), a2, 1);
            PG8_WAIT_L(8); PG8_BAR; PG8_WAIT_L(0); PG8_MMA(0, 0, At, B0); PG8_BAR; PG8_SCHED;
            PG8_LDB(B1, 1, 1); PG8_STAGE(PG8_SB(1, 0), b3, voffB);
            PG8_BAR; PG8_WAIT_L(0); PG8_MMA(0, 1, At, B1); PG8_BAR;
            PG8_LDA(At, 1, 1); PG8_STAGEA2(PG8_SA(1, 0), a3, 0);
            PG8_BAR; PG8_WAIT_L(0); PG8_MMA(1, 0, At, B0); PG8_BAR; PG8_SCHED;
            PG8_STAGE(PG8_SB(1, 1), b3 + hstep, voffB);
            PG8_WAIT_V(6); PG8_BAR; PG8_MMA(1, 1, At, B1); PG8_BAR;
            }
        }
        if constexpr (ALIGN_EPI) { if (wr == 0) PG8_BAR; }
        if constexpr (!Epi::AFTER_DRAIN) { E(acc, cur, wr, wc, fr, fq); S.done(cur); }
        if (!has_next) break;
#pragma unroll
        for (int a = 0; a < 2; ++a)
#pragma unroll
            for (int b = 0; b < 2; ++b)
#pragma unroll
                for (int m = 0; m < 4; ++m)
#pragma unroll
                    for (int n = 0; n < 2; ++n) acc[a][b][m][n] = (f32x4){0.f, 0.f, 0.f, 0.f};
        cur = nxt; cA = nA; cB = nB; ++ui;
        _Pragma("unroll") for (int _h = 0; _h < 2; ++_h) _Pragma("unroll") for (int _i = 0; _i < 2; ++_i) vcA[_h][_i] = vnA[_h][_i];
        if constexpr (ALIGN_EPI) { if (wr == 1) PG8_BAR; }
    }
    PG8_WAIT_V(0);
    if constexpr (!ALIGN_EPI) { if (wr == 0) PG8_BAR; }
    PG8_BAR;
    if constexpr (Epi::AFTER_DRAIN) { E.fused(acc, cur, wr, wc, fr, fq, lds, wid, lane); S.done(cur); }
#undef PG8_SA
#undef PG8_SB
#undef PG8_STAGE
#undef PG8_STAGEA
#undef PG8_STAGEA2
#undef PG8_AOFF
#undef PG8_LDA
#undef PG8_LDB
#undef PG8_MMA
#undef PG8_WAIT_V
#undef PG8_WAIT_L
#undef PG8_BAR
#undef PG8_SCHED
}


template <int WHICH> struct MoeOrder {
    const int* TP; int G, c; const char* Abase; const char* Bbase; const int* LIST;
    static constexpr int KK = WHICH == 0 ? 1024 : 512, NN = 4;
    __device__ __forceinline__ bool next(int i, Unit& u) const {
        const int L = i * G + c; if (L >= TP[NEXP]) return false;
        int e = 0;
#pragma unroll 1
        for (int j = 16; j >= 1; j >>= 1) if (TP[e + j] <= L) e += j;
        const int lt = L - TP[e]; u.pm = e * 1024 + lt / NN; u.pn = lt % NN; return true;
    }
    __device__ __forceinline__ const char* a_base(const Unit& u) const { const int e = u.pm >> 10, mt = u.pm & 1023; return WHICH == 0 ? Abase : Abase + (size_t)(TP[64 + e] + mt * 256) * (DEXP * 2); }
    __device__ __forceinline__ const char* b_base(const Unit& u) const { const int e = u.pm >> 10; return Bbase + ((size_t)e * 1024 + (size_t)u.pn * 256) * (KK * 2); }
    __device__ __forceinline__ unsigned a_off(const Unit& u, int r, int C) const {
        if (WHICH == 1) return (unsigned)(r * DEXP + C) * 2u;
        const int e = u.pm >> 10, s = (u.pm & 1023) * 256 + r; const int tok = s < TP[128 + e] ? (LIST[(size_t)e * NR + s] >> 1) : 0;
        return (unsigned)tok * (D * 2) + (unsigned)C * 2u;
    }
    __device__ __forceinline__ void a_ready(const Unit&) const {}
    __device__ __forceinline__ void done(const Unit&) const {}
};
struct TokRowOrder : StaticOrder {
    const char* Abase; const char* Bbase; int K;
    __device__ __forceinline__ const char* a_base(const Unit& u) const { return Abase + (size_t)tokrow(u.pm * BM) * K * 2; }
    __device__ __forceinline__ const char* b_base(const Unit& u) const { return Bbase + (size_t)u.pn * BM * K * 2; }
    __device__ __forceinline__ unsigned a_off(const Unit&, int r, int C) const { return (unsigned)(r * K + C) * 2u; }
};
#define PG8_FOR_FRAGS_M(...) _Pragma("unroll") for (int ai = 0; ai < 2; ++ai) _Pragma("unroll") for (int m = 0; m < 4; ++m) { const int r = ai * HALF + wr * 64 + m * 16 + fr; \
    _Pragma("unroll") for (int bj = 0; bj < 2; ++bj) _Pragma("unroll") for (int n = 0; n < 2; ++n) { const int col = u.pn * BM + bj * HALF + wc * 32 + n * 16 + 4 * fq; ::f32x4 v = acc[ai][bj][m][n]; __VA_ARGS__ } }
struct EpiMoe1 {
    static constexpr bool PERM = false, AFTER_DRAIN = false;
    bf16_t* HID; const int* TP;
    __device__ __forceinline__ void operator()(const f32x4 (&acc)[2][2][4][2], const Unit& u, int wr, int wc, int fr, int fq) const {
        const int e = u.pm >> 10, mt = u.pm & 1023; bf16_t* base = HID + (size_t)(TP[64 + e] + mt * 256) * DEXP;
        PG8_FOR_FRAGS_M( const float h0 = v.x / (1.f + __expf(-v.x)) * v.y, h1 = v.z / (1.f + __expf(-v.z)) * v.w; *(unsigned*)(base + (size_t)r * DEXP + (col >> 1)) = pk2(h0, h1); )
    }
};
struct EpiMoe2 {
    static constexpr bool PERM = false, AFTER_DRAIN = false;
    bf16_t* MO; const int* TP; const int* LIST; const float* GATE;
    __device__ __forceinline__ void operator()(const f32x4 (&acc)[2][2][4][2], const Unit& u, int wr, int wc, int fr, int fq) const {
        const int e = u.pm >> 10, mt = u.pm & 1023, cnt = TP[128 + e];
#pragma unroll
        for (int ai = 0; ai < 2; ++ai)
#pragma unroll
            for (int m = 0; m < 4; ++m) {
                const int s = mt * 256 + ai * HALF + wr * 64 + m * 16 + fr;
                if (s < cnt) {
                    const int ent = LIST[(size_t)e * NR + s]; const float gt = GATE[ent]; bf16_t* row = MO + (size_t)ent * D;
#pragma unroll
                    for (int bj = 0; bj < 2; ++bj)
#pragma unroll
                        for (int n = 0; n < 2; ++n) { const int col = u.pn * BM + bj * HALF + wc * 32 + n * 16 + 4 * fq; const ::f32x4 v = acc[ai][bj][m][n];
                            ::u32x2 w; w.x = pk2(v.x * gt, v.y * gt); w.y = pk2(v.z * gt, v.w * gt); *(::u32x2*)(row + col) = w; }
                }
            }
    }
};
#undef PG8_FOR_FRAGS_M
}
constexpr int SB_NQT = SEQ / 32;
constexpr int SB_VT_STRIDE = 40;
__device__ __forceinline__ void phase_sb_fast(const Params& p, char* lds) {
    const bf16_t* P = (const bf16_t*)(p.ws + WS_P); bf16_t* YA = (bf16_t*)(p.ws + WS_YA);
    const int tid = threadIdx.x, lane = tid & 63, wave = tid >> 6, n = lane & 31, hh = lane >> 5;
    bf16_t* VT = (bf16_t*)(lds + wave * (64 * SB_VT_STRIDE * 2));
    const int gw = blockIdx.x * NWAVES + wave, NGW = gridDim.x * NWAVES;
    for (int unit = gw; unit < 64 * SB_NQT; unit += NGW) {
        const int qt = SB_NQT - 1 - unit / 64, bh = unit % 64, h = bh & 7, b = bh >> 3;
        const int i0 = NMETA + qt * 32, qi = i0 + n, qrow = qi;
        const bf16_t* Pb = P + (size_t)b * T * PW;
        bf16x8 qf[4];
#pragma unroll
        for (int s = 0; s < 4; ++s) qf[s] = *(const bf16x8*)(Pb + (size_t)qrow * PW + C_QA + h * 64 + 16 * s + 8 * hh);
        f32x16 o0, o1;
#pragma unroll
        for (int r = 0; r < 16; ++r) { o0[r] = 0.f; o1[r] = 0.f; }
        float L = 0.f;
        for (int kt = qt + 1; kt >= 0; --kt) {
            const int j0 = kt * 32, krow = (j0 + n) < T ? (j0 + n) : T - 1;
            bf16x8 kf[4];
#pragma unroll
            for (int s = 0; s < 4; ++s) kf[s] = *(const bf16x8*)(Pb + (size_t)krow * PW + C_KA + h * 64 + 16 * s + 8 * hh);
#pragma unroll
            for (int i = 0; i < 4; ++i) {
                const int c = lane + 64 * i, key = c >> 3, d0 = (c & 7) * 8, vrow = (j0 + key) < T ? (j0 + key) : T - 1;
                const u32x4 w = *(const u32x4*)(Pb + (size_t)vrow * PW + C_VA + h * 64 + d0);
                bf16_t* vp = VT + d0 * SB_VT_STRIDE + key;
                vp[0] = (bf16_t)(w.x & 0xffff); vp[SB_VT_STRIDE] = (bf16_t)(w.x >> 16); vp[2 * SB_VT_STRIDE] = (bf16_t)(w.y & 0xffff); vp[3 * SB_VT_STRIDE] = (bf16_t)(w.y >> 16);
                vp[4 * SB_VT_STRIDE] = (bf16_t)(w.z & 0xffff); vp[5 * SB_VT_STRIDE] = (bf16_t)(w.z >> 16); vp[6 * SB_VT_STRIDE] = (bf16_t)(w.w & 0xffff); vp[7 * SB_VT_STRIDE] = (bf16_t)(w.w >> 16);
            }
            f32x16 sa;
#pragma unroll
            for (int r = 0; r < 16; ++r) sa[r] = 0.f;
#pragma unroll
            for (int s = 0; s < 4; ++s) sa = __builtin_amdgcn_mfma_f32_32x32x16_bf16(kf[s], qf[s], sa, 0, 0, 0);
            float lk[16], z[16];
#pragma unroll
            for (int r = 0; r < 16; ++r) {
                const int kk = (r & 3) + 8 * (r >> 2) + 4 * hh; const bool valid = (j0 + kk) < qi;
                const float zz = fminf(sa[r], 80.f); const float l = -__log2f(1.f + exp2f(zz));
                z[r] = zz; lk[r] = valid ? l : 0.f;
            }
            const float gs0 = (lk[0] + lk[1]) + (lk[2] + lk[3]), gs1 = (lk[4] + lk[5]) + (lk[6] + lk[7]), gs2 = (lk[8] + lk[9]) + (lk[10] + lk[11]), gs3 = (lk[12] + lk[13]) + (lk[14] + lk[15]);
            const float ps0 = __shfl_xor(gs0, 32), ps1 = __shfl_xor(gs1, 32), ps2 = __shfl_xor(gs2, 32), ps3 = __shfl_xor(gs3, 32);
            const float pc3 = ps3, pc2 = pc3 + ps2, pc1 = pc2 + ps1, pc0 = pc1 + ps0;
            float base[4];
            base[3] = L + (hh ? 0.f : pc3);
            base[2] = L + gs3 + (hh ? pc3 : pc2);
            base[1] = L + (gs3 + gs2) + (hh ? pc2 : pc1);
            base[0] = L + (gs3 + gs2 + gs1) + (hh ? pc1 : pc0);
            float a[16];
#pragma unroll
            for (int g = 0; g < 4; ++g) {
                float c = base[g];
#pragma unroll
                for (int e = 3; e >= 0; --e) {
                    const int r = 4 * g + e; c += lk[r];
                    const int kk = e + 8 * g + 4 * hh; const bool valid = (j0 + kk) < qi;
                    a[r] = valid ? exp2f(z[r] + c) : 0.f;
                }
            }
            L += (gs0 + gs1 + gs2 + gs3) + pc0;
            u32x4 pw0, pw1;
            pw0.x = pk2(a[0], a[1]); pw0.y = pk2(a[2], a[3]); pw0.z = pk2(a[4], a[5]); pw0.w = pk2(a[6], a[7]);
            pw1.x = pk2(a[8], a[9]); pw1.y = pk2(a[10], a[11]); pw1.z = pk2(a[12], a[13]); pw1.w = pk2(a[14], a[15]);
            const bf16x8 pf0 = __builtin_bit_cast(bf16x8, pw0), pf1 = __builtin_bit_cast(bf16x8, pw1);
#pragma unroll
            for (int mt = 0; mt < 2; ++mt) {
                const bf16_t* vr = VT + (32 * mt + n) * SB_VT_STRIDE + 4 * hh;
                u32x4 v0, v1;
                { const u32x2 x = *(const u32x2*)(vr), y = *(const u32x2*)(vr + 8); v0.x = x.x; v0.y = x.y; v0.z = y.x; v0.w = y.y; }
                { const u32x2 x = *(const u32x2*)(vr + 16), y = *(const u32x2*)(vr + 24); v1.x = x.x; v1.y = x.y; v1.z = y.x; v1.w = y.y; }
                if (mt == 0) { o0 = __builtin_amdgcn_mfma_f32_32x32x16_bf16(__builtin_bit_cast(bf16x8, v0), pf0, o0, 0, 0, 0); o0 = __builtin_amdgcn_mfma_f32_32x32x16_bf16(__builtin_bit_cast(bf16x8, v1), pf1, o0, 0, 0, 0); }
                else { o1 = __builtin_amdgcn_mfma_f32_32x32x16_bf16(__builtin_bit_cast(bf16x8, v0), pf0, o1, 0, 0, 0); o1 = __builtin_amdgcn_mfma_f32_32x32x16_bf16(__builtin_bit_cast(bf16x8, v1), pf1, o1, 0, 0, 0); }
            }
            const bool done = L < -152.f;
            if (__all(done)) break;
        }
        {
            bf16_t* yp = YA + ((size_t)b * SEQ + (qi - NMETA)) * 512 + h * 64 + 4 * hh;
#pragma unroll
            for (int g = 0; g < 4; ++g) {
                u32x2 w; w.x = pk2(o0[4 * g], o0[4 * g + 1]); w.y = pk2(o0[4 * g + 2], o0[4 * g + 3]); *(u32x2*)(yp + 8 * g) = w;
                w.x = pk2(o1[4 * g], o1[4 * g + 1]); w.y = pk2(o1[4 * g + 2], o1[4 * g + 3]); *(u32x2*)(yp + 32 + 8 * g) = w;
            }
        }
    }
}

constexpr int DSA_NQ = 8;
constexpr int DSA_SCS = 4128;
constexpr int DSA_KVB = 0, DSA_RING = 18432, DSA_IDX = DSA_NQ * DSA_RING, DSA_MISC = DSA_IDX + DSA_NQ * 1024, DSA_LDS = DSA_MISC + 512;
static_assert(DSA_NQ * DSA_SCS * 4 <= DSA_IDX, "score rows fit under the index lists");
__device__ __forceinline__ unsigned fkey(float f) { const unsigned u = __float_as_uint(f); return (u & 0x80000000u) ? ~u : (u | 0x80000000u); }
__device__ __forceinline__ int mbcnt64(unsigned long long m) { return (int)__builtin_amdgcn_mbcnt_hi((unsigned)(m >> 32), __builtin_amdgcn_mbcnt_lo((unsigned)m, 0u)); }
__device__ __forceinline__ void phase_dsa(const Params& p, char* lds) {
    const bf16_t* P = (const bf16_t*)(p.ws + WS_P); bf16_t* OL = (bf16_t*)(p.ws + WS_OLAT);
    const int tid = threadIdx.x, lane = tid & 63, wave = __builtin_amdgcn_readfirstlane(tid >> 6);
    unsigned* SC = (unsigned*)(lds + DSA_KVB);
    unsigned short* IDX = (unsigned short*)(lds + DSA_IDX);
    int* MISC = (int*)(lds + DSA_MISC);
    const unsigned lds_base = (unsigned)(size_t)lds;
    constexpr int NU = SEQ / DSA_NQ;
    for (int unit = blockIdx.x; unit < BATCH * NU; unit += gridDim.x) {
        const int u8 = NU - 1 - unit / BATCH, b = unit % BATCH, t0 = NMETA + u8 * DSA_NQ;
        const int cid = 1 + (t0 - NMETA) / 64, n = NMETA + 64 * cid;
        const bf16_t* Pb = P + (size_t)b * T * PW;
        __syncthreads();
        {
            const int m = lane & 31, hh = lane >> 5;
            bf16x8 aq[2][4]; float wv[2][16];
#pragma unroll
            for (int rt = 0; rt < 2; ++rt) {
#pragma unroll
                for (int s = 0; s < 4; ++s) aq[rt][s] = *(const bf16x8*)(Pb + (size_t)(t0 + 4 * rt + (m >> 3)) * PW + C_QI + (m & 7) * 64 + 16 * s + 8 * hh);
#pragma unroll
                for (int r = 0; r < 16; ++r) wv[rt][r] = bf2f(Pb[(size_t)(t0 + 4 * rt + (r >> 2)) * PW + C_WI + (r & 3) + 4 * hh]);
            }
            const int ntile = (n + 31) / 32;
            const unsigned char* KIPb = p.ws + WS_KIP + (size_t)b * KIP_BATCH + lane * 16;
            bf16x8 bk[4];
#pragma unroll
            for (int s = 0; s < 4; ++s) bk[s] = *(const bf16x8*)(KIPb + (size_t)wave * 4096 + s * 1024);
            for (int kt = wave; kt < ntile; kt += NWAVES) {
                const int j0 = kt * 32, key = j0 + m;
                bf16x8 bn[4];
                { const int ktn = kt + NWAVES < 129 ? kt + NWAVES : 128;
#pragma unroll
                  for (int s = 0; s < 4; ++s) bn[s] = *(const bf16x8*)(KIPb + (size_t)ktn * 4096 + s * 1024); }
                const bool ok = key < n;
#pragma unroll
                for (int rt = 0; rt < 2; ++rt) {
                    f32x16 acc;
#pragma unroll
                    for (int r = 0; r < 16; ++r) acc[r] = 0.f;
#pragma unroll
                    for (int s = 0; s < 4; ++s) acc = __builtin_amdgcn_mfma_f32_32x32x16_bf16(aq[rt][s], bk[s], acc, 0, 0, 0);
                    float tq[4];
#pragma unroll
                    for (int q = 0; q < 4; ++q) {
                        float s = wv[rt][4 * q] * fmaxf(acc[4 * q], 0.f); s += wv[rt][4 * q + 1] * fmaxf(acc[4 * q + 1], 0.f); s += wv[rt][4 * q + 2] * fmaxf(acc[4 * q + 2], 0.f); s += wv[rt][4 * q + 3] * fmaxf(acc[4 * q + 3], 0.f);
                        tq[q] = s + __shfl_xor(s, 32);
                    }
                    const float s0 = hh ? tq[2] : tq[0], s1 = hh ? tq[3] : tq[1];
                    SC[(4 * rt + 2 * hh) * DSA_SCS + key] = ok ? fkey(s0) : 0u;
                    SC[(4 * rt + 2 * hh + 1) * DSA_SCS + key] = ok ? fkey(s1) : 0u;
                }
#pragma unroll
                for (int s = 0; s < 4; ++s) bk[s] = bn[s];
            }
        }
        __syncthreads();
        {
            unsigned* sc = SC + wave * DSA_SCS;
            unsigned v[65];
#pragma unroll
            for (int i = 0; i < 65; ++i) { const int k = i * 64 + lane; v[i] = (k < n) ? sc[k] : 0u; }
            unsigned prefix = 0u; int cge = n, bit = 31;
            if (n >= 256) {
                for (; bit >= 0 && cge > 512; --bit) {
                    const unsigned cand = prefix | (1u << bit); int c = 0;
#pragma unroll
                    for (int gi = 0; gi < 5; ++gi) if (gi * 832 < n) {
#pragma unroll
                        for (int i = 13 * gi; i < 13 * gi + 13; ++i) { c += __popcll(__ballot(v[i] >= cand)); if ((i & 3) == 3) __builtin_amdgcn_sched_barrier(0); }
                        __builtin_amdgcn_sched_barrier(0);
                    }
                    if (c >= 256) { prefix = cand; cge = c; }
                }
            }
            int ngt = n;
            if (n >= 256) {
                asm volatile("s_waitcnt lgkmcnt(0)" ::: "memory");
                int cb = 0;
                if (bit >= 0) {
#pragma unroll
                    for (int gi = 0; gi < 5; ++gi) if (gi * 832 < n) {
#pragma unroll
                        for (int i = 13 * gi; i < 13 * gi + 13; ++i) {
                            const unsigned u = v[i]; const bool in = u >= prefix && u != 0u; const unsigned long long mk = __ballot(in);
                            sc[in ? cb + mbcnt64(mk) : 4096 + (lane & 15)] = u;
                            cb += __popcll(mk);
                            __builtin_amdgcn_sched_barrier(0);
                        }
                    }
                    asm volatile("s_waitcnt lgkmcnt(0)" ::: "memory");
                    unsigned w[8];
#pragma unroll
                    for (int j = 0; j < 8; ++j) { const int k = j * 64 + lane; w[j] = (k < cb) ? sc[k] : 0u; }
                    for (; bit >= 0; --bit) {
                        const unsigned cand = prefix | (1u << bit); int c = 0;
#pragma unroll
                        for (int j = 0; j < 8; ++j) c += __popcll(__ballot(w[j] >= cand));
                        if (c >= 256) prefix = cand;
                    }
                    int c = 0;
#pragma unroll
                    for (int j = 0; j < 8; ++j) c += __popcll(__ballot(w[j] > prefix));
                    ngt = c;
                } else {
                    int c = 0;
#pragma unroll
                    for (int i = 0; i < 65; ++i) { c += __popcll(__ballot(v[i] > prefix)); if ((i & 3) == 3) __builtin_amdgcn_sched_barrier(0); }
                    ngt = c;
                }
            }
            const unsigned tau = prefix;
            const int need_eq = n >= 256 ? 256 - ngt : 0; int base = 0, eqb = 0;
            unsigned short* idx = IDX + wave * 512;
#pragma unroll
            for (int gi = 0; gi < 5; ++gi) if (gi * 832 < n) {
#pragma unroll
                for (int i = 13 * gi; i < 13 * gi + 13; ++i) {
                    const int k = i * 64 + lane; const unsigned u = v[i];
                    const bool eq = (u == tau); const unsigned long long meq = __ballot(eq);
                    const bool take = (u > tau) || (eq && (eqb + mbcnt64(meq)) < need_eq);
                    const unsigned long long mt = __ballot(take);
                    idx[take ? base + mbcnt64(mt) : 256 + lane] = (unsigned short)k;
                    base += __popcll(mt); eqb += __popcll(meq);
                    __builtin_amdgcn_sched_barrier(0);
                }
            }
            for (int pos = base + lane; pos < 256; pos += 64) idx[pos] = 0;
            if (lane == 0) MISC[wave] = base;
        }
        __syncthreads();
        {
            const int q = wave; const int nsel = MISC[q];
            const size_t qrow = (size_t)(t0 + q);
            int ln = lane; asm volatile("" : "+v"(ln));
            const int hd = ln & 15, g = ln >> 4, qd = (ln & 15) >> 2, pp = ln & 3;
            char* ring = lds + DSA_KVB + wave * DSA_RING;
            const unsigned ring_a = lds_base + DSA_KVB + wave * DSA_RING;
            const unsigned short* idx = IDX + q * 512;
            bf16x8 qf[5];
#pragma unroll
            for (int ks = 0; ks < 5; ++ks) {
                u32x4 w = (u32x4){0u, 0u, 0u, 0u};
                if (hd < 8 && (ks < 4 || g < 2)) w = *(const u32x4*)(Pb + qrow * PW + C_QF + hd * QFW + 32 * ks + 8 * g);
                qf[ks] = __builtin_bit_cast(bf16x8, w);
            }
            asm volatile("s_waitcnt vmcnt(0)" ::: "memory");
#define DSA_ISSUE(c) do { _Pragma("unroll") for (int i_ = 0; i_ < 9; ++i_) { const int pid_ = ln + 64 * i_, row_ = pid_ / 18, part_ = pid_ - row_ * 18; \
                const bf16_t* src_ = Pb + (size_t)idx[32 * (c) + row_] * PW + C_KV + part_ * 8; \
                __builtin_amdgcn_global_load_lds((const unsigned*)src_, (LAS unsigned*)(ring + ((c) & 1) * 9216 + i_ * 1024), 16, 0, 0); } } while (0)
            DSA_ISSUE(0); DSA_ISSUE(1);
            f32x4 O[8];
#pragma unroll
            for (int nt = 0; nt < 8; ++nt) O[nt] = (f32x4){0.f, 0.f, 0.f, 0.f};
            float mrun = -3e38f, lrun = 0.f;
            for (int c = 0; c < 8; ++c) {
                if (c < 7) asm volatile("s_waitcnt vmcnt(9)" ::: "memory"); else asm volatile("s_waitcnt vmcnt(0)" ::: "memory");
                const char* buf = ring + (c & 1) * 9216;
                f32x4 S0 = (f32x4){0.f, 0.f, 0.f, 0.f}, S1 = S0;
                {
                    const char* kr = buf + hd * 288 + 16 * g;
#pragma unroll
                    for (int ks = 0; ks < 4; ++ks) { S0 = __builtin_amdgcn_mfma_f32_16x16x32_bf16(*(const bf16x8*)(kr + 64 * ks), qf[ks], S0, 0, 0, 0); S1 = __builtin_amdgcn_mfma_f32_16x16x32_bf16(*(const bf16x8*)(kr + 16 * 288 + 64 * ks), qf[ks], S1, 0, 0, 0); }
                    u32x4 w0 = (u32x4){0u, 0u, 0u, 0u}, w1 = w0; if (g < 2) { w0 = *(const u32x4*)(kr + 256); w1 = *(const u32x4*)(kr + 16 * 288 + 256); }
                    S0 = __builtin_amdgcn_mfma_f32_16x16x32_bf16(__builtin_bit_cast(bf16x8, w0), qf[4], S0, 0, 0, 0); S1 = __builtin_amdgcn_mfma_f32_16x16x32_bf16(__builtin_bit_cast(bf16x8, w1), qf[4], S1, 0, 0, 0);
                }
                float cm = -3e38f;
#pragma unroll
                for (int r = 0; r < 4; ++r) { const int sl = 32 * c + 4 * g + r; S0[r] = sl < nsel ? S0[r] : -1e30f; S1[r] = (sl + 16) < nsel ? S1[r] : -1e30f; cm = fmaxf(cm, fmaxf(S0[r], S1[r])); }
                cm = fmaxf(cm, __shfl_xor(cm, 16)); cm = fmaxf(cm, __shfl_xor(cm, 32));
                const float mnew = fmaxf(mrun, cm), alpha = exp2f(mrun - mnew);
                float ps = 0.f;
#pragma unroll
                for (int r = 0; r < 4; ++r) { S0[r] = exp2f(S0[r] - mnew); S1[r] = exp2f(S1[r] - mnew); ps += S0[r] + S1[r]; }
                ps += __shfl_xor(ps, 16); ps += __shfl_xor(ps, 32);
                lrun = lrun * alpha + ps; mrun = mnew;
                const float a0 = __shfl(alpha, 4 * g), a1 = __shfl(alpha, 4 * g + 1), a2 = __shfl(alpha, 4 * g + 2), a3 = __shfl(alpha, 4 * g + 3);
#pragma unroll
                for (int nt = 0; nt < 8; ++nt) { O[nt][0] *= a0; O[nt][1] *= a1; O[nt][2] *= a2; O[nt][3] *= a3; }
                u32x4 pw; pw.x = pk2(S0[0], S0[1]); pw.y = pk2(S0[2], S0[3]); pw.z = pk2(S1[0], S1[1]); pw.w = pk2(S1[2], S1[3]);
                const bf16x8 pf = __builtin_bit_cast(bf16x8, pw);
                const unsigned va = ring_a + (unsigned)((c & 1) * 9216 + (4 * g + qd) * 288 + 8 * pp);
#pragma unroll
                for (int h2 = 0; h2 < 2; ++h2) {
                    u16x4 x0, x1, x2, x3, y0, y1, y2, y3;
                    asm volatile("ds_read_b64_tr_b16 %0, %8 offset:%9\n\tds_read_b64_tr_b16 %1, %8 offset:%10\n\tds_read_b64_tr_b16 %2, %8 offset:%11\n\tds_read_b64_tr_b16 %3, %8 offset:%12\n\t"
                                 "ds_read_b64_tr_b16 %4, %8 offset:%13\n\tds_read_b64_tr_b16 %5, %8 offset:%14\n\tds_read_b64_tr_b16 %6, %8 offset:%15\n\tds_read_b64_tr_b16 %7, %8 offset:%16\n\ts_waitcnt lgkmcnt(0)"
                                 : "=&v"(x0), "=&v"(x1), "=&v"(x2), "=&v"(x3), "=&v"(y0), "=&v"(y1), "=&v"(y2), "=&v"(y3)
                                 : "v"(va), "i"(128 * h2), "i"(128 * h2 + 32), "i"(128 * h2 + 64), "i"(128 * h2 + 96), "i"(128 * h2 + 4608), "i"(128 * h2 + 4640), "i"(128 * h2 + 4672), "i"(128 * h2 + 4704) : "memory");
#define DSA_PV(nt_, x_, y_) do { bf16x8 vf_; vf_[0] = (short)x_[0]; vf_[1] = (short)x_[1]; vf_[2] = (short)x_[2]; vf_[3] = (short)x_[3]; vf_[4] = (short)y_[0]; vf_[5] = (short)y_[1]; vf_[6] = (short)y_[2]; vf_[7] = (short)y_[3]; \
                    O[nt_] = __builtin_amdgcn_mfma_f32_16x16x32_bf16(pf, vf_, O[nt_], 0, 0, 0); } while (0)
                    DSA_PV(4 * h2 + 0, x0, y0); DSA_PV(4 * h2 + 1, x1, y1); DSA_PV(4 * h2 + 2, x2, y2); DSA_PV(4 * h2 + 3, x3, y3);
                }
                asm volatile("s_waitcnt lgkmcnt(0)" ::: "memory");
                if (c + 2 < 8) DSA_ISSUE(c + 2);
            }
#undef DSA_PV
#undef DSA_ISSUE
            const float inv = 1.f / lrun;
            const float i0 = __shfl(inv, 4 * g), i1 = __shfl(inv, 4 * g + 1), i2 = __shfl(inv, 4 * g + 2), i3 = __shfl(inv, 4 * g + 3);
            if (g < 2) {
                bf16_t* op = OL + ((size_t)b * SEQ + (qrow - NMETA)) * 1024 + (4 * g) * 128 + hd;
#pragma unroll
                for (int nt = 0; nt < 8; ++nt) { op[16 * nt] = (bf16_t)f2bf(O[nt][0] * i0); op[128 + 16 * nt] = (bf16_t)f2bf(O[nt][1] * i1); op[256 + 16 * nt] = (bf16_t)f2bf(O[nt][2] * i2); op[384 + 16 * nt] = (bf16_t)f2bf(O[nt][3] * i3); }
            }
        }
    }
}

__device__ __forceinline__ void phase_inproj_meta(const Params& p) {
    unsigned char* ws = p.ws; const int tid = threadIdx.x, lane = tid & 63, wave = tid >> 6, fr = lane & 15, fq = lane >> 4;
    const bf16_t* U = (const bf16_t*)(ws + WS_U); const bf16_t* WP = (const bf16_t*)(ws + WS_WP); bf16_t* P = (bf16_t*)(ws + WS_P); const float2* cs = (const float2*)(ws + WS_CS);
    const int gw = blockIdx.x * NWAVES + wave, NGW = gridDim.x * NWAVES;
    for (int nt = gw; nt < PW / 16; nt += NGW) {
        const bf16_t* ap = U + (size_t)fr * D + 8 * fq; const bf16_t* bp = WP + (size_t)(16 * nt + fr) * D + 8 * fq;
        f32x4 acc = (f32x4){0.f, 0.f, 0.f, 0.f};
#pragma unroll 8
        for (int ks = 0; ks < D / 32; ++ks) acc = __builtin_amdgcn_mfma_f32_16x16x32_bf16(*(const bf16x8*)(bp + 32 * ks), *(const bf16x8*)(ap + 32 * ks), acc, 0, 0, 0);
        const int col = 16 * nt + 4 * fq, t = fr; f32x4 v = acc; int o;
        if (pg8::rope_off(col, o)) { const float2 c0 = cs[t * 8 + (o >> 1)], c1 = cs[t * 8 + (o >> 1) + 1]; v = (f32x4){v.x * c0.x - v.y * c0.y, v.y * c0.x + v.x * c0.y, v.z * c1.x - v.w * c1.y, v.w * c1.x + v.z * c1.y}; }
        u32x2 w; w.x = pk2(v.x, v.y); w.y = pk2(v.z, v.w);
        for (int b = 0; b < BATCH; ++b) {
            if (col >= C_KI && col < C_WI) { const int d0 = col - C_KI;
                *(u32x2*)(ws + WS_KIP + (size_t)b * KIP_BATCH + (size_t)((((t >> 5) * 4 + (d0 >> 4)) * 2 + ((d0 >> 3) & 1)) * 512 + (t & 31) * 16 + (d0 & 7) * 2)) = w; }
            else *(u32x2*)(P + ((size_t)b * T + t) * PW + col) = w;
        }
    }
}

__device__ __forceinline__ void phase_c3(const Params& p, char* lds) {
    unsigned char* ws = p.ws; const int tid = threadIdx.x, lane = tid & 63, wave = __builtin_amdgcn_readfirstlane(tid >> 6);
    const float* H1 = (const float*)(ws + WS_H1); const float* g = p.in[I_GFFN];
    {
        bf16_t* U2 = (bf16_t*)(ws + WS_U); const int gw = blockIdx.x * NWAVES + wave, NGW = gridDim.x * NWAVES;
        for (int row = gw; row < NR; row += NGW) {
            const f32x4* xr = (const f32x4*)(H1 + (size_t)row * D) + lane;
            f32x4 v[4]; float s = 0.f;
#pragma unroll
            for (int j = 0; j < 4; ++j) { v[j] = xr[64 * j]; s += (v[j].x * v[j].x + v[j].y * v[j].y) + (v[j].z * v[j].z + v[j].w * v[j].w); }
            const float rstd = rsqrtf(wave_sum(s) * (1.f / D) + NORM_EPS);
            u32x2* o = (u32x2*)(U2 + (size_t)row * D) + lane;
#pragma unroll
            for (int j = 0; j < 4; ++j) { const f32x4 gg = ((const f32x4*)g)[lane + 64 * j];
                u32x2 w; w.x = pk2(v[j].x * rstd * gg.x, v[j].y * rstd * gg.y); w.y = pk2(v[j].z * rstd * gg.z, v[j].w * rstd * gg.w); o[64 * j] = w; }
        }
    }
    {
        float* Tl = (float*)lds;
        float* RED = (float*)lds;
        const float* wg = p.in[I_WGRP]; const float* wr = p.in[I_WRT]; const float* bg = p.in[I_BGRP]; const float* br = p.in[I_BRT];
        unsigned* ctl = (unsigned*)(ws + WS_CTL); int* LIST = (int*)(ws + WS_LIST); float* GATE = (float*)(ws + WS_GATE);
        const int tk = tid & 127, kq = wave >> 1;
        for (int grp = blockIdx.x; grp < NR / 128; grp += gridDim.x) {
            const int tok0 = grp * 128;
            float acc[36]; float ss = 0.f;
#pragma unroll
            for (int o = 0; o < 36; ++o) acc[o] = 0.f;
            for (int step = 0; step < 8; ++step) {
                __syncthreads();
#pragma unroll
                for (int i = 0; i < 8; ++i) { const int idx = tid + NTHREADS * i, qq = idx >> 10, rem = idx & 1023, t2 = rem >> 3, kc = rem & 7;
                    const f32x4 v = *(const f32x4*)(H1 + (size_t)(tok0 + t2) * D + qq * 256 + step * 32 + kc * 4);
                    float* d = Tl + qq * (32 * 129) + (kc * 4) * 129 + t2; d[0] = v.x; d[129] = v.y; d[258] = v.z; d[387] = v.w; }
                __syncthreads();
                const int kb = kq * 256 + step * 32;
#pragma unroll 4
                for (int k = 0; k < 32; ++k) {
                    const float h = Tl[kq * (32 * 129) + k * 129 + tk]; ss += h * h; const float hg = h * g[kb + k];
                    const float* w4 = wg + (size_t)(kb + k) * 4; const float* w32 = wr + (size_t)(kb + k) * 32;
#pragma unroll
                    for (int o = 0; o < 4; ++o) acc[o] += hg * w4[o];
#pragma unroll
                    for (int o = 0; o < 32; ++o) acc[4 + o] += hg * w32[o];
                }
            }
            __syncthreads();
#pragma unroll
            for (int o = 0; o < 36; ++o) RED[(kq * 37 + o) * 128 + tk] = acc[o];
            RED[(kq * 37 + 36) * 128 + tk] = ss;
            __syncthreads();
            if (tid < 128) {
                const int tok = tok0 + tk;
#pragma unroll
                for (int o = 0; o < 36; ++o) acc[o] = (RED[o * 128 + tk] + RED[(37 + o) * 128 + tk]) + (RED[(74 + o) * 128 + tk] + RED[(111 + o) * 128 + tk]);
                ss = (RED[36 * 128 + tk] + RED[(37 + 36) * 128 + tk]) + (RED[(74 + 36) * 128 + tk] + RED[(111 + 36) * 128 + tk]);
                const float rstd = rsqrtf(ss * (1.f / D) + NORM_EPS);
                float gl[4]; int gs = 0; float gm;
#pragma unroll
                for (int o = 0; o < 4; ++o) gl[o] = acc[o] * rstd + bg[o];
                gm = gl[0];
#pragma unroll
                for (int o = 1; o < 4; ++o) if (gl[o] > gm) { gm = gl[o]; gs = o; }
                float gsum = 0.f;
#pragma unroll
                for (int o = 0; o < 4; ++o) gsum += __expf(gl[o] - gm);
                const float pgrp = 1.f / gsum;
                float el[8];
#pragma unroll
                for (int j = 0; j < 8; ++j) { float a = acc[4 + j]; float bb = br[j];
                    a = gs == 1 ? acc[12 + j] : a; bb = gs == 1 ? br[8 + j] : bb; a = gs == 2 ? acc[20 + j] : a; bb = gs == 2 ? br[16 + j] : bb; a = gs == 3 ? acc[28 + j] : a; bb = gs == 3 ? br[24 + j] : bb;
                    el[j] = a * rstd + bb; }
                int e0 = 0; float m0 = el[0];
#pragma unroll
                for (int j = 1; j < 8; ++j) if (el[j] > m0) { m0 = el[j]; e0 = j; }
                int e1 = -1; float m1 = -3e38f;
#pragma unroll
                for (int j = 0; j < 8; ++j) if (j != e0 && el[j] > m1) { m1 = el[j]; e1 = j; }
                const float x1 = __expf(m1 - m0); const float g0 = pgrp / (1.f + x1), g1 = pgrp * x1 / (1.f + x1);
                const int ex0 = gs * 8 + e0, ex1 = gs * 8 + e1;
                const int s0 = (int)atomicAdd(ctl + CW_CNT + 64 * ex0, 1u); LIST[(size_t)ex0 * NR + s0] = tok * 2;
                const int s1 = (int)atomicAdd(ctl + CW_CNT + 64 * ex1, 1u); LIST[(size_t)ex1 * NR + s1] = tok * 2 + 1;
                GATE[tok * 2] = g0; GATE[tok * 2 + 1] = g1;
            }
        }
    }
}

template <int WHICH>
__device__ __forceinline__ void phase_moe(const Params& p, char* lds) {
    unsigned char* ws = p.ws; const int tid = threadIdx.x;
    const unsigned* ctl = (const unsigned*)(ws + WS_CTL);
    int* TP = (int*)(lds + pg8::STAGE_BYTES);
    __syncthreads();
    if (tid == 0) { int tp = 0, ro = 0; for (int e = 0; e < NEXP; ++e) { const int c = (int)ctl[CW_CNT + 64 * e]; TP[e] = tp; TP[64 + e] = ro; TP[128 + e] = c; const int t = (c + 255) / 256; tp += t * 4; ro += t * 256; } TP[NEXP] = tp; }
    __syncthreads();
    pg8::MoeOrder<WHICH> S{TP, (int)gridDim.x, (int)blockIdx.x, (const char*)(ws + (WHICH == 0 ? WS_U : WS_HID)), (const char*)(ws + (WHICH == 0 ? WS_W13 : WS_W2)), (const int*)(ws + WS_LIST)};
    if constexpr (WHICH == 0) { pg8::EpiMoe1 E{(bf16_t*)(ws + WS_HID), TP}; pg8::gemm_phase_x<pg8::EpiMoe1, pg8::MoeOrder<0>, true, true>((LAS unsigned char*)lds, 1024, S, E); }
    else { pg8::EpiMoe2 E{(bf16_t*)(ws + WS_MO), TP, (const int*)(ws + WS_LIST), (const float*)(ws + WS_GATE)}; pg8::gemm_phase_x<pg8::EpiMoe2, pg8::MoeOrder<1>, true, true>((LAS unsigned char*)lds, 512, S, E); }
}

__device__ __forceinline__ void phase_final(const Params& p) {
    unsigned char* ws = p.ws; const int tid = threadIdx.x, lane = tid & 63, wave = tid >> 6;
    const float* H1 = (const float*)(ws + WS_H1); const bf16_t* MO = (const bf16_t*)(ws + WS_MO); const float* g = p.in[I_GFIN];
    const int gw = blockIdx.x * NWAVES + wave, NGW = gridDim.x * NWAVES;
    for (int orow = gw; orow < BATCH * SEQ; orow += NGW) {
        const size_t row = (size_t)orow;
        const f32x4* xr = (const f32x4*)(H1 + row * D) + lane; const u32x2* m0 = (const u32x2*)(MO + row * 2 * D) + lane; const u32x2* m1 = m0 + 256;
        f32x4 v[4]; float ss = 0.f;
#pragma unroll
        for (int j = 0; j < 4; ++j) { const u32x2 a = m0[64 * j], c = m1[64 * j]; v[j] = xr[64 * j];
            v[j].x += bflo(a.x) + bflo(c.x); v[j].y += bfhi(a.x) + bfhi(c.x); v[j].z += bflo(a.y) + bflo(c.y); v[j].w += bfhi(a.y) + bfhi(c.y);
            ss += (v[j].x * v[j].x + v[j].y * v[j].y) + (v[j].z * v[j].z + v[j].w * v[j].w); }
        const float rstd = rsqrtf(wave_sum(ss) * (1.f / D) + NORM_EPS);
        f32x4* o = (f32x4*)(p.out + (size_t)orow * D) + lane;
#pragma unroll
        for (int j = 0; j < 4; ++j) { const f32x4 gg = ((const f32x4*)g)[lane + 64 * j]; o[64 * j] = v[j] * rstd * gg; }
    }
}

#define XB_TMO      128
#define XB_XCNT(j)  (256  + 64 * (j))
#define XB_XSUB(j)  (1280 + 64 * (j))
#define XB_XGEN(j)  (2304 + 64 * (j))
#define XB_TOP      3328
#define XB_TOPGEN   3392
#define XCD_BAR_WORDS 3456
#define XB_SPIN_CAP (1u << 18)
__device__ __forceinline__ unsigned xb_ld(unsigned* p)              { return __hip_atomic_load(p, __ATOMIC_RELAXED, __HIP_MEMORY_SCOPE_AGENT); }
__device__ __forceinline__ unsigned xb_add(unsigned* p, unsigned v) { return __hip_atomic_fetch_add(p, v, __ATOMIC_RELAXED, __HIP_MEMORY_SCOPE_AGENT); }
__device__ __forceinline__ unsigned xb_xcc_id() { return (unsigned)__builtin_amdgcn_s_getreg((3 << 11) | 20) & 0xFu; }
#define XB_SPIN(cond, bar) do { unsigned _sp = 0; while (cond) { __builtin_amdgcn_s_sleep(1); \
    if ((++_sp & 255u) == 0u) { if (xb_ld(&(bar)[XB_TMO])) break; if (_sp > XB_SPIN_CAP) { atomicAdd(&(bar)[XB_TMO], 1u); break; } } } } while (0)
struct XcdBarrier { unsigned* bar; unsigned x; volatile LAS unsigned* st; };
__device__ __forceinline__ XcdBarrier xcd_barrier_post(unsigned* bar, volatile LAS unsigned* st) {
    XcdBarrier b; b.bar = bar; b.x = xb_xcc_id(); b.st = st;
    if (threadIdx.x == 0) (void)xb_add(&bar[XB_XCNT(b.x)], 1u);
    return b;
}
__device__ __forceinline__ void xcd_barrier_complete(unsigned* bar, unsigned x, unsigned& nloc, unsigned& nx) {
    const unsigned G = gridDim.x * gridDim.y * gridDim.z;
    unsigned sum, cnt, mine, sp = 0u;
    for (;;) {
        sum = 0u; cnt = 0u; mine = 0u;
#pragma unroll
        for (unsigned j = 0; j < 16; ++j) { const unsigned c = xb_ld(&bar[XB_XCNT(j)]); sum += c; cnt += (c > 0u) ? 1u : 0u; mine = (j == x) ? c : mine; }
        if (sum == G) break;
        __builtin_amdgcn_s_sleep(1);
        if ((++sp & 255u) == 0u) { if (xb_ld(&bar[XB_TMO])) break; if (sp > XB_SPIN_CAP) { atomicAdd(&bar[XB_TMO], 1u); break; } }
    }
    nloc = mine > 0u ? mine : 1u; nx = cnt > 0u ? cnt : 1u;
}
__device__ __forceinline__ void xcd_barrier(const XcdBarrier& b) {
    asm volatile("s_waitcnt vmcnt(0)" ::: "memory");
    __syncthreads();
    if (threadIdx.x == 0) {
        unsigned* bar = b.bar;
        __builtin_amdgcn_s_waitcnt(0);
        unsigned nloc = b.st[0], nx = b.st[1];
        if (nloc == 0u) { xcd_barrier_complete(bar, b.x, nloc, nx); b.st[0] = nloc; b.st[1] = nx; }
        const unsigned old = xb_add(&bar[XB_XSUB(b.x)], 1u);
        const unsigned gen = old / nloc;
        if (old + 1u == (gen + 1u) * nloc) {
            __builtin_amdgcn_fence(__ATOMIC_RELEASE, "agent");
            asm volatile("s_waitcnt vmcnt(0)" ::: "memory");
            const unsigned og = xb_add(&bar[XB_TOP], 1u);
            const unsigned tg = og / nx;
            if (og + 1u == (tg + 1u) * nx) xb_add(&bar[XB_TOPGEN], 1u);
            else XB_SPIN(xb_ld(&bar[XB_TOPGEN]) == tg, bar);
            __builtin_amdgcn_fence(__ATOMIC_ACQUIRE, "agent");
            xb_add(&bar[XB_XGEN(b.x)], 1u);
            asm volatile("s_waitcnt vmcnt(0)" ::: "memory");
        } else {
            XB_SPIN(xb_ld(&bar[XB_XGEN(b.x)]) == gen, bar);
            __builtin_amdgcn_fence(__ATOMIC_ACQUIRE, "agent");
            asm volatile("s_waitcnt vmcnt(0)" ::: "memory");
        }
    }
    __syncthreads();
}

constexpr int LDS_XB = DSA_LDS;
constexpr int LDS_BYTES = DSA_LDS + 256;
static_assert(pg8::STAGE_BYTES <= LDS_XB && pg8::STAGE_BYTES + 1024 <= LDS_XB && NWAVES * 64 * 33 * 4 <= LDS_XB && NWAVES * 64 * SB_VT_STRIDE * 2 <= LDS_XB && 4 * 37 * 128 * 4 <= LDS_XB, "LDS map");

__global__ void __launch_bounds__(NTHREADS, 2) mega(Params p) {
    extern __shared__ __attribute__((aligned(16))) char lds[];
    const int lo = p.ph_lo, hi = p.ph_hi;
    unsigned char* ws = p.ws;
    XcdBarrier xb;
    {
        volatile LAS unsigned* st = (volatile LAS unsigned*)(lds + LDS_XB);
        if (threadIdx.x < 4) st[threadIdx.x] = 0u;
        __syncthreads();
        xb = xcd_barrier_post((unsigned*)(ws + WS_CTL) + CW_BAR, st);
    }
#define IN(k) (lo <= (k) && (k) < hi)
#define GSYNC() xcd_barrier(xb)
#define SEAM(k) do { if (IN(k) && IN((k) + 1)) GSYNC(); } while (0)
#define REP(k, ...) do { if (IN(k)) { __VA_ARGS__; if (PROBE_PH == (k)) { GSYNC(); __VA_ARGS__; } } } while (0)
    LAS unsigned char* ldsl = (LAS unsigned char*)lds;
    REP(0, phase_prologue(p, lds));
    SEAM(0);
    REP(1, { phase_inproj_meta(p);
             pg8::TokRowOrder S; S.init(NR, PWN, gridDim.x, blockIdx.x); S.Abase = (const char*)(ws + WS_U); S.Bbase = (const char*)(ws + WS_WP); S.K = D;
             pg8::EpiInproj E{(bf16_t*)(ws + WS_P), (const float2*)(ws + WS_CS), ws + WS_KIP}; pg8::gemm_phase_x<pg8::EpiInproj, pg8::TokRowOrder, true, true>(ldsl, D, S, E); });
    SEAM(1);
    if (IN(2)) {
        phase_dsa(p, lds);
        if (PROBE_PH == 20) { GSYNC(); phase_dsa(p, lds); }
        __syncthreads(); phase_sb_fast(p, lds);
        if (PROBE_PH == 21) { GSYNC(); phase_sb_fast(p, lds); }
    }
    SEAM(2);
    REP(3, { pg8::TokRowOrder S; S.init(NR, 2048, gridDim.x, blockIdx.x); S.Abase = (const char*)(ws + WS_U); S.Bbase = (const char*)(ws + WS_WG); S.K = D;
             pg8::EpiGate E{(bf16_t*)(ws + WS_G)}; pg8::gemm_phase_x<pg8::EpiGate, pg8::TokRowOrder, true, true>(ldsl, D, S, E); });
    SEAM(3);
    REP(4, { { pg8::Gemm g{(const bf16_t*)(ws + WS_YA), (const bf16_t*)(ws + WS_WUA), NR, D, 512}; pg8::StaticOrder S; S.init(NR, D, gridDim.x, blockIdx.x);
               pg8::EpiZ<false> E{(bf16_t*)(ws + WS_Z), (const bf16_t*)(ws + WS_G), 0}; pg8::gemm_phase<pg8::EpiZ<false>, pg8::StaticOrder, true, true>(ldsl, g, S, E); }
             asm volatile("s_waitcnt vmcnt(0)" ::: "memory"); __syncthreads();
             { pg8::Gemm g{(const bf16_t*)(ws + WS_OLAT), (const bf16_t*)(ws + WS_WBP), NR, D, D}; pg8::StaticOrder S; S.init(NR, D, gridDim.x, blockIdx.x);
               pg8::EpiZ<true> E{(bf16_t*)(ws + WS_Z), (const bf16_t*)(ws + WS_G), 1024}; pg8::gemm_phase<pg8::EpiZ<true>, pg8::StaticOrder, true, true>(ldsl, g, S, E); } });
    SEAM(4);
    REP(5, { pg8::Gemm g{(const bf16_t*)(ws + WS_Z), (const bf16_t*)(ws + WS_WO), NR, D, D}; pg8::StaticOrder S; S.init(NR, D, gridDim.x, blockIdx.x);
             pg8::EpiH1 E{(float*)(ws + WS_H1), p.in[I_META], p.in[I_X]}; pg8::gemm_phase<pg8::EpiH1, pg8::StaticOrder, true, true>(ldsl, g, S, E); });
    SEAM(5);
    if (IN(6)) phase_c3(p, lds);
    SEAM(6);
    REP(7, phase_moe<0>(p, lds));
    SEAM(7);
    REP(8, phase_moe<1>(p, lds));
    SEAM(8);
    REP(9, phase_final(p));
}

extern "C" void kernel_launch(void* const* d_in, const int* in_sizes, int n_in, void* d_out, int out_size, void* d_ws, size_t ws_size, hipStream_t stream) {
    if (n_in != 18 || ws_size < WS_END) { fprintf(stderr, "kernel_launch: unexpected n_in %d / ws_size %zu\n", n_in, ws_size); return; }
    static int grid = 0;
    if (grid == 0) {
        int dev = 0, cus = 0, per_cu = 0;
        (void)hipGetDevice(&dev);
        (void)hipDeviceGetAttribute(&cus, hipDeviceAttributeMultiprocessorCount, dev);
        (void)hipFuncSetAttribute((const void*)mega, hipFuncAttributeMaxDynamicSharedMemorySize, LDS_BYTES);
        (void)hipOccupancyMaxActiveBlocksPerMultiprocessor(&per_cu, (const void*)mega, NTHREADS, LDS_BYTES);
        if (per_cu < 1) fprintf(stderr, "kernel_launch: occupancy query reports %d workgroups per CU\n", per_cu);
        grid = cus;
    }
    (void)hipMemsetAsync((char*)d_ws + WS_CTL, 0, CTL_BYTES, stream);
    Params p{};
    for (int i = 0; i < 18; ++i) p.in[i] = (const float*)d_in[i];
    p.out = (float*)d_out; p.ws = (unsigned char*)d_ws;
    p.ph_lo = 0; p.ph_hi = 10;
    void* args[] = {&p};
    hipError_t e = hipLaunchCooperativeKernel((const void*)mega, dim3(grid), dim3(NTHREADS), args, LDS_BYTES, stream);
    if (e != hipSuccess) fprintf(stderr, "cooperative launch failed: %s (grid %d)\n", hipGetErrorString(e), grid);
}
```

```cpp
#include <hip/hip_runtime.h>
#include <cstdio>
#include <cstdint>
#ifndef PROBE_PH
#define PROBE_PH -1
#endif

constexpr int BATCH = 8, SEQ = 4096, NMETA = 16, T = SEQ + NMETA, D = 1024, NTOK = BATCH * T;
constexpr int MROWS = 33024;
constexpr int NR = BATCH * SEQ;
__device__ __forceinline__ int tokrow(int cr) { return cr + NMETA * (cr / SEQ + 1); }
constexpr int INW = 4824;
constexpr int NEXP = 32, DEXP = 512;
constexpr int NWAVES = 8, NTHREADS = 512;
constexpr float NORM_EPS = 1e-6f;
constexpr float LOG2E = 1.4426950408889634f;
constexpr float QSCALE = 0.125f * LOG2E;
constexpr int PW = 3456, PWN = 3584;
constexpr int C_QA = 0, C_KA = 512, C_VA = 1024, C_QF = 1536, C_KV = 2688, C_QI = 2832, C_KI = 3344, C_WI = 3408, C_END = 3416;
constexpr int QFW = 144;

constexpr size_t MiB = 1u << 20;
constexpr size_t WS_CTL = 0, CTL_BYTES = 1 * MiB;
constexpr size_t WS_CS = 1 * MiB;
constexpr size_t WS_WP = 2 * MiB;
constexpr size_t WS_WG = 9 * MiB;
constexpr size_t WS_WUA = 13 * MiB, WS_WBP = 14 * MiB, WS_WO = 16 * MiB;
constexpr size_t WS_W2 = 18 * MiB;
constexpr size_t WS_W13 = 50 * MiB;
constexpr size_t WS_U = 114 * MiB;
constexpr size_t WS_P = 179 * MiB;
constexpr size_t WS_Z = 179 * MiB;
constexpr size_t WS_G = 244 * MiB;
constexpr size_t WS_H1 = 244 * MiB;
constexpr size_t WS_LIST = 374 * MiB;
constexpr size_t WS_GATE = 379 * MiB;
constexpr size_t WS_YA = 397 * MiB;
constexpr size_t WS_OLAT = 430 * MiB;
constexpr size_t WS_HID = 397 * MiB;
constexpr size_t WS_MO = 50 * MiB;
constexpr size_t WS_KIP = 495 * MiB;
constexpr size_t KIP_BATCH = 129 * 4096;
constexpr size_t WS_END = 500 * MiB;
static_assert(WS_P + (size_t)MROWS * PW * 2 <= WS_YA && WS_G + (size_t)MROWS * 2048 * 2 <= WS_LIST && WS_Z + (size_t)MROWS * 1024 * 2 <= WS_G, "ws map");
static_assert(WS_OLAT + (size_t)MROWS * 1024 * 2 <= WS_END && WS_U + (size_t)MROWS * 1024 * 2 <= WS_P && WS_MO + (size_t)NTOK * 2048 * 2 <= WS_P, "ws map");
constexpr int CW_CNT = 1024;
constexpr int CW_BAR = 4096;

typedef unsigned short bf16_t;
typedef short bf16x8 __attribute__((ext_vector_type(8)));
typedef float f32x4 __attribute__((ext_vector_type(4)));
typedef float f32x16 __attribute__((ext_vector_type(16)));
typedef unsigned u32x2 __attribute__((ext_vector_type(2)));
typedef unsigned u32x4 __attribute__((ext_vector_type(4)));
typedef unsigned short u16x4 __attribute__((ext_vector_type(4)));
#define LAS __attribute__((address_space(3)))

__device__ __forceinline__ unsigned f2bf(float f) { unsigned u = __float_as_uint(f); return (u + 0x7fffu + ((u >> 16) & 1u)) >> 16; }
typedef __bf16 bf16v2_t __attribute__((ext_vector_type(2)));
typedef float f32v2_t __attribute__((ext_vector_type(2)));
__device__ __forceinline__ unsigned pk2(float lo, float hi) { const f32v2_t v = {lo, hi}; const bf16v2_t r = __builtin_convertvector(v, bf16v2_t); return __builtin_bit_cast(unsigned, r); }
__device__ __forceinline__ float bflo(unsigned w) { return __uint_as_float(w << 16); }
__device__ __forceinline__ float bfhi(unsigned w) { return __uint_as_float(w & 0xffff0000u); }
__device__ __forceinline__ float bf2f(bf16_t b) { return __uint_as_float((unsigned)b << 16); }
__device__ __forceinline__ float wave_sum(float v) {
#pragma unroll
    for (int o = 1; o < 64; o <<= 1) v += __shfl_xor(v, o);
    return v;
}
__device__ __forceinline__ float xsum32(float x) { const auto r = __builtin_amdgcn_permlane32_swap(__float_as_uint(x), __float_as_uint(x), false, false); return __uint_as_float(r[0]) + __uint_as_float(r[1]); }
__device__ __forceinline__ float xsum16(float x) { const auto r = __builtin_amdgcn_permlane16_swap(__float_as_uint(x), __float_as_uint(x), false, false); return __uint_as_float(r[0]) + __uint_as_float(r[1]); }
__device__ __forceinline__ float xmax32(float x) { const auto r = __builtin_amdgcn_permlane32_swap(__float_as_uint(x), __float_as_uint(x), false, false); return fmaxf(__uint_as_float(r[0]), __uint_as_float(r[1])); }
__device__ __forceinline__ float xmax16(float x) { const auto r = __builtin_amdgcn_permlane16_swap(__float_as_uint(x), __float_as_uint(x), false, false); return fmaxf(__uint_as_float(r[0]), __uint_as_float(r[1])); }
__device__ __forceinline__ float xpartner32(float x, int hh) { const auto r = __builtin_amdgcn_permlane32_swap(__float_as_uint(x), __float_as_uint(x), false, false); return __uint_as_float(hh ? r[0] : r[1]); }
__device__ __forceinline__ float sigmoidf(float x) { return 1.0f / (1.0f + __expf(-x)); }

struct Params {
    const float* in[18];
    float* out;
    unsigned char* ws;
    int ph_lo, ph_hi;
};
enum { I_X = 0, I_META, I_GMIX, I_WIN, I_WUK, I_WUV, I_WUPA, I_WUPB, I_WO, I_GFFN, I_WGRP, I_BGRP, I_WRT, I_BRT, I_W1, I_W3, I_W2, I_GFIN };

__device__ __forceinline__ const float* h0_row(const Params& p, int row) {
    const int b = row / T, t = row - b * T;
    return t < NMETA ? p.in[I_META] + (size_t)t * D : p.in[I_X] + ((size_t)b * SEQ + (t - NMETA)) * D;
}
template <class F>
__device__ __forceinline__ void tr_item(F val, bf16_t* dst, int ldd, int row0, int k0, float* scr, int lane, int rstep = 1) {
    float tv[32];
#pragma unroll
    for (int i = 0; i < 32; ++i) tv[i] = val(k0 + 2 * i + (lane >> 5), lane & 31);
#pragma unroll
    for (int i = 0; i < 32; ++i) scr[(2 * i + (lane >> 5)) * 33 + (lane & 31)] = tv[i];
    __builtin_amdgcn_s_waitcnt(0xC07F);
    asm volatile("" ::: "memory");
    const int c = lane & 7;
#pragma unroll
    for (int j = 0; j < 4; ++j) {
        const int n = (lane >> 3) + 8 * j; const float* s = scr + (8 * c) * 33 + n;
        u32x4 o; o.x = pk2(s[0], s[33]); o.y = pk2(s[66], s[99]); o.z = pk2(s[132], s[165]); o.w = pk2(s[198], s[231]);
        *(u32x4*)(dst + (size_t)(row0 + n * rstep) * ldd + k0 + 8 * c) = o;
    }
    __builtin_amdgcn_s_waitcnt(0xC07F);
    asm volatile("" ::: "memory");
}

__device__ __forceinline__ void wp_src(int c, int& kind, int& col, int& aux, float& scale) {
    kind = 1; aux = 0; scale = 1.f; col = 0;
    if (c < 512) { col = c; scale = QSCALE; }
    else if (c < C_QF) { col = c; }
    else if (c < C_KV) { const int r = c - C_QF, h = r / QFW, j = r % QFW; scale = QSCALE;
        if (j < 128) { kind = 2; col = h; aux = j; } else { const int i = j - 128; col = 1536 + 64 * h + (i >> 1) + 8 * (i & 1); } }
    else if (c < C_QI) { const int j = c - C_KV; if (j < 128) col = 2048 + j; else { const int i = j - 128; col = 2176 + (i >> 1) + 8 * (i & 1); } }
    else if (c < C_KI) { const int r = c - C_QI, h = r >> 6, j = r & 63; col = 2192 + 64 * h + (j < 16 ? (j >> 1) + 8 * (j & 1) : j); }
    else if (c < C_WI) { const int j = c - C_KI; col = 2704 + (j < 16 ? (j >> 1) + 8 * (j & 1) : j); }
    else if (c < C_END) { col = 2768 + (c - C_WI); }
    else kind = 0;
}

constexpr int IT_WP = (PWN / 32) * 16;
constexpr int IT_WG = 32 * 16;
constexpr int IT_WUA = 32 * 8;
constexpr int IT_WBP = 32 * 16, IT_WO = 32 * 16;
constexpr int IT_W13 = NEXP * 32 * 16;
constexpr int IT_W2 = NEXP * 32 * 8;
constexpr int IT_TOTAL = IT_WP + 2 * IT_WG + IT_WUA + IT_WBP + IT_WO + IT_W13 + IT_W2;

__device__ __forceinline__ void phase_prologue(const Params& p, char* lds) {
    const int tid = threadIdx.x, lane = tid & 63, wave = tid >> 6;
    const int gw = blockIdx.x * NWAVES + wave, NGW = gridDim.x * NWAVES;
    float* scr = (float*)lds + wave * (64 * 33);
    unsigned char* ws = p.ws;
    const float* w_in = p.in[I_WIN];
    {
        float2* cs = (float2*)(ws + WS_CS);
        for (int i = blockIdx.x * NTHREADS + tid; i < T * 8; i += gridDim.x * NTHREADS) {
            const int pos = i >> 3, f = i & 7;
            const float inv = powf(500000.0f, -(float)f / 8.0f);
            const float ang = (float)pos * inv;
            cs[i] = make_float2(cosf(ang), sinf(ang));
        }
    }
    for (int it = gw; it < IT_TOTAL; it += NGW) {
        int r = it;
        if (r < IT_WP) {
            const int rg = r / 16, kb = r % 16, c = rg * 32 + (lane & 31);
            int kind, col, aux; float scale; wp_src(c, kind, col, aux, scale);
            const float* w_uk = p.in[I_WUK];
            float wu[48];
#pragma unroll
            for (int n4 = 0; n4 < 12; ++n4) { f32x4 t = (f32x4){0.f, 0.f, 0.f, 0.f}; if (kind == 2) t = *(const f32x4*)(w_uk + ((size_t)col * 128 + aux) * 48 + 4 * n4); wu[4 * n4] = t.x; wu[4 * n4 + 1] = t.y; wu[4 * n4 + 2] = t.z; wu[4 * n4 + 3] = t.w; }
            tr_item([&](int k, int) -> float {
                if (kind == 0) return 0.f;
                if (kind == 1) return scale * w_in[(size_t)k * INW + col];
                const f32x4* wi = (const f32x4*)(w_in + (size_t)k * INW + 1536 + 64 * col + 16);
                float s = 0.f;
#pragma unroll
                for (int n4 = 0; n4 < 12; ++n4) { const f32x4 t = wi[n4]; s += t.x * wu[4 * n4] + t.y * wu[4 * n4 + 1] + t.z * wu[4 * n4 + 2] + t.w * wu[4 * n4 + 3]; }
                return scale * s; }, (bf16_t*)(ws + WS_WP), 1024, rg * 32, kb * 64, scr, lane);
            continue; }
        r -= IT_WP;
        if (r < 2 * IT_WG) {
            const int which = r / IT_WG; r %= IT_WG; const int rg = r / 16, kb = r % 16; const int col0 = (which ? 3800 : 2776) + rg * 32;
            tr_item([&](int k, int n) -> float { return w_in[(size_t)k * INW + col0 + n]; }, (bf16_t*)(ws + WS_WG) + (size_t)which * 1024 * 1024, 1024, rg * 32, kb * 64, scr, lane);
            continue; }
        r -= 2 * IT_WG;
        if (r < IT_WUA) {
            const int rg = r / 8, kb = r % 8; const float* w = p.in[I_WUPA];
            tr_item([&](int k, int n) -> float { return w[(size_t)k * 1024 + rg * 32 + n]; }, (bf16_t*)(ws + WS_WUA), 512, rg * 32, kb * 64, scr, lane);
            continue; }
        r -= IT_WUA;
        if (r < IT_WBP) {
            const int rg = r / 16, kb = r % 16; const float* wuv = p.in[I_WUV]; const float* wub = p.in[I_WUPB];
            const int hB = kb >> 1;
            float bc[64];
#pragma unroll
            for (int d = 0; d < 64; ++d) bc[d] = wub[(size_t)(64 * hB + d) * 1024 + rg * 32 + (lane & 31)];
            tr_item([&](int kk, int) -> float {
                const f32x4* a = (const f32x4*)(wuv + (size_t)kk * 64);
                float s = 0.f;
#pragma unroll
                for (int d4 = 0; d4 < 16; ++d4) { const f32x4 t = a[d4]; s += t.x * bc[4 * d4] + t.y * bc[4 * d4 + 1] + t.z * bc[4 * d4 + 2] + t.w * bc[4 * d4 + 3]; }
                return s; }, (bf16_t*)(ws + WS_WBP), 1024, rg * 32, kb * 64, scr, lane);
            continue; }
        r -= IT_WBP;
        if (r < IT_WO) {
            const int rg = r / 16, kb = r % 16; const float* w = p.in[I_WO];
            tr_item([&](int k, int n) -> float { return w[(size_t)k * 1024 + rg * 32 + n]; }, (bf16_t*)(ws + WS_WO), 1024, rg * 32, kb * 64, scr, lane);
            continue; }
        r -= IT_WO;
        if (r < IT_W13) {
            const int e = r / 512; r %= 512; const int which = r & 1, cg = (r >> 1) & 15, kb = r >> 5;
            const float* w = (which ? p.in[I_W3] : p.in[I_W1]) + (size_t)e * 1024 * 512 + cg * 32;
            tr_item([&](int k, int n) -> float { return w[(size_t)k * 512 + n]; },
                    (bf16_t*)(ws + WS_W13) + (size_t)e * 1024 * 1024, 1024, 2 * cg * 32 + which, kb * 64, scr, lane, 2);
            continue; }
        r -= IT_W13;
        {
            const int e = r / 256; r %= 256; const int rg = r / 8, kb = r % 8;
            const float* w2 = p.in[I_W2] + (size_t)e * 512 * 1024;
            tr_item([&](int k, int n) -> float { return w2[(size_t)k * 1024 + rg * 32 + n]; }, (bf16_t*)(ws + WS_W2) + (size_t)e * 1024 * 512, 512, rg * 32, kb * 64, scr, lane);
        }
    }
    {
        const float* g = p.in[I_GMIX]; bf16_t* U = (bf16_t*)(ws + WS_U);
        for (int row = gw; row < NTOK; row += NGW) {
            const f32x4* xr = (const f32x4*)h0_row(p, row) + lane;
            f32x4 v[4]; float s = 0.f;
#pragma unroll
            for (int j = 0; j < 4; ++j) { v[j] = xr[64 * j]; s += (v[j].x * v[j].x + v[j].y * v[j].y) + (v[j].z * v[j].z + v[j].w * v[j].w); }
            const float rstd = rsqrtf(wave_sum(s) * (1.f / D) + NORM_EPS);
            u32x2* o = (u32x2*)(U + (size_t)row * D) + lane;
#pragma unroll
            for (int j = 0; j < 4; ++j) { const f32x4 gg = ((const f32x4*)g)[lane + 64 * j];
                u32x2 w; w.x = pk2(v[j].x * rstd * gg.x, v[j].y * rstd * gg.y); w.y = pk2(v[j].z * rstd * gg.z, v[j].w * rstd * gg.w); o[64 * j] = w; }
        }
    }
}

namespace pg8 {
#define PG8_LAS __attribute__((address_space(3)))
typedef unsigned short bf16_t;
typedef short bf16x8 __attribute__((ext_vector_type(8)));
typedef float f32x4 __attribute__((ext_vector_type(4)));
typedef unsigned u32x4 __attribute__((ext_vector_type(4)));
constexpr int BM = 256, BK = 64, HALF = 128, HTB = HALF * BK * 2  , STAGE_BYTES = 8 * HTB, NXCD = 8, WGM = 8;

__host__ __device__ __forceinline__ int lds_byte(int r, int c) { const int st = (r >> 4) * 2 + (c >> 5), rr = r & 15, cc = c & 31, ob = rr * 64 + cc * 2; return st * 1024 + (ob ^ (((ob >> 9) & 1) << 5)); }
__host__ __device__ __forceinline__ void stage_rc(int b, int& R, int& C) { const int st = b / 1024, sb = b % 1024, swz = sb ^ (((sb >> 9) & 1) << 5); R = (st >> 1) * 16 + swz / 64; C = (st & 1) * 32 + (swz % 64) / 2; }
__host__ __device__ __forceinline__ int perm32(int rho) { const int n = rho >> 4, i = rho & 15; return 8 * (i >> 2) + 4 * n + (i & 3); }

struct Unit { int pm, pn; };
struct Gemm { const bf16_t* A; const bf16_t* Bt; int M, N, K; };

struct StaticOrder {
    int nM, nN, nwg, G, c;
    __host__ __device__ void init(int M, int N, int G_, int c_) { nM = M / BM; nN = N / BM; nwg = nM * nN; G = G_; c = c_; }
    __host__ __device__ bool next(int i, Unit& u) const {
        const long L = (long)i * G + c; if (L >= nwg) return false;
        int wgid = (int)L; { const int q = nwg / NXCD, r = nwg % NXCD, xcd = wgid % NXCD, off = wgid / NXCD; wgid = (xcd < r ? xcd * (q + 1) : r * (q + 1) + (xcd - r) * q) + off; }
        const int nig = WGM * nN, gid = wgid / nig, fm = gid * WGM, gsz = (nM - fm) < WGM ? (nM - fm) : WGM;
        u.pm = fm + ((wgid % nig) % gsz); u.pn = (wgid % nig) / gsz; return true;
    }
    __device__ __forceinline__ void a_ready(const Unit&) const {}
    __device__ __forceinline__ void done(const Unit&) const {}
};


#define PG8_FOR_FRAGS(...) _Pragma("unroll") for (int ai = 0; ai < 2; ++ai) _Pragma("unroll") for (int m = 0; m < 4; ++m) { const int row = u.pm * BM + ai * HALF + wr * 64 + m * 16 + fr; \
    _Pragma("unroll") for (int bj = 0; bj < 2; ++bj) _Pragma("unroll") for (int n = 0; n < 2; ++n) { const int col = u.pn * BM + bj * HALF + wc * 32 + n * 16 + 4 * fq; ::f32x4 v = acc[ai][bj][m][n]; __VA_ARGS__ } }
__device__ __forceinline__ bool rope_off(int c, int& o) {
    if (c < C_QF) return false;
    if (c < C_KV) { const int j = (c - C_QF) % QFW; o = j - 128; return j >= 128; }
    if (c < C_QI) { const int j = c - C_KV; o = j - 128; return j >= 128; }
    if (c < C_KI) { const int j = (c - C_QI) & 63; o = j; return j < 16; }
    if (c < C_WI) { const int j = c - C_KI; o = j; return j < 16; }
    return false;
}
struct EpiInproj {
    static constexpr bool PERM = false, AFTER_DRAIN = false;
    bf16_t* P; const float2* cs; unsigned char* KIP;
    __device__ __forceinline__ void operator()(const f32x4 (&acc)[2][2][4][2], const Unit& u, int wr, int wc, int fr, int fq) const {
        PG8_FOR_FRAGS(
            if (col < PW) {
                int o; const int trow = tokrow(row);
                if (rope_off(col, o)) {
                    const int pos = (row % SEQ) + NMETA; const float2 c0 = cs[pos * 8 + (o >> 1)], c1 = cs[pos * 8 + (o >> 1) + 1];
                    v = (::f32x4){v.x * c0.x - v.y * c0.y, v.y * c0.x + v.x * c0.y, v.z * c1.x - v.w * c1.y, v.w * c1.x + v.z * c1.y};
                }
                ::u32x2 w; w.x = pk2(v.x, v.y); w.y = pk2(v.z, v.w);
                if (col >= C_KI && col < C_WI) {
                    { const int b = row / SEQ, t = row - b * SEQ + NMETA, d0 = col - C_KI;
                        *(::u32x2*)(KIP + (size_t)b * KIP_BATCH + (size_t)((((t >> 5) * 4 + (d0 >> 4)) * 2 + ((d0 >> 3) & 1)) * 512 + (t & 31) * 16 + (d0 & 7) * 2)) = w; }
                } else *(::u32x2*)(P + (size_t)trow * PW + col) = w;
            })
    }
};
struct EpiGate {
    static constexpr bool PERM = false, AFTER_DRAIN = false;
    bf16_t* G;
    __device__ __forceinline__ void operator()(const f32x4 (&acc)[2][2][4][2], const Unit& u, int wr, int wc, int fr, int fq) const {
        PG8_FOR_FRAGS( ::u32x2 w; w.x = pk2(sigmoidf(v.x), sigmoidf(v.y)); w.y = pk2(sigmoidf(v.z), sigmoidf(v.w)); *(::u32x2*)(G + (size_t)row * 2048 + col) = w; )
    }
};
template <bool ACCUM> struct EpiZ {
    static constexpr bool PERM = false, AFTER_DRAIN = false;
    bf16_t* Z; const bf16_t* G; int goff;
    __device__ __forceinline__ void operator()(const f32x4 (&acc)[2][2][4][2], const Unit& u, int wr, int wc, int fr, int fq) const {
        PG8_FOR_FRAGS(
            const ::u32x2 g = *(const ::u32x2*)(G + (size_t)row * 2048 + goff + col);
            ::f32x4 z = (::f32x4){bflo(g.x) * v.x, bfhi(g.x) * v.y, bflo(g.y) * v.z, bfhi(g.y) * v.w};
            ::u32x2* zp = (::u32x2*)(Z + (size_t)row * D + col);
            if (ACCUM) { const ::u32x2 o = *zp; z.x += bflo(o.x); z.y += bfhi(o.x); z.z += bflo(o.y); z.w += bfhi(o.y); }
            ::u32x2 w; w.x = pk2(z.x, z.y); w.y = pk2(z.z, z.w); *zp = w; )
    }
};
struct EpiH1 {
    static constexpr bool PERM = false, AFTER_DRAIN = false;
    float* H1; const float* meta; const float* x;
    __device__ __forceinline__ void operator()(const f32x4 (&acc)[2][2][4][2], const Unit& u, int wr, int wc, int fr, int fq) const {
        PG8_FOR_FRAGS( const ::f32x4 h = *(const ::f32x4*)(x + (size_t)row * D + col); *(::f32x4*)(H1 + (size_t)row * D + col) = h + v; )
    }
};
#undef PG8_FOR_FRAGS

template <class Epi, class Sched, bool ALIGN_EPI = false, bool SP2 = false>
__device__ __forceinline__ void gemm_phase(PG8_LAS unsigned char* lds, const Gemm g, const Sched& S, const Epi& E) {
    const int tid = threadIdx.x, wid = __builtin_amdgcn_readfirstlane(tid >> 6), lane = tid & 63, wr = wid >> 2, wc = wid & 3, fr = lane & 15, fq = lane >> 4;
    const int K = g.K, nt = K / BK;
    unsigned voffA[2], voffB[2];
#pragma unroll
    for (int i = 0; i < 2; ++i) { int R, C; stage_rc(tid * 16 + i * 8192, R, C); const int Rb = Epi::PERM ? ((R & ~31) + perm32(R & 31)) : R;
        voffA[i] = (unsigned)(R * K + C) * 2u; voffB[i] = (unsigned)(Rb * K + C) * 2u; }
    const size_t kstep = (size_t)(BK * 2);
    const size_t hstep = (size_t)HALF * K * 2;
    const size_t tstep = 2 * hstep;
    const unsigned ldsw = (unsigned)wid * 1024u;
    const int aoff = lds_byte(wr * 64 + fr, fq * 8), boff = lds_byte(wc * 32 + fr, fq * 8);
#define PG8_SA(b, h) (((b) * 2 + (h)) * HTB)
#define PG8_SB(b, h) ((4 + (b) * 2 + (h)) * HTB)
#define PG8_STAGE(bufoff, gbase, voff) do { _Pragma("unroll") for (int _i = 0; _i < 2; ++_i) \
        __builtin_amdgcn_global_load_lds((const unsigned*)((const char*)(gbase) + (voff)[_i]), (PG8_LAS unsigned*)(lds + (bufoff) + ldsw + _i * 8192), 16, 0, 0); } while (0)
#define PG8_LDA(dst, b, h) do { _Pragma("unroll") for (int m = 0; m < 4; ++m) _Pragma("unroll") for (int k = 0; k < 2; ++k) dst[m][k] = *(const PG8_LAS bf16x8*)(lds + PG8_SA(b, h) + aoff + m * 2048 + k * 1024); } while (0)
#define PG8_LDB(dst, b, h) do { _Pragma("unroll") for (int n = 0; n < 2; ++n) _Pragma("unroll") for (int k = 0; k < 2; ++k) dst[n][k] = *(const PG8_LAS bf16x8*)(lds + PG8_SB(b, h) + boff + n * 2048 + k * 1024); } while (0)
#define PG8_MMA(ai, bj, At, Bt) do { __builtin_amdgcn_s_setprio(1); _Pragma("unroll") for (int m = 0; m < 4; ++m) _Pragma("unroll") for (int n = 0; n < 2; ++n) _Pragma("unroll") for (int k = 0; k < 2; ++k) \
        acc[ai][bj][m][n] = __builtin_amdgcn_mfma_f32_16x16x32_bf16(Bt[n][k], At[m][k], acc[ai][bj][m][n], 0, 0, 0); __builtin_amdgcn_s_setprio(0); } while (0)
#define PG8_WAIT_V(n) asm volatile("s_waitcnt vmcnt(" #n ")" ::: "memory")
#define PG8_WAIT_L(n) asm volatile("s_waitcnt lgkmcnt(" #n ")" ::: "memory")
#define PG8_BAR __builtin_amdgcn_s_barrier()
#define PG8_SCHED __builtin_amdgcn_sched_barrier(0)
    Unit cur, nxt; int ui = 0;
    if (!S.next(0, cur)) return;
    f32x4 acc[2][2][4][2];
#pragma unroll
    for (int a = 0; a < 2; ++a)
#pragma unroll
        for (int b = 0; b < 2; ++b)
#pragma unroll
            for (int m = 0; m < 4; ++m)
#pragma unroll
                for (int n = 0; n < 2; ++n) acc[a][b][m][n] = (f32x4){0.f, 0.f, 0.f, 0.f};
    bf16x8 At[4][2], B0[2][2], B1[2][2];
    const char* cA = (const char*)g.A + (size_t)cur.pm * tstep; const char* cB = (const char*)g.Bt + (size_t)cur.pn * tstep;
    S.a_ready(cur);
    if constexpr (SP2) {
        PG8_STAGE(PG8_SB(0, 0), cB, voffB); PG8_STAGE(PG8_SB(0, 1), cB + hstep, voffB); PG8_STAGE(PG8_SA(0, 0), cA, voffA); PG8_STAGE(PG8_SA(0, 1), cA + hstep, voffA);
        if (wr == 1) PG8_BAR;
        PG8_WAIT_V(2); PG8_BAR;
        PG8_STAGE(PG8_SB(1, 0), cB + kstep, voffB); PG8_STAGE(PG8_SA(1, 0), cA + kstep, voffA); PG8_STAGE(PG8_SB(1, 1), cB + hstep + kstep, voffB);
        PG8_WAIT_V(6); PG8_BAR;
    } else {
        PG8_STAGE(PG8_SB(0, 0), cB, voffB); PG8_STAGE(PG8_SA(0, 0), cA, voffA); PG8_STAGE(PG8_SB(0, 1), cB + hstep, voffB); PG8_STAGE(PG8_SA(0, 1), cA + hstep, voffA);
        if (wr == 1) PG8_BAR;
        PG8_WAIT_V(4); PG8_BAR;
        PG8_STAGE(PG8_SB(1, 0), cB + kstep, voffB); PG8_STAGE(PG8_SA(1, 0), cA + kstep, voffA); PG8_STAGE(PG8_SB(1, 1), cB + hstep + kstep, voffB);
        PG8_WAIT_V(6); PG8_BAR;
    }
    for (;;) {
        const bool has_next = S.next(ui + 1, nxt);
        const char* nA = has_next ? (const char*)g.A + (size_t)nxt.pm * tstep : cA; const char* nB = has_next ? (const char*)g.Bt + (size_t)nxt.pn * tstep : cB;
        for (int t = 0; t < nt; t += 2) {
            const bool last = (t == nt - 2);
            const char* a1 = cA + (size_t)(t + 1) * kstep;
            const char* a2 = last ? nA : cA + (size_t)(t + 2) * kstep; const char* b2 = last ? nB : cB + (size_t)(t + 2) * kstep;
            const char* a3 = a2 + kstep; const char* b3 = b2 + kstep;
            if (last && has_next) S.a_ready(nxt);
            if constexpr (SP2) {
            PG8_LDB(B0, 0, 0); PG8_LDB(B1, 0, 1); PG8_SCHED; PG8_LDA(At, 0, 0); PG8_STAGE(PG8_SA(1, 1), a1 + hstep, voffA);
            PG8_WAIT_V(8); PG8_WAIT_L(0); PG8_BAR; PG8_MMA(0, 0, At, B0); PG8_MMA(0, 1, At, B1); PG8_BAR; PG8_SCHED;
            PG8_LDA(At, 0, 1); PG8_STAGE(PG8_SB(0, 0), b2, voffB); PG8_STAGE(PG8_SB(0, 1), b2 + hstep, voffB); PG8_STAGE(PG8_SA(0, 0), a2, voffA);
            PG8_WAIT_V(8); PG8_WAIT_L(0); PG8_BAR; PG8_MMA(1, 0, At, B0); PG8_MMA(1, 1, At, B1); PG8_BAR; PG8_SCHED;
            PG8_LDB(B0, 1, 0); PG8_LDB(B1, 1, 1); PG8_SCHED; PG8_LDA(At, 1, 0); PG8_STAGE(PG8_SA(0, 1), a2 + hstep, voffA);
            PG8_WAIT_V(8); PG8_WAIT_L(0); PG8_BAR; PG8_MMA(0, 0, At, B0); PG8_MMA(0, 1, At, B1); PG8_BAR; PG8_SCHED;
            PG8_LDA(At, 1, 1); PG8_STAGE(PG8_SB(1, 0), b3, voffB); PG8_STAGE(PG8_SB(1, 1), b3 + hstep, voffB); PG8_STAGE(PG8_SA(1, 0), a3, voffA);
            PG8_WAIT_V(8); PG8_WAIT_L(0); PG8_BAR; PG8_MMA(1, 0, At, B0); PG8_MMA(1, 1, At, B1); PG8_BAR; PG8_SCHED;
            } else {
            PG8_LDB(B0, 0, 0); PG8_SCHED; PG8_LDA(At, 0, 0); PG8_STAGE(PG8_SA(1, 1), a1 + hstep, voffA);
            PG8_WAIT_L(8); PG8_BAR; PG8_WAIT_L(0); PG8_MMA(0, 0, At, B0); PG8_BAR; PG8_SCHED;
            PG8_LDB(B1, 0, 1); PG8_STAGE(PG8_SB(0, 0), b2, voffB);
            PG8_BAR; PG8_WAIT_L(0); PG8_MMA(0, 1, At, B1); PG8_BAR;
            PG8_LDA(At, 0, 1); PG8_STAGE(PG8_SA(0, 0), a2, voffA);
            PG8_BAR; PG8_WAIT_L(0); PG8_MMA(1, 0, At, B0); PG8_BAR; PG8_SCHED;
            PG8_STAGE(PG8_SB(0, 1), b2 + hstep, voffB);
            PG8_WAIT_V(6); PG8_BAR; PG8_MMA(1, 1, At, B1); PG8_BAR;
            PG8_LDB(B0, 1, 0); PG8_SCHED; PG8_LDA(At, 1, 0); PG8_STAGE(PG8_SA(0, 1), a2 + hstep, voffA);
            PG8_WAIT_L(8); PG8_BAR; PG8_WAIT_L(0); PG8_MMA(0, 0, At, B0); PG8_BAR; PG8_SCHED;
            PG8_LDB(B1, 1, 1); PG8_STAGE(PG8_SB(1, 0), b3, voffB);
            PG8_BAR; PG8_WAIT_L(0); PG8_MMA(0, 1, At, B1); PG8_BAR;
            PG8_LDA(At, 1, 1); PG8_STAGE(PG8_SA(1, 0), a3, voffA);
            PG8_BAR; PG8_WAIT_L(0); PG8_MMA(1, 0, At, B0); PG8_BAR; PG8_SCHED;
            PG8_STAGE(PG8_SB(1, 1), b3 + hstep, voffB);
            PG8_WAIT_V(6); PG8_BAR; PG8_MMA(1, 1, At, B1); PG8_BAR;
            }
        }
        if constexpr (ALIGN_EPI) { if (wr == 0) PG8_BAR; }
        if constexpr (!Epi::AFTER_DRAIN) { E(acc, cur, wr, wc, fr, fq); S.done(cur); }
        if (!has_next) break;
#pragma unroll
        for (int a = 0; a < 2; ++a)
#pragma unroll
            for (int b = 0; b < 2; ++b)
#pragma unroll
                for (int m = 0; m < 4; ++m)
#pragma unroll
                    for (int n = 0; n < 2; ++n) acc[a][b][m][n] = (f32x4){0.f, 0.f, 0.f, 0.f};
        cur = nxt; cA = nA; cB = nB; ++ui;
        if constexpr (ALIGN_EPI) { if (wr == 1) PG8_BAR; }
    }
    PG8_WAIT_V(0);
    if constexpr (!ALIGN_EPI) { if (wr == 0) PG8_BAR; }
    PG8_BAR;
    if constexpr (Epi::AFTER_DRAIN) { E.fused(acc, cur, wr, wc, fr, fq, lds, wid, lane); S.done(cur); }
#undef PG8_SA
#undef PG8_SB
#undef PG8_STAGE
#undef PG8_LDA
#undef PG8_LDB
#undef PG8_MMA
#undef PG8_WAIT_V
#undef PG8_WAIT_L
#undef PG8_BAR
#undef PG8_SCHED
}
template <class Epi, class Sched, bool ALIGN_EPI = false, bool SP2 = false>
__device__ __forceinline__ void gemm_phase_x(PG8_LAS unsigned char* lds, const int K, const Sched& S, const Epi& E) {
    const int tid = threadIdx.x, wid = __builtin_amdgcn_readfirstlane(tid >> 6), lane = tid & 63, wr = wid >> 2, wc = wid & 3, fr = lane & 15, fq = lane >> 4;
    const int nt = K / BK;
    unsigned vcA[2][2], vnA[2][2], voffB[2];
#pragma unroll
    for (int i = 0; i < 2; ++i) { int R, C; stage_rc(tid * 16 + i * 8192, R, C); const int Rb = Epi::PERM ? ((R & ~31) + perm32(R & 31)) : R;
        voffB[i] = (unsigned)(Rb * K + C) * 2u; }
    const size_t kstep = (size_t)(BK * 2);
    const size_t hstep = (size_t)HALF * K * 2;
    const unsigned ldsw = (unsigned)wid * 1024u;
    const int aoff = lds_byte(wr * 64 + fr, fq * 8), boff = lds_byte(wc * 32 + fr, fq * 8);
#define PG8_SA(b, h) (((b) * 2 + (h)) * HTB)
#define PG8_SB(b, h) ((4 + (b) * 2 + (h)) * HTB)
#define PG8_STAGE(bufoff, gbase, voff) do { _Pragma("unroll") for (int _i = 0; _i < 2; ++_i) \
        __builtin_amdgcn_global_load_lds((const unsigned*)((const char*)(gbase) + (voff)[_i]), (PG8_LAS unsigned*)(lds + (bufoff) + ldsw + _i * 8192), 16, 0, 0); } while (0)
#define PG8_STAGEA(bufoff, gbase, V, h) do { _Pragma("unroll") for (int _i = 0; _i < 2; ++_i) \
        __builtin_amdgcn_global_load_lds((const unsigned*)((const char*)(gbase) + (V)[h][_i]), (PG8_LAS unsigned*)(lds + (bufoff) + ldsw + _i * 8192), 16, 0, 0); } while (0)
#define PG8_STAGEA2(bufoff, gbase, h) do { _Pragma("unroll") for (int _i = 0; _i < 2; ++_i) \
        __builtin_amdgcn_global_load_lds((const unsigned*)((const char*)(gbase) + (last ? vnA[h][_i] : vcA[h][_i])), (PG8_LAS unsigned*)(lds + (bufoff) + ldsw + _i * 8192), 16, 0, 0); } while (0)
#define PG8_AOFF(V, u) do { _Pragma("unroll") for (int _h = 0; _h < 2; ++_h) _Pragma("unroll") for (int _i = 0; _i < 2; ++_i) { int R_, C_; stage_rc(tid * 16 + _i * 8192, R_, C_); (V)[_h][_i] = S.a_off(u, _h * HALF + R_, C_); } } while (0)
#define PG8_LDA(dst, b, h) do { _Pragma("unroll") for (int m = 0; m < 4; ++m) _Pragma("unroll") for (int k = 0; k < 2; ++k) dst[m][k] = *(const PG8_LAS bf16x8*)(lds + PG8_SA(b, h) + aoff + m * 2048 + k * 1024); } while (0)
#define PG8_LDB(dst, b, h) do { _Pragma("unroll") for (int n = 0; n < 2; ++n) _Pragma("unroll") for (int k = 0; k < 2; ++k) dst[n][k] = *(const PG8_LAS bf16x8*)(lds + PG8_SB(b, h) + boff + n * 2048 + k * 1024); } while (0)
#define PG8_MMA(ai, bj, At, Bt) do { __builtin_amdgcn_s_setprio(1); _Pragma("unroll") for (int m = 0; m < 4; ++m) _Pragma("unroll") for (int n = 0; n < 2; ++n) _Pragma("unroll") for (int k = 0; k < 2; ++k) \
        acc[ai][bj][m][n] = __builtin_amdgcn_mfma_f32_16x16x32_bf16(Bt[n][k], At[m][k], acc[ai][bj][m][n], 0, 0, 0); __builtin_amdgcn_s_setprio(0); } while (0)
#define PG8_WAIT_V(n) asm volatile("s_waitcnt vmcnt(" #n ")" ::: "memory")
#define PG8_WAIT_L(n) asm volatile("s_waitcnt lgkmcnt(" #n ")" ::: "memory")
#define PG8_BAR __builtin_amdgcn_s_barrier()
#define PG8_SCHED __builtin_amdgcn_sched_barrier(0)
    Unit cur, nxt; int ui = 0;
    if (!S.next(0, cur)) return;
    f32x4 acc[2][2][4][2];
#pragma unroll
    for (int a = 0; a < 2; ++a)
#pragma unroll
        for (int b = 0; b < 2; ++b)
#pragma unroll
            for (int m = 0; m < 4; ++m)
#pragma unroll
                for (int n = 0; n < 2; ++n) acc[a][b][m][n] = (f32x4){0.f, 0.f, 0.f, 0.f};
    bf16x8 At[4][2], B0[2][2], B1[2][2];
    const char* cA = S.a_base(cur); const char* cB = S.b_base(cur);
    PG8_AOFF(vcA, cur);
    S.a_ready(cur);
    if constexpr (SP2) {
        PG8_STAGE(PG8_SB(0, 0), cB, voffB); PG8_STAGE(PG8_SB(0, 1), cB + hstep, voffB); PG8_STAGEA(PG8_SA(0, 0), cA, vcA, 0); PG8_STAGEA(PG8_SA(0, 1), cA, vcA, 1);
        if (wr == 1) PG8_BAR;
        PG8_WAIT_V(2); PG8_BAR;
        PG8_STAGE(PG8_SB(1, 0), cB + kstep, voffB); PG8_STAGEA(PG8_SA(1, 0), cA + kstep, vcA, 0); PG8_STAGE(PG8_SB(1, 1), cB + hstep + kstep, voffB);
        PG8_WAIT_V(6); PG8_BAR;
    } else {
        PG8_STAGE(PG8_SB(0, 0), cB, voffB); PG8_STAGEA(PG8_SA(0, 0), cA, vcA, 0); PG8_STAGE(PG8_SB(0, 1), cB + hstep, voffB); PG8_STAGEA(PG8_SA(0, 1), cA, vcA, 1);
        if (wr == 1) PG8_BAR;
        PG8_WAIT_V(4); PG8_BAR;
        PG8_STAGE(PG8_SB(1, 0), cB + kstep, voffB); PG8_STAGEA(PG8_SA(1, 0), cA + kstep, vcA, 0); PG8_STAGE(PG8_SB(1, 1), cB + hstep + kstep, voffB);
        PG8_WAIT_V(6); PG8_BAR;
    }
    for (;;) {
        const bool has_next = S.next(ui + 1, nxt);
        const char* nA = has_next ? S.a_base(nxt) : cA; const char* nB = has_next ? S.b_base(nxt) : cB;
        if (has_next) { PG8_AOFF(vnA, nxt); } else { _Pragma("unroll") for (int _h = 0; _h < 2; ++_h) _Pragma("unroll") for (int _i = 0; _i < 2; ++_i) vnA[_h][_i] = vcA[_h][_i]; }
        for (int t = 0; t < nt; t += 2) {
            const bool last = (t == nt - 2);
            const char* a1 = cA + (size_t)(t + 1) * kstep;
            const char* a2 = last ? nA : cA + (size_t)(t + 2) * kstep; const char* b2 = last ? nB : cB + (size_t)(t + 2) * kstep;
            const char* a3 = a2 + kstep; const char* b3 = b2 + kstep;
            if (last && has_next) S.a_ready(nxt);
            if constexpr (SP2) {
            PG8_LDB(B0, 0, 0); PG8_LDB(B1, 0, 1); PG8_SCHED; PG8_LDA(At, 0, 0); PG8_STAGEA(PG8_SA(1, 1), a1, vcA, 1);
            PG8_WAIT_V(8); PG8_WAIT_L(0); PG8_BAR; PG8_MMA(0, 0, At, B0); PG8_MMA(0, 1, At, B1); PG8_BAR; PG8_SCHED;
            PG8_LDA(At, 0, 1); PG8_STAGE(PG8_SB(0, 0), b2, voffB); PG8_STAGE(PG8_SB(0, 1), b2 + hstep, voffB); PG8_STAGEA2(PG8_SA(0, 0), a2, 0);
            PG8_WAIT_V(8); PG8_WAIT_L(0); PG8_BAR; PG8_MMA(1, 0, At, B0); PG8_MMA(1, 1, At, B1); PG8_BAR; PG8_SCHED;
            PG8_LDB(B0, 1, 0); PG8_LDB(B1, 1, 1); PG8_SCHED; PG8_LDA(At, 1, 0); PG8_STAGEA2(PG8_SA(0, 1), a2, 1);
            PG8_WAIT_V(8); PG8_WAIT_L(0); PG8_BAR; PG8_MMA(0, 0, At, B0); PG8_MMA(0, 1, At, B1); PG8_BAR; PG8_SCHED;
            PG8_LDA(At, 1, 1); PG8_STAGE(PG8_SB(1, 0), b3, voffB); PG8_STAGE(PG8_SB(1, 1), b3 + hstep, voffB); PG8_STAGEA2(PG8_SA(1, 0), a3, 0);
            PG8_WAIT_V(8); PG8_WAIT_L(0); PG8_BAR; PG8_MMA(1, 0, At, B0); PG8_MMA(1, 1, At, B1); PG8_BAR; PG8_SCHED;
            } else {
            PG8_LDB(B0, 0, 0); PG8_SCHED; PG8_LDA(At, 0, 0); PG8_STAGEA(PG8_SA(1, 1), a1, vcA, 1);
            PG8_WAIT_L(8); PG8_BAR; PG8_WAIT_L(0); PG8_MMA(0, 0, At, B0); PG8_BAR; PG8_SCHED;
            PG8_LDB(B1, 0, 1); PG8_STAGE(PG8_SB(0, 0), b2, voffB);
            PG8_BAR; PG8_WAIT_L(0); PG8_MMA(0, 1, At, B1); PG8_BAR;
            PG8_LDA(At, 0, 1); PG8_STAGEA2(PG8_SA(0, 0), a2, 0);
            PG8_BAR; PG8_WAIT_L(0); PG8_MMA(1, 0, At, B0); PG8_BAR; PG8_SCHED;
            PG8_STAGE(PG8_SB(0, 1), b2 + hstep, voffB);
            PG8_WAIT_V(6); PG8_BAR; PG8_MMA(1, 1, At, B1); PG8_BAR;
            PG8_LDB(B0, 1, 0); PG8_SCHED; PG8_LDA(At, 1, 0); PG8_STAGEA2(PG8_SA(0, 1), a2, 1);
            PG8_WAIT_L(8); PG8_BAR; PG8_WAIT_L(0); PG8_MMA(0, 0, At, B0); PG8_BAR; PG8_SCHED;
            PG8_LDB(B1, 1, 1); PG8_STAGE(PG8_SB(1, 0), b3, voffB);
            PG8_BAR; PG8_WAIT_L(0); PG8_MMA(0, 1, At, B1); PG8_BAR;
            PG8_LDA(At, 1, 1); PG8_STAGEA2(PG8_SA(1, 0), a3, 0);
            PG8_BAR; PG8_WAIT_L(0); PG8_MMA(1, 0, At, B0); PG8_BAR; PG8_SCHED;
            PG8_STAGE(PG8_SB(1, 1), b3 + hstep, voffB);
            PG8_WAIT_V(6); PG8_BAR; PG8_MMA(1, 1, At, B1); PG8_BAR;
            }
        }
        if constexpr (ALIGN_EPI) { if (wr == 0) PG8_BAR; }
        if constexpr (!Epi::AFTER_DRAIN) { E(acc, cur, wr, wc, fr, fq); S.done(cur); }
        if (!has_next) break;
#pragma unroll
        for (int a = 0; a < 2; ++a)
#pragma unroll
            for (int b = 0; b < 2; ++b)
#pragma unroll
                for (int m = 0; m < 4; ++m)
#pragma unroll
                    for (int n = 0; n < 2; ++n) acc[a][b][m][n] = (f32x4){0.f, 0.f, 0.f, 0.f};
        cur = nxt; cA = nA; cB = nB; ++ui;
        _Pragma("unroll") for (int _h = 0; _h < 2; ++_h) _Pragma("unroll") for (int _i = 0; _i < 2; ++_i) vcA[_h][_i] = vnA[_h][_i];
        if constexpr (ALIGN_EPI) { if (wr == 1) PG8_BAR; }
    }
    PG8_WAIT_V(0);
    if constexpr (!ALIGN_EPI) { if (wr == 0) PG8_BAR; }
    PG8_BAR;
    if constexpr (Epi::AFTER_DRAIN) { E.fused(acc, cur, wr, wc, fr, fq, lds, wid, lane); S.done(cur); }
#undef PG8_SA
#undef PG8_SB
#undef PG8_STAGE
#undef PG8_STAGEA
#undef PG8_STAGEA2
#undef PG8_AOFF
#undef PG8_LDA
#undef PG8_LDB
#undef PG8_MMA
#undef PG8_WAIT_V
#undef PG8_WAIT_L
#undef PG8_BAR
#undef PG8_SCHED
}


template <int WHICH> struct MoeOrder {
    const int* TP; int G, c; const char* Abase; const char* Bbase; const int* LIST;
    static constexpr int KK = WHICH == 0 ? 1024 : 512, NN = 4;
    __device__ __forceinline__ bool next(int i, Unit& u) const {
        const int L = i * G + c; if (L >= TP[NEXP]) return false;
        int e = 0;
#pragma unroll 1
        for (int j = 16; j >= 1; j >>= 1) if (TP[e + j] <= L) e += j;
        const int lt = L - TP[e]; u.pm = e * 1024 + lt / NN; u.pn = lt % NN; return true;
    }
    __device__ __forceinline__ const char* a_base(const Unit& u) const { const int e = u.pm >> 10, mt = u.pm & 1023; return WHICH == 0 ? Abase : Abase + (size_t)(TP[64 + e] + mt * 256) * (DEXP * 2); }
    __device__ __forceinline__ const char* b_base(const Unit& u) const { const int e = u.pm >> 10; return Bbase + ((size_t)e * 1024 + (size_t)u.pn * 256) * (KK * 2); }
    __device__ __forceinline__ unsigned a_off(const Unit& u, int r, int C) const {
        if (WHICH == 1) return (unsigned)(r * DEXP + C) * 2u;
        const int e = u.pm >> 10, s = (u.pm & 1023) * 256 + r; const int tok = s < TP[128 + e] ? (LIST[(size_t)e * NR + s] >> 1) : 0;
        return (unsigned)tok * (D * 2) + (unsigned)C * 2u;
    }
    __device__ __forceinline__ void a_ready(const Unit&) const {}
    __device__ __forceinline__ void done(const Unit&) const {}
};
struct TokRowOrder : StaticOrder {
    const char* Abase; const char* Bbase; int K;
    __device__ __forceinline__ const char* a_base(const Unit& u) const { return Abase + (size_t)tokrow(u.pm * BM) * K * 2; }
    __device__ __forceinline__ const char* b_base(const Unit& u) const { return Bbase + (size_t)u.pn * BM * K * 2; }
    __device__ __forceinline__ unsigned a_off(const Unit&, int r, int C) const { return (unsigned)(r * K + C) * 2u; }
};
#define PG8_FOR_FRAGS_M(...) _Pragma("unroll") for (int ai = 0; ai < 2; ++ai) _Pragma("unroll") for (int m = 0; m < 4; ++m) { const int r = ai * HALF + wr * 64 + m * 16 + fr; \
    _Pragma("unroll") for (int bj = 0; bj < 2; ++bj) _Pragma("unroll") for (int n = 0; n < 2; ++n) { const int col = u.pn * BM + bj * HALF + wc * 32 + n * 16 + 4 * fq; ::f32x4 v = acc[ai][bj][m][n]; __VA_ARGS__ } }
struct EpiMoe1 {
    static constexpr bool PERM = false, AFTER_DRAIN = false;
    bf16_t* HID; const int* TP;
    __device__ __forceinline__ void operator()(const f32x4 (&acc)[2][2][4][2], const Unit& u, int wr, int wc, int fr, int fq) const {
        const int e = u.pm >> 10, mt = u.pm & 1023; bf16_t* base = HID + (size_t)(TP[64 + e] + mt * 256) * DEXP;
        PG8_FOR_FRAGS_M( const float h0 = v.x / (1.f + __expf(-v.x)) * v.y, h1 = v.z / (1.f + __expf(-v.z)) * v.w; *(unsigned*)(base + (size_t)r * DEXP + (col >> 1)) = pk2(h0, h1); )
    }
};
struct EpiMoe2 {
    static constexpr bool PERM = false, AFTER_DRAIN = false;
    bf16_t* MO; const int* TP; const int* LIST; const float* GATE;
    __device__ __forceinline__ void operator()(const f32x4 (&acc)[2][2][4][2], const Unit& u, int wr, int wc, int fr, int fq) const {
        const int e = u.pm >> 10, mt = u.pm & 1023, cnt = TP[128 + e];
#pragma unroll
        for (int ai = 0; ai < 2; ++ai)
#pragma unroll
            for (int m = 0; m < 4; ++m) {
                const int s = mt * 256 + ai * HALF + wr * 64 + m * 16 + fr;
                if (s < cnt) {
                    const int ent = LIST[(size_t)e * NR + s]; const float gt = GATE[ent]; bf16_t* row = MO + (size_t)ent * D;
#pragma unroll
                    for (int bj = 0; bj < 2; ++bj)
#pragma unroll
                        for (int n = 0; n < 2; ++n) { const int col = u.pn * BM + bj * HALF + wc * 32 + n * 16 + 4 * fq; const ::f32x4 v = acc[ai][bj][m][n];
                            ::u32x2 w; w.x = pk2(v.x * gt, v.y * gt); w.y = pk2(v.z * gt, v.w * gt); *(::u32x2*)(row + col) = w; }
                }
            }
    }
};
#undef PG8_FOR_FRAGS_M
}
constexpr int SB_NQT = SEQ / 32;
constexpr int SB_VT_STRIDE = 40;
__device__ __forceinline__ void phase_sb_fast(const Params& p, char* lds) {
    const bf16_t* P = (const bf16_t*)(p.ws + WS_P); bf16_t* YA = (bf16_t*)(p.ws + WS_YA);
    const int tid = threadIdx.x, lane = tid & 63, wave = tid >> 6, n = lane & 31, hh = lane >> 5;
    bf16_t* VT = (bf16_t*)(lds + wave * (64 * SB_VT_STRIDE * 2));
    const int gw = blockIdx.x * NWAVES + wave, NGW = gridDim.x * NWAVES;
    for (int unit = gw; unit < 64 * SB_NQT; unit += NGW) {
        const int qt = SB_NQT - 1 - unit / 64, bh = unit % 64, h = bh & 7, b = bh >> 3;
        const int i0 = NMETA + qt * 32, qi = i0 + n, qrow = qi;
        const bf16_t* Pb = P + (size_t)b * T * PW;
        bf16x8 qf[4];
#pragma unroll
        for (int s = 0; s < 4; ++s) qf[s] = *(const bf16x8*)(Pb + (size_t)qrow * PW + C_QA + h * 64 + 16 * s + 8 * hh);
        f32x16 o0, o1;
#pragma unroll
        for (int r = 0; r < 16; ++r) { o0[r] = 0.f; o1[r] = 0.f; }
        float L = 0.f;
        for (int kt = qt + 1; kt >= 0; --kt) {
            const int j0 = kt * 32, krow = (j0 + n) < T ? (j0 + n) : T - 1;
            bf16x8 kf[4];
#pragma unroll
            for (int s = 0; s < 4; ++s) kf[s] = *(const bf16x8*)(Pb + (size_t)krow * PW + C_KA + h * 64 + 16 * s + 8 * hh);
#pragma unroll
            for (int i = 0; i < 4; ++i) {
                const int c = lane + 64 * i, key = c >> 3, d0 = (c & 7) * 8, vrow = (j0 + key) < T ? (j0 + key) : T - 1;
                const u32x4 w = *(const u32x4*)(Pb + (size_t)vrow * PW + C_VA + h * 64 + d0);
                bf16_t* vp = VT + d0 * SB_VT_STRIDE + key;
                vp[0] = (bf16_t)(w.x & 0xffff); vp[SB_VT_STRIDE] = (bf16_t)(w.x >> 16); vp[2 * SB_VT_STRIDE] = (bf16_t)(w.y & 0xffff); vp[3 * SB_VT_STRIDE] = (bf16_t)(w.y >> 16);
                vp[4 * SB_VT_STRIDE] = (bf16_t)(w.z & 0xffff); vp[5 * SB_VT_STRIDE] = (bf16_t)(w.z >> 16); vp[6 * SB_VT_STRIDE] = (bf16_t)(w.w & 0xffff); vp[7 * SB_VT_STRIDE] = (bf16_t)(w.w >> 16);
            }
            f32x16 sa;
#pragma unroll
            for (int r = 0; r < 16; ++r) sa[r] = 0.f;
#pragma unroll
            for (int s = 0; s < 4; ++s) sa = __builtin_amdgcn_mfma_f32_32x32x16_bf16(kf[s], qf[s], sa, 0, 0, 0);
            float lk[16], z[16];
#pragma unroll
            for (int r = 0; r < 16; ++r) {
                const int kk = (r & 3) + 8 * (r >> 2) + 4 * hh; const bool valid = (j0 + kk) < qi;
                const float zz = fminf(sa[r], 80.f); const float l = -__log2f(1.f + exp2f(zz));
                z[r] = zz; lk[r] = valid ? l : 0.f;
            }
            const float gs0 = (lk[0] + lk[1]) + (lk[2] + lk[3]), gs1 = (lk[4] + lk[5]) + (lk[6] + lk[7]), gs2 = (lk[8] + lk[9]) + (lk[10] + lk[11]), gs3 = (lk[12] + lk[13]) + (lk[14] + lk[15]);
            const float ps0 = xpartner32(gs0, hh), ps1 = xpartner32(gs1, hh), ps2 = xpartner32(gs2, hh), ps3 = xpartner32(gs3, hh);
            const float pc3 = ps3, pc2 = pc3 + ps2, pc1 = pc2 + ps1, pc0 = pc1 + ps0;
            float base[4];
            base[3] = L + (hh ? 0.f : pc3);
            base[2] = L + gs3 + (hh ? pc3 : pc2);
            base[1] = L + (gs3 + gs2) + (hh ? pc2 : pc1);
            base[0] = L + (gs3 + gs2 + gs1) + (hh ? pc1 : pc0);
            float a[16];
#pragma unroll
            for (int g = 0; g < 4; ++g) {
                float c = base[g];
#pragma unroll
                for (int e = 3; e >= 0; --e) {
                    const int r = 4 * g + e; c += lk[r];
                    const int kk = e + 8 * g + 4 * hh; const bool valid = (j0 + kk) < qi;
                    a[r] = valid ? exp2f(z[r] + c) : 0.f;
                }
            }
            L += (gs0 + gs1 + gs2 + gs3) + pc0;
            u32x4 pw0, pw1;
            pw0.x = pk2(a[0], a[1]); pw0.y = pk2(a[2], a[3]); pw0.z = pk2(a[4], a[5]); pw0.w = pk2(a[6], a[7]);
            pw1.x = pk2(a[8], a[9]); pw1.y = pk2(a[10], a[11]); pw1.z = pk2(a[12], a[13]); pw1.w = pk2(a[14], a[15]);
            const bf16x8 pf0 = __builtin_bit_cast(bf16x8, pw0), pf1 = __builtin_bit_cast(bf16x8, pw1);
#pragma unroll
            for (int mt = 0; mt < 2; ++mt) {
                const bf16_t* vr = VT + (32 * mt + n) * SB_VT_STRIDE + 4 * hh;
                u32x4 v0, v1;
                { const u32x2 x = *(const u32x2*)(vr), y = *(const u32x2*)(vr + 8); v0.x = x.x; v0.y = x.y; v0.z = y.x; v0.w = y.y; }
                { const u32x2 x = *(const u32x2*)(vr + 16), y = *(const u32x2*)(vr + 24); v1.x = x.x; v1.y = x.y; v1.z = y.x; v1.w = y.y; }
                if (mt == 0) { o0 = __builtin_amdgcn_mfma_f32_32x32x16_bf16(__builtin_bit_cast(bf16x8, v0), pf0, o0, 0, 0, 0); o0 = __builtin_amdgcn_mfma_f32_32x32x16_bf16(__builtin_bit_cast(bf16x8, v1), pf1, o0, 0, 0, 0); }
                else { o1 = __builtin_amdgcn_mfma_f32_32x32x16_bf16(__builtin_bit_cast(bf16x8, v0), pf0, o1, 0, 0, 0); o1 = __builtin_amdgcn_mfma_f32_32x32x16_bf16(__builtin_bit_cast(bf16x8, v1), pf1, o1, 0, 0, 0); }
            }
            const bool done = L < -152.f;
            if (__all(done)) break;
        }
        {
            bf16_t* yp = YA + ((size_t)b * SEQ + (qi - NMETA)) * 512 + h * 64 + 4 * hh;
#pragma unroll
            for (int g = 0; g < 4; ++g) {
                u32x2 w; w.x = pk2(o0[4 * g], o0[4 * g + 1]); w.y = pk2(o0[4 * g + 2], o0[4 * g + 3]); *(u32x2*)(yp + 8 * g) = w;
                w.x = pk2(o1[4 * g], o1[4 * g + 1]); w.y = pk2(o1[4 * g + 2], o1[4 * g + 3]); *(u32x2*)(yp + 32 + 8 * g) = w;
            }
        }
    }
}

constexpr int DSA_NQ = 8;
constexpr int DSA_SCS = 4608;
constexpr int DSA_KVB = 0, DSA_RING = 18432, DSA_IDX = DSA_NQ * DSA_RING, DSA_MISC = DSA_IDX + DSA_NQ * 1024, DSA_LDS = DSA_MISC + 512;
static_assert(DSA_NQ * DSA_SCS * 4 <= DSA_IDX, "score rows fit under the index lists");
__device__ __forceinline__ unsigned fkey(float f) { const unsigned u = __float_as_uint(f); return (u & 0x80000000u) ? ~u : (u | 0x80000000u); }
__device__ __forceinline__ int wave_sum_i32(int v) {
    v += __builtin_amdgcn_update_dpp(0, v, 0xB1, 0xF, 0xF, false);
    v += __builtin_amdgcn_update_dpp(0, v, 0x4E, 0xF, 0xF, false);
    v += __builtin_amdgcn_update_dpp(0, v, 0x141, 0xF, 0xF, false);
    v += __builtin_amdgcn_update_dpp(0, v, 0x140, 0xF, 0xF, false);
    return __builtin_amdgcn_readlane(v, 0) + __builtin_amdgcn_readlane(v, 16) + __builtin_amdgcn_readlane(v, 32) + __builtin_amdgcn_readlane(v, 48);
}
__device__ __forceinline__ int wave_excl_scan_i32(int c, int lane, int& total) {
    int x = c;
    x += __builtin_amdgcn_update_dpp(0, x, 0x111, 0xF, 0xF, true);
    x += __builtin_amdgcn_update_dpp(0, x, 0x112, 0xF, 0xF, true);
    x += __builtin_amdgcn_update_dpp(0, x, 0x114, 0xF, 0xF, true);
    x += __builtin_amdgcn_update_dpp(0, x, 0x118, 0xF, 0xF, true);
    const int t0 = __builtin_amdgcn_readlane(x, 15), t1 = __builtin_amdgcn_readlane(x, 31), t2 = __builtin_amdgcn_readlane(x, 47), t3 = __builtin_amdgcn_readlane(x, 63);
    const int row = lane >> 4;
    x += (row > 0 ? t0 : 0) + (row > 1 ? t1 : 0) + (row > 2 ? t2 : 0);
    total = t0 + t1 + t2 + t3;
    return x - c;
}
__device__ __forceinline__ int mbcnt64(unsigned long long m) { return (int)__builtin_amdgcn_mbcnt_hi((unsigned)(m >> 32), __builtin_amdgcn_mbcnt_lo((unsigned)m, 0u)); }
__device__ __forceinline__ void phase_dsa(const Params& p, char* lds) {
    const bf16_t* P = (const bf16_t*)(p.ws + WS_P); bf16_t* OL = (bf16_t*)(p.ws + WS_OLAT);
    const int tid = threadIdx.x, lane = tid & 63, wave = __builtin_amdgcn_readfirstlane(tid >> 6);
    unsigned* SC = (unsigned*)(lds + DSA_KVB);
    unsigned short* IDX = (unsigned short*)(lds + DSA_IDX);
    int* MISC = (int*)(lds + DSA_MISC);
    const unsigned lds_base = (unsigned)(size_t)lds;
    constexpr int NU = SEQ / DSA_NQ;
    for (int unit = blockIdx.x; unit < BATCH * NU; unit += gridDim.x) {
        const int u8 = NU - 1 - unit / BATCH, b = unit % BATCH, t0 = NMETA + u8 * DSA_NQ;
        const int cid = 1 + (t0 - NMETA) / 64, n = NMETA + 64 * cid;
        const bf16_t* Pb = P + (size_t)b * T * PW;
        const int m = lane & 31, hh = lane >> 5;
        bf16x8 aq[2][4]; float wv[2][16];
#pragma unroll
        for (int rt = 0; rt < 2; ++rt) {
#pragma unroll
            for (int s = 0; s < 4; ++s) aq[rt][s] = *(const bf16x8*)(Pb + (size_t)(t0 + 4 * rt + (m >> 3)) * PW + C_QI + (m & 7) * 64 + 16 * s + 8 * hh);
#pragma unroll
            for (int r = 0; r < 16; ++r) wv[rt][r] = bf2f(Pb[(size_t)(t0 + 4 * rt + (r >> 2)) * PW + C_WI + (r & 3) + 4 * hh]);
        }
        const unsigned char* KIPb = p.ws + WS_KIP + (size_t)b * KIP_BATCH + lane * 16;
        bf16x8 bk[4];
#pragma unroll
        for (int s = 0; s < 4; ++s) bk[s] = *(const bf16x8*)(KIPb + (size_t)wave * 4096 + s * 1024);
        __syncthreads();
        {
            const int ntile = (n + 31) / 32;
            for (int kt = wave; kt < ntile; kt += NWAVES) {
                const int j0 = kt * 32, key = j0 + m;
                bf16x8 bn[4];
                { const int ktn = kt + NWAVES < 129 ? kt + NWAVES : 128;
#pragma unroll
                  for (int s = 0; s < 4; ++s) bn[s] = *(const bf16x8*)(KIPb + (size_t)ktn * 4096 + s * 1024); }
                const bool ok = key < n;
#pragma unroll
                for (int rt = 0; rt < 2; ++rt) {
                    f32x16 acc;
#pragma unroll
                    for (int r = 0; r < 16; ++r) acc[r] = 0.f;
#pragma unroll
                    for (int s = 0; s < 4; ++s) acc = __builtin_amdgcn_mfma_f32_32x32x16_bf16(aq[rt][s], bk[s], acc, 0, 0, 0);
                    float tq[4];
#pragma unroll
                    for (int q = 0; q < 4; ++q) {
#define RELU_(x) __builtin_amdgcn_fmed3f((x), 0.f, 3.0e38f)
                        float s = wv[rt][4 * q] * RELU_(acc[4 * q]); s += wv[rt][4 * q + 1] * RELU_(acc[4 * q + 1]); s += wv[rt][4 * q + 2] * RELU_(acc[4 * q + 2]); s += wv[rt][4 * q + 3] * RELU_(acc[4 * q + 3]);
#undef RELU_
                        tq[q] = xsum32(s);
                    }
                    const float s0 = hh ? tq[2] : tq[0], s1 = hh ? tq[3] : tq[1];
                    SC[(4 * rt + 2 * hh) * DSA_SCS + key] = ok ? fkey(s0) : 0u;
                    SC[(4 * rt + 2 * hh + 1) * DSA_SCS + key] = ok ? fkey(s1) : 0u;
                }
#pragma unroll
                for (int s = 0; s < 4; ++s) bk[s] = bn[s];
            }
        }
        __syncthreads();
        bf16x8 qf[5];
        {
            const int hd_ = lane & 15, g_ = lane >> 4;
#pragma unroll
            for (int ks = 0; ks < 5; ++ks) {
                u32x4 w = (u32x4){0u, 0u, 0u, 0u};
                if (hd_ < 8 && (ks < 4 || g_ < 2)) w = *(const u32x4*)(Pb + (size_t)(t0 + wave) * PW + C_QF + hd_ * QFW + 32 * ks + 8 * g_);
                qf[ks] = __builtin_bit_cast(bf16x8, w);
            }
        }
        {
            unsigned* sc = SC + wave * DSA_SCS;
            unsigned v[65];
#pragma unroll
            for (int i = 0; i < 65; ++i) { const int k = i * 64 + lane; v[i] = (k < n) ? sc[k] : 0u; }
            unsigned prefix = 0u; int cge = n, bit = 31;
            bool exact = false;
            if (n >= 256) {
                for (; bit >= 0 && cge > 512; --bit) {
                    const unsigned cand = prefix | (1u << bit); const int sc_ = (int)(cand ^ 0x80000000u);
                    unsigned b0 = 0u, b1 = 0u, b2 = 0u; int slots = 0;
#pragma unroll
                    for (int gi = 0; gi < 5; ++gi) if (gi * 832 < n) {
#pragma unroll
                        for (int i = 13 * gi; i < 13 * gi + 13; ++i) {
                            const unsigned d = (unsigned)__builtin_elementwise_sub_sat((int)(v[i] ^ 0x80000000u), sc_);
                            if (i % 3 == 0) b0 = __builtin_amdgcn_alignbit(b0, d, 31); else if (i % 3 == 1) b1 = __builtin_amdgcn_alignbit(b1, d, 31); else b2 = __builtin_amdgcn_alignbit(b2, d, 31);
                        }
                        slots += 13 * 64;
                    }
                    const int c = slots - wave_sum_i32(__builtin_popcount(b0) + __builtin_popcount(b1) + __builtin_popcount(b2));
                    if (c >= 256) { prefix = cand; cge = c; if (c == 256) { exact = true; break; } }
                }
            }
            int ngt = n;
            if (n >= 256 && !exact) {
                asm volatile("s_waitcnt lgkmcnt(0)" ::: "memory");
                int cb = 0;
                if (bit >= 0) {
                    const int sp_ = (int)((prefix > 0u ? prefix : 1u) ^ 0x80000000u);
                    unsigned lb0 = 0u, lb1 = 0u, lb2 = 0u;
#pragma unroll
                    for (int i = 0; i < 65; ++i) { const unsigned d = (unsigned)__builtin_elementwise_sub_sat((int)(v[i] ^ 0x80000000u), sp_);
                        if (i < 32) lb0 = __builtin_amdgcn_alignbit(lb0, d, 31); else if (i < 64) lb1 = __builtin_amdgcn_alignbit(lb1, d, 31); else lb2 = d >> 31; }
                    const unsigned tk0 = ~lb0, tk1 = ~lb1, tk2 = (~lb2) & 1u;
                    const int c0 = __builtin_popcount(tk0), c1 = __builtin_popcount(tk1);
                    const int lbase = wave_excl_scan_i32(c0 + c1 + (int)tk2, lane, cb);
#pragma unroll
                    for (int i = 0; i < 65; ++i) {
                        bool tkn; int rk;
                        if (i < 32) { tkn = (tk0 >> (31 - i)) & 1u; rk = i == 0 ? 0 : __builtin_popcount(tk0 >> (32 - i)); }
                        else if (i < 64) { tkn = (tk1 >> (63 - i)) & 1u; rk = c0 + (i == 32 ? 0 : __builtin_popcount(tk1 >> (64 - i))); }
                        else { tkn = tk2 != 0u; rk = c0 + c1; }
                        sc[tkn ? lbase + rk : 4096 + (lane & 15)] = v[i];
                    }
                    asm volatile("s_waitcnt lgkmcnt(0)" ::: "memory");
                    unsigned w[8];
#pragma unroll
                    for (int j = 0; j < 8; ++j) { const int k = j * 64 + lane; w[j] = (k < cb) ? sc[k] : 0u; }
                    for (; bit >= 0; --bit) {
                        const unsigned cand = prefix | (1u << bit); const int sc_ = (int)(cand ^ 0x80000000u); unsigned b0 = 0u, b1 = 0u;
#pragma unroll
                        for (int j = 0; j < 8; ++j) { const unsigned d = (unsigned)__builtin_elementwise_sub_sat((int)(w[j] ^ 0x80000000u), sc_); if (j & 1) b1 = __builtin_amdgcn_alignbit(b1, d, 31); else b0 = __builtin_amdgcn_alignbit(b0, d, 31); }
                        const int c = 512 - wave_sum_i32(__builtin_popcount(b0) + __builtin_popcount(b1));
                        if (c >= 256) { prefix = cand; if (c == 256) { exact = true; break; } }
                    }
                    int c = 0;
#pragma unroll
                    for (int j = 0; j < 8; ++j) c += __popcll(__ballot(w[j] > prefix));
                    ngt = c;
                } else {
                    int c = 0;
#pragma unroll
                    for (int i = 0; i < 65; ++i) { c += __popcll(__ballot(v[i] > prefix)); if ((i & 3) == 3) __builtin_amdgcn_sched_barrier(0); }
                    ngt = c;
                }
            }
            const unsigned tau = prefix;
            const int need_eq = n >= 256 ? 256 - ngt : 0; int base = 0, eqb = 0;
            unsigned short* idx = IDX + wave * 512;
            int neq = 0;
            {
                const int st_ = (int)(tau ^ 0x80000000u); unsigned e0 = 0u, e1 = 0u, e2 = 0u;
#pragma unroll
                for (int i = 0; i < 65; ++i) { const unsigned d = (unsigned)__builtin_elementwise_sub_sat((int)(v[i] ^ 0x80000000u), st_);
                    if (i < 32) e0 = __builtin_amdgcn_alignbit(e0, d, 31); else if (i < 64) e1 = __builtin_amdgcn_alignbit(e1, d, 31); else e2 = d >> 31; }
                const unsigned tk0 = ~e0, tk1 = ~e1, tk2 = (~e2) & 1u;
                const int c0 = __builtin_popcount(tk0), c1 = __builtin_popcount(tk1);
                int nge; const int lbase = wave_excl_scan_i32(c0 + c1 + (int)tk2, lane, nge);
                neq = nge - ngt;
                if (n >= 256 && nge == 256) {
#pragma unroll
                    for (int i = 0; i < 65; ++i) {
                        bool tkn; int rk;
                        if (i < 32) { tkn = (tk0 >> (31 - i)) & 1u; rk = i == 0 ? 0 : __builtin_popcount(tk0 >> (32 - i)); }
                        else if (i < 64) { tkn = (tk1 >> (63 - i)) & 1u; rk = c0 + (i == 32 ? 0 : __builtin_popcount(tk1 >> (64 - i))); }
                        else { tkn = tk2 != 0u; rk = c0 + c1; }
                        idx[tkn ? lbase + rk : 256 + lane] = (unsigned short)(i * 64 + lane);
                    }
                    base = nge;
                } else {
#pragma unroll
                    for (int gi = 0; gi < 5; ++gi) if (gi * 832 < n) {
#pragma unroll
                        for (int i = 13 * gi; i < 13 * gi + 13; ++i) {
                            const int k = i * 64 + lane; const unsigned u = v[i];
                            const bool eq = (u == tau); const unsigned long long meq = __ballot(eq);
                            const bool take = (u > tau) || (eq && (eqb + mbcnt64(meq)) < need_eq);
                            const unsigned long long mt = __ballot(take);
                            idx[take ? base + mbcnt64(mt) : 256 + lane] = (unsigned short)k;
                            base += __popcll(mt); eqb += __popcll(meq);
                            if ((i & 3) == 3) __builtin_amdgcn_sched_barrier(0);
                        }
                    }
                }
            }
            for (int pos = base + lane; pos < 256; pos += 64) idx[pos] = 0;
            if (lane == 0) MISC[wave] = base;
        }
        asm volatile("s_waitcnt lgkmcnt(0)" ::: "memory");
        {
            const int q = wave; const int nsel = MISC[q];
            const size_t qrow = (size_t)(t0 + q);
            int ln = lane; asm volatile("" : "+v"(ln));
            const int hd = ln & 15, g = ln >> 4, qd = (ln & 15) >> 2, pp = ln & 3;
            char* ring = lds + DSA_KVB + wave * DSA_RING;
            const unsigned ring_a = lds_base + DSA_KVB + wave * DSA_RING;
            const unsigned short* idx = IDX + q * 512;
            asm volatile("s_waitcnt vmcnt(0)" ::: "memory");
#define DSA_ISSUE(c) do { _Pragma("unroll") for (int i_ = 0; i_ < 9; ++i_) { const int pid_ = ln + 64 * i_, row_ = pid_ / 18, part_ = pid_ - row_ * 18; \
                const bf16_t* src_ = Pb + (size_t)idx[32 * (c) + row_] * PW + C_KV + part_ * 8; \
                __builtin_amdgcn_global_load_lds((const unsigned*)src_, (LAS unsigned*)(ring + ((c) & 1) * 9216 + i_ * 1024), 16, 0, 0); } } while (0)
            DSA_ISSUE(0); DSA_ISSUE(1);
            f32x4 O[8];
#pragma unroll
            for (int nt = 0; nt < 8; ++nt) O[nt] = (f32x4){0.f, 0.f, 0.f, 0.f};
            float mrun = -3e38f, lrun = 0.f;
            for (int c = 0; c < 8; ++c) {
                if (c < 7) asm volatile("s_waitcnt vmcnt(9)" ::: "memory"); else asm volatile("s_waitcnt vmcnt(0)" ::: "memory");
                const char* buf = ring + (c & 1) * 9216;
                f32x4 S0 = (f32x4){0.f, 0.f, 0.f, 0.f}, S1 = S0;
                {
                    const char* kr = buf + hd * 288 + 16 * g;
#pragma unroll
                    for (int ks = 0; ks < 4; ++ks) { S0 = __builtin_amdgcn_mfma_f32_16x16x32_bf16(*(const bf16x8*)(kr + 64 * ks), qf[ks], S0, 0, 0, 0); S1 = __builtin_amdgcn_mfma_f32_16x16x32_bf16(*(const bf16x8*)(kr + 16 * 288 + 64 * ks), qf[ks], S1, 0, 0, 0); }
                    u32x4 w0 = (u32x4){0u, 0u, 0u, 0u}, w1 = w0; if (g < 2) { w0 = *(const u32x4*)(kr + 256); w1 = *(const u32x4*)(kr + 16 * 288 + 256); }
                    S0 = __builtin_amdgcn_mfma_f32_16x16x32_bf16(__builtin_bit_cast(bf16x8, w0), qf[4], S0, 0, 0, 0); S1 = __builtin_amdgcn_mfma_f32_16x16x32_bf16(__builtin_bit_cast(bf16x8, w1), qf[4], S1, 0, 0, 0);
                }
                float cm = -3e38f;
#pragma unroll
                for (int r = 0; r < 4; ++r) { if (nsel < 256) { const int sl = 32 * c + 4 * g + r; S0[r] = sl < nsel ? S0[r] : -1e30f; S1[r] = (sl + 16) < nsel ? S1[r] : -1e30f; } cm = fmaxf(cm, fmaxf(S0[r], S1[r])); }
                cm = xmax16(xmax32(cm));
                const float mnew = fmaxf(mrun, cm), alpha = exp2f(mrun - mnew);
                float ps = 0.f;
#pragma unroll
                for (int r = 0; r < 4; ++r) { S0[r] = exp2f(S0[r] - mnew); S1[r] = exp2f(S1[r] - mnew); ps += S0[r] + S1[r]; }
                ps = xsum16(xsum32(ps));
                lrun = lrun * alpha + ps; mrun = mnew;
                if (__any(alpha != 1.f)) {
                    const float a0 = __shfl(alpha, 4 * g), a1 = __shfl(alpha, 4 * g + 1), a2 = __shfl(alpha, 4 * g + 2), a3 = __shfl(alpha, 4 * g + 3);
#pragma unroll
                    for (int nt = 0; nt < 8; ++nt) { O[nt][0] *= a0; O[nt][1] *= a1; O[nt][2] *= a2; O[nt][3] *= a3; }
                }
                u32x4 pw; pw.x = pk2(S0[0], S0[1]); pw.y = pk2(S0[2], S0[3]); pw.z = pk2(S1[0], S1[1]); pw.w = pk2(S1[2], S1[3]);
                const bf16x8 pf = __builtin_bit_cast(bf16x8, pw);
                const unsigned va = ring_a + (unsigned)((c & 1) * 9216 + (4 * g + qd) * 288 + 8 * pp);
#pragma unroll
                for (int h2 = 0; h2 < 2; ++h2) {
                    u16x4 x0, x1, x2, x3, y0, y1, y2, y3;
                    asm volatile("ds_read_b64_tr_b16 %0, %8 offset:%9\n\tds_read_b64_tr_b16 %1, %8 offset:%10\n\tds_read_b64_tr_b16 %2, %8 offset:%11\n\tds_read_b64_tr_b16 %3, %8 offset:%12\n\t"
                                 "ds_read_b64_tr_b16 %4, %8 offset:%13\n\tds_read_b64_tr_b16 %5, %8 offset:%14\n\tds_read_b64_tr_b16 %6, %8 offset:%15\n\tds_read_b64_tr_b16 %7, %8 offset:%16\n\ts_waitcnt lgkmcnt(0)"
                                 : "=&v"(x0), "=&v"(x1), "=&v"(x2), "=&v"(x3), "=&v"(y0), "=&v"(y1), "=&v"(y2), "=&v"(y3)
                                 : "v"(va), "i"(128 * h2), "i"(128 * h2 + 32), "i"(128 * h2 + 64), "i"(128 * h2 + 96), "i"(128 * h2 + 4608), "i"(128 * h2 + 4640), "i"(128 * h2 + 4672), "i"(128 * h2 + 4704) : "memory");
#define DSA_PV(nt_, x_, y_) do { bf16x8 vf_; vf_[0] = (short)x_[0]; vf_[1] = (short)x_[1]; vf_[2] = (short)x_[2]; vf_[3] = (short)x_[3]; vf_[4] = (short)y_[0]; vf_[5] = (short)y_[1]; vf_[6] = (short)y_[2]; vf_[7] = (short)y_[3]; \
                    O[nt_] = __builtin_amdgcn_mfma_f32_16x16x32_bf16(pf, vf_, O[nt_], 0, 0, 0); } while (0)
                    DSA_PV(4 * h2 + 0, x0, y0); DSA_PV(4 * h2 + 1, x1, y1); DSA_PV(4 * h2 + 2, x2, y2); DSA_PV(4 * h2 + 3, x3, y3);
                }
                asm volatile("s_waitcnt lgkmcnt(0)" ::: "memory");
                if (c + 2 < 8) DSA_ISSUE(c + 2);
            }
#undef DSA_PV
#undef DSA_ISSUE
            const float inv = 1.f / lrun;
            const float i0 = __shfl(inv, 4 * g), i1 = __shfl(inv, 4 * g + 1), i2 = __shfl(inv, 4 * g + 2), i3 = __shfl(inv, 4 * g + 3);
            if (g < 2) {
                bf16_t* op = OL + ((size_t)b * SEQ + (qrow - NMETA)) * 1024 + (4 * g) * 128 + hd;
#pragma unroll
                for (int nt = 0; nt < 8; ++nt) { op[16 * nt] = (bf16_t)f2bf(O[nt][0] * i0); op[128 + 16 * nt] = (bf16_t)f2bf(O[nt][1] * i1); op[256 + 16 * nt] = (bf16_t)f2bf(O[nt][2] * i2); op[384 + 16 * nt] = (bf16_t)f2bf(O[nt][3] * i3); }
            }
        }
    }
}

__device__ __forceinline__ void phase_inproj_meta(const Params& p) {
    unsigned char* ws = p.ws; const int tid = threadIdx.x, lane = tid & 63, wave = tid >> 6, fr = lane & 15, fq = lane >> 4;
    const bf16_t* U = (const bf16_t*)(ws + WS_U); const bf16_t* WP = (const bf16_t*)(ws + WS_WP); bf16_t* P = (bf16_t*)(ws + WS_P); const float2* cs = (const float2*)(ws + WS_CS);
    const int gw = blockIdx.x * NWAVES + wave, NGW = gridDim.x * NWAVES;
    for (int nt = gw; nt < PW / 16; nt += NGW) {
        const bf16_t* ap = U + (size_t)fr * D + 8 * fq; const bf16_t* bp = WP + (size_t)(16 * nt + fr) * D + 8 * fq;
        f32x4 acc = (f32x4){0.f, 0.f, 0.f, 0.f};
#pragma unroll 8
        for (int ks = 0; ks < D / 32; ++ks) acc = __builtin_amdgcn_mfma_f32_16x16x32_bf16(*(const bf16x8*)(bp + 32 * ks), *(const bf16x8*)(ap + 32 * ks), acc, 0, 0, 0);
        const int col = 16 * nt + 4 * fq, t = fr; f32x4 v = acc; int o;
        if (pg8::rope_off(col, o)) { const float2 c0 = cs[t * 8 + (o >> 1)], c1 = cs[t * 8 + (o >> 1) + 1]; v = (f32x4){v.x * c0.x - v.y * c0.y, v.y * c0.x + v.x * c0.y, v.z * c1.x - v.w * c1.y, v.w * c1.x + v.z * c1.y}; }
        u32x2 w; w.x = pk2(v.x, v.y); w.y = pk2(v.z, v.w);
        for (int b = 0; b < BATCH; ++b) {
            if (col >= C_KI && col < C_WI) { const int d0 = col - C_KI;
                *(u32x2*)(ws + WS_KIP + (size_t)b * KIP_BATCH + (size_t)((((t >> 5) * 4 + (d0 >> 4)) * 2 + ((d0 >> 3) & 1)) * 512 + (t & 31) * 16 + (d0 & 7) * 2)) = w; }
            else *(u32x2*)(P + ((size_t)b * T + t) * PW + col) = w;
        }
    }
}

__device__ __forceinline__ void phase_c3(const Params& p, char* lds) {
    unsigned char* ws = p.ws; const int tid = threadIdx.x, lane = tid & 63, wave = __builtin_amdgcn_readfirstlane(tid >> 6);
    const float* H1 = (const float*)(ws + WS_H1); const float* g = p.in[I_GFFN];
    {
        bf16_t* U2 = (bf16_t*)(ws + WS_U); const int gw = blockIdx.x * NWAVES + wave, NGW = gridDim.x * NWAVES;
        for (int row = gw; row < NR; row += NGW) {
            const f32x4* xr = (const f32x4*)(H1 + (size_t)row * D) + lane;
            f32x4 v[4]; float s = 0.f;
#pragma unroll
            for (int j = 0; j < 4; ++j) { v[j] = xr[64 * j]; s += (v[j].x * v[j].x + v[j].y * v[j].y) + (v[j].z * v[j].z + v[j].w * v[j].w); }
            const float rstd = rsqrtf(wave_sum(s) * (1.f / D) + NORM_EPS);
            u32x2* o = (u32x2*)(U2 + (size_t)row * D) + lane;
#pragma unroll
            for (int j = 0; j < 4; ++j) { const f32x4 gg = ((const f32x4*)g)[lane + 64 * j];
                u32x2 w; w.x = pk2(v[j].x * rstd * gg.x, v[j].y * rstd * gg.y); w.y = pk2(v[j].z * rstd * gg.z, v[j].w * rstd * gg.w); o[64 * j] = w; }
        }
    }
    {
        float* Tl = (float*)lds;
        float* RED = (float*)lds;
        const float* wg = p.in[I_WGRP]; const float* wr = p.in[I_WRT]; const float* bg = p.in[I_BGRP]; const float* br = p.in[I_BRT];
        unsigned* ctl = (unsigned*)(ws + WS_CTL); int* LIST = (int*)(ws + WS_LIST); float* GATE = (float*)(ws + WS_GATE);
        const int tk = tid & 127, kq = wave >> 1;
        for (int grp = blockIdx.x; grp < NR / 128; grp += gridDim.x) {
            const int tok0 = grp * 128;
            float acc[36]; float ss = 0.f;
#pragma unroll
            for (int o = 0; o < 36; ++o) acc[o] = 0.f;
            for (int step = 0; step < 8; ++step) {
                __syncthreads();
#pragma unroll
                for (int i = 0; i < 8; ++i) { const int idx = tid + NTHREADS * i, qq = idx >> 10, rem = idx & 1023, t2 = rem >> 3, kc = rem & 7;
                    const f32x4 v = *(const f32x4*)(H1 + (size_t)(tok0 + t2) * D + qq * 256 + step * 32 + kc * 4);
                    float* d = Tl + qq * (32 * 129) + (kc * 4) * 129 + t2; d[0] = v.x; d[129] = v.y; d[258] = v.z; d[387] = v.w; }
                __syncthreads();
                const int kb = kq * 256 + step * 32;
#pragma unroll 4
                for (int k = 0; k < 32; ++k) {
                    const float h = Tl[kq * (32 * 129) + k * 129 + tk]; ss += h * h; const float hg = h * g[kb + k];
                    const float* w4 = wg + (size_t)(kb + k) * 4; const float* w32 = wr + (size_t)(kb + k) * 32;
#pragma unroll
                    for (int o = 0; o < 4; ++o) acc[o] += hg * w4[o];
#pragma unroll
                    for (int o = 0; o < 32; ++o) acc[4 + o] += hg * w32[o];
                }
            }
            __syncthreads();
#pragma unroll
            for (int o = 0; o < 36; ++o) RED[(kq * 37 + o) * 128 + tk] = acc[o];
            RED[(kq * 37 + 36) * 128 + tk] = ss;
            __syncthreads();
            if (tid < 128) {
                const int tok = tok0 + tk;
#pragma unroll
                for (int o = 0; o < 36; ++o) acc[o] = (RED[o * 128 + tk] + RED[(37 + o) * 128 + tk]) + (RED[(74 + o) * 128 + tk] + RED[(111 + o) * 128 + tk]);
                ss = (RED[36 * 128 + tk] + RED[(37 + 36) * 128 + tk]) + (RED[(74 + 36) * 128 + tk] + RED[(111 + 36) * 128 + tk]);
                const float rstd = rsqrtf(ss * (1.f / D) + NORM_EPS);
                float gl[4]; int gs = 0; float gm;
#pragma unroll
                for (int o = 0; o < 4; ++o) gl[o] = acc[o] * rstd + bg[o];
                gm = gl[0];
#pragma unroll
                for (int o = 1; o < 4; ++o) if (gl[o] > gm) { gm = gl[o]; gs = o; }
                float gsum = 0.f;
#pragma unroll
                for (int o = 0; o < 4; ++o) gsum += __expf(gl[o] - gm);
                const float pgrp = 1.f / gsum;
                float el[8];
#pragma unroll
                for (int j = 0; j < 8; ++j) { float a = acc[4 + j]; float bb = br[j];
                    a = gs == 1 ? acc[12 + j] : a; bb = gs == 1 ? br[8 + j] : bb; a = gs == 2 ? acc[20 + j] : a; bb = gs == 2 ? br[16 + j] : bb; a = gs == 3 ? acc[28 + j] : a; bb = gs == 3 ? br[24 + j] : bb;
                    el[j] = a * rstd + bb; }
                int e0 = 0; float m0 = el[0];
#pragma unroll
                for (int j = 1; j < 8; ++j) if (el[j] > m0) { m0 = el[j]; e0 = j; }
                int e1 = -1; float m1 = -3e38f;
#pragma unroll
                for (int j = 0; j < 8; ++j) if (j != e0 && el[j] > m1) { m1 = el[j]; e1 = j; }
                const float x1 = __expf(m1 - m0); const float g0 = pgrp / (1.f + x1), g1 = pgrp * x1 / (1.f + x1);
                const int ex0 = gs * 8 + e0, ex1 = gs * 8 + e1;
                const int s0 = (int)atomicAdd(ctl + CW_CNT + 64 * ex0, 1u); LIST[(size_t)ex0 * NR + s0] = tok * 2;
                const int s1 = (int)atomicAdd(ctl + CW_CNT + 64 * ex1, 1u); LIST[(size_t)ex1 * NR + s1] = tok * 2 + 1;
                GATE[tok * 2] = g0; GATE[tok * 2 + 1] = g1;
            }
        }
    }
}

template <int WHICH>
__device__ __forceinline__ void phase_moe(const Params& p, char* lds) {
    unsigned char* ws = p.ws; const int tid = threadIdx.x;
    const unsigned* ctl = (const unsigned*)(ws + WS_CTL);
    int* TP = (int*)(lds + pg8::STAGE_BYTES);
    __syncthreads();
    if (tid == 0) { int tp = 0, ro = 0; for (int e = 0; e < NEXP; ++e) { const int c = (int)ctl[CW_CNT + 64 * e]; TP[e] = tp; TP[64 + e] = ro; TP[128 + e] = c; const int t = (c + 255) / 256; tp += t * 4; ro += t * 256; } TP[NEXP] = tp; }
    __syncthreads();
    pg8::MoeOrder<WHICH> S{TP, (int)gridDim.x, (int)blockIdx.x, (const char*)(ws + (WHICH == 0 ? WS_U : WS_HID)), (const char*)(ws + (WHICH == 0 ? WS_W13 : WS_W2)), (const int*)(ws + WS_LIST)};
    if constexpr (WHICH == 0) { pg8::EpiMoe1 E{(bf16_t*)(ws + WS_HID), TP}; pg8::gemm_phase_x<pg8::EpiMoe1, pg8::MoeOrder<0>, true, true>((LAS unsigned char*)lds, 1024, S, E); }
    else { pg8::EpiMoe2 E{(bf16_t*)(ws + WS_MO), TP, (const int*)(ws + WS_LIST), (const float*)(ws + WS_GATE)}; pg8::gemm_phase_x<pg8::EpiMoe2, pg8::MoeOrder<1>, true, true>((LAS unsigned char*)lds, 512, S, E); }
}

__device__ __forceinline__ void phase_final(const Params& p) {
    unsigned char* ws = p.ws; const int tid = threadIdx.x, lane = tid & 63, wave = tid >> 6;
    const float* H1 = (const float*)(ws + WS_H1); const bf16_t* MO = (const bf16_t*)(ws + WS_MO); const float* g = p.in[I_GFIN];
    const int gw = blockIdx.x * NWAVES + wave, NGW = gridDim.x * NWAVES;
    for (int orow = gw; orow < BATCH * SEQ; orow += NGW) {
        const size_t row = (size_t)orow;
        const f32x4* xr = (const f32x4*)(H1 + row * D) + lane; const u32x2* m0 = (const u32x2*)(MO + row * 2 * D) + lane; const u32x2* m1 = m0 + 256;
        f32x4 v[4]; float ss = 0.f;
#pragma unroll
        for (int j = 0; j < 4; ++j) { const u32x2 a = m0[64 * j], c = m1[64 * j]; v[j] = xr[64 * j];
            v[j].x += bflo(a.x) + bflo(c.x); v[j].y += bfhi(a.x) + bfhi(c.x); v[j].z += bflo(a.y) + bflo(c.y); v[j].w += bfhi(a.y) + bfhi(c.y);
            ss += (v[j].x * v[j].x + v[j].y * v[j].y) + (v[j].z * v[j].z + v[j].w * v[j].w); }
        const float rstd = rsqrtf(wave_sum(ss) * (1.f / D) + NORM_EPS);
        f32x4* o = (f32x4*)(p.out + (size_t)orow * D) + lane;
#pragma unroll
        for (int j = 0; j < 4; ++j) { const f32x4 gg = ((const f32x4*)g)[lane + 64 * j]; o[64 * j] = v[j] * rstd * gg; }
    }
}

#define XB_TMO      128
#define XB_XCNT(j)  (256  + 64 * (j))
#define XB_XSUB(j)  (1280 + 64 * (j))
#define XB_XGEN(j)  (2304 + 64 * (j))
#define XB_TOP      3328
#define XB_TOPGEN   3392
#define XCD_BAR_WORDS 3456
#define XB_SPIN_CAP (1u << 18)
__device__ __forceinline__ unsigned xb_ld(unsigned* p)              { return __hip_atomic_load(p, __ATOMIC_RELAXED, __HIP_MEMORY_SCOPE_AGENT); }
__device__ __forceinline__ unsigned xb_add(unsigned* p, unsigned v) { return __hip_atomic_fetch_add(p, v, __ATOMIC_RELAXED, __HIP_MEMORY_SCOPE_AGENT); }
__device__ __forceinline__ unsigned xb_xcc_id() { return (unsigned)__builtin_amdgcn_s_getreg((3 << 11) | 20) & 0xFu; }
#define XB_SPIN(cond, bar) do { unsigned _sp = 0; while (cond) { __builtin_amdgcn_s_sleep(1); \
    if ((++_sp & 255u) == 0u) { if (xb_ld(&(bar)[XB_TMO])) break; if (_sp > XB_SPIN_CAP) { atomicAdd(&(bar)[XB_TMO], 1u); break; } } } } while (0)
struct XcdBarrier { unsigned* bar; unsigned x; volatile LAS unsigned* st; };
__device__ __forceinline__ XcdBarrier xcd_barrier_post(unsigned* bar, volatile LAS unsigned* st) {
    XcdBarrier b; b.bar = bar; b.x = xb_xcc_id(); b.st = st;
    if (threadIdx.x == 0) (void)xb_add(&bar[XB_XCNT(b.x)], 1u);
    return b;
}
__device__ __forceinline__ void xcd_barrier_complete(unsigned* bar, unsigned x, unsigned& nloc, unsigned& nx) {
    const unsigned G = gridDim.x * gridDim.y * gridDim.z;
    unsigned sum, cnt, mine, sp = 0u;
    for (;;) {
        sum = 0u; cnt = 0u; mine = 0u;
#pragma unroll
        for (unsigned j = 0; j < 16; ++j) { const unsigned c = xb_ld(&bar[XB_XCNT(j)]); sum += c; cnt += (c > 0u) ? 1u : 0u; mine = (j == x) ? c : mine; }
        if (sum == G) break;
        __builtin_amdgcn_s_sleep(1);
        if ((++sp & 255u) == 0u) { if (xb_ld(&bar[XB_TMO])) break; if (sp > XB_SPIN_CAP) { atomicAdd(&bar[XB_TMO], 1u); break; } }
    }
    nloc = mine > 0u ? mine : 1u; nx = cnt > 0u ? cnt : 1u;
}
__device__ __forceinline__ void xcd_barrier(const XcdBarrier& b) {
    asm volatile("s_waitcnt vmcnt(0)" ::: "memory");
    __syncthreads();
    if (threadIdx.x == 0) {
        unsigned* bar = b.bar;
        __builtin_amdgcn_s_waitcnt(0);
        unsigned nloc = b.st[0], nx = b.st[1];
        if (nloc == 0u) { xcd_barrier_complete(bar, b.x, nloc, nx); b.st[0] = nloc; b.st[1] = nx; }
        const unsigned old = xb_add(&bar[XB_XSUB(b.x)], 1u);
        const unsigned gen = old / nloc;
        if (old + 1u == (gen + 1u) * nloc) {
            __builtin_amdgcn_fence(__ATOMIC_RELEASE, "agent");
            asm volatile("s_waitcnt vmcnt(0)" ::: "memory");
            const unsigned og = xb_add(&bar[XB_TOP], 1u);
            const unsigned tg = og / nx;
            if (og + 1u == (tg + 1u) * nx) xb_add(&bar[XB_TOPGEN], 1u);
            else XB_SPIN(xb_ld(&bar[XB_TOPGEN]) == tg, bar);
            __builtin_amdgcn_fence(__ATOMIC_ACQUIRE, "agent");
            xb_add(&bar[XB_XGEN(b.x)], 1u);
            asm volatile("s_waitcnt vmcnt(0)" ::: "memory");
        } else {
            XB_SPIN(xb_ld(&bar[XB_XGEN(b.x)]) == gen, bar);
            __builtin_amdgcn_fence(__ATOMIC_ACQUIRE, "agent");
            asm volatile("s_waitcnt vmcnt(0)" ::: "memory");
        }
    }
    __syncthreads();
}

constexpr int LDS_XB = DSA_LDS;
constexpr int LDS_BYTES = DSA_LDS + 256;
static_assert(pg8::STAGE_BYTES <= LDS_XB && pg8::STAGE_BYTES + 1024 <= LDS_XB && NWAVES * 64 * 33 * 4 <= LDS_XB && NWAVES * 64 * SB_VT_STRIDE * 2 <= LDS_XB && 4 * 37 * 128 * 4 <= LDS_XB, "LDS map");

__global__ void __launch_bounds__(NTHREADS, 2) mega(Params p) {
    extern __shared__ __attribute__((aligned(16))) char lds[];
    const int lo = p.ph_lo, hi = p.ph_hi;
    unsigned char* ws = p.ws;
    XcdBarrier xb;
    {
        volatile LAS unsigned* st = (volatile LAS unsigned*)(lds + LDS_XB);
        if (threadIdx.x < 4) st[threadIdx.x] = 0u;
        __syncthreads();
        xb = xcd_barrier_post((unsigned*)(ws + WS_CTL) + CW_BAR, st);
    }
#define IN(k) (lo <= (k) && (k) < hi)
#define GSYNC() xcd_barrier(xb)
#define SEAM(k) do { if (IN(k) && IN((k) + 1)) GSYNC(); } while (0)
#define REP(k, ...) do { if (IN(k)) { __VA_ARGS__; if (PROBE_PH == (k)) { GSYNC(); __VA_ARGS__; } } } while (0)
    LAS unsigned char* ldsl = (LAS unsigned char*)lds;
    REP(0, phase_prologue(p, lds));
    SEAM(0);
    REP(1, { phase_inproj_meta(p);
             pg8::TokRowOrder S; S.init(NR, PWN, gridDim.x, blockIdx.x); S.Abase = (const char*)(ws + WS_U); S.Bbase = (const char*)(ws + WS_WP); S.K = D;
             pg8::EpiInproj E{(bf16_t*)(ws + WS_P), (const float2*)(ws + WS_CS), ws + WS_KIP}; pg8::gemm_phase_x<pg8::EpiInproj, pg8::TokRowOrder, true, true>(ldsl, D, S, E); });
    SEAM(1);
    if (IN(2)) {
        phase_dsa(p, lds);
        if (PROBE_PH == 20) { GSYNC(); phase_dsa(p, lds); }
        __syncthreads(); phase_sb_fast(p, lds);
        if (PROBE_PH == 21) { GSYNC(); phase_sb_fast(p, lds); }
    }
    SEAM(2);
    REP(3, { pg8::TokRowOrder S; S.init(NR, 2048, gridDim.x, blockIdx.x); S.Abase = (const char*)(ws + WS_U); S.Bbase = (const char*)(ws + WS_WG); S.K = D;
             pg8::EpiGate E{(bf16_t*)(ws + WS_G)}; pg8::gemm_phase_x<pg8::EpiGate, pg8::TokRowOrder, true, true>(ldsl, D, S, E); });
    SEAM(3);
    REP(4, { { pg8::Gemm g{(const bf16_t*)(ws + WS_YA), (const bf16_t*)(ws + WS_WUA), NR, D, 512}; pg8::StaticOrder S; S.init(NR, D, gridDim.x, blockIdx.x);
               pg8::EpiZ<false> E{(bf16_t*)(ws + WS_Z), (const bf16_t*)(ws + WS_G), 0}; pg8::gemm_phase<pg8::EpiZ<false>, pg8::StaticOrder, true, true>(ldsl, g, S, E); }
             asm volatile("s_waitcnt vmcnt(0)" ::: "memory"); __syncthreads();
             { pg8::Gemm g{(const bf16_t*)(ws + WS_OLAT), (const bf16_t*)(ws + WS_WBP), NR, D, D}; pg8::StaticOrder S; S.init(NR, D, gridDim.x, blockIdx.x);
               pg8::EpiZ<true> E{(bf16_t*)(ws + WS_Z), (const bf16_t*)(ws + WS_G), 1024}; pg8::gemm_phase<pg8::EpiZ<true>, pg8::StaticOrder, true, true>(ldsl, g, S, E); } });
    SEAM(4);
    REP(5, { pg8::Gemm g{(const bf16_t*)(ws + WS_Z), (const bf16_t*)(ws + WS_WO), NR, D, D}; pg8::StaticOrder S; S.init(NR, D, gridDim.x, blockIdx.x);
             pg8::EpiH1 E{(float*)(ws + WS_H1), p.in[I_META], p.in[I_X]}; pg8::gemm_phase<pg8::EpiH1, pg8::StaticOrder, true, true>(ldsl, g, S, E); });
    SEAM(5);
    if (IN(6)) phase_c3(p, lds);
    SEAM(6);
    REP(7, phase_moe<0>(p, lds));
    SEAM(7);
    REP(8, phase_moe<1>(p, lds));
    SEAM(8);
    REP(9, phase_final(p));
}

extern "C" void kernel_launch(void* const* d_in, const int* in_sizes, int n_in, void* d_out, int out_size, void* d_ws, size_t ws_size, hipStream_t stream) {
    if (n_in != 18 || ws_size < WS_END) { fprintf(stderr, "kernel_launch: unexpected n_in %d / ws_size %zu\n", n_in, ws_size); return; }
    static int grid = 0;
    if (grid == 0) {
        int dev = 0, cus = 0, per_cu = 0;
        (void)hipGetDevice(&dev);
        (void)hipDeviceGetAttribute(&cus, hipDeviceAttributeMultiprocessorCount, dev);
        (void)hipFuncSetAttribute((const void*)mega, hipFuncAttributeMaxDynamicSharedMemorySize, LDS_BYTES);
        (void)hipOccupancyMaxActiveBlocksPerMultiprocessor(&per_cu, (const void*)mega, NTHREADS, LDS_BYTES);
        if (per_cu < 1) fprintf(stderr, "kernel_launch: occupancy query reports %d workgroups per CU\n", per_cu);
        grid = cus;
    }
    (void)hipMemsetAsync((char*)d_ws + WS_CTL, 0, CTL_BYTES, stream);
    Params p{};
    for (int i = 0; i < 18; ++i) p.in[i] = (const float*)d_in[i];
    p.out = (float*)d_out; p.ws = (unsigned char*)d_ws;
    p.ph_lo = 0; p.ph_hi = 10;
    void* args[] = {&p};
    hipError_t e = hipLaunchCooperativeKernel((const void*)mega, dim3(grid), dim3(NTHREADS), args, LDS_BYTES, stream);
    if (e != hipSuccess) fprintf(stderr, "cooperative launch failed: %s (grid %d)\n", hipGetErrorString(e), grid);
}
```

```cpp
#include <hip/hip_runtime.h>
#include <cstdio>
#include <cstdint>
#ifndef PROBE_PH
#define PROBE_PH -1
#endif

constexpr int BATCH = 8, SEQ = 4096, NMETA = 16, T = SEQ + NMETA, D = 1024, NTOK = BATCH * T;
constexpr int MROWS = 33024;
constexpr int NR = BATCH * SEQ;
__device__ __forceinline__ int tokrow(int cr) { return cr + NMETA * (cr / SEQ + 1); }
constexpr int INW = 4824;
constexpr int NEXP = 32, DEXP = 512;
constexpr int NWAVES = 8, NTHREADS = 512;
constexpr float NORM_EPS = 1e-6f;
constexpr float LOG2E = 1.4426950408889634f;
constexpr float QSCALE = 0.125f * LOG2E;
constexpr int PW = 3456, PWN = 3584;
constexpr int C_QA = 0, C_KA = 512, C_VA = 1024, C_QF = 1536, C_KV = 2688, C_QI = 2832, C_KI = 3344, C_WI = 3408, C_END = 3416;
constexpr int QFW = 144;

constexpr size_t MiB = 1u << 20;
constexpr size_t WS_CTL = 0, CTL_BYTES = 1 * MiB;
constexpr size_t WS_CS = 1 * MiB;
constexpr size_t WS_WP = 2 * MiB;
constexpr size_t WS_WG = 9 * MiB;
constexpr size_t WS_WUA = 13 * MiB, WS_WBP = 14 * MiB, WS_WO = 16 * MiB;
constexpr size_t WS_W2 = 18 * MiB;
constexpr size_t WS_W13 = 50 * MiB;
constexpr size_t WS_U = 114 * MiB;
constexpr size_t WS_P = 179 * MiB;
constexpr size_t WS_Z = 179 * MiB;
constexpr size_t WS_G = 244 * MiB;
constexpr size_t WS_H1 = 244 * MiB;
constexpr size_t WS_LIST = 374 * MiB;
constexpr size_t WS_GATE = 379 * MiB;
constexpr size_t WS_YA = 397 * MiB;
constexpr size_t WS_OLAT = 430 * MiB;
constexpr size_t WS_HID = 397 * MiB;
constexpr size_t WS_MO = 50 * MiB;
constexpr size_t WS_KIP = 495 * MiB;
constexpr size_t KIP_BATCH = 129 * 4096;
constexpr size_t WS_END = 500 * MiB;
static_assert(WS_P + (size_t)MROWS * PW * 2 <= WS_YA && WS_G + (size_t)MROWS * 2048 * 2 <= WS_LIST && WS_Z + (size_t)MROWS * 1024 * 2 <= WS_G, "ws map");
static_assert(WS_OLAT + (size_t)MROWS * 1024 * 2 <= WS_END && WS_U + (size_t)MROWS * 1024 * 2 <= WS_P && WS_MO + (size_t)NTOK * 2048 * 2 <= WS_P, "ws map");
constexpr int CW_CNT = 1024;
constexpr int CW_BAR = 4096;

typedef unsigned short bf16_t;
typedef short bf16x8 __attribute__((ext_vector_type(8)));
typedef float f32x4 __attribute__((ext_vector_type(4)));
typedef float f32x16 __attribute__((ext_vector_type(16)));
typedef unsigned u32x2 __attribute__((ext_vector_type(2)));
typedef unsigned u32x4 __attribute__((ext_vector_type(4)));
typedef unsigned short u16x4 __attribute__((ext_vector_type(4)));
#define LAS __attribute__((address_space(3)))

__device__ __forceinline__ unsigned f2bf(float f) { unsigned u = __float_as_uint(f); return (u + 0x7fffu + ((u >> 16) & 1u)) >> 16; }
typedef __bf16 bf16v2_t __attribute__((ext_vector_type(2)));
typedef float f32v2_t __attribute__((ext_vector_type(2)));
__device__ __forceinline__ unsigned pk2(float lo, float hi) { const f32v2_t v = {lo, hi}; const bf16v2_t r = __builtin_convertvector(v, bf16v2_t); return __builtin_bit_cast(unsigned, r); }
__device__ __forceinline__ float bflo(unsigned w) { return __uint_as_float(w << 16); }
__device__ __forceinline__ float bfhi(unsigned w) { return __uint_as_float(w & 0xffff0000u); }
__device__ __forceinline__ float bf2f(bf16_t b) { return __uint_as_float((unsigned)b << 16); }
__device__ __forceinline__ float wave_sum(float v) {
#pragma unroll
    for (int o = 1; o < 64; o <<= 1) v += __shfl_xor(v, o);
    return v;
}
__device__ __forceinline__ float xsum32(float x) { const auto r = __builtin_amdgcn_permlane32_swap(__float_as_uint(x), __float_as_uint(x), false, false); return __uint_as_float(r[0]) + __uint_as_float(r[1]); }
__device__ __forceinline__ float xsum16(float x) { const auto r = __builtin_amdgcn_permlane16_swap(__float_as_uint(x), __float_as_uint(x), false, false); return __uint_as_float(r[0]) + __uint_as_float(r[1]); }
__device__ __forceinline__ float xmax32(float x) { const auto r = __builtin_amdgcn_permlane32_swap(__float_as_uint(x), __float_as_uint(x), false, false); return fmaxf(__uint_as_float(r[0]), __uint_as_float(r[1])); }
__device__ __forceinline__ float xmax16(float x) { const auto r = __builtin_amdgcn_permlane16_swap(__float_as_uint(x), __float_as_uint(x), false, false); return fmaxf(__uint_as_float(r[0]), __uint_as_float(r[1])); }
__device__ __forceinline__ float xpartner32(float x, int hh) { const auto r = __builtin_amdgcn_permlane32_swap(__float_as_uint(x), __float_as_uint(x), false, false); return __uint_as_float(hh ? r[0] : r[1]); }
__device__ __forceinline__ float sigmoidf(float x) { return 1.0f / (1.0f + __expf(-x)); }

struct Params {
    const float* in[18];
    float* out;
    unsigned char* ws;
    int ph_lo, ph_hi;
};
enum { I_X = 0, I_META, I_GMIX, I_WIN, I_WUK, I_WUV, I_WUPA, I_WUPB, I_WO, I_GFFN, I_WGRP, I_BGRP, I_WRT, I_BRT, I_W1, I_W3, I_W2, I_GFIN };

__device__ __forceinline__ const float* h0_row(const Params& p, int row) {
    const int b = row / T, t = row - b * T;
    return t < NMETA ? p.in[I_META] + (size_t)t * D : p.in[I_X] + ((size_t)b * SEQ + (t - NMETA)) * D;
}
template <class F>
__device__ __forceinline__ void tr_item(F val, bf16_t* dst, int ldd, int row0, int k0, float* scr, int lane, int rstep = 1) {
    float tv[32];
#pragma unroll
    for (int i = 0; i < 32; ++i) tv[i] = val(k0 + 2 * i + (lane >> 5), lane & 31);
#pragma unroll
    for (int i = 0; i < 32; ++i) scr[(2 * i + (lane >> 5)) * 33 + (lane & 31)] = tv[i];
    __builtin_amdgcn_s_waitcnt(0xC07F);
    asm volatile("" ::: "memory");
    const int c = lane & 7;
#pragma unroll
    for (int j = 0; j < 4; ++j) {
        const int n = (lane >> 3) + 8 * j; const float* s = scr + (8 * c) * 33 + n;
        u32x4 o; o.x = pk2(s[0], s[33]); o.y = pk2(s[66], s[99]); o.z = pk2(s[132], s[165]); o.w = pk2(s[198], s[231]);
        *(u32x4*)(dst + (size_t)(row0 + n * rstep) * ldd + k0 + 8 * c) = o;
    }
    __builtin_amdgcn_s_waitcnt(0xC07F);
    asm volatile("" ::: "memory");
}

__device__ __forceinline__ void wp_src(int c, int& kind, int& col, int& aux, float& scale) {
    kind = 1; aux = 0; scale = 1.f; col = 0;
    if (c < 512) { col = c; scale = QSCALE; }
    else if (c < C_QF) { col = c; }
    else if (c < C_KV) { const int r = c - C_QF, h = r / QFW, j = r % QFW; scale = QSCALE;
        if (j < 128) { kind = 2; col = h; aux = j; } else { const int i = j - 128; col = 1536 + 64 * h + (i >> 1) + 8 * (i & 1); } }
    else if (c < C_QI) { const int j = c - C_KV; if (j < 128) col = 2048 + j; else { const int i = j - 128; col = 2176 + (i >> 1) + 8 * (i & 1); } }
    else if (c < C_KI) { const int r = c - C_QI, h = r >> 6, j = r & 63; col = 2192 + 64 * h + (j < 16 ? (j >> 1) + 8 * (j & 1) : j); }
    else if (c < C_WI) { const int j = c - C_KI; col = 2704 + (j < 16 ? (j >> 1) + 8 * (j & 1) : j); }
    else if (c < C_END) { col = 2768 + (c - C_WI); }
    else kind = 0;
}

constexpr int IT_WP = (PWN / 32) * 16;
constexpr int IT_WG = 32 * 16;
constexpr int IT_WUA = 32 * 8;
constexpr int IT_WBP = 32 * 16, IT_WO = 32 * 16;
constexpr int IT_W13 = NEXP * 32 * 16;
constexpr int IT_W2 = NEXP * 32 * 8;
constexpr int IT_TOTAL = IT_WP + 2 * IT_WG + IT_WUA + IT_WBP + IT_WO + IT_W13 + IT_W2;

__device__ __forceinline__ void phase_prologue(const Params& p, char* lds) {
    const int tid = threadIdx.x, lane = tid & 63, wave = tid >> 6;
    const int gw = blockIdx.x * NWAVES + wave, NGW = gridDim.x * NWAVES;
    float* scr = (float*)lds + wave * (64 * 33);
    unsigned char* ws = p.ws;
    const float* w_in = p.in[I_WIN];
    {
        float2* cs = (float2*)(ws + WS_CS);
        for (int i = blockIdx.x * NTHREADS + tid; i < T * 8; i += gridDim.x * NTHREADS) {
            const int pos = i >> 3, f = i & 7;
            const float inv = powf(500000.0f, -(float)f / 8.0f);
            const float ang = (float)pos * inv;
            cs[i] = make_float2(cosf(ang), sinf(ang));
        }
    }
    for (int it = gw; it < IT_TOTAL; it += NGW) {
        int r = it;
        if (r < IT_WP) {
            const int rg = r / 16, kb = r % 16, c = rg * 32 + (lane & 31);
            int kind, col, aux; float scale; wp_src(c, kind, col, aux, scale);
            const float* w_uk = p.in[I_WUK];
            float wu[48];
#pragma unroll
            for (int n4 = 0; n4 < 12; ++n4) { f32x4 t = (f32x4){0.f, 0.f, 0.f, 0.f}; if (kind == 2) t = *(const f32x4*)(w_uk + ((size_t)col * 128 + aux) * 48 + 4 * n4); wu[4 * n4] = t.x; wu[4 * n4 + 1] = t.y; wu[4 * n4 + 2] = t.z; wu[4 * n4 + 3] = t.w; }
            tr_item([&](int k, int) -> float {
                if (kind == 0) return 0.f;
                if (kind == 1) return scale * w_in[(size_t)k * INW + col];
                const f32x4* wi = (const f32x4*)(w_in + (size_t)k * INW + 1536 + 64 * col + 16);
                float s = 0.f;
#pragma unroll
                for (int n4 = 0; n4 < 12; ++n4) { const f32x4 t = wi[n4]; s += t.x * wu[4 * n4] + t.y * wu[4 * n4 + 1] + t.z * wu[4 * n4 + 2] + t.w * wu[4 * n4 + 3]; }
                return scale * s; }, (bf16_t*)(ws + WS_WP), 1024, rg * 32, kb * 64, scr, lane);
            continue; }
        r -= IT_WP;
        if (r < 2 * IT_WG) {
            const int which = r / IT_WG; r %= IT_WG; const int rg = r / 16, kb = r % 16; const int col0 = (which ? 3800 : 2776) + rg * 32;
            tr_item([&](int k, int n) -> float { return w_in[(size_t)k * INW + col0 + n]; }, (bf16_t*)(ws + WS_WG) + (size_t)which * 1024 * 1024, 1024, rg * 32, kb * 64, scr, lane);
            continue; }
        r -= 2 * IT_WG;
        if (r < IT_WUA) {
            const int rg = r / 8, kb = r % 8; const float* w = p.in[I_WUPA];
            tr_item([&](int k, int n) -> float { return w[(size_t)k * 1024 + rg * 32 + n]; }, (bf16_t*)(ws + WS_WUA), 512, rg * 32, kb * 64, scr, lane);
            continue; }
        r -= IT_WUA;
        if (r < IT_WBP) {
            const int rg = r / 16, kb = r % 16; const float* wuv = p.in[I_WUV]; const float* wub = p.in[I_WUPB];
            const int hB = kb >> 1;
            float bc[64];
#pragma unroll
            for (int d = 0; d < 64; ++d) bc[d] = wub[(size_t)(64 * hB + d) * 1024 + rg * 32 + (lane & 31)];
            tr_item([&](int kk, int) -> float {
                const f32x4* a = (const f32x4*)(wuv + (size_t)kk * 64);
                float s = 0.f;
#pragma unroll
                for (int d4 = 0; d4 < 16; ++d4) { const f32x4 t = a[d4]; s += t.x * bc[4 * d4] + t.y * bc[4 * d4 + 1] + t.z * bc[4 * d4 + 2] + t.w * bc[4 * d4 + 3]; }
                return s; }, (bf16_t*)(ws + WS_WBP), 1024, rg * 32, kb * 64, scr, lane);
            continue; }
        r -= IT_WBP;
        if (r < IT_WO) {
            const int rg = r / 16, kb = r % 16; const float* w = p.in[I_WO];
            tr_item([&](int k, int n) -> float { return w[(size_t)k * 1024 + rg * 32 + n]; }, (bf16_t*)(ws + WS_WO), 1024, rg * 32, kb * 64, scr, lane);
            continue; }
        r -= IT_WO;
        if (r < IT_W13) {
            const int e = r / 512; r %= 512; const int which = r & 1, cg = (r >> 1) & 15, kb = r >> 5;
            const float* w = (which ? p.in[I_W3] : p.in[I_W1]) + (size_t)e * 1024 * 512 + cg * 32;
            tr_item([&](int k, int n) -> float { return w[(size_t)k * 512 + n]; },
                    (bf16_t*)(ws + WS_W13) + (size_t)e * 1024 * 1024, 1024, 2 * cg * 32 + which, kb * 64, scr, lane, 2);
            continue; }
        r -= IT_W13;
        {
            const int e = r / 256; r %= 256; const int rg = r / 8, kb = r % 8;
            const float* w2 = p.in[I_W2] + (size_t)e * 512 * 1024;
            tr_item([&](int k, int n) -> float { return w2[(size_t)k * 1024 + rg * 32 + n]; }, (bf16_t*)(ws + WS_W2) + (size_t)e * 1024 * 512, 512, rg * 32, kb * 64, scr, lane);
        }
    }
    {
        const float* g = p.in[I_GMIX]; bf16_t* U = (bf16_t*)(ws + WS_U);
        for (int row = gw; row < NTOK; row += NGW) {
            const f32x4* xr = (const f32x4*)h0_row(p, row) + lane;
            f32x4 v[4]; float s = 0.f;
#pragma unroll
            for (int j = 0; j < 4; ++j) { v[j] = xr[64 * j]; s += (v[j].x * v[j].x + v[j].y * v[j].y) + (v[j].z * v[j].z + v[j].w * v[j].w); }
            const float rstd = rsqrtf(wave_sum(s) * (1.f / D) + NORM_EPS);
            u32x2* o = (u32x2*)(U + (size_t)row * D) + lane;
#pragma unroll
            for (int j = 0; j < 4; ++j) { const f32x4 gg = ((const f32x4*)g)[lane + 64 * j];
                u32x2 w; w.x = pk2(v[j].x * rstd * gg.x, v[j].y * rstd * gg.y); w.y = pk2(v[j].z * rstd * gg.z, v[j].w * rstd * gg.w); o[64 * j] = w; }
        }
    }
}

namespace pg8 {
#define PG8_LAS __attribute__((address_space(3)))
typedef unsigned short bf16_t;
typedef short bf16x8 __attribute__((ext_vector_type(8)));
typedef float f32x4 __attribute__((ext_vector_type(4)));
typedef unsigned u32x4 __attribute__((ext_vector_type(4)));
constexpr int BM = 256, BK = 64, HALF = 128, HTB = HALF * BK * 2  , STAGE_BYTES = 8 * HTB, NXCD = 8, WGM = 8;

__host__ __device__ __forceinline__ int lds_byte(int r, int c) { const int st = (r >> 4) * 2 + (c >> 5), rr = r & 15, cc = c & 31, ob = rr * 64 + cc * 2; return st * 1024 + (ob ^ (((ob >> 9) & 1) << 5)); }
__host__ __device__ __forceinline__ void stage_rc(int b, int& R, int& C) { const int st = b / 1024, sb = b % 1024, swz = sb ^ (((sb >> 9) & 1) << 5); R = (st >> 1) * 16 + swz / 64; C = (st & 1) * 32 + (swz % 64) / 2; }
__host__ __device__ __forceinline__ int perm32(int rho) { const int n = rho >> 4, i = rho & 15; return 8 * (i >> 2) + 4 * n + (i & 3); }

struct Unit { int pm, pn; };
struct Gemm { const bf16_t* A; const bf16_t* Bt; int M, N, K; };

struct StaticOrder {
    int nM, nN, nwg, G, c;
    __host__ __device__ void init(int M, int N, int G_, int c_) { nM = M / BM; nN = N / BM; nwg = nM * nN; G = G_; c = c_; }
    __host__ __device__ bool next(int i, Unit& u) const {
        const long L = (long)i * G + c; if (L >= nwg) return false;
        int wgid = (int)L; { const int q = nwg / NXCD, r = nwg % NXCD, xcd = wgid % NXCD, off = wgid / NXCD; wgid = (xcd < r ? xcd * (q + 1) : r * (q + 1) + (xcd - r) * q) + off; }
        const int nig = WGM * nN, gid = wgid / nig, fm = gid * WGM, gsz = (nM - fm) < WGM ? (nM - fm) : WGM;
        u.pm = fm + ((wgid % nig) % gsz); u.pn = (wgid % nig) / gsz; return true;
    }
    __device__ __forceinline__ void a_ready(const Unit&) const {}
    __device__ __forceinline__ void done(const Unit&) const {}
};


#define PG8_FOR_FRAGS(...) _Pragma("unroll") for (int ai = 0; ai < 2; ++ai) _Pragma("unroll") for (int m = 0; m < 4; ++m) { const int row = u.pm * BM + ai * HALF + wr * 64 + m * 16 + fr; \
    _Pragma("unroll") for (int bj = 0; bj < 2; ++bj) _Pragma("unroll") for (int n = 0; n < 2; ++n) { const int col = u.pn * BM + bj * HALF + wc * 32 + n * 16 + 4 * fq; ::f32x4 v = acc[ai][bj][m][n]; __VA_ARGS__ } }
__device__ __forceinline__ bool rope_off(int c, int& o) {
    if (c < C_QF) return false;
    if (c < C_KV) { const int j = (c - C_QF) % QFW; o = j - 128; return j >= 128; }
    if (c < C_QI) { const int j = c - C_KV; o = j - 128; return j >= 128; }
    if (c < C_KI) { const int j = (c - C_QI) & 63; o = j; return j < 16; }
    if (c < C_WI) { const int j = c - C_KI; o = j; return j < 16; }
    return false;
}
struct EpiInproj {
    static constexpr bool PERM = false, AFTER_DRAIN = false;
    bf16_t* P; const float2* cs; unsigned char* KIP;
    __device__ __forceinline__ void operator()(const f32x4 (&acc)[2][2][4][2], const Unit& u, int wr, int wc, int fr, int fq) const {
        PG8_FOR_FRAGS(
            if (col < PW) {
                int o; const int trow = tokrow(row);
                if (rope_off(col, o)) {
                    const int pos = (row % SEQ) + NMETA; const float2 c0 = cs[pos * 8 + (o >> 1)], c1 = cs[pos * 8 + (o >> 1) + 1];
                    v = (::f32x4){v.x * c0.x - v.y * c0.y, v.y * c0.x + v.x * c0.y, v.z * c1.x - v.w * c1.y, v.w * c1.x + v.z * c1.y};
                }
                ::u32x2 w; w.x = pk2(v.x, v.y); w.y = pk2(v.z, v.w);
                if (col >= C_KI && col < C_WI) {
                    { const int b = row / SEQ, t = row - b * SEQ + NMETA, d0 = col - C_KI;
                        *(::u32x2*)(KIP + (size_t)b * KIP_BATCH + (size_t)((((t >> 5) * 4 + (d0 >> 4)) * 2 + ((d0 >> 3) & 1)) * 512 + (t & 31) * 16 + (d0 & 7) * 2)) = w; }
                } else *(::u32x2*)(P + (size_t)trow * PW + col) = w;
            })
    }
};
struct EpiGate {
    static constexpr bool PERM = false, AFTER_DRAIN = false;
    bf16_t* G;
    __device__ __forceinline__ void operator()(const f32x4 (&acc)[2][2][4][2], const Unit& u, int wr, int wc, int fr, int fq) const {
        PG8_FOR_FRAGS( ::u32x2 w; w.x = pk2(sigmoidf(v.x), sigmoidf(v.y)); w.y = pk2(sigmoidf(v.z), sigmoidf(v.w)); *(::u32x2*)(G + (size_t)row * 2048 + col) = w; )
    }
};
template <bool ACCUM> struct EpiZ {
    static constexpr bool PERM = false, AFTER_DRAIN = false;
    bf16_t* Z; const bf16_t* G; int goff;
    __device__ __forceinline__ void operator()(const f32x4 (&acc)[2][2][4][2], const Unit& u, int wr, int wc, int fr, int fq) const {
        PG8_FOR_FRAGS(
            const ::u32x2 g = *(const ::u32x2*)(G + (size_t)row * 2048 + goff + col);
            ::f32x4 z = (::f32x4){bflo(g.x) * v.x, bfhi(g.x) * v.y, bflo(g.y) * v.z, bfhi(g.y) * v.w};
            ::u32x2* zp = (::u32x2*)(Z + (size_t)row * D + col);
            if (ACCUM) { const ::u32x2 o = *zp; z.x += bflo(o.x); z.y += bfhi(o.x); z.z += bflo(o.y); z.w += bfhi(o.y); }
            ::u32x2 w; w.x = pk2(z.x, z.y); w.y = pk2(z.z, z.w); *zp = w; )
    }
};
struct EpiH1 {
    static constexpr bool PERM = false, AFTER_DRAIN = false;
    float* H1; const float* meta; const float* x;
    __device__ __forceinline__ void operator()(const f32x4 (&acc)[2][2][4][2], const Unit& u, int wr, int wc, int fr, int fq) const {
        PG8_FOR_FRAGS( const ::f32x4 h = *(const ::f32x4*)(x + (size_t)row * D + col); *(::f32x4*)(H1 + (size_t)row * D + col) = h + v; )
    }
};
#undef PG8_FOR_FRAGS

template <class Epi, class Sched, bool ALIGN_EPI = false, bool SP2 = false>
__device__ __forceinline__ void gemm_phase(PG8_LAS unsigned char* lds, const Gemm g, const Sched& S, const Epi& E) {
    const int tid = threadIdx.x, wid = __builtin_amdgcn_readfirstlane(tid >> 6), lane = tid & 63, wr = wid >> 2, wc = wid & 3, fr = lane & 15, fq = lane >> 4;
    const int K = g.K, nt = K / BK;
    unsigned voffA[2], voffB[2];
#pragma unroll
    for (int i = 0; i < 2; ++i) { int R, C; stage_rc(tid * 16 + i * 8192, R, C); const int Rb = Epi::PERM ? ((R & ~31) + perm32(R & 31)) : R;
        voffA[i] = (unsigned)(R * K + C) * 2u; voffB[i] = (unsigned)(Rb * K + C) * 2u; }
    const size_t kstep = (size_t)(BK * 2);
    const size_t hstep = (size_t)HALF * K * 2;
    const size_t tstep = 2 * hstep;
    const unsigned ldsw = (unsigned)wid * 1024u;
    const int aoff = lds_byte(wr * 64 + fr, fq * 8), boff = lds_byte(wc * 32 + fr, fq * 8);
#define PG8_SA(b, h) (((b) * 2 + (h)) * HTB)
#define PG8_SB(b, h) ((4 + (b) * 2 + (h)) * HTB)
#define PG8_STAGE(bufoff, gbase, voff) do { _Pragma("unroll") for (int _i = 0; _i < 2; ++_i) \
        __builtin_amdgcn_global_load_lds((const unsigned*)((const char*)(gbase) + (voff)[_i]), (PG8_LAS unsigned*)(lds + (bufoff) + ldsw + _i * 8192), 16, 0, 0); } while (0)
#define PG8_LDA(dst, b, h) do { _Pragma("unroll") for (int m = 0; m < 4; ++m) _Pragma("unroll") for (int k = 0; k < 2; ++k) dst[m][k] = *(const PG8_LAS bf16x8*)(lds + PG8_SA(b, h) + aoff + m * 2048 + k * 1024); } while (0)
#define PG8_LDB(dst, b, h) do { _Pragma("unroll") for (int n = 0; n < 2; ++n) _Pragma("unroll") for (int k = 0; k < 2; ++k) dst[n][k] = *(const PG8_LAS bf16x8*)(lds + PG8_SB(b, h) + boff + n * 2048 + k * 1024); } while (0)
#define PG8_MMA(ai, bj, At, Bt) do { __builtin_amdgcn_s_setprio(1); _Pragma("unroll") for (int m = 0; m < 4; ++m) _Pragma("unroll") for (int n = 0; n < 2; ++n) _Pragma("unroll") for (int k = 0; k < 2; ++k) \
        acc[ai][bj][m][n] = __builtin_amdgcn_mfma_f32_16x16x32_bf16(Bt[n][k], At[m][k], acc[ai][bj][m][n], 0, 0, 0); __builtin_amdgcn_s_setprio(0); } while (0)
#define PG8_WAIT_V(n) asm volatile("s_waitcnt vmcnt(" #n ")" ::: "memory")
#define PG8_WAIT_L(n) asm volatile("s_waitcnt lgkmcnt(" #n ")" ::: "memory")
#define PG8_BAR __builtin_amdgcn_s_barrier()
#define PG8_SCHED __builtin_amdgcn_sched_barrier(0)
    Unit cur, nxt; int ui = 0;
    if (!S.next(0, cur)) return;
    f32x4 acc[2][2][4][2];
#pragma unroll
    for (int a = 0; a < 2; ++a)
#pragma unroll
        for (int b = 0; b < 2; ++b)
#pragma unroll
            for (int m = 0; m < 4; ++m)
#pragma unroll
                for (int n = 0; n < 2; ++n) acc[a][b][m][n] = (f32x4){0.f, 0.f, 0.f, 0.f};
    bf16x8 At[4][2], B0[2][2], B1[2][2];
    const char* cA = (const char*)g.A + (size_t)cur.pm * tstep; const char* cB = (const char*)g.Bt + (size_t)cur.pn * tstep;
    S.a_ready(cur);
    if constexpr (SP2) {
        PG8_STAGE(PG8_SB(0, 0), cB, voffB); PG8_STAGE(PG8_SB(0, 1), cB + hstep, voffB); PG8_STAGE(PG8_SA(0, 0), cA, voffA); PG8_STAGE(PG8_SA(0, 1), cA + hstep, voffA);
        if (wr == 1) PG8_BAR;
        PG8_WAIT_V(2); PG8_BAR;
        PG8_STAGE(PG8_SB(1, 0), cB + kstep, voffB); PG8_STAGE(PG8_SA(1, 0), cA + kstep, voffA); PG8_STAGE(PG8_SB(1, 1), cB + hstep + kstep, voffB);
        PG8_WAIT_V(6); PG8_BAR;
    } else {
        PG8_STAGE(PG8_SB(0, 0), cB, voffB); PG8_STAGE(PG8_SA(0, 0), cA, voffA); PG8_STAGE(PG8_SB(0, 1), cB + hstep, voffB); PG8_STAGE(PG8_SA(0, 1), cA + hstep, voffA);
        if (wr == 1) PG8_BAR;
        PG8_WAIT_V(4); PG8_BAR;
        PG8_STAGE(PG8_SB(1, 0), cB + kstep, voffB); PG8_STAGE(PG8_SA(1, 0), cA + kstep, voffA); PG8_STAGE(PG8_SB(1, 1), cB + hstep + kstep, voffB);
        PG8_WAIT_V(6); PG8_BAR;
    }
    for (;;) {
        const bool has_next = S.next(ui + 1, nxt);
        const char* nA = has_next ? (const char*)g.A + (size_t)nxt.pm * tstep : cA; const char* nB = has_next ? (const char*)g.Bt + (size_t)nxt.pn * tstep : cB;
        for (int t = 0; t < nt; t += 2) {
            const bool last = (t == nt - 2);
            const char* a1 = cA + (size_t)(t + 1) * kstep;
            const char* a2 = last ? nA : cA + (size_t)(t + 2) * kstep; const char* b2 = last ? nB : cB + (size_t)(t + 2) * kstep;
            const char* a3 = a2 + kstep; const char* b3 = b2 + kstep;
            if (last && has_next) S.a_ready(nxt);
            if constexpr (SP2) {
            PG8_LDB(B0, 0, 0); PG8_LDB(B1, 0, 1); PG8_SCHED; PG8_LDA(At, 0, 0); PG8_STAGE(PG8_SA(1, 1), a1 + hstep, voffA);
            PG8_WAIT_V(8); PG8_WAIT_L(0); PG8_BAR; PG8_MMA(0, 0, At, B0); PG8_MMA(0, 1, At, B1); PG8_BAR; PG8_SCHED;
            PG8_LDA(At, 0, 1); PG8_STAGE(PG8_SB(0, 0), b2, voffB); PG8_STAGE(PG8_SB(0, 1), b2 + hstep, voffB); PG8_STAGE(PG8_SA(0, 0), a2, voffA);
            PG8_WAIT_V(8); PG8_WAIT_L(0); PG8_BAR; PG8_MMA(1, 0, At, B0); PG8_MMA(1, 1, At, B1); PG8_BAR; PG8_SCHED;
            PG8_LDB(B0, 1, 0); PG8_LDB(B1, 1, 1); PG8_SCHED; PG8_LDA(At, 1, 0); PG8_STAGE(PG8_SA(0, 1), a2 + hstep, voffA);
            PG8_WAIT_V(8); PG8_WAIT_L(0); PG8_BAR; PG8_MMA(0, 0, At, B0); PG8_MMA(0, 1, At, B1); PG8_BAR; PG8_SCHED;
            PG8_LDA(At, 1, 1); PG8_STAGE(PG8_SB(1, 0), b3, voffB); PG8_STAGE(PG8_SB(1, 1), b3 + hstep, voffB); PG8_STAGE(PG8_SA(1, 0), a3, voffA);
            PG8_WAIT_V(8); PG8_WAIT_L(0); PG8_BAR; PG8_MMA(1, 0, At, B0); PG8_MMA(1, 1, At, B1); PG8_BAR; PG8_SCHED;
            } else {
            PG8_LDB(B0, 0, 0); PG8_SCHED; PG8_LDA(At, 0, 0); PG8_STAGE(PG8_SA(1, 1), a1 + hstep, voffA);
            PG8_WAIT_L(8); PG8_BAR; PG8_WAIT_L(0); PG8_MMA(0, 0, At, B0); PG8_BAR; PG8_SCHED;
            PG8_LDB(B1, 0, 1); PG8_STAGE(PG8_SB(0, 0), b2, voffB);
            PG8_BAR; PG8_WAIT_L(0); PG8_MMA(0, 1, At, B1); PG8_BAR;
            PG8_LDA(At, 0, 1); PG8_STAGE(PG8_SA(0, 0), a2, voffA);
            PG8_BAR; PG8_WAIT_L(0); PG8_MMA(1, 0, At, B0); PG8_BAR; PG8_SCHED;
            PG8_STAGE(PG8_SB(0, 1), b2 + hstep, voffB);
            PG8_WAIT_V(6); PG8_BAR; PG8_MMA(1, 1, At, B1); PG8_BAR;
            PG8_LDB(B0, 1, 0); PG8_SCHED; PG8_LDA(At, 1, 0); PG8_STAGE(PG8_SA(0, 1), a2 + hstep, voffA);
            PG8_WAIT_L(8); PG8_BAR; PG8_WAIT_L(0); PG8_MMA(0, 0, At, B0); PG8_BAR; PG8_SCHED;
            PG8_LDB(B1, 1, 1); PG8_STAGE(PG8_SB(1, 0), b3, voffB);
            PG8_BAR; PG8_WAIT_L(0); PG8_MMA(0, 1, At, B1); PG8_BAR;
            PG8_LDA(At, 1, 1); PG8_STAGE(PG8_SA(1, 0), a3, voffA);
            PG8_BAR; PG8_WAIT_L(0); PG8_MMA(1, 0, At, B0); PG8_BAR; PG8_SCHED;
            PG8_STAGE(PG8_SB(1, 1), b3 + hstep, voffB);
            PG8_WAIT_V(6); PG8_BAR; PG8_MMA(1, 1, At, B1); PG8_BAR;
            }
        }
        if constexpr (ALIGN_EPI) { if (wr == 0) PG8_BAR; }
        if constexpr (!Epi::AFTER_DRAIN) { E(acc, cur, wr, wc, fr, fq); S.done(cur); }
        if (!has_next) break;
#pragma unroll
        for (int a = 0; a < 2; ++a)
#pragma unroll
            for (int b = 0; b < 2; ++b)
#pragma unroll
                for (int m = 0; m < 4; ++m)
#pragma unroll
                    for (int n = 0; n < 2; ++n) acc[a][b][m][n] = (f32x4){0.f, 0.f, 0.f, 0.f};
        cur = nxt; cA = nA; cB = nB; ++ui;
        if constexpr (ALIGN_EPI) { if (wr == 1) PG8_BAR; }
    }
    PG8_WAIT_V(0);
    if constexpr (!ALIGN_EPI) { if (wr == 0) PG8_BAR; }
    PG8_BAR;
    if constexpr (Epi::AFTER_DRAIN) { E.fused(acc, cur, wr, wc, fr, fq, lds, wid, lane); S.done(cur); }
#undef PG8_SA
#undef PG8_SB
#undef PG8_STAGE
#undef PG8_LDA
#undef PG8_LDB
#undef PG8_MMA
#undef PG8_WAIT_V
#undef PG8_WAIT_L
#undef PG8_BAR
#undef PG8_SCHED
}
template <class Epi, class Sched, bool ALIGN_EPI = false, bool SP2 = false>
__device__ __forceinline__ void gemm_phase_x(PG8_LAS unsigned char* lds, const int K, const Sched& S, const Epi& E) {
    const int tid = threadIdx.x, wid = __builtin_amdgcn_readfirstlane(tid >> 6), lane = tid & 63, wr = wid >> 2, wc = wid & 3, fr = lane & 15, fq = lane >> 4;
    const int nt = K / BK;
    unsigned vcA[2][2], vnA[2][2], voffB[2];
#pragma unroll
    for (int i = 0; i < 2; ++i) { int R, C; stage_rc(tid * 16 + i * 8192, R, C); const int Rb = Epi::PERM ? ((R & ~31) + perm32(R & 31)) : R;
        voffB[i] = (unsigned)(Rb * K + C) * 2u; }
    const size_t kstep = (size_t)(BK * 2);
    const size_t hstep = (size_t)HALF * K * 2;
    const unsigned ldsw = (unsigned)wid * 1024u;
    const int aoff = lds_byte(wr * 64 + fr, fq * 8), boff = lds_byte(wc * 32 + fr, fq * 8);
#define PG8_SA(b, h) (((b) * 2 + (h)) * HTB)
#define PG8_SB(b, h) ((4 + (b) * 2 + (h)) * HTB)
#define PG8_STAGE(bufoff, gbase, voff) do { _Pragma("unroll") for (int _i = 0; _i < 2; ++_i) \
        __builtin_amdgcn_global_load_lds((const unsigned*)((const char*)(gbase) + (voff)[_i]), (PG8_LAS unsigned*)(lds + (bufoff) + ldsw + _i * 8192), 16, 0, 0); } while (0)
#define PG8_STAGEA(bufoff, gbase, V, h) do { _Pragma("unroll") for (int _i = 0; _i < 2; ++_i) \
        __builtin_amdgcn_global_load_lds((const unsigned*)((const char*)(gbase) + (V)[h][_i]), (PG8_LAS unsigned*)(lds + (bufoff) + ldsw + _i * 8192), 16, 0, 0); } while (0)
#define PG8_STAGEA2(bufoff, gbase, h) do { _Pragma("unroll") for (int _i = 0; _i < 2; ++_i) \
        __builtin_amdgcn_global_load_lds((const unsigned*)((const char*)(gbase) + (last ? vnA[h][_i] : vcA[h][_i])), (PG8_LAS unsigned*)(lds + (bufoff) + ldsw + _i * 8192), 16, 0, 0); } while (0)
#define PG8_AOFF(V, u) do { _Pragma("unroll") for (int _h = 0; _h < 2; ++_h) _Pragma("unroll") for (int _i = 0; _i < 2; ++_i) { int R_, C_; stage_rc(tid * 16 + _i * 8192, R_, C_); (V)[_h][_i] = S.a_off(u, _h * HALF + R_, C_); } } while (0)
#define PG8_LDA(dst, b, h) do { _Pragma("unroll") for (int m = 0; m < 4; ++m) _Pragma("unroll") for (int k = 0; k < 2; ++k) dst[m][k] = *(const PG8_LAS bf16x8*)(lds + PG8_SA(b, h) + aoff + m * 2048 + k * 1024); } while (0)
#define PG8_LDB(dst, b, h) do { _Pragma("unroll") for (int n = 0; n < 2; ++n) _Pragma("unroll") for (int k = 0; k < 2; ++k) dst[n][k] = *(const PG8_LAS bf16x8*)(lds + PG8_SB(b, h) + boff + n * 2048 + k * 1024); } while (0)
#define PG8_MMA(ai, bj, At, Bt) do { __builtin_amdgcn_s_setprio(1); _Pragma("unroll") for (int m = 0; m < 4; ++m) _Pragma("unroll") for (int n = 0; n < 2; ++n) _Pragma("unroll") for (int k = 0; k < 2; ++k) \
        acc[ai][bj][m][n] = __builtin_amdgcn_mfma_f32_16x16x32_bf16(Bt[n][k], At[m][k], acc[ai][bj][m][n], 0, 0, 0); __builtin_amdgcn_s_setprio(0); } while (0)
#define PG8_WAIT_V(n) asm volatile("s_waitcnt vmcnt(" #n ")" ::: "memory")
#define PG8_WAIT_L(n) asm volatile("s_waitcnt lgkmcnt(" #n ")" ::: "memory")
#define PG8_BAR __builtin_amdgcn_s_barrier()
#define PG8_SCHED __builtin_amdgcn_sched_barrier(0)
    Unit cur, nxt; int ui = 0;
    if (!S.next(0, cur)) return;
    f32x4 acc[2][2][4][2];
#pragma unroll
    for (int a = 0; a < 2; ++a)
#pragma unroll
        for (int b = 0; b < 2; ++b)
#pragma unroll
            for (int m = 0; m < 4; ++m)
#pragma unroll
                for (int n = 0; n < 2; ++n) acc[a][b][m][n] = (f32x4){0.f, 0.f, 0.f, 0.f};
    bf16x8 At[4][2], B0[2][2], B1[2][2];
    const char* cA = S.a_base(cur); const char* cB = S.b_base(cur);
    PG8_AOFF(vcA, cur);
    S.a_ready(cur);
    if constexpr (SP2) {
        PG8_STAGE(PG8_SB(0, 0), cB, voffB); PG8_STAGE(PG8_SB(0, 1), cB + hstep, voffB); PG8_STAGEA(PG8_SA(0, 0), cA, vcA, 0); PG8_STAGEA(PG8_SA(0, 1), cA, vcA, 1);
        if (wr == 1) PG8_BAR;
        PG8_WAIT_V(2); PG8_BAR;
        PG8_STAGE(PG8_SB(1, 0), cB + kstep, voffB); PG8_STAGEA(PG8_SA(1, 0), cA + kstep, vcA, 0); PG8_STAGE(PG8_SB(1, 1), cB + hstep + kstep, voffB);
        PG8_WAIT_V(6); PG8_BAR;
    } else {
        PG8_STAGE(PG8_SB(0, 0), cB, voffB); PG8_STAGEA(PG8_SA(0, 0), cA, vcA, 0); PG8_STAGE(PG8_SB(0, 1), cB + hstep, voffB); PG8_STAGEA(PG8_SA(0, 1), cA, vcA, 1);
        if (wr == 1) PG8_BAR;
        PG8_WAIT_V(4); PG8_BAR;
        PG8_STAGE(PG8_SB(1, 0), cB + kstep, voffB); PG8_STAGEA(PG8_SA(1, 0), cA + kstep, vcA, 0); PG8_STAGE(PG8_SB(1, 1), cB + hstep + kstep, voffB);
        PG8_WAIT_V(6); PG8_BAR;
    }
    for (;;) {
        const bool has_next = S.next(ui + 1, nxt);
        const char* nA = has_next ? S.a_base(nxt) : cA; const char* nB = has_next ? S.b_base(nxt) : cB;
        if (has_next) { PG8_AOFF(vnA, nxt); } else { _Pragma("unroll") for (int _h = 0; _h < 2; ++_h) _Pragma("unroll") for (int _i = 0; _i < 2; ++_i) vnA[_h][_i] = vcA[_h][_i]; }
        for (int t = 0; t < nt; t += 2) {
            const bool last = (t == nt - 2);
            const char* a1 = cA + (size_t)(t + 1) * kstep;
            const char* a2 = last ? nA : cA + (size_t)(t + 2) * kstep; const char* b2 = last ? nB : cB + (size_t)(t + 2) * kstep;
            const char* a3 = a2 + kstep; const char* b3 = b2 + kstep;
            if (last && has_next) S.a_ready(nxt);
            if constexpr (SP2) {
            PG8_LDB(B0, 0, 0); PG8_LDB(B1, 0, 1); PG8_SCHED; PG8_LDA(At, 0, 0); PG8_STAGEA(PG8_SA(1, 1), a1, vcA, 1);
            PG8_WAIT_V(8); PG8_WAIT_L(0); PG8_BAR; PG8_MMA(0, 0, At, B0); PG8_MMA(0, 1, At, B1); PG8_BAR; PG8_SCHED;
            PG8_LDA(At, 0, 1); PG8_STAGE(PG8_SB(0, 0), b2, voffB); PG8_STAGE(PG8_SB(0, 1), b2 + hstep, voffB); PG8_STAGEA2(PG8_SA(0, 0), a2, 0);
            PG8_WAIT_V(8); PG8_WAIT_L(0); PG8_BAR; PG8_MMA(1, 0, At, B0); PG8_MMA(1, 1, At, B1); PG8_BAR; PG8_SCHED;
            PG8_LDB(B0, 1, 0); PG8_LDB(B1, 1, 1); PG8_SCHED; PG8_LDA(At, 1, 0); PG8_STAGEA2(PG8_SA(0, 1), a2, 1);
            PG8_WAIT_V(8); PG8_WAIT_L(0); PG8_BAR; PG8_MMA(0, 0, At, B0); PG8_MMA(0, 1, At, B1); PG8_BAR; PG8_SCHED;
            PG8_LDA(At, 1, 1); PG8_STAGE(PG8_SB(1, 0), b3, voffB); PG8_STAGE(PG8_SB(1, 1), b3 + hstep, voffB); PG8_STAGEA2(PG8_SA(1, 0), a3, 0);
            PG8_WAIT_V(8); PG8_WAIT_L(0); PG8_BAR; PG8_MMA(1, 0, At, B0); PG8_MMA(1, 1, At, B1); PG8_BAR; PG8_SCHED;
            } else {
            PG8_LDB(B0, 0, 0); PG8_SCHED; PG8_LDA(At, 0, 0); PG8_STAGEA(PG8_SA(1, 1), a1, vcA, 1);
            PG8_WAIT_L(8); PG8_BAR; PG8_WAIT_L(0); PG8_MMA(0, 0, At, B0); PG8_BAR; PG8_SCHED;
            PG8_LDB(B1, 0, 1); PG8_STAGE(PG8_SB(0, 0), b2, voffB);
            PG8_BAR; PG8_WAIT_L(0); PG8_MMA(0, 1, At, B1); PG8_BAR;
            PG8_LDA(At, 0, 1); PG8_STAGEA2(PG8_SA(0, 0), a2, 0);
            PG8_BAR; PG8_WAIT_L(0); PG8_MMA(1, 0, At, B0); PG8_BAR; PG8_SCHED;
            PG8_STAGE(PG8_SB(0, 1), b2 + hstep, voffB);
            PG8_WAIT_V(6); PG8_BAR; PG8_MMA(1, 1, At, B1); PG8_BAR;
            PG8_LDB(B0, 1, 0); PG8_SCHED; PG8_LDA(At, 1, 0); PG8_STAGEA2(PG8_SA(0, 1), a2, 1);
            PG8_WAIT_L(8); PG8_BAR; PG8_WAIT_L(0); PG8_MMA(0, 0, At, B0); PG8_BAR; PG8_SCHED;
            PG8_LDB(B1, 1, 1); PG8_STAGE(PG8_SB(1, 0), b3, voffB);
            PG8_BAR; PG8_WAIT_L(0); PG8_MMA(0, 1, At, B1); PG8_BAR;
            PG8_LDA(At, 1, 1); PG8_STAGEA2(PG8_SA(1, 0), a3, 0);
            PG8_BAR; PG8_WAIT_L(0); PG8_MMA(1, 0, At, B0); PG8_BAR; PG8_SCHED;
            PG8_STAGE(PG8_SB(1, 1), b3 + hstep, voffB);
            PG8_WAIT_V(6); PG8_BAR; PG8_MMA(1, 1, At, B1); PG8_BAR;
            }
        }
        if constexpr (ALIGN_EPI) { if (wr == 0) PG8_BAR; }
        if constexpr (!Epi::AFTER_DRAIN) { E(acc, cur, wr, wc, fr, fq); S.done(cur); }
        if (!has_next) break;
#pragma unroll
        for (int a = 0; a < 2; ++a)
#pragma unroll
            for (int b = 0; b < 2; ++b)
#pragma unroll
                for (int m = 0; m < 4; ++m)
#pragma unroll
                    for (int n = 0; n < 2; ++n) acc[a][b][m][n] = (f32x4){0.f, 0.f, 0.f, 0.f};
        cur = nxt; cA = nA; cB = nB; ++ui;
        _Pragma("unroll") for (int _h = 0; _h < 2; ++_h) _Pragma("unroll") for (int _i = 0; _i < 2; ++_i) vcA[_h][_i] = vnA[_h][_i];
        if constexpr (ALIGN_EPI) { if (wr == 1) PG8_BAR; }
    }
    PG8_WAIT_V(0);
    if constexpr (!ALIGN_EPI) { if (wr == 0) PG8_BAR; }
    PG8_BAR;
    if constexpr (Epi::AFTER_DRAIN) { E.fused(acc, cur, wr, wc, fr, fq, lds, wid, lane); S.done(cur); }
#undef PG8_SA
#undef PG8_SB
#undef PG8_STAGE
#undef PG8_STAGEA
#undef PG8_STAGEA2
#undef PG8_AOFF
#undef PG8_LDA
#undef PG8_LDB
#undef PG8_MMA
#undef PG8_WAIT_V
#undef PG8_WAIT_L
#undef PG8_BAR
#undef PG8_SCHED
}


template <int WHICH> struct MoeOrder {
    const int* TP; int G, c; const char* Abase; const char* Bbase; const int* LIST;
    static constexpr int KK = WHICH == 0 ? 1024 : 512, NN = 4;
    __device__ __forceinline__ bool next(int i, Unit& u) const {
        const int L = i * G + c; if (L >= TP[NEXP]) return false;
        int e = 0;
#pragma unroll 1
        for (int j = 16; j >= 1; j >>= 1) if (TP[e + j] <= L) e += j;
        const int lt = L - TP[e]; u.pm = e * 1024 + lt / NN; u.pn = lt % NN; return true;
    }
    __device__ __forceinline__ const char* a_base(const Unit& u) const { const int e = u.pm >> 10, mt = u.pm & 1023; return WHICH == 0 ? Abase : Abase + (size_t)(TP[64 + e] + mt * 256) * (DEXP * 2); }
    __device__ __forceinline__ const char* b_base(const Unit& u) const { const int e = u.pm >> 10; return Bbase + ((size_t)e * 1024 + (size_t)u.pn * 256) * (KK * 2); }
    __device__ __forceinline__ unsigned a_off(const Unit& u, int r, int C) const {
        if (WHICH == 1) return (unsigned)(r * DEXP + C) * 2u;
        const int e = u.pm >> 10, s = (u.pm & 1023) * 256 + r; const int tok = s < TP[128 + e] ? (LIST[(size_t)e * NR + s] >> 1) : 0;
        return (unsigned)tok * (D * 2) + (unsigned)C * 2u;
    }
    __device__ __forceinline__ void a_ready(const Unit&) const {}
    __device__ __forceinline__ void done(const Unit&) const {}
};
struct TokRowOrder : StaticOrder {
    const char* Abase; const char* Bbase; int K;
    __device__ __forceinline__ const char* a_base(const Unit& u) const { return Abase + (size_t)tokrow(u.pm * BM) * K * 2; }
    __device__ __forceinline__ const char* b_base(const Unit& u) const { return Bbase + (size_t)u.pn * BM * K * 2; }
    __device__ __forceinline__ unsigned a_off(const Unit&, int r, int C) const { return (unsigned)(r * K + C) * 2u; }
};
#define PG8_FOR_FRAGS_M(...) _Pragma("unroll") for (int ai = 0; ai < 2; ++ai) _Pragma("unroll") for (int m = 0; m < 4; ++m) { const int r = ai * HALF + wr * 64 + m * 16 + fr; \
    _Pragma("unroll") for (int bj = 0; bj < 2; ++bj) _Pragma("unroll") for (int n = 0; n < 2; ++n) { const int col = u.pn * BM + bj * HALF + wc * 32 + n * 16 + 4 * fq; ::f32x4 v = acc[ai][bj][m][n]; __VA_ARGS__ } }
struct EpiMoe1 {
    static constexpr bool PERM = false, AFTER_DRAIN = false;
    bf16_t* HID; const int* TP;
    __device__ __forceinline__ void operator()(const f32x4 (&acc)[2][2][4][2], const Unit& u, int wr, int wc, int fr, int fq) const {
        const int e = u.pm >> 10, mt = u.pm & 1023; bf16_t* base = HID + (size_t)(TP[64 + e] + mt * 256) * DEXP;
        PG8_FOR_FRAGS_M( const float h0 = v.x / (1.f + __expf(-v.x)) * v.y, h1 = v.z / (1.f + __expf(-v.z)) * v.w; *(unsigned*)(base + (size_t)r * DEXP + (col >> 1)) = pk2(h0, h1); )
    }
};
struct EpiMoe2 {
    static constexpr bool PERM = false, AFTER_DRAIN = false;
    bf16_t* MO; const int* TP; const int* LIST; const float* GATE;
    __device__ __forceinline__ void operator()(const f32x4 (&acc)[2][2][4][2], const Unit& u, int wr, int wc, int fr, int fq) const {
        const int e = u.pm >> 10, mt = u.pm & 1023, cnt = TP[128 + e];
#pragma unroll
        for (int ai = 0; ai < 2; ++ai)
#pragma unroll
            for (int m = 0; m < 4; ++m) {
                const int s = mt * 256 + ai * HALF + wr * 64 + m * 16 + fr;
                if (s < cnt) {
                    const int ent = LIST[(size_t)e * NR + s]; const float gt = GATE[ent]; bf16_t* row = MO + (size_t)ent * D;
#pragma unroll
                    for (int bj = 0; bj < 2; ++bj)
#pragma unroll
                        for (int n = 0; n < 2; ++n) { const int col = u.pn * BM + bj * HALF + wc * 32 + n * 16 + 4 * fq; const ::f32x4 v = acc[ai][bj][m][n];
                            ::u32x2 w; w.x = pk2(v.x * gt, v.y * gt); w.y = pk2(v.z * gt, v.w * gt); *(::u32x2*)(row + col) = w; }
                }
            }
    }
};
#undef PG8_FOR_FRAGS_M
}
constexpr int SB_NQT = SEQ / 32;
constexpr int SB_VT_STRIDE = 40;
__device__ __forceinline__ void phase_sb_fast(const Params& p, char* lds) {
    const bf16_t* P = (const bf16_t*)(p.ws + WS_P); bf16_t* YA = (bf16_t*)(p.ws + WS_YA);
    const int tid = threadIdx.x, lane = tid & 63, wave = tid >> 6, n = lane & 31, hh = lane >> 5;
    bf16_t* VT = (bf16_t*)(lds + wave * (64 * SB_VT_STRIDE * 2));
    const int gw = blockIdx.x * NWAVES + wave, NGW = gridDim.x * NWAVES;
    for (int unit = gw; unit < 64 * SB_NQT; unit += NGW) {
        const int qt = SB_NQT - 1 - unit / 64, bh = unit % 64, h = bh & 7, b = bh >> 3;
        const int i0 = NMETA + qt * 32, qi = i0 + n, qrow = qi;
        const bf16_t* Pb = P + (size_t)b * T * PW;
        bf16x8 qf[4];
#pragma unroll
        for (int s = 0; s < 4; ++s) qf[s] = *(const bf16x8*)(Pb + (size_t)qrow * PW + C_QA + h * 64 + 16 * s + 8 * hh);
        f32x16 o0, o1;
#pragma unroll
        for (int r = 0; r < 16; ++r) { o0[r] = 0.f; o1[r] = 0.f; }
        float L = 0.f;
        for (int kt = qt + 1; kt >= 0; --kt) {
            const int j0 = kt * 32, krow = (j0 + n) < T ? (j0 + n) : T - 1;
            bf16x8 kf[4];
#pragma unroll
            for (int s = 0; s < 4; ++s) kf[s] = *(const bf16x8*)(Pb + (size_t)krow * PW + C_KA + h * 64 + 16 * s + 8 * hh);
#pragma unroll
            for (int i = 0; i < 4; ++i) {
                const int c = lane + 64 * i, key = c >> 3, d0 = (c & 7) * 8, vrow = (j0 + key) < T ? (j0 + key) : T - 1;
                const u32x4 w = *(const u32x4*)(Pb + (size_t)vrow * PW + C_VA + h * 64 + d0);
                bf16_t* vp = VT + d0 * SB_VT_STRIDE + key;
                vp[0] = (bf16_t)(w.x & 0xffff); vp[SB_VT_STRIDE] = (bf16_t)(w.x >> 16); vp[2 * SB_VT_STRIDE] = (bf16_t)(w.y & 0xffff); vp[3 * SB_VT_STRIDE] = (bf16_t)(w.y >> 16);
                vp[4 * SB_VT_STRIDE] = (bf16_t)(w.z & 0xffff); vp[5 * SB_VT_STRIDE] = (bf16_t)(w.z >> 16); vp[6 * SB_VT_STRIDE] = (bf16_t)(w.w & 0xffff); vp[7 * SB_VT_STRIDE] = (bf16_t)(w.w >> 16);
            }
            f32x16 sa;
#pragma unroll
            for (int r = 0; r < 16; ++r) sa[r] = 0.f;
#pragma unroll
            for (int s = 0; s < 4; ++s) sa = __builtin_amdgcn_mfma_f32_32x32x16_bf16(kf[s], qf[s], sa, 0, 0, 0);
            float lk[16], z[16];
#pragma unroll
            for (int r = 0; r < 16; ++r) {
                const int kk = (r & 3) + 8 * (r >> 2) + 4 * hh; const bool valid = (j0 + kk) < qi;
                const float zz = fminf(sa[r], 80.f); const float l = -__log2f(1.f + exp2f(zz));
                z[r] = zz; lk[r] = valid ? l : 0.f;
            }
            const float gs0 = (lk[0] + lk[1]) + (lk[2] + lk[3]), gs1 = (lk[4] + lk[5]) + (lk[6] + lk[7]), gs2 = (lk[8] + lk[9]) + (lk[10] + lk[11]), gs3 = (lk[12] + lk[13]) + (lk[14] + lk[15]);
            const float ps0 = xpartner32(gs0, hh), ps1 = xpartner32(gs1, hh), ps2 = xpartner32(gs2, hh), ps3 = xpartner32(gs3, hh);
            const float pc3 = ps3, pc2 = pc3 + ps2, pc1 = pc2 + ps1, pc0 = pc1 + ps0;
            float base[4];
            base[3] = L + (hh ? 0.f : pc3);
            base[2] = L + gs3 + (hh ? pc3 : pc2);
            base[1] = L + (gs3 + gs2) + (hh ? pc2 : pc1);
            base[0] = L + (gs3 + gs2 + gs1) + (hh ? pc1 : pc0);
            float a[16];
#pragma unroll
            for (int g = 0; g < 4; ++g) {
                float c = base[g];
#pragma unroll
                for (int e = 3; e >= 0; --e) {
                    const int r = 4 * g + e; c += lk[r];
                    const int kk = e + 8 * g + 4 * hh; const bool valid = (j0 + kk) < qi;
                    a[r] = valid ? exp2f(z[r] + c) : 0.f;
                }
            }
            L += (gs0 + gs1 + gs2 + gs3) + pc0;
            u32x4 pw0, pw1;
            pw0.x = pk2(a[0], a[1]); pw0.y = pk2(a[2], a[3]); pw0.z = pk2(a[4], a[5]); pw0.w = pk2(a[6], a[7]);
            pw1.x = pk2(a[8], a[9]); pw1.y = pk2(a[10], a[11]); pw1.z = pk2(a[12], a[13]); pw1.w = pk2(a[14], a[15]);
            const bf16x8 pf0 = __builtin_bit_cast(bf16x8, pw0), pf1 = __builtin_bit_cast(bf16x8, pw1);
#pragma unroll
            for (int mt = 0; mt < 2; ++mt) {
                const bf16_t* vr = VT + (32 * mt + n) * SB_VT_STRIDE + 4 * hh;
                u32x4 v0, v1;
                { const u32x2 x = *(const u32x2*)(vr), y = *(const u32x2*)(vr + 8); v0.x = x.x; v0.y = x.y; v0.z = y.x; v0.w = y.y; }
                { const u32x2 x = *(const u32x2*)(vr + 16), y = *(const u32x2*)(vr + 24); v1.x = x.x; v1.y = x.y; v1.z = y.x; v1.w = y.y; }
                if (mt == 0) { o0 = __builtin_amdgcn_mfma_f32_32x32x16_bf16(__builtin_bit_cast(bf16x8, v0), pf0, o0, 0, 0, 0); o0 = __builtin_amdgcn_mfma_f32_32x32x16_bf16(__builtin_bit_cast(bf16x8, v1), pf1, o0, 0, 0, 0); }
                else { o1 = __builtin_amdgcn_mfma_f32_32x32x16_bf16(__builtin_bit_cast(bf16x8, v0), pf0, o1, 0, 0, 0); o1 = __builtin_amdgcn_mfma_f32_32x32x16_bf16(__builtin_bit_cast(bf16x8, v1), pf1, o1, 0, 0, 0); }
            }
            const bool done = L < -152.f;
            if (__all(done)) break;
        }
        {
            bf16_t* yp = YA + ((size_t)b * SEQ + (qi - NMETA)) * 512 + h * 64 + 4 * hh;
#pragma unroll
            for (int g = 0; g < 4; ++g) {
                u32x2 w; w.x = pk2(o0[4 * g], o0[4 * g + 1]); w.y = pk2(o0[4 * g + 2], o0[4 * g + 3]); *(u32x2*)(yp + 8 * g) = w;
                w.x = pk2(o1[4 * g], o1[4 * g + 1]); w.y = pk2(o1[4 * g + 2], o1[4 * g + 3]); *(u32x2*)(yp + 32 + 8 * g) = w;
            }
        }
    }
}

constexpr int DSA_NQ = 8;
constexpr int DSA_SCS = 4608;
constexpr int DSA_KVB = 0, DSA_RING = 18432, DSA_IDX = DSA_NQ * DSA_RING, DSA_MISC = DSA_IDX + DSA_NQ * 1024, DSA_LDS = DSA_MISC + 512;
static_assert(DSA_NQ * DSA_SCS * 4 <= DSA_IDX, "score rows fit under the index lists");
__device__ __forceinline__ unsigned fkey(float f) { const unsigned u = __float_as_uint(f); return (u & 0x80000000u) ? ~u : (u | 0x80000000u); }
__device__ __forceinline__ int wave_sum_i32(int v) {
    v += __builtin_amdgcn_update_dpp(0, v, 0xB1, 0xF, 0xF, false);
    v += __builtin_amdgcn_update_dpp(0, v, 0x4E, 0xF, 0xF, false);
    v += __builtin_amdgcn_update_dpp(0, v, 0x141, 0xF, 0xF, false);
    v += __builtin_amdgcn_update_dpp(0, v, 0x140, 0xF, 0xF, false);
    return __builtin_amdgcn_readlane(v, 0) + __builtin_amdgcn_readlane(v, 16) + __builtin_amdgcn_readlane(v, 32) + __builtin_amdgcn_readlane(v, 48);
}
__device__ __forceinline__ int wave_excl_scan_i32(int c, int lane, int& total) {
    int x = c;
    x += __builtin_amdgcn_update_dpp(0, x, 0x111, 0xF, 0xF, true);
    x += __builtin_amdgcn_update_dpp(0, x, 0x112, 0xF, 0xF, true);
    x += __builtin_amdgcn_update_dpp(0, x, 0x114, 0xF, 0xF, true);
    x += __builtin_amdgcn_update_dpp(0, x, 0x118, 0xF, 0xF, true);
    const int t0 = __builtin_amdgcn_readlane(x, 15), t1 = __builtin_amdgcn_readlane(x, 31), t2 = __builtin_amdgcn_readlane(x, 47), t3 = __builtin_amdgcn_readlane(x, 63);
    const int row = lane >> 4;
    x += (row > 0 ? t0 : 0) + (row > 1 ? t1 : 0) + (row > 2 ? t2 : 0);
    total = t0 + t1 + t2 + t3;
    return x - c;
}
__device__ __forceinline__ int mbcnt64(unsigned long long m) { return (int)__builtin_amdgcn_mbcnt_hi((unsigned)(m >> 32), __builtin_amdgcn_mbcnt_lo((unsigned)m, 0u)); }
__device__ __forceinline__ void phase_dsa(const Params& p, char* lds) {
    const bf16_t* P = (const bf16_t*)(p.ws + WS_P); bf16_t* OL = (bf16_t*)(p.ws + WS_OLAT);
    const int tid = threadIdx.x, lane = tid & 63, wave = __builtin_amdgcn_readfirstlane(tid >> 6);
    unsigned* SC = (unsigned*)(lds + DSA_KVB);
    unsigned short* IDX = (unsigned short*)(lds + DSA_IDX);
    int* MISC = (int*)(lds + DSA_MISC);
    const unsigned lds_base = (unsigned)(size_t)lds;
    constexpr int NU = SEQ / DSA_NQ;
    for (int unit = blockIdx.x; unit < BATCH * NU; unit += gridDim.x) {
        const int u8 = NU - 1 - unit / BATCH, b = unit % BATCH, t0 = NMETA + u8 * DSA_NQ;
        const int cid = 1 + (t0 - NMETA) / 64, n = NMETA + 64 * cid;
        const bf16_t* Pb = P + (size_t)b * T * PW;
        const int m = lane & 31, hh = lane >> 5;
        bf16x8 aq[2][4]; float wv[2][16];
#pragma unroll
        for (int rt = 0; rt < 2; ++rt) {
#pragma unroll
            for (int s = 0; s < 4; ++s) aq[rt][s] = *(const bf16x8*)(Pb + (size_t)(t0 + 4 * rt + (m >> 3)) * PW + C_QI + (m & 7) * 64 + 16 * s + 8 * hh);
#pragma unroll
            for (int r = 0; r < 16; ++r) wv[rt][r] = bf2f(Pb[(size_t)(t0 + 4 * rt + (r >> 2)) * PW + C_WI + (r & 3) + 4 * hh]);
        }
        const unsigned char* KIPb = p.ws + WS_KIP + (size_t)b * KIP_BATCH + lane * 16;
        bf16x8 bk[4];
#pragma unroll
        for (int s = 0; s < 4; ++s) bk[s] = *(const bf16x8*)(KIPb + (size_t)wave * 4096 + s * 1024);
        __syncthreads();
        {
            const int ntile = (n + 31) / 32;
            for (int kt = wave; kt < ntile; kt += NWAVES) {
                const int j0 = kt * 32, key = j0 + m;
                bf16x8 bn[4];
                { const int ktn = kt + NWAVES < 129 ? kt + NWAVES : 128;
#pragma unroll
                  for (int s = 0; s < 4; ++s) bn[s] = *(const bf16x8*)(KIPb + (size_t)ktn * 4096 + s * 1024); }
                const bool ok = key < n;
#pragma unroll
                for (int rt = 0; rt < 2; ++rt) {
                    f32x16 acc;
#pragma unroll
                    for (int r = 0; r < 16; ++r) acc[r] = 0.f;
#pragma unroll
                    for (int s = 0; s < 4; ++s) acc = __builtin_amdgcn_mfma_f32_32x32x16_bf16(aq[rt][s], bk[s], acc, 0, 0, 0);
                    float tq[4];
#pragma unroll
                    for (int q = 0; q < 4; ++q) {
#define RELU_(x) __builtin_amdgcn_fmed3f((x), 0.f, 3.0e38f)
                        float s = wv[rt][4 * q] * RELU_(acc[4 * q]); s += wv[rt][4 * q + 1] * RELU_(acc[4 * q + 1]); s += wv[rt][4 * q + 2] * RELU_(acc[4 * q + 2]); s += wv[rt][4 * q + 3] * RELU_(acc[4 * q + 3]);
#undef RELU_
                        tq[q] = xsum32(s);
                    }
                    const float s0 = hh ? tq[2] : tq[0], s1 = hh ? tq[3] : tq[1];
                    SC[(4 * rt + 2 * hh) * DSA_SCS + key] = ok ? fkey(s0) : 0u;
                    SC[(4 * rt + 2 * hh + 1) * DSA_SCS + key] = ok ? fkey(s1) : 0u;
                }
#pragma unroll
                for (int s = 0; s < 4; ++s) bk[s] = bn[s];
            }
        }
        __syncthreads();
        bf16x8 qf[5];
        {
            const int hd_ = lane & 15, g_ = lane >> 4;
#pragma unroll
            for (int ks = 0; ks < 5; ++ks) {
                u32x4 w = (u32x4){0u, 0u, 0u, 0u};
                if (hd_ < 8 && (ks < 4 || g_ < 2)) w = *(const u32x4*)(Pb + (size_t)(t0 + wave) * PW + C_QF + hd_ * QFW + 32 * ks + 8 * g_);
                qf[ks] = __builtin_bit_cast(bf16x8, w);
            }
        }
        {
            unsigned* sc = SC + wave * DSA_SCS;
            unsigned v[65];
#pragma unroll
            for (int i = 0; i < 65; ++i) { const int k = i * 64 + lane; v[i] = (k < n) ? sc[k] : 0u; }
            unsigned prefix = 0u; int cge = n, bit = 31;
            bool exact = false;
            if (n >= 256) {
                for (; bit >= 0 && cge > 512; --bit) {
                    const unsigned cand = prefix | (1u << bit); const int sc_ = (int)(cand ^ 0x80000000u);
                    unsigned b0 = 0u, b1 = 0u, b2 = 0u; int slots = 0;
#pragma unroll
                    for (int gi = 0; gi < 5; ++gi) if (gi * 832 < n) {
#pragma unroll
                        for (int i = 13 * gi; i < 13 * gi + 13; ++i) {
                            const unsigned d = (unsigned)__builtin_elementwise_sub_sat((int)(v[i] ^ 0x80000000u), sc_);
                            if (i % 3 == 0) b0 = __builtin_amdgcn_alignbit(b0, d, 31); else if (i % 3 == 1) b1 = __builtin_amdgcn_alignbit(b1, d, 31); else b2 = __builtin_amdgcn_alignbit(b2, d, 31);
                        }
                        slots += 13 * 64;
                    }
                    const int c = slots - wave_sum_i32(__builtin_popcount(b0) + __builtin_popcount(b1) + __builtin_popcount(b2));
                    if (c >= 256) { prefix = cand; cge = c; if (c == 256) { exact = true; break; } }
                }
            }
            int ngt = n;
            if (n >= 256 && !exact) {
                asm volatile("s_waitcnt lgkmcnt(0)" ::: "memory");
                int cb = 0;
                if (bit >= 0) {
                    const int sp_ = (int)((prefix > 0u ? prefix : 1u) ^ 0x80000000u);
                    unsigned lb0 = 0u, lb1 = 0u, lb2 = 0u;
#pragma unroll
                    for (int i = 0; i < 65; ++i) { const unsigned d = (unsigned)__builtin_elementwise_sub_sat((int)(v[i] ^ 0x80000000u), sp_);
                        if (i < 32) lb0 = __builtin_amdgcn_alignbit(lb0, d, 31); else if (i < 64) lb1 = __builtin_amdgcn_alignbit(lb1, d, 31); else lb2 = d >> 31; }
                    const unsigned tk0 = ~lb0, tk1 = ~lb1, tk2 = (~lb2) & 1u;
                    const int c0 = __builtin_popcount(tk0), c1 = __builtin_popcount(tk1);
                    const int lbase = wave_excl_scan_i32(c0 + c1 + (int)tk2, lane, cb);
#pragma unroll
                    for (int i = 0; i < 65; ++i) {
                        bool tkn; int rk;
                        if (i < 32) { tkn = (tk0 >> (31 - i)) & 1u; rk = i == 0 ? 0 : __builtin_popcount(tk0 >> (32 - i)); }
                        else if (i < 64) { tkn = (tk1 >> (63 - i)) & 1u; rk = c0 + (i == 32 ? 0 : __builtin_popcount(tk1 >> (64 - i))); }
                        else { tkn = tk2 != 0u; rk = c0 + c1; }
                        sc[tkn ? lbase + rk : 4096 + (lane & 15)] = v[i];
                    }
                    asm volatile("s_waitcnt lgkmcnt(0)" ::: "memory");
                    unsigned w[8];
#pragma unroll
                    for (int j = 0; j < 8; ++j) { const int k = j * 64 + lane; w[j] = (k < cb) ? sc[k] : 0u; }
                    for (; bit >= 0; --bit) {
                        const unsigned cand = prefix | (1u << bit); const int sc_ = (int)(cand ^ 0x80000000u); unsigned b0 = 0u, b1 = 0u;
#pragma unroll
                        for (int j = 0; j < 8; ++j) { const unsigned d = (unsigned)__builtin_elementwise_sub_sat((int)(w[j] ^ 0x80000000u), sc_); if (j & 1) b1 = __builtin_amdgcn_alignbit(b1, d, 31); else b0 = __builtin_amdgcn_alignbit(b0, d, 31); }
                        const int c = 512 - wave_sum_i32(__builtin_popcount(b0) + __builtin_popcount(b1));
                        if (c >= 256) { prefix = cand; if (c == 256) { exact = true; break; } }
                    }
                    int c = 0;
#pragma unroll
                    for (int j = 0; j < 8; ++j) c += __popcll(__ballot(w[j] > prefix));
                    ngt = c;
                } else {
                    int c = 0;
#pragma unroll
                    for (int i = 0; i < 65; ++i) { c += __popcll(__ballot(v[i] > prefix)); if ((i & 3) == 3) __builtin_amdgcn_sched_barrier(0); }
                    ngt = c;
                }
            }
            const unsigned tau = prefix;
            const int need_eq = n >= 256 ? 256 - ngt : 0; int base = 0, eqb = 0;
            unsigned short* idx = IDX + wave * 512;
            int neq = 0;
            {
                const int st_ = (int)(tau ^ 0x80000000u); unsigned e0 = 0u, e1 = 0u, e2 = 0u;
#pragma unroll
                for (int i = 0; i < 65; ++i) { const unsigned d = (unsigned)__builtin_elementwise_sub_sat((int)(v[i] ^ 0x80000000u), st_);
                    if (i < 32) e0 = __builtin_amdgcn_alignbit(e0, d, 31); else if (i < 64) e1 = __builtin_amdgcn_alignbit(e1, d, 31); else e2 = d >> 31; }
                const unsigned tk0 = ~e0, tk1 = ~e1, tk2 = (~e2) & 1u;
                const int c0 = __builtin_popcount(tk0), c1 = __builtin_popcount(tk1);
                int nge; const int lbase = wave_excl_scan_i32(c0 + c1 + (int)tk2, lane, nge);
                neq = nge - ngt;
                if (n >= 256 && nge == 256) {
#pragma unroll
                    for (int i = 0; i < 65; ++i) {
                        bool tkn; int rk;
                        if (i < 32) { tkn = (tk0 >> (31 - i)) & 1u; rk = i == 0 ? 0 : __builtin_popcount(tk0 >> (32 - i)); }
                        else if (i < 64) { tkn = (tk1 >> (63 - i)) & 1u; rk = c0 + (i == 32 ? 0 : __builtin_popcount(tk1 >> (64 - i))); }
                        else { tkn = tk2 != 0u; rk = c0 + c1; }
                        idx[tkn ? lbase + rk : 256 + lane] = (unsigned short)(i * 64 + lane);
                    }
                    base = nge;
                } else {
#pragma unroll
                    for (int gi = 0; gi < 5; ++gi) if (gi * 832 < n) {
#pragma unroll
                        for (int i = 13 * gi; i < 13 * gi + 13; ++i) {
                            const int k = i * 64 + lane; const unsigned u = v[i];
                            const bool eq = (u == tau); const unsigned long long meq = __ballot(eq);
                            const bool take = (u > tau) || (eq && (eqb + mbcnt64(meq)) < need_eq);
                            const unsigned long long mt = __ballot(take);
                            idx[take ? base + mbcnt64(mt) : 256 + lane] = (unsigned short)k;
                            base += __popcll(mt); eqb += __popcll(meq);
                            if ((i & 3) == 3) __builtin_amdgcn_sched_barrier(0);
                        }
                    }
                }
            }
            for (int pos = base + lane; pos < 256; pos += 64) idx[pos] = 0;
            if (lane == 0) MISC[wave] = base;
        }
        asm volatile("s_waitcnt lgkmcnt(0)" ::: "memory");
        {
            const int q = wave; const int nsel = MISC[q];
            const size_t qrow = (size_t)(t0 + q);
            int ln = lane; asm volatile("" : "+v"(ln));
            const int hd = ln & 15, g = ln >> 4, qd = (ln & 15) >> 2, pp = ln & 3;
            char* ring = lds + DSA_KVB + wave * DSA_RING;
            const unsigned ring_a = lds_base + DSA_KVB + wave * DSA_RING;
            const unsigned short* idx = IDX + q * 512;
            asm volatile("s_waitcnt vmcnt(0)" ::: "memory");
#define DSA_ISSUE(c) do { _Pragma("unroll") for (int i_ = 0; i_ < 9; ++i_) { const int pid_ = ln + 64 * i_, row_ = pid_ / 18, part_ = pid_ - row_ * 18; \
                const bf16_t* src_ = Pb + (size_t)idx[32 * (c) + row_] * PW + C_KV + part_ * 8; \
                __builtin_amdgcn_global_load_lds((const unsigned*)src_, (LAS unsigned*)(ring + ((c) & 1) * 9216 + i_ * 1024), 16, 0, 0); } } while (0)
            DSA_ISSUE(0); DSA_ISSUE(1);
            f32x4 O[8];
#pragma unroll
            for (int nt = 0; nt < 8; ++nt) O[nt] = (f32x4){0.f, 0.f, 0.f, 0.f};
            float mrun = -3e38f, lrun = 0.f;
            for (int c = 0; c < 8; ++c) {
                if (c < 7) asm volatile("s_waitcnt vmcnt(9)" ::: "memory"); else asm volatile("s_waitcnt vmcnt(0)" ::: "memory");
                const char* buf = ring + (c & 1) * 9216;
                f32x4 S0 = (f32x4){0.f, 0.f, 0.f, 0.f}, S1 = S0;
                {
                    const char* kr = buf + hd * 288 + 16 * g;
#pragma unroll
                    for (int ks = 0; ks < 4; ++ks) { S0 = __builtin_amdgcn_mfma_f32_16x16x32_bf16(*(const bf16x8*)(kr + 64 * ks), qf[ks], S0, 0, 0, 0); S1 = __builtin_amdgcn_mfma_f32_16x16x32_bf16(*(const bf16x8*)(kr + 16 * 288 + 64 * ks), qf[ks], S1, 0, 0, 0); }
                    u32x4 w0 = (u32x4){0u, 0u, 0u, 0u}, w1 = w0; if (g < 2) { w0 = *(const u32x4*)(kr + 256); w1 = *(const u32x4*)(kr + 16 * 288 + 256); }
                    S0 = __builtin_amdgcn_mfma_f32_16x16x32_bf16(__builtin_bit_cast(bf16x8, w0), qf[4], S0, 0, 0, 0); S1 = __builtin_amdgcn_mfma_f32_16x16x32_bf16(__builtin_bit_cast(bf16x8, w1), qf[4], S1, 0, 0, 0);
                }
                float cm = -3e38f;
#pragma unroll
                for (int r = 0; r < 4; ++r) { if (nsel < 256) { const int sl = 32 * c + 4 * g + r; S0[r] = sl < nsel ? S0[r] : -1e30f; S1[r] = (sl + 16) < nsel ? S1[r] : -1e30f; } cm = fmaxf(cm, fmaxf(S0[r], S1[r])); }
                cm = xmax16(xmax32(cm));
                if (__any(cm > mrun + 6.f)) {
                    const float mnew = fmaxf(mrun, cm), alpha = exp2f(mrun - mnew);
                    lrun *= alpha; mrun = mnew;
                    const float a0 = __shfl(alpha, 4 * g), a1 = __shfl(alpha, 4 * g + 1), a2 = __shfl(alpha, 4 * g + 2), a3 = __shfl(alpha, 4 * g + 3);
#pragma unroll
                    for (int nt = 0; nt < 8; ++nt) { O[nt][0] *= a0; O[nt][1] *= a1; O[nt][2] *= a2; O[nt][3] *= a3; }
                }
                float ps = 0.f;
#pragma unroll
                for (int r = 0; r < 4; ++r) { S0[r] = exp2f(S0[r] - mrun); S1[r] = exp2f(S1[r] - mrun); ps += S0[r] + S1[r]; }
                ps = xsum16(xsum32(ps));
                lrun += ps;
                u32x4 pw; pw.x = pk2(S0[0], S0[1]); pw.y = pk2(S0[2], S0[3]); pw.z = pk2(S1[0], S1[1]); pw.w = pk2(S1[2], S1[3]);
                const bf16x8 pf = __builtin_bit_cast(bf16x8, pw);
                const unsigned va = ring_a + (unsigned)((c & 1) * 9216 + (4 * g + qd) * 288 + 8 * pp);
#pragma unroll
                for (int h2 = 0; h2 < 2; ++h2) {
                    u16x4 x0, x1, x2, x3, y0, y1, y2, y3;
                    asm volatile("ds_read_b64_tr_b16 %0, %8 offset:%9\n\tds_read_b64_tr_b16 %1, %8 offset:%10\n\tds_read_b64_tr_b16 %2, %8 offset:%11\n\tds_read_b64_tr_b16 %3, %8 offset:%12\n\t"
                                 "ds_read_b64_tr_b16 %4, %8 offset:%13\n\tds_read_b64_tr_b16 %5, %8 offset:%14\n\tds_read_b64_tr_b16 %6, %8 offset:%15\n\tds_read_b64_tr_b16 %7, %8 offset:%16\n\ts_waitcnt lgkmcnt(0)"
                                 : "=&v"(x0), "=&v"(x1), "=&v"(x2), "=&v"(x3), "=&v"(y0), "=&v"(y1), "=&v"(y2), "=&v"(y3)
                                 : "v"(va), "i"(128 * h2), "i"(128 * h2 + 32), "i"(128 * h2 + 64), "i"(128 * h2 + 96), "i"(128 * h2 + 4608), "i"(128 * h2 + 4640), "i"(128 * h2 + 4672), "i"(128 * h2 + 4704) : "memory");
#define DSA_PV(nt_, x_, y_) do { bf16x8 vf_; vf_[0] = (short)x_[0]; vf_[1] = (short)x_[1]; vf_[2] = (short)x_[2]; vf_[3] = (short)x_[3]; vf_[4] = (short)y_[0]; vf_[5] = (short)y_[1]; vf_[6] = (short)y_[2]; vf_[7] = (short)y_[3]; \
                    O[nt_] = __builtin_amdgcn_mfma_f32_16x16x32_bf16(pf, vf_, O[nt_], 0, 0, 0); } while (0)
                    DSA_PV(4 * h2 + 0, x0, y0); DSA_PV(4 * h2 + 1, x1, y1); DSA_PV(4 * h2 + 2, x2, y2); DSA_PV(4 * h2 + 3, x3, y3);
                }
                asm volatile("s_waitcnt lgkmcnt(0)" ::: "memory");
                if (c + 2 < 8) DSA_ISSUE(c + 2);
            }
#undef DSA_PV
#undef DSA_ISSUE
            const float inv = 1.f / lrun;
            const float i0 = __shfl(inv, 4 * g), i1 = __shfl(inv, 4 * g + 1), i2 = __shfl(inv, 4 * g + 2), i3 = __shfl(inv, 4 * g + 3);
            if (g < 2) {
                bf16_t* op = OL + ((size_t)b * SEQ + (qrow - NMETA)) * 1024 + (4 * g) * 128 + hd;
#pragma unroll
                for (int nt = 0; nt < 8; ++nt) { op[16 * nt] = (bf16_t)f2bf(O[nt][0] * i0); op[128 + 16 * nt] = (bf16_t)f2bf(O[nt][1] * i1); op[256 + 16 * nt] = (bf16_t)f2bf(O[nt][2] * i2); op[384 + 16 * nt] = (bf16_t)f2bf(O[nt][3] * i3); }
            }
        }
    }
}

__device__ __forceinline__ void phase_inproj_meta(const Params& p) {
    unsigned char* ws = p.ws; const int tid = threadIdx.x, lane = tid & 63, wave = tid >> 6, fr = lane & 15, fq = lane >> 4;
    const bf16_t* U = (const bf16_t*)(ws + WS_U); const bf16_t* WP = (const bf16_t*)(ws + WS_WP); bf16_t* P = (bf16_t*)(ws + WS_P); const float2* cs = (const float2*)(ws + WS_CS);
    const int gw = blockIdx.x * NWAVES + wave, NGW = gridDim.x * NWAVES;
    for (int nt = gw; nt < PW / 16; nt += NGW) {
        const bf16_t* ap = U + (size_t)fr * D + 8 * fq; const bf16_t* bp = WP + (size_t)(16 * nt + fr) * D + 8 * fq;
        f32x4 acc = (f32x4){0.f, 0.f, 0.f, 0.f};
#pragma unroll 8
        for (int ks = 0; ks < D / 32; ++ks) acc = __builtin_amdgcn_mfma_f32_16x16x32_bf16(*(const bf16x8*)(bp + 32 * ks), *(const bf16x8*)(ap + 32 * ks), acc, 0, 0, 0);
        const int col = 16 * nt + 4 * fq, t = fr; f32x4 v = acc; int o;
        if (pg8::rope_off(col, o)) { const float2 c0 = cs[t * 8 + (o >> 1)], c1 = cs[t * 8 + (o >> 1) + 1]; v = (f32x4){v.x * c0.x - v.y * c0.y, v.y * c0.x + v.x * c0.y, v.z * c1.x - v.w * c1.y, v.w * c1.x + v.z * c1.y}; }
        u32x2 w; w.x = pk2(v.x, v.y); w.y = pk2(v.z, v.w);
        for (int b = 0; b < BATCH; ++b) {
            if (col >= C_KI && col < C_WI) { const int d0 = col - C_KI;
                *(u32x2*)(ws + WS_KIP + (size_t)b * KIP_BATCH + (size_t)((((t >> 5) * 4 + (d0 >> 4)) * 2 + ((d0 >> 3) & 1)) * 512 + (t & 31) * 16 + (d0 & 7) * 2)) = w; }
            else *(u32x2*)(P + ((size_t)b * T + t) * PW + col) = w;
        }
    }
}

__device__ __forceinline__ void phase_c3(const Params& p, char* lds) {
    unsigned char* ws = p.ws; const int tid = threadIdx.x, lane = tid & 63, wave = __builtin_amdgcn_readfirstlane(tid >> 6);
    const float* H1 = (const float*)(ws + WS_H1); const float* g = p.in[I_GFFN];
    {
        bf16_t* U2 = (bf16_t*)(ws + WS_U); const int gw = blockIdx.x * NWAVES + wave, NGW = gridDim.x * NWAVES;
        for (int row = gw; row < NR; row += NGW) {
            const f32x4* xr = (const f32x4*)(H1 + (size_t)row * D) + lane;
            f32x4 v[4]; float s = 0.f;
#pragma unroll
            for (int j = 0; j < 4; ++j) { v[j] = xr[64 * j]; s += (v[j].x * v[j].x + v[j].y * v[j].y) + (v[j].z * v[j].z + v[j].w * v[j].w); }
            const float rstd = rsqrtf(wave_sum(s) * (1.f / D) + NORM_EPS);
            u32x2* o = (u32x2*)(U2 + (size_t)row * D) + lane;
#pragma unroll
            for (int j = 0; j < 4; ++j) { const f32x4 gg = ((const f32x4*)g)[lane + 64 * j];
                u32x2 w; w.x = pk2(v[j].x * rstd * gg.x, v[j].y * rstd * gg.y); w.y = pk2(v[j].z * rstd * gg.z, v[j].w * rstd * gg.w); o[64 * j] = w; }
        }
    }
    {
        float* Tl = (float*)lds;
        float* RED = (float*)lds;
        const float* wg = p.in[I_WGRP]; const float* wr = p.in[I_WRT]; const float* bg = p.in[I_BGRP]; const float* br = p.in[I_BRT];
        unsigned* ctl = (unsigned*)(ws + WS_CTL); int* LIST = (int*)(ws + WS_LIST); float* GATE = (float*)(ws + WS_GATE);
        const int tk = tid & 127, kq = wave >> 1;
        for (int grp = blockIdx.x; grp < NR / 128; grp += gridDim.x) {
            const int tok0 = grp * 128;
            float acc[36]; float ss = 0.f;
#pragma unroll
            for (int o = 0; o < 36; ++o) acc[o] = 0.f;
            for (int step = 0; step < 8; ++step) {
                __syncthreads();
#pragma unroll
                for (int i = 0; i < 8; ++i) { const int idx = tid + NTHREADS * i, qq = idx >> 10, rem = idx & 1023, t2 = rem >> 3, kc = rem & 7;
                    const f32x4 v = *(const f32x4*)(H1 + (size_t)(tok0 + t2) * D + qq * 256 + step * 32 + kc * 4);
                    float* d = Tl + qq * (32 * 129) + (kc * 4) * 129 + t2; d[0] = v.x; d[129] = v.y; d[258] = v.z; d[387] = v.w; }
                __syncthreads();
                const int kb = kq * 256 + step * 32;
#pragma unroll 4
                for (int k = 0; k < 32; ++k) {
                    const float h = Tl[kq * (32 * 129) + k * 129 + tk]; ss += h * h; const float hg = h * g[kb + k];
                    const float* w4 = wg + (size_t)(kb + k) * 4; const float* w32 = wr + (size_t)(kb + k) * 32;
#pragma unroll
                    for (int o = 0; o < 4; ++o) acc[o] += hg * w4[o];
#pragma unroll
                    for (int o = 0; o < 32; ++o) acc[4 + o] += hg * w32[o];
                }
            }
            __syncthreads();
#pragma unroll
            for (int o = 0; o < 36; ++o) RED[(kq * 37 + o) * 128 + tk] = acc[o];
            RED[(kq * 37 + 36) * 128 + tk] = ss;
            __syncthreads();
            if (tid < 128) {
                const int tok = tok0 + tk;
#pragma unroll
                for (int o = 0; o < 36; ++o) acc[o] = (RED[o * 128 + tk] + RED[(37 + o) * 128 + tk]) + (RED[(74 + o) * 128 + tk] + RED[(111 + o) * 128 + tk]);
                ss = (RED[36 * 128 + tk] + RED[(37 + 36) * 128 + tk]) + (RED[(74 + 36) * 128 + tk] + RED[(111 + 36) * 128 + tk]);
                const float rstd = rsqrtf(ss * (1.f / D) + NORM_EPS);
                float gl[4]; int gs = 0; float gm;
#pragma unroll
                for (int o = 0; o < 4; ++o) gl[o] = acc[o] * rstd + bg[o];
                gm = gl[0];
#pragma unroll
                for (int o = 1; o < 4; ++o) if (gl[o] > gm) { gm = gl[o]; gs = o; }
                float gsum = 0.f;
#pragma unroll
                for (int o = 0; o < 4; ++o) gsum += __expf(gl[o] - gm);
                const float pgrp = 1.f / gsum;
                float el[8];
#pragma unroll
                for (int j = 0; j < 8; ++j) { float a = acc[4 + j]; float bb = br[j];
                    a = gs == 1 ? acc[12 + j] : a; bb = gs == 1 ? br[8 + j] : bb; a = gs == 2 ? acc[20 + j] : a; bb = gs == 2 ? br[16 + j] : bb; a = gs == 3 ? acc[28 + j] : a; bb = gs == 3 ? br[24 + j] : bb;
                    el[j] = a * rstd + bb; }
                int e0 = 0; float m0 = el[0];
#pragma unroll
                for (int j = 1; j < 8; ++j) if (el[j] > m0) { m0 = el[j]; e0 = j; }
                int e1 = -1; float m1 = -3e38f;
#pragma unroll
                for (int j = 0; j < 8; ++j) if (j != e0 && el[j] > m1) { m1 = el[j]; e1 = j; }
                const float x1 = __expf(m1 - m0); const float g0 = pgrp / (1.f + x1), g1 = pgrp * x1 / (1.f + x1);
                const int ex0 = gs * 8 + e0, ex1 = gs * 8 + e1;
                const int s0 = (int)atomicAdd(ctl + CW_CNT + 64 * ex0, 1u); LIST[(size_t)ex0 * NR + s0] = tok * 2;
                const int s1 = (int)atomicAdd(ctl + CW_CNT + 64 * ex1, 1u); LIST[(size_t)ex1 * NR + s1] = tok * 2 + 1;
                GATE[tok * 2] = g0; GATE[tok * 2 + 1] = g1;
            }
        }
    }
}

template <int WHICH>
__device__ __forceinline__ void phase_moe(const Params& p, char* lds) {
    unsigned char* ws = p.ws; const int tid = threadIdx.x;
    const unsigned* ctl = (const unsigned*)(ws + WS_CTL);
    int* TP = (int*)(lds + pg8::STAGE_BYTES);
    __syncthreads();
    if (tid == 0) { int tp = 0, ro = 0; for (int e = 0; e < NEXP; ++e) { const int c = (int)ctl[CW_CNT + 64 * e]; TP[e] = tp; TP[64 + e] = ro; TP[128 + e] = c; const int t = (c + 255) / 256; tp += t * 4; ro += t * 256; } TP[NEXP] = tp; }
    __syncthreads();
    pg8::MoeOrder<WHICH> S{TP, (int)gridDim.x, (int)blockIdx.x, (const char*)(ws + (WHICH == 0 ? WS_U : WS_HID)), (const char*)(ws + (WHICH == 0 ? WS_W13 : WS_W2)), (const int*)(ws + WS_LIST)};
    if constexpr (WHICH == 0) { pg8::EpiMoe1 E{(bf16_t*)(ws + WS_HID), TP}; pg8::gemm_phase_x<pg8::EpiMoe1, pg8::MoeOrder<0>, true, true>((LAS unsigned char*)lds, 1024, S, E); }
    else { pg8::EpiMoe2 E{(bf16_t*)(ws + WS_MO), TP, (const int*)(ws + WS_LIST), (const float*)(ws + WS_GATE)}; pg8::gemm_phase_x<pg8::EpiMoe2, pg8::MoeOrder<1>, true, true>((LAS unsigned char*)lds, 512, S, E); }
}

__device__ __forceinline__ void phase_final(const Params& p) {
    unsigned char* ws = p.ws; const int tid = threadIdx.x, lane = tid & 63, wave = tid >> 6;
    const float* H1 = (const float*)(ws + WS_H1); const bf16_t* MO = (const bf16_t*)(ws + WS_MO); const float* g = p.in[I_GFIN];
    const int gw = blockIdx.x * NWAVES + wave, NGW = gridDim.x * NWAVES;
    for (int orow = gw; orow < BATCH * SEQ; orow += NGW) {
        const size_t row = (size_t)orow;
        const f32x4* xr = (const f32x4*)(H1 + row * D) + lane; const u32x2* m0 = (const u32x2*)(MO + row * 2 * D) + lane; const u32x2* m1 = m0 + 256;
        f32x4 v[4]; float ss = 0.f;
#pragma unroll
        for (int j = 0; j < 4; ++j) { const u32x2 a = m0[64 * j], c = m1[64 * j]; v[j] = xr[64 * j];
            v[j].x += bflo(a.x) + bflo(c.x); v[j].y += bfhi(a.x) + bfhi(c.x); v[j].z += bflo(a.y) + bflo(c.y); v[j].w += bfhi(a.y) + bfhi(c.y);
            ss += (v[j].x * v[j].x + v[j].y * v[j].y) + (v[j].z * v[j].z + v[j].w * v[j].w); }
        const float rstd = rsqrtf(wave_sum(ss) * (1.f / D) + NORM_EPS);
        f32x4* o = (f32x4*)(p.out + (size_t)orow * D) + lane;
#pragma unroll
        for (int j = 0; j < 4; ++j) { const f32x4 gg = ((const f32x4*)g)[lane + 64 * j]; o[64 * j] = v[j] * rstd * gg; }
    }
}

#define XB_TMO      128
#define XB_XCNT(j)  (256  + 64 * (j))
#define XB_XSUB(j)  (1280 + 64 * (j))
#define XB_XGEN(j)  (2304 + 64 * (j))
#define XB_TOP      3328
#define XB_TOPGEN   3392
#define XCD_BAR_WORDS 3456
#define XB_SPIN_CAP (1u << 18)
__device__ __forceinline__ unsigned xb_ld(unsigned* p)              { return __hip_atomic_load(p, __ATOMIC_RELAXED, __HIP_MEMORY_SCOPE_AGENT); }
__device__ __forceinline__ unsigned xb_add(unsigned* p, unsigned v) { return __hip_atomic_fetch_add(p, v, __ATOMIC_RELAXED, __HIP_MEMORY_SCOPE_AGENT); }
__device__ __forceinline__ unsigned xb_xcc_id() { return (unsigned)__builtin_amdgcn_s_getreg((3 << 11) | 20) & 0xFu; }
#define XB_SPIN(cond, bar) do { unsigned _sp = 0; while (cond) { __builtin_amdgcn_s_sleep(1); \
    if ((++_sp & 255u) == 0u) { if (xb_ld(&(bar)[XB_TMO])) break; if (_sp > XB_SPIN_CAP) { atomicAdd(&(bar)[XB_TMO], 1u); break; } } } } while (0)
struct XcdBarrier { unsigned* bar; unsigned x; volatile LAS unsigned* st; };
__device__ __forceinline__ XcdBarrier xcd_barrier_post(unsigned* bar, volatile LAS unsigned* st) {
    XcdBarrier b; b.bar = bar; b.x = xb_xcc_id(); b.st = st;
    if (threadIdx.x == 0) (void)xb_add(&bar[XB_XCNT(b.x)], 1u);
    return b;
}
__device__ __forceinline__ void xcd_barrier_complete(unsigned* bar, unsigned x, unsigned& nloc, unsigned& nx) {
    const unsigned G = gridDim.x * gridDim.y * gridDim.z;
    unsigned sum, cnt, mine, sp = 0u;
    for (;;) {
        sum = 0u; cnt = 0u; mine = 0u;
#pragma unroll
        for (unsigned j = 0; j < 16; ++j) { const unsigned c = xb_ld(&bar[XB_XCNT(j)]); sum += c; cnt += (c > 0u) ? 1u : 0u; mine = (j == x) ? c : mine; }
        if (sum == G) break;
        __builtin_amdgcn_s_sleep(1);
        if ((++sp & 255u) == 0u) { if (xb_ld(&bar[XB_TMO])) break; if (sp > XB_SPIN_CAP) { atomicAdd(&bar[XB_TMO], 1u); break; } }
    }
    nloc = mine > 0u ? mine : 1u; nx = cnt > 0u ? cnt : 1u;
}
__device__ __forceinline__ void xcd_barrier(const XcdBarrier& b) {
    asm volatile("s_waitcnt vmcnt(0)" ::: "memory");
    __syncthreads();
    if (threadIdx.x == 0) {
        unsigned* bar = b.bar;
        __builtin_amdgcn_s_waitcnt(0);
        unsigned nloc = b.st[0], nx = b.st[1];
        if (nloc == 0u) { xcd_barrier_complete(bar, b.x, nloc, nx); b.st[0] = nloc; b.st[1] = nx; }
        const unsigned old = xb_add(&bar[XB_XSUB(b.x)], 1u);
        const unsigned gen = old / nloc;
        if (old + 1u == (gen + 1u) * nloc) {
            __builtin_amdgcn_fence(__ATOMIC_RELEASE, "agent");
            asm volatile("s_waitcnt vmcnt(0)" ::: "memory");
            const unsigned og = xb_add(&bar[XB_TOP], 1u);
            const unsigned tg = og / nx;
            if (og + 1u == (tg + 1u) * nx) xb_add(&bar[XB_TOPGEN], 1u);
            else XB_SPIN(xb_ld(&bar[XB_TOPGEN]) == tg, bar);
            __builtin_amdgcn_fence(__ATOMIC_ACQUIRE, "agent");
            xb_add(&bar[XB_XGEN(b.x)], 1u);
            asm volatile("s_waitcnt vmcnt(0)" ::: "memory");
        } else {
            XB_SPIN(xb_ld(&bar[XB_XGEN(b.x)]) == gen, bar);
            __builtin_amdgcn_fence(__ATOMIC_ACQUIRE, "agent");
            asm volatile("s_waitcnt vmcnt(0)" ::: "memory");
        }
    }
    __syncthreads();
}

constexpr int LDS_XB = DSA_LDS;
constexpr int LDS_BYTES = DSA_LDS + 256;
static_assert(pg8::STAGE_BYTES <= LDS_XB && pg8::STAGE_BYTES + 1024 <= LDS_XB && NWAVES * 64 * 33 * 4 <= LDS_XB && NWAVES * 64 * SB_VT_STRIDE * 2 <= LDS_XB && 4 * 37 * 128 * 4 <= LDS_XB, "LDS map");

__global__ void __launch_bounds__(NTHREADS, 2) mega(Params p) {
    extern __shared__ __attribute__((aligned(16))) char lds[];
    const int lo = p.ph_lo, hi = p.ph_hi;
    unsigned char* ws = p.ws;
    XcdBarrier xb;
    {
        volatile LAS unsigned* st = (volatile LAS unsigned*)(lds + LDS_XB);
        if (threadIdx.x < 4) st[threadIdx.x] = 0u;
        __syncthreads();
        xb = xcd_barrier_post((unsigned*)(ws + WS_CTL) + CW_BAR, st);
    }
#define IN(k) (lo <= (k) && (k) < hi)
#define GSYNC() xcd_barrier(xb)
#define SEAM(k) do { if (IN(k) && IN((k) + 1)) GSYNC(); } while (0)
#define REP(k, ...) do { if (IN(k)) { __VA_ARGS__; if (PROBE_PH == (k)) { GSYNC(); __VA_ARGS__; } } } while (0)
    LAS unsigned char* ldsl = (LAS unsigned char*)lds;
    REP(0, phase_prologue(p, lds));
    SEAM(0);
    REP(1, { phase_inproj_meta(p);
             pg8::TokRowOrder S; S.init(NR, PWN, gridDim.x, blockIdx.x); S.Abase = (const char*)(ws + WS_U); S.Bbase = (const char*)(ws + WS_WP); S.K = D;
             pg8::EpiInproj E{(bf16_t*)(ws + WS_P), (const float2*)(ws + WS_CS), ws + WS_KIP}; pg8::gemm_phase_x<pg8::EpiInproj, pg8::TokRowOrder, true, true>(ldsl, D, S, E); });
    SEAM(1);
    if (IN(2)) {
        phase_dsa(p, lds);
        if (PROBE_PH == 20) { GSYNC(); phase_dsa(p, lds); }
        __syncthreads(); phase_sb_fast(p, lds);
        if (PROBE_PH == 21) { GSYNC(); phase_sb_fast(p, lds); }
    }
    SEAM(2);
    REP(3, { pg8::TokRowOrder S; S.init(NR, 2048, gridDim.x, blockIdx.x); S.Abase = (const char*)(ws + WS_U); S.Bbase = (const char*)(ws + WS_WG); S.K = D;
             pg8::EpiGate E{(bf16_t*)(ws + WS_G)}; pg8::gemm_phase_x<pg8::EpiGate, pg8::TokRowOrder, true, true>(ldsl, D, S, E); });
    SEAM(3);
    REP(4, { { pg8::Gemm g{(const bf16_t*)(ws + WS_YA), (const bf16_t*)(ws + WS_WUA), NR, D, 512}; pg8::StaticOrder S; S.init(NR, D, gridDim.x, blockIdx.x);
               pg8::EpiZ<false> E{(bf16_t*)(ws + WS_Z), (const bf16_t*)(ws + WS_G), 0}; pg8::gemm_phase<pg8::EpiZ<false>, pg8::StaticOrder, true, true>(ldsl, g, S, E); }
             asm volatile("s_waitcnt vmcnt(0)" ::: "memory"); __syncthreads();
             { pg8::Gemm g{(const bf16_t*)(ws + WS_OLAT), (const bf16_t*)(ws + WS_WBP), NR, D, D}; pg8::StaticOrder S; S.init(NR, D, gridDim.x, blockIdx.x);
               pg8::EpiZ<true> E{(bf16_t*)(ws + WS_Z), (const bf16_t*)(ws + WS_G), 1024}; pg8::gemm_phase<pg8::EpiZ<true>, pg8::StaticOrder, true, true>(ldsl, g, S, E); } });
    SEAM(4);
    REP(5, { pg8::Gemm g{(const bf16_t*)(ws + WS_Z), (const bf16_t*)(ws + WS_WO), NR, D, D}; pg8::StaticOrder S; S.init(NR, D, gridDim.x, blockIdx.x);
             pg8::EpiH1 E{(float*)(ws + WS_H1), p.in[I_META], p.in[I_X]}; pg8::gemm_phase<pg8::EpiH1, pg8::StaticOrder, true, true>(ldsl, g, S, E); });
    SEAM(5);
    if (IN(6)) phase_c3(p, lds);
    SEAM(6);
    REP(7, phase_moe<0>(p, lds));
    SEAM(7);
    REP(8, phase_moe<1>(p, lds));
    SEAM(8);
    REP(9, phase_final(p));
}

extern "C" void kernel_launch(void* const* d_in, const int* in_sizes, int n_in, void* d_out, int out_size, void* d_ws, size_t ws_size, hipStream_t stream) {
    if (n_in != 18 || ws_size < WS_END) { fprintf(stderr, "kernel_launch: unexpected n_in %d / ws_size %zu\n", n_in, ws_size); return; }
    static int grid = 0;
    if (grid == 0) {
        int dev = 0, cus = 0, per_cu = 0;
        (void)hipGetDevice(&dev);
        (void)hipDeviceGetAttribute(&cus, hipDeviceAttributeMultiprocessorCount, dev);
        (void)hipFuncSetAttribute((const void*)mega, hipFuncAttributeMaxDynamicSharedMemorySize, LDS_BYTES);
        (void)hipOccupancyMaxActiveBlocksPerMultiprocessor(&per_cu, (const void*)mega, NTHREADS, LDS_BYTES);
        if (per_cu < 1) fprintf(stderr, "kernel_launch: occupancy query reports %d workgroups per CU\n", per_cu);
        grid = cus;
    }
    (void)hipMemsetAsync((char*)d_ws + WS_CTL, 0, CTL_BYTES, stream);
    Params p{};
    for (int i = 0; i < 18; ++i) p.in[i] = (const float*)d_in[i];
    p.out = (float*)d_out; p.ws = (unsigned char*)d_ws;
    p.ph_lo = 0; p.ph_hi = 10;
    void* args[] = {&p};
    hipError_t e = hipLaunchCooperativeKernel((const void*)mega, dim3(grid), dim3(NTHREADS), args, LDS_BYTES, stream);
    if (e != hipSuccess) fprintf(stderr, "cooperative launch failed: %s (grid %d)\n", hipGetErrorString(e), grid);
}
```

```cpp
#include <hip/hip_runtime.h>
#include <cstdio>
#include <cstdint>

constexpr int BATCH = 8, SEQ = 4096, NMETA = 16, T = SEQ + NMETA, D = 1024, NTOK = BATCH * T;
constexpr int MROWS = 33024;
constexpr int NR = BATCH * SEQ;
__device__ __forceinline__ int tokrow(int cr) { return cr + NMETA * (cr / SEQ + 1); }
constexpr int INW = 4824;
constexpr int NEXP = 32, DEXP = 512;
constexpr int NWAVES = 8, NTHREADS = 512;
constexpr float NORM_EPS = 1e-6f;
constexpr float LOG2E = 1.4426950408889634f;
constexpr float QSCALE = 0.125f * LOG2E;
constexpr int PW = 3456, PWN = 3584;
constexpr int C_QA = 0, C_KA = 512, C_VA = 1024, C_QF = 1536, C_KV = 2688, C_QI = 2832, C_KI = 3344, C_WI = 3408, C_END = 3416;
constexpr int QFW = 144;

constexpr size_t MiB = 1u << 20;
constexpr size_t WS_CTL = 0, CTL_BYTES = 1 * MiB;
constexpr size_t WS_CS = 1 * MiB;
constexpr size_t WS_WP = 2 * MiB;
constexpr size_t WS_WG = 9 * MiB;
constexpr size_t WS_WUA = 13 * MiB, WS_WBP = 14 * MiB, WS_WO = 16 * MiB;
constexpr size_t WS_W2 = 18 * MiB;
constexpr size_t WS_W13 = 50 * MiB;
constexpr size_t WS_U = 114 * MiB;
constexpr size_t WS_P = 179 * MiB;
constexpr size_t WS_Z = 179 * MiB;
constexpr size_t WS_G = 244 * MiB;
constexpr size_t WS_H1 = 244 * MiB;
constexpr size_t WS_LIST = 374 * MiB;
constexpr size_t WS_GATE = 379 * MiB;
constexpr size_t WS_YA = 397 * MiB;
constexpr size_t WS_OLAT = 430 * MiB;
constexpr size_t WS_HID = 397 * MiB;
constexpr size_t WS_MO = 50 * MiB;
constexpr size_t WS_KIP = 495 * MiB;
constexpr size_t KIP_BATCH = 129 * 4096;
constexpr size_t WS_END = 500 * MiB;
static_assert(WS_P + (size_t)MROWS * PW * 2 <= WS_YA && WS_G + (size_t)MROWS * 2048 * 2 <= WS_LIST && WS_Z + (size_t)MROWS * 1024 * 2 <= WS_G, "ws map");
static_assert(WS_OLAT + (size_t)MROWS * 1024 * 2 <= WS_END && WS_U + (size_t)MROWS * 1024 * 2 <= WS_P && WS_MO + (size_t)NTOK * 2048 * 2 <= WS_P, "ws map");
constexpr int CW_CNT = 1024;
constexpr int CW_BAR = 4096;

typedef unsigned short bf16_t;
typedef short bf16x8 __attribute__((ext_vector_type(8)));
typedef float f32x4 __attribute__((ext_vector_type(4)));
typedef float f32x16 __attribute__((ext_vector_type(16)));
typedef unsigned u32x2 __attribute__((ext_vector_type(2)));
typedef unsigned u32x4 __attribute__((ext_vector_type(4)));
typedef unsigned short u16x4 __attribute__((ext_vector_type(4)));
#define LAS __attribute__((address_space(3)))

__device__ __forceinline__ unsigned f2bf(float f) { unsigned u = __float_as_uint(f); return (u + 0x7fffu + ((u >> 16) & 1u)) >> 16; }
typedef __bf16 bf16v2_t __attribute__((ext_vector_type(2)));
typedef float f32v2_t __attribute__((ext_vector_type(2)));
__device__ __forceinline__ unsigned pk2(float lo, float hi) { const f32v2_t v = {lo, hi}; const bf16v2_t r = __builtin_convertvector(v, bf16v2_t); return __builtin_bit_cast(unsigned, r); }
__device__ __forceinline__ float bflo(unsigned w) { return __uint_as_float(w << 16); }
__device__ __forceinline__ float bfhi(unsigned w) { return __uint_as_float(w & 0xffff0000u); }
__device__ __forceinline__ float bf2f(bf16_t b) { return __uint_as_float((unsigned)b << 16); }
__device__ __forceinline__ float wave_sum(float v) {
#pragma unroll
    for (int o = 1; o < 64; o <<= 1) v += __shfl_xor(v, o);
    return v;
}
__device__ __forceinline__ float xsum32(float x) { const auto r = __builtin_amdgcn_permlane32_swap(__float_as_uint(x), __float_as_uint(x), false, false); return __uint_as_float(r[0]) + __uint_as_float(r[1]); }
__device__ __forceinline__ float xsum16(float x) { const auto r = __builtin_amdgcn_permlane16_swap(__float_as_uint(x), __float_as_uint(x), false, false); return __uint_as_float(r[0]) + __uint_as_float(r[1]); }
__device__ __forceinline__ float xmax32(float x) { const auto r = __builtin_amdgcn_permlane32_swap(__float_as_uint(x), __float_as_uint(x), false, false); return fmaxf(__uint_as_float(r[0]), __uint_as_float(r[1])); }
__device__ __forceinline__ float xmax16(float x) { const auto r = __builtin_amdgcn_permlane16_swap(__float_as_uint(x), __float_as_uint(x), false, false); return fmaxf(__uint_as_float(r[0]), __uint_as_float(r[1])); }
__device__ __forceinline__ float xpartner32(float x, int hh) { const auto r = __builtin_amdgcn_permlane32_swap(__float_as_uint(x), __float_as_uint(x), false, false); return __uint_as_float(hh ? r[0] : r[1]); }
__device__ __forceinline__ float sigmoidf(float x) { return 1.0f / (1.0f + __expf(-x)); }

struct Params {
    const float* in[18];
    float* out;
    unsigned char* ws;
    int ph_lo, ph_hi;
};
enum { I_X = 0, I_META, I_GMIX, I_WIN, I_WUK, I_WUV, I_WUPA, I_WUPB, I_WO, I_GFFN, I_WGRP, I_BGRP, I_WRT, I_BRT, I_W1, I_W3, I_W2, I_GFIN };

__device__ __forceinline__ const float* h0_row(const Params& p, int row) {
    const int b = row / T, t = row - b * T;
    return t < NMETA ? p.in[I_META] + (size_t)t * D : p.in[I_X] + ((size_t)b * SEQ + (t - NMETA)) * D;
}
template <class F>
__device__ __forceinline__ void tr_item(F val, bf16_t* dst, int ldd, int row0, int k0, float* scr, int lane, int rstep = 1) {
    float tv[32];
#pragma unroll
    for (int i = 0; i < 32; ++i) tv[i] = val(k0 + 2 * i + (lane >> 5), lane & 31);
#pragma unroll
    for (int i = 0; i < 32; ++i) scr[(2 * i + (lane >> 5)) * 33 + (lane & 31)] = tv[i];
    __builtin_amdgcn_s_waitcnt(0xC07F);
    asm volatile("" ::: "memory");
    const int c = lane & 7;
#pragma unroll
    for (int j = 0; j < 4; ++j) {
        const int n = (lane >> 3) + 8 * j; const float* s = scr + (8 * c) * 33 + n;
        u32x4 o; o.x = pk2(s[0], s[33]); o.y = pk2(s[66], s[99]); o.z = pk2(s[132], s[165]); o.w = pk2(s[198], s[231]);
        *(u32x4*)(dst + (size_t)(row0 + n * rstep) * ldd + k0 + 8 * c) = o;
    }
    __builtin_amdgcn_s_waitcnt(0xC07F);
    asm volatile("" ::: "memory");
}

__device__ __forceinline__ void wp_src(int c, int& kind, int& col, int& aux, float& scale) {
    kind = 1; aux = 0; scale = 1.f; col = 0;
    if (c < 512) { col = c; scale = QSCALE; }
    else if (c < C_QF) { col = c; }
    else if (c < C_KV) { const int r = c - C_QF, h = r / QFW, j = r % QFW; scale = QSCALE;
        if (j < 128) { kind = 2; col = h; aux = j; } else { const int i = j - 128; col = 1536 + 64 * h + (i >> 1) + 8 * (i & 1); } }
    else if (c < C_QI) { const int j = c - C_KV; if (j < 128) col = 2048 + j; else { const int i = j - 128; col = 2176 + (i >> 1) + 8 * (i & 1); } }
    else if (c < C_KI) { const int r = c - C_QI, h = r >> 6, j = r & 63; col = 2192 + 64 * h + (j < 16 ? (j >> 1) + 8 * (j & 1) : j); }
    else if (c < C_WI) { const int j = c - C_KI; col = 2704 + (j < 16 ? (j >> 1) + 8 * (j & 1) : j); }
    else if (c < C_END) { col = 2768 + (c - C_WI); }
    else kind = 0;
}

constexpr int IT_WP = (PWN / 32) * 16;
constexpr int IT_WG = 32 * 16;
constexpr int IT_WUA = 32 * 8;
constexpr int IT_WBP = 32 * 16, IT_WO = 32 * 16;
constexpr int IT_W13 = NEXP * 32 * 16;
constexpr int IT_W2 = NEXP * 32 * 8;
constexpr int IT_TOTAL = IT_WP + 2 * IT_WG + IT_WUA + IT_WBP + IT_WO + IT_W13 + IT_W2;

__device__ __forceinline__ void phase_prologue(const Params& p, char* lds) {
    const int tid = threadIdx.x, lane = tid & 63, wave = tid >> 6;
    const int gw = blockIdx.x * NWAVES + wave, NGW = gridDim.x * NWAVES;
    float* scr = (float*)lds + wave * (64 * 33);
    unsigned char* ws = p.ws;
    const float* w_in = p.in[I_WIN];
    {
        float2* cs = (float2*)(ws + WS_CS);
        for (int i = blockIdx.x * NTHREADS + tid; i < T * 8; i += gridDim.x * NTHREADS) {
            const int pos = i >> 3, f = i & 7;
            const float inv = powf(500000.0f, -(float)f / 8.0f);
            const float ang = (float)pos * inv;
            cs[i] = make_float2(cosf(ang), sinf(ang));
        }
    }
    for (int it = gw; it < IT_TOTAL; it += NGW) {
        int r = it;
        if (r < IT_WP) {
            const int rg = r / 16, kb = r % 16, c = rg * 32 + (lane & 31);
            int kind, col, aux; float scale; wp_src(c, kind, col, aux, scale);
            const float* w_uk = p.in[I_WUK];
            float wu[48];
#pragma unroll
            for (int n4 = 0; n4 < 12; ++n4) { f32x4 t = (f32x4){0.f, 0.f, 0.f, 0.f}; if (kind == 2) t = *(const f32x4*)(w_uk + ((size_t)col * 128 + aux) * 48 + 4 * n4); wu[4 * n4] = t.x; wu[4 * n4 + 1] = t.y; wu[4 * n4 + 2] = t.z; wu[4 * n4 + 3] = t.w; }
            tr_item([&](int k, int) -> float {
                if (kind == 0) return 0.f;
                if (kind == 1) return scale * w_in[(size_t)k * INW + col];
                const f32x4* wi = (const f32x4*)(w_in + (size_t)k * INW + 1536 + 64 * col + 16);
                float s = 0.f;
#pragma unroll
                for (int n4 = 0; n4 < 12; ++n4) { const f32x4 t = wi[n4]; s += t.x * wu[4 * n4] + t.y * wu[4 * n4 + 1] + t.z * wu[4 * n4 + 2] + t.w * wu[4 * n4 + 3]; }
                return scale * s; }, (bf16_t*)(ws + WS_WP), 1024, rg * 32, kb * 64, scr, lane);
            continue; }
        r -= IT_WP;
        if (r < 2 * IT_WG) {
            const int which = r / IT_WG; r %= IT_WG; const int rg = r / 16, kb = r % 16; const int col0 = (which ? 3800 : 2776) + rg * 32;
            tr_item([&](int k, int n) -> float { return w_in[(size_t)k * INW + col0 + n]; }, (bf16_t*)(ws + WS_WG) + (size_t)which * 1024 * 1024, 1024, rg * 32, kb * 64, scr, lane);
            continue; }
        r -= 2 * IT_WG;
        if (r < IT_WUA) {
            const int rg = r / 8, kb = r % 8; const float* w = p.in[I_WUPA];
            tr_item([&](int k, int n) -> float { return w[(size_t)k * 1024 + rg * 32 + n]; }, (bf16_t*)(ws + WS_WUA), 512, rg * 32, kb * 64, scr, lane);
            continue; }
        r -= IT_WUA;
        if (r < IT_WBP) {
            const int rg = r / 16, kb = r % 16; const float* wuv = p.in[I_WUV]; const float* wub = p.in[I_WUPB];
            const int hB = kb >> 1;
            float bc[64];
#pragma unroll
            for (int d = 0; d < 64; ++d) bc[d] = wub[(size_t)(64 * hB + d) * 1024 + rg * 32 + (lane & 31)];
            tr_item([&](int kk, int) -> float {
                const f32x4* a = (const f32x4*)(wuv + (size_t)kk * 64);
                float s = 0.f;
#pragma unroll
                for (int d4 = 0; d4 < 16; ++d4) { const f32x4 t = a[d4]; s += t.x * bc[4 * d4] + t.y * bc[4 * d4 + 1] + t.z * bc[4 * d4 + 2] + t.w * bc[4 * d4 + 3]; }
                return s; }, (bf16_t*)(ws + WS_WBP), 1024, rg * 32, kb * 64, scr, lane);
            continue; }
        r -= IT_WBP;
        if (r < IT_WO) {
            const int rg = r / 16, kb = r % 16; const float* w = p.in[I_WO];
            tr_item([&](int k, int n) -> float { return w[(size_t)k * 1024 + rg * 32 + n]; }, (bf16_t*)(ws + WS_WO), 1024, rg * 32, kb * 64, scr, lane);
            continue; }
        r -= IT_WO;
        if (r < IT_W13) {
            const int e = r / 512; r %= 512; const int which = r & 1, cg = (r >> 1) & 15, kb = r >> 5;
            const float* w = (which ? p.in[I_W3] : p.in[I_W1]) + (size_t)e * 1024 * 512 + cg * 32;
            tr_item([&](int k, int n) -> float { return w[(size_t)k * 512 + n]; },
                    (bf16_t*)(ws + WS_W13) + (size_t)e * 1024 * 1024, 1024, 2 * cg * 32 + which, kb * 64, scr, lane, 2);
            continue; }
        r -= IT_W13;
        {
            const int e = r / 256; r %= 256; const int rg = r / 8, kb = r % 8;
            const float* w2 = p.in[I_W2] + (size_t)e * 512 * 1024;
            tr_item([&](int k, int n) -> float { return w2[(size_t)k * 1024 + rg * 32 + n]; }, (bf16_t*)(ws + WS_W2) + (size_t)e * 1024 * 512, 512, rg * 32, kb * 64, scr, lane);
        }
    }
    {
        const float* g = p.in[I_GMIX]; bf16_t* U = (bf16_t*)(ws + WS_U);
        for (int row = gw; row < NTOK; row += NGW) {
            const f32x4* xr = (const f32x4*)h0_row(p, row) + lane;
            f32x4 v[4]; float s = 0.f;
#pragma unroll
            for (int j = 0; j < 4; ++j) { v[j] = xr[64 * j]; s += (v[j].x * v[j].x + v[j].y * v[j].y) + (v[j].z * v[j].z + v[j].w * v[j].w); }
            const float rstd = rsqrtf(wave_sum(s) * (1.f / D) + NORM_EPS);
            u32x2* o = (u32x2*)(U + (size_t)row * D) + lane;
#pragma unroll
            for (int j = 0; j < 4; ++j) { const f32x4 gg = ((const f32x4*)g)[lane + 64 * j];
                u32x2 w; w.x = pk2(v[j].x * rstd * gg.x, v[j].y * rstd * gg.y); w.y = pk2(v[j].z * rstd * gg.z, v[j].w * rstd * gg.w); o[64 * j] = w; }
        }
    }
}

namespace pg8 {
#define PG8_LAS __attribute__((address_space(3)))
typedef unsigned short bf16_t;
typedef short bf16x8 __attribute__((ext_vector_type(8)));
typedef float f32x4 __attribute__((ext_vector_type(4)));
typedef unsigned u32x4 __attribute__((ext_vector_type(4)));
constexpr int BM = 256, BK = 64, HALF = 128, HTB = HALF * BK * 2  , STAGE_BYTES = 8 * HTB, NXCD = 8, WGM = 8;

__host__ __device__ __forceinline__ int lds_byte(int r, int c) { const int st = (r >> 4) * 2 + (c >> 5), rr = r & 15, cc = c & 31, ob = rr * 64 + cc * 2; return st * 1024 + (ob ^ (((ob >> 9) & 1) << 5)); }
__host__ __device__ __forceinline__ void stage_rc(int b, int& R, int& C) { const int st = b / 1024, sb = b % 1024, swz = sb ^ (((sb >> 9) & 1) << 5); R = (st >> 1) * 16 + swz / 64; C = (st & 1) * 32 + (swz % 64) / 2; }
__host__ __device__ __forceinline__ int perm32(int rho) { const int n = rho >> 4, i = rho & 15; return 8 * (i >> 2) + 4 * n + (i & 3); }

struct Unit { int pm, pn; };
struct Gemm { const bf16_t* A; const bf16_t* Bt; int M, N, K; };

struct StaticOrder {
    int nM, nN, nwg, G, c;
    __host__ __device__ void init(int M, int N, int G_, int c_) { nM = M / BM; nN = N / BM; nwg = nM * nN; G = G_; c = c_; }
    __host__ __device__ bool next(int i, Unit& u) const {
        const long L = (long)i * G + c; if (L >= nwg) return false;
        int wgid = (int)L; { const int q = nwg / NXCD, r = nwg % NXCD, xcd = wgid % NXCD, off = wgid / NXCD; wgid = (xcd < r ? xcd * (q + 1) : r * (q + 1) + (xcd - r) * q) + off; }
        const int nig = WGM * nN, gid = wgid / nig, fm = gid * WGM, gsz = (nM - fm) < WGM ? (nM - fm) : WGM;
        u.pm = fm + ((wgid % nig) % gsz); u.pn = (wgid % nig) / gsz; return true;
    }
    __device__ __forceinline__ void a_ready(const Unit&) const {}
    __device__ __forceinline__ void done(const Unit&) const {}
};


#define PG8_FOR_FRAGS(...) _Pragma("unroll") for (int ai = 0; ai < 2; ++ai) _Pragma("unroll") for (int m = 0; m < 4; ++m) { const int row = u.pm * BM + ai * HALF + wr * 64 + m * 16 + fr; \
    _Pragma("unroll") for (int bj = 0; bj < 2; ++bj) _Pragma("unroll") for (int n = 0; n < 2; ++n) { const int col = u.pn * BM + bj * HALF + wc * 32 + n * 16 + 4 * fq; ::f32x4 v = acc[ai][bj][m][n]; __VA_ARGS__ } }
__device__ __forceinline__ bool rope_off(int c, int& o) {
    if (c < C_QF) return false;
    if (c < C_KV) { const int j = (c - C_QF) % QFW; o = j - 128; return j >= 128; }
    if (c < C_QI) { const int j = c - C_KV; o = j - 128; return j >= 128; }
    if (c < C_KI) { const int j = (c - C_QI) & 63; o = j; return j < 16; }
    if (c < C_WI) { const int j = c - C_KI; o = j; return j < 16; }
    return false;
}
struct EpiInproj {
    static constexpr bool PERM = false, AFTER_DRAIN = false;
    bf16_t* P; const float2* cs; unsigned char* KIP;
    __device__ __forceinline__ void operator()(const f32x4 (&acc)[2][2][4][2], const Unit& u, int wr, int wc, int fr, int fq) const {
        PG8_FOR_FRAGS(
            if (col < PW) {
                int o; const int trow = tokrow(row);
                if (rope_off(col, o)) {
                    const int pos = (row % SEQ) + NMETA; const float2 c0 = cs[pos * 8 + (o >> 1)], c1 = cs[pos * 8 + (o >> 1) + 1];
                    v = (::f32x4){v.x * c0.x - v.y * c0.y, v.y * c0.x + v.x * c0.y, v.z * c1.x - v.w * c1.y, v.w * c1.x + v.z * c1.y};
                }
                ::u32x2 w; w.x = pk2(v.x, v.y); w.y = pk2(v.z, v.w);
                if (col >= C_KI && col < C_WI) {
                    { const int b = row / SEQ, t = row - b * SEQ + NMETA, d0 = col - C_KI;
                        *(::u32x2*)(KIP + (size_t)b * KIP_BATCH + (size_t)((((t >> 5) * 4 + (d0 >> 4)) * 2 + ((d0 >> 3) & 1)) * 512 + (t & 31) * 16 + (d0 & 7) * 2)) = w; }
                } else *(::u32x2*)(P + (size_t)trow * PW + col) = w;
            })
    }
};
struct EpiGate {
    static constexpr bool PERM = false, AFTER_DRAIN = false;
    bf16_t* G;
    __device__ __forceinline__ void operator()(const f32x4 (&acc)[2][2][4][2], const Unit& u, int wr, int wc, int fr, int fq) const {
        PG8_FOR_FRAGS( ::u32x2 w; w.x = pk2(sigmoidf(v.x), sigmoidf(v.y)); w.y = pk2(sigmoidf(v.z), sigmoidf(v.w)); *(::u32x2*)(G + (size_t)row * 2048 + col) = w; )
    }
};
template <bool ACCUM> struct EpiZ {
    static constexpr bool PERM = false, AFTER_DRAIN = false;
    bf16_t* Z; const bf16_t* G; int goff;
    __device__ __forceinline__ void operator()(const f32x4 (&acc)[2][2][4][2], const Unit& u, int wr, int wc, int fr, int fq) const {
        PG8_FOR_FRAGS(
            const ::u32x2 g = *(const ::u32x2*)(G + (size_t)row * 2048 + goff + col);
            ::f32x4 z = (::f32x4){bflo(g.x) * v.x, bfhi(g.x) * v.y, bflo(g.y) * v.z, bfhi(g.y) * v.w};
            ::u32x2* zp = (::u32x2*)(Z + (size_t)row * D + col);
            if (ACCUM) { const ::u32x2 o = *zp; z.x += bflo(o.x); z.y += bfhi(o.x); z.z += bflo(o.y); z.w += bfhi(o.y); }
            ::u32x2 w; w.x = pk2(z.x, z.y); w.y = pk2(z.z, z.w); *zp = w; )
    }
};
struct EpiH1 {
    static constexpr bool PERM = false, AFTER_DRAIN = false;
    float* H1; const float* meta; const float* x;
    __device__ __forceinline__ void operator()(const f32x4 (&acc)[2][2][4][2], const Unit& u, int wr, int wc, int fr, int fq) const {
        PG8_FOR_FRAGS( const ::f32x4 h = *(const ::f32x4*)(x + (size_t)row * D + col); *(::f32x4*)(H1 + (size_t)row * D + col) = h + v; )
    }
};
#undef PG8_FOR_FRAGS

template <class Epi, class Sched, bool ALIGN_EPI = false, bool SP2 = false>
__device__ __forceinline__ void gemm_phase(PG8_LAS unsigned char* lds, const Gemm g, const Sched& S, const Epi& E) {
    const int tid = threadIdx.x, wid = __builtin_amdgcn_readfirstlane(tid >> 6), lane = tid & 63, wr = wid >> 2, wc = wid & 3, fr = lane & 15, fq = lane >> 4;
    const int K = g.K, nt = K / BK;
    unsigned voffA[2], voffB[2];
#pragma unroll
    for (int i = 0; i < 2; ++i) { int R, C; stage_rc(tid * 16 + i * 8192, R, C); const int Rb = Epi::PERM ? ((R & ~31) + perm32(R & 31)) : R;
        voffA[i] = (unsigned)(R * K + C) * 2u; voffB[i] = (unsigned)(Rb * K + C) * 2u; }
    const size_t kstep = (size_t)(BK * 2);
    const size_t hstep = (size_t)HALF * K * 2;
    const size_t tstep = 2 * hstep;
    const unsigned ldsw = (unsigned)wid * 1024u;
    const int aoff = lds_byte(wr * 64 + fr, fq * 8), boff = lds_byte(wc * 32 + fr, fq * 8);
#define PG8_SA(b, h) (((b) * 2 + (h)) * HTB)
#define PG8_SB(b, h) ((4 + (b) * 2 + (h)) * HTB)
#define PG8_STAGE(bufoff, gbase, voff) do { _Pragma("unroll") for (int _i = 0; _i < 2; ++_i) \
        __builtin_amdgcn_global_load_lds((const unsigned*)((const char*)(gbase) + (voff)[_i]), (PG8_LAS unsigned*)(lds + (bufoff) + ldsw + _i * 8192), 16, 0, 0); } while (0)
#define PG8_LDA(dst, b, h) do { _Pragma("unroll") for (int m = 0; m < 4; ++m) _Pragma("unroll") for (int k = 0; k < 2; ++k) dst[m][k] = *(const PG8_LAS bf16x8*)(lds + PG8_SA(b, h) + aoff + m * 2048 + k * 1024); } while (0)
#define PG8_LDB(dst, b, h) do { _Pragma("unroll") for (int n = 0; n < 2; ++n) _Pragma("unroll") for (int k = 0; k < 2; ++k) dst[n][k] = *(const PG8_LAS bf16x8*)(lds + PG8_SB(b, h) + boff + n * 2048 + k * 1024); } while (0)
#define PG8_MMA(ai, bj, At, Bt) do { __builtin_amdgcn_s_setprio(1); _Pragma("unroll") for (int m = 0; m < 4; ++m) _Pragma("unroll") for (int n = 0; n < 2; ++n) _Pragma("unroll") for (int k = 0; k < 2; ++k) \
        acc[ai][bj][m][n] = __builtin_amdgcn_mfma_f32_16x16x32_bf16(Bt[n][k], At[m][k], acc[ai][bj][m][n], 0, 0, 0); __builtin_amdgcn_s_setprio(0); } while (0)
#define PG8_WAIT_V(n) asm volatile("s_waitcnt vmcnt(" #n ")" ::: "memory")
#define PG8_WAIT_L(n) asm volatile("s_waitcnt lgkmcnt(" #n ")" ::: "memory")
#define PG8_BAR __builtin_amdgcn_s_barrier()
#define PG8_SCHED __builtin_amdgcn_sched_barrier(0)
    Unit cur, nxt; int ui = 0;
    if (!S.next(0, cur)) return;
    f32x4 acc[2][2][4][2];
#pragma unroll
    for (int a = 0; a < 2; ++a)
#pragma unroll
        for (int b = 0; b < 2; ++b)
#pragma unroll
            for (int m = 0; m < 4; ++m)
#pragma unroll
                for (int n = 0; n < 2; ++n) acc[a][b][m][n] = (f32x4){0.f, 0.f, 0.f, 0.f};
    bf16x8 At[4][2], B0[2][2], B1[2][2];
    const char* cA = (const char*)g.A + (size_t)cur.pm * tstep; const char* cB = (const char*)g.Bt + (size_t)cur.pn * tstep;
    S.a_ready(cur);
    if constexpr (SP2) {
        PG8_STAGE(PG8_SB(0, 0), cB, voffB); PG8_STAGE(PG8_SB(0, 1), cB + hstep, voffB); PG8_STAGE(PG8_SA(0, 0), cA, voffA); PG8_STAGE(PG8_SA(0, 1), cA + hstep, voffA);
        if (wr == 1) PG8_BAR;
        PG8_WAIT_V(2); PG8_BAR;
        PG8_STAGE(PG8_SB(1, 0), cB + kstep, voffB); PG8_STAGE(PG8_SA(1, 0), cA + kstep, voffA); PG8_STAGE(PG8_SB(1, 1), cB + hstep + kstep, voffB);
        PG8_WAIT_V(6); PG8_BAR;
    } else {
        PG8_STAGE(PG8_SB(0, 0), cB, voffB); PG8_STAGE(PG8_SA(0, 0), cA, voffA); PG8_STAGE(PG8_SB(0, 1), cB + hstep, voffB); PG8_STAGE(PG8_SA(0, 1), cA + hstep, voffA);
        if (wr == 1) PG8_BAR;
        PG8_WAIT_V(4); PG8_BAR;
        PG8_STAGE(PG8_SB(1, 0), cB + kstep, voffB); PG8_STAGE(PG8_SA(1, 0), cA + kstep, voffA); PG8_STAGE(PG8_SB(1, 1), cB + hstep + kstep, voffB);
        PG8_WAIT_V(6); PG8_BAR;
    }
    for (;;) {
        const bool has_next = S.next(ui + 1, nxt);
        const char* nA = has_next ? (const char*)g.A + (size_t)nxt.pm * tstep : cA; const char* nB = has_next ? (const char*)g.Bt + (size_t)nxt.pn * tstep : cB;
        for (int t = 0; t < nt; t += 2) {
            const bool last = (t == nt - 2);
            const char* a1 = cA + (size_t)(t + 1) * kstep;
            const char* a2 = last ? nA : cA + (size_t)(t + 2) * kstep; const char* b2 = last ? nB : cB + (size_t)(t + 2) * kstep;
            const char* a3 = a2 + kstep; const char* b3 = b2 + kstep;
            if (last && has_next) S.a_ready(nxt);
            if constexpr (SP2) {
            PG8_LDB(B0, 0, 0); PG8_LDB(B1, 0, 1); PG8_SCHED; PG8_LDA(At, 0, 0); PG8_STAGE(PG8_SA(1, 1), a1 + hstep, voffA);
            PG8_WAIT_V(8); PG8_WAIT_L(0); PG8_BAR; PG8_MMA(0, 0, At, B0); PG8_MMA(0, 1, At, B1); PG8_BAR; PG8_SCHED;
            PG8_LDA(At, 0, 1); PG8_STAGE(PG8_SB(0, 0), b2, voffB); PG8_STAGE(PG8_SB(0, 1), b2 + hstep, voffB); PG8_STAGE(PG8_SA(0, 0), a2, voffA);
            PG8_WAIT_V(8); PG8_WAIT_L(0); PG8_BAR; PG8_MMA(1, 0, At, B0); PG8_MMA(1, 1, At, B1); PG8_BAR; PG8_SCHED;
            PG8_LDB(B0, 1, 0); PG8_LDB(B1, 1, 1); PG8_SCHED; PG8_LDA(At, 1, 0); PG8_STAGE(PG8_SA(0, 1), a2 + hstep, voffA);
            PG8_WAIT_V(8); PG8_WAIT_L(0); PG8_BAR; PG8_MMA(0, 0, At, B0); PG8_MMA(0, 1, At, B1); PG8_BAR; PG8_SCHED;
            PG8_LDA(At, 1, 1); PG8_STAGE(PG8_SB(1, 0), b3, voffB); PG8_STAGE(PG8_SB(1, 1), b3 + hstep, voffB); PG8_STAGE(PG8_SA(1, 0), a3, voffA);
            PG8_WAIT_V(8); PG8_WAIT_L(0); PG8_BAR; PG8_MMA(1, 0, At, B0); PG8_MMA(1, 1, At, B1); PG8_BAR; PG8_SCHED;
            } else {
            PG8_LDB(B0, 0, 0); PG8_SCHED; PG8_LDA(At, 0, 0); PG8_STAGE(PG8_SA(1, 1), a1 + hstep, voffA);
            PG8_WAIT_L(8); PG8_BAR; PG8_WAIT_L(0); PG8_MMA(0, 0, At, B0); PG8_BAR; PG8_SCHED;
            PG8_LDB(B1, 0, 1); PG8_STAGE(PG8_SB(0, 0), b2, voffB);
            PG8_BAR; PG8_WAIT_L(0); PG8_MMA(0, 1, At, B1); PG8_BAR;
            PG8_LDA(At, 0, 1); PG8_STAGE(PG8_SA(0, 0), a2, voffA);
            PG8_BAR; PG8_WAIT_L(0); PG8_MMA(1, 0, At, B0); PG8_BAR; PG8_SCHED;
            PG8_STAGE(PG8_SB(0, 1), b2 + hstep, voffB);
            PG8_WAIT_V(6); PG8_BAR; PG8_MMA(1, 1, At, B1); PG8_BAR;
            PG8_LDB(B0, 1, 0); PG8_SCHED; PG8_LDA(At, 1, 0); PG8_STAGE(PG8_SA(0, 1), a2 + hstep, voffA);
            PG8_WAIT_L(8); PG8_BAR; PG8_WAIT_L(0); PG8_MMA(0, 0, At, B0); PG8_BAR; PG8_SCHED;
            PG8_LDB(B1, 1, 1); PG8_STAGE(PG8_SB(1, 0), b3, voffB);
            PG8_BAR; PG8_WAIT_L(0); PG8_MMA(0, 1, At, B1); PG8_BAR;
            PG8_LDA(At, 1, 1); PG8_STAGE(PG8_SA(1, 0), a3, voffA);
            PG8_BAR; PG8_WAIT_L(0); PG8_MMA(1, 0, At, B0); PG8_BAR; PG8_SCHED;
            PG8_STAGE(PG8_SB(1, 1), b3 + hstep, voffB);
            PG8_WAIT_V(6); PG8_BAR; PG8_MMA(1, 1, At, B1); PG8_BAR;
            }
        }
        if constexpr (ALIGN_EPI) { if (wr == 0) PG8_BAR; }
        if constexpr (!Epi::AFTER_DRAIN) { E(acc, cur, wr, wc, fr, fq); S.done(cur); }
        if (!has_next) break;
#pragma unroll
        for (int a = 0; a < 2; ++a)
#pragma unroll
            for (int b = 0; b < 2; ++b)
#pragma unroll
                for (int m = 0; m < 4; ++m)
#pragma unroll
                    for (int n = 0; n < 2; ++n) acc[a][b][m][n] = (f32x4){0.f, 0.f, 0.f, 0.f};
        cur = nxt; cA = nA; cB = nB; ++ui;
        if constexpr (ALIGN_EPI) { if (wr == 1) PG8_BAR; }
    }
    PG8_WAIT_V(0);
    if constexpr (!ALIGN_EPI) { if (wr == 0) PG8_BAR; }
    PG8_BAR;
    if constexpr (Epi::AFTER_DRAIN) { E.fused(acc, cur, wr, wc, fr, fq, lds, wid, lane); S.done(cur); }
#undef PG8_SA
#undef PG8_SB
#undef PG8_STAGE
#undef PG8_LDA
#undef PG8_LDB
#undef PG8_MMA
#undef PG8_WAIT_V
#undef PG8_WAIT_L
#undef PG8_BAR
#undef PG8_SCHED
}
template <class Epi, class Sched, bool ALIGN_EPI = false, bool SP2 = false>
__device__ __forceinline__ void gemm_phase_x(PG8_LAS unsigned char* lds, const int K, const Sched& S, const Epi& E) {
    const int tid = threadIdx.x, wid = __builtin_amdgcn_readfirstlane(tid >> 6), lane = tid & 63, wr = wid >> 2, wc = wid & 3, fr = lane & 15, fq = lane >> 4;
    const int nt = K / BK;
    unsigned vcA[2][2], vnA[2][2], voffB[2];
#pragma unroll
    for (int i = 0; i < 2; ++i) { int R, C; stage_rc(tid * 16 + i * 8192, R, C); const int Rb = Epi::PERM ? ((R & ~31) + perm32(R & 31)) : R;
        voffB[i] = (unsigned)(Rb * K + C) * 2u; }
    const size_t kstep = (size_t)(BK * 2);
    const size_t hstep = (size_t)HALF * K * 2;
    const unsigned ldsw = (unsigned)wid * 1024u;
    const int aoff = lds_byte(wr * 64 + fr, fq * 8), boff = lds_byte(wc * 32 + fr, fq * 8);
#define PG8_SA(b, h) (((b) * 2 + (h)) * HTB)
#define PG8_SB(b, h) ((4 + (b) * 2 + (h)) * HTB)
#define PG8_STAGE(bufoff, gbase, voff) do { _Pragma("unroll") for (int _i = 0; _i < 2; ++_i) \
        __builtin_amdgcn_global_load_lds((const unsigned*)((const char*)(gbase) + (voff)[_i]), (PG8_LAS unsigned*)(lds + (bufoff) + ldsw + _i * 8192), 16, 0, 0); } while (0)
#define PG8_STAGEA(bufoff, gbase, V, h) do { _Pragma("unroll") for (int _i = 0; _i < 2; ++_i) \
        __builtin_amdgcn_global_load_lds((const unsigned*)((const char*)(gbase) + (V)[h][_i]), (PG8_LAS unsigned*)(lds + (bufoff) + ldsw + _i * 8192), 16, 0, 0); } while (0)
#define PG8_STAGEA2(bufoff, gbase, h) do { _Pragma("unroll") for (int _i = 0; _i < 2; ++_i) \
        __builtin_amdgcn_global_load_lds((const unsigned*)((const char*)(gbase) + (last ? vnA[h][_i] : vcA[h][_i])), (PG8_LAS unsigned*)(lds + (bufoff) + ldsw + _i * 8192), 16, 0, 0); } while (0)
#define PG8_AOFF(V, u) do { _Pragma("unroll") for (int _h = 0; _h < 2; ++_h) _Pragma("unroll") for (int _i = 0; _i < 2; ++_i) { int R_, C_; stage_rc(tid * 16 + _i * 8192, R_, C_); (V)[_h][_i] = S.a_off(u, _h * HALF + R_, C_); } } while (0)
#define PG8_LDA(dst, b, h) do { _Pragma("unroll") for (int m = 0; m < 4; ++m) _Pragma("unroll") for (int k = 0; k < 2; ++k) dst[m][k] = *(const PG8_LAS bf16x8*)(lds + PG8_SA(b, h) + aoff + m * 2048 + k * 1024); } while (0)
#define PG8_LDB(dst, b, h) do { _Pragma("unroll") for (int n = 0; n < 2; ++n) _Pragma("unroll") for (int k = 0; k < 2; ++k) dst[n][k] = *(const PG8_LAS bf16x8*)(lds + PG8_SB(b, h) + boff + n * 2048 + k * 1024); } while (0)
#define PG8_MMA(ai, bj, At, Bt) do { __builtin_amdgcn_s_setprio(1); _Pragma("unroll") for (int m = 0; m < 4; ++m) _Pragma("unroll") for (int n = 0; n < 2; ++n) _Pragma("unroll") for (int k = 0; k < 2; ++k) \
        acc[ai][bj][m][n] = __builtin_amdgcn_mfma_f32_16x16x32_bf16(Bt[n][k], At[m][k], acc[ai][bj][m][n], 0, 0, 0); __builtin_amdgcn_s_setprio(0); } while (0)
#define PG8_WAIT_V(n) asm volatile("s_waitcnt vmcnt(" #n ")" ::: "memory")
#define PG8_WAIT_L(n) asm volatile("s_waitcnt lgkmcnt(" #n ")" ::: "memory")
#define PG8_BAR __builtin_amdgcn_s_barrier()
#define PG8_SCHED __builtin_amdgcn_sched_barrier(0)
    Unit cur, nxt; int ui = 0;
    if (!S.next(0, cur)) return;
    f32x4 acc[2][2][4][2];
#pragma unroll
    for (int a = 0; a < 2; ++a)
#pragma unroll
        for (int b = 0; b < 2; ++b)
#pragma unroll
            for (int m = 0; m < 4; ++m)
#pragma unroll
                for (int n = 0; n < 2; ++n) acc[a][b][m][n] = (f32x4){0.f, 0.f, 0.f, 0.f};
    bf16x8 At[4][2], B0[2][2], B1[2][2];
    const char* cA = S.a_base(cur); const char* cB = S.b_base(cur);
    PG8_AOFF(vcA, cur);
    S.a_ready(cur);
    if constexpr (SP2) {
        PG8_STAGE(PG8_SB(0, 0), cB, voffB); PG8_STAGE(PG8_SB(0, 1), cB + hstep, voffB); PG8_STAGEA(PG8_SA(0, 0), cA, vcA, 0); PG8_STAGEA(PG8_SA(0, 1), cA, vcA, 1);
        if (wr == 1) PG8_BAR;
        PG8_WAIT_V(2); PG8_BAR;
        PG8_STAGE(PG8_SB(1, 0), cB + kstep, voffB); PG8_STAGEA(PG8_SA(1, 0), cA + kstep, vcA, 0); PG8_STAGE(PG8_SB(1, 1), cB + hstep + kstep, voffB);
        PG8_WAIT_V(6); PG8_BAR;
    } else {
        PG8_STAGE(PG8_SB(0, 0), cB, voffB); PG8_STAGEA(PG8_SA(0, 0), cA, vcA, 0); PG8_STAGE(PG8_SB(0, 1), cB + hstep, voffB); PG8_STAGEA(PG8_SA(0, 1), cA, vcA, 1);
        if (wr == 1) PG8_BAR;
        PG8_WAIT_V(4); PG8_BAR;
        PG8_STAGE(PG8_SB(1, 0), cB + kstep, voffB); PG8_STAGEA(PG8_SA(1, 0), cA + kstep, vcA, 0); PG8_STAGE(PG8_SB(1, 1), cB + hstep + kstep, voffB);
        PG8_WAIT_V(6); PG8_BAR;
    }
    for (;;) {
        const bool has_next = S.next(ui + 1, nxt);
        const char* nA = has_next ? S.a_base(nxt) : cA; const char* nB = has_next ? S.b_base(nxt) : cB;
        if (has_next) { PG8_AOFF(vnA, nxt); } else { _Pragma("unroll") for (int _h = 0; _h < 2; ++_h) _Pragma("unroll") for (int _i = 0; _i < 2; ++_i) vnA[_h][_i] = vcA[_h][_i]; }
        for (int t = 0; t < nt; t += 2) {
            const bool last = (t == nt - 2);
            const char* a1 = cA + (size_t)(t + 1) * kstep;
            const char* a2 = last ? nA : cA + (size_t)(t + 2) * kstep; const char* b2 = last ? nB : cB + (size_t)(t + 2) * kstep;
            const char* a3 = a2 + kstep; const char* b3 = b2 + kstep;
            if (last && has_next) S.a_ready(nxt);
            if constexpr (SP2) {
            PG8_LDB(B0, 0, 0); PG8_LDB(B1, 0, 1); PG8_SCHED; PG8_LDA(At, 0, 0); PG8_STAGEA(PG8_SA(1, 1), a1, vcA, 1);
            PG8_WAIT_V(8); PG8_WAIT_L(0); PG8_BAR; PG8_MMA(0, 0, At, B0); PG8_MMA(0, 1, At, B1); PG8_BAR; PG8_SCHED;
            PG8_LDA(At, 0, 1); PG8_STAGE(PG8_SB(0, 0), b2, voffB); PG8_STAGE(PG8_SB(0, 1), b2 + hstep, voffB); PG8_STAGEA2(PG8_SA(0, 0), a2, 0);
            PG8_WAIT_V(8); PG8_WAIT_L(0); PG8_BAR; PG8_MMA(1, 0, At, B0); PG8_MMA(1, 1, At, B1); PG8_BAR; PG8_SCHED;
            PG8_LDB(B0, 1, 0); PG8_LDB(B1, 1, 1); PG8_SCHED; PG8_LDA(At, 1, 0); PG8_STAGEA2(PG8_SA(0, 1), a2, 1);
            PG8_WAIT_V(8); PG8_WAIT_L(0); PG8_BAR; PG8_MMA(0, 0, At, B0); PG8_MMA(0, 1, At, B1); PG8_BAR; PG8_SCHED;
            PG8_LDA(At, 1, 1); PG8_STAGE(PG8_SB(1, 0), b3, voffB); PG8_STAGE(PG8_SB(1, 1), b3 + hstep, voffB); PG8_STAGEA2(PG8_SA(1, 0), a3, 0);
            PG8_WAIT_V(8); PG8_WAIT_L(0); PG8_BAR; PG8_MMA(1, 0, At, B0); PG8_MMA(1, 1, At, B1); PG8_BAR; PG8_SCHED;
            } else {
            PG8_LDB(B0, 0, 0); PG8_SCHED; PG8_LDA(At, 0, 0); PG8_STAGEA(PG8_SA(1, 1), a1, vcA, 1);
            PG8_WAIT_L(8); PG8_BAR; PG8_WAIT_L(0); PG8_MMA(0, 0, At, B0); PG8_BAR; PG8_SCHED;
            PG8_LDB(B1, 0, 1); PG8_STAGE(PG8_SB(0, 0), b2, voffB);
            PG8_BAR; PG8_WAIT_L(0); PG8_MMA(0, 1, At, B1); PG8_BAR;
            PG8_LDA(At, 0, 1); PG8_STAGEA2(PG8_SA(0, 0), a2, 0);
            PG8_BAR; PG8_WAIT_L(0); PG8_MMA(1, 0, At, B0); PG8_BAR; PG8_SCHED;
            PG8_STAGE(PG8_SB(0, 1), b2 + hstep, voffB);
            PG8_WAIT_V(6); PG8_BAR; PG8_MMA(1, 1, At, B1); PG8_BAR;
            PG8_LDB(B0, 1, 0); PG8_SCHED; PG8_LDA(At, 1, 0); PG8_STAGEA2(PG8_SA(0, 1), a2, 1);
            PG8_WAIT_L(8); PG8_BAR; PG8_WAIT_L(0); PG8_MMA(0, 0, At, B0); PG8_BAR; PG8_SCHED;
            PG8_LDB(B1, 1, 1); PG8_STAGE(PG8_SB(1, 0), b3, voffB);
            PG8_BAR; PG8_WAIT_L(0); PG8_MMA(0, 1, At, B1); PG8_BAR;
            PG8_LDA(At, 1, 1); PG8_STAGEA2(PG8_SA(1, 0), a3, 0);
            PG8_BAR; PG8_WAIT_L(0); PG8_MMA(1, 0, At, B0); PG8_BAR; PG8_SCHED;
            PG8_STAGE(PG8_SB(1, 1), b3 + hstep, voffB);
            PG8_WAIT_V(6); PG8_BAR; PG8_MMA(1, 1, At, B1); PG8_BAR;
            }
        }
        if constexpr (ALIGN_EPI) { if (wr == 0) PG8_BAR; }
        if constexpr (!Epi::AFTER_DRAIN) { E(acc, cur, wr, wc, fr, fq); S.done(cur); }
        if (!has_next) break;
#pragma unroll
        for (int a = 0; a < 2; ++a)
#pragma unroll
            for (int b = 0; b < 2; ++b)
#pragma unroll
                for (int m = 0; m < 4; ++m)
#pragma unroll
                    for (int n = 0; n < 2; ++n) acc[a][b][m][n] = (f32x4){0.f, 0.f, 0.f, 0.f};
        cur = nxt; cA = nA; cB = nB; ++ui;
        _Pragma("unroll") for (int _h = 0; _h < 2; ++_h) _Pragma("unroll") for (int _i = 0; _i < 2; ++_i) vcA[_h][_i] = vnA[_h][_i];
        if constexpr (ALIGN_EPI) { if (wr == 1) PG8_BAR; }
    }
    PG8_WAIT_V(0);
    if constexpr (!ALIGN_EPI) { if (wr == 0) PG8_BAR; }
    PG8_BAR;
    if constexpr (Epi::AFTER_DRAIN) { E.fused(acc, cur, wr, wc, fr, fq, lds, wid, lane); S.done(cur); }
#undef PG8_SA
#undef PG8_SB
#undef PG8_STAGE
#undef PG8_STAGEA
#undef PG8_STAGEA2
#undef PG8_AOFF
#undef PG8_LDA
#undef PG8_LDB
#undef PG8_MMA
#undef PG8_WAIT_V
#undef PG8_WAIT_L
#undef PG8_BAR
#undef PG8_SCHED
}


template <int WHICH> struct MoeOrder {
    const int* TP; int G, c; const char* Abase; const char* Bbase; const int* LIST;
    static constexpr int KK = WHICH == 0 ? 1024 : 512, NN = 4;
    __device__ __forceinline__ bool next(int i, Unit& u) const {
        const int L = i * G + c; if (L >= TP[NEXP]) return false;
        int e = 0;
#pragma unroll 1
        for (int j = 16; j >= 1; j >>= 1) if (TP[e + j] <= L) e += j;
        const int lt = L - TP[e]; u.pm = e * 1024 + lt / NN; u.pn = lt % NN; return true;
    }
    __device__ __forceinline__ const char* a_base(const Unit& u) const { const int e = u.pm >> 10, mt = u.pm & 1023; return WHICH == 0 ? Abase : Abase + (size_t)(TP[64 + e] + mt * 256) * (DEXP * 2); }
    __device__ __forceinline__ const char* b_base(const Unit& u) const { const int e = u.pm >> 10; return Bbase + ((size_t)e * 1024 + (size_t)u.pn * 256) * (KK * 2); }
    __device__ __forceinline__ unsigned a_off(const Unit& u, int r, int C) const {
        if (WHICH == 1) return (unsigned)(r * DEXP + C) * 2u;
        const int e = u.pm >> 10, s = (u.pm & 1023) * 256 + r; const int tok = s < TP[128 + e] ? (LIST[(size_t)e * NR + s] >> 1) : 0;
        return (unsigned)tok * (D * 2) + (unsigned)C * 2u;
    }
    __device__ __forceinline__ void a_ready(const Unit&) const {}
    __device__ __forceinline__ void done(const Unit&) const {}
};
struct TokRowOrder : StaticOrder {
    const char* Abase; const char* Bbase; int K;
    __device__ __forceinline__ const char* a_base(const Unit& u) const { return Abase + (size_t)tokrow(u.pm * BM) * K * 2; }
    __device__ __forceinline__ const char* b_base(const Unit& u) const { return Bbase + (size_t)u.pn * BM * K * 2; }
    __device__ __forceinline__ unsigned a_off(const Unit&, int r, int C) const { return (unsigned)(r * K + C) * 2u; }
};
#define PG8_FOR_FRAGS_M(...) _Pragma("unroll") for (int ai = 0; ai < 2; ++ai) _Pragma("unroll") for (int m = 0; m < 4; ++m) { const int r = ai * HALF + wr * 64 + m * 16 + fr; \
    _Pragma("unroll") for (int bj = 0; bj < 2; ++bj) _Pragma("unroll") for (int n = 0; n < 2; ++n) { const int col = u.pn * BM + bj * HALF + wc * 32 + n * 16 + 4 * fq; ::f32x4 v = acc[ai][bj][m][n]; __VA_ARGS__ } }
struct EpiMoe1 {
    static constexpr bool PERM = false, AFTER_DRAIN = false;
    bf16_t* HID; const int* TP;
    __device__ __forceinline__ void operator()(const f32x4 (&acc)[2][2][4][2], const Unit& u, int wr, int wc, int fr, int fq) const {
        const int e = u.pm >> 10, mt = u.pm & 1023; bf16_t* base = HID + (size_t)(TP[64 + e] + mt * 256) * DEXP;
        PG8_FOR_FRAGS_M( const float h0 = v.x / (1.f + __expf(-v.x)) * v.y, h1 = v.z / (1.f + __expf(-v.z)) * v.w; *(unsigned*)(base + (size_t)r * DEXP + (col >> 1)) = pk2(h0, h1); )
    }
};
struct EpiMoe2 {
    static constexpr bool PERM = false, AFTER_DRAIN = false;
    bf16_t* MO; const int* TP; const int* LIST; const float* GATE;
    __device__ __forceinline__ void operator()(const f32x4 (&acc)[2][2][4][2], const Unit& u, int wr, int wc, int fr, int fq) const {
        const int e = u.pm >> 10, mt = u.pm & 1023, cnt = TP[128 + e];
#pragma unroll
        for (int ai = 0; ai < 2; ++ai)
#pragma unroll
            for (int m = 0; m < 4; ++m) {
                const int s = mt * 256 + ai * HALF + wr * 64 + m * 16 + fr;
                if (s < cnt) {
                    const int ent = LIST[(size_t)e * NR + s]; const float gt = GATE[ent]; bf16_t* row = MO + (size_t)ent * D;
#pragma unroll
                    for (int bj = 0; bj < 2; ++bj)
#pragma unroll
                        for (int n = 0; n < 2; ++n) { const int col = u.pn * BM + bj * HALF + wc * 32 + n * 16 + 4 * fq; const ::f32x4 v = acc[ai][bj][m][n];
                            ::u32x2 w; w.x = pk2(v.x * gt, v.y * gt); w.y = pk2(v.z * gt, v.w * gt); *(::u32x2*)(row + col) = w; }
                }
            }
    }
};
#undef PG8_FOR_FRAGS_M
}
constexpr int SB_NQT = SEQ / 32;
constexpr int SB_VT_STRIDE = 40;
__device__ __forceinline__ void phase_sb_fast(const Params& p, char* lds) {
    const bf16_t* P = (const bf16_t*)(p.ws + WS_P); bf16_t* YA = (bf16_t*)(p.ws + WS_YA);
    const int tid = threadIdx.x, lane = tid & 63, wave = tid >> 6, n = lane & 31, hh = lane >> 5;
    bf16_t* VT = (bf16_t*)(lds + wave * (64 * SB_VT_STRIDE * 2));
    const int gw = blockIdx.x * NWAVES + wave, NGW = gridDim.x * NWAVES;
    for (int unit = gw; unit < 64 * SB_NQT; unit += NGW) {
        const int qt = SB_NQT - 1 - unit / 64, bh = unit % 64, h = bh & 7, b = bh >> 3;
        const int i0 = NMETA + qt * 32, qi = i0 + n, qrow = qi;
        const bf16_t* Pb = P + (size_t)b * T * PW;
        bf16x8 qf[4];
#pragma unroll
        for (int s = 0; s < 4; ++s) qf[s] = *(const bf16x8*)(Pb + (size_t)qrow * PW + C_QA + h * 64 + 16 * s + 8 * hh);
        f32x16 o0, o1;
#pragma unroll
        for (int r = 0; r < 16; ++r) { o0[r] = 0.f; o1[r] = 0.f; }
        float L = 0.f;
        for (int kt = qt + 1; kt >= 0; --kt) {
            const int j0 = kt * 32, krow = (j0 + n) < T ? (j0 + n) : T - 1;
            bf16x8 kf[4];
#pragma unroll
            for (int s = 0; s < 4; ++s) kf[s] = *(const bf16x8*)(Pb + (size_t)krow * PW + C_KA + h * 64 + 16 * s + 8 * hh);
#pragma unroll
            for (int i = 0; i < 4; ++i) {
                const int c = lane + 64 * i, key = c >> 3, d0 = (c & 7) * 8, vrow = (j0 + key) < T ? (j0 + key) : T - 1;
                const u32x4 w = *(const u32x4*)(Pb + (size_t)vrow * PW + C_VA + h * 64 + d0);
                bf16_t* vp = VT + d0 * SB_VT_STRIDE + key;
                vp[0] = (bf16_t)(w.x & 0xffff); vp[SB_VT_STRIDE] = (bf16_t)(w.x >> 16); vp[2 * SB_VT_STRIDE] = (bf16_t)(w.y & 0xffff); vp[3 * SB_VT_STRIDE] = (bf16_t)(w.y >> 16);
                vp[4 * SB_VT_STRIDE] = (bf16_t)(w.z & 0xffff); vp[5 * SB_VT_STRIDE] = (bf16_t)(w.z >> 16); vp[6 * SB_VT_STRIDE] = (bf16_t)(w.w & 0xffff); vp[7 * SB_VT_STRIDE] = (bf16_t)(w.w >> 16);
            }
            f32x16 sa;
#pragma unroll
            for (int r = 0; r < 16; ++r) sa[r] = 0.f;
#pragma unroll
            for (int s = 0; s < 4; ++s) sa = __builtin_amdgcn_mfma_f32_32x32x16_bf16(kf[s], qf[s], sa, 0, 0, 0);
            float lk[16], z[16];
#pragma unroll
            for (int r = 0; r < 16; ++r) {
                const int kk = (r & 3) + 8 * (r >> 2) + 4 * hh; const bool valid = (j0 + kk) < qi;
                const float zz = fminf(sa[r], 80.f); const float l = -__log2f(1.f + exp2f(zz));
                z[r] = zz; lk[r] = valid ? l : 0.f;
            }
            const float gs0 = (lk[0] + lk[1]) + (lk[2] + lk[3]), gs1 = (lk[4] + lk[5]) + (lk[6] + lk[7]), gs2 = (lk[8] + lk[9]) + (lk[10] + lk[11]), gs3 = (lk[12] + lk[13]) + (lk[14] + lk[15]);
            const float ps0 = xpartner32(gs0, hh), ps1 = xpartner32(gs1, hh), ps2 = xpartner32(gs2, hh), ps3 = xpartner32(gs3, hh);
            const float pc3 = ps3, pc2 = pc3 + ps2, pc1 = pc2 + ps1, pc0 = pc1 + ps0;
            float base[4];
            base[3] = L + (hh ? 0.f : pc3);
            base[2] = L + gs3 + (hh ? pc3 : pc2);
            base[1] = L + (gs3 + gs2) + (hh ? pc2 : pc1);
            base[0] = L + (gs3 + gs2 + gs1) + (hh ? pc1 : pc0);
            float a[16];
#pragma unroll
            for (int g = 0; g < 4; ++g) {
                float c = base[g];
#pragma unroll
                for (int e = 3; e >= 0; --e) {
                    const int r = 4 * g + e; c += lk[r];
                    const int kk = e + 8 * g + 4 * hh; const bool valid = (j0 + kk) < qi;
                    a[r] = valid ? exp2f(z[r] + c) : 0.f;
                }
            }
            L += (gs0 + gs1 + gs2 + gs3) + pc0;
            u32x4 pw0, pw1;
            pw0.x = pk2(a[0], a[1]); pw0.y = pk2(a[2], a[3]); pw0.z = pk2(a[4], a[5]); pw0.w = pk2(a[6], a[7]);
            pw1.x = pk2(a[8], a[9]); pw1.y = pk2(a[10], a[11]); pw1.z = pk2(a[12], a[13]); pw1.w = pk2(a[14], a[15]);
            const bf16x8 pf0 = __builtin_bit_cast(bf16x8, pw0), pf1 = __builtin_bit_cast(bf16x8, pw1);
#pragma unroll
            for (int mt = 0; mt < 2; ++mt) {
                const bf16_t* vr = VT + (32 * mt + n) * SB_VT_STRIDE + 4 * hh;
                u32x4 v0, v1;
                { const u32x2 x = *(const u32x2*)(vr), y = *(const u32x2*)(vr + 8); v0.x = x.x; v0.y = x.y; v0.z = y.x; v0.w = y.y; }
                { const u32x2 x = *(const u32x2*)(vr + 16), y = *(const u32x2*)(vr + 24); v1.x = x.x; v1.y = x.y; v1.z = y.x; v1.w = y.y; }
                if (mt == 0) { o0 = __builtin_amdgcn_mfma_f32_32x32x16_bf16(__builtin_bit_cast(bf16x8, v0), pf0, o0, 0, 0, 0); o0 = __builtin_amdgcn_mfma_f32_32x32x16_bf16(__builtin_bit_cast(bf16x8, v1), pf1, o0, 0, 0, 0); }
                else { o1 = __builtin_amdgcn_mfma_f32_32x32x16_bf16(__builtin_bit_cast(bf16x8, v0), pf0, o1, 0, 0, 0); o1 = __builtin_amdgcn_mfma_f32_32x32x16_bf16(__builtin_bit_cast(bf16x8, v1), pf1, o1, 0, 0, 0); }
            }
            const bool done = L < -152.f;
            if (__all(done)) break;
        }
        {
            bf16_t* yp = YA + ((size_t)b * SEQ + (qi - NMETA)) * 512 + h * 64 + 4 * hh;
#pragma unroll
            for (int g = 0; g < 4; ++g) {
                u32x2 w; w.x = pk2(o0[4 * g], o0[4 * g + 1]); w.y = pk2(o0[4 * g + 2], o0[4 * g + 3]); *(u32x2*)(yp + 8 * g) = w;
                w.x = pk2(o1[4 * g], o1[4 * g + 1]); w.y = pk2(o1[4 * g + 2], o1[4 * g + 3]); *(u32x2*)(yp + 32 + 8 * g) = w;
            }
        }
    }
}

constexpr int DSA_NQ = 8;
constexpr int DSA_SCS = 4608;
constexpr int DSA_KVB = 0, DSA_RING = 18432, DSA_IDX = DSA_NQ * DSA_RING, DSA_MISC = DSA_IDX + DSA_NQ * 1024, DSA_LDS = DSA_MISC + 512;
static_assert(DSA_NQ * DSA_SCS * 4 <= DSA_IDX, "score rows fit under the index lists");
__device__ __forceinline__ unsigned fkey(float f) { const unsigned u = __float_as_uint(f); return (u & 0x80000000u) ? ~u : (u | 0x80000000u); }
__device__ __forceinline__ int wave_sum_i32(int v) {
    v += __builtin_amdgcn_update_dpp(0, v, 0xB1, 0xF, 0xF, false);
    v += __builtin_amdgcn_update_dpp(0, v, 0x4E, 0xF, 0xF, false);
    v += __builtin_amdgcn_update_dpp(0, v, 0x141, 0xF, 0xF, false);
    v += __builtin_amdgcn_update_dpp(0, v, 0x140, 0xF, 0xF, false);
    return __builtin_amdgcn_readlane(v, 0) + __builtin_amdgcn_readlane(v, 16) + __builtin_amdgcn_readlane(v, 32) + __builtin_amdgcn_readlane(v, 48);
}
__device__ __forceinline__ int wave_excl_scan_i32(int c, int lane, int& total) {
    int x = c;
    x += __builtin_amdgcn_update_dpp(0, x, 0x111, 0xF, 0xF, true);
    x += __builtin_amdgcn_update_dpp(0, x, 0x112, 0xF, 0xF, true);
    x += __builtin_amdgcn_update_dpp(0, x, 0x114, 0xF, 0xF, true);
    x += __builtin_amdgcn_update_dpp(0, x, 0x118, 0xF, 0xF, true);
    const int t0 = __builtin_amdgcn_readlane(x, 15), t1 = __builtin_amdgcn_readlane(x, 31), t2 = __builtin_amdgcn_readlane(x, 47), t3 = __builtin_amdgcn_readlane(x, 63);
    const int row = lane >> 4;
    x += (row > 0 ? t0 : 0) + (row > 1 ? t1 : 0) + (row > 2 ? t2 : 0);
    total = t0 + t1 + t2 + t3;
    return x - c;
}
__device__ __forceinline__ int mbcnt64(unsigned long long m) { return (int)__builtin_amdgcn_mbcnt_hi((unsigned)(m >> 32), __builtin_amdgcn_mbcnt_lo((unsigned)m, 0u)); }
__device__ __forceinline__ void phase_dsa(const Params& p, char* lds) {
    const bf16_t* P = (const bf16_t*)(p.ws + WS_P); bf16_t* OL = (bf16_t*)(p.ws + WS_OLAT);
    const int tid = threadIdx.x, lane = tid & 63, wave = __builtin_amdgcn_readfirstlane(tid >> 6);
    unsigned* SC = (unsigned*)(lds + DSA_KVB);
    unsigned short* IDX = (unsigned short*)(lds + DSA_IDX);
    int* MISC = (int*)(lds + DSA_MISC);
    const unsigned lds_base = (unsigned)(size_t)lds;
    constexpr int NU = SEQ / DSA_NQ;
    for (int unit = blockIdx.x; unit < BATCH * NU; unit += gridDim.x) {
        const int u8 = NU - 1 - unit / BATCH, b = unit % BATCH, t0 = NMETA + u8 * DSA_NQ;
        const int cid = 1 + (t0 - NMETA) / 64, n = NMETA + 64 * cid;
        const bf16_t* Pb = P + (size_t)b * T * PW;
        const int m = lane & 31, hh = lane >> 5;
        bf16x8 aq[2][4]; float wv[2][16];
#pragma unroll
        for (int rt = 0; rt < 2; ++rt) {
#pragma unroll
            for (int s = 0; s < 4; ++s) aq[rt][s] = *(const bf16x8*)(Pb + (size_t)(t0 + 4 * rt + (m >> 3)) * PW + C_QI + (m & 7) * 64 + 16 * s + 8 * hh);
#pragma unroll
            for (int r = 0; r < 16; ++r) wv[rt][r] = bf2f(Pb[(size_t)(t0 + 4 * rt + (r >> 2)) * PW + C_WI + (r & 3) + 4 * hh]);
        }
        const unsigned char* KIPb = p.ws + WS_KIP + (size_t)b * KIP_BATCH + lane * 16;
        bf16x8 bk[4];
#pragma unroll
        for (int s = 0; s < 4; ++s) bk[s] = *(const bf16x8*)(KIPb + (size_t)wave * 4096 + s * 1024);
        __syncthreads();
        {
            const int ntile = (n + 31) / 32;
            for (int kt = wave; kt < ntile; kt += NWAVES) {
                const int j0 = kt * 32, key = j0 + m;
                bf16x8 bn[4];
                { const int ktn = kt + NWAVES < 129 ? kt + NWAVES : 128;
#pragma unroll
                  for (int s = 0; s < 4; ++s) bn[s] = *(const bf16x8*)(KIPb + (size_t)ktn * 4096 + s * 1024); }
                const bool ok = key < n;
#pragma unroll
                for (int rt = 0; rt < 2; ++rt) {
                    f32x16 acc;
#pragma unroll
                    for (int r = 0; r < 16; ++r) acc[r] = 0.f;
#pragma unroll
                    for (int s = 0; s < 4; ++s) acc = __builtin_amdgcn_mfma_f32_32x32x16_bf16(aq[rt][s], bk[s], acc, 0, 0, 0);
                    float tq[4];
#pragma unroll
                    for (int q = 0; q < 4; ++q) {
#define RELU_(x) __builtin_amdgcn_fmed3f((x), 0.f, 3.0e38f)
                        float s = wv[rt][4 * q] * RELU_(acc[4 * q]); s += wv[rt][4 * q + 1] * RELU_(acc[4 * q + 1]); s += wv[rt][4 * q + 2] * RELU_(acc[4 * q + 2]); s += wv[rt][4 * q + 3] * RELU_(acc[4 * q + 3]);
#undef RELU_
                        tq[q] = xsum32(s);
                    }
                    const float s0 = hh ? tq[2] : tq[0], s1 = hh ? tq[3] : tq[1];
                    SC[(4 * rt + 2 * hh) * DSA_SCS + key] = ok ? fkey(s0) : 0u;
                    SC[(4 * rt + 2 * hh + 1) * DSA_SCS + key] = ok ? fkey(s1) : 0u;
                }
#pragma unroll
                for (int s = 0; s < 4; ++s) bk[s] = bn[s];
            }
        }
        __syncthreads();
        bf16x8 qf[5];
        {
            const int hd_ = lane & 15, g_ = lane >> 4;
#pragma unroll
            for (int ks = 0; ks < 5; ++ks) {
                u32x4 w = (u32x4){0u, 0u, 0u, 0u};
                if (hd_ < 8 && (ks < 4 || g_ < 2)) w = *(const u32x4*)(Pb + (size_t)(t0 + wave) * PW + C_QF + hd_ * QFW + 32 * ks + 8 * g_);
                qf[ks] = __builtin_bit_cast(bf16x8, w);
            }
        }
        {
            unsigned* sc = SC + wave * DSA_SCS;
            unsigned v[65];
#pragma unroll
            for (int i = 0; i < 65; ++i) { const int k = i * 64 + lane; v[i] = (k < n) ? sc[k] : 0u; }
            unsigned prefix = 0u; int cge = n, bit = 31;
            bool exact = false;
            if (n >= 256) {
                for (; bit >= 0 && cge > 512; --bit) {
                    const unsigned cand = prefix | (1u << bit); const int sc_ = (int)(cand ^ 0x80000000u);
                    unsigned b0 = 0u, b1 = 0u, b2 = 0u; int slots = 0;
#pragma unroll
                    for (int gi = 0; gi < 5; ++gi) if (gi * 832 < n) {
#pragma unroll
                        for (int i = 13 * gi; i < 13 * gi + 13; ++i) {
                            const unsigned d = (unsigned)__builtin_elementwise_sub_sat((int)(v[i] ^ 0x80000000u), sc_);
                            if (i % 3 == 0) b0 = __builtin_amdgcn_alignbit(b0, d, 31); else if (i % 3 == 1) b1 = __builtin_amdgcn_alignbit(b1, d, 31); else b2 = __builtin_amdgcn_alignbit(b2, d, 31);
                        }
                        slots += 13 * 64;
                    }
                    const int c = slots - wave_sum_i32(__builtin_popcount(b0) + __builtin_popcount(b1) + __builtin_popcount(b2));
                    if (c >= 256) { prefix = cand; cge = c; if (c == 256) { exact = true; break; } }
                }
            }
            int ngt = n;
            if (n >= 256 && !exact) {
                asm volatile("s_waitcnt lgkmcnt(0)" ::: "memory");
                int cb = 0;
                if (bit >= 0) {
                    const int sp_ = (int)((prefix > 0u ? prefix : 1u) ^ 0x80000000u);
                    unsigned lb0 = 0u, lb1 = 0u, lb2 = 0u;
#pragma unroll
                    for (int i = 0; i < 65; ++i) { const unsigned d = (unsigned)__builtin_elementwise_sub_sat((int)(v[i] ^ 0x80000000u), sp_);
                        if (i < 32) lb0 = __builtin_amdgcn_alignbit(lb0, d, 31); else if (i < 64) lb1 = __builtin_amdgcn_alignbit(lb1, d, 31); else lb2 = d >> 31; }
                    const unsigned tk0 = ~lb0, tk1 = ~lb1, tk2 = (~lb2) & 1u;
                    const int c0 = __builtin_popcount(tk0), c1 = __builtin_popcount(tk1);
                    const int lbase = wave_excl_scan_i32(c0 + c1 + (int)tk2, lane, cb);
#pragma unroll
                    for (int i = 0; i < 65; ++i) {
                        bool tkn; int rk;
                        if (i < 32) { tkn = (tk0 >> (31 - i)) & 1u; rk = i == 0 ? 0 : __builtin_popcount(tk0 >> (32 - i)); }
                        else if (i < 64) { tkn = (tk1 >> (63 - i)) & 1u; rk = c0 + (i == 32 ? 0 : __builtin_popcount(tk1 >> (64 - i))); }
                        else { tkn = tk2 != 0u; rk = c0 + c1; }
                        sc[tkn ? lbase + rk : 4096 + (lane & 15)] = v[i];
                    }
                    asm volatile("s_waitcnt lgkmcnt(0)" ::: "memory");
                    unsigned w[8];
#pragma unroll
                    for (int j = 0; j < 8; ++j) { const int k = j * 64 + lane; w[j] = (k < cb) ? sc[k] : 0u; }
                    for (; bit >= 0; --bit) {
                        const unsigned cand = prefix | (1u << bit); const int sc_ = (int)(cand ^ 0x80000000u); unsigned b0 = 0u, b1 = 0u;
#pragma unroll
                        for (int j = 0; j < 8; ++j) { const unsigned d = (unsigned)__builtin_elementwise_sub_sat((int)(w[j] ^ 0x80000000u), sc_); if (j & 1) b1 = __builtin_amdgcn_alignbit(b1, d, 31); else b0 = __builtin_amdgcn_alignbit(b0, d, 31); }
                        const int c = 512 - wave_sum_i32(__builtin_popcount(b0) + __builtin_popcount(b1));
                        if (c >= 256) { prefix = cand; if (c == 256) { exact = true; break; } }
                    }
                    int c = 0;
#pragma unroll
                    for (int j = 0; j < 8; ++j) c += __popcll(__ballot(w[j] > prefix));
                    ngt = c;
                } else {
                    int c = 0;
#pragma unroll
                    for (int i = 0; i < 65; ++i) { c += __popcll(__ballot(v[i] > prefix)); if ((i & 3) == 3) __builtin_amdgcn_sched_barrier(0); }
                    ngt = c;
                }
            }
            const unsigned tau = prefix;
            const int need_eq = n >= 256 ? 256 - ngt : 0; int base = 0, eqb = 0;
            unsigned short* idx = IDX + wave * 512;
            {
                const int st_ = (int)(tau ^ 0x80000000u); unsigned e0 = 0u, e1 = 0u, e2 = 0u;
#pragma unroll
                for (int i = 0; i < 65; ++i) { const unsigned d = (unsigned)__builtin_elementwise_sub_sat((int)(v[i] ^ 0x80000000u), st_);
                    if (i < 32) e0 = __builtin_amdgcn_alignbit(e0, d, 31); else if (i < 64) e1 = __builtin_amdgcn_alignbit(e1, d, 31); else e2 = d >> 31; }
                const unsigned tk0 = ~e0, tk1 = ~e1, tk2 = (~e2) & 1u;
                const int c0 = __builtin_popcount(tk0), c1 = __builtin_popcount(tk1);
                int nge; const int lbase = wave_excl_scan_i32(c0 + c1 + (int)tk2, lane, nge);
                if (n >= 256 && nge == 256) {
#pragma unroll
                    for (int i = 0; i < 65; ++i) {
                        bool tkn; int rk;
                        if (i < 32) { tkn = (tk0 >> (31 - i)) & 1u; rk = i == 0 ? 0 : __builtin_popcount(tk0 >> (32 - i)); }
                        else if (i < 64) { tkn = (tk1 >> (63 - i)) & 1u; rk = c0 + (i == 32 ? 0 : __builtin_popcount(tk1 >> (64 - i))); }
                        else { tkn = tk2 != 0u; rk = c0 + c1; }
                        idx[tkn ? lbase + rk : 256 + lane] = (unsigned short)(i * 64 + lane);
                    }
                    base = nge;
                } else {
#pragma unroll
                    for (int gi = 0; gi < 5; ++gi) if (gi * 832 < n) {
#pragma unroll
                        for (int i = 13 * gi; i < 13 * gi + 13; ++i) {
                            const int k = i * 64 + lane; const unsigned u = v[i];
                            const bool eq = (u == tau); const unsigned long long meq = __ballot(eq);
                            const bool take = (u > tau) || (eq && (eqb + mbcnt64(meq)) < need_eq);
                            const unsigned long long mt = __ballot(take);
                            idx[take ? base + mbcnt64(mt) : 256 + lane] = (unsigned short)k;
                            base += __popcll(mt); eqb += __popcll(meq);
                            if ((i & 3) == 3) __builtin_amdgcn_sched_barrier(0);
                        }
                    }
                }
            }
            for (int pos = base + lane; pos < 256; pos += 64) idx[pos] = 0;
            if (lane == 0) MISC[wave] = base;
        }
        asm volatile("s_waitcnt lgkmcnt(0)" ::: "memory");
        {
            const int q = wave; const int nsel = MISC[q];
            const size_t qrow = (size_t)(t0 + q);
            int ln = lane; asm volatile("" : "+v"(ln));
            const int hd = ln & 15, g = ln >> 4, qd = (ln & 15) >> 2, pp = ln & 3;
            char* ring = lds + DSA_KVB + wave * DSA_RING;
            const unsigned ring_a = lds_base + DSA_KVB + wave * DSA_RING;
            const unsigned short* idx = IDX + q * 512;
            asm volatile("s_waitcnt vmcnt(0)" ::: "memory");
#define DSA_ISSUE(c) do { _Pragma("unroll") for (int i_ = 0; i_ < 9; ++i_) { const int pid_ = ln + 64 * i_, row_ = pid_ / 18, part_ = pid_ - row_ * 18; \
                const bf16_t* src_ = Pb + (size_t)idx[32 * (c) + row_] * PW + C_KV + part_ * 8; \
                __builtin_amdgcn_global_load_lds((const unsigned*)src_, (LAS unsigned*)(ring + ((c) & 1) * 9216 + i_ * 1024), 16, 0, 0); } } while (0)
            DSA_ISSUE(0); DSA_ISSUE(1);
            f32x4 O[8];
#pragma unroll
            for (int nt = 0; nt < 8; ++nt) O[nt] = (f32x4){0.f, 0.f, 0.f, 0.f};
            float mrun = -3e38f, lrun = 0.f;
            for (int c = 0; c < 8; ++c) {
                if (c < 7) asm volatile("s_waitcnt vmcnt(9)" ::: "memory"); else asm volatile("s_waitcnt vmcnt(0)" ::: "memory");
                const char* buf = ring + (c & 1) * 9216;
                f32x4 S0 = (f32x4){0.f, 0.f, 0.f, 0.f}, S1 = S0;
                {
                    const char* kr = buf + hd * 288 + 16 * g;
#pragma unroll
                    for (int ks = 0; ks < 4; ++ks) { S0 = __builtin_amdgcn_mfma_f32_16x16x32_bf16(*(const bf16x8*)(kr + 64 * ks), qf[ks], S0, 0, 0, 0); S1 = __builtin_amdgcn_mfma_f32_16x16x32_bf16(*(const bf16x8*)(kr + 16 * 288 + 64 * ks), qf[ks], S1, 0, 0, 0); }
                    u32x4 w0 = (u32x4){0u, 0u, 0u, 0u}, w1 = w0; if (g < 2) { w0 = *(const u32x4*)(kr + 256); w1 = *(const u32x4*)(kr + 16 * 288 + 256); }
                    S0 = __builtin_amdgcn_mfma_f32_16x16x32_bf16(__builtin_bit_cast(bf16x8, w0), qf[4], S0, 0, 0, 0); S1 = __builtin_amdgcn_mfma_f32_16x16x32_bf16(__builtin_bit_cast(bf16x8, w1), qf[4], S1, 0, 0, 0);
                }
                float cm = -3e38f;
#pragma unroll
                for (int r = 0; r < 4; ++r) { if (nsel < 256) { const int sl = 32 * c + 4 * g + r; S0[r] = sl < nsel ? S0[r] : -1e30f; S1[r] = (sl + 16) < nsel ? S1[r] : -1e30f; } cm = fmaxf(cm, fmaxf(S0[r], S1[r])); }
                cm = xmax16(xmax32(cm));
                if (__any(cm > mrun + 6.f)) {
                    const float mnew = fmaxf(mrun, cm), alpha = exp2f(mrun - mnew);
                    lrun *= alpha; mrun = mnew;
                    const float a0 = __shfl(alpha, 4 * g), a1 = __shfl(alpha, 4 * g + 1), a2 = __shfl(alpha, 4 * g + 2), a3 = __shfl(alpha, 4 * g + 3);
#pragma unroll
                    for (int nt = 0; nt < 8; ++nt) { O[nt][0] *= a0; O[nt][1] *= a1; O[nt][2] *= a2; O[nt][3] *= a3; }
                }
                float ps = 0.f;
#pragma unroll
                for (int r = 0; r < 4; ++r) { S0[r] = exp2f(S0[r] - mrun); S1[r] = exp2f(S1[r] - mrun); ps += S0[r] + S1[r]; }
                ps = xsum16(xsum32(ps));
                lrun += ps;
                u32x4 pw; pw.x = pk2(S0[0], S0[1]); pw.y = pk2(S0[2], S0[3]); pw.z = pk2(S1[0], S1[1]); pw.w = pk2(S1[2], S1[3]);
                const bf16x8 pf = __builtin_bit_cast(bf16x8, pw);
                const unsigned va = ring_a + (unsigned)((c & 1) * 9216 + (4 * g + qd) * 288 + 8 * pp);
#pragma unroll
                for (int h2 = 0; h2 < 2; ++h2) {
                    u16x4 x0, x1, x2, x3, y0, y1, y2, y3;
                    asm volatile("ds_read_b64_tr_b16 %0, %8 offset:%9\n\tds_read_b64_tr_b16 %1, %8 offset:%10\n\tds_read_b64_tr_b16 %2, %8 offset:%11\n\tds_read_b64_tr_b16 %3, %8 offset:%12\n\t"
                                 "ds_read_b64_tr_b16 %4, %8 offset:%13\n\tds_read_b64_tr_b16 %5, %8 offset:%14\n\tds_read_b64_tr_b16 %6, %8 offset:%15\n\tds_read_b64_tr_b16 %7, %8 offset:%16\n\ts_waitcnt lgkmcnt(0)"
                                 : "=&v"(x0), "=&v"(x1), "=&v"(x2), "=&v"(x3), "=&v"(y0), "=&v"(y1), "=&v"(y2), "=&v"(y3)
                                 : "v"(va), "i"(128 * h2), "i"(128 * h2 + 32), "i"(128 * h2 + 64), "i"(128 * h2 + 96), "i"(128 * h2 + 4608), "i"(128 * h2 + 4640), "i"(128 * h2 + 4672), "i"(128 * h2 + 4704) : "memory");
#define DSA_PV(nt_, x_, y_) do { bf16x8 vf_; vf_[0] = (short)x_[0]; vf_[1] = (short)x_[1]; vf_[2] = (short)x_[2]; vf_[3] = (short)x_[3]; vf_[4] = (short)y_[0]; vf_[5] = (short)y_[1]; vf_[6] = (short)y_[2]; vf_[7] = (short)y_[3]; \
                    O[nt_] = __builtin_amdgcn_mfma_f32_16x16x32_bf16(pf, vf_, O[nt_], 0, 0, 0); } while (0)
                    DSA_PV(4 * h2 + 0, x0, y0); DSA_PV(4 * h2 + 1, x1, y1); DSA_PV(4 * h2 + 2, x2, y2); DSA_PV(4 * h2 + 3, x3, y3);
                }
                asm volatile("s_waitcnt lgkmcnt(0)" ::: "memory");
                if (c + 2 < 8) DSA_ISSUE(c + 2);
            }
#undef DSA_PV
#undef DSA_ISSUE
            const float inv = 1.f / lrun;
            const float i0 = __shfl(inv, 4 * g), i1 = __shfl(inv, 4 * g + 1), i2 = __shfl(inv, 4 * g + 2), i3 = __shfl(inv, 4 * g + 3);
            if (g < 2) {
                bf16_t* op = OL + ((size_t)b * SEQ + (qrow - NMETA)) * 1024 + (4 * g) * 128 + hd;
#pragma unroll
                for (int nt = 0; nt < 8; ++nt) { op[16 * nt] = (bf16_t)f2bf(O[nt][0] * i0); op[128 + 16 * nt] = (bf16_t)f2bf(O[nt][1] * i1); op[256 + 16 * nt] = (bf16_t)f2bf(O[nt][2] * i2); op[384 + 16 * nt] = (bf16_t)f2bf(O[nt][3] * i3); }
            }
        }
    }
}

__device__ __forceinline__ void phase_inproj_meta(const Params& p) {
    unsigned char* ws = p.ws; const int tid = threadIdx.x, lane = tid & 63, wave = tid >> 6, fr = lane & 15, fq = lane >> 4;
    const bf16_t* U = (const bf16_t*)(ws + WS_U); const bf16_t* WP = (const bf16_t*)(ws + WS_WP); bf16_t* P = (bf16_t*)(ws + WS_P); const float2* cs = (const float2*)(ws + WS_CS);
    const int gw = blockIdx.x * NWAVES + wave, NGW = gridDim.x * NWAVES;
    for (int nt = gw; nt < PW / 16; nt += NGW) {
        const bf16_t* ap = U + (size_t)fr * D + 8 * fq; const bf16_t* bp = WP + (size_t)(16 * nt + fr) * D + 8 * fq;
        f32x4 acc = (f32x4){0.f, 0.f, 0.f, 0.f};
#pragma unroll 8
        for (int ks = 0; ks < D / 32; ++ks) acc = __builtin_amdgcn_mfma_f32_16x16x32_bf16(*(const bf16x8*)(bp + 32 * ks), *(const bf16x8*)(ap + 32 * ks), acc, 0, 0, 0);
        const int col = 16 * nt + 4 * fq, t = fr; f32x4 v = acc; int o;
        if (pg8::rope_off(col, o)) { const float2 c0 = cs[t * 8 + (o >> 1)], c1 = cs[t * 8 + (o >> 1) + 1]; v = (f32x4){v.x * c0.x - v.y * c0.y, v.y * c0.x + v.x * c0.y, v.z * c1.x - v.w * c1.y, v.w * c1.x + v.z * c1.y}; }
        u32x2 w; w.x = pk2(v.x, v.y); w.y = pk2(v.z, v.w);
        for (int b = 0; b < BATCH; ++b) {
            if (col >= C_KI && col < C_WI) { const int d0 = col - C_KI;
                *(u32x2*)(ws + WS_KIP + (size_t)b * KIP_BATCH + (size_t)((((t >> 5) * 4 + (d0 >> 4)) * 2 + ((d0 >> 3) & 1)) * 512 + (t & 31) * 16 + (d0 & 7) * 2)) = w; }
            else *(u32x2*)(P + ((size_t)b * T + t) * PW + col) = w;
        }
    }
}

__device__ __forceinline__ void phase_c3(const Params& p, char* lds) {
    unsigned char* ws = p.ws; const int tid = threadIdx.x, lane = tid & 63, wave = __builtin_amdgcn_readfirstlane(tid >> 6);
    const float* H1 = (const float*)(ws + WS_H1); const float* g = p.in[I_GFFN];
    {
        bf16_t* U2 = (bf16_t*)(ws + WS_U); const int gw = blockIdx.x * NWAVES + wave, NGW = gridDim.x * NWAVES;
        for (int row = gw; row < NR; row += NGW) {
            const f32x4* xr = (const f32x4*)(H1 + (size_t)row * D) + lane;
            f32x4 v[4]; float s = 0.f;
#pragma unroll
            for (int j = 0; j < 4; ++j) { v[j] = xr[64 * j]; s += (v[j].x * v[j].x + v[j].y * v[j].y) + (v[j].z * v[j].z + v[j].w * v[j].w); }
            const float rstd = rsqrtf(wave_sum(s) * (1.f / D) + NORM_EPS);
            u32x2* o = (u32x2*)(U2 + (size_t)row * D) + lane;
#pragma unroll
            for (int j = 0; j < 4; ++j) { const f32x4 gg = ((const f32x4*)g)[lane + 64 * j];
                u32x2 w; w.x = pk2(v[j].x * rstd * gg.x, v[j].y * rstd * gg.y); w.y = pk2(v[j].z * rstd * gg.z, v[j].w * rstd * gg.w); o[64 * j] = w; }
        }
    }
    {
        float* Tl = (float*)lds;
        float* RED = (float*)lds;
        const float* wg = p.in[I_WGRP]; const float* wr = p.in[I_WRT]; const float* bg = p.in[I_BGRP]; const float* br = p.in[I_BRT];
        unsigned* ctl = (unsigned*)(ws + WS_CTL); int* LIST = (int*)(ws + WS_LIST); float* GATE = (float*)(ws + WS_GATE);
        const int tk = tid & 127, kq = wave >> 1;
        for (int grp = blockIdx.x; grp < NR / 128; grp += gridDim.x) {
            const int tok0 = grp * 128;
            float acc[36]; float ss = 0.f;
#pragma unroll
            for (int o = 0; o < 36; ++o) acc[o] = 0.f;
            for (int step = 0; step < 8; ++step) {
                __syncthreads();
#pragma unroll
                for (int i = 0; i < 8; ++i) { const int idx = tid + NTHREADS * i, qq = idx >> 10, rem = idx & 1023, t2 = rem >> 3, kc = rem & 7;
                    const f32x4 v = *(const f32x4*)(H1 + (size_t)(tok0 + t2) * D + qq * 256 + step * 32 + kc * 4);
                    float* d = Tl + qq * (32 * 129) + (kc * 4) * 129 + t2; d[0] = v.x; d[129] = v.y; d[258] = v.z; d[387] = v.w; }
                __syncthreads();
                const int kb = kq * 256 + step * 32;
#pragma unroll 4
                for (int k = 0; k < 32; ++k) {
                    const float h = Tl[kq * (32 * 129) + k * 129 + tk]; ss += h * h; const float hg = h * g[kb + k];
                    const float* w4 = wg + (size_t)(kb + k) * 4; const float* w32 = wr + (size_t)(kb + k) * 32;
#pragma unroll
                    for (int o = 0; o < 4; ++o) acc[o] += hg * w4[o];
#pragma unroll
                    for (int o = 0; o < 32; ++o) acc[4 + o] += hg * w32[o];
                }
            }
            __syncthreads();
#pragma unroll
            for (int o = 0; o < 36; ++o) RED[(kq * 37 + o) * 128 + tk] = acc[o];
            RED[(kq * 37 + 36) * 128 + tk] = ss;
            __syncthreads();
            if (tid < 128) {
                const int tok = tok0 + tk;
#pragma unroll
                for (int o = 0; o < 36; ++o) acc[o] = (RED[o * 128 + tk] + RED[(37 + o) * 128 + tk]) + (RED[(74 + o) * 128 + tk] + RED[(111 + o) * 128 + tk]);
                ss = (RED[36 * 128 + tk] + RED[(37 + 36) * 128 + tk]) + (RED[(74 + 36) * 128 + tk] + RED[(111 + 36) * 128 + tk]);
                const float rstd = rsqrtf(ss * (1.f / D) + NORM_EPS);
                float gl[4]; int gs = 0; float gm;
#pragma unroll
                for (int o = 0; o < 4; ++o) gl[o] = acc[o] * rstd + bg[o];
                gm = gl[0];
#pragma unroll
                for (int o = 1; o < 4; ++o) if (gl[o] > gm) { gm = gl[o]; gs = o; }
                float gsum = 0.f;
#pragma unroll
                for (int o = 0; o < 4; ++o) gsum += __expf(gl[o] - gm);
                const float pgrp = 1.f / gsum;
                float el[8];
#pragma unroll
                for (int j = 0; j < 8; ++j) { float a = acc[4 + j]; float bb = br[j];
                    a = gs == 1 ? acc[12 + j] : a; bb = gs == 1 ? br[8 + j] : bb; a = gs == 2 ? acc[20 + j] : a; bb = gs == 2 ? br[16 + j] : bb; a = gs == 3 ? acc[28 + j] : a; bb = gs == 3 ? br[24 + j] : bb;
                    el[j] = a * rstd + bb; }
                int e0 = 0; float m0 = el[0];
#pragma unroll
                for (int j = 1; j < 8; ++j) if (el[j] > m0) { m0 = el[j]; e0 = j; }
                int e1 = -1; float m1 = -3e38f;
#pragma unroll
                for (int j = 0; j < 8; ++j) if (j != e0 && el[j] > m1) { m1 = el[j]; e1 = j; }
                const float x1 = __expf(m1 - m0); const float g0 = pgrp / (1.f + x1), g1 = pgrp * x1 / (1.f + x1);
                const int ex0 = gs * 8 + e0, ex1 = gs * 8 + e1;
                const int s0 = (int)atomicAdd(ctl + CW_CNT + 64 * ex0, 1u); LIST[(size_t)ex0 * NR + s0] = tok * 2;
                const int s1 = (int)atomicAdd(ctl + CW_CNT + 64 * ex1, 1u); LIST[(size_t)ex1 * NR + s1] = tok * 2 + 1;
                GATE[tok * 2] = g0; GATE[tok * 2 + 1] = g1;
            }
        }
    }
}

template <int WHICH>
__device__ __forceinline__ void phase_moe(const Params& p, char* lds) {
    unsigned char* ws = p.ws; const int tid = threadIdx.x;
    const unsigned* ctl = (const unsigned*)(ws + WS_CTL);
    int* TP = (int*)(lds + pg8::STAGE_BYTES);
    __syncthreads();
    if (tid == 0) { int tp = 0, ro = 0; for (int e = 0; e < NEXP; ++e) { const int c = (int)ctl[CW_CNT + 64 * e]; TP[e] = tp; TP[64 + e] = ro; TP[128 + e] = c; const int t = (c + 255) / 256; tp += t * 4; ro += t * 256; } TP[NEXP] = tp; }
    __syncthreads();
    pg8::MoeOrder<WHICH> S{TP, (int)gridDim.x, (int)blockIdx.x, (const char*)(ws + (WHICH == 0 ? WS_U : WS_HID)), (const char*)(ws + (WHICH == 0 ? WS_W13 : WS_W2)), (const int*)(ws + WS_LIST)};
    if constexpr (WHICH == 0) { pg8::EpiMoe1 E{(bf16_t*)(ws + WS_HID), TP}; pg8::gemm_phase_x<pg8::EpiMoe1, pg8::MoeOrder<0>, true, true>((LAS unsigned char*)lds, 1024, S, E); }
    else { pg8::EpiMoe2 E{(bf16_t*)(ws + WS_MO), TP, (const int*)(ws + WS_LIST), (const float*)(ws + WS_GATE)}; pg8::gemm_phase_x<pg8::EpiMoe2, pg8::MoeOrder<1>, true, true>((LAS unsigned char*)lds, 512, S, E); }
}

__device__ __forceinline__ void phase_final(const Params& p) {
    unsigned char* ws = p.ws; const int tid = threadIdx.x, lane = tid & 63, wave = tid >> 6;
    const float* H1 = (const float*)(ws + WS_H1); const bf16_t* MO = (const bf16_t*)(ws + WS_MO); const float* g = p.in[I_GFIN];
    const int gw = blockIdx.x * NWAVES + wave, NGW = gridDim.x * NWAVES;
    for (int orow = gw; orow < BATCH * SEQ; orow += NGW) {
        const size_t row = (size_t)orow;
        const f32x4* xr = (const f32x4*)(H1 + row * D) + lane; const u32x2* m0 = (const u32x2*)(MO + row * 2 * D) + lane; const u32x2* m1 = m0 + 256;
        f32x4 v[4]; float ss = 0.f;
#pragma unroll
        for (int j = 0; j < 4; ++j) { const u32x2 a = m0[64 * j], c = m1[64 * j]; v[j] = xr[64 * j];
            v[j].x += bflo(a.x) + bflo(c.x); v[j].y += bfhi(a.x) + bfhi(c.x); v[j].z += bflo(a.y) + bflo(c.y); v[j].w += bfhi(a.y) + bfhi(c.y);
            ss += (v[j].x * v[j].x + v[j].y * v[j].y) + (v[j].z * v[j].z + v[j].w * v[j].w); }
        const float rstd = rsqrtf(wave_sum(ss) * (1.f / D) + NORM_EPS);
        f32x4* o = (f32x4*)(p.out + (size_t)orow * D) + lane;
#pragma unroll
        for (int j = 0; j < 4; ++j) { const f32x4 gg = ((const f32x4*)g)[lane + 64 * j]; o[64 * j] = v[j] * rstd * gg; }
    }
}

#define XB_TMO      128
#define XB_XCNT(j)  (256  + 64 * (j))
#define XB_XSUB(j)  (1280 + 64 * (j))
#define XB_XGEN(j)  (2304 + 64 * (j))
#define XB_TOP      3328
#define XB_TOPGEN   3392
#define XCD_BAR_WORDS 3456
#define XB_SPIN_CAP (1u << 18)
__device__ __forceinline__ unsigned xb_ld(unsigned* p)              { return __hip_atomic_load(p, __ATOMIC_RELAXED, __HIP_MEMORY_SCOPE_AGENT); }
__device__ __forceinline__ unsigned xb_add(unsigned* p, unsigned v) { return __hip_atomic_fetch_add(p, v, __ATOMIC_RELAXED, __HIP_MEMORY_SCOPE_AGENT); }
__device__ __forceinline__ unsigned xb_xcc_id() { return (unsigned)__builtin_amdgcn_s_getreg((3 << 11) | 20) & 0xFu; }
#define XB_SPIN(cond, bar) do { unsigned _sp = 0; while (cond) { __builtin_amdgcn_s_sleep(1); \
    if ((++_sp & 255u) == 0u) { if (xb_ld(&(bar)[XB_TMO])) break; if (_sp > XB_SPIN_CAP) { atomicAdd(&(bar)[XB_TMO], 1u); break; } } } } while (0)
struct XcdBarrier { unsigned* bar; unsigned x; volatile LAS unsigned* st; };
__device__ __forceinline__ XcdBarrier xcd_barrier_post(unsigned* bar, volatile LAS unsigned* st) {
    XcdBarrier b; b.bar = bar; b.x = xb_xcc_id(); b.st = st;
    if (threadIdx.x == 0) (void)xb_add(&bar[XB_XCNT(b.x)], 1u);
    return b;
}
__device__ __forceinline__ void xcd_barrier_complete(unsigned* bar, unsigned x, unsigned& nloc, unsigned& nx) {
    const unsigned G = gridDim.x * gridDim.y * gridDim.z;
    unsigned sum, cnt, mine, sp = 0u;
    for (;;) {
        sum = 0u; cnt = 0u; mine = 0u;
#pragma unroll
        for (unsigned j = 0; j < 16; ++j) { const unsigned c = xb_ld(&bar[XB_XCNT(j)]); sum += c; cnt += (c > 0u) ? 1u : 0u; mine = (j == x) ? c : mine; }
        if (sum == G) break;
        __builtin_amdgcn_s_sleep(1);
        if ((++sp & 255u) == 0u) { if (xb_ld(&bar[XB_TMO])) break; if (sp > XB_SPIN_CAP) { atomicAdd(&bar[XB_TMO], 1u); break; } }
    }
    nloc = mine > 0u ? mine : 1u; nx = cnt > 0u ? cnt : 1u;
}
__device__ __forceinline__ void xcd_barrier(const XcdBarrier& b) {
    asm volatile("s_waitcnt vmcnt(0)" ::: "memory");
    __syncthreads();
    if (threadIdx.x == 0) {
        unsigned* bar = b.bar;
        __builtin_amdgcn_s_waitcnt(0);
        unsigned nloc = b.st[0], nx = b.st[1];
        if (nloc == 0u) { xcd_barrier_complete(bar, b.x, nloc, nx); b.st[0] = nloc; b.st[1] = nx; }
        const unsigned old = xb_add(&bar[XB_XSUB(b.x)], 1u);
        const unsigned gen = old / nloc;
        if (old + 1u == (gen + 1u) * nloc) {
            __builtin_amdgcn_fence(__ATOMIC_RELEASE, "agent");
            asm volatile("s_waitcnt vmcnt(0)" ::: "memory");
            const unsigned og = xb_add(&bar[XB_TOP], 1u);
            const unsigned tg = og / nx;
            if (og + 1u == (tg + 1u) * nx) xb_add(&bar[XB_TOPGEN], 1u);
            else XB_SPIN(xb_ld(&bar[XB_TOPGEN]) == tg, bar);
            __builtin_amdgcn_fence(__ATOMIC_ACQUIRE, "agent");
            xb_add(&bar[XB_XGEN(b.x)], 1u);
            asm volatile("s_waitcnt vmcnt(0)" ::: "memory");
        } else {
            XB_SPIN(xb_ld(&bar[XB_XGEN(b.x)]) == gen, bar);
            __builtin_amdgcn_fence(__ATOMIC_ACQUIRE, "agent");
            asm volatile("s_waitcnt vmcnt(0)" ::: "memory");
        }
    }
    __syncthreads();
}

constexpr int LDS_XB = DSA_LDS;
constexpr int LDS_BYTES = DSA_LDS + 256;
static_assert(pg8::STAGE_BYTES <= LDS_XB && pg8::STAGE_BYTES + 1024 <= LDS_XB && NWAVES * 64 * 33 * 4 <= LDS_XB && NWAVES * 64 * SB_VT_STRIDE * 2 <= LDS_XB && 4 * 37 * 128 * 4 <= LDS_XB, "LDS map");

__global__ void __launch_bounds__(NTHREADS, 2) mega(Params p) {
    extern __shared__ __attribute__((aligned(16))) char lds[];
    const int lo = p.ph_lo, hi = p.ph_hi;
    unsigned char* ws = p.ws;
    XcdBarrier xb;
    {
        volatile LAS unsigned* st = (volatile LAS unsigned*)(lds + LDS_XB);
        if (threadIdx.x < 4) st[threadIdx.x] = 0u;
        __syncthreads();
        xb = xcd_barrier_post((unsigned*)(ws + WS_CTL) + CW_BAR, st);
    }
#define IN(k) (lo <= (k) && (k) < hi)
#define GSYNC() xcd_barrier(xb)
#define SEAM(k) do { if (IN(k) && IN((k) + 1)) GSYNC(); } while (0)
#define REP(k, ...) do { if (IN(k)) { __VA_ARGS__; } } while (0)
    LAS unsigned char* ldsl = (LAS unsigned char*)lds;
    REP(0, phase_prologue(p, lds));
    SEAM(0);
    REP(1, { phase_inproj_meta(p);
             pg8::TokRowOrder S; S.init(NR, PWN, gridDim.x, blockIdx.x); S.Abase = (const char*)(ws + WS_U); S.Bbase = (const char*)(ws + WS_WP); S.K = D;
             pg8::EpiInproj E{(bf16_t*)(ws + WS_P), (const float2*)(ws + WS_CS), ws + WS_KIP}; pg8::gemm_phase_x<pg8::EpiInproj, pg8::TokRowOrder, true, true>(ldsl, D, S, E); });
    SEAM(1);
    if (IN(2)) {
        phase_dsa(p, lds);
        __syncthreads(); phase_sb_fast(p, lds);
    }
    SEAM(2);
    REP(3, { pg8::TokRowOrder S; S.init(NR, 2048, gridDim.x, blockIdx.x); S.Abase = (const char*)(ws + WS_U); S.Bbase = (const char*)(ws + WS_WG); S.K = D;
             pg8::EpiGate E{(bf16_t*)(ws + WS_G)}; pg8::gemm_phase_x<pg8::EpiGate, pg8::TokRowOrder, true, true>(ldsl, D, S, E); });
    SEAM(3);
    REP(4, { { pg8::Gemm g{(const bf16_t*)(ws + WS_YA), (const bf16_t*)(ws + WS_WUA), NR, D, 512}; pg8::StaticOrder S; S.init(NR, D, gridDim.x, blockIdx.x);
               pg8::EpiZ<false> E{(bf16_t*)(ws + WS_Z), (const bf16_t*)(ws + WS_G), 0}; pg8::gemm_phase<pg8::EpiZ<false>, pg8::StaticOrder, true, true>(ldsl, g, S, E); }
             asm volatile("s_waitcnt vmcnt(0)" ::: "memory"); __syncthreads();
             { pg8::Gemm g{(const bf16_t*)(ws + WS_OLAT), (const bf16_t*)(ws + WS_WBP), NR, D, D}; pg8::StaticOrder S; S.init(NR, D, gridDim.x, blockIdx.x);
               pg8::EpiZ<true> E{(bf16_t*)(ws + WS_Z), (const bf16_t*)(ws + WS_G), 1024}; pg8::gemm_phase<pg8::EpiZ<true>, pg8::StaticOrder, true, true>(ldsl, g, S, E); } });
    SEAM(4);
    REP(5, { pg8::Gemm g{(const bf16_t*)(ws + WS_Z), (const bf16_t*)(ws + WS_WO), NR, D, D}; pg8::StaticOrder S; S.init(NR, D, gridDim.x, blockIdx.x);
             pg8::EpiH1 E{(float*)(ws + WS_H1), p.in[I_META], p.in[I_X]}; pg8::gemm_phase<pg8::EpiH1, pg8::StaticOrder, true, true>(ldsl, g, S, E); });
    SEAM(5);
    if (IN(6)) phase_c3(p, lds);
    SEAM(6);
    REP(7, phase_moe<0>(p, lds));
    SEAM(7);
    REP(8, phase_moe<1>(p, lds));
    SEAM(8);
    REP(9, phase_final(p));
}

extern "C" void kernel_launch(void* const* d_in, const int* in_sizes, int n_in, void* d_out, int out_size, void* d_ws, size_t ws_size, hipStream_t stream) {
    if (n_in != 18 || ws_size < WS_END) { fprintf(stderr, "kernel_launch: unexpected n_in %d / ws_size %zu\n", n_in, ws_size); return; }
    static int grid = 0;
    if (grid == 0) {
        int dev = 0, cus = 0, per_cu = 0;
        (void)hipGetDevice(&dev);
        (void)hipDeviceGetAttribute(&cus, hipDeviceAttributeMultiprocessorCount, dev);
        (void)hipFuncSetAttribute((const void*)mega, hipFuncAttributeMaxDynamicSharedMemorySize, LDS_BYTES);
        (void)hipOccupancyMaxActiveBlocksPerMultiprocessor(&per_cu, (const void*)mega, NTHREADS, LDS_BYTES);
        if (per_cu < 1) fprintf(stderr, "kernel_launch: occupancy query reports %d workgroups per CU\n", per_cu);
        grid = cus;
    }
    (void)hipMemsetAsync((char*)d_ws + WS_CTL, 0, CTL_BYTES, stream);
    Params p{};
    for (int i = 0; i < 18; ++i) p.in[i] = (const float*)d_in[i];
    p.out = (float*)d_out; p.ws = (unsigned char*)d_ws;
    p.ph_lo = 0; p.ph_hi = 10;
    void* args[] = {&p};
    hipError_t e = hipLaunchCooperativeKernel((const void*)mega, dim3(grid), dim3(NTHREADS), args, LDS_BYTES, stream);
    if (e != hipSuccess) fprintf(stderr, "cooperative launch failed: %s (grid %d)\n", hipGetErrorString(e), grid);
}
```

```cpp
#include <hip/hip_runtime.h>
#include <cstdio>
#include <cstdint>

constexpr int BATCH = 8, SEQ = 4096, NMETA = 16, T = SEQ + NMETA, D = 1024, NTOK = BATCH * T;
constexpr int MROWS = 33024;
constexpr int NR = BATCH * SEQ;
__device__ __forceinline__ int tokrow(int cr) { return cr + NMETA * (cr / SEQ + 1); }
constexpr int INW = 4824;
constexpr int NEXP = 32, DEXP = 512;
constexpr int NWAVES = 8, NTHREADS = 512;
constexpr float NORM_EPS = 1e-6f;
constexpr float LOG2E = 1.4426950408889634f;
constexpr float QSCALE = 0.125f * LOG2E;
constexpr int PW = 3456, PWN = 3584;
constexpr int C_QA = 0, C_KA = 512, C_VA = 1024, C_QF = 1536, C_KV = 2688, C_QI = 2832, C_KI = 3344, C_WI = 3408, C_END = 3416;
constexpr int QFW = 144;

constexpr size_t MiB = 1u << 20;
constexpr size_t WS_CTL = 0, CTL_BYTES = 1 * MiB;
constexpr size_t WS_CS = 1 * MiB;
constexpr size_t WS_WP = 2 * MiB;
constexpr size_t WS_WG = 9 * MiB;
constexpr size_t WS_WUA = 13 * MiB, WS_WBP = 14 * MiB, WS_WO = 16 * MiB;
constexpr size_t WS_W2 = 18 * MiB;
constexpr size_t WS_W13 = 50 * MiB;
constexpr size_t WS_U = 114 * MiB;
constexpr size_t WS_P = 179 * MiB;
constexpr size_t WS_Z = 179 * MiB;
constexpr size_t WS_G = 244 * MiB;
constexpr size_t WS_H1 = 244 * MiB;
constexpr size_t WS_LIST = 374 * MiB;
constexpr size_t WS_GATE = 379 * MiB;
constexpr size_t WS_YA = 397 * MiB;
constexpr size_t WS_OLAT = 430 * MiB;
constexpr size_t WS_HID = 397 * MiB;
constexpr size_t WS_MO = 50 * MiB;
constexpr size_t WS_KIP = 495 * MiB;
constexpr size_t KIP_BATCH = 129 * 4096;
constexpr size_t WS_END = 500 * MiB;
static_assert(WS_P + (size_t)MROWS * PW * 2 <= WS_YA && WS_G + (size_t)MROWS * 2048 * 2 <= WS_LIST && WS_Z + (size_t)MROWS * 1024 * 2 <= WS_G, "ws map");
static_assert(WS_OLAT + (size_t)MROWS * 1024 * 2 <= WS_END && WS_U + (size_t)MROWS * 1024 * 2 <= WS_P && WS_MO + (size_t)NTOK * 2048 * 2 <= WS_P, "ws map");
constexpr int CW_CNT = 1024;
constexpr int CW_BAR = 4096;

typedef unsigned short bf16_t;
typedef short bf16x8 __attribute__((ext_vector_type(8)));
typedef float f32x4 __attribute__((ext_vector_type(4)));
typedef float f32x16 __attribute__((ext_vector_type(16)));
typedef unsigned u32x2 __attribute__((ext_vector_type(2)));
typedef unsigned u32x4 __attribute__((ext_vector_type(4)));
typedef unsigned short u16x4 __attribute__((ext_vector_type(4)));
#define LAS __attribute__((address_space(3)))

__device__ __forceinline__ unsigned f2bf(float f) { unsigned u = __float_as_uint(f); return (u + 0x7fffu + ((u >> 16) & 1u)) >> 16; }
typedef __bf16 bf16v2_t __attribute__((ext_vector_type(2)));
typedef float f32v2_t __attribute__((ext_vector_type(2)));
__device__ __forceinline__ unsigned pk2(float lo, float hi) { const f32v2_t v = {lo, hi}; const bf16v2_t r = __builtin_convertvector(v, bf16v2_t); return __builtin_bit_cast(unsigned, r); }
__device__ __forceinline__ float bflo(unsigned w) { return __uint_as_float(w << 16); }
__device__ __forceinline__ float bfhi(unsigned w) { return __uint_as_float(w & 0xffff0000u); }
__device__ __forceinline__ float bf2f(bf16_t b) { return __uint_as_float((unsigned)b << 16); }
__device__ __forceinline__ float wave_sum(float v) {
#pragma unroll
    for (int o = 1; o < 64; o <<= 1) v += __shfl_xor(v, o);
    return v;
}
__device__ __forceinline__ float xsum32(float x) { const auto r = __builtin_amdgcn_permlane32_swap(__float_as_uint(x), __float_as_uint(x), false, false); return __uint_as_float(r[0]) + __uint_as_float(r[1]); }
__device__ __forceinline__ float xsum16(float x) { const auto r = __builtin_amdgcn_permlane16_swap(__float_as_uint(x), __float_as_uint(x), false, false); return __uint_as_float(r[0]) + __uint_as_float(r[1]); }
__device__ __forceinline__ float xmax32(float x) { const auto r = __builtin_amdgcn_permlane32_swap(__float_as_uint(x), __float_as_uint(x), false, false); return fmaxf(__uint_as_float(r[0]), __uint_as_float(r[1])); }
__device__ __forceinline__ float xmax16(float x) { const auto r = __builtin_amdgcn_permlane16_swap(__float_as_uint(x), __float_as_uint(x), false, false); return fmaxf(__uint_as_float(r[0]), __uint_as_float(r[1])); }
__device__ __forceinline__ float xpartner32(float x, int hh) { const auto r = __builtin_amdgcn_permlane32_swap(__float_as_uint(x), __float_as_uint(x), false, false); return __uint_as_float(hh ? r[0] : r[1]); }
__device__ __forceinline__ float sigmoidf(float x) { return 1.0f / (1.0f + __expf(-x)); }

struct Params {
    const float* in[18];
    float* out;
    unsigned char* ws;
    int ph_lo, ph_hi;
};
enum { I_X = 0, I_META, I_GMIX, I_WIN, I_WUK, I_WUV, I_WUPA, I_WUPB, I_WO, I_GFFN, I_WGRP, I_BGRP, I_WRT, I_BRT, I_W1, I_W3, I_W2, I_GFIN };

__device__ __forceinline__ const float* h0_row(const Params& p, int row) {
    const int b = row / T, t = row - b * T;
    return t < NMETA ? p.in[I_META] + (size_t)t * D : p.in[I_X] + ((size_t)b * SEQ + (t - NMETA)) * D;
}
template <class F>
__device__ __forceinline__ void tr_item(F val, bf16_t* dst, int ldd, int row0, int k0, float* scr, int lane, int rstep = 1) {
    float tv[32];
#pragma unroll
    for (int i = 0; i < 32; ++i) tv[i] = val(k0 + 2 * i + (lane >> 5), lane & 31);
#pragma unroll
    for (int i = 0; i < 32; ++i) scr[(2 * i + (lane >> 5)) * 33 + (lane & 31)] = tv[i];
    __builtin_amdgcn_s_waitcnt(0xC07F);
    asm volatile("" ::: "memory");
    const int c = lane & 7;
#pragma unroll
    for (int j = 0; j < 4; ++j) {
        const int n = (lane >> 3) + 8 * j; const float* s = scr + (8 * c) * 33 + n;
        u32x4 o; o.x = pk2(s[0], s[33]); o.y = pk2(s[66], s[99]); o.z = pk2(s[132], s[165]); o.w = pk2(s[198], s[231]);
        *(u32x4*)(dst + (size_t)(row0 + n * rstep) * ldd + k0 + 8 * c) = o;
    }
    __builtin_amdgcn_s_waitcnt(0xC07F);
    asm volatile("" ::: "memory");
}

__device__ __forceinline__ void wp_src(int c, int& kind, int& col, int& aux, float& scale) {
    kind = 1; aux = 0; scale = 1.f; col = 0;
    if (c < 512) { col = c; scale = QSCALE; }
    else if (c < C_QF) { col = c; }
    else if (c < C_KV) { const int r = c - C_QF, h = r / QFW, j = r % QFW; scale = QSCALE;
        if (j < 128) { kind = 2; col = h; aux = j; } else { const int i = j - 128; col = 1536 + 64 * h + (i >> 1) + 8 * (i & 1); } }
    else if (c < C_QI) { const int j = c - C_KV; if (j < 128) col = 2048 + j; else { const int i = j - 128; col = 2176 + (i >> 1) + 8 * (i & 1); } }
    else if (c < C_KI) { const int r = c - C_QI, h = r >> 6, j = r & 63; col = 2192 + 64 * h + (j < 16 ? (j >> 1) + 8 * (j & 1) : j); }
    else if (c < C_WI) { const int j = c - C_KI; col = 2704 + (j < 16 ? (j >> 1) + 8 * (j & 1) : j); }
    else if (c < C_END) { col = 2768 + (c - C_WI); }
    else kind = 0;
}

constexpr int IT_WP = (PWN / 32) * 16;
constexpr int IT_WG = 32 * 16;
constexpr int IT_WUA = 32 * 8;
constexpr int IT_WBP = 32 * 16, IT_WO = 32 * 16;
constexpr int IT_W13 = NEXP * 32 * 16;
constexpr int IT_W2 = NEXP * 32 * 8;
constexpr int IT_TOTAL = IT_WP + 2 * IT_WG + IT_WUA + IT_WBP + IT_WO + IT_W13 + IT_W2;

__device__ __forceinline__ void phase_prologue(const Params& p, char* lds) {
    const int tid = threadIdx.x, lane = tid & 63, wave = tid >> 6;
    const int gw = blockIdx.x * NWAVES + wave, NGW = gridDim.x * NWAVES;
    float* scr = (float*)lds + wave * (64 * 33);
    unsigned char* ws = p.ws;
    const float* w_in = p.in[I_WIN];
    {
        float2* cs = (float2*)(ws + WS_CS);
        for (int i = blockIdx.x * NTHREADS + tid; i < T * 8; i += gridDim.x * NTHREADS) {
            const int pos = i >> 3, f = i & 7;
            const float inv = powf(500000.0f, -(float)f / 8.0f);
            const float ang = (float)pos * inv;
            cs[i] = make_float2(cosf(ang), sinf(ang));
        }
    }
    for (int it = gw; it < IT_TOTAL; it += NGW) {
        int r = it;
        if (r < IT_WP) {
            const int rg = r / 16, kb = r % 16, c = rg * 32 + (lane & 31);
            int kind, col, aux; float scale; wp_src(c, kind, col, aux, scale);
            const float* w_uk = p.in[I_WUK];
            float wu[48];
#pragma unroll
            for (int n4 = 0; n4 < 12; ++n4) { f32x4 t = (f32x4){0.f, 0.f, 0.f, 0.f}; if (kind == 2) t = *(const f32x4*)(w_uk + ((size_t)col * 128 + aux) * 48 + 4 * n4); wu[4 * n4] = t.x; wu[4 * n4 + 1] = t.y; wu[4 * n4 + 2] = t.z; wu[4 * n4 + 3] = t.w; }
            tr_item([&](int k, int) -> float {
                if (kind == 0) return 0.f;
                if (kind == 1) return scale * w_in[(size_t)k * INW + col];
                const f32x4* wi = (const f32x4*)(w_in + (size_t)k * INW + 1536 + 64 * col + 16);
                float s = 0.f;
#pragma unroll
                for (int n4 = 0; n4 < 12; ++n4) { const f32x4 t = wi[n4]; s += t.x * wu[4 * n4] + t.y * wu[4 * n4 + 1] + t.z * wu[4 * n4 + 2] + t.w * wu[4 * n4 + 3]; }
                return scale * s; }, (bf16_t*)(ws + WS_WP), 1024, rg * 32, kb * 64, scr, lane);
            continue; }
        r -= IT_WP;
        if (r < 2 * IT_WG) {
            const int which = r / IT_WG; r %= IT_WG; const int rg = r / 16, kb = r % 16; const int col0 = (which ? 3800 : 2776) + rg * 32;
            tr_item([&](int k, int n) -> float { return w_in[(size_t)k * INW + col0 + n]; }, (bf16_t*)(ws + WS_WG) + (size_t)which * 1024 * 1024, 1024, rg * 32, kb * 64, scr, lane);
            continue; }
        r -= 2 * IT_WG;
        if (r < IT_WUA) {
            const int rg = r / 8, kb = r % 8; const float* w = p.in[I_WUPA];
            tr_item([&](int k, int n) -> float { return w[(size_t)k * 1024 + rg * 32 + n]; }, (bf16_t*)(ws + WS_WUA), 512, rg * 32, kb * 64, scr, lane);
            continue; }
        r -= IT_WUA;
        if (r < IT_WBP) {
            const int rg = r / 16, kb = r % 16; const float* wuv = p.in[I_WUV]; const float* wub = p.in[I_WUPB];
            const int hB = kb >> 1;
            float bc[64];
#pragma unroll
            for (int d = 0; d < 64; ++d) bc[d] = wub[(size_t)(64 * hB + d) * 1024 + rg * 32 + (lane & 31)];
            tr_item([&](int kk, int) -> float {
                const f32x4* a = (const f32x4*)(wuv + (size_t)kk * 64);
                float s = 0.f;
#pragma unroll
                for (int d4 = 0; d4 < 16; ++d4) { const f32x4 t = a[d4]; s += t.x * bc[4 * d4] + t.y * bc[4 * d4 + 1] + t.z * bc[4 * d4 + 2] + t.w * bc[4 * d4 + 3]; }
                return s; }, (bf16_t*)(ws + WS_WBP), 1024, rg * 32, kb * 64, scr, lane);
            continue; }
        r -= IT_WBP;
        if (r < IT_WO) {
            const int rg = r / 16, kb = r % 16; const float* w = p.in[I_WO];
            tr_item([&](int k, int n) -> float { return w[(size_t)k * 1024 + rg * 32 + n]; }, (bf16_t*)(ws + WS_WO), 1024, rg * 32, kb * 64, scr, lane);
            continue; }
        r -= IT_WO;
        if (r < IT_W13) {
            const int e = r / 512; r %= 512; const int which = r & 1, cg = (r >> 1) & 15, kb = r >> 5;
            const float* w = (which ? p.in[I_W3] : p.in[I_W1]) + (size_t)e * 1024 * 512 + cg * 32;
            tr_item([&](int k, int n) -> float { return w[(size_t)k * 512 + n]; },
                    (bf16_t*)(ws + WS_W13) + (size_t)e * 1024 * 1024, 1024, 2 * cg * 32 + which, kb * 64, scr, lane, 2);
            continue; }
        r -= IT_W13;
        {
            const int e = r / 256; r %= 256; const int rg = r / 8, kb = r % 8;
            const float* w2 = p.in[I_W2] + (size_t)e * 512 * 1024;
            tr_item([&](int k, int n) -> float { return w2[(size_t)k * 1024 + rg * 32 + n]; }, (bf16_t*)(ws + WS_W2) + (size_t)e * 1024 * 512, 512, rg * 32, kb * 64, scr, lane);
        }
    }
    {
        const float* g = p.in[I_GMIX]; bf16_t* U = (bf16_t*)(ws + WS_U);
        for (int row = gw; row < NTOK; row += NGW) {
            const f32x4* xr = (const f32x4*)h0_row(p, row) + lane;
            f32x4 v[4]; float s = 0.f;
#pragma unroll
            for (int j = 0; j < 4; ++j) { v[j] = xr[64 * j]; s += (v[j].x * v[j].x + v[j].y * v[j].y) + (v[j].z * v[j].z + v[j].w * v[j].w); }
            const float rstd = rsqrtf(wave_sum(s) * (1.f / D) + NORM_EPS);
            u32x2* o = (u32x2*)(U + (size_t)row * D) + lane;
#pragma unroll
            for (int j = 0; j < 4; ++j) { const f32x4 gg = ((const f32x4*)g)[lane + 64 * j];
                u32x2 w; w.x = pk2(v[j].x * rstd * gg.x, v[j].y * rstd * gg.y); w.y = pk2(v[j].z * rstd * gg.z, v[j].w * rstd * gg.w); o[64 * j] = w; }
        }
    }
}

namespace pg8 {
#define PG8_LAS __attribute__((address_space(3)))
typedef unsigned short bf16_t;
typedef short bf16x8 __attribute__((ext_vector_type(8)));
typedef float f32x4 __attribute__((ext_vector_type(4)));
typedef unsigned u32x4 __attribute__((ext_vector_type(4)));
constexpr int BM = 256, BK = 64, HALF = 128, HTB = HALF * BK * 2  , STAGE_BYTES = 8 * HTB, NXCD = 8, WGM = 8;

__host__ __device__ __forceinline__ int lds_byte(int r, int c) { const int st = (r >> 4) * 2 + (c >> 5), rr = r & 15, cc = c & 31, ob = rr * 64 + cc * 2; return st * 1024 + (ob ^ (((ob >> 9) & 1) << 5)); }
__host__ __device__ __forceinline__ void stage_rc(int b, int& R, int& C) { const int st = b / 1024, sb = b % 1024, swz = sb ^ (((sb >> 9) & 1) << 5); R = (st >> 1) * 16 + swz / 64; C = (st & 1) * 32 + (swz % 64) / 2; }
__host__ __device__ __forceinline__ int perm32(int rho) { const int n = rho >> 4, i = rho & 15; return 8 * (i >> 2) + 4 * n + (i & 3); }

struct Unit { int pm, pn; };
struct Gemm { const bf16_t* A; const bf16_t* Bt; int M, N, K; };

struct StaticOrder {
    int nM, nN, nwg, G, c;
    __host__ __device__ void init(int M, int N, int G_, int c_) { nM = M / BM; nN = N / BM; nwg = nM * nN; G = G_; c = c_; }
    __host__ __device__ bool next(int i, Unit& u) const {
        const long L = (long)i * G + c; if (L >= nwg) return false;
        int wgid = (int)L; { const int q = nwg / NXCD, r = nwg % NXCD, xcd = wgid % NXCD, off = wgid / NXCD; wgid = (xcd < r ? xcd * (q + 1) : r * (q + 1) + (xcd - r) * q) + off; }
        const int nig = WGM * nN, gid = wgid / nig, fm = gid * WGM, gsz = (nM - fm) < WGM ? (nM - fm) : WGM;
        u.pm = fm + ((wgid % nig) % gsz); u.pn = (wgid % nig) / gsz; return true;
    }
    __device__ __forceinline__ void a_ready(const Unit&) const {}
    __device__ __forceinline__ void done(const Unit&) const {}
};


#define PG8_FOR_FRAGS(...) _Pragma("unroll") for (int ai = 0; ai < 2; ++ai) _Pragma("unroll") for (int m = 0; m < 4; ++m) { const int row = u.pm * BM + ai * HALF + wr * 64 + m * 16 + fr; \
    _Pragma("unroll") for (int bj = 0; bj < 2; ++bj) _Pragma("unroll") for (int n = 0; n < 2; ++n) { const int col = u.pn * BM + bj * HALF + wc * 32 + n * 16 + 4 * fq; ::f32x4 v = acc[ai][bj][m][n]; __VA_ARGS__ } }
__device__ __forceinline__ bool rope_off(int c, int& o) {
    if (c < C_QF) return false;
    if (c < C_KV) { const int j = (c - C_QF) % QFW; o = j - 128; return j >= 128; }
    if (c < C_QI) { const int j = c - C_KV; o = j - 128; return j >= 128; }
    if (c < C_KI) { const int j = (c - C_QI) & 63; o = j; return j < 16; }
    if (c < C_WI) { const int j = c - C_KI; o = j; return j < 16; }
    return false;
}
#define PG8_FOR_FRAGS8(...) _Pragma("unroll") for (int ai = 0; ai < 2; ++ai) _Pragma("unroll") for (int m = 0; m < 4; ++m) { const int row = u.pm * BM + ai * HALF + wr * 64 + m * 16 + fr; \
    _Pragma("unroll") for (int bj = 0; bj < 2; ++bj) { const int col = u.pn * BM + bj * HALF + wc * 32 + 8 * fq; ::f32x4 v0 = acc[ai][bj][m][0], v1 = acc[ai][bj][m][1]; __VA_ARGS__ } }
struct EpiInproj {
    static constexpr bool PERM = true, AFTER_DRAIN = false;
    bf16_t* P; const float2* cs; unsigned char* KIP;
    __device__ __forceinline__ void operator()(const f32x4 (&acc)[2][2][4][2], const Unit& u, int wr, int wc, int fr, int fq) const {
        PG8_FOR_FRAGS8(
            if (col < PW) {
                int o; const int trow = tokrow(row);
                if (rope_off(col, o)) {
                    const int pos = (row % SEQ) + NMETA; const float2* cp = cs + pos * 8 + (o >> 1); const float2 c0 = cp[0], c1 = cp[1], c2 = cp[2], c3 = cp[3];
                    v0 = (::f32x4){v0.x * c0.x - v0.y * c0.y, v0.y * c0.x + v0.x * c0.y, v0.z * c1.x - v0.w * c1.y, v0.w * c1.x + v0.z * c1.y};
                    v1 = (::f32x4){v1.x * c2.x - v1.y * c2.y, v1.y * c2.x + v1.x * c2.y, v1.z * c3.x - v1.w * c3.y, v1.w * c3.x + v1.z * c3.y};
                }
                ::u32x4 w; w.x = pk2(v0.x, v0.y); w.y = pk2(v0.z, v0.w); w.z = pk2(v1.x, v1.y); w.w = pk2(v1.z, v1.w);
                if (col >= C_KI && col < C_WI) {
                    const int b = row / SEQ, t = row - b * SEQ + NMETA, d0 = col - C_KI;
                    *(::u32x4*)(KIP + (size_t)b * KIP_BATCH + (size_t)((((t >> 5) * 4 + (d0 >> 4)) * 2 + ((d0 >> 3) & 1)) * 512 + (t & 31) * 16)) = w;
                } else *(::u32x4*)(P + (size_t)trow * PW + col) = w;
            })
    }
};
struct EpiGate {
    static constexpr bool PERM = true, AFTER_DRAIN = false;
    bf16_t* G;
    __device__ __forceinline__ void operator()(const f32x4 (&acc)[2][2][4][2], const Unit& u, int wr, int wc, int fr, int fq) const {
        PG8_FOR_FRAGS8( ::u32x4 w; w.x = pk2(sigmoidf(v0.x), sigmoidf(v0.y)); w.y = pk2(sigmoidf(v0.z), sigmoidf(v0.w)); w.z = pk2(sigmoidf(v1.x), sigmoidf(v1.y)); w.w = pk2(sigmoidf(v1.z), sigmoidf(v1.w));
            *(::u32x4*)(G + (size_t)row * 2048 + col) = w; )
    }
};
template <bool ACCUM> struct EpiZ {
    static constexpr bool PERM = true, AFTER_DRAIN = false;
    bf16_t* Z; const bf16_t* G; int goff;
    __device__ __forceinline__ void operator()(const f32x4 (&acc)[2][2][4][2], const Unit& u, int wr, int wc, int fr, int fq) const {
        PG8_FOR_FRAGS8(
            const ::u32x4 g = *(const ::u32x4*)(G + (size_t)row * 2048 + goff + col);
            ::f32x4 z0 = (::f32x4){bflo(g.x) * v0.x, bfhi(g.x) * v0.y, bflo(g.y) * v0.z, bfhi(g.y) * v0.w}, z1 = (::f32x4){bflo(g.z) * v1.x, bfhi(g.z) * v1.y, bflo(g.w) * v1.z, bfhi(g.w) * v1.w};
            ::u32x4* zp = (::u32x4*)(Z + (size_t)row * D + col);
            if (ACCUM) { const ::u32x4 o = *zp; z0.x += bflo(o.x); z0.y += bfhi(o.x); z0.z += bflo(o.y); z0.w += bfhi(o.y); z1.x += bflo(o.z); z1.y += bfhi(o.z); z1.z += bflo(o.w); z1.w += bfhi(o.w); }
            ::u32x4 w; w.x = pk2(z0.x, z0.y); w.y = pk2(z0.z, z0.w); w.z = pk2(z1.x, z1.y); w.w = pk2(z1.z, z1.w); *zp = w; )
    }
};
struct EpiH1 {
    static constexpr bool PERM = false, AFTER_DRAIN = false;
    float* H1; const float* meta; const float* x;
    __device__ __forceinline__ void operator()(const f32x4 (&acc)[2][2][4][2], const Unit& u, int wr, int wc, int fr, int fq) const {
        PG8_FOR_FRAGS( const ::f32x4 h = *(const ::f32x4*)(x + (size_t)row * D + col); *(::f32x4*)(H1 + (size_t)row * D + col) = h + v; )
    }
};
#undef PG8_FOR_FRAGS
#undef PG8_FOR_FRAGS8

template <class Epi, class Sched, bool ALIGN_EPI = false, bool SP2 = false>
__device__ __forceinline__ void gemm_phase(PG8_LAS unsigned char* lds, const Gemm g, const Sched& S, const Epi& E) {
    const int tid = threadIdx.x, wid = __builtin_amdgcn_readfirstlane(tid >> 6), lane = tid & 63, wr = wid >> 2, wc = wid & 3, fr = lane & 15, fq = lane >> 4;
    const int K = g.K, nt = K / BK;
    unsigned voffA[2], voffB[2];
#pragma unroll
    for (int i = 0; i < 2; ++i) { int R, C; stage_rc(tid * 16 + i * 8192, R, C); const int Rb = Epi::PERM ? ((R & ~31) + perm32(R & 31)) : R;
        voffA[i] = (unsigned)(R * K + C) * 2u; voffB[i] = (unsigned)(Rb * K + C) * 2u; }
    const size_t kstep = (size_t)(BK * 2);
    const size_t hstep = (size_t)HALF * K * 2;
    const size_t tstep = 2 * hstep;
    const unsigned ldsw = (unsigned)wid * 1024u;
    const int aoff = lds_byte(wr * 64 + fr, fq * 8), boff = lds_byte(wc * 32 + fr, fq * 8);
#define PG8_SA(b, h) (((b) * 2 + (h)) * HTB)
#define PG8_SB(b, h) ((4 + (b) * 2 + (h)) * HTB)
#define PG8_STAGE(bufoff, gbase, voff) do { _Pragma("unroll") for (int _i = 0; _i < 2; ++_i) \
        __builtin_amdgcn_global_load_lds((const unsigned*)((const char*)(gbase) + (voff)[_i]), (PG8_LAS unsigned*)(lds + (bufoff) + ldsw + _i * 8192), 16, 0, 0); } while (0)
#define PG8_LDA(dst, b, h) do { _Pragma("unroll") for (int m = 0; m < 4; ++m) _Pragma("unroll") for (int k = 0; k < 2; ++k) dst[m][k] = *(const PG8_LAS bf16x8*)(lds + PG8_SA(b, h) + aoff + m * 2048 + k * 1024); } while (0)
#define PG8_LDB(dst, b, h) do { _Pragma("unroll") for (int n = 0; n < 2; ++n) _Pragma("unroll") for (int k = 0; k < 2; ++k) dst[n][k] = *(const PG8_LAS bf16x8*)(lds + PG8_SB(b, h) + boff + n * 2048 + k * 1024); } while (0)
#define PG8_MMA(ai, bj, At, Bt) do { __builtin_amdgcn_s_setprio(1); _Pragma("unroll") for (int m = 0; m < 4; ++m) _Pragma("unroll") for (int n = 0; n < 2; ++n) _Pragma("unroll") for (int k = 0; k < 2; ++k) \
        acc[ai][bj][m][n] = __builtin_amdgcn_mfma_f32_16x16x32_bf16(Bt[n][k], At[m][k], acc[ai][bj][m][n], 0, 0, 0); __builtin_amdgcn_s_setprio(0); } while (0)
#define PG8_WAIT_V(n) asm volatile("s_waitcnt vmcnt(" #n ")" ::: "memory")
#define PG8_WAIT_L(n) asm volatile("s_waitcnt lgkmcnt(" #n ")" ::: "memory")
#define PG8_BAR __builtin_amdgcn_s_barrier()
#define PG8_SCHED __builtin_amdgcn_sched_barrier(0)
    Unit cur, nxt; int ui = 0;
    if (!S.next(0, cur)) return;
    f32x4 acc[2][2][4][2];
#pragma unroll
    for (int a = 0; a < 2; ++a)
#pragma unroll
        for (int b = 0; b < 2; ++b)
#pragma unroll
            for (int m = 0; m < 4; ++m)
#pragma unroll
                for (int n = 0; n < 2; ++n) acc[a][b][m][n] = (f32x4){0.f, 0.f, 0.f, 0.f};
    bf16x8 At[4][2], B0[2][2], B1[2][2];
    const char* cA = (const char*)g.A + (size_t)cur.pm * tstep; const char* cB = (const char*)g.Bt + (size_t)cur.pn * tstep;
    S.a_ready(cur);
    if constexpr (SP2) {
        PG8_STAGE(PG8_SB(0, 0), cB, voffB); PG8_STAGE(PG8_SB(0, 1), cB + hstep, voffB); PG8_STAGE(PG8_SA(0, 0), cA, voffA); PG8_STAGE(PG8_SA(0, 1), cA + hstep, voffA);
        if (wr == 1) PG8_BAR;
        PG8_WAIT_V(2); PG8_BAR;
        PG8_STAGE(PG8_SB(1, 0), cB + kstep, voffB); PG8_STAGE(PG8_SA(1, 0), cA + kstep, voffA); PG8_STAGE(PG8_SB(1, 1), cB + hstep + kstep, voffB);
        PG8_WAIT_V(6); PG8_BAR;
    } else {
        PG8_STAGE(PG8_SB(0, 0), cB, voffB); PG8_STAGE(PG8_SA(0, 0), cA, voffA); PG8_STAGE(PG8_SB(0, 1), cB + hstep, voffB); PG8_STAGE(PG8_SA(0, 1), cA + hstep, voffA);
        if (wr == 1) PG8_BAR;
        PG8_WAIT_V(4); PG8_BAR;
        PG8_STAGE(PG8_SB(1, 0), cB + kstep, voffB); PG8_STAGE(PG8_SA(1, 0), cA + kstep, voffA); PG8_STAGE(PG8_SB(1, 1), cB + hstep + kstep, voffB);
        PG8_WAIT_V(6); PG8_BAR;
    }
    for (;;) {
        const bool has_next = S.next(ui + 1, nxt);
        const char* nA = has_next ? (const char*)g.A + (size_t)nxt.pm * tstep : cA; const char* nB = has_next ? (const char*)g.Bt + (size_t)nxt.pn * tstep : cB;
        for (int t = 0; t < nt; t += 2) {
            const bool last = (t == nt - 2);
            const char* a1 = cA + (size_t)(t + 1) * kstep;
            const char* a2 = last ? nA : cA + (size_t)(t + 2) * kstep; const char* b2 = last ? nB : cB + (size_t)(t + 2) * kstep;
            const char* a3 = a2 + kstep; const char* b3 = b2 + kstep;
            if (last && has_next) S.a_ready(nxt);
            if constexpr (SP2) {
            PG8_LDB(B0, 0, 0); PG8_LDB(B1, 0, 1); PG8_SCHED; PG8_LDA(At, 0, 0); PG8_STAGE(PG8_SA(1, 1), a1 + hstep, voffA);
            PG8_WAIT_V(8); PG8_WAIT_L(0); PG8_BAR; PG8_MMA(0, 0, At, B0); PG8_MMA(0, 1, At, B1); PG8_BAR; PG8_SCHED;
            PG8_LDA(At, 0, 1); PG8_STAGE(PG8_SB(0, 0), b2, voffB); PG8_STAGE(PG8_SB(0, 1), b2 + hstep, voffB); PG8_STAGE(PG8_SA(0, 0), a2, voffA);
            PG8_WAIT_V(8); PG8_WAIT_L(0); PG8_BAR; PG8_MMA(1, 0, At, B0); PG8_MMA(1, 1, At, B1); PG8_BAR; PG8_SCHED;
            PG8_LDB(B0, 1, 0); PG8_LDB(B1, 1, 1); PG8_SCHED; PG8_LDA(At, 1, 0); PG8_STAGE(PG8_SA(0, 1), a2 + hstep, voffA);
            PG8_WAIT_V(8); PG8_WAIT_L(0); PG8_BAR; PG8_MMA(0, 0, At, B0); PG8_MMA(0, 1, At, B1); PG8_BAR; PG8_SCHED;
            PG8_LDA(At, 1, 1); PG8_STAGE(PG8_SB(1, 0), b3, voffB); PG8_STAGE(PG8_SB(1, 1), b3 + hstep, voffB); PG8_STAGE(PG8_SA(1, 0), a3, voffA);
            PG8_WAIT_V(8); PG8_WAIT_L(0); PG8_BAR; PG8_MMA(1, 0, At, B0); PG8_MMA(1, 1, At, B1); PG8_BAR; PG8_SCHED;
            } else {
            PG8_LDB(B0, 0, 0); PG8_SCHED; PG8_LDA(At, 0, 0); PG8_STAGE(PG8_SA(1, 1), a1 + hstep, voffA);
            PG8_WAIT_L(8); PG8_BAR; PG8_WAIT_L(0); PG8_MMA(0, 0, At, B0); PG8_BAR; PG8_SCHED;
            PG8_LDB(B1, 0, 1); PG8_STAGE(PG8_SB(0, 0), b2, voffB);
            PG8_BAR; PG8_WAIT_L(0); PG8_MMA(0, 1, At, B1); PG8_BAR;
            PG8_LDA(At, 0, 1); PG8_STAGE(PG8_SA(0, 0), a2, voffA);
            PG8_BAR; PG8_WAIT_L(0); PG8_MMA(1, 0, At, B0); PG8_BAR; PG8_SCHED;
            PG8_STAGE(PG8_SB(0, 1), b2 + hstep, voffB);
            PG8_WAIT_V(6); PG8_BAR; PG8_MMA(1, 1, At, B1); PG8_BAR;
            PG8_LDB(B0, 1, 0); PG8_SCHED; PG8_LDA(At, 1, 0); PG8_STAGE(PG8_SA(0, 1), a2 + hstep, voffA);
            PG8_WAIT_L(8); PG8_BAR; PG8_WAIT_L(0); PG8_MMA(0, 0, At, B0); PG8_BAR; PG8_SCHED;
            PG8_LDB(B1, 1, 1); PG8_STAGE(PG8_SB(1, 0), b3, voffB);
            PG8_BAR; PG8_WAIT_L(0); PG8_MMA(0, 1, At, B1); PG8_BAR;
            PG8_LDA(At, 1, 1); PG8_STAGE(PG8_SA(1, 0), a3, voffA);
            PG8_BAR; PG8_WAIT_L(0); PG8_MMA(1, 0, At, B0); PG8_BAR; PG8_SCHED;
            PG8_STAGE(PG8_SB(1, 1), b3 + hstep, voffB);
            PG8_WAIT_V(6); PG8_BAR; PG8_MMA(1, 1, At, B1); PG8_BAR;
            }
        }
        if constexpr (ALIGN_EPI) { if (wr == 0) PG8_BAR; }
        if constexpr (!Epi::AFTER_DRAIN) { E(acc, cur, wr, wc, fr, fq); S.done(cur); }
        if (!has_next) break;
#pragma unroll
        for (int a = 0; a < 2; ++a)
#pragma unroll
            for (int b = 0; b < 2; ++b)
#pragma unroll
                for (int m = 0; m < 4; ++m)
#pragma unroll
                    for (int n = 0; n < 2; ++n) acc[a][b][m][n] = (f32x4){0.f, 0.f, 0.f, 0.f};
        cur = nxt; cA = nA; cB = nB; ++ui;
        if constexpr (ALIGN_EPI) { if (wr == 1) PG8_BAR; }
    }
    PG8_WAIT_V(0);
    if constexpr (!ALIGN_EPI) { if (wr == 0) PG8_BAR; }
    PG8_BAR;
    if constexpr (Epi::AFTER_DRAIN) { E.fused(acc, cur, wr, wc, fr, fq, lds, wid, lane); S.done(cur); }
#undef PG8_SA
#undef PG8_SB
#undef PG8_STAGE
#undef PG8_LDA
#undef PG8_LDB
#undef PG8_MMA
#undef PG8_WAIT_V
#undef PG8_WAIT_L
#undef PG8_BAR
#undef PG8_SCHED
}
template <class Epi, class Sched, bool ALIGN_EPI = false, bool SP2 = false>
__device__ __forceinline__ void gemm_phase_x(PG8_LAS unsigned char* lds, const int K, const Sched& S, const Epi& E) {
    const int tid = threadIdx.x, wid = __builtin_amdgcn_readfirstlane(tid >> 6), lane = tid & 63, wr = wid >> 2, wc = wid & 3, fr = lane & 15, fq = lane >> 4;
    const int nt = K / BK;
    unsigned vcA[2][2], vnA[2][2], voffB[2];
#pragma unroll
    for (int i = 0; i < 2; ++i) { int R, C; stage_rc(tid * 16 + i * 8192, R, C); const int Rb = Epi::PERM ? ((R & ~31) + perm32(R & 31)) : R;
        voffB[i] = (unsigned)(Rb * K + C) * 2u; }
    const size_t kstep = (size_t)(BK * 2);
    const size_t hstep = (size_t)HALF * K * 2;
    const unsigned ldsw = (unsigned)wid * 1024u;
    const int aoff = lds_byte(wr * 64 + fr, fq * 8), boff = lds_byte(wc * 32 + fr, fq * 8);
#define PG8_SA(b, h) (((b) * 2 + (h)) * HTB)
#define PG8_SB(b, h) ((4 + (b) * 2 + (h)) * HTB)
#define PG8_STAGE(bufoff, gbase, voff) do { _Pragma("unroll") for (int _i = 0; _i < 2; ++_i) \
        __builtin_amdgcn_global_load_lds((const unsigned*)((const char*)(gbase) + (voff)[_i]), (PG8_LAS unsigned*)(lds + (bufoff) + ldsw + _i * 8192), 16, 0, 0); } while (0)
#define PG8_STAGEA(bufoff, gbase, V, h) do { _Pragma("unroll") for (int _i = 0; _i < 2; ++_i) \
        __builtin_amdgcn_global_load_lds((const unsigned*)((const char*)(gbase) + (V)[h][_i]), (PG8_LAS unsigned*)(lds + (bufoff) + ldsw + _i * 8192), 16, 0, 0); } while (0)
#define PG8_STAGEA2(bufoff, gbase, h) do { _Pragma("unroll") for (int _i = 0; _i < 2; ++_i) \
        __builtin_amdgcn_global_load_lds((const unsigned*)((const char*)(gbase) + (last ? vnA[h][_i] : vcA[h][_i])), (PG8_LAS unsigned*)(lds + (bufoff) + ldsw + _i * 8192), 16, 0, 0); } while (0)
#define PG8_AOFF(V, u) do { _Pragma("unroll") for (int _h = 0; _h < 2; ++_h) _Pragma("unroll") for (int _i = 0; _i < 2; ++_i) { int R_, C_; stage_rc(tid * 16 + _i * 8192, R_, C_); (V)[_h][_i] = S.a_off(u, _h * HALF + R_, C_); } } while (0)
#define PG8_LDA(dst, b, h) do { _Pragma("unroll") for (int m = 0; m < 4; ++m) _Pragma("unroll") for (int k = 0; k < 2; ++k) dst[m][k] = *(const PG8_LAS bf16x8*)(lds + PG8_SA(b, h) + aoff + m * 2048 + k * 1024); } while (0)
#define PG8_LDB(dst, b, h) do { _Pragma("unroll") for (int n = 0; n < 2; ++n) _Pragma("unroll") for (int k = 0; k < 2; ++k) dst[n][k] = *(const PG8_LAS bf16x8*)(lds + PG8_SB(b, h) + boff + n * 2048 + k * 1024); } while (0)
#define PG8_MMA(ai, bj, At, Bt) do { __builtin_amdgcn_s_setprio(1); _Pragma("unroll") for (int m = 0; m < 4; ++m) _Pragma("unroll") for (int n = 0; n < 2; ++n) _Pragma("unroll") for (int k = 0; k < 2; ++k) \
        acc[ai][bj][m][n] = __builtin_amdgcn_mfma_f32_16x16x32_bf16(Bt[n][k], At[m][k], acc[ai][bj][m][n], 0, 0, 0); __builtin_amdgcn_s_setprio(0); } while (0)
#define PG8_WAIT_V(n) asm volatile("s_waitcnt vmcnt(" #n ")" ::: "memory")
#define PG8_WAIT_L(n) asm volatile("s_waitcnt lgkmcnt(" #n ")" ::: "memory")
#define PG8_BAR __builtin_amdgcn_s_barrier()
#define PG8_SCHED __builtin_amdgcn_sched_barrier(0)
    Unit cur, nxt; int ui = 0;
    if (!S.next(0, cur)) return;
    f32x4 acc[2][2][4][2];
#pragma unroll
    for (int a = 0; a < 2; ++a)
#pragma unroll
        for (int b = 0; b < 2; ++b)
#pragma unroll
            for (int m = 0; m < 4; ++m)
#pragma unroll
                for (int n = 0; n < 2; ++n) acc[a][b][m][n] = (f32x4){0.f, 0.f, 0.f, 0.f};
    bf16x8 At[4][2], B0[2][2], B1[2][2];
    const char* cA = S.a_base(cur); const char* cB = S.b_base(cur);
    PG8_AOFF(vcA, cur);
    S.a_ready(cur);
    if constexpr (SP2) {
        PG8_STAGE(PG8_SB(0, 0), cB, voffB); PG8_STAGE(PG8_SB(0, 1), cB + hstep, voffB); PG8_STAGEA(PG8_SA(0, 0), cA, vcA, 0); PG8_STAGEA(PG8_SA(0, 1), cA, vcA, 1);
        if (wr == 1) PG8_BAR;
        PG8_WAIT_V(2); PG8_BAR;
        PG8_STAGE(PG8_SB(1, 0), cB + kstep, voffB); PG8_STAGEA(PG8_SA(1, 0), cA + kstep, vcA, 0); PG8_STAGE(PG8_SB(1, 1), cB + hstep + kstep, voffB);
        PG8_WAIT_V(6); PG8_BAR;
    } else {
        PG8_STAGE(PG8_SB(0, 0), cB, voffB); PG8_STAGEA(PG8_SA(0, 0), cA, vcA, 0); PG8_STAGE(PG8_SB(0, 1), cB + hstep, voffB); PG8_STAGEA(PG8_SA(0, 1), cA, vcA, 1);
        if (wr == 1) PG8_BAR;
        PG8_WAIT_V(4); PG8_BAR;
        PG8_STAGE(PG8_SB(1, 0), cB + kstep, voffB); PG8_STAGEA(PG8_SA(1, 0), cA + kstep, vcA, 0); PG8_STAGE(PG8_SB(1, 1), cB + hstep + kstep, voffB);
        PG8_WAIT_V(6); PG8_BAR;
    }
    for (;;) {
        const bool has_next = S.next(ui + 1, nxt);
        const char* nA = has_next ? S.a_base(nxt) : cA; const char* nB = has_next ? S.b_base(nxt) : cB;
        if (has_next) { PG8_AOFF(vnA, nxt); } else { _Pragma("unroll") for (int _h = 0; _h < 2; ++_h) _Pragma("unroll") for (int _i = 0; _i < 2; ++_i) vnA[_h][_i] = vcA[_h][_i]; }
        for (int t = 0; t < nt; t += 2) {
            const bool last = (t == nt - 2);
            const char* a1 = cA + (size_t)(t + 1) * kstep;
            const char* a2 = last ? nA : cA + (size_t)(t + 2) * kstep; const char* b2 = last ? nB : cB + (size_t)(t + 2) * kstep;
            const char* a3 = a2 + kstep; const char* b3 = b2 + kstep;
            if (last && has_next) S.a_ready(nxt);
            if constexpr (SP2) {
            PG8_LDB(B0, 0, 0); PG8_LDB(B1, 0, 1); PG8_SCHED; PG8_LDA(At, 0, 0); PG8_STAGEA(PG8_SA(1, 1), a1, vcA, 1);
            PG8_WAIT_V(8); PG8_WAIT_L(0); PG8_BAR; PG8_MMA(0, 0, At, B0); PG8_MMA(0, 1, At, B1); PG8_BAR; PG8_SCHED;
            PG8_LDA(At, 0, 1); PG8_STAGE(PG8_SB(0, 0), b2, voffB); PG8_STAGE(PG8_SB(0, 1), b2 + hstep, voffB); PG8_STAGEA2(PG8_SA(0, 0), a2, 0);
            PG8_WAIT_V(8); PG8_WAIT_L(0); PG8_BAR; PG8_MMA(1, 0, At, B0); PG8_MMA(1, 1, At, B1); PG8_BAR; PG8_SCHED;
            PG8_LDB(B0, 1, 0); PG8_LDB(B1, 1, 1); PG8_SCHED; PG8_LDA(At, 1, 0); PG8_STAGEA2(PG8_SA(0, 1), a2, 1);
            PG8_WAIT_V(8); PG8_WAIT_L(0); PG8_BAR; PG8_MMA(0, 0, At, B0); PG8_MMA(0, 1, At, B1); PG8_BAR; PG8_SCHED;
            PG8_LDA(At, 1, 1); PG8_STAGE(PG8_SB(1, 0), b3, voffB); PG8_STAGE(PG8_SB(1, 1), b3 + hstep, voffB); PG8_STAGEA2(PG8_SA(1, 0), a3, 0);
            PG8_WAIT_V(8); PG8_WAIT_L(0); PG8_BAR; PG8_MMA(1, 0, At, B0); PG8_MMA(1, 1, At, B1); PG8_BAR; PG8_SCHED;
            } else {
            PG8_LDB(B0, 0, 0); PG8_SCHED; PG8_LDA(At, 0, 0); PG8_STAGEA(PG8_SA(1, 1), a1, vcA, 1);
            PG8_WAIT_L(8); PG8_BAR; PG8_WAIT_L(0); PG8_MMA(0, 0, At, B0); PG8_BAR; PG8_SCHED;
            PG8_LDB(B1, 0, 1); PG8_STAGE(PG8_SB(0, 0), b2, voffB);
            PG8_BAR; PG8_WAIT_L(0); PG8_MMA(0, 1, At, B1); PG8_BAR;
            PG8_LDA(At, 0, 1); PG8_STAGEA2(PG8_SA(0, 0), a2, 0);
            PG8_BAR; PG8_WAIT_L(0); PG8_MMA(1, 0, At, B0); PG8_BAR; PG8_SCHED;
            PG8_STAGE(PG8_SB(0, 1), b2 + hstep, voffB);
            PG8_WAIT_V(6); PG8_BAR; PG8_MMA(1, 1, At, B1); PG8_BAR;
            PG8_LDB(B0, 1, 0); PG8_SCHED; PG8_LDA(At, 1, 0); PG8_STAGEA2(PG8_SA(0, 1), a2, 1);
            PG8_WAIT_L(8); PG8_BAR; PG8_WAIT_L(0); PG8_MMA(0, 0, At, B0); PG8_BAR; PG8_SCHED;
            PG8_LDB(B1, 1, 1); PG8_STAGE(PG8_SB(1, 0), b3, voffB);
            PG8_BAR; PG8_WAIT_L(0); PG8_MMA(0, 1, At, B1); PG8_BAR;
            PG8_LDA(At, 1, 1); PG8_STAGEA2(PG8_SA(1, 0), a3, 0);
            PG8_BAR; PG8_WAIT_L(0); PG8_MMA(1, 0, At, B0); PG8_BAR; PG8_SCHED;
            PG8_STAGE(PG8_SB(1, 1), b3 + hstep, voffB);
            PG8_WAIT_V(6); PG8_BAR; PG8_MMA(1, 1, At, B1); PG8_BAR;
            }
        }
        if constexpr (ALIGN_EPI) { if (wr == 0) PG8_BAR; }
        if constexpr (!Epi::AFTER_DRAIN) { E(acc, cur, wr, wc, fr, fq); S.done(cur); }
        if (!has_next) break;
#pragma unroll
        for (int a = 0; a < 2; ++a)
#pragma unroll
            for (int b = 0; b < 2; ++b)
#pragma unroll
                for (int m = 0; m < 4; ++m)
#pragma unroll
                    for (int n = 0; n < 2; ++n) acc[a][b][m][n] = (f32x4){0.f, 0.f, 0.f, 0.f};
        cur = nxt; cA = nA; cB = nB; ++ui;
        _Pragma("unroll") for (int _h = 0; _h < 2; ++_h) _Pragma("unroll") for (int _i = 0; _i < 2; ++_i) vcA[_h][_i] = vnA[_h][_i];
        if constexpr (ALIGN_EPI) { if (wr == 1) PG8_BAR; }
    }
    PG8_WAIT_V(0);
    if constexpr (!ALIGN_EPI) { if (wr == 0) PG8_BAR; }
    PG8_BAR;
    if constexpr (Epi::AFTER_DRAIN) { E.fused(acc, cur, wr, wc, fr, fq, lds, wid, lane); S.done(cur); }
#undef PG8_SA
#undef PG8_SB
#undef PG8_STAGE
#undef PG8_STAGEA
#undef PG8_STAGEA2
#undef PG8_AOFF
#undef PG8_LDA
#undef PG8_LDB
#undef PG8_MMA
#undef PG8_WAIT_V
#undef PG8_WAIT_L
#undef PG8_BAR
#undef PG8_SCHED
}


template <int WHICH> struct MoeOrder {
    const int* TP; int G, c; const char* Abase; const char* Bbase; const int* LIST;
    static constexpr int KK = WHICH == 0 ? 1024 : 512, NN = 4;
    __device__ __forceinline__ bool next(int i, Unit& u) const {
        const int L = i * G + c; if (L >= TP[NEXP]) return false;
        int e = 0;
#pragma unroll 1
        for (int j = 16; j >= 1; j >>= 1) if (TP[e + j] <= L) e += j;
        const int lt = L - TP[e]; u.pm = e * 1024 + lt / NN; u.pn = lt % NN; return true;
    }
    __device__ __forceinline__ const char* a_base(const Unit& u) const { const int e = u.pm >> 10, mt = u.pm & 1023; return WHICH == 0 ? Abase : Abase + (size_t)(TP[64 + e] + mt * 256) * (DEXP * 2); }
    __device__ __forceinline__ const char* b_base(const Unit& u) const { const int e = u.pm >> 10; return Bbase + ((size_t)e * 1024 + (size_t)u.pn * 256) * (KK * 2); }
    __device__ __forceinline__ unsigned a_off(const Unit& u, int r, int C) const {
        if (WHICH == 1) return (unsigned)(r * DEXP + C) * 2u;
        const int e = u.pm >> 10, s = (u.pm & 1023) * 256 + r; const int tok = s < TP[128 + e] ? (LIST[(size_t)e * NR + s] >> 1) : 0;
        return (unsigned)tok * (D * 2) + (unsigned)C * 2u;
    }
    __device__ __forceinline__ void a_ready(const Unit&) const {}
    __device__ __forceinline__ void done(const Unit&) const {}
};
struct TokRowOrder : StaticOrder {
    const char* Abase; const char* Bbase; int K;
    __device__ __forceinline__ const char* a_base(const Unit& u) const { return Abase + (size_t)tokrow(u.pm * BM) * K * 2; }
    __device__ __forceinline__ const char* b_base(const Unit& u) const { return Bbase + (size_t)u.pn * BM * K * 2; }
    __device__ __forceinline__ unsigned a_off(const Unit&, int r, int C) const { return (unsigned)(r * K + C) * 2u; }
};
#define PG8_FOR_FRAGS_M(...) _Pragma("unroll") for (int ai = 0; ai < 2; ++ai) _Pragma("unroll") for (int m = 0; m < 4; ++m) { const int r = ai * HALF + wr * 64 + m * 16 + fr; \
    _Pragma("unroll") for (int bj = 0; bj < 2; ++bj) _Pragma("unroll") for (int n = 0; n < 2; ++n) { const int col = u.pn * BM + bj * HALF + wc * 32 + n * 16 + 4 * fq; ::f32x4 v = acc[ai][bj][m][n]; __VA_ARGS__ } }
struct EpiMoe1 {
    static constexpr bool PERM = true, AFTER_DRAIN = false;
    bf16_t* HID; const int* TP;
    __device__ __forceinline__ void operator()(const f32x4 (&acc)[2][2][4][2], const Unit& u, int wr, int wc, int fr, int fq) const {
        const int e = u.pm >> 10, mt = u.pm & 1023; bf16_t* base = HID + (size_t)(TP[64 + e] + mt * 256) * DEXP;
#pragma unroll
        for (int ai = 0; ai < 2; ++ai)
#pragma unroll
            for (int m = 0; m < 4; ++m) { const int r = ai * HALF + wr * 64 + m * 16 + fr;
#pragma unroll
                for (int bj = 0; bj < 2; ++bj) { const int col = u.pn * BM + bj * HALF + wc * 32 + 8 * fq; const ::f32x4 v0 = acc[ai][bj][m][0], v1 = acc[ai][bj][m][1];
                    const float h0 = v0.x / (1.f + __expf(-v0.x)) * v0.y, h1 = v0.z / (1.f + __expf(-v0.z)) * v0.w, h2 = v1.x / (1.f + __expf(-v1.x)) * v1.y, h3 = v1.z / (1.f + __expf(-v1.z)) * v1.w;
                    ::u32x2 w; w.x = pk2(h0, h1); w.y = pk2(h2, h3); *(::u32x2*)(base + (size_t)r * DEXP + (col >> 1)) = w; } }
    }
};
struct EpiMoe2 {
    static constexpr bool PERM = true, AFTER_DRAIN = false;
    bf16_t* MO; const int* TP; const int* LIST; const float* GATE;
    __device__ __forceinline__ void operator()(const f32x4 (&acc)[2][2][4][2], const Unit& u, int wr, int wc, int fr, int fq) const {
        const int e = u.pm >> 10, mt = u.pm & 1023, cnt = TP[128 + e];
#pragma unroll
        for (int ai = 0; ai < 2; ++ai)
#pragma unroll
            for (int m = 0; m < 4; ++m) {
                const int s = mt * 256 + ai * HALF + wr * 64 + m * 16 + fr;
                if (s < cnt) {
                    const int ent = LIST[(size_t)e * NR + s]; const float gt = GATE[ent]; bf16_t* row = MO + (size_t)ent * D;
#pragma unroll
                    for (int bj = 0; bj < 2; ++bj) { const int col = u.pn * BM + bj * HALF + wc * 32 + 8 * fq; const ::f32x4 v0 = acc[ai][bj][m][0], v1 = acc[ai][bj][m][1];
                        ::u32x4 w; w.x = pk2(v0.x * gt, v0.y * gt); w.y = pk2(v0.z * gt, v0.w * gt); w.z = pk2(v1.x * gt, v1.y * gt); w.w = pk2(v1.z * gt, v1.w * gt); *(::u32x4*)(row + col) = w; }
                }
            }
    }
};
#undef PG8_FOR_FRAGS_M
}
constexpr int SB_NQT = SEQ / 32;
constexpr int SB_VT_STRIDE = 40;
__device__ __forceinline__ void phase_sb_fast(const Params& p, char* lds) {
    const bf16_t* P = (const bf16_t*)(p.ws + WS_P); bf16_t* YA = (bf16_t*)(p.ws + WS_YA);
    const int tid = threadIdx.x, lane = tid & 63, wave = tid >> 6, n = lane & 31, hh = lane >> 5;
    bf16_t* VT = (bf16_t*)(lds + wave * (64 * SB_VT_STRIDE * 2));
    const int gw = blockIdx.x * NWAVES + wave, NGW = gridDim.x * NWAVES;
    for (int unit = gw; unit < 64 * SB_NQT; unit += NGW) {
        const int qt = SB_NQT - 1 - unit / 64, bh = unit % 64, h = bh & 7, b = bh >> 3;
        const int i0 = NMETA + qt * 32, qi = i0 + n, qrow = qi;
        const bf16_t* Pb = P + (size_t)b * T * PW;
        bf16x8 qf[4];
#pragma unroll
        for (int s = 0; s < 4; ++s) qf[s] = *(const bf16x8*)(Pb + (size_t)qrow * PW + C_QA + h * 64 + 16 * s + 8 * hh);
        f32x16 o0, o1;
#pragma unroll
        for (int r = 0; r < 16; ++r) { o0[r] = 0.f; o1[r] = 0.f; }
        float L = 0.f;
        for (int kt = qt + 1; kt >= 0; --kt) {
            const int j0 = kt * 32, krow = (j0 + n) < T ? (j0 + n) : T - 1;
            bf16x8 kf[4];
#pragma unroll
            for (int s = 0; s < 4; ++s) kf[s] = *(const bf16x8*)(Pb + (size_t)krow * PW + C_KA + h * 64 + 16 * s + 8 * hh);
#pragma unroll
            for (int i = 0; i < 4; ++i) {
                const int c = lane + 64 * i, key = c >> 3, d0 = (c & 7) * 8, vrow = (j0 + key) < T ? (j0 + key) : T - 1;
                const u32x4 w = *(const u32x4*)(Pb + (size_t)vrow * PW + C_VA + h * 64 + d0);
                bf16_t* vp = VT + d0 * SB_VT_STRIDE + key;
                vp[0] = (bf16_t)(w.x & 0xffff); vp[SB_VT_STRIDE] = (bf16_t)(w.x >> 16); vp[2 * SB_VT_STRIDE] = (bf16_t)(w.y & 0xffff); vp[3 * SB_VT_STRIDE] = (bf16_t)(w.y >> 16);
                vp[4 * SB_VT_STRIDE] = (bf16_t)(w.z & 0xffff); vp[5 * SB_VT_STRIDE] = (bf16_t)(w.z >> 16); vp[6 * SB_VT_STRIDE] = (bf16_t)(w.w & 0xffff); vp[7 * SB_VT_STRIDE] = (bf16_t)(w.w >> 16);
            }
            f32x16 sa;
#pragma unroll
            for (int r = 0; r < 16; ++r) sa[r] = 0.f;
#pragma unroll
            for (int s = 0; s < 4; ++s) sa = __builtin_amdgcn_mfma_f32_32x32x16_bf16(kf[s], qf[s], sa, 0, 0, 0);
            float lk[16], z[16];
#pragma unroll
            for (int r = 0; r < 16; ++r) {
                const int kk = (r & 3) + 8 * (r >> 2) + 4 * hh; const bool valid = (j0 + kk) < qi;
                const float zz = fminf(sa[r], 80.f); const float l = -__log2f(1.f + exp2f(zz));
                z[r] = zz; lk[r] = valid ? l : 0.f;
            }
            const float gs0 = (lk[0] + lk[1]) + (lk[2] + lk[3]), gs1 = (lk[4] + lk[5]) + (lk[6] + lk[7]), gs2 = (lk[8] + lk[9]) + (lk[10] + lk[11]), gs3 = (lk[12] + lk[13]) + (lk[14] + lk[15]);
            const float ps0 = xpartner32(gs0, hh), ps1 = xpartner32(gs1, hh), ps2 = xpartner32(gs2, hh), ps3 = xpartner32(gs3, hh);
            const float pc3 = ps3, pc2 = pc3 + ps2, pc1 = pc2 + ps1, pc0 = pc1 + ps0;
            float base[4];
            base[3] = L + (hh ? 0.f : pc3);
            base[2] = L + gs3 + (hh ? pc3 : pc2);
            base[1] = L + (gs3 + gs2) + (hh ? pc2 : pc1);
            base[0] = L + (gs3 + gs2 + gs1) + (hh ? pc1 : pc0);
            float a[16];
#pragma unroll
            for (int g = 0; g < 4; ++g) {
                float c = base[g];
#pragma unroll
                for (int e = 3; e >= 0; --e) {
                    const int r = 4 * g + e; c += lk[r];
                    const int kk = e + 8 * g + 4 * hh; const bool valid = (j0 + kk) < qi;
                    a[r] = valid ? exp2f(z[r] + c) : 0.f;
                }
            }
            L += (gs0 + gs1 + gs2 + gs3) + pc0;
            u32x4 pw0, pw1;
            pw0.x = pk2(a[0], a[1]); pw0.y = pk2(a[2], a[3]); pw0.z = pk2(a[4], a[5]); pw0.w = pk2(a[6], a[7]);
            pw1.x = pk2(a[8], a[9]); pw1.y = pk2(a[10], a[11]); pw1.z = pk2(a[12], a[13]); pw1.w = pk2(a[14], a[15]);
            const bf16x8 pf0 = __builtin_bit_cast(bf16x8, pw0), pf1 = __builtin_bit_cast(bf16x8, pw1);
#pragma unroll
            for (int mt = 0; mt < 2; ++mt) {
                const bf16_t* vr = VT + (32 * mt + n) * SB_VT_STRIDE + 4 * hh;
                u32x4 v0, v1;
                { const u32x2 x = *(const u32x2*)(vr), y = *(const u32x2*)(vr + 8); v0.x = x.x; v0.y = x.y; v0.z = y.x; v0.w = y.y; }
                { const u32x2 x = *(const u32x2*)(vr + 16), y = *(const u32x2*)(vr + 24); v1.x = x.x; v1.y = x.y; v1.z = y.x; v1.w = y.y; }
                if (mt == 0) { o0 = __builtin_amdgcn_mfma_f32_32x32x16_bf16(__builtin_bit_cast(bf16x8, v0), pf0, o0, 0, 0, 0); o0 = __builtin_amdgcn_mfma_f32_32x32x16_bf16(__builtin_bit_cast(bf16x8, v1), pf1, o0, 0, 0, 0); }
                else { o1 = __builtin_amdgcn_mfma_f32_32x32x16_bf16(__builtin_bit_cast(bf16x8, v0), pf0, o1, 0, 0, 0); o1 = __builtin_amdgcn_mfma_f32_32x32x16_bf16(__builtin_bit_cast(bf16x8, v1), pf1, o1, 0, 0, 0); }
            }
            const bool done = L < -152.f;
            if (__all(done)) break;
        }
        {
            bf16_t* yp = YA + ((size_t)b * SEQ + (qi - NMETA)) * 512 + h * 64 + 4 * hh;
#pragma unroll
            for (int g = 0; g < 4; ++g) {
                u32x2 w; w.x = pk2(o0[4 * g], o0[4 * g + 1]); w.y = pk2(o0[4 * g + 2], o0[4 * g + 3]); *(u32x2*)(yp + 8 * g) = w;
                w.x = pk2(o1[4 * g], o1[4 * g + 1]); w.y = pk2(o1[4 * g + 2], o1[4 * g + 3]); *(u32x2*)(yp + 32 + 8 * g) = w;
            }
        }
    }
}

constexpr int DSA_NQ = 8;
constexpr int DSA_SCS = 4608;
constexpr int DSA_KVB = 0, DSA_RING = 18432, DSA_IDX = DSA_NQ * DSA_RING, DSA_MISC = DSA_IDX + DSA_NQ * 1024, DSA_LDS = DSA_MISC + 512;
static_assert(DSA_NQ * DSA_SCS * 4 <= DSA_IDX, "score rows fit under the index lists");
__device__ __forceinline__ unsigned fkey(float f) { const unsigned u = __float_as_uint(f); return (u & 0x80000000u) ? ~u : (u | 0x80000000u); }
__device__ __forceinline__ int wave_sum_i32(int v) {
    v += __builtin_amdgcn_update_dpp(0, v, 0xB1, 0xF, 0xF, false);
    v += __builtin_amdgcn_update_dpp(0, v, 0x4E, 0xF, 0xF, false);
    v += __builtin_amdgcn_update_dpp(0, v, 0x141, 0xF, 0xF, false);
    v += __builtin_amdgcn_update_dpp(0, v, 0x140, 0xF, 0xF, false);
    return __builtin_amdgcn_readlane(v, 0) + __builtin_amdgcn_readlane(v, 16) + __builtin_amdgcn_readlane(v, 32) + __builtin_amdgcn_readlane(v, 48);
}
__device__ __forceinline__ int wave_excl_scan_i32(int c, int lane, int& total) {
    int x = c;
    x += __builtin_amdgcn_update_dpp(0, x, 0x111, 0xF, 0xF, true);
    x += __builtin_amdgcn_update_dpp(0, x, 0x112, 0xF, 0xF, true);
    x += __builtin_amdgcn_update_dpp(0, x, 0x114, 0xF, 0xF, true);
    x += __builtin_amdgcn_update_dpp(0, x, 0x118, 0xF, 0xF, true);
    const int t0 = __builtin_amdgcn_readlane(x, 15), t1 = __builtin_amdgcn_readlane(x, 31), t2 = __builtin_amdgcn_readlane(x, 47), t3 = __builtin_amdgcn_readlane(x, 63);
    const int row = lane >> 4;
    x += (row > 0 ? t0 : 0) + (row > 1 ? t1 : 0) + (row > 2 ? t2 : 0);
    total = t0 + t1 + t2 + t3;
    return x - c;
}
__device__ __forceinline__ int mbcnt64(unsigned long long m) { return (int)__builtin_amdgcn_mbcnt_hi((unsigned)(m >> 32), __builtin_amdgcn_mbcnt_lo((unsigned)m, 0u)); }
__device__ __forceinline__ void phase_dsa(const Params& p, char* lds) {
    const bf16_t* P = (const bf16_t*)(p.ws + WS_P); bf16_t* OL = (bf16_t*)(p.ws + WS_OLAT);
    const int tid = threadIdx.x, lane = tid & 63, wave = __builtin_amdgcn_readfirstlane(tid >> 6);
    unsigned* SC = (unsigned*)(lds + DSA_KVB);
    unsigned short* IDX = (unsigned short*)(lds + DSA_IDX);
    int* MISC = (int*)(lds + DSA_MISC);
    const unsigned lds_base = (unsigned)(size_t)lds;
    constexpr int NU = SEQ / DSA_NQ;
    for (int unit = blockIdx.x; unit < BATCH * NU; unit += gridDim.x) {
        const int u8 = NU - 1 - unit / BATCH, b = unit % BATCH, t0 = NMETA + u8 * DSA_NQ;
        const int cid = 1 + (t0 - NMETA) / 64, n = NMETA + 64 * cid;
        const bf16_t* Pb = P + (size_t)b * T * PW;
        const int m = lane & 31, hh = lane >> 5;
        bf16x8 aq[2][4]; float wv[2][16];
#pragma unroll
        for (int rt = 0; rt < 2; ++rt) {
#pragma unroll
            for (int s = 0; s < 4; ++s) aq[rt][s] = *(const bf16x8*)(Pb + (size_t)(t0 + 4 * rt + (m >> 3)) * PW + C_QI + (m & 7) * 64 + 16 * s + 8 * hh);
#pragma unroll
            for (int r = 0; r < 16; ++r) wv[rt][r] = bf2f(Pb[(size_t)(t0 + 4 * rt + (r >> 2)) * PW + C_WI + (r & 3) + 4 * hh]);
        }
        const unsigned char* KIPb = p.ws + WS_KIP + (size_t)b * KIP_BATCH + lane * 16;
        bf16x8 bk[4];
#pragma unroll
        for (int s = 0; s < 4; ++s) bk[s] = *(const bf16x8*)(KIPb + (size_t)wave * 4096 + s * 1024);
        __syncthreads();
        {
            const int ntile = (n + 31) / 32;
            for (int kt = wave; kt < ntile; kt += NWAVES) {
                const int j0 = kt * 32, key = j0 + m;
                bf16x8 bn[4];
                { const int ktn = kt + NWAVES < 129 ? kt + NWAVES : 128;
#pragma unroll
                  for (int s = 0; s < 4; ++s) bn[s] = *(const bf16x8*)(KIPb + (size_t)ktn * 4096 + s * 1024); }
                const bool ok = key < n;
#pragma unroll
                for (int rt = 0; rt < 2; ++rt) {
                    f32x16 acc;
#pragma unroll
                    for (int r = 0; r < 16; ++r) acc[r] = 0.f;
#pragma unroll
                    for (int s = 0; s < 4; ++s) acc = __builtin_amdgcn_mfma_f32_32x32x16_bf16(aq[rt][s], bk[s], acc, 0, 0, 0);
                    float tq[4];
#pragma unroll
                    for (int q = 0; q < 4; ++q) {
#define RELU_(x) __builtin_amdgcn_fmed3f((x), 0.f, 3.0e38f)
                        float s = wv[rt][4 * q] * RELU_(acc[4 * q]); s += wv[rt][4 * q + 1] * RELU_(acc[4 * q + 1]); s += wv[rt][4 * q + 2] * RELU_(acc[4 * q + 2]); s += wv[rt][4 * q + 3] * RELU_(acc[4 * q + 3]);
#undef RELU_
                        tq[q] = xsum32(s);
                    }
                    const float s0 = hh ? tq[2] : tq[0], s1 = hh ? tq[3] : tq[1];
                    SC[(4 * rt + 2 * hh) * DSA_SCS + key] = ok ? fkey(s0) : 0u;
                    SC[(4 * rt + 2 * hh + 1) * DSA_SCS + key] = ok ? fkey(s1) : 0u;
                }
#pragma unroll
                for (int s = 0; s < 4; ++s) bk[s] = bn[s];
            }
        }
        __syncthreads();
        bf16x8 qf[5];
        {
            const int hd_ = lane & 15, g_ = lane >> 4;
#pragma unroll
            for (int ks = 0; ks < 5; ++ks) {
                u32x4 w = (u32x4){0u, 0u, 0u, 0u};
                if (hd_ < 8 && (ks < 4 || g_ < 2)) w = *(const u32x4*)(Pb + (size_t)(t0 + wave) * PW + C_QF + hd_ * QFW + 32 * ks + 8 * g_);
                qf[ks] = __builtin_bit_cast(bf16x8, w);
            }
        }
        {
            unsigned* sc = SC + wave * DSA_SCS;
            unsigned v[65];
#pragma unroll
            for (int i = 0; i < 65; ++i) { const int k = i * 64 + lane; v[i] = (k < n) ? sc[k] : 0u; }
            unsigned prefix = 0u; int cge = n, bit = 31;
            bool exact = false;
            if (n >= 256) {
                for (; bit >= 0 && cge > 512; --bit) {
                    const unsigned cand = prefix | (1u << bit); const int sc_ = (int)(cand ^ 0x80000000u);
                    unsigned b0 = 0u, b1 = 0u, b2 = 0u; int slots = 0;
#pragma unroll
                    for (int gi = 0; gi < 5; ++gi) if (gi * 832 < n) {
#pragma unroll
                        for (int i = 13 * gi; i < 13 * gi + 13; ++i) {
                            const unsigned d = (unsigned)__builtin_elementwise_sub_sat((int)(v[i] ^ 0x80000000u), sc_);
                            if (i % 3 == 0) b0 = __builtin_amdgcn_alignbit(b0, d, 31); else if (i % 3 == 1) b1 = __builtin_amdgcn_alignbit(b1, d, 31); else b2 = __builtin_amdgcn_alignbit(b2, d, 31);
                        }
                        slots += 13 * 64;
                    }
                    const int c = slots - wave_sum_i32(__builtin_popcount(b0) + __builtin_popcount(b1) + __builtin_popcount(b2));
                    if (c >= 256) { prefix = cand; cge = c; if (c == 256) { exact = true; break; } }
                }
            }
            int ngt = n;
            if (n >= 256 && !exact) {
                asm volatile("s_waitcnt lgkmcnt(0)" ::: "memory");
                int cb = 0;
                if (bit >= 0) {
                    const int sp_ = (int)((prefix > 0u ? prefix : 1u) ^ 0x80000000u);
                    unsigned lb0 = 0u, lb1 = 0u, lb2 = 0u;
#pragma unroll
                    for (int i = 0; i < 65; ++i) { const unsigned d = (unsigned)__builtin_elementwise_sub_sat((int)(v[i] ^ 0x80000000u), sp_);
                        if (i < 32) lb0 = __builtin_amdgcn_alignbit(lb0, d, 31); else if (i < 64) lb1 = __builtin_amdgcn_alignbit(lb1, d, 31); else lb2 = d >> 31; }
                    const unsigned tk0 = ~lb0, tk1 = ~lb1, tk2 = (~lb2) & 1u;
                    const int c0 = __builtin_popcount(tk0), c1 = __builtin_popcount(tk1);
                    const int lbase = wave_excl_scan_i32(c0 + c1 + (int)tk2, lane, cb);
#pragma unroll
                    for (int i = 0; i < 65; ++i) {
                        bool tkn; int rk;
                        if (i < 32) { tkn = (tk0 >> (31 - i)) & 1u; rk = i == 0 ? 0 : __builtin_popcount(tk0 >> (32 - i)); }
                        else if (i < 64) { tkn = (tk1 >> (63 - i)) & 1u; rk = c0 + (i == 32 ? 0 : __builtin_popcount(tk1 >> (64 - i))); }
                        else { tkn = tk2 != 0u; rk = c0 + c1; }
                        sc[tkn ? lbase + rk : 4096 + (lane & 15)] = v[i];
                    }
                    asm volatile("s_waitcnt lgkmcnt(0)" ::: "memory");
                    unsigned w[8];
#pragma unroll
                    for (int j = 0; j < 8; ++j) { const int k = j * 64 + lane; w[j] = (k < cb) ? sc[k] : 0u; }
                    for (; bit >= 0; --bit) {
                        const unsigned cand = prefix | (1u << bit); const int sc_ = (int)(cand ^ 0x80000000u); unsigned b0 = 0u, b1 = 0u;
#pragma unroll
                        for (int j = 0; j < 8; ++j) { const unsigned d = (unsigned)__builtin_elementwise_sub_sat((int)(w[j] ^ 0x80000000u), sc_); if (j & 1) b1 = __builtin_amdgcn_alignbit(b1, d, 31); else b0 = __builtin_amdgcn_alignbit(b0, d, 31); }
                        const int c = 512 - wave_sum_i32(__builtin_popcount(b0) + __builtin_popcount(b1));
                        if (c >= 256) { prefix = cand; if (c == 256) { exact = true; break; } }
                    }
                    int c = 0;
#pragma unroll
                    for (int j = 0; j < 8; ++j) c += __popcll(__ballot(w[j] > prefix));
                    ngt = c;
                } else {
                    int c = 0;
#pragma unroll
                    for (int i = 0; i < 65; ++i) { c += __popcll(__ballot(v[i] > prefix)); if ((i & 3) == 3) __builtin_amdgcn_sched_barrier(0); }
                    ngt = c;
                }
            }
            const unsigned tau = prefix;
            const int need_eq = n >= 256 ? 256 - ngt : 0; int base = 0, eqb = 0;
            unsigned short* idx = IDX + wave * 512;
            {
                const int st_ = (int)(tau ^ 0x80000000u); unsigned e0 = 0u, e1 = 0u, e2 = 0u;
#pragma unroll
                for (int i = 0; i < 65; ++i) { const unsigned d = (unsigned)__builtin_elementwise_sub_sat((int)(v[i] ^ 0x80000000u), st_);
                    if (i < 32) e0 = __builtin_amdgcn_alignbit(e0, d, 31); else if (i < 64) e1 = __builtin_amdgcn_alignbit(e1, d, 31); else e2 = d >> 31; }
                const unsigned tk0 = ~e0, tk1 = ~e1, tk2 = (~e2) & 1u;
                const int c0 = __builtin_popcount(tk0), c1 = __builtin_popcount(tk1);
                int nge; const int lbase = wave_excl_scan_i32(c0 + c1 + (int)tk2, lane, nge);
                if (n >= 256 && nge == 256) {
#pragma unroll
                    for (int i = 0; i < 65; ++i) {
                        bool tkn; int rk;
                        if (i < 32) { tkn = (tk0 >> (31 - i)) & 1u; rk = i == 0 ? 0 : __builtin_popcount(tk0 >> (32 - i)); }
                        else if (i < 64) { tkn = (tk1 >> (63 - i)) & 1u; rk = c0 + (i == 32 ? 0 : __builtin_popcount(tk1 >> (64 - i))); }
                        else { tkn = tk2 != 0u; rk = c0 + c1; }
                        idx[tkn ? lbase + rk : 256 + lane] = (unsigned short)(i * 64 + lane);
                    }
                    base = nge;
                } else {
#pragma unroll
                    for (int gi = 0; gi < 5; ++gi) if (gi * 832 < n) {
#pragma unroll
                        for (int i = 13 * gi; i < 13 * gi + 13; ++i) {
                            const int k = i * 64 + lane; const unsigned u = v[i];
                            const bool eq = (u == tau); const unsigned long long meq = __ballot(eq);
                            const bool take = (u > tau) || (eq && (eqb + mbcnt64(meq)) < need_eq);
                            const unsigned long long mt = __ballot(take);
                            idx[take ? base + mbcnt64(mt) : 256 + lane] = (unsigned short)k;
                            base += __popcll(mt); eqb += __popcll(meq);
                            if ((i & 3) == 3) __builtin_amdgcn_sched_barrier(0);
                        }
                    }
                }
            }
            for (int pos = base + lane; pos < 256; pos += 64) idx[pos] = 0;
            if (lane == 0) MISC[wave] = base;
        }
        asm volatile("s_waitcnt lgkmcnt(0)" ::: "memory");
        {
            const int q = wave; const int nsel = MISC[q];
            const size_t qrow = (size_t)(t0 + q);
            int ln = lane; asm volatile("" : "+v"(ln));
            const int hd = ln & 15, g = ln >> 4, qd = (ln & 15) >> 2, pp = ln & 3;
            char* ring = lds + DSA_KVB + wave * DSA_RING;
            const unsigned ring_a = lds_base + DSA_KVB + wave * DSA_RING;
            const unsigned short* idx = IDX + q * 512;
            asm volatile("s_waitcnt vmcnt(0)" ::: "memory");
#define DSA_ISSUE(c) do { _Pragma("unroll") for (int i_ = 0; i_ < 9; ++i_) { const int pid_ = ln + 64 * i_, row_ = pid_ / 18, part_ = pid_ - row_ * 18; \
                const bf16_t* src_ = Pb + (size_t)idx[32 * (c) + row_] * PW + C_KV + part_ * 8; \
                __builtin_amdgcn_global_load_lds((const unsigned*)src_, (LAS unsigned*)(ring + ((c) & 1) * 9216 + i_ * 1024), 16, 0, 0); } } while (0)
            DSA_ISSUE(0); DSA_ISSUE(1);
            f32x4 O[8];
#pragma unroll
            for (int nt = 0; nt < 8; ++nt) O[nt] = (f32x4){0.f, 0.f, 0.f, 0.f};
            float mrun = -3e38f, lrun = 0.f;
            for (int c = 0; c < 8; ++c) {
                if (c < 7) asm volatile("s_waitcnt vmcnt(9)" ::: "memory"); else asm volatile("s_waitcnt vmcnt(0)" ::: "memory");
                const char* buf = ring + (c & 1) * 9216;
                f32x4 S0 = (f32x4){0.f, 0.f, 0.f, 0.f}, S1 = S0;
                {
                    const char* kr = buf + hd * 288 + 16 * g;
#pragma unroll
                    for (int ks = 0; ks < 4; ++ks) { S0 = __builtin_amdgcn_mfma_f32_16x16x32_bf16(*(const bf16x8*)(kr + 64 * ks), qf[ks], S0, 0, 0, 0); S1 = __builtin_amdgcn_mfma_f32_16x16x32_bf16(*(const bf16x8*)(kr + 16 * 288 + 64 * ks), qf[ks], S1, 0, 0, 0); }
                    u32x4 w0 = (u32x4){0u, 0u, 0u, 0u}, w1 = w0; if (g < 2) { w0 = *(const u32x4*)(kr + 256); w1 = *(const u32x4*)(kr + 16 * 288 + 256); }
                    S0 = __builtin_amdgcn_mfma_f32_16x16x32_bf16(__builtin_bit_cast(bf16x8, w0), qf[4], S0, 0, 0, 0); S1 = __builtin_amdgcn_mfma_f32_16x16x32_bf16(__builtin_bit_cast(bf16x8, w1), qf[4], S1, 0, 0, 0);
                }
                float cm = -3e38f;
#pragma unroll
                for (int r = 0; r < 4; ++r) { if (nsel < 256) { const int sl = 32 * c + 4 * g + r; S0[r] = sl < nsel ? S0[r] : -1e30f; S1[r] = (sl + 16) < nsel ? S1[r] : -1e30f; } cm = fmaxf(cm, fmaxf(S0[r], S1[r])); }
                cm = xmax16(xmax32(cm));
                if (__any(cm > mrun + 6.f)) {
                    const float mnew = fmaxf(mrun, cm), alpha = exp2f(mrun - mnew);
                    lrun *= alpha; mrun = mnew;
                    const float a0 = __shfl(alpha, 4 * g), a1 = __shfl(alpha, 4 * g + 1), a2 = __shfl(alpha, 4 * g + 2), a3 = __shfl(alpha, 4 * g + 3);
#pragma unroll
                    for (int nt = 0; nt < 8; ++nt) { O[nt][0] *= a0; O[nt][1] *= a1; O[nt][2] *= a2; O[nt][3] *= a3; }
                }
                float ps = 0.f;
#pragma unroll
                for (int r = 0; r < 4; ++r) { S0[r] = exp2f(S0[r] - mrun); S1[r] = exp2f(S1[r] - mrun); ps += S0[r] + S1[r]; }
                ps = xsum16(xsum32(ps));
                lrun += ps;
                u32x4 pw; pw.x = pk2(S0[0], S0[1]); pw.y = pk2(S0[2], S0[3]); pw.z = pk2(S1[0], S1[1]); pw.w = pk2(S1[2], S1[3]);
                const bf16x8 pf = __builtin_bit_cast(bf16x8, pw);
                const unsigned va = ring_a + (unsigned)((c & 1) * 9216 + (4 * g + qd) * 288 + 8 * pp);
#pragma unroll
                for (int h2 = 0; h2 < 2; ++h2) {
                    u16x4 x0, x1, x2, x3, y0, y1, y2, y3;
                    asm volatile("ds_read_b64_tr_b16 %0, %8 offset:%9\n\tds_read_b64_tr_b16 %1, %8 offset:%10\n\tds_read_b64_tr_b16 %2, %8 offset:%11\n\tds_read_b64_tr_b16 %3, %8 offset:%12\n\t"
                                 "ds_read_b64_tr_b16 %4, %8 offset:%13\n\tds_read_b64_tr_b16 %5, %8 offset:%14\n\tds_read_b64_tr_b16 %6, %8 offset:%15\n\tds_read_b64_tr_b16 %7, %8 offset:%16\n\ts_waitcnt lgkmcnt(0)"
                                 : "=&v"(x0), "=&v"(x1), "=&v"(x2), "=&v"(x3), "=&v"(y0), "=&v"(y1), "=&v"(y2), "=&v"(y3)
                                 : "v"(va), "i"(128 * h2), "i"(128 * h2 + 32), "i"(128 * h2 + 64), "i"(128 * h2 + 96), "i"(128 * h2 + 4608), "i"(128 * h2 + 4640), "i"(128 * h2 + 4672), "i"(128 * h2 + 4704) : "memory");
#define DSA_PV(nt_, x_, y_) do { bf16x8 vf_; vf_[0] = (short)x_[0]; vf_[1] = (short)x_[1]; vf_[2] = (short)x_[2]; vf_[3] = (short)x_[3]; vf_[4] = (short)y_[0]; vf_[5] = (short)y_[1]; vf_[6] = (short)y_[2]; vf_[7] = (short)y_[3]; \
                    O[nt_] = __builtin_amdgcn_mfma_f32_16x16x32_bf16(pf, vf_, O[nt_], 0, 0, 0); } while (0)
                    DSA_PV(4 * h2 + 0, x0, y0); DSA_PV(4 * h2 + 1, x1, y1); DSA_PV(4 * h2 + 2, x2, y2); DSA_PV(4 * h2 + 3, x3, y3);
                }
                asm volatile("s_waitcnt lgkmcnt(0)" ::: "memory");
                if (c + 2 < 8) DSA_ISSUE(c + 2);
            }
#undef DSA_PV
#undef DSA_ISSUE
            const float inv = 1.f / lrun;
            const float i0 = __shfl(inv, 4 * g), i1 = __shfl(inv, 4 * g + 1), i2 = __shfl(inv, 4 * g + 2), i3 = __shfl(inv, 4 * g + 3);
            if (g < 2) {
                bf16_t* op = OL + ((size_t)b * SEQ + (qrow - NMETA)) * 1024 + (4 * g) * 128 + hd;
#pragma unroll
                for (int nt = 0; nt < 8; ++nt) { op[16 * nt] = (bf16_t)f2bf(O[nt][0] * i0); op[128 + 16 * nt] = (bf16_t)f2bf(O[nt][1] * i1); op[256 + 16 * nt] = (bf16_t)f2bf(O[nt][2] * i2); op[384 + 16 * nt] = (bf16_t)f2bf(O[nt][3] * i3); }
            }
        }
    }
}

__device__ __forceinline__ void phase_inproj_meta(const Params& p) {
    unsigned char* ws = p.ws; const int tid = threadIdx.x, lane = tid & 63, wave = tid >> 6, fr = lane & 15, fq = lane >> 4;
    const bf16_t* U = (const bf16_t*)(ws + WS_U); const bf16_t* WP = (const bf16_t*)(ws + WS_WP); bf16_t* P = (bf16_t*)(ws + WS_P); const float2* cs = (const float2*)(ws + WS_CS);
    const int gw = blockIdx.x * NWAVES + wave, NGW = gridDim.x * NWAVES;
    for (int nt = gw; nt < PW / 16; nt += NGW) {
        const bf16_t* ap = U + (size_t)fr * D + 8 * fq; const bf16_t* bp = WP + (size_t)(16 * nt + fr) * D + 8 * fq;
        f32x4 acc = (f32x4){0.f, 0.f, 0.f, 0.f};
#pragma unroll 8
        for (int ks = 0; ks < D / 32; ++ks) acc = __builtin_amdgcn_mfma_f32_16x16x32_bf16(*(const bf16x8*)(bp + 32 * ks), *(const bf16x8*)(ap + 32 * ks), acc, 0, 0, 0);
        const int col = 16 * nt + 4 * fq, t = fr; f32x4 v = acc; int o;
        if (pg8::rope_off(col, o)) { const float2 c0 = cs[t * 8 + (o >> 1)], c1 = cs[t * 8 + (o >> 1) + 1]; v = (f32x4){v.x * c0.x - v.y * c0.y, v.y * c0.x + v.x * c0.y, v.z * c1.x - v.w * c1.y, v.w * c1.x + v.z * c1.y}; }
        u32x2 w; w.x = pk2(v.x, v.y); w.y = pk2(v.z, v.w);
        for (int b = 0; b < BATCH; ++b) {
            if (col >= C_KI && col < C_WI) { const int d0 = col - C_KI;
                *(u32x2*)(ws + WS_KIP + (size_t)b * KIP_BATCH + (size_t)((((t >> 5) * 4 + (d0 >> 4)) * 2 + ((d0 >> 3) & 1)) * 512 + (t & 31) * 16 + (d0 & 7) * 2)) = w; }
            else *(u32x2*)(P + ((size_t)b * T + t) * PW + col) = w;
        }
    }
}

__device__ __forceinline__ void phase_c3(const Params& p, char* lds) {
    unsigned char* ws = p.ws; const int tid = threadIdx.x, lane = tid & 63, wave = __builtin_amdgcn_readfirstlane(tid >> 6);
    const float* H1 = (const float*)(ws + WS_H1); const float* g = p.in[I_GFFN];
    {
        bf16_t* U2 = (bf16_t*)(ws + WS_U); const int gw = blockIdx.x * NWAVES + wave, NGW = gridDim.x * NWAVES;
        for (int row = gw; row < NR; row += NGW) {
            const f32x4* xr = (const f32x4*)(H1 + (size_t)row * D) + lane;
            f32x4 v[4]; float s = 0.f;
#pragma unroll
            for (int j = 0; j < 4; ++j) { v[j] = xr[64 * j]; s += (v[j].x * v[j].x + v[j].y * v[j].y) + (v[j].z * v[j].z + v[j].w * v[j].w); }
            const float rstd = rsqrtf(wave_sum(s) * (1.f / D) + NORM_EPS);
            u32x2* o = (u32x2*)(U2 + (size_t)row * D) + lane;
#pragma unroll
            for (int j = 0; j < 4; ++j) { const f32x4 gg = ((const f32x4*)g)[lane + 64 * j];
                u32x2 w; w.x = pk2(v[j].x * rstd * gg.x, v[j].y * rstd * gg.y); w.y = pk2(v[j].z * rstd * gg.z, v[j].w * rstd * gg.w); o[64 * j] = w; }
        }
    }
    {
        float* Tl = (float*)lds;
        float* RED = (float*)lds;
        const float* wg = p.in[I_WGRP]; const float* wr = p.in[I_WRT]; const float* bg = p.in[I_BGRP]; const float* br = p.in[I_BRT];
        unsigned* ctl = (unsigned*)(ws + WS_CTL); int* LIST = (int*)(ws + WS_LIST); float* GATE = (float*)(ws + WS_GATE);
        const int tk = tid & 127, kq = wave >> 1;
        for (int grp = blockIdx.x; grp < NR / 128; grp += gridDim.x) {
            const int tok0 = grp * 128;
            float acc[36]; float ss = 0.f;
#pragma unroll
            for (int o = 0; o < 36; ++o) acc[o] = 0.f;
            for (int step = 0; step < 8; ++step) {
                __syncthreads();
#pragma unroll
                for (int i = 0; i < 8; ++i) { const int idx = tid + NTHREADS * i, qq = idx >> 10, rem = idx & 1023, t2 = rem >> 3, kc = rem & 7;
                    const f32x4 v = *(const f32x4*)(H1 + (size_t)(tok0 + t2) * D + qq * 256 + step * 32 + kc * 4);
                    float* d = Tl + qq * (32 * 129) + (kc * 4) * 129 + t2; d[0] = v.x; d[129] = v.y; d[258] = v.z; d[387] = v.w; }
                __syncthreads();
                const int kb = kq * 256 + step * 32;
#pragma unroll 4
                for (int k = 0; k < 32; ++k) {
                    const float h = Tl[kq * (32 * 129) + k * 129 + tk]; ss += h * h; const float hg = h * g[kb + k];
                    const float* w4 = wg + (size_t)(kb + k) * 4; const float* w32 = wr + (size_t)(kb + k) * 32;
#pragma unroll
                    for (int o = 0; o < 4; ++o) acc[o] += hg * w4[o];
#pragma unroll
                    for (int o = 0; o < 32; ++o) acc[4 + o] += hg * w32[o];
                }
            }
            __syncthreads();
#pragma unroll
            for (int o = 0; o < 36; ++o) RED[(kq * 37 + o) * 128 + tk] = acc[o];
            RED[(kq * 37 + 36) * 128 + tk] = ss;
            __syncthreads();
            if (tid < 128) {
                const int tok = tok0 + tk;
#pragma unroll
                for (int o = 0; o < 36; ++o) acc[o] = (RED[o * 128 + tk] + RED[(37 + o) * 128 + tk]) + (RED[(74 + o) * 128 + tk] + RED[(111 + o) * 128 + tk]);
                ss = (RED[36 * 128 + tk] + RED[(37 + 36) * 128 + tk]) + (RED[(74 + 36) * 128 + tk] + RED[(111 + 36) * 128 + tk]);
                const float rstd = rsqrtf(ss * (1.f / D) + NORM_EPS);
                float gl[4]; int gs = 0; float gm;
#pragma unroll
                for (int o = 0; o < 4; ++o) gl[o] = acc[o] * rstd + bg[o];
                gm = gl[0];
#pragma unroll
                for (int o = 1; o < 4; ++o) if (gl[o] > gm) { gm = gl[o]; gs = o; }
                float gsum = 0.f;
#pragma unroll
                for (int o = 0; o < 4; ++o) gsum += __expf(gl[o] - gm);
                const float pgrp = 1.f / gsum;
                float el[8];
#pragma unroll
                for (int j = 0; j < 8; ++j) { float a = acc[4 + j]; float bb = br[j];
                    a = gs == 1 ? acc[12 + j] : a; bb = gs == 1 ? br[8 + j] : bb; a = gs == 2 ? acc[20 + j] : a; bb = gs == 2 ? br[16 + j] : bb; a = gs == 3 ? acc[28 + j] : a; bb = gs == 3 ? br[24 + j] : bb;
                    el[j] = a * rstd + bb; }
                int e0 = 0; float m0 = el[0];
#pragma unroll
                for (int j = 1; j < 8; ++j) if (el[j] > m0) { m0 = el[j]; e0 = j; }
                int e1 = -1; float m1 = -3e38f;
#pragma unroll
                for (int j = 0; j < 8; ++j) if (j != e0 && el[j] > m1) { m1 = el[j]; e1 = j; }
                const float x1 = __expf(m1 - m0); const float g0 = pgrp / (1.f + x1), g1 = pgrp * x1 / (1.f + x1);
                const int ex0 = gs * 8 + e0, ex1 = gs * 8 + e1;
                const int s0 = (int)atomicAdd(ctl + CW_CNT + 64 * ex0, 1u); LIST[(size_t)ex0 * NR + s0] = tok * 2;
                const int s1 = (int)atomicAdd(ctl + CW_CNT + 64 * ex1, 1u); LIST[(size_t)ex1 * NR + s1] = tok * 2 + 1;
                GATE[tok * 2] = g0; GATE[tok * 2 + 1] = g1;
            }
        }
    }
}

template <int WHICH>
__device__ __forceinline__ void phase_moe(const Params& p, char* lds) {
    unsigned char* ws = p.ws; const int tid = threadIdx.x;
    const unsigned* ctl = (const unsigned*)(ws + WS_CTL);
    int* TP = (int*)(lds + pg8::STAGE_BYTES);
    __syncthreads();
    if (tid == 0) { int tp = 0, ro = 0; for (int e = 0; e < NEXP; ++e) { const int c = (int)ctl[CW_CNT + 64 * e]; TP[e] = tp; TP[64 + e] = ro; TP[128 + e] = c; const int t = (c + 255) / 256; tp += t * 4; ro += t * 256; } TP[NEXP] = tp; }
    __syncthreads();
    pg8::MoeOrder<WHICH> S{TP, (int)gridDim.x, (int)blockIdx.x, (const char*)(ws + (WHICH == 0 ? WS_U : WS_HID)), (const char*)(ws + (WHICH == 0 ? WS_W13 : WS_W2)), (const int*)(ws + WS_LIST)};
    if constexpr (WHICH == 0) { pg8::EpiMoe1 E{(bf16_t*)(ws + WS_HID), TP}; pg8::gemm_phase_x<pg8::EpiMoe1, pg8::MoeOrder<0>, true, true>((LAS unsigned char*)lds, 1024, S, E); }
    else { pg8::EpiMoe2 E{(bf16_t*)(ws + WS_MO), TP, (const int*)(ws + WS_LIST), (const float*)(ws + WS_GATE)}; pg8::gemm_phase_x<pg8::EpiMoe2, pg8::MoeOrder<1>, true, true>((LAS unsigned char*)lds, 512, S, E); }
}

__device__ __forceinline__ void phase_final(const Params& p) {
    unsigned char* ws = p.ws; const int tid = threadIdx.x, lane = tid & 63, wave = tid >> 6;
    const float* H1 = (const float*)(ws + WS_H1); const bf16_t* MO = (const bf16_t*)(ws + WS_MO); const float* g = p.in[I_GFIN];
    const int gw = blockIdx.x * NWAVES + wave, NGW = gridDim.x * NWAVES;
    for (int orow = gw; orow < BATCH * SEQ; orow += NGW) {
        const size_t row = (size_t)orow;
        const f32x4* xr = (const f32x4*)(H1 + row * D) + lane; const u32x2* m0 = (const u32x2*)(MO + row * 2 * D) + lane; const u32x2* m1 = m0 + 256;
        f32x4 v[4]; float ss = 0.f;
#pragma unroll
        for (int j = 0; j < 4; ++j) { const u32x2 a = m0[64 * j], c = m1[64 * j]; v[j] = xr[64 * j];
            v[j].x += bflo(a.x) + bflo(c.x); v[j].y += bfhi(a.x) + bfhi(c.x); v[j].z += bflo(a.y) + bflo(c.y); v[j].w += bfhi(a.y) + bfhi(c.y);
            ss += (v[j].x * v[j].x + v[j].y * v[j].y) + (v[j].z * v[j].z + v[j].w * v[j].w); }
        const float rstd = rsqrtf(wave_sum(ss) * (1.f / D) + NORM_EPS);
        f32x4* o = (f32x4*)(p.out + (size_t)orow * D) + lane;
#pragma unroll
        for (int j = 0; j < 4; ++j) { const f32x4 gg = ((const f32x4*)g)[lane + 64 * j]; o[64 * j] = v[j] * rstd * gg; }
    }
}

#define XB_TMO      128
#define XB_XCNT(j)  (256  + 64 * (j))
#define XB_XSUB(j)  (1280 + 64 * (j))
#define XB_XGEN(j)  (2304 + 64 * (j))
#define XB_TOP      3328
#define XB_TOPGEN   3392
#define XCD_BAR_WORDS 3456
#define XB_SPIN_CAP (1u << 18)
__device__ __forceinline__ unsigned xb_ld(unsigned* p)              { return __hip_atomic_load(p, __ATOMIC_RELAXED, __HIP_MEMORY_SCOPE_AGENT); }
__device__ __forceinline__ unsigned xb_add(unsigned* p, unsigned v) { return __hip_atomic_fetch_add(p, v, __ATOMIC_RELAXED, __HIP_MEMORY_SCOPE_AGENT); }
__device__ __forceinline__ unsigned xb_xcc_id() { return (unsigned)__builtin_amdgcn_s_getreg((3 << 11) | 20) & 0xFu; }
#define XB_SPIN(cond, bar) do { unsigned _sp = 0; while (cond) { __builtin_amdgcn_s_sleep(1); \
    if ((++_sp & 255u) == 0u) { if (xb_ld(&(bar)[XB_TMO])) break; if (_sp > XB_SPIN_CAP) { atomicAdd(&(bar)[XB_TMO], 1u); break; } } } } while (0)
struct XcdBarrier { unsigned* bar; unsigned x; volatile LAS unsigned* st; };
__device__ __forceinline__ XcdBarrier xcd_barrier_post(unsigned* bar, volatile LAS unsigned* st) {
    XcdBarrier b; b.bar = bar; b.x = xb_xcc_id(); b.st = st;
    if (threadIdx.x == 0) (void)xb_add(&bar[XB_XCNT(b.x)], 1u);
    return b;
}
__device__ __forceinline__ void xcd_barrier_complete(unsigned* bar, unsigned x, unsigned& nloc, unsigned& nx) {
    const unsigned G = gridDim.x * gridDim.y * gridDim.z;
    unsigned sum, cnt, mine, sp = 0u;
    for (;;) {
        sum = 0u; cnt = 0u; mine = 0u;
#pragma unroll
        for (unsigned j = 0; j < 16; ++j) { const unsigned c = xb_ld(&bar[XB_XCNT(j)]); sum += c; cnt += (c > 0u) ? 1u : 0u; mine = (j == x) ? c : mine; }
        if (sum == G) break;
        __builtin_amdgcn_s_sleep(1);
        if ((++sp & 255u) == 0u) { if (xb_ld(&bar[XB_TMO])) break; if (sp > XB_SPIN_CAP) { atomicAdd(&bar[XB_TMO], 1u); break; } }
    }
    nloc = mine > 0u ? mine : 1u; nx = cnt > 0u ? cnt : 1u;
}
__device__ __forceinline__ void xcd_barrier(const XcdBarrier& b) {
    asm volatile("s_waitcnt vmcnt(0)" ::: "memory");
    __syncthreads();
    if (threadIdx.x == 0) {
        unsigned* bar = b.bar;
        __builtin_amdgcn_s_waitcnt(0);
        unsigned nloc = b.st[0], nx = b.st[1];
        if (nloc == 0u) { xcd_barrier_complete(bar, b.x, nloc, nx); b.st[0] = nloc; b.st[1] = nx; }
        const unsigned old = xb_add(&bar[XB_XSUB(b.x)], 1u);
        const unsigned gen = old / nloc;
        if (old + 1u == (gen + 1u) * nloc) {
            __builtin_amdgcn_fence(__ATOMIC_RELEASE, "agent");
            asm volatile("s_waitcnt vmcnt(0)" ::: "memory");
            const unsigned og = xb_add(&bar[XB_TOP], 1u);
            const unsigned tg = og / nx;
            if (og + 1u == (tg + 1u) * nx) xb_add(&bar[XB_TOPGEN], 1u);
            else XB_SPIN(xb_ld(&bar[XB_TOPGEN]) == tg, bar);
            __builtin_amdgcn_fence(__ATOMIC_ACQUIRE, "agent");
            xb_add(&bar[XB_XGEN(b.x)], 1u);
            asm volatile("s_waitcnt vmcnt(0)" ::: "memory");
        } else {
            XB_SPIN(xb_ld(&bar[XB_XGEN(b.x)]) == gen, bar);
            __builtin_amdgcn_fence(__ATOMIC_ACQUIRE, "agent");
            asm volatile("s_waitcnt vmcnt(0)" ::: "memory");
        }
    }
    __syncthreads();
}

constexpr int LDS_XB = DSA_LDS;
constexpr int LDS_BYTES = DSA_LDS + 256;
static_assert(pg8::STAGE_BYTES <= LDS_XB && pg8::STAGE_BYTES + 1024 <= LDS_XB && NWAVES * 64 * 33 * 4 <= LDS_XB && NWAVES * 64 * SB_VT_STRIDE * 2 <= LDS_XB && 4 * 37 * 128 * 4 <= LDS_XB, "LDS map");

__global__ void __launch_bounds__(NTHREADS, 2) mega(Params p) {
    extern __shared__ __attribute__((aligned(16))) char lds[];
    const int lo = p.ph_lo, hi = p.ph_hi;
    unsigned char* ws = p.ws;
    XcdBarrier xb;
    {
        volatile LAS unsigned* st = (volatile LAS unsigned*)(lds + LDS_XB);
        if (threadIdx.x < 4) st[threadIdx.x] = 0u;
        __syncthreads();
        xb = xcd_barrier_post((unsigned*)(ws + WS_CTL) + CW_BAR, st);
    }
#define IN(k) (lo <= (k) && (k) < hi)
#define GSYNC() xcd_barrier(xb)
#define SEAM(k) do { if (IN(k) && IN((k) + 1)) GSYNC(); } while (0)
#define REP(k, ...) do { if (IN(k)) { __VA_ARGS__; } } while (0)
    LAS unsigned char* ldsl = (LAS unsigned char*)lds;
    REP(0, phase_prologue(p, lds));
    SEAM(0);
    REP(1, { phase_inproj_meta(p);
             pg8::TokRowOrder S; S.init(NR, PWN, gridDim.x, blockIdx.x); S.Abase = (const char*)(ws + WS_U); S.Bbase = (const char*)(ws + WS_WP); S.K = D;
             pg8::EpiInproj E{(bf16_t*)(ws + WS_P), (const float2*)(ws + WS_CS), ws + WS_KIP}; pg8::gemm_phase_x<pg8::EpiInproj, pg8::TokRowOrder, true, true>(ldsl, D, S, E); });
    SEAM(1);
    if (IN(2)) {
        phase_dsa(p, lds);
        __syncthreads(); phase_sb_fast(p, lds);
    }
    SEAM(2);
    REP(3, { pg8::TokRowOrder S; S.init(NR, 2048, gridDim.x, blockIdx.x); S.Abase = (const char*)(ws + WS_U); S.Bbase = (const char*)(ws + WS_WG); S.K = D;
             pg8::EpiGate E{(bf16_t*)(ws + WS_G)}; pg8::gemm_phase_x<pg8::EpiGate, pg8::TokRowOrder, true, true>(ldsl, D, S, E); });
    SEAM(3);
    REP(4, { { pg8::Gemm g{(const bf16_t*)(ws + WS_YA), (const bf16_t*)(ws + WS_WUA), NR, D, 512}; pg8::StaticOrder S; S.init(NR, D, gridDim.x, blockIdx.x);
               pg8::EpiZ<false> E{(bf16_t*)(ws + WS_Z), (const bf16_t*)(ws + WS_G), 0}; pg8::gemm_phase<pg8::EpiZ<false>, pg8::StaticOrder, true, true>(ldsl, g, S, E); }
             asm volatile("s_waitcnt vmcnt(0)" ::: "memory"); __syncthreads();
             { pg8::Gemm g{(const bf16_t*)(ws + WS_OLAT), (const bf16_t*)(ws + WS_WBP), NR, D, D}; pg8::StaticOrder S; S.init(NR, D, gridDim.x, blockIdx.x);
               pg8::EpiZ<true> E{(bf16_t*)(ws + WS_Z), (const bf16_t*)(ws + WS_G), 1024}; pg8::gemm_phase<pg8::EpiZ<true>, pg8::StaticOrder, true, true>(ldsl, g, S, E); } });
    SEAM(4);
    REP(5, { pg8::Gemm g{(const bf16_t*)(ws + WS_Z), (const bf16_t*)(ws + WS_WO), NR, D, D}; pg8::StaticOrder S; S.init(NR, D, gridDim.x, blockIdx.x);
             pg8::EpiH1 E{(float*)(ws + WS_H1), p.in[I_META], p.in[I_X]}; pg8::gemm_phase<pg8::EpiH1, pg8::StaticOrder, true, true>(ldsl, g, S, E); });
    SEAM(5);
    if (IN(6)) phase_c3(p, lds);
    SEAM(6);
    REP(7, phase_moe<0>(p, lds));
    SEAM(7);
    REP(8, phase_moe<1>(p, lds));
    SEAM(8);
    REP(9, phase_final(p));
}

extern "C" void kernel_launch(void* const* d_in, const int* in_sizes, int n_in, void* d_out, int out_size, void* d_ws, size_t ws_size, hipStream_t stream) {
    if (n_in != 18 || ws_size < WS_END) { fprintf(stderr, "kernel_launch: unexpected n_in %d / ws_size %zu\n", n_in, ws_size); return; }
    static int grid = 0;
    if (grid == 0) {
        int dev = 0, cus = 0, per_cu = 0;
        (void)hipGetDevice(&dev);
        (void)hipDeviceGetAttribute(&cus, hipDeviceAttributeMultiprocessorCount, dev);
        (void)hipFuncSetAttribute((const void*)mega, hipFuncAttributeMaxDynamicSharedMemorySize, LDS_BYTES);
        (void)hipOccupancyMaxActiveBlocksPerMultiprocessor(&per_cu, (const void*)mega, NTHREADS, LDS_BYTES);
        if (per_cu < 1) fprintf(stderr, "kernel_launch: occupancy query reports %d workgroups per CU\n", per_cu);
        grid = cus;
    }
    (void)hipMemsetAsync((char*)d_ws + WS_CTL, 0, CTL_BYTES, stream);
    Params p{};
    for (int i = 0; i < 18; ++i) p.in[i] = (const float*)d_in[i];
    p.out = (float*)d_out; p.ws = (unsigned char*)d_ws;
    p.ph_lo = 0; p.ph_hi = 10;
    void* args[] = {&p};
    hipError_t e = hipLaunchCooperativeKernel((const void*)mega, dim3(grid), dim3(NTHREADS), args, LDS_BYTES, stream);
    if (e != hipSuccess) fprintf(stderr, "cooperative launch failed: %s (grid %d)\n", hipGetErrorString(e), grid);
}
```

```cpp
#include <hip/hip_runtime.h>
#include <cstdio>
#include <cstdint>

constexpr int BATCH = 8, SEQ = 4096, NMETA = 16, T = SEQ + NMETA, D = 1024, NTOK = BATCH * T;
constexpr int MROWS = 33024;
constexpr int NR = BATCH * SEQ;
__device__ __forceinline__ int tokrow(int cr) { return cr + NMETA * (cr / SEQ + 1); }
constexpr int INW = 4824;
constexpr int NEXP = 32, DEXP = 512;
constexpr int NWAVES = 8, NTHREADS = 512;
constexpr float NORM_EPS = 1e-6f;
constexpr float LOG2E = 1.4426950408889634f;
constexpr float QSCALE = 0.125f * LOG2E;
constexpr int PW = 3456, PWN = 3584;
constexpr int C_QA = 0, C_KA = 512, C_VA = 1024, C_QF = 1536, C_KV = 2688, C_QI = 2832, C_KI = 3344, C_WI = 3408, C_END = 3416;
constexpr int QFW = 144;

constexpr size_t MiB = 1u << 20;
constexpr size_t WS_CTL = 0, CTL_BYTES = 1 * MiB;
constexpr size_t WS_CS = 1 * MiB;
constexpr size_t WS_WP = 2 * MiB;
constexpr size_t WS_WG = 9 * MiB;
constexpr size_t WS_WUA = 13 * MiB, WS_WBP = 14 * MiB, WS_WO = 16 * MiB;
constexpr size_t WS_W2 = 18 * MiB;
constexpr size_t WS_W13 = 50 * MiB;
constexpr size_t WS_U = 114 * MiB;
constexpr size_t WS_P = 179 * MiB;
constexpr size_t WS_Z = 179 * MiB;
constexpr size_t WS_G = 244 * MiB;
constexpr size_t WS_H1 = 244 * MiB;
constexpr size_t WS_LIST = 374 * MiB;
constexpr size_t WS_GATE = 379 * MiB;
constexpr size_t WS_YA = 397 * MiB;
constexpr size_t WS_OLAT = 430 * MiB;
constexpr size_t WS_HID = 397 * MiB;
constexpr size_t WS_MO = 50 * MiB;
constexpr size_t WS_KIP = 495 * MiB;
constexpr size_t KIP_BATCH = 129 * 4096;
constexpr size_t WS_END = 500 * MiB;
static_assert(WS_P + (size_t)MROWS * PW * 2 <= WS_YA && WS_G + (size_t)MROWS * 2048 * 2 <= WS_LIST && WS_Z + (size_t)MROWS * 1024 * 2 <= WS_G, "ws map");
static_assert(WS_OLAT + (size_t)MROWS * 1024 * 2 <= WS_END && WS_U + (size_t)MROWS * 1024 * 2 <= WS_P && WS_MO + (size_t)NTOK * 2048 * 2 <= WS_P, "ws map");
constexpr int CW_CNT = 1024;
constexpr int CW_BAR = 4096;

typedef unsigned short bf16_t;
typedef short bf16x8 __attribute__((ext_vector_type(8)));
typedef float f32x4 __attribute__((ext_vector_type(4)));
typedef float f32x16 __attribute__((ext_vector_type(16)));
typedef unsigned u32x2 __attribute__((ext_vector_type(2)));
typedef unsigned u32x4 __attribute__((ext_vector_type(4)));
typedef unsigned short u16x4 __attribute__((ext_vector_type(4)));
#define LAS __attribute__((address_space(3)))

__device__ __forceinline__ unsigned f2bf(float f) { unsigned u = __float_as_uint(f); return (u + 0x7fffu + ((u >> 16) & 1u)) >> 16; }
typedef __bf16 bf16v2_t __attribute__((ext_vector_type(2)));
typedef float f32v2_t __attribute__((ext_vector_type(2)));
__device__ __forceinline__ unsigned pk2(float lo, float hi) { const f32v2_t v = {lo, hi}; const bf16v2_t r = __builtin_convertvector(v, bf16v2_t); return __builtin_bit_cast(unsigned, r); }
__device__ __forceinline__ float bflo(unsigned w) { return __uint_as_float(w << 16); }
__device__ __forceinline__ float bfhi(unsigned w) { return __uint_as_float(w & 0xffff0000u); }
__device__ __forceinline__ float bf2f(bf16_t b) { return __uint_as_float((unsigned)b << 16); }
__device__ __forceinline__ float wave_sum(float v) {
#pragma unroll
    for (int o = 1; o < 64; o <<= 1) v += __shfl_xor(v, o);
    return v;
}
__device__ __forceinline__ float xsum32(float x) { const auto r = __builtin_amdgcn_permlane32_swap(__float_as_uint(x), __float_as_uint(x), false, false); return __uint_as_float(r[0]) + __uint_as_float(r[1]); }
__device__ __forceinline__ float xsum16(float x) { const auto r = __builtin_amdgcn_permlane16_swap(__float_as_uint(x), __float_as_uint(x), false, false); return __uint_as_float(r[0]) + __uint_as_float(r[1]); }
__device__ __forceinline__ float xmax32(float x) { const auto r = __builtin_amdgcn_permlane32_swap(__float_as_uint(x), __float_as_uint(x), false, false); return fmaxf(__uint_as_float(r[0]), __uint_as_float(r[1])); }
__device__ __forceinline__ float xmax16(float x) { const auto r = __builtin_amdgcn_permlane16_swap(__float_as_uint(x), __float_as_uint(x), false, false); return fmaxf(__uint_as_float(r[0]), __uint_as_float(r[1])); }
__device__ __forceinline__ float xpartner32(float x, int hh) { const auto r = __builtin_amdgcn_permlane32_swap(__float_as_uint(x), __float_as_uint(x), false, false); return __uint_as_float(hh ? r[0] : r[1]); }
__device__ __forceinline__ float sigmoidf(float x) { return 1.0f / (1.0f + __expf(-x)); }

struct Params {
    const float* in[18];
    float* out;
    unsigned char* ws;
    int ph_lo, ph_hi;
};
enum { I_X = 0, I_META, I_GMIX, I_WIN, I_WUK, I_WUV, I_WUPA, I_WUPB, I_WO, I_GFFN, I_WGRP, I_BGRP, I_WRT, I_BRT, I_W1, I_W3, I_W2, I_GFIN };

__device__ __forceinline__ const float* h0_row(const Params& p, int row) {
    const int b = row / T, t = row - b * T;
    return t < NMETA ? p.in[I_META] + (size_t)t * D : p.in[I_X] + ((size_t)b * SEQ + (t - NMETA)) * D;
}
template <class F>
__device__ __forceinline__ void tr_item(F val, bf16_t* dst, int ldd, int row0, int k0, float* scr, int lane, int rstep = 1) {
    float tv[32];
#pragma unroll
    for (int i = 0; i < 32; ++i) tv[i] = val(k0 + 2 * i + (lane >> 5), lane & 31);
#pragma unroll
    for (int i = 0; i < 32; ++i) scr[(2 * i + (lane >> 5)) * 33 + (lane & 31)] = tv[i];
    __builtin_amdgcn_s_waitcnt(0xC07F);
    asm volatile("" ::: "memory");
    const int c = lane & 7;
#pragma unroll
    for (int j = 0; j < 4; ++j) {
        const int n = (lane >> 3) + 8 * j; const float* s = scr + (8 * c) * 33 + n;
        u32x4 o; o.x = pk2(s[0], s[33]); o.y = pk2(s[66], s[99]); o.z = pk2(s[132], s[165]); o.w = pk2(s[198], s[231]);
        *(u32x4*)(dst + (size_t)(row0 + n * rstep) * ldd + k0 + 8 * c) = o;
    }
    __builtin_amdgcn_s_waitcnt(0xC07F);
    asm volatile("" ::: "memory");
}

__device__ __forceinline__ void wp_src(int c, int& kind, int& col, int& aux, float& scale) {
    kind = 1; aux = 0; scale = 1.f; col = 0;
    if (c < 512) { col = c; scale = QSCALE; }
    else if (c < C_QF) { col = c; }
    else if (c < C_KV) { const int r = c - C_QF, h = r / QFW, j = r % QFW; scale = QSCALE;
        if (j < 128) { kind = 2; col = h; aux = j; } else { const int i = j - 128; col = 1536 + 64 * h + (i >> 1) + 8 * (i & 1); } }
    else if (c < C_QI) { const int j = c - C_KV; if (j < 128) col = 2048 + j; else { const int i = j - 128; col = 2176 + (i >> 1) + 8 * (i & 1); } }
    else if (c < C_KI) { const int r = c - C_QI, h = r >> 6, j = r & 63; col = 2192 + 64 * h + (j < 16 ? (j >> 1) + 8 * (j & 1) : j); }
    else if (c < C_WI) { const int j = c - C_KI; col = 2704 + (j < 16 ? (j >> 1) + 8 * (j & 1) : j); }
    else if (c < C_END) { col = 2768 + (c - C_WI); }
    else kind = 0;
}

constexpr int IT_WP = (PWN / 32) * 16;
constexpr int IT_WG = 32 * 16;
constexpr int IT_WUA = 32 * 8;
constexpr int IT_WBP = 32 * 16, IT_WO = 32 * 16;
constexpr int IT_W13 = NEXP * 32 * 16;
constexpr int IT_W2 = NEXP * 32 * 8;
constexpr int IT_TOTAL = IT_WP + 2 * IT_WG + IT_WUA + IT_WBP + IT_WO + IT_W13 + IT_W2;

__device__ __forceinline__ void phase_prologue(const Params& p, char* lds) {
    const int tid = threadIdx.x, lane = tid & 63, wave = tid >> 6;
    const int gw = blockIdx.x * NWAVES + wave, NGW = gridDim.x * NWAVES;
    float* scr = (float*)lds + wave * (64 * 33);
    unsigned char* ws = p.ws;
    const float* w_in = p.in[I_WIN];
    {
        float2* cs = (float2*)(ws + WS_CS);
        for (int i = blockIdx.x * NTHREADS + tid; i < T * 8; i += gridDim.x * NTHREADS) {
            const int pos = i >> 3, f = i & 7;
            const float inv = powf(500000.0f, -(float)f / 8.0f);
            const float ang = (float)pos * inv;
            cs[i] = make_float2(cosf(ang), sinf(ang));
        }
    }
    for (int it = gw; it < IT_TOTAL; it += NGW) {
        int r = it;
        if (r < IT_WP) {
            const int rg = r / 16, kb = r % 16, c = rg * 32 + (lane & 31);
            int kind, col, aux; float scale; wp_src(c, kind, col, aux, scale);
            const float* w_uk = p.in[I_WUK];
            float wu[48];
#pragma unroll
            for (int n4 = 0; n4 < 12; ++n4) { f32x4 t = (f32x4){0.f, 0.f, 0.f, 0.f}; if (kind == 2) t = *(const f32x4*)(w_uk + ((size_t)col * 128 + aux) * 48 + 4 * n4); wu[4 * n4] = t.x; wu[4 * n4 + 1] = t.y; wu[4 * n4 + 2] = t.z; wu[4 * n4 + 3] = t.w; }
            tr_item([&](int k, int) -> float {
                if (kind == 0) return 0.f;
                if (kind == 1) return scale * w_in[(size_t)k * INW + col];
                const f32x4* wi = (const f32x4*)(w_in + (size_t)k * INW + 1536 + 64 * col + 16);
                float s = 0.f;
#pragma unroll
                for (int n4 = 0; n4 < 12; ++n4) { const f32x4 t = wi[n4]; s += t.x * wu[4 * n4] + t.y * wu[4 * n4 + 1] + t.z * wu[4 * n4 + 2] + t.w * wu[4 * n4 + 3]; }
                return scale * s; }, (bf16_t*)(ws + WS_WP), 1024, rg * 32, kb * 64, scr, lane);
            continue; }
        r -= IT_WP;
        if (r < 2 * IT_WG) {
            const int which = r / IT_WG; r %= IT_WG; const int rg = r / 16, kb = r % 16; const int col0 = (which ? 3800 : 2776) + rg * 32;
            tr_item([&](int k, int n) -> float { return w_in[(size_t)k * INW + col0 + n]; }, (bf16_t*)(ws + WS_WG) + (size_t)which * 1024 * 1024, 1024, rg * 32, kb * 64, scr, lane);
            continue; }
        r -= 2 * IT_WG;
        if (r < IT_WUA) {
            const int rg = r / 8, kb = r % 8; const float* w = p.in[I_WUPA];
            tr_item([&](int k, int n) -> float { return w[(size_t)k * 1024 + rg * 32 + n]; }, (bf16_t*)(ws + WS_WUA), 512, rg * 32, kb * 64, scr, lane);
            continue; }
        r -= IT_WUA;
        if (r < IT_WBP) {
            const int rg = r / 16, kb = r % 16; const float* wuv = p.in[I_WUV]; const float* wub = p.in[I_WUPB];
            const int hB = kb >> 1;
            float bc[64];
#pragma unroll
            for (int d = 0; d < 64; ++d) bc[d] = wub[(size_t)(64 * hB + d) * 1024 + rg * 32 + (lane & 31)];
            tr_item([&](int kk, int) -> float {
                const f32x4* a = (const f32x4*)(wuv + (size_t)kk * 64);
                float s = 0.f;
#pragma unroll
                for (int d4 = 0; d4 < 16; ++d4) { const f32x4 t = a[d4]; s += t.x * bc[4 * d4] + t.y * bc[4 * d4 + 1] + t.z * bc[4 * d4 + 2] + t.w * bc[4 * d4 + 3]; }
                return s; }, (bf16_t*)(ws + WS_WBP), 1024, rg * 32, kb * 64, scr, lane);
            continue; }
        r -= IT_WBP;
        if (r < IT_WO) {
            const int rg = r / 16, kb = r % 16; const float* w = p.in[I_WO];
            tr_item([&](int k, int n) -> float { return w[(size_t)k * 1024 + rg * 32 + n]; }, (bf16_t*)(ws + WS_WO), 1024, rg * 32, kb * 64, scr, lane);
            continue; }
        r -= IT_WO;
        if (r < IT_W13) {
            const int e = r / 512; r %= 512; const int which = r & 1, cg = (r >> 1) & 15, kb = r >> 5;
            const float* w = (which ? p.in[I_W3] : p.in[I_W1]) + (size_t)e * 1024 * 512 + cg * 32;
            tr_item([&](int k, int n) -> float { return w[(size_t)k * 512 + n]; },
                    (bf16_t*)(ws + WS_W13) + (size_t)e * 1024 * 1024, 1024, 2 * cg * 32 + which, kb * 64, scr, lane, 2);
            continue; }
        r -= IT_W13;
        {
            const int e = r / 256; r %= 256; const int rg = r / 8, kb = r % 8;
            const float* w2 = p.in[I_W2] + (size_t)e * 512 * 1024;
            tr_item([&](int k, int n) -> float { return w2[(size_t)k * 1024 + rg * 32 + n]; }, (bf16_t*)(ws + WS_W2) + (size_t)e * 1024 * 512, 512, rg * 32, kb * 64, scr, lane);
        }
    }
    {
        const float* g = p.in[I_GMIX]; bf16_t* U = (bf16_t*)(ws + WS_U);
        for (int row = gw; row < NTOK; row += NGW) {
            const f32x4* xr = (const f32x4*)h0_row(p, row) + lane;
            f32x4 v[4]; float s = 0.f;
#pragma unroll
            for (int j = 0; j < 4; ++j) { v[j] = xr[64 * j]; s += (v[j].x * v[j].x + v[j].y * v[j].y) + (v[j].z * v[j].z + v[j].w * v[j].w); }
            const float rstd = rsqrtf(wave_sum(s) * (1.f / D) + NORM_EPS);
            u32x2* o = (u32x2*)(U + (size_t)row * D) + lane;
#pragma unroll
            for (int j = 0; j < 4; ++j) { const f32x4 gg = ((const f32x4*)g)[lane + 64 * j];
                u32x2 w; w.x = pk2(v[j].x * rstd * gg.x, v[j].y * rstd * gg.y); w.y = pk2(v[j].z * rstd * gg.z, v[j].w * rstd * gg.w); o[64 * j] = w; }
        }
    }
}

namespace pg8 {
#define PG8_LAS __attribute__((address_space(3)))
typedef unsigned short bf16_t;
typedef short bf16x8 __attribute__((ext_vector_type(8)));
typedef float f32x4 __attribute__((ext_vector_type(4)));
typedef unsigned u32x4 __attribute__((ext_vector_type(4)));
constexpr int BM = 256, BK = 64, HALF = 128, HTB = HALF * BK * 2  , STAGE_BYTES = 8 * HTB, NXCD = 8, WGM = 8;

__host__ __device__ __forceinline__ int lds_byte(int r, int c) { const int st = (r >> 4) * 2 + (c >> 5), rr = r & 15, cc = c & 31, ob = rr * 64 + cc * 2; return st * 1024 + (ob ^ (((ob >> 9) & 1) << 5)); }
__host__ __device__ __forceinline__ void stage_rc(int b, int& R, int& C) { const int st = b / 1024, sb = b % 1024, swz = sb ^ (((sb >> 9) & 1) << 5); R = (st >> 1) * 16 + swz / 64; C = (st & 1) * 32 + (swz % 64) / 2; }
__host__ __device__ __forceinline__ int perm32(int rho) { const int n = rho >> 4, i = rho & 15; return 8 * (i >> 2) + 4 * n + (i & 3); }

struct Unit { int pm, pn; };
struct Gemm { const bf16_t* A; const bf16_t* Bt; int M, N, K; };

struct StaticOrder {
    int nM, nN, nwg, G, c;
    __host__ __device__ void init(int M, int N, int G_, int c_) { nM = M / BM; nN = N / BM; nwg = nM * nN; G = G_; c = c_; }
    __host__ __device__ bool next(int i, Unit& u) const {
        const long L = (long)i * G + c; if (L >= nwg) return false;
        int wgid = (int)L; { const int q = nwg / NXCD, r = nwg % NXCD, xcd = wgid % NXCD, off = wgid / NXCD; wgid = (xcd < r ? xcd * (q + 1) : r * (q + 1) + (xcd - r) * q) + off; }
        const int nig = WGM * nN, gid = wgid / nig, fm = gid * WGM, gsz = (nM - fm) < WGM ? (nM - fm) : WGM;
        u.pm = fm + ((wgid % nig) % gsz); u.pn = (wgid % nig) / gsz; return true;
    }
    __device__ __forceinline__ void a_ready(const Unit&) const {}
    __device__ __forceinline__ void done(const Unit&) const {}
};


#define PG8_FOR_FRAGS(...) _Pragma("unroll") for (int ai = 0; ai < 2; ++ai) _Pragma("unroll") for (int m = 0; m < 4; ++m) { const int row = u.pm * BM + ai * HALF + wr * 64 + m * 16 + fr; \
    _Pragma("unroll") for (int bj = 0; bj < 2; ++bj) _Pragma("unroll") for (int n = 0; n < 2; ++n) { const int col = u.pn * BM + bj * HALF + wc * 32 + n * 16 + 4 * fq; ::f32x4 v = acc[ai][bj][m][n]; __VA_ARGS__ } }
__device__ __forceinline__ bool rope_off(int c, int& o) {
    if (c < C_QF) return false;
    if (c < C_KV) { const int j = (c - C_QF) % QFW; o = j - 128; return j >= 128; }
    if (c < C_QI) { const int j = c - C_KV; o = j - 128; return j >= 128; }
    if (c < C_KI) { const int j = (c - C_QI) & 63; o = j; return j < 16; }
    if (c < C_WI) { const int j = c - C_KI; o = j; return j < 16; }
    return false;
}
#define PG8_FOR_FRAGS8(...) _Pragma("unroll") for (int ai = 0; ai < 2; ++ai) _Pragma("unroll") for (int m = 0; m < 4; ++m) { const int row = u.pm * BM + ai * HALF + wr * 64 + m * 16 + fr; \
    _Pragma("unroll") for (int bj = 0; bj < 2; ++bj) { const int col = u.pn * BM + bj * HALF + wc * 32 + 8 * fq; ::f32x4 v0 = acc[ai][bj][m][0], v1 = acc[ai][bj][m][1]; __VA_ARGS__ } }
struct EpiInproj {
    static constexpr bool PERM = true, AFTER_DRAIN = false;
    bf16_t* P; const float2* cs; unsigned char* KIP;
    __device__ __forceinline__ void operator()(const f32x4 (&acc)[2][2][4][2], const Unit& u, int wr, int wc, int fr, int fq) const {
        PG8_FOR_FRAGS8(
            if (col < PW) {
                int o; const int trow = tokrow(row);
                if (rope_off(col, o)) {
                    const int pos = (row % SEQ) + NMETA; const float2* cp = cs + pos * 8 + (o >> 1); const float2 c0 = cp[0], c1 = cp[1], c2 = cp[2], c3 = cp[3];
                    v0 = (::f32x4){v0.x * c0.x - v0.y * c0.y, v0.y * c0.x + v0.x * c0.y, v0.z * c1.x - v0.w * c1.y, v0.w * c1.x + v0.z * c1.y};
                    v1 = (::f32x4){v1.x * c2.x - v1.y * c2.y, v1.y * c2.x + v1.x * c2.y, v1.z * c3.x - v1.w * c3.y, v1.w * c3.x + v1.z * c3.y};
                }
                ::u32x4 w; w.x = pk2(v0.x, v0.y); w.y = pk2(v0.z, v0.w); w.z = pk2(v1.x, v1.y); w.w = pk2(v1.z, v1.w);
                if (col >= C_KI && col < C_WI) {
                    const int b = row / SEQ, t = row - b * SEQ + NMETA, d0 = col - C_KI;
                    *(::u32x4*)(KIP + (size_t)b * KIP_BATCH + (size_t)((((t >> 5) * 4 + (d0 >> 4)) * 2 + ((d0 >> 3) & 1)) * 512 + (t & 31) * 16)) = w;
                } else *(::u32x4*)(P + (size_t)trow * PW + col) = w;
            })
    }
};
struct EpiGate {
    static constexpr bool PERM = true, AFTER_DRAIN = false;
    bf16_t* G;
    __device__ __forceinline__ void operator()(const f32x4 (&acc)[2][2][4][2], const Unit& u, int wr, int wc, int fr, int fq) const {
        PG8_FOR_FRAGS8( ::u32x4 w; w.x = pk2(sigmoidf(v0.x), sigmoidf(v0.y)); w.y = pk2(sigmoidf(v0.z), sigmoidf(v0.w)); w.z = pk2(sigmoidf(v1.x), sigmoidf(v1.y)); w.w = pk2(sigmoidf(v1.z), sigmoidf(v1.w));
            *(::u32x4*)(G + (size_t)row * 2048 + col) = w; )
    }
};
template <bool ACCUM> struct EpiZ {
    static constexpr bool PERM = true, AFTER_DRAIN = false;
    bf16_t* Z; const bf16_t* G; int goff;
    __device__ __forceinline__ void operator()(const f32x4 (&acc)[2][2][4][2], const Unit& u, int wr, int wc, int fr, int fq) const {
        PG8_FOR_FRAGS8(
            const ::u32x4 g = *(const ::u32x4*)(G + (size_t)row * 2048 + goff + col);
            ::f32x4 z0 = (::f32x4){bflo(g.x) * v0.x, bfhi(g.x) * v0.y, bflo(g.y) * v0.z, bfhi(g.y) * v0.w}, z1 = (::f32x4){bflo(g.z) * v1.x, bfhi(g.z) * v1.y, bflo(g.w) * v1.z, bfhi(g.w) * v1.w};
            ::u32x4* zp = (::u32x4*)(Z + (size_t)row * D + col);
            if (ACCUM) { const ::u32x4 o = *zp; z0.x += bflo(o.x); z0.y += bfhi(o.x); z0.z += bflo(o.y); z0.w += bfhi(o.y); z1.x += bflo(o.z); z1.y += bfhi(o.z); z1.z += bflo(o.w); z1.w += bfhi(o.w); }
            ::u32x4 w; w.x = pk2(z0.x, z0.y); w.y = pk2(z0.z, z0.w); w.z = pk2(z1.x, z1.y); w.w = pk2(z1.z, z1.w); *zp = w; )
    }
};
struct EpiH1 {
    static constexpr bool PERM = true, AFTER_DRAIN = false;
    float* H1; const float* meta; const float* x;
    __device__ __forceinline__ void operator()(const f32x4 (&acc)[2][2][4][2], const Unit& u, int wr, int wc, int fr, int fq) const {
        PG8_FOR_FRAGS8( const float* xp = x + (size_t)row * D + col; float* hp = H1 + (size_t)row * D + col; const ::f32x4 h0 = *(const ::f32x4*)xp, h1 = *(const ::f32x4*)(xp + 4);
            *(::f32x4*)hp = h0 + v0; *(::f32x4*)(hp + 4) = h1 + v1; )
    }
};
#undef PG8_FOR_FRAGS
#undef PG8_FOR_FRAGS8

template <class Epi, class Sched, bool ALIGN_EPI = false, bool SP2 = false>
__device__ __forceinline__ void gemm_phase(PG8_LAS unsigned char* lds, const Gemm g, const Sched& S, const Epi& E) {
    const int tid = threadIdx.x, wid = __builtin_amdgcn_readfirstlane(tid >> 6), lane = tid & 63, wr = wid >> 2, wc = wid & 3, fr = lane & 15, fq = lane >> 4;
    const int K = g.K, nt = K / BK;
    unsigned voffA[2], voffB[2];
#pragma unroll
    for (int i = 0; i < 2; ++i) { int R, C; stage_rc(tid * 16 + i * 8192, R, C); const int Rb = Epi::PERM ? ((R & ~31) + perm32(R & 31)) : R;
        voffA[i] = (unsigned)(R * K + C) * 2u; voffB[i] = (unsigned)(Rb * K + C) * 2u; }
    const size_t kstep = (size_t)(BK * 2);
    const size_t hstep = (size_t)HALF * K * 2;
    const size_t tstep = 2 * hstep;
    const unsigned ldsw = (unsigned)wid * 1024u;
    const int aoff = lds_byte(wr * 64 + fr, fq * 8), boff = lds_byte(wc * 32 + fr, fq * 8);
#define PG8_SA(b, h) (((b) * 2 + (h)) * HTB)
#define PG8_SB(b, h) ((4 + (b) * 2 + (h)) * HTB)
#define PG8_STAGE(bufoff, gbase, voff) do { _Pragma("unroll") for (int _i = 0; _i < 2; ++_i) \
        __builtin_amdgcn_global_load_lds((const unsigned*)((const char*)(gbase) + (voff)[_i]), (PG8_LAS unsigned*)(lds + (bufoff) + ldsw + _i * 8192), 16, 0, 0); } while (0)
#define PG8_LDA(dst, b, h) do { _Pragma("unroll") for (int m = 0; m < 4; ++m) _Pragma("unroll") for (int k = 0; k < 2; ++k) dst[m][k] = *(const PG8_LAS bf16x8*)(lds + PG8_SA(b, h) + aoff + m * 2048 + k * 1024); } while (0)
#define PG8_LDB(dst, b, h) do { _Pragma("unroll") for (int n = 0; n < 2; ++n) _Pragma("unroll") for (int k = 0; k < 2; ++k) dst[n][k] = *(const PG8_LAS bf16x8*)(lds + PG8_SB(b, h) + boff + n * 2048 + k * 1024); } while (0)
#define PG8_MMA(ai, bj, At, Bt) do { __builtin_amdgcn_s_setprio(1); _Pragma("unroll") for (int m = 0; m < 4; ++m) _Pragma("unroll") for (int n = 0; n < 2; ++n) _Pragma("unroll") for (int k = 0; k < 2; ++k) \
        acc[ai][bj][m][n] = __builtin_amdgcn_mfma_f32_16x16x32_bf16(Bt[n][k], At[m][k], acc[ai][bj][m][n], 0, 0, 0); __builtin_amdgcn_s_setprio(0); } while (0)
#define PG8_WAIT_V(n) asm volatile("s_waitcnt vmcnt(" #n ")" ::: "memory")
#define PG8_WAIT_L(n) asm volatile("s_waitcnt lgkmcnt(" #n ")" ::: "memory")
#define PG8_BAR __builtin_amdgcn_s_barrier()
#define PG8_SCHED __builtin_amdgcn_sched_barrier(0)
    Unit cur, nxt; int ui = 0;
    if (!S.next(0, cur)) return;
    f32x4 acc[2][2][4][2];
#pragma unroll
    for (int a = 0; a < 2; ++a)
#pragma unroll
        for (int b = 0; b < 2; ++b)
#pragma unroll
            for (int m = 0; m < 4; ++m)
#pragma unroll
                for (int n = 0; n < 2; ++n) acc[a][b][m][n] = (f32x4){0.f, 0.f, 0.f, 0.f};
    bf16x8 At[4][2], B0[2][2], B1[2][2];
    const char* cA = (const char*)g.A + (size_t)cur.pm * tstep; const char* cB = (const char*)g.Bt + (size_t)cur.pn * tstep;
    S.a_ready(cur);
    if constexpr (SP2) {
        PG8_STAGE(PG8_SB(0, 0), cB, voffB); PG8_STAGE(PG8_SB(0, 1), cB + hstep, voffB); PG8_STAGE(PG8_SA(0, 0), cA, voffA); PG8_STAGE(PG8_SA(0, 1), cA + hstep, voffA);
        if (wr == 1) PG8_BAR;
        PG8_WAIT_V(2); PG8_BAR;
        PG8_STAGE(PG8_SB(1, 0), cB + kstep, voffB); PG8_STAGE(PG8_SA(1, 0), cA + kstep, voffA); PG8_STAGE(PG8_SB(1, 1), cB + hstep + kstep, voffB);
        PG8_WAIT_V(6); PG8_BAR;
    } else {
        PG8_STAGE(PG8_SB(0, 0), cB, voffB); PG8_STAGE(PG8_SA(0, 0), cA, voffA); PG8_STAGE(PG8_SB(0, 1), cB + hstep, voffB); PG8_STAGE(PG8_SA(0, 1), cA + hstep, voffA);
        if (wr == 1) PG8_BAR;
        PG8_WAIT_V(4); PG8_BAR;
        PG8_STAGE(PG8_SB(1, 0), cB + kstep, voffB); PG8_STAGE(PG8_SA(1, 0), cA + kstep, voffA); PG8_STAGE(PG8_SB(1, 1), cB + hstep + kstep, voffB);
        PG8_WAIT_V(6); PG8_BAR;
    }
    for (;;) {
        const bool has_next = S.next(ui + 1, nxt);
        const char* nA = has_next ? (const char*)g.A + (size_t)nxt.pm * tstep : cA; const char* nB = has_next ? (const char*)g.Bt + (size_t)nxt.pn * tstep : cB;
        for (int t = 0; t < nt; t += 2) {
            const bool last = (t == nt - 2);
            const char* a1 = cA + (size_t)(t + 1) * kstep;
            const char* a2 = last ? nA : cA + (size_t)(t + 2) * kstep; const char* b2 = last ? nB : cB + (size_t)(t + 2) * kstep;
            const char* a3 = a2 + kstep; const char* b3 = b2 + kstep;
            if (last && has_next) S.a_ready(nxt);
            if constexpr (SP2) {
            PG8_LDB(B0, 0, 0); PG8_LDB(B1, 0, 1); PG8_SCHED; PG8_LDA(At, 0, 0); PG8_STAGE(PG8_SA(1, 1), a1 + hstep, voffA);
            PG8_WAIT_V(8); PG8_WAIT_L(0); PG8_BAR; PG8_MMA(0, 0, At, B0); PG8_MMA(0, 1, At, B1); PG8_BAR; PG8_SCHED;
            PG8_LDA(At, 0, 1); PG8_STAGE(PG8_SB(0, 0), b2, voffB); PG8_STAGE(PG8_SB(0, 1), b2 + hstep, voffB); PG8_STAGE(PG8_SA(0, 0), a2, voffA);
            PG8_WAIT_V(8); PG8_WAIT_L(0); PG8_BAR; PG8_MMA(1, 0, At, B0); PG8_MMA(1, 1, At, B1); PG8_BAR; PG8_SCHED;
            PG8_LDB(B0, 1, 0); PG8_LDB(B1, 1, 1); PG8_SCHED; PG8_LDA(At, 1, 0); PG8_STAGE(PG8_SA(0, 1), a2 + hstep, voffA);
            PG8_WAIT_V(8); PG8_WAIT_L(0); PG8_BAR; PG8_MMA(0, 0, At, B0); PG8_MMA(0, 1, At, B1); PG8_BAR; PG8_SCHED;
            PG8_LDA(At, 1, 1); PG8_STAGE(PG8_SB(1, 0), b3, voffB); PG8_STAGE(PG8_SB(1, 1), b3 + hstep, voffB); PG8_STAGE(PG8_SA(1, 0), a3, voffA);
            PG8_WAIT_V(8); PG8_WAIT_L(0); PG8_BAR; PG8_MMA(1, 0, At, B0); PG8_MMA(1, 1, At, B1); PG8_BAR; PG8_SCHED;
            } else {
            PG8_LDB(B0, 0, 0); PG8_SCHED; PG8_LDA(At, 0, 0); PG8_STAGE(PG8_SA(1, 1), a1 + hstep, voffA);
            PG8_WAIT_L(8); PG8_BAR; PG8_WAIT_L(0); PG8_MMA(0, 0, At, B0); PG8_BAR; PG8_SCHED;
            PG8_LDB(B1, 0, 1); PG8_STAGE(PG8_SB(0, 0), b2, voffB);
            PG8_BAR; PG8_WAIT_L(0); PG8_MMA(0, 1, At, B1); PG8_BAR;
            PG8_LDA(At, 0, 1); PG8_STAGE(PG8_SA(0, 0), a2, voffA);
            PG8_BAR; PG8_WAIT_L(0); PG8_MMA(1, 0, At, B0); PG8_BAR; PG8_SCHED;
            PG8_STAGE(PG8_SB(0, 1), b2 + hstep, voffB);
            PG8_WAIT_V(6); PG8_BAR; PG8_MMA(1, 1, At, B1); PG8_BAR;
            PG8_LDB(B0, 1, 0); PG8_SCHED; PG8_LDA(At, 1, 0); PG8_STAGE(PG8_SA(0, 1), a2 + hstep, voffA);
            PG8_WAIT_L(8); PG8_BAR; PG8_WAIT_L(0); PG8_MMA(0, 0, At, B0); PG8_BAR; PG8_SCHED;
            PG8_LDB(B1, 1, 1); PG8_STAGE(PG8_SB(1, 0), b3, voffB);
            PG8_BAR; PG8_WAIT_L(0); PG8_MMA(0, 1, At, B1); PG8_BAR;
            PG8_LDA(At, 1, 1); PG8_STAGE(PG8_SA(1, 0), a3, voffA);
            PG8_BAR; PG8_WAIT_L(0); PG8_MMA(1, 0, At, B0); PG8_BAR; PG8_SCHED;
            PG8_STAGE(PG8_SB(1, 1), b3 + hstep, voffB);
            PG8_WAIT_V(6); PG8_BAR; PG8_MMA(1, 1, At, B1); PG8_BAR;
            }
        }
        if constexpr (ALIGN_EPI) { if (wr == 0) PG8_BAR; }
        if constexpr (!Epi::AFTER_DRAIN) { E(acc, cur, wr, wc, fr, fq); S.done(cur); }
        if (!has_next) break;
#pragma unroll
        for (int a = 0; a < 2; ++a)
#pragma unroll
            for (int b = 0; b < 2; ++b)
#pragma unroll
                for (int m = 0; m < 4; ++m)
#pragma unroll
                    for (int n = 0; n < 2; ++n) acc[a][b][m][n] = (f32x4){0.f, 0.f, 0.f, 0.f};
        cur = nxt; cA = nA; cB = nB; ++ui;
        if constexpr (ALIGN_EPI) { if (wr == 1) PG8_BAR; }
    }
    PG8_WAIT_V(0);
    if constexpr (!ALIGN_EPI) { if (wr == 0) PG8_BAR; }
    PG8_BAR;
    if constexpr (Epi::AFTER_DRAIN) { E.fused(acc, cur, wr, wc, fr, fq, lds, wid, lane); S.done(cur); }
#undef PG8_SA
#undef PG8_SB
#undef PG8_STAGE
#undef PG8_LDA
#undef PG8_LDB
#undef PG8_MMA
#undef PG8_WAIT_V
#undef PG8_WAIT_L
#undef PG8_BAR
#undef PG8_SCHED
}
template <class Epi, class Sched, bool ALIGN_EPI = false, bool SP2 = false>
__device__ __forceinline__ void gemm_phase_x(PG8_LAS unsigned char* lds, const int K, const Sched& S, const Epi& E) {
    const int tid = threadIdx.x, wid = __builtin_amdgcn_readfirstlane(tid >> 6), lane = tid & 63, wr = wid >> 2, wc = wid & 3, fr = lane & 15, fq = lane >> 4;
    const int nt = K / BK;
    unsigned vcA[2][2], vnA[2][2], voffB[2];
#pragma unroll
    for (int i = 0; i < 2; ++i) { int R, C; stage_rc(tid * 16 + i * 8192, R, C); const int Rb = Epi::PERM ? ((R & ~31) + perm32(R & 31)) : R;
        voffB[i] = (unsigned)(Rb * K + C) * 2u; }
    const size_t kstep = (size_t)(BK * 2);
    const size_t hstep = (size_t)HALF * K * 2;
    const unsigned ldsw = (unsigned)wid * 1024u;
    const int aoff = lds_byte(wr * 64 + fr, fq * 8), boff = lds_byte(wc * 32 + fr, fq * 8);
#define PG8_SA(b, h) (((b) * 2 + (h)) * HTB)
#define PG8_SB(b, h) ((4 + (b) * 2 + (h)) * HTB)
#define PG8_STAGE(bufoff, gbase, voff) do { _Pragma("unroll") for (int _i = 0; _i < 2; ++_i) \
        __builtin_amdgcn_global_load_lds((const unsigned*)((const char*)(gbase) + (voff)[_i]), (PG8_LAS unsigned*)(lds + (bufoff) + ldsw + _i * 8192), 16, 0, 0); } while (0)
#define PG8_STAGEA(bufoff, gbase, V, h) do { _Pragma("unroll") for (int _i = 0; _i < 2; ++_i) \
        __builtin_amdgcn_global_load_lds((const unsigned*)((const char*)(gbase) + (V)[h][_i]), (PG8_LAS unsigned*)(lds + (bufoff) + ldsw + _i * 8192), 16, 0, 0); } while (0)
#define PG8_STAGEA2(bufoff, gbase, h) do { _Pragma("unroll") for (int _i = 0; _i < 2; ++_i) \
        __builtin_amdgcn_global_load_lds((const unsigned*)((const char*)(gbase) + (last ? vnA[h][_i] : vcA[h][_i])), (PG8_LAS unsigned*)(lds + (bufoff) + ldsw + _i * 8192), 16, 0, 0); } while (0)
#define PG8_AOFF(V, u) do { _Pragma("unroll") for (int _h = 0; _h < 2; ++_h) _Pragma("unroll") for (int _i = 0; _i < 2; ++_i) { int R_, C_; stage_rc(tid * 16 + _i * 8192, R_, C_); (V)[_h][_i] = S.a_off(u, _h * HALF + R_, C_); } } while (0)
#define PG8_LDA(dst, b, h) do { _Pragma("unroll") for (int m = 0; m < 4; ++m) _Pragma("unroll") for (int k = 0; k < 2; ++k) dst[m][k] = *(const PG8_LAS bf16x8*)(lds + PG8_SA(b, h) + aoff + m * 2048 + k * 1024); } while (0)
#define PG8_LDB(dst, b, h) do { _Pragma("unroll") for (int n = 0; n < 2; ++n) _Pragma("unroll") for (int k = 0; k < 2; ++k) dst[n][k] = *(const PG8_LAS bf16x8*)(lds + PG8_SB(b, h) + boff + n * 2048 + k * 1024); } while (0)
#define PG8_MMA(ai, bj, At, Bt) do { __builtin_amdgcn_s_setprio(1); _Pragma("unroll") for (int m = 0; m < 4; ++m) _Pragma("unroll") for (int n = 0; n < 2; ++n) _Pragma("unroll") for (int k = 0; k < 2; ++k) \
        acc[ai][bj][m][n] = __builtin_amdgcn_mfma_f32_16x16x32_bf16(Bt[n][k], At[m][k], acc[ai][bj][m][n], 0, 0, 0); __builtin_amdgcn_s_setprio(0); } while (0)
#define PG8_WAIT_V(n) asm volatile("s_waitcnt vmcnt(" #n ")" ::: "memory")
#define PG8_WAIT_L(n) asm volatile("s_waitcnt lgkmcnt(" #n ")" ::: "memory")
#define PG8_BAR __builtin_amdgcn_s_barrier()
#define PG8_SCHED __builtin_amdgcn_sched_barrier(0)
    Unit cur, nxt; int ui = 0;
    if (!S.next(0, cur)) return;
    f32x4 acc[2][2][4][2];
#pragma unroll
    for (int a = 0; a < 2; ++a)
#pragma unroll
        for (int b = 0; b < 2; ++b)
#pragma unroll
            for (int m = 0; m < 4; ++m)
#pragma unroll
                for (int n = 0; n < 2; ++n) acc[a][b][m][n] = (f32x4){0.f, 0.f, 0.f, 0.f};
    bf16x8 At[4][2], B0[2][2], B1[2][2];
    const char* cA = S.a_base(cur); const char* cB = S.b_base(cur);
    PG8_AOFF(vcA, cur);
    S.a_ready(cur);
    if constexpr (SP2) {
        PG8_STAGE(PG8_SB(0, 0), cB, voffB); PG8_STAGE(PG8_SB(0, 1), cB + hstep, voffB); PG8_STAGEA(PG8_SA(0, 0), cA, vcA, 0); PG8_STAGEA(PG8_SA(0, 1), cA, vcA, 1);
        if (wr == 1) PG8_BAR;
        PG8_WAIT_V(2); PG8_BAR;
        PG8_STAGE(PG8_SB(1, 0), cB + kstep, voffB); PG8_STAGEA(PG8_SA(1, 0), cA + kstep, vcA, 0); PG8_STAGE(PG8_SB(1, 1), cB + hstep + kstep, voffB);
        PG8_WAIT_V(6); PG8_BAR;
    } else {
        PG8_STAGE(PG8_SB(0, 0), cB, voffB); PG8_STAGEA(PG8_SA(0, 0), cA, vcA, 0); PG8_STAGE(PG8_SB(0, 1), cB + hstep, voffB); PG8_STAGEA(PG8_SA(0, 1), cA, vcA, 1);
        if (wr == 1) PG8_BAR;
        PG8_WAIT_V(4); PG8_BAR;
        PG8_STAGE(PG8_SB(1, 0), cB + kstep, voffB); PG8_STAGEA(PG8_SA(1, 0), cA + kstep, vcA, 0); PG8_STAGE(PG8_SB(1, 1), cB + hstep + kstep, voffB);
        PG8_WAIT_V(6); PG8_BAR;
    }
    for (;;) {
        const bool has_next = S.next(ui + 1, nxt);
        const char* nA = has_next ? S.a_base(nxt) : cA; const char* nB = has_next ? S.b_base(nxt) : cB;
        if (has_next) { PG8_AOFF(vnA, nxt); } else { _Pragma("unroll") for (int _h = 0; _h < 2; ++_h) _Pragma("unroll") for (int _i = 0; _i < 2; ++_i) vnA[_h][_i] = vcA[_h][_i]; }
        for (int t = 0; t < nt; t += 2) {
            const bool last = (t == nt - 2);
            const char* a1 = cA + (size_t)(t + 1) * kstep;
            const char* a2 = last ? nA : cA + (size_t)(t + 2) * kstep; const char* b2 = last ? nB : cB + (size_t)(t + 2) * kstep;
            const char* a3 = a2 + kstep; const char* b3 = b2 + kstep;
            if (last && has_next) S.a_ready(nxt);
            if constexpr (SP2) {
            PG8_LDB(B0, 0, 0); PG8_LDB(B1, 0, 1); PG8_SCHED; PG8_LDA(At, 0, 0); PG8_STAGEA(PG8_SA(1, 1), a1, vcA, 1);
            PG8_WAIT_V(8); PG8_WAIT_L(0); PG8_BAR; PG8_MMA(0, 0, At, B0); PG8_MMA(0, 1, At, B1); PG8_BAR; PG8_SCHED;
            PG8_LDA(At, 0, 1); PG8_STAGE(PG8_SB(0, 0), b2, voffB); PG8_STAGE(PG8_SB(0, 1), b2 + hstep, voffB); PG8_STAGEA2(PG8_SA(0, 0), a2, 0);
            PG8_WAIT_V(8); PG8_WAIT_L(0); PG8_BAR; PG8_MMA(1, 0, At, B0); PG8_MMA(1, 1, At, B1); PG8_BAR; PG8_SCHED;
            PG8_LDB(B0, 1, 0); PG8_LDB(B1, 1, 1); PG8_SCHED; PG8_LDA(At, 1, 0); PG8_STAGEA2(PG8_SA(0, 1), a2, 1);
            PG8_WAIT_V(8); PG8_WAIT_L(0); PG8_BAR; PG8_MMA(0, 0, At, B0); PG8_MMA(0, 1, At, B1); PG8_BAR; PG8_SCHED;
            PG8_LDA(At, 1, 1); PG8_STAGE(PG8_SB(1, 0), b3, voffB); PG8_STAGE(PG8_SB(1, 1), b3 + hstep, voffB); PG8_STAGEA2(PG8_SA(1, 0), a3, 0);
            PG8_WAIT_V(8); PG8_WAIT_L(0); PG8_BAR; PG8_MMA(1, 0, At, B0); PG8_MMA(1, 1, At, B1); PG8_BAR; PG8_SCHED;
            } else {
            PG8_LDB(B0, 0, 0); PG8_SCHED; PG8_LDA(At, 0, 0); PG8_STAGEA(PG8_SA(1, 1), a1, vcA, 1);
            PG8_WAIT_L(8); PG8_BAR; PG8_WAIT_L(0); PG8_MMA(0, 0, At, B0); PG8_BAR; PG8_SCHED;
            PG8_LDB(B1, 0, 1); PG8_STAGE(PG8_SB(0, 0), b2, voffB);
            PG8_BAR; PG8_WAIT_L(0); PG8_MMA(0, 1, At, B1); PG8_BAR;
            PG8_LDA(At, 0, 1); PG8_STAGEA2(PG8_SA(0, 0), a2, 0);
            PG8_BAR; PG8_WAIT_L(0); PG8_MMA(1, 0, At, B0); PG8_BAR; PG8_SCHED;
            PG8_STAGE(PG8_SB(0, 1), b2 + hstep, voffB);
            PG8_WAIT_V(6); PG8_BAR; PG8_MMA(1, 1, At, B1); PG8_BAR;
            PG8_LDB(B0, 1, 0); PG8_SCHED; PG8_LDA(At, 1, 0); PG8_STAGEA2(PG8_SA(0, 1), a2, 1);
            PG8_WAIT_L(8); PG8_BAR; PG8_WAIT_L(0); PG8_MMA(0, 0, At, B0); PG8_BAR; PG8_SCHED;
            PG8_LDB(B1, 1, 1); PG8_STAGE(PG8_SB(1, 0), b3, voffB);
            PG8_BAR; PG8_WAIT_L(0); PG8_MMA(0, 1, At, B1); PG8_BAR;
            PG8_LDA(At, 1, 1); PG8_STAGEA2(PG8_SA(1, 0), a3, 0);
            PG8_BAR; PG8_WAIT_L(0); PG8_MMA(1, 0, At, B0); PG8_BAR; PG8_SCHED;
            PG8_STAGE(PG8_SB(1, 1), b3 + hstep, voffB);
            PG8_WAIT_V(6); PG8_BAR; PG8_MMA(1, 1, At, B1); PG8_BAR;
            }
        }
        if constexpr (ALIGN_EPI) { if (wr == 0) PG8_BAR; }
        if constexpr (!Epi::AFTER_DRAIN) { E(acc, cur, wr, wc, fr, fq); S.done(cur); }
        if (!has_next) break;
#pragma unroll
        for (int a = 0; a < 2; ++a)
#pragma unroll
            for (int b = 0; b < 2; ++b)
#pragma unroll
                for (int m = 0; m < 4; ++m)
#pragma unroll
                    for (int n = 0; n < 2; ++n) acc[a][b][m][n] = (f32x4){0.f, 0.f, 0.f, 0.f};
        cur = nxt; cA = nA; cB = nB; ++ui;
        _Pragma("unroll") for (int _h = 0; _h < 2; ++_h) _Pragma("unroll") for (int _i = 0; _i < 2; ++_i) vcA[_h][_i] = vnA[_h][_i];
        if constexpr (ALIGN_EPI) { if (wr == 1) PG8_BAR; }
    }
    PG8_WAIT_V(0);
    if constexpr (!ALIGN_EPI) { if (wr == 0) PG8_BAR; }
    PG8_BAR;
    if constexpr (Epi::AFTER_DRAIN) { E.fused(acc, cur, wr, wc, fr, fq, lds, wid, lane); S.done(cur); }
#undef PG8_SA
#undef PG8_SB
#undef PG8_STAGE
#undef PG8_STAGEA
#undef PG8_STAGEA2
#undef PG8_AOFF
#undef PG8_LDA
#undef PG8_LDB
#undef PG8_MMA
#undef PG8_WAIT_V
#undef PG8_WAIT_L
#undef PG8_BAR
#undef PG8_SCHED
}


template <int WHICH> struct MoeOrder {
    const int* TP; int G, c; const char* Abase; const char* Bbase; const int* LIST;
    static constexpr int KK = WHICH == 0 ? 1024 : 512, NN = 4;
    __device__ __forceinline__ bool next(int i, Unit& u) const {
        const int L = i * G + c; if (L >= TP[NEXP]) return false;
        int e = 0;
#pragma unroll 1
        for (int j = 16; j >= 1; j >>= 1) if (TP[e + j] <= L) e += j;
        const int lt = L - TP[e]; u.pm = e * 1024 + lt / NN; u.pn = lt % NN; return true;
    }
    __device__ __forceinline__ const char* a_base(const Unit& u) const { const int e = u.pm >> 10, mt = u.pm & 1023; return WHICH == 0 ? Abase : Abase + (size_t)(TP[64 + e] + mt * 256) * (DEXP * 2); }
    __device__ __forceinline__ const char* b_base(const Unit& u) const { const int e = u.pm >> 10; return Bbase + ((size_t)e * 1024 + (size_t)u.pn * 256) * (KK * 2); }
    __device__ __forceinline__ unsigned a_off(const Unit& u, int r, int C) const {
        if (WHICH == 1) return (unsigned)(r * DEXP + C) * 2u;
        const int e = u.pm >> 10, s = (u.pm & 1023) * 256 + r; const int tok = s < TP[128 + e] ? (LIST[(size_t)e * NR + s] >> 1) : 0;
        return (unsigned)tok * (D * 2) + (unsigned)C * 2u;
    }
    __device__ __forceinline__ void a_ready(const Unit&) const {}
    __device__ __forceinline__ void done(const Unit&) const {}
};
struct TokRowOrder : StaticOrder {
    const char* Abase; const char* Bbase; int K;
    __device__ __forceinline__ const char* a_base(const Unit& u) const { return Abase + (size_t)tokrow(u.pm * BM) * K * 2; }
    __device__ __forceinline__ const char* b_base(const Unit& u) const { return Bbase + (size_t)u.pn * BM * K * 2; }
    __device__ __forceinline__ unsigned a_off(const Unit&, int r, int C) const { return (unsigned)(r * K + C) * 2u; }
};
#define PG8_FOR_FRAGS_M(...) _Pragma("unroll") for (int ai = 0; ai < 2; ++ai) _Pragma("unroll") for (int m = 0; m < 4; ++m) { const int r = ai * HALF + wr * 64 + m * 16 + fr; \
    _Pragma("unroll") for (int bj = 0; bj < 2; ++bj) _Pragma("unroll") for (int n = 0; n < 2; ++n) { const int col = u.pn * BM + bj * HALF + wc * 32 + n * 16 + 4 * fq; ::f32x4 v = acc[ai][bj][m][n]; __VA_ARGS__ } }
struct EpiMoe1 {
    static constexpr bool PERM = true, AFTER_DRAIN = false;
    bf16_t* HID; const int* TP;
    __device__ __forceinline__ void operator()(const f32x4 (&acc)[2][2][4][2], const Unit& u, int wr, int wc, int fr, int fq) const {
        const int e = u.pm >> 10, mt = u.pm & 1023; bf16_t* base = HID + (size_t)(TP[64 + e] + mt * 256) * DEXP;
#pragma unroll
        for (int ai = 0; ai < 2; ++ai)
#pragma unroll
            for (int m = 0; m < 4; ++m) { const int r = ai * HALF + wr * 64 + m * 16 + fr;
#pragma unroll
                for (int bj = 0; bj < 2; ++bj) { const int col = u.pn * BM + bj * HALF + wc * 32 + 8 * fq; const ::f32x4 v0 = acc[ai][bj][m][0], v1 = acc[ai][bj][m][1];
                    const float h0 = v0.x / (1.f + __expf(-v0.x)) * v0.y, h1 = v0.z / (1.f + __expf(-v0.z)) * v0.w, h2 = v1.x / (1.f + __expf(-v1.x)) * v1.y, h3 = v1.z / (1.f + __expf(-v1.z)) * v1.w;
                    ::u32x2 w; w.x = pk2(h0, h1); w.y = pk2(h2, h3); *(::u32x2*)(base + (size_t)r * DEXP + (col >> 1)) = w; } }
    }
};
struct EpiMoe2 {
    static constexpr bool PERM = true, AFTER_DRAIN = false;
    bf16_t* MO; const int* TP; const int* LIST; const float* GATE;
    __device__ __forceinline__ void operator()(const f32x4 (&acc)[2][2][4][2], const Unit& u, int wr, int wc, int fr, int fq) const {
        const int e = u.pm >> 10, mt = u.pm & 1023, cnt = TP[128 + e];
#pragma unroll
        for (int ai = 0; ai < 2; ++ai)
#pragma unroll
            for (int m = 0; m < 4; ++m) {
                const int s = mt * 256 + ai * HALF + wr * 64 + m * 16 + fr;
                if (s < cnt) {
                    const int ent = LIST[(size_t)e * NR + s]; const float gt = GATE[ent]; bf16_t* row = MO + (size_t)ent * D;
#pragma unroll
                    for (int bj = 0; bj < 2; ++bj) { const int col = u.pn * BM + bj * HALF + wc * 32 + 8 * fq; const ::f32x4 v0 = acc[ai][bj][m][0], v1 = acc[ai][bj][m][1];
                        ::u32x4 w; w.x = pk2(v0.x * gt, v0.y * gt); w.y = pk2(v0.z * gt, v0.w * gt); w.z = pk2(v1.x * gt, v1.y * gt); w.w = pk2(v1.z * gt, v1.w * gt); *(::u32x4*)(row + col) = w; }
                }
            }
    }
};
#undef PG8_FOR_FRAGS_M
}
constexpr int SB_NQT = SEQ / 32;
constexpr int SB_VT_STRIDE = 40;
__device__ __forceinline__ void phase_sb_fast(const Params& p, char* lds) {
    const bf16_t* P = (const bf16_t*)(p.ws + WS_P); bf16_t* YA = (bf16_t*)(p.ws + WS_YA);
    const int tid = threadIdx.x, lane = tid & 63, wave = tid >> 6, n = lane & 31, hh = lane >> 5;
    bf16_t* VT = (bf16_t*)(lds + wave * (64 * SB_VT_STRIDE * 2));
    const int gw = blockIdx.x * NWAVES + wave, NGW = gridDim.x * NWAVES;
    for (int unit = gw; unit < 64 * SB_NQT; unit += NGW) {
        const int qt = SB_NQT - 1 - unit / 64, bh = unit % 64, h = bh & 7, b = bh >> 3;
        const int i0 = NMETA + qt * 32, qi = i0 + n, qrow = qi;
        const bf16_t* Pb = P + (size_t)b * T * PW;
        bf16x8 qf[4];
#pragma unroll
        for (int s = 0; s < 4; ++s) qf[s] = *(const bf16x8*)(Pb + (size_t)qrow * PW + C_QA + h * 64 + 16 * s + 8 * hh);
        f32x16 o0, o1;
#pragma unroll
        for (int r = 0; r < 16; ++r) { o0[r] = 0.f; o1[r] = 0.f; }
        float L = 0.f;
        for (int kt = qt + 1; kt >= 0; --kt) {
            const int j0 = kt * 32, krow = (j0 + n) < T ? (j0 + n) : T - 1;
            bf16x8 kf[4];
#pragma unroll
            for (int s = 0; s < 4; ++s) kf[s] = *(const bf16x8*)(Pb + (size_t)krow * PW + C_KA + h * 64 + 16 * s + 8 * hh);
#pragma unroll
            for (int i = 0; i < 4; ++i) {
                const int c = lane + 64 * i, key = c >> 3, d0 = (c & 7) * 8, vrow = (j0 + key) < T ? (j0 + key) : T - 1;
                const u32x4 w = *(const u32x4*)(Pb + (size_t)vrow * PW + C_VA + h * 64 + d0);
                bf16_t* vp = VT + d0 * SB_VT_STRIDE + key;
                vp[0] = (bf16_t)(w.x & 0xffff); vp[SB_VT_STRIDE] = (bf16_t)(w.x >> 16); vp[2 * SB_VT_STRIDE] = (bf16_t)(w.y & 0xffff); vp[3 * SB_VT_STRIDE] = (bf16_t)(w.y >> 16);
                vp[4 * SB_VT_STRIDE] = (bf16_t)(w.z & 0xffff); vp[5 * SB_VT_STRIDE] = (bf16_t)(w.z >> 16); vp[6 * SB_VT_STRIDE] = (bf16_t)(w.w & 0xffff); vp[7 * SB_VT_STRIDE] = (bf16_t)(w.w >> 16);
            }
            f32x16 sa;
#pragma unroll
            for (int r = 0; r < 16; ++r) sa[r] = 0.f;
#pragma unroll
            for (int s = 0; s < 4; ++s) sa = __builtin_amdgcn_mfma_f32_32x32x16_bf16(kf[s], qf[s], sa, 0, 0, 0);
            float lk[16], z[16];
#pragma unroll
            for (int r = 0; r < 16; ++r) {
                const int kk = (r & 3) + 8 * (r >> 2) + 4 * hh; const bool valid = (j0 + kk) < qi;
                const float zz = fminf(sa[r], 80.f); const float l = -__log2f(1.f + exp2f(zz));
                z[r] = zz; lk[r] = valid ? l : 0.f;
            }
            const float gs0 = (lk[0] + lk[1]) + (lk[2] + lk[3]), gs1 = (lk[4] + lk[5]) + (lk[6] + lk[7]), gs2 = (lk[8] + lk[9]) + (lk[10] + lk[11]), gs3 = (lk[12] + lk[13]) + (lk[14] + lk[15]);
            const float ps0 = xpartner32(gs0, hh), ps1 = xpartner32(gs1, hh), ps2 = xpartner32(gs2, hh), ps3 = xpartner32(gs3, hh);
            const float pc3 = ps3, pc2 = pc3 + ps2, pc1 = pc2 + ps1, pc0 = pc1 + ps0;
            float base[4];
            base[3] = L + (hh ? 0.f : pc3);
            base[2] = L + gs3 + (hh ? pc3 : pc2);
            base[1] = L + (gs3 + gs2) + (hh ? pc2 : pc1);
            base[0] = L + (gs3 + gs2 + gs1) + (hh ? pc1 : pc0);
            float a[16];
#pragma unroll
            for (int g = 0; g < 4; ++g) {
                float c = base[g];
#pragma unroll
                for (int e = 3; e >= 0; --e) {
                    const int r = 4 * g + e; c += lk[r];
                    const int kk = e + 8 * g + 4 * hh; const bool valid = (j0 + kk) < qi;
                    a[r] = valid ? exp2f(z[r] + c) : 0.f;
                }
            }
            L += (gs0 + gs1 + gs2 + gs3) + pc0;
            u32x4 pw0, pw1;
            pw0.x = pk2(a[0], a[1]); pw0.y = pk2(a[2], a[3]); pw0.z = pk2(a[4], a[5]); pw0.w = pk2(a[6], a[7]);
            pw1.x = pk2(a[8], a[9]); pw1.y = pk2(a[10], a[11]); pw1.z = pk2(a[12], a[13]); pw1.w = pk2(a[14], a[15]);
            const bf16x8 pf0 = __builtin_bit_cast(bf16x8, pw0), pf1 = __builtin_bit_cast(bf16x8, pw1);
#pragma unroll
            for (int mt = 0; mt < 2; ++mt) {
                const bf16_t* vr = VT + (32 * mt + n) * SB_VT_STRIDE + 4 * hh;
                u32x4 v0, v1;
                { const u32x2 x = *(const u32x2*)(vr), y = *(const u32x2*)(vr + 8); v0.x = x.x; v0.y = x.y; v0.z = y.x; v0.w = y.y; }
                { const u32x2 x = *(const u32x2*)(vr + 16), y = *(const u32x2*)(vr + 24); v1.x = x.x; v1.y = x.y; v1.z = y.x; v1.w = y.y; }
                if (mt == 0) { o0 = __builtin_amdgcn_mfma_f32_32x32x16_bf16(__builtin_bit_cast(bf16x8, v0), pf0, o0, 0, 0, 0); o0 = __builtin_amdgcn_mfma_f32_32x32x16_bf16(__builtin_bit_cast(bf16x8, v1), pf1, o0, 0, 0, 0); }
                else { o1 = __builtin_amdgcn_mfma_f32_32x32x16_bf16(__builtin_bit_cast(bf16x8, v0), pf0, o1, 0, 0, 0); o1 = __builtin_amdgcn_mfma_f32_32x32x16_bf16(__builtin_bit_cast(bf16x8, v1), pf1, o1, 0, 0, 0); }
            }
            const bool done = L < -152.f;
            if (__all(done)) break;
        }
        {
            bf16_t* yp = YA + ((size_t)b * SEQ + (qi - NMETA)) * 512 + h * 64 + 4 * hh;
#pragma unroll
            for (int g = 0; g < 4; ++g) {
                u32x2 w; w.x = pk2(o0[4 * g], o0[4 * g + 1]); w.y = pk2(o0[4 * g + 2], o0[4 * g + 3]); *(u32x2*)(yp + 8 * g) = w;
                w.x = pk2(o1[4 * g], o1[4 * g + 1]); w.y = pk2(o1[4 * g + 2], o1[4 * g + 3]); *(u32x2*)(yp + 32 + 8 * g) = w;
            }
        }
    }
}

constexpr int DSA_NQ = 8;
constexpr int DSA_SCS = 4608;
constexpr int DSA_KVB = 0, DSA_RING = 18432, DSA_IDX = DSA_NQ * DSA_RING, DSA_MISC = DSA_IDX + DSA_NQ * 1024, DSA_LDS = DSA_MISC + 512;
static_assert(DSA_NQ * DSA_SCS * 4 <= DSA_IDX, "score rows fit under the index lists");
__device__ __forceinline__ unsigned fkey(float f) { const unsigned u = __float_as_uint(f); return (u & 0x80000000u) ? ~u : (u | 0x80000000u); }
__device__ __forceinline__ int wave_sum_i32(int v) {
    v += __builtin_amdgcn_update_dpp(0, v, 0xB1, 0xF, 0xF, false);
    v += __builtin_amdgcn_update_dpp(0, v, 0x4E, 0xF, 0xF, false);
    v += __builtin_amdgcn_update_dpp(0, v, 0x141, 0xF, 0xF, false);
    v += __builtin_amdgcn_update_dpp(0, v, 0x140, 0xF, 0xF, false);
    return __builtin_amdgcn_readlane(v, 0) + __builtin_amdgcn_readlane(v, 16) + __builtin_amdgcn_readlane(v, 32) + __builtin_amdgcn_readlane(v, 48);
}
__device__ __forceinline__ int wave_excl_scan_i32(int c, int lane, int& total) {
    int x = c;
    x += __builtin_amdgcn_update_dpp(0, x, 0x111, 0xF, 0xF, true);
    x += __builtin_amdgcn_update_dpp(0, x, 0x112, 0xF, 0xF, true);
    x += __builtin_amdgcn_update_dpp(0, x, 0x114, 0xF, 0xF, true);
    x += __builtin_amdgcn_update_dpp(0, x, 0x118, 0xF, 0xF, true);
    const int t0 = __builtin_amdgcn_readlane(x, 15), t1 = __builtin_amdgcn_readlane(x, 31), t2 = __builtin_amdgcn_readlane(x, 47), t3 = __builtin_amdgcn_readlane(x, 63);
    const int row = lane >> 4;
    x += (row > 0 ? t0 : 0) + (row > 1 ? t1 : 0) + (row > 2 ? t2 : 0);
    total = t0 + t1 + t2 + t3;
    return x - c;
}
__device__ __forceinline__ int mbcnt64(unsigned long long m) { return (int)__builtin_amdgcn_mbcnt_hi((unsigned)(m >> 32), __builtin_amdgcn_mbcnt_lo((unsigned)m, 0u)); }
__device__ __forceinline__ void phase_dsa(const Params& p, char* lds) {
    const bf16_t* P = (const bf16_t*)(p.ws + WS_P); bf16_t* OL = (bf16_t*)(p.ws + WS_OLAT);
    const int tid = threadIdx.x, lane = tid & 63, wave = __builtin_amdgcn_readfirstlane(tid >> 6);
    unsigned* SC = (unsigned*)(lds + DSA_KVB);
    unsigned short* IDX = (unsigned short*)(lds + DSA_IDX);
    int* MISC = (int*)(lds + DSA_MISC);
    const unsigned lds_base = (unsigned)(size_t)lds;
    constexpr int NU = SEQ / DSA_NQ;
    for (int unit = blockIdx.x; unit < BATCH * NU; unit += gridDim.x) {
        const int u8 = NU - 1 - unit / BATCH, b = unit % BATCH, t0 = NMETA + u8 * DSA_NQ;
        const int cid = 1 + (t0 - NMETA) / 64, n = NMETA + 64 * cid;
        const bf16_t* Pb = P + (size_t)b * T * PW;
        const int m = lane & 31, hh = lane >> 5;
        bf16x8 aq[2][4]; float wv[2][16];
#pragma unroll
        for (int rt = 0; rt < 2; ++rt) {
#pragma unroll
            for (int s = 0; s < 4; ++s) aq[rt][s] = *(const bf16x8*)(Pb + (size_t)(t0 + 4 * rt + (m >> 3)) * PW + C_QI + (m & 7) * 64 + 16 * s + 8 * hh);
#pragma unroll
            for (int r = 0; r < 16; ++r) wv[rt][r] = bf2f(Pb[(size_t)(t0 + 4 * rt + (r >> 2)) * PW + C_WI + (r & 3) + 4 * hh]);
        }
        const unsigned char* KIPb = p.ws + WS_KIP + (size_t)b * KIP_BATCH + lane * 16;
        bf16x8 bk[4];
#pragma unroll
        for (int s = 0; s < 4; ++s) bk[s] = *(const bf16x8*)(KIPb + (size_t)wave * 4096 + s * 1024);
        __syncthreads();
        {
            const int ntile = (n + 31) / 32;
            for (int kt = wave; kt < ntile; kt += NWAVES) {
                const int j0 = kt * 32, key = j0 + m;
                bf16x8 bn[4];
                { const int ktn = kt + NWAVES < 129 ? kt + NWAVES : 128;
#pragma unroll
                  for (int s = 0; s < 4; ++s) bn[s] = *(const bf16x8*)(KIPb + (size_t)ktn * 4096 + s * 1024); }
                const bool ok = key < n;
#pragma unroll
                for (int rt = 0; rt < 2; ++rt) {
                    f32x16 acc;
#pragma unroll
                    for (int r = 0; r < 16; ++r) acc[r] = 0.f;
#pragma unroll
                    for (int s = 0; s < 4; ++s) acc = __builtin_amdgcn_mfma_f32_32x32x16_bf16(aq[rt][s], bk[s], acc, 0, 0, 0);
                    float tq[4];
#pragma unroll
                    for (int q = 0; q < 4; ++q) {
#define RELU_(x) __builtin_amdgcn_fmed3f((x), 0.f, 3.0e38f)
                        float s = wv[rt][4 * q] * RELU_(acc[4 * q]); s += wv[rt][4 * q + 1] * RELU_(acc[4 * q + 1]); s += wv[rt][4 * q + 2] * RELU_(acc[4 * q + 2]); s += wv[rt][4 * q + 3] * RELU_(acc[4 * q + 3]);
#undef RELU_
                        tq[q] = xsum32(s);
                    }
                    const float s0 = hh ? tq[2] : tq[0], s1 = hh ? tq[3] : tq[1];
                    SC[(4 * rt + 2 * hh) * DSA_SCS + key] = ok ? fkey(s0) : 0u;
                    SC[(4 * rt + 2 * hh + 1) * DSA_SCS + key] = ok ? fkey(s1) : 0u;
                }
#pragma unroll
                for (int s = 0; s < 4; ++s) bk[s] = bn[s];
            }
        }
        __syncthreads();
        bf16x8 qf[5];
        {
            const int hd_ = lane & 15, g_ = lane >> 4;
#pragma unroll
            for (int ks = 0; ks < 5; ++ks) {
                u32x4 w = (u32x4){0u, 0u, 0u, 0u};
                if (hd_ < 8 && (ks < 4 || g_ < 2)) w = *(const u32x4*)(Pb + (size_t)(t0 + wave) * PW + C_QF + hd_ * QFW + 32 * ks + 8 * g_);
                qf[ks] = __builtin_bit_cast(bf16x8, w);
            }
        }
        {
            unsigned* sc = SC + wave * DSA_SCS;
            unsigned v[65];
#pragma unroll
            for (int i = 0; i < 65; ++i) { const int k = i * 64 + lane; v[i] = (k < n) ? sc[k] : 0u; }
            unsigned prefix = 0u; int cge = n, bit = 31;
            bool exact = false;
            if (n >= 256) {
                for (; bit >= 0 && cge > 512; --bit) {
                    const unsigned cand = prefix | (1u << bit); const int sc_ = (int)(cand ^ 0x80000000u);
                    unsigned b0 = 0u, b1 = 0u, b2 = 0u; int slots = 0;
#pragma unroll
                    for (int gi = 0; gi < 5; ++gi) if (gi * 832 < n) {
#pragma unroll
                        for (int i = 13 * gi; i < 13 * gi + 13; ++i) {
                            const unsigned d = (unsigned)__builtin_elementwise_sub_sat((int)(v[i] ^ 0x80000000u), sc_);
                            if (i % 3 == 0) b0 = __builtin_amdgcn_alignbit(b0, d, 31); else if (i % 3 == 1) b1 = __builtin_amdgcn_alignbit(b1, d, 31); else b2 = __builtin_amdgcn_alignbit(b2, d, 31);
                        }
                        slots += 13 * 64;
                    }
                    const int c = slots - wave_sum_i32(__builtin_popcount(b0) + __builtin_popcount(b1) + __builtin_popcount(b2));
                    if (c >= 256) { prefix = cand; cge = c; if (c == 256) { exact = true; break; } }
                }
            }
            int ngt = n;
            if (n >= 256 && !exact) {
                asm volatile("s_waitcnt lgkmcnt(0)" ::: "memory");
                int cb = 0;
                if (bit >= 0) {
                    const int sp_ = (int)((prefix > 0u ? prefix : 1u) ^ 0x80000000u);
                    unsigned lb0 = 0u, lb1 = 0u, lb2 = 0u;
#pragma unroll
                    for (int i = 0; i < 65; ++i) { const unsigned d = (unsigned)__builtin_elementwise_sub_sat((int)(v[i] ^ 0x80000000u), sp_);
                        if (i < 32) lb0 = __builtin_amdgcn_alignbit(lb0, d, 31); else if (i < 64) lb1 = __builtin_amdgcn_alignbit(lb1, d, 31); else lb2 = d >> 31; }
                    const unsigned tk0 = ~lb0, tk1 = ~lb1, tk2 = (~lb2) & 1u;
                    const int c0 = __builtin_popcount(tk0), c1 = __builtin_popcount(tk1);
                    const int lbase = wave_excl_scan_i32(c0 + c1 + (int)tk2, lane, cb);
#pragma unroll
                    for (int i = 0; i < 65; ++i) {
                        bool tkn; int rk;
                        if (i < 32) { tkn = (tk0 >> (31 - i)) & 1u; rk = i == 0 ? 0 : __builtin_popcount(tk0 >> (32 - i)); }
                        else if (i < 64) { tkn = (tk1 >> (63 - i)) & 1u; rk = c0 + (i == 32 ? 0 : __builtin_popcount(tk1 >> (64 - i))); }
                        else { tkn = tk2 != 0u; rk = c0 + c1; }
                        sc[tkn ? lbase + rk : 4096 + (lane & 15)] = v[i];
                    }
                    asm volatile("s_waitcnt lgkmcnt(0)" ::: "memory");
                    unsigned w[8];
#pragma unroll
                    for (int j = 0; j < 8; ++j) { const int k = j * 64 + lane; w[j] = (k < cb) ? sc[k] : 0u; }
                    for (; bit >= 0; --bit) {
                        const unsigned cand = prefix | (1u << bit); const int sc_ = (int)(cand ^ 0x80000000u); unsigned b0 = 0u, b1 = 0u;
#pragma unroll
                        for (int j = 0; j < 8; ++j) { const unsigned d = (unsigned)__builtin_elementwise_sub_sat((int)(w[j] ^ 0x80000000u), sc_); if (j & 1) b1 = __builtin_amdgcn_alignbit(b1, d, 31); else b0 = __builtin_amdgcn_alignbit(b0, d, 31); }
                        const int c = 512 - wave_sum_i32(__builtin_popcount(b0) + __builtin_popcount(b1));
                        if (c >= 256) { prefix = cand; if (c == 256) { exact = true; break; } }
                    }
                    int c = 0;
#pragma unroll
                    for (int j = 0; j < 8; ++j) c += __popcll(__ballot(w[j] > prefix));
                    ngt = c;
                } else {
                    int c = 0;
#pragma unroll
                    for (int i = 0; i < 65; ++i) { c += __popcll(__ballot(v[i] > prefix)); if ((i & 3) == 3) __builtin_amdgcn_sched_barrier(0); }
                    ngt = c;
                }
            }
            const unsigned tau = prefix;
            const int need_eq = n >= 256 ? 256 - ngt : 0; int base = 0, eqb = 0;
            unsigned short* idx = IDX + wave * 512;
            {
                const int st_ = (int)(tau ^ 0x80000000u); unsigned e0 = 0u, e1 = 0u, e2 = 0u;
#pragma unroll
                for (int i = 0; i < 65; ++i) { const unsigned d = (unsigned)__builtin_elementwise_sub_sat((int)(v[i] ^ 0x80000000u), st_);
                    if (i < 32) e0 = __builtin_amdgcn_alignbit(e0, d, 31); else if (i < 64) e1 = __builtin_amdgcn_alignbit(e1, d, 31); else e2 = d >> 31; }
                const unsigned tk0 = ~e0, tk1 = ~e1, tk2 = (~e2) & 1u;
                const int c0 = __builtin_popcount(tk0), c1 = __builtin_popcount(tk1);
                int nge; const int lbase = wave_excl_scan_i32(c0 + c1 + (int)tk2, lane, nge);
                if (n >= 256 && nge == 256) {
#pragma unroll
                    for (int i = 0; i < 65; ++i) {
                        bool tkn; int rk;
                        if (i < 32) { tkn = (tk0 >> (31 - i)) & 1u; rk = i == 0 ? 0 : __builtin_popcount(tk0 >> (32 - i)); }
                        else if (i < 64) { tkn = (tk1 >> (63 - i)) & 1u; rk = c0 + (i == 32 ? 0 : __builtin_popcount(tk1 >> (64 - i))); }
                        else { tkn = tk2 != 0u; rk = c0 + c1; }
                        idx[tkn ? lbase + rk : 256 + lane] = (unsigned short)(i * 64 + lane);
                    }
                    base = nge;
                } else {
#pragma unroll
                    for (int gi = 0; gi < 5; ++gi) if (gi * 832 < n) {
#pragma unroll
                        for (int i = 13 * gi; i < 13 * gi + 13; ++i) {
                            const int k = i * 64 + lane; const unsigned u = v[i];
                            const bool eq = (u == tau); const unsigned long long meq = __ballot(eq);
                            const bool take = (u > tau) || (eq && (eqb + mbcnt64(meq)) < need_eq);
                            const unsigned long long mt = __ballot(take);
                            idx[take ? base + mbcnt64(mt) : 256 + lane] = (unsigned short)k;
                            base += __popcll(mt); eqb += __popcll(meq);
                            if ((i & 3) == 3) __builtin_amdgcn_sched_barrier(0);
                        }
                    }
                }
            }
            for (int pos = base + lane; pos < 256; pos += 64) idx[pos] = 0;
            if (lane == 0) MISC[wave] = base;
        }
        asm volatile("s_waitcnt lgkmcnt(0)" ::: "memory");
        {
            const int q = wave; const int nsel = MISC[q];
            const size_t qrow = (size_t)(t0 + q);
            int ln = lane; asm volatile("" : "+v"(ln));
            const int hd = ln & 15, g = ln >> 4, qd = (ln & 15) >> 2, pp = ln & 3;
            char* ring = lds + DSA_KVB + wave * DSA_RING;
            const unsigned ring_a = lds_base + DSA_KVB + wave * DSA_RING;
            const unsigned short* idx = IDX + q * 512;
            asm volatile("s_waitcnt vmcnt(0)" ::: "memory");
#define DSA_ISSUE(c) do { _Pragma("unroll") for (int i_ = 0; i_ < 9; ++i_) { const int pid_ = ln + 64 * i_, row_ = pid_ / 18, part_ = pid_ - row_ * 18; \
                const bf16_t* src_ = Pb + (size_t)idx[32 * (c) + row_] * PW + C_KV + part_ * 8; \
                __builtin_amdgcn_global_load_lds((const unsigned*)src_, (LAS unsigned*)(ring + ((c) & 1) * 9216 + i_ * 1024), 16, 0, 0); } } while (0)
            DSA_ISSUE(0); DSA_ISSUE(1);
            f32x4 O[8];
#pragma unroll
            for (int nt = 0; nt < 8; ++nt) O[nt] = (f32x4){0.f, 0.f, 0.f, 0.f};
            float mrun = -3e38f, lrun = 0.f;
            for (int c = 0; c < 8; ++c) {
                if (c < 7) asm volatile("s_waitcnt vmcnt(9)" ::: "memory"); else asm volatile("s_waitcnt vmcnt(0)" ::: "memory");
                const char* buf = ring + (c & 1) * 9216;
                f32x4 S0 = (f32x4){0.f, 0.f, 0.f, 0.f}, S1 = S0;
                {
                    const char* kr = buf + hd * 288 + 16 * g;
#pragma unroll
                    for (int ks = 0; ks < 4; ++ks) { S0 = __builtin_amdgcn_mfma_f32_16x16x32_bf16(*(const bf16x8*)(kr + 64 * ks), qf[ks], S0, 0, 0, 0); S1 = __builtin_amdgcn_mfma_f32_16x16x32_bf16(*(const bf16x8*)(kr + 16 * 288 + 64 * ks), qf[ks], S1, 0, 0, 0); }
                    u32x4 w0 = (u32x4){0u, 0u, 0u, 0u}, w1 = w0; if (g < 2) { w0 = *(const u32x4*)(kr + 256); w1 = *(const u32x4*)(kr + 16 * 288 + 256); }
                    S0 = __builtin_amdgcn_mfma_f32_16x16x32_bf16(__builtin_bit_cast(bf16x8, w0), qf[4], S0, 0, 0, 0); S1 = __builtin_amdgcn_mfma_f32_16x16x32_bf16(__builtin_bit_cast(bf16x8, w1), qf[4], S1, 0, 0, 0);
                }
                float cm = -3e38f;
#pragma unroll
                for (int r = 0; r < 4; ++r) { if (nsel < 256) { const int sl = 32 * c + 4 * g + r; S0[r] = sl < nsel ? S0[r] : -1e30f; S1[r] = (sl + 16) < nsel ? S1[r] : -1e30f; } cm = fmaxf(cm, fmaxf(S0[r], S1[r])); }
                cm = xmax16(xmax32(cm));
                if (__any(cm > mrun + 6.f)) {
                    const float mnew = fmaxf(mrun, cm), alpha = exp2f(mrun - mnew);
                    lrun *= alpha; mrun = mnew;
#pragma unroll
                    for (int nt = 0; nt < 8; ++nt) O[nt] *= alpha;
                }
                float ps = 0.f;
#pragma unroll
                for (int r = 0; r < 4; ++r) { S0[r] = exp2f(S0[r] - mrun); S1[r] = exp2f(S1[r] - mrun); ps += S0[r] + S1[r]; }
                ps = xsum16(xsum32(ps));
                lrun += ps;
                u32x4 pw; pw.x = pk2(S0[0], S0[1]); pw.y = pk2(S0[2], S0[3]); pw.z = pk2(S1[0], S1[1]); pw.w = pk2(S1[2], S1[3]);
                const bf16x8 pf = __builtin_bit_cast(bf16x8, pw);
                const unsigned va = ring_a + (unsigned)((c & 1) * 9216 + (4 * g + qd) * 288 + 8 * pp);
#pragma unroll
                for (int h2 = 0; h2 < 2; ++h2) {
                    u16x4 x0, x1, x2, x3, y0, y1, y2, y3;
                    asm volatile("ds_read_b64_tr_b16 %0, %8 offset:%9\n\tds_read_b64_tr_b16 %1, %8 offset:%10\n\tds_read_b64_tr_b16 %2, %8 offset:%11\n\tds_read_b64_tr_b16 %3, %8 offset:%12\n\t"
                                 "ds_read_b64_tr_b16 %4, %8 offset:%13\n\tds_read_b64_tr_b16 %5, %8 offset:%14\n\tds_read_b64_tr_b16 %6, %8 offset:%15\n\tds_read_b64_tr_b16 %7, %8 offset:%16\n\ts_waitcnt lgkmcnt(0)"
                                 : "=&v"(x0), "=&v"(x1), "=&v"(x2), "=&v"(x3), "=&v"(y0), "=&v"(y1), "=&v"(y2), "=&v"(y3)
                                 : "v"(va), "i"(128 * h2), "i"(128 * h2 + 32), "i"(128 * h2 + 64), "i"(128 * h2 + 96), "i"(128 * h2 + 4608), "i"(128 * h2 + 4640), "i"(128 * h2 + 4672), "i"(128 * h2 + 4704) : "memory");
#define DSA_PV(nt_, x_, y_) do { bf16x8 vf_; vf_[0] = (short)x_[0]; vf_[1] = (short)x_[1]; vf_[2] = (short)x_[2]; vf_[3] = (short)x_[3]; vf_[4] = (short)y_[0]; vf_[5] = (short)y_[1]; vf_[6] = (short)y_[2]; vf_[7] = (short)y_[3]; \
                    O[nt_] = __builtin_amdgcn_mfma_f32_16x16x32_bf16(vf_, pf, O[nt_], 0, 0, 0); } while (0)
                    DSA_PV(4 * h2 + 0, x0, y0); DSA_PV(4 * h2 + 1, x1, y1); DSA_PV(4 * h2 + 2, x2, y2); DSA_PV(4 * h2 + 3, x3, y3);
                }
                asm volatile("s_waitcnt lgkmcnt(0)" ::: "memory");
                if (c + 2 < 8) DSA_ISSUE(c + 2);
            }
#undef DSA_PV
#undef DSA_ISSUE
            const float inv = 1.f / lrun;
            if (hd < 8) {
                bf16_t* op = OL + ((size_t)b * SEQ + (qrow - NMETA)) * 1024 + hd * 128 + 4 * g;
#pragma unroll
                for (int nt = 0; nt < 8; ++nt) { u32x2 w; w.x = pk2(O[nt][0] * inv, O[nt][1] * inv); w.y = pk2(O[nt][2] * inv, O[nt][3] * inv); *(u32x2*)(op + 16 * nt) = w; }
            }
        }
    }
}

__device__ __forceinline__ void phase_inproj_meta(const Params& p) {
    unsigned char* ws = p.ws; const int tid = threadIdx.x, lane = tid & 63, wave = tid >> 6, fr = lane & 15, fq = lane >> 4;
    const bf16_t* U = (const bf16_t*)(ws + WS_U); const bf16_t* WP = (const bf16_t*)(ws + WS_WP); bf16_t* P = (bf16_t*)(ws + WS_P); const float2* cs = (const float2*)(ws + WS_CS);
    const int gw = blockIdx.x * NWAVES + wave, NGW = gridDim.x * NWAVES;
    for (int nt = gw; nt < PW / 16; nt += NGW) {
        const bf16_t* ap = U + (size_t)fr * D + 8 * fq; const bf16_t* bp = WP + (size_t)(16 * nt + fr) * D + 8 * fq;
        f32x4 acc = (f32x4){0.f, 0.f, 0.f, 0.f};
#pragma unroll 8
        for (int ks = 0; ks < D / 32; ++ks) acc = __builtin_amdgcn_mfma_f32_16x16x32_bf16(*(const bf16x8*)(bp + 32 * ks), *(const bf16x8*)(ap + 32 * ks), acc, 0, 0, 0);
        const int col = 16 * nt + 4 * fq, t = fr; f32x4 v = acc; int o;
        if (pg8::rope_off(col, o)) { const float2 c0 = cs[t * 8 + (o >> 1)], c1 = cs[t * 8 + (o >> 1) + 1]; v = (f32x4){v.x * c0.x - v.y * c0.y, v.y * c0.x + v.x * c0.y, v.z * c1.x - v.w * c1.y, v.w * c1.x + v.z * c1.y}; }
        u32x2 w; w.x = pk2(v.x, v.y); w.y = pk2(v.z, v.w);
        for (int b = 0; b < BATCH; ++b) {
            if (col >= C_KI && col < C_WI) { const int d0 = col - C_KI;
                *(u32x2*)(ws + WS_KIP + (size_t)b * KIP_BATCH + (size_t)((((t >> 5) * 4 + (d0 >> 4)) * 2 + ((d0 >> 3) & 1)) * 512 + (t & 31) * 16 + (d0 & 7) * 2)) = w; }
            else *(u32x2*)(P + ((size_t)b * T + t) * PW + col) = w;
        }
    }
}

__device__ __forceinline__ void phase_c3(const Params& p, char* lds) {
    unsigned char* ws = p.ws; const int tid = threadIdx.x, lane = tid & 63, wave = __builtin_amdgcn_readfirstlane(tid >> 6);
    const float* H1 = (const float*)(ws + WS_H1); const float* g = p.in[I_GFFN];
    {
        bf16_t* U2 = (bf16_t*)(ws + WS_U); const int gw = blockIdx.x * NWAVES + wave, NGW = gridDim.x * NWAVES;
        for (int row = gw; row < NR; row += NGW) {
            const f32x4* xr = (const f32x4*)(H1 + (size_t)row * D) + lane;
            f32x4 v[4]; float s = 0.f;
#pragma unroll
            for (int j = 0; j < 4; ++j) { v[j] = xr[64 * j]; s += (v[j].x * v[j].x + v[j].y * v[j].y) + (v[j].z * v[j].z + v[j].w * v[j].w); }
            const float rstd = rsqrtf(wave_sum(s) * (1.f / D) + NORM_EPS);
            u32x2* o = (u32x2*)(U2 + (size_t)row * D) + lane;
#pragma unroll
            for (int j = 0; j < 4; ++j) { const f32x4 gg = ((const f32x4*)g)[lane + 64 * j];
                u32x2 w; w.x = pk2(v[j].x * rstd * gg.x, v[j].y * rstd * gg.y); w.y = pk2(v[j].z * rstd * gg.z, v[j].w * rstd * gg.w); o[64 * j] = w; }
        }
    }
    {
        float* Tl = (float*)lds;
        float* RED = (float*)lds;
        const float* wg = p.in[I_WGRP]; const float* wr = p.in[I_WRT]; const float* bg = p.in[I_BGRP]; const float* br = p.in[I_BRT];
        unsigned* ctl = (unsigned*)(ws + WS_CTL); int* LIST = (int*)(ws + WS_LIST); float* GATE = (float*)(ws + WS_GATE);
        const int tk = tid & 127, kq = wave >> 1;
        for (int grp = blockIdx.x; grp < NR / 128; grp += gridDim.x) {
            const int tok0 = grp * 128;
            float acc[36]; float ss = 0.f;
#pragma unroll
            for (int o = 0; o < 36; ++o) acc[o] = 0.f;
            for (int step = 0; step < 8; ++step) {
                __syncthreads();
#pragma unroll
                for (int i = 0; i < 8; ++i) { const int idx = tid + NTHREADS * i, qq = idx >> 10, rem = idx & 1023, t2 = rem >> 3, kc = rem & 7;
                    const f32x4 v = *(const f32x4*)(H1 + (size_t)(tok0 + t2) * D + qq * 256 + step * 32 + kc * 4);
                    float* d = Tl + qq * (32 * 129) + (kc * 4) * 129 + t2; d[0] = v.x; d[129] = v.y; d[258] = v.z; d[387] = v.w; }
                __syncthreads();
                const int kb = kq * 256 + step * 32;
#pragma unroll 4
                for (int k = 0; k < 32; ++k) {
                    const float h = Tl[kq * (32 * 129) + k * 129 + tk]; ss += h * h; const float hg = h * g[kb + k];
                    const float* w4 = wg + (size_t)(kb + k) * 4; const float* w32 = wr + (size_t)(kb + k) * 32;
#pragma unroll
                    for (int o = 0; o < 4; ++o) acc[o] += hg * w4[o];
#pragma unroll
                    for (int o = 0; o < 32; ++o) acc[4 + o] += hg * w32[o];
                }
            }
            __syncthreads();
#pragma unroll
            for (int o = 0; o < 36; ++o) RED[(kq * 37 + o) * 128 + tk] = acc[o];
            RED[(kq * 37 + 36) * 128 + tk] = ss;
            __syncthreads();
            if (tid < 128) {
                const int tok = tok0 + tk;
#pragma unroll
                for (int o = 0; o < 36; ++o) acc[o] = (RED[o * 128 + tk] + RED[(37 + o) * 128 + tk]) + (RED[(74 + o) * 128 + tk] + RED[(111 + o) * 128 + tk]);
                ss = (RED[36 * 128 + tk] + RED[(37 + 36) * 128 + tk]) + (RED[(74 + 36) * 128 + tk] + RED[(111 + 36) * 128 + tk]);
                const float rstd = rsqrtf(ss * (1.f / D) + NORM_EPS);
                float gl[4]; int gs = 0; float gm;
#pragma unroll
                for (int o = 0; o < 4; ++o) gl[o] = acc[o] * rstd + bg[o];
                gm = gl[0];
#pragma unroll
                for (int o = 1; o < 4; ++o) if (gl[o] > gm) { gm = gl[o]; gs = o; }
                float gsum = 0.f;
#pragma unroll
                for (int o = 0; o < 4; ++o) gsum += __expf(gl[o] - gm);
                const float pgrp = 1.f / gsum;
                float el[8];
#pragma unroll
                for (int j = 0; j < 8; ++j) { float a = acc[4 + j]; float bb = br[j];
                    a = gs == 1 ? acc[12 + j] : a; bb = gs == 1 ? br[8 + j] : bb; a = gs == 2 ? acc[20 + j] : a; bb = gs == 2 ? br[16 + j] : bb; a = gs == 3 ? acc[28 + j] : a; bb = gs == 3 ? br[24 + j] : bb;
                    el[j] = a * rstd + bb; }
                int e0 = 0; float m0 = el[0];
#pragma unroll
                for (int j = 1; j < 8; ++j) if (el[j] > m0) { m0 = el[j]; e0 = j; }
                int e1 = -1; float m1 = -3e38f;
#pragma unroll
                for (int j = 0; j < 8; ++j) if (j != e0 && el[j] > m1) { m1 = el[j]; e1 = j; }
                const float x1 = __expf(m1 - m0); const float g0 = pgrp / (1.f + x1), g1 = pgrp * x1 / (1.f + x1);
                const int ex0 = gs * 8 + e0, ex1 = gs * 8 + e1;
                const int s0 = (int)atomicAdd(ctl + CW_CNT + 64 * ex0, 1u); LIST[(size_t)ex0 * NR + s0] = tok * 2;
                const int s1 = (int)atomicAdd(ctl + CW_CNT + 64 * ex1, 1u); LIST[(size_t)ex1 * NR + s1] = tok * 2 + 1;
                GATE[tok * 2] = g0; GATE[tok * 2 + 1] = g1;
            }
        }
    }
}

template <int WHICH>
__device__ __forceinline__ void phase_moe(const Params& p, char* lds) {
    unsigned char* ws = p.ws; const int tid = threadIdx.x;
    const unsigned* ctl = (const unsigned*)(ws + WS_CTL);
    int* TP = (int*)(lds + pg8::STAGE_BYTES);
    __syncthreads();
    if (tid == 0) { int tp = 0, ro = 0; for (int e = 0; e < NEXP; ++e) { const int c = (int)ctl[CW_CNT + 64 * e]; TP[e] = tp; TP[64 + e] = ro; TP[128 + e] = c; const int t = (c + 255) / 256; tp += t * 4; ro += t * 256; } TP[NEXP] = tp; }
    __syncthreads();
    pg8::MoeOrder<WHICH> S{TP, (int)gridDim.x, (int)blockIdx.x, (const char*)(ws + (WHICH == 0 ? WS_U : WS_HID)), (const char*)(ws + (WHICH == 0 ? WS_W13 : WS_W2)), (const int*)(ws + WS_LIST)};
    if constexpr (WHICH == 0) { pg8::EpiMoe1 E{(bf16_t*)(ws + WS_HID), TP}; pg8::gemm_phase_x<pg8::EpiMoe1, pg8::MoeOrder<0>, true, true>((LAS unsigned char*)lds, 1024, S, E); }
    else { pg8::EpiMoe2 E{(bf16_t*)(ws + WS_MO), TP, (const int*)(ws + WS_LIST), (const float*)(ws + WS_GATE)}; pg8::gemm_phase_x<pg8::EpiMoe2, pg8::MoeOrder<1>, true, true>((LAS unsigned char*)lds, 512, S, E); }
}

__device__ __forceinline__ void phase_final(const Params& p) {
    unsigned char* ws = p.ws; const int tid = threadIdx.x, lane = tid & 63, wave = tid >> 6;
    const float* H1 = (const float*)(ws + WS_H1); const bf16_t* MO = (const bf16_t*)(ws + WS_MO); const float* g = p.in[I_GFIN];
    const int gw = blockIdx.x * NWAVES + wave, NGW = gridDim.x * NWAVES;
    for (int orow = gw; orow < BATCH * SEQ; orow += NGW) {
        const size_t row = (size_t)orow;
        const f32x4* xr = (const f32x4*)(H1 + row * D) + lane; const u32x2* m0 = (const u32x2*)(MO + row * 2 * D) + lane; const u32x2* m1 = m0 + 256;
        f32x4 v[4]; float ss = 0.f;
#pragma unroll
        for (int j = 0; j < 4; ++j) { const u32x2 a = m0[64 * j], c = m1[64 * j]; v[j] = xr[64 * j];
            v[j].x += bflo(a.x) + bflo(c.x); v[j].y += bfhi(a.x) + bfhi(c.x); v[j].z += bflo(a.y) + bflo(c.y); v[j].w += bfhi(a.y) + bfhi(c.y);
            ss += (v[j].x * v[j].x + v[j].y * v[j].y) + (v[j].z * v[j].z + v[j].w * v[j].w); }
        const float rstd = rsqrtf(wave_sum(ss) * (1.f / D) + NORM_EPS);
        f32x4* o = (f32x4*)(p.out + (size_t)orow * D) + lane;
#pragma unroll
        for (int j = 0; j < 4; ++j) { const f32x4 gg = ((const f32x4*)g)[lane + 64 * j]; o[64 * j] = v[j] * rstd * gg; }
    }
}

#define XB_TMO      128
#define XB_XCNT(j)  (256  + 64 * (j))
#define XB_XSUB(j)  (1280 + 64 * (j))
#define XB_XGEN(j)  (2304 + 64 * (j))
#define XB_TOP      3328
#define XB_TOPGEN   3392
#define XCD_BAR_WORDS 3456
#define XB_SPIN_CAP (1u << 18)
__device__ __forceinline__ unsigned xb_ld(unsigned* p)              { return __hip_atomic_load(p, __ATOMIC_RELAXED, __HIP_MEMORY_SCOPE_AGENT); }
__device__ __forceinline__ unsigned xb_add(unsigned* p, unsigned v) { return __hip_atomic_fetch_add(p, v, __ATOMIC_RELAXED, __HIP_MEMORY_SCOPE_AGENT); }
__device__ __forceinline__ unsigned xb_xcc_id() { return (unsigned)__builtin_amdgcn_s_getreg((3 << 11) | 20) & 0xFu; }
#define XB_SPIN(cond, bar) do { unsigned _sp = 0; while (cond) { __builtin_amdgcn_s_sleep(1); \
    if ((++_sp & 255u) == 0u) { if (xb_ld(&(bar)[XB_TMO])) break; if (_sp > XB_SPIN_CAP) { atomicAdd(&(bar)[XB_TMO], 1u); break; } } } } while (0)
struct XcdBarrier { unsigned* bar; unsigned x; volatile LAS unsigned* st; };
__device__ __forceinline__ XcdBarrier xcd_barrier_post(unsigned* bar, volatile LAS unsigned* st) {
    XcdBarrier b; b.bar = bar; b.x = xb_xcc_id(); b.st = st;
    if (threadIdx.x == 0) (void)xb_add(&bar[XB_XCNT(b.x)], 1u);
    return b;
}
__device__ __forceinline__ void xcd_barrier_complete(unsigned* bar, unsigned x, unsigned& nloc, unsigned& nx) {
    const unsigned G = gridDim.x * gridDim.y * gridDim.z;
    unsigned sum, cnt, mine, sp = 0u;
    for (;;) {
        sum = 0u; cnt = 0u; mine = 0u;
#pragma unroll
        for (unsigned j = 0; j < 16; ++j) { const unsigned c = xb_ld(&bar[XB_XCNT(j)]); sum += c; cnt += (c > 0u) ? 1u : 0u; mine = (j == x) ? c : mine; }
        if (sum == G) break;
        __builtin_amdgcn_s_sleep(1);
        if ((++sp & 255u) == 0u) { if (xb_ld(&bar[XB_TMO])) break; if (sp > XB_SPIN_CAP) { atomicAdd(&bar[XB_TMO], 1u); break; } }
    }
    nloc = mine > 0u ? mine : 1u; nx = cnt > 0u ? cnt : 1u;
}
__device__ __forceinline__ void xcd_barrier(const XcdBarrier& b) {
    asm volatile("s_waitcnt vmcnt(0)" ::: "memory");
    __syncthreads();
    if (threadIdx.x == 0) {
        unsigned* bar = b.bar;
        __builtin_amdgcn_s_waitcnt(0);
        unsigned nloc = b.st[0], nx = b.st[1];
        if (nloc == 0u) { xcd_barrier_complete(bar, b.x, nloc, nx); b.st[0] = nloc; b.st[1] = nx; }
        const unsigned old = xb_add(&bar[XB_XSUB(b.x)], 1u);
        const unsigned gen = old / nloc;
        if (old + 1u == (gen + 1u) * nloc) {
            __builtin_amdgcn_fence(__ATOMIC_RELEASE, "agent");
            asm volatile("s_waitcnt vmcnt(0)" ::: "memory");
            const unsigned og = xb_add(&bar[XB_TOP], 1u);
            const unsigned tg = og / nx;
            if (og + 1u == (tg + 1u) * nx) xb_add(&bar[XB_TOPGEN], 1u);
            else XB_SPIN(xb_ld(&bar[XB_TOPGEN]) == tg, bar);
            __builtin_amdgcn_fence(__ATOMIC_ACQUIRE, "agent");
            xb_add(&bar[XB_XGEN(b.x)], 1u);
            asm volatile("s_waitcnt vmcnt(0)" ::: "memory");
        } else {
            XB_SPIN(xb_ld(&bar[XB_XGEN(b.x)]) == gen, bar);
            __builtin_amdgcn_fence(__ATOMIC_ACQUIRE, "agent");
            asm volatile("s_waitcnt vmcnt(0)" ::: "memory");
        }
    }
    __syncthreads();
}

constexpr int LDS_XB = DSA_LDS;
constexpr int LDS_BYTES = DSA_LDS + 256;
static_assert(pg8::STAGE_BYTES <= LDS_XB && pg8::STAGE_BYTES + 1024 <= LDS_XB && NWAVES * 64 * 33 * 4 <= LDS_XB && NWAVES * 64 * SB_VT_STRIDE * 2 <= LDS_XB && 4 * 37 * 128 * 4 <= LDS_XB, "LDS map");

__global__ void __launch_bounds__(NTHREADS, 2) mega(Params p) {
    extern __shared__ __attribute__((aligned(16))) char lds[];
    const int lo = p.ph_lo, hi = p.ph_hi;
    unsigned char* ws = p.ws;
    XcdBarrier xb;
    {
        volatile LAS unsigned* st = (volatile LAS unsigned*)(lds + LDS_XB);
        if (threadIdx.x < 4) st[threadIdx.x] = 0u;
        __syncthreads();
        xb = xcd_barrier_post((unsigned*)(ws + WS_CTL) + CW_BAR, st);
    }
#define IN(k) (lo <= (k) && (k) < hi)
#define GSYNC() xcd_barrier(xb)
#define SEAM(k) do { if (IN(k) && IN((k) + 1)) GSYNC(); } while (0)
#define REP(k, ...) do { if (IN(k)) { __VA_ARGS__; } } while (0)
    LAS unsigned char* ldsl = (LAS unsigned char*)lds;
    REP(0, phase_prologue(p, lds));
    SEAM(0);
    REP(1, { phase_inproj_meta(p);
             pg8::TokRowOrder S; S.init(NR, PWN, gridDim.x, blockIdx.x); S.Abase = (const char*)(ws + WS_U); S.Bbase = (const char*)(ws + WS_WP); S.K = D;
             pg8::EpiInproj E{(bf16_t*)(ws + WS_P), (const float2*)(ws + WS_CS), ws + WS_KIP}; pg8::gemm_phase_x<pg8::EpiInproj, pg8::TokRowOrder, true, true>(ldsl, D, S, E); });
    SEAM(1);
    if (IN(2)) {
        phase_dsa(p, lds);
        __syncthreads(); phase_sb_fast(p, lds);
    }
    SEAM(2);
    REP(3, { pg8::TokRowOrder S; S.init(NR, 2048, gridDim.x, blockIdx.x); S.Abase = (const char*)(ws + WS_U); S.Bbase = (const char*)(ws + WS_WG); S.K = D;
             pg8::EpiGate E{(bf16_t*)(ws + WS_G)}; pg8::gemm_phase_x<pg8::EpiGate, pg8::TokRowOrder, true, true>(ldsl, D, S, E); });
    SEAM(3);
    REP(4, { { pg8::Gemm g{(const bf16_t*)(ws + WS_YA), (const bf16_t*)(ws + WS_WUA), NR, D, 512}; pg8::StaticOrder S; S.init(NR, D, gridDim.x, blockIdx.x);
               pg8::EpiZ<false> E{(bf16_t*)(ws + WS_Z), (const bf16_t*)(ws + WS_G), 0}; pg8::gemm_phase<pg8::EpiZ<false>, pg8::StaticOrder, true, true>(ldsl, g, S, E); }
             asm volatile("s_waitcnt vmcnt(0)" ::: "memory"); __syncthreads();
             { pg8::Gemm g{(const bf16_t*)(ws + WS_OLAT), (const bf16_t*)(ws + WS_WBP), NR, D, D}; pg8::StaticOrder S; S.init(NR, D, gridDim.x, blockIdx.x);
               pg8::EpiZ<true> E{(bf16_t*)(ws + WS_Z), (const bf16_t*)(ws + WS_G), 1024}; pg8::gemm_phase<pg8::EpiZ<true>, pg8::StaticOrder, true, true>(ldsl, g, S, E); } });
    SEAM(4);
    REP(5, { pg8::Gemm g{(const bf16_t*)(ws + WS_Z), (const bf16_t*)(ws + WS_WO), NR, D, D}; pg8::StaticOrder S; S.init(NR, D, gridDim.x, blockIdx.x);
             pg8::EpiH1 E{(float*)(ws + WS_H1), p.in[I_META], p.in[I_X]}; pg8::gemm_phase<pg8::EpiH1, pg8::StaticOrder, true, true>(ldsl, g, S, E); });
    SEAM(5);
    if (IN(6)) phase_c3(p, lds);
    SEAM(6);
    REP(7, phase_moe<0>(p, lds));
    SEAM(7);
    REP(8, phase_moe<1>(p, lds));
    SEAM(8);
    REP(9, phase_final(p));
}

extern "C" void kernel_launch(void* const* d_in, const int* in_sizes, int n_in, void* d_out, int out_size, void* d_ws, size_t ws_size, hipStream_t stream) {
    if (n_in != 18 || ws_size < WS_END) { fprintf(stderr, "kernel_launch: unexpected n_in %d / ws_size %zu\n", n_in, ws_size); return; }
    static int grid = 0;
    if (grid == 0) {
        int dev = 0, cus = 0, per_cu = 0;
        (void)hipGetDevice(&dev);
        (void)hipDeviceGetAttribute(&cus, hipDeviceAttributeMultiprocessorCount, dev);
        (void)hipFuncSetAttribute((const void*)mega, hipFuncAttributeMaxDynamicSharedMemorySize, LDS_BYTES);
        (void)hipOccupancyMaxActiveBlocksPerMultiprocessor(&per_cu, (const void*)mega, NTHREADS, LDS_BYTES);
        if (per_cu < 1) fprintf(stderr, "kernel_launch: occupancy query reports %d workgroups per CU\n", per_cu);
        grid = cus;
    }
    (void)hipMemsetAsync((char*)d_ws + WS_CTL, 0, CTL_BYTES, stream);
    Params p{};
    for (int i = 0; i < 18; ++i) p.in[i] = (const float*)d_in[i];
    p.out = (float*)d_out; p.ws = (unsigned char*)d_ws;
    p.ph_lo = 0; p.ph_hi = 10;
    void* args[] = {&p};
    hipError_t e = hipLaunchCooperativeKernel((const void*)mega, dim3(grid), dim3(NTHREADS), args, LDS_BYTES, stream);
    if (e != hipSuccess) fprintf(stderr, "cooperative launch failed: %s (grid %d)\n", hipGetErrorString(e), grid);
}
```

```cpp
#include <hip/hip_runtime.h>
#include <cstdio>
#include <cstdint>

constexpr int BATCH = 8, SEQ = 4096, NMETA = 16, T = SEQ + NMETA, D = 1024, NTOK = BATCH * T;
constexpr int MROWS = 33024;
constexpr int NR = BATCH * SEQ;
__device__ __forceinline__ int tokrow(int cr) { return cr + NMETA * (cr / SEQ + 1); }
constexpr int INW = 4824;
constexpr int NEXP = 32, DEXP = 512;
constexpr int NWAVES = 8, NTHREADS = 512;
constexpr float NORM_EPS = 1e-6f;
constexpr float LOG2E = 1.4426950408889634f;
constexpr float QSCALE = 0.125f * LOG2E;
constexpr int PW = 3456, PWN = 3584;
constexpr int C_QA = 0, C_KA = 512, C_VA = 1024, C_QF = 1536, C_KV = 2688, C_QI = 2832, C_KI = 3344, C_WI = 3408, C_END = 3416;
constexpr int QFW = 144;

constexpr size_t MiB = 1u << 20;
constexpr size_t WS_CTL = 0, CTL_BYTES = 1 * MiB;
constexpr size_t WS_CS = 1 * MiB;
constexpr size_t WS_WP = 2 * MiB;
constexpr size_t WS_WG = 9 * MiB;
constexpr size_t WS_WUA = 13 * MiB, WS_WBP = 14 * MiB, WS_WO = 16 * MiB;
constexpr size_t WS_W2 = 18 * MiB;
constexpr size_t WS_W13 = 50 * MiB;
constexpr size_t WS_U = 114 * MiB;
constexpr size_t WS_P = 179 * MiB;
constexpr size_t WS_Z = 179 * MiB;
constexpr size_t WS_G = 244 * MiB;
constexpr size_t WS_H1 = 244 * MiB;
constexpr size_t WS_LIST = 374 * MiB;
constexpr size_t WS_GATE = 379 * MiB;
constexpr size_t WS_YA = 397 * MiB;
constexpr size_t WS_OLAT = 430 * MiB;
constexpr size_t WS_HID = 397 * MiB;
constexpr size_t WS_MO = 50 * MiB;
constexpr size_t WS_KIP = 495 * MiB;
constexpr size_t KIP_BATCH = 129 * 4096;
constexpr size_t WS_END = 500 * MiB;
static_assert(WS_P + (size_t)MROWS * PW * 2 <= WS_YA && WS_G + (size_t)MROWS * 2048 * 2 <= WS_LIST && WS_Z + (size_t)MROWS * 1024 * 2 <= WS_G, "ws map");
static_assert(WS_OLAT + (size_t)MROWS * 1024 * 2 <= WS_END && WS_U + (size_t)MROWS * 1024 * 2 <= WS_P && WS_MO + (size_t)NTOK * 2048 * 2 <= WS_P, "ws map");
constexpr int CW_CNT = 1024;
constexpr int CW_BAR = 4096;

typedef unsigned short bf16_t;
typedef short bf16x8 __attribute__((ext_vector_type(8)));
typedef float f32x4 __attribute__((ext_vector_type(4)));
typedef float f32x16 __attribute__((ext_vector_type(16)));
typedef unsigned u32x2 __attribute__((ext_vector_type(2)));
typedef unsigned u32x4 __attribute__((ext_vector_type(4)));
typedef unsigned short u16x4 __attribute__((ext_vector_type(4)));
#define LAS __attribute__((address_space(3)))

__device__ __forceinline__ unsigned f2bf(float f) { unsigned u = __float_as_uint(f); return (u + 0x7fffu + ((u >> 16) & 1u)) >> 16; }
typedef __bf16 bf16v2_t __attribute__((ext_vector_type(2)));
typedef float f32v2_t __attribute__((ext_vector_type(2)));
__device__ __forceinline__ unsigned pk2(float lo, float hi) { const f32v2_t v = {lo, hi}; const bf16v2_t r = __builtin_convertvector(v, bf16v2_t); return __builtin_bit_cast(unsigned, r); }
__device__ __forceinline__ float bflo(unsigned w) { return __uint_as_float(w << 16); }
__device__ __forceinline__ float bfhi(unsigned w) { return __uint_as_float(w & 0xffff0000u); }
__device__ __forceinline__ float bf2f(bf16_t b) { return __uint_as_float((unsigned)b << 16); }
__device__ __forceinline__ float wave_sum(float v) {
#pragma unroll
    for (int o = 1; o < 64; o <<= 1) v += __shfl_xor(v, o);
    return v;
}
__device__ __forceinline__ float fmax2(float a, float b) { return __builtin_amdgcn_fmed3f(a, b, 3.0e38f); }
__device__ __forceinline__ float xsum32(float x) { const auto r = __builtin_amdgcn_permlane32_swap(__float_as_uint(x), __float_as_uint(x), false, false); return __uint_as_float(r[0]) + __uint_as_float(r[1]); }
__device__ __forceinline__ float xsum16(float x) { const auto r = __builtin_amdgcn_permlane16_swap(__float_as_uint(x), __float_as_uint(x), false, false); return __uint_as_float(r[0]) + __uint_as_float(r[1]); }
__device__ __forceinline__ float xmax32(float x) { const auto r = __builtin_amdgcn_permlane32_swap(__float_as_uint(x), __float_as_uint(x), false, false); return fmax2(__uint_as_float(r[0]), __uint_as_float(r[1])); }
__device__ __forceinline__ float xmax16(float x) { const auto r = __builtin_amdgcn_permlane16_swap(__float_as_uint(x), __float_as_uint(x), false, false); return fmax2(__uint_as_float(r[0]), __uint_as_float(r[1])); }
__device__ __forceinline__ float xpartner32(float x, int hh) { const auto r = __builtin_amdgcn_permlane32_swap(__float_as_uint(x), __float_as_uint(x), false, false); return __uint_as_float(hh ? r[0] : r[1]); }
__device__ __forceinline__ float fexp2(float x) { return __builtin_amdgcn_exp2f(x); }
__device__ __forceinline__ float sigmoidf(float x) { return __builtin_amdgcn_rcpf(1.0f + fexp2(-LOG2E * x)); }

struct Params {
    const float* in[18];
    float* out;
    unsigned char* ws;
    int ph_lo, ph_hi;
};
enum { I_X = 0, I_META, I_GMIX, I_WIN, I_WUK, I_WUV, I_WUPA, I_WUPB, I_WO, I_GFFN, I_WGRP, I_BGRP, I_WRT, I_BRT, I_W1, I_W3, I_W2, I_GFIN };

__device__ __forceinline__ const float* h0_row(const Params& p, int row) {
    const int b = row / T, t = row - b * T;
    return t < NMETA ? p.in[I_META] + (size_t)t * D : p.in[I_X] + ((size_t)b * SEQ + (t - NMETA)) * D;
}
template <class F>
__device__ __forceinline__ void tr_item(F val, bf16_t* dst, int ldd, int row0, int k0, float* scr, int lane, int rstep = 1) {
    float tv[32];
#pragma unroll
    for (int i = 0; i < 32; ++i) tv[i] = val(k0 + 2 * i + (lane >> 5), lane & 31);
#pragma unroll
    for (int i = 0; i < 32; ++i) scr[(2 * i + (lane >> 5)) * 33 + (lane & 31)] = tv[i];
    __builtin_amdgcn_s_waitcnt(0xC07F);
    asm volatile("" ::: "memory");
    const int c = lane & 7;
#pragma unroll
    for (int j = 0; j < 4; ++j) {
        const int n = (lane >> 3) + 8 * j; const float* s = scr + (8 * c) * 33 + n;
        u32x4 o; o.x = pk2(s[0], s[33]); o.y = pk2(s[66], s[99]); o.z = pk2(s[132], s[165]); o.w = pk2(s[198], s[231]);
        *(u32x4*)(dst + (size_t)(row0 + n * rstep) * ldd + k0 + 8 * c) = o;
    }
    __builtin_amdgcn_s_waitcnt(0xC07F);
    asm volatile("" ::: "memory");
}

__device__ __forceinline__ void wp_src(int c, int& kind, int& col, int& aux, float& scale) {
    kind = 1; aux = 0; scale = 1.f; col = 0;
    if (c < 512) { col = c; scale = QSCALE; }
    else if (c < C_QF) { col = c; }
    else if (c < C_KV) { const int r = c - C_QF, h = r / QFW, j = r % QFW; scale = QSCALE;
        if (j < 128) { kind = 2; col = h; aux = j; } else { const int i = j - 128; col = 1536 + 64 * h + (i >> 1) + 8 * (i & 1); } }
    else if (c < C_QI) { const int j = c - C_KV; if (j < 128) col = 2048 + j; else { const int i = j - 128; col = 2176 + (i >> 1) + 8 * (i & 1); } }
    else if (c < C_KI) { const int r = c - C_QI, h = r >> 6, j = r & 63; col = 2192 + 64 * h + (j < 16 ? (j >> 1) + 8 * (j & 1) : j); }
    else if (c < C_WI) { const int j = c - C_KI; col = 2704 + (j < 16 ? (j >> 1) + 8 * (j & 1) : j); }
    else if (c < C_END) { col = 2768 + (c - C_WI); }
    else kind = 0;
}

constexpr int IT_WP = (PWN / 32) * 16;
constexpr int IT_WG = 32 * 16;
constexpr int IT_WUA = 32 * 8;
constexpr int IT_WBP = 32 * 16, IT_WO = 32 * 16;
constexpr int IT_W13 = NEXP * 32 * 16;
constexpr int IT_W2 = NEXP * 32 * 8;
constexpr int IT_TOTAL = IT_WP + 2 * IT_WG + IT_WUA + IT_WBP + IT_WO + IT_W13 + IT_W2;

__device__ __forceinline__ void phase_prologue(const Params& p, char* lds) {
    const int tid = threadIdx.x, lane = tid & 63, wave = tid >> 6;
    const int gw = blockIdx.x * NWAVES + wave, NGW = gridDim.x * NWAVES;
    float* scr = (float*)lds + wave * (64 * 33);
    unsigned char* ws = p.ws;
    const float* w_in = p.in[I_WIN];
    {
        float2* cs = (float2*)(ws + WS_CS);
        for (int i = blockIdx.x * NTHREADS + tid; i < T * 8; i += gridDim.x * NTHREADS) {
            const int pos = i >> 3, f = i & 7;
            const float inv = powf(500000.0f, -(float)f / 8.0f);
            const float ang = (float)pos * inv;
            cs[i] = make_float2(cosf(ang), sinf(ang));
        }
    }
    for (int it = gw; it < IT_TOTAL; it += NGW) {
        int r = it;
        if (r < IT_WP) {
            const int rg = r / 16, kb = r % 16, c = rg * 32 + (lane & 31);
            int kind, col, aux; float scale; wp_src(c, kind, col, aux, scale);
            const float* w_uk = p.in[I_WUK];
            float wu[48];
#pragma unroll
            for (int n4 = 0; n4 < 12; ++n4) { f32x4 t = (f32x4){0.f, 0.f, 0.f, 0.f}; if (kind == 2) t = *(const f32x4*)(w_uk + ((size_t)col * 128 + aux) * 48 + 4 * n4); wu[4 * n4] = t.x; wu[4 * n4 + 1] = t.y; wu[4 * n4 + 2] = t.z; wu[4 * n4 + 3] = t.w; }
            tr_item([&](int k, int) -> float {
                if (kind == 0) return 0.f;
                if (kind == 1) return scale * w_in[(size_t)k * INW + col];
                const f32x4* wi = (const f32x4*)(w_in + (size_t)k * INW + 1536 + 64 * col + 16);
                float s = 0.f;
#pragma unroll
                for (int n4 = 0; n4 < 12; ++n4) { const f32x4 t = wi[n4]; s += t.x * wu[4 * n4] + t.y * wu[4 * n4 + 1] + t.z * wu[4 * n4 + 2] + t.w * wu[4 * n4 + 3]; }
                return scale * s; }, (bf16_t*)(ws + WS_WP), 1024, rg * 32, kb * 64, scr, lane);
            continue; }
        r -= IT_WP;
        if (r < 2 * IT_WG) {
            const int which = r / IT_WG; r %= IT_WG; const int rg = r / 16, kb = r % 16; const int col0 = (which ? 3800 : 2776) + rg * 32;
            tr_item([&](int k, int n) -> float { return w_in[(size_t)k * INW + col0 + n]; }, (bf16_t*)(ws + WS_WG) + (size_t)which * 1024 * 1024, 1024, rg * 32, kb * 64, scr, lane);
            continue; }
        r -= 2 * IT_WG;
        if (r < IT_WUA) {
            const int rg = r / 8, kb = r % 8; const float* w = p.in[I_WUPA];
            tr_item([&](int k, int n) -> float { return w[(size_t)k * 1024 + rg * 32 + n]; }, (bf16_t*)(ws + WS_WUA), 512, rg * 32, kb * 64, scr, lane);
            continue; }
        r -= IT_WUA;
        if (r < IT_WBP) {
            const int rg = r / 16, kb = r % 16; const float* wuv = p.in[I_WUV]; const float* wub = p.in[I_WUPB];
            const int hB = kb >> 1;
            float bc[64];
#pragma unroll
            for (int d = 0; d < 64; ++d) bc[d] = wub[(size_t)(64 * hB + d) * 1024 + rg * 32 + (lane & 31)];
            tr_item([&](int kk, int) -> float {
                const f32x4* a = (const f32x4*)(wuv + (size_t)kk * 64);
                float s = 0.f;
#pragma unroll
                for (int d4 = 0; d4 < 16; ++d4) { const f32x4 t = a[d4]; s += t.x * bc[4 * d4] + t.y * bc[4 * d4 + 1] + t.z * bc[4 * d4 + 2] + t.w * bc[4 * d4 + 3]; }
                return s; }, (bf16_t*)(ws + WS_WBP), 1024, rg * 32, kb * 64, scr, lane);
            continue; }
        r -= IT_WBP;
        if (r < IT_WO) {
            const int rg = r / 16, kb = r % 16; const float* w = p.in[I_WO];
            tr_item([&](int k, int n) -> float { return w[(size_t)k * 1024 + rg * 32 + n]; }, (bf16_t*)(ws + WS_WO), 1024, rg * 32, kb * 64, scr, lane);
            continue; }
        r -= IT_WO;
        if (r < IT_W13) {
            const int e = r / 512; r %= 512; const int which = r & 1, cg = (r >> 1) & 15, kb = r >> 5;
            const float* w = (which ? p.in[I_W3] : p.in[I_W1]) + (size_t)e * 1024 * 512 + cg * 32;
            tr_item([&](int k, int n) -> float { return w[(size_t)k * 512 + n]; },
                    (bf16_t*)(ws + WS_W13) + (size_t)e * 1024 * 1024, 1024, 2 * cg * 32 + which, kb * 64, scr, lane, 2);
            continue; }
        r -= IT_W13;
        {
            const int e = r / 256; r %= 256; const int rg = r / 8, kb = r % 8;
            const float* w2 = p.in[I_W2] + (size_t)e * 512 * 1024;
            tr_item([&](int k, int n) -> float { return w2[(size_t)k * 1024 + rg * 32 + n]; }, (bf16_t*)(ws + WS_W2) + (size_t)e * 1024 * 512, 512, rg * 32, kb * 64, scr, lane);
        }
    }
    {
        const float* g = p.in[I_GMIX]; bf16_t* U = (bf16_t*)(ws + WS_U);
        for (int row = gw; row < NTOK; row += NGW) {
            const f32x4* xr = (const f32x4*)h0_row(p, row) + lane;
            f32x4 v[4]; float s = 0.f;
#pragma unroll
            for (int j = 0; j < 4; ++j) { v[j] = xr[64 * j]; s += (v[j].x * v[j].x + v[j].y * v[j].y) + (v[j].z * v[j].z + v[j].w * v[j].w); }
            const float rstd = rsqrtf(wave_sum(s) * (1.f / D) + NORM_EPS);
            u32x2* o = (u32x2*)(U + (size_t)row * D) + lane;
#pragma unroll
            for (int j = 0; j < 4; ++j) { const f32x4 gg = ((const f32x4*)g)[lane + 64 * j];
                u32x2 w; w.x = pk2(v[j].x * rstd * gg.x, v[j].y * rstd * gg.y); w.y = pk2(v[j].z * rstd * gg.z, v[j].w * rstd * gg.w); o[64 * j] = w; }
        }
    }
}

namespace pg8 {
#define PG8_LAS __attribute__((address_space(3)))
typedef unsigned short bf16_t;
typedef short bf16x8 __attribute__((ext_vector_type(8)));
typedef float f32x4 __attribute__((ext_vector_type(4)));
typedef unsigned u32x4 __attribute__((ext_vector_type(4)));
constexpr int BM = 256, BK = 64, HALF = 128, HTB = HALF * BK * 2  , STAGE_BYTES = 8 * HTB, NXCD = 8, WGM = 8;

__host__ __device__ __forceinline__ int lds_byte(int r, int c) { const int st = (r >> 4) * 2 + (c >> 5), rr = r & 15, cc = c & 31, ob = rr * 64 + cc * 2; return st * 1024 + (ob ^ (((ob >> 9) & 1) << 5)); }
__host__ __device__ __forceinline__ void stage_rc(int b, int& R, int& C) { const int st = b / 1024, sb = b % 1024, swz = sb ^ (((sb >> 9) & 1) << 5); R = (st >> 1) * 16 + swz / 64; C = (st & 1) * 32 + (swz % 64) / 2; }
__host__ __device__ __forceinline__ int perm32(int rho) { const int n = rho >> 4, i = rho & 15; return 8 * (i >> 2) + 4 * n + (i & 3); }

struct Unit { int pm, pn; };
struct Gemm { const bf16_t* A; const bf16_t* Bt; int M, N, K; };

struct StaticOrder {
    int nM, nN, nwg, G, c;
    __host__ __device__ void init(int M, int N, int G_, int c_) { nM = M / BM; nN = N / BM; nwg = nM * nN; G = G_; c = c_; }
    __host__ __device__ bool next(int i, Unit& u) const {
        const long L = (long)i * G + c; if (L >= nwg) return false;
        int wgid = (int)L; { const int q = nwg / NXCD, r = nwg % NXCD, xcd = wgid % NXCD, off = wgid / NXCD; wgid = (xcd < r ? xcd * (q + 1) : r * (q + 1) + (xcd - r) * q) + off; }
        const int nig = WGM * nN, gid = wgid / nig, fm = gid * WGM, gsz = (nM - fm) < WGM ? (nM - fm) : WGM;
        u.pm = fm + ((wgid % nig) % gsz); u.pn = (wgid % nig) / gsz; return true;
    }
    __device__ __forceinline__ void a_ready(const Unit&) const {}
    __device__ __forceinline__ void done(const Unit&) const {}
};


#define PG8_FOR_FRAGS(...) _Pragma("unroll") for (int ai = 0; ai < 2; ++ai) _Pragma("unroll") for (int m = 0; m < 4; ++m) { const int row = u.pm * BM + ai * HALF + wr * 64 + m * 16 + fr; \
    _Pragma("unroll") for (int bj = 0; bj < 2; ++bj) _Pragma("unroll") for (int n = 0; n < 2; ++n) { const int col = u.pn * BM + bj * HALF + wc * 32 + n * 16 + 4 * fq; ::f32x4 v = acc[ai][bj][m][n]; __VA_ARGS__ } }
__device__ __forceinline__ bool rope_off(int c, int& o) {
    if (c < C_QF) return false;
    if (c < C_KV) { const int j = (c - C_QF) % QFW; o = j - 128; return j >= 128; }
    if (c < C_QI) { const int j = c - C_KV; o = j - 128; return j >= 128; }
    if (c < C_KI) { const int j = (c - C_QI) & 63; o = j; return j < 16; }
    if (c < C_WI) { const int j = c - C_KI; o = j; return j < 16; }
    return false;
}
#define PG8_FOR_FRAGS8(...) _Pragma("unroll") for (int ai = 0; ai < 2; ++ai) _Pragma("unroll") for (int m = 0; m < 4; ++m) { const int row = u.pm * BM + ai * HALF + wr * 64 + m * 16 + fr; \
    _Pragma("unroll") for (int bj = 0; bj < 2; ++bj) { const int col = u.pn * BM + bj * HALF + wc * 32 + 8 * fq; ::f32x4 v0 = acc[ai][bj][m][0], v1 = acc[ai][bj][m][1]; __VA_ARGS__ } }
struct EpiInproj {
    static constexpr bool PERM = true, AFTER_DRAIN = false;
    bf16_t* P; const float2* cs; unsigned char* KIP;
    __device__ __forceinline__ void operator()(const f32x4 (&acc)[2][2][4][2], const Unit& u, int wr, int wc, int fr, int fq) const {
        PG8_FOR_FRAGS8(
            if (col < PW) {
                int o; const int trow = tokrow(row);
                if (rope_off(col, o)) {
                    const int pos = (row % SEQ) + NMETA; const float2* cp = cs + pos * 8 + (o >> 1); const float2 c0 = cp[0], c1 = cp[1], c2 = cp[2], c3 = cp[3];
                    v0 = (::f32x4){v0.x * c0.x - v0.y * c0.y, v0.y * c0.x + v0.x * c0.y, v0.z * c1.x - v0.w * c1.y, v0.w * c1.x + v0.z * c1.y};
                    v1 = (::f32x4){v1.x * c2.x - v1.y * c2.y, v1.y * c2.x + v1.x * c2.y, v1.z * c3.x - v1.w * c3.y, v1.w * c3.x + v1.z * c3.y};
                }
                ::u32x4 w; w.x = pk2(v0.x, v0.y); w.y = pk2(v0.z, v0.w); w.z = pk2(v1.x, v1.y); w.w = pk2(v1.z, v1.w);
                if (col >= C_KI && col < C_WI) {
                    const int b = row / SEQ, t = row - b * SEQ + NMETA, d0 = col - C_KI;
                    *(::u32x4*)(KIP + (size_t)b * KIP_BATCH + (size_t)((((t >> 5) * 4 + (d0 >> 4)) * 2 + ((d0 >> 3) & 1)) * 512 + (t & 31) * 16)) = w;
                } else *(::u32x4*)(P + (size_t)trow * PW + col) = w;
            })
    }
};
struct EpiGate {
    static constexpr bool PERM = true, AFTER_DRAIN = false;
    bf16_t* G;
    __device__ __forceinline__ void operator()(const f32x4 (&acc)[2][2][4][2], const Unit& u, int wr, int wc, int fr, int fq) const {
        PG8_FOR_FRAGS8( ::u32x4 w; w.x = pk2(sigmoidf(v0.x), sigmoidf(v0.y)); w.y = pk2(sigmoidf(v0.z), sigmoidf(v0.w)); w.z = pk2(sigmoidf(v1.x), sigmoidf(v1.y)); w.w = pk2(sigmoidf(v1.z), sigmoidf(v1.w));
            *(::u32x4*)(G + (size_t)row * 2048 + col) = w; )
    }
};
template <bool ACCUM> struct EpiZ {
    static constexpr bool PERM = true, AFTER_DRAIN = false;
    bf16_t* Z; const bf16_t* G; int goff;
    __device__ __forceinline__ void operator()(const f32x4 (&acc)[2][2][4][2], const Unit& u, int wr, int wc, int fr, int fq) const {
        PG8_FOR_FRAGS8(
            const ::u32x4 g = *(const ::u32x4*)(G + (size_t)row * 2048 + goff + col);
            ::f32x4 z0 = (::f32x4){bflo(g.x) * v0.x, bfhi(g.x) * v0.y, bflo(g.y) * v0.z, bfhi(g.y) * v0.w}, z1 = (::f32x4){bflo(g.z) * v1.x, bfhi(g.z) * v1.y, bflo(g.w) * v1.z, bfhi(g.w) * v1.w};
            ::u32x4* zp = (::u32x4*)(Z + (size_t)row * D + col);
            if (ACCUM) { const ::u32x4 o = *zp; z0.x += bflo(o.x); z0.y += bfhi(o.x); z0.z += bflo(o.y); z0.w += bfhi(o.y); z1.x += bflo(o.z); z1.y += bfhi(o.z); z1.z += bflo(o.w); z1.w += bfhi(o.w); }
            ::u32x4 w; w.x = pk2(z0.x, z0.y); w.y = pk2(z0.z, z0.w); w.z = pk2(z1.x, z1.y); w.w = pk2(z1.z, z1.w); *zp = w; )
    }
};
struct EpiH1 {
    static constexpr bool PERM = true, AFTER_DRAIN = false;
    float* H1; const float* meta; const float* x;
    __device__ __forceinline__ void operator()(const f32x4 (&acc)[2][2][4][2], const Unit& u, int wr, int wc, int fr, int fq) const {
        PG8_FOR_FRAGS8( const float* xp = x + (size_t)row * D + col; float* hp = H1 + (size_t)row * D + col; const ::f32x4 h0 = *(const ::f32x4*)xp, h1 = *(const ::f32x4*)(xp + 4);
            *(::f32x4*)hp = h0 + v0; *(::f32x4*)(hp + 4) = h1 + v1; )
    }
};
#undef PG8_FOR_FRAGS
#undef PG8_FOR_FRAGS8

template <class Epi, class Sched, bool ALIGN_EPI = false, bool SP2 = false>
__device__ __forceinline__ void gemm_phase(PG8_LAS unsigned char* lds, const Gemm g, const Sched& S, const Epi& E) {
    const int tid = threadIdx.x, wid = __builtin_amdgcn_readfirstlane(tid >> 6), lane = tid & 63, wr = wid >> 2, wc = wid & 3, fr = lane & 15, fq = lane >> 4;
    const int K = g.K, nt = K / BK;
    unsigned voffA[2], voffB[2];
#pragma unroll
    for (int i = 0; i < 2; ++i) { int R, C; stage_rc(tid * 16 + i * 8192, R, C); const int Rb = Epi::PERM ? ((R & ~31) + perm32(R & 31)) : R;
        voffA[i] = (unsigned)(R * K + C) * 2u; voffB[i] = (unsigned)(Rb * K + C) * 2u; }
    const size_t kstep = (size_t)(BK * 2);
    const size_t hstep = (size_t)HALF * K * 2;
    const size_t tstep = 2 * hstep;
    const unsigned ldsw = (unsigned)wid * 1024u;
    const int aoff = lds_byte(wr * 64 + fr, fq * 8), boff = lds_byte(wc * 32 + fr, fq * 8);
#define PG8_SA(b, h) (((b) * 2 + (h)) * HTB)
#define PG8_SB(b, h) ((4 + (b) * 2 + (h)) * HTB)
#define PG8_STAGE(bufoff, gbase, voff) do { _Pragma("unroll") for (int _i = 0; _i < 2; ++_i) \
        __builtin_amdgcn_global_load_lds((const unsigned*)((const char*)(gbase) + (voff)[_i]), (PG8_LAS unsigned*)(lds + (bufoff) + ldsw + _i * 8192), 16, 0, 0); } while (0)
#define PG8_LDA(dst, b, h) do { _Pragma("unroll") for (int m = 0; m < 4; ++m) _Pragma("unroll") for (int k = 0; k < 2; ++k) dst[m][k] = *(const PG8_LAS bf16x8*)(lds + PG8_SA(b, h) + aoff + m * 2048 + k * 1024); } while (0)
#define PG8_LDB(dst, b, h) do { _Pragma("unroll") for (int n = 0; n < 2; ++n) _Pragma("unroll") for (int k = 0; k < 2; ++k) dst[n][k] = *(const PG8_LAS bf16x8*)(lds + PG8_SB(b, h) + boff + n * 2048 + k * 1024); } while (0)
#define PG8_MMA(ai, bj, At, Bt) do { __builtin_amdgcn_s_setprio(1); _Pragma("unroll") for (int m = 0; m < 4; ++m) _Pragma("unroll") for (int n = 0; n < 2; ++n) _Pragma("unroll") for (int k = 0; k < 2; ++k) \
        acc[ai][bj][m][n] = __builtin_amdgcn_mfma_f32_16x16x32_bf16(Bt[n][k], At[m][k], acc[ai][bj][m][n], 0, 0, 0); __builtin_amdgcn_s_setprio(0); } while (0)
#define PG8_WAIT_V(n) asm volatile("s_waitcnt vmcnt(" #n ")" ::: "memory")
#define PG8_WAIT_L(n) asm volatile("s_waitcnt lgkmcnt(" #n ")" ::: "memory")
#define PG8_BAR __builtin_amdgcn_s_barrier()
#define PG8_SCHED __builtin_amdgcn_sched_barrier(0)
    Unit cur, nxt; int ui = 0;
    if (!S.next(0, cur)) return;
    f32x4 acc[2][2][4][2];
#pragma unroll
    for (int a = 0; a < 2; ++a)
#pragma unroll
        for (int b = 0; b < 2; ++b)
#pragma unroll
            for (int m = 0; m < 4; ++m)
#pragma unroll
                for (int n = 0; n < 2; ++n) acc[a][b][m][n] = (f32x4){0.f, 0.f, 0.f, 0.f};
    bf16x8 At[4][2], B0[2][2], B1[2][2];
    const char* cA = (const char*)g.A + (size_t)cur.pm * tstep; const char* cB = (const char*)g.Bt + (size_t)cur.pn * tstep;
    S.a_ready(cur);
    if constexpr (SP2) {
        PG8_STAGE(PG8_SB(0, 0), cB, voffB); PG8_STAGE(PG8_SB(0, 1), cB + hstep, voffB); PG8_STAGE(PG8_SA(0, 0), cA, voffA); PG8_STAGE(PG8_SA(0, 1), cA + hstep, voffA);
        if (wr == 1) PG8_BAR;
        PG8_WAIT_V(2); PG8_BAR;
        PG8_STAGE(PG8_SB(1, 0), cB + kstep, voffB); PG8_STAGE(PG8_SA(1, 0), cA + kstep, voffA); PG8_STAGE(PG8_SB(1, 1), cB + hstep + kstep, voffB);
        PG8_WAIT_V(6); PG8_BAR;
    } else {
        PG8_STAGE(PG8_SB(0, 0), cB, voffB); PG8_STAGE(PG8_SA(0, 0), cA, voffA); PG8_STAGE(PG8_SB(0, 1), cB + hstep, voffB); PG8_STAGE(PG8_SA(0, 1), cA + hstep, voffA);
        if (wr == 1) PG8_BAR;
        PG8_WAIT_V(4); PG8_BAR;
        PG8_STAGE(PG8_SB(1, 0), cB + kstep, voffB); PG8_STAGE(PG8_SA(1, 0), cA + kstep, voffA); PG8_STAGE(PG8_SB(1, 1), cB + hstep + kstep, voffB);
        PG8_WAIT_V(6); PG8_BAR;
    }
    for (;;) {
        const bool has_next = S.next(ui + 1, nxt);
        const char* nA = has_next ? (const char*)g.A + (size_t)nxt.pm * tstep : cA; const char* nB = has_next ? (const char*)g.Bt + (size_t)nxt.pn * tstep : cB;
        for (int t = 0; t < nt; t += 2) {
            const bool last = (t == nt - 2);
            const char* a1 = cA + (size_t)(t + 1) * kstep;
            const char* a2 = last ? nA : cA + (size_t)(t + 2) * kstep; const char* b2 = last ? nB : cB + (size_t)(t + 2) * kstep;
            const char* a3 = a2 + kstep; const char* b3 = b2 + kstep;
            if (last && has_next) S.a_ready(nxt);
            if constexpr (SP2) {
            PG8_LDB(B0, 0, 0); PG8_LDB(B1, 0, 1); PG8_SCHED; PG8_LDA(At, 0, 0); PG8_STAGE(PG8_SA(1, 1), a1 + hstep, voffA);
            PG8_WAIT_V(8); PG8_WAIT_L(0); PG8_BAR; PG8_MMA(0, 0, At, B0); PG8_MMA(0, 1, At, B1); PG8_BAR; PG8_SCHED;
            PG8_LDA(At, 0, 1); PG8_STAGE(PG8_SB(0, 0), b2, voffB); PG8_STAGE(PG8_SB(0, 1), b2 + hstep, voffB); PG8_STAGE(PG8_SA(0, 0), a2, voffA);
            PG8_WAIT_V(8); PG8_WAIT_L(0); PG8_BAR; PG8_MMA(1, 0, At, B0); PG8_MMA(1, 1, At, B1); PG8_BAR; PG8_SCHED;
            PG8_LDB(B0, 1, 0); PG8_LDB(B1, 1, 1); PG8_SCHED; PG8_LDA(At, 1, 0); PG8_STAGE(PG8_SA(0, 1), a2 + hstep, voffA);
            PG8_WAIT_V(8); PG8_WAIT_L(0); PG8_BAR; PG8_MMA(0, 0, At, B0); PG8_MMA(0, 1, At, B1); PG8_BAR; PG8_SCHED;
            PG8_LDA(At, 1, 1); PG8_STAGE(PG8_SB(1, 0), b3, voffB); PG8_STAGE(PG8_SB(1, 1), b3 + hstep, voffB); PG8_STAGE(PG8_SA(1, 0), a3, voffA);
            PG8_WAIT_V(8); PG8_WAIT_L(0); PG8_BAR; PG8_MMA(1, 0, At, B0); PG8_MMA(1, 1, At, B1); PG8_BAR; PG8_SCHED;
            } else {
            PG8_LDB(B0, 0, 0); PG8_SCHED; PG8_LDA(At, 0, 0); PG8_STAGE(PG8_SA(1, 1), a1 + hstep, voffA);
            PG8_WAIT_L(8); PG8_BAR; PG8_WAIT_L(0); PG8_MMA(0, 0, At, B0); PG8_BAR; PG8_SCHED;
            PG8_LDB(B1, 0, 1); PG8_STAGE(PG8_SB(0, 0), b2, voffB);
            PG8_BAR; PG8_WAIT_L(0); PG8_MMA(0, 1, At, B1); PG8_BAR;
            PG8_LDA(At, 0, 1); PG8_STAGE(PG8_SA(0, 0), a2, voffA);
            PG8_BAR; PG8_WAIT_L(0); PG8_MMA(1, 0, At, B0); PG8_BAR; PG8_SCHED;
            PG8_STAGE(PG8_SB(0, 1), b2 + hstep, voffB);
            PG8_WAIT_V(6); PG8_BAR; PG8_MMA(1, 1, At, B1); PG8_BAR;
            PG8_LDB(B0, 1, 0); PG8_SCHED; PG8_LDA(At, 1, 0); PG8_STAGE(PG8_SA(0, 1), a2 + hstep, voffA);
            PG8_WAIT_L(8); PG8_BAR; PG8_WAIT_L(0); PG8_MMA(0, 0, At, B0); PG8_BAR; PG8_SCHED;
            PG8_LDB(B1, 1, 1); PG8_STAGE(PG8_SB(1, 0), b3, voffB);
            PG8_BAR; PG8_WAIT_L(0); PG8_MMA(0, 1, At, B1); PG8_BAR;
            PG8_LDA(At, 1, 1); PG8_STAGE(PG8_SA(1, 0), a3, voffA);
            PG8_BAR; PG8_WAIT_L(0); PG8_MMA(1, 0, At, B0); PG8_BAR; PG8_SCHED;
            PG8_STAGE(PG8_SB(1, 1), b3 + hstep, voffB);
            PG8_WAIT_V(6); PG8_BAR; PG8_MMA(1, 1, At, B1); PG8_BAR;
            }
        }
        if constexpr (ALIGN_EPI) { if (wr == 0) PG8_BAR; }
        if constexpr (!Epi::AFTER_DRAIN) { E(acc, cur, wr, wc, fr, fq); S.done(cur); }
        if (!has_next) break;
#pragma unroll
        for (int a = 0; a < 2; ++a)
#pragma unroll
            for (int b = 0; b < 2; ++b)
#pragma unroll
                for (int m = 0; m < 4; ++m)
#pragma unroll
                    for (int n = 0; n < 2; ++n) acc[a][b][m][n] = (f32x4){0.f, 0.f, 0.f, 0.f};
        cur = nxt; cA = nA; cB = nB; ++ui;
        if constexpr (ALIGN_EPI) { if (wr == 1) PG8_BAR; }
    }
    PG8_WAIT_V(0);
    if constexpr (!ALIGN_EPI) { if (wr == 0) PG8_BAR; }
    PG8_BAR;
    if constexpr (Epi::AFTER_DRAIN) { E.fused(acc, cur, wr, wc, fr, fq, lds, wid, lane); S.done(cur); }
#undef PG8_SA
#undef PG8_SB
#undef PG8_STAGE
#undef PG8_LDA
#undef PG8_LDB
#undef PG8_MMA
#undef PG8_WAIT_V
#undef PG8_WAIT_L
#undef PG8_BAR
#undef PG8_SCHED
}
template <class Epi, class Sched, bool ALIGN_EPI = false, bool SP2 = false>
__device__ __forceinline__ void gemm_phase_x(PG8_LAS unsigned char* lds, const int K, const Sched& S, const Epi& E) {
    const int tid = threadIdx.x, wid = __builtin_amdgcn_readfirstlane(tid >> 6), lane = tid & 63, wr = wid >> 2, wc = wid & 3, fr = lane & 15, fq = lane >> 4;
    const int nt = K / BK;
    unsigned vcA[2][2], vnA[2][2], voffB[2];
#pragma unroll
    for (int i = 0; i < 2; ++i) { int R, C; stage_rc(tid * 16 + i * 8192, R, C); const int Rb = Epi::PERM ? ((R & ~31) + perm32(R & 31)) : R;
        voffB[i] = (unsigned)(Rb * K + C) * 2u; }
    const size_t kstep = (size_t)(BK * 2);
    const size_t hstep = (size_t)HALF * K * 2;
    const unsigned ldsw = (unsigned)wid * 1024u;
    const int aoff = lds_byte(wr * 64 + fr, fq * 8), boff = lds_byte(wc * 32 + fr, fq * 8);
#define PG8_SA(b, h) (((b) * 2 + (h)) * HTB)
#define PG8_SB(b, h) ((4 + (b) * 2 + (h)) * HTB)
#define PG8_STAGE(bufoff, gbase, voff) do { _Pragma("unroll") for (int _i = 0; _i < 2; ++_i) \
        __builtin_amdgcn_global_load_lds((const unsigned*)((const char*)(gbase) + (voff)[_i]), (PG8_LAS unsigned*)(lds + (bufoff) + ldsw + _i * 8192), 16, 0, 0); } while (0)
#define PG8_STAGEA(bufoff, gbase, V, h) do { _Pragma("unroll") for (int _i = 0; _i < 2; ++_i) \
        __builtin_amdgcn_global_load_lds((const unsigned*)((const char*)(gbase) + (V)[h][_i]), (PG8_LAS unsigned*)(lds + (bufoff) + ldsw + _i * 8192), 16, 0, 0); } while (0)
#define PG8_STAGEA2(bufoff, gbase, h) do { _Pragma("unroll") for (int _i = 0; _i < 2; ++_i) \
        __builtin_amdgcn_global_load_lds((const unsigned*)((const char*)(gbase) + (last ? vnA[h][_i] : vcA[h][_i])), (PG8_LAS unsigned*)(lds + (bufoff) + ldsw + _i * 8192), 16, 0, 0); } while (0)
#define PG8_AOFF(V, u) do { _Pragma("unroll") for (int _h = 0; _h < 2; ++_h) _Pragma("unroll") for (int _i = 0; _i < 2; ++_i) { int R_, C_; stage_rc(tid * 16 + _i * 8192, R_, C_); (V)[_h][_i] = S.a_off(u, _h * HALF + R_, C_); } } while (0)
#define PG8_LDA(dst, b, h) do { _Pragma("unroll") for (int m = 0; m < 4; ++m) _Pragma("unroll") for (int k = 0; k < 2; ++k) dst[m][k] = *(const PG8_LAS bf16x8*)(lds + PG8_SA(b, h) + aoff + m * 2048 + k * 1024); } while (0)
#define PG8_LDB(dst, b, h) do { _Pragma("unroll") for (int n = 0; n < 2; ++n) _Pragma("unroll") for (int k = 0; k < 2; ++k) dst[n][k] = *(const PG8_LAS bf16x8*)(lds + PG8_SB(b, h) + boff + n * 2048 + k * 1024); } while (0)
#define PG8_MMA(ai, bj, At, Bt) do { __builtin_amdgcn_s_setprio(1); _Pragma("unroll") for (int m = 0; m < 4; ++m) _Pragma("unroll") for (int n = 0; n < 2; ++n) _Pragma("unroll") for (int k = 0; k < 2; ++k) \
        acc[ai][bj][m][n] = __builtin_amdgcn_mfma_f32_16x16x32_bf16(Bt[n][k], At[m][k], acc[ai][bj][m][n], 0, 0, 0); __builtin_amdgcn_s_setprio(0); } while (0)
#define PG8_WAIT_V(n) asm volatile("s_waitcnt vmcnt(" #n ")" ::: "memory")
#define PG8_WAIT_L(n) asm volatile("s_waitcnt lgkmcnt(" #n ")" ::: "memory")
#define PG8_BAR __builtin_amdgcn_s_barrier()
#define PG8_SCHED __builtin_amdgcn_sched_barrier(0)
    Unit cur, nxt; int ui = 0;
    if (!S.next(0, cur)) return;
    f32x4 acc[2][2][4][2];
#pragma unroll
    for (int a = 0; a < 2; ++a)
#pragma unroll
        for (int b = 0; b < 2; ++b)
#pragma unroll
            for (int m = 0; m < 4; ++m)
#pragma unroll
                for (int n = 0; n < 2; ++n) acc[a][b][m][n] = (f32x4){0.f, 0.f, 0.f, 0.f};
    bf16x8 At[4][2], B0[2][2], B1[2][2];
    const char* cA = S.a_base(cur); const char* cB = S.b_base(cur);
    PG8_AOFF(vcA, cur);
    S.a_ready(cur);
    if constexpr (SP2) {
        PG8_STAGE(PG8_SB(0, 0), cB, voffB); PG8_STAGE(PG8_SB(0, 1), cB + hstep, voffB); PG8_STAGEA(PG8_SA(0, 0), cA, vcA, 0); PG8_STAGEA(PG8_SA(0, 1), cA, vcA, 1);
        if (wr == 1) PG8_BAR;
        PG8_WAIT_V(2); PG8_BAR;
        PG8_STAGE(PG8_SB(1, 0), cB + kstep, voffB); PG8_STAGEA(PG8_SA(1, 0), cA + kstep, vcA, 0); PG8_STAGE(PG8_SB(1, 1), cB + hstep + kstep, voffB);
        PG8_WAIT_V(6); PG8_BAR;
    } else {
        PG8_STAGE(PG8_SB(0, 0), cB, voffB); PG8_STAGEA(PG8_SA(0, 0), cA, vcA, 0); PG8_STAGE(PG8_SB(0, 1), cB + hstep, voffB); PG8_STAGEA(PG8_SA(0, 1), cA, vcA, 1);
        if (wr == 1) PG8_BAR;
        PG8_WAIT_V(4); PG8_BAR;
        PG8_STAGE(PG8_SB(1, 0), cB + kstep, voffB); PG8_STAGEA(PG8_SA(1, 0), cA + kstep, vcA, 0); PG8_STAGE(PG8_SB(1, 1), cB + hstep + kstep, voffB);
        PG8_WAIT_V(6); PG8_BAR;
    }
    for (;;) {
        const bool has_next = S.next(ui + 1, nxt);
        const char* nA = has_next ? S.a_base(nxt) : cA; const char* nB = has_next ? S.b_base(nxt) : cB;
        if (has_next) { PG8_AOFF(vnA, nxt); } else { _Pragma("unroll") for (int _h = 0; _h < 2; ++_h) _Pragma("unroll") for (int _i = 0; _i < 2; ++_i) vnA[_h][_i] = vcA[_h][_i]; }
        for (int t = 0; t < nt; t += 2) {
            const bool last = (t == nt - 2);
            const char* a1 = cA + (size_t)(t + 1) * kstep;
            const char* a2 = last ? nA : cA + (size_t)(t + 2) * kstep; const char* b2 = last ? nB : cB + (size_t)(t + 2) * kstep;
            const char* a3 = a2 + kstep; const char* b3 = b2 + kstep;
            if (last && has_next) S.a_ready(nxt);
            if constexpr (SP2) {
            PG8_LDB(B0, 0, 0); PG8_LDB(B1, 0, 1); PG8_SCHED; PG8_LDA(At, 0, 0); PG8_STAGEA(PG8_SA(1, 1), a1, vcA, 1);
            PG8_WAIT_V(8); PG8_WAIT_L(0); PG8_BAR; PG8_MMA(0, 0, At, B0); PG8_MMA(0, 1, At, B1); PG8_BAR; PG8_SCHED;
            PG8_LDA(At, 0, 1); PG8_STAGE(PG8_SB(0, 0), b2, voffB); PG8_STAGE(PG8_SB(0, 1), b2 + hstep, voffB); PG8_STAGEA2(PG8_SA(0, 0), a2, 0);
            PG8_WAIT_V(8); PG8_WAIT_L(0); PG8_BAR; PG8_MMA(1, 0, At, B0); PG8_MMA(1, 1, At, B1); PG8_BAR; PG8_SCHED;
            PG8_LDB(B0, 1, 0); PG8_LDB(B1, 1, 1); PG8_SCHED; PG8_LDA(At, 1, 0); PG8_STAGEA2(PG8_SA(0, 1), a2, 1);
            PG8_WAIT_V(8); PG8_WAIT_L(0); PG8_BAR; PG8_MMA(0, 0, At, B0); PG8_MMA(0, 1, At, B1); PG8_BAR; PG8_SCHED;
            PG8_LDA(At, 1, 1); PG8_STAGE(PG8_SB(1, 0), b3, voffB); PG8_STAGE(PG8_SB(1, 1), b3 + hstep, voffB); PG8_STAGEA2(PG8_SA(1, 0), a3, 0);
            PG8_WAIT_V(8); PG8_WAIT_L(0); PG8_BAR; PG8_MMA(1, 0, At, B0); PG8_MMA(1, 1, At, B1); PG8_BAR; PG8_SCHED;
            } else {
            PG8_LDB(B0, 0, 0); PG8_SCHED; PG8_LDA(At, 0, 0); PG8_STAGEA(PG8_SA(1, 1), a1, vcA, 1);
            PG8_WAIT_L(8); PG8_BAR; PG8_WAIT_L(0); PG8_MMA(0, 0, At, B0); PG8_BAR; PG8_SCHED;
            PG8_LDB(B1, 0, 1); PG8_STAGE(PG8_SB(0, 0), b2, voffB);
            PG8_BAR; PG8_WAIT_L(0); PG8_MMA(0, 1, At, B1); PG8_BAR;
            PG8_LDA(At, 0, 1); PG8_STAGEA2(PG8_SA(0, 0), a2, 0);
            PG8_BAR; PG8_WAIT_L(0); PG8_MMA(1, 0, At, B0); PG8_BAR; PG8_SCHED;
            PG8_STAGE(PG8_SB(0, 1), b2 + hstep, voffB);
            PG8_WAIT_V(6); PG8_BAR; PG8_MMA(1, 1, At, B1); PG8_BAR;
            PG8_LDB(B0, 1, 0); PG8_SCHED; PG8_LDA(At, 1, 0); PG8_STAGEA2(PG8_SA(0, 1), a2, 1);
            PG8_WAIT_L(8); PG8_BAR; PG8_WAIT_L(0); PG8_MMA(0, 0, At, B0); PG8_BAR; PG8_SCHED;
            PG8_LDB(B1, 1, 1); PG8_STAGE(PG8_SB(1, 0), b3, voffB);
            PG8_BAR; PG8_WAIT_L(0); PG8_MMA(0, 1, At, B1); PG8_BAR;
            PG8_LDA(At, 1, 1); PG8_STAGEA2(PG8_SA(1, 0), a3, 0);
            PG8_BAR; PG8_WAIT_L(0); PG8_MMA(1, 0, At, B0); PG8_BAR; PG8_SCHED;
            PG8_STAGE(PG8_SB(1, 1), b3 + hstep, voffB);
            PG8_WAIT_V(6); PG8_BAR; PG8_MMA(1, 1, At, B1); PG8_BAR;
            }
        }
        if constexpr (ALIGN_EPI) { if (wr == 0) PG8_BAR; }
        if constexpr (!Epi::AFTER_DRAIN) { E(acc, cur, wr, wc, fr, fq); S.done(cur); }
        if (!has_next) break;
#pragma unroll
        for (int a = 0; a < 2; ++a)
#pragma unroll
            for (int b = 0; b < 2; ++b)
#pragma unroll
                for (int m = 0; m < 4; ++m)
#pragma unroll
                    for (int n = 0; n < 2; ++n) acc[a][b][m][n] = (f32x4){0.f, 0.f, 0.f, 0.f};
        cur = nxt; cA = nA; cB = nB; ++ui;
        _Pragma("unroll") for (int _h = 0; _h < 2; ++_h) _Pragma("unroll") for (int _i = 0; _i < 2; ++_i) vcA[_h][_i] = vnA[_h][_i];
        if constexpr (ALIGN_EPI) { if (wr == 1) PG8_BAR; }
    }
    PG8_WAIT_V(0);
    if constexpr (!ALIGN_EPI) { if (wr == 0) PG8_BAR; }
    PG8_BAR;
    if constexpr (Epi::AFTER_DRAIN) { E.fused(acc, cur, wr, wc, fr, fq, lds, wid, lane); S.done(cur); }
#undef PG8_SA
#undef PG8_SB
#undef PG8_STAGE
#undef PG8_STAGEA
#undef PG8_STAGEA2
#undef PG8_AOFF
#undef PG8_LDA
#undef PG8_LDB
#undef PG8_MMA
#undef PG8_WAIT_V
#undef PG8_WAIT_L
#undef PG8_BAR
#undef PG8_SCHED
}


template <int WHICH> struct MoeOrder {
    const int* TP; int G, c; const char* Abase; const char* Bbase; const int* LIST;
    static constexpr int KK = WHICH == 0 ? 1024 : 512, NN = 4;
    __device__ __forceinline__ bool next(int i, Unit& u) const {
        const int L = i * G + c; if (L >= TP[NEXP]) return false;
        int e = 0;
#pragma unroll 1
        for (int j = 16; j >= 1; j >>= 1) if (TP[e + j] <= L) e += j;
        const int lt = L - TP[e]; u.pm = e * 1024 + lt / NN; u.pn = lt % NN; return true;
    }
    __device__ __forceinline__ const char* a_base(const Unit& u) const { const int e = u.pm >> 10, mt = u.pm & 1023; return WHICH == 0 ? Abase : Abase + (size_t)(TP[64 + e] + mt * 256) * (DEXP * 2); }
    __device__ __forceinline__ const char* b_base(const Unit& u) const { const int e = u.pm >> 10; return Bbase + ((size_t)e * 1024 + (size_t)u.pn * 256) * (KK * 2); }
    __device__ __forceinline__ unsigned a_off(const Unit& u, int r, int C) const {
        if (WHICH == 1) return (unsigned)(r * DEXP + C) * 2u;
        const int e = u.pm >> 10, s = (u.pm & 1023) * 256 + r; const int tok = s < TP[128 + e] ? (LIST[(size_t)e * NR + s] >> 1) : 0;
        return (unsigned)tok * (D * 2) + (unsigned)C * 2u;
    }
    __device__ __forceinline__ void a_ready(const Unit&) const {}
    __device__ __forceinline__ void done(const Unit&) const {}
};
struct TokRowOrder : StaticOrder {
    const char* Abase; const char* Bbase; int K;
    __device__ __forceinline__ const char* a_base(const Unit& u) const { return Abase + (size_t)tokrow(u.pm * BM) * K * 2; }
    __device__ __forceinline__ const char* b_base(const Unit& u) const { return Bbase + (size_t)u.pn * BM * K * 2; }
    __device__ __forceinline__ unsigned a_off(const Unit&, int r, int C) const { return (unsigned)(r * K + C) * 2u; }
};
#define PG8_FOR_FRAGS_M(...) _Pragma("unroll") for (int ai = 0; ai < 2; ++ai) _Pragma("unroll") for (int m = 0; m < 4; ++m) { const int r = ai * HALF + wr * 64 + m * 16 + fr; \
    _Pragma("unroll") for (int bj = 0; bj < 2; ++bj) _Pragma("unroll") for (int n = 0; n < 2; ++n) { const int col = u.pn * BM + bj * HALF + wc * 32 + n * 16 + 4 * fq; ::f32x4 v = acc[ai][bj][m][n]; __VA_ARGS__ } }
struct EpiMoe1 {
    static constexpr bool PERM = true, AFTER_DRAIN = false;
    bf16_t* HID; const int* TP;
    __device__ __forceinline__ void operator()(const f32x4 (&acc)[2][2][4][2], const Unit& u, int wr, int wc, int fr, int fq) const {
        const int e = u.pm >> 10, mt = u.pm & 1023; bf16_t* base = HID + (size_t)(TP[64 + e] + mt * 256) * DEXP;
#pragma unroll
        for (int ai = 0; ai < 2; ++ai)
#pragma unroll
            for (int m = 0; m < 4; ++m) { const int r = ai * HALF + wr * 64 + m * 16 + fr;
#pragma unroll
                for (int bj = 0; bj < 2; ++bj) { const int col = u.pn * BM + bj * HALF + wc * 32 + 8 * fq; const ::f32x4 v0 = acc[ai][bj][m][0], v1 = acc[ai][bj][m][1];
                    const float h0 = v0.x * sigmoidf(v0.x) * v0.y, h1 = v0.z * sigmoidf(v0.z) * v0.w, h2 = v1.x * sigmoidf(v1.x) * v1.y, h3 = v1.z * sigmoidf(v1.z) * v1.w;
                    ::u32x2 w; w.x = pk2(h0, h1); w.y = pk2(h2, h3); *(::u32x2*)(base + (size_t)r * DEXP + (col >> 1)) = w; } }
    }
};
struct EpiMoe2 {
    static constexpr bool PERM = true, AFTER_DRAIN = false;
    bf16_t* MO; const int* TP; const int* LIST; const float* GATE;
    __device__ __forceinline__ void operator()(const f32x4 (&acc)[2][2][4][2], const Unit& u, int wr, int wc, int fr, int fq) const {
        const int e = u.pm >> 10, mt = u.pm & 1023, cnt = TP[128 + e];
#pragma unroll
        for (int ai = 0; ai < 2; ++ai)
#pragma unroll
            for (int m = 0; m < 4; ++m) {
                const int s = mt * 256 + ai * HALF + wr * 64 + m * 16 + fr;
                if (s < cnt) {
                    const int ent = LIST[(size_t)e * NR + s]; const float gt = GATE[ent]; bf16_t* row = MO + (size_t)ent * D;
#pragma unroll
                    for (int bj = 0; bj < 2; ++bj) { const int col = u.pn * BM + bj * HALF + wc * 32 + 8 * fq; const ::f32x4 v0 = acc[ai][bj][m][0], v1 = acc[ai][bj][m][1];
                        ::u32x4 w; w.x = pk2(v0.x * gt, v0.y * gt); w.y = pk2(v0.z * gt, v0.w * gt); w.z = pk2(v1.x * gt, v1.y * gt); w.w = pk2(v1.z * gt, v1.w * gt); *(::u32x4*)(row + col) = w; }
                }
            }
    }
};
#undef PG8_FOR_FRAGS_M
}
constexpr int SB_NQT = SEQ / 32;
constexpr int SB_VT_STRIDE = 40;
__device__ __forceinline__ void phase_sb_fast(const Params& p, char* lds) {
    const bf16_t* P = (const bf16_t*)(p.ws + WS_P); bf16_t* YA = (bf16_t*)(p.ws + WS_YA);
    const int tid = threadIdx.x, lane = tid & 63, wave = tid >> 6, n = lane & 31, hh = lane >> 5;
    bf16_t* VT = (bf16_t*)(lds + wave * (64 * SB_VT_STRIDE * 2));
    const int gw = blockIdx.x * NWAVES + wave, NGW = gridDim.x * NWAVES;
    for (int unit = gw; unit < 64 * SB_NQT; unit += NGW) {
        const int qt = SB_NQT - 1 - unit / 64, bh = unit % 64, h = bh & 7, b = bh >> 3;
        const int i0 = NMETA + qt * 32, qi = i0 + n, qrow = qi;
        const bf16_t* Pb = P + (size_t)b * T * PW;
        bf16x8 qf[4];
#pragma unroll
        for (int s = 0; s < 4; ++s) qf[s] = *(const bf16x8*)(Pb + (size_t)qrow * PW + C_QA + h * 64 + 16 * s + 8 * hh);
        f32x16 o0, o1;
#pragma unroll
        for (int r = 0; r < 16; ++r) { o0[r] = 0.f; o1[r] = 0.f; }
        float L = 0.f;
        for (int kt = qt + 1; kt >= 0; --kt) {
            const int j0 = kt * 32, krow = (j0 + n) < T ? (j0 + n) : T - 1;
            bf16x8 kf[4];
#pragma unroll
            for (int s = 0; s < 4; ++s) kf[s] = *(const bf16x8*)(Pb + (size_t)krow * PW + C_KA + h * 64 + 16 * s + 8 * hh);
#pragma unroll
            for (int i = 0; i < 4; ++i) {
                const int c = lane + 64 * i, key = c >> 3, d0 = (c & 7) * 8, vrow = (j0 + key) < T ? (j0 + key) : T - 1;
                const u32x4 w = *(const u32x4*)(Pb + (size_t)vrow * PW + C_VA + h * 64 + d0);
                bf16_t* vp = VT + d0 * SB_VT_STRIDE + key;
                vp[0] = (bf16_t)(w.x & 0xffff); vp[SB_VT_STRIDE] = (bf16_t)(w.x >> 16); vp[2 * SB_VT_STRIDE] = (bf16_t)(w.y & 0xffff); vp[3 * SB_VT_STRIDE] = (bf16_t)(w.y >> 16);
                vp[4 * SB_VT_STRIDE] = (bf16_t)(w.z & 0xffff); vp[5 * SB_VT_STRIDE] = (bf16_t)(w.z >> 16); vp[6 * SB_VT_STRIDE] = (bf16_t)(w.w & 0xffff); vp[7 * SB_VT_STRIDE] = (bf16_t)(w.w >> 16);
            }
            f32x16 sa;
#pragma unroll
            for (int r = 0; r < 16; ++r) sa[r] = 0.f;
#pragma unroll
            for (int s = 0; s < 4; ++s) sa = __builtin_amdgcn_mfma_f32_32x32x16_bf16(kf[s], qf[s], sa, 0, 0, 0);
            float lk[16], z[16];
#pragma unroll
            for (int r = 0; r < 16; ++r) {
                const int kk = (r & 3) + 8 * (r >> 2) + 4 * hh; const bool valid = (j0 + kk) < qi;
                const float zz = __builtin_amdgcn_fmed3f(sa[r], -3.0e38f, 80.f); const float l = -__log2f(1.f + fexp2(zz));
                z[r] = zz; lk[r] = valid ? l : 0.f;
            }
            const float gs0 = (lk[0] + lk[1]) + (lk[2] + lk[3]), gs1 = (lk[4] + lk[5]) + (lk[6] + lk[7]), gs2 = (lk[8] + lk[9]) + (lk[10] + lk[11]), gs3 = (lk[12] + lk[13]) + (lk[14] + lk[15]);
            const float ps0 = xpartner32(gs0, hh), ps1 = xpartner32(gs1, hh), ps2 = xpartner32(gs2, hh), ps3 = xpartner32(gs3, hh);
            const float pc3 = ps3, pc2 = pc3 + ps2, pc1 = pc2 + ps1, pc0 = pc1 + ps0;
            float base[4];
            base[3] = L + (hh ? 0.f : pc3);
            base[2] = L + gs3 + (hh ? pc3 : pc2);
            base[1] = L + (gs3 + gs2) + (hh ? pc2 : pc1);
            base[0] = L + (gs3 + gs2 + gs1) + (hh ? pc1 : pc0);
            float a[16];
#pragma unroll
            for (int g = 0; g < 4; ++g) {
                float c = base[g];
#pragma unroll
                for (int e = 3; e >= 0; --e) {
                    const int r = 4 * g + e; c += lk[r];
                    const int kk = e + 8 * g + 4 * hh; const bool valid = (j0 + kk) < qi;
                    a[r] = valid ? fexp2(z[r] + c) : 0.f;
                }
            }
            L += (gs0 + gs1 + gs2 + gs3) + pc0;
            u32x4 pw0, pw1;
            pw0.x = pk2(a[0], a[1]); pw0.y = pk2(a[2], a[3]); pw0.z = pk2(a[4], a[5]); pw0.w = pk2(a[6], a[7]);
            pw1.x = pk2(a[8], a[9]); pw1.y = pk2(a[10], a[11]); pw1.z = pk2(a[12], a[13]); pw1.w = pk2(a[14], a[15]);
            const bf16x8 pf0 = __builtin_bit_cast(bf16x8, pw0), pf1 = __builtin_bit_cast(bf16x8, pw1);
#pragma unroll
            for (int mt = 0; mt < 2; ++mt) {
                const bf16_t* vr = VT + (32 * mt + n) * SB_VT_STRIDE + 4 * hh;
                u32x4 v0, v1;
                { const u32x2 x = *(const u32x2*)(vr), y = *(const u32x2*)(vr + 8); v0.x = x.x; v0.y = x.y; v0.z = y.x; v0.w = y.y; }
                { const u32x2 x = *(const u32x2*)(vr + 16), y = *(const u32x2*)(vr + 24); v1.x = x.x; v1.y = x.y; v1.z = y.x; v1.w = y.y; }
                if (mt == 0) { o0 = __builtin_amdgcn_mfma_f32_32x32x16_bf16(__builtin_bit_cast(bf16x8, v0), pf0, o0, 0, 0, 0); o0 = __builtin_amdgcn_mfma_f32_32x32x16_bf16(__builtin_bit_cast(bf16x8, v1), pf1, o0, 0, 0, 0); }
                else { o1 = __builtin_amdgcn_mfma_f32_32x32x16_bf16(__builtin_bit_cast(bf16x8, v0), pf0, o1, 0, 0, 0); o1 = __builtin_amdgcn_mfma_f32_32x32x16_bf16(__builtin_bit_cast(bf16x8, v1), pf1, o1, 0, 0, 0); }
            }
            const bool done = L < -152.f;
            if (__all(done)) break;
        }
        {
            bf16_t* yp = YA + ((size_t)b * SEQ + (qi - NMETA)) * 512 + h * 64 + 4 * hh;
#pragma unroll
            for (int g = 0; g < 4; ++g) {
                u32x2 w; w.x = pk2(o0[4 * g], o0[4 * g + 1]); w.y = pk2(o0[4 * g + 2], o0[4 * g + 3]); *(u32x2*)(yp + 8 * g) = w;
                w.x = pk2(o1[4 * g], o1[4 * g + 1]); w.y = pk2(o1[4 * g + 2], o1[4 * g + 3]); *(u32x2*)(yp + 32 + 8 * g) = w;
            }
        }
    }
}

constexpr int DSA_NQ = 8;
constexpr int DSA_SCS = 4608;
constexpr int DSA_KVB = 0, DSA_RING = 18432, DSA_IDX = DSA_NQ * DSA_RING, DSA_MISC = DSA_IDX + DSA_NQ * 1024, DSA_LDS = DSA_MISC + 512;
static_assert(DSA_NQ * DSA_SCS * 4 <= DSA_IDX, "score rows fit under the index lists");
__device__ __forceinline__ unsigned fkey(float f) { const unsigned u = __float_as_uint(f); return (u & 0x80000000u) ? ~u : (u | 0x80000000u); }
__device__ __forceinline__ int wave_sum_i32(int v) {
    v += __builtin_amdgcn_update_dpp(0, v, 0xB1, 0xF, 0xF, false);
    v += __builtin_amdgcn_update_dpp(0, v, 0x4E, 0xF, 0xF, false);
    v += __builtin_amdgcn_update_dpp(0, v, 0x141, 0xF, 0xF, false);
    v += __builtin_amdgcn_update_dpp(0, v, 0x140, 0xF, 0xF, false);
    return __builtin_amdgcn_readlane(v, 0) + __builtin_amdgcn_readlane(v, 16) + __builtin_amdgcn_readlane(v, 32) + __builtin_amdgcn_readlane(v, 48);
}
__device__ __forceinline__ int wave_excl_scan_i32(int c, int lane, int& total) {
    int x = c;
    x += __builtin_amdgcn_update_dpp(0, x, 0x111, 0xF, 0xF, true);
    x += __builtin_amdgcn_update_dpp(0, x, 0x112, 0xF, 0xF, true);
    x += __builtin_amdgcn_update_dpp(0, x, 0x114, 0xF, 0xF, true);
    x += __builtin_amdgcn_update_dpp(0, x, 0x118, 0xF, 0xF, true);
    const int t0 = __builtin_amdgcn_readlane(x, 15), t1 = __builtin_amdgcn_readlane(x, 31), t2 = __builtin_amdgcn_readlane(x, 47), t3 = __builtin_amdgcn_readlane(x, 63);
    const int row = lane >> 4;
    x += (row > 0 ? t0 : 0) + (row > 1 ? t1 : 0) + (row > 2 ? t2 : 0);
    total = t0 + t1 + t2 + t3;
    return x - c;
}
__device__ __forceinline__ int mbcnt64(unsigned long long m) { return (int)__builtin_amdgcn_mbcnt_hi((unsigned)(m >> 32), __builtin_amdgcn_mbcnt_lo((unsigned)m, 0u)); }
__device__ __forceinline__ void phase_dsa(const Params& p, char* lds) {
    const bf16_t* P = (const bf16_t*)(p.ws + WS_P); bf16_t* OL = (bf16_t*)(p.ws + WS_OLAT);
    const int tid = threadIdx.x, lane = tid & 63, wave = __builtin_amdgcn_readfirstlane(tid >> 6);
    unsigned* SC = (unsigned*)(lds + DSA_KVB);
    unsigned short* IDX = (unsigned short*)(lds + DSA_IDX);
    int* MISC = (int*)(lds + DSA_MISC);
    const unsigned lds_base = (unsigned)(size_t)lds;
    constexpr int NU = SEQ / DSA_NQ;
    for (int unit = blockIdx.x; unit < BATCH * NU; unit += gridDim.x) {
        const int u8 = NU - 1 - unit / BATCH, b = unit % BATCH, t0 = NMETA + u8 * DSA_NQ;
        const int cid = 1 + (t0 - NMETA) / 64, n = NMETA + 64 * cid;
        const bf16_t* Pb = P + (size_t)b * T * PW;
        const int m = lane & 31, hh = lane >> 5;
        bf16x8 aq[2][4]; float wv[2][16];
#pragma unroll
        for (int rt = 0; rt < 2; ++rt) {
#pragma unroll
            for (int s = 0; s < 4; ++s) aq[rt][s] = *(const bf16x8*)(Pb + (size_t)(t0 + 4 * rt + (m >> 3)) * PW + C_QI + (m & 7) * 64 + 16 * s + 8 * hh);
#pragma unroll
            for (int r = 0; r < 16; ++r) wv[rt][r] = bf2f(Pb[(size_t)(t0 + 4 * rt + (r >> 2)) * PW + C_WI + (r & 3) + 4 * hh]);
        }
        const unsigned char* KIPb = p.ws + WS_KIP + (size_t)b * KIP_BATCH + lane * 16;
        bf16x8 bk[4];
#pragma unroll
        for (int s = 0; s < 4; ++s) bk[s] = *(const bf16x8*)(KIPb + (size_t)wave * 4096 + s * 1024);
        __syncthreads();
        {
            const int ntile = (n + 31) / 32;
            for (int kt = wave; kt < ntile; kt += NWAVES) {
                const int j0 = kt * 32, key = j0 + m;
                bf16x8 bn[4];
                { const int ktn = kt + NWAVES < 129 ? kt + NWAVES : 128;
#pragma unroll
                  for (int s = 0; s < 4; ++s) bn[s] = *(const bf16x8*)(KIPb + (size_t)ktn * 4096 + s * 1024); }
                const bool ok = key < n;
#pragma unroll
                for (int rt = 0; rt < 2; ++rt) {
                    f32x16 acc;
#pragma unroll
                    for (int r = 0; r < 16; ++r) acc[r] = 0.f;
#pragma unroll
                    for (int s = 0; s < 4; ++s) acc = __builtin_amdgcn_mfma_f32_32x32x16_bf16(aq[rt][s], bk[s], acc, 0, 0, 0);
                    float tq[4];
#pragma unroll
                    for (int q = 0; q < 4; ++q) {
#define RELU_(x) __builtin_amdgcn_fmed3f((x), 0.f, 3.0e38f)
                        float s = wv[rt][4 * q] * RELU_(acc[4 * q]); s += wv[rt][4 * q + 1] * RELU_(acc[4 * q + 1]); s += wv[rt][4 * q + 2] * RELU_(acc[4 * q + 2]); s += wv[rt][4 * q + 3] * RELU_(acc[4 * q + 3]);
#undef RELU_
                        tq[q] = xsum32(s);
                    }
                    const float s0 = hh ? tq[2] : tq[0], s1 = hh ? tq[3] : tq[1];
                    SC[(4 * rt + 2 * hh) * DSA_SCS + key] = ok ? fkey(s0) : 0u;
                    SC[(4 * rt + 2 * hh + 1) * DSA_SCS + key] = ok ? fkey(s1) : 0u;
                }
#pragma unroll
                for (int s = 0; s < 4; ++s) bk[s] = bn[s];
            }
        }
        __syncthreads();
        bf16x8 qf[5];
        {
            const int hd_ = lane & 15, g_ = lane >> 4;
#pragma unroll
            for (int ks = 0; ks < 5; ++ks) {
                u32x4 w = (u32x4){0u, 0u, 0u, 0u};
                if (hd_ < 8 && (ks < 4 || g_ < 2)) w = *(const u32x4*)(Pb + (size_t)(t0 + wave) * PW + C_QF + hd_ * QFW + 32 * ks + 8 * g_);
                qf[ks] = __builtin_bit_cast(bf16x8, w);
            }
        }
        {
            unsigned* sc = SC + wave * DSA_SCS;
            unsigned v[65];
#pragma unroll
            for (int i = 0; i < 65; ++i) { const int k = i * 64 + lane; v[i] = (k < n) ? sc[k] : 0u; }
            unsigned prefix = 0u; int cge = n, bit = 31;
            bool exact = false;
            if (n >= 256) {
                for (; bit >= 0 && cge > 512; --bit) {
                    const unsigned cand = prefix | (1u << bit); const int sc_ = (int)(cand ^ 0x80000000u);
                    unsigned b0 = 0u, b1 = 0u, b2 = 0u; int slots = 0;
#pragma unroll
                    for (int gi = 0; gi < 5; ++gi) if (gi * 832 < n) {
#pragma unroll
                        for (int i = 13 * gi; i < 13 * gi + 13; ++i) {
                            const unsigned d = (unsigned)__builtin_elementwise_sub_sat((int)(v[i] ^ 0x80000000u), sc_);
                            if (i % 3 == 0) b0 = __builtin_amdgcn_alignbit(b0, d, 31); else if (i % 3 == 1) b1 = __builtin_amdgcn_alignbit(b1, d, 31); else b2 = __builtin_amdgcn_alignbit(b2, d, 31);
                        }
                        slots += 13 * 64;
                    }
                    const int c = slots - wave_sum_i32(__builtin_popcount(b0) + __builtin_popcount(b1) + __builtin_popcount(b2));
                    if (c >= 256) { prefix = cand; cge = c; if (c == 256) { exact = true; break; } }
                }
            }
            int ngt = n;
            if (n >= 256 && !exact) {
                asm volatile("s_waitcnt lgkmcnt(0)" ::: "memory");
                int cb = 0;
                if (bit >= 0) {
                    const int sp_ = (int)((prefix > 0u ? prefix : 1u) ^ 0x80000000u);
                    unsigned lb0 = 0u, lb1 = 0u, lb2 = 0u;
#pragma unroll
                    for (int i = 0; i < 65; ++i) { const unsigned d = (unsigned)__builtin_elementwise_sub_sat((int)(v[i] ^ 0x80000000u), sp_);
                        if (i < 32) lb0 = __builtin_amdgcn_alignbit(lb0, d, 31); else if (i < 64) lb1 = __builtin_amdgcn_alignbit(lb1, d, 31); else lb2 = d >> 31; }
                    const unsigned tk0 = ~lb0, tk1 = ~lb1, tk2 = (~lb2) & 1u;
                    const int c0 = __builtin_popcount(tk0), c1 = __builtin_popcount(tk1);
                    const int lbase = wave_excl_scan_i32(c0 + c1 + (int)tk2, lane, cb);
#pragma unroll
                    for (int i = 0; i < 65; ++i) {
                        bool tkn; int rk;
                        if (i < 32) { tkn = (tk0 >> (31 - i)) & 1u; rk = i == 0 ? 0 : __builtin_popcount(tk0 >> (32 - i)); }
                        else if (i < 64) { tkn = (tk1 >> (63 - i)) & 1u; rk = c0 + (i == 32 ? 0 : __builtin_popcount(tk1 >> (64 - i))); }
                        else { tkn = tk2 != 0u; rk = c0 + c1; }
                        sc[tkn ? lbase + rk : 4096 + (lane & 15)] = v[i];
                    }
                    asm volatile("s_waitcnt lgkmcnt(0)" ::: "memory");
                    unsigned w[8];
#pragma unroll
                    for (int j = 0; j < 8; ++j) { const int k = j * 64 + lane; w[j] = (k < cb) ? sc[k] : 0u; }
                    for (; bit >= 0; --bit) {
                        const unsigned cand = prefix | (1u << bit); const int sc_ = (int)(cand ^ 0x80000000u); unsigned b0 = 0u, b1 = 0u;
#pragma unroll
                        for (int j = 0; j < 8; ++j) { const unsigned d = (unsigned)__builtin_elementwise_sub_sat((int)(w[j] ^ 0x80000000u), sc_); if (j & 1) b1 = __builtin_amdgcn_alignbit(b1, d, 31); else b0 = __builtin_amdgcn_alignbit(b0, d, 31); }
                        const int c = 512 - wave_sum_i32(__builtin_popcount(b0) + __builtin_popcount(b1));
                        if (c >= 256) { prefix = cand; if (c == 256) { exact = true; break; } }
                    }
                    int c = 0;
#pragma unroll
                    for (int j = 0; j < 8; ++j) c += __popcll(__ballot(w[j] > prefix));
                    ngt = c;
                } else {
                    int c = 0;
#pragma unroll
                    for (int i = 0; i < 65; ++i) { c += __popcll(__ballot(v[i] > prefix)); if ((i & 3) == 3) __builtin_amdgcn_sched_barrier(0); }
                    ngt = c;
                }
            }
            const unsigned tau = prefix;
            const int need_eq = n >= 256 ? 256 - ngt : 0; int base = 0, eqb = 0;
            unsigned short* idx = IDX + wave * 512;
            {
                const int st_ = (int)(tau ^ 0x80000000u); unsigned e0 = 0u, e1 = 0u, e2 = 0u;
#pragma unroll
                for (int i = 0; i < 65; ++i) { const unsigned d = (unsigned)__builtin_elementwise_sub_sat((int)(v[i] ^ 0x80000000u), st_);
                    if (i < 32) e0 = __builtin_amdgcn_alignbit(e0, d, 31); else if (i < 64) e1 = __builtin_amdgcn_alignbit(e1, d, 31); else e2 = d >> 31; }
                const unsigned tk0 = ~e0, tk1 = ~e1, tk2 = (~e2) & 1u;
                const int c0 = __builtin_popcount(tk0), c1 = __builtin_popcount(tk1);
                int nge; const int lbase = wave_excl_scan_i32(c0 + c1 + (int)tk2, lane, nge);
                if (n >= 256 && nge == 256) {
#pragma unroll
                    for (int i = 0; i < 65; ++i) {
                        bool tkn; int rk;
                        if (i < 32) { tkn = (tk0 >> (31 - i)) & 1u; rk = i == 0 ? 0 : __builtin_popcount(tk0 >> (32 - i)); }
                        else if (i < 64) { tkn = (tk1 >> (63 - i)) & 1u; rk = c0 + (i == 32 ? 0 : __builtin_popcount(tk1 >> (64 - i))); }
                        else { tkn = tk2 != 0u; rk = c0 + c1; }
                        idx[tkn ? lbase + rk : 256 + lane] = (unsigned short)(i * 64 + lane);
                    }
                    base = nge;
                } else {
#pragma unroll
                    for (int gi = 0; gi < 5; ++gi) if (gi * 832 < n) {
#pragma unroll
                        for (int i = 13 * gi; i < 13 * gi + 13; ++i) {
                            const int k = i * 64 + lane; const unsigned u = v[i];
                            const bool eq = (u == tau); const unsigned long long meq = __ballot(eq);
                            const bool take = (u > tau) || (eq && (eqb + mbcnt64(meq)) < need_eq);
                            const unsigned long long mt = __ballot(take);
                            idx[take ? base + mbcnt64(mt) : 256 + lane] = (unsigned short)k;
                            base += __popcll(mt); eqb += __popcll(meq);
                            if ((i & 3) == 3) __builtin_amdgcn_sched_barrier(0);
                        }
                    }
                }
            }
            for (int pos = base + lane; pos < 256; pos += 64) idx[pos] = 0;
            if (lane == 0) MISC[wave] = base;
        }
        asm volatile("s_waitcnt lgkmcnt(0)" ::: "memory");
        {
            const int q = wave; const int nsel = MISC[q];
            const size_t qrow = (size_t)(t0 + q);
            int ln = lane; asm volatile("" : "+v"(ln));
            const int hd = ln & 15, g = ln >> 4, qd = (ln & 15) >> 2, pp = ln & 3;
            char* ring = lds + DSA_KVB + wave * DSA_RING;
            const unsigned ring_a = lds_base + DSA_KVB + wave * DSA_RING;
            const unsigned short* idx = IDX + q * 512;
            asm volatile("s_waitcnt vmcnt(0)" ::: "memory");
#define DSA_ISSUE(c) do { _Pragma("unroll") for (int i_ = 0; i_ < 9; ++i_) { const int pid_ = ln + 64 * i_, row_ = pid_ / 18, part_ = pid_ - row_ * 18; \
                const bf16_t* src_ = Pb + (size_t)idx[32 * (c) + row_] * PW + C_KV + part_ * 8; \
                __builtin_amdgcn_global_load_lds((const unsigned*)src_, (LAS unsigned*)(ring + ((c) & 1) * 9216 + i_ * 1024), 16, 0, 0); } } while (0)
            DSA_ISSUE(0); DSA_ISSUE(1);
            f32x4 O[8];
#pragma unroll
            for (int nt = 0; nt < 8; ++nt) O[nt] = (f32x4){0.f, 0.f, 0.f, 0.f};
            float mrun = -3e38f, lrun = 0.f;
            for (int c = 0; c < 8; ++c) {
                if (c < 7) asm volatile("s_waitcnt vmcnt(9)" ::: "memory"); else asm volatile("s_waitcnt vmcnt(0)" ::: "memory");
                const char* buf = ring + (c & 1) * 9216;
                f32x4 S0 = (f32x4){0.f, 0.f, 0.f, 0.f}, S1 = S0;
                {
                    const char* kr = buf + hd * 288 + 16 * g;
#pragma unroll
                    for (int ks = 0; ks < 4; ++ks) { S0 = __builtin_amdgcn_mfma_f32_16x16x32_bf16(*(const bf16x8*)(kr + 64 * ks), qf[ks], S0, 0, 0, 0); S1 = __builtin_amdgcn_mfma_f32_16x16x32_bf16(*(const bf16x8*)(kr + 16 * 288 + 64 * ks), qf[ks], S1, 0, 0, 0); }
                    u32x4 w0 = (u32x4){0u, 0u, 0u, 0u}, w1 = w0; if (g < 2) { w0 = *(const u32x4*)(kr + 256); w1 = *(const u32x4*)(kr + 16 * 288 + 256); }
                    S0 = __builtin_amdgcn_mfma_f32_16x16x32_bf16(__builtin_bit_cast(bf16x8, w0), qf[4], S0, 0, 0, 0); S1 = __builtin_amdgcn_mfma_f32_16x16x32_bf16(__builtin_bit_cast(bf16x8, w1), qf[4], S1, 0, 0, 0);
                }
                float cm = -3e38f;
#pragma unroll
                for (int r = 0; r < 4; ++r) { if (nsel < 256) { const int sl = 32 * c + 4 * g + r; S0[r] = sl < nsel ? S0[r] : -1e30f; S1[r] = (sl + 16) < nsel ? S1[r] : -1e30f; } cm = fmax2(cm, fmax2(S0[r], S1[r])); }
                cm = xmax16(xmax32(cm));
                if (__any(cm > mrun + 6.f)) {
                    const float mnew = fmaxf(mrun, cm), alpha = fexp2(mrun - mnew);
                    lrun *= alpha; mrun = mnew;
#pragma unroll
                    for (int nt = 0; nt < 8; ++nt) O[nt] *= alpha;
                }
                float ps = 0.f;
#pragma unroll
                for (int r = 0; r < 4; ++r) { S0[r] = fexp2(S0[r] - mrun); S1[r] = fexp2(S1[r] - mrun); ps += S0[r] + S1[r]; }
                ps = xsum16(xsum32(ps));
                lrun += ps;
                u32x4 pw; pw.x = pk2(S0[0], S0[1]); pw.y = pk2(S0[2], S0[3]); pw.z = pk2(S1[0], S1[1]); pw.w = pk2(S1[2], S1[3]);
                const bf16x8 pf = __builtin_bit_cast(bf16x8, pw);
                const unsigned va = ring_a + (unsigned)((c & 1) * 9216 + (4 * g + qd) * 288 + 8 * pp);
#pragma unroll
                for (int h2 = 0; h2 < 2; ++h2) {
                    u16x4 x0, x1, x2, x3, y0, y1, y2, y3;
                    asm volatile("ds_read_b64_tr_b16 %0, %8 offset:%9\n\tds_read_b64_tr_b16 %1, %8 offset:%10\n\tds_read_b64_tr_b16 %2, %8 offset:%11\n\tds_read_b64_tr_b16 %3, %8 offset:%12\n\t"
                                 "ds_read_b64_tr_b16 %4, %8 offset:%13\n\tds_read_b64_tr_b16 %5, %8 offset:%14\n\tds_read_b64_tr_b16 %6, %8 offset:%15\n\tds_read_b64_tr_b16 %7, %8 offset:%16\n\ts_waitcnt lgkmcnt(0)"
                                 : "=&v"(x0), "=&v"(x1), "=&v"(x2), "=&v"(x3), "=&v"(y0), "=&v"(y1), "=&v"(y2), "=&v"(y3)
                                 : "v"(va), "i"(128 * h2), "i"(128 * h2 + 32), "i"(128 * h2 + 64), "i"(128 * h2 + 96), "i"(128 * h2 + 4608), "i"(128 * h2 + 4640), "i"(128 * h2 + 4672), "i"(128 * h2 + 4704) : "memory");
#define DSA_PV(nt_, x_, y_) do { bf16x8 vf_; vf_[0] = (short)x_[0]; vf_[1] = (short)x_[1]; vf_[2] = (short)x_[2]; vf_[3] = (short)x_[3]; vf_[4] = (short)y_[0]; vf_[5] = (short)y_[1]; vf_[6] = (short)y_[2]; vf_[7] = (short)y_[3]; \
                    O[nt_] = __builtin_amdgcn_mfma_f32_16x16x32_bf16(vf_, pf, O[nt_], 0, 0, 0); } while (0)
                    DSA_PV(4 * h2 + 0, x0, y0); DSA_PV(4 * h2 + 1, x1, y1); DSA_PV(4 * h2 + 2, x2, y2); DSA_PV(4 * h2 + 3, x3, y3);
                }
                asm volatile("s_waitcnt lgkmcnt(0)" ::: "memory");
                if (c + 2 < 8) DSA_ISSUE(c + 2);
            }
#undef DSA_PV
#undef DSA_ISSUE
            const float inv = __builtin_amdgcn_rcpf(lrun);
            if (hd < 8) {
                bf16_t* op = OL + ((size_t)b * SEQ + (qrow - NMETA)) * 1024 + hd * 128 + 4 * g;
#pragma unroll
                for (int nt = 0; nt < 8; ++nt) { u32x2 w; w.x = pk2(O[nt][0] * inv, O[nt][1] * inv); w.y = pk2(O[nt][2] * inv, O[nt][3] * inv); *(u32x2*)(op + 16 * nt) = w; }
            }
        }
    }
}

__device__ __forceinline__ void phase_inproj_meta(const Params& p) {
    unsigned char* ws = p.ws; const int tid = threadIdx.x, lane = tid & 63, wave = tid >> 6, fr = lane & 15, fq = lane >> 4;
    const bf16_t* U = (const bf16_t*)(ws + WS_U); const bf16_t* WP = (const bf16_t*)(ws + WS_WP); bf16_t* P = (bf16_t*)(ws + WS_P); const float2* cs = (const float2*)(ws + WS_CS);
    const int gw = blockIdx.x * NWAVES + wave, NGW = gridDim.x * NWAVES;
    for (int nt = gw; nt < PW / 16; nt += NGW) {
        const bf16_t* ap = U + (size_t)fr * D + 8 * fq; const bf16_t* bp = WP + (size_t)(16 * nt + fr) * D + 8 * fq;
        f32x4 acc = (f32x4){0.f, 0.f, 0.f, 0.f};
#pragma unroll 8
        for (int ks = 0; ks < D / 32; ++ks) acc = __builtin_amdgcn_mfma_f32_16x16x32_bf16(*(const bf16x8*)(bp + 32 * ks), *(const bf16x8*)(ap + 32 * ks), acc, 0, 0, 0);
        const int col = 16 * nt + 4 * fq, t = fr; f32x4 v = acc; int o;
        if (pg8::rope_off(col, o)) { const float2 c0 = cs[t * 8 + (o >> 1)], c1 = cs[t * 8 + (o >> 1) + 1]; v = (f32x4){v.x * c0.x - v.y * c0.y, v.y * c0.x + v.x * c0.y, v.z * c1.x - v.w * c1.y, v.w * c1.x + v.z * c1.y}; }
        u32x2 w; w.x = pk2(v.x, v.y); w.y = pk2(v.z, v.w);
        for (int b = 0; b < BATCH; ++b) {
            if (col >= C_KI && col < C_WI) { const int d0 = col - C_KI;
                *(u32x2*)(ws + WS_KIP + (size_t)b * KIP_BATCH + (size_t)((((t >> 5) * 4 + (d0 >> 4)) * 2 + ((d0 >> 3) & 1)) * 512 + (t & 31) * 16 + (d0 & 7) * 2)) = w; }
            else *(u32x2*)(P + ((size_t)b * T + t) * PW + col) = w;
        }
    }
}

__device__ __forceinline__ void phase_c3(const Params& p, char* lds) {
    unsigned char* ws = p.ws; const int tid = threadIdx.x, lane = tid & 63, wave = __builtin_amdgcn_readfirstlane(tid >> 6);
    const float* H1 = (const float*)(ws + WS_H1); const float* g = p.in[I_GFFN];
    {
        bf16_t* U2 = (bf16_t*)(ws + WS_U); const int gw = blockIdx.x * NWAVES + wave, NGW = gridDim.x * NWAVES;
        for (int row = gw; row < NR; row += NGW) {
            const f32x4* xr = (const f32x4*)(H1 + (size_t)row * D) + lane;
            f32x4 v[4]; float s = 0.f;
#pragma unroll
            for (int j = 0; j < 4; ++j) { v[j] = xr[64 * j]; s += (v[j].x * v[j].x + v[j].y * v[j].y) + (v[j].z * v[j].z + v[j].w * v[j].w); }
            const float rstd = rsqrtf(wave_sum(s) * (1.f / D) + NORM_EPS);
            u32x2* o = (u32x2*)(U2 + (size_t)row * D) + lane;
#pragma unroll
            for (int j = 0; j < 4; ++j) { const f32x4 gg = ((const f32x4*)g)[lane + 64 * j];
                u32x2 w; w.x = pk2(v[j].x * rstd * gg.x, v[j].y * rstd * gg.y); w.y = pk2(v[j].z * rstd * gg.z, v[j].w * rstd * gg.w); o[64 * j] = w; }
        }
    }
    {
        float* Tl = (float*)lds;
        float* RED = (float*)lds;
        const float* wg = p.in[I_WGRP]; const float* wr = p.in[I_WRT]; const float* bg = p.in[I_BGRP]; const float* br = p.in[I_BRT];
        unsigned* ctl = (unsigned*)(ws + WS_CTL); int* LIST = (int*)(ws + WS_LIST); float* GATE = (float*)(ws + WS_GATE);
        const int tk = tid & 127, kq = wave >> 1;
        for (int grp = blockIdx.x; grp < NR / 128; grp += gridDim.x) {
            const int tok0 = grp * 128;
            float acc[36]; float ss = 0.f;
#pragma unroll
            for (int o = 0; o < 36; ++o) acc[o] = 0.f;
            for (int step = 0; step < 8; ++step) {
                __syncthreads();
#pragma unroll
                for (int i = 0; i < 8; ++i) { const int idx = tid + NTHREADS * i, qq = idx >> 10, rem = idx & 1023, t2 = rem >> 3, kc = rem & 7;
                    const f32x4 v = *(const f32x4*)(H1 + (size_t)(tok0 + t2) * D + qq * 256 + step * 32 + kc * 4);
                    float* d = Tl + qq * (32 * 129) + (kc * 4) * 129 + t2; d[0] = v.x; d[129] = v.y; d[258] = v.z; d[387] = v.w; }
                __syncthreads();
                const int kb = kq * 256 + step * 32;
#pragma unroll 4
                for (int k = 0; k < 32; ++k) {
                    const float h = Tl[kq * (32 * 129) + k * 129 + tk]; ss += h * h; const float hg = h * g[kb + k];
                    const float* w4 = wg + (size_t)(kb + k) * 4; const float* w32 = wr + (size_t)(kb + k) * 32;
#pragma unroll
                    for (int o = 0; o < 4; ++o) acc[o] += hg * w4[o];
#pragma unroll
                    for (int o = 0; o < 32; ++o) acc[4 + o] += hg * w32[o];
                }
            }
            __syncthreads();
#pragma unroll
            for (int o = 0; o < 36; ++o) RED[(kq * 37 + o) * 128 + tk] = acc[o];
            RED[(kq * 37 + 36) * 128 + tk] = ss;
            __syncthreads();
            if (tid < 128) {
                const int tok = tok0 + tk;
#pragma unroll
                for (int o = 0; o < 36; ++o) acc[o] = (RED[o * 128 + tk] + RED[(37 + o) * 128 + tk]) + (RED[(74 + o) * 128 + tk] + RED[(111 + o) * 128 + tk]);
                ss = (RED[36 * 128 + tk] + RED[(37 + 36) * 128 + tk]) + (RED[(74 + 36) * 128 + tk] + RED[(111 + 36) * 128 + tk]);
                const float rstd = rsqrtf(ss * (1.f / D) + NORM_EPS);
                float gl[4]; int gs = 0; float gm;
#pragma unroll
                for (int o = 0; o < 4; ++o) gl[o] = acc[o] * rstd + bg[o];
                gm = gl[0];
#pragma unroll
                for (int o = 1; o < 4; ++o) if (gl[o] > gm) { gm = gl[o]; gs = o; }
                float gsum = 0.f;
#pragma unroll
                for (int o = 0; o < 4; ++o) gsum += __expf(gl[o] - gm);
                const float pgrp = 1.f / gsum;
                float el[8];
#pragma unroll
                for (int j = 0; j < 8; ++j) { float a = acc[4 + j]; float bb = br[j];
                    a = gs == 1 ? acc[12 + j] : a; bb = gs == 1 ? br[8 + j] : bb; a = gs == 2 ? acc[20 + j] : a; bb = gs == 2 ? br[16 + j] : bb; a = gs == 3 ? acc[28 + j] : a; bb = gs == 3 ? br[24 + j] : bb;
                    el[j] = a * rstd + bb; }
                int e0 = 0; float m0 = el[0];
#pragma unroll
                for (int j = 1; j < 8; ++j) if (el[j] > m0) { m0 = el[j]; e0 = j; }
                int e1 = -1; float m1 = -3e38f;
#pragma unroll
                for (int j = 0; j < 8; ++j) if (j != e0 && el[j] > m1) { m1 = el[j]; e1 = j; }
                const float x1 = __expf(m1 - m0); const float g0 = pgrp / (1.f + x1), g1 = pgrp * x1 / (1.f + x1);
                const int ex0 = gs * 8 + e0, ex1 = gs * 8 + e1;
                const int s0 = (int)atomicAdd(ctl + CW_CNT + 64 * ex0, 1u); LIST[(size_t)ex0 * NR + s0] = tok * 2;
                const int s1 = (int)atomicAdd(ctl + CW_CNT + 64 * ex1, 1u); LIST[(size_t)ex1 * NR + s1] = tok * 2 + 1;
                GATE[tok * 2] = g0; GATE[tok * 2 + 1] = g1;
            }
        }
    }
}

template <int WHICH>
__device__ __forceinline__ void phase_moe(const Params& p, char* lds) {
    unsigned char* ws = p.ws; const int tid = threadIdx.x;
    const unsigned* ctl = (const unsigned*)(ws + WS_CTL);
    int* TP = (int*)(lds + pg8::STAGE_BYTES);
    __syncthreads();
    if (tid == 0) { int tp = 0, ro = 0; for (int e = 0; e < NEXP; ++e) { const int c = (int)ctl[CW_CNT + 64 * e]; TP[e] = tp; TP[64 + e] = ro; TP[128 + e] = c; const int t = (c + 255) / 256; tp += t * 4; ro += t * 256; } TP[NEXP] = tp; }
    __syncthreads();
    pg8::MoeOrder<WHICH> S{TP, (int)gridDim.x, (int)blockIdx.x, (const char*)(ws + (WHICH == 0 ? WS_U : WS_HID)), (const char*)(ws + (WHICH == 0 ? WS_W13 : WS_W2)), (const int*)(ws + WS_LIST)};
    if constexpr (WHICH == 0) { pg8::EpiMoe1 E{(bf16_t*)(ws + WS_HID), TP}; pg8::gemm_phase_x<pg8::EpiMoe1, pg8::MoeOrder<0>, true, true>((LAS unsigned char*)lds, 1024, S, E); }
    else { pg8::EpiMoe2 E{(bf16_t*)(ws + WS_MO), TP, (const int*)(ws + WS_LIST), (const float*)(ws + WS_GATE)}; pg8::gemm_phase_x<pg8::EpiMoe2, pg8::MoeOrder<1>, true, true>((LAS unsigned char*)lds, 512, S, E); }
}

__device__ __forceinline__ void phase_final(const Params& p) {
    unsigned char* ws = p.ws; const int tid = threadIdx.x, lane = tid & 63, wave = tid >> 6;
    const float* H1 = (const float*)(ws + WS_H1); const bf16_t* MO = (const bf16_t*)(ws + WS_MO); const float* g = p.in[I_GFIN];
    const int gw = blockIdx.x * NWAVES + wave, NGW = gridDim.x * NWAVES;
    for (int orow = gw; orow < BATCH * SEQ; orow += NGW) {
        const size_t row = (size_t)orow;
        const f32x4* xr = (const f32x4*)(H1 + row * D) + lane; const u32x2* m0 = (const u32x2*)(MO + row * 2 * D) + lane; const u32x2* m1 = m0 + 256;
        f32x4 v[4]; float ss = 0.f;
#pragma unroll
        for (int j = 0; j < 4; ++j) { const u32x2 a = m0[64 * j], c = m1[64 * j]; v[j] = xr[64 * j];
            v[j].x += bflo(a.x) + bflo(c.x); v[j].y += bfhi(a.x) + bfhi(c.x); v[j].z += bflo(a.y) + bflo(c.y); v[j].w += bfhi(a.y) + bfhi(c.y);
            ss += (v[j].x * v[j].x + v[j].y * v[j].y) + (v[j].z * v[j].z + v[j].w * v[j].w); }
        const float rstd = rsqrtf(wave_sum(ss) * (1.f / D) + NORM_EPS);
        f32x4* o = (f32x4*)(p.out + (size_t)orow * D) + lane;
#pragma unroll
        for (int j = 0; j < 4; ++j) { const f32x4 gg = ((const f32x4*)g)[lane + 64 * j]; o[64 * j] = v[j] * rstd * gg; }
    }
}

#define XB_TMO      128
#define XB_XCNT(j)  (256  + 64 * (j))
#define XB_XSUB(j)  (1280 + 64 * (j))
#define XB_XGEN(j)  (2304 + 64 * (j))
#define XB_TOP      3328
#define XB_TOPGEN   3392
#define XCD_BAR_WORDS 3456
#define XB_SPIN_CAP (1u << 18)
__device__ __forceinline__ unsigned xb_ld(unsigned* p)              { return __hip_atomic_load(p, __ATOMIC_RELAXED, __HIP_MEMORY_SCOPE_AGENT); }
__device__ __forceinline__ unsigned xb_add(unsigned* p, unsigned v) { return __hip_atomic_fetch_add(p, v, __ATOMIC_RELAXED, __HIP_MEMORY_SCOPE_AGENT); }
__device__ __forceinline__ unsigned xb_xcc_id() { return (unsigned)__builtin_amdgcn_s_getreg((3 << 11) | 20) & 0xFu; }
#define XB_SPIN(cond, bar) do { unsigned _sp = 0; while (cond) { __builtin_amdgcn_s_sleep(1); \
    if ((++_sp & 255u) == 0u) { if (xb_ld(&(bar)[XB_TMO])) break; if (_sp > XB_SPIN_CAP) { atomicAdd(&(bar)[XB_TMO], 1u); break; } } } } while (0)
struct XcdBarrier { unsigned* bar; unsigned x; volatile LAS unsigned* st; };
__device__ __forceinline__ XcdBarrier xcd_barrier_post(unsigned* bar, volatile LAS unsigned* st) {
    XcdBarrier b; b.bar = bar; b.x = xb_xcc_id(); b.st = st;
    if (threadIdx.x == 0) (void)xb_add(&bar[XB_XCNT(b.x)], 1u);
    return b;
}
__device__ __forceinline__ void xcd_barrier_complete(unsigned* bar, unsigned x, unsigned& nloc, unsigned& nx) {
    const unsigned G = gridDim.x * gridDim.y * gridDim.z;
    unsigned sum, cnt, mine, sp = 0u;
    for (;;) {
        sum = 0u; cnt = 0u; mine = 0u;
#pragma unroll
        for (unsigned j = 0; j < 16; ++j) { const unsigned c = xb_ld(&bar[XB_XCNT(j)]); sum += c; cnt += (c > 0u) ? 1u : 0u; mine = (j == x) ? c : mine; }
        if (sum == G) break;
        __builtin_amdgcn_s_sleep(1);
        if ((++sp & 255u) == 0u) { if (xb_ld(&bar[XB_TMO])) break; if (sp > XB_SPIN_CAP) { atomicAdd(&bar[XB_TMO], 1u); break; } }
    }
    nloc = mine > 0u ? mine : 1u; nx = cnt > 0u ? cnt : 1u;
}
__device__ __forceinline__ void xcd_barrier(const XcdBarrier& b) {
    asm volatile("s_waitcnt vmcnt(0)" ::: "memory");
    __syncthreads();
    if (threadIdx.x == 0) {
        unsigned* bar = b.bar;
        __builtin_amdgcn_s_waitcnt(0);
        unsigned nloc = b.st[0], nx = b.st[1];
        if (nloc == 0u) { xcd_barrier_complete(bar, b.x, nloc, nx); b.st[0] = nloc; b.st[1] = nx; }
        const unsigned old = xb_add(&bar[XB_XSUB(b.x)], 1u);
        const unsigned gen = old / nloc;
        if (old + 1u == (gen + 1u) * nloc) {
            __builtin_amdgcn_fence(__ATOMIC_RELEASE, "agent");
            asm volatile("s_waitcnt vmcnt(0)" ::: "memory");
            const unsigned og = xb_add(&bar[XB_TOP], 1u);
            const unsigned tg = og / nx;
            if (og + 1u == (tg + 1u) * nx) xb_add(&bar[XB_TOPGEN], 1u);
            else XB_SPIN(xb_ld(&bar[XB_TOPGEN]) == tg, bar);
            __builtin_amdgcn_fence(__ATOMIC_ACQUIRE, "agent");
            xb_add(&bar[XB_XGEN(b.x)], 1u);
            asm volatile("s_waitcnt vmcnt(0)" ::: "memory");
        } else {
            XB_SPIN(xb_ld(&bar[XB_XGEN(b.x)]) == gen, bar);
            __builtin_amdgcn_fence(__ATOMIC_ACQUIRE, "agent");
            asm volatile("s_waitcnt vmcnt(0)" ::: "memory");
        }
    }
    __syncthreads();
}

constexpr int LDS_XB = DSA_LDS;
constexpr int LDS_BYTES = DSA_LDS + 256;
static_assert(pg8::STAGE_BYTES <= LDS_XB && pg8::STAGE_BYTES + 1024 <= LDS_XB && NWAVES * 64 * 33 * 4 <= LDS_XB && NWAVES * 64 * SB_VT_STRIDE * 2 <= LDS_XB && 4 * 37 * 128 * 4 <= LDS_XB, "LDS map");

__global__ void __launch_bounds__(NTHREADS, 2) mega(Params p) {
    extern __shared__ __attribute__((aligned(16))) char lds[];
    const int lo = p.ph_lo, hi = p.ph_hi;
    unsigned char* ws = p.ws;
    XcdBarrier xb;
    {
        volatile LAS unsigned* st = (volatile LAS unsigned*)(lds + LDS_XB);
        if (threadIdx.x < 4) st[threadIdx.x] = 0u;
        __syncthreads();
        xb = xcd_barrier_post((unsigned*)(ws + WS_CTL) + CW_BAR, st);
    }
#define IN(k) (lo <= (k) && (k) < hi)
#define GSYNC() xcd_barrier(xb)
#define SEAM(k) do { if (IN(k) && IN((k) + 1)) GSYNC(); } while (0)
#define REP(k, ...) do { if (IN(k)) { __VA_ARGS__; } } while (0)
    LAS unsigned char* ldsl = (LAS unsigned char*)lds;
    REP(0, phase_prologue(p, lds));
    SEAM(0);
    REP(1, { phase_inproj_meta(p);
             pg8::TokRowOrder S; S.init(NR, PWN, gridDim.x, blockIdx.x); S.Abase = (const char*)(ws + WS_U); S.Bbase = (const char*)(ws + WS_WP); S.K = D;
             pg8::EpiInproj E{(bf16_t*)(ws + WS_P), (const float2*)(ws + WS_CS), ws + WS_KIP}; pg8::gemm_phase_x<pg8::EpiInproj, pg8::TokRowOrder, true, true>(ldsl, D, S, E); });
    SEAM(1);
    if (IN(2)) {
        phase_dsa(p, lds);
        __syncthreads(); phase_sb_fast(p, lds);
    }
    SEAM(2);
    REP(3, { pg8::TokRowOrder S; S.init(NR, 2048, gridDim.x, blockIdx.x); S.Abase = (const char*)(ws + WS_U); S.Bbase = (const char*)(ws + WS_WG); S.K = D;
             pg8::EpiGate E{(bf16_t*)(ws + WS_G)}; pg8::gemm_phase_x<pg8::EpiGate, pg8::TokRowOrder, true, true>(ldsl, D, S, E); });
    SEAM(3);
    REP(4, { { pg8::Gemm g{(const bf16_t*)(ws + WS_YA), (const bf16_t*)(ws + WS_WUA), NR, D, 512}; pg8::StaticOrder S; S.init(NR, D, gridDim.x, blockIdx.x);
               pg8::EpiZ<false> E{(bf16_t*)(ws + WS_Z), (const bf16_t*)(ws + WS_G), 0}; pg8::gemm_phase<pg8::EpiZ<false>, pg8::StaticOrder, true, true>(ldsl, g, S, E); }
             asm volatile("s_waitcnt vmcnt(0)" ::: "memory"); __syncthreads();
             { pg8::Gemm g{(const bf16_t*)(ws + WS_OLAT), (const bf16_t*)(ws + WS_WBP), NR, D, D}; pg8::StaticOrder S; S.init(NR, D, gridDim.x, blockIdx.x);
               pg8::EpiZ<true> E{(bf16_t*)(ws + WS_Z), (const bf16_t*)(ws + WS_G), 1024}; pg8::gemm_phase<pg8::EpiZ<true>, pg8::StaticOrder, true, true>(ldsl, g, S, E); } });
    SEAM(4);
    REP(5, { pg8::Gemm g{(const bf16_t*)(ws + WS_Z), (const bf16_t*)(ws + WS_WO), NR, D, D}; pg8::StaticOrder S; S.init(NR, D, gridDim.x, blockIdx.x);
             pg8::EpiH1 E{(float*)(ws + WS_H1), p.in[I_META], p.in[I_X]}; pg8::gemm_phase<pg8::EpiH1, pg8::StaticOrder, true, true>(ldsl, g, S, E); });
    SEAM(5);
    if (IN(6)) phase_c3(p, lds);
    SEAM(6);
    REP(7, phase_moe<0>(p, lds));
    SEAM(7);
    REP(8, phase_moe<1>(p, lds));
    SEAM(8);
    REP(9, phase_final(p));
}

extern "C" void kernel_launch(void* const* d_in, const int* in_sizes, int n_in, void* d_out, int out_size, void* d_ws, size_t ws_size, hipStream_t stream) {
    if (n_in != 18 || ws_size < WS_END) { fprintf(stderr, "kernel_launch: unexpected n_in %d / ws_size %zu\n", n_in, ws_size); return; }
    static int grid = 0;
    if (grid == 0) {
        int dev = 0, cus = 0, per_cu = 0;
        (void)hipGetDevice(&dev);
        (void)hipDeviceGetAttribute(&cus, hipDeviceAttributeMultiprocessorCount, dev);
        (void)hipFuncSetAttribute((const void*)mega, hipFuncAttributeMaxDynamicSharedMemorySize, LDS_BYTES);
        (void)hipOccupancyMaxActiveBlocksPerMultiprocessor(&per_cu, (const void*)mega, NTHREADS, LDS_BYTES);
        if (per_cu < 1) fprintf(stderr, "kernel_launch: occupancy query reports %d workgroups per CU\n", per_cu);
        grid = cus;
    }
    (void)hipMemsetAsync((char*)d_ws + WS_CTL, 0, CTL_BYTES, stream);
    Params p{};
    for (int i = 0; i < 18; ++i) p.in[i] = (const float*)d_in[i];
    p.out = (float*)d_out; p.ws = (unsigned char*)d_ws;
    p.ph_lo = 0; p.ph_hi = 10;
    void* args[] = {&p};
    hipError_t e = hipLaunchCooperativeKernel((const void*)mega, dim3(grid), dim3(NTHREADS), args, LDS_BYTES, stream);
    if (e != hipSuccess) fprintf(stderr, "cooperative launch failed: %s (grid %d)\n", hipGetErrorString(e), grid);
}
```

```cpp
#include <hip/hip_runtime.h>
#include <cstdio>
#include <cstdint>

constexpr int BATCH = 8, SEQ = 4096, NMETA = 16, T = SEQ + NMETA, D = 1024, NTOK = BATCH * T;
constexpr int MROWS = 33024;
constexpr int NR = BATCH * SEQ;
__device__ __forceinline__ int tokrow(int cr) { return cr + NMETA * (cr / SEQ + 1); }
constexpr int INW = 4824;
constexpr int NEXP = 32, DEXP = 512;
constexpr int NWAVES = 8, NTHREADS = 512;
constexpr float NORM_EPS = 1e-6f;
constexpr float LOG2E = 1.4426950408889634f;
constexpr float QSCALE = 0.125f * LOG2E;
constexpr int PW = 3456, PWN = 3584;
constexpr int C_QA = 0, C_KA = 512, C_VA = 1024, C_QF = 1536, C_KV = 2688, C_QI = 2832, C_KI = 3344, C_WI = 3408, C_END = 3416;
constexpr int QFW = 144;

constexpr size_t MiB = 1u << 20;
constexpr size_t WS_CTL = 0, CTL_BYTES = 1 * MiB;
constexpr size_t WS_CS = 1 * MiB;
constexpr size_t WS_WP = 2 * MiB;
constexpr size_t WS_WG = 9 * MiB;
constexpr size_t WS_WUA = 13 * MiB, WS_WBP = 14 * MiB, WS_WO = 16 * MiB;
constexpr size_t WS_W2 = 18 * MiB;
constexpr size_t WS_W13 = 50 * MiB;
constexpr size_t WS_U = 114 * MiB;
constexpr size_t WS_P = 179 * MiB;
constexpr size_t WS_Z = 179 * MiB;
constexpr size_t WS_G = 244 * MiB;
constexpr size_t WS_H1 = 244 * MiB;
constexpr size_t WS_LIST = 374 * MiB;
constexpr size_t WS_GATE = 379 * MiB;
constexpr size_t WS_YA = 397 * MiB;
constexpr size_t WS_OLAT = 430 * MiB;
constexpr size_t WS_HID = 397 * MiB;
constexpr size_t WS_MO = 50 * MiB;
constexpr size_t WS_KIP = 495 * MiB;
constexpr size_t KIP_BATCH = 129 * 4096;
constexpr size_t WS_END = 500 * MiB;
static_assert(WS_P + (size_t)MROWS * PW * 2 <= WS_YA && WS_G + (size_t)MROWS * 2048 * 2 <= WS_LIST && WS_Z + (size_t)MROWS * 1024 * 2 <= WS_G, "ws map");
static_assert(WS_OLAT + (size_t)MROWS * 1024 * 2 <= WS_END && WS_U + (size_t)MROWS * 1024 * 2 <= WS_P && WS_MO + (size_t)NTOK * 2048 * 2 <= WS_P, "ws map");
constexpr int CW_CNT = 1024;
constexpr int CW_BAR = 4096;

typedef unsigned short bf16_t;
typedef short bf16x8 __attribute__((ext_vector_type(8)));
typedef float f32x4 __attribute__((ext_vector_type(4)));
typedef float f32x16 __attribute__((ext_vector_type(16)));
typedef unsigned u32x2 __attribute__((ext_vector_type(2)));
typedef unsigned u32x4 __attribute__((ext_vector_type(4)));
typedef unsigned short u16x4 __attribute__((ext_vector_type(4)));
#define LAS __attribute__((address_space(3)))

__device__ __forceinline__ unsigned f2bf(float f) { unsigned u = __float_as_uint(f); return (u + 0x7fffu + ((u >> 16) & 1u)) >> 16; }
typedef __bf16 bf16v2_t __attribute__((ext_vector_type(2)));
typedef float f32v2_t __attribute__((ext_vector_type(2)));
__device__ __forceinline__ unsigned pk2(float lo, float hi) { const f32v2_t v = {lo, hi}; const bf16v2_t r = __builtin_convertvector(v, bf16v2_t); return __builtin_bit_cast(unsigned, r); }
__device__ __forceinline__ float bflo(unsigned w) { return __uint_as_float(w << 16); }
__device__ __forceinline__ float bfhi(unsigned w) { return __uint_as_float(w & 0xffff0000u); }
__device__ __forceinline__ float bf2f(bf16_t b) { return __uint_as_float((unsigned)b << 16); }
__device__ __forceinline__ float wave_sum(float v) {
#pragma unroll
    for (int o = 1; o < 64; o <<= 1) v += __shfl_xor(v, o);
    return v;
}
__device__ __forceinline__ float fmax2(float a, float b) { return __builtin_amdgcn_fmed3f(a, b, 3.0e38f); }
__device__ __forceinline__ float xsum32(float x) { const auto r = __builtin_amdgcn_permlane32_swap(__float_as_uint(x), __float_as_uint(x), false, false); return __uint_as_float(r[0]) + __uint_as_float(r[1]); }
__device__ __forceinline__ float xsum16(float x) { const auto r = __builtin_amdgcn_permlane16_swap(__float_as_uint(x), __float_as_uint(x), false, false); return __uint_as_float(r[0]) + __uint_as_float(r[1]); }
__device__ __forceinline__ float xmax32(float x) { const auto r = __builtin_amdgcn_permlane32_swap(__float_as_uint(x), __float_as_uint(x), false, false); return fmax2(__uint_as_float(r[0]), __uint_as_float(r[1])); }
__device__ __forceinline__ float xmax16(float x) { const auto r = __builtin_amdgcn_permlane16_swap(__float_as_uint(x), __float_as_uint(x), false, false); return fmax2(__uint_as_float(r[0]), __uint_as_float(r[1])); }
__device__ __forceinline__ float xpartner32(float x, int hh) { const auto r = __builtin_amdgcn_permlane32_swap(__float_as_uint(x), __float_as_uint(x), false, false); return __uint_as_float(hh ? r[0] : r[1]); }
__device__ __forceinline__ float fexp2(float x) { return __builtin_amdgcn_exp2f(x); }
__device__ __forceinline__ float sigmoidf(float x) { return __builtin_amdgcn_rcpf(1.0f + fexp2(-LOG2E * x)); }

struct Params {
    const float* in[18];
    float* out;
    unsigned char* ws;
    int ph_lo, ph_hi;
};
enum { I_X = 0, I_META, I_GMIX, I_WIN, I_WUK, I_WUV, I_WUPA, I_WUPB, I_WO, I_GFFN, I_WGRP, I_BGRP, I_WRT, I_BRT, I_W1, I_W3, I_W2, I_GFIN };

__device__ __forceinline__ const float* h0_row(const Params& p, int row) {
    const int b = row / T, t = row - b * T;
    return t < NMETA ? p.in[I_META] + (size_t)t * D : p.in[I_X] + ((size_t)b * SEQ + (t - NMETA)) * D;
}
template <class F>
__device__ __forceinline__ void tr_item(F val, bf16_t* dst, int ldd, int row0, int k0, float* scr, int lane, int rstep = 1) {
    float tv[32];
#pragma unroll
    for (int i = 0; i < 32; ++i) tv[i] = val(k0 + 2 * i + (lane >> 5), lane & 31);
#pragma unroll
    for (int i = 0; i < 32; ++i) scr[(2 * i + (lane >> 5)) * 33 + (lane & 31)] = tv[i];
    __builtin_amdgcn_s_waitcnt(0xC07F);
    asm volatile("" ::: "memory");
    const int c = lane & 7;
#pragma unroll
    for (int j = 0; j < 4; ++j) {
        const int n = (lane >> 3) + 8 * j; const float* s = scr + (8 * c) * 33 + n;
        u32x4 o; o.x = pk2(s[0], s[33]); o.y = pk2(s[66], s[99]); o.z = pk2(s[132], s[165]); o.w = pk2(s[198], s[231]);
        *(u32x4*)(dst + (size_t)(row0 + n * rstep) * ldd + k0 + 8 * c) = o;
    }
    __builtin_amdgcn_s_waitcnt(0xC07F);
    asm volatile("" ::: "memory");
}

__device__ __forceinline__ void wp_src(int c, int& kind, int& col, int& aux, float& scale) {
    kind = 1; aux = 0; scale = 1.f; col = 0;
    if (c < 512) { col = c; scale = QSCALE; }
    else if (c < C_QF) { col = c; }
    else if (c < C_KV) { const int r = c - C_QF, h = r / QFW, j = r % QFW; scale = QSCALE;
        if (j < 128) { kind = 2; col = h; aux = j; } else { const int i = j - 128; col = 1536 + 64 * h + (i >> 1) + 8 * (i & 1); } }
    else if (c < C_QI) { const int j = c - C_KV; if (j < 128) col = 2048 + j; else { const int i = j - 128; col = 2176 + (i >> 1) + 8 * (i & 1); } }
    else if (c < C_KI) { const int r = c - C_QI, h = r >> 6, j = r & 63; col = 2192 + 64 * h + (j < 16 ? (j >> 1) + 8 * (j & 1) : j); }
    else if (c < C_WI) { const int j = c - C_KI; col = 2704 + (j < 16 ? (j >> 1) + 8 * (j & 1) : j); }
    else if (c < C_END) { col = 2768 + (c - C_WI); }
    else kind = 0;
}

constexpr int IT_WP = (PWN / 32) * 16;
constexpr int IT_WG = 32 * 16;
constexpr int IT_WUA = 32 * 8;
constexpr int IT_WBP = 32 * 16, IT_WO = 32 * 16;
constexpr int IT_W13 = NEXP * 32 * 16;
constexpr int IT_W2 = NEXP * 32 * 8;
constexpr int IT_TOTAL = IT_WP + 2 * IT_WG + IT_WUA + IT_WBP + IT_WO + IT_W13 + IT_W2;

__device__ __forceinline__ void phase_prologue(const Params& p, char* lds) {
    const int tid = threadIdx.x, lane = tid & 63, wave = tid >> 6;
    const int gw = blockIdx.x * NWAVES + wave, NGW = gridDim.x * NWAVES;
    float* scr = (float*)lds + wave * (64 * 33);
    unsigned char* ws = p.ws;
    const float* w_in = p.in[I_WIN];
    {
        float2* cs = (float2*)(ws + WS_CS);
        for (int i = blockIdx.x * NTHREADS + tid; i < T * 8; i += gridDim.x * NTHREADS) {
            const int pos = i >> 3, f = i & 7;
            const float inv = powf(500000.0f, -(float)f / 8.0f);
            const float ang = (float)pos * inv;
            cs[i] = make_float2(cosf(ang), sinf(ang));
        }
    }
    for (int it = gw; it < IT_TOTAL; it += NGW) {
        int r = it;
        if (r < IT_WP) {
            const int rg = r / 16, kb = r % 16, c = rg * 32 + (lane & 31);
            int kind, col, aux; float scale; wp_src(c, kind, col, aux, scale);
            const float* w_uk = p.in[I_WUK];
            float wu[48];
#pragma unroll
            for (int n4 = 0; n4 < 12; ++n4) { f32x4 t = (f32x4){0.f, 0.f, 0.f, 0.f}; if (kind == 2) t = *(const f32x4*)(w_uk + ((size_t)col * 128 + aux) * 48 + 4 * n4); wu[4 * n4] = t.x; wu[4 * n4 + 1] = t.y; wu[4 * n4 + 2] = t.z; wu[4 * n4 + 3] = t.w; }
            tr_item([&](int k, int) -> float {
                if (kind == 0) return 0.f;
                if (kind == 1) return scale * w_in[(size_t)k * INW + col];
                const f32x4* wi = (const f32x4*)(w_in + (size_t)k * INW + 1536 + 64 * col + 16);
                float s = 0.f;
#pragma unroll
                for (int n4 = 0; n4 < 12; ++n4) { const f32x4 t = wi[n4]; s += t.x * wu[4 * n4] + t.y * wu[4 * n4 + 1] + t.z * wu[4 * n4 + 2] + t.w * wu[4 * n4 + 3]; }
                return scale * s; }, (bf16_t*)(ws + WS_WP), 1024, rg * 32, kb * 64, scr, lane);
            continue; }
        r -= IT_WP;
        if (r < 2 * IT_WG) {
            const int which = r / IT_WG; r %= IT_WG; const int rg = r / 16, kb = r % 16; const int col0 = (which ? 3800 : 2776) + rg * 32;
            tr_item([&](int k, int n) -> float { return w_in[(size_t)k * INW + col0 + n]; }, (bf16_t*)(ws + WS_WG) + (size_t)which * 1024 * 1024, 1024, rg * 32, kb * 64, scr, lane);
            continue; }
        r -= 2 * IT_WG;
        if (r < IT_WUA) {
            const int rg = r / 8, kb = r % 8; const float* w = p.in[I_WUPA];
            tr_item([&](int k, int n) -> float { return w[(size_t)k * 1024 + rg * 32 + n]; }, (bf16_t*)(ws + WS_WUA), 512, rg * 32, kb * 64, scr, lane);
            continue; }
        r -= IT_WUA;
        if (r < IT_WBP) {
            const int rg = r / 16, kb = r % 16; const float* wuv = p.in[I_WUV]; const float* wub = p.in[I_WUPB];
            const int hB = kb >> 1;
            float bc[64];
#pragma unroll
            for (int d = 0; d < 64; ++d) bc[d] = wub[(size_t)(64 * hB + d) * 1024 + rg * 32 + (lane & 31)];
            tr_item([&](int kk, int) -> float {
                const f32x4* a = (const f32x4*)(wuv + (size_t)kk * 64);
                float s = 0.f;
#pragma unroll
                for (int d4 = 0; d4 < 16; ++d4) { const f32x4 t = a[d4]; s += t.x * bc[4 * d4] + t.y * bc[4 * d4 + 1] + t.z * bc[4 * d4 + 2] + t.w * bc[4 * d4 + 3]; }
                return s; }, (bf16_t*)(ws + WS_WBP), 1024, rg * 32, kb * 64, scr, lane);
            continue; }
        r -= IT_WBP;
        if (r < IT_WO) {
            const int rg = r / 16, kb = r % 16; const float* w = p.in[I_WO];
            tr_item([&](int k, int n) -> float { return w[(size_t)k * 1024 + rg * 32 + n]; }, (bf16_t*)(ws + WS_WO), 1024, rg * 32, kb * 64, scr, lane);
            continue; }
        r -= IT_WO;
        if (r < IT_W13) {
            const int e = r / 512; r %= 512; const int which = r & 1, cg = (r >> 1) & 15, kb = r >> 5;
            const float* w = (which ? p.in[I_W3] : p.in[I_W1]) + (size_t)e * 1024 * 512 + cg * 32;
            tr_item([&](int k, int n) -> float { return w[(size_t)k * 512 + n]; },
                    (bf16_t*)(ws + WS_W13) + (size_t)e * 1024 * 1024, 1024, 2 * cg * 32 + which, kb * 64, scr, lane, 2);
            continue; }
        r -= IT_W13;
        {
            const int e = r / 256; r %= 256; const int rg = r / 8, kb = r % 8;
            const float* w2 = p.in[I_W2] + (size_t)e * 512 * 1024;
            tr_item([&](int k, int n) -> float { return w2[(size_t)k * 1024 + rg * 32 + n]; }, (bf16_t*)(ws + WS_W2) + (size_t)e * 1024 * 512, 512, rg * 32, kb * 64, scr, lane);
        }
    }
    {
        const float* g = p.in[I_GMIX]; bf16_t* U = (bf16_t*)(ws + WS_U);
        for (int row = gw; row < NTOK; row += NGW) {
            const f32x4* xr = (const f32x4*)h0_row(p, row) + lane;
            f32x4 v[4]; float s = 0.f;
#pragma unroll
            for (int j = 0; j < 4; ++j) { v[j] = xr[64 * j]; s += (v[j].x * v[j].x + v[j].y * v[j].y) + (v[j].z * v[j].z + v[j].w * v[j].w); }
            const float rstd = rsqrtf(wave_sum(s) * (1.f / D) + NORM_EPS);
            u32x2* o = (u32x2*)(U + (size_t)row * D) + lane;
#pragma unroll
            for (int j = 0; j < 4; ++j) { const f32x4 gg = ((const f32x4*)g)[lane + 64 * j];
                u32x2 w; w.x = pk2(v[j].x * rstd * gg.x, v[j].y * rstd * gg.y); w.y = pk2(v[j].z * rstd * gg.z, v[j].w * rstd * gg.w); o[64 * j] = w; }
        }
    }
}

namespace pg8 {
#define PG8_LAS __attribute__((address_space(3)))
typedef unsigned short bf16_t;
typedef short bf16x8 __attribute__((ext_vector_type(8)));
typedef float f32x4 __attribute__((ext_vector_type(4)));
typedef unsigned u32x4 __attribute__((ext_vector_type(4)));
constexpr int BM = 256, BK = 64, HALF = 128, HTB = HALF * BK * 2  , STAGE_BYTES = 8 * HTB, NXCD = 8, WGM = 8;

__host__ __device__ __forceinline__ int lds_byte(int r, int c) { const int st = (r >> 4) * 2 + (c >> 5), rr = r & 15, cc = c & 31, ob = rr * 64 + cc * 2; return st * 1024 + (ob ^ (((ob >> 9) & 1) << 5)); }
__host__ __device__ __forceinline__ void stage_rc(int b, int& R, int& C) { const int st = b / 1024, sb = b % 1024, swz = sb ^ (((sb >> 9) & 1) << 5); R = (st >> 1) * 16 + swz / 64; C = (st & 1) * 32 + (swz % 64) / 2; }
__host__ __device__ __forceinline__ int perm32(int rho) { const int n = rho >> 4, i = rho & 15; return 8 * (i >> 2) + 4 * n + (i & 3); }

struct Unit { int pm, pn; };
struct Gemm { const bf16_t* A; const bf16_t* Bt; int M, N, K; };

struct StaticOrder {
    int nM, nN, nwg, G, c;
    __host__ __device__ void init(int M, int N, int G_, int c_) { nM = M / BM; nN = N / BM; nwg = nM * nN; G = G_; c = c_; }
    __host__ __device__ bool next(int i, Unit& u) const {
        const long L = (long)i * G + c; if (L >= nwg) return false;
        int wgid = (int)L; { const int q = nwg / NXCD, r = nwg % NXCD, xcd = wgid % NXCD, off = wgid / NXCD; wgid = (xcd < r ? xcd * (q + 1) : r * (q + 1) + (xcd - r) * q) + off; }
        const int nig = WGM * nN, gid = wgid / nig, fm = gid * WGM, gsz = (nM - fm) < WGM ? (nM - fm) : WGM;
        u.pm = fm + ((wgid % nig) % gsz); u.pn = (wgid % nig) / gsz; return true;
    }
    __device__ __forceinline__ void a_ready(const Unit&) const {}
    __device__ __forceinline__ void done(const Unit&) const {}
};


#define PG8_FOR_FRAGS(...) _Pragma("unroll") for (int ai = 0; ai < 2; ++ai) _Pragma("unroll") for (int m = 0; m < 4; ++m) { const int row = u.pm * BM + ai * HALF + wr * 64 + m * 16 + fr; \
    _Pragma("unroll") for (int bj = 0; bj < 2; ++bj) _Pragma("unroll") for (int n = 0; n < 2; ++n) { const int col = u.pn * BM + bj * HALF + wc * 32 + n * 16 + 4 * fq; ::f32x4 v = acc[ai][bj][m][n]; __VA_ARGS__ } }
__device__ __forceinline__ bool rope_off(int c, int& o) {
    if (c < C_QF) return false;
    if (c < C_KV) { const int j = (c - C_QF) % QFW; o = j - 128; return j >= 128; }
    if (c < C_QI) { const int j = c - C_KV; o = j - 128; return j >= 128; }
    if (c < C_KI) { const int j = (c - C_QI) & 63; o = j; return j < 16; }
    if (c < C_WI) { const int j = c - C_KI; o = j; return j < 16; }
    return false;
}
#define PG8_FOR_FRAGS8(...) _Pragma("unroll") for (int ai = 0; ai < 2; ++ai) _Pragma("unroll") for (int m = 0; m < 4; ++m) { const int row = u.pm * BM + ai * HALF + wr * 64 + m * 16 + fr; \
    _Pragma("unroll") for (int bj = 0; bj < 2; ++bj) { const int col = u.pn * BM + bj * HALF + wc * 32 + 8 * fq; ::f32x4 v0 = acc[ai][bj][m][0], v1 = acc[ai][bj][m][1]; __VA_ARGS__ } }
struct EpiInproj {
    static constexpr bool PERM = true, AFTER_DRAIN = false;
    bf16_t* P; const float2* cs; unsigned char* KIP;
    __device__ __forceinline__ void operator()(const f32x4 (&acc)[2][2][4][2], const Unit& u, int wr, int wc, int fr, int fq) const {
        PG8_FOR_FRAGS8(
            if (col < PW) {
                int o; const int trow = tokrow(row);
                if (rope_off(col, o)) {
                    const int pos = (row % SEQ) + NMETA; const float2* cp = cs + pos * 8 + (o >> 1); const float2 c0 = cp[0], c1 = cp[1], c2 = cp[2], c3 = cp[3];
                    v0 = (::f32x4){v0.x * c0.x - v0.y * c0.y, v0.y * c0.x + v0.x * c0.y, v0.z * c1.x - v0.w * c1.y, v0.w * c1.x + v0.z * c1.y};
                    v1 = (::f32x4){v1.x * c2.x - v1.y * c2.y, v1.y * c2.x + v1.x * c2.y, v1.z * c3.x - v1.w * c3.y, v1.w * c3.x + v1.z * c3.y};
                }
                ::u32x4 w; w.x = pk2(v0.x, v0.y); w.y = pk2(v0.z, v0.w); w.z = pk2(v1.x, v1.y); w.w = pk2(v1.z, v1.w);
                if (col >= C_KI && col < C_WI) {
                    const int b = row / SEQ, t = row - b * SEQ + NMETA, d0 = col - C_KI;
                    *(::u32x4*)(KIP + (size_t)b * KIP_BATCH + (size_t)((((t >> 5) * 4 + (d0 >> 4)) * 2 + ((d0 >> 3) & 1)) * 512 + (t & 31) * 16)) = w;
                } else *(::u32x4*)(P + (size_t)trow * PW + col) = w;
            })
    }
};
struct EpiGate {
    static constexpr bool PERM = true, AFTER_DRAIN = false;
    bf16_t* G;
    __device__ __forceinline__ void operator()(const f32x4 (&acc)[2][2][4][2], const Unit& u, int wr, int wc, int fr, int fq) const {
        PG8_FOR_FRAGS8( ::u32x4 w; w.x = pk2(sigmoidf(v0.x), sigmoidf(v0.y)); w.y = pk2(sigmoidf(v0.z), sigmoidf(v0.w)); w.z = pk2(sigmoidf(v1.x), sigmoidf(v1.y)); w.w = pk2(sigmoidf(v1.z), sigmoidf(v1.w));
            *(::u32x4*)(G + (size_t)row * 2048 + col) = w; )
    }
};
template <bool ACCUM> struct EpiZ {
    static constexpr bool PERM = true, AFTER_DRAIN = false;
    bf16_t* Z; const bf16_t* G; int goff;
    __device__ __forceinline__ void operator()(const f32x4 (&acc)[2][2][4][2], const Unit& u, int wr, int wc, int fr, int fq) const {
        PG8_FOR_FRAGS8(
            const ::u32x4 g = *(const ::u32x4*)(G + (size_t)row * 2048 + goff + col);
            ::f32x4 z0 = (::f32x4){bflo(g.x) * v0.x, bfhi(g.x) * v0.y, bflo(g.y) * v0.z, bfhi(g.y) * v0.w}, z1 = (::f32x4){bflo(g.z) * v1.x, bfhi(g.z) * v1.y, bflo(g.w) * v1.z, bfhi(g.w) * v1.w};
            ::u32x4* zp = (::u32x4*)(Z + (size_t)row * D + col);
            if (ACCUM) { const ::u32x4 o = *zp; z0.x += bflo(o.x); z0.y += bfhi(o.x); z0.z += bflo(o.y); z0.w += bfhi(o.y); z1.x += bflo(o.z); z1.y += bfhi(o.z); z1.z += bflo(o.w); z1.w += bfhi(o.w); }
            ::u32x4 w; w.x = pk2(z0.x, z0.y); w.y = pk2(z0.z, z0.w); w.z = pk2(z1.x, z1.y); w.w = pk2(z1.z, z1.w); *zp = w; )
    }
};
struct EpiH1 {
    static constexpr bool PERM = true, AFTER_DRAIN = false;
    float* H1; const float* meta; const float* x;
    __device__ __forceinline__ void operator()(const f32x4 (&acc)[2][2][4][2], const Unit& u, int wr, int wc, int fr, int fq) const {
        PG8_FOR_FRAGS8( const float* xp = x + (size_t)row * D + col; float* hp = H1 + (size_t)row * D + col; const ::f32x4 h0 = *(const ::f32x4*)xp, h1 = *(const ::f32x4*)(xp + 4);
            *(::f32x4*)hp = h0 + v0; *(::f32x4*)(hp + 4) = h1 + v1; )
    }
};
#undef PG8_FOR_FRAGS
#undef PG8_FOR_FRAGS8

template <class Epi, class Sched, bool ALIGN_EPI = false, bool SP2 = false>
__device__ __forceinline__ void gemm_phase(PG8_LAS unsigned char* lds, const Gemm g, const Sched& S, const Epi& E) {
    const int tid = threadIdx.x, wid = __builtin_amdgcn_readfirstlane(tid >> 6), lane = tid & 63, wr = wid >> 2, wc = wid & 3, fr = lane & 15, fq = lane >> 4;
    const int K = g.K, nt = K / BK;
    unsigned voffA[2], voffB[2];
#pragma unroll
    for (int i = 0; i < 2; ++i) { int R, C; stage_rc(tid * 16 + i * 8192, R, C); const int Rb = Epi::PERM ? ((R & ~31) + perm32(R & 31)) : R;
        voffA[i] = (unsigned)(R * K + C) * 2u; voffB[i] = (unsigned)(Rb * K + C) * 2u; }
    const size_t kstep = (size_t)(BK * 2);
    const size_t hstep = (size_t)HALF * K * 2;
    const size_t tstep = 2 * hstep;
    const unsigned ldsw = (unsigned)wid * 1024u;
    const int aoff = lds_byte(wr * 64 + fr, fq * 8), boff = lds_byte(wc * 32 + fr, fq * 8);
#define PG8_SA(b, h) (((b) * 2 + (h)) * HTB)
#define PG8_SB(b, h) ((4 + (b) * 2 + (h)) * HTB)
#define PG8_STAGE(bufoff, gbase, voff) do { _Pragma("unroll") for (int _i = 0; _i < 2; ++_i) \
        __builtin_amdgcn_global_load_lds((const unsigned*)((const char*)(gbase) + (voff)[_i]), (PG8_LAS unsigned*)(lds + (bufoff) + ldsw + _i * 8192), 16, 0, 0); } while (0)
#define PG8_LDA(dst, b, h) do { _Pragma("unroll") for (int m = 0; m < 4; ++m) _Pragma("unroll") for (int k = 0; k < 2; ++k) dst[m][k] = *(const PG8_LAS bf16x8*)(lds + PG8_SA(b, h) + aoff + m * 2048 + k * 1024); } while (0)
#define PG8_LDB(dst, b, h) do { _Pragma("unroll") for (int n = 0; n < 2; ++n) _Pragma("unroll") for (int k = 0; k < 2; ++k) dst[n][k] = *(const PG8_LAS bf16x8*)(lds + PG8_SB(b, h) + boff + n * 2048 + k * 1024); } while (0)
#define PG8_MMA(ai, bj, At, Bt) do { __builtin_amdgcn_s_setprio(1); _Pragma("unroll") for (int m = 0; m < 4; ++m) _Pragma("unroll") for (int n = 0; n < 2; ++n) _Pragma("unroll") for (int k = 0; k < 2; ++k) \
        acc[ai][bj][m][n] = __builtin_amdgcn_mfma_f32_16x16x32_bf16(Bt[n][k], At[m][k], acc[ai][bj][m][n], 0, 0, 0); __builtin_amdgcn_s_setprio(0); } while (0)
#define PG8_WAIT_V(n) asm volatile("s_waitcnt vmcnt(" #n ")" ::: "memory")
#define PG8_WAIT_L(n) asm volatile("s_waitcnt lgkmcnt(" #n ")" ::: "memory")
#define PG8_BAR __builtin_amdgcn_s_barrier()
#define PG8_SCHED __builtin_amdgcn_sched_barrier(0)
    Unit cur, nxt; int ui = 0;
    if (!S.next(0, cur)) return;
    f32x4 acc[2][2][4][2];
#pragma unroll
    for (int a = 0; a < 2; ++a)
#pragma unroll
        for (int b = 0; b < 2; ++b)
#pragma unroll
            for (int m = 0; m < 4; ++m)
#pragma unroll
                for (int n = 0; n < 2; ++n) acc[a][b][m][n] = (f32x4){0.f, 0.f, 0.f, 0.f};
    bf16x8 At[4][2], B0[2][2], B1[2][2];
    const char* cA = (const char*)g.A + (size_t)cur.pm * tstep; const char* cB = (const char*)g.Bt + (size_t)cur.pn * tstep;
    S.a_ready(cur);
    if constexpr (SP2) {
        PG8_STAGE(PG8_SB(0, 0), cB, voffB); PG8_STAGE(PG8_SB(0, 1), cB + hstep, voffB); PG8_STAGE(PG8_SA(0, 0), cA, voffA); PG8_STAGE(PG8_SA(0, 1), cA + hstep, voffA);
        if (wr == 1) PG8_BAR;
        PG8_WAIT_V(2); PG8_BAR;
        PG8_STAGE(PG8_SB(1, 0), cB + kstep, voffB); PG8_STAGE(PG8_SA(1, 0), cA + kstep, voffA); PG8_STAGE(PG8_SB(1, 1), cB + hstep + kstep, voffB);
        PG8_WAIT_V(6); PG8_BAR;
    } else {
        PG8_STAGE(PG8_SB(0, 0), cB, voffB); PG8_STAGE(PG8_SA(0, 0), cA, voffA); PG8_STAGE(PG8_SB(0, 1), cB + hstep, voffB); PG8_STAGE(PG8_SA(0, 1), cA + hstep, voffA);
        if (wr == 1) PG8_BAR;
        PG8_WAIT_V(4); PG8_BAR;
        PG8_STAGE(PG8_SB(1, 0), cB + kstep, voffB); PG8_STAGE(PG8_SA(1, 0), cA + kstep, voffA); PG8_STAGE(PG8_SB(1, 1), cB + hstep + kstep, voffB);
        PG8_WAIT_V(6); PG8_BAR;
    }
    for (;;) {
        const bool has_next = S.next(ui + 1, nxt);
        const char* nA = has_next ? (const char*)g.A + (size_t)nxt.pm * tstep : cA; const char* nB = has_next ? (const char*)g.Bt + (size_t)nxt.pn * tstep : cB;
        for (int t = 0; t < nt; t += 2) {
            const bool last = (t == nt - 2);
            const char* a1 = cA + (size_t)(t + 1) * kstep;
            const char* a2 = last ? nA : cA + (size_t)(t + 2) * kstep; const char* b2 = last ? nB : cB + (size_t)(t + 2) * kstep;
            const char* a3 = a2 + kstep; const char* b3 = b2 + kstep;
            if (last && has_next) S.a_ready(nxt);
            if constexpr (SP2) {
            PG8_LDB(B0, 0, 0); PG8_LDB(B1, 0, 1); PG8_SCHED; PG8_LDA(At, 0, 0); PG8_STAGE(PG8_SA(1, 1), a1 + hstep, voffA);
            PG8_WAIT_V(8); PG8_WAIT_L(0); PG8_BAR; PG8_MMA(0, 0, At, B0); PG8_MMA(0, 1, At, B1); PG8_BAR; PG8_SCHED;
            PG8_LDA(At, 0, 1); PG8_STAGE(PG8_SB(0, 0), b2, voffB); PG8_STAGE(PG8_SB(0, 1), b2 + hstep, voffB); PG8_STAGE(PG8_SA(0, 0), a2, voffA);
            PG8_WAIT_V(8); PG8_WAIT_L(0); PG8_BAR; PG8_MMA(1, 0, At, B0); PG8_MMA(1, 1, At, B1); PG8_BAR; PG8_SCHED;
            PG8_LDB(B0, 1, 0); PG8_LDB(B1, 1, 1); PG8_SCHED; PG8_LDA(At, 1, 0); PG8_STAGE(PG8_SA(0, 1), a2 + hstep, voffA);
            PG8_WAIT_V(8); PG8_WAIT_L(0); PG8_BAR; PG8_MMA(0, 0, At, B0); PG8_MMA(0, 1, At, B1); PG8_BAR; PG8_SCHED;
            PG8_LDA(At, 1, 1); PG8_STAGE(PG8_SB(1, 0), b3, voffB); PG8_STAGE(PG8_SB(1, 1), b3 + hstep, voffB); PG8_STAGE(PG8_SA(1, 0), a3, voffA);
            PG8_WAIT_V(8); PG8_WAIT_L(0); PG8_BAR; PG8_MMA(1, 0, At, B0); PG8_MMA(1, 1, At, B1); PG8_BAR; PG8_SCHED;
            } else {
            PG8_LDB(B0, 0, 0); PG8_SCHED; PG8_LDA(At, 0, 0); PG8_STAGE(PG8_SA(1, 1), a1 + hstep, voffA);
            PG8_WAIT_L(8); PG8_BAR; PG8_WAIT_L(0); PG8_MMA(0, 0, At, B0); PG8_BAR; PG8_SCHED;
            PG8_LDB(B1, 0, 1); PG8_STAGE(PG8_SB(0, 0), b2, voffB);
            PG8_BAR; PG8_WAIT_L(0); PG8_MMA(0, 1, At, B1); PG8_BAR;
            PG8_LDA(At, 0, 1); PG8_STAGE(PG8_SA(0, 0), a2, voffA);
            PG8_BAR; PG8_WAIT_L(0); PG8_MMA(1, 0, At, B0); PG8_BAR; PG8_SCHED;
            PG8_STAGE(PG8_SB(0, 1), b2 + hstep, voffB);
            PG8_WAIT_V(6); PG8_BAR; PG8_MMA(1, 1, At, B1); PG8_BAR;
            PG8_LDB(B0, 1, 0); PG8_SCHED; PG8_LDA(At, 1, 0); PG8_STAGE(PG8_SA(0, 1), a2 + hstep, voffA);
            PG8_WAIT_L(8); PG8_BAR; PG8_WAIT_L(0); PG8_MMA(0, 0, At, B0); PG8_BAR; PG8_SCHED;
            PG8_LDB(B1, 1, 1); PG8_STAGE(PG8_SB(1, 0), b3, voffB);
            PG8_BAR; PG8_WAIT_L(0); PG8_MMA(0, 1, At, B1); PG8_BAR;
            PG8_LDA(At, 1, 1); PG8_STAGE(PG8_SA(1, 0), a3, voffA);
            PG8_BAR; PG8_WAIT_L(0); PG8_MMA(1, 0, At, B0); PG8_BAR; PG8_SCHED;
            PG8_STAGE(PG8_SB(1, 1), b3 + hstep, voffB);
            PG8_WAIT_V(6); PG8_BAR; PG8_MMA(1, 1, At, B1); PG8_BAR;
            }
        }
        if constexpr (ALIGN_EPI) { if (wr == 0) PG8_BAR; }
        if constexpr (!Epi::AFTER_DRAIN) { E(acc, cur, wr, wc, fr, fq); S.done(cur); }
        if (!has_next) break;
#pragma unroll
        for (int a = 0; a < 2; ++a)
#pragma unroll
            for (int b = 0; b < 2; ++b)
#pragma unroll
                for (int m = 0; m < 4; ++m)
#pragma unroll
                    for (int n = 0; n < 2; ++n) acc[a][b][m][n] = (f32x4){0.f, 0.f, 0.f, 0.f};
        cur = nxt; cA = nA; cB = nB; ++ui;
        if constexpr (ALIGN_EPI) { if (wr == 1) PG8_BAR; }
    }
    PG8_WAIT_V(0);
    if constexpr (!ALIGN_EPI) { if (wr == 0) PG8_BAR; }
    PG8_BAR;
    if constexpr (Epi::AFTER_DRAIN) { E.fused(acc, cur, wr, wc, fr, fq, lds, wid, lane); S.done(cur); }
#undef PG8_SA
#undef PG8_SB
#undef PG8_STAGE
#undef PG8_LDA
#undef PG8_LDB
#undef PG8_MMA
#undef PG8_WAIT_V
#undef PG8_WAIT_L
#undef PG8_BAR
#undef PG8_SCHED
}
template <class Epi, class Sched, bool ALIGN_EPI = false, bool SP2 = false>
__device__ __forceinline__ void gemm_phase_x(PG8_LAS unsigned char* lds, const int K, const Sched& S, const Epi& E) {
    const int tid = threadIdx.x, wid = __builtin_amdgcn_readfirstlane(tid >> 6), lane = tid & 63, wr = wid >> 2, wc = wid & 3, fr = lane & 15, fq = lane >> 4;
    const int nt = K / BK;
    unsigned vcA[2][2], vnA[2][2], voffB[2];
#pragma unroll
    for (int i = 0; i < 2; ++i) { int R, C; stage_rc(tid * 16 + i * 8192, R, C); const int Rb = Epi::PERM ? ((R & ~31) + perm32(R & 31)) : R;
        voffB[i] = (unsigned)(Rb * K + C) * 2u; }
    const size_t kstep = (size_t)(BK * 2);
    const size_t hstep = (size_t)HALF * K * 2;
    const unsigned ldsw = (unsigned)wid * 1024u;
    const int aoff = lds_byte(wr * 64 + fr, fq * 8), boff = lds_byte(wc * 32 + fr, fq * 8);
#define PG8_SA(b, h) (((b) * 2 + (h)) * HTB)
#define PG8_SB(b, h) ((4 + (b) * 2 + (h)) * HTB)
#define PG8_STAGE(bufoff, gbase, voff) do { _Pragma("unroll") for (int _i = 0; _i < 2; ++_i) \
        __builtin_amdgcn_global_load_lds((const unsigned*)((const char*)(gbase) + (voff)[_i]), (PG8_LAS unsigned*)(lds + (bufoff) + ldsw + _i * 8192), 16, 0, 0); } while (0)
#define PG8_STAGEA(bufoff, gbase, V, h) do { _Pragma("unroll") for (int _i = 0; _i < 2; ++_i) \
        __builtin_amdgcn_global_load_lds((const unsigned*)((const char*)(gbase) + (V)[h][_i]), (PG8_LAS unsigned*)(lds + (bufoff) + ldsw + _i * 8192), 16, 0, 0); } while (0)
#define PG8_STAGEA2(bufoff, gbase, h) do { _Pragma("unroll") for (int _i = 0; _i < 2; ++_i) \
        __builtin_amdgcn_global_load_lds((const unsigned*)((const char*)(gbase) + (last ? vnA[h][_i] : vcA[h][_i])), (PG8_LAS unsigned*)(lds + (bufoff) + ldsw + _i * 8192), 16, 0, 0); } while (0)
#define PG8_AOFF(V, u) do { _Pragma("unroll") for (int _h = 0; _h < 2; ++_h) _Pragma("unroll") for (int _i = 0; _i < 2; ++_i) { int R_, C_; stage_rc(tid * 16 + _i * 8192, R_, C_); (V)[_h][_i] = S.a_off(u, _h * HALF + R_, C_); } } while (0)
#define PG8_LDA(dst, b, h) do { _Pragma("unroll") for (int m = 0; m < 4; ++m) _Pragma("unroll") for (int k = 0; k < 2; ++k) dst[m][k] = *(const PG8_LAS bf16x8*)(lds + PG8_SA(b, h) + aoff + m * 2048 + k * 1024); } while (0)
#define PG8_LDB(dst, b, h) do { _Pragma("unroll") for (int n = 0; n < 2; ++n) _Pragma("unroll") for (int k = 0; k < 2; ++k) dst[n][k] = *(const PG8_LAS bf16x8*)(lds + PG8_SB(b, h) + boff + n * 2048 + k * 1024); } while (0)
#define PG8_MMA(ai, bj, At, Bt) do { __builtin_amdgcn_s_setprio(1); _Pragma("unroll") for (int m = 0; m < 4; ++m) _Pragma("unroll") for (int n = 0; n < 2; ++n) _Pragma("unroll") for (int k = 0; k < 2; ++k) \
        acc[ai][bj][m][n] = __builtin_amdgcn_mfma_f32_16x16x32_bf16(Bt[n][k], At[m][k], acc[ai][bj][m][n], 0, 0, 0); __builtin_amdgcn_s_setprio(0); } while (0)
#define PG8_WAIT_V(n) asm volatile("s_waitcnt vmcnt(" #n ")" ::: "memory")
#define PG8_WAIT_L(n) asm volatile("s_waitcnt lgkmcnt(" #n ")" ::: "memory")
#define PG8_BAR __builtin_amdgcn_s_barrier()
#define PG8_SCHED __builtin_amdgcn_sched_barrier(0)
    Unit cur, nxt; int ui = 0;
    if (!S.next(0, cur)) return;
    f32x4 acc[2][2][4][2];
#pragma unroll
    for (int a = 0; a < 2; ++a)
#pragma unroll
        for (int b = 0; b < 2; ++b)
#pragma unroll
            for (int m = 0; m < 4; ++m)
#pragma unroll
                for (int n = 0; n < 2; ++n) acc[a][b][m][n] = (f32x4){0.f, 0.f, 0.f, 0.f};
    bf16x8 At[4][2], B0[2][2], B1[2][2];
    const char* cA = S.a_base(cur); const char* cB = S.b_base(cur);
    PG8_AOFF(vcA, cur);
    S.a_ready(cur);
    if constexpr (SP2) {
        PG8_STAGE(PG8_SB(0, 0), cB, voffB); PG8_STAGE(PG8_SB(0, 1), cB + hstep, voffB); PG8_STAGEA(PG8_SA(0, 0), cA, vcA, 0); PG8_STAGEA(PG8_SA(0, 1), cA, vcA, 1);
        if (wr == 1) PG8_BAR;
        PG8_WAIT_V(2); PG8_BAR;
        PG8_STAGE(PG8_SB(1, 0), cB + kstep, voffB); PG8_STAGEA(PG8_SA(1, 0), cA + kstep, vcA, 0); PG8_STAGE(PG8_SB(1, 1), cB + hstep + kstep, voffB);
        PG8_WAIT_V(6); PG8_BAR;
    } else {
        PG8_STAGE(PG8_SB(0, 0), cB, voffB); PG8_STAGEA(PG8_SA(0, 0), cA, vcA, 0); PG8_STAGE(PG8_SB(0, 1), cB + hstep, voffB); PG8_STAGEA(PG8_SA(0, 1), cA, vcA, 1);
        if (wr == 1) PG8_BAR;
        PG8_WAIT_V(4); PG8_BAR;
        PG8_STAGE(PG8_SB(1, 0), cB + kstep, voffB); PG8_STAGEA(PG8_SA(1, 0), cA + kstep, vcA, 0); PG8_STAGE(PG8_SB(1, 1), cB + hstep + kstep, voffB);
        PG8_WAIT_V(6); PG8_BAR;
    }
    for (;;) {
        const bool has_next = S.next(ui + 1, nxt);
        const char* nA = has_next ? S.a_base(nxt) : cA; const char* nB = has_next ? S.b_base(nxt) : cB;
        if (has_next) { PG8_AOFF(vnA, nxt); } else { _Pragma("unroll") for (int _h = 0; _h < 2; ++_h) _Pragma("unroll") for (int _i = 0; _i < 2; ++_i) vnA[_h][_i] = vcA[_h][_i]; }
        for (int t = 0; t < nt; t += 2) {
            const bool last = (t == nt - 2);
            const char* a1 = cA + (size_t)(t + 1) * kstep;
            const char* a2 = last ? nA : cA + (size_t)(t + 2) * kstep; const char* b2 = last ? nB : cB + (size_t)(t + 2) * kstep;
            const char* a3 = a2 + kstep; const char* b3 = b2 + kstep;
            if (last && has_next) S.a_ready(nxt);
            if constexpr (SP2) {
            PG8_LDB(B0, 0, 0); PG8_LDB(B1, 0, 1); PG8_SCHED; PG8_LDA(At, 0, 0); PG8_STAGEA(PG8_SA(1, 1), a1, vcA, 1);
            PG8_WAIT_V(8); PG8_WAIT_L(0); PG8_BAR; PG8_MMA(0, 0, At, B0); PG8_MMA(0, 1, At, B1); PG8_BAR; PG8_SCHED;
            PG8_LDA(At, 0, 1); PG8_STAGE(PG8_SB(0, 0), b2, voffB); PG8_STAGE(PG8_SB(0, 1), b2 + hstep, voffB); PG8_STAGEA2(PG8_SA(0, 0), a2, 0);
            PG8_WAIT_V(8); PG8_WAIT_L(0); PG8_BAR; PG8_MMA(1, 0, At, B0); PG8_MMA(1, 1, At, B1); PG8_BAR; PG8_SCHED;
            PG8_LDB(B0, 1, 0); PG8_LDB(B1, 1, 1); PG8_SCHED; PG8_LDA(At, 1, 0); PG8_STAGEA2(PG8_SA(0, 1), a2, 1);
            PG8_WAIT_V(8); PG8_WAIT_L(0); PG8_BAR; PG8_MMA(0, 0, At, B0); PG8_MMA(0, 1, At, B1); PG8_BAR; PG8_SCHED;
            PG8_LDA(At, 1, 1); PG8_STAGE(PG8_SB(1, 0), b3, voffB); PG8_STAGE(PG8_SB(1, 1), b3 + hstep, voffB); PG8_STAGEA2(PG8_SA(1, 0), a3, 0);
            PG8_WAIT_V(8); PG8_WAIT_L(0); PG8_BAR; PG8_MMA(1, 0, At, B0); PG8_MMA(1, 1, At, B1); PG8_BAR; PG8_SCHED;
            } else {
            PG8_LDB(B0, 0, 0); PG8_SCHED; PG8_LDA(At, 0, 0); PG8_STAGEA(PG8_SA(1, 1), a1, vcA, 1);
            PG8_WAIT_L(8); PG8_BAR; PG8_WAIT_L(0); PG8_MMA(0, 0, At, B0); PG8_BAR; PG8_SCHED;
            PG8_LDB(B1, 0, 1); PG8_STAGE(PG8_SB(0, 0), b2, voffB);
            PG8_BAR; PG8_WAIT_L(0); PG8_MMA(0, 1, At, B1); PG8_BAR;
            PG8_LDA(At, 0, 1); PG8_STAGEA2(PG8_SA(0, 0), a2, 0);
            PG8_BAR; PG8_WAIT_L(0); PG8_MMA(1, 0, At, B0); PG8_BAR; PG8_SCHED;
            PG8_STAGE(PG8_SB(0, 1), b2 + hstep, voffB);
            PG8_WAIT_V(6); PG8_BAR; PG8_MMA(1, 1, At, B1); PG8_BAR;
            PG8_LDB(B0, 1, 0); PG8_SCHED; PG8_LDA(At, 1, 0); PG8_STAGEA2(PG8_SA(0, 1), a2, 1);
            PG8_WAIT_L(8); PG8_BAR; PG8_WAIT_L(0); PG8_MMA(0, 0, At, B0); PG8_BAR; PG8_SCHED;
            PG8_LDB(B1, 1, 1); PG8_STAGE(PG8_SB(1, 0), b3, voffB);
            PG8_BAR; PG8_WAIT_L(0); PG8_MMA(0, 1, At, B1); PG8_BAR;
            PG8_LDA(At, 1, 1); PG8_STAGEA2(PG8_SA(1, 0), a3, 0);
            PG8_BAR; PG8_WAIT_L(0); PG8_MMA(1, 0, At, B0); PG8_BAR; PG8_SCHED;
            PG8_STAGE(PG8_SB(1, 1), b3 + hstep, voffB);
            PG8_WAIT_V(6); PG8_BAR; PG8_MMA(1, 1, At, B1); PG8_BAR;
            }
        }
        if constexpr (ALIGN_EPI) { if (wr == 0) PG8_BAR; }
        if constexpr (!Epi::AFTER_DRAIN) { E(acc, cur, wr, wc, fr, fq); S.done(cur); }
        if (!has_next) break;
#pragma unroll
        for (int a = 0; a < 2; ++a)
#pragma unroll
            for (int b = 0; b < 2; ++b)
#pragma unroll
                for (int m = 0; m < 4; ++m)
#pragma unroll
                    for (int n = 0; n < 2; ++n) acc[a][b][m][n] = (f32x4){0.f, 0.f, 0.f, 0.f};
        cur = nxt; cA = nA; cB = nB; ++ui;
        _Pragma("unroll") for (int _h = 0; _h < 2; ++_h) _Pragma("unroll") for (int _i = 0; _i < 2; ++_i) vcA[_h][_i] = vnA[_h][_i];
        if constexpr (ALIGN_EPI) { if (wr == 1) PG8_BAR; }
    }
    PG8_WAIT_V(0);
    if constexpr (!ALIGN_EPI) { if (wr == 0) PG8_BAR; }
    PG8_BAR;
    if constexpr (Epi::AFTER_DRAIN) { E.fused(acc, cur, wr, wc, fr, fq, lds, wid, lane); S.done(cur); }
#undef PG8_SA
#undef PG8_SB
#undef PG8_STAGE
#undef PG8_STAGEA
#undef PG8_STAGEA2
#undef PG8_AOFF
#undef PG8_LDA
#undef PG8_LDB
#undef PG8_MMA
#undef PG8_WAIT_V
#undef PG8_WAIT_L
#undef PG8_BAR
#undef PG8_SCHED
}


template <int WHICH> struct MoeOrder {
    const int* TP; int G, c; const char* Abase; const char* Bbase; const int* LIST;
    static constexpr int KK = WHICH == 0 ? 1024 : 512, NN = 4;
    __device__ __forceinline__ bool next(int i, Unit& u) const {
        const int L = i * G + c; if (L >= TP[NEXP]) return false;
        int e = 0;
#pragma unroll 1
        for (int j = 16; j >= 1; j >>= 1) if (TP[e + j] <= L) e += j;
        const int lt = L - TP[e]; u.pm = e * 1024 + lt / NN; u.pn = lt % NN; return true;
    }
    __device__ __forceinline__ const char* a_base(const Unit& u) const { const int e = u.pm >> 10, mt = u.pm & 1023; return WHICH == 0 ? Abase : Abase + (size_t)(TP[64 + e] + mt * 256) * (DEXP * 2); }
    __device__ __forceinline__ const char* b_base(const Unit& u) const { const int e = u.pm >> 10; return Bbase + ((size_t)e * 1024 + (size_t)u.pn * 256) * (KK * 2); }
    __device__ __forceinline__ unsigned a_off(const Unit& u, int r, int C) const {
        if (WHICH == 1) return (unsigned)(r * DEXP + C) * 2u;
        const int e = u.pm >> 10, s = (u.pm & 1023) * 256 + r; const int tok = s < TP[128 + e] ? (LIST[(size_t)e * NR + s] >> 1) : 0;
        return (unsigned)tok * (D * 2) + (unsigned)C * 2u;
    }
    __device__ __forceinline__ void a_ready(const Unit&) const {}
    __device__ __forceinline__ void done(const Unit&) const {}
};
struct TokRowOrder : StaticOrder {
    const char* Abase; const char* Bbase; int K;
    __device__ __forceinline__ const char* a_base(const Unit& u) const { return Abase + (size_t)tokrow(u.pm * BM) * K * 2; }
    __device__ __forceinline__ const char* b_base(const Unit& u) const { return Bbase + (size_t)u.pn * BM * K * 2; }
    __device__ __forceinline__ unsigned a_off(const Unit&, int r, int C) const { return (unsigned)(r * K + C) * 2u; }
};
#define PG8_FOR_FRAGS_M(...) _Pragma("unroll") for (int ai = 0; ai < 2; ++ai) _Pragma("unroll") for (int m = 0; m < 4; ++m) { const int r = ai * HALF + wr * 64 + m * 16 + fr; \
    _Pragma("unroll") for (int bj = 0; bj < 2; ++bj) _Pragma("unroll") for (int n = 0; n < 2; ++n) { const int col = u.pn * BM + bj * HALF + wc * 32 + n * 16 + 4 * fq; ::f32x4 v = acc[ai][bj][m][n]; __VA_ARGS__ } }
struct EpiMoe1 {
    static constexpr bool PERM = true, AFTER_DRAIN = false;
    bf16_t* HID; const int* TP;
    __device__ __forceinline__ void operator()(const f32x4 (&acc)[2][2][4][2], const Unit& u, int wr, int wc, int fr, int fq) const {
        const int e = u.pm >> 10, mt = u.pm & 1023; bf16_t* base = HID + (size_t)(TP[64 + e] + mt * 256) * DEXP;
#pragma unroll
        for (int ai = 0; ai < 2; ++ai)
#pragma unroll
            for (int m = 0; m < 4; ++m) { const int r = ai * HALF + wr * 64 + m * 16 + fr;
#pragma unroll
                for (int bj = 0; bj < 2; ++bj) { const int col = u.pn * BM + bj * HALF + wc * 32 + 8 * fq; const ::f32x4 v0 = acc[ai][bj][m][0], v1 = acc[ai][bj][m][1];
                    const float h0 = v0.x * sigmoidf(v0.x) * v0.y, h1 = v0.z * sigmoidf(v0.z) * v0.w, h2 = v1.x * sigmoidf(v1.x) * v1.y, h3 = v1.z * sigmoidf(v1.z) * v1.w;
                    ::u32x2 w; w.x = pk2(h0, h1); w.y = pk2(h2, h3); *(::u32x2*)(base + (size_t)r * DEXP + (col >> 1)) = w; } }
    }
};
struct EpiMoe2 {
    static constexpr bool PERM = true, AFTER_DRAIN = false;
    bf16_t* MO; const int* TP; const int* LIST; const float* GATE;
    __device__ __forceinline__ void operator()(const f32x4 (&acc)[2][2][4][2], const Unit& u, int wr, int wc, int fr, int fq) const {
        const int e = u.pm >> 10, mt = u.pm & 1023, cnt = TP[128 + e];
#pragma unroll
        for (int ai = 0; ai < 2; ++ai)
#pragma unroll
            for (int m = 0; m < 4; ++m) {
                const int s = mt * 256 + ai * HALF + wr * 64 + m * 16 + fr;
                if (s < cnt) {
                    const int ent = LIST[(size_t)e * NR + s]; const float gt = GATE[ent]; bf16_t* row = MO + (size_t)ent * D;
#pragma unroll
                    for (int bj = 0; bj < 2; ++bj) { const int col = u.pn * BM + bj * HALF + wc * 32 + 8 * fq; const ::f32x4 v0 = acc[ai][bj][m][0], v1 = acc[ai][bj][m][1];
                        ::u32x4 w; w.x = pk2(v0.x * gt, v0.y * gt); w.y = pk2(v0.z * gt, v0.w * gt); w.z = pk2(v1.x * gt, v1.y * gt); w.w = pk2(v1.z * gt, v1.w * gt); *(::u32x4*)(row + col) = w; }
                }
            }
    }
};
#undef PG8_FOR_FRAGS_M
}
template <bool B> struct BoolT { static constexpr bool value = B; };
constexpr int SB_NQT = SEQ / 32;
constexpr int SB_VROW = 192;
__device__ __forceinline__ void phase_sb_fast(const Params& p, char* lds) {
    const bf16_t* P = (const bf16_t*)(p.ws + WS_P); bf16_t* YA = (bf16_t*)(p.ws + WS_YA);
    const int tid = threadIdx.x, lane = tid & 63, wave = tid >> 6, n = lane & 31, hh = lane >> 5;
    char* VB = lds + wave * (32 * SB_VROW);
    const unsigned vtr = (unsigned)(size_t)lds + (unsigned)(wave * (32 * SB_VROW) + (4 * hh + ((lane & 15) >> 2)) * SB_VROW + (16 * ((lane >> 4) & 1) + 4 * (lane & 3)) * 2);
    const int gw = blockIdx.x * NWAVES + wave, NGW = gridDim.x * NWAVES;
    for (int unit = gw; unit < 64 * SB_NQT; unit += NGW) {
        const int qt = SB_NQT - 1 - unit / 64, bh = unit % 64, h = bh & 7, b = bh >> 3;
        const int i0 = NMETA + qt * 32, qi = i0 + n, qrow = qi;
        const bf16_t* Pb = P + (size_t)b * T * PW;
        bf16x8 qf[4];
#pragma unroll
        for (int s = 0; s < 4; ++s) qf[s] = *(const bf16x8*)(Pb + (size_t)qrow * PW + C_QA + h * 64 + 16 * s + 8 * hh);
        f32x16 o0, o1;
#pragma unroll
        for (int r = 0; r < 16; ++r) { o0[r] = 0.f; o1[r] = 0.f; }
        float EL = 1.f;
        auto tile = [&](const int kt, auto MT) {
            constexpr bool MASKED = decltype(MT)::value;
            const int j0 = kt * 32, krow = (!MASKED || (j0 + n) < T) ? (j0 + n) : T - 1;
            bf16x8 kf[4];
#pragma unroll
            for (int s = 0; s < 4; ++s) kf[s] = *(const bf16x8*)(Pb + (size_t)krow * PW + C_KA + h * 64 + 16 * s + 8 * hh);
#pragma unroll
            for (int i = 0; i < 4; ++i) {
                const int c = lane + 64 * i, key = c >> 3, d0 = (c & 7) * 8, vrow = (!MASKED || (j0 + key) < T) ? (j0 + key) : T - 1;
                const u32x4 w = *(const u32x4*)(Pb + (size_t)vrow * PW + C_VA + h * 64 + d0);
                *(u32x4*)(VB + key * SB_VROW + d0 * 2) = w;
            }
            f32x16 sa;
#pragma unroll
            for (int r = 0; r < 16; ++r) sa[r] = 0.f;
#pragma unroll
            for (int s = 0; s < 4; ++s) sa = __builtin_amdgcn_mfma_f32_32x32x16_bf16(kf[s], qf[s], sa, 0, 0, 0);
            float kp[16], sg[16];
#pragma unroll
            for (int r = 0; r < 16; ++r) {
                const float e = fexp2(__builtin_amdgcn_fmed3f(sa[r], -3.0e38f, 80.f)), k = __builtin_amdgcn_rcpf(1.f + e), s = e * k;
                if (MASKED) { const int kk = (r & 3) + 8 * (r >> 2) + 4 * hh; const bool valid = (j0 + kk) < qi; kp[r] = valid ? k : 1.f; sg[r] = valid ? s : 0.f; }
                else { kp[r] = k; sg[r] = s; }
            }
            const float gp0 = (kp[0] * kp[1]) * (kp[2] * kp[3]), gp1 = (kp[4] * kp[5]) * (kp[6] * kp[7]), gp2 = (kp[8] * kp[9]) * (kp[10] * kp[11]), gp3 = (kp[12] * kp[13]) * (kp[14] * kp[15]);
            const float pp0 = xpartner32(gp0, hh), pp1 = xpartner32(gp1, hh), pp2 = xpartner32(gp2, hh), pp3 = xpartner32(gp3, hh);
            const float pc3 = pp3, pc2 = pc3 * pp2, pc1 = pc2 * pp1, pc0 = pc1 * pp0;
            float base[4];
            base[3] = EL * (hh ? 1.f : pc3);
            base[2] = EL * gp3 * (hh ? pc3 : pc2);
            base[1] = EL * (gp3 * gp2) * (hh ? pc2 : pc1);
            base[0] = EL * (gp3 * gp2 * gp1) * (hh ? pc1 : pc0);
            float a[16];
#pragma unroll
            for (int g = 0; g < 4; ++g) {
                float c = base[g];
#pragma unroll
                for (int e = 3; e >= 0; --e) { const int r = 4 * g + e; a[r] = sg[r] * c; c *= kp[r]; }
            }
            EL *= ((gp0 * gp1) * (gp2 * gp3)) * pc0;
            u32x4 pw0, pw1;
            pw0.x = pk2(a[0], a[1]); pw0.y = pk2(a[2], a[3]); pw0.z = pk2(a[4], a[5]); pw0.w = pk2(a[6], a[7]);
            pw1.x = pk2(a[8], a[9]); pw1.y = pk2(a[10], a[11]); pw1.z = pk2(a[12], a[13]); pw1.w = pk2(a[14], a[15]);
            const bf16x8 pf0 = __builtin_bit_cast(bf16x8, pw0), pf1 = __builtin_bit_cast(bf16x8, pw1);
            {
                u16x4 x0, x1, x2, x3, y0, y1, y2, y3;
                asm volatile("s_waitcnt lgkmcnt(0)\n\tds_read_b64_tr_b16 %0, %8 offset:%9\n\tds_read_b64_tr_b16 %1, %8 offset:%10\n\tds_read_b64_tr_b16 %2, %8 offset:%11\n\tds_read_b64_tr_b16 %3, %8 offset:%12\n\t"
                             "ds_read_b64_tr_b16 %4, %8 offset:%13\n\tds_read_b64_tr_b16 %5, %8 offset:%14\n\tds_read_b64_tr_b16 %6, %8 offset:%15\n\tds_read_b64_tr_b16 %7, %8 offset:%16\n\ts_waitcnt lgkmcnt(0)"
                             : "=&v"(x0), "=&v"(x1), "=&v"(x2), "=&v"(x3), "=&v"(y0), "=&v"(y1), "=&v"(y2), "=&v"(y3)
                             : "v"(vtr), "i"(0), "i"(8 * SB_VROW), "i"(16 * SB_VROW), "i"(24 * SB_VROW), "i"(64), "i"(64 + 8 * SB_VROW), "i"(64 + 16 * SB_VROW), "i"(64 + 24 * SB_VROW) : "memory");
#define SB_VF(a_, b_) ({ bf16x8 f_; f_[0] = (short)a_[0]; f_[1] = (short)a_[1]; f_[2] = (short)a_[2]; f_[3] = (short)a_[3]; f_[4] = (short)b_[0]; f_[5] = (short)b_[1]; f_[6] = (short)b_[2]; f_[7] = (short)b_[3]; f_; })
                o0 = __builtin_amdgcn_mfma_f32_32x32x16_bf16(SB_VF(x0, x1), pf0, o0, 0, 0, 0); o0 = __builtin_amdgcn_mfma_f32_32x32x16_bf16(SB_VF(x2, x3), pf1, o0, 0, 0, 0);
                o1 = __builtin_amdgcn_mfma_f32_32x32x16_bf16(SB_VF(y0, y1), pf0, o1, 0, 0, 0); o1 = __builtin_amdgcn_mfma_f32_32x32x16_bf16(SB_VF(y2, y3), pf1, o1, 0, 0, 0);
#undef SB_VF
            }
        };
        int kt = qt + 1;
        for (; kt >= qt; --kt) tile(kt, BoolT<true>{});
        for (; kt >= 0; --kt) {
            if (__all(EL < 1e-37f)) break;
            tile(kt, BoolT<false>{});
        }
        {
            bf16_t* yp = YA + ((size_t)b * SEQ + (qi - NMETA)) * 512 + h * 64 + 4 * hh;
#pragma unroll
            for (int g = 0; g < 4; ++g) {
                u32x2 w; w.x = pk2(o0[4 * g], o0[4 * g + 1]); w.y = pk2(o0[4 * g + 2], o0[4 * g + 3]); *(u32x2*)(yp + 8 * g) = w;
                w.x = pk2(o1[4 * g], o1[4 * g + 1]); w.y = pk2(o1[4 * g + 2], o1[4 * g + 3]); *(u32x2*)(yp + 32 + 8 * g) = w;
            }
        }
    }
}

constexpr int DSA_NQ = 8;
constexpr int DSA_SCS = 4608;
constexpr int DSA_KVB = 0, DSA_RING = 18432, DSA_IDX = DSA_NQ * DSA_RING, DSA_MISC = DSA_IDX + DSA_NQ * 1024, DSA_LDS = DSA_MISC + 512;
static_assert(DSA_NQ * DSA_SCS * 4 <= DSA_IDX, "score rows fit under the index lists");
__device__ __forceinline__ unsigned fkey(float f) { const unsigned u = __float_as_uint(f); return (u & 0x80000000u) ? ~u : (u | 0x80000000u); }
__device__ __forceinline__ int wave_sum_i32(int v) {
    v += __builtin_amdgcn_update_dpp(0, v, 0xB1, 0xF, 0xF, false);
    v += __builtin_amdgcn_update_dpp(0, v, 0x4E, 0xF, 0xF, false);
    v += __builtin_amdgcn_update_dpp(0, v, 0x141, 0xF, 0xF, false);
    v += __builtin_amdgcn_update_dpp(0, v, 0x140, 0xF, 0xF, false);
    return __builtin_amdgcn_readlane(v, 0) + __builtin_amdgcn_readlane(v, 16) + __builtin_amdgcn_readlane(v, 32) + __builtin_amdgcn_readlane(v, 48);
}
__device__ __forceinline__ int wave_excl_scan_i32(int c, int lane, int& total) {
    int x = c;
    x += __builtin_amdgcn_update_dpp(0, x, 0x111, 0xF, 0xF, true);
    x += __builtin_amdgcn_update_dpp(0, x, 0x112, 0xF, 0xF, true);
    x += __builtin_amdgcn_update_dpp(0, x, 0x114, 0xF, 0xF, true);
    x += __builtin_amdgcn_update_dpp(0, x, 0x118, 0xF, 0xF, true);
    const int t0 = __builtin_amdgcn_readlane(x, 15), t1 = __builtin_amdgcn_readlane(x, 31), t2 = __builtin_amdgcn_readlane(x, 47), t3 = __builtin_amdgcn_readlane(x, 63);
    const int row = lane >> 4;
    x += (row > 0 ? t0 : 0) + (row > 1 ? t1 : 0) + (row > 2 ? t2 : 0);
    total = t0 + t1 + t2 + t3;
    return x - c;
}
__device__ __forceinline__ int mbcnt64(unsigned long long m) { return (int)__builtin_amdgcn_mbcnt_hi((unsigned)(m >> 32), __builtin_amdgcn_mbcnt_lo((unsigned)m, 0u)); }
__device__ __forceinline__ void phase_dsa(const Params& p, char* lds) {
    const bf16_t* P = (const bf16_t*)(p.ws + WS_P); bf16_t* OL = (bf16_t*)(p.ws + WS_OLAT);
    const int tid = threadIdx.x, lane = tid & 63, wave = __builtin_amdgcn_readfirstlane(tid >> 6);
    unsigned* SC = (unsigned*)(lds + DSA_KVB);
    unsigned short* IDX = (unsigned short*)(lds + DSA_IDX);
    int* MISC = (int*)(lds + DSA_MISC);
    const unsigned lds_base = (unsigned)(size_t)lds;
    constexpr int NU = SEQ / DSA_NQ;
    for (int unit = blockIdx.x; unit < BATCH * NU; unit += gridDim.x) {
        const int u8 = NU - 1 - unit / BATCH, b = unit % BATCH, t0 = NMETA + u8 * DSA_NQ;
        const int cid = 1 + (t0 - NMETA) / 64, n = NMETA + 64 * cid;
        const bf16_t* Pb = P + (size_t)b * T * PW;
        const int m = lane & 31, hh = lane >> 5;
        bf16x8 aq[2][4]; float wv[2][16];
#pragma unroll
        for (int rt = 0; rt < 2; ++rt) {
#pragma unroll
            for (int s = 0; s < 4; ++s) aq[rt][s] = *(const bf16x8*)(Pb + (size_t)(t0 + 4 * rt + (m >> 3)) * PW + C_QI + (m & 7) * 64 + 16 * s + 8 * hh);
#pragma unroll
            for (int r = 0; r < 16; ++r) wv[rt][r] = bf2f(Pb[(size_t)(t0 + 4 * rt + (r >> 2)) * PW + C_WI + (r & 3) + 4 * hh]);
        }
        const unsigned char* KIPb = p.ws + WS_KIP + (size_t)b * KIP_BATCH + lane * 16;
        bf16x8 bk[4];
#pragma unroll
        for (int s = 0; s < 4; ++s) bk[s] = *(const bf16x8*)(KIPb + (size_t)wave * 4096 + s * 1024);
        __syncthreads();
        {
            const int ntile = (n + 31) / 32;
            for (int kt = wave; kt < ntile; kt += NWAVES) {
                const int j0 = kt * 32, key = j0 + m;
                bf16x8 bn[4];
                { const int ktn = kt + NWAVES < 129 ? kt + NWAVES : 128;
#pragma unroll
                  for (int s = 0; s < 4; ++s) bn[s] = *(const bf16x8*)(KIPb + (size_t)ktn * 4096 + s * 1024); }
                const bool ok = key < n;
#pragma unroll
                for (int rt = 0; rt < 2; ++rt) {
                    f32x16 acc;
#pragma unroll
                    for (int r = 0; r < 16; ++r) acc[r] = 0.f;
#pragma unroll
                    for (int s = 0; s < 4; ++s) acc = __builtin_amdgcn_mfma_f32_32x32x16_bf16(aq[rt][s], bk[s], acc, 0, 0, 0);
                    float tq[4];
#pragma unroll
                    for (int q = 0; q < 4; ++q) {
#define RELU_(x) __builtin_amdgcn_fmed3f((x), 0.f, 3.0e38f)
                        float s = wv[rt][4 * q] * RELU_(acc[4 * q]); s += wv[rt][4 * q + 1] * RELU_(acc[4 * q + 1]); s += wv[rt][4 * q + 2] * RELU_(acc[4 * q + 2]); s += wv[rt][4 * q + 3] * RELU_(acc[4 * q + 3]);
#undef RELU_
                        tq[q] = xsum32(s);
                    }
                    const float s0 = hh ? tq[2] : tq[0], s1 = hh ? tq[3] : tq[1];
                    SC[(4 * rt + 2 * hh) * DSA_SCS + key] = ok ? fkey(s0) : 0u;
                    SC[(4 * rt + 2 * hh + 1) * DSA_SCS + key] = ok ? fkey(s1) : 0u;
                }
#pragma unroll
                for (int s = 0; s < 4; ++s) bk[s] = bn[s];
            }
        }
        __syncthreads();
        bf16x8 qf[5];
        {
            const int hd_ = lane & 15, g_ = lane >> 4;
#pragma unroll
            for (int ks = 0; ks < 5; ++ks) {
                u32x4 w = (u32x4){0u, 0u, 0u, 0u};
                if (hd_ < 8 && (ks < 4 || g_ < 2)) w = *(const u32x4*)(Pb + (size_t)(t0 + wave) * PW + C_QF + hd_ * QFW + 32 * ks + 8 * g_);
                qf[ks] = __builtin_bit_cast(bf16x8, w);
            }
        }
        {
            unsigned* sc = SC + wave * DSA_SCS;
            unsigned v[65];
#pragma unroll
            for (int i = 0; i < 65; ++i) { const int k = i * 64 + lane; v[i] = (k < n) ? sc[k] : 0u; }
            unsigned prefix = 0u; int cge = n, bit = 31;
            bool exact = false;
            if (n >= 256) {
                for (; bit >= 0 && cge > 512; --bit) {
                    const unsigned cand = prefix | (1u << bit); const int sc_ = (int)(cand ^ 0x80000000u);
                    unsigned b0 = 0u, b1 = 0u, b2 = 0u; int slots = 0;
#pragma unroll
                    for (int gi = 0; gi < 5; ++gi) if (gi * 832 < n) {
#pragma unroll
                        for (int i = 13 * gi; i < 13 * gi + 13; ++i) {
                            const unsigned d = (unsigned)__builtin_elementwise_sub_sat((int)(v[i] ^ 0x80000000u), sc_);
                            if (i % 3 == 0) b0 = __builtin_amdgcn_alignbit(b0, d, 31); else if (i % 3 == 1) b1 = __builtin_amdgcn_alignbit(b1, d, 31); else b2 = __builtin_amdgcn_alignbit(b2, d, 31);
                        }
                        slots += 13 * 64;
                    }
                    const int c = slots - wave_sum_i32(__builtin_popcount(b0) + __builtin_popcount(b1) + __builtin_popcount(b2));
                    if (c >= 256) { prefix = cand; cge = c; if (c == 256) { exact = true; break; } }
                }
            }
            int ngt = n;
            if (n >= 256 && !exact) {
                asm volatile("s_waitcnt lgkmcnt(0)" ::: "memory");
                int cb = 0;
                if (bit >= 0) {
                    const int sp_ = (int)((prefix > 0u ? prefix : 1u) ^ 0x80000000u);
                    unsigned lb0 = 0u, lb1 = 0u, lb2 = 0u;
#pragma unroll
                    for (int i = 0; i < 65; ++i) { const unsigned d = (unsigned)__builtin_elementwise_sub_sat((int)(v[i] ^ 0x80000000u), sp_);
                        if (i < 32) lb0 = __builtin_amdgcn_alignbit(lb0, d, 31); else if (i < 64) lb1 = __builtin_amdgcn_alignbit(lb1, d, 31); else lb2 = d >> 31; }
                    const unsigned tk0 = ~lb0, tk1 = ~lb1, tk2 = (~lb2) & 1u;
                    const int c0 = __builtin_popcount(tk0), c1 = __builtin_popcount(tk1);
                    const int lbase = wave_excl_scan_i32(c0 + c1 + (int)tk2, lane, cb);
#pragma unroll
                    for (int i = 0; i < 65; ++i) {
                        bool tkn; int rk;
                        if (i < 32) { tkn = (tk0 >> (31 - i)) & 1u; rk = i == 0 ? 0 : __builtin_popcount(tk0 >> (32 - i)); }
                        else if (i < 64) { tkn = (tk1 >> (63 - i)) & 1u; rk = c0 + (i == 32 ? 0 : __builtin_popcount(tk1 >> (64 - i))); }
                        else { tkn = tk2 != 0u; rk = c0 + c1; }
                        sc[tkn ? lbase + rk : 4096 + (lane & 15)] = v[i];
                    }
                    asm volatile("s_waitcnt lgkmcnt(0)" ::: "memory");
                    unsigned w[8];
#pragma unroll
                    for (int j = 0; j < 8; ++j) { const int k = j * 64 + lane; w[j] = (k < cb) ? sc[k] : 0u; }
                    for (; bit >= 0; --bit) {
                        const unsigned cand = prefix | (1u << bit); const int sc_ = (int)(cand ^ 0x80000000u); unsigned b0 = 0u, b1 = 0u;
#pragma unroll
                        for (int j = 0; j < 8; ++j) { const unsigned d = (unsigned)__builtin_elementwise_sub_sat((int)(w[j] ^ 0x80000000u), sc_); if (j & 1) b1 = __builtin_amdgcn_alignbit(b1, d, 31); else b0 = __builtin_amdgcn_alignbit(b0, d, 31); }
                        const int c = 512 - wave_sum_i32(__builtin_popcount(b0) + __builtin_popcount(b1));
                        if (c >= 256) { prefix = cand; if (c == 256) { exact = true; break; } }
                    }
                    int c = 0;
#pragma unroll
                    for (int j = 0; j < 8; ++j) c += __popcll(__ballot(w[j] > prefix));
                    ngt = c;
                } else {
                    int c = 0;
#pragma unroll
                    for (int i = 0; i < 65; ++i) { c += __popcll(__ballot(v[i] > prefix)); if ((i & 3) == 3) __builtin_amdgcn_sched_barrier(0); }
                    ngt = c;
                }
            }
            const unsigned tau = prefix;
            const int need_eq = n >= 256 ? 256 - ngt : 0; int base = 0, eqb = 0;
            unsigned short* idx = IDX + wave * 512;
            {
                const int st_ = (int)(tau ^ 0x80000000u); unsigned e0 = 0u, e1 = 0u, e2 = 0u;
#pragma unroll
                for (int i = 0; i < 65; ++i) { const unsigned d = (unsigned)__builtin_elementwise_sub_sat((int)(v[i] ^ 0x80000000u), st_);
                    if (i < 32) e0 = __builtin_amdgcn_alignbit(e0, d, 31); else if (i < 64) e1 = __builtin_amdgcn_alignbit(e1, d, 31); else e2 = d >> 31; }
                const unsigned tk0 = ~e0, tk1 = ~e1, tk2 = (~e2) & 1u;
                const int c0 = __builtin_popcount(tk0), c1 = __builtin_popcount(tk1);
                int nge; const int lbase = wave_excl_scan_i32(c0 + c1 + (int)tk2, lane, nge);
                if (n >= 256 && nge == 256) {
                    unsigned short* ib = idx + lbase;
                    { unsigned x = tk0; int j = 0; while (__any(x != 0u)) { if (x != 0u) { const int i = __builtin_clz(x); ib[j] = (unsigned short)(i * 64 + lane); x ^= 0x80000000u >> i; } ++j; } }
                    ib += c0;
                    { unsigned x = tk1; int j = 0; while (__any(x != 0u)) { if (x != 0u) { const int i = __builtin_clz(x); ib[j] = (unsigned short)((32 + i) * 64 + lane); x ^= 0x80000000u >> i; } ++j; } }
                    if (tk2 != 0u) ib[c1] = (unsigned short)(64 * 64 + lane);
                    base = nge;
                } else {
#pragma unroll
                    for (int gi = 0; gi < 5; ++gi) if (gi * 832 < n) {
#pragma unroll
                        for (int i = 13 * gi; i < 13 * gi + 13; ++i) {
                            const int k = i * 64 + lane; const unsigned u = v[i];
                            const bool eq = (u == tau); const unsigned long long meq = __ballot(eq);
                            const bool take = (u > tau) || (eq && (eqb + mbcnt64(meq)) < need_eq);
                            const unsigned long long mt = __ballot(take);
                            idx[take ? base + mbcnt64(mt) : 256 + lane] = (unsigned short)k;
                            base += __popcll(mt); eqb += __popcll(meq);
                            if ((i & 3) == 3) __builtin_amdgcn_sched_barrier(0);
                        }
                    }
                }
            }
            for (int pos = base + lane; pos < 256; pos += 64) idx[pos] = 0;
            if (lane == 0) MISC[wave] = base;
        }
        asm volatile("s_waitcnt lgkmcnt(0)" ::: "memory");
        {
            const int q = wave; const int nsel = MISC[q];
            const size_t qrow = (size_t)(t0 + q);
            int ln = lane; asm volatile("" : "+v"(ln));
            const int hd = ln & 15, g = ln >> 4, qd = (ln & 15) >> 2, pp = ln & 3;
            char* ring = lds + DSA_KVB + wave * DSA_RING;
            const unsigned ring_a = lds_base + DSA_KVB + wave * DSA_RING;
            const unsigned short* idx = IDX + q * 512;
            asm volatile("s_waitcnt vmcnt(0)" ::: "memory");
#define DSA_ISSUE(c) do { _Pragma("unroll") for (int i_ = 0; i_ < 9; ++i_) { const int pid_ = ln + 64 * i_, row_ = pid_ / 18, part_ = pid_ - row_ * 18; \
                const bf16_t* src_ = Pb + (size_t)idx[32 * (c) + row_] * PW + C_KV + part_ * 8; \
                __builtin_amdgcn_global_load_lds((const unsigned*)src_, (LAS unsigned*)(ring + ((c) & 1) * 9216 + i_ * 1024), 16, 0, 0); } } while (0)
            DSA_ISSUE(0); DSA_ISSUE(1);
            f32x4 O[8];
#pragma unroll
            for (int nt = 0; nt < 8; ++nt) O[nt] = (f32x4){0.f, 0.f, 0.f, 0.f};
            float mrun = -3e38f, lrun = 0.f;
            for (int c = 0; c < 8; ++c) {
                if (c < 7) asm volatile("s_waitcnt vmcnt(9)" ::: "memory"); else asm volatile("s_waitcnt vmcnt(0)" ::: "memory");
                const char* buf = ring + (c & 1) * 9216;
                f32x4 S0 = (f32x4){0.f, 0.f, 0.f, 0.f}, S1 = S0;
                {
                    const char* kr = buf + hd * 288 + 16 * g;
#pragma unroll
                    for (int ks = 0; ks < 4; ++ks) { S0 = __builtin_amdgcn_mfma_f32_16x16x32_bf16(*(const bf16x8*)(kr + 64 * ks), qf[ks], S0, 0, 0, 0); S1 = __builtin_amdgcn_mfma_f32_16x16x32_bf16(*(const bf16x8*)(kr + 16 * 288 + 64 * ks), qf[ks], S1, 0, 0, 0); }
                    u32x4 w0 = (u32x4){0u, 0u, 0u, 0u}, w1 = w0; if (g < 2) { w0 = *(const u32x4*)(kr + 256); w1 = *(const u32x4*)(kr + 16 * 288 + 256); }
                    S0 = __builtin_amdgcn_mfma_f32_16x16x32_bf16(__builtin_bit_cast(bf16x8, w0), qf[4], S0, 0, 0, 0); S1 = __builtin_amdgcn_mfma_f32_16x16x32_bf16(__builtin_bit_cast(bf16x8, w1), qf[4], S1, 0, 0, 0);
                }
                float cm = -3e38f;
#pragma unroll
                for (int r = 0; r < 4; ++r) { if (nsel < 256) { const int sl = 32 * c + 4 * g + r; S0[r] = sl < nsel ? S0[r] : -1e30f; S1[r] = (sl + 16) < nsel ? S1[r] : -1e30f; } cm = fmax2(cm, fmax2(S0[r], S1[r])); }
                cm = xmax16(xmax32(cm));
                if (__any(cm > mrun + 6.f)) {
                    const float mnew = fmaxf(mrun, cm), alpha = fexp2(mrun - mnew);
                    lrun *= alpha; mrun = mnew;
#pragma unroll
                    for (int nt = 0; nt < 8; ++nt) O[nt] *= alpha;
                }
                float ps = 0.f;
#pragma unroll
                for (int r = 0; r < 4; ++r) { S0[r] = fexp2(S0[r] - mrun); S1[r] = fexp2(S1[r] - mrun); ps += S0[r] + S1[r]; }
                ps = xsum16(xsum32(ps));
                lrun += ps;
                u32x4 pw; pw.x = pk2(S0[0], S0[1]); pw.y = pk2(S0[2], S0[3]); pw.z = pk2(S1[0], S1[1]); pw.w = pk2(S1[2], S1[3]);
                const bf16x8 pf = __builtin_bit_cast(bf16x8, pw);
                const unsigned va = ring_a + (unsigned)((c & 1) * 9216 + (4 * g + qd) * 288 + 8 * pp);
#pragma unroll
                for (int h2 = 0; h2 < 2; ++h2) {
                    u16x4 x0, x1, x2, x3, y0, y1, y2, y3;
                    asm volatile("ds_read_b64_tr_b16 %0, %8 offset:%9\n\tds_read_b64_tr_b16 %1, %8 offset:%10\n\tds_read_b64_tr_b16 %2, %8 offset:%11\n\tds_read_b64_tr_b16 %3, %8 offset:%12\n\t"
                                 "ds_read_b64_tr_b16 %4, %8 offset:%13\n\tds_read_b64_tr_b16 %5, %8 offset:%14\n\tds_read_b64_tr_b16 %6, %8 offset:%15\n\tds_read_b64_tr_b16 %7, %8 offset:%16\n\ts_waitcnt lgkmcnt(0)"
                                 : "=&v"(x0), "=&v"(x1), "=&v"(x2), "=&v"(x3), "=&v"(y0), "=&v"(y1), "=&v"(y2), "=&v"(y3)
                                 : "v"(va), "i"(128 * h2), "i"(128 * h2 + 32), "i"(128 * h2 + 64), "i"(128 * h2 + 96), "i"(128 * h2 + 4608), "i"(128 * h2 + 4640), "i"(128 * h2 + 4672), "i"(128 * h2 + 4704) : "memory");
#define DSA_PV(nt_, x_, y_) do { bf16x8 vf_; vf_[0] = (short)x_[0]; vf_[1] = (short)x_[1]; vf_[2] = (short)x_[2]; vf_[3] = (short)x_[3]; vf_[4] = (short)y_[0]; vf_[5] = (short)y_[1]; vf_[6] = (short)y_[2]; vf_[7] = (short)y_[3]; \
                    O[nt_] = __builtin_amdgcn_mfma_f32_16x16x32_bf16(vf_, pf, O[nt_], 0, 0, 0); } while (0)
                    DSA_PV(4 * h2 + 0, x0, y0); DSA_PV(4 * h2 + 1, x1, y1); DSA_PV(4 * h2 + 2, x2, y2); DSA_PV(4 * h2 + 3, x3, y3);
                }
                asm volatile("s_waitcnt lgkmcnt(0)" ::: "memory");
                if (c + 2 < 8) DSA_ISSUE(c + 2);
            }
#undef DSA_PV
#undef DSA_ISSUE
            const float inv = __builtin_amdgcn_rcpf(lrun);
            if (hd < 8) {
                bf16_t* op = OL + ((size_t)b * SEQ + (qrow - NMETA)) * 1024 + hd * 128 + 4 * g;
#pragma unroll
                for (int nt = 0; nt < 8; ++nt) { u32x2 w; w.x = pk2(O[nt][0] * inv, O[nt][1] * inv); w.y = pk2(O[nt][2] * inv, O[nt][3] * inv); *(u32x2*)(op + 16 * nt) = w; }
            }
        }
    }
}

__device__ __forceinline__ void phase_inproj_meta(const Params& p) {
    unsigned char* ws = p.ws; const int tid = threadIdx.x, lane = tid & 63, wave = tid >> 6, fr = lane & 15, fq = lane >> 4;
    const bf16_t* U = (const bf16_t*)(ws + WS_U); const bf16_t* WP = (const bf16_t*)(ws + WS_WP); bf16_t* P = (bf16_t*)(ws + WS_P); const float2* cs = (const float2*)(ws + WS_CS);
    const int gw = blockIdx.x * NWAVES + wave, NGW = gridDim.x * NWAVES;
    for (int nt = gw; nt < PW / 16; nt += NGW) {
        const bf16_t* ap = U + (size_t)fr * D + 8 * fq; const bf16_t* bp = WP + (size_t)(16 * nt + fr) * D + 8 * fq;
        f32x4 acc = (f32x4){0.f, 0.f, 0.f, 0.f};
#pragma unroll 8
        for (int ks = 0; ks < D / 32; ++ks) acc = __builtin_amdgcn_mfma_f32_16x16x32_bf16(*(const bf16x8*)(bp + 32 * ks), *(const bf16x8*)(ap + 32 * ks), acc, 0, 0, 0);
        const int col = 16 * nt + 4 * fq, t = fr; f32x4 v = acc; int o;
        if (pg8::rope_off(col, o)) { const float2 c0 = cs[t * 8 + (o >> 1)], c1 = cs[t * 8 + (o >> 1) + 1]; v = (f32x4){v.x * c0.x - v.y * c0.y, v.y * c0.x + v.x * c0.y, v.z * c1.x - v.w * c1.y, v.w * c1.x + v.z * c1.y}; }
        u32x2 w; w.x = pk2(v.x, v.y); w.y = pk2(v.z, v.w);
        for (int b = 0; b < BATCH; ++b) {
            if (col >= C_KI && col < C_WI) { const int d0 = col - C_KI;
                *(u32x2*)(ws + WS_KIP + (size_t)b * KIP_BATCH + (size_t)((((t >> 5) * 4 + (d0 >> 4)) * 2 + ((d0 >> 3) & 1)) * 512 + (t & 31) * 16 + (d0 & 7) * 2)) = w; }
            else *(u32x2*)(P + ((size_t)b * T + t) * PW + col) = w;
        }
    }
}

__device__ __forceinline__ void phase_c3(const Params& p, char* lds) {
    unsigned char* ws = p.ws; const int tid = threadIdx.x, lane = tid & 63, wave = __builtin_amdgcn_readfirstlane(tid >> 6);
    const float* H1 = (const float*)(ws + WS_H1); const float* g = p.in[I_GFFN];
    {
        bf16_t* U2 = (bf16_t*)(ws + WS_U); const int gw = blockIdx.x * NWAVES + wave, NGW = gridDim.x * NWAVES;
        for (int row = gw; row < NR; row += NGW) {
            const f32x4* xr = (const f32x4*)(H1 + (size_t)row * D) + lane;
            f32x4 v[4]; float s = 0.f;
#pragma unroll
            for (int j = 0; j < 4; ++j) { v[j] = xr[64 * j]; s += (v[j].x * v[j].x + v[j].y * v[j].y) + (v[j].z * v[j].z + v[j].w * v[j].w); }
            const float rstd = rsqrtf(wave_sum(s) * (1.f / D) + NORM_EPS);
            u32x2* o = (u32x2*)(U2 + (size_t)row * D) + lane;
#pragma unroll
            for (int j = 0; j < 4; ++j) { const f32x4 gg = ((const f32x4*)g)[lane + 64 * j];
                u32x2 w; w.x = pk2(v[j].x * rstd * gg.x, v[j].y * rstd * gg.y); w.y = pk2(v[j].z * rstd * gg.z, v[j].w * rstd * gg.w); o[64 * j] = w; }
        }
    }
    {
        float* Tl = (float*)lds;
        float* RED = (float*)lds;
        const float* wg = p.in[I_WGRP]; const float* wr = p.in[I_WRT]; const float* bg = p.in[I_BGRP]; const float* br = p.in[I_BRT];
        unsigned* ctl = (unsigned*)(ws + WS_CTL); int* LIST = (int*)(ws + WS_LIST); float* GATE = (float*)(ws + WS_GATE);
        const int tk = tid & 127, kq = wave >> 1;
        for (int grp = blockIdx.x; grp < NR / 128; grp += gridDim.x) {
            const int tok0 = grp * 128;
            float acc[36]; float ss = 0.f;
#pragma unroll
            for (int o = 0; o < 36; ++o) acc[o] = 0.f;
            for (int step = 0; step < 8; ++step) {
                __syncthreads();
#pragma unroll
                for (int i = 0; i < 8; ++i) { const int idx = tid + NTHREADS * i, qq = idx >> 10, rem = idx & 1023, t2 = rem >> 3, kc = rem & 7;
                    const f32x4 v = *(const f32x4*)(H1 + (size_t)(tok0 + t2) * D + qq * 256 + step * 32 + kc * 4);
                    float* d = Tl + qq * (32 * 129) + (kc * 4) * 129 + t2; d[0] = v.x; d[129] = v.y; d[258] = v.z; d[387] = v.w; }
                __syncthreads();
                const int kb = kq * 256 + step * 32;
#pragma unroll 4
                for (int k = 0; k < 32; ++k) {
                    const float h = Tl[kq * (32 * 129) + k * 129 + tk]; ss += h * h; const float hg = h * g[kb + k];
                    const float* w4 = wg + (size_t)(kb + k) * 4; const float* w32 = wr + (size_t)(kb + k) * 32;
#pragma unroll
                    for (int o = 0; o < 4; ++o) acc[o] += hg * w4[o];
#pragma unroll
                    for (int o = 0; o < 32; ++o) acc[4 + o] += hg * w32[o];
                }
            }
            __syncthreads();
#pragma unroll
            for (int o = 0; o < 36; ++o) RED[(kq * 37 + o) * 128 + tk] = acc[o];
            RED[(kq * 37 + 36) * 128 + tk] = ss;
            __syncthreads();
            if (tid < 128) {
                const int tok = tok0 + tk;
#pragma unroll
                for (int o = 0; o < 36; ++o) acc[o] = (RED[o * 128 + tk] + RED[(37 + o) * 128 + tk]) + (RED[(74 + o) * 128 + tk] + RED[(111 + o) * 128 + tk]);
                ss = (RED[36 * 128 + tk] + RED[(37 + 36) * 128 + tk]) + (RED[(74 + 36) * 128 + tk] + RED[(111 + 36) * 128 + tk]);
                const float rstd = rsqrtf(ss * (1.f / D) + NORM_EPS);
                float gl[4]; int gs = 0; float gm;
#pragma unroll
                for (int o = 0; o < 4; ++o) gl[o] = acc[o] * rstd + bg[o];
                gm = gl[0];
#pragma unroll
                for (int o = 1; o < 4; ++o) if (gl[o] > gm) { gm = gl[o]; gs = o; }
                float gsum = 0.f;
#pragma unroll
                for (int o = 0; o < 4; ++o) gsum += __expf(gl[o] - gm);
                const float pgrp = 1.f / gsum;
                float el[8];
#pragma unroll
                for (int j = 0; j < 8; ++j) { float a = acc[4 + j]; float bb = br[j];
                    a = gs == 1 ? acc[12 + j] : a; bb = gs == 1 ? br[8 + j] : bb; a = gs == 2 ? acc[20 + j] : a; bb = gs == 2 ? br[16 + j] : bb; a = gs == 3 ? acc[28 + j] : a; bb = gs == 3 ? br[24 + j] : bb;
                    el[j] = a * rstd + bb; }
                int e0 = 0; float m0 = el[0];
#pragma unroll
                for (int j = 1; j < 8; ++j) if (el[j] > m0) { m0 = el[j]; e0 = j; }
                int e1 = -1; float m1 = -3e38f;
#pragma unroll
                for (int j = 0; j < 8; ++j) if (j != e0 && el[j] > m1) { m1 = el[j]; e1 = j; }
                const float x1 = __expf(m1 - m0); const float g0 = pgrp / (1.f + x1), g1 = pgrp * x1 / (1.f + x1);
                const int ex0 = gs * 8 + e0, ex1 = gs * 8 + e1;
                const int s0 = (int)atomicAdd(ctl + CW_CNT + 64 * ex0, 1u); LIST[(size_t)ex0 * NR + s0] = tok * 2;
                const int s1 = (int)atomicAdd(ctl + CW_CNT + 64 * ex1, 1u); LIST[(size_t)ex1 * NR + s1] = tok * 2 + 1;
                GATE[tok * 2] = g0; GATE[tok * 2 + 1] = g1;
            }
        }
    }
}

template <int WHICH>
__device__ __forceinline__ void phase_moe(const Params& p, char* lds) {
    unsigned char* ws = p.ws; const int tid = threadIdx.x;
    const unsigned* ctl = (const unsigned*)(ws + WS_CTL);
    int* TP = (int*)(lds + pg8::STAGE_BYTES);
    __syncthreads();
    if (tid == 0) { int tp = 0, ro = 0; for (int e = 0; e < NEXP; ++e) { const int c = (int)ctl[CW_CNT + 64 * e]; TP[e] = tp; TP[64 + e] = ro; TP[128 + e] = c; const int t = (c + 255) / 256; tp += t * 4; ro += t * 256; } TP[NEXP] = tp; }
    __syncthreads();
    pg8::MoeOrder<WHICH> S{TP, (int)gridDim.x, (int)blockIdx.x, (const char*)(ws + (WHICH == 0 ? WS_U : WS_HID)), (const char*)(ws + (WHICH == 0 ? WS_W13 : WS_W2)), (const int*)(ws + WS_LIST)};
    if constexpr (WHICH == 0) { pg8::EpiMoe1 E{(bf16_t*)(ws + WS_HID), TP}; pg8::gemm_phase_x<pg8::EpiMoe1, pg8::MoeOrder<0>, true, true>((LAS unsigned char*)lds, 1024, S, E); }
    else { pg8::EpiMoe2 E{(bf16_t*)(ws + WS_MO), TP, (const int*)(ws + WS_LIST), (const float*)(ws + WS_GATE)}; pg8::gemm_phase_x<pg8::EpiMoe2, pg8::MoeOrder<1>, true, true>((LAS unsigned char*)lds, 512, S, E); }
}

__device__ __forceinline__ void phase_final(const Params& p) {
    unsigned char* ws = p.ws; const int tid = threadIdx.x, lane = tid & 63, wave = tid >> 6;
    const float* H1 = (const float*)(ws + WS_H1); const bf16_t* MO = (const bf16_t*)(ws + WS_MO); const float* g = p.in[I_GFIN];
    const int gw = blockIdx.x * NWAVES + wave, NGW = gridDim.x * NWAVES;
    for (int orow = gw; orow < BATCH * SEQ; orow += NGW) {
        const size_t row = (size_t)orow;
        const f32x4* xr = (const f32x4*)(H1 + row * D) + lane; const u32x2* m0 = (const u32x2*)(MO + row * 2 * D) + lane; const u32x2* m1 = m0 + 256;
        f32x4 v[4]; float ss = 0.f;
#pragma unroll
        for (int j = 0; j < 4; ++j) { const u32x2 a = m0[64 * j], c = m1[64 * j]; v[j] = xr[64 * j];
            v[j].x += bflo(a.x) + bflo(c.x); v[j].y += bfhi(a.x) + bfhi(c.x); v[j].z += bflo(a.y) + bflo(c.y); v[j].w += bfhi(a.y) + bfhi(c.y);
            ss += (v[j].x * v[j].x + v[j].y * v[j].y) + (v[j].z * v[j].z + v[j].w * v[j].w); }
        const float rstd = rsqrtf(wave_sum(ss) * (1.f / D) + NORM_EPS);
        f32x4* o = (f32x4*)(p.out + (size_t)orow * D) + lane;
#pragma unroll
        for (int j = 0; j < 4; ++j) { const f32x4 gg = ((const f32x4*)g)[lane + 64 * j]; o[64 * j] = v[j] * rstd * gg; }
    }
}

#define XB_TMO      128
#define XB_XCNT(j)  (256  + 64 * (j))
#define XB_XSUB(j)  (1280 + 64 * (j))
#define XB_XGEN(j)  (2304 + 64 * (j))
#define XB_TOP      3328
#define XB_TOPGEN   3392
#define XCD_BAR_WORDS 3456
#define XB_SPIN_CAP (1u << 18)
__device__ __forceinline__ unsigned xb_ld(unsigned* p)              { return __hip_atomic_load(p, __ATOMIC_RELAXED, __HIP_MEMORY_SCOPE_AGENT); }
__device__ __forceinline__ unsigned xb_add(unsigned* p, unsigned v) { return __hip_atomic_fetch_add(p, v, __ATOMIC_RELAXED, __HIP_MEMORY_SCOPE_AGENT); }
__device__ __forceinline__ unsigned xb_xcc_id() { return (unsigned)__builtin_amdgcn_s_getreg((3 << 11) | 20) & 0xFu; }
#define XB_SPIN(cond, bar) do { unsigned _sp = 0; while (cond) { __builtin_amdgcn_s_sleep(1); \
    if ((++_sp & 255u) == 0u) { if (xb_ld(&(bar)[XB_TMO])) break; if (_sp > XB_SPIN_CAP) { atomicAdd(&(bar)[XB_TMO], 1u); break; } } } } while (0)
struct XcdBarrier { unsigned* bar; unsigned x; volatile LAS unsigned* st; };
__device__ __forceinline__ XcdBarrier xcd_barrier_post(unsigned* bar, volatile LAS unsigned* st) {
    XcdBarrier b; b.bar = bar; b.x = xb_xcc_id(); b.st = st;
    if (threadIdx.x == 0) (void)xb_add(&bar[XB_XCNT(b.x)], 1u);
    return b;
}
__device__ __forceinline__ void xcd_barrier_complete(unsigned* bar, unsigned x, unsigned& nloc, unsigned& nx) {
    const unsigned G = gridDim.x * gridDim.y * gridDim.z;
    unsigned sum, cnt, mine, sp = 0u;
    for (;;) {
        sum = 0u; cnt = 0u; mine = 0u;
#pragma unroll
        for (unsigned j = 0; j < 16; ++j) { const unsigned c = xb_ld(&bar[XB_XCNT(j)]); sum += c; cnt += (c > 0u) ? 1u : 0u; mine = (j == x) ? c : mine; }
        if (sum == G) break;
        __builtin_amdgcn_s_sleep(1);
        if ((++sp & 255u) == 0u) { if (xb_ld(&bar[XB_TMO])) break; if (sp > XB_SPIN_CAP) { atomicAdd(&bar[XB_TMO], 1u); break; } }
    }
    nloc = mine > 0u ? mine : 1u; nx = cnt > 0u ? cnt : 1u;
}
__device__ __forceinline__ void xcd_barrier(const XcdBarrier& b) {
    asm volatile("s_waitcnt vmcnt(0)" ::: "memory");
    __syncthreads();
    if (threadIdx.x == 0) {
        unsigned* bar = b.bar;
        __builtin_amdgcn_s_waitcnt(0);
        unsigned nloc = b.st[0], nx = b.st[1];
        if (nloc == 0u) { xcd_barrier_complete(bar, b.x, nloc, nx); b.st[0] = nloc; b.st[1] = nx; }
        const unsigned old = xb_add(&bar[XB_XSUB(b.x)], 1u);
        const unsigned gen = old / nloc;
        if (old + 1u == (gen + 1u) * nloc) {
            __builtin_amdgcn_fence(__ATOMIC_RELEASE, "agent");
            asm volatile("s_waitcnt vmcnt(0)" ::: "memory");
            const unsigned og = xb_add(&bar[XB_TOP], 1u);
            const unsigned tg = og / nx;
            if (og + 1u == (tg + 1u) * nx) xb_add(&bar[XB_TOPGEN], 1u);
            else XB_SPIN(xb_ld(&bar[XB_TOPGEN]) == tg, bar);
            __builtin_amdgcn_fence(__ATOMIC_ACQUIRE, "agent");
            xb_add(&bar[XB_XGEN(b.x)], 1u);
            asm volatile("s_waitcnt vmcnt(0)" ::: "memory");
        } else {
            XB_SPIN(xb_ld(&bar[XB_XGEN(b.x)]) == gen, bar);
            __builtin_amdgcn_fence(__ATOMIC_ACQUIRE, "agent");
            asm volatile("s_waitcnt vmcnt(0)" ::: "memory");
        }
    }
    __syncthreads();
}

constexpr int LDS_XB = DSA_LDS;
constexpr int LDS_BYTES = DSA_LDS + 256;
static_assert(pg8::STAGE_BYTES <= LDS_XB && pg8::STAGE_BYTES + 1024 <= LDS_XB && NWAVES * 64 * 33 * 4 <= LDS_XB && NWAVES * 32 * SB_VROW <= LDS_XB && 4 * 37 * 128 * 4 <= LDS_XB, "LDS map");

__global__ void __launch_bounds__(NTHREADS, 2) mega(Params p) {
    extern __shared__ __attribute__((aligned(16))) char lds[];
    const int lo = p.ph_lo, hi = p.ph_hi;
    unsigned char* ws = p.ws;
    XcdBarrier xb;
    {
        volatile LAS unsigned* st = (volatile LAS unsigned*)(lds + LDS_XB);
        if (threadIdx.x < 4) st[threadIdx.x] = 0u;
        __syncthreads();
        xb = xcd_barrier_post((unsigned*)(ws + WS_CTL) + CW_BAR, st);
    }
#define IN(k) (lo <= (k) && (k) < hi)
#define GSYNC() xcd_barrier(xb)
#define SEAM(k) do { if (IN(k) && IN((k) + 1)) GSYNC(); } while (0)
#define REP(k, ...) do { if (IN(k)) { __VA_ARGS__; } } while (0)
    LAS unsigned char* ldsl = (LAS unsigned char*)lds;
    REP(0, phase_prologue(p, lds));
    SEAM(0);
    REP(1, { phase_inproj_meta(p);
             pg8::TokRowOrder S; S.init(NR, PWN, gridDim.x, blockIdx.x); S.Abase = (const char*)(ws + WS_U); S.Bbase = (const char*)(ws + WS_WP); S.K = D;
             pg8::EpiInproj E{(bf16_t*)(ws + WS_P), (const float2*)(ws + WS_CS), ws + WS_KIP}; pg8::gemm_phase_x<pg8::EpiInproj, pg8::TokRowOrder, true, true>(ldsl, D, S, E); });
    SEAM(1);
    if (IN(2)) {
        phase_dsa(p, lds);
        __syncthreads(); phase_sb_fast(p, lds);
    }
    SEAM(2);
    REP(3, { pg8::TokRowOrder S; S.init(NR, 2048, gridDim.x, blockIdx.x); S.Abase = (const char*)(ws + WS_U); S.Bbase = (const char*)(ws + WS_WG); S.K = D;
             pg8::EpiGate E{(bf16_t*)(ws + WS_G)}; pg8::gemm_phase_x<pg8::EpiGate, pg8::TokRowOrder, true, true>(ldsl, D, S, E); });
    SEAM(3);
    REP(4, { { pg8::Gemm g{(const bf16_t*)(ws + WS_YA), (const bf16_t*)(ws + WS_WUA), NR, D, 512}; pg8::StaticOrder S; S.init(NR, D, gridDim.x, blockIdx.x);
               pg8::EpiZ<false> E{(bf16_t*)(ws + WS_Z), (const bf16_t*)(ws + WS_G), 0}; pg8::gemm_phase<pg8::EpiZ<false>, pg8::StaticOrder, true, true>(ldsl, g, S, E); }
             asm volatile("s_waitcnt vmcnt(0)" ::: "memory"); __syncthreads();
             { pg8::Gemm g{(const bf16_t*)(ws + WS_OLAT), (const bf16_t*)(ws + WS_WBP), NR, D, D}; pg8::StaticOrder S; S.init(NR, D, gridDim.x, blockIdx.x);
               pg8::EpiZ<true> E{(bf16_t*)(ws + WS_Z), (const bf16_t*)(ws + WS_G), 1024}; pg8::gemm_phase<pg8::EpiZ<true>, pg8::StaticOrder, true, true>(ldsl, g, S, E); } });
    SEAM(4);
    REP(5, { pg8::Gemm g{(const bf16_t*)(ws + WS_Z), (const bf16_t*)(ws + WS_WO), NR, D, D}; pg8::StaticOrder S; S.init(NR, D, gridDim.x, blockIdx.x);
             pg8::EpiH1 E{(float*)(ws + WS_H1), p.in[I_META], p.in[I_X]}; pg8::gemm_phase<pg8::EpiH1, pg8::StaticOrder, true, true>(ldsl, g, S, E); });
    SEAM(5);
    if (IN(6)) phase_c3(p, lds);
    SEAM(6);
    REP(7, phase_moe<0>(p, lds));
    SEAM(7);
    REP(8, phase_moe<1>(p, lds));
    SEAM(8);
    REP(9, phase_final(p));
}

extern "C" void kernel_launch(void* const* d_in, const int* in_sizes, int n_in, void* d_out, int out_size, void* d_ws, size_t ws_size, hipStream_t stream) {
    if (n_in != 18 || ws_size < WS_END) { fprintf(stderr, "kernel_launch: unexpected n_in %d / ws_size %zu\n", n_in, ws_size); return; }
    static int grid = 0;
    if (grid == 0) {
        int dev = 0, cus = 0, per_cu = 0;
        (void)hipGetDevice(&dev);
        (void)hipDeviceGetAttribute(&cus, hipDeviceAttributeMultiprocessorCount, dev);
        (void)hipFuncSetAttribute((const void*)mega, hipFuncAttributeMaxDynamicSharedMemorySize, LDS_BYTES);
        (void)hipOccupancyMaxActiveBlocksPerMultiprocessor(&per_cu, (const void*)mega, NTHREADS, LDS_BYTES);
        if (per_cu < 1) fprintf(stderr, "kernel_launch: occupancy query reports %d workgroups per CU\n", per_cu);
        grid = cus;
    }
    (void)hipMemsetAsync((char*)d_ws + WS_CTL, 0, CTL_BYTES, stream);
    Params p{};
    for (int i = 0; i < 18; ++i) p.in[i] = (const float*)d_in[i];
    p.out = (float*)d_out; p.ws = (unsigned char*)d_ws;
    p.ph_lo = 0; p.ph_hi = 10;
    void* args[] = {&p};
    hipError_t e = hipLaunchCooperativeKernel((const void*)mega, dim3(grid), dim3(NTHREADS), args, LDS_BYTES, stream);
    if (e != hipSuccess) fprintf(stderr, "cooperative launch failed: %s (grid %d)\n", hipGetErrorString(e), grid);
}
```

```cpp
#include <hip/hip_runtime.h>
#include <cstdio>
#include <cstdint>

constexpr int BATCH = 8, SEQ = 4096, NMETA = 16, T = SEQ + NMETA, D = 1024, NTOK = BATCH * T;
constexpr int MROWS = 33024;
constexpr int NR = BATCH * SEQ;
__device__ __forceinline__ int tokrow(int cr) { return cr + NMETA * (cr / SEQ + 1); }
constexpr int INW = 4824;
constexpr int NEXP = 32, DEXP = 512;
constexpr int NWAVES = 8, NTHREADS = 512;
constexpr float NORM_EPS = 1e-6f;
constexpr float LOG2E = 1.4426950408889634f;
constexpr float QSCALE = 0.125f * LOG2E;
constexpr int PW = 3456, PWN = 3584;
constexpr int C_QA = 0, C_KA = 512, C_VA = 1024, C_QF = 1536, C_KV = 2688, C_QI = 2832, C_KI = 3344, C_WI = 3408, C_END = 3416;
constexpr int QFW = 144;

constexpr size_t MiB = 1u << 20;
constexpr size_t WS_CTL = 0, CTL_BYTES = 1 * MiB;
constexpr size_t WS_CS = 1 * MiB;
constexpr size_t WS_WRT = 1 * MiB + 512 * 1024;
constexpr int WRT_N = 48;
constexpr size_t WS_WP = 2 * MiB;
constexpr size_t WS_WG = 9 * MiB;
constexpr size_t WS_WUA = 13 * MiB, WS_WBP = 14 * MiB, WS_WO = 16 * MiB;
constexpr size_t WS_W2 = 18 * MiB;
constexpr size_t WS_W13 = 50 * MiB;
constexpr size_t WS_U = 114 * MiB;
constexpr size_t WS_P = 179 * MiB;
constexpr size_t WS_Z = 179 * MiB;
constexpr size_t WS_G = 244 * MiB;
constexpr size_t WS_H1 = 244 * MiB;
constexpr size_t WS_LIST = 374 * MiB;
constexpr size_t WS_GATE = 379 * MiB;
constexpr size_t WS_RSTD2 = 380 * MiB;
constexpr size_t WS_YA = 397 * MiB;
constexpr size_t WS_OLAT = 430 * MiB;
constexpr size_t WS_HID = 397 * MiB;
constexpr size_t WS_MO = 50 * MiB;
constexpr size_t WS_KIP = 495 * MiB;
constexpr size_t KIP_BATCH = 129 * 4096;
constexpr size_t WS_END = 500 * MiB;
static_assert(WS_P + (size_t)MROWS * PW * 2 <= WS_YA && WS_G + (size_t)MROWS * 2048 * 2 <= WS_LIST && WS_Z + (size_t)MROWS * 1024 * 2 <= WS_G, "ws map");
static_assert(WS_OLAT + (size_t)MROWS * 1024 * 2 <= WS_END && WS_U + (size_t)MROWS * 1024 * 2 <= WS_P && WS_MO + (size_t)NTOK * 2048 * 2 <= WS_P, "ws map");
constexpr int CW_CNT = 1024;
constexpr int CW_BAR = 4096;

typedef unsigned short bf16_t;
typedef short bf16x8 __attribute__((ext_vector_type(8)));
typedef float f32x4 __attribute__((ext_vector_type(4)));
typedef float f32x16 __attribute__((ext_vector_type(16)));
typedef unsigned u32x2 __attribute__((ext_vector_type(2)));
typedef unsigned u32x4 __attribute__((ext_vector_type(4)));
typedef unsigned short u16x4 __attribute__((ext_vector_type(4)));
#define LAS __attribute__((address_space(3)))

__device__ __forceinline__ unsigned f2bf(float f) { unsigned u = __float_as_uint(f); return (u + 0x7fffu + ((u >> 16) & 1u)) >> 16; }
typedef __bf16 bf16v2_t __attribute__((ext_vector_type(2)));
typedef float f32v2_t __attribute__((ext_vector_type(2)));
__device__ __forceinline__ unsigned pk2(float lo, float hi) { const f32v2_t v = {lo, hi}; const bf16v2_t r = __builtin_convertvector(v, bf16v2_t); return __builtin_bit_cast(unsigned, r); }
__device__ __forceinline__ float bflo(unsigned w) { return __uint_as_float(w << 16); }
__device__ __forceinline__ float bfhi(unsigned w) { return __uint_as_float(w & 0xffff0000u); }
__device__ __forceinline__ float bf2f(bf16_t b) { return __uint_as_float((unsigned)b << 16); }
__device__ __forceinline__ float wave_sum(float v) {
#pragma unroll
    for (int o = 1; o < 64; o <<= 1) v += __shfl_xor(v, o);
    return v;
}
__device__ __forceinline__ float fmax2(float a, float b) { return __builtin_amdgcn_fmed3f(a, b, 3.0e38f); }
__device__ __forceinline__ float xsum32(float x) { const auto r = __builtin_amdgcn_permlane32_swap(__float_as_uint(x), __float_as_uint(x), false, false); return __uint_as_float(r[0]) + __uint_as_float(r[1]); }
__device__ __forceinline__ float xsum16(float x) { const auto r = __builtin_amdgcn_permlane16_swap(__float_as_uint(x), __float_as_uint(x), false, false); return __uint_as_float(r[0]) + __uint_as_float(r[1]); }
__device__ __forceinline__ float xmax32(float x) { const auto r = __builtin_amdgcn_permlane32_swap(__float_as_uint(x), __float_as_uint(x), false, false); return fmax2(__uint_as_float(r[0]), __uint_as_float(r[1])); }
__device__ __forceinline__ float xmax16(float x) { const auto r = __builtin_amdgcn_permlane16_swap(__float_as_uint(x), __float_as_uint(x), false, false); return fmax2(__uint_as_float(r[0]), __uint_as_float(r[1])); }
__device__ __forceinline__ float xpartner32(float x, int hh) { const auto r = __builtin_amdgcn_permlane32_swap(__float_as_uint(x), __float_as_uint(x), false, false); return __uint_as_float(hh ? r[0] : r[1]); }
__device__ __forceinline__ float fexp2(float x) { return __builtin_amdgcn_exp2f(x); }
__device__ __forceinline__ float sigmoidf(float x) { return __builtin_amdgcn_rcpf(1.0f + fexp2(-LOG2E * x)); }

struct Params {
    const float* in[18];
    float* out;
    unsigned char* ws;
    int ph_lo, ph_hi;
};
enum { I_X = 0, I_META, I_GMIX, I_WIN, I_WUK, I_WUV, I_WUPA, I_WUPB, I_WO, I_GFFN, I_WGRP, I_BGRP, I_WRT, I_BRT, I_W1, I_W3, I_W2, I_GFIN };

__device__ __forceinline__ const float* h0_row(const Params& p, int row) {
    const int b = row / T, t = row - b * T;
    return t < NMETA ? p.in[I_META] + (size_t)t * D : p.in[I_X] + ((size_t)b * SEQ + (t - NMETA)) * D;
}
template <class F>
__device__ __forceinline__ void tr_item(F val, bf16_t* dst, int ldd, int row0, int k0, float* scr, int lane, int rstep = 1) {
    float tv[32];
#pragma unroll
    for (int i = 0; i < 32; ++i) tv[i] = val(k0 + 2 * i + (lane >> 5), lane & 31);
#pragma unroll
    for (int i = 0; i < 32; ++i) scr[(2 * i + (lane >> 5)) * 33 + (lane & 31)] = tv[i];
    __builtin_amdgcn_s_waitcnt(0xC07F);
    asm volatile("" ::: "memory");
    const int c = lane & 7;
#pragma unroll
    for (int j = 0; j < 4; ++j) {
        const int n = (lane >> 3) + 8 * j; const float* s = scr + (8 * c) * 33 + n;
        u32x4 o; o.x = pk2(s[0], s[33]); o.y = pk2(s[66], s[99]); o.z = pk2(s[132], s[165]); o.w = pk2(s[198], s[231]);
        *(u32x4*)(dst + (size_t)(row0 + n * rstep) * ldd + k0 + 8 * c) = o;
    }
    __builtin_amdgcn_s_waitcnt(0xC07F);
    asm volatile("" ::: "memory");
}

__device__ __forceinline__ void wp_src(int c, int& kind, int& col, int& aux, float& scale) {
    kind = 1; aux = 0; scale = 1.f; col = 0;
    if (c < 512) { col = c; scale = QSCALE; }
    else if (c < C_QF) { col = c; }
    else if (c < C_KV) { const int r = c - C_QF, h = r / QFW, j = r % QFW; scale = QSCALE;
        if (j < 128) { kind = 2; col = h; aux = j; } else { const int i = j - 128; col = 1536 + 64 * h + (i >> 1) + 8 * (i & 1); } }
    else if (c < C_QI) { const int j = c - C_KV; if (j < 128) col = 2048 + j; else { const int i = j - 128; col = 2176 + (i >> 1) + 8 * (i & 1); } }
    else if (c < C_KI) { const int r = c - C_QI, h = r >> 6, j = r & 63; col = 2192 + 64 * h + (j < 16 ? (j >> 1) + 8 * (j & 1) : j); }
    else if (c < C_WI) { const int j = c - C_KI; col = 2704 + (j < 16 ? (j >> 1) + 8 * (j & 1) : j); }
    else if (c < C_END) { col = 2768 + (c - C_WI); }
    else kind = 0;
}

constexpr int IT_WP = (PWN / 32) * 16;
constexpr int IT_WG = 32 * 16;
constexpr int IT_WUA = 32 * 8;
constexpr int IT_WBP = 32 * 16, IT_WO = 32 * 16;
constexpr int IT_W13 = NEXP * 32 * 16;
constexpr int IT_W2 = NEXP * 32 * 8;
constexpr int IT_TOTAL = IT_WP + 2 * IT_WG + IT_WUA + IT_WBP + IT_WO + IT_W13 + IT_W2;

__device__ __forceinline__ void phase_prologue(const Params& p, char* lds) {
    const int tid = threadIdx.x, lane = tid & 63, wave = tid >> 6;
    const int gw = blockIdx.x * NWAVES + wave, NGW = gridDim.x * NWAVES;
    float* scr = (float*)lds + wave * (64 * 33);
    unsigned char* ws = p.ws;
    const float* w_in = p.in[I_WIN];
    {
        float2* cs = (float2*)(ws + WS_CS);
        for (int i = blockIdx.x * NTHREADS + tid; i < T * 8; i += gridDim.x * NTHREADS) {
            const int pos = i >> 3, f = i & 7;
            const float inv = powf(500000.0f, -(float)f / 8.0f);
            const float ang = (float)pos * inv;
            cs[i] = make_float2(cosf(ang), sinf(ang));
        }
    }
    {
        bf16_t* wrt = (bf16_t*)(ws + WS_WRT); const float* wgp = p.in[I_WGRP]; const float* wrp = p.in[I_WRT];
        for (int i = blockIdx.x * NTHREADS + tid; i < WRT_N * D; i += gridDim.x * NTHREADS) {
            const int nn = i >> 10, k = i & 1023;
            const float w = nn < 4 ? wgp[k * 4 + nn] : nn < 36 ? wrp[k * 32 + (nn - 4)] : 0.f;
            const unsigned hi = f2bf(w); wrt[i] = (bf16_t)hi; wrt[WRT_N * D + i] = (bf16_t)f2bf(w - __uint_as_float(hi << 16));
        }
    }
    for (int it = gw; it < IT_TOTAL; it += NGW) {
        int r = it;
        if (r < IT_WP) {
            const int rg = r / 16, kb = r % 16, c = rg * 32 + (lane & 31);
            int kind, col, aux; float scale; wp_src(c, kind, col, aux, scale);
            const float* w_uk = p.in[I_WUK];
            float wu[48];
#pragma unroll
            for (int n4 = 0; n4 < 12; ++n4) { f32x4 t = (f32x4){0.f, 0.f, 0.f, 0.f}; if (kind == 2) t = *(const f32x4*)(w_uk + ((size_t)col * 128 + aux) * 48 + 4 * n4); wu[4 * n4] = t.x; wu[4 * n4 + 1] = t.y; wu[4 * n4 + 2] = t.z; wu[4 * n4 + 3] = t.w; }
            tr_item([&](int k, int) -> float {
                if (kind == 0) return 0.f;
                if (kind == 1) return scale * w_in[(size_t)k * INW + col];
                const f32x4* wi = (const f32x4*)(w_in + (size_t)k * INW + 1536 + 64 * col + 16);
                float s = 0.f;
#pragma unroll
                for (int n4 = 0; n4 < 12; ++n4) { const f32x4 t = wi[n4]; s += t.x * wu[4 * n4] + t.y * wu[4 * n4 + 1] + t.z * wu[4 * n4 + 2] + t.w * wu[4 * n4 + 3]; }
                return scale * s; }, (bf16_t*)(ws + WS_WP), 1024, rg * 32, kb * 64, scr, lane);
            continue; }
        r -= IT_WP;
        if (r < 2 * IT_WG) {
            const int which = r / IT_WG; r %= IT_WG; const int rg = r / 16, kb = r % 16; const int col0 = (which ? 3800 : 2776) + rg * 32;
            tr_item([&](int k, int n) -> float { return w_in[(size_t)k * INW + col0 + n]; }, (bf16_t*)(ws + WS_WG) + (size_t)which * 1024 * 1024, 1024, rg * 32, kb * 64, scr, lane);
            continue; }
        r -= 2 * IT_WG;
        if (r < IT_WUA) {
            const int rg = r / 8, kb = r % 8; const float* w = p.in[I_WUPA];
            tr_item([&](int k, int n) -> float { return w[(size_t)k * 1024 + rg * 32 + n]; }, (bf16_t*)(ws + WS_WUA), 512, rg * 32, kb * 64, scr, lane);
            continue; }
        r -= IT_WUA;
        if (r < IT_WBP) {
            const int rg = r / 16, kb = r % 16; const float* wuv = p.in[I_WUV]; const float* wub = p.in[I_WUPB];
            const int hB = kb >> 1;
            float bc[64];
#pragma unroll
            for (int d = 0; d < 64; ++d) bc[d] = wub[(size_t)(64 * hB + d) * 1024 + rg * 32 + (lane & 31)];
            tr_item([&](int kk, int) -> float {
                const f32x4* a = (const f32x4*)(wuv + (size_t)kk * 64);
                float s = 0.f;
#pragma unroll
                for (int d4 = 0; d4 < 16; ++d4) { const f32x4 t = a[d4]; s += t.x * bc[4 * d4] + t.y * bc[4 * d4 + 1] + t.z * bc[4 * d4 + 2] + t.w * bc[4 * d4 + 3]; }
                return s; }, (bf16_t*)(ws + WS_WBP), 1024, rg * 32, kb * 64, scr, lane);
            continue; }
        r -= IT_WBP;
        if (r < IT_WO) {
            const int rg = r / 16, kb = r % 16; const float* w = p.in[I_WO];
            tr_item([&](int k, int n) -> float { return w[(size_t)k * 1024 + rg * 32 + n]; }, (bf16_t*)(ws + WS_WO), 1024, rg * 32, kb * 64, scr, lane);
            continue; }
        r -= IT_WO;
        if (r < IT_W13) {
            const int e = r / 512; r %= 512; const int which = r & 1, cg = (r >> 1) & 15, kb = r >> 5;
            const float* w = (which ? p.in[I_W3] : p.in[I_W1]) + (size_t)e * 1024 * 512 + cg * 32;
            tr_item([&](int k, int n) -> float { return w[(size_t)k * 512 + n]; },
                    (bf16_t*)(ws + WS_W13) + (size_t)e * 1024 * 1024, 1024, 2 * cg * 32 + which, kb * 64, scr, lane, 2);
            continue; }
        r -= IT_W13;
        {
            const int e = r / 256; r %= 256; const int rg = r / 8, kb = r % 8;
            const float* w2 = p.in[I_W2] + (size_t)e * 512 * 1024;
            tr_item([&](int k, int n) -> float { return w2[(size_t)k * 1024 + rg * 32 + n]; }, (bf16_t*)(ws + WS_W2) + (size_t)e * 1024 * 512, 512, rg * 32, kb * 64, scr, lane);
        }
    }
    {
        const float* g = p.in[I_GMIX]; bf16_t* U = (bf16_t*)(ws + WS_U);
        for (int row = gw; row < NTOK; row += NGW) {
            const f32x4* xr = (const f32x4*)h0_row(p, row) + lane;
            f32x4 v[4]; float s = 0.f;
#pragma unroll
            for (int j = 0; j < 4; ++j) { v[j] = xr[64 * j]; s += (v[j].x * v[j].x + v[j].y * v[j].y) + (v[j].z * v[j].z + v[j].w * v[j].w); }
            const float rstd = rsqrtf(wave_sum(s) * (1.f / D) + NORM_EPS);
            u32x2* o = (u32x2*)(U + (size_t)row * D) + lane;
#pragma unroll
            for (int j = 0; j < 4; ++j) { const f32x4 gg = ((const f32x4*)g)[lane + 64 * j];
                u32x2 w; w.x = pk2(v[j].x * rstd * gg.x, v[j].y * rstd * gg.y); w.y = pk2(v[j].z * rstd * gg.z, v[j].w * rstd * gg.w); o[64 * j] = w; }
        }
    }
}

namespace pg8 {
#define PG8_LAS __attribute__((address_space(3)))
typedef unsigned short bf16_t;
typedef short bf16x8 __attribute__((ext_vector_type(8)));
typedef float f32x4 __attribute__((ext_vector_type(4)));
typedef unsigned u32x4 __attribute__((ext_vector_type(4)));
constexpr int BM = 256, BK = 64, HALF = 128, HTB = HALF * BK * 2  , STAGE_BYTES = 8 * HTB, NXCD = 8, WGM = 8;

__host__ __device__ __forceinline__ int lds_byte(int r, int c) { const int st = (r >> 4) * 2 + (c >> 5), rr = r & 15, cc = c & 31, ob = rr * 64 + cc * 2; return st * 1024 + (ob ^ (((ob >> 9) & 1) << 5)); }
__host__ __device__ __forceinline__ void stage_rc(int b, int& R, int& C) { const int st = b / 1024, sb = b % 1024, swz = sb ^ (((sb >> 9) & 1) << 5); R = (st >> 1) * 16 + swz / 64; C = (st & 1) * 32 + (swz % 64) / 2; }
__host__ __device__ __forceinline__ int perm32(int rho) { const int n = rho >> 4, i = rho & 15; return 8 * (i >> 2) + 4 * n + (i & 3); }

struct Unit { int pm, pn; };
struct Gemm { const bf16_t* A; const bf16_t* Bt; int M, N, K; };

struct StaticOrder {
    int nM, nN, nwg, G, c;
    __host__ __device__ void init(int M, int N, int G_, int c_) { nM = M / BM; nN = N / BM; nwg = nM * nN; G = G_; c = c_; }
    __host__ __device__ bool next(int i, Unit& u) const {
        const long L = (long)i * G + c; if (L >= nwg) return false;
        int wgid = (int)L; { const int q = nwg / NXCD, r = nwg % NXCD, xcd = wgid % NXCD, off = wgid / NXCD; wgid = (xcd < r ? xcd * (q + 1) : r * (q + 1) + (xcd - r) * q) + off; }
        const int nig = WGM * nN, gid = wgid / nig, fm = gid * WGM, gsz = (nM - fm) < WGM ? (nM - fm) : WGM;
        u.pm = fm + ((wgid % nig) % gsz); u.pn = (wgid % nig) / gsz; return true;
    }
    __device__ __forceinline__ void a_ready(const Unit&) const {}
    __device__ __forceinline__ void done(const Unit&) const {}
};


#define PG8_FOR_FRAGS(...) _Pragma("unroll") for (int ai = 0; ai < 2; ++ai) _Pragma("unroll") for (int m = 0; m < 4; ++m) { const int row = u.pm * BM + ai * HALF + wr * 64 + m * 16 + fr; \
    _Pragma("unroll") for (int bj = 0; bj < 2; ++bj) _Pragma("unroll") for (int n = 0; n < 2; ++n) { const int col = u.pn * BM + bj * HALF + wc * 32 + n * 16 + 4 * fq; ::f32x4 v = acc[ai][bj][m][n]; __VA_ARGS__ } }
__device__ __forceinline__ bool rope_off(int c, int& o) {
    if (c < C_QF) return false;
    if (c < C_KV) { const int j = (c - C_QF) % QFW; o = j - 128; return j >= 128; }
    if (c < C_QI) { const int j = c - C_KV; o = j - 128; return j >= 128; }
    if (c < C_KI) { const int j = (c - C_QI) & 63; o = j; return j < 16; }
    if (c < C_WI) { const int j = c - C_KI; o = j; return j < 16; }
    return false;
}
#define PG8_FOR_FRAGS8(...) _Pragma("unroll") for (int ai = 0; ai < 2; ++ai) _Pragma("unroll") for (int m = 0; m < 4; ++m) { const int row = u.pm * BM + ai * HALF + wr * 64 + m * 16 + fr; \
    _Pragma("unroll") for (int bj = 0; bj < 2; ++bj) { const int col = u.pn * BM + bj * HALF + wc * 32 + 8 * fq; ::f32x4 v0 = acc[ai][bj][m][0], v1 = acc[ai][bj][m][1]; __VA_ARGS__ } }
struct EpiInproj {
    static constexpr bool PERM = true, AFTER_DRAIN = false;
    bf16_t* P; const float2* cs; unsigned char* KIP;
    __device__ __forceinline__ void operator()(const f32x4 (&acc)[2][2][4][2], const Unit& u, int wr, int wc, int fr, int fq) const {
        PG8_FOR_FRAGS8(
            if (col < PW) {
                int o; const int trow = tokrow(row);
                if (rope_off(col, o)) {
                    const int pos = (row % SEQ) + NMETA; const float2* cp = cs + pos * 8 + (o >> 1); const float2 c0 = cp[0], c1 = cp[1], c2 = cp[2], c3 = cp[3];
                    v0 = (::f32x4){v0.x * c0.x - v0.y * c0.y, v0.y * c0.x + v0.x * c0.y, v0.z * c1.x - v0.w * c1.y, v0.w * c1.x + v0.z * c1.y};
                    v1 = (::f32x4){v1.x * c2.x - v1.y * c2.y, v1.y * c2.x + v1.x * c2.y, v1.z * c3.x - v1.w * c3.y, v1.w * c3.x + v1.z * c3.y};
                }
                ::u32x4 w; w.x = pk2(v0.x, v0.y); w.y = pk2(v0.z, v0.w); w.z = pk2(v1.x, v1.y); w.w = pk2(v1.z, v1.w);
                if (col >= C_KI && col < C_WI) {
                    const int b = row / SEQ, t = row - b * SEQ + NMETA, d0 = col - C_KI;
                    *(::u32x4*)(KIP + (size_t)b * KIP_BATCH + (size_t)((((t >> 5) * 4 + (d0 >> 4)) * 2 + ((d0 >> 3) & 1)) * 512 + (t & 31) * 16)) = w;
                } else *(::u32x4*)(P + (size_t)trow * PW + col) = w;
            })
    }
};
struct EpiGate {
    static constexpr bool PERM = true, AFTER_DRAIN = false;
    bf16_t* G;
    __device__ __forceinline__ void operator()(const f32x4 (&acc)[2][2][4][2], const Unit& u, int wr, int wc, int fr, int fq) const {
        PG8_FOR_FRAGS8( ::u32x4 w; w.x = pk2(sigmoidf(v0.x), sigmoidf(v0.y)); w.y = pk2(sigmoidf(v0.z), sigmoidf(v0.w)); w.z = pk2(sigmoidf(v1.x), sigmoidf(v1.y)); w.w = pk2(sigmoidf(v1.z), sigmoidf(v1.w));
            *(::u32x4*)(G + (size_t)row * 2048 + col) = w; )
    }
};
template <bool ACCUM> struct EpiZ {
    static constexpr bool PERM = true, AFTER_DRAIN = false;
    bf16_t* Z; const bf16_t* G; int goff;
    __device__ __forceinline__ void operator()(const f32x4 (&acc)[2][2][4][2], const Unit& u, int wr, int wc, int fr, int fq) const {
        PG8_FOR_FRAGS8(
            const ::u32x4 g = *(const ::u32x4*)(G + (size_t)row * 2048 + goff + col);
            ::f32x4 z0 = (::f32x4){bflo(g.x) * v0.x, bfhi(g.x) * v0.y, bflo(g.y) * v0.z, bfhi(g.y) * v0.w}, z1 = (::f32x4){bflo(g.z) * v1.x, bfhi(g.z) * v1.y, bflo(g.w) * v1.z, bfhi(g.w) * v1.w};
            ::u32x4* zp = (::u32x4*)(Z + (size_t)row * D + col);
            if (ACCUM) { const ::u32x4 o = *zp; z0.x += bflo(o.x); z0.y += bfhi(o.x); z0.z += bflo(o.y); z0.w += bfhi(o.y); z1.x += bflo(o.z); z1.y += bfhi(o.z); z1.z += bflo(o.w); z1.w += bfhi(o.w); }
            ::u32x4 w; w.x = pk2(z0.x, z0.y); w.y = pk2(z0.z, z0.w); w.z = pk2(z1.x, z1.y); w.w = pk2(z1.z, z1.w); *zp = w; )
    }
};
struct EpiH1 {
    static constexpr bool PERM = true, AFTER_DRAIN = false;
    float* H1; const float* meta; const float* x;
    __device__ __forceinline__ void operator()(const f32x4 (&acc)[2][2][4][2], const Unit& u, int wr, int wc, int fr, int fq) const {
        PG8_FOR_FRAGS8( const float* xp = x + (size_t)row * D + col; float* hp = H1 + (size_t)row * D + col; const ::f32x4 h0 = *(const ::f32x4*)xp, h1 = *(const ::f32x4*)(xp + 4);
            *(::f32x4*)hp = h0 + v0; *(::f32x4*)(hp + 4) = h1 + v1; )
    }
};
#undef PG8_FOR_FRAGS
#undef PG8_FOR_FRAGS8

template <class Epi, class Sched, bool ALIGN_EPI = false, bool SP2 = false>
__device__ __forceinline__ void gemm_phase(PG8_LAS unsigned char* lds, const Gemm g, const Sched& S, const Epi& E) {
    const int tid = threadIdx.x, wid = __builtin_amdgcn_readfirstlane(tid >> 6), lane = tid & 63, wr = wid >> 2, wc = wid & 3, fr = lane & 15, fq = lane >> 4;
    const int K = g.K, nt = K / BK;
    unsigned voffA[2], voffB[2];
#pragma unroll
    for (int i = 0; i < 2; ++i) { int R, C; stage_rc(tid * 16 + i * 8192, R, C); const int Rb = Epi::PERM ? ((R & ~31) + perm32(R & 31)) : R;
        voffA[i] = (unsigned)(R * K + C) * 2u; voffB[i] = (unsigned)(Rb * K + C) * 2u; }
    const size_t kstep = (size_t)(BK * 2);
    const size_t hstep = (size_t)HALF * K * 2;
    const size_t tstep = 2 * hstep;
    const unsigned ldsw = (unsigned)wid * 1024u;
    const int aoff = lds_byte(wr * 64 + fr, fq * 8), boff = lds_byte(wc * 32 + fr, fq * 8);
#define PG8_SA(b, h) (((b) * 2 + (h)) * HTB)
#define PG8_SB(b, h) ((4 + (b) * 2 + (h)) * HTB)
#define PG8_STAGE(bufoff, gbase, voff) do { _Pragma("unroll") for (int _i = 0; _i < 2; ++_i) \
        __builtin_amdgcn_global_load_lds((const unsigned*)((const char*)(gbase) + (voff)[_i]), (PG8_LAS unsigned*)(lds + (bufoff) + ldsw + _i * 8192), 16, 0, 0); } while (0)
#define PG8_LDA(dst, b, h) do { _Pragma("unroll") for (int m = 0; m < 4; ++m) _Pragma("unroll") for (int k = 0; k < 2; ++k) dst[m][k] = *(const PG8_LAS bf16x8*)(lds + PG8_SA(b, h) + aoff + m * 2048 + k * 1024); } while (0)
#define PG8_LDB(dst, b, h) do { _Pragma("unroll") for (int n = 0; n < 2; ++n) _Pragma("unroll") for (int k = 0; k < 2; ++k) dst[n][k] = *(const PG8_LAS bf16x8*)(lds + PG8_SB(b, h) + boff + n * 2048 + k * 1024); } while (0)
#define PG8_MMA(ai, bj, At, Bt) do { __builtin_amdgcn_s_setprio(1); _Pragma("unroll") for (int m = 0; m < 4; ++m) _Pragma("unroll") for (int n = 0; n < 2; ++n) _Pragma("unroll") for (int k = 0; k < 2; ++k) \
        acc[ai][bj][m][n] = __builtin_amdgcn_mfma_f32_16x16x32_bf16(Bt[n][k], At[m][k], acc[ai][bj][m][n], 0, 0, 0); __builtin_amdgcn_s_setprio(0); } while (0)
#define PG8_WAIT_V(n) asm volatile("s_waitcnt vmcnt(" #n ")" ::: "memory")
#define PG8_WAIT_L(n) asm volatile("s_waitcnt lgkmcnt(" #n ")" ::: "memory")
#define PG8_BAR __builtin_amdgcn_s_barrier()
#define PG8_SCHED __builtin_amdgcn_sched_barrier(0)
    Unit cur, nxt; int ui = 0;
    if (!S.next(0, cur)) return;
    f32x4 acc[2][2][4][2];
#pragma unroll
    for (int a = 0; a < 2; ++a)
#pragma unroll
        for (int b = 0; b < 2; ++b)
#pragma unroll
            for (int m = 0; m < 4; ++m)
#pragma unroll
                for (int n = 0; n < 2; ++n) acc[a][b][m][n] = (f32x4){0.f, 0.f, 0.f, 0.f};
    bf16x8 At[4][2], B0[2][2], B1[2][2];
    const char* cA = (const char*)g.A + (size_t)cur.pm * tstep; const char* cB = (const char*)g.Bt + (size_t)cur.pn * tstep;
    S.a_ready(cur);
    if constexpr (SP2) {
        PG8_STAGE(PG8_SB(0, 0), cB, voffB); PG8_STAGE(PG8_SB(0, 1), cB + hstep, voffB); PG8_STAGE(PG8_SA(0, 0), cA, voffA); PG8_STAGE(PG8_SA(0, 1), cA + hstep, voffA);
        if (wr == 1) PG8_BAR;
        PG8_WAIT_V(2); PG8_BAR;
        PG8_STAGE(PG8_SB(1, 0), cB + kstep, voffB); PG8_STAGE(PG8_SA(1, 0), cA + kstep, voffA); PG8_STAGE(PG8_SB(1, 1), cB + hstep + kstep, voffB);
        PG8_WAIT_V(6); PG8_BAR;
    } else {
        PG8_STAGE(PG8_SB(0, 0), cB, voffB); PG8_STAGE(PG8_SA(0, 0), cA, voffA); PG8_STAGE(PG8_SB(0, 1), cB + hstep, voffB); PG8_STAGE(PG8_SA(0, 1), cA + hstep, voffA);
        if (wr == 1) PG8_BAR;
        PG8_WAIT_V(4); PG8_BAR;
        PG8_STAGE(PG8_SB(1, 0), cB + kstep, voffB); PG8_STAGE(PG8_SA(1, 0), cA + kstep, voffA); PG8_STAGE(PG8_SB(1, 1), cB + hstep + kstep, voffB);
        PG8_WAIT_V(6); PG8_BAR;
    }
    for (;;) {
        const bool has_next = S.next(ui + 1, nxt);
        const char* nA = has_next ? (const char*)g.A + (size_t)nxt.pm * tstep : cA; const char* nB = has_next ? (const char*)g.Bt + (size_t)nxt.pn * tstep : cB;
        for (int t = 0; t < nt; t += 2) {
            const bool last = (t == nt - 2);
            const char* a1 = cA + (size_t)(t + 1) * kstep;
            const char* a2 = last ? nA : cA + (size_t)(t + 2) * kstep; const char* b2 = last ? nB : cB + (size_t)(t + 2) * kstep;
            const char* a3 = a2 + kstep; const char* b3 = b2 + kstep;
            if (last && has_next) S.a_ready(nxt);
            if constexpr (SP2) {
            PG8_LDB(B0, 0, 0); PG8_LDB(B1, 0, 1); PG8_SCHED; PG8_LDA(At, 0, 0); PG8_STAGE(PG8_SA(1, 1), a1 + hstep, voffA);
            PG8_WAIT_V(8); PG8_WAIT_L(0); PG8_BAR; PG8_MMA(0, 0, At, B0); PG8_MMA(0, 1, At, B1); PG8_BAR; PG8_SCHED;
            PG8_LDA(At, 0, 1); PG8_STAGE(PG8_SB(0, 0), b2, voffB); PG8_STAGE(PG8_SB(0, 1), b2 + hstep, voffB); PG8_STAGE(PG8_SA(0, 0), a2, voffA);
            PG8_WAIT_V(8); PG8_WAIT_L(0); PG8_BAR; PG8_MMA(1, 0, At, B0); PG8_MMA(1, 1, At, B1); PG8_BAR; PG8_SCHED;
            PG8_LDB(B0, 1, 0); PG8_LDB(B1, 1, 1); PG8_SCHED; PG8_LDA(At, 1, 0); PG8_STAGE(PG8_SA(0, 1), a2 + hstep, voffA);
            PG8_WAIT_V(8); PG8_WAIT_L(0); PG8_BAR; PG8_MMA(0, 0, At, B0); PG8_MMA(0, 1, At, B1); PG8_BAR; PG8_SCHED;
            PG8_LDA(At, 1, 1); PG8_STAGE(PG8_SB(1, 0), b3, voffB); PG8_STAGE(PG8_SB(1, 1), b3 + hstep, voffB); PG8_STAGE(PG8_SA(1, 0), a3, voffA);
            PG8_WAIT_V(8); PG8_WAIT_L(0); PG8_BAR; PG8_MMA(1, 0, At, B0); PG8_MMA(1, 1, At, B1); PG8_BAR; PG8_SCHED;
            } else {
            PG8_LDB(B0, 0, 0); PG8_SCHED; PG8_LDA(At, 0, 0); PG8_STAGE(PG8_SA(1, 1), a1 + hstep, voffA);
            PG8_WAIT_L(8); PG8_BAR; PG8_WAIT_L(0); PG8_MMA(0, 0, At, B0); PG8_BAR; PG8_SCHED;
            PG8_LDB(B1, 0, 1); PG8_STAGE(PG8_SB(0, 0), b2, voffB);
            PG8_BAR; PG8_WAIT_L(0); PG8_MMA(0, 1, At, B1); PG8_BAR;
            PG8_LDA(At, 0, 1); PG8_STAGE(PG8_SA(0, 0), a2, voffA);
            PG8_BAR; PG8_WAIT_L(0); PG8_MMA(1, 0, At, B0); PG8_BAR; PG8_SCHED;
            PG8_STAGE(PG8_SB(0, 1), b2 + hstep, voffB);
            PG8_WAIT_V(6); PG8_BAR; PG8_MMA(1, 1, At, B1); PG8_BAR;
            PG8_LDB(B0, 1, 0); PG8_SCHED; PG8_LDA(At, 1, 0); PG8_STAGE(PG8_SA(0, 1), a2 + hstep, voffA);
            PG8_WAIT_L(8); PG8_BAR; PG8_WAIT_L(0); PG8_MMA(0, 0, At, B0); PG8_BAR; PG8_SCHED;
            PG8_LDB(B1, 1, 1); PG8_STAGE(PG8_SB(1, 0), b3, voffB);
            PG8_BAR; PG8_WAIT_L(0); PG8_MMA(0, 1, At, B1); PG8_BAR;
            PG8_LDA(At, 1, 1); PG8_STAGE(PG8_SA(1, 0), a3, voffA);
            PG8_BAR; PG8_WAIT_L(0); PG8_MMA(1, 0, At, B0); PG8_BAR; PG8_SCHED;
            PG8_STAGE(PG8_SB(1, 1), b3 + hstep, voffB);
            PG8_WAIT_V(6); PG8_BAR; PG8_MMA(1, 1, At, B1); PG8_BAR;
            }
        }
        if constexpr (ALIGN_EPI) { if (wr == 0) PG8_BAR; }
        if constexpr (!Epi::AFTER_DRAIN) { E(acc, cur, wr, wc, fr, fq); S.done(cur); }
        if (!has_next) break;
#pragma unroll
        for (int a = 0; a < 2; ++a)
#pragma unroll
            for (int b = 0; b < 2; ++b)
#pragma unroll
                for (int m = 0; m < 4; ++m)
#pragma unroll
                    for (int n = 0; n < 2; ++n) acc[a][b][m][n] = (f32x4){0.f, 0.f, 0.f, 0.f};
        cur = nxt; cA = nA; cB = nB; ++ui;
        if constexpr (ALIGN_EPI) { if (wr == 1) PG8_BAR; }
    }
    PG8_WAIT_V(0);
    if constexpr (!ALIGN_EPI) { if (wr == 0) PG8_BAR; }
    PG8_BAR;
    if constexpr (Epi::AFTER_DRAIN) { E.fused(acc, cur, wr, wc, fr, fq, lds, wid, lane); S.done(cur); }
#undef PG8_SA
#undef PG8_SB
#undef PG8_STAGE
#undef PG8_LDA
#undef PG8_LDB
#undef PG8_MMA
#undef PG8_WAIT_V
#undef PG8_WAIT_L
#undef PG8_BAR
#undef PG8_SCHED
}
template <class Epi, class Sched, bool ALIGN_EPI = false, bool SP2 = false>
__device__ __forceinline__ void gemm_phase_x(PG8_LAS unsigned char* lds, const int K, const Sched& S, const Epi& E) {
    const int tid = threadIdx.x, wid = __builtin_amdgcn_readfirstlane(tid >> 6), lane = tid & 63, wr = wid >> 2, wc = wid & 3, fr = lane & 15, fq = lane >> 4;
    const int nt = K / BK;
    unsigned vcA[2][2], vnA[2][2], voffB[2];
#pragma unroll
    for (int i = 0; i < 2; ++i) { int R, C; stage_rc(tid * 16 + i * 8192, R, C); const int Rb = Epi::PERM ? ((R & ~31) + perm32(R & 31)) : R;
        voffB[i] = (unsigned)(Rb * K + C) * 2u; }
    const size_t kstep = (size_t)(BK * 2);
    const size_t hstep = (size_t)HALF * K * 2;
    const unsigned ldsw = (unsigned)wid * 1024u;
    const int aoff = lds_byte(wr * 64 + fr, fq * 8), boff = lds_byte(wc * 32 + fr, fq * 8);
#define PG8_SA(b, h) (((b) * 2 + (h)) * HTB)
#define PG8_SB(b, h) ((4 + (b) * 2 + (h)) * HTB)
#define PG8_STAGE(bufoff, gbase, voff) do { _Pragma("unroll") for (int _i = 0; _i < 2; ++_i) \
        __builtin_amdgcn_global_load_lds((const unsigned*)((const char*)(gbase) + (voff)[_i]), (PG8_LAS unsigned*)(lds + (bufoff) + ldsw + _i * 8192), 16, 0, 0); } while (0)
#define PG8_STAGEA(bufoff, gbase, V, h) do { _Pragma("unroll") for (int _i = 0; _i < 2; ++_i) \
        __builtin_amdgcn_global_load_lds((const unsigned*)((const char*)(gbase) + (V)[h][_i]), (PG8_LAS unsigned*)(lds + (bufoff) + ldsw + _i * 8192), 16, 0, 0); } while (0)
#define PG8_STAGEA2(bufoff, gbase, h) do { _Pragma("unroll") for (int _i = 0; _i < 2; ++_i) \
        __builtin_amdgcn_global_load_lds((const unsigned*)((const char*)(gbase) + (last ? vnA[h][_i] : vcA[h][_i])), (PG8_LAS unsigned*)(lds + (bufoff) + ldsw + _i * 8192), 16, 0, 0); } while (0)
#define PG8_AOFF(V, u) do { _Pragma("unroll") for (int _h = 0; _h < 2; ++_h) _Pragma("unroll") for (int _i = 0; _i < 2; ++_i) { int R_, C_; stage_rc(tid * 16 + _i * 8192, R_, C_); (V)[_h][_i] = S.a_off(u, _h * HALF + R_, C_); } } while (0)
#define PG8_LDA(dst, b, h) do { _Pragma("unroll") for (int m = 0; m < 4; ++m) _Pragma("unroll") for (int k = 0; k < 2; ++k) dst[m][k] = *(const PG8_LAS bf16x8*)(lds + PG8_SA(b, h) + aoff + m * 2048 + k * 1024); } while (0)
#define PG8_LDB(dst, b, h) do { _Pragma("unroll") for (int n = 0; n < 2; ++n) _Pragma("unroll") for (int k = 0; k < 2; ++k) dst[n][k] = *(const PG8_LAS bf16x8*)(lds + PG8_SB(b, h) + boff + n * 2048 + k * 1024); } while (0)
#define PG8_MMA(ai, bj, At, Bt) do { __builtin_amdgcn_s_setprio(1); _Pragma("unroll") for (int m = 0; m < 4; ++m) _Pragma("unroll") for (int n = 0; n < 2; ++n) _Pragma("unroll") for (int k = 0; k < 2; ++k) \
        acc[ai][bj][m][n] = __builtin_amdgcn_mfma_f32_16x16x32_bf16(Bt[n][k], At[m][k], acc[ai][bj][m][n], 0, 0, 0); __builtin_amdgcn_s_setprio(0); } while (0)
#define PG8_WAIT_V(n) asm volatile("s_waitcnt vmcnt(" #n ")" ::: "memory")
#define PG8_WAIT_L(n) asm volatile("s_waitcnt lgkmcnt(" #n ")" ::: "memory")
#define PG8_BAR __builtin_amdgcn_s_barrier()
#define PG8_SCHED __builtin_amdgcn_sched_barrier(0)
    Unit cur, nxt; int ui = 0;
    if (!S.next(0, cur)) return;
    f32x4 acc[2][2][4][2];
#pragma unroll
    for (int a = 0; a < 2; ++a)
#pragma unroll
        for (int b = 0; b < 2; ++b)
#pragma unroll
            for (int m = 0; m < 4; ++m)
#pragma unroll
                for (int n = 0; n < 2; ++n) acc[a][b][m][n] = (f32x4){0.f, 0.f, 0.f, 0.f};
    bf16x8 At[4][2], B0[2][2], B1[2][2];
    const char* cA = S.a_base(cur); const char* cB = S.b_base(cur);
    PG8_AOFF(vcA, cur);
    S.a_ready(cur);
    if constexpr (SP2) {
        PG8_STAGE(PG8_SB(0, 0), cB, voffB); PG8_STAGE(PG8_SB(0, 1), cB + hstep, voffB); PG8_STAGEA(PG8_SA(0, 0), cA, vcA, 0); PG8_STAGEA(PG8_SA(0, 1), cA, vcA, 1);
        if (wr == 1) PG8_BAR;
        PG8_WAIT_V(2); PG8_BAR;
        PG8_STAGE(PG8_SB(1, 0), cB + kstep, voffB); PG8_STAGEA(PG8_SA(1, 0), cA + kstep, vcA, 0); PG8_STAGE(PG8_SB(1, 1), cB + hstep + kstep, voffB);
        PG8_WAIT_V(6); PG8_BAR;
    } else {
        PG8_STAGE(PG8_SB(0, 0), cB, voffB); PG8_STAGEA(PG8_SA(0, 0), cA, vcA, 0); PG8_STAGE(PG8_SB(0, 1), cB + hstep, voffB); PG8_STAGEA(PG8_SA(0, 1), cA, vcA, 1);
        if (wr == 1) PG8_BAR;
        PG8_WAIT_V(4); PG8_BAR;
        PG8_STAGE(PG8_SB(1, 0), cB + kstep, voffB); PG8_STAGEA(PG8_SA(1, 0), cA + kstep, vcA, 0); PG8_STAGE(PG8_SB(1, 1), cB + hstep + kstep, voffB);
        PG8_WAIT_V(6); PG8_BAR;
    }
    for (;;) {
        const bool has_next = S.next(ui + 1, nxt);
        const char* nA = has_next ? S.a_base(nxt) : cA; const char* nB = has_next ? S.b_base(nxt) : cB;
        if (has_next) { PG8_AOFF(vnA, nxt); } else { _Pragma("unroll") for (int _h = 0; _h < 2; ++_h) _Pragma("unroll") for (int _i = 0; _i < 2; ++_i) vnA[_h][_i] = vcA[_h][_i]; }
        for (int t = 0; t < nt; t += 2) {
            const bool last = (t == nt - 2);
            const char* a1 = cA + (size_t)(t + 1) * kstep;
            const char* a2 = last ? nA : cA + (size_t)(t + 2) * kstep; const char* b2 = last ? nB : cB + (size_t)(t + 2) * kstep;
            const char* a3 = a2 + kstep; const char* b3 = b2 + kstep;
            if (last && has_next) S.a_ready(nxt);
            if constexpr (SP2) {
            PG8_LDB(B0, 0, 0); PG8_LDB(B1, 0, 1); PG8_SCHED; PG8_LDA(At, 0, 0); PG8_STAGEA(PG8_SA(1, 1), a1, vcA, 1);
            PG8_WAIT_V(8); PG8_WAIT_L(0); PG8_BAR; PG8_MMA(0, 0, At, B0); PG8_MMA(0, 1, At, B1); PG8_BAR; PG8_SCHED;
            PG8_LDA(At, 0, 1); PG8_STAGE(PG8_SB(0, 0), b2, voffB); PG8_STAGE(PG8_SB(0, 1), b2 + hstep, voffB); PG8_STAGEA2(PG8_SA(0, 0), a2, 0);
            PG8_WAIT_V(8); PG8_WAIT_L(0); PG8_BAR; PG8_MMA(1, 0, At, B0); PG8_MMA(1, 1, At, B1); PG8_BAR; PG8_SCHED;
            PG8_LDB(B0, 1, 0); PG8_LDB(B1, 1, 1); PG8_SCHED; PG8_LDA(At, 1, 0); PG8_STAGEA2(PG8_SA(0, 1), a2, 1);
            PG8_WAIT_V(8); PG8_WAIT_L(0); PG8_BAR; PG8_MMA(0, 0, At, B0); PG8_MMA(0, 1, At, B1); PG8_BAR; PG8_SCHED;
            PG8_LDA(At, 1, 1); PG8_STAGE(PG8_SB(1, 0), b3, voffB); PG8_STAGE(PG8_SB(1, 1), b3 + hstep, voffB); PG8_STAGEA2(PG8_SA(1, 0), a3, 0);
            PG8_WAIT_V(8); PG8_WAIT_L(0); PG8_BAR; PG8_MMA(1, 0, At, B0); PG8_MMA(1, 1, At, B1); PG8_BAR; PG8_SCHED;
            } else {
            PG8_LDB(B0, 0, 0); PG8_SCHED; PG8_LDA(At, 0, 0); PG8_STAGEA(PG8_SA(1, 1), a1, vcA, 1);
            PG8_WAIT_L(8); PG8_BAR; PG8_WAIT_L(0); PG8_MMA(0, 0, At, B0); PG8_BAR; PG8_SCHED;
            PG8_LDB(B1, 0, 1); PG8_STAGE(PG8_SB(0, 0), b2, voffB);
            PG8_BAR; PG8_WAIT_L(0); PG8_MMA(0, 1, At, B1); PG8_BAR;
            PG8_LDA(At, 0, 1); PG8_STAGEA2(PG8_SA(0, 0), a2, 0);
            PG8_BAR; PG8_WAIT_L(0); PG8_MMA(1, 0, At, B0); PG8_BAR; PG8_SCHED;
            PG8_STAGE(PG8_SB(0, 1), b2 + hstep, voffB);
            PG8_WAIT_V(6); PG8_BAR; PG8_MMA(1, 1, At, B1); PG8_BAR;
            PG8_LDB(B0, 1, 0); PG8_SCHED; PG8_LDA(At, 1, 0); PG8_STAGEA2(PG8_SA(0, 1), a2, 1);
            PG8_WAIT_L(8); PG8_BAR; PG8_WAIT_L(0); PG8_MMA(0, 0, At, B0); PG8_BAR; PG8_SCHED;
            PG8_LDB(B1, 1, 1); PG8_STAGE(PG8_SB(1, 0), b3, voffB);
            PG8_BAR; PG8_WAIT_L(0); PG8_MMA(0, 1, At, B1); PG8_BAR;
            PG8_LDA(At, 1, 1); PG8_STAGEA2(PG8_SA(1, 0), a3, 0);
            PG8_BAR; PG8_WAIT_L(0); PG8_MMA(1, 0, At, B0); PG8_BAR; PG8_SCHED;
            PG8_STAGE(PG8_SB(1, 1), b3 + hstep, voffB);
            PG8_WAIT_V(6); PG8_BAR; PG8_MMA(1, 1, At, B1); PG8_BAR;
            }
        }
        if constexpr (ALIGN_EPI) { if (wr == 0) PG8_BAR; }
        if constexpr (!Epi::AFTER_DRAIN) { E(acc, cur, wr, wc, fr, fq); S.done(cur); }
        if (!has_next) break;
#pragma unroll
        for (int a = 0; a < 2; ++a)
#pragma unroll
            for (int b = 0; b < 2; ++b)
#pragma unroll
                for (int m = 0; m < 4; ++m)
#pragma unroll
                    for (int n = 0; n < 2; ++n) acc[a][b][m][n] = (f32x4){0.f, 0.f, 0.f, 0.f};
        cur = nxt; cA = nA; cB = nB; ++ui;
        _Pragma("unroll") for (int _h = 0; _h < 2; ++_h) _Pragma("unroll") for (int _i = 0; _i < 2; ++_i) vcA[_h][_i] = vnA[_h][_i];
        if constexpr (ALIGN_EPI) { if (wr == 1) PG8_BAR; }
    }
    PG8_WAIT_V(0);
    if constexpr (!ALIGN_EPI) { if (wr == 0) PG8_BAR; }
    PG8_BAR;
    if constexpr (Epi::AFTER_DRAIN) { E.fused(acc, cur, wr, wc, fr, fq, lds, wid, lane); S.done(cur); }
#undef PG8_SA
#undef PG8_SB
#undef PG8_STAGE
#undef PG8_STAGEA
#undef PG8_STAGEA2
#undef PG8_AOFF
#undef PG8_LDA
#undef PG8_LDB
#undef PG8_MMA
#undef PG8_WAIT_V
#undef PG8_WAIT_L
#undef PG8_BAR
#undef PG8_SCHED
}


template <int WHICH> struct MoeOrder {
    const int* TP; int G, c; const char* Abase; const char* Bbase; const int* LIST;
    static constexpr int KK = WHICH == 0 ? 1024 : 512, NN = 4;
    __device__ __forceinline__ bool next(int i, Unit& u) const {
        const int L = i * G + c; if (L >= TP[NEXP]) return false;
        int e = 0;
#pragma unroll 1
        for (int j = 16; j >= 1; j >>= 1) if (TP[e + j] <= L) e += j;
        const int lt = L - TP[e]; u.pm = e * 1024 + lt / NN; u.pn = lt % NN; return true;
    }
    __device__ __forceinline__ const char* a_base(const Unit& u) const { const int e = u.pm >> 10, mt = u.pm & 1023; return WHICH == 0 ? Abase : Abase + (size_t)(TP[64 + e] + mt * 256) * (DEXP * 2); }
    __device__ __forceinline__ const char* b_base(const Unit& u) const { const int e = u.pm >> 10; return Bbase + ((size_t)e * 1024 + (size_t)u.pn * 256) * (KK * 2); }
    __device__ __forceinline__ unsigned a_off(const Unit& u, int r, int C) const {
        if (WHICH == 1) return (unsigned)(r * DEXP + C) * 2u;
        const int e = u.pm >> 10, s = (u.pm & 1023) * 256 + r; const int tok = s < TP[128 + e] ? (LIST[(size_t)e * NR + s] >> 1) : 0;
        return (unsigned)tok * (D * 2) + (unsigned)C * 2u;
    }
    __device__ __forceinline__ void a_ready(const Unit&) const {}
    __device__ __forceinline__ void done(const Unit&) const {}
};
struct TokRowOrder : StaticOrder {
    const char* Abase; const char* Bbase; int K;
    __device__ __forceinline__ const char* a_base(const Unit& u) const { return Abase + (size_t)tokrow(u.pm * BM) * K * 2; }
    __device__ __forceinline__ const char* b_base(const Unit& u) const { return Bbase + (size_t)u.pn * BM * K * 2; }
    __device__ __forceinline__ unsigned a_off(const Unit&, int r, int C) const { return (unsigned)(r * K + C) * 2u; }
};
#define PG8_FOR_FRAGS_M(...) _Pragma("unroll") for (int ai = 0; ai < 2; ++ai) _Pragma("unroll") for (int m = 0; m < 4; ++m) { const int r = ai * HALF + wr * 64 + m * 16 + fr; \
    _Pragma("unroll") for (int bj = 0; bj < 2; ++bj) _Pragma("unroll") for (int n = 0; n < 2; ++n) { const int col = u.pn * BM + bj * HALF + wc * 32 + n * 16 + 4 * fq; ::f32x4 v = acc[ai][bj][m][n]; __VA_ARGS__ } }
struct EpiMoe1 {
    static constexpr bool PERM = true, AFTER_DRAIN = false;
    bf16_t* HID; const int* TP; const int* LIST; const float* RS;
    __device__ __forceinline__ void operator()(const f32x4 (&acc)[2][2][4][2], const Unit& u, int wr, int wc, int fr, int fq) const {
        const int e = u.pm >> 10, mt = u.pm & 1023, cnt = TP[128 + e]; bf16_t* base = HID + (size_t)(TP[64 + e] + mt * 256) * DEXP;
#pragma unroll
        for (int ai = 0; ai < 2; ++ai)
#pragma unroll
            for (int m = 0; m < 4; ++m) { const int r = ai * HALF + wr * 64 + m * 16 + fr; const int s = mt * 256 + r;
                const float rs = RS[s < cnt ? (LIST[(size_t)e * NR + s] >> 1) : 0];
#pragma unroll
                for (int bj = 0; bj < 2; ++bj) { const int col = u.pn * BM + bj * HALF + wc * 32 + 8 * fq; const ::f32x4 v0 = acc[ai][bj][m][0] * rs, v1 = acc[ai][bj][m][1] * rs;
                    const float h0 = v0.x * sigmoidf(v0.x) * v0.y, h1 = v0.z * sigmoidf(v0.z) * v0.w, h2 = v1.x * sigmoidf(v1.x) * v1.y, h3 = v1.z * sigmoidf(v1.z) * v1.w;
                    ::u32x2 w; w.x = pk2(h0, h1); w.y = pk2(h2, h3); *(::u32x2*)(base + (size_t)r * DEXP + (col >> 1)) = w; } }
    }
};
struct EpiMoe2 {
    static constexpr bool PERM = true, AFTER_DRAIN = false;
    bf16_t* MO; const int* TP; const int* LIST; const float* GATE;
    __device__ __forceinline__ void operator()(const f32x4 (&acc)[2][2][4][2], const Unit& u, int wr, int wc, int fr, int fq) const {
        const int e = u.pm >> 10, mt = u.pm & 1023, cnt = TP[128 + e];
#pragma unroll
        for (int ai = 0; ai < 2; ++ai)
#pragma unroll
            for (int m = 0; m < 4; ++m) {
                const int s = mt * 256 + ai * HALF + wr * 64 + m * 16 + fr;
                if (s < cnt) {
                    const int ent = LIST[(size_t)e * NR + s]; const float gt = GATE[ent]; bf16_t* row = MO + (size_t)ent * D;
#pragma unroll
                    for (int bj = 0; bj < 2; ++bj) { const int col = u.pn * BM + bj * HALF + wc * 32 + 8 * fq; const ::f32x4 v0 = acc[ai][bj][m][0], v1 = acc[ai][bj][m][1];
                        ::u32x4 w; w.x = pk2(v0.x * gt, v0.y * gt); w.y = pk2(v0.z * gt, v0.w * gt); w.z = pk2(v1.x * gt, v1.y * gt); w.w = pk2(v1.z * gt, v1.w * gt); *(::u32x4*)(row + col) = w; }
                }
            }
    }
};
#undef PG8_FOR_FRAGS_M
}
template <bool B> struct BoolT { static constexpr bool value = B; };
constexpr int SB_NQT = SEQ / 32;
constexpr int SB_VROW = 192;
__device__ __forceinline__ void phase_sb_fast(const Params& p, char* lds) {
    const bf16_t* P = (const bf16_t*)(p.ws + WS_P); bf16_t* YA = (bf16_t*)(p.ws + WS_YA);
    const int tid = threadIdx.x, lane = tid & 63, wave = tid >> 6, n = lane & 31, hh = lane >> 5;
    char* VB = lds + wave * (32 * SB_VROW);
    const unsigned vtr = (unsigned)(size_t)lds + (unsigned)(wave * (32 * SB_VROW) + (4 * hh + ((lane & 15) >> 2)) * SB_VROW + (16 * ((lane >> 4) & 1) + 4 * (lane & 3)) * 2);
    const int gw = blockIdx.x * NWAVES + wave, NGW = gridDim.x * NWAVES;
    for (int unit = gw; unit < 64 * SB_NQT; unit += NGW) {
        const int qt = SB_NQT - 1 - unit / 64, bh = unit % 64, h = bh & 7, b = bh >> 3;
        const int i0 = NMETA + qt * 32, qi = i0 + n, qrow = qi;
        const bf16_t* Pb = P + (size_t)b * T * PW;
        bf16x8 qf[4];
#pragma unroll
        for (int s = 0; s < 4; ++s) qf[s] = *(const bf16x8*)(Pb + (size_t)qrow * PW + C_QA + h * 64 + 16 * s + 8 * hh);
        f32x16 o0, o1;
#pragma unroll
        for (int r = 0; r < 16; ++r) { o0[r] = 0.f; o1[r] = 0.f; }
        float EL = 1.f;
        auto tile = [&](const int kt, auto MT) {
            constexpr bool MASKED = decltype(MT)::value;
            const int j0 = kt * 32, krow = (!MASKED || (j0 + n) < T) ? (j0 + n) : T - 1;
            bf16x8 kf[4];
#pragma unroll
            for (int s = 0; s < 4; ++s) kf[s] = *(const bf16x8*)(Pb + (size_t)krow * PW + C_KA + h * 64 + 16 * s + 8 * hh);
#pragma unroll
            for (int i = 0; i < 4; ++i) {
                const int c = lane + 64 * i, key = c >> 3, d0 = (c & 7) * 8, vrow = (!MASKED || (j0 + key) < T) ? (j0 + key) : T - 1;
                const u32x4 w = *(const u32x4*)(Pb + (size_t)vrow * PW + C_VA + h * 64 + d0);
                *(u32x4*)(VB + key * SB_VROW + d0 * 2) = w;
            }
            f32x16 sa;
#pragma unroll
            for (int r = 0; r < 16; ++r) sa[r] = 0.f;
#pragma unroll
            for (int s = 0; s < 4; ++s) sa = __builtin_amdgcn_mfma_f32_32x32x16_bf16(kf[s], qf[s], sa, 0, 0, 0);
            float kp[16], sg[16];
#pragma unroll
            for (int r = 0; r < 16; ++r) {
                const float e = fexp2(__builtin_amdgcn_fmed3f(sa[r], -3.0e38f, 80.f)), k = __builtin_amdgcn_rcpf(1.f + e), s = e * k;
                if (MASKED) { const int kk = (r & 3) + 8 * (r >> 2) + 4 * hh; const bool valid = (j0 + kk) < qi; kp[r] = valid ? k : 1.f; sg[r] = valid ? s : 0.f; }
                else { kp[r] = k; sg[r] = s; }
            }
            const float gp0 = (kp[0] * kp[1]) * (kp[2] * kp[3]), gp1 = (kp[4] * kp[5]) * (kp[6] * kp[7]), gp2 = (kp[8] * kp[9]) * (kp[10] * kp[11]), gp3 = (kp[12] * kp[13]) * (kp[14] * kp[15]);
            const float pp0 = xpartner32(gp0, hh), pp1 = xpartner32(gp1, hh), pp2 = xpartner32(gp2, hh), pp3 = xpartner32(gp3, hh);
            const float pc3 = pp3, pc2 = pc3 * pp2, pc1 = pc2 * pp1, pc0 = pc1 * pp0;
            float base[4];
            base[3] = EL * (hh ? 1.f : pc3);
            base[2] = EL * gp3 * (hh ? pc3 : pc2);
            base[1] = EL * (gp3 * gp2) * (hh ? pc2 : pc1);
            base[0] = EL * (gp3 * gp2 * gp1) * (hh ? pc1 : pc0);
            float a[16];
#pragma unroll
            for (int g = 0; g < 4; ++g) {
                float c = base[g];
#pragma unroll
                for (int e = 3; e >= 0; --e) { const int r = 4 * g + e; a[r] = sg[r] * c; c *= kp[r]; }
            }
            EL *= ((gp0 * gp1) * (gp2 * gp3)) * pc0;
            u32x4 pw0, pw1;
            pw0.x = pk2(a[0], a[1]); pw0.y = pk2(a[2], a[3]); pw0.z = pk2(a[4], a[5]); pw0.w = pk2(a[6], a[7]);
            pw1.x = pk2(a[8], a[9]); pw1.y = pk2(a[10], a[11]); pw1.z = pk2(a[12], a[13]); pw1.w = pk2(a[14], a[15]);
            const bf16x8 pf0 = __builtin_bit_cast(bf16x8, pw0), pf1 = __builtin_bit_cast(bf16x8, pw1);
            {
                u16x4 x0, x1, x2, x3, y0, y1, y2, y3;
                asm volatile("s_waitcnt lgkmcnt(0)\n\tds_read_b64_tr_b16 %0, %8 offset:%9\n\tds_read_b64_tr_b16 %1, %8 offset:%10\n\tds_read_b64_tr_b16 %2, %8 offset:%11\n\tds_read_b64_tr_b16 %3, %8 offset:%12\n\t"
                             "ds_read_b64_tr_b16 %4, %8 offset:%13\n\tds_read_b64_tr_b16 %5, %8 offset:%14\n\tds_read_b64_tr_b16 %6, %8 offset:%15\n\tds_read_b64_tr_b16 %7, %8 offset:%16\n\ts_waitcnt lgkmcnt(0)"
                             : "=&v"(x0), "=&v"(x1), "=&v"(x2), "=&v"(x3), "=&v"(y0), "=&v"(y1), "=&v"(y2), "=&v"(y3)
                             : "v"(vtr), "i"(0), "i"(8 * SB_VROW), "i"(16 * SB_VROW), "i"(24 * SB_VROW), "i"(64), "i"(64 + 8 * SB_VROW), "i"(64 + 16 * SB_VROW), "i"(64 + 24 * SB_VROW) : "memory");
#define SB_VF(a_, b_) ({ bf16x8 f_; f_[0] = (short)a_[0]; f_[1] = (short)a_[1]; f_[2] = (short)a_[2]; f_[3] = (short)a_[3]; f_[4] = (short)b_[0]; f_[5] = (short)b_[1]; f_[6] = (short)b_[2]; f_[7] = (short)b_[3]; f_; })
                o0 = __builtin_amdgcn_mfma_f32_32x32x16_bf16(SB_VF(x0, x1), pf0, o0, 0, 0, 0); o0 = __builtin_amdgcn_mfma_f32_32x32x16_bf16(SB_VF(x2, x3), pf1, o0, 0, 0, 0);
                o1 = __builtin_amdgcn_mfma_f32_32x32x16_bf16(SB_VF(y0, y1), pf0, o1, 0, 0, 0); o1 = __builtin_amdgcn_mfma_f32_32x32x16_bf16(SB_VF(y2, y3), pf1, o1, 0, 0, 0);
#undef SB_VF
            }
        };
        int kt = qt + 1;
        for (; kt >= qt; --kt) tile(kt, BoolT<true>{});
        for (; kt >= 0; --kt) {
            if (__all(EL < 1e-37f)) break;
            tile(kt, BoolT<false>{});
        }
        {
            bf16_t* yp = YA + ((size_t)b * SEQ + (qi - NMETA)) * 512 + h * 64 + 4 * hh;
#pragma unroll
            for (int g = 0; g < 4; ++g) {
                u32x2 w; w.x = pk2(o0[4 * g], o0[4 * g + 1]); w.y = pk2(o0[4 * g + 2], o0[4 * g + 3]); *(u32x2*)(yp + 8 * g) = w;
                w.x = pk2(o1[4 * g], o1[4 * g + 1]); w.y = pk2(o1[4 * g + 2], o1[4 * g + 3]); *(u32x2*)(yp + 32 + 8 * g) = w;
            }
        }
    }
}

constexpr int DSA_NQ = 8;
constexpr int DSA_SCS = 4608;
constexpr int DSA_KVB = 0, DSA_RING = 18432, DSA_IDX = DSA_NQ * DSA_RING, DSA_MISC = DSA_IDX + DSA_NQ * 1024, DSA_LDS = DSA_MISC + 512;
static_assert(DSA_NQ * DSA_SCS * 4 <= DSA_IDX, "score rows fit under the index lists");
__device__ __forceinline__ unsigned fkey(float f) { const unsigned u = __float_as_uint(f); return (u & 0x80000000u) ? ~u : (u | 0x80000000u); }
__device__ __forceinline__ int wave_sum_i32(int v) {
    v += __builtin_amdgcn_update_dpp(0, v, 0xB1, 0xF, 0xF, false);
    v += __builtin_amdgcn_update_dpp(0, v, 0x4E, 0xF, 0xF, false);
    v += __builtin_amdgcn_update_dpp(0, v, 0x141, 0xF, 0xF, false);
    v += __builtin_amdgcn_update_dpp(0, v, 0x140, 0xF, 0xF, false);
    return __builtin_amdgcn_readlane(v, 0) + __builtin_amdgcn_readlane(v, 16) + __builtin_amdgcn_readlane(v, 32) + __builtin_amdgcn_readlane(v, 48);
}
__device__ __forceinline__ int wave_excl_scan_i32(int c, int lane, int& total) {
    int x = c;
    x += __builtin_amdgcn_update_dpp(0, x, 0x111, 0xF, 0xF, true);
    x += __builtin_amdgcn_update_dpp(0, x, 0x112, 0xF, 0xF, true);
    x += __builtin_amdgcn_update_dpp(0, x, 0x114, 0xF, 0xF, true);
    x += __builtin_amdgcn_update_dpp(0, x, 0x118, 0xF, 0xF, true);
    const int t0 = __builtin_amdgcn_readlane(x, 15), t1 = __builtin_amdgcn_readlane(x, 31), t2 = __builtin_amdgcn_readlane(x, 47), t3 = __builtin_amdgcn_readlane(x, 63);
    const int row = lane >> 4;
    x += (row > 0 ? t0 : 0) + (row > 1 ? t1 : 0) + (row > 2 ? t2 : 0);
    total = t0 + t1 + t2 + t3;
    return x - c;
}
__device__ __forceinline__ int mbcnt64(unsigned long long m) { return (int)__builtin_amdgcn_mbcnt_hi((unsigned)(m >> 32), __builtin_amdgcn_mbcnt_lo((unsigned)m, 0u)); }
__device__ __forceinline__ void phase_dsa(const Params& p, char* lds) {
    const bf16_t* P = (const bf16_t*)(p.ws + WS_P); bf16_t* OL = (bf16_t*)(p.ws + WS_OLAT);
    const int tid = threadIdx.x, lane = tid & 63, wave = __builtin_amdgcn_readfirstlane(tid >> 6);
    unsigned* SC = (unsigned*)(lds + DSA_KVB);
    unsigned short* IDX = (unsigned short*)(lds + DSA_IDX);
    int* MISC = (int*)(lds + DSA_MISC);
    const unsigned lds_base = (unsigned)(size_t)lds;
    constexpr int NU = SEQ / DSA_NQ;
    for (int unit = blockIdx.x; unit < BATCH * NU; unit += gridDim.x) {
        const int u8 = NU - 1 - unit / BATCH, b = unit % BATCH, t0 = NMETA + u8 * DSA_NQ;
        const int cid = 1 + (t0 - NMETA) / 64, n = NMETA + 64 * cid;
        const bf16_t* Pb = P + (size_t)b * T * PW;
        const int m = lane & 31, hh = lane >> 5;
        bf16x8 aq[2][4]; float wv[2][16];
#pragma unroll
        for (int rt = 0; rt < 2; ++rt) {
#pragma unroll
            for (int s = 0; s < 4; ++s) aq[rt][s] = *(const bf16x8*)(Pb + (size_t)(t0 + 4 * rt + (m >> 3)) * PW + C_QI + (m & 7) * 64 + 16 * s + 8 * hh);
#pragma unroll
            for (int r = 0; r < 16; ++r) wv[rt][r] = bf2f(Pb[(size_t)(t0 + 4 * rt + (r >> 2)) * PW + C_WI + (r & 3) + 4 * hh]);
        }
        const unsigned char* KIPb = p.ws + WS_KIP + (size_t)b * KIP_BATCH + lane * 16;
        bf16x8 bk[4];
#pragma unroll
        for (int s = 0; s < 4; ++s) bk[s] = *(const bf16x8*)(KIPb + (size_t)wave * 4096 + s * 1024);
        __syncthreads();
        {
            const int ntile = (n + 31) / 32;
            for (int kt = wave; kt < ntile; kt += NWAVES) {
                const int j0 = kt * 32, key = j0 + m;
                bf16x8 bn[4];
                { const int ktn = kt + NWAVES < 129 ? kt + NWAVES : 128;
#pragma unroll
                  for (int s = 0; s < 4; ++s) bn[s] = *(const bf16x8*)(KIPb + (size_t)ktn * 4096 + s * 1024); }
                const bool ok = key < n;
#pragma unroll
                for (int rt = 0; rt < 2; ++rt) {
                    f32x16 acc;
#pragma unroll
                    for (int r = 0; r < 16; ++r) acc[r] = 0.f;
#pragma unroll
                    for (int s = 0; s < 4; ++s) acc = __builtin_amdgcn_mfma_f32_32x32x16_bf16(aq[rt][s], bk[s], acc, 0, 0, 0);
                    float tq[4];
#pragma unroll
                    for (int q = 0; q < 4; ++q) {
#define RELU_(x) __builtin_amdgcn_fmed3f((x), 0.f, 3.0e38f)
                        float s = wv[rt][4 * q] * RELU_(acc[4 * q]); s += wv[rt][4 * q + 1] * RELU_(acc[4 * q + 1]); s += wv[rt][4 * q + 2] * RELU_(acc[4 * q + 2]); s += wv[rt][4 * q + 3] * RELU_(acc[4 * q + 3]);
#undef RELU_
                        tq[q] = xsum32(s);
                    }
                    const float s0 = hh ? tq[2] : tq[0], s1 = hh ? tq[3] : tq[1];
                    SC[(4 * rt + 2 * hh) * DSA_SCS + key] = ok ? fkey(s0) : 0u;
                    SC[(4 * rt + 2 * hh + 1) * DSA_SCS + key] = ok ? fkey(s1) : 0u;
                }
#pragma unroll
                for (int s = 0; s < 4; ++s) bk[s] = bn[s];
            }
        }
        __syncthreads();
        bf16x8 qf[5];
        {
            const int hd_ = lane & 15, g_ = lane >> 4;
#pragma unroll
            for (int ks = 0; ks < 5; ++ks) {
                u32x4 w = (u32x4){0u, 0u, 0u, 0u};
                if (hd_ < 8 && (ks < 4 || g_ < 2)) w = *(const u32x4*)(Pb + (size_t)(t0 + wave) * PW + C_QF + hd_ * QFW + 32 * ks + 8 * g_);
                qf[ks] = __builtin_bit_cast(bf16x8, w);
            }
        }
        {
            unsigned* sc = SC + wave * DSA_SCS;
            unsigned v[65];
#pragma unroll
            for (int i = 0; i < 65; ++i) { const int k = i * 64 + lane; v[i] = (k < n) ? sc[k] : 0u; }
            unsigned prefix = 0u; int cge = n, bit = 31;
            bool exact = false;
            if (n >= 256) {
                for (; bit >= 0 && cge > 512; --bit) {
                    const unsigned cand = prefix | (1u << bit); const int sc_ = (int)(cand ^ 0x80000000u);
                    unsigned b0 = 0u, b1 = 0u, b2 = 0u; int slots = 0;
#pragma unroll
                    for (int gi = 0; gi < 5; ++gi) if (gi * 832 < n) {
#pragma unroll
                        for (int i = 13 * gi; i < 13 * gi + 13; ++i) {
                            const unsigned d = (unsigned)__builtin_elementwise_sub_sat((int)(v[i] ^ 0x80000000u), sc_);
                            if (i % 3 == 0) b0 = __builtin_amdgcn_alignbit(b0, d, 31); else if (i % 3 == 1) b1 = __builtin_amdgcn_alignbit(b1, d, 31); else b2 = __builtin_amdgcn_alignbit(b2, d, 31);
                        }
                        slots += 13 * 64;
                    }
                    const int c = slots - wave_sum_i32(__builtin_popcount(b0) + __builtin_popcount(b1) + __builtin_popcount(b2));
                    if (c >= 256) { prefix = cand; cge = c; if (c == 256) { exact = true; break; } }
                }
            }
            int ngt = n;
            if (n >= 256 && !exact) {
                asm volatile("s_waitcnt lgkmcnt(0)" ::: "memory");
                int cb = 0;
                if (bit >= 0) {
                    const int sp_ = (int)((prefix > 0u ? prefix : 1u) ^ 0x80000000u);
                    unsigned lb0 = 0u, lb1 = 0u, lb2 = 0u;
#pragma unroll
                    for (int i = 0; i < 65; ++i) { const unsigned d = (unsigned)__builtin_elementwise_sub_sat((int)(v[i] ^ 0x80000000u), sp_);
                        if (i < 32) lb0 = __builtin_amdgcn_alignbit(lb0, d, 31); else if (i < 64) lb1 = __builtin_amdgcn_alignbit(lb1, d, 31); else lb2 = d >> 31; }
                    const unsigned tk0 = ~lb0, tk1 = ~lb1, tk2 = (~lb2) & 1u;
                    const int c0 = __builtin_popcount(tk0), c1 = __builtin_popcount(tk1);
                    const int lbase = wave_excl_scan_i32(c0 + c1 + (int)tk2, lane, cb);
#pragma unroll
                    for (int i = 0; i < 65; ++i) {
                        bool tkn; int rk;
                        if (i < 32) { tkn = (tk0 >> (31 - i)) & 1u; rk = i == 0 ? 0 : __builtin_popcount(tk0 >> (32 - i)); }
                        else if (i < 64) { tkn = (tk1 >> (63 - i)) & 1u; rk = c0 + (i == 32 ? 0 : __builtin_popcount(tk1 >> (64 - i))); }
                        else { tkn = tk2 != 0u; rk = c0 + c1; }
                        sc[tkn ? lbase + rk : 4096 + (lane & 15)] = v[i];
                    }
                    asm volatile("s_waitcnt lgkmcnt(0)" ::: "memory");
                    unsigned w[8];
#pragma unroll
                    for (int j = 0; j < 8; ++j) { const int k = j * 64 + lane; w[j] = (k < cb) ? sc[k] : 0u; }
                    for (; bit >= 0; --bit) {
                        const unsigned cand = prefix | (1u << bit); const int sc_ = (int)(cand ^ 0x80000000u); unsigned b0 = 0u, b1 = 0u;
#pragma unroll
                        for (int j = 0; j < 8; ++j) { const unsigned d = (unsigned)__builtin_elementwise_sub_sat((int)(w[j] ^ 0x80000000u), sc_); if (j & 1) b1 = __builtin_amdgcn_alignbit(b1, d, 31); else b0 = __builtin_amdgcn_alignbit(b0, d, 31); }
                        const int c = 512 - wave_sum_i32(__builtin_popcount(b0) + __builtin_popcount(b1));
                        if (c >= 256) { prefix = cand; if (c == 256) { exact = true; break; } }
                    }
                    int c = 0;
#pragma unroll
                    for (int j = 0; j < 8; ++j) c += __popcll(__ballot(w[j] > prefix));
                    ngt = c;
                } else {
                    int c = 0;
#pragma unroll
                    for (int i = 0; i < 65; ++i) { c += __popcll(__ballot(v[i] > prefix)); if ((i & 3) == 3) __builtin_amdgcn_sched_barrier(0); }
                    ngt = c;
                }
            }
            const unsigned tau = prefix;
            const int need_eq = n >= 256 ? 256 - ngt : 0; int base = 0, eqb = 0;
            unsigned short* idx = IDX + wave * 512;
            {
                const int st_ = (int)(tau ^ 0x80000000u); unsigned e0 = 0u, e1 = 0u, e2 = 0u;
#pragma unroll
                for (int i = 0; i < 65; ++i) { const unsigned d = (unsigned)__builtin_elementwise_sub_sat((int)(v[i] ^ 0x80000000u), st_);
                    if (i < 32) e0 = __builtin_amdgcn_alignbit(e0, d, 31); else if (i < 64) e1 = __builtin_amdgcn_alignbit(e1, d, 31); else e2 = d >> 31; }
                const unsigned tk0 = ~e0, tk1 = ~e1, tk2 = (~e2) & 1u;
                const int c0 = __builtin_popcount(tk0), c1 = __builtin_popcount(tk1);
                int nge; const int lbase = wave_excl_scan_i32(c0 + c1 + (int)tk2, lane, nge);
                if (n >= 256 && nge == 256) {
                    unsigned short* ib = idx + lbase;
                    { unsigned x = tk0; int j = 0; while (__any(x != 0u)) { if (x != 0u) { const int i = __builtin_clz(x); ib[j] = (unsigned short)(i * 64 + lane); x ^= 0x80000000u >> i; } ++j; } }
                    ib += c0;
                    { unsigned x = tk1; int j = 0; while (__any(x != 0u)) { if (x != 0u) { const int i = __builtin_clz(x); ib[j] = (unsigned short)((32 + i) * 64 + lane); x ^= 0x80000000u >> i; } ++j; } }
                    if (tk2 != 0u) ib[c1] = (unsigned short)(64 * 64 + lane);
                    base = nge;
                } else {
#pragma unroll
                    for (int gi = 0; gi < 5; ++gi) if (gi * 832 < n) {
#pragma unroll
                        for (int i = 13 * gi; i < 13 * gi + 13; ++i) {
                            const int k = i * 64 + lane; const unsigned u = v[i];
                            const bool eq = (u == tau); const unsigned long long meq = __ballot(eq);
                            const bool take = (u > tau) || (eq && (eqb + mbcnt64(meq)) < need_eq);
                            const unsigned long long mt = __ballot(take);
                            idx[take ? base + mbcnt64(mt) : 256 + lane] = (unsigned short)k;
                            base += __popcll(mt); eqb += __popcll(meq);
                            if ((i & 3) == 3) __builtin_amdgcn_sched_barrier(0);
                        }
                    }
                }
            }
            for (int pos = base + lane; pos < 256; pos += 64) idx[pos] = 0;
            if (lane == 0) MISC[wave] = base;
        }
        asm volatile("s_waitcnt lgkmcnt(0)" ::: "memory");
        {
            const int q = wave; const int nsel = __builtin_amdgcn_readfirstlane(MISC[q]);
            const size_t qrow = (size_t)(t0 + q);
            int ln = lane; asm volatile("" : "+v"(ln));
            const int hd = ln & 15, g = ln >> 4, qd = (ln & 15) >> 2, pp = ln & 3;
            char* ring = lds + DSA_KVB + wave * DSA_RING;
            const unsigned ring_a = lds_base + DSA_KVB + wave * DSA_RING;
            const unsigned short* idx = IDX + q * 512;
            asm volatile("s_waitcnt vmcnt(0)" ::: "memory");
#define DSA_ISSUE(c) do { unsigned rw_[9]; \
                _Pragma("unroll") for (int i_ = 0; i_ < 9; ++i_) { const int pid_ = ln + 64 * i_, row_ = pid_ / 18; rw_[i_] = idx[32 * (c) + row_]; } \
                _Pragma("unroll") for (int i_ = 0; i_ < 9; ++i_) { const int pid_ = ln + 64 * i_, row_ = pid_ / 18, part_ = pid_ - row_ * 18; \
                    const unsigned off_ = rw_[i_] * (unsigned)(PW * 2) + (unsigned)((C_KV + part_ * 8) * 2); \
                    __builtin_amdgcn_global_load_lds((const unsigned*)((const char*)Pb + off_), (LAS unsigned*)(ring + ((c) & 1) * 9216 + i_ * 1024), 16, 0, 0); } } while (0)
            DSA_ISSUE(0); DSA_ISSUE(1);
            f32x4 O[8];
#pragma unroll
            for (int nt = 0; nt < 8; ++nt) O[nt] = (f32x4){0.f, 0.f, 0.f, 0.f};
            float mrun = -3e38f, lrun = 0.f;
            for (int c = 0; c < 8; ++c) {
                if (c < 7) asm volatile("s_waitcnt vmcnt(9)" ::: "memory"); else asm volatile("s_waitcnt vmcnt(0)" ::: "memory");
                const char* buf = ring + (c & 1) * 9216;
                f32x4 S0 = (f32x4){0.f, 0.f, 0.f, 0.f}, S1 = S0;
                {
                    const char* kr = buf + hd * 288 + 16 * g;
#pragma unroll
                    for (int ks = 0; ks < 4; ++ks) { S0 = __builtin_amdgcn_mfma_f32_16x16x32_bf16(*(const bf16x8*)(kr + 64 * ks), qf[ks], S0, 0, 0, 0); S1 = __builtin_amdgcn_mfma_f32_16x16x32_bf16(*(const bf16x8*)(kr + 16 * 288 + 64 * ks), qf[ks], S1, 0, 0, 0); }
                    u32x4 w0 = (u32x4){0u, 0u, 0u, 0u}, w1 = w0; if (g < 2) { w0 = *(const u32x4*)(kr + 256); w1 = *(const u32x4*)(kr + 16 * 288 + 256); }
                    S0 = __builtin_amdgcn_mfma_f32_16x16x32_bf16(__builtin_bit_cast(bf16x8, w0), qf[4], S0, 0, 0, 0); S1 = __builtin_amdgcn_mfma_f32_16x16x32_bf16(__builtin_bit_cast(bf16x8, w1), qf[4], S1, 0, 0, 0);
                }
                float cm = -3e38f;
#pragma unroll
                for (int r = 0; r < 4; ++r) { if (nsel < 256) { const int sl = 32 * c + 4 * g + r; S0[r] = sl < nsel ? S0[r] : -1e30f; S1[r] = (sl + 16) < nsel ? S1[r] : -1e30f; } cm = fmax2(cm, fmax2(S0[r], S1[r])); }
                cm = xmax16(xmax32(cm));
                if (__any(cm > mrun + 6.f)) {
                    const float mnew = fmaxf(mrun, cm), alpha = fexp2(mrun - mnew);
                    lrun *= alpha; mrun = mnew;
#pragma unroll
                    for (int nt = 0; nt < 8; ++nt) O[nt] *= alpha;
                }
                float ps = 0.f;
#pragma unroll
                for (int r = 0; r < 4; ++r) { S0[r] = fexp2(S0[r] - mrun); S1[r] = fexp2(S1[r] - mrun); ps += S0[r] + S1[r]; }
                ps = xsum16(xsum32(ps));
                lrun += ps;
                u32x4 pw; pw.x = pk2(S0[0], S0[1]); pw.y = pk2(S0[2], S0[3]); pw.z = pk2(S1[0], S1[1]); pw.w = pk2(S1[2], S1[3]);
                const bf16x8 pf = __builtin_bit_cast(bf16x8, pw);
                const unsigned va = ring_a + (unsigned)((c & 1) * 9216 + (4 * g + qd) * 288 + 8 * pp);
#pragma unroll
                for (int h2 = 0; h2 < 2; ++h2) {
                    u16x4 x0, x1, x2, x3, y0, y1, y2, y3;
                    asm volatile("ds_read_b64_tr_b16 %0, %8 offset:%9\n\tds_read_b64_tr_b16 %1, %8 offset:%10\n\tds_read_b64_tr_b16 %2, %8 offset:%11\n\tds_read_b64_tr_b16 %3, %8 offset:%12\n\t"
                                 "ds_read_b64_tr_b16 %4, %8 offset:%13\n\tds_read_b64_tr_b16 %5, %8 offset:%14\n\tds_read_b64_tr_b16 %6, %8 offset:%15\n\tds_read_b64_tr_b16 %7, %8 offset:%16\n\ts_waitcnt lgkmcnt(0)"
                                 : "=&v"(x0), "=&v"(x1), "=&v"(x2), "=&v"(x3), "=&v"(y0), "=&v"(y1), "=&v"(y2), "=&v"(y3)
                                 : "v"(va), "i"(128 * h2), "i"(128 * h2 + 32), "i"(128 * h2 + 64), "i"(128 * h2 + 96), "i"(128 * h2 + 4608), "i"(128 * h2 + 4640), "i"(128 * h2 + 4672), "i"(128 * h2 + 4704) : "memory");
#define DSA_PV(nt_, x_, y_) do { bf16x8 vf_; vf_[0] = (short)x_[0]; vf_[1] = (short)x_[1]; vf_[2] = (short)x_[2]; vf_[3] = (short)x_[3]; vf_[4] = (short)y_[0]; vf_[5] = (short)y_[1]; vf_[6] = (short)y_[2]; vf_[7] = (short)y_[3]; \
                    O[nt_] = __builtin_amdgcn_mfma_f32_16x16x32_bf16(vf_, pf, O[nt_], 0, 0, 0); } while (0)
                    DSA_PV(4 * h2 + 0, x0, y0); DSA_PV(4 * h2 + 1, x1, y1); DSA_PV(4 * h2 + 2, x2, y2); DSA_PV(4 * h2 + 3, x3, y3);
                }
                asm volatile("s_waitcnt lgkmcnt(0)" ::: "memory");
                if (c + 2 < 8) DSA_ISSUE(c + 2);
            }
#undef DSA_PV
#undef DSA_ISSUE
            const float inv = __builtin_amdgcn_rcpf(lrun);
            if (hd < 8) {
                bf16_t* op = OL + ((size_t)b * SEQ + (qrow - NMETA)) * 1024 + hd * 128 + 4 * g;
#pragma unroll
                for (int nt = 0; nt < 8; ++nt) { u32x2 w; w.x = pk2(O[nt][0] * inv, O[nt][1] * inv); w.y = pk2(O[nt][2] * inv, O[nt][3] * inv); *(u32x2*)(op + 16 * nt) = w; }
            }
        }
    }
}

__device__ __forceinline__ void phase_inproj_meta(const Params& p) {
    unsigned char* ws = p.ws; const int tid = threadIdx.x, lane = tid & 63, wave = tid >> 6, fr = lane & 15, fq = lane >> 4;
    const bf16_t* U = (const bf16_t*)(ws + WS_U); const bf16_t* WP = (const bf16_t*)(ws + WS_WP); bf16_t* P = (bf16_t*)(ws + WS_P); const float2* cs = (const float2*)(ws + WS_CS);
    const int gw = blockIdx.x * NWAVES + wave, NGW = gridDim.x * NWAVES;
    for (int nt = gw; nt < PW / 16; nt += NGW) {
        const bf16_t* ap = U + (size_t)fr * D + 8 * fq; const bf16_t* bp = WP + (size_t)(16 * nt + fr) * D + 8 * fq;
        f32x4 acc = (f32x4){0.f, 0.f, 0.f, 0.f};
#pragma unroll 8
        for (int ks = 0; ks < D / 32; ++ks) acc = __builtin_amdgcn_mfma_f32_16x16x32_bf16(*(const bf16x8*)(bp + 32 * ks), *(const bf16x8*)(ap + 32 * ks), acc, 0, 0, 0);
        const int col = 16 * nt + 4 * fq, t = fr; f32x4 v = acc; int o;
        if (pg8::rope_off(col, o)) { const float2 c0 = cs[t * 8 + (o >> 1)], c1 = cs[t * 8 + (o >> 1) + 1]; v = (f32x4){v.x * c0.x - v.y * c0.y, v.y * c0.x + v.x * c0.y, v.z * c1.x - v.w * c1.y, v.w * c1.x + v.z * c1.y}; }
        u32x2 w; w.x = pk2(v.x, v.y); w.y = pk2(v.z, v.w);
        for (int b = 0; b < BATCH; ++b) {
            if (col >= C_KI && col < C_WI) { const int d0 = col - C_KI;
                *(u32x2*)(ws + WS_KIP + (size_t)b * KIP_BATCH + (size_t)((((t >> 5) * 4 + (d0 >> 4)) * 2 + ((d0 >> 3) & 1)) * 512 + (t & 31) * 16 + (d0 & 7) * 2)) = w; }
            else *(u32x2*)(P + ((size_t)b * T + t) * PW + col) = w;
        }
    }
}

__device__ __forceinline__ void phase_c3(const Params& p, char* lds) {
    unsigned char* ws = p.ws; const int tid = threadIdx.x, lane = tid & 63, wave = __builtin_amdgcn_readfirstlane(tid >> 6);
    const float* H1 = (const float*)(ws + WS_H1); const float* g = p.in[I_GFFN]; bf16_t* U2 = (bf16_t*)(ws + WS_U);
    const bf16_t* WH = (const bf16_t*)(ws + WS_WRT); const bf16_t* WL = WH + WRT_N * D;
    const float* bg = p.in[I_BGRP]; const float* br = p.in[I_BRT];
    unsigned* ctl = (unsigned*)(ws + WS_CTL); int* LIST = (int*)(ws + WS_LIST); float* GATE = (float*)(ws + WS_GATE); float* RS = (float*)(ws + WS_RSTD2);
    float* LG = (float*)lds + wave * (16 * 49 + 16);
    const int gw = blockIdx.x * NWAVES + wave, NGW = gridDim.x * NWAVES;
    const int tr = lane & 15, g4 = lane >> 4;
    for (int tile = gw; tile < NR / 16; tile += NGW) {
        const int row = tile * 16 + tr;
        const float* hp = H1 + (size_t)row * D + 8 * g4; bf16_t* up = U2 + (size_t)row * D + 8 * g4;
        const bf16_t* whp = WH + (size_t)tr * D + 8 * g4; const bf16_t* wlp = WL + (size_t)tr * D + 8 * g4;
        f32x4 acc[3]; float ss = 0.f;
#pragma unroll
        for (int nt = 0; nt < 3; ++nt) acc[nt] = (f32x4){0.f, 0.f, 0.f, 0.f};
        f32x4 xq[4][2]; bf16x8 bc[6], bn[6];
#pragma unroll
        for (int j = 0; j < 4; ++j) { xq[j][0] = *(const f32x4*)(hp + 32 * j); xq[j][1] = *(const f32x4*)(hp + 32 * j + 4); }
#pragma unroll
        for (int nt = 0; nt < 3; ++nt) { bc[2 * nt] = *(const bf16x8*)(whp + (size_t)nt * 16 * D); bc[2 * nt + 1] = *(const bf16x8*)(wlp + (size_t)nt * 16 * D); }
#pragma unroll 4
        for (int s = 0; s < 32; ++s) {
            const f32x4 x0 = xq[s & 3][0], x1 = xq[s & 3][1];
            { const int sn = s + 4 < 32 ? s + 4 : 31; xq[s & 3][0] = *(const f32x4*)(hp + 32 * sn); xq[s & 3][1] = *(const f32x4*)(hp + 32 * sn + 4); }
            { const int sb = s + 1 < 32 ? s + 1 : 31;
#pragma unroll
              for (int nt = 0; nt < 3; ++nt) { bn[2 * nt] = *(const bf16x8*)(whp + (size_t)nt * 16 * D + 32 * sb); bn[2 * nt + 1] = *(const bf16x8*)(wlp + (size_t)nt * 16 * D + 32 * sb); } }
            const f32x4 g0 = *(const f32x4*)(g + 32 * s + 8 * g4), g1 = *(const f32x4*)(g + 32 * s + 8 * g4 + 4);
            ss += (x0.x * x0.x + x0.y * x0.y) + (x0.z * x0.z + x0.w * x0.w) + (x1.x * x1.x + x1.y * x1.y) + (x1.z * x1.z + x1.w * x1.w);
            const f32x4 h0 = x0 * g0, h1 = x1 * g1;
            u32x4 hi; hi.x = pk2(h0.x, h0.y); hi.y = pk2(h0.z, h0.w); hi.z = pk2(h1.x, h1.y); hi.w = pk2(h1.z, h1.w);
            *(u32x4*)(up + 32 * s) = hi;
            u32x4 lo; lo.x = pk2(h0.x - bflo(hi.x), h0.y - bfhi(hi.x)); lo.y = pk2(h0.z - bflo(hi.y), h0.w - bfhi(hi.y)); lo.z = pk2(h1.x - bflo(hi.z), h1.y - bfhi(hi.z)); lo.w = pk2(h1.z - bflo(hi.w), h1.w - bfhi(hi.w));
            const bf16x8 ah = __builtin_bit_cast(bf16x8, hi), al = __builtin_bit_cast(bf16x8, lo);
#pragma unroll
            for (int nt = 0; nt < 3; ++nt) {
                acc[nt] = __builtin_amdgcn_mfma_f32_16x16x32_bf16(ah, bc[2 * nt], acc[nt], 0, 0, 0);
                acc[nt] = __builtin_amdgcn_mfma_f32_16x16x32_bf16(ah, bc[2 * nt + 1], acc[nt], 0, 0, 0);
                acc[nt] = __builtin_amdgcn_mfma_f32_16x16x32_bf16(al, bc[2 * nt], acc[nt], 0, 0, 0);
            }
#pragma unroll
            for (int j = 0; j < 6; ++j) bc[j] = bn[j];
        }
        ss = xsum16(xsum32(ss));
#pragma unroll
        for (int nt = 0; nt < 3; ++nt)
#pragma unroll
            for (int r = 0; r < 4; ++r) LG[(4 * g4 + r) * 49 + 16 * nt + tr] = acc[nt][r];
        if (g4 == 0) LG[16 * 49 + tr] = ss;
        asm volatile("s_waitcnt lgkmcnt(0)" ::: "memory");
        if (lane < 16) {
            const int tok = tile * 16 + lane; const float* lg = LG + lane * 49;
            const float rstd = rsqrtf(LG[16 * 49 + lane] * (1.f / D) + NORM_EPS);
            RS[tok] = rstd;
            float gl[4]; int gs = 0; float gm;
#pragma unroll
            for (int o = 0; o < 4; ++o) gl[o] = lg[o] * rstd + bg[o];
            gm = gl[0];
#pragma unroll
            for (int o = 1; o < 4; ++o) if (gl[o] > gm) { gm = gl[o]; gs = o; }
            float gsum = 0.f;
#pragma unroll
            for (int o = 0; o < 4; ++o) gsum += __expf(gl[o] - gm);
            const float pgrp = 1.f / gsum;
            float el[8];
#pragma unroll
            for (int j = 0; j < 8; ++j) el[j] = lg[4 + gs * 8 + j] * rstd + br[gs * 8 + j];
            int e0 = 0; float m0 = el[0];
#pragma unroll
            for (int j = 1; j < 8; ++j) if (el[j] > m0) { m0 = el[j]; e0 = j; }
            int e1 = -1; float m1 = -3e38f;
#pragma unroll
            for (int j = 0; j < 8; ++j) if (j != e0 && el[j] > m1) { m1 = el[j]; e1 = j; }
            const float x1 = __expf(m1 - m0); const float g0 = pgrp / (1.f + x1), g1 = pgrp * x1 / (1.f + x1);
            const int ex0 = gs * 8 + e0, ex1 = gs * 8 + e1;
            const int s0 = (int)atomicAdd(ctl + CW_CNT + 64 * ex0, 1u); LIST[(size_t)ex0 * NR + s0] = tok * 2;
            const int s1 = (int)atomicAdd(ctl + CW_CNT + 64 * ex1, 1u); LIST[(size_t)ex1 * NR + s1] = tok * 2 + 1;
            GATE[tok * 2] = g0; GATE[tok * 2 + 1] = g1;
        }
        asm volatile("s_waitcnt lgkmcnt(0)" ::: "memory");
    }
}

template <int WHICH>
__device__ __forceinline__ void phase_moe(const Params& p, char* lds) {
    unsigned char* ws = p.ws; const int tid = threadIdx.x;
    const unsigned* ctl = (const unsigned*)(ws + WS_CTL);
    int* TP = (int*)(lds + pg8::STAGE_BYTES);
    __syncthreads();
    if (tid == 0) { int tp = 0, ro = 0; for (int e = 0; e < NEXP; ++e) { const int c = (int)ctl[CW_CNT + 64 * e]; TP[e] = tp; TP[64 + e] = ro; TP[128 + e] = c; const int t = (c + 255) / 256; tp += t * 4; ro += t * 256; } TP[NEXP] = tp; }
    __syncthreads();
    pg8::MoeOrder<WHICH> S{TP, (int)gridDim.x, (int)blockIdx.x, (const char*)(ws + (WHICH == 0 ? WS_U : WS_HID)), (const char*)(ws + (WHICH == 0 ? WS_W13 : WS_W2)), (const int*)(ws + WS_LIST)};
    if constexpr (WHICH == 0) { pg8::EpiMoe1 E{(bf16_t*)(ws + WS_HID), TP, (const int*)(ws + WS_LIST), (const float*)(ws + WS_RSTD2)}; pg8::gemm_phase_x<pg8::EpiMoe1, pg8::MoeOrder<0>, true, true>((LAS unsigned char*)lds, 1024, S, E); }
    else { pg8::EpiMoe2 E{(bf16_t*)(ws + WS_MO), TP, (const int*)(ws + WS_LIST), (const float*)(ws + WS_GATE)}; pg8::gemm_phase_x<pg8::EpiMoe2, pg8::MoeOrder<1>, true, true>((LAS unsigned char*)lds, 512, S, E); }
}

__device__ __forceinline__ void phase_final(const Params& p) {
    unsigned char* ws = p.ws; const int tid = threadIdx.x, lane = tid & 63, wave = tid >> 6;
    const float* H1 = (const float*)(ws + WS_H1); const bf16_t* MO = (const bf16_t*)(ws + WS_MO); const float* g = p.in[I_GFIN];
    const int gw = blockIdx.x * NWAVES + wave, NGW = gridDim.x * NWAVES;
    for (int orow = gw; orow < BATCH * SEQ; orow += NGW) {
        const size_t row = (size_t)orow;
        const f32x4* xr = (const f32x4*)(H1 + row * D) + lane; const u32x2* m0 = (const u32x2*)(MO + row * 2 * D) + lane; const u32x2* m1 = m0 + 256;
        f32x4 v[4]; float ss = 0.f;
#pragma unroll
        for (int j = 0; j < 4; ++j) { const u32x2 a = m0[64 * j], c = m1[64 * j]; v[j] = xr[64 * j];
            v[j].x += bflo(a.x) + bflo(c.x); v[j].y += bfhi(a.x) + bfhi(c.x); v[j].z += bflo(a.y) + bflo(c.y); v[j].w += bfhi(a.y) + bfhi(c.y);
            ss += (v[j].x * v[j].x + v[j].y * v[j].y) + (v[j].z * v[j].z + v[j].w * v[j].w); }
        const float rstd = rsqrtf(wave_sum(ss) * (1.f / D) + NORM_EPS);
        f32x4* o = (f32x4*)(p.out + (size_t)orow * D) + lane;
#pragma unroll
        for (int j = 0; j < 4; ++j) { const f32x4 gg = ((const f32x4*)g)[lane + 64 * j]; o[64 * j] = v[j] * rstd * gg; }
    }
}

#define XB_TMO      128
#define XB_XCNT(j)  (256  + 64 * (j))
#define XB_XSUB(j)  (1280 + 64 * (j))
#define XB_XGEN(j)  (2304 + 64 * (j))
#define XB_TOP      3328
#define XB_TOPGEN   3392
#define XCD_BAR_WORDS 3456
#define XB_SPIN_CAP (1u << 18)
__device__ __forceinline__ unsigned xb_ld(unsigned* p)              { return __hip_atomic_load(p, __ATOMIC_RELAXED, __HIP_MEMORY_SCOPE_AGENT); }
__device__ __forceinline__ unsigned xb_add(unsigned* p, unsigned v) { return __hip_atomic_fetch_add(p, v, __ATOMIC_RELAXED, __HIP_MEMORY_SCOPE_AGENT); }
__device__ __forceinline__ unsigned xb_xcc_id() { return (unsigned)__builtin_amdgcn_s_getreg((3 << 11) | 20) & 0xFu; }
#define XB_SPIN(cond, bar) do { unsigned _sp = 0; while (cond) { __builtin_amdgcn_s_sleep(1); \
    if ((++_sp & 255u) == 0u) { if (xb_ld(&(bar)[XB_TMO])) break; if (_sp > XB_SPIN_CAP) { atomicAdd(&(bar)[XB_TMO], 1u); break; } } } } while (0)
struct XcdBarrier { unsigned* bar; unsigned x; volatile LAS unsigned* st; };
__device__ __forceinline__ XcdBarrier xcd_barrier_post(unsigned* bar, volatile LAS unsigned* st) {
    XcdBarrier b; b.bar = bar; b.x = xb_xcc_id(); b.st = st;
    if (threadIdx.x == 0) (void)xb_add(&bar[XB_XCNT(b.x)], 1u);
    return b;
}
__device__ __forceinline__ void xcd_barrier_complete(unsigned* bar, unsigned x, unsigned& nloc, unsigned& nx) {
    const unsigned G = gridDim.x * gridDim.y * gridDim.z;
    unsigned sum, cnt, mine, sp = 0u;
    for (;;) {
        sum = 0u; cnt = 0u; mine = 0u;
#pragma unroll
        for (unsigned j = 0; j < 16; ++j) { const unsigned c = xb_ld(&bar[XB_XCNT(j)]); sum += c; cnt += (c > 0u) ? 1u : 0u; mine = (j == x) ? c : mine; }
        if (sum == G) break;
        __builtin_amdgcn_s_sleep(1);
        if ((++sp & 255u) == 0u) { if (xb_ld(&bar[XB_TMO])) break; if (sp > XB_SPIN_CAP) { atomicAdd(&bar[XB_TMO], 1u); break; } }
    }
    nloc = mine > 0u ? mine : 1u; nx = cnt > 0u ? cnt : 1u;
}
__device__ __forceinline__ void xcd_barrier(const XcdBarrier& b) {
    asm volatile("s_waitcnt vmcnt(0)" ::: "memory");
    __syncthreads();
    if (threadIdx.x == 0) {
        unsigned* bar = b.bar;
        __builtin_amdgcn_s_waitcnt(0);
        unsigned nloc = b.st[0], nx = b.st[1];
        if (nloc == 0u) { xcd_barrier_complete(bar, b.x, nloc, nx); b.st[0] = nloc; b.st[1] = nx; }
        const unsigned old = xb_add(&bar[XB_XSUB(b.x)], 1u);
        const unsigned gen = old / nloc;
        if (old + 1u == (gen + 1u) * nloc) {
            __builtin_amdgcn_fence(__ATOMIC_RELEASE, "agent");
            asm volatile("s_waitcnt vmcnt(0)" ::: "memory");
            const unsigned og = xb_add(&bar[XB_TOP], 1u);
            const unsigned tg = og / nx;
            if (og + 1u == (tg + 1u) * nx) xb_add(&bar[XB_TOPGEN], 1u);
            else XB_SPIN(xb_ld(&bar[XB_TOPGEN]) == tg, bar);
            __builtin_amdgcn_fence(__ATOMIC_ACQUIRE, "agent");
            xb_add(&bar[XB_XGEN(b.x)], 1u);
            asm volatile("s_waitcnt vmcnt(0)" ::: "memory");
        } else {
            XB_SPIN(xb_ld(&bar[XB_XGEN(b.x)]) == gen, bar);
            __builtin_amdgcn_fence(__ATOMIC_ACQUIRE, "agent");
            asm volatile("s_waitcnt vmcnt(0)" ::: "memory");
        }
    }
    __syncthreads();
}

constexpr int LDS_XB = DSA_LDS;
constexpr int LDS_BYTES = DSA_LDS + 256;
static_assert(pg8::STAGE_BYTES <= LDS_XB && pg8::STAGE_BYTES + 1024 <= LDS_XB && NWAVES * 64 * 33 * 4 <= LDS_XB && NWAVES * 32 * SB_VROW <= LDS_XB && NWAVES * (16 * 49 + 16) * 4 <= LDS_XB, "LDS map");

__global__ void __launch_bounds__(NTHREADS, 2) mega(Params p) {
    extern __shared__ __attribute__((aligned(16))) char lds[];
    const int lo = p.ph_lo, hi = p.ph_hi;
    unsigned char* ws = p.ws;
    XcdBarrier xb;
    {
        volatile LAS unsigned* st = (volatile LAS unsigned*)(lds + LDS_XB);
        if (threadIdx.x < 4) st[threadIdx.x] = 0u;
        __syncthreads();
        xb = xcd_barrier_post((unsigned*)(ws + WS_CTL) + CW_BAR, st);
    }
#define IN(k) (lo <= (k) && (k) < hi)
#define GSYNC() xcd_barrier(xb)
#define SEAM(k) do { if (IN(k) && IN((k) + 1)) GSYNC(); } while (0)
#define REP(k, ...) do { if (IN(k)) { __VA_ARGS__; } } while (0)
    LAS unsigned char* ldsl = (LAS unsigned char*)lds;
    REP(0, phase_prologue(p, lds));
    SEAM(0);
    REP(1, { phase_inproj_meta(p);
             pg8::TokRowOrder S; S.init(NR, PWN, gridDim.x, blockIdx.x); S.Abase = (const char*)(ws + WS_U); S.Bbase = (const char*)(ws + WS_WP); S.K = D;
             pg8::EpiInproj E{(bf16_t*)(ws + WS_P), (const float2*)(ws + WS_CS), ws + WS_KIP}; pg8::gemm_phase_x<pg8::EpiInproj, pg8::TokRowOrder, true, true>(ldsl, D, S, E); });
    SEAM(1);
    if (IN(2)) {
        phase_dsa(p, lds);
        __syncthreads(); phase_sb_fast(p, lds);
    }
    SEAM(2);
    REP(3, { pg8::TokRowOrder S; S.init(NR, 2048, gridDim.x, blockIdx.x); S.Abase = (const char*)(ws + WS_U); S.Bbase = (const char*)(ws + WS_WG); S.K = D;
             pg8::EpiGate E{(bf16_t*)(ws + WS_G)}; pg8::gemm_phase_x<pg8::EpiGate, pg8::TokRowOrder, true, true>(ldsl, D, S, E); });
    SEAM(3);
    REP(4, { { pg8::Gemm g{(const bf16_t*)(ws + WS_YA), (const bf16_t*)(ws + WS_WUA), NR, D, 512}; pg8::StaticOrder S; S.init(NR, D, gridDim.x, blockIdx.x);
               pg8::EpiZ<false> E{(bf16_t*)(ws + WS_Z), (const bf16_t*)(ws + WS_G), 0}; pg8::gemm_phase<pg8::EpiZ<false>, pg8::StaticOrder, true, true>(ldsl, g, S, E); }
             asm volatile("s_waitcnt vmcnt(0)" ::: "memory"); __syncthreads();
             { pg8::Gemm g{(const bf16_t*)(ws + WS_OLAT), (const bf16_t*)(ws + WS_WBP), NR, D, D}; pg8::StaticOrder S; S.init(NR, D, gridDim.x, blockIdx.x);
               pg8::EpiZ<true> E{(bf16_t*)(ws + WS_Z), (const bf16_t*)(ws + WS_G), 1024}; pg8::gemm_phase<pg8::EpiZ<true>, pg8::StaticOrder, true, true>(ldsl, g, S, E); } });
    SEAM(4);
    REP(5, { pg8::Gemm g{(const bf16_t*)(ws + WS_Z), (const bf16_t*)(ws + WS_WO), NR, D, D}; pg8::StaticOrder S; S.init(NR, D, gridDim.x, blockIdx.x);
             pg8::EpiH1 E{(float*)(ws + WS_H1), p.in[I_META], p.in[I_X]}; pg8::gemm_phase<pg8::EpiH1, pg8::StaticOrder, true, true>(ldsl, g, S, E); });
    SEAM(5);
    if (IN(6)) phase_c3(p, lds);
    SEAM(6);
    REP(7, phase_moe<0>(p, lds));
    SEAM(7);
    REP(8, phase_moe<1>(p, lds));
    SEAM(8);
    REP(9, phase_final(p));
}

extern "C" void kernel_launch(void* const* d_in, const int* in_sizes, int n_in, void* d_out, int out_size, void* d_ws, size_t ws_size, hipStream_t stream) {
    if (n_in != 18 || ws_size < WS_END) { fprintf(stderr, "kernel_launch: unexpected n_in %d / ws_size %zu\n", n_in, ws_size); return; }
    static int grid = 0;
    if (grid == 0) {
        int dev = 0, cus = 0, per_cu = 0;
        (void)hipGetDevice(&dev);
        (void)hipDeviceGetAttribute(&cus, hipDeviceAttributeMultiprocessorCount, dev);
        (void)hipFuncSetAttribute((const void*)mega, hipFuncAttributeMaxDynamicSharedMemorySize, LDS_BYTES);
        (void)hipOccupancyMaxActiveBlocksPerMultiprocessor(&per_cu, (const void*)mega, NTHREADS, LDS_BYTES);
        if (per_cu < 1) fprintf(stderr, "kernel_launch: occupancy query reports %d workgroups per CU\n", per_cu);
        grid = cus;
    }
    (void)hipMemsetAsync((char*)d_ws + WS_CTL, 0, CTL_BYTES, stream);
    Params p{};
    for (int i = 0; i < 18; ++i) p.in[i] = (const float*)d_in[i];
    p.out = (float*)d_out; p.ws = (unsigned char*)d_ws;
    p.ph_lo = 0; p.ph_hi = 10;
    void* args[] = {&p};
    hipError_t e = hipLaunchCooperativeKernel((const void*)mega, dim3(grid), dim3(NTHREADS), args, LDS_BYTES, stream);
    if (e != hipSuccess) fprintf(stderr, "cooperative launch failed: %s (grid %d)\n", hipGetErrorString(e), grid);
}
```

```cpp
#include <hip/hip_runtime.h>
#include <cstdio>
#include <cstdint>

constexpr int BATCH = 8, SEQ = 4096, NMETA = 16, T = SEQ + NMETA, D = 1024, NTOK = BATCH * T;
constexpr int MROWS = 33024;
constexpr int NR = BATCH * SEQ;
__device__ __forceinline__ int tokrow(int cr) { return cr + NMETA * (cr / SEQ + 1); }
constexpr int INW = 4824;
constexpr int NEXP = 32, DEXP = 512;
constexpr int NWAVES = 8, NTHREADS = 512;
constexpr float NORM_EPS = 1e-6f;
constexpr float LOG2E = 1.4426950408889634f;
constexpr float QSCALE = 0.125f * LOG2E;
constexpr int PW = 3456, PWN = 3584;
constexpr int C_QA = 0, C_KA = 512, C_VA = 1024, C_QF = 1536, C_KV = 2688, C_QI = 2832, C_KI = 3344, C_WI = 3408, C_END = 3416;
constexpr int QFW = 144;

constexpr size_t MiB = 1u << 20;
constexpr size_t WS_CTL = 0, CTL_BYTES = 1 * MiB;
constexpr size_t WS_CS = 1 * MiB;
constexpr size_t WS_WRT = 1 * MiB + 512 * 1024;
constexpr int WRT_N = 48;
constexpr size_t WS_WP = 2 * MiB;
constexpr size_t WS_WG = 9 * MiB;
constexpr size_t WS_WUA = 13 * MiB, WS_WBP = 14 * MiB, WS_WO = 16 * MiB;
constexpr size_t WS_W2 = 18 * MiB;
constexpr size_t WS_W13 = 50 * MiB;
constexpr size_t WS_U = 114 * MiB;
constexpr size_t WS_P = 179 * MiB;
constexpr size_t WS_Z = 179 * MiB;
constexpr size_t WS_G = 244 * MiB;
constexpr size_t WS_H1 = 244 * MiB;
constexpr size_t WS_LIST = 374 * MiB;
constexpr size_t WS_GATE = 379 * MiB;
constexpr size_t WS_RSTD2 = 380 * MiB;
constexpr size_t WS_YA = 397 * MiB;
constexpr size_t WS_OLAT = 430 * MiB;
constexpr size_t WS_HID = 397 * MiB;
constexpr size_t WS_MO = 50 * MiB;
constexpr size_t WS_KIP = 495 * MiB;
constexpr size_t KIP_BATCH = 129 * 4096;
constexpr size_t WS_END = 500 * MiB;
static_assert(WS_P + (size_t)MROWS * PW * 2 <= WS_YA && WS_G + (size_t)MROWS * 2048 * 2 <= WS_LIST && WS_Z + (size_t)MROWS * 1024 * 2 <= WS_G, "ws map");
static_assert(WS_OLAT + (size_t)MROWS * 1024 * 2 <= WS_END && WS_U + (size_t)MROWS * 1024 * 2 <= WS_P && WS_MO + (size_t)NTOK * 2048 * 2 <= WS_P, "ws map");
constexpr int CW_CNT = 1024;
constexpr int CW_BAR = 4096;

typedef unsigned short bf16_t;
typedef short bf16x8 __attribute__((ext_vector_type(8)));
typedef float f32x4 __attribute__((ext_vector_type(4)));
typedef float f32x16 __attribute__((ext_vector_type(16)));
typedef unsigned u32x2 __attribute__((ext_vector_type(2)));
typedef unsigned u32x4 __attribute__((ext_vector_type(4)));
typedef unsigned short u16x4 __attribute__((ext_vector_type(4)));
#define LAS __attribute__((address_space(3)))

__device__ __forceinline__ unsigned f2bf(float f) { unsigned u = __float_as_uint(f); return (u + 0x7fffu + ((u >> 16) & 1u)) >> 16; }
typedef __bf16 bf16v2_t __attribute__((ext_vector_type(2)));
typedef float f32v2_t __attribute__((ext_vector_type(2)));
__device__ __forceinline__ unsigned pk2(float lo, float hi) { const f32v2_t v = {lo, hi}; const bf16v2_t r = __builtin_convertvector(v, bf16v2_t); return __builtin_bit_cast(unsigned, r); }
__device__ __forceinline__ float bflo(unsigned w) { return __uint_as_float(w << 16); }
__device__ __forceinline__ float bfhi(unsigned w) { return __uint_as_float(w & 0xffff0000u); }
__device__ __forceinline__ float bf2f(bf16_t b) { return __uint_as_float((unsigned)b << 16); }
__device__ __forceinline__ float wave_sum(float v) {
#pragma unroll
    for (int o = 1; o < 64; o <<= 1) v += __shfl_xor(v, o);
    return v;
}
__device__ __forceinline__ float fmax2(float a, float b) { return __builtin_amdgcn_fmed3f(a, b, 3.0e38f); }
__device__ __forceinline__ float xsum32(float x) { const auto r = __builtin_amdgcn_permlane32_swap(__float_as_uint(x), __float_as_uint(x), false, false); return __uint_as_float(r[0]) + __uint_as_float(r[1]); }
__device__ __forceinline__ float xsum16(float x) { const auto r = __builtin_amdgcn_permlane16_swap(__float_as_uint(x), __float_as_uint(x), false, false); return __uint_as_float(r[0]) + __uint_as_float(r[1]); }
__device__ __forceinline__ float xmax32(float x) { const auto r = __builtin_amdgcn_permlane32_swap(__float_as_uint(x), __float_as_uint(x), false, false); return fmax2(__uint_as_float(r[0]), __uint_as_float(r[1])); }
__device__ __forceinline__ float xmax16(float x) { const auto r = __builtin_amdgcn_permlane16_swap(__float_as_uint(x), __float_as_uint(x), false, false); return fmax2(__uint_as_float(r[0]), __uint_as_float(r[1])); }
__device__ __forceinline__ float xpartner32(float x, int hh) { const auto r = __builtin_amdgcn_permlane32_swap(__float_as_uint(x), __float_as_uint(x), false, false); return __uint_as_float(hh ? r[0] : r[1]); }
__device__ __forceinline__ float fexp2(float x) { return __builtin_amdgcn_exp2f(x); }
__device__ __forceinline__ float sigmoidf(float x) { return __builtin_amdgcn_rcpf(1.0f + fexp2(-LOG2E * x)); }

struct Params {
    const float* in[18];
    float* out;
    unsigned char* ws;
    int ph_lo, ph_hi;
};
enum { I_X = 0, I_META, I_GMIX, I_WIN, I_WUK, I_WUV, I_WUPA, I_WUPB, I_WO, I_GFFN, I_WGRP, I_BGRP, I_WRT, I_BRT, I_W1, I_W3, I_W2, I_GFIN };

__device__ __forceinline__ const float* h0_row(const Params& p, int row) {
    const int b = row / T, t = row - b * T;
    return t < NMETA ? p.in[I_META] + (size_t)t * D : p.in[I_X] + ((size_t)b * SEQ + (t - NMETA)) * D;
}
template <class F>
__device__ __forceinline__ void tr_item(F val, bf16_t* dst, int ldd, int row0, int k0, float* scr, int lane, int rstep = 1) {
    float tv[32];
#pragma unroll
    for (int i = 0; i < 32; ++i) tv[i] = val(k0 + 2 * i + (lane >> 5), lane & 31);
#pragma unroll
    for (int i = 0; i < 32; ++i) scr[(2 * i + (lane >> 5)) * 33 + (lane & 31)] = tv[i];
    __builtin_amdgcn_s_waitcnt(0xC07F);
    asm volatile("" ::: "memory");
    const int c = lane & 7;
#pragma unroll
    for (int j = 0; j < 4; ++j) {
        const int n = (lane >> 3) + 8 * j; const float* s = scr + (8 * c) * 33 + n;
        u32x4 o; o.x = pk2(s[0], s[33]); o.y = pk2(s[66], s[99]); o.z = pk2(s[132], s[165]); o.w = pk2(s[198], s[231]);
        *(u32x4*)(dst + (size_t)(row0 + n * rstep) * ldd + k0 + 8 * c) = o;
    }
    __builtin_amdgcn_s_waitcnt(0xC07F);
    asm volatile("" ::: "memory");
}

__device__ __forceinline__ void wp_src(int c, int& kind, int& col, int& aux, float& scale) {
    kind = 1; aux = 0; scale = 1.f; col = 0;
    if (c < 512) { col = c; scale = QSCALE; }
    else if (c < C_QF) { col = c; }
    else if (c < C_KV) { const int r = c - C_QF, h = r / QFW, j = r % QFW; scale = QSCALE;
        if (j < 128) { kind = 2; col = h; aux = j; } else { const int i = j - 128; col = 1536 + 64 * h + (i >> 1) + 8 * (i & 1); } }
    else if (c < C_QI) { const int j = c - C_KV; if (j < 128) col = 2048 + j; else { const int i = j - 128; col = 2176 + (i >> 1) + 8 * (i & 1); } }
    else if (c < C_KI) { const int r = c - C_QI, h = r >> 6, j = r & 63; col = 2192 + 64 * h + (j < 16 ? (j >> 1) + 8 * (j & 1) : j); }
    else if (c < C_WI) { const int j = c - C_KI; col = 2704 + (j < 16 ? (j >> 1) + 8 * (j & 1) : j); }
    else if (c < C_END) { col = 2768 + (c - C_WI); }
    else kind = 0;
}

constexpr int IT_WP = (PWN / 32) * 16;
constexpr int IT_WG = 32 * 16;
constexpr int IT_WUA = 32 * 8;
constexpr int IT_WBP = 32 * 16, IT_WO = 32 * 16;
constexpr int IT_W13 = NEXP * 32 * 16;
constexpr int IT_W2 = NEXP * 32 * 8;
constexpr int IT_TOTAL = IT_WP + 2 * IT_WG + IT_WUA + IT_WBP + IT_WO + IT_W13 + IT_W2;

__device__ __forceinline__ void phase_prologue(const Params& p, char* lds) {
    const int tid = threadIdx.x, lane = tid & 63, wave = tid >> 6;
    const int gw = blockIdx.x * NWAVES + wave, NGW = gridDim.x * NWAVES;
    float* scr = (float*)lds + wave * (64 * 33);
    unsigned char* ws = p.ws;
    const float* w_in = p.in[I_WIN];
    {
        float2* cs = (float2*)(ws + WS_CS);
        for (int i = blockIdx.x * NTHREADS + tid; i < T * 8; i += gridDim.x * NTHREADS) {
            const int pos = i >> 3, f = i & 7;
            const float inv = powf(500000.0f, -(float)f / 8.0f);
            const float ang = (float)pos * inv;
            cs[i] = make_float2(cosf(ang), sinf(ang));
        }
    }
    {
        bf16_t* wrt = (bf16_t*)(ws + WS_WRT); const float* wgp = p.in[I_WGRP]; const float* wrp = p.in[I_WRT];
        for (int i = blockIdx.x * NTHREADS + tid; i < WRT_N * D; i += gridDim.x * NTHREADS) {
            const int nn = i >> 10, k = i & 1023;
            const float w = nn < 4 ? wgp[k * 4 + nn] : nn < 36 ? wrp[k * 32 + (nn - 4)] : 0.f;
            const unsigned hi = f2bf(w); wrt[i] = (bf16_t)hi; wrt[WRT_N * D + i] = (bf16_t)f2bf(w - __uint_as_float(hi << 16));
        }
    }
    for (int it = gw; it < IT_TOTAL; it += NGW) {
        int r = it;
        if (r < IT_WP) {
            const int rg = r / 16, kb = r % 16, c = rg * 32 + (lane & 31);
            int kind, col, aux; float scale; wp_src(c, kind, col, aux, scale);
            const float* w_uk = p.in[I_WUK];
            float wu[48];
#pragma unroll
            for (int n4 = 0; n4 < 12; ++n4) { f32x4 t = (f32x4){0.f, 0.f, 0.f, 0.f}; if (kind == 2) t = *(const f32x4*)(w_uk + ((size_t)col * 128 + aux) * 48 + 4 * n4); wu[4 * n4] = t.x; wu[4 * n4 + 1] = t.y; wu[4 * n4 + 2] = t.z; wu[4 * n4 + 3] = t.w; }
            tr_item([&](int k, int) -> float {
                if (kind == 0) return 0.f;
                if (kind == 1) return scale * w_in[(size_t)k * INW + col];
                const f32x4* wi = (const f32x4*)(w_in + (size_t)k * INW + 1536 + 64 * col + 16);
                float s = 0.f;
#pragma unroll
                for (int n4 = 0; n4 < 12; ++n4) { const f32x4 t = wi[n4]; s += t.x * wu[4 * n4] + t.y * wu[4 * n4 + 1] + t.z * wu[4 * n4 + 2] + t.w * wu[4 * n4 + 3]; }
                return scale * s; }, (bf16_t*)(ws + WS_WP), 1024, rg * 32, kb * 64, scr, lane);
            continue; }
        r -= IT_WP;
        if (r < 2 * IT_WG) {
            const int which = r / IT_WG; r %= IT_WG; const int rg = r / 16, kb = r % 16; const int col0 = (which ? 3800 : 2776) + rg * 32;
            tr_item([&](int k, int n) -> float { return w_in[(size_t)k * INW + col0 + n]; }, (bf16_t*)(ws + WS_WG) + (size_t)which * 1024 * 1024, 1024, rg * 32, kb * 64, scr, lane);
            continue; }
        r -= 2 * IT_WG;
        if (r < IT_WUA) {
            const int rg = r / 8, kb = r % 8; const float* w = p.in[I_WUPA];
            tr_item([&](int k, int n) -> float { return w[(size_t)k * 1024 + rg * 32 + n]; }, (bf16_t*)(ws + WS_WUA), 512, rg * 32, kb * 64, scr, lane);
            continue; }
        r -= IT_WUA;
        if (r < IT_WO) {
            const int rg = r / 16, kb = r % 16; const float* w = p.in[I_WO];
            tr_item([&](int k, int n) -> float { return w[(size_t)k * 1024 + rg * 32 + n]; }, (bf16_t*)(ws + WS_WO), 1024, rg * 32, kb * 64, scr, lane);
            continue; }
        r -= IT_WO;
        if (r < IT_WBP) {
            const int rg = r / 16, kb = r % 16; const float* wuv = p.in[I_WUV]; const float* wub = p.in[I_WUPB];
            const int hB = kb >> 1;
            float bc[64];
#pragma unroll
            for (int d = 0; d < 64; ++d) bc[d] = wub[(size_t)(64 * hB + d) * 1024 + rg * 32 + (lane & 31)];
            tr_item([&](int kk, int) -> float {
                const f32x4* a = (const f32x4*)(wuv + (size_t)kk * 64);
                float s = 0.f;
#pragma unroll
                for (int d4 = 0; d4 < 16; ++d4) { const f32x4 t = a[d4]; s += t.x * bc[4 * d4] + t.y * bc[4 * d4 + 1] + t.z * bc[4 * d4 + 2] + t.w * bc[4 * d4 + 3]; }
                return s; }, (bf16_t*)(ws + WS_WBP), 1024, rg * 32, kb * 64, scr, lane);
            continue; }
        r -= IT_WBP;
        if (r < IT_W13) {
            const int e = r / 512; r %= 512; const int which = r & 1, cg = (r >> 1) & 15, kb = r >> 5;
            const float* w = (which ? p.in[I_W3] : p.in[I_W1]) + (size_t)e * 1024 * 512 + cg * 32;
            tr_item([&](int k, int n) -> float { return w[(size_t)k * 512 + n]; },
                    (bf16_t*)(ws + WS_W13) + (size_t)e * 1024 * 1024, 1024, 2 * cg * 32 + which, kb * 64, scr, lane, 2);
            continue; }
        r -= IT_W13;
        {
            const int e = r / 256; r %= 256; const int rg = r / 8, kb = r % 8;
            const float* w2 = p.in[I_W2] + (size_t)e * 512 * 1024;
            tr_item([&](int k, int n) -> float { return w2[(size_t)k * 1024 + rg * 32 + n]; }, (bf16_t*)(ws + WS_W2) + (size_t)e * 1024 * 512, 512, rg * 32, kb * 64, scr, lane);
        }
    }
    {
        const float* g = p.in[I_GMIX]; bf16_t* U = (bf16_t*)(ws + WS_U);
        f32x4 vn[4];
        if (gw < NTOK) { const f32x4* xr = (const f32x4*)h0_row(p, gw) + lane;
#pragma unroll
            for (int j = 0; j < 4; ++j) vn[j] = xr[64 * j]; }
        for (int row = gw; row < NTOK; row += NGW) {
            f32x4 v[4]; float s = 0.f;
#pragma unroll
            for (int j = 0; j < 4; ++j) v[j] = vn[j];
            if (row + NGW < NTOK) { const f32x4* xr = (const f32x4*)h0_row(p, row + NGW) + lane;
#pragma unroll
                for (int j = 0; j < 4; ++j) vn[j] = xr[64 * j]; }
#pragma unroll
            for (int j = 0; j < 4; ++j) s += (v[j].x * v[j].x + v[j].y * v[j].y) + (v[j].z * v[j].z + v[j].w * v[j].w);
            const float rstd = rsqrtf(wave_sum(s) * (1.f / D) + NORM_EPS);
            u32x2* o = (u32x2*)(U + (size_t)row * D) + lane;
#pragma unroll
            for (int j = 0; j < 4; ++j) { const f32x4 gg = ((const f32x4*)g)[lane + 64 * j];
                u32x2 w; w.x = pk2(v[j].x * rstd * gg.x, v[j].y * rstd * gg.y); w.y = pk2(v[j].z * rstd * gg.z, v[j].w * rstd * gg.w); o[64 * j] = w; }
        }
    }
}

namespace pg8 {
#define PG8_LAS __attribute__((address_space(3)))
typedef unsigned short bf16_t;
typedef short bf16x8 __attribute__((ext_vector_type(8)));
typedef float f32x4 __attribute__((ext_vector_type(4)));
typedef unsigned u32x4 __attribute__((ext_vector_type(4)));
constexpr int BM = 256, BK = 64, HALF = 128, HTB = HALF * BK * 2  , STAGE_BYTES = 8 * HTB, NXCD = 8, WGM = 8;

__host__ __device__ __forceinline__ int lds_byte(int r, int c) { const int st = (r >> 4) * 2 + (c >> 5), rr = r & 15, cc = c & 31, ob = rr * 64 + cc * 2; return st * 1024 + (ob ^ (((ob >> 9) & 1) << 5)); }
__host__ __device__ __forceinline__ void stage_rc(int b, int& R, int& C) { const int st = b / 1024, sb = b % 1024, swz = sb ^ (((sb >> 9) & 1) << 5); R = (st >> 1) * 16 + swz / 64; C = (st & 1) * 32 + (swz % 64) / 2; }
__host__ __device__ __forceinline__ int perm32(int rho) { const int n = rho >> 4, i = rho & 15; return 8 * (i >> 2) + 4 * n + (i & 3); }

struct Unit { int pm, pn; };
struct Gemm { const bf16_t* A; const bf16_t* Bt; int M, N, K; };

struct StaticOrder {
    int nM, nN, nwg, G, c;
    __host__ __device__ void init(int M, int N, int G_, int c_) { nM = M / BM; nN = N / BM; nwg = nM * nN; G = G_; c = c_; }
    __host__ __device__ bool next(int i, Unit& u) const {
        const long L = (long)i * G + c; if (L >= nwg) return false;
        int wgid = (int)L; { const int q = nwg / NXCD, r = nwg % NXCD, xcd = wgid % NXCD, off = wgid / NXCD; wgid = (xcd < r ? xcd * (q + 1) : r * (q + 1) + (xcd - r) * q) + off; }
        const int nig = WGM * nN, gid = wgid / nig, fm = gid * WGM, gsz = (nM - fm) < WGM ? (nM - fm) : WGM;
        u.pm = fm + ((wgid % nig) % gsz); u.pn = (wgid % nig) / gsz; return true;
    }
    __device__ __forceinline__ void a_ready(const Unit&) const {}
    __device__ __forceinline__ void done(const Unit&) const {}
};


#define PG8_FOR_FRAGS(...) _Pragma("unroll") for (int ai = 0; ai < 2; ++ai) _Pragma("unroll") for (int m = 0; m < 4; ++m) { const int row = u.pm * BM + ai * HALF + wr * 64 + m * 16 + fr; \
    _Pragma("unroll") for (int bj = 0; bj < 2; ++bj) _Pragma("unroll") for (int n = 0; n < 2; ++n) { const int col = u.pn * BM + bj * HALF + wc * 32 + n * 16 + 4 * fq; ::f32x4 v = acc[ai][bj][m][n]; __VA_ARGS__ } }
__device__ __forceinline__ bool rope_off(int c, int& o) {
    if (c < C_QF) return false;
    if (c < C_KV) { const int j = (c - C_QF) % QFW; o = j - 128; return j >= 128; }
    if (c < C_QI) { const int j = c - C_KV; o = j - 128; return j >= 128; }
    if (c < C_KI) { const int j = (c - C_QI) & 63; o = j; return j < 16; }
    if (c < C_WI) { const int j = c - C_KI; o = j; return j < 16; }
    return false;
}
#define PG8_FOR_FRAGS8(...) _Pragma("unroll") for (int ai = 0; ai < 2; ++ai) _Pragma("unroll") for (int m = 0; m < 4; ++m) { const int row = u.pm * BM + ai * HALF + wr * 64 + m * 16 + fr; \
    _Pragma("unroll") for (int bj = 0; bj < 2; ++bj) { const int col = u.pn * BM + bj * HALF + wc * 32 + 8 * fq; ::f32x4 v0 = acc[ai][bj][m][0], v1 = acc[ai][bj][m][1]; __VA_ARGS__ } }
struct EpiInproj {
    static constexpr bool PERM = true, AFTER_DRAIN = false;
    bf16_t* P; const float2* cs; unsigned char* KIP;
    __device__ __forceinline__ void operator()(const f32x4 (&acc)[2][2][4][2], const Unit& u, int wr, int wc, int fr, int fq) const {
        PG8_FOR_FRAGS8(
            if (col < PW) {
                int o; const int trow = tokrow(row);
                if (rope_off(col, o)) {
                    const int pos = (row % SEQ) + NMETA; const float2* cp = cs + pos * 8 + (o >> 1); const float2 c0 = cp[0], c1 = cp[1], c2 = cp[2], c3 = cp[3];
                    v0 = (::f32x4){v0.x * c0.x - v0.y * c0.y, v0.y * c0.x + v0.x * c0.y, v0.z * c1.x - v0.w * c1.y, v0.w * c1.x + v0.z * c1.y};
                    v1 = (::f32x4){v1.x * c2.x - v1.y * c2.y, v1.y * c2.x + v1.x * c2.y, v1.z * c3.x - v1.w * c3.y, v1.w * c3.x + v1.z * c3.y};
                }
                ::u32x4 w; w.x = pk2(v0.x, v0.y); w.y = pk2(v0.z, v0.w); w.z = pk2(v1.x, v1.y); w.w = pk2(v1.z, v1.w);
                if (col >= C_KI && col < C_WI) {
                    const int b = row / SEQ, t = row - b * SEQ + NMETA, d0 = col - C_KI;
                    *(::u32x4*)(KIP + (size_t)b * KIP_BATCH + (size_t)((((t >> 5) * 4 + (d0 >> 4)) * 2 + ((d0 >> 3) & 1)) * 512 + (t & 31) * 16)) = w;
                } else *(::u32x4*)(P + (size_t)trow * PW + col) = w;
            })
    }
};
struct EpiGate {
    static constexpr bool PERM = true, AFTER_DRAIN = false;
    bf16_t* G;
    __device__ __forceinline__ void operator()(const f32x4 (&acc)[2][2][4][2], const Unit& u, int wr, int wc, int fr, int fq) const {
        PG8_FOR_FRAGS8( ::u32x4 w; w.x = pk2(sigmoidf(v0.x), sigmoidf(v0.y)); w.y = pk2(sigmoidf(v0.z), sigmoidf(v0.w)); w.z = pk2(sigmoidf(v1.x), sigmoidf(v1.y)); w.w = pk2(sigmoidf(v1.z), sigmoidf(v1.w));
            *(::u32x4*)(G + (size_t)row * 2048 + col) = w; )
    }
};
template <bool ACCUM> struct EpiZ {
    static constexpr bool PERM = true, AFTER_DRAIN = false;
    bf16_t* Z; const bf16_t* G; int goff;
    __device__ __forceinline__ void operator()(const f32x4 (&acc)[2][2][4][2], const Unit& u, int wr, int wc, int fr, int fq) const {
        PG8_FOR_FRAGS8(
            const ::u32x4 g = *(const ::u32x4*)(G + (size_t)row * 2048 + goff + col);
            ::f32x4 z0 = (::f32x4){bflo(g.x) * v0.x, bfhi(g.x) * v0.y, bflo(g.y) * v0.z, bfhi(g.y) * v0.w}, z1 = (::f32x4){bflo(g.z) * v1.x, bfhi(g.z) * v1.y, bflo(g.w) * v1.z, bfhi(g.w) * v1.w};
            ::u32x4* zp = (::u32x4*)(Z + (size_t)row * D + col);
            if (ACCUM) { const ::u32x4 o = *zp; z0.x += bflo(o.x); z0.y += bfhi(o.x); z0.z += bflo(o.y); z0.w += bfhi(o.y); z1.x += bflo(o.z); z1.y += bfhi(o.z); z1.z += bflo(o.w); z1.w += bfhi(o.w); }
            ::u32x4 w; w.x = pk2(z0.x, z0.y); w.y = pk2(z0.z, z0.w); w.z = pk2(z1.x, z1.y); w.w = pk2(z1.z, z1.w); *zp = w; )
    }
};
struct EpiH1 {
    static constexpr bool PERM = true, AFTER_DRAIN = false;
    float* H1; const float* meta; const float* x;
    __device__ __forceinline__ void operator()(const f32x4 (&acc)[2][2][4][2], const Unit& u, int wr, int wc, int fr, int fq) const {
        PG8_FOR_FRAGS8( const float* xp = x + (size_t)row * D + col; float* hp = H1 + (size_t)row * D + col; const ::f32x4 h0 = *(const ::f32x4*)xp, h1 = *(const ::f32x4*)(xp + 4);
            *(::f32x4*)hp = h0 + v0; *(::f32x4*)(hp + 4) = h1 + v1; )
    }
};
#undef PG8_FOR_FRAGS
#undef PG8_FOR_FRAGS8

template <class Epi, class Sched, bool ALIGN_EPI = false, bool SP2 = false>
__device__ __forceinline__ void gemm_phase(PG8_LAS unsigned char* lds, const Gemm g, const Sched& S, const Epi& E) {
    const int tid = threadIdx.x, wid = __builtin_amdgcn_readfirstlane(tid >> 6), lane = tid & 63, wr = wid >> 2, wc = wid & 3, fr = lane & 15, fq = lane >> 4;
    const int K = g.K, nt = K / BK;
    unsigned voffA[2], voffB[2];
#pragma unroll
    for (int i = 0; i < 2; ++i) { int R, C; stage_rc(tid * 16 + i * 8192, R, C); const int Rb = Epi::PERM ? ((R & ~31) + perm32(R & 31)) : R;
        voffA[i] = (unsigned)(R * K + C) * 2u; voffB[i] = (unsigned)(Rb * K + C) * 2u; }
    const size_t kstep = (size_t)(BK * 2);
    const size_t hstep = (size_t)HALF * K * 2;
    const size_t tstep = 2 * hstep;
    const unsigned ldsw = (unsigned)wid * 1024u;
    const int aoff = lds_byte(wr * 64 + fr, fq * 8), boff = lds_byte(wc * 32 + fr, fq * 8);
#define PG8_SA(b, h) (((b) * 2 + (h)) * HTB)
#define PG8_SB(b, h) ((4 + (b) * 2 + (h)) * HTB)
#define PG8_STAGE(bufoff, gbase, voff) do { _Pragma("unroll") for (int _i = 0; _i < 2; ++_i) \
        __builtin_amdgcn_global_load_lds((const unsigned*)((const char*)(gbase) + (voff)[_i]), (PG8_LAS unsigned*)(lds + (bufoff) + ldsw + _i * 8192), 16, 0, 0); } while (0)
#define PG8_LDA(dst, b, h) do { _Pragma("unroll") for (int m = 0; m < 4; ++m) _Pragma("unroll") for (int k = 0; k < 2; ++k) dst[m][k] = *(const PG8_LAS bf16x8*)(lds + PG8_SA(b, h) + aoff + m * 2048 + k * 1024); } while (0)
#define PG8_LDB(dst, b, h) do { _Pragma("unroll") for (int n = 0; n < 2; ++n) _Pragma("unroll") for (int k = 0; k < 2; ++k) dst[n][k] = *(const PG8_LAS bf16x8*)(lds + PG8_SB(b, h) + boff + n * 2048 + k * 1024); } while (0)
#define PG8_MMA(ai, bj, At, Bt) do { __builtin_amdgcn_s_setprio(1); _Pragma("unroll") for (int m = 0; m < 4; ++m) _Pragma("unroll") for (int n = 0; n < 2; ++n) _Pragma("unroll") for (int k = 0; k < 2; ++k) \
        acc[ai][bj][m][n] = __builtin_amdgcn_mfma_f32_16x16x32_bf16(Bt[n][k], At[m][k], acc[ai][bj][m][n], 0, 0, 0); __builtin_amdgcn_s_setprio(0); } while (0)
#define PG8_WAIT_V(n) asm volatile("s_waitcnt vmcnt(" #n ")" ::: "memory")
#define PG8_WAIT_L(n) asm volatile("s_waitcnt lgkmcnt(" #n ")" ::: "memory")
#define PG8_BAR __builtin_amdgcn_s_barrier()
#define PG8_SCHED __builtin_amdgcn_sched_barrier(0)
    Unit cur, nxt; int ui = 0;
    if (!S.next(0, cur)) return;
    f32x4 acc[2][2][4][2];
#pragma unroll
    for (int a = 0; a < 2; ++a)
#pragma unroll
        for (int b = 0; b < 2; ++b)
#pragma unroll
            for (int m = 0; m < 4; ++m)
#pragma unroll
                for (int n = 0; n < 2; ++n) acc[a][b][m][n] = (f32x4){0.f, 0.f, 0.f, 0.f};
    bf16x8 At[4][2], B0[2][2], B1[2][2];
    const char* cA = (const char*)g.A + (size_t)cur.pm * tstep; const char* cB = (const char*)g.Bt + (size_t)cur.pn * tstep;
    S.a_ready(cur);
    if constexpr (SP2) {
        PG8_STAGE(PG8_SB(0, 0), cB, voffB); PG8_STAGE(PG8_SB(0, 1), cB + hstep, voffB); PG8_STAGE(PG8_SA(0, 0), cA, voffA); PG8_STAGE(PG8_SA(0, 1), cA + hstep, voffA);
        if (wr == 1) PG8_BAR;
        PG8_WAIT_V(2); PG8_BAR;
        PG8_STAGE(PG8_SB(1, 0), cB + kstep, voffB); PG8_STAGE(PG8_SA(1, 0), cA + kstep, voffA); PG8_STAGE(PG8_SB(1, 1), cB + hstep + kstep, voffB);
        PG8_WAIT_V(6); PG8_BAR;
    } else {
        PG8_STAGE(PG8_SB(0, 0), cB, voffB); PG8_STAGE(PG8_SA(0, 0), cA, voffA); PG8_STAGE(PG8_SB(0, 1), cB + hstep, voffB); PG8_STAGE(PG8_SA(0, 1), cA + hstep, voffA);
        if (wr == 1) PG8_BAR;
        PG8_WAIT_V(4); PG8_BAR;
        PG8_STAGE(PG8_SB(1, 0), cB + kstep, voffB); PG8_STAGE(PG8_SA(1, 0), cA + kstep, voffA); PG8_STAGE(PG8_SB(1, 1), cB + hstep + kstep, voffB);
        PG8_WAIT_V(6); PG8_BAR;
    }
    for (;;) {
        const bool has_next = S.next(ui + 1, nxt);
        const char* nA = has_next ? (const char*)g.A + (size_t)nxt.pm * tstep : cA; const char* nB = has_next ? (const char*)g.Bt + (size_t)nxt.pn * tstep : cB;
        for (int t = 0; t < nt; t += 2) {
            const bool last = (t == nt - 2);
            const char* a1 = cA + (size_t)(t + 1) * kstep;
            const char* a2 = last ? nA : cA + (size_t)(t + 2) * kstep; const char* b2 = last ? nB : cB + (size_t)(t + 2) * kstep;
            const char* a3 = a2 + kstep; const char* b3 = b2 + kstep;
            if (last && has_next) S.a_ready(nxt);
            if constexpr (SP2) {
            PG8_LDB(B0, 0, 0); PG8_LDB(B1, 0, 1); PG8_SCHED; PG8_LDA(At, 0, 0); PG8_STAGE(PG8_SA(1, 1), a1 + hstep, voffA);
            PG8_WAIT_V(8); PG8_WAIT_L(0); PG8_BAR; PG8_MMA(0, 0, At, B0); PG8_MMA(0, 1, At, B1); PG8_BAR; PG8_SCHED;
            PG8_LDA(At, 0, 1); PG8_STAGE(PG8_SB(0, 0), b2, voffB); PG8_STAGE(PG8_SB(0, 1), b2 + hstep, voffB); PG8_STAGE(PG8_SA(0, 0), a2, voffA);
            PG8_WAIT_V(8); PG8_WAIT_L(0); PG8_BAR; PG8_MMA(1, 0, At, B0); PG8_MMA(1, 1, At, B1); PG8_BAR; PG8_SCHED;
            PG8_LDB(B0, 1, 0); PG8_LDB(B1, 1, 1); PG8_SCHED; PG8_LDA(At, 1, 0); PG8_STAGE(PG8_SA(0, 1), a2 + hstep, voffA);
            PG8_WAIT_V(8); PG8_WAIT_L(0); PG8_BAR; PG8_MMA(0, 0, At, B0); PG8_MMA(0, 1, At, B1); PG8_BAR; PG8_SCHED;
            PG8_LDA(At, 1, 1); PG8_STAGE(PG8_SB(1, 0), b3, voffB); PG8_STAGE(PG8_SB(1, 1), b3 + hstep, voffB); PG8_STAGE(PG8_SA(1, 0), a3, voffA);
            PG8_WAIT_V(8); PG8_WAIT_L(0); PG8_BAR; PG8_MMA(1, 0, At, B0); PG8_MMA(1, 1, At, B1); PG8_BAR; PG8_SCHED;
            } else {
            PG8_LDB(B0, 0, 0); PG8_SCHED; PG8_LDA(At, 0, 0); PG8_STAGE(PG8_SA(1, 1), a1 + hstep, voffA);
            PG8_WAIT_L(8); PG8_BAR; PG8_WAIT_L(0); PG8_MMA(0, 0, At, B0); PG8_BAR; PG8_SCHED;
            PG8_LDB(B1, 0, 1); PG8_STAGE(PG8_SB(0, 0), b2, voffB);
            PG8_BAR; PG8_WAIT_L(0); PG8_MMA(0, 1, At, B1); PG8_BAR;
            PG8_LDA(At, 0, 1); PG8_STAGE(PG8_SA(0, 0), a2, voffA);
            PG8_BAR; PG8_WAIT_L(0); PG8_MMA(1, 0, At, B0); PG8_BAR; PG8_SCHED;
            PG8_STAGE(PG8_SB(0, 1), b2 + hstep, voffB);
            PG8_WAIT_V(6); PG8_BAR; PG8_MMA(1, 1, At, B1); PG8_BAR;
            PG8_LDB(B0, 1, 0); PG8_SCHED; PG8_LDA(At, 1, 0); PG8_STAGE(PG8_SA(0, 1), a2 + hstep, voffA);
            PG8_WAIT_L(8); PG8_BAR; PG8_WAIT_L(0); PG8_MMA(0, 0, At, B0); PG8_BAR; PG8_SCHED;
            PG8_LDB(B1, 1, 1); PG8_STAGE(PG8_SB(1, 0), b3, voffB);
            PG8_BAR; PG8_WAIT_L(0); PG8_MMA(0, 1, At, B1); PG8_BAR;
            PG8_LDA(At, 1, 1); PG8_STAGE(PG8_SA(1, 0), a3, voffA);
            PG8_BAR; PG8_WAIT_L(0); PG8_MMA(1, 0, At, B0); PG8_BAR; PG8_SCHED;
            PG8_STAGE(PG8_SB(1, 1), b3 + hstep, voffB);
            PG8_WAIT_V(6); PG8_BAR; PG8_MMA(1, 1, At, B1); PG8_BAR;
            }
        }
        if constexpr (ALIGN_EPI) { if (wr == 0) PG8_BAR; }
        if constexpr (!Epi::AFTER_DRAIN) { E(acc, cur, wr, wc, fr, fq); S.done(cur); }
        if (!has_next) break;
#pragma unroll
        for (int a = 0; a < 2; ++a)
#pragma unroll
            for (int b = 0; b < 2; ++b)
#pragma unroll
                for (int m = 0; m < 4; ++m)
#pragma unroll
                    for (int n = 0; n < 2; ++n) acc[a][b][m][n] = (f32x4){0.f, 0.f, 0.f, 0.f};
        cur = nxt; cA = nA; cB = nB; ++ui;
        if constexpr (ALIGN_EPI) { if (wr == 1) PG8_BAR; }
    }
    PG8_WAIT_V(0);
    if constexpr (!ALIGN_EPI) { if (wr == 0) PG8_BAR; }
    PG8_BAR;
    if constexpr (Epi::AFTER_DRAIN) { E.fused(acc, cur, wr, wc, fr, fq, lds, wid, lane); S.done(cur); }
#undef PG8_SA
#undef PG8_SB
#undef PG8_STAGE
#undef PG8_LDA
#undef PG8_LDB
#undef PG8_MMA
#undef PG8_WAIT_V
#undef PG8_WAIT_L
#undef PG8_BAR
#undef PG8_SCHED
}
template <class Epi, class Sched, bool ALIGN_EPI = false, bool SP2 = false>
__device__ __forceinline__ void gemm_phase_x(PG8_LAS unsigned char* lds, const int K, const Sched& S, const Epi& E) {
    const int tid = threadIdx.x, wid = __builtin_amdgcn_readfirstlane(tid >> 6), lane = tid & 63, wr = wid >> 2, wc = wid & 3, fr = lane & 15, fq = lane >> 4;
    const int nt = K / BK;
    unsigned vcA[2][2], vnA[2][2], voffB[2];
#pragma unroll
    for (int i = 0; i < 2; ++i) { int R, C; stage_rc(tid * 16 + i * 8192, R, C); const int Rb = Epi::PERM ? ((R & ~31) + perm32(R & 31)) : R;
        voffB[i] = (unsigned)(Rb * K + C) * 2u; }
    const size_t kstep = (size_t)(BK * 2);
    const size_t hstep = (size_t)HALF * K * 2;
    const unsigned ldsw = (unsigned)wid * 1024u;
    const int aoff = lds_byte(wr * 64 + fr, fq * 8), boff = lds_byte(wc * 32 + fr, fq * 8);
#define PG8_SA(b, h) (((b) * 2 + (h)) * HTB)
#define PG8_SB(b, h) ((4 + (b) * 2 + (h)) * HTB)
#define PG8_STAGE(bufoff, gbase, voff) do { _Pragma("unroll") for (int _i = 0; _i < 2; ++_i) \
        __builtin_amdgcn_global_load_lds((const unsigned*)((const char*)(gbase) + (voff)[_i]), (PG8_LAS unsigned*)(lds + (bufoff) + ldsw + _i * 8192), 16, 0, 0); } while (0)
#define PG8_STAGEA(bufoff, gbase, V, h) do { _Pragma("unroll") for (int _i = 0; _i < 2; ++_i) \
        __builtin_amdgcn_global_load_lds((const unsigned*)((const char*)(gbase) + (V)[h][_i]), (PG8_LAS unsigned*)(lds + (bufoff) + ldsw + _i * 8192), 16, 0, 0); } while (0)
#define PG8_STAGEA2(bufoff, gbase, h) do { _Pragma("unroll") for (int _i = 0; _i < 2; ++_i) \
        __builtin_amdgcn_global_load_lds((const unsigned*)((const char*)(gbase) + (last ? vnA[h][_i] : vcA[h][_i])), (PG8_LAS unsigned*)(lds + (bufoff) + ldsw + _i * 8192), 16, 0, 0); } while (0)
#define PG8_AOFF(V, u) do { _Pragma("unroll") for (int _h = 0; _h < 2; ++_h) _Pragma("unroll") for (int _i = 0; _i < 2; ++_i) { int R_, C_; stage_rc(tid * 16 + _i * 8192, R_, C_); (V)[_h][_i] = S.a_off(u, _h * HALF + R_, C_); } } while (0)
#define PG8_LDA(dst, b, h) do { _Pragma("unroll") for (int m = 0; m < 4; ++m) _Pragma("unroll") for (int k = 0; k < 2; ++k) dst[m][k] = *(const PG8_LAS bf16x8*)(lds + PG8_SA(b, h) + aoff + m * 2048 + k * 1024); } while (0)
#define PG8_LDB(dst, b, h) do { _Pragma("unroll") for (int n = 0; n < 2; ++n) _Pragma("unroll") for (int k = 0; k < 2; ++k) dst[n][k] = *(const PG8_LAS bf16x8*)(lds + PG8_SB(b, h) + boff + n * 2048 + k * 1024); } while (0)
#define PG8_MMA(ai, bj, At, Bt) do { __builtin_amdgcn_s_setprio(1); _Pragma("unroll") for (int m = 0; m < 4; ++m) _Pragma("unroll") for (int n = 0; n < 2; ++n) _Pragma("unroll") for (int k = 0; k < 2; ++k) \
        acc[ai][bj][m][n] = __builtin_amdgcn_mfma_f32_16x16x32_bf16(Bt[n][k], At[m][k], acc[ai][bj][m][n], 0, 0, 0); __builtin_amdgcn_s_setprio(0); } while (0)
#define PG8_WAIT_V(n) asm volatile("s_waitcnt vmcnt(" #n ")" ::: "memory")
#define PG8_WAIT_L(n) asm volatile("s_waitcnt lgkmcnt(" #n ")" ::: "memory")
#define PG8_BAR __builtin_amdgcn_s_barrier()
#define PG8_SCHED __builtin_amdgcn_sched_barrier(0)
    Unit cur, nxt; int ui = 0;
    if (!S.next(0, cur)) return;
    f32x4 acc[2][2][4][2];
#pragma unroll
    for (int a = 0; a < 2; ++a)
#pragma unroll
        for (int b = 0; b < 2; ++b)
#pragma unroll
            for (int m = 0; m < 4; ++m)
#pragma unroll
                for (int n = 0; n < 2; ++n) acc[a][b][m][n] = (f32x4){0.f, 0.f, 0.f, 0.f};
    bf16x8 At[4][2], B0[2][2], B1[2][2];
    const char* cA = S.a_base(cur); const char* cB = S.b_base(cur);
    PG8_AOFF(vcA, cur);
    S.a_ready(cur);
    if constexpr (SP2) {
        PG8_STAGE(PG8_SB(0, 0), cB, voffB); PG8_STAGE(PG8_SB(0, 1), cB + hstep, voffB); PG8_STAGEA(PG8_SA(0, 0), cA, vcA, 0); PG8_STAGEA(PG8_SA(0, 1), cA, vcA, 1);
        if (wr == 1) PG8_BAR;
        PG8_WAIT_V(2); PG8_BAR;
        PG8_STAGE(PG8_SB(1, 0), cB + kstep, voffB); PG8_STAGEA(PG8_SA(1, 0), cA + kstep, vcA, 0); PG8_STAGE(PG8_SB(1, 1), cB + hstep + kstep, voffB);
        PG8_WAIT_V(6); PG8_BAR;
    } else {
        PG8_STAGE(PG8_SB(0, 0), cB, voffB); PG8_STAGEA(PG8_SA(0, 0), cA, vcA, 0); PG8_STAGE(PG8_SB(0, 1), cB + hstep, voffB); PG8_STAGEA(PG8_SA(0, 1), cA, vcA, 1);
        if (wr == 1) PG8_BAR;
        PG8_WAIT_V(4); PG8_BAR;
        PG8_STAGE(PG8_SB(1, 0), cB + kstep, voffB); PG8_STAGEA(PG8_SA(1, 0), cA + kstep, vcA, 0); PG8_STAGE(PG8_SB(1, 1), cB + hstep + kstep, voffB);
        PG8_WAIT_V(6); PG8_BAR;
    }
    for (;;) {
        const bool has_next = S.next(ui + 1, nxt);
        const char* nA = has_next ? S.a_base(nxt) : cA; const char* nB = has_next ? S.b_base(nxt) : cB;
        if (has_next) { PG8_AOFF(vnA, nxt); } else { _Pragma("unroll") for (int _h = 0; _h < 2; ++_h) _Pragma("unroll") for (int _i = 0; _i < 2; ++_i) vnA[_h][_i] = vcA[_h][_i]; }
        for (int t = 0; t < nt; t += 2) {
            const bool last = (t == nt - 2);
            const char* a1 = cA + (size_t)(t + 1) * kstep;
            const char* a2 = last ? nA : cA + (size_t)(t + 2) * kstep; const char* b2 = last ? nB : cB + (size_t)(t + 2) * kstep;
            const char* a3 = a2 + kstep; const char* b3 = b2 + kstep;
            if (last && has_next) S.a_ready(nxt);
            if constexpr (SP2) {
            PG8_LDB(B0, 0, 0); PG8_LDB(B1, 0, 1); PG8_SCHED; PG8_LDA(At, 0, 0); PG8_STAGEA(PG8_SA(1, 1), a1, vcA, 1);
            PG8_WAIT_V(8); PG8_WAIT_L(0); PG8_BAR; PG8_MMA(0, 0, At, B0); PG8_MMA(0, 1, At, B1); PG8_BAR; PG8_SCHED;
            PG8_LDA(At, 0, 1); PG8_STAGE(PG8_SB(0, 0), b2, voffB); PG8_STAGE(PG8_SB(0, 1), b2 + hstep, voffB); PG8_STAGEA2(PG8_SA(0, 0), a2, 0);
            PG8_WAIT_V(8); PG8_WAIT_L(0); PG8_BAR; PG8_MMA(1, 0, At, B0); PG8_MMA(1, 1, At, B1); PG8_BAR; PG8_SCHED;
            PG8_LDB(B0, 1, 0); PG8_LDB(B1, 1, 1); PG8_SCHED; PG8_LDA(At, 1, 0); PG8_STAGEA2(PG8_SA(0, 1), a2, 1);
            PG8_WAIT_V(8); PG8_WAIT_L(0); PG8_BAR; PG8_MMA(0, 0, At, B0); PG8_MMA(0, 1, At, B1); PG8_BAR; PG8_SCHED;
            PG8_LDA(At, 1, 1); PG8_STAGE(PG8_SB(1, 0), b3, voffB); PG8_STAGE(PG8_SB(1, 1), b3 + hstep, voffB); PG8_STAGEA2(PG8_SA(1, 0), a3, 0);
            PG8_WAIT_V(8); PG8_WAIT_L(0); PG8_BAR; PG8_MMA(1, 0, At, B0); PG8_MMA(1, 1, At, B1); PG8_BAR; PG8_SCHED;
            } else {
            PG8_LDB(B0, 0, 0); PG8_SCHED; PG8_LDA(At, 0, 0); PG8_STAGEA(PG8_SA(1, 1), a1, vcA, 1);
            PG8_WAIT_L(8); PG8_BAR; PG8_WAIT_L(0); PG8_MMA(0, 0, At, B0); PG8_BAR; PG8_SCHED;
            PG8_LDB(B1, 0, 1); PG8_STAGE(PG8_SB(0, 0), b2, voffB);
            PG8_BAR; PG8_WAIT_L(0); PG8_MMA(0, 1, At, B1); PG8_BAR;
            PG8_LDA(At, 0, 1); PG8_STAGEA2(PG8_SA(0, 0), a2, 0);
            PG8_BAR; PG8_WAIT_L(0); PG8_MMA(1, 0, At, B0); PG8_BAR; PG8_SCHED;
            PG8_STAGE(PG8_SB(0, 1), b2 + hstep, voffB);
            PG8_WAIT_V(6); PG8_BAR; PG8_MMA(1, 1, At, B1); PG8_BAR;
            PG8_LDB(B0, 1, 0); PG8_SCHED; PG8_LDA(At, 1, 0); PG8_STAGEA2(PG8_SA(0, 1), a2, 1);
            PG8_WAIT_L(8); PG8_BAR; PG8_WAIT_L(0); PG8_MMA(0, 0, At, B0); PG8_BAR; PG8_SCHED;
            PG8_LDB(B1, 1, 1); PG8_STAGE(PG8_SB(1, 0), b3, voffB);
            PG8_BAR; PG8_WAIT_L(0); PG8_MMA(0, 1, At, B1); PG8_BAR;
            PG8_LDA(At, 1, 1); PG8_STAGEA2(PG8_SA(1, 0), a3, 0);
            PG8_BAR; PG8_WAIT_L(0); PG8_MMA(1, 0, At, B0); PG8_BAR; PG8_SCHED;
            PG8_STAGE(PG8_SB(1, 1), b3 + hstep, voffB);
            PG8_WAIT_V(6); PG8_BAR; PG8_MMA(1, 1, At, B1); PG8_BAR;
            }
        }
        if constexpr (ALIGN_EPI) { if (wr == 0) PG8_BAR; }
        if constexpr (!Epi::AFTER_DRAIN) { E(acc, cur, wr, wc, fr, fq); S.done(cur); }
        if (!has_next) break;
#pragma unroll
        for (int a = 0; a < 2; ++a)
#pragma unroll
            for (int b = 0; b < 2; ++b)
#pragma unroll
                for (int m = 0; m < 4; ++m)
#pragma unroll
                    for (int n = 0; n < 2; ++n) acc[a][b][m][n] = (f32x4){0.f, 0.f, 0.f, 0.f};
        cur = nxt; cA = nA; cB = nB; ++ui;
        _Pragma("unroll") for (int _h = 0; _h < 2; ++_h) _Pragma("unroll") for (int _i = 0; _i < 2; ++_i) vcA[_h][_i] = vnA[_h][_i];
        if constexpr (ALIGN_EPI) { if (wr == 1) PG8_BAR; }
    }
    PG8_WAIT_V(0);
    if constexpr (!ALIGN_EPI) { if (wr == 0) PG8_BAR; }
    PG8_BAR;
    if constexpr (Epi::AFTER_DRAIN) { E.fused(acc, cur, wr, wc, fr, fq, lds, wid, lane); S.done(cur); }
#undef PG8_SA
#undef PG8_SB
#undef PG8_STAGE
#undef PG8_STAGEA
#undef PG8_STAGEA2
#undef PG8_AOFF
#undef PG8_LDA
#undef PG8_LDB
#undef PG8_MMA
#undef PG8_WAIT_V
#undef PG8_WAIT_L
#undef PG8_BAR
#undef PG8_SCHED
}


template <int WHICH> struct MoeOrder {
    const int* TP; int G, c; const char* Abase; const char* Bbase; const int* LIST;
    static constexpr int KK = WHICH == 0 ? 1024 : 512, NN = 4;
    __device__ __forceinline__ bool next(int i, Unit& u) const {
        const int L = i * G + c; if (L >= TP[NEXP]) return false;
        int e = 0;
#pragma unroll 1
        for (int j = 16; j >= 1; j >>= 1) if (TP[e + j] <= L) e += j;
        const int lt = L - TP[e]; u.pm = e * 1024 + lt / NN; u.pn = lt % NN; return true;
    }
    __device__ __forceinline__ const char* a_base(const Unit& u) const { const int e = u.pm >> 10, mt = u.pm & 1023; return WHICH == 0 ? Abase : Abase + (size_t)(TP[64 + e] + mt * 256) * (DEXP * 2); }
    __device__ __forceinline__ const char* b_base(const Unit& u) const { const int e = u.pm >> 10; return Bbase + ((size_t)e * 1024 + (size_t)u.pn * 256) * (KK * 2); }
    __device__ __forceinline__ unsigned a_off(const Unit& u, int r, int C) const {
        if (WHICH == 1) return (unsigned)(r * DEXP + C) * 2u;
        const int e = u.pm >> 10, s = (u.pm & 1023) * 256 + r; const int tok = s < TP[128 + e] ? (LIST[(size_t)e * NR + s] >> 1) : 0;
        return (unsigned)tok * (D * 2) + (unsigned)C * 2u;
    }
    __device__ __forceinline__ void a_ready(const Unit&) const {}
    __device__ __forceinline__ void done(const Unit&) const {}
};
struct TokRowOrder : StaticOrder {
    const char* Abase; const char* Bbase; int K;
    __device__ __forceinline__ const char* a_base(const Unit& u) const { return Abase + (size_t)tokrow(u.pm * BM) * K * 2; }
    __device__ __forceinline__ const char* b_base(const Unit& u) const { return Bbase + (size_t)u.pn * BM * K * 2; }
    __device__ __forceinline__ unsigned a_off(const Unit&, int r, int C) const { return (unsigned)(r * K + C) * 2u; }
};
#define PG8_FOR_FRAGS_M(...) _Pragma("unroll") for (int ai = 0; ai < 2; ++ai) _Pragma("unroll") for (int m = 0; m < 4; ++m) { const int r = ai * HALF + wr * 64 + m * 16 + fr; \
    _Pragma("unroll") for (int bj = 0; bj < 2; ++bj) _Pragma("unroll") for (int n = 0; n < 2; ++n) { const int col = u.pn * BM + bj * HALF + wc * 32 + n * 16 + 4 * fq; ::f32x4 v = acc[ai][bj][m][n]; __VA_ARGS__ } }
struct EpiMoe1 {
    static constexpr bool PERM = true, AFTER_DRAIN = false;
    bf16_t* HID; const int* TP; const int* LIST; const float* RS;
    __device__ __forceinline__ void operator()(const f32x4 (&acc)[2][2][4][2], const Unit& u, int wr, int wc, int fr, int fq) const {
        const int e = u.pm >> 10, mt = u.pm & 1023, cnt = TP[128 + e]; bf16_t* base = HID + (size_t)(TP[64 + e] + mt * 256) * DEXP;
#pragma unroll
        for (int ai = 0; ai < 2; ++ai)
#pragma unroll
            for (int m = 0; m < 4; ++m) { const int r = ai * HALF + wr * 64 + m * 16 + fr; const int s = mt * 256 + r;
                const float rs = RS[s < cnt ? (LIST[(size_t)e * NR + s] >> 1) : 0];
#pragma unroll
                for (int bj = 0; bj < 2; ++bj) { const int col = u.pn * BM + bj * HALF + wc * 32 + 8 * fq; const ::f32x4 v0 = acc[ai][bj][m][0] * rs, v1 = acc[ai][bj][m][1] * rs;
                    const float h0 = v0.x * sigmoidf(v0.x) * v0.y, h1 = v0.z * sigmoidf(v0.z) * v0.w, h2 = v1.x * sigmoidf(v1.x) * v1.y, h3 = v1.z * sigmoidf(v1.z) * v1.w;
                    ::u32x2 w; w.x = pk2(h0, h1); w.y = pk2(h2, h3); *(::u32x2*)(base + (size_t)r * DEXP + (col >> 1)) = w; } }
    }
};
struct EpiMoe2 {
    static constexpr bool PERM = true, AFTER_DRAIN = false;
    bf16_t* MO; const int* TP; const int* LIST; const float* GATE;
    __device__ __forceinline__ void operator()(const f32x4 (&acc)[2][2][4][2], const Unit& u, int wr, int wc, int fr, int fq) const {
        const int e = u.pm >> 10, mt = u.pm & 1023, cnt = TP[128 + e];
#pragma unroll
        for (int ai = 0; ai < 2; ++ai)
#pragma unroll
            for (int m = 0; m < 4; ++m) {
                const int s = mt * 256 + ai * HALF + wr * 64 + m * 16 + fr;
                if (s < cnt) {
                    const int ent = LIST[(size_t)e * NR + s]; const float gt = GATE[ent]; bf16_t* row = MO + (size_t)ent * D;
#pragma unroll
                    for (int bj = 0; bj < 2; ++bj) { const int col = u.pn * BM + bj * HALF + wc * 32 + 8 * fq; const ::f32x4 v0 = acc[ai][bj][m][0], v1 = acc[ai][bj][m][1];
                        ::u32x4 w; w.x = pk2(v0.x * gt, v0.y * gt); w.y = pk2(v0.z * gt, v0.w * gt); w.z = pk2(v1.x * gt, v1.y * gt); w.w = pk2(v1.z * gt, v1.w * gt); *(::u32x4*)(row + col) = w; }
                }
            }
    }
};
#undef PG8_FOR_FRAGS_M
}
template <bool B> struct BoolT { static constexpr bool value = B; };
constexpr int SB_NQT = SEQ / 32;
constexpr int SB_VROW = 192;
__device__ __forceinline__ void phase_sb_fast(const Params& p, char* lds) {
    const bf16_t* P = (const bf16_t*)(p.ws + WS_P); bf16_t* YA = (bf16_t*)(p.ws + WS_YA);
    const int tid = threadIdx.x, lane = tid & 63, wave = tid >> 6, n = lane & 31, hh = lane >> 5;
    char* VB = lds + wave * (32 * SB_VROW);
    const unsigned vtr = (unsigned)(size_t)lds + (unsigned)(wave * (32 * SB_VROW) + (4 * hh + ((lane & 15) >> 2)) * SB_VROW + (16 * ((lane >> 4) & 1) + 4 * (lane & 3)) * 2);
    const int gw = blockIdx.x * NWAVES + wave, NGW = gridDim.x * NWAVES;
    for (int unit = gw; unit < 64 * SB_NQT; unit += NGW) {
        const int qt = SB_NQT - 1 - unit / 64, bh = unit % 64, h = bh & 7, b = bh >> 3;
        const int i0 = NMETA + qt * 32, qi = i0 + n, qrow = qi;
        const bf16_t* Pb = P + (size_t)b * T * PW;
        bf16x8 qf[4];
#pragma unroll
        for (int s = 0; s < 4; ++s) qf[s] = *(const bf16x8*)(Pb + (size_t)qrow * PW + C_QA + h * 64 + 16 * s + 8 * hh);
        f32x16 o0, o1;
#pragma unroll
        for (int r = 0; r < 16; ++r) { o0[r] = 0.f; o1[r] = 0.f; }
        float EL = 1.f;
        auto tile = [&](const int kt, auto MT) {
            constexpr bool MASKED = decltype(MT)::value;
            const int j0 = kt * 32, krow = (!MASKED || (j0 + n) < T) ? (j0 + n) : T - 1;
            bf16x8 kf[4];
#pragma unroll
            for (int s = 0; s < 4; ++s) kf[s] = *(const bf16x8*)(Pb + (size_t)krow * PW + C_KA + h * 64 + 16 * s + 8 * hh);
#pragma unroll
            for (int i = 0; i < 4; ++i) {
                const int c = lane + 64 * i, key = c >> 3, d0 = (c & 7) * 8, vrow = (!MASKED || (j0 + key) < T) ? (j0 + key) : T - 1;
                const u32x4 w = *(const u32x4*)(Pb + (size_t)vrow * PW + C_VA + h * 64 + d0);
                *(u32x4*)(VB + key * SB_VROW + d0 * 2) = w;
            }
            f32x16 sa;
#pragma unroll
            for (int r = 0; r < 16; ++r) sa[r] = 0.f;
#pragma unroll
            for (int s = 0; s < 4; ++s) sa = __builtin_amdgcn_mfma_f32_32x32x16_bf16(kf[s], qf[s], sa, 0, 0, 0);
            float kp[16], sg[16];
#pragma unroll
            for (int r = 0; r < 16; ++r) {
                const float e = fexp2(__builtin_amdgcn_fmed3f(sa[r], -3.0e38f, 80.f)), k = __builtin_amdgcn_rcpf(1.f + e), s = e * k;
                if (MASKED) { const int kk = (r & 3) + 8 * (r >> 2) + 4 * hh; const bool valid = (j0 + kk) < qi; kp[r] = valid ? k : 1.f; sg[r] = valid ? s : 0.f; }
                else { kp[r] = k; sg[r] = s; }
            }
            const float gp0 = (kp[0] * kp[1]) * (kp[2] * kp[3]), gp1 = (kp[4] * kp[5]) * (kp[6] * kp[7]), gp2 = (kp[8] * kp[9]) * (kp[10] * kp[11]), gp3 = (kp[12] * kp[13]) * (kp[14] * kp[15]);
            const float pp0 = xpartner32(gp0, hh), pp1 = xpartner32(gp1, hh), pp2 = xpartner32(gp2, hh), pp3 = xpartner32(gp3, hh);
            const float pc3 = pp3, pc2 = pc3 * pp2, pc1 = pc2 * pp1, pc0 = pc1 * pp0;
            float base[4];
            base[3] = EL * (hh ? 1.f : pc3);
            base[2] = EL * gp3 * (hh ? pc3 : pc2);
            base[1] = EL * (gp3 * gp2) * (hh ? pc2 : pc1);
            base[0] = EL * (gp3 * gp2 * gp1) * (hh ? pc1 : pc0);
            float a[16];
#pragma unroll
            for (int g = 0; g < 4; ++g) {
                float c = base[g];
#pragma unroll
                for (int e = 3; e >= 0; --e) { const int r = 4 * g + e; a[r] = sg[r] * c; c *= kp[r]; }
            }
            EL *= ((gp0 * gp1) * (gp2 * gp3)) * pc0;
            u32x4 pw0, pw1;
            pw0.x = pk2(a[0], a[1]); pw0.y = pk2(a[2], a[3]); pw0.z = pk2(a[4], a[5]); pw0.w = pk2(a[6], a[7]);
            pw1.x = pk2(a[8], a[9]); pw1.y = pk2(a[10], a[11]); pw1.z = pk2(a[12], a[13]); pw1.w = pk2(a[14], a[15]);
            const bf16x8 pf0 = __builtin_bit_cast(bf16x8, pw0), pf1 = __builtin_bit_cast(bf16x8, pw1);
            {
                u16x4 x0, x1, x2, x3, y0, y1, y2, y3;
                asm volatile("s_waitcnt lgkmcnt(0)\n\tds_read_b64_tr_b16 %0, %8 offset:%9\n\tds_read_b64_tr_b16 %1, %8 offset:%10\n\tds_read_b64_tr_b16 %2, %8 offset:%11\n\tds_read_b64_tr_b16 %3, %8 offset:%12\n\t"
                             "ds_read_b64_tr_b16 %4, %8 offset:%13\n\tds_read_b64_tr_b16 %5, %8 offset:%14\n\tds_read_b64_tr_b16 %6, %8 offset:%15\n\tds_read_b64_tr_b16 %7, %8 offset:%16\n\ts_waitcnt lgkmcnt(0)"
                             : "=&v"(x0), "=&v"(x1), "=&v"(x2), "=&v"(x3), "=&v"(y0), "=&v"(y1), "=&v"(y2), "=&v"(y3)
                             : "v"(vtr), "i"(0), "i"(8 * SB_VROW), "i"(16 * SB_VROW), "i"(24 * SB_VROW), "i"(64), "i"(64 + 8 * SB_VROW), "i"(64 + 16 * SB_VROW), "i"(64 + 24 * SB_VROW) : "memory");
#define SB_VF(a_, b_) ({ bf16x8 f_; f_[0] = (short)a_[0]; f_[1] = (short)a_[1]; f_[2] = (short)a_[2]; f_[3] = (short)a_[3]; f_[4] = (short)b_[0]; f_[5] = (short)b_[1]; f_[6] = (short)b_[2]; f_[7] = (short)b_[3]; f_; })
                o0 = __builtin_amdgcn_mfma_f32_32x32x16_bf16(SB_VF(x0, x1), pf0, o0, 0, 0, 0); o0 = __builtin_amdgcn_mfma_f32_32x32x16_bf16(SB_VF(x2, x3), pf1, o0, 0, 0, 0);
                o1 = __builtin_amdgcn_mfma_f32_32x32x16_bf16(SB_VF(y0, y1), pf0, o1, 0, 0, 0); o1 = __builtin_amdgcn_mfma_f32_32x32x16_bf16(SB_VF(y2, y3), pf1, o1, 0, 0, 0);
#undef SB_VF
            }
        };
        int kt = qt + 1;
        for (; kt >= qt; --kt) tile(kt, BoolT<true>{});
        for (; kt >= 0; --kt) {
            if (__all(EL < 1e-37f)) break;
            tile(kt, BoolT<false>{});
        }
        {
            bf16_t* yp = YA + ((size_t)b * SEQ + (qi - NMETA)) * 512 + h * 64 + 4 * hh;
#pragma unroll
            for (int g = 0; g < 4; ++g) {
                u32x2 w; w.x = pk2(o0[4 * g], o0[4 * g + 1]); w.y = pk2(o0[4 * g + 2], o0[4 * g + 3]); *(u32x2*)(yp + 8 * g) = w;
                w.x = pk2(o1[4 * g], o1[4 * g + 1]); w.y = pk2(o1[4 * g + 2], o1[4 * g + 3]); *(u32x2*)(yp + 32 + 8 * g) = w;
            }
        }
    }
}

constexpr int DSA_NQ = 8;
constexpr int DSA_SCS = 4608;
constexpr int DSA_KVB = 0, DSA_RING = 18432, DSA_IDX = DSA_NQ * DSA_RING, DSA_MISC = DSA_IDX + DSA_NQ * 1024, DSA_LDS = DSA_MISC + 512;
static_assert(DSA_NQ * DSA_SCS * 4 <= DSA_IDX, "score rows fit under the index lists");
__device__ __forceinline__ unsigned fkey(float f) { const unsigned u = __float_as_uint(f); return (u & 0x80000000u) ? ~u : (u | 0x80000000u); }
__device__ __forceinline__ int wave_sum_i32(int v) {
    v += __builtin_amdgcn_update_dpp(0, v, 0xB1, 0xF, 0xF, false);
    v += __builtin_amdgcn_update_dpp(0, v, 0x4E, 0xF, 0xF, false);
    v += __builtin_amdgcn_update_dpp(0, v, 0x141, 0xF, 0xF, false);
    v += __builtin_amdgcn_update_dpp(0, v, 0x140, 0xF, 0xF, false);
    return __builtin_amdgcn_readlane(v, 0) + __builtin_amdgcn_readlane(v, 16) + __builtin_amdgcn_readlane(v, 32) + __builtin_amdgcn_readlane(v, 48);
}
__device__ __forceinline__ int wave_excl_scan_i32(int c, int lane, int& total) {
    int x = c;
    x += __builtin_amdgcn_update_dpp(0, x, 0x111, 0xF, 0xF, true);
    x += __builtin_amdgcn_update_dpp(0, x, 0x112, 0xF, 0xF, true);
    x += __builtin_amdgcn_update_dpp(0, x, 0x114, 0xF, 0xF, true);
    x += __builtin_amdgcn_update_dpp(0, x, 0x118, 0xF, 0xF, true);
    const int t0 = __builtin_amdgcn_readlane(x, 15), t1 = __builtin_amdgcn_readlane(x, 31), t2 = __builtin_amdgcn_readlane(x, 47), t3 = __builtin_amdgcn_readlane(x, 63);
    const int row = lane >> 4;
    x += (row > 0 ? t0 : 0) + (row > 1 ? t1 : 0) + (row > 2 ? t2 : 0);
    total = t0 + t1 + t2 + t3;
    return x - c;
}
__device__ __forceinline__ int mbcnt64(unsigned long long m) { return (int)__builtin_amdgcn_mbcnt_hi((unsigned)(m >> 32), __builtin_amdgcn_mbcnt_lo((unsigned)m, 0u)); }
__device__ __forceinline__ void phase_dsa(const Params& p, char* lds) {
    const bf16_t* P = (const bf16_t*)(p.ws + WS_P); bf16_t* OL = (bf16_t*)(p.ws + WS_OLAT);
    const int tid = threadIdx.x, lane = tid & 63, wave = __builtin_amdgcn_readfirstlane(tid >> 6);
    unsigned* SC = (unsigned*)(lds + DSA_KVB);
    unsigned short* IDX = (unsigned short*)(lds + DSA_IDX);
    int* MISC = (int*)(lds + DSA_MISC);
    const unsigned lds_base = (unsigned)(size_t)lds;
    constexpr int NU = SEQ / DSA_NQ;
    for (int unit = blockIdx.x; unit < BATCH * NU; unit += gridDim.x) {
        const int u8 = NU - 1 - unit / BATCH, b = unit % BATCH, t0 = NMETA + u8 * DSA_NQ;
        const int cid = 1 + (t0 - NMETA) / 64, n = NMETA + 64 * cid;
        const bf16_t* Pb = P + (size_t)b * T * PW;
        const int m = lane & 31, hh = lane >> 5;
        bf16x8 aq[2][4]; float wv[2][16];
#pragma unroll
        for (int rt = 0; rt < 2; ++rt) {
#pragma unroll
            for (int s = 0; s < 4; ++s) aq[rt][s] = *(const bf16x8*)(Pb + (size_t)(t0 + 4 * rt + (m >> 3)) * PW + C_QI + (m & 7) * 64 + 16 * s + 8 * hh);
#pragma unroll
            for (int r = 0; r < 16; ++r) wv[rt][r] = bf2f(Pb[(size_t)(t0 + 4 * rt + (r >> 2)) * PW + C_WI + (r & 3) + 4 * hh]);
        }
        const unsigned char* KIPb = p.ws + WS_KIP + (size_t)b * KIP_BATCH + lane * 16;
        bf16x8 bk[4];
#pragma unroll
        for (int s = 0; s < 4; ++s) bk[s] = *(const bf16x8*)(KIPb + (size_t)wave * 4096 + s * 1024);
        __syncthreads();
        {
            const int ntile = (n + 31) / 32;
            for (int kt = wave; kt < ntile; kt += NWAVES) {
                const int j0 = kt * 32, key = j0 + m;
                bf16x8 bn[4];
                { const int ktn = kt + NWAVES < 129 ? kt + NWAVES : 128;
#pragma unroll
                  for (int s = 0; s < 4; ++s) bn[s] = *(const bf16x8*)(KIPb + (size_t)ktn * 4096 + s * 1024); }
                const bool ok = key < n;
#pragma unroll
                for (int rt = 0; rt < 2; ++rt) {
                    f32x16 acc;
#pragma unroll
                    for (int r = 0; r < 16; ++r) acc[r] = 0.f;
#pragma unroll
                    for (int s = 0; s < 4; ++s) acc = __builtin_amdgcn_mfma_f32_32x32x16_bf16(aq[rt][s], bk[s], acc, 0, 0, 0);
                    float tq[4];
#pragma unroll
                    for (int q = 0; q < 4; ++q) {
#define RELU_(x) __builtin_amdgcn_fmed3f((x), 0.f, 3.0e38f)
                        float s = wv[rt][4 * q] * RELU_(acc[4 * q]); s += wv[rt][4 * q + 1] * RELU_(acc[4 * q + 1]); s += wv[rt][4 * q + 2] * RELU_(acc[4 * q + 2]); s += wv[rt][4 * q + 3] * RELU_(acc[4 * q + 3]);
#undef RELU_
                        tq[q] = xsum32(s);
                    }
                    const float s0 = hh ? tq[2] : tq[0], s1 = hh ? tq[3] : tq[1];
                    SC[(4 * rt + 2 * hh) * DSA_SCS + key] = ok ? fkey(s0) : 0u;
                    SC[(4 * rt + 2 * hh + 1) * DSA_SCS + key] = ok ? fkey(s1) : 0u;
                }
#pragma unroll
                for (int s = 0; s < 4; ++s) bk[s] = bn[s];
            }
        }
        __syncthreads();
        bf16x8 qf[5];
        {
            const int hd_ = lane & 15, g_ = lane >> 4;
#pragma unroll
            for (int ks = 0; ks < 5; ++ks) {
                u32x4 w = (u32x4){0u, 0u, 0u, 0u};
                if (hd_ < 8 && (ks < 4 || g_ < 2)) w = *(const u32x4*)(Pb + (size_t)(t0 + wave) * PW + C_QF + hd_ * QFW + 32 * ks + 8 * g_);
                qf[ks] = __builtin_bit_cast(bf16x8, w);
            }
        }
        {
            unsigned* sc = SC + wave * DSA_SCS;
            unsigned v[65];
#pragma unroll
            for (int i = 0; i < 65; ++i) { const int k = i * 64 + lane; v[i] = (k < n) ? sc[k] : 0u; }
            unsigned prefix = 0u; int cge = n, bit = 31;
            bool exact = false;
            if (n >= 256) {
                for (; bit >= 0 && cge > 512; --bit) {
                    const unsigned cand = prefix | (1u << bit); const int sc_ = (int)(cand ^ 0x80000000u);
                    unsigned b0 = 0u, b1 = 0u, b2 = 0u; int slots = 0;
#pragma unroll
                    for (int gi = 0; gi < 5; ++gi) if (gi * 832 < n) {
#pragma unroll
                        for (int i = 13 * gi; i < 13 * gi + 13; ++i) {
                            const unsigned d = (unsigned)__builtin_elementwise_sub_sat((int)(v[i] ^ 0x80000000u), sc_);
                            if (i % 3 == 0) b0 = __builtin_amdgcn_alignbit(b0, d, 31); else if (i % 3 == 1) b1 = __builtin_amdgcn_alignbit(b1, d, 31); else b2 = __builtin_amdgcn_alignbit(b2, d, 31);
                        }
                        slots += 13 * 64;
                    }
                    const int c = slots - wave_sum_i32(__builtin_popcount(b0) + __builtin_popcount(b1) + __builtin_popcount(b2));
                    if (c >= 256) { prefix = cand; cge = c; if (c == 256) { exact = true; break; } }
                }
            }
            int ngt = n;
            if (n >= 256 && !exact) {
                asm volatile("s_waitcnt lgkmcnt(0)" ::: "memory");
                int cb = 0;
                if (bit >= 0) {
                    const int sp_ = (int)((prefix > 0u ? prefix : 1u) ^ 0x80000000u);
                    unsigned lb0 = 0u, lb1 = 0u, lb2 = 0u;
#pragma unroll
                    for (int i = 0; i < 65; ++i) { const unsigned d = (unsigned)__builtin_elementwise_sub_sat((int)(v[i] ^ 0x80000000u), sp_);
                        if (i < 32) lb0 = __builtin_amdgcn_alignbit(lb0, d, 31); else if (i < 64) lb1 = __builtin_amdgcn_alignbit(lb1, d, 31); else lb2 = d >> 31; }
                    const unsigned tk0 = ~lb0, tk1 = ~lb1, tk2 = (~lb2) & 1u;
                    const int c0 = __builtin_popcount(tk0), c1 = __builtin_popcount(tk1);
                    const int lbase = wave_excl_scan_i32(c0 + c1 + (int)tk2, lane, cb);
#pragma unroll
                    for (int i = 0; i < 65; ++i) {
                        bool tkn; int rk;
                        if (i < 32) { tkn = (tk0 >> (31 - i)) & 1u; rk = i == 0 ? 0 : __builtin_popcount(tk0 >> (32 - i)); }
                        else if (i < 64) { tkn = (tk1 >> (63 - i)) & 1u; rk = c0 + (i == 32 ? 0 : __builtin_popcount(tk1 >> (64 - i))); }
                        else { tkn = tk2 != 0u; rk = c0 + c1; }
                        sc[tkn ? lbase + rk : 4096 + (lane & 15)] = v[i];
                    }
                    asm volatile("s_waitcnt lgkmcnt(0)" ::: "memory");
                    unsigned w[8];
#pragma unroll
                    for (int j = 0; j < 8; ++j) { const int k = j * 64 + lane; w[j] = (k < cb) ? sc[k] : 0u; }
                    for (; bit >= 0; --bit) {
                        const unsigned cand = prefix | (1u << bit); const int sc_ = (int)(cand ^ 0x80000000u); unsigned b0 = 0u, b1 = 0u;
#pragma unroll
                        for (int j = 0; j < 8; ++j) { const unsigned d = (unsigned)__builtin_elementwise_sub_sat((int)(w[j] ^ 0x80000000u), sc_); if (j & 1) b1 = __builtin_amdgcn_alignbit(b1, d, 31); else b0 = __builtin_amdgcn_alignbit(b0, d, 31); }
                        const int c = 512 - wave_sum_i32(__builtin_popcount(b0) + __builtin_popcount(b1));
                        if (c >= 256) { prefix = cand; if (c == 256) { exact = true; break; } }
                    }
                    int c = 0;
#pragma unroll
                    for (int j = 0; j < 8; ++j) c += __popcll(__ballot(w[j] > prefix));
                    ngt = c;
                } else {
                    int c = 0;
#pragma unroll
                    for (int i = 0; i < 65; ++i) { c += __popcll(__ballot(v[i] > prefix)); if ((i & 3) == 3) __builtin_amdgcn_sched_barrier(0); }
                    ngt = c;
                }
            }
            const unsigned tau = prefix;
            const int need_eq = n >= 256 ? 256 - ngt : 0; int base = 0, eqb = 0;
            unsigned short* idx = IDX + wave * 512;
            {
                const int st_ = (int)(tau ^ 0x80000000u); unsigned e0 = 0u, e1 = 0u, e2 = 0u;
#pragma unroll
                for (int i = 0; i < 65; ++i) { const unsigned d = (unsigned)__builtin_elementwise_sub_sat((int)(v[i] ^ 0x80000000u), st_);
                    if (i < 32) e0 = __builtin_amdgcn_alignbit(e0, d, 31); else if (i < 64) e1 = __builtin_amdgcn_alignbit(e1, d, 31); else e2 = d >> 31; }
                const unsigned tk0 = ~e0, tk1 = ~e1, tk2 = (~e2) & 1u;
                const int c0 = __builtin_popcount(tk0), c1 = __builtin_popcount(tk1);
                int nge; const int lbase = wave_excl_scan_i32(c0 + c1 + (int)tk2, lane, nge);
                if (n >= 256 && nge == 256) {
                    unsigned short* ib = idx + lbase;
                    { unsigned x = tk0; int j = 0; while (__any(x != 0u)) { if (x != 0u) { const int i = __builtin_clz(x); ib[j] = (unsigned short)(i * 64 + lane); x ^= 0x80000000u >> i; } ++j; } }
                    ib += c0;
                    { unsigned x = tk1; int j = 0; while (__any(x != 0u)) { if (x != 0u) { const int i = __builtin_clz(x); ib[j] = (unsigned short)((32 + i) * 64 + lane); x ^= 0x80000000u >> i; } ++j; } }
                    if (tk2 != 0u) ib[c1] = (unsigned short)(64 * 64 + lane);
                    base = nge;
                } else {
#pragma unroll
                    for (int gi = 0; gi < 5; ++gi) if (gi * 832 < n) {
#pragma unroll
                        for (int i = 13 * gi; i < 13 * gi + 13; ++i) {
                            const int k = i * 64 + lane; const unsigned u = v[i];
                            const bool eq = (u == tau); const unsigned long long meq = __ballot(eq);
                            const bool take = (u > tau) || (eq && (eqb + mbcnt64(meq)) < need_eq);
                            const unsigned long long mt = __ballot(take);
                            idx[take ? base + mbcnt64(mt) : 256 + lane] = (unsigned short)k;
                            base += __popcll(mt); eqb += __popcll(meq);
                            if ((i & 3) == 3) __builtin_amdgcn_sched_barrier(0);
                        }
                    }
                }
            }
            for (int pos = base + lane; pos < 256; pos += 64) idx[pos] = 0;
            if (lane == 0) MISC[wave] = base;
        }
        asm volatile("s_waitcnt lgkmcnt(0)" ::: "memory");
        {
            const int q = wave; const int nsel = __builtin_amdgcn_readfirstlane(MISC[q]);
            const size_t qrow = (size_t)(t0 + q);
            int ln = lane; asm volatile("" : "+v"(ln));
            const int hd = ln & 15, g = ln >> 4, qd = (ln & 15) >> 2, pp = ln & 3;
            char* ring = lds + DSA_KVB + wave * DSA_RING;
            const unsigned ring_a = lds_base + DSA_KVB + wave * DSA_RING;
            const unsigned short* idx = IDX + q * 512;
            asm volatile("s_waitcnt vmcnt(0)" ::: "memory");
#define DSA_ISSUE(c) do { unsigned rw_[9]; \
                _Pragma("unroll") for (int i_ = 0; i_ < 9; ++i_) { const int pid_ = ln + 64 * i_, row_ = pid_ / 18; rw_[i_] = idx[32 * (c) + row_]; } \
                _Pragma("unroll") for (int i_ = 0; i_ < 9; ++i_) { const int pid_ = ln + 64 * i_, row_ = pid_ / 18, part_ = pid_ - row_ * 18; \
                    const unsigned off_ = rw_[i_] * (unsigned)(PW * 2) + (unsigned)((C_KV + part_ * 8) * 2); \
                    __builtin_amdgcn_global_load_lds((const unsigned*)((const char*)Pb + off_), (LAS unsigned*)(ring + ((c) & 1) * 9216 + i_ * 1024), 16, 0, 0); } } while (0)
            DSA_ISSUE(0); DSA_ISSUE(1);
            f32x4 O[8];
#pragma unroll
            for (int nt = 0; nt < 8; ++nt) O[nt] = (f32x4){0.f, 0.f, 0.f, 0.f};
            float mrun = -3e38f, lrun = 0.f;
            for (int c = 0; c < 8; ++c) {
                if (c < 7) asm volatile("s_waitcnt vmcnt(9)" ::: "memory"); else asm volatile("s_waitcnt vmcnt(0)" ::: "memory");
                const char* buf = ring + (c & 1) * 9216;
                f32x4 S0 = (f32x4){0.f, 0.f, 0.f, 0.f}, S1 = S0;
                {
                    const char* kr = buf + hd * 288 + 16 * g;
#pragma unroll
                    for (int ks = 0; ks < 4; ++ks) { S0 = __builtin_amdgcn_mfma_f32_16x16x32_bf16(*(const bf16x8*)(kr + 64 * ks), qf[ks], S0, 0, 0, 0); S1 = __builtin_amdgcn_mfma_f32_16x16x32_bf16(*(const bf16x8*)(kr + 16 * 288 + 64 * ks), qf[ks], S1, 0, 0, 0); }
                    u32x4 w0 = (u32x4){0u, 0u, 0u, 0u}, w1 = w0; if (g < 2) { w0 = *(const u32x4*)(kr + 256); w1 = *(const u32x4*)(kr + 16 * 288 + 256); }
                    S0 = __builtin_amdgcn_mfma_f32_16x16x32_bf16(__builtin_bit_cast(bf16x8, w0), qf[4], S0, 0, 0, 0); S1 = __builtin_amdgcn_mfma_f32_16x16x32_bf16(__builtin_bit_cast(bf16x8, w1), qf[4], S1, 0, 0, 0);
                }
                float cm = -3e38f;
#pragma unroll
                for (int r = 0; r < 4; ++r) { if (nsel < 256) { const int sl = 32 * c + 4 * g + r; S0[r] = sl < nsel ? S0[r] : -1e30f; S1[r] = (sl + 16) < nsel ? S1[r] : -1e30f; } cm = fmax2(cm, fmax2(S0[r], S1[r])); }
                cm = xmax16(xmax32(cm));
                if (__any(cm > mrun + 6.f)) {
                    const float mnew = fmaxf(mrun, cm), alpha = fexp2(mrun - mnew);
                    lrun *= alpha; mrun = mnew;
#pragma unroll
                    for (int nt = 0; nt < 8; ++nt) O[nt] *= alpha;
                }
                float ps = 0.f;
#pragma unroll
                for (int r = 0; r < 4; ++r) { S0[r] = fexp2(S0[r] - mrun); S1[r] = fexp2(S1[r] - mrun); ps += S0[r] + S1[r]; }
                ps = xsum16(xsum32(ps));
                lrun += ps;
                u32x4 pw; pw.x = pk2(S0[0], S0[1]); pw.y = pk2(S0[2], S0[3]); pw.z = pk2(S1[0], S1[1]); pw.w = pk2(S1[2], S1[3]);
                const bf16x8 pf = __builtin_bit_cast(bf16x8, pw);
                const unsigned va = ring_a + (unsigned)((c & 1) * 9216 + (4 * g + qd) * 288 + 8 * pp);
#pragma unroll
                for (int h2 = 0; h2 < 2; ++h2) {
                    u16x4 x0, x1, x2, x3, y0, y1, y2, y3;
                    asm volatile("ds_read_b64_tr_b16 %0, %8 offset:%9\n\tds_read_b64_tr_b16 %1, %8 offset:%10\n\tds_read_b64_tr_b16 %2, %8 offset:%11\n\tds_read_b64_tr_b16 %3, %8 offset:%12\n\t"
                                 "ds_read_b64_tr_b16 %4, %8 offset:%13\n\tds_read_b64_tr_b16 %5, %8 offset:%14\n\tds_read_b64_tr_b16 %6, %8 offset:%15\n\tds_read_b64_tr_b16 %7, %8 offset:%16\n\ts_waitcnt lgkmcnt(0)"
                                 : "=&v"(x0), "=&v"(x1), "=&v"(x2), "=&v"(x3), "=&v"(y0), "=&v"(y1), "=&v"(y2), "=&v"(y3)
                                 : "v"(va), "i"(128 * h2), "i"(128 * h2 + 32), "i"(128 * h2 + 64), "i"(128 * h2 + 96), "i"(128 * h2 + 4608), "i"(128 * h2 + 4640), "i"(128 * h2 + 4672), "i"(128 * h2 + 4704) : "memory");
#define DSA_PV(nt_, x_, y_) do { bf16x8 vf_; vf_[0] = (short)x_[0]; vf_[1] = (short)x_[1]; vf_[2] = (short)x_[2]; vf_[3] = (short)x_[3]; vf_[4] = (short)y_[0]; vf_[5] = (short)y_[1]; vf_[6] = (short)y_[2]; vf_[7] = (short)y_[3]; \
                    O[nt_] = __builtin_amdgcn_mfma_f32_16x16x32_bf16(vf_, pf, O[nt_], 0, 0, 0); } while (0)
                    DSA_PV(4 * h2 + 0, x0, y0); DSA_PV(4 * h2 + 1, x1, y1); DSA_PV(4 * h2 + 2, x2, y2); DSA_PV(4 * h2 + 3, x3, y3);
                }
                asm volatile("s_waitcnt lgkmcnt(0)" ::: "memory");
                if (c + 2 < 8) DSA_ISSUE(c + 2);
            }
#undef DSA_PV
#undef DSA_ISSUE
            const float inv = __builtin_amdgcn_rcpf(lrun);
            if (hd < 8) {
                bf16_t* op = OL + ((size_t)b * SEQ + (qrow - NMETA)) * 1024 + hd * 128 + 4 * g;
#pragma unroll
                for (int nt = 0; nt < 8; ++nt) { u32x2 w; w.x = pk2(O[nt][0] * inv, O[nt][1] * inv); w.y = pk2(O[nt][2] * inv, O[nt][3] * inv); *(u32x2*)(op + 16 * nt) = w; }
            }
        }
    }
}

__device__ __forceinline__ void phase_inproj_meta(const Params& p) {
    unsigned char* ws = p.ws; const int tid = threadIdx.x, lane = tid & 63, wave = tid >> 6, fr = lane & 15, fq = lane >> 4;
    const bf16_t* U = (const bf16_t*)(ws + WS_U); const bf16_t* WP = (const bf16_t*)(ws + WS_WP); bf16_t* P = (bf16_t*)(ws + WS_P); const float2* cs = (const float2*)(ws + WS_CS);
    const int gw = blockIdx.x * NWAVES + wave, NGW = gridDim.x * NWAVES;
    for (int nt = gw; nt < PW / 16; nt += NGW) {
        const bf16_t* ap = U + (size_t)fr * D + 8 * fq; const bf16_t* bp = WP + (size_t)(16 * nt + fr) * D + 8 * fq;
        f32x4 acc = (f32x4){0.f, 0.f, 0.f, 0.f};
#pragma unroll 8
        for (int ks = 0; ks < D / 32; ++ks) acc = __builtin_amdgcn_mfma_f32_16x16x32_bf16(*(const bf16x8*)(bp + 32 * ks), *(const bf16x8*)(ap + 32 * ks), acc, 0, 0, 0);
        const int col = 16 * nt + 4 * fq, t = fr; f32x4 v = acc; int o;
        if (pg8::rope_off(col, o)) { const float2 c0 = cs[t * 8 + (o >> 1)], c1 = cs[t * 8 + (o >> 1) + 1]; v = (f32x4){v.x * c0.x - v.y * c0.y, v.y * c0.x + v.x * c0.y, v.z * c1.x - v.w * c1.y, v.w * c1.x + v.z * c1.y}; }
        u32x2 w; w.x = pk2(v.x, v.y); w.y = pk2(v.z, v.w);
        for (int b = 0; b < BATCH; ++b) {
            if (col >= C_KI && col < C_WI) { const int d0 = col - C_KI;
                *(u32x2*)(ws + WS_KIP + (size_t)b * KIP_BATCH + (size_t)((((t >> 5) * 4 + (d0 >> 4)) * 2 + ((d0 >> 3) & 1)) * 512 + (t & 31) * 16 + (d0 & 7) * 2)) = w; }
            else *(u32x2*)(P + ((size_t)b * T + t) * PW + col) = w;
        }
    }
}

__device__ __forceinline__ void phase_c3(const Params& p, char* lds) {
    unsigned char* ws = p.ws; const int tid = threadIdx.x, lane = tid & 63, wave = __builtin_amdgcn_readfirstlane(tid >> 6);
    const float* H1 = (const float*)(ws + WS_H1); const float* g = p.in[I_GFFN]; bf16_t* U2 = (bf16_t*)(ws + WS_U);
    const bf16_t* WH = (const bf16_t*)(ws + WS_WRT); const bf16_t* WL = WH + WRT_N * D;
    const float* bg = p.in[I_BGRP]; const float* br = p.in[I_BRT];
    unsigned* ctl = (unsigned*)(ws + WS_CTL); int* LIST = (int*)(ws + WS_LIST); float* GATE = (float*)(ws + WS_GATE); float* RS = (float*)(ws + WS_RSTD2);
    float* LG = (float*)lds + wave * (16 * 49 + 16);
    const int gw = blockIdx.x * NWAVES + wave, NGW = gridDim.x * NWAVES;
    const int tr = lane & 15, g4 = lane >> 4;
    for (int tile = gw; tile < NR / 16; tile += NGW) {
        const int row = tile * 16 + tr;
        const float* hp = H1 + (size_t)row * D + 8 * g4; bf16_t* up = U2 + (size_t)row * D + 8 * g4;
        const bf16_t* whp = WH + (size_t)tr * D + 8 * g4; const bf16_t* wlp = WL + (size_t)tr * D + 8 * g4;
        f32x4 acc[3]; float ss = 0.f;
#pragma unroll
        for (int nt = 0; nt < 3; ++nt) acc[nt] = (f32x4){0.f, 0.f, 0.f, 0.f};
        f32x4 xq[4][2]; bf16x8 bc[6], bn[6];
#pragma unroll
        for (int j = 0; j < 4; ++j) { xq[j][0] = *(const f32x4*)(hp + 32 * j); xq[j][1] = *(const f32x4*)(hp + 32 * j + 4); }
#pragma unroll
        for (int nt = 0; nt < 3; ++nt) { bc[2 * nt] = *(const bf16x8*)(whp + (size_t)nt * 16 * D); bc[2 * nt + 1] = *(const bf16x8*)(wlp + (size_t)nt * 16 * D); }
#pragma unroll 4
        for (int s = 0; s < 32; ++s) {
            const f32x4 x0 = xq[s & 3][0], x1 = xq[s & 3][1];
            { const int sn = s + 4 < 32 ? s + 4 : 31; xq[s & 3][0] = *(const f32x4*)(hp + 32 * sn); xq[s & 3][1] = *(const f32x4*)(hp + 32 * sn + 4); }
            { const int sb = s + 1 < 32 ? s + 1 : 31;
#pragma unroll
              for (int nt = 0; nt < 3; ++nt) { bn[2 * nt] = *(const bf16x8*)(whp + (size_t)nt * 16 * D + 32 * sb); bn[2 * nt + 1] = *(const bf16x8*)(wlp + (size_t)nt * 16 * D + 32 * sb); } }
            const f32x4 g0 = *(const f32x4*)(g + 32 * s + 8 * g4), g1 = *(const f32x4*)(g + 32 * s + 8 * g4 + 4);
            ss += (x0.x * x0.x + x0.y * x0.y) + (x0.z * x0.z + x0.w * x0.w) + (x1.x * x1.x + x1.y * x1.y) + (x1.z * x1.z + x1.w * x1.w);
            const f32x4 h0 = x0 * g0, h1 = x1 * g1;
            u32x4 hi; hi.x = pk2(h0.x, h0.y); hi.y = pk2(h0.z, h0.w); hi.z = pk2(h1.x, h1.y); hi.w = pk2(h1.z, h1.w);
            *(u32x4*)(up + 32 * s) = hi;
            u32x4 lo; lo.x = pk2(h0.x - bflo(hi.x), h0.y - bfhi(hi.x)); lo.y = pk2(h0.z - bflo(hi.y), h0.w - bfhi(hi.y)); lo.z = pk2(h1.x - bflo(hi.z), h1.y - bfhi(hi.z)); lo.w = pk2(h1.z - bflo(hi.w), h1.w - bfhi(hi.w));
            const bf16x8 ah = __builtin_bit_cast(bf16x8, hi), al = __builtin_bit_cast(bf16x8, lo);
#pragma unroll
            for (int nt = 0; nt < 3; ++nt) {
                acc[nt] = __builtin_amdgcn_mfma_f32_16x16x32_bf16(ah, bc[2 * nt], acc[nt], 0, 0, 0);
                acc[nt] = __builtin_amdgcn_mfma_f32_16x16x32_bf16(ah, bc[2 * nt + 1], acc[nt], 0, 0, 0);
                acc[nt] = __builtin_amdgcn_mfma_f32_16x16x32_bf16(al, bc[2 * nt], acc[nt], 0, 0, 0);
            }
#pragma unroll
            for (int j = 0; j < 6; ++j) bc[j] = bn[j];
        }
        ss = xsum16(xsum32(ss));
#pragma unroll
        for (int nt = 0; nt < 3; ++nt)
#pragma unroll
            for (int r = 0; r < 4; ++r) LG[(4 * g4 + r) * 49 + 16 * nt + tr] = acc[nt][r];
        if (g4 == 0) LG[16 * 49 + tr] = ss;
        asm volatile("s_waitcnt lgkmcnt(0)" ::: "memory");
        if (lane < 16) {
            const int tok = tile * 16 + lane; const float* lg = LG + lane * 49;
            const float rstd = rsqrtf(LG[16 * 49 + lane] * (1.f / D) + NORM_EPS);
            RS[tok] = rstd;
            float gl[4]; int gs = 0; float gm;
#pragma unroll
            for (int o = 0; o < 4; ++o) gl[o] = lg[o] * rstd + bg[o];
            gm = gl[0];
#pragma unroll
            for (int o = 1; o < 4; ++o) if (gl[o] > gm) { gm = gl[o]; gs = o; }
            float gsum = 0.f;
#pragma unroll
            for (int o = 0; o < 4; ++o) gsum += __expf(gl[o] - gm);
            const float pgrp = 1.f / gsum;
            float el[8];
#pragma unroll
            for (int j = 0; j < 8; ++j) el[j] = lg[4 + gs * 8 + j] * rstd + br[gs * 8 + j];
            int e0 = 0; float m0 = el[0];
#pragma unroll
            for (int j = 1; j < 8; ++j) if (el[j] > m0) { m0 = el[j]; e0 = j; }
            int e1 = -1; float m1 = -3e38f;
#pragma unroll
            for (int j = 0; j < 8; ++j) if (j != e0 && el[j] > m1) { m1 = el[j]; e1 = j; }
            const float x1 = __expf(m1 - m0); const float g0 = pgrp / (1.f + x1), g1 = pgrp * x1 / (1.f + x1);
            const int ex0 = gs * 8 + e0, ex1 = gs * 8 + e1;
            const int s0 = (int)atomicAdd(ctl + CW_CNT + 64 * ex0, 1u); LIST[(size_t)ex0 * NR + s0] = tok * 2;
            const int s1 = (int)atomicAdd(ctl + CW_CNT + 64 * ex1, 1u); LIST[(size_t)ex1 * NR + s1] = tok * 2 + 1;
            GATE[tok * 2] = g0; GATE[tok * 2 + 1] = g1;
        }
        asm volatile("s_waitcnt lgkmcnt(0)" ::: "memory");
    }
}

template <int WHICH>
__device__ __forceinline__ void phase_moe(const Params& p, char* lds) {
    unsigned char* ws = p.ws; const int tid = threadIdx.x;
    const unsigned* ctl = (const unsigned*)(ws + WS_CTL);
    int* TP = (int*)(lds + pg8::STAGE_BYTES);
    __syncthreads();
    if (tid == 0) { int tp = 0, ro = 0; for (int e = 0; e < NEXP; ++e) { const int c = (int)ctl[CW_CNT + 64 * e]; TP[e] = tp; TP[64 + e] = ro; TP[128 + e] = c; const int t = (c + 255) / 256; tp += t * 4; ro += t * 256; } TP[NEXP] = tp; }
    __syncthreads();
    pg8::MoeOrder<WHICH> S{TP, (int)gridDim.x, (int)blockIdx.x, (const char*)(ws + (WHICH == 0 ? WS_U : WS_HID)), (const char*)(ws + (WHICH == 0 ? WS_W13 : WS_W2)), (const int*)(ws + WS_LIST)};
    if constexpr (WHICH == 0) { pg8::EpiMoe1 E{(bf16_t*)(ws + WS_HID), TP, (const int*)(ws + WS_LIST), (const float*)(ws + WS_RSTD2)}; pg8::gemm_phase_x<pg8::EpiMoe1, pg8::MoeOrder<0>, true, true>((LAS unsigned char*)lds, 1024, S, E); }
    else { pg8::EpiMoe2 E{(bf16_t*)(ws + WS_MO), TP, (const int*)(ws + WS_LIST), (const float*)(ws + WS_GATE)}; pg8::gemm_phase_x<pg8::EpiMoe2, pg8::MoeOrder<1>, true, true>((LAS unsigned char*)lds, 512, S, E); }
}

__device__ __forceinline__ void phase_final(const Params& p) {
    unsigned char* ws = p.ws; const int tid = threadIdx.x, lane = tid & 63, wave = tid >> 6;
    const float* H1 = (const float*)(ws + WS_H1); const bf16_t* MO = (const bf16_t*)(ws + WS_MO); const float* g = p.in[I_GFIN];
    const int gw = blockIdx.x * NWAVES + wave, NGW = gridDim.x * NWAVES;
    f32x4 vn[4]; u32x2 an[4], cn[4];
#define FIN_LOAD(r_) do { const size_t row_ = (size_t)(r_); const f32x4* xr_ = (const f32x4*)(H1 + row_ * D) + lane; const u32x2* m0_ = (const u32x2*)(MO + row_ * 2 * D) + lane; \
        _Pragma("unroll") for (int j = 0; j < 4; ++j) { vn[j] = xr_[64 * j]; an[j] = m0_[64 * j]; cn[j] = m0_[256 + 64 * j]; } } while (0)
    if (gw < BATCH * SEQ) FIN_LOAD(gw);
    for (int orow = gw; orow < BATCH * SEQ; orow += NGW) {
        f32x4 v[4]; u32x2 aa[4], cc[4]; float ss = 0.f;
#pragma unroll
        for (int j = 0; j < 4; ++j) { v[j] = vn[j]; aa[j] = an[j]; cc[j] = cn[j]; }
        if (orow + NGW < BATCH * SEQ) FIN_LOAD(orow + NGW);
#pragma unroll
        for (int j = 0; j < 4; ++j) { const u32x2 a = aa[j], c = cc[j];
            v[j].x += bflo(a.x) + bflo(c.x); v[j].y += bfhi(a.x) + bfhi(c.x); v[j].z += bflo(a.y) + bflo(c.y); v[j].w += bfhi(a.y) + bfhi(c.y);
            ss += (v[j].x * v[j].x + v[j].y * v[j].y) + (v[j].z * v[j].z + v[j].w * v[j].w); }
        const float rstd = rsqrtf(wave_sum(ss) * (1.f / D) + NORM_EPS);
        f32x4* o = (f32x4*)(p.out + (size_t)orow * D) + lane;
#pragma unroll
        for (int j = 0; j < 4; ++j) { const f32x4 gg = ((const f32x4*)g)[lane + 64 * j]; o[64 * j] = v[j] * rstd * gg; }
    }
#undef FIN_LOAD
}

#define XB_TMO      128
#define XB_XCNT(j)  (256  + 64 * (j))
#define XB_XSUB(j)  (1280 + 64 * (j))
#define XB_XGEN(j)  (2304 + 64 * (j))
#define XB_TOP      3328
#define XB_TOPGEN   3392
#define XCD_BAR_WORDS 3456
#define XB_SPIN_CAP (1u << 18)
__device__ __forceinline__ unsigned xb_ld(unsigned* p)              { return __hip_atomic_load(p, __ATOMIC_RELAXED, __HIP_MEMORY_SCOPE_AGENT); }
__device__ __forceinline__ unsigned xb_add(unsigned* p, unsigned v) { return __hip_atomic_fetch_add(p, v, __ATOMIC_RELAXED, __HIP_MEMORY_SCOPE_AGENT); }
__device__ __forceinline__ unsigned xb_xcc_id() { return (unsigned)__builtin_amdgcn_s_getreg((3 << 11) | 20) & 0xFu; }
#define XB_SPIN(cond, bar) do { unsigned _sp = 0; while (cond) { __builtin_amdgcn_s_sleep(1); \
    if ((++_sp & 255u) == 0u) { if (xb_ld(&(bar)[XB_TMO])) break; if (_sp > XB_SPIN_CAP) { atomicAdd(&(bar)[XB_TMO], 1u); break; } } } } while (0)
struct XcdBarrier { unsigned* bar; unsigned x; volatile LAS unsigned* st; };
__device__ __forceinline__ XcdBarrier xcd_barrier_post(unsigned* bar, volatile LAS unsigned* st) {
    XcdBarrier b; b.bar = bar; b.x = xb_xcc_id(); b.st = st;
    if (threadIdx.x == 0) (void)xb_add(&bar[XB_XCNT(b.x)], 1u);
    return b;
}
__device__ __forceinline__ void xcd_barrier_complete(unsigned* bar, unsigned x, unsigned& nloc, unsigned& nx) {
    const unsigned G = gridDim.x * gridDim.y * gridDim.z;
    unsigned sum, cnt, mine, sp = 0u;
    for (;;) {
        sum = 0u; cnt = 0u; mine = 0u;
#pragma unroll
        for (unsigned j = 0; j < 16; ++j) { const unsigned c = xb_ld(&bar[XB_XCNT(j)]); sum += c; cnt += (c > 0u) ? 1u : 0u; mine = (j == x) ? c : mine; }
        if (sum == G) break;
        __builtin_amdgcn_s_sleep(1);
        if ((++sp & 255u) == 0u) { if (xb_ld(&bar[XB_TMO])) break; if (sp > XB_SPIN_CAP) { atomicAdd(&bar[XB_TMO], 1u); break; } }
    }
    nloc = mine > 0u ? mine : 1u; nx = cnt > 0u ? cnt : 1u;
}
__device__ __forceinline__ void xcd_barrier(const XcdBarrier& b) {
    asm volatile("s_waitcnt vmcnt(0)" ::: "memory");
    __syncthreads();
    if (threadIdx.x == 0) {
        unsigned* bar = b.bar;
        __builtin_amdgcn_s_waitcnt(0);
        unsigned nloc = b.st[0], nx = b.st[1];
        if (nloc == 0u) { xcd_barrier_complete(bar, b.x, nloc, nx); b.st[0] = nloc; b.st[1] = nx; }
        const unsigned old = xb_add(&bar[XB_XSUB(b.x)], 1u);
        const unsigned gen = old / nloc;
        if (old + 1u == (gen + 1u) * nloc) {
            __builtin_amdgcn_fence(__ATOMIC_RELEASE, "agent");
            asm volatile("s_waitcnt vmcnt(0)" ::: "memory");
            const unsigned og = xb_add(&bar[XB_TOP], 1u);
            const unsigned tg = og / nx;
            if (og + 1u == (tg + 1u) * nx) xb_add(&bar[XB_TOPGEN], 1u);
            else XB_SPIN(xb_ld(&bar[XB_TOPGEN]) == tg, bar);
            __builtin_amdgcn_fence(__ATOMIC_ACQUIRE, "agent");
            xb_add(&bar[XB_XGEN(b.x)], 1u);
            asm volatile("s_waitcnt vmcnt(0)" ::: "memory");
        } else {
            XB_SPIN(xb_ld(&bar[XB_XGEN(b.x)]) == gen, bar);
            __builtin_amdgcn_fence(__ATOMIC_ACQUIRE, "agent");
            asm volatile("s_waitcnt vmcnt(0)" ::: "memory");
        }
    }
    __syncthreads();
}

constexpr int LDS_XB = DSA_LDS;
constexpr int LDS_BYTES = DSA_LDS + 256;
static_assert(pg8::STAGE_BYTES <= LDS_XB && pg8::STAGE_BYTES + 1024 <= LDS_XB && NWAVES * 64 * 33 * 4 <= LDS_XB && NWAVES * 32 * SB_VROW <= LDS_XB && NWAVES * (16 * 49 + 16) * 4 <= LDS_XB, "LDS map");

__global__ void __launch_bounds__(NTHREADS, 2) mega(Params p) {
    extern __shared__ __attribute__((aligned(16))) char lds[];
    const int lo = p.ph_lo, hi = p.ph_hi;
    unsigned char* ws = p.ws;
    XcdBarrier xb;
    {
        volatile LAS unsigned* st = (volatile LAS unsigned*)(lds + LDS_XB);
        if (threadIdx.x < 4) st[threadIdx.x] = 0u;
        __syncthreads();
        xb = xcd_barrier_post((unsigned*)(ws + WS_CTL) + CW_BAR, st);
    }
#define IN(k) (lo <= (k) && (k) < hi)
#define GSYNC() xcd_barrier(xb)
#define SEAM(k) do { if (IN(k) && IN((k) + 1)) GSYNC(); } while (0)
#define REP(k, ...) do { if (IN(k)) { __VA_ARGS__; } } while (0)
    LAS unsigned char* ldsl = (LAS unsigned char*)lds;
    REP(0, phase_prologue(p, lds));
    SEAM(0);
    REP(1, { phase_inproj_meta(p);
             pg8::TokRowOrder S; S.init(NR, PWN, gridDim.x, blockIdx.x); S.Abase = (const char*)(ws + WS_U); S.Bbase = (const char*)(ws + WS_WP); S.K = D;
             pg8::EpiInproj E{(bf16_t*)(ws + WS_P), (const float2*)(ws + WS_CS), ws + WS_KIP}; pg8::gemm_phase_x<pg8::EpiInproj, pg8::TokRowOrder, true, true>(ldsl, D, S, E); });
    SEAM(1);
    if (IN(2)) {
        phase_dsa(p, lds);
        __syncthreads(); phase_sb_fast(p, lds);
    }
    SEAM(2);
    REP(3, { pg8::TokRowOrder S; S.init(NR, 2048, gridDim.x, blockIdx.x); S.Abase = (const char*)(ws + WS_U); S.Bbase = (const char*)(ws + WS_WG); S.K = D;
             pg8::EpiGate E{(bf16_t*)(ws + WS_G)}; pg8::gemm_phase_x<pg8::EpiGate, pg8::TokRowOrder, true, true>(ldsl, D, S, E); });
    SEAM(3);
    REP(4, { { pg8::Gemm g{(const bf16_t*)(ws + WS_YA), (const bf16_t*)(ws + WS_WUA), NR, D, 512}; pg8::StaticOrder S; S.init(NR, D, gridDim.x, blockIdx.x);
               pg8::EpiZ<false> E{(bf16_t*)(ws + WS_Z), (const bf16_t*)(ws + WS_G), 0}; pg8::gemm_phase<pg8::EpiZ<false>, pg8::StaticOrder, true, true>(ldsl, g, S, E); }
             asm volatile("s_waitcnt vmcnt(0)" ::: "memory"); __syncthreads();
             { pg8::Gemm g{(const bf16_t*)(ws + WS_OLAT), (const bf16_t*)(ws + WS_WBP), NR, D, D}; pg8::StaticOrder S; S.init(NR, D, gridDim.x, blockIdx.x);
               pg8::EpiZ<true> E{(bf16_t*)(ws + WS_Z), (const bf16_t*)(ws + WS_G), 1024}; pg8::gemm_phase<pg8::EpiZ<true>, pg8::StaticOrder, true, true>(ldsl, g, S, E); } });
    SEAM(4);
    REP(5, { pg8::Gemm g{(const bf16_t*)(ws + WS_Z), (const bf16_t*)(ws + WS_WO), NR, D, D}; pg8::StaticOrder S; S.init(NR, D, gridDim.x, blockIdx.x);
             pg8::EpiH1 E{(float*)(ws + WS_H1), p.in[I_META], p.in[I_X]}; pg8::gemm_phase<pg8::EpiH1, pg8::StaticOrder, true, true>(ldsl, g, S, E); });
    SEAM(5);
    if (IN(6)) phase_c3(p, lds);
    SEAM(6);
    REP(7, phase_moe<0>(p, lds));
    SEAM(7);
    REP(8, phase_moe<1>(p, lds));
    SEAM(8);
    REP(9, phase_final(p));
}

extern "C" void kernel_launch(void* const* d_in, const int* in_sizes, int n_in, void* d_out, int out_size, void* d_ws, size_t ws_size, hipStream_t stream) {
    if (n_in != 18 || ws_size < WS_END) { fprintf(stderr, "kernel_launch: unexpected n_in %d / ws_size %zu\n", n_in, ws_size); return; }
    static int grid = 0;
    if (grid == 0) {
        int dev = 0, cus = 0, per_cu = 0;
        (void)hipGetDevice(&dev);
        (void)hipDeviceGetAttribute(&cus, hipDeviceAttributeMultiprocessorCount, dev);
        (void)hipFuncSetAttribute((const void*)mega, hipFuncAttributeMaxDynamicSharedMemorySize, LDS_BYTES);
        (void)hipOccupancyMaxActiveBlocksPerMultiprocessor(&per_cu, (const void*)mega, NTHREADS, LDS_BYTES);
        if (per_cu < 1) fprintf(stderr, "kernel_launch: occupancy query reports %d workgroups per CU\n", per_cu);
        grid = cus;
    }
    (void)hipMemsetAsync((char*)d_ws + WS_CTL, 0, CTL_BYTES, stream);
    Params p{};
    for (int i = 0; i < 18; ++i) p.in[i] = (const float*)d_in[i];
    p.out = (float*)d_out; p.ws = (unsigned char*)d_ws;
    p.ph_lo = 0; p.ph_hi = 10;
    void* args[] = {&p};
    hipError_t e = hipLaunchCooperativeKernel((const void*)mega, dim3(grid), dim3(NTHREADS), args, LDS_BYTES, stream);
    if (e != hipSuccess) fprintf(stderr, "cooperative launch failed: %s (grid %d)\n", hipGetErrorString(e), grid);
}
```

```cpp
#include <hip/hip_runtime.h>
#include <cstdio>
#include <cstdint>

constexpr int BATCH = 8, SEQ = 4096, NMETA = 16, T = SEQ + NMETA, D = 1024, NTOK = BATCH * T;
constexpr int MROWS = 33024;
constexpr int NR = BATCH * SEQ;
__device__ __forceinline__ int tokrow(int cr) { return cr + NMETA * (cr / SEQ + 1); }
constexpr int INW = 4824;
constexpr int NEXP = 32, DEXP = 512;
constexpr int NWAVES = 8, NTHREADS = 512;
constexpr float NORM_EPS = 1e-6f;
constexpr float LOG2E = 1.4426950408889634f;
constexpr float QSCALE = 0.125f * LOG2E;
constexpr int PW = 3456, PWN = 3584;
constexpr int C_QA = 0, C_KA = 512, C_VA = 1024, C_QF = 1536, C_KV = 2688, C_QI = 2832, C_KI = 3344, C_WI = 3408, C_END = 3416;
constexpr int QFW = 144;

constexpr size_t MiB = 1u << 20;
constexpr size_t WS_CTL = 0, CTL_BYTES = 1 * MiB;
constexpr size_t WS_CS = 1 * MiB;
constexpr size_t WS_WRT = 1 * MiB + 512 * 1024;
constexpr int WRT_N = 48;
constexpr size_t WS_WP = 2 * MiB;
constexpr size_t WS_WG = 9 * MiB;
constexpr size_t WS_WUA = 13 * MiB, WS_WBP = 14 * MiB, WS_WO = 16 * MiB;
constexpr size_t WS_W2 = 18 * MiB;
constexpr size_t WS_W13 = 50 * MiB;
constexpr size_t WS_U = 114 * MiB;
constexpr size_t WS_P = 179 * MiB;
constexpr size_t WS_Z = 179 * MiB;
constexpr size_t WS_G = 244 * MiB;
constexpr size_t WS_H1 = 244 * MiB;
constexpr size_t WS_LIST = 374 * MiB;
constexpr size_t WS_GATE = 379 * MiB;
constexpr size_t WS_RSTD2 = 380 * MiB;
constexpr size_t WS_YA = 397 * MiB;
constexpr size_t WS_OLAT = 430 * MiB;
constexpr size_t WS_HID = 397 * MiB;
constexpr size_t WS_MO = 50 * MiB;
constexpr size_t WS_KIP = 495 * MiB;
constexpr size_t KIP_BATCH = 129 * 4096;
constexpr size_t WS_END = 500 * MiB;
static_assert(WS_P + (size_t)MROWS * PW * 2 <= WS_YA && WS_G + (size_t)MROWS * 2048 * 2 <= WS_LIST && WS_Z + (size_t)MROWS * 1024 * 2 <= WS_G, "ws map");
static_assert(WS_OLAT + (size_t)MROWS * 1024 * 2 <= WS_END && WS_U + (size_t)MROWS * 1024 * 2 <= WS_P && WS_MO + (size_t)NTOK * 2048 * 2 <= WS_P, "ws map");
constexpr int CW_CNT = 1024;
constexpr int CW_BAR = 4096;

typedef unsigned short bf16_t;
typedef short bf16x8 __attribute__((ext_vector_type(8)));
typedef float f32x4 __attribute__((ext_vector_type(4)));
typedef float f32x16 __attribute__((ext_vector_type(16)));
typedef unsigned u32x2 __attribute__((ext_vector_type(2)));
typedef unsigned u32x4 __attribute__((ext_vector_type(4)));
typedef unsigned short u16x4 __attribute__((ext_vector_type(4)));
typedef short s16x2 __attribute__((ext_vector_type(2)));
#define LAS __attribute__((address_space(3)))

__device__ __forceinline__ unsigned f2bf(float f) { unsigned u = __float_as_uint(f); return (u + 0x7fffu + ((u >> 16) & 1u)) >> 16; }
typedef __bf16 bf16v2_t __attribute__((ext_vector_type(2)));
typedef float f32v2_t __attribute__((ext_vector_type(2)));
__device__ __forceinline__ unsigned pk2(float lo, float hi) { const f32v2_t v = {lo, hi}; const bf16v2_t r = __builtin_convertvector(v, bf16v2_t); return __builtin_bit_cast(unsigned, r); }
__device__ __forceinline__ float bflo(unsigned w) { return __uint_as_float(w << 16); }
__device__ __forceinline__ float bfhi(unsigned w) { return __uint_as_float(w & 0xffff0000u); }
__device__ __forceinline__ float bf2f(bf16_t b) { return __uint_as_float((unsigned)b << 16); }
__device__ __forceinline__ float wave_sum(float v) {
#pragma unroll
    for (int o = 1; o < 64; o <<= 1) v += __shfl_xor(v, o);
    return v;
}
__device__ __forceinline__ float fmax2(float a, float b) { return __builtin_amdgcn_fmed3f(a, b, 3.0e38f); }
__device__ __forceinline__ float xsum32(float x) { const auto r = __builtin_amdgcn_permlane32_swap(__float_as_uint(x), __float_as_uint(x), false, false); return __uint_as_float(r[0]) + __uint_as_float(r[1]); }
__device__ __forceinline__ float xsum16(float x) { const auto r = __builtin_amdgcn_permlane16_swap(__float_as_uint(x), __float_as_uint(x), false, false); return __uint_as_float(r[0]) + __uint_as_float(r[1]); }
__device__ __forceinline__ float xmax32(float x) { const auto r = __builtin_amdgcn_permlane32_swap(__float_as_uint(x), __float_as_uint(x), false, false); return fmax2(__uint_as_float(r[0]), __uint_as_float(r[1])); }
__device__ __forceinline__ float xmax16(float x) { const auto r = __builtin_amdgcn_permlane16_swap(__float_as_uint(x), __float_as_uint(x), false, false); return fmax2(__uint_as_float(r[0]), __uint_as_float(r[1])); }
__device__ __forceinline__ float xpartner32(float x, int hh) { const auto r = __builtin_amdgcn_permlane32_swap(__float_as_uint(x), __float_as_uint(x), false, false); return __uint_as_float(hh ? r[0] : r[1]); }
__device__ __forceinline__ float fexp2(float x) { return __builtin_amdgcn_exp2f(x); }
__device__ __forceinline__ float sigmoidf(float x) { return __builtin_amdgcn_rcpf(1.0f + fexp2(-LOG2E * x)); }

struct Params {
    const float* in[18];
    float* out;
    unsigned char* ws;
    int ph_lo, ph_hi;
};
enum { I_X = 0, I_META, I_GMIX, I_WIN, I_WUK, I_WUV, I_WUPA, I_WUPB, I_WO, I_GFFN, I_WGRP, I_BGRP, I_WRT, I_BRT, I_W1, I_W3, I_W2, I_GFIN };

__device__ __forceinline__ const float* h0_row(const Params& p, int row) {
    const int b = row / T, t = row - b * T;
    return t < NMETA ? p.in[I_META] + (size_t)t * D : p.in[I_X] + ((size_t)b * SEQ + (t - NMETA)) * D;
}
template <class F>
__device__ __forceinline__ void tr_item(F val, bf16_t* dst, int ldd, int row0, int k0, float* scr, int lane, int rstep = 1) {
    float tv[32];
#pragma unroll
    for (int i = 0; i < 32; ++i) tv[i] = val(k0 + 2 * i + (lane >> 5), lane & 31);
#pragma unroll
    for (int i = 0; i < 32; ++i) scr[(2 * i + (lane >> 5)) * 33 + (lane & 31)] = tv[i];
    __builtin_amdgcn_s_waitcnt(0xC07F);
    asm volatile("" ::: "memory");
    const int c = lane & 7;
#pragma unroll
    for (int j = 0; j < 4; ++j) {
        const int n = (lane >> 3) + 8 * j; const float* s = scr + (8 * c) * 33 + n;
        u32x4 o; o.x = pk2(s[0], s[33]); o.y = pk2(s[66], s[99]); o.z = pk2(s[132], s[165]); o.w = pk2(s[198], s[231]);
        *(u32x4*)(dst + (size_t)(row0 + n * rstep) * ldd + k0 + 8 * c) = o;
    }
    __builtin_amdgcn_s_waitcnt(0xC07F);
    asm volatile("" ::: "memory");
}

__device__ __forceinline__ void wp_src(int c, int& kind, int& col, int& aux, float& scale) {
    kind = 1; aux = 0; scale = 1.f; col = 0;
    if (c < 512) { col = c; scale = QSCALE; }
    else if (c < C_QF) { col = c; }
    else if (c < C_KV) { const int r = c - C_QF, h = r / QFW, j = r % QFW; scale = QSCALE;
        if (j < 128) { kind = 2; col = h; aux = j; } else { const int i = j - 128; col = 1536 + 64 * h + (i >> 1) + 8 * (i & 1); } }
    else if (c < C_QI) { const int j = c - C_KV; if (j < 128) col = 2048 + j; else { const int i = j - 128; col = 2176 + (i >> 1) + 8 * (i & 1); } }
    else if (c < C_KI) { const int r = c - C_QI, h = r >> 6, j = r & 63; col = 2192 + 64 * h + (j < 16 ? (j >> 1) + 8 * (j & 1) : j); }
    else if (c < C_WI) { const int j = c - C_KI; col = 2704 + (j < 16 ? (j >> 1) + 8 * (j & 1) : j); }
    else if (c < C_END) { col = 2768 + (c - C_WI); }
    else kind = 0;
}

constexpr int IT_WP = (PWN / 32) * 16;
constexpr int IT_WG = 32 * 16;
constexpr int IT_WUA = 32 * 8;
constexpr int IT_WBP = 32 * 16, IT_WO = 32 * 16;
constexpr int IT_W13 = NEXP * 32 * 16;
constexpr int IT_W2 = NEXP * 32 * 8;
constexpr int IT_TOTAL = IT_WP + 2 * IT_WG + IT_WUA + IT_WBP + IT_WO + IT_W13 + IT_W2;

__device__ __forceinline__ void phase_prologue(const Params& p, char* lds) {
    const int tid = threadIdx.x, lane = tid & 63, wave = tid >> 6;
    const int gw = blockIdx.x * NWAVES + wave, NGW = gridDim.x * NWAVES;
    float* scr = (float*)lds + wave * (64 * 33);
    unsigned char* ws = p.ws;
    const float* w_in = p.in[I_WIN];
    {
        float2* cs = (float2*)(ws + WS_CS);
        for (int i = blockIdx.x * NTHREADS + tid; i < T * 8; i += gridDim.x * NTHREADS) {
            const int pos = i >> 3, f = i & 7;
            const float inv = powf(500000.0f, -(float)f / 8.0f);
            const float ang = (float)pos * inv;
            cs[i] = make_float2(cosf(ang), sinf(ang));
        }
    }
    {
        bf16_t* wrt = (bf16_t*)(ws + WS_WRT); const float* wgp = p.in[I_WGRP]; const float* wrp = p.in[I_WRT];
        for (int i = blockIdx.x * NTHREADS + tid; i < WRT_N * D; i += gridDim.x * NTHREADS) {
            const int nn = i >> 10, k = i & 1023;
            const float w = nn < 4 ? wgp[k * 4 + nn] : nn < 36 ? wrp[k * 32 + (nn - 4)] : 0.f;
            const unsigned hi = f2bf(w); wrt[i] = (bf16_t)hi; wrt[WRT_N * D + i] = (bf16_t)f2bf(w - __uint_as_float(hi << 16));
        }
    }
    for (int it = gw; it < IT_TOTAL; it += NGW) {
        int r = it;
        if (r < IT_WP) {
            const int rg = r / 16, kb = r % 16, c = rg * 32 + (lane & 31);
            int kind, col, aux; float scale; wp_src(c, kind, col, aux, scale);
            const float* w_uk = p.in[I_WUK];
            float wu[48];
#pragma unroll
            for (int n4 = 0; n4 < 12; ++n4) { f32x4 t = (f32x4){0.f, 0.f, 0.f, 0.f}; if (kind == 2) t = *(const f32x4*)(w_uk + ((size_t)col * 128 + aux) * 48 + 4 * n4); wu[4 * n4] = t.x; wu[4 * n4 + 1] = t.y; wu[4 * n4 + 2] = t.z; wu[4 * n4 + 3] = t.w; }
            tr_item([&](int k, int) -> float {
                if (kind == 0) return 0.f;
                if (kind == 1) return scale * w_in[(size_t)k * INW + col];
                const f32x4* wi = (const f32x4*)(w_in + (size_t)k * INW + 1536 + 64 * col + 16);
                float s = 0.f;
#pragma unroll
                for (int n4 = 0; n4 < 12; ++n4) { const f32x4 t = wi[n4]; s += t.x * wu[4 * n4] + t.y * wu[4 * n4 + 1] + t.z * wu[4 * n4 + 2] + t.w * wu[4 * n4 + 3]; }
                return scale * s; }, (bf16_t*)(ws + WS_WP), 1024, rg * 32, kb * 64, scr, lane);
            continue; }
        r -= IT_WP;
        if (r < 2 * IT_WG) {
            const int which = r / IT_WG; r %= IT_WG; const int rg = r / 16, kb = r % 16; const int col0 = (which ? 3800 : 2776) + rg * 32;
            tr_item([&](int k, int n) -> float { return w_in[(size_t)k * INW + col0 + n]; }, (bf16_t*)(ws + WS_WG) + (size_t)which * 1024 * 1024, 1024, rg * 32, kb * 64, scr, lane);
            continue; }
        r -= 2 * IT_WG;
        if (r < IT_WUA) {
            const int rg = r / 8, kb = r % 8; const float* w = p.in[I_WUPA];
            tr_item([&](int k, int n) -> float { return w[(size_t)k * 1024 + rg * 32 + n]; }, (bf16_t*)(ws + WS_WUA), 512, rg * 32, kb * 64, scr, lane);
            continue; }
        r -= IT_WUA;
        if (r < IT_WO) {
            const int rg = r / 16, kb = r % 16; const float* w = p.in[I_WO];
            tr_item([&](int k, int n) -> float { return w[(size_t)k * 1024 + rg * 32 + n]; }, (bf16_t*)(ws + WS_WO), 1024, rg * 32, kb * 64, scr, lane);
            continue; }
        r -= IT_WO;
        if (r < IT_WBP) {
            const int rg = r / 16, kb = r % 16; const float* wuv = p.in[I_WUV]; const float* wub = p.in[I_WUPB];
            const int hB = kb >> 1;
            float bc[64];
#pragma unroll
            for (int d = 0; d < 64; ++d) bc[d] = wub[(size_t)(64 * hB + d) * 1024 + rg * 32 + (lane & 31)];
            tr_item([&](int kk, int) -> float {
                const f32x4* a = (const f32x4*)(wuv + (size_t)kk * 64);
                float s = 0.f;
#pragma unroll
                for (int d4 = 0; d4 < 16; ++d4) { const f32x4 t = a[d4]; s += t.x * bc[4 * d4] + t.y * bc[4 * d4 + 1] + t.z * bc[4 * d4 + 2] + t.w * bc[4 * d4 + 3]; }
                return s; }, (bf16_t*)(ws + WS_WBP), 1024, rg * 32, kb * 64, scr, lane);
            continue; }
        r -= IT_WBP;
        if (r < IT_W13) {
            const int e = r / 512; r %= 512; const int which = r & 1, cg = (r >> 1) & 15, kb = r >> 5;
            const float* w = (which ? p.in[I_W3] : p.in[I_W1]) + (size_t)e * 1024 * 512 + cg * 32;
            tr_item([&](int k, int n) -> float { return w[(size_t)k * 512 + n]; },
                    (bf16_t*)(ws + WS_W13) + (size_t)e * 1024 * 1024, 1024, 2 * cg * 32 + which, kb * 64, scr, lane, 2);
            continue; }
        r -= IT_W13;
        {
            const int e = r / 256; r %= 256; const int rg = r / 8, kb = r % 8;
            const float* w2 = p.in[I_W2] + (size_t)e * 512 * 1024;
            tr_item([&](int k, int n) -> float { return w2[(size_t)k * 1024 + rg * 32 + n]; }, (bf16_t*)(ws + WS_W2) + (size_t)e * 1024 * 512, 512, rg * 32, kb * 64, scr, lane);
        }
    }
    {
        const float* g = p.in[I_GMIX]; bf16_t* U = (bf16_t*)(ws + WS_U);
        f32x4 vn[4];
        if (gw < NTOK) { const f32x4* xr = (const f32x4*)h0_row(p, gw) + lane;
#pragma unroll
            for (int j = 0; j < 4; ++j) vn[j] = xr[64 * j]; }
        for (int row = gw; row < NTOK; row += NGW) {
            f32x4 v[4]; float s = 0.f;
#pragma unroll
            for (int j = 0; j < 4; ++j) v[j] = vn[j];
            if (row + NGW < NTOK) { const f32x4* xr = (const f32x4*)h0_row(p, row + NGW) + lane;
#pragma unroll
                for (int j = 0; j < 4; ++j) vn[j] = xr[64 * j]; }
#pragma unroll
            for (int j = 0; j < 4; ++j) s += (v[j].x * v[j].x + v[j].y * v[j].y) + (v[j].z * v[j].z + v[j].w * v[j].w);
            const float rstd = rsqrtf(wave_sum(s) * (1.f / D) + NORM_EPS);
            u32x2* o = (u32x2*)(U + (size_t)row * D) + lane;
#pragma unroll
            for (int j = 0; j < 4; ++j) { const f32x4 gg = ((const f32x4*)g)[lane + 64 * j];
                u32x2 w; w.x = pk2(v[j].x * rstd * gg.x, v[j].y * rstd * gg.y); w.y = pk2(v[j].z * rstd * gg.z, v[j].w * rstd * gg.w); o[64 * j] = w; }
        }
    }
}

namespace pg8 {
#define PG8_LAS __attribute__((address_space(3)))
typedef unsigned short bf16_t;
typedef short bf16x8 __attribute__((ext_vector_type(8)));
typedef float f32x4 __attribute__((ext_vector_type(4)));
typedef unsigned u32x4 __attribute__((ext_vector_type(4)));
constexpr int BM = 256, BK = 64, HALF = 128, HTB = HALF * BK * 2  , STAGE_BYTES = 8 * HTB, NXCD = 8, WGM = 8;

__host__ __device__ __forceinline__ int lds_byte(int r, int c) { const int st = (r >> 4) * 2 + (c >> 5), rr = r & 15, cc = c & 31, ob = rr * 64 + cc * 2; return st * 1024 + (ob ^ (((ob >> 9) & 1) << 5)); }
__host__ __device__ __forceinline__ void stage_rc(int b, int& R, int& C) { const int st = b / 1024, sb = b % 1024, swz = sb ^ (((sb >> 9) & 1) << 5); R = (st >> 1) * 16 + swz / 64; C = (st & 1) * 32 + (swz % 64) / 2; }
__host__ __device__ __forceinline__ int perm32(int rho) { const int n = rho >> 4, i = rho & 15; return 8 * (i >> 2) + 4 * n + (i & 3); }

struct Unit { int pm, pn; };
struct Gemm { const bf16_t* A; const bf16_t* Bt; int M, N, K; };

struct StaticOrder {
    int nM, nN, nwg, G, c;
    __host__ __device__ void init(int M, int N, int G_, int c_) { nM = M / BM; nN = N / BM; nwg = nM * nN; G = G_; c = c_; }
    __host__ __device__ bool next(int i, Unit& u) const {
        const long L = (long)i * G + c; if (L >= nwg) return false;
        int wgid = (int)L; { const int q = nwg / NXCD, r = nwg % NXCD, xcd = wgid % NXCD, off = wgid / NXCD; wgid = (xcd < r ? xcd * (q + 1) : r * (q + 1) + (xcd - r) * q) + off; }
        const int nig = WGM * nN, gid = wgid / nig, fm = gid * WGM, gsz = (nM - fm) < WGM ? (nM - fm) : WGM;
        u.pm = fm + ((wgid % nig) % gsz); u.pn = (wgid % nig) / gsz; return true;
    }
    __device__ __forceinline__ void a_ready(const Unit&) const {}
    __device__ __forceinline__ void done(const Unit&) const {}
};


#define PG8_FOR_FRAGS(...) _Pragma("unroll") for (int ai = 0; ai < 2; ++ai) _Pragma("unroll") for (int m = 0; m < 4; ++m) { const int row = u.pm * BM + ai * HALF + wr * 64 + m * 16 + fr; \
    _Pragma("unroll") for (int bj = 0; bj < 2; ++bj) _Pragma("unroll") for (int n = 0; n < 2; ++n) { const int col = u.pn * BM + bj * HALF + wc * 32 + n * 16 + 4 * fq; ::f32x4 v = acc[ai][bj][m][n]; __VA_ARGS__ } }
__device__ __forceinline__ bool rope_off(int c, int& o) {
    if (c < C_QF) return false;
    if (c < C_KV) { const int j = (c - C_QF) % QFW; o = j - 128; return j >= 128; }
    if (c < C_QI) { const int j = c - C_KV; o = j - 128; return j >= 128; }
    if (c < C_KI) { const int j = (c - C_QI) & 63; o = j; return j < 16; }
    if (c < C_WI) { const int j = c - C_KI; o = j; return j < 16; }
    return false;
}
#define PG8_FOR_FRAGS8(...) _Pragma("unroll") for (int ai = 0; ai < 2; ++ai) _Pragma("unroll") for (int m = 0; m < 4; ++m) { const int row = u.pm * BM + ai * HALF + wr * 64 + m * 16 + fr; \
    _Pragma("unroll") for (int bj = 0; bj < 2; ++bj) { const int col = u.pn * BM + bj * HALF + wc * 32 + 8 * fq; ::f32x4 v0 = acc[ai][bj][m][0], v1 = acc[ai][bj][m][1]; __VA_ARGS__ } }
struct EpiInproj {
    static constexpr bool PERM = true, AFTER_DRAIN = false;
    bf16_t* P; const float2* cs; unsigned char* KIP;
    __device__ __forceinline__ void operator()(const f32x4 (&acc)[2][2][4][2], const Unit& u, int wr, int wc, int fr, int fq) const {
        PG8_FOR_FRAGS8(
            if (col < PW) {
                int o; const int trow = tokrow(row);
                if (rope_off(col, o)) {
                    const int pos = (row % SEQ) + NMETA; const float2* cp = cs + pos * 8 + (o >> 1); const float2 c0 = cp[0], c1 = cp[1], c2 = cp[2], c3 = cp[3];
                    v0 = (::f32x4){v0.x * c0.x - v0.y * c0.y, v0.y * c0.x + v0.x * c0.y, v0.z * c1.x - v0.w * c1.y, v0.w * c1.x + v0.z * c1.y};
                    v1 = (::f32x4){v1.x * c2.x - v1.y * c2.y, v1.y * c2.x + v1.x * c2.y, v1.z * c3.x - v1.w * c3.y, v1.w * c3.x + v1.z * c3.y};
                }
                ::u32x4 w; w.x = pk2(v0.x, v0.y); w.y = pk2(v0.z, v0.w); w.z = pk2(v1.x, v1.y); w.w = pk2(v1.z, v1.w);
                if (col >= C_KI && col < C_WI) {
                    const int b = row / SEQ, t = row - b * SEQ + NMETA, d0 = col - C_KI;
                    *(::u32x4*)(KIP + (size_t)b * KIP_BATCH + (size_t)((((t >> 5) * 4 + (d0 >> 4)) * 2 + ((d0 >> 3) & 1)) * 512 + (t & 31) * 16)) = w;
                } else *(::u32x4*)(P + (size_t)trow * PW + col) = w;
            })
    }
};
struct EpiGate {
    static constexpr bool PERM = true, AFTER_DRAIN = false;
    bf16_t* G;
    __device__ __forceinline__ void operator()(const f32x4 (&acc)[2][2][4][2], const Unit& u, int wr, int wc, int fr, int fq) const {
        PG8_FOR_FRAGS8( ::u32x4 w; w.x = pk2(sigmoidf(v0.x), sigmoidf(v0.y)); w.y = pk2(sigmoidf(v0.z), sigmoidf(v0.w)); w.z = pk2(sigmoidf(v1.x), sigmoidf(v1.y)); w.w = pk2(sigmoidf(v1.z), sigmoidf(v1.w));
            *(::u32x4*)(G + (size_t)row * 2048 + col) = w; )
    }
};
template <bool ACCUM> struct EpiZ {
    static constexpr bool PERM = true, AFTER_DRAIN = false;
    bf16_t* Z; const bf16_t* G; int goff;
    __device__ __forceinline__ void operator()(const f32x4 (&acc)[2][2][4][2], const Unit& u, int wr, int wc, int fr, int fq) const {
        PG8_FOR_FRAGS8(
            const ::u32x4 g = *(const ::u32x4*)(G + (size_t)row * 2048 + goff + col);
            ::f32x4 z0 = (::f32x4){bflo(g.x) * v0.x, bfhi(g.x) * v0.y, bflo(g.y) * v0.z, bfhi(g.y) * v0.w}, z1 = (::f32x4){bflo(g.z) * v1.x, bfhi(g.z) * v1.y, bflo(g.w) * v1.z, bfhi(g.w) * v1.w};
            ::u32x4* zp = (::u32x4*)(Z + (size_t)row * D + col);
            if (ACCUM) { const ::u32x4 o = *zp; z0.x += bflo(o.x); z0.y += bfhi(o.x); z0.z += bflo(o.y); z0.w += bfhi(o.y); z1.x += bflo(o.z); z1.y += bfhi(o.z); z1.z += bflo(o.w); z1.w += bfhi(o.w); }
            ::u32x4 w; w.x = pk2(z0.x, z0.y); w.y = pk2(z0.z, z0.w); w.z = pk2(z1.x, z1.y); w.w = pk2(z1.z, z1.w); *zp = w; )
    }
};
struct EpiH1 {
    static constexpr bool PERM = true, AFTER_DRAIN = false;
    float* H1; const float* meta; const float* x;
    __device__ __forceinline__ void operator()(const f32x4 (&acc)[2][2][4][2], const Unit& u, int wr, int wc, int fr, int fq) const {
        PG8_FOR_FRAGS8( const float* xp = x + (size_t)row * D + col; float* hp = H1 + (size_t)row * D + col; const ::f32x4 h0 = *(const ::f32x4*)xp, h1 = *(const ::f32x4*)(xp + 4);
            *(::f32x4*)hp = h0 + v0; *(::f32x4*)(hp + 4) = h1 + v1; )
    }
};
#undef PG8_FOR_FRAGS
#undef PG8_FOR_FRAGS8

template <class Epi, class Sched, bool ALIGN_EPI = false, bool SP2 = false>
__device__ __forceinline__ void gemm_phase(PG8_LAS unsigned char* lds, const Gemm g, const Sched& S, const Epi& E) {
    const int tid = threadIdx.x, wid = __builtin_amdgcn_readfirstlane(tid >> 6), lane = tid & 63, wr = wid >> 2, wc = wid & 3, fr = lane & 15, fq = lane >> 4;
    const int K = g.K, nt = K / BK;
    unsigned voffA[2], voffB[2];
#pragma unroll
    for (int i = 0; i < 2; ++i) { int R, C; stage_rc(tid * 16 + i * 8192, R, C); const int Rb = Epi::PERM ? ((R & ~31) + perm32(R & 31)) : R;
        voffA[i] = (unsigned)(R * K + C) * 2u; voffB[i] = (unsigned)(Rb * K + C) * 2u; }
    const size_t kstep = (size_t)(BK * 2);
    const size_t hstep = (size_t)HALF * K * 2;
    const size_t tstep = 2 * hstep;
    const unsigned ldsw = (unsigned)wid * 1024u;
    const int aoff = lds_byte(wr * 64 + fr, fq * 8), boff = lds_byte(wc * 32 + fr, fq * 8);
#define PG8_SA(b, h) (((b) * 2 + (h)) * HTB)
#define PG8_SB(b, h) ((4 + (b) * 2 + (h)) * HTB)
#define PG8_STAGE(bufoff, gbase, voff) do { _Pragma("unroll") for (int _i = 0; _i < 2; ++_i) \
        __builtin_amdgcn_global_load_lds((const unsigned*)((const char*)(gbase) + (voff)[_i]), (PG8_LAS unsigned*)(lds + (bufoff) + ldsw + _i * 8192), 16, 0, 0); } while (0)
#define PG8_LDA(dst, b, h) do { _Pragma("unroll") for (int m = 0; m < 4; ++m) _Pragma("unroll") for (int k = 0; k < 2; ++k) dst[m][k] = *(const PG8_LAS bf16x8*)(lds + PG8_SA(b, h) + aoff + m * 2048 + k * 1024); } while (0)
#define PG8_LDB(dst, b, h) do { _Pragma("unroll") for (int n = 0; n < 2; ++n) _Pragma("unroll") for (int k = 0; k < 2; ++k) dst[n][k] = *(const PG8_LAS bf16x8*)(lds + PG8_SB(b, h) + boff + n * 2048 + k * 1024); } while (0)
#define PG8_MMA(ai, bj, At, Bt) do { __builtin_amdgcn_s_setprio(1); _Pragma("unroll") for (int m = 0; m < 4; ++m) _Pragma("unroll") for (int n = 0; n < 2; ++n) _Pragma("unroll") for (int k = 0; k < 2; ++k) \
        acc[ai][bj][m][n] = __builtin_amdgcn_mfma_f32_16x16x32_bf16(Bt[n][k], At[m][k], acc[ai][bj][m][n], 0, 0, 0); __builtin_amdgcn_s_setprio(0); } while (0)
#define PG8_WAIT_V(n) asm volatile("s_waitcnt vmcnt(" #n ")" ::: "memory")
#define PG8_WAIT_L(n) asm volatile("s_waitcnt lgkmcnt(" #n ")" ::: "memory")
#define PG8_BAR __builtin_amdgcn_s_barrier()
#define PG8_SCHED __builtin_amdgcn_sched_barrier(0)
    Unit cur, nxt; int ui = 0;
    if (!S.next(0, cur)) return;
    f32x4 acc[2][2][4][2];
#pragma unroll
    for (int a = 0; a < 2; ++a)
#pragma unroll
        for (int b = 0; b < 2; ++b)
#pragma unroll
            for (int m = 0; m < 4; ++m)
#pragma unroll
                for (int n = 0; n < 2; ++n) acc[a][b][m][n] = (f32x4){0.f, 0.f, 0.f, 0.f};
    bf16x8 At[4][2], B0[2][2], B1[2][2];
    const char* cA = (const char*)g.A + (size_t)cur.pm * tstep; const char* cB = (const char*)g.Bt + (size_t)cur.pn * tstep;
    S.a_ready(cur);
    if constexpr (SP2) {
        PG8_STAGE(PG8_SB(0, 0), cB, voffB); PG8_STAGE(PG8_SB(0, 1), cB + hstep, voffB); PG8_STAGE(PG8_SA(0, 0), cA, voffA); PG8_STAGE(PG8_SA(0, 1), cA + hstep, voffA);
        if (wr == 1) PG8_BAR;
        PG8_WAIT_V(2); PG8_BAR;
        PG8_STAGE(PG8_SB(1, 0), cB + kstep, voffB); PG8_STAGE(PG8_SA(1, 0), cA + kstep, voffA); PG8_STAGE(PG8_SB(1, 1), cB + hstep + kstep, voffB);
        PG8_WAIT_V(6); PG8_BAR;
    } else {
        PG8_STAGE(PG8_SB(0, 0), cB, voffB); PG8_STAGE(PG8_SA(0, 0), cA, voffA); PG8_STAGE(PG8_SB(0, 1), cB + hstep, voffB); PG8_STAGE(PG8_SA(0, 1), cA + hstep, voffA);
        if (wr == 1) PG8_BAR;
        PG8_WAIT_V(4); PG8_BAR;
        PG8_STAGE(PG8_SB(1, 0), cB + kstep, voffB); PG8_STAGE(PG8_SA(1, 0), cA + kstep, voffA); PG8_STAGE(PG8_SB(1, 1), cB + hstep + kstep, voffB);
        PG8_WAIT_V(6); PG8_BAR;
    }
    for (;;) {
        const bool has_next = S.next(ui + 1, nxt);
        const char* nA = has_next ? (const char*)g.A + (size_t)nxt.pm * tstep : cA; const char* nB = has_next ? (const char*)g.Bt + (size_t)nxt.pn * tstep : cB;
        for (int t = 0; t < nt; t += 2) {
            const bool last = (t == nt - 2);
            const char* a1 = cA + (size_t)(t + 1) * kstep;
            const char* a2 = last ? nA : cA + (size_t)(t + 2) * kstep; const char* b2 = last ? nB : cB + (size_t)(t + 2) * kstep;
            const char* a3 = a2 + kstep; const char* b3 = b2 + kstep;
            if (last && has_next) S.a_ready(nxt);
            if constexpr (SP2) {
            PG8_LDB(B0, 0, 0); PG8_LDB(B1, 0, 1); PG8_SCHED; PG8_LDA(At, 0, 0); PG8_STAGE(PG8_SA(1, 1), a1 + hstep, voffA);
            PG8_WAIT_V(8); PG8_WAIT_L(0); PG8_BAR; PG8_MMA(0, 0, At, B0); PG8_MMA(0, 1, At, B1); PG8_BAR; PG8_SCHED;
            PG8_LDA(At, 0, 1); PG8_STAGE(PG8_SB(0, 0), b2, voffB); PG8_STAGE(PG8_SB(0, 1), b2 + hstep, voffB); PG8_STAGE(PG8_SA(0, 0), a2, voffA);
            PG8_WAIT_V(8); PG8_WAIT_L(0); PG8_BAR; PG8_MMA(1, 0, At, B0); PG8_MMA(1, 1, At, B1); PG8_BAR; PG8_SCHED;
            PG8_LDB(B0, 1, 0); PG8_LDB(B1, 1, 1); PG8_SCHED; PG8_LDA(At, 1, 0); PG8_STAGE(PG8_SA(0, 1), a2 + hstep, voffA);
            PG8_WAIT_V(8); PG8_WAIT_L(0); PG8_BAR; PG8_MMA(0, 0, At, B0); PG8_MMA(0, 1, At, B1); PG8_BAR; PG8_SCHED;
            PG8_LDA(At, 1, 1); PG8_STAGE(PG8_SB(1, 0), b3, voffB); PG8_STAGE(PG8_SB(1, 1), b3 + hstep, voffB); PG8_STAGE(PG8_SA(1, 0), a3, voffA);
            PG8_WAIT_V(8); PG8_WAIT_L(0); PG8_BAR; PG8_MMA(1, 0, At, B0); PG8_MMA(1, 1, At, B1); PG8_BAR; PG8_SCHED;
            } else {
            PG8_LDB(B0, 0, 0); PG8_SCHED; PG8_LDA(At, 0, 0); PG8_STAGE(PG8_SA(1, 1), a1 + hstep, voffA);
            PG8_WAIT_L(8); PG8_BAR; PG8_WAIT_L(0); PG8_MMA(0, 0, At, B0); PG8_BAR; PG8_SCHED;
            PG8_LDB(B1, 0, 1); PG8_STAGE(PG8_SB(0, 0), b2, voffB);
            PG8_BAR; PG8_WAIT_L(0); PG8_MMA(0, 1, At, B1); PG8_BAR;
            PG8_LDA(At, 0, 1); PG8_STAGE(PG8_SA(0, 0), a2, voffA);
            PG8_BAR; PG8_WAIT_L(0); PG8_MMA(1, 0, At, B0); PG8_BAR; PG8_SCHED;
            PG8_STAGE(PG8_SB(0, 1), b2 + hstep, voffB);
            PG8_WAIT_V(6); PG8_BAR; PG8_MMA(1, 1, At, B1); PG8_BAR;
            PG8_LDB(B0, 1, 0); PG8_SCHED; PG8_LDA(At, 1, 0); PG8_STAGE(PG8_SA(0, 1), a2 + hstep, voffA);
            PG8_WAIT_L(8); PG8_BAR; PG8_WAIT_L(0); PG8_MMA(0, 0, At, B0); PG8_BAR; PG8_SCHED;
            PG8_LDB(B1, 1, 1); PG8_STAGE(PG8_SB(1, 0), b3, voffB);
            PG8_BAR; PG8_WAIT_L(0); PG8_MMA(0, 1, At, B1); PG8_BAR;
            PG8_LDA(At, 1, 1); PG8_STAGE(PG8_SA(1, 0), a3, voffA);
            PG8_BAR; PG8_WAIT_L(0); PG8_MMA(1, 0, At, B0); PG8_BAR; PG8_SCHED;
            PG8_STAGE(PG8_SB(1, 1), b3 + hstep, voffB);
            PG8_WAIT_V(6); PG8_BAR; PG8_MMA(1, 1, At, B1); PG8_BAR;
            }
        }
        if constexpr (ALIGN_EPI) { if (wr == 0) PG8_BAR; }
        if constexpr (!Epi::AFTER_DRAIN) { E(acc, cur, wr, wc, fr, fq); S.done(cur); }
        if (!has_next) break;
#pragma unroll
        for (int a = 0; a < 2; ++a)
#pragma unroll
            for (int b = 0; b < 2; ++b)
#pragma unroll
                for (int m = 0; m < 4; ++m)
#pragma unroll
                    for (int n = 0; n < 2; ++n) acc[a][b][m][n] = (f32x4){0.f, 0.f, 0.f, 0.f};
        cur = nxt; cA = nA; cB = nB; ++ui;
        if constexpr (ALIGN_EPI) { if (wr == 1) PG8_BAR; }
    }
    PG8_WAIT_V(0);
    if constexpr (!ALIGN_EPI) { if (wr == 0) PG8_BAR; }
    PG8_BAR;
    if constexpr (Epi::AFTER_DRAIN) { E.fused(acc, cur, wr, wc, fr, fq, lds, wid, lane); S.done(cur); }
#undef PG8_SA
#undef PG8_SB
#undef PG8_STAGE
#undef PG8_LDA
#undef PG8_LDB
#undef PG8_MMA
#undef PG8_WAIT_V
#undef PG8_WAIT_L
#undef PG8_BAR
#undef PG8_SCHED
}
template <class Epi, class Sched, bool ALIGN_EPI = false, bool SP2 = false>
__device__ __forceinline__ void gemm_phase_x(PG8_LAS unsigned char* lds, const int K, const Sched& S, const Epi& E) {
    const int tid = threadIdx.x, wid = __builtin_amdgcn_readfirstlane(tid >> 6), lane = tid & 63, wr = wid >> 2, wc = wid & 3, fr = lane & 15, fq = lane >> 4;
    const int nt = K / BK;
    unsigned vcA[2][2], vnA[2][2], voffB[2];
#pragma unroll
    for (int i = 0; i < 2; ++i) { int R, C; stage_rc(tid * 16 + i * 8192, R, C); const int Rb = Epi::PERM ? ((R & ~31) + perm32(R & 31)) : R;
        voffB[i] = (unsigned)(Rb * K + C) * 2u; }
    const size_t kstep = (size_t)(BK * 2);
    const size_t hstep = (size_t)HALF * K * 2;
    const unsigned ldsw = (unsigned)wid * 1024u;
    const int aoff = lds_byte(wr * 64 + fr, fq * 8), boff = lds_byte(wc * 32 + fr, fq * 8);
#define PG8_SA(b, h) (((b) * 2 + (h)) * HTB)
#define PG8_SB(b, h) ((4 + (b) * 2 + (h)) * HTB)
#define PG8_STAGE(bufoff, gbase, voff) do { _Pragma("unroll") for (int _i = 0; _i < 2; ++_i) \
        __builtin_amdgcn_global_load_lds((const unsigned*)((const char*)(gbase) + (voff)[_i]), (PG8_LAS unsigned*)(lds + (bufoff) + ldsw + _i * 8192), 16, 0, 0); } while (0)
#define PG8_STAGEA(bufoff, gbase, V, h) do { _Pragma("unroll") for (int _i = 0; _i < 2; ++_i) \
        __builtin_amdgcn_global_load_lds((const unsigned*)((const char*)(gbase) + (V)[h][_i]), (PG8_LAS unsigned*)(lds + (bufoff) + ldsw + _i * 8192), 16, 0, 0); } while (0)
#define PG8_STAGEA2(bufoff, gbase, h) do { _Pragma("unroll") for (int _i = 0; _i < 2; ++_i) \
        __builtin_amdgcn_global_load_lds((const unsigned*)((const char*)(gbase) + (last ? vnA[h][_i] : vcA[h][_i])), (PG8_LAS unsigned*)(lds + (bufoff) + ldsw + _i * 8192), 16, 0, 0); } while (0)
#define PG8_AOFF(V, u) do { _Pragma("unroll") for (int _h = 0; _h < 2; ++_h) _Pragma("unroll") for (int _i = 0; _i < 2; ++_i) { int R_, C_; stage_rc(tid * 16 + _i * 8192, R_, C_); (V)[_h][_i] = S.a_off(u, _h * HALF + R_, C_); } } while (0)
#define PG8_LDA(dst, b, h) do { _Pragma("unroll") for (int m = 0; m < 4; ++m) _Pragma("unroll") for (int k = 0; k < 2; ++k) dst[m][k] = *(const PG8_LAS bf16x8*)(lds + PG8_SA(b, h) + aoff + m * 2048 + k * 1024); } while (0)
#define PG8_LDB(dst, b, h) do { _Pragma("unroll") for (int n = 0; n < 2; ++n) _Pragma("unroll") for (int k = 0; k < 2; ++k) dst[n][k] = *(const PG8_LAS bf16x8*)(lds + PG8_SB(b, h) + boff + n * 2048 + k * 1024); } while (0)
#define PG8_MMA(ai, bj, At, Bt) do { __builtin_amdgcn_s_setprio(1); _Pragma("unroll") for (int m = 0; m < 4; ++m) _Pragma("unroll") for (int n = 0; n < 2; ++n) _Pragma("unroll") for (int k = 0; k < 2; ++k) \
        acc[ai][bj][m][n] = __builtin_amdgcn_mfma_f32_16x16x32_bf16(Bt[n][k], At[m][k], acc[ai][bj][m][n], 0, 0, 0); __builtin_amdgcn_s_setprio(0); } while (0)
#define PG8_WAIT_V(n) asm volatile("s_waitcnt vmcnt(" #n ")" ::: "memory")
#define PG8_WAIT_L(n) asm volatile("s_waitcnt lgkmcnt(" #n ")" ::: "memory")
#define PG8_BAR __builtin_amdgcn_s_barrier()
#define PG8_SCHED __builtin_amdgcn_sched_barrier(0)
    Unit cur, nxt; int ui = 0;
    if (!S.next(0, cur)) return;
    f32x4 acc[2][2][4][2];
#pragma unroll
    for (int a = 0; a < 2; ++a)
#pragma unroll
        for (int b = 0; b < 2; ++b)
#pragma unroll
            for (int m = 0; m < 4; ++m)
#pragma unroll
                for (int n = 0; n < 2; ++n) acc[a][b][m][n] = (f32x4){0.f, 0.f, 0.f, 0.f};
    bf16x8 At[4][2], B0[2][2], B1[2][2];
    const char* cA = S.a_base(cur); const char* cB = S.b_base(cur);
    PG8_AOFF(vcA, cur);
    S.a_ready(cur);
    if constexpr (SP2) {
        PG8_STAGE(PG8_SB(0, 0), cB, voffB); PG8_STAGE(PG8_SB(0, 1), cB + hstep, voffB); PG8_STAGEA(PG8_SA(0, 0), cA, vcA, 0); PG8_STAGEA(PG8_SA(0, 1), cA, vcA, 1);
        if (wr == 1) PG8_BAR;
        PG8_WAIT_V(2); PG8_BAR;
        PG8_STAGE(PG8_SB(1, 0), cB + kstep, voffB); PG8_STAGEA(PG8_SA(1, 0), cA + kstep, vcA, 0); PG8_STAGE(PG8_SB(1, 1), cB + hstep + kstep, voffB);
        PG8_WAIT_V(6); PG8_BAR;
    } else {
        PG8_STAGE(PG8_SB(0, 0), cB, voffB); PG8_STAGEA(PG8_SA(0, 0), cA, vcA, 0); PG8_STAGE(PG8_SB(0, 1), cB + hstep, voffB); PG8_STAGEA(PG8_SA(0, 1), cA, vcA, 1);
        if (wr == 1) PG8_BAR;
        PG8_WAIT_V(4); PG8_BAR;
        PG8_STAGE(PG8_SB(1, 0), cB + kstep, voffB); PG8_STAGEA(PG8_SA(1, 0), cA + kstep, vcA, 0); PG8_STAGE(PG8_SB(1, 1), cB + hstep + kstep, voffB);
        PG8_WAIT_V(6); PG8_BAR;
    }
    for (;;) {
        const bool has_next = S.next(ui + 1, nxt);
        const char* nA = has_next ? S.a_base(nxt) : cA; const char* nB = has_next ? S.b_base(nxt) : cB;
        if (has_next) { PG8_AOFF(vnA, nxt); } else { _Pragma("unroll") for (int _h = 0; _h < 2; ++_h) _Pragma("unroll") for (int _i = 0; _i < 2; ++_i) vnA[_h][_i] = vcA[_h][_i]; }
        for (int t = 0; t < nt; t += 2) {
            const bool last = (t == nt - 2);
            const char* a1 = cA + (size_t)(t + 1) * kstep;
            const char* a2 = last ? nA : cA + (size_t)(t + 2) * kstep; const char* b2 = last ? nB : cB + (size_t)(t + 2) * kstep;
            const char* a3 = a2 + kstep; const char* b3 = b2 + kstep;
            if (last && has_next) S.a_ready(nxt);
            if constexpr (SP2) {
            PG8_LDB(B0, 0, 0); PG8_LDB(B1, 0, 1); PG8_SCHED; PG8_LDA(At, 0, 0); PG8_STAGEA(PG8_SA(1, 1), a1, vcA, 1);
            PG8_WAIT_V(8); PG8_WAIT_L(0); PG8_BAR; PG8_MMA(0, 0, At, B0); PG8_MMA(0, 1, At, B1); PG8_BAR; PG8_SCHED;
            PG8_LDA(At, 0, 1); PG8_STAGE(PG8_SB(0, 0), b2, voffB); PG8_STAGE(PG8_SB(0, 1), b2 + hstep, voffB); PG8_STAGEA2(PG8_SA(0, 0), a2, 0);
            PG8_WAIT_V(8); PG8_WAIT_L(0); PG8_BAR; PG8_MMA(1, 0, At, B0); PG8_MMA(1, 1, At, B1); PG8_BAR; PG8_SCHED;
            PG8_LDB(B0, 1, 0); PG8_LDB(B1, 1, 1); PG8_SCHED; PG8_LDA(At, 1, 0); PG8_STAGEA2(PG8_SA(0, 1), a2, 1);
            PG8_WAIT_V(8); PG8_WAIT_L(0); PG8_BAR; PG8_MMA(0, 0, At, B0); PG8_MMA(0, 1, At, B1); PG8_BAR; PG8_SCHED;
            PG8_LDA(At, 1, 1); PG8_STAGE(PG8_SB(1, 0), b3, voffB); PG8_STAGE(PG8_SB(1, 1), b3 + hstep, voffB); PG8_STAGEA2(PG8_SA(1, 0), a3, 0);
            PG8_WAIT_V(8); PG8_WAIT_L(0); PG8_BAR; PG8_MMA(1, 0, At, B0); PG8_MMA(1, 1, At, B1); PG8_BAR; PG8_SCHED;
            } else {
            PG8_LDB(B0, 0, 0); PG8_SCHED; PG8_LDA(At, 0, 0); PG8_STAGEA(PG8_SA(1, 1), a1, vcA, 1);
            PG8_WAIT_L(8); PG8_BAR; PG8_WAIT_L(0); PG8_MMA(0, 0, At, B0); PG8_BAR; PG8_SCHED;
            PG8_LDB(B1, 0, 1); PG8_STAGE(PG8_SB(0, 0), b2, voffB);
            PG8_BAR; PG8_WAIT_L(0); PG8_MMA(0, 1, At, B1); PG8_BAR;
            PG8_LDA(At, 0, 1); PG8_STAGEA2(PG8_SA(0, 0), a2, 0);
            PG8_BAR; PG8_WAIT_L(0); PG8_MMA(1, 0, At, B0); PG8_BAR; PG8_SCHED;
            PG8_STAGE(PG8_SB(0, 1), b2 + hstep, voffB);
            PG8_WAIT_V(6); PG8_BAR; PG8_MMA(1, 1, At, B1); PG8_BAR;
            PG8_LDB(B0, 1, 0); PG8_SCHED; PG8_LDA(At, 1, 0); PG8_STAGEA2(PG8_SA(0, 1), a2, 1);
            PG8_WAIT_L(8); PG8_BAR; PG8_WAIT_L(0); PG8_MMA(0, 0, At, B0); PG8_BAR; PG8_SCHED;
            PG8_LDB(B1, 1, 1); PG8_STAGE(PG8_SB(1, 0), b3, voffB);
            PG8_BAR; PG8_WAIT_L(0); PG8_MMA(0, 1, At, B1); PG8_BAR;
            PG8_LDA(At, 1, 1); PG8_STAGEA2(PG8_SA(1, 0), a3, 0);
            PG8_BAR; PG8_WAIT_L(0); PG8_MMA(1, 0, At, B0); PG8_BAR; PG8_SCHED;
            PG8_STAGE(PG8_SB(1, 1), b3 + hstep, voffB);
            PG8_WAIT_V(6); PG8_BAR; PG8_MMA(1, 1, At, B1); PG8_BAR;
            }
        }
        if constexpr (ALIGN_EPI) { if (wr == 0) PG8_BAR; }
        if constexpr (!Epi::AFTER_DRAIN) { E(acc, cur, wr, wc, fr, fq); S.done(cur); }
        if (!has_next) break;
#pragma unroll
        for (int a = 0; a < 2; ++a)
#pragma unroll
            for (int b = 0; b < 2; ++b)
#pragma unroll
                for (int m = 0; m < 4; ++m)
#pragma unroll
                    for (int n = 0; n < 2; ++n) acc[a][b][m][n] = (f32x4){0.f, 0.f, 0.f, 0.f};
        cur = nxt; cA = nA; cB = nB; ++ui;
        _Pragma("unroll") for (int _h = 0; _h < 2; ++_h) _Pragma("unroll") for (int _i = 0; _i < 2; ++_i) vcA[_h][_i] = vnA[_h][_i];
        if constexpr (ALIGN_EPI) { if (wr == 1) PG8_BAR; }
    }
    PG8_WAIT_V(0);
    if constexpr (!ALIGN_EPI) { if (wr == 0) PG8_BAR; }
    PG8_BAR;
    if constexpr (Epi::AFTER_DRAIN) { E.fused(acc, cur, wr, wc, fr, fq, lds, wid, lane); S.done(cur); }
#undef PG8_SA
#undef PG8_SB
#undef PG8_STAGE
#undef PG8_STAGEA
#undef PG8_STAGEA2
#undef PG8_AOFF
#undef PG8_LDA
#undef PG8_LDB
#undef PG8_MMA
#undef PG8_WAIT_V
#undef PG8_WAIT_L
#undef PG8_BAR
#undef PG8_SCHED
}


template <int WHICH> struct MoeOrder {
    const int* TP; int G, c; const char* Abase; const char* Bbase; const int* LIST;
    static constexpr int KK = WHICH == 0 ? 1024 : 512, NN = 4;
    __device__ __forceinline__ bool next(int i, Unit& u) const {
        const int L = i * G + c; if (L >= TP[NEXP]) return false;
        int e = 0;
#pragma unroll 1
        for (int j = 16; j >= 1; j >>= 1) if (TP[e + j] <= L) e += j;
        const int lt = L - TP[e]; u.pm = e * 1024 + lt / NN; u.pn = lt % NN; return true;
    }
    __device__ __forceinline__ const char* a_base(const Unit& u) const { const int e = u.pm >> 10, mt = u.pm & 1023; return WHICH == 0 ? Abase : Abase + (size_t)(TP[64 + e] + mt * 256) * (DEXP * 2); }
    __device__ __forceinline__ const char* b_base(const Unit& u) const { const int e = u.pm >> 10; return Bbase + ((size_t)e * 1024 + (size_t)u.pn * 256) * (KK * 2); }
    __device__ __forceinline__ unsigned a_off(const Unit& u, int r, int C) const {
        if (WHICH == 1) return (unsigned)(r * DEXP + C) * 2u;
        const int e = u.pm >> 10, s = (u.pm & 1023) * 256 + r; const int tok = s < TP[128 + e] ? (LIST[(size_t)e * NR + s] >> 1) : 0;
        return (unsigned)tok * (D * 2) + (unsigned)C * 2u;
    }
    __device__ __forceinline__ void a_ready(const Unit&) const {}
    __device__ __forceinline__ void done(const Unit&) const {}
};
struct TokRowOrder : StaticOrder {
    const char* Abase; const char* Bbase; int K;
    __device__ __forceinline__ const char* a_base(const Unit& u) const { return Abase + (size_t)tokrow(u.pm * BM) * K * 2; }
    __device__ __forceinline__ const char* b_base(const Unit& u) const { return Bbase + (size_t)u.pn * BM * K * 2; }
    __device__ __forceinline__ unsigned a_off(const Unit&, int r, int C) const { return (unsigned)(r * K + C) * 2u; }
};
#define PG8_FOR_FRAGS_M(...) _Pragma("unroll") for (int ai = 0; ai < 2; ++ai) _Pragma("unroll") for (int m = 0; m < 4; ++m) { const int r = ai * HALF + wr * 64 + m * 16 + fr; \
    _Pragma("unroll") for (int bj = 0; bj < 2; ++bj) _Pragma("unroll") for (int n = 0; n < 2; ++n) { const int col = u.pn * BM + bj * HALF + wc * 32 + n * 16 + 4 * fq; ::f32x4 v = acc[ai][bj][m][n]; __VA_ARGS__ } }
struct EpiMoe1 {
    static constexpr bool PERM = true, AFTER_DRAIN = false;
    bf16_t* HID; const int* TP; const int* LIST; const float* RS;
    __device__ __forceinline__ void operator()(const f32x4 (&acc)[2][2][4][2], const Unit& u, int wr, int wc, int fr, int fq) const {
        const int e = u.pm >> 10, mt = u.pm & 1023, cnt = TP[128 + e]; bf16_t* base = HID + (size_t)(TP[64 + e] + mt * 256) * DEXP;
#pragma unroll
        for (int ai = 0; ai < 2; ++ai)
#pragma unroll
            for (int m = 0; m < 4; ++m) { const int r = ai * HALF + wr * 64 + m * 16 + fr; const int s = mt * 256 + r;
                const float rs = RS[s < cnt ? (LIST[(size_t)e * NR + s] >> 1) : 0];
#pragma unroll
                for (int bj = 0; bj < 2; ++bj) { const int col = u.pn * BM + bj * HALF + wc * 32 + 8 * fq; const ::f32x4 v0 = acc[ai][bj][m][0] * rs, v1 = acc[ai][bj][m][1] * rs;
                    const float h0 = v0.x * sigmoidf(v0.x) * v0.y, h1 = v0.z * sigmoidf(v0.z) * v0.w, h2 = v1.x * sigmoidf(v1.x) * v1.y, h3 = v1.z * sigmoidf(v1.z) * v1.w;
                    ::u32x2 w; w.x = pk2(h0, h1); w.y = pk2(h2, h3); *(::u32x2*)(base + (size_t)r * DEXP + (col >> 1)) = w; } }
    }
};
struct EpiMoe2 {
    static constexpr bool PERM = true, AFTER_DRAIN = false;
    bf16_t* MO; const int* TP; const int* LIST; const float* GATE;
    __device__ __forceinline__ void operator()(const f32x4 (&acc)[2][2][4][2], const Unit& u, int wr, int wc, int fr, int fq) const {
        const int e = u.pm >> 10, mt = u.pm & 1023, cnt = TP[128 + e];
#pragma unroll
        for (int ai = 0; ai < 2; ++ai)
#pragma unroll
            for (int m = 0; m < 4; ++m) {
                const int s = mt * 256 + ai * HALF + wr * 64 + m * 16 + fr;
                if (s < cnt) {
                    const int ent = LIST[(size_t)e * NR + s]; const float gt = GATE[ent]; bf16_t* row = MO + (size_t)ent * D;
#pragma unroll
                    for (int bj = 0; bj < 2; ++bj) { const int col = u.pn * BM + bj * HALF + wc * 32 + 8 * fq; const ::f32x4 v0 = acc[ai][bj][m][0], v1 = acc[ai][bj][m][1];
                        ::u32x4 w; w.x = pk2(v0.x * gt, v0.y * gt); w.y = pk2(v0.z * gt, v0.w * gt); w.z = pk2(v1.x * gt, v1.y * gt); w.w = pk2(v1.z * gt, v1.w * gt); *(::u32x4*)(row + col) = w; }
                }
            }
    }
};
#undef PG8_FOR_FRAGS_M
}
template <bool B> struct BoolT { static constexpr bool value = B; };
constexpr int SB_NQT = SEQ / 32;
constexpr int SB_VROW = 192;
__device__ __forceinline__ void phase_sb_fast(const Params& p, char* lds) {
    const bf16_t* P = (const bf16_t*)(p.ws + WS_P); bf16_t* YA = (bf16_t*)(p.ws + WS_YA);
    const int tid = threadIdx.x, lane = tid & 63, wave = tid >> 6, n = lane & 31, hh = lane >> 5;
    char* VB = lds + wave * (32 * SB_VROW);
    const unsigned vtr = (unsigned)(size_t)lds + (unsigned)(wave * (32 * SB_VROW) + (4 * hh + ((lane & 15) >> 2)) * SB_VROW + (16 * ((lane >> 4) & 1) + 4 * (lane & 3)) * 2);
    const int gw = blockIdx.x * NWAVES + wave, NGW = gridDim.x * NWAVES;
    for (int unit = gw; unit < 64 * SB_NQT; unit += NGW) {
        const int qt = SB_NQT - 1 - unit / 64, bh = unit % 64, h = bh & 7, b = bh >> 3;
        const int i0 = NMETA + qt * 32, qi = i0 + n, qrow = qi;
        const bf16_t* Pb = P + (size_t)b * T * PW;
        bf16x8 qf[4];
#pragma unroll
        for (int s = 0; s < 4; ++s) qf[s] = *(const bf16x8*)(Pb + (size_t)qrow * PW + C_QA + h * 64 + 16 * s + 8 * hh);
        f32x16 o0, o1;
#pragma unroll
        for (int r = 0; r < 16; ++r) { o0[r] = 0.f; o1[r] = 0.f; }
        float EL = 1.f;
        auto tile = [&](const int kt, auto MT) {
            constexpr bool MASKED = decltype(MT)::value;
            const int j0 = kt * 32, krow = (!MASKED || (j0 + n) < T) ? (j0 + n) : T - 1;
            bf16x8 kf[4];
#pragma unroll
            for (int s = 0; s < 4; ++s) kf[s] = *(const bf16x8*)(Pb + (size_t)krow * PW + C_KA + h * 64 + 16 * s + 8 * hh);
#pragma unroll
            for (int i = 0; i < 4; ++i) {
                const int c = lane + 64 * i, key = c >> 3, d0 = (c & 7) * 8, vrow = (!MASKED || (j0 + key) < T) ? (j0 + key) : T - 1;
                const u32x4 w = *(const u32x4*)(Pb + (size_t)vrow * PW + C_VA + h * 64 + d0);
                *(u32x4*)(VB + key * SB_VROW + d0 * 2) = w;
            }
            f32x16 sa;
#pragma unroll
            for (int r = 0; r < 16; ++r) sa[r] = 0.f;
#pragma unroll
            for (int s = 0; s < 4; ++s) sa = __builtin_amdgcn_mfma_f32_32x32x16_bf16(kf[s], qf[s], sa, 0, 0, 0);
            float kp[16], sg[16];
#pragma unroll
            for (int r = 0; r < 16; ++r) {
                const float e = fexp2(__builtin_amdgcn_fmed3f(sa[r], -3.0e38f, 80.f)), k = __builtin_amdgcn_rcpf(1.f + e), s = e * k;
                if (MASKED) { const int kk = (r & 3) + 8 * (r >> 2) + 4 * hh; const bool valid = (j0 + kk) < qi; kp[r] = valid ? k : 1.f; sg[r] = valid ? s : 0.f; }
                else { kp[r] = k; sg[r] = s; }
            }
            const float gp0 = (kp[0] * kp[1]) * (kp[2] * kp[3]), gp1 = (kp[4] * kp[5]) * (kp[6] * kp[7]), gp2 = (kp[8] * kp[9]) * (kp[10] * kp[11]), gp3 = (kp[12] * kp[13]) * (kp[14] * kp[15]);
            const float pp0 = xpartner32(gp0, hh), pp1 = xpartner32(gp1, hh), pp2 = xpartner32(gp2, hh), pp3 = xpartner32(gp3, hh);
            const float pc3 = pp3, pc2 = pc3 * pp2, pc1 = pc2 * pp1, pc0 = pc1 * pp0;
            float base[4];
            base[3] = EL * (hh ? 1.f : pc3);
            base[2] = EL * gp3 * (hh ? pc3 : pc2);
            base[1] = EL * (gp3 * gp2) * (hh ? pc2 : pc1);
            base[0] = EL * (gp3 * gp2 * gp1) * (hh ? pc1 : pc0);
            float a[16];
#pragma unroll
            for (int g = 0; g < 4; ++g) {
                float c = base[g];
#pragma unroll
                for (int e = 3; e >= 0; --e) { const int r = 4 * g + e; a[r] = sg[r] * c; c *= kp[r]; }
            }
            EL *= ((gp0 * gp1) * (gp2 * gp3)) * pc0;
            u32x4 pw0, pw1;
            pw0.x = pk2(a[0], a[1]); pw0.y = pk2(a[2], a[3]); pw0.z = pk2(a[4], a[5]); pw0.w = pk2(a[6], a[7]);
            pw1.x = pk2(a[8], a[9]); pw1.y = pk2(a[10], a[11]); pw1.z = pk2(a[12], a[13]); pw1.w = pk2(a[14], a[15]);
            const bf16x8 pf0 = __builtin_bit_cast(bf16x8, pw0), pf1 = __builtin_bit_cast(bf16x8, pw1);
            {
                u16x4 x0, x1, x2, x3, y0, y1, y2, y3;
                asm volatile("s_waitcnt lgkmcnt(0)\n\tds_read_b64_tr_b16 %0, %8 offset:%9\n\tds_read_b64_tr_b16 %1, %8 offset:%10\n\tds_read_b64_tr_b16 %2, %8 offset:%11\n\tds_read_b64_tr_b16 %3, %8 offset:%12\n\t"
                             "ds_read_b64_tr_b16 %4, %8 offset:%13\n\tds_read_b64_tr_b16 %5, %8 offset:%14\n\tds_read_b64_tr_b16 %6, %8 offset:%15\n\tds_read_b64_tr_b16 %7, %8 offset:%16\n\ts_waitcnt lgkmcnt(0)"
                             : "=&v"(x0), "=&v"(x1), "=&v"(x2), "=&v"(x3), "=&v"(y0), "=&v"(y1), "=&v"(y2), "=&v"(y3)
                             : "v"(vtr), "i"(0), "i"(8 * SB_VROW), "i"(16 * SB_VROW), "i"(24 * SB_VROW), "i"(64), "i"(64 + 8 * SB_VROW), "i"(64 + 16 * SB_VROW), "i"(64 + 24 * SB_VROW) : "memory");
#define SB_VF(a_, b_) ({ bf16x8 f_; f_[0] = (short)a_[0]; f_[1] = (short)a_[1]; f_[2] = (short)a_[2]; f_[3] = (short)a_[3]; f_[4] = (short)b_[0]; f_[5] = (short)b_[1]; f_[6] = (short)b_[2]; f_[7] = (short)b_[3]; f_; })
                o0 = __builtin_amdgcn_mfma_f32_32x32x16_bf16(SB_VF(x0, x1), pf0, o0, 0, 0, 0); o0 = __builtin_amdgcn_mfma_f32_32x32x16_bf16(SB_VF(x2, x3), pf1, o0, 0, 0, 0);
                o1 = __builtin_amdgcn_mfma_f32_32x32x16_bf16(SB_VF(y0, y1), pf0, o1, 0, 0, 0); o1 = __builtin_amdgcn_mfma_f32_32x32x16_bf16(SB_VF(y2, y3), pf1, o1, 0, 0, 0);
#undef SB_VF
            }
        };
        int kt = qt + 1;
        for (; kt >= qt; --kt) tile(kt, BoolT<true>{});
        for (; kt >= 0; --kt) {
            if (__all(EL < 1e-37f)) break;
            tile(kt, BoolT<false>{});
        }
        {
            bf16_t* yp = YA + ((size_t)b * SEQ + (qi - NMETA)) * 512 + h * 64 + 4 * hh;
#pragma unroll
            for (int g = 0; g < 4; ++g) {
                u32x2 w; w.x = pk2(o0[4 * g], o0[4 * g + 1]); w.y = pk2(o0[4 * g + 2], o0[4 * g + 3]); *(u32x2*)(yp + 8 * g) = w;
                w.x = pk2(o1[4 * g], o1[4 * g + 1]); w.y = pk2(o1[4 * g + 2], o1[4 * g + 3]); *(u32x2*)(yp + 32 + 8 * g) = w;
            }
        }
    }
}

constexpr int DSA_NQ = 8;
constexpr int DSA_SCS = 4608;
constexpr int DSA_KVB = 0, DSA_RING = 18432, DSA_IDX = DSA_NQ * DSA_RING, DSA_MISC = DSA_IDX + DSA_NQ * 1024, DSA_LDS = DSA_MISC + 512;
static_assert(DSA_NQ * DSA_SCS * 4 <= DSA_IDX, "score rows fit under the index lists");
__device__ __forceinline__ unsigned fkey(float f) { const unsigned u = __float_as_uint(f); return (u & 0x80000000u) ? ~u : (u | 0x80000000u); }
__device__ __forceinline__ int wave_sum_i32(int v) {
    v += __builtin_amdgcn_update_dpp(0, v, 0xB1, 0xF, 0xF, false);
    v += __builtin_amdgcn_update_dpp(0, v, 0x4E, 0xF, 0xF, false);
    v += __builtin_amdgcn_update_dpp(0, v, 0x141, 0xF, 0xF, false);
    v += __builtin_amdgcn_update_dpp(0, v, 0x140, 0xF, 0xF, false);
    return __builtin_amdgcn_readlane(v, 0) + __builtin_amdgcn_readlane(v, 16) + __builtin_amdgcn_readlane(v, 32) + __builtin_amdgcn_readlane(v, 48);
}
__device__ __forceinline__ int wave_excl_scan_i32(int c, int lane, int& total) {
    int x = c;
    x += __builtin_amdgcn_update_dpp(0, x, 0x111, 0xF, 0xF, true);
    x += __builtin_amdgcn_update_dpp(0, x, 0x112, 0xF, 0xF, true);
    x += __builtin_amdgcn_update_dpp(0, x, 0x114, 0xF, 0xF, true);
    x += __builtin_amdgcn_update_dpp(0, x, 0x118, 0xF, 0xF, true);
    const int t0 = __builtin_amdgcn_readlane(x, 15), t1 = __builtin_amdgcn_readlane(x, 31), t2 = __builtin_amdgcn_readlane(x, 47), t3 = __builtin_amdgcn_readlane(x, 63);
    const int row = lane >> 4;
    x += (row > 0 ? t0 : 0) + (row > 1 ? t1 : 0) + (row > 2 ? t2 : 0);
    total = t0 + t1 + t2 + t3;
    return x - c;
}
__device__ __forceinline__ int mbcnt64(unsigned long long m) { return (int)__builtin_amdgcn_mbcnt_hi((unsigned)(m >> 32), __builtin_amdgcn_mbcnt_lo((unsigned)m, 0u)); }
__device__ __forceinline__ void phase_dsa(const Params& p, char* lds) {
    const bf16_t* P = (const bf16_t*)(p.ws + WS_P); bf16_t* OL = (bf16_t*)(p.ws + WS_OLAT);
    const int tid = threadIdx.x, lane = tid & 63, wave = __builtin_amdgcn_readfirstlane(tid >> 6);
    unsigned* SC = (unsigned*)(lds + DSA_KVB);
    unsigned short* IDX = (unsigned short*)(lds + DSA_IDX);
    int* MISC = (int*)(lds + DSA_MISC);
    const unsigned lds_base = (unsigned)(size_t)lds;
    constexpr int NU = SEQ / DSA_NQ;
    for (int unit = blockIdx.x; unit < BATCH * NU; unit += gridDim.x) {
        const int u8 = NU - 1 - unit / BATCH, b = unit % BATCH, t0 = NMETA + u8 * DSA_NQ;
        const int cid = 1 + (t0 - NMETA) / 64, n = NMETA + 64 * cid;
        const bf16_t* Pb = P + (size_t)b * T * PW;
        const int m = lane & 31, hh = lane >> 5;
        bf16x8 aq[2][4], wa[2][2];
#pragma unroll
        for (int rt = 0; rt < 2; ++rt) {
#pragma unroll
            for (int s = 0; s < 4; ++s) aq[rt][s] = *(const bf16x8*)(Pb + (size_t)(t0 + 4 * rt + (m >> 3)) * PW + C_QI + (m & 7) * 64 + 16 * s + 8 * hh);
            const int o = m - 8 * rt, ql = (o == 0) ? 0 : (o == 1) ? 1 : (o == 4) ? 2 : (o == 5) ? 3 : -1;
            u32x2 wq = (u32x2){0u, 0u};
            if (ql >= 0) wq = *(const u32x2*)(Pb + (size_t)(t0 + 4 * rt + ql) * PW + C_WI + 4 * hh);
            u32x4 w0 = (u32x4){0u, 0u, 0u, 0u}, w1 = w0;
            if (ql == 0) { w0.x = wq.x; w0.y = wq.y; } else if (ql == 1) { w0.z = wq.x; w0.w = wq.y; } else if (ql == 2) { w1.x = wq.x; w1.y = wq.y; } else if (ql == 3) { w1.z = wq.x; w1.w = wq.y; }
            wa[rt][0] = __builtin_bit_cast(bf16x8, w0); wa[rt][1] = __builtin_bit_cast(bf16x8, w1);
        }
        const unsigned char* KIPb = p.ws + WS_KIP + (size_t)b * KIP_BATCH + lane * 16;
        bf16x8 bk[4];
#pragma unroll
        for (int s = 0; s < 4; ++s) bk[s] = *(const bf16x8*)(KIPb + (size_t)wave * 4096 + s * 1024);
        __syncthreads();
        {
            const int ntile = (n + 31) / 32;
            for (int kt = wave; kt < ntile; kt += NWAVES) {
                const int j0 = kt * 32, key = j0 + m;
                bf16x8 bn[4];
                { const int ktn = kt + NWAVES < 129 ? kt + NWAVES : 128;
#pragma unroll
                  for (int s = 0; s < 4; ++s) bn[s] = *(const bf16x8*)(KIPb + (size_t)ktn * 4096 + s * 1024); }
                const bool ok = key < n;
                f32x16 outp;
#pragma unroll
                for (int r = 0; r < 16; ++r) outp[r] = 0.f;
#pragma unroll
                for (int rt = 0; rt < 2; ++rt) {
                    f32x16 acc;
#pragma unroll
                    for (int r = 0; r < 16; ++r) acc[r] = 0.f;
#pragma unroll
                    for (int s = 0; s < 4; ++s) acc = __builtin_amdgcn_mfma_f32_32x32x16_bf16(aq[rt][s], bk[s], acc, 0, 0, 0);
                    u32x4 p0, p1;
#define RELU2_(a_, b_) __builtin_bit_cast(unsigned, __builtin_elementwise_max(__builtin_bit_cast(s16x2, pk2((a_), (b_))), (s16x2){0, 0}))
                    p0.x = RELU2_(acc[0], acc[1]); p0.y = RELU2_(acc[2], acc[3]); p0.z = RELU2_(acc[4], acc[5]); p0.w = RELU2_(acc[6], acc[7]);
                    p1.x = RELU2_(acc[8], acc[9]); p1.y = RELU2_(acc[10], acc[11]); p1.z = RELU2_(acc[12], acc[13]); p1.w = RELU2_(acc[14], acc[15]);
#undef RELU2_
                    outp = __builtin_amdgcn_mfma_f32_32x32x16_bf16(wa[rt][0], __builtin_bit_cast(bf16x8, p0), outp, 0, 0, 0);
                    outp = __builtin_amdgcn_mfma_f32_32x32x16_bf16(wa[rt][1], __builtin_bit_cast(bf16x8, p1), outp, 0, 0, 0);
                }
#pragma unroll
                for (int rt = 0; rt < 2; ++rt) {
                    SC[(4 * rt + 2 * hh) * DSA_SCS + key] = ok ? fkey(outp[4 * rt]) : 0u;
                    SC[(4 * rt + 2 * hh + 1) * DSA_SCS + key] = ok ? fkey(outp[4 * rt + 1]) : 0u;
                }
#pragma unroll
                for (int s = 0; s < 4; ++s) bk[s] = bn[s];
            }
        }
        __syncthreads();
        bf16x8 qf[5];
        {
            const int hd_ = lane & 15, g_ = lane >> 4;
#pragma unroll
            for (int ks = 0; ks < 5; ++ks) {
                u32x4 w = (u32x4){0u, 0u, 0u, 0u};
                if (hd_ < 8 && (ks < 4 || g_ < 2)) w = *(const u32x4*)(Pb + (size_t)(t0 + wave) * PW + C_QF + hd_ * QFW + 32 * ks + 8 * g_);
                qf[ks] = __builtin_bit_cast(bf16x8, w);
            }
        }
        {
            unsigned* sc = SC + wave * DSA_SCS;
            unsigned v[65];
#pragma unroll
            for (int i = 0; i < 65; ++i) { const int k = i * 64 + lane; v[i] = (k < n) ? sc[k] : 0u; }
            unsigned prefix = 0u; int cge = n, bit = 31;
            bool exact = false;
            if (n >= 256) {
                for (; bit >= 0 && cge > 512; --bit) {
                    const unsigned cand = prefix | (1u << bit); const int sc_ = (int)(cand ^ 0x80000000u);
                    unsigned b0 = 0u, b1 = 0u, b2 = 0u; int slots = 0;
#pragma unroll
                    for (int gi = 0; gi < 5; ++gi) if (gi * 832 < n) {
#pragma unroll
                        for (int i = 13 * gi; i < 13 * gi + 13; ++i) {
                            const unsigned d = (unsigned)__builtin_elementwise_sub_sat((int)(v[i] ^ 0x80000000u), sc_);
                            if (i % 3 == 0) b0 = __builtin_amdgcn_alignbit(b0, d, 31); else if (i % 3 == 1) b1 = __builtin_amdgcn_alignbit(b1, d, 31); else b2 = __builtin_amdgcn_alignbit(b2, d, 31);
                        }
                        slots += 13 * 64;
                    }
                    const int c = slots - wave_sum_i32(__builtin_popcount(b0) + __builtin_popcount(b1) + __builtin_popcount(b2));
                    if (c >= 256) { prefix = cand; cge = c; if (c == 256) { exact = true; break; } }
                }
            }
            int ngt = n;
            if (n >= 256 && !exact) {
                asm volatile("s_waitcnt lgkmcnt(0)" ::: "memory");
                int cb = 0;
                if (bit >= 0) {
                    const int sp_ = (int)((prefix > 0u ? prefix : 1u) ^ 0x80000000u);
                    unsigned lb0 = 0u, lb1 = 0u, lb2 = 0u;
#pragma unroll
                    for (int i = 0; i < 65; ++i) { const unsigned d = (unsigned)__builtin_elementwise_sub_sat((int)(v[i] ^ 0x80000000u), sp_);
                        if (i < 32) lb0 = __builtin_amdgcn_alignbit(lb0, d, 31); else if (i < 64) lb1 = __builtin_amdgcn_alignbit(lb1, d, 31); else lb2 = d >> 31; }
                    const unsigned tk0 = ~lb0, tk1 = ~lb1, tk2 = (~lb2) & 1u;
                    const int c0 = __builtin_popcount(tk0), c1 = __builtin_popcount(tk1);
                    const int lbase = wave_excl_scan_i32(c0 + c1 + (int)tk2, lane, cb);
#pragma unroll
                    for (int i = 0; i < 65; ++i) {
                        bool tkn; int rk;
                        if (i < 32) { tkn = (tk0 >> (31 - i)) & 1u; rk = i == 0 ? 0 : __builtin_popcount(tk0 >> (32 - i)); }
                        else if (i < 64) { tkn = (tk1 >> (63 - i)) & 1u; rk = c0 + (i == 32 ? 0 : __builtin_popcount(tk1 >> (64 - i))); }
                        else { tkn = tk2 != 0u; rk = c0 + c1; }
                        sc[tkn ? lbase + rk : 4096 + (lane & 15)] = v[i];
                    }
                    asm volatile("s_waitcnt lgkmcnt(0)" ::: "memory");
                    unsigned w[8];
#pragma unroll
                    for (int j = 0; j < 8; ++j) { const int k = j * 64 + lane; w[j] = (k < cb) ? sc[k] : 0u; }
                    for (; bit >= 0; --bit) {
                        const unsigned cand = prefix | (1u << bit); const int sc_ = (int)(cand ^ 0x80000000u); unsigned b0 = 0u, b1 = 0u;
#pragma unroll
                        for (int j = 0; j < 8; ++j) { const unsigned d = (unsigned)__builtin_elementwise_sub_sat((int)(w[j] ^ 0x80000000u), sc_); if (j & 1) b1 = __builtin_amdgcn_alignbit(b1, d, 31); else b0 = __builtin_amdgcn_alignbit(b0, d, 31); }
                        const int c = 512 - wave_sum_i32(__builtin_popcount(b0) + __builtin_popcount(b1));
                        if (c >= 256) { prefix = cand; if (c == 256) { exact = true; break; } }
                    }
                    int c = 0;
#pragma unroll
                    for (int j = 0; j < 8; ++j) c += __popcll(__ballot(w[j] > prefix));
                    ngt = c;
                } else {
                    int c = 0;
#pragma unroll
                    for (int i = 0; i < 65; ++i) { c += __popcll(__ballot(v[i] > prefix)); if ((i & 3) == 3) __builtin_amdgcn_sched_barrier(0); }
                    ngt = c;
                }
            }
            const unsigned tau = prefix;
            const int need_eq = n >= 256 ? 256 - ngt : 0; int base = 0, eqb = 0;
            unsigned short* idx = IDX + wave * 512;
            {
                const int st_ = (int)(tau ^ 0x80000000u); unsigned e0 = 0u, e1 = 0u, e2 = 0u;
#pragma unroll
                for (int i = 0; i < 65; ++i) { const unsigned d = (unsigned)__builtin_elementwise_sub_sat((int)(v[i] ^ 0x80000000u), st_);
                    if (i < 32) e0 = __builtin_amdgcn_alignbit(e0, d, 31); else if (i < 64) e1 = __builtin_amdgcn_alignbit(e1, d, 31); else e2 = d >> 31; }
                const unsigned tk0 = ~e0, tk1 = ~e1, tk2 = (~e2) & 1u;
                const int c0 = __builtin_popcount(tk0), c1 = __builtin_popcount(tk1);
                int nge; const int lbase = wave_excl_scan_i32(c0 + c1 + (int)tk2, lane, nge);
                if (n >= 256 && nge == 256) {
                    unsigned short* ib = idx + lbase;
                    { unsigned x = tk0; int j = 0; while (__any(x != 0u)) { if (x != 0u) { const int i = __builtin_clz(x); ib[j] = (unsigned short)(i * 64 + lane); x ^= 0x80000000u >> i; } ++j; } }
                    ib += c0;
                    { unsigned x = tk1; int j = 0; while (__any(x != 0u)) { if (x != 0u) { const int i = __builtin_clz(x); ib[j] = (unsigned short)((32 + i) * 64 + lane); x ^= 0x80000000u >> i; } ++j; } }
                    if (tk2 != 0u) ib[c1] = (unsigned short)(64 * 64 + lane);
                    base = nge;
                } else {
#pragma unroll
                    for (int gi = 0; gi < 5; ++gi) if (gi * 832 < n) {
#pragma unroll
                        for (int i = 13 * gi; i < 13 * gi + 13; ++i) {
                            const int k = i * 64 + lane; const unsigned u = v[i];
                            const bool eq = (u == tau); const unsigned long long meq = __ballot(eq);
                            const bool take = (u > tau) || (eq && (eqb + mbcnt64(meq)) < need_eq);
                            const unsigned long long mt = __ballot(take);
                            idx[take ? base + mbcnt64(mt) : 256 + lane] = (unsigned short)k;
                            base += __popcll(mt); eqb += __popcll(meq);
                            if ((i & 3) == 3) __builtin_amdgcn_sched_barrier(0);
                        }
                    }
                }
            }
            for (int pos = base + lane; pos < 256; pos += 64) idx[pos] = 0;
            if (lane == 0) MISC[wave] = base;
        }
        asm volatile("s_waitcnt lgkmcnt(0)" ::: "memory");
        {
            const int q = wave; const int nsel = __builtin_amdgcn_readfirstlane(MISC[q]);
            const size_t qrow = (size_t)(t0 + q);
            int ln = lane; asm volatile("" : "+v"(ln));
            const int hd = ln & 15, g = ln >> 4, qd = (ln & 15) >> 2, pp = ln & 3;
            char* ring = lds + DSA_KVB + wave * DSA_RING;
            const unsigned ring_a = lds_base + DSA_KVB + wave * DSA_RING;
            const unsigned short* idx = IDX + q * 512;
            asm volatile("s_waitcnt vmcnt(0)" ::: "memory");
#define DSA_ISSUE(c) do { unsigned rw_[9]; \
                _Pragma("unroll") for (int i_ = 0; i_ < 9; ++i_) { const int pid_ = ln + 64 * i_, row_ = pid_ / 18; rw_[i_] = idx[32 * (c) + row_]; } \
                _Pragma("unroll") for (int i_ = 0; i_ < 9; ++i_) { const int pid_ = ln + 64 * i_, row_ = pid_ / 18, part_ = pid_ - row_ * 18; \
                    const unsigned off_ = rw_[i_] * (unsigned)(PW * 2) + (unsigned)((C_KV + part_ * 8) * 2); \
                    __builtin_amdgcn_global_load_lds((const unsigned*)((const char*)Pb + off_), (LAS unsigned*)(ring + ((c) & 1) * 9216 + i_ * 1024), 16, 0, 0); } } while (0)
            DSA_ISSUE(0); DSA_ISSUE(1);
            f32x4 O[8];
#pragma unroll
            for (int nt = 0; nt < 8; ++nt) O[nt] = (f32x4){0.f, 0.f, 0.f, 0.f};
            float mrun = -3e38f, lrun = 0.f;
            for (int c = 0; c < 8; ++c) {
                if (c < 7) asm volatile("s_waitcnt vmcnt(9)" ::: "memory"); else asm volatile("s_waitcnt vmcnt(0)" ::: "memory");
                const char* buf = ring + (c & 1) * 9216;
                f32x4 S0 = (f32x4){0.f, 0.f, 0.f, 0.f}, S1 = S0;
                {
                    const char* kr = buf + hd * 288 + 16 * g;
#pragma unroll
                    for (int ks = 0; ks < 4; ++ks) { S0 = __builtin_amdgcn_mfma_f32_16x16x32_bf16(*(const bf16x8*)(kr + 64 * ks), qf[ks], S0, 0, 0, 0); S1 = __builtin_amdgcn_mfma_f32_16x16x32_bf16(*(const bf16x8*)(kr + 16 * 288 + 64 * ks), qf[ks], S1, 0, 0, 0); }
                    u32x4 w0 = (u32x4){0u, 0u, 0u, 0u}, w1 = w0; if (g < 2) { w0 = *(const u32x4*)(kr + 256); w1 = *(const u32x4*)(kr + 16 * 288 + 256); }
                    S0 = __builtin_amdgcn_mfma_f32_16x16x32_bf16(__builtin_bit_cast(bf16x8, w0), qf[4], S0, 0, 0, 0); S1 = __builtin_amdgcn_mfma_f32_16x16x32_bf16(__builtin_bit_cast(bf16x8, w1), qf[4], S1, 0, 0, 0);
                }
                float cm = -3e38f;
#pragma unroll
                for (int r = 0; r < 4; ++r) { if (nsel < 256) { const int sl = 32 * c + 4 * g + r; S0[r] = sl < nsel ? S0[r] : -1e30f; S1[r] = (sl + 16) < nsel ? S1[r] : -1e30f; } cm = fmax2(cm, fmax2(S0[r], S1[r])); }
                cm = xmax16(xmax32(cm));
                if (__any(cm > mrun + 6.f)) {
                    const float mnew = fmaxf(mrun, cm), alpha = fexp2(mrun - mnew);
                    lrun *= alpha; mrun = mnew;
#pragma unroll
                    for (int nt = 0; nt < 8; ++nt) O[nt] *= alpha;
                }
                float ps = 0.f;
#pragma unroll
                for (int r = 0; r < 4; ++r) { S0[r] = fexp2(S0[r] - mrun); S1[r] = fexp2(S1[r] - mrun); ps += S0[r] + S1[r]; }
                ps = xsum16(xsum32(ps));
                lrun += ps;
                u32x4 pw; pw.x = pk2(S0[0], S0[1]); pw.y = pk2(S0[2], S0[3]); pw.z = pk2(S1[0], S1[1]); pw.w = pk2(S1[2], S1[3]);
                const bf16x8 pf = __builtin_bit_cast(bf16x8, pw);
                const unsigned va = ring_a + (unsigned)((c & 1) * 9216 + (4 * g + qd) * 288 + 8 * pp);
#pragma unroll
                for (int h2 = 0; h2 < 2; ++h2) {
                    u16x4 x0, x1, x2, x3, y0, y1, y2, y3;
                    asm volatile("ds_read_b64_tr_b16 %0, %8 offset:%9\n\tds_read_b64_tr_b16 %1, %8 offset:%10\n\tds_read_b64_tr_b16 %2, %8 offset:%11\n\tds_read_b64_tr_b16 %3, %8 offset:%12\n\t"
                                 "ds_read_b64_tr_b16 %4, %8 offset:%13\n\tds_read_b64_tr_b16 %5, %8 offset:%14\n\tds_read_b64_tr_b16 %6, %8 offset:%15\n\tds_read_b64_tr_b16 %7, %8 offset:%16\n\ts_waitcnt lgkmcnt(0)"
                                 : "=&v"(x0), "=&v"(x1), "=&v"(x2), "=&v"(x3), "=&v"(y0), "=&v"(y1), "=&v"(y2), "=&v"(y3)
                                 : "v"(va), "i"(128 * h2), "i"(128 * h2 + 32), "i"(128 * h2 + 64), "i"(128 * h2 + 96), "i"(128 * h2 + 4608), "i"(128 * h2 + 4640), "i"(128 * h2 + 4672), "i"(128 * h2 + 4704) : "memory");
#define DSA_PV(nt_, x_, y_) do { bf16x8 vf_; vf_[0] = (short)x_[0]; vf_[1] = (short)x_[1]; vf_[2] = (short)x_[2]; vf_[3] = (short)x_[3]; vf_[4] = (short)y_[0]; vf_[5] = (short)y_[1]; vf_[6] = (short)y_[2]; vf_[7] = (short)y_[3]; \
                    O[nt_] = __builtin_amdgcn_mfma_f32_16x16x32_bf16(vf_, pf, O[nt_], 0, 0, 0); } while (0)
                    DSA_PV(4 * h2 + 0, x0, y0); DSA_PV(4 * h2 + 1, x1, y1); DSA_PV(4 * h2 + 2, x2, y2); DSA_PV(4 * h2 + 3, x3, y3);
                }
                asm volatile("s_waitcnt lgkmcnt(0)" ::: "memory");
                if (c + 2 < 8) DSA_ISSUE(c + 2);
            }
#undef DSA_PV
#undef DSA_ISSUE
            const float inv = __builtin_amdgcn_rcpf(lrun);
            if (hd < 8) {
                bf16_t* op = OL + ((size_t)b * SEQ + (qrow - NMETA)) * 1024 + hd * 128 + 4 * g;
#pragma unroll
                for (int nt = 0; nt < 8; ++nt) { u32x2 w; w.x = pk2(O[nt][0] * inv, O[nt][1] * inv); w.y = pk2(O[nt][2] * inv, O[nt][3] * inv); *(u32x2*)(op + 16 * nt) = w; }
            }
        }
    }
}

__device__ __forceinline__ void phase_inproj_meta(const Params& p) {
    unsigned char* ws = p.ws; const int tid = threadIdx.x, lane = tid & 63, wave = tid >> 6, fr = lane & 15, fq = lane >> 4;
    const bf16_t* U = (const bf16_t*)(ws + WS_U); const bf16_t* WP = (const bf16_t*)(ws + WS_WP); bf16_t* P = (bf16_t*)(ws + WS_P); const float2* cs = (const float2*)(ws + WS_CS);
    const int gw = blockIdx.x * NWAVES + wave, NGW = gridDim.x * NWAVES;
    for (int nt = gw; nt < PW / 16; nt += NGW) {
        const bf16_t* ap = U + (size_t)fr * D + 8 * fq; const bf16_t* bp = WP + (size_t)(16 * nt + fr) * D + 8 * fq;
        f32x4 acc = (f32x4){0.f, 0.f, 0.f, 0.f};
#pragma unroll 8
        for (int ks = 0; ks < D / 32; ++ks) acc = __builtin_amdgcn_mfma_f32_16x16x32_bf16(*(const bf16x8*)(bp + 32 * ks), *(const bf16x8*)(ap + 32 * ks), acc, 0, 0, 0);
        const int col = 16 * nt + 4 * fq, t = fr; f32x4 v = acc; int o;
        if (pg8::rope_off(col, o)) { const float2 c0 = cs[t * 8 + (o >> 1)], c1 = cs[t * 8 + (o >> 1) + 1]; v = (f32x4){v.x * c0.x - v.y * c0.y, v.y * c0.x + v.x * c0.y, v.z * c1.x - v.w * c1.y, v.w * c1.x + v.z * c1.y}; }
        u32x2 w; w.x = pk2(v.x, v.y); w.y = pk2(v.z, v.w);
        for (int b = 0; b < BATCH; ++b) {
            if (col >= C_KI && col < C_WI) { const int d0 = col - C_KI;
                *(u32x2*)(ws + WS_KIP + (size_t)b * KIP_BATCH + (size_t)((((t >> 5) * 4 + (d0 >> 4)) * 2 + ((d0 >> 3) & 1)) * 512 + (t & 31) * 16 + (d0 & 7) * 2)) = w; }
            else *(u32x2*)(P + ((size_t)b * T + t) * PW + col) = w;
        }
    }
}

__device__ __forceinline__ void phase_c3(const Params& p, char* lds) {
    unsigned char* ws = p.ws; const int tid = threadIdx.x, lane = tid & 63, wave = __builtin_amdgcn_readfirstlane(tid >> 6);
    const float* H1 = (const float*)(ws + WS_H1); const float* g = p.in[I_GFFN]; bf16_t* U2 = (bf16_t*)(ws + WS_U);
    const bf16_t* WH = (const bf16_t*)(ws + WS_WRT); const bf16_t* WL = WH + WRT_N * D;
    const float* bg = p.in[I_BGRP]; const float* br = p.in[I_BRT];
    unsigned* ctl = (unsigned*)(ws + WS_CTL); int* LIST = (int*)(ws + WS_LIST); float* GATE = (float*)(ws + WS_GATE); float* RS = (float*)(ws + WS_RSTD2);
    float* LG = (float*)lds + wave * (16 * 49 + 16);
    const int gw = blockIdx.x * NWAVES + wave, NGW = gridDim.x * NWAVES;
    const int tr = lane & 15, g4 = lane >> 4;
    for (int tile = gw; tile < NR / 16; tile += NGW) {
        const int row = tile * 16 + tr;
        const float* hp = H1 + (size_t)row * D + 8 * g4; bf16_t* up = U2 + (size_t)row * D + 8 * g4;
        const bf16_t* whp = WH + (size_t)tr * D + 8 * g4; const bf16_t* wlp = WL + (size_t)tr * D + 8 * g4;
        f32x4 acc[3]; float ss = 0.f;
#pragma unroll
        for (int nt = 0; nt < 3; ++nt) acc[nt] = (f32x4){0.f, 0.f, 0.f, 0.f};
        f32x4 xq[4][2]; bf16x8 bc[6], bn[6];
#pragma unroll
        for (int j = 0; j < 4; ++j) { xq[j][0] = *(const f32x4*)(hp + 32 * j); xq[j][1] = *(const f32x4*)(hp + 32 * j + 4); }
#pragma unroll
        for (int nt = 0; nt < 3; ++nt) { bc[2 * nt] = *(const bf16x8*)(whp + (size_t)nt * 16 * D); bc[2 * nt + 1] = *(const bf16x8*)(wlp + (size_t)nt * 16 * D); }
#pragma unroll 4
        for (int s = 0; s < 32; ++s) {
            const f32x4 x0 = xq[s & 3][0], x1 = xq[s & 3][1];
            { const int sn = s + 4 < 32 ? s + 4 : 31; xq[s & 3][0] = *(const f32x4*)(hp + 32 * sn); xq[s & 3][1] = *(const f32x4*)(hp + 32 * sn + 4); }
            { const int sb = s + 1 < 32 ? s + 1 : 31;
#pragma unroll
              for (int nt = 0; nt < 3; ++nt) { bn[2 * nt] = *(const bf16x8*)(whp + (size_t)nt * 16 * D + 32 * sb); bn[2 * nt + 1] = *(const bf16x8*)(wlp + (size_t)nt * 16 * D + 32 * sb); } }
            const f32x4 g0 = *(const f32x4*)(g + 32 * s + 8 * g4), g1 = *(const f32x4*)(g + 32 * s + 8 * g4 + 4);
            ss += (x0.x * x0.x + x0.y * x0.y) + (x0.z * x0.z + x0.w * x0.w) + (x1.x * x1.x + x1.y * x1.y) + (x1.z * x1.z + x1.w * x1.w);
            const f32x4 h0 = x0 * g0, h1 = x1 * g1;
            u32x4 hi; hi.x = pk2(h0.x, h0.y); hi.y = pk2(h0.z, h0.w); hi.z = pk2(h1.x, h1.y); hi.w = pk2(h1.z, h1.w);
            *(u32x4*)(up + 32 * s) = hi;
            u32x4 lo; lo.x = pk2(h0.x - bflo(hi.x), h0.y - bfhi(hi.x)); lo.y = pk2(h0.z - bflo(hi.y), h0.w - bfhi(hi.y)); lo.z = pk2(h1.x - bflo(hi.z), h1.y - bfhi(hi.z)); lo.w = pk2(h1.z - bflo(hi.w), h1.w - bfhi(hi.w));
            const bf16x8 ah = __builtin_bit_cast(bf16x8, hi), al = __builtin_bit_cast(bf16x8, lo);
#pragma unroll
            for (int nt = 0; nt < 3; ++nt) {
                acc[nt] = __builtin_amdgcn_mfma_f32_16x16x32_bf16(ah, bc[2 * nt], acc[nt], 0, 0, 0);
                acc[nt] = __builtin_amdgcn_mfma_f32_16x16x32_bf16(ah, bc[2 * nt + 1], acc[nt], 0, 0, 0);
                acc[nt] = __builtin_amdgcn_mfma_f32_16x16x32_bf16(al, bc[2 * nt], acc[nt], 0, 0, 0);
            }
#pragma unroll
            for (int j = 0; j < 6; ++j) bc[j] = bn[j];
        }
        ss = xsum16(xsum32(ss));
#pragma unroll
        for (int nt = 0; nt < 3; ++nt)
#pragma unroll
            for (int r = 0; r < 4; ++r) LG[(4 * g4 + r) * 49 + 16 * nt + tr] = acc[nt][r];
        if (g4 == 0) LG[16 * 49 + tr] = ss;
        asm volatile("s_waitcnt lgkmcnt(0)" ::: "memory");
        if (lane < 16) {
            const int tok = tile * 16 + lane; const float* lg = LG + lane * 49;
            const float rstd = rsqrtf(LG[16 * 49 + lane] * (1.f / D) + NORM_EPS);
            RS[tok] = rstd;
            float gl[4]; int gs = 0; float gm;
#pragma unroll
            for (int o = 0; o < 4; ++o) gl[o] = lg[o] * rstd + bg[o];
            gm = gl[0];
#pragma unroll
            for (int o = 1; o < 4; ++o) if (gl[o] > gm) { gm = gl[o]; gs = o; }
            float gsum = 0.f;
#pragma unroll
            for (int o = 0; o < 4; ++o) gsum += __expf(gl[o] - gm);
            const float pgrp = 1.f / gsum;
            float el[8];
#pragma unroll
            for (int j = 0; j < 8; ++j) el[j] = lg[4 + gs * 8 + j] * rstd + br[gs * 8 + j];
            int e0 = 0; float m0 = el[0];
#pragma unroll
            for (int j = 1; j < 8; ++j) if (el[j] > m0) { m0 = el[j]; e0 = j; }
            int e1 = -1; float m1 = -3e38f;
#pragma unroll
            for (int j = 0; j < 8; ++j) if (j != e0 && el[j] > m1) { m1 = el[j]; e1 = j; }
            const float x1 = __expf(m1 - m0); const float g0 = pgrp / (1.f + x1), g1 = pgrp * x1 / (1.f + x1);
            const int ex0 = gs * 8 + e0, ex1 = gs * 8 + e1;
            const int s0 = (int)atomicAdd(ctl + CW_CNT + 64 * ex0, 1u); LIST[(size_t)ex0 * NR + s0] = tok * 2;
            const int s1 = (int)atomicAdd(ctl + CW_CNT + 64 * ex1, 1u); LIST[(size_t)ex1 * NR + s1] = tok * 2 + 1;
            GATE[tok * 2] = g0; GATE[tok * 2 + 1] = g1;
        }
        asm volatile("s_waitcnt lgkmcnt(0)" ::: "memory");
    }
}

template <int WHICH>
__device__ __forceinline__ void phase_moe(const Params& p, char* lds) {
    unsigned char* ws = p.ws; const int tid = threadIdx.x;
    const unsigned* ctl = (const unsigned*)(ws + WS_CTL);
    int* TP = (int*)(lds + pg8::STAGE_BYTES);
    __syncthreads();
    if (tid == 0) { int tp = 0, ro = 0; for (int e = 0; e < NEXP; ++e) { const int c = (int)ctl[CW_CNT + 64 * e]; TP[e] = tp; TP[64 + e] = ro; TP[128 + e] = c; const int t = (c + 255) / 256; tp += t * 4; ro += t * 256; } TP[NEXP] = tp; }
    __syncthreads();
    pg8::MoeOrder<WHICH> S{TP, (int)gridDim.x, (int)blockIdx.x, (const char*)(ws + (WHICH == 0 ? WS_U : WS_HID)), (const char*)(ws + (WHICH == 0 ? WS_W13 : WS_W2)), (const int*)(ws + WS_LIST)};
    if constexpr (WHICH == 0) { pg8::EpiMoe1 E{(bf16_t*)(ws + WS_HID), TP, (const int*)(ws + WS_LIST), (const float*)(ws + WS_RSTD2)}; pg8::gemm_phase_x<pg8::EpiMoe1, pg8::MoeOrder<0>, true, true>((LAS unsigned char*)lds, 1024, S, E); }
    else { pg8::EpiMoe2 E{(bf16_t*)(ws + WS_MO), TP, (const int*)(ws + WS_LIST), (const float*)(ws + WS_GATE)}; pg8::gemm_phase_x<pg8::EpiMoe2, pg8::MoeOrder<1>, true, true>((LAS unsigned char*)lds, 512, S, E); }
}

__device__ __forceinline__ void phase_final(const Params& p) {
    unsigned char* ws = p.ws; const int tid = threadIdx.x, lane = tid & 63, wave = tid >> 6;
    const float* H1 = (const float*)(ws + WS_H1); const bf16_t* MO = (const bf16_t*)(ws + WS_MO); const float* g = p.in[I_GFIN];
    const int gw = blockIdx.x * NWAVES + wave, NGW = gridDim.x * NWAVES;
    f32x4 vn[4]; u32x2 an[4], cn[4];
#define FIN_LOAD(r_) do { const size_t row_ = (size_t)(r_); const f32x4* xr_ = (const f32x4*)(H1 + row_ * D) + lane; const u32x2* m0_ = (const u32x2*)(MO + row_ * 2 * D) + lane; \
        _Pragma("unroll") for (int j = 0; j < 4; ++j) { vn[j] = xr_[64 * j]; an[j] = m0_[64 * j]; cn[j] = m0_[256 + 64 * j]; } } while (0)
    if (gw < BATCH * SEQ) FIN_LOAD(gw);
    for (int orow = gw; orow < BATCH * SEQ; orow += NGW) {
        f32x4 v[4]; u32x2 aa[4], cc[4]; float ss = 0.f;
#pragma unroll
        for (int j = 0; j < 4; ++j) { v[j] = vn[j]; aa[j] = an[j]; cc[j] = cn[j]; }
        if (orow + NGW < BATCH * SEQ) FIN_LOAD(orow + NGW);
#pragma unroll
        for (int j = 0; j < 4; ++j) { const u32x2 a = aa[j], c = cc[j];
            v[j].x += bflo(a.x) + bflo(c.x); v[j].y += bfhi(a.x) + bfhi(c.x); v[j].z += bflo(a.y) + bflo(c.y); v[j].w += bfhi(a.y) + bfhi(c.y);
            ss += (v[j].x * v[j].x + v[j].y * v[j].y) + (v[j].z * v[j].z + v[j].w * v[j].w); }
        const float rstd = rsqrtf(wave_sum(ss) * (1.f / D) + NORM_EPS);
        f32x4* o = (f32x4*)(p.out + (size_t)orow * D) + lane;
#pragma unroll
        for (int j = 0; j < 4; ++j) { const f32x4 gg = ((const f32x4*)g)[lane + 64 * j]; o[64 * j] = v[j] * rstd * gg; }
    }
#undef FIN_LOAD
}

#define XB_TMO      128
#define XB_XCNT(j)  (256  + 64 * (j))
#define XB_XSUB(j)  (1280 + 64 * (j))
#define XB_XGEN(j)  (2304 + 64 * (j))
#define XB_TOP      3328
#define XB_TOPGEN   3392
#define XCD_BAR_WORDS 3456
#define XB_SPIN_CAP (1u << 18)
__device__ __forceinline__ unsigned xb_ld(unsigned* p)              { return __hip_atomic_load(p, __ATOMIC_RELAXED, __HIP_MEMORY_SCOPE_AGENT); }
__device__ __forceinline__ unsigned xb_add(unsigned* p, unsigned v) { return __hip_atomic_fetch_add(p, v, __ATOMIC_RELAXED, __HIP_MEMORY_SCOPE_AGENT); }
__device__ __forceinline__ unsigned xb_xcc_id() { return (unsigned)__builtin_amdgcn_s_getreg((3 << 11) | 20) & 0xFu; }
#define XB_SPIN(cond, bar) do { unsigned _sp = 0; while (cond) { __builtin_amdgcn_s_sleep(1); \
    if ((++_sp & 255u) == 0u) { if (xb_ld(&(bar)[XB_TMO])) break; if (_sp > XB_SPIN_CAP) { atomicAdd(&(bar)[XB_TMO], 1u); break; } } } } while (0)
struct XcdBarrier { unsigned* bar; unsigned x; volatile LAS unsigned* st; };
__device__ __forceinline__ XcdBarrier xcd_barrier_post(unsigned* bar, volatile LAS unsigned* st) {
    XcdBarrier b; b.bar = bar; b.x = xb_xcc_id(); b.st = st;
    if (threadIdx.x == 0) (void)xb_add(&bar[XB_XCNT(b.x)], 1u);
    return b;
}
__device__ __forceinline__ void xcd_barrier_complete(unsigned* bar, unsigned x, unsigned& nloc, unsigned& nx) {
    const unsigned G = gridDim.x * gridDim.y * gridDim.z;
    unsigned sum, cnt, mine, sp = 0u;
    for (;;) {
        sum = 0u; cnt = 0u; mine = 0u;
#pragma unroll
        for (unsigned j = 0; j < 16; ++j) { const unsigned c = xb_ld(&bar[XB_XCNT(j)]); sum += c; cnt += (c > 0u) ? 1u : 0u; mine = (j == x) ? c : mine; }
        if (sum == G) break;
        __builtin_amdgcn_s_sleep(1);
        if ((++sp & 255u) == 0u) { if (xb_ld(&bar[XB_TMO])) break; if (sp > XB_SPIN_CAP) { atomicAdd(&bar[XB_TMO], 1u); break; } }
    }
    nloc = mine > 0u ? mine : 1u; nx = cnt > 0u ? cnt : 1u;
}
__device__ __forceinline__ void xcd_barrier(const XcdBarrier& b) {
    asm volatile("s_waitcnt vmcnt(0)" ::: "memory");
    __syncthreads();
    if (threadIdx.x == 0) {
        unsigned* bar = b.bar;
        __builtin_amdgcn_s_waitcnt(0);
        unsigned nloc = b.st[0], nx = b.st[1];
        if (nloc == 0u) { xcd_barrier_complete(bar, b.x, nloc, nx); b.st[0] = nloc; b.st[1] = nx; }
        const unsigned old = xb_add(&bar[XB_XSUB(b.x)], 1u);
        const unsigned gen = old / nloc;
        if (old + 1u == (gen + 1u) * nloc) {
            __builtin_amdgcn_fence(__ATOMIC_RELEASE, "agent");
            asm volatile("s_waitcnt vmcnt(0)" ::: "memory");
            const unsigned og = xb_add(&bar[XB_TOP], 1u);
            const unsigned tg = og / nx;
            if (og + 1u == (tg + 1u) * nx) xb_add(&bar[XB_TOPGEN], 1u);
            else XB_SPIN(xb_ld(&bar[XB_TOPGEN]) == tg, bar);
            __builtin_amdgcn_fence(__ATOMIC_ACQUIRE, "agent");
            xb_add(&bar[XB_XGEN(b.x)], 1u);
            asm volatile("s_waitcnt vmcnt(0)" ::: "memory");
        } else {
            XB_SPIN(xb_ld(&bar[XB_XGEN(b.x)]) == gen, bar);
            __builtin_amdgcn_fence(__ATOMIC_ACQUIRE, "agent");
            asm volatile("s_waitcnt vmcnt(0)" ::: "memory");
        }
    }
    __syncthreads();
}

constexpr int LDS_XB = DSA_LDS;
constexpr int LDS_BYTES = DSA_LDS + 256;
static_assert(pg8::STAGE_BYTES <= LDS_XB && pg8::STAGE_BYTES + 1024 <= LDS_XB && NWAVES * 64 * 33 * 4 <= LDS_XB && NWAVES * 32 * SB_VROW <= LDS_XB && NWAVES * (16 * 49 + 16) * 4 <= LDS_XB, "LDS map");

__global__ void __launch_bounds__(NTHREADS, 2) mega(Params p) {
    extern __shared__ __attribute__((aligned(16))) char lds[];
    const int lo = p.ph_lo, hi = p.ph_hi;
    unsigned char* ws = p.ws;
    XcdBarrier xb;
    {
        volatile LAS unsigned* st = (volatile LAS unsigned*)(lds + LDS_XB);
        if (threadIdx.x < 4) st[threadIdx.x] = 0u;
        __syncthreads();
        xb = xcd_barrier_post((unsigned*)(ws + WS_CTL) + CW_BAR, st);
    }
#define IN(k) (lo <= (k) && (k) < hi)
#define GSYNC() xcd_barrier(xb)
#define SEAM(k) do { if (IN(k) && IN((k) + 1)) GSYNC(); } while (0)
#define REP(k, ...) do { if (IN(k)) { __VA_ARGS__; } } while (0)
    LAS unsigned char* ldsl = (LAS unsigned char*)lds;
    REP(0, phase_prologue(p, lds));
    SEAM(0);
    REP(1, { phase_inproj_meta(p);
             pg8::TokRowOrder S; S.init(NR, PWN, gridDim.x, blockIdx.x); S.Abase = (const char*)(ws + WS_U); S.Bbase = (const char*)(ws + WS_WP); S.K = D;
             pg8::EpiInproj E{(bf16_t*)(ws + WS_P), (const float2*)(ws + WS_CS), ws + WS_KIP}; pg8::gemm_phase_x<pg8::EpiInproj, pg8::TokRowOrder, true, true>(ldsl, D, S, E); });
    SEAM(1);
    if (IN(2)) {
        phase_dsa(p, lds);
        __syncthreads(); phase_sb_fast(p, lds);
    }
    SEAM(2);
    REP(3, { pg8::TokRowOrder S; S.init(NR, 2048, gridDim.x, blockIdx.x); S.Abase = (const char*)(ws + WS_U); S.Bbase = (const char*)(ws + WS_WG); S.K = D;
             pg8::EpiGate E{(bf16_t*)(ws + WS_G)}; pg8::gemm_phase_x<pg8::EpiGate, pg8::TokRowOrder, true, true>(ldsl, D, S, E); });
    SEAM(3);
    REP(4, { { pg8::Gemm g{(const bf16_t*)(ws + WS_YA), (const bf16_t*)(ws + WS_WUA), NR, D, 512}; pg8::StaticOrder S; S.init(NR, D, gridDim.x, blockIdx.x);
               pg8::EpiZ<false> E{(bf16_t*)(ws + WS_Z), (const bf16_t*)(ws + WS_G), 0}; pg8::gemm_phase<pg8::EpiZ<false>, pg8::StaticOrder, true, true>(ldsl, g, S, E); }
             asm volatile("s_waitcnt vmcnt(0)" ::: "memory"); __syncthreads();
             { pg8::Gemm g{(const bf16_t*)(ws + WS_OLAT), (const bf16_t*)(ws + WS_WBP), NR, D, D}; pg8::StaticOrder S; S.init(NR, D, gridDim.x, blockIdx.x);
               pg8::EpiZ<true> E{(bf16_t*)(ws + WS_Z), (const bf16_t*)(ws + WS_G), 1024}; pg8::gemm_phase<pg8::EpiZ<true>, pg8::StaticOrder, true, true>(ldsl, g, S, E); } });
    SEAM(4);
    REP(5, { pg8::Gemm g{(const bf16_t*)(ws + WS_Z), (const bf16_t*)(ws + WS_WO), NR, D, D}; pg8::StaticOrder S; S.init(NR, D, gridDim.x, blockIdx.x);
             pg8::EpiH1 E{(float*)(ws + WS_H1), p.in[I_META], p.in[I_X]}; pg8::gemm_phase<pg8::EpiH1, pg8::StaticOrder, true, true>(ldsl, g, S, E); });
    SEAM(5);
    if (IN(6)) phase_c3(p, lds);
    SEAM(6);
    REP(7, phase_moe<0>(p, lds));
    SEAM(7);
    REP(8, phase_moe<1>(p, lds));
    SEAM(8);
    REP(9, phase_final(p));
}

extern "C" void kernel_launch(void* const* d_in, const int* in_sizes, int n_in, void* d_out, int out_size, void* d_ws, size_t ws_size, hipStream_t stream) {
    if (n_in != 18 || ws_size < WS_END) { fprintf(stderr, "kernel_launch: unexpected n_in %d / ws_size %zu\n", n_in, ws_size); return; }
    static int grid = 0;
    if (grid == 0) {
        int dev = 0, cus = 0, per_cu = 0;
        (void)hipGetDevice(&dev);
        (void)hipDeviceGetAttribute(&cus, hipDeviceAttributeMultiprocessorCount, dev);
        (void)hipFuncSetAttribute((const void*)mega, hipFuncAttributeMaxDynamicSharedMemorySize, LDS_BYTES);
        (void)hipOccupancyMaxActiveBlocksPerMultiprocessor(&per_cu, (const void*)mega, NTHREADS, LDS_BYTES);
        if (per_cu < 1) fprintf(stderr, "kernel_launch: occupancy query reports %d workgroups per CU\n", per_cu);
        grid = cus;
    }
    (void)hipMemsetAsync((char*)d_ws + WS_CTL, 0, CTL_BYTES, stream);
    Params p{};
    for (int i = 0; i < 18; ++i) p.in[i] = (const float*)d_in[i];
    p.out = (float*)d_out; p.ws = (unsigned char*)d_ws;
    p.ph_lo = 0; p.ph_hi = 10;
    void* args[] = {&p};
    hipError_t e = hipLaunchCooperativeKernel((const void*)mega, dim3(grid), dim3(NTHREADS), args, LDS_BYTES, stream);
    if (e != hipSuccess) fprintf(stderr, "cooperative launch failed: %s (grid %d)\n", hipGetErrorString(e), grid);
}
```

```cpp
#include <hip/hip_runtime.h>
#include <cstdio>
#include <cstdint>

constexpr int BATCH = 8, SEQ = 4096, NMETA = 16, T = SEQ + NMETA, D = 1024, NTOK = BATCH * T;
constexpr int MROWS = 33024;
constexpr int NR = BATCH * SEQ;
__device__ __forceinline__ int tokrow(int cr) { return cr + NMETA * (cr / SEQ + 1); }
constexpr int INW = 4824;
constexpr int NEXP = 32, DEXP = 512;
constexpr int NWAVES = 8, NTHREADS = 512;
constexpr float NORM_EPS = 1e-6f;
constexpr float LOG2E = 1.4426950408889634f;
constexpr float QSCALE = 0.125f * LOG2E;
constexpr int PW = 3456, PWN = 3584;
constexpr int C_QA = 0, C_KA = 512, C_VA = 1024, C_QF = 1536, C_KV = 2688, C_QI = 2832, C_KI = 3344, C_WI = 3408, C_END = 3416;
constexpr int QFW = 144;

constexpr size_t MiB = 1u << 20;
constexpr size_t WS_CTL = 0, CTL_BYTES = 1 * MiB;
constexpr size_t WS_CS = 1 * MiB;
constexpr size_t WS_WRT = 1 * MiB + 512 * 1024;
constexpr int WRT_N = 48;
constexpr size_t WS_WP = 2 * MiB;
constexpr size_t WS_WG = 9 * MiB;
constexpr size_t WS_WUA = 13 * MiB, WS_WBP = 14 * MiB, WS_WO = 16 * MiB;
constexpr size_t WS_W2 = 18 * MiB;
constexpr size_t WS_W13 = 50 * MiB;
constexpr size_t WS_U = 114 * MiB;
constexpr size_t WS_P = 179 * MiB;
constexpr size_t WS_Z = 179 * MiB;
constexpr size_t WS_G = 244 * MiB;
constexpr size_t WS_H1 = 244 * MiB;
constexpr size_t WS_LIST = 374 * MiB;
constexpr size_t WS_GATE = 379 * MiB;
constexpr size_t WS_RSTD2 = 380 * MiB;
constexpr size_t WS_YA = 397 * MiB;
constexpr size_t WS_OLAT = 430 * MiB;
constexpr size_t WS_HID = 397 * MiB;
constexpr size_t WS_MO = 50 * MiB;
constexpr size_t WS_KIP = 495 * MiB;
constexpr size_t KIP_BATCH = 129 * 4096;
constexpr size_t WS_END = 500 * MiB;
static_assert(WS_P + (size_t)MROWS * PW * 2 <= WS_YA && WS_G + (size_t)MROWS * 2048 * 2 <= WS_LIST && WS_Z + (size_t)MROWS * 1024 * 2 <= WS_G, "ws map");
static_assert(WS_OLAT + (size_t)MROWS * 1024 * 2 <= WS_END && WS_U + (size_t)MROWS * 1024 * 2 <= WS_P && WS_MO + (size_t)NTOK * 2048 * 2 <= WS_P, "ws map");
constexpr int CW_CNT = 1024;
constexpr int CW_BAR = 4096;

typedef unsigned short bf16_t;
typedef short bf16x8 __attribute__((ext_vector_type(8)));
typedef float f32x4 __attribute__((ext_vector_type(4)));
typedef float f32x16 __attribute__((ext_vector_type(16)));
typedef unsigned u32x2 __attribute__((ext_vector_type(2)));
typedef unsigned u32x4 __attribute__((ext_vector_type(4)));
typedef unsigned short u16x4 __attribute__((ext_vector_type(4)));
typedef short s16x2 __attribute__((ext_vector_type(2)));
#define LAS __attribute__((address_space(3)))

__device__ __forceinline__ unsigned f2bf(float f) { unsigned u = __float_as_uint(f); return (u + 0x7fffu + ((u >> 16) & 1u)) >> 16; }
typedef __bf16 bf16v2_t __attribute__((ext_vector_type(2)));
typedef float f32v2_t __attribute__((ext_vector_type(2)));
__device__ __forceinline__ unsigned pk2(float lo, float hi) { const f32v2_t v = {lo, hi}; const bf16v2_t r = __builtin_convertvector(v, bf16v2_t); return __builtin_bit_cast(unsigned, r); }
__device__ __forceinline__ float bflo(unsigned w) { return __uint_as_float(w << 16); }
__device__ __forceinline__ float bfhi(unsigned w) { return __uint_as_float(w & 0xffff0000u); }
__device__ __forceinline__ float bf2f(bf16_t b) { return __uint_as_float((unsigned)b << 16); }
__device__ __forceinline__ float wave_sum(float v) {
#pragma unroll
    for (int o = 1; o < 64; o <<= 1) v += __shfl_xor(v, o);
    return v;
}
__device__ __forceinline__ float fmax2(float a, float b) { return __builtin_amdgcn_fmed3f(a, b, 3.0e38f); }
__device__ __forceinline__ float xsum32(float x) { const auto r = __builtin_amdgcn_permlane32_swap(__float_as_uint(x), __float_as_uint(x), false, false); return __uint_as_float(r[0]) + __uint_as_float(r[1]); }
__device__ __forceinline__ float xsum16(float x) { const auto r = __builtin_amdgcn_permlane16_swap(__float_as_uint(x), __float_as_uint(x), false, false); return __uint_as_float(r[0]) + __uint_as_float(r[1]); }
__device__ __forceinline__ float xmax32(float x) { const auto r = __builtin_amdgcn_permlane32_swap(__float_as_uint(x), __float_as_uint(x), false, false); return fmax2(__uint_as_float(r[0]), __uint_as_float(r[1])); }
__device__ __forceinline__ float xmax16(float x) { const auto r = __builtin_amdgcn_permlane16_swap(__float_as_uint(x), __float_as_uint(x), false, false); return fmax2(__uint_as_float(r[0]), __uint_as_float(r[1])); }
__device__ __forceinline__ float xpartner32(float x, int hh) { const auto r = __builtin_amdgcn_permlane32_swap(__float_as_uint(x), __float_as_uint(x), false, false); return __uint_as_float(hh ? r[0] : r[1]); }
__device__ __forceinline__ float fexp2(float x) { return __builtin_amdgcn_exp2f(x); }
__device__ __forceinline__ float sigmoidf(float x) { return __builtin_amdgcn_rcpf(1.0f + fexp2(-LOG2E * x)); }

struct Params {
    const float* in[18];
    float* out;
    unsigned char* ws;
    int ph_lo, ph_hi;
};
enum { I_X = 0, I_META, I_GMIX, I_WIN, I_WUK, I_WUV, I_WUPA, I_WUPB, I_WO, I_GFFN, I_WGRP, I_BGRP, I_WRT, I_BRT, I_W1, I_W3, I_W2, I_GFIN };

__device__ __forceinline__ const float* h0_row(const Params& p, int row) {
    const int b = row / T, t = row - b * T;
    return t < NMETA ? p.in[I_META] + (size_t)t * D : p.in[I_X] + ((size_t)b * SEQ + (t - NMETA)) * D;
}
template <class F>
__device__ __forceinline__ void tr_item(F val, bf16_t* dst, int ldd, int row0, int k0, float* scr, int lane, int rstep = 1) {
    float tv[32];
#pragma unroll
    for (int i = 0; i < 32; ++i) tv[i] = val(k0 + 2 * i + (lane >> 5), lane & 31);
#pragma unroll
    for (int i = 0; i < 32; ++i) scr[(2 * i + (lane >> 5)) * 33 + (lane & 31)] = tv[i];
    __builtin_amdgcn_s_waitcnt(0xC07F);
    asm volatile("" ::: "memory");
    const int c = lane & 7;
#pragma unroll
    for (int j = 0; j < 4; ++j) {
        const int n = (lane >> 3) + 8 * j; const float* s = scr + (8 * c) * 33 + n;
        u32x4 o; o.x = pk2(s[0], s[33]); o.y = pk2(s[66], s[99]); o.z = pk2(s[132], s[165]); o.w = pk2(s[198], s[231]);
        *(u32x4*)(dst + (size_t)(row0 + n * rstep) * ldd + k0 + 8 * c) = o;
    }
    __builtin_amdgcn_s_waitcnt(0xC07F);
    asm volatile("" ::: "memory");
}

__device__ __forceinline__ void wp_src(int c, int& kind, int& col, int& aux, float& scale) {
    kind = 1; aux = 0; scale = 1.f; col = 0;
    if (c < 512) { col = c; scale = QSCALE; }
    else if (c < C_QF) { col = c; }
    else if (c < C_KV) { const int r = c - C_QF, h = r / QFW, j = r % QFW; scale = QSCALE;
        if (j < 128) { kind = 2; col = h; aux = j; } else { const int i = j - 128; col = 1536 + 64 * h + (i >> 1) + 8 * (i & 1); } }
    else if (c < C_QI) { const int j = c - C_KV; if (j < 128) col = 2048 + j; else { const int i = j - 128; col = 2176 + (i >> 1) + 8 * (i & 1); } }
    else if (c < C_KI) { const int r = c - C_QI, h = r >> 6, j = r & 63; col = 2192 + 64 * h + (j < 16 ? (j >> 1) + 8 * (j & 1) : j); }
    else if (c < C_WI) { const int j = c - C_KI; col = 2704 + (j < 16 ? (j >> 1) + 8 * (j & 1) : j); }
    else if (c < C_END) { col = 2768 + (c - C_WI); }
    else kind = 0;
}

constexpr int IT_WP = (PWN / 32) * 16;
constexpr int IT_WG = 32 * 16;
constexpr int IT_WUA = 32 * 8;
constexpr int IT_WBP = 32 * 16, IT_WO = 32 * 16;
constexpr int IT_W13 = NEXP * 32 * 16;
constexpr int IT_W2 = NEXP * 32 * 8;
constexpr int IT_TOTAL = IT_WP + 2 * IT_WG + IT_WUA + IT_WBP + IT_WO + IT_W13 + IT_W2;

__device__ __forceinline__ void phase_prologue(const Params& p, char* lds) {
    const int tid = threadIdx.x, lane = tid & 63, wave = tid >> 6;
    const int gw = blockIdx.x * NWAVES + wave, NGW = gridDim.x * NWAVES;
    float* scr = (float*)lds + wave * (64 * 33);
    unsigned char* ws = p.ws;
    const float* w_in = p.in[I_WIN];
    {
        float2* cs = (float2*)(ws + WS_CS);
        for (int i = blockIdx.x * NTHREADS + tid; i < T * 8; i += gridDim.x * NTHREADS) {
            const int pos = i >> 3, f = i & 7;
            const float inv = powf(500000.0f, -(float)f / 8.0f);
            const float ang = (float)pos * inv;
            cs[i] = make_float2(cosf(ang), sinf(ang));
        }
    }
    {
        bf16_t* wrt = (bf16_t*)(ws + WS_WRT); const float* wgp = p.in[I_WGRP]; const float* wrp = p.in[I_WRT];
        for (int i = blockIdx.x * NTHREADS + tid; i < WRT_N * D; i += gridDim.x * NTHREADS) {
            const int nn = i >> 10, k = i & 1023;
            const float w = nn < 4 ? wgp[k * 4 + nn] : nn < 36 ? wrp[k * 32 + (nn - 4)] : 0.f;
            const unsigned hi = f2bf(w); wrt[i] = (bf16_t)hi; wrt[WRT_N * D + i] = (bf16_t)f2bf(w - __uint_as_float(hi << 16));
        }
    }
    for (int it = gw; it < IT_TOTAL; it += NGW) {
        int r = it;
        if (r < IT_WP) {
            const int rg = r / 16, kb = r % 16, c = rg * 32 + (lane & 31);
            int kind, col, aux; float scale; wp_src(c, kind, col, aux, scale);
            const float* w_uk = p.in[I_WUK];
            float wu[48];
#pragma unroll
            for (int n4 = 0; n4 < 12; ++n4) { f32x4 t = (f32x4){0.f, 0.f, 0.f, 0.f}; if (kind == 2) t = *(const f32x4*)(w_uk + ((size_t)col * 128 + aux) * 48 + 4 * n4); wu[4 * n4] = t.x; wu[4 * n4 + 1] = t.y; wu[4 * n4 + 2] = t.z; wu[4 * n4 + 3] = t.w; }
            tr_item([&](int k, int) -> float {
                if (kind == 0) return 0.f;
                if (kind == 1) return scale * w_in[(size_t)k * INW + col];
                const f32x4* wi = (const f32x4*)(w_in + (size_t)k * INW + 1536 + 64 * col + 16);
                float s = 0.f;
#pragma unroll
                for (int n4 = 0; n4 < 12; ++n4) { const f32x4 t = wi[n4]; s += t.x * wu[4 * n4] + t.y * wu[4 * n4 + 1] + t.z * wu[4 * n4 + 2] + t.w * wu[4 * n4 + 3]; }
                return scale * s; }, (bf16_t*)(ws + WS_WP), 1024, rg * 32, kb * 64, scr, lane);
            continue; }
        r -= IT_WP;
        if (r < 2 * IT_WG) {
            const int which = r / IT_WG; r %= IT_WG; const int rg = r / 16, kb = r % 16; const int col0 = (which ? 3800 : 2776) + rg * 32;
            tr_item([&](int k, int n) -> float { return w_in[(size_t)k * INW + col0 + n]; }, (bf16_t*)(ws + WS_WG) + (size_t)which * 1024 * 1024, 1024, rg * 32, kb * 64, scr, lane);
            continue; }
        r -= 2 * IT_WG;
        if (r < IT_WUA) {
            const int rg = r / 8, kb = r % 8; const float* w = p.in[I_WUPA];
            tr_item([&](int k, int n) -> float { return w[(size_t)k * 1024 + rg * 32 + n]; }, (bf16_t*)(ws + WS_WUA), 512, rg * 32, kb * 64, scr, lane);
            continue; }
        r -= IT_WUA;
        if (r < IT_WO) {
            const int rg = r / 16, kb = r % 16; const float* w = p.in[I_WO];
            tr_item([&](int k, int n) -> float { return w[(size_t)k * 1024 + rg * 32 + n]; }, (bf16_t*)(ws + WS_WO), 1024, rg * 32, kb * 64, scr, lane);
            continue; }
        r -= IT_WO;
        if (r < IT_WBP) {
            const int rg = r / 16, kb = r % 16; const float* wuv = p.in[I_WUV]; const float* wub = p.in[I_WUPB];
            const int hB = kb >> 1;
            float bc[64];
#pragma unroll
            for (int d = 0; d < 64; ++d) bc[d] = wub[(size_t)(64 * hB + d) * 1024 + rg * 32 + (lane & 31)];
            tr_item([&](int kk, int) -> float {
                const f32x4* a = (const f32x4*)(wuv + (size_t)kk * 64);
                float s = 0.f;
#pragma unroll
                for (int d4 = 0; d4 < 16; ++d4) { const f32x4 t = a[d4]; s += t.x * bc[4 * d4] + t.y * bc[4 * d4 + 1] + t.z * bc[4 * d4 + 2] + t.w * bc[4 * d4 + 3]; }
                return s; }, (bf16_t*)(ws + WS_WBP), 1024, rg * 32, kb * 64, scr, lane);
            continue; }
        r -= IT_WBP;
        if (r < IT_W13) {
            const int e = r / 512; r %= 512; const int which = r & 1, cg = (r >> 1) & 15, kb = r >> 5;
            const float* w = (which ? p.in[I_W3] : p.in[I_W1]) + (size_t)e * 1024 * 512 + cg * 32;
            tr_item([&](int k, int n) -> float { return w[(size_t)k * 512 + n]; },
                    (bf16_t*)(ws + WS_W13) + (size_t)e * 1024 * 1024, 1024, 2 * cg * 32 + which, kb * 64, scr, lane, 2);
            continue; }
        r -= IT_W13;
        {
            const int e = r / 256; r %= 256; const int rg = r / 8, kb = r % 8;
            const float* w2 = p.in[I_W2] + (size_t)e * 512 * 1024;
            tr_item([&](int k, int n) -> float { return w2[(size_t)k * 1024 + rg * 32 + n]; }, (bf16_t*)(ws + WS_W2) + (size_t)e * 1024 * 512, 512, rg * 32, kb * 64, scr, lane);
        }
    }
    {
        const float* g = p.in[I_GMIX]; bf16_t* U = (bf16_t*)(ws + WS_U);
        f32x4 vn[4];
        if (gw < NTOK) { const f32x4* xr = (const f32x4*)h0_row(p, gw) + lane;
#pragma unroll
            for (int j = 0; j < 4; ++j) vn[j] = xr[64 * j]; }
        for (int row = gw; row < NTOK; row += NGW) {
            f32x4 v[4]; float s = 0.f;
#pragma unroll
            for (int j = 0; j < 4; ++j) v[j] = vn[j];
            if (row + NGW < NTOK) { const f32x4* xr = (const f32x4*)h0_row(p, row + NGW) + lane;
#pragma unroll
                for (int j = 0; j < 4; ++j) vn[j] = xr[64 * j]; }
#pragma unroll
            for (int j = 0; j < 4; ++j) s += (v[j].x * v[j].x + v[j].y * v[j].y) + (v[j].z * v[j].z + v[j].w * v[j].w);
            const float rstd = rsqrtf(wave_sum(s) * (1.f / D) + NORM_EPS);
            u32x2* o = (u32x2*)(U + (size_t)row * D) + lane;
#pragma unroll
            for (int j = 0; j < 4; ++j) { const f32x4 gg = ((const f32x4*)g)[lane + 64 * j];
                u32x2 w; w.x = pk2(v[j].x * rstd * gg.x, v[j].y * rstd * gg.y); w.y = pk2(v[j].z * rstd * gg.z, v[j].w * rstd * gg.w); o[64 * j] = w; }
        }
    }
}

namespace pg8 {
#define PG8_LAS __attribute__((address_space(3)))
typedef unsigned short bf16_t;
typedef short bf16x8 __attribute__((ext_vector_type(8)));
typedef float f32x4 __attribute__((ext_vector_type(4)));
typedef unsigned u32x4 __attribute__((ext_vector_type(4)));
constexpr int BM = 256, BK = 64, HALF = 128, HTB = HALF * BK * 2  , STAGE_BYTES = 8 * HTB, NXCD = 8, WGM = 8;

__host__ __device__ __forceinline__ int lds_byte(int r, int c) { const int st = (r >> 4) * 2 + (c >> 5), rr = r & 15, cc = c & 31, ob = rr * 64 + cc * 2; return st * 1024 + (ob ^ (((ob >> 9) & 1) << 5)); }
__host__ __device__ __forceinline__ void stage_rc(int b, int& R, int& C) { const int st = b / 1024, sb = b % 1024, swz = sb ^ (((sb >> 9) & 1) << 5); R = (st >> 1) * 16 + swz / 64; C = (st & 1) * 32 + (swz % 64) / 2; }
__host__ __device__ __forceinline__ int perm32(int rho) { const int n = rho >> 4, i = rho & 15; return 8 * (i >> 2) + 4 * n + (i & 3); }

struct Unit { int pm, pn; };
struct Gemm { const bf16_t* A; const bf16_t* Bt; int M, N, K; };

struct StaticOrder {
    int nM, nN, nwg, G, c;
    __host__ __device__ void init(int M, int N, int G_, int c_) { nM = M / BM; nN = N / BM; nwg = nM * nN; G = G_; c = c_; }
    __host__ __device__ bool next(int i, Unit& u) const {
        const long L = (long)i * G + c; if (L >= nwg) return false;
        int wgid = (int)L; { const int q = nwg / NXCD, r = nwg % NXCD, xcd = wgid % NXCD, off = wgid / NXCD; wgid = (xcd < r ? xcd * (q + 1) : r * (q + 1) + (xcd - r) * q) + off; }
        const int nig = WGM * nN, gid = wgid / nig, fm = gid * WGM, gsz = (nM - fm) < WGM ? (nM - fm) : WGM;
        u.pm = fm + ((wgid % nig) % gsz); u.pn = (wgid % nig) / gsz; return true;
    }
    __device__ __forceinline__ void a_ready(const Unit&) const {}
    __device__ __forceinline__ void done(const Unit&) const {}
};


#define PG8_FOR_FRAGS(...) _Pragma("unroll") for (int ai = 0; ai < 2; ++ai) _Pragma("unroll") for (int m = 0; m < 4; ++m) { const int row = u.pm * BM + ai * HALF + wr * 64 + m * 16 + fr; \
    _Pragma("unroll") for (int bj = 0; bj < 2; ++bj) _Pragma("unroll") for (int n = 0; n < 2; ++n) { const int col = u.pn * BM + bj * HALF + wc * 32 + n * 16 + 4 * fq; ::f32x4 v = acc[ai][bj][m][n]; __VA_ARGS__ } }
__device__ __forceinline__ bool rope_off(int c, int& o) {
    if (c < C_QF) return false;
    if (c < C_KV) { const int j = (c - C_QF) % QFW; o = j - 128; return j >= 128; }
    if (c < C_QI) { const int j = c - C_KV; o = j - 128; return j >= 128; }
    if (c < C_KI) { const int j = (c - C_QI) & 63; o = j; return j < 16; }
    if (c < C_WI) { const int j = c - C_KI; o = j; return j < 16; }
    return false;
}
#define PG8_FOR_FRAGS8(...) _Pragma("unroll") for (int ai = 0; ai < 2; ++ai) _Pragma("unroll") for (int m = 0; m < 4; ++m) { const int row = u.pm * BM + ai * HALF + wr * 64 + m * 16 + fr; \
    _Pragma("unroll") for (int bj = 0; bj < 2; ++bj) { const int col = u.pn * BM + bj * HALF + wc * 32 + 8 * fq; ::f32x4 v0 = acc[ai][bj][m][0], v1 = acc[ai][bj][m][1]; __VA_ARGS__ } }
struct EpiInproj {
    static constexpr bool PERM = true, AFTER_DRAIN = false;
    bf16_t* P; const float2* cs; unsigned char* KIP;
    __device__ __forceinline__ void operator()(const f32x4 (&acc)[2][2][4][2], const Unit& u, int wr, int wc, int fr, int fq) const {
        PG8_FOR_FRAGS8(
            if (col < PW) {
                int o; const int trow = tokrow(row);
                if (rope_off(col, o)) {
                    const int pos = (row % SEQ) + NMETA; const float2* cp = cs + pos * 8 + (o >> 1); const float2 c0 = cp[0], c1 = cp[1], c2 = cp[2], c3 = cp[3];
                    v0 = (::f32x4){v0.x * c0.x - v0.y * c0.y, v0.y * c0.x + v0.x * c0.y, v0.z * c1.x - v0.w * c1.y, v0.w * c1.x + v0.z * c1.y};
                    v1 = (::f32x4){v1.x * c2.x - v1.y * c2.y, v1.y * c2.x + v1.x * c2.y, v1.z * c3.x - v1.w * c3.y, v1.w * c3.x + v1.z * c3.y};
                }
                ::u32x4 w; w.x = pk2(v0.x, v0.y); w.y = pk2(v0.z, v0.w); w.z = pk2(v1.x, v1.y); w.w = pk2(v1.z, v1.w);
                if (col >= C_KI && col < C_WI) {
                    const int b = row / SEQ, t = row - b * SEQ + NMETA, d0 = col - C_KI;
                    *(::u32x4*)(KIP + (size_t)b * KIP_BATCH + (size_t)((((t >> 5) * 4 + (d0 >> 4)) * 2 + ((d0 >> 3) & 1)) * 512 + (t & 31) * 16)) = w;
                } else *(::u32x4*)(P + (size_t)trow * PW + col) = w;
            })
    }
};
struct EpiGate {
    static constexpr bool PERM = true, AFTER_DRAIN = false;
    bf16_t* G;
    __device__ __forceinline__ void operator()(const f32x4 (&acc)[2][2][4][2], const Unit& u, int wr, int wc, int fr, int fq) const {
        PG8_FOR_FRAGS8( ::u32x4 w; w.x = pk2(sigmoidf(v0.x), sigmoidf(v0.y)); w.y = pk2(sigmoidf(v0.z), sigmoidf(v0.w)); w.z = pk2(sigmoidf(v1.x), sigmoidf(v1.y)); w.w = pk2(sigmoidf(v1.z), sigmoidf(v1.w));
            *(::u32x4*)(G + (size_t)row * 2048 + col) = w; )
    }
};
template <bool ACCUM> struct EpiZ {
    static constexpr bool PERM = true, AFTER_DRAIN = false;
    bf16_t* Z; const bf16_t* G; int goff;
    __device__ __forceinline__ void operator()(const f32x4 (&acc)[2][2][4][2], const Unit& u, int wr, int wc, int fr, int fq) const {
        PG8_FOR_FRAGS8(
            const ::u32x4 g = *(const ::u32x4*)(G + (size_t)row * 2048 + goff + col);
            ::f32x4 z0 = (::f32x4){bflo(g.x) * v0.x, bfhi(g.x) * v0.y, bflo(g.y) * v0.z, bfhi(g.y) * v0.w}, z1 = (::f32x4){bflo(g.z) * v1.x, bfhi(g.z) * v1.y, bflo(g.w) * v1.z, bfhi(g.w) * v1.w};
            ::u32x4* zp = (::u32x4*)(Z + (size_t)row * D + col);
            if (ACCUM) { const ::u32x4 o = *zp; z0.x += bflo(o.x); z0.y += bfhi(o.x); z0.z += bflo(o.y); z0.w += bfhi(o.y); z1.x += bflo(o.z); z1.y += bfhi(o.z); z1.z += bflo(o.w); z1.w += bfhi(o.w); }
            ::u32x4 w; w.x = pk2(z0.x, z0.y); w.y = pk2(z0.z, z0.w); w.z = pk2(z1.x, z1.y); w.w = pk2(z1.z, z1.w); *zp = w; )
    }
};
struct EpiH1 {
    static constexpr bool PERM = true, AFTER_DRAIN = false;
    float* H1; const float* meta; const float* x;
    __device__ __forceinline__ void operator()(const f32x4 (&acc)[2][2][4][2], const Unit& u, int wr, int wc, int fr, int fq) const {
        PG8_FOR_FRAGS8( const float* xp = x + (size_t)row * D + col; float* hp = H1 + (size_t)row * D + col; const ::f32x4 h0 = *(const ::f32x4*)xp, h1 = *(const ::f32x4*)(xp + 4);
            *(::f32x4*)hp = h0 + v0; *(::f32x4*)(hp + 4) = h1 + v1; )
    }
};
#undef PG8_FOR_FRAGS
#undef PG8_FOR_FRAGS8

template <class Epi, class Sched, bool ALIGN_EPI = false, bool SP2 = false>
__device__ __forceinline__ void gemm_phase(PG8_LAS unsigned char* lds, const Gemm g, const Sched& S, const Epi& E) {
    const int tid = threadIdx.x, wid = __builtin_amdgcn_readfirstlane(tid >> 6), lane = tid & 63, wr = wid >> 2, wc = wid & 3, fr = lane & 15, fq = lane >> 4;
    const int K = g.K, nt = K / BK;
    unsigned voffA[2], voffB[2];
#pragma unroll
    for (int i = 0; i < 2; ++i) { int R, C; stage_rc(tid * 16 + i * 8192, R, C); const int Rb = Epi::PERM ? ((R & ~31) + perm32(R & 31)) : R;
        voffA[i] = (unsigned)(R * K + C) * 2u; voffB[i] = (unsigned)(Rb * K + C) * 2u; }
    const size_t kstep = (size_t)(BK * 2);
    const size_t hstep = (size_t)HALF * K * 2;
    const size_t tstep = 2 * hstep;
    const unsigned ldsw = (unsigned)wid * 1024u;
    const int aoff = lds_byte(wr * 64 + fr, fq * 8), boff = lds_byte(wc * 32 + fr, fq * 8);
#define PG8_SA(b, h) (((b) * 2 + (h)) * HTB)
#define PG8_SB(b, h) ((4 + (b) * 2 + (h)) * HTB)
#define PG8_STAGE(bufoff, gbase, voff) do { _Pragma("unroll") for (int _i = 0; _i < 2; ++_i) \
        __builtin_amdgcn_global_load_lds((const unsigned*)((const char*)(gbase) + (voff)[_i]), (PG8_LAS unsigned*)(lds + (bufoff) + ldsw + _i * 8192), 16, 0, 0); } while (0)
#define PG8_LDA(dst, b, h) do { _Pragma("unroll") for (int m = 0; m < 4; ++m) _Pragma("unroll") for (int k = 0; k < 2; ++k) dst[m][k] = *(const PG8_LAS bf16x8*)(lds + PG8_SA(b, h) + aoff + m * 2048 + k * 1024); } while (0)
#define PG8_LDB(dst, b, h) do { _Pragma("unroll") for (int n = 0; n < 2; ++n) _Pragma("unroll") for (int k = 0; k < 2; ++k) dst[n][k] = *(const PG8_LAS bf16x8*)(lds + PG8_SB(b, h) + boff + n * 2048 + k * 1024); } while (0)
#define PG8_MMA(ai, bj, At, Bt) do { __builtin_amdgcn_s_setprio(1); _Pragma("unroll") for (int m = 0; m < 4; ++m) _Pragma("unroll") for (int n = 0; n < 2; ++n) _Pragma("unroll") for (int k = 0; k < 2; ++k) \
        acc[ai][bj][m][n] = __builtin_amdgcn_mfma_f32_16x16x32_bf16(Bt[n][k], At[m][k], acc[ai][bj][m][n], 0, 0, 0); __builtin_amdgcn_s_setprio(0); } while (0)
#define PG8_WAIT_V(n) asm volatile("s_waitcnt vmcnt(" #n ")" ::: "memory")
#define PG8_WAIT_L(n) asm volatile("s_waitcnt lgkmcnt(" #n ")" ::: "memory")
#define PG8_BAR __builtin_amdgcn_s_barrier()
#define PG8_SCHED __builtin_amdgcn_sched_barrier(0)
    Unit cur, nxt; int ui = 0;
    if (!S.next(0, cur)) return;
    f32x4 acc[2][2][4][2];
#pragma unroll
    for (int a = 0; a < 2; ++a)
#pragma unroll
        for (int b = 0; b < 2; ++b)
#pragma unroll
            for (int m = 0; m < 4; ++m)
#pragma unroll
                for (int n = 0; n < 2; ++n) acc[a][b][m][n] = (f32x4){0.f, 0.f, 0.f, 0.f};
    bf16x8 At[4][2], B0[2][2], B1[2][2];
    const char* cA = (const char*)g.A + (size_t)cur.pm * tstep; const char* cB = (const char*)g.Bt + (size_t)cur.pn * tstep;
    S.a_ready(cur);
    if constexpr (SP2) {
        PG8_STAGE(PG8_SB(0, 0), cB, voffB); PG8_STAGE(PG8_SB(0, 1), cB + hstep, voffB); PG8_STAGE(PG8_SA(0, 0), cA, voffA); PG8_STAGE(PG8_SA(0, 1), cA + hstep, voffA);
        if (wr == 1) PG8_BAR;
        PG8_WAIT_V(2); PG8_BAR;
        PG8_STAGE(PG8_SB(1, 0), cB + kstep, voffB); PG8_STAGE(PG8_SA(1, 0), cA + kstep, voffA); PG8_STAGE(PG8_SB(1, 1), cB + hstep + kstep, voffB);
        PG8_WAIT_V(6); PG8_BAR;
    } else {
        PG8_STAGE(PG8_SB(0, 0), cB, voffB); PG8_STAGE(PG8_SA(0, 0), cA, voffA); PG8_STAGE(PG8_SB(0, 1), cB + hstep, voffB); PG8_STAGE(PG8_SA(0, 1), cA + hstep, voffA);
        if (wr == 1) PG8_BAR;
        PG8_WAIT_V(4); PG8_BAR;
        PG8_STAGE(PG8_SB(1, 0), cB + kstep, voffB); PG8_STAGE(PG8_SA(1, 0), cA + kstep, voffA); PG8_STAGE(PG8_SB(1, 1), cB + hstep + kstep, voffB);
        PG8_WAIT_V(6); PG8_BAR;
    }
    for (;;) {
        const bool has_next = S.next(ui + 1, nxt);
        const char* nA = has_next ? (const char*)g.A + (size_t)nxt.pm * tstep : cA; const char* nB = has_next ? (const char*)g.Bt + (size_t)nxt.pn * tstep : cB;
        for (int t = 0; t < nt; t += 2) {
            const bool last = (t == nt - 2);
            const char* a1 = cA + (size_t)(t + 1) * kstep;
            const char* a2 = last ? nA : cA + (size_t)(t + 2) * kstep; const char* b2 = last ? nB : cB + (size_t)(t + 2) * kstep;
            const char* a3 = a2 + kstep; const char* b3 = b2 + kstep;
            if (last && has_next) S.a_ready(nxt);
            if constexpr (SP2) {
            PG8_LDB(B0, 0, 0); PG8_LDB(B1, 0, 1); PG8_SCHED; PG8_LDA(At, 0, 0); PG8_STAGE(PG8_SA(1, 1), a1 + hstep, voffA);
            PG8_WAIT_V(8); PG8_WAIT_L(0); PG8_BAR; PG8_MMA(0, 0, At, B0); PG8_MMA(0, 1, At, B1); PG8_BAR; PG8_SCHED;
            PG8_LDA(At, 0, 1); PG8_STAGE(PG8_SB(0, 0), b2, voffB); PG8_STAGE(PG8_SB(0, 1), b2 + hstep, voffB); PG8_STAGE(PG8_SA(0, 0), a2, voffA);
            PG8_WAIT_V(8); PG8_WAIT_L(0); PG8_BAR; PG8_MMA(1, 0, At, B0); PG8_MMA(1, 1, At, B1); PG8_BAR; PG8_SCHED;
            PG8_LDB(B0, 1, 0); PG8_LDB(B1, 1, 1); PG8_SCHED; PG8_LDA(At, 1, 0); PG8_STAGE(PG8_SA(0, 1), a2 + hstep, voffA);
            PG8_WAIT_V(8); PG8_WAIT_L(0); PG8_BAR; PG8_MMA(0, 0, At, B0); PG8_MMA(0, 1, At, B1); PG8_BAR; PG8_SCHED;
            PG8_LDA(At, 1, 1); PG8_STAGE(PG8_SB(1, 0), b3, voffB); PG8_STAGE(PG8_SB(1, 1), b3 + hstep, voffB); PG8_STAGE(PG8_SA(1, 0), a3, voffA);
            PG8_WAIT_V(8); PG8_WAIT_L(0); PG8_BAR; PG8_MMA(1, 0, At, B0); PG8_MMA(1, 1, At, B1); PG8_BAR; PG8_SCHED;
            } else {
            PG8_LDB(B0, 0, 0); PG8_SCHED; PG8_LDA(At, 0, 0); PG8_STAGE(PG8_SA(1, 1), a1 + hstep, voffA);
            PG8_WAIT_L(8); PG8_BAR; PG8_WAIT_L(0); PG8_MMA(0, 0, At, B0); PG8_BAR; PG8_SCHED;
            PG8_LDB(B1, 0, 1); PG8_STAGE(PG8_SB(0, 0), b2, voffB);
            PG8_BAR; PG8_WAIT_L(0); PG8_MMA(0, 1, At, B1); PG8_BAR;
            PG8_LDA(At, 0, 1); PG8_STAGE(PG8_SA(0, 0), a2, voffA);
            PG8_BAR; PG8_WAIT_L(0); PG8_MMA(1, 0, At, B0); PG8_BAR; PG8_SCHED;
            PG8_STAGE(PG8_SB(0, 1), b2 + hstep, voffB);
            PG8_WAIT_V(6); PG8_BAR; PG8_MMA(1, 1, At, B1); PG8_BAR;
            PG8_LDB(B0, 1, 0); PG8_SCHED; PG8_LDA(At, 1, 0); PG8_STAGE(PG8_SA(0, 1), a2 + hstep, voffA);
            PG8_WAIT_L(8); PG8_BAR; PG8_WAIT_L(0); PG8_MMA(0, 0, At, B0); PG8_BAR; PG8_SCHED;
            PG8_LDB(B1, 1, 1); PG8_STAGE(PG8_SB(1, 0), b3, voffB);
            PG8_BAR; PG8_WAIT_L(0); PG8_MMA(0, 1, At, B1); PG8_BAR;
            PG8_LDA(At, 1, 1); PG8_STAGE(PG8_SA(1, 0), a3, voffA);
            PG8_BAR; PG8_WAIT_L(0); PG8_MMA(1, 0, At, B0); PG8_BAR; PG8_SCHED;
            PG8_STAGE(PG8_SB(1, 1), b3 + hstep, voffB);
            PG8_WAIT_V(6); PG8_BAR; PG8_MMA(1, 1, At, B1); PG8_BAR;
            }
        }
        if constexpr (ALIGN_EPI) { if (wr == 0) PG8_BAR; }
        if constexpr (!Epi::AFTER_DRAIN) { E(acc, cur, wr, wc, fr, fq); S.done(cur); }
        if (!has_next) break;
#pragma unroll
        for (int a = 0; a < 2; ++a)
#pragma unroll
            for (int b = 0; b < 2; ++b)
#pragma unroll
                for (int m = 0; m < 4; ++m)
#pragma unroll
                    for (int n = 0; n < 2; ++n) acc[a][b][m][n] = (f32x4){0.f, 0.f, 0.f, 0.f};
        cur = nxt; cA = nA; cB = nB; ++ui;
        if constexpr (ALIGN_EPI) { if (wr == 1) PG8_BAR; }
    }
    PG8_WAIT_V(0);
    if constexpr (!ALIGN_EPI) { if (wr == 0) PG8_BAR; }
    PG8_BAR;
    if constexpr (Epi::AFTER_DRAIN) { E.fused(acc, cur, wr, wc, fr, fq, lds, wid, lane); S.done(cur); }
#undef PG8_SA
#undef PG8_SB
#undef PG8_STAGE
#undef PG8_LDA
#undef PG8_LDB
#undef PG8_MMA
#undef PG8_WAIT_V
#undef PG8_WAIT_L
#undef PG8_BAR
#undef PG8_SCHED
}
__device__ __forceinline__ void gemm_phase_zf(PG8_LAS unsigned char* lds, const bf16_t* Ap1, const bf16_t* Bp1, const bf16_t* Ap2, const bf16_t* Bp2, const StaticOrder& S, const bf16_t* G, bf16_t* Z) {
    const int tid = threadIdx.x, wid = __builtin_amdgcn_readfirstlane(tid >> 6), lane = tid & 63, wr = wid >> 2, wc = wid & 3, fr = lane & 15, fq = lane >> 4;
    constexpr int K1 = 512, K2 = 1024, NT1 = K1 / BK, NT = (K1 + K2) / BK;
    unsigned vA[2], vB[2]; unsigned c2 = 0u;
#pragma unroll
    for (int i = 0; i < 2; ++i) { int R, C; stage_rc(tid * 16 + i * 8192, R, C); const int Rb = (R & ~31) + perm32(R & 31);
        vA[i] = (unsigned)(R * K1 + C) * 2u; vB[i] = (unsigned)(Rb * K1 + C) * 2u; c2 = (unsigned)C * 2u; }
    constexpr size_t kstep = (size_t)(BK * 2), hs1 = (size_t)HALF * K1 * 2, hs2 = (size_t)HALF * K2 * 2, ts1 = 2 * hs1, ts2 = 2 * hs2;
    const unsigned ldsw = (unsigned)wid * 1024u;
    const int aoff = lds_byte(wr * 64 + fr, fq * 8), boff = lds_byte(wc * 32 + fr, fq * 8);
#define PG8_SA(b, h) (((b) * 2 + (h)) * HTB)
#define PG8_SB(b, h) ((4 + (b) * 2 + (h)) * HTB)
#define PG8_STAGE(bufoff, gbase, voff) do { _Pragma("unroll") for (int _i = 0; _i < 2; ++_i) { unsigned o_ = (voff)[_i]; asm volatile("" : "+v"(o_));   \
        __builtin_amdgcn_global_load_lds((const unsigned*)((const char*)(gbase) + o_), (PG8_LAS unsigned*)(lds + (bufoff) + ldsw + _i * 8192), 16, 0, 0); } } while (0)
#define PG8_LDA(dst, b, h) do { _Pragma("unroll") for (int m = 0; m < 4; ++m) _Pragma("unroll") for (int k = 0; k < 2; ++k) dst[m][k] = *(const PG8_LAS bf16x8*)(lds + PG8_SA(b, h) + aoff + m * 2048 + k * 1024); } while (0)
#define PG8_LDB(dst, b, h) do { _Pragma("unroll") for (int n = 0; n < 2; ++n) _Pragma("unroll") for (int k = 0; k < 2; ++k) dst[n][k] = *(const PG8_LAS bf16x8*)(lds + PG8_SB(b, h) + boff + n * 2048 + k * 1024); } while (0)
#define PG8_MMA(ai, bj, At, Bt) do { __builtin_amdgcn_s_setprio(1); _Pragma("unroll") for (int m = 0; m < 4; ++m) _Pragma("unroll") for (int n = 0; n < 2; ++n) _Pragma("unroll") for (int k = 0; k < 2; ++k) \
        acc[ai][bj][m][n] = __builtin_amdgcn_mfma_f32_16x16x32_bf16(Bt[n][k], At[m][k], acc[ai][bj][m][n], 0, 0, 0); __builtin_amdgcn_s_setprio(0); } while (0)
#define PG8_WAIT_V(n) asm volatile("s_waitcnt vmcnt(" #n ")" ::: "memory")
#define PG8_WAIT_L(n) asm volatile("s_waitcnt lgkmcnt(" #n ")" ::: "memory")
#define PG8_BAR __builtin_amdgcn_s_barrier()
#define PG8_SCHED __builtin_amdgcn_sched_barrier(0)
#define PG8_ZBODY(A1H, O1, A2P, B2P, HS2, OA2, OB2) do { \
        PG8_LDB(B0, 0, 0); PG8_LDB(B1, 0, 1); PG8_SCHED; PG8_LDA(At, 0, 0); PG8_STAGE(PG8_SA(1, 1), (A1H), O1); \
        PG8_WAIT_V(8); PG8_WAIT_L(0); PG8_BAR; PG8_MMA(0, 0, At, B0); PG8_MMA(0, 1, At, B1); PG8_BAR; PG8_SCHED; \
        PG8_LDA(At, 0, 1); PG8_STAGE(PG8_SB(0, 0), (B2P), OB2); PG8_STAGE(PG8_SB(0, 1), (B2P) + (HS2), OB2); PG8_STAGE(PG8_SA(0, 0), (A2P), OA2); \
        PG8_WAIT_V(8); PG8_WAIT_L(0); PG8_BAR; PG8_MMA(1, 0, At, B0); PG8_MMA(1, 1, At, B1); PG8_BAR; PG8_SCHED; \
        PG8_LDB(B0, 1, 0); PG8_LDB(B1, 1, 1); PG8_SCHED; PG8_LDA(At, 1, 0); PG8_STAGE(PG8_SA(0, 1), (A2P) + (HS2), OA2); \
        PG8_WAIT_V(8); PG8_WAIT_L(0); PG8_BAR; PG8_MMA(0, 0, At, B0); PG8_MMA(0, 1, At, B1); PG8_BAR; PG8_SCHED; \
        PG8_LDA(At, 1, 1); PG8_STAGE(PG8_SB(1, 0), (B2P) + kstep, OB2); PG8_STAGE(PG8_SB(1, 1), (B2P) + kstep + (HS2), OB2); PG8_STAGE(PG8_SA(1, 0), (A2P) + kstep, OA2); \
        PG8_WAIT_V(8); PG8_WAIT_L(0); PG8_BAR; PG8_MMA(1, 0, At, B0); PG8_MMA(1, 1, At, B1); PG8_BAR; PG8_SCHED; } while (0)
    Unit cur, nxt; int ui = 0;
    if (!S.next(0, cur)) return;
    f32x4 acc[2][2][4][2];
#pragma unroll
    for (int a = 0; a < 2; ++a)
#pragma unroll
        for (int b = 0; b < 2; ++b)
#pragma unroll
            for (int m = 0; m < 4; ++m)
#pragma unroll
                for (int n = 0; n < 2; ++n) acc[a][b][m][n] = (f32x4){0.f, 0.f, 0.f, 0.f};
    bf16x8 At[4][2], B0[2][2], B1[2][2];
    const char* cA1 = (const char*)Ap1 + (size_t)cur.pm * ts1; const char* cB1 = (const char*)Bp1 + (size_t)cur.pn * ts1;
    PG8_STAGE(PG8_SB(0, 0), cB1, vB); PG8_STAGE(PG8_SB(0, 1), cB1 + hs1, vB); PG8_STAGE(PG8_SA(0, 0), cA1, vA); PG8_STAGE(PG8_SA(0, 1), cA1 + hs1, vA);
    if (wr == 1) PG8_BAR;
    PG8_WAIT_V(2); PG8_BAR;
    PG8_STAGE(PG8_SB(1, 0), cB1 + kstep, vB); PG8_STAGE(PG8_SA(1, 0), cA1 + kstep, vA); PG8_STAGE(PG8_SB(1, 1), cB1 + hs1 + kstep, vB);
    PG8_WAIT_V(6); PG8_BAR;
    for (;;) {
        const bool has_next = S.next(ui + 1, nxt);
        const char* cA2 = (const char*)Ap2 + (size_t)cur.pm * ts2; const char* cB2 = (const char*)Bp2 + (size_t)cur.pn * ts2;
        const char* nA1 = has_next ? (const char*)Ap1 + (size_t)nxt.pm * ts1 : cA1; const char* nB1 = has_next ? (const char*)Bp1 + (size_t)nxt.pn * ts1 : cB1;
        for (int t = 0; t < NT; t += 2) {
            const bool s1 = t < NT1, nx = t + 2 >= NT, f2 = nx || (t + 2 < NT1);
            const char* a1h = s1 ? cA1 + (size_t)(t + 1) * kstep + hs1 : cA2 + (size_t)(t + 1 - NT1) * kstep + hs2;
            const char* a2 = nx ? nA1 : f2 ? cA1 + (size_t)(t + 2) * kstep : cA2 + (size_t)(t + 2 - NT1) * kstep;
            const char* b2 = nx ? nB1 : f2 ? cB1 + (size_t)(t + 2) * kstep : cB2 + (size_t)(t + 2 - NT1) * kstep;
            const size_t hsx = f2 ? hs1 : hs2;
            const unsigned sh1 = s1 ? 0u : 1u, m1 = s1 ? 0u : ~0u, sh2 = f2 ? 0u : 1u, m2 = f2 ? 0u : ~0u;
            unsigned o1[2], oa2[2], ob2[2];
#pragma unroll
            for (int i = 0; i < 2; ++i) { o1[i] = (vA[i] << sh1) - (c2 & m1); oa2[i] = (vA[i] << sh2) - (c2 & m2); ob2[i] = (vB[i] << sh2) - (c2 & m2); }
            if (nx && has_next) S.a_ready(nxt);
            PG8_ZBODY(a1h, o1, a2, b2, hsx, oa2, ob2);
            if (t == NT1 - 2) {
            {
    #pragma unroll
                for (int ai = 0; ai < 2; ++ai)
    #pragma unroll
                    for (int m = 0; m < 4; ++m) { const int row = cur.pm * BM + ai * HALF + wr * 64 + m * 16 + fr;
    #pragma unroll
                        for (int bj = 0; bj < 2; ++bj) { const int col = cur.pn * BM + bj * HALF + wc * 32 + 8 * fq;
                            const ::u32x4 ga = *(const ::u32x4*)(G + (size_t)row * 2048 + col), gb = *(const ::u32x4*)(G + (size_t)row * 2048 + 1024 + col);
    #define PG8_RT(a_, b_) ((a_) * __builtin_amdgcn_rcpf(__builtin_amdgcn_fmed3f((b_), 1e-30f, 3.0e38f)))
                            const ::f32x4 r0 = (::f32x4){PG8_RT(bflo(ga.x), bflo(gb.x)), PG8_RT(bfhi(ga.x), bfhi(gb.x)), PG8_RT(bflo(ga.y), bflo(gb.y)), PG8_RT(bfhi(ga.y), bfhi(gb.y))};
                            const ::f32x4 r1 = (::f32x4){PG8_RT(bflo(ga.z), bflo(gb.z)), PG8_RT(bfhi(ga.z), bfhi(gb.z)), PG8_RT(bflo(ga.w), bflo(gb.w)), PG8_RT(bfhi(ga.w), bfhi(gb.w))};
                            acc[ai][bj][m][0] *= r0; acc[ai][bj][m][1] *= r1;
    #undef PG8_RT
                        }
                        PG8_SCHED; }
                PG8_SCHED;
            }
            }
        }
        if (wr == 0) PG8_BAR;
        {
#pragma unroll
            for (int ai = 0; ai < 2; ++ai)
#pragma unroll
                for (int m = 0; m < 4; ++m) { const int row = cur.pm * BM + ai * HALF + wr * 64 + m * 16 + fr;
#pragma unroll
                    for (int bj = 0; bj < 2; ++bj) { const int col = cur.pn * BM + bj * HALF + wc * 32 + 8 * fq;
                        const ::u32x4 gb = *(const ::u32x4*)(G + (size_t)row * 2048 + 1024 + col); const ::f32x4 v0 = acc[ai][bj][m][0], v1 = acc[ai][bj][m][1];
#define PG8_GC(b_) __builtin_amdgcn_fmed3f((b_), 1e-30f, 3.0e38f)
                        ::u32x4 w; w.x = pk2(v0.x * PG8_GC(bflo(gb.x)), v0.y * PG8_GC(bfhi(gb.x))); w.y = pk2(v0.z * PG8_GC(bflo(gb.y)), v0.w * PG8_GC(bfhi(gb.y)));
                        w.z = pk2(v1.x * PG8_GC(bflo(gb.z)), v1.y * PG8_GC(bfhi(gb.z))); w.w = pk2(v1.z * PG8_GC(bflo(gb.w)), v1.w * PG8_GC(bfhi(gb.w)));
#undef PG8_GC
                        *(::u32x4*)(Z + (size_t)row * D + col) = w; } }
        }
        if (!has_next) break;
#pragma unroll
        for (int a = 0; a < 2; ++a)
#pragma unroll
            for (int b = 0; b < 2; ++b)
#pragma unroll
                for (int m = 0; m < 4; ++m)
#pragma unroll
                    for (int n = 0; n < 2; ++n) acc[a][b][m][n] = (f32x4){0.f, 0.f, 0.f, 0.f};
        cur = nxt; cA1 = nA1; cB1 = nB1; ++ui;
        if (wr == 1) PG8_BAR;
    }
    PG8_WAIT_V(0);
    PG8_BAR;
#undef PG8_ZBODY
#undef PG8_SA
#undef PG8_SB
#undef PG8_STAGE
#undef PG8_LDA
#undef PG8_LDB
#undef PG8_MMA
#undef PG8_WAIT_V
#undef PG8_WAIT_L
#undef PG8_BAR
#undef PG8_SCHED
}
template <class Epi, class Sched, bool ALIGN_EPI = false, bool SP2 = false>
__device__ __forceinline__ void gemm_phase_x(PG8_LAS unsigned char* lds, const int K, const Sched& S, const Epi& E) {
    const int tid = threadIdx.x, wid = __builtin_amdgcn_readfirstlane(tid >> 6), lane = tid & 63, wr = wid >> 2, wc = wid & 3, fr = lane & 15, fq = lane >> 4;
    const int nt = K / BK;
    unsigned vcA[2][2], vnA[2][2], voffB[2];
#pragma unroll
    for (int i = 0; i < 2; ++i) { int R, C; stage_rc(tid * 16 + i * 8192, R, C); const int Rb = Epi::PERM ? ((R & ~31) + perm32(R & 31)) : R;
        voffB[i] = (unsigned)(Rb * K + C) * 2u; }
    const size_t kstep = (size_t)(BK * 2);
    const size_t hstep = (size_t)HALF * K * 2;
    const unsigned ldsw = (unsigned)wid * 1024u;
    const int aoff = lds_byte(wr * 64 + fr, fq * 8), boff = lds_byte(wc * 32 + fr, fq * 8);
#define PG8_SA(b, h) (((b) * 2 + (h)) * HTB)
#define PG8_SB(b, h) ((4 + (b) * 2 + (h)) * HTB)
#define PG8_STAGE(bufoff, gbase, voff) do { _Pragma("unroll") for (int _i = 0; _i < 2; ++_i) \
        __builtin_amdgcn_global_load_lds((const unsigned*)((const char*)(gbase) + (voff)[_i]), (PG8_LAS unsigned*)(lds + (bufoff) + ldsw + _i * 8192), 16, 0, 0); } while (0)
#define PG8_STAGEA(bufoff, gbase, V, h) do { _Pragma("unroll") for (int _i = 0; _i < 2; ++_i) \
        __builtin_amdgcn_global_load_lds((const unsigned*)((const char*)(gbase) + (V)[h][_i]), (PG8_LAS unsigned*)(lds + (bufoff) + ldsw + _i * 8192), 16, 0, 0); } while (0)
#define PG8_STAGEA2(bufoff, gbase, h) do { _Pragma("unroll") for (int _i = 0; _i < 2; ++_i) \
        __builtin_amdgcn_global_load_lds((const unsigned*)((const char*)(gbase) + (last ? vnA[h][_i] : vcA[h][_i])), (PG8_LAS unsigned*)(lds + (bufoff) + ldsw + _i * 8192), 16, 0, 0); } while (0)
#define PG8_AOFF(V, u) do { _Pragma("unroll") for (int _h = 0; _h < 2; ++_h) _Pragma("unroll") for (int _i = 0; _i < 2; ++_i) { int R_, C_; stage_rc(tid * 16 + _i * 8192, R_, C_); (V)[_h][_i] = S.a_off(u, _h * HALF + R_, C_); } } while (0)
#define PG8_LDA(dst, b, h) do { _Pragma("unroll") for (int m = 0; m < 4; ++m) _Pragma("unroll") for (int k = 0; k < 2; ++k) dst[m][k] = *(const PG8_LAS bf16x8*)(lds + PG8_SA(b, h) + aoff + m * 2048 + k * 1024); } while (0)
#define PG8_LDB(dst, b, h) do { _Pragma("unroll") for (int n = 0; n < 2; ++n) _Pragma("unroll") for (int k = 0; k < 2; ++k) dst[n][k] = *(const PG8_LAS bf16x8*)(lds + PG8_SB(b, h) + boff + n * 2048 + k * 1024); } while (0)
#define PG8_MMA(ai, bj, At, Bt) do { __builtin_amdgcn_s_setprio(1); _Pragma("unroll") for (int m = 0; m < 4; ++m) _Pragma("unroll") for (int n = 0; n < 2; ++n) _Pragma("unroll") for (int k = 0; k < 2; ++k) \
        acc[ai][bj][m][n] = __builtin_amdgcn_mfma_f32_16x16x32_bf16(Bt[n][k], At[m][k], acc[ai][bj][m][n], 0, 0, 0); __builtin_amdgcn_s_setprio(0); } while (0)
#define PG8_WAIT_V(n) asm volatile("s_waitcnt vmcnt(" #n ")" ::: "memory")
#define PG8_WAIT_L(n) asm volatile("s_waitcnt lgkmcnt(" #n ")" ::: "memory")
#define PG8_BAR __builtin_amdgcn_s_barrier()
#define PG8_SCHED __builtin_amdgcn_sched_barrier(0)
    Unit cur, nxt; int ui = 0;
    if (!S.next(0, cur)) return;
    f32x4 acc[2][2][4][2];
#pragma unroll
    for (int a = 0; a < 2; ++a)
#pragma unroll
        for (int b = 0; b < 2; ++b)
#pragma unroll
            for (int m = 0; m < 4; ++m)
#pragma unroll
                for (int n = 0; n < 2; ++n) acc[a][b][m][n] = (f32x4){0.f, 0.f, 0.f, 0.f};
    bf16x8 At[4][2], B0[2][2], B1[2][2];
    const char* cA = S.a_base(cur); const char* cB = S.b_base(cur);
    PG8_AOFF(vcA, cur);
    S.a_ready(cur);
    if constexpr (SP2) {
        PG8_STAGE(PG8_SB(0, 0), cB, voffB); PG8_STAGE(PG8_SB(0, 1), cB + hstep, voffB); PG8_STAGEA(PG8_SA(0, 0), cA, vcA, 0); PG8_STAGEA(PG8_SA(0, 1), cA, vcA, 1);
        if (wr == 1) PG8_BAR;
        PG8_WAIT_V(2); PG8_BAR;
        PG8_STAGE(PG8_SB(1, 0), cB + kstep, voffB); PG8_STAGEA(PG8_SA(1, 0), cA + kstep, vcA, 0); PG8_STAGE(PG8_SB(1, 1), cB + hstep + kstep, voffB);
        PG8_WAIT_V(6); PG8_BAR;
    } else {
        PG8_STAGE(PG8_SB(0, 0), cB, voffB); PG8_STAGEA(PG8_SA(0, 0), cA, vcA, 0); PG8_STAGE(PG8_SB(0, 1), cB + hstep, voffB); PG8_STAGEA(PG8_SA(0, 1), cA, vcA, 1);
        if (wr == 1) PG8_BAR;
        PG8_WAIT_V(4); PG8_BAR;
        PG8_STAGE(PG8_SB(1, 0), cB + kstep, voffB); PG8_STAGEA(PG8_SA(1, 0), cA + kstep, vcA, 0); PG8_STAGE(PG8_SB(1, 1), cB + hstep + kstep, voffB);
        PG8_WAIT_V(6); PG8_BAR;
    }
    for (;;) {
        const bool has_next = S.next(ui + 1, nxt);
        const char* nA = has_next ? S.a_base(nxt) : cA; const char* nB = has_next ? S.b_base(nxt) : cB;
        if (has_next) { PG8_AOFF(vnA, nxt); } else { _Pragma("unroll") for (int _h = 0; _h < 2; ++_h) _Pragma("unroll") for (int _i = 0; _i < 2; ++_i) vnA[_h][_i] = vcA[_h][_i]; }
        for (int t = 0; t < nt; t += 2) {
            const bool last = (t == nt - 2);
            const char* a1 = cA + (size_t)(t + 1) * kstep;
            const char* a2 = last ? nA : cA + (size_t)(t + 2) * kstep; const char* b2 = last ? nB : cB + (size_t)(t + 2) * kstep;
            const char* a3 = a2 + kstep; const char* b3 = b2 + kstep;
            if (last && has_next) S.a_ready(nxt);
            if constexpr (SP2) {
            PG8_LDB(B0, 0, 0); PG8_LDB(B1, 0, 1); PG8_SCHED; PG8_LDA(At, 0, 0); PG8_STAGEA(PG8_SA(1, 1), a1, vcA, 1);
            PG8_WAIT_V(8); PG8_WAIT_L(0); PG8_BAR; PG8_MMA(0, 0, At, B0); PG8_MMA(0, 1, At, B1); PG8_BAR; PG8_SCHED;
            PG8_LDA(At, 0, 1); PG8_STAGE(PG8_SB(0, 0), b2, voffB); PG8_STAGE(PG8_SB(0, 1), b2 + hstep, voffB); PG8_STAGEA2(PG8_SA(0, 0), a2, 0);
            PG8_WAIT_V(8); PG8_WAIT_L(0); PG8_BAR; PG8_MMA(1, 0, At, B0); PG8_MMA(1, 1, At, B1); PG8_BAR; PG8_SCHED;
            PG8_LDB(B0, 1, 0); PG8_LDB(B1, 1, 1); PG8_SCHED; PG8_LDA(At, 1, 0); PG8_STAGEA2(PG8_SA(0, 1), a2, 1);
            PG8_WAIT_V(8); PG8_WAIT_L(0); PG8_BAR; PG8_MMA(0, 0, At, B0); PG8_MMA(0, 1, At, B1); PG8_BAR; PG8_SCHED;
            PG8_LDA(At, 1, 1); PG8_STAGE(PG8_SB(1, 0), b3, voffB); PG8_STAGE(PG8_SB(1, 1), b3 + hstep, voffB); PG8_STAGEA2(PG8_SA(1, 0), a3, 0);
            PG8_WAIT_V(8); PG8_WAIT_L(0); PG8_BAR; PG8_MMA(1, 0, At, B0); PG8_MMA(1, 1, At, B1); PG8_BAR; PG8_SCHED;
            } else {
            PG8_LDB(B0, 0, 0); PG8_SCHED; PG8_LDA(At, 0, 0); PG8_STAGEA(PG8_SA(1, 1), a1, vcA, 1);
            PG8_WAIT_L(8); PG8_BAR; PG8_WAIT_L(0); PG8_MMA(0, 0, At, B0); PG8_BAR; PG8_SCHED;
            PG8_LDB(B1, 0, 1); PG8_STAGE(PG8_SB(0, 0), b2, voffB);
            PG8_BAR; PG8_WAIT_L(0); PG8_MMA(0, 1, At, B1); PG8_BAR;
            PG8_LDA(At, 0, 1); PG8_STAGEA2(PG8_SA(0, 0), a2, 0);
            PG8_BAR; PG8_WAIT_L(0); PG8_MMA(1, 0, At, B0); PG8_BAR; PG8_SCHED;
            PG8_STAGE(PG8_SB(0, 1), b2 + hstep, voffB);
            PG8_WAIT_V(6); PG8_BAR; PG8_MMA(1, 1, At, B1); PG8_BAR;
            PG8_LDB(B0, 1, 0); PG8_SCHED; PG8_LDA(At, 1, 0); PG8_STAGEA2(PG8_SA(0, 1), a2, 1);
            PG8_WAIT_L(8); PG8_BAR; PG8_WAIT_L(0); PG8_MMA(0, 0, At, B0); PG8_BAR; PG8_SCHED;
            PG8_LDB(B1, 1, 1); PG8_STAGE(PG8_SB(1, 0), b3, voffB);
            PG8_BAR; PG8_WAIT_L(0); PG8_MMA(0, 1, At, B1); PG8_BAR;
            PG8_LDA(At, 1, 1); PG8_STAGEA2(PG8_SA(1, 0), a3, 0);
            PG8_BAR; PG8_WAIT_L(0); PG8_MMA(1, 0, At, B0); PG8_BAR; PG8_SCHED;
            PG8_STAGE(PG8_SB(1, 1), b3 + hstep, voffB);
            PG8_WAIT_V(6); PG8_BAR; PG8_MMA(1, 1, At, B1); PG8_BAR;
            }
        }
        if constexpr (ALIGN_EPI) { if (wr == 0) PG8_BAR; }
        if constexpr (!Epi::AFTER_DRAIN) { E(acc, cur, wr, wc, fr, fq); S.done(cur); }
        if (!has_next) break;
#pragma unroll
        for (int a = 0; a < 2; ++a)
#pragma unroll
            for (int b = 0; b < 2; ++b)
#pragma unroll
                for (int m = 0; m < 4; ++m)
#pragma unroll
                    for (int n = 0; n < 2; ++n) acc[a][b][m][n] = (f32x4){0.f, 0.f, 0.f, 0.f};
        cur = nxt; cA = nA; cB = nB; ++ui;
        _Pragma("unroll") for (int _h = 0; _h < 2; ++_h) _Pragma("unroll") for (int _i = 0; _i < 2; ++_i) vcA[_h][_i] = vnA[_h][_i];
        if constexpr (ALIGN_EPI) { if (wr == 1) PG8_BAR; }
    }
    PG8_WAIT_V(0);
    if constexpr (!ALIGN_EPI) { if (wr == 0) PG8_BAR; }
    PG8_BAR;
    if constexpr (Epi::AFTER_DRAIN) { E.fused(acc, cur, wr, wc, fr, fq, lds, wid, lane); S.done(cur); }
#undef PG8_SA
#undef PG8_SB
#undef PG8_STAGE
#undef PG8_STAGEA
#undef PG8_STAGEA2
#undef PG8_AOFF
#undef PG8_LDA
#undef PG8_LDB
#undef PG8_MMA
#undef PG8_WAIT_V
#undef PG8_WAIT_L
#undef PG8_BAR
#undef PG8_SCHED
}


template <int WHICH> struct MoeOrder {
    const int* TP; int G, c; const char* Abase; const char* Bbase; const int* LIST;
    static constexpr int KK = WHICH == 0 ? 1024 : 512, NN = 4;
    __device__ __forceinline__ bool next(int i, Unit& u) const {
        const int L = i * G + c; if (L >= TP[NEXP]) return false;
        int e = 0;
#pragma unroll 1
        for (int j = 16; j >= 1; j >>= 1) if (TP[e + j] <= L) e += j;
        const int lt = L - TP[e]; u.pm = e * 1024 + lt / NN; u.pn = lt % NN; return true;
    }
    __device__ __forceinline__ const char* a_base(const Unit& u) const { const int e = u.pm >> 10, mt = u.pm & 1023; return WHICH == 0 ? Abase : Abase + (size_t)(TP[64 + e] + mt * 256) * (DEXP * 2); }
    __device__ __forceinline__ const char* b_base(const Unit& u) const { const int e = u.pm >> 10; return Bbase + ((size_t)e * 1024 + (size_t)u.pn * 256) * (KK * 2); }
    __device__ __forceinline__ unsigned a_off(const Unit& u, int r, int C) const {
        if (WHICH == 1) return (unsigned)(r * DEXP + C) * 2u;
        const int e = u.pm >> 10, s = (u.pm & 1023) * 256 + r; const int tok = s < TP[128 + e] ? (LIST[(size_t)e * NR + s] >> 1) : 0;
        return (unsigned)tok * (D * 2) + (unsigned)C * 2u;
    }
    __device__ __forceinline__ void a_ready(const Unit&) const {}
    __device__ __forceinline__ void done(const Unit&) const {}
};
struct TokRowOrder : StaticOrder {
    const char* Abase; const char* Bbase; int K;
    __device__ __forceinline__ const char* a_base(const Unit& u) const { return Abase + (size_t)tokrow(u.pm * BM) * K * 2; }
    __device__ __forceinline__ const char* b_base(const Unit& u) const { return Bbase + (size_t)u.pn * BM * K * 2; }
    __device__ __forceinline__ unsigned a_off(const Unit&, int r, int C) const { return (unsigned)(r * K + C) * 2u; }
};
#define PG8_FOR_FRAGS_M(...) _Pragma("unroll") for (int ai = 0; ai < 2; ++ai) _Pragma("unroll") for (int m = 0; m < 4; ++m) { const int r = ai * HALF + wr * 64 + m * 16 + fr; \
    _Pragma("unroll") for (int bj = 0; bj < 2; ++bj) _Pragma("unroll") for (int n = 0; n < 2; ++n) { const int col = u.pn * BM + bj * HALF + wc * 32 + n * 16 + 4 * fq; ::f32x4 v = acc[ai][bj][m][n]; __VA_ARGS__ } }
struct EpiMoe1 {
    static constexpr bool PERM = true, AFTER_DRAIN = false;
    bf16_t* HID; const int* TP; const int* LIST; const float* RS;
    __device__ __forceinline__ void operator()(const f32x4 (&acc)[2][2][4][2], const Unit& u, int wr, int wc, int fr, int fq) const {
        const int e = u.pm >> 10, mt = u.pm & 1023, cnt = TP[128 + e]; bf16_t* base = HID + (size_t)(TP[64 + e] + mt * 256) * DEXP;
#pragma unroll
        for (int ai = 0; ai < 2; ++ai)
#pragma unroll
            for (int m = 0; m < 4; ++m) { const int r = ai * HALF + wr * 64 + m * 16 + fr; const int s = mt * 256 + r;
                const float rs = RS[s < cnt ? (LIST[(size_t)e * NR + s] >> 1) : 0];
#pragma unroll
                for (int bj = 0; bj < 2; ++bj) { const int col = u.pn * BM + bj * HALF + wc * 32 + 8 * fq; const ::f32x4 v0 = acc[ai][bj][m][0] * rs, v1 = acc[ai][bj][m][1] * rs;
                    const float h0 = v0.x * sigmoidf(v0.x) * v0.y, h1 = v0.z * sigmoidf(v0.z) * v0.w, h2 = v1.x * sigmoidf(v1.x) * v1.y, h3 = v1.z * sigmoidf(v1.z) * v1.w;
                    ::u32x2 w; w.x = pk2(h0, h1); w.y = pk2(h2, h3); *(::u32x2*)(base + (size_t)r * DEXP + (col >> 1)) = w; } }
    }
};
struct EpiMoe2 {
    static constexpr bool PERM = true, AFTER_DRAIN = false;
    bf16_t* MO; const int* TP; const int* LIST; const float* GATE;
    __device__ __forceinline__ void operator()(const f32x4 (&acc)[2][2][4][2], const Unit& u, int wr, int wc, int fr, int fq) const {
        const int e = u.pm >> 10, mt = u.pm & 1023, cnt = TP[128 + e];
#pragma unroll
        for (int ai = 0; ai < 2; ++ai)
#pragma unroll
            for (int m = 0; m < 4; ++m) {
                const int s = mt * 256 + ai * HALF + wr * 64 + m * 16 + fr;
                if (s < cnt) {
                    const int ent = LIST[(size_t)e * NR + s]; const float gt = GATE[ent]; bf16_t* row = MO + (size_t)ent * D;
#pragma unroll
                    for (int bj = 0; bj < 2; ++bj) { const int col = u.pn * BM + bj * HALF + wc * 32 + 8 * fq; const ::f32x4 v0 = acc[ai][bj][m][0], v1 = acc[ai][bj][m][1];
                        ::u32x4 w; w.x = pk2(v0.x * gt, v0.y * gt); w.y = pk2(v0.z * gt, v0.w * gt); w.z = pk2(v1.x * gt, v1.y * gt); w.w = pk2(v1.z * gt, v1.w * gt); *(::u32x4*)(row + col) = w; }
                }
            }
    }
};
#undef PG8_FOR_FRAGS_M
}
template <bool B> struct BoolT { static constexpr bool value = B; };
constexpr int SB_NQT = SEQ / 32;
constexpr int SB_VROW = 192;
__device__ __forceinline__ void phase_sb_fast(const Params& p, char* lds) {
    const bf16_t* P = (const bf16_t*)(p.ws + WS_P); bf16_t* YA = (bf16_t*)(p.ws + WS_YA);
    const int tid = threadIdx.x, lane = tid & 63, wave = tid >> 6, n = lane & 31, hh = lane >> 5;
    char* VB = lds + wave * (32 * SB_VROW);
    const unsigned vtr = (unsigned)(size_t)lds + (unsigned)(wave * (32 * SB_VROW) + (4 * hh + ((lane & 15) >> 2)) * SB_VROW + (16 * ((lane >> 4) & 1) + 4 * (lane & 3)) * 2);
    const int gw = blockIdx.x * NWAVES + wave, NGW = gridDim.x * NWAVES;
    for (int unit = gw; unit < 64 * SB_NQT; unit += NGW) {
        const int qt = SB_NQT - 1 - unit / 64, bh = unit % 64, h = bh & 7, b = bh >> 3;
        const int i0 = NMETA + qt * 32, qi = i0 + n, qrow = qi;
        const bf16_t* Pb = P + (size_t)b * T * PW;
        bf16x8 qf[4];
#pragma unroll
        for (int s = 0; s < 4; ++s) qf[s] = *(const bf16x8*)(Pb + (size_t)qrow * PW + C_QA + h * 64 + 16 * s + 8 * hh);
        f32x16 o0, o1;
#pragma unroll
        for (int r = 0; r < 16; ++r) { o0[r] = 0.f; o1[r] = 0.f; }
        float EL = 1.f;
        auto tile = [&](const int kt, auto MT) {
            constexpr bool MASKED = decltype(MT)::value;
            const int j0 = kt * 32, krow = (!MASKED || (j0 + n) < T) ? (j0 + n) : T - 1;
            bf16x8 kf[4];
#pragma unroll
            for (int s = 0; s < 4; ++s) kf[s] = *(const bf16x8*)(Pb + (size_t)krow * PW + C_KA + h * 64 + 16 * s + 8 * hh);
#pragma unroll
            for (int i = 0; i < 4; ++i) {
                const int c = lane + 64 * i, key = c >> 3, d0 = (c & 7) * 8, vrow = (!MASKED || (j0 + key) < T) ? (j0 + key) : T - 1;
                const u32x4 w = *(const u32x4*)(Pb + (size_t)vrow * PW + C_VA + h * 64 + d0);
                *(u32x4*)(VB + key * SB_VROW + d0 * 2) = w;
            }
            f32x16 sa;
#pragma unroll
            for (int r = 0; r < 16; ++r) sa[r] = 0.f;
#pragma unroll
            for (int s = 0; s < 4; ++s) sa = __builtin_amdgcn_mfma_f32_32x32x16_bf16(kf[s], qf[s], sa, 0, 0, 0);
            float kp[16], sg[16];
#pragma unroll
            for (int r = 0; r < 16; ++r) {
                const float e = fexp2(__builtin_amdgcn_fmed3f(sa[r], -3.0e38f, 80.f)), k = __builtin_amdgcn_rcpf(1.f + e), s = e * k;
                if (MASKED) { const int kk = (r & 3) + 8 * (r >> 2) + 4 * hh; const bool valid = (j0 + kk) < qi; kp[r] = valid ? k : 1.f; sg[r] = valid ? s : 0.f; }
                else { kp[r] = k; sg[r] = s; }
            }
            const float gp0 = (kp[0] * kp[1]) * (kp[2] * kp[3]), gp1 = (kp[4] * kp[5]) * (kp[6] * kp[7]), gp2 = (kp[8] * kp[9]) * (kp[10] * kp[11]), gp3 = (kp[12] * kp[13]) * (kp[14] * kp[15]);
            const float pp0 = xpartner32(gp0, hh), pp1 = xpartner32(gp1, hh), pp2 = xpartner32(gp2, hh), pp3 = xpartner32(gp3, hh);
            const float pc3 = pp3, pc2 = pc3 * pp2, pc1 = pc2 * pp1, pc0 = pc1 * pp0;
            float base[4];
            base[3] = EL * (hh ? 1.f : pc3);
            base[2] = EL * gp3 * (hh ? pc3 : pc2);
            base[1] = EL * (gp3 * gp2) * (hh ? pc2 : pc1);
            base[0] = EL * (gp3 * gp2 * gp1) * (hh ? pc1 : pc0);
            float a[16];
#pragma unroll
            for (int g = 0; g < 4; ++g) {
                float c = base[g];
#pragma unroll
                for (int e = 3; e >= 0; --e) { const int r = 4 * g + e; a[r] = sg[r] * c; c *= kp[r]; }
            }
            EL *= ((gp0 * gp1) * (gp2 * gp3)) * pc0;
            u32x4 pw0, pw1;
            pw0.x = pk2(a[0], a[1]); pw0.y = pk2(a[2], a[3]); pw0.z = pk2(a[4], a[5]); pw0.w = pk2(a[6], a[7]);
            pw1.x = pk2(a[8], a[9]); pw1.y = pk2(a[10], a[11]); pw1.z = pk2(a[12], a[13]); pw1.w = pk2(a[14], a[15]);
            const bf16x8 pf0 = __builtin_bit_cast(bf16x8, pw0), pf1 = __builtin_bit_cast(bf16x8, pw1);
            {
                u16x4 x0, x1, x2, x3, y0, y1, y2, y3;
                asm volatile("s_waitcnt lgkmcnt(0)\n\tds_read_b64_tr_b16 %0, %8 offset:%9\n\tds_read_b64_tr_b16 %1, %8 offset:%10\n\tds_read_b64_tr_b16 %2, %8 offset:%11\n\tds_read_b64_tr_b16 %3, %8 offset:%12\n\t"
                             "ds_read_b64_tr_b16 %4, %8 offset:%13\n\tds_read_b64_tr_b16 %5, %8 offset:%14\n\tds_read_b64_tr_b16 %6, %8 offset:%15\n\tds_read_b64_tr_b16 %7, %8 offset:%16\n\ts_waitcnt lgkmcnt(0)"
                             : "=&v"(x0), "=&v"(x1), "=&v"(x2), "=&v"(x3), "=&v"(y0), "=&v"(y1), "=&v"(y2), "=&v"(y3)
                             : "v"(vtr), "i"(0), "i"(8 * SB_VROW), "i"(16 * SB_VROW), "i"(24 * SB_VROW), "i"(64), "i"(64 + 8 * SB_VROW), "i"(64 + 16 * SB_VROW), "i"(64 + 24 * SB_VROW) : "memory");
#define SB_VF(a_, b_) ({ bf16x8 f_; f_[0] = (short)a_[0]; f_[1] = (short)a_[1]; f_[2] = (short)a_[2]; f_[3] = (short)a_[3]; f_[4] = (short)b_[0]; f_[5] = (short)b_[1]; f_[6] = (short)b_[2]; f_[7] = (short)b_[3]; f_; })
                o0 = __builtin_amdgcn_mfma_f32_32x32x16_bf16(SB_VF(x0, x1), pf0, o0, 0, 0, 0); o0 = __builtin_amdgcn_mfma_f32_32x32x16_bf16(SB_VF(x2, x3), pf1, o0, 0, 0, 0);
                o1 = __builtin_amdgcn_mfma_f32_32x32x16_bf16(SB_VF(y0, y1), pf0, o1, 0, 0, 0); o1 = __builtin_amdgcn_mfma_f32_32x32x16_bf16(SB_VF(y2, y3), pf1, o1, 0, 0, 0);
#undef SB_VF
            }
        };
        int kt = qt + 1;
        for (; kt >= qt; --kt) tile(kt, BoolT<true>{});
        for (; kt >= 0; --kt) {
            if (__all(EL < 1e-37f)) break;
            tile(kt, BoolT<false>{});
        }
        {
            bf16_t* yp = YA + ((size_t)b * SEQ + (qi - NMETA)) * 512 + h * 64 + 4 * hh;
#pragma unroll
            for (int g = 0; g < 4; ++g) {
                u32x2 w; w.x = pk2(o0[4 * g], o0[4 * g + 1]); w.y = pk2(o0[4 * g + 2], o0[4 * g + 3]); *(u32x2*)(yp + 8 * g) = w;
                w.x = pk2(o1[4 * g], o1[4 * g + 1]); w.y = pk2(o1[4 * g + 2], o1[4 * g + 3]); *(u32x2*)(yp + 32 + 8 * g) = w;
            }
        }
    }
}

constexpr int DSA_NQ = 8;
constexpr int DSA_SCS = 4608;
constexpr int DSA_KVB = 0, DSA_RING = 18432, DSA_IDX = DSA_NQ * DSA_RING, DSA_MISC = DSA_IDX + DSA_NQ * 1024, DSA_LDS = DSA_MISC + 512;
static_assert(DSA_NQ * DSA_SCS * 4 <= DSA_IDX, "score rows fit under the index lists");
__device__ __forceinline__ unsigned fkey(float f) { const unsigned u = __float_as_uint(f); return (u & 0x80000000u) ? ~u : (u | 0x80000000u); }
__device__ __forceinline__ int wave_sum_i32(int v) {
    v += __builtin_amdgcn_update_dpp(0, v, 0xB1, 0xF, 0xF, false);
    v += __builtin_amdgcn_update_dpp(0, v, 0x4E, 0xF, 0xF, false);
    v += __builtin_amdgcn_update_dpp(0, v, 0x141, 0xF, 0xF, false);
    v += __builtin_amdgcn_update_dpp(0, v, 0x140, 0xF, 0xF, false);
    return __builtin_amdgcn_readlane(v, 0) + __builtin_amdgcn_readlane(v, 16) + __builtin_amdgcn_readlane(v, 32) + __builtin_amdgcn_readlane(v, 48);
}
__device__ __forceinline__ int wave_excl_scan_i32(int c, int lane, int& total) {
    int x = c;
    x += __builtin_amdgcn_update_dpp(0, x, 0x111, 0xF, 0xF, true);
    x += __builtin_amdgcn_update_dpp(0, x, 0x112, 0xF, 0xF, true);
    x += __builtin_amdgcn_update_dpp(0, x, 0x114, 0xF, 0xF, true);
    x += __builtin_amdgcn_update_dpp(0, x, 0x118, 0xF, 0xF, true);
    const int t0 = __builtin_amdgcn_readlane(x, 15), t1 = __builtin_amdgcn_readlane(x, 31), t2 = __builtin_amdgcn_readlane(x, 47), t3 = __builtin_amdgcn_readlane(x, 63);
    const int row = lane >> 4;
    x += (row > 0 ? t0 : 0) + (row > 1 ? t1 : 0) + (row > 2 ? t2 : 0);
    total = t0 + t1 + t2 + t3;
    return x - c;
}
__device__ __forceinline__ int mbcnt64(unsigned long long m) { return (int)__builtin_amdgcn_mbcnt_hi((unsigned)(m >> 32), __builtin_amdgcn_mbcnt_lo((unsigned)m, 0u)); }
__device__ __forceinline__ void phase_dsa(const Params& p, char* lds) {
    const bf16_t* P = (const bf16_t*)(p.ws + WS_P); bf16_t* OL = (bf16_t*)(p.ws + WS_OLAT);
    const int tid = threadIdx.x, lane = tid & 63, wave = __builtin_amdgcn_readfirstlane(tid >> 6);
    unsigned* SC = (unsigned*)(lds + DSA_KVB);
    unsigned short* IDX = (unsigned short*)(lds + DSA_IDX);
    int* MISC = (int*)(lds + DSA_MISC);
    const unsigned lds_base = (unsigned)(size_t)lds;
    constexpr int NU = SEQ / DSA_NQ;
    for (int unit = blockIdx.x; unit < BATCH * NU; unit += gridDim.x) {
        const int u8 = NU - 1 - unit / BATCH, b = unit % BATCH, t0 = NMETA + u8 * DSA_NQ;
        const int cid = 1 + (t0 - NMETA) / 64, n = NMETA + 64 * cid;
        const bf16_t* Pb = P + (size_t)b * T * PW;
        const int m = lane & 31, hh = lane >> 5;
        bf16x8 aq[2][4], wa[2][2];
#pragma unroll
        for (int rt = 0; rt < 2; ++rt) {
#pragma unroll
            for (int s = 0; s < 4; ++s) aq[rt][s] = *(const bf16x8*)(Pb + (size_t)(t0 + 4 * rt + (m >> 3)) * PW + C_QI + (m & 7) * 64 + 16 * s + 8 * hh);
            const int o = m - 8 * rt, ql = (o == 0) ? 0 : (o == 1) ? 1 : (o == 4) ? 2 : (o == 5) ? 3 : -1;
            u32x2 wq = (u32x2){0u, 0u};
            if (ql >= 0) wq = *(const u32x2*)(Pb + (size_t)(t0 + 4 * rt + ql) * PW + C_WI + 4 * hh);
            u32x4 w0 = (u32x4){0u, 0u, 0u, 0u}, w1 = w0;
            if (ql == 0) { w0.x = wq.x; w0.y = wq.y; } else if (ql == 1) { w0.z = wq.x; w0.w = wq.y; } else if (ql == 2) { w1.x = wq.x; w1.y = wq.y; } else if (ql == 3) { w1.z = wq.x; w1.w = wq.y; }
            wa[rt][0] = __builtin_bit_cast(bf16x8, w0); wa[rt][1] = __builtin_bit_cast(bf16x8, w1);
        }
        const unsigned char* KIPb = p.ws + WS_KIP + (size_t)b * KIP_BATCH + lane * 16;
        bf16x8 bk[4];
#pragma unroll
        for (int s = 0; s < 4; ++s) bk[s] = *(const bf16x8*)(KIPb + (size_t)wave * 4096 + s * 1024);
        __syncthreads();
        {
            const int ntile = (n + 31) / 32;
            for (int kt = wave; kt < ntile; kt += NWAVES) {
                const int j0 = kt * 32, key = j0 + m;
                bf16x8 bn[4];
                { const int ktn = kt + NWAVES < 129 ? kt + NWAVES : 128;
#pragma unroll
                  for (int s = 0; s < 4; ++s) bn[s] = *(const bf16x8*)(KIPb + (size_t)ktn * 4096 + s * 1024); }
                const bool ok = key < n;
                f32x16 outp;
#pragma unroll
                for (int r = 0; r < 16; ++r) outp[r] = 0.f;
#pragma unroll
                for (int rt = 0; rt < 2; ++rt) {
                    f32x16 acc;
#pragma unroll
                    for (int r = 0; r < 16; ++r) acc[r] = 0.f;
#pragma unroll
                    for (int s = 0; s < 4; ++s) acc = __builtin_amdgcn_mfma_f32_32x32x16_bf16(aq[rt][s], bk[s], acc, 0, 0, 0);
                    u32x4 p0, p1;
#define RELU2_(a_, b_) __builtin_bit_cast(unsigned, __builtin_elementwise_max(__builtin_bit_cast(s16x2, pk2((a_), (b_))), (s16x2){0, 0}))
                    p0.x = RELU2_(acc[0], acc[1]); p0.y = RELU2_(acc[2], acc[3]); p0.z = RELU2_(acc[4], acc[5]); p0.w = RELU2_(acc[6], acc[7]);
                    p1.x = RELU2_(acc[8], acc[9]); p1.y = RELU2_(acc[10], acc[11]); p1.z = RELU2_(acc[12], acc[13]); p1.w = RELU2_(acc[14], acc[15]);
#undef RELU2_
                    outp = __builtin_amdgcn_mfma_f32_32x32x16_bf16(wa[rt][0], __builtin_bit_cast(bf16x8, p0), outp, 0, 0, 0);
                    outp = __builtin_amdgcn_mfma_f32_32x32x16_bf16(wa[rt][1], __builtin_bit_cast(bf16x8, p1), outp, 0, 0, 0);
                }
#pragma unroll
                for (int rt = 0; rt < 2; ++rt) {
                    SC[(4 * rt + 2 * hh) * DSA_SCS + key] = ok ? fkey(outp[4 * rt]) : 0u;
                    SC[(4 * rt + 2 * hh + 1) * DSA_SCS + key] = ok ? fkey(outp[4 * rt + 1]) : 0u;
                }
#pragma unroll
                for (int s = 0; s < 4; ++s) bk[s] = bn[s];
            }
        }
        __syncthreads();
        bf16x8 qf[5];
        {
            const int hd_ = lane & 15, g_ = lane >> 4;
#pragma unroll
            for (int ks = 0; ks < 5; ++ks) {
                u32x4 w = (u32x4){0u, 0u, 0u, 0u};
                if (hd_ < 8 && (ks < 4 || g_ < 2)) w = *(const u32x4*)(Pb + (size_t)(t0 + wave) * PW + C_QF + hd_ * QFW + 32 * ks + 8 * g_);
                qf[ks] = __builtin_bit_cast(bf16x8, w);
            }
        }
        {
            unsigned* sc = SC + wave * DSA_SCS;
            unsigned v[65];
#pragma unroll
            for (int i = 0; i < 65; ++i) { const int k = i * 64 + lane; v[i] = (k < n) ? sc[k] : 0u; }
            unsigned prefix = 0u; int cge = n, bit = 31;
            bool exact = false;
            if (n >= 256) {
                for (; bit >= 0 && cge > 512; --bit) {
                    const unsigned cand = prefix | (1u << bit); const int sc_ = (int)(cand ^ 0x80000000u);
                    unsigned b0 = 0u, b1 = 0u, b2 = 0u; int slots = 0;
#pragma unroll
                    for (int gi = 0; gi < 5; ++gi) if (gi * 832 < n) {
#pragma unroll
                        for (int i = 13 * gi; i < 13 * gi + 13; ++i) {
                            const unsigned d = (unsigned)__builtin_elementwise_sub_sat((int)(v[i] ^ 0x80000000u), sc_);
                            if (i % 3 == 0) b0 = __builtin_amdgcn_alignbit(b0, d, 31); else if (i % 3 == 1) b1 = __builtin_amdgcn_alignbit(b1, d, 31); else b2 = __builtin_amdgcn_alignbit(b2, d, 31);
                        }
                        slots += 13 * 64;
                    }
                    const int c = slots - wave_sum_i32(__builtin_popcount(b0) + __builtin_popcount(b1) + __builtin_popcount(b2));
                    if (c >= 256) { prefix = cand; cge = c; if (c == 256) { exact = true; break; } }
                }
            }
            int ngt = n;
            if (n >= 256 && !exact) {
                asm volatile("s_waitcnt lgkmcnt(0)" ::: "memory");
                int cb = 0;
                if (bit >= 0) {
                    const int sp_ = (int)((prefix > 0u ? prefix : 1u) ^ 0x80000000u);
                    unsigned lb0 = 0u, lb1 = 0u, lb2 = 0u;
#pragma unroll
                    for (int i = 0; i < 65; ++i) { const unsigned d = (unsigned)__builtin_elementwise_sub_sat((int)(v[i] ^ 0x80000000u), sp_);
                        if (i < 32) lb0 = __builtin_amdgcn_alignbit(lb0, d, 31); else if (i < 64) lb1 = __builtin_amdgcn_alignbit(lb1, d, 31); else lb2 = d >> 31; }
                    const unsigned tk0 = ~lb0, tk1 = ~lb1, tk2 = (~lb2) & 1u;
                    const int c0 = __builtin_popcount(tk0), c1 = __builtin_popcount(tk1);
                    const int lbase = wave_excl_scan_i32(c0 + c1 + (int)tk2, lane, cb);
#pragma unroll
                    for (int i = 0; i < 65; ++i) {
                        bool tkn; int rk;
                        if (i < 32) { tkn = (tk0 >> (31 - i)) & 1u; rk = i == 0 ? 0 : __builtin_popcount(tk0 >> (32 - i)); }
                        else if (i < 64) { tkn = (tk1 >> (63 - i)) & 1u; rk = c0 + (i == 32 ? 0 : __builtin_popcount(tk1 >> (64 - i))); }
                        else { tkn = tk2 != 0u; rk = c0 + c1; }
                        sc[tkn ? lbase + rk : 4096 + (lane & 15)] = v[i];
                    }
                    asm volatile("s_waitcnt lgkmcnt(0)" ::: "memory");
                    unsigned w[8];
#pragma unroll
                    for (int j = 0; j < 8; ++j) { const int k = j * 64 + lane; w[j] = (k < cb) ? sc[k] : 0u; }
                    for (; bit >= 0; --bit) {
                        const unsigned cand = prefix | (1u << bit); const int sc_ = (int)(cand ^ 0x80000000u); unsigned b0 = 0u, b1 = 0u;
#pragma unroll
                        for (int j = 0; j < 8; ++j) { const unsigned d = (unsigned)__builtin_elementwise_sub_sat((int)(w[j] ^ 0x80000000u), sc_); if (j & 1) b1 = __builtin_amdgcn_alignbit(b1, d, 31); else b0 = __builtin_amdgcn_alignbit(b0, d, 31); }
                        const int c = 512 - wave_sum_i32(__builtin_popcount(b0) + __builtin_popcount(b1));
                        if (c >= 256) { prefix = cand; if (c == 256) { exact = true; break; } }
                    }
                    int c = 0;
#pragma unroll
                    for (int j = 0; j < 8; ++j) c += __popcll(__ballot(w[j] > prefix));
                    ngt = c;
                } else {
                    int c = 0;
#pragma unroll
                    for (int i = 0; i < 65; ++i) { c += __popcll(__ballot(v[i] > prefix)); if ((i & 3) == 3) __builtin_amdgcn_sched_barrier(0); }
                    ngt = c;
                }
            }
            const unsigned tau = prefix;
            const int need_eq = n >= 256 ? 256 - ngt : 0; int base = 0, eqb = 0;
            unsigned short* idx = IDX + wave * 512;
            {
                const int st_ = (int)(tau ^ 0x80000000u); unsigned e0 = 0u, e1 = 0u, e2 = 0u;
#pragma unroll
                for (int i = 0; i < 65; ++i) { const unsigned d = (unsigned)__builtin_elementwise_sub_sat((int)(v[i] ^ 0x80000000u), st_);
                    if (i < 32) e0 = __builtin_amdgcn_alignbit(e0, d, 31); else if (i < 64) e1 = __builtin_amdgcn_alignbit(e1, d, 31); else e2 = d >> 31; }
                const unsigned tk0 = ~e0, tk1 = ~e1, tk2 = (~e2) & 1u;
                const int c0 = __builtin_popcount(tk0), c1 = __builtin_popcount(tk1);
                int nge; const int lbase = wave_excl_scan_i32(c0 + c1 + (int)tk2, lane, nge);
                if (n >= 256 && nge == 256) {
                    unsigned short* ib = idx + lbase;
                    { unsigned x = tk0; int j = 0; while (__any(x != 0u)) { if (x != 0u) { const int i = __builtin_clz(x); ib[j] = (unsigned short)(i * 64 + lane); x ^= 0x80000000u >> i; } ++j; } }
                    ib += c0;
                    { unsigned x = tk1; int j = 0; while (__any(x != 0u)) { if (x != 0u) { const int i = __builtin_clz(x); ib[j] = (unsigned short)((32 + i) * 64 + lane); x ^= 0x80000000u >> i; } ++j; } }
                    if (tk2 != 0u) ib[c1] = (unsigned short)(64 * 64 + lane);
                    base = nge;
                } else {
#pragma unroll
                    for (int gi = 0; gi < 5; ++gi) if (gi * 832 < n) {
#pragma unroll
                        for (int i = 13 * gi; i < 13 * gi + 13; ++i) {
                            const int k = i * 64 + lane; const unsigned u = v[i];
                            const bool eq = (u == tau); const unsigned long long meq = __ballot(eq);
                            const bool take = (u > tau) || (eq && (eqb + mbcnt64(meq)) < need_eq);
                            const unsigned long long mt = __ballot(take);
                            idx[take ? base + mbcnt64(mt) : 256 + lane] = (unsigned short)k;
                            base += __popcll(mt); eqb += __popcll(meq);
                            if ((i & 3) == 3) __builtin_amdgcn_sched_barrier(0);
                        }
                    }
                }
            }
            for (int pos = base + lane; pos < 256; pos += 64) idx[pos] = 0;
            if (lane == 0) MISC[wave] = base;
        }
        asm volatile("s_waitcnt lgkmcnt(0)" ::: "memory");
        {
            const int q = wave; const int nsel = __builtin_amdgcn_readfirstlane(MISC[q]);
            const size_t qrow = (size_t)(t0 + q);
            int ln = lane; asm volatile("" : "+v"(ln));
            const int hd = ln & 15, g = ln >> 4, qd = (ln & 15) >> 2, pp = ln & 3;
            char* ring = lds + DSA_KVB + wave * DSA_RING;
            const unsigned ring_a = lds_base + DSA_KVB + wave * DSA_RING;
            const unsigned short* idx = IDX + q * 512;
            asm volatile("s_waitcnt vmcnt(0)" ::: "memory");
#define DSA_ISSUE(c) do { unsigned rw_[9]; \
                _Pragma("unroll") for (int i_ = 0; i_ < 9; ++i_) { const int pid_ = ln + 64 * i_, row_ = pid_ / 18; rw_[i_] = idx[32 * (c) + row_]; } \
                _Pragma("unroll") for (int i_ = 0; i_ < 9; ++i_) { const int pid_ = ln + 64 * i_, row_ = pid_ / 18, part_ = pid_ - row_ * 18; \
                    const unsigned off_ = rw_[i_] * (unsigned)(PW * 2) + (unsigned)((C_KV + part_ * 8) * 2); \
                    __builtin_amdgcn_global_load_lds((const unsigned*)((const char*)Pb + off_), (LAS unsigned*)(ring + ((c) & 1) * 9216 + i_ * 1024), 16, 0, 0); } } while (0)
            DSA_ISSUE(0); DSA_ISSUE(1);
            f32x4 O[8];
#pragma unroll
            for (int nt = 0; nt < 8; ++nt) O[nt] = (f32x4){0.f, 0.f, 0.f, 0.f};
            float mrun = -3e38f, lrun = 0.f;
            for (int c = 0; c < 8; ++c) {
                if (c < 7) asm volatile("s_waitcnt vmcnt(9)" ::: "memory"); else asm volatile("s_waitcnt vmcnt(0)" ::: "memory");
                const char* buf = ring + (c & 1) * 9216;
                f32x4 S0 = (f32x4){0.f, 0.f, 0.f, 0.f}, S1 = S0;
                {
                    const char* kr = buf + hd * 288 + 16 * g;
#pragma unroll
                    for (int ks = 0; ks < 4; ++ks) { S0 = __builtin_amdgcn_mfma_f32_16x16x32_bf16(*(const bf16x8*)(kr + 64 * ks), qf[ks], S0, 0, 0, 0); S1 = __builtin_amdgcn_mfma_f32_16x16x32_bf16(*(const bf16x8*)(kr + 16 * 288 + 64 * ks), qf[ks], S1, 0, 0, 0); }
                    u32x4 w0 = (u32x4){0u, 0u, 0u, 0u}, w1 = w0; if (g < 2) { w0 = *(const u32x4*)(kr + 256); w1 = *(const u32x4*)(kr + 16 * 288 + 256); }
                    S0 = __builtin_amdgcn_mfma_f32_16x16x32_bf16(__builtin_bit_cast(bf16x8, w0), qf[4], S0, 0, 0, 0); S1 = __builtin_amdgcn_mfma_f32_16x16x32_bf16(__builtin_bit_cast(bf16x8, w1), qf[4], S1, 0, 0, 0);
                }
                float cm = -3e38f;
#pragma unroll
                for (int r = 0; r < 4; ++r) { if (nsel < 256) { const int sl = 32 * c + 4 * g + r; S0[r] = sl < nsel ? S0[r] : -1e30f; S1[r] = (sl + 16) < nsel ? S1[r] : -1e30f; } cm = fmax2(cm, fmax2(S0[r], S1[r])); }
                cm = xmax16(xmax32(cm));
                if (__any(cm > mrun + 6.f)) {
                    const float mnew = fmaxf(mrun, cm), alpha = fexp2(mrun - mnew);
                    lrun *= alpha; mrun = mnew;
#pragma unroll
                    for (int nt = 0; nt < 8; ++nt) O[nt] *= alpha;
                }
                float ps = 0.f;
#pragma unroll
                for (int r = 0; r < 4; ++r) { S0[r] = fexp2(S0[r] - mrun); S1[r] = fexp2(S1[r] - mrun); ps += S0[r] + S1[r]; }
                ps = xsum16(xsum32(ps));
                lrun += ps;
                u32x4 pw; pw.x = pk2(S0[0], S0[1]); pw.y = pk2(S0[2], S0[3]); pw.z = pk2(S1[0], S1[1]); pw.w = pk2(S1[2], S1[3]);
                const bf16x8 pf = __builtin_bit_cast(bf16x8, pw);
                const unsigned va = ring_a + (unsigned)((c & 1) * 9216 + (4 * g + qd) * 288 + 8 * pp);
#pragma unroll
                for (int h2 = 0; h2 < 2; ++h2) {
                    u16x4 x0, x1, x2, x3, y0, y1, y2, y3;
                    asm volatile("ds_read_b64_tr_b16 %0, %8 offset:%9\n\tds_read_b64_tr_b16 %1, %8 offset:%10\n\tds_read_b64_tr_b16 %2, %8 offset:%11\n\tds_read_b64_tr_b16 %3, %8 offset:%12\n\t"
                                 "ds_read_b64_tr_b16 %4, %8 offset:%13\n\tds_read_b64_tr_b16 %5, %8 offset:%14\n\tds_read_b64_tr_b16 %6, %8 offset:%15\n\tds_read_b64_tr_b16 %7, %8 offset:%16\n\ts_waitcnt lgkmcnt(0)"
                                 : "=&v"(x0), "=&v"(x1), "=&v"(x2), "=&v"(x3), "=&v"(y0), "=&v"(y1), "=&v"(y2), "=&v"(y3)
                                 : "v"(va), "i"(128 * h2), "i"(128 * h2 + 32), "i"(128 * h2 + 64), "i"(128 * h2 + 96), "i"(128 * h2 + 4608), "i"(128 * h2 + 4640), "i"(128 * h2 + 4672), "i"(128 * h2 + 4704) : "memory");
#define DSA_PV(nt_, x_, y_) do { bf16x8 vf_; vf_[0] = (short)x_[0]; vf_[1] = (short)x_[1]; vf_[2] = (short)x_[2]; vf_[3] = (short)x_[3]; vf_[4] = (short)y_[0]; vf_[5] = (short)y_[1]; vf_[6] = (short)y_[2]; vf_[7] = (short)y_[3]; \
                    O[nt_] = __builtin_amdgcn_mfma_f32_16x16x32_bf16(vf_, pf, O[nt_], 0, 0, 0); } while (0)
                    DSA_PV(4 * h2 + 0, x0, y0); DSA_PV(4 * h2 + 1, x1, y1); DSA_PV(4 * h2 + 2, x2, y2); DSA_PV(4 * h2 + 3, x3, y3);
                }
                asm volatile("s_waitcnt lgkmcnt(0)" ::: "memory");
                if (c + 2 < 8) DSA_ISSUE(c + 2);
            }
#undef DSA_PV
#undef DSA_ISSUE
            const float inv = __builtin_amdgcn_rcpf(lrun);
            if (hd < 8) {
                bf16_t* op = OL + ((size_t)b * SEQ + (qrow - NMETA)) * 1024 + hd * 128 + 4 * g;
#pragma unroll
                for (int nt = 0; nt < 8; ++nt) { u32x2 w; w.x = pk2(O[nt][0] * inv, O[nt][1] * inv); w.y = pk2(O[nt][2] * inv, O[nt][3] * inv); *(u32x2*)(op + 16 * nt) = w; }
            }
        }
    }
}

__device__ __forceinline__ void phase_inproj_meta(const Params& p) {
    unsigned char* ws = p.ws; const int tid = threadIdx.x, lane = tid & 63, wave = tid >> 6, fr = lane & 15, fq = lane >> 4;
    const bf16_t* U = (const bf16_t*)(ws + WS_U); const bf16_t* WP = (const bf16_t*)(ws + WS_WP); bf16_t* P = (bf16_t*)(ws + WS_P); const float2* cs = (const float2*)(ws + WS_CS);
    const int gw = blockIdx.x * NWAVES + wave, NGW = gridDim.x * NWAVES;
    for (int nt = gw; nt < PW / 16; nt += NGW) {
        const bf16_t* ap = U + (size_t)fr * D + 8 * fq; const bf16_t* bp = WP + (size_t)(16 * nt + fr) * D + 8 * fq;
        f32x4 acc = (f32x4){0.f, 0.f, 0.f, 0.f};
#pragma unroll 8
        for (int ks = 0; ks < D / 32; ++ks) acc = __builtin_amdgcn_mfma_f32_16x16x32_bf16(*(const bf16x8*)(bp + 32 * ks), *(const bf16x8*)(ap + 32 * ks), acc, 0, 0, 0);
        const int col = 16 * nt + 4 * fq, t = fr; f32x4 v = acc; int o;
        if (pg8::rope_off(col, o)) { const float2 c0 = cs[t * 8 + (o >> 1)], c1 = cs[t * 8 + (o >> 1) + 1]; v = (f32x4){v.x * c0.x - v.y * c0.y, v.y * c0.x + v.x * c0.y, v.z * c1.x - v.w * c1.y, v.w * c1.x + v.z * c1.y}; }
        u32x2 w; w.x = pk2(v.x, v.y); w.y = pk2(v.z, v.w);
        for (int b = 0; b < BATCH; ++b) {
            if (col >= C_KI && col < C_WI) { const int d0 = col - C_KI;
                *(u32x2*)(ws + WS_KIP + (size_t)b * KIP_BATCH + (size_t)((((t >> 5) * 4 + (d0 >> 4)) * 2 + ((d0 >> 3) & 1)) * 512 + (t & 31) * 16 + (d0 & 7) * 2)) = w; }
            else *(u32x2*)(P + ((size_t)b * T + t) * PW + col) = w;
        }
    }
}

__device__ __forceinline__ void phase_c3(const Params& p, char* lds) {
    unsigned char* ws = p.ws; const int tid = threadIdx.x, lane = tid & 63, wave = __builtin_amdgcn_readfirstlane(tid >> 6);
    const float* H1 = (const float*)(ws + WS_H1); const float* g = p.in[I_GFFN]; bf16_t* U2 = (bf16_t*)(ws + WS_U);
    const bf16_t* WH = (const bf16_t*)(ws + WS_WRT); const bf16_t* WL = WH + WRT_N * D;
    const float* bg = p.in[I_BGRP]; const float* br = p.in[I_BRT];
    unsigned* ctl = (unsigned*)(ws + WS_CTL); int* LIST = (int*)(ws + WS_LIST); float* GATE = (float*)(ws + WS_GATE); float* RS = (float*)(ws + WS_RSTD2);
    float* LG = (float*)lds + wave * (16 * 49 + 16);
    const int gw = blockIdx.x * NWAVES + wave, NGW = gridDim.x * NWAVES;
    const int tr = lane & 15, g4 = lane >> 4;
    for (int tile = gw; tile < NR / 16; tile += NGW) {
        const int row = tile * 16 + tr;
        const float* hp = H1 + (size_t)row * D + 8 * g4; bf16_t* up = U2 + (size_t)row * D + 8 * g4;
        const bf16_t* whp = WH + (size_t)tr * D + 8 * g4; const bf16_t* wlp = WL + (size_t)tr * D + 8 * g4;
        f32x4 acc[3]; float ss = 0.f;
#pragma unroll
        for (int nt = 0; nt < 3; ++nt) acc[nt] = (f32x4){0.f, 0.f, 0.f, 0.f};
        f32x4 xq[4][2]; bf16x8 bc[6], bn[6];
#pragma unroll
        for (int j = 0; j < 4; ++j) { xq[j][0] = *(const f32x4*)(hp + 32 * j); xq[j][1] = *(const f32x4*)(hp + 32 * j + 4); }
#pragma unroll
        for (int nt = 0; nt < 3; ++nt) { bc[2 * nt] = *(const bf16x8*)(whp + (size_t)nt * 16 * D); bc[2 * nt + 1] = *(const bf16x8*)(wlp + (size_t)nt * 16 * D); }
#pragma unroll 4
        for (int s = 0; s < 32; ++s) {
            const f32x4 x0 = xq[s & 3][0], x1 = xq[s & 3][1];
            { const int sn = s + 4 < 32 ? s + 4 : 31; xq[s & 3][0] = *(const f32x4*)(hp + 32 * sn); xq[s & 3][1] = *(const f32x4*)(hp + 32 * sn + 4); }
            { const int sb = s + 1 < 32 ? s + 1 : 31;
#pragma unroll
              for (int nt = 0; nt < 3; ++nt) { bn[2 * nt] = *(const bf16x8*)(whp + (size_t)nt * 16 * D + 32 * sb); bn[2 * nt + 1] = *(const bf16x8*)(wlp + (size_t)nt * 16 * D + 32 * sb); } }
            const f32x4 g0 = *(const f32x4*)(g + 32 * s + 8 * g4), g1 = *(const f32x4*)(g + 32 * s + 8 * g4 + 4);
            ss += (x0.x * x0.x + x0.y * x0.y) + (x0.z * x0.z + x0.w * x0.w) + (x1.x * x1.x + x1.y * x1.y) + (x1.z * x1.z + x1.w * x1.w);
            const f32x4 h0 = x0 * g0, h1 = x1 * g1;
            u32x4 hi; hi.x = pk2(h0.x, h0.y); hi.y = pk2(h0.z, h0.w); hi.z = pk2(h1.x, h1.y); hi.w = pk2(h1.z, h1.w);
            *(u32x4*)(up + 32 * s) = hi;
            u32x4 lo; lo.x = pk2(h0.x - bflo(hi.x), h0.y - bfhi(hi.x)); lo.y = pk2(h0.z - bflo(hi.y), h0.w - bfhi(hi.y)); lo.z = pk2(h1.x - bflo(hi.z), h1.y - bfhi(hi.z)); lo.w = pk2(h1.z - bflo(hi.w), h1.w - bfhi(hi.w));
            const bf16x8 ah = __builtin_bit_cast(bf16x8, hi), al = __builtin_bit_cast(bf16x8, lo);
#pragma unroll
            for (int nt = 0; nt < 3; ++nt) {
                acc[nt] = __builtin_amdgcn_mfma_f32_16x16x32_bf16(ah, bc[2 * nt], acc[nt], 0, 0, 0);
                acc[nt] = __builtin_amdgcn_mfma_f32_16x16x32_bf16(ah, bc[2 * nt + 1], acc[nt], 0, 0, 0);
                acc[nt] = __builtin_amdgcn_mfma_f32_16x16x32_bf16(al, bc[2 * nt], acc[nt], 0, 0, 0);
            }
#pragma unroll
            for (int j = 0; j < 6; ++j) bc[j] = bn[j];
        }
        ss = xsum16(xsum32(ss));
#pragma unroll
        for (int nt = 0; nt < 3; ++nt)
#pragma unroll
            for (int r = 0; r < 4; ++r) LG[(4 * g4 + r) * 49 + 16 * nt + tr] = acc[nt][r];
        if (g4 == 0) LG[16 * 49 + tr] = ss;
        asm volatile("s_waitcnt lgkmcnt(0)" ::: "memory");
        if (lane < 16) {
            const int tok = tile * 16 + lane; const float* lg = LG + lane * 49;
            const float rstd = rsqrtf(LG[16 * 49 + lane] * (1.f / D) + NORM_EPS);
            RS[tok] = rstd;
            float gl[4]; int gs = 0; float gm;
#pragma unroll
            for (int o = 0; o < 4; ++o) gl[o] = lg[o] * rstd + bg[o];
            gm = gl[0];
#pragma unroll
            for (int o = 1; o < 4; ++o) if (gl[o] > gm) { gm = gl[o]; gs = o; }
            float gsum = 0.f;
#pragma unroll
            for (int o = 0; o < 4; ++o) gsum += __expf(gl[o] - gm);
            const float pgrp = 1.f / gsum;
            float el[8];
#pragma unroll
            for (int j = 0; j < 8; ++j) el[j] = lg[4 + gs * 8 + j] * rstd + br[gs * 8 + j];
            int e0 = 0; float m0 = el[0];
#pragma unroll
            for (int j = 1; j < 8; ++j) if (el[j] > m0) { m0 = el[j]; e0 = j; }
            int e1 = -1; float m1 = -3e38f;
#pragma unroll
            for (int j = 0; j < 8; ++j) if (j != e0 && el[j] > m1) { m1 = el[j]; e1 = j; }
            const float x1 = __expf(m1 - m0); const float g0 = pgrp / (1.f + x1), g1 = pgrp * x1 / (1.f + x1);
            const int ex0 = gs * 8 + e0, ex1 = gs * 8 + e1;
            const int s0 = (int)atomicAdd(ctl + CW_CNT + 64 * ex0, 1u); LIST[(size_t)ex0 * NR + s0] = tok * 2;
            const int s1 = (int)atomicAdd(ctl + CW_CNT + 64 * ex1, 1u); LIST[(size_t)ex1 * NR + s1] = tok * 2 + 1;
            GATE[tok * 2] = g0; GATE[tok * 2 + 1] = g1;
        }
        asm volatile("s_waitcnt lgkmcnt(0)" ::: "memory");
    }
}

template <int WHICH>
__device__ __forceinline__ void phase_moe(const Params& p, char* lds) {
    unsigned char* ws = p.ws; const int tid = threadIdx.x;
    const unsigned* ctl = (const unsigned*)(ws + WS_CTL);
    int* TP = (int*)(lds + pg8::STAGE_BYTES);
    __syncthreads();
    if (tid == 0) { int tp = 0, ro = 0; for (int e = 0; e < NEXP; ++e) { const int c = (int)ctl[CW_CNT + 64 * e]; TP[e] = tp; TP[64 + e] = ro; TP[128 + e] = c; const int t = (c + 255) / 256; tp += t * 4; ro += t * 256; } TP[NEXP] = tp; }
    __syncthreads();
    pg8::MoeOrder<WHICH> S{TP, (int)gridDim.x, (int)blockIdx.x, (const char*)(ws + (WHICH == 0 ? WS_U : WS_HID)), (const char*)(ws + (WHICH == 0 ? WS_W13 : WS_W2)), (const int*)(ws + WS_LIST)};
    if constexpr (WHICH == 0) { pg8::EpiMoe1 E{(bf16_t*)(ws + WS_HID), TP, (const int*)(ws + WS_LIST), (const float*)(ws + WS_RSTD2)}; pg8::gemm_phase_x<pg8::EpiMoe1, pg8::MoeOrder<0>, true, true>((LAS unsigned char*)lds, 1024, S, E); }
    else { pg8::EpiMoe2 E{(bf16_t*)(ws + WS_MO), TP, (const int*)(ws + WS_LIST), (const float*)(ws + WS_GATE)}; pg8::gemm_phase_x<pg8::EpiMoe2, pg8::MoeOrder<1>, true, true>((LAS unsigned char*)lds, 512, S, E); }
}

__device__ __forceinline__ void phase_final(const Params& p) {
    unsigned char* ws = p.ws; const int tid = threadIdx.x, lane = tid & 63, wave = tid >> 6;
    const float* H1 = (const float*)(ws + WS_H1); const bf16_t* MO = (const bf16_t*)(ws + WS_MO); const float* g = p.in[I_GFIN];
    const int gw = blockIdx.x * NWAVES + wave, NGW = gridDim.x * NWAVES;
    f32x4 vn[4]; u32x2 an[4], cn[4];
#define FIN_LOAD(r_) do { const size_t row_ = (size_t)(r_); const f32x4* xr_ = (const f32x4*)(H1 + row_ * D) + lane; const u32x2* m0_ = (const u32x2*)(MO + row_ * 2 * D) + lane; \
        _Pragma("unroll") for (int j = 0; j < 4; ++j) { vn[j] = xr_[64 * j]; an[j] = m0_[64 * j]; cn[j] = m0_[256 + 64 * j]; } } while (0)
    if (gw < BATCH * SEQ) FIN_LOAD(gw);
    for (int orow = gw; orow < BATCH * SEQ; orow += NGW) {
        f32x4 v[4]; u32x2 aa[4], cc[4]; float ss = 0.f;
#pragma unroll
        for (int j = 0; j < 4; ++j) { v[j] = vn[j]; aa[j] = an[j]; cc[j] = cn[j]; }
        if (orow + NGW < BATCH * SEQ) FIN_LOAD(orow + NGW);
#pragma unroll
        for (int j = 0; j < 4; ++j) { const u32x2 a = aa[j], c = cc[j];
            v[j].x += bflo(a.x) + bflo(c.x); v[j].y += bfhi(a.x) + bfhi(c.x); v[j].z += bflo(a.y) + bflo(c.y); v[j].w += bfhi(a.y) + bfhi(c.y);
            ss += (v[j].x * v[j].x + v[j].y * v[j].y) + (v[j].z * v[j].z + v[j].w * v[j].w); }
        const float rstd = rsqrtf(wave_sum(ss) * (1.f / D) + NORM_EPS);
        f32x4* o = (f32x4*)(p.out + (size_t)orow * D) + lane;
#pragma unroll
        for (int j = 0; j < 4; ++j) { const f32x4 gg = ((const f32x4*)g)[lane + 64 * j]; o[64 * j] = v[j] * rstd * gg; }
    }
#undef FIN_LOAD
}

#define XB_TMO      128
#define XB_XCNT(j)  (256  + 64 * (j))
#define XB_XSUB(j)  (1280 + 64 * (j))
#define XB_XGEN(j)  (2304 + 64 * (j))
#define XB_TOP      3328
#define XB_TOPGEN   3392
#define XCD_BAR_WORDS 3456
#define XB_SPIN_CAP (1u << 18)
__device__ __forceinline__ unsigned xb_ld(unsigned* p)              { return __hip_atomic_load(p, __ATOMIC_RELAXED, __HIP_MEMORY_SCOPE_AGENT); }
__device__ __forceinline__ unsigned xb_add(unsigned* p, unsigned v) { return __hip_atomic_fetch_add(p, v, __ATOMIC_RELAXED, __HIP_MEMORY_SCOPE_AGENT); }
__device__ __forceinline__ unsigned xb_xcc_id() { return (unsigned)__builtin_amdgcn_s_getreg((3 << 11) | 20) & 0xFu; }
#define XB_SPIN(cond, bar) do { unsigned _sp = 0; while (cond) { __builtin_amdgcn_s_sleep(1); \
    if ((++_sp & 255u) == 0u) { if (xb_ld(&(bar)[XB_TMO])) break; if (_sp > XB_SPIN_CAP) { atomicAdd(&(bar)[XB_TMO], 1u); break; } } } } while (0)
struct XcdBarrier { unsigned* bar; unsigned x; volatile LAS unsigned* st; };
__device__ __forceinline__ XcdBarrier xcd_barrier_post(unsigned* bar, volatile LAS unsigned* st) {
    XcdBarrier b; b.bar = bar; b.x = xb_xcc_id(); b.st = st;
    if (threadIdx.x == 0) (void)xb_add(&bar[XB_XCNT(b.x)], 1u);
    return b;
}
__device__ __forceinline__ void xcd_barrier_complete(unsigned* bar, unsigned x, unsigned& nloc, unsigned& nx) {
    const unsigned G = gridDim.x * gridDim.y * gridDim.z;
    unsigned sum, cnt, mine, sp = 0u;
    for (;;) {
        sum = 0u; cnt = 0u; mine = 0u;
#pragma unroll
        for (unsigned j = 0; j < 16; ++j) { const unsigned c = xb_ld(&bar[XB_XCNT(j)]); sum += c; cnt += (c > 0u) ? 1u : 0u; mine = (j == x) ? c : mine; }
        if (sum == G) break;
        __builtin_amdgcn_s_sleep(1);
        if ((++sp & 255u) == 0u) { if (xb_ld(&bar[XB_TMO])) break; if (sp > XB_SPIN_CAP) { atomicAdd(&bar[XB_TMO], 1u); break; } }
    }
    nloc = mine > 0u ? mine : 1u; nx = cnt > 0u ? cnt : 1u;
}
__device__ __forceinline__ void xcd_barrier(const XcdBarrier& b) {
    asm volatile("s_waitcnt vmcnt(0)" ::: "memory");
    __syncthreads();
    if (threadIdx.x == 0) {
        unsigned* bar = b.bar;
        __builtin_amdgcn_s_waitcnt(0);
        unsigned nloc = b.st[0], nx = b.st[1];
        if (nloc == 0u) { xcd_barrier_complete(bar, b.x, nloc, nx); b.st[0] = nloc; b.st[1] = nx; }
        const unsigned old = xb_add(&bar[XB_XSUB(b.x)], 1u);
        const unsigned gen = old / nloc;
        if (old + 1u == (gen + 1u) * nloc) {
            __builtin_amdgcn_fence(__ATOMIC_RELEASE, "agent");
            asm volatile("s_waitcnt vmcnt(0)" ::: "memory");
            const unsigned og = xb_add(&bar[XB_TOP], 1u);
            const unsigned tg = og / nx;
            if (og + 1u == (tg + 1u) * nx) xb_add(&bar[XB_TOPGEN], 1u);
            else XB_SPIN(xb_ld(&bar[XB_TOPGEN]) == tg, bar);
            __builtin_amdgcn_fence(__ATOMIC_ACQUIRE, "agent");
            xb_add(&bar[XB_XGEN(b.x)], 1u);
            asm volatile("s_waitcnt vmcnt(0)" ::: "memory");
        } else {
            XB_SPIN(xb_ld(&bar[XB_XGEN(b.x)]) == gen, bar);
            __builtin_amdgcn_fence(__ATOMIC_ACQUIRE, "agent");
            asm volatile("s_waitcnt vmcnt(0)" ::: "memory");
        }
    }
    __syncthreads();
}

constexpr int LDS_XB = DSA_LDS;
constexpr int LDS_BYTES = DSA_LDS + 256;
static_assert(pg8::STAGE_BYTES <= LDS_XB && pg8::STAGE_BYTES + 1024 <= LDS_XB && NWAVES * 64 * 33 * 4 <= LDS_XB && NWAVES * 32 * SB_VROW <= LDS_XB && NWAVES * (16 * 49 + 16) * 4 <= LDS_XB, "LDS map");

__global__ void __launch_bounds__(NTHREADS, 2) mega(Params p) {
    extern __shared__ __attribute__((aligned(16))) char lds[];
    const int lo = p.ph_lo, hi = p.ph_hi;
    unsigned char* ws = p.ws;
    XcdBarrier xb;
    {
        volatile LAS unsigned* st = (volatile LAS unsigned*)(lds + LDS_XB);
        if (threadIdx.x < 4) st[threadIdx.x] = 0u;
        __syncthreads();
        xb = xcd_barrier_post((unsigned*)(ws + WS_CTL) + CW_BAR, st);
    }
#define IN(k) (lo <= (k) && (k) < hi)
#define GSYNC() xcd_barrier(xb)
#define SEAM(k) do { if (IN(k) && IN((k) + 1)) GSYNC(); } while (0)
#define REP(k, ...) do { if (IN(k)) { __VA_ARGS__; } } while (0)
    LAS unsigned char* ldsl = (LAS unsigned char*)lds;
    REP(0, phase_prologue(p, lds));
    SEAM(0);
    REP(1, { phase_inproj_meta(p);
             pg8::TokRowOrder S; S.init(NR, PWN, gridDim.x, blockIdx.x); S.Abase = (const char*)(ws + WS_U); S.Bbase = (const char*)(ws + WS_WP); S.K = D;
             pg8::EpiInproj E{(bf16_t*)(ws + WS_P), (const float2*)(ws + WS_CS), ws + WS_KIP}; pg8::gemm_phase_x<pg8::EpiInproj, pg8::TokRowOrder, true, true>(ldsl, D, S, E); });
    SEAM(1);
    if (IN(2)) {
        phase_dsa(p, lds);
        __syncthreads(); phase_sb_fast(p, lds);
    }
    SEAM(2);
    REP(3, { pg8::TokRowOrder S; S.init(NR, 2048, gridDim.x, blockIdx.x); S.Abase = (const char*)(ws + WS_U); S.Bbase = (const char*)(ws + WS_WG); S.K = D;
             pg8::EpiGate E{(bf16_t*)(ws + WS_G)}; pg8::gemm_phase_x<pg8::EpiGate, pg8::TokRowOrder, true, true>(ldsl, D, S, E); });
    SEAM(3);
    REP(4, { pg8::StaticOrder S; S.init(NR, D, gridDim.x, blockIdx.x);
             pg8::gemm_phase_zf(ldsl, (const bf16_t*)(ws + WS_YA), (const bf16_t*)(ws + WS_WUA), (const bf16_t*)(ws + WS_OLAT), (const bf16_t*)(ws + WS_WBP), S, (const bf16_t*)(ws + WS_G), (bf16_t*)(ws + WS_Z)); });
    SEAM(4);
    REP(5, { pg8::Gemm g{(const bf16_t*)(ws + WS_Z), (const bf16_t*)(ws + WS_WO), NR, D, D}; pg8::StaticOrder S; S.init(NR, D, gridDim.x, blockIdx.x);
             pg8::EpiH1 E{(float*)(ws + WS_H1), p.in[I_META], p.in[I_X]}; pg8::gemm_phase<pg8::EpiH1, pg8::StaticOrder, true, true>(ldsl, g, S, E); });
    SEAM(5);
    if (IN(6)) phase_c3(p, lds);
    SEAM(6);
    REP(7, phase_moe<0>(p, lds));
    SEAM(7);
    REP(8, phase_moe<1>(p, lds));
    SEAM(8);
    REP(9, phase_final(p));
}

extern "C" void kernel_launch(void* const* d_in, const int* in_sizes, int n_in, void* d_out, int out_size, void* d_ws, size_t ws_size, hipStream_t stream) {
    if (n_in != 18 || ws_size < WS_END) { fprintf(stderr, "kernel_launch: unexpected n_in %d / ws_size %zu\n", n_in, ws_size); return; }
    static int grid = 0;
    if (grid == 0) {
        int dev = 0, cus = 0, per_cu = 0;
        (void)hipGetDevice(&dev);
        (void)hipDeviceGetAttribute(&cus, hipDeviceAttributeMultiprocessorCount, dev);
        (void)hipFuncSetAttribute((const void*)mega, hipFuncAttributeMaxDynamicSharedMemorySize, LDS_BYTES);
        (void)hipOccupancyMaxActiveBlocksPerMultiprocessor(&per_cu, (const void*)mega, NTHREADS, LDS_BYTES);
        if (per_cu < 1) fprintf(stderr, "kernel_launch: occupancy query reports %d workgroups per CU\n", per_cu);
        grid = cus;
    }
    (void)hipMemsetAsync((char*)d_ws + WS_CTL, 0, CTL_BYTES, stream);
    Params p{};
    for (int i = 0; i < 18; ++i) p.in[i] = (const float*)d_in[i];
    p.out = (float*)d_out; p.ws = (unsigned char*)d_ws;
    p.ph_lo = 0; p.ph_hi = 10;
    void* args[] = {&p};
    hipError_t e = hipLaunchCooperativeKernel((const void*)mega, dim3(grid), dim3(NTHREADS), args, LDS_BYTES, stream);
    if (e != hipSuccess) fprintf(stderr, "cooperative launch failed: %s (grid %d)\n", hipGetErrorString(e), grid);
}
```

```cpp
#include <hip/hip_runtime.h>
#include <cstdio>
#include <cstdint>

constexpr int BATCH = 8, SEQ = 4096, NMETA = 16, T = SEQ + NMETA, D = 1024, NTOK = BATCH * T;
constexpr int MROWS = 33024;
constexpr int NR = BATCH * SEQ;
__device__ __forceinline__ int tokrow(int cr) { return cr + NMETA * (cr / SEQ + 1); }
constexpr int INW = 4824;
constexpr int NEXP = 32, DEXP = 512;
constexpr int NWAVES = 8, NTHREADS = 512;
constexpr float NORM_EPS = 1e-6f;
constexpr float LOG2E = 1.4426950408889634f;
constexpr float QSCALE = 0.125f * LOG2E;
constexpr int PW = 3456, PWN = 3584;
constexpr int C_QA = 0, C_KA = 512, C_VA = 1024, C_QF = 1536, C_KV = 2688, C_QI = 2832, C_KI = 3344, C_WI = 3408, C_END = 3416;
constexpr int QFW = 144;

constexpr size_t MiB = 1u << 20;
constexpr size_t WS_CTL = 0, CTL_BYTES = 1 * MiB;
constexpr size_t WS_CS = 1 * MiB;
constexpr size_t WS_WRT = 1 * MiB + 512 * 1024;
constexpr int WRT_N = 48;
constexpr size_t WS_WP = 2 * MiB;
constexpr size_t WS_WG = 9 * MiB;
constexpr size_t WS_WUA = 13 * MiB, WS_WBP = 14 * MiB, WS_WO = 16 * MiB;
constexpr size_t WS_W2 = 18 * MiB;
constexpr size_t WS_W13 = 50 * MiB;
constexpr size_t WS_U = 114 * MiB;
constexpr size_t WS_P = 179 * MiB;
constexpr size_t WS_Z = 179 * MiB;
constexpr size_t WS_G = 244 * MiB;
constexpr size_t WS_H1 = 244 * MiB;
constexpr size_t WS_LIST = 374 * MiB;
constexpr size_t WS_GATE = 379 * MiB;
constexpr size_t WS_RSTD2 = 380 * MiB;
constexpr size_t WS_YA = 397 * MiB;
constexpr size_t WS_OLAT = 430 * MiB;
constexpr size_t WS_HID = 397 * MiB;
constexpr size_t WS_MO = 50 * MiB;
constexpr size_t WS_KIP = 495 * MiB;
constexpr size_t KIP_BATCH = 129 * 4096;
constexpr size_t WS_END = 500 * MiB;
static_assert(WS_P + (size_t)MROWS * PW * 2 <= WS_YA && WS_G + (size_t)MROWS * 2048 * 2 <= WS_LIST && WS_Z + (size_t)MROWS * 1024 * 2 <= WS_G, "ws map");
static_assert(WS_OLAT + (size_t)MROWS * 1024 * 2 <= WS_END && WS_U + (size_t)MROWS * 1024 * 2 <= WS_P && WS_MO + (size_t)NTOK * 2048 * 2 <= WS_P, "ws map");
constexpr int CW_CNT = 1024;
constexpr int CW_BAR = 4096;

typedef unsigned short bf16_t;
typedef short bf16x8 __attribute__((ext_vector_type(8)));
typedef float f32x4 __attribute__((ext_vector_type(4)));
typedef float f32x16 __attribute__((ext_vector_type(16)));
typedef unsigned u32x2 __attribute__((ext_vector_type(2)));
typedef unsigned u32x4 __attribute__((ext_vector_type(4)));
typedef unsigned short u16x4 __attribute__((ext_vector_type(4)));
typedef short s16x2 __attribute__((ext_vector_type(2)));
#define LAS __attribute__((address_space(3)))

__device__ __forceinline__ unsigned f2bf(float f) { unsigned u = __float_as_uint(f); return (u + 0x7fffu + ((u >> 16) & 1u)) >> 16; }
typedef __bf16 bf16v2_t __attribute__((ext_vector_type(2)));
typedef float f32v2_t __attribute__((ext_vector_type(2)));
__device__ __forceinline__ unsigned pk2(float lo, float hi) { const f32v2_t v = {lo, hi}; const bf16v2_t r = __builtin_convertvector(v, bf16v2_t); return __builtin_bit_cast(unsigned, r); }
__device__ __forceinline__ float bflo(unsigned w) { return __uint_as_float(w << 16); }
__device__ __forceinline__ float bfhi(unsigned w) { return __uint_as_float(w & 0xffff0000u); }
__device__ __forceinline__ float bf2f(bf16_t b) { return __uint_as_float((unsigned)b << 16); }
__device__ __forceinline__ float wave_sum(float v) {
#pragma unroll
    for (int o = 1; o < 64; o <<= 1) v += __shfl_xor(v, o);
    return v;
}
__device__ __forceinline__ float fmax2(float a, float b) { return __builtin_amdgcn_fmed3f(a, b, 3.0e38f); }
__device__ __forceinline__ float xsum32(float x) { const auto r = __builtin_amdgcn_permlane32_swap(__float_as_uint(x), __float_as_uint(x), false, false); return __uint_as_float(r[0]) + __uint_as_float(r[1]); }
__device__ __forceinline__ float xsum16(float x) { const auto r = __builtin_amdgcn_permlane16_swap(__float_as_uint(x), __float_as_uint(x), false, false); return __uint_as_float(r[0]) + __uint_as_float(r[1]); }
__device__ __forceinline__ float xmax32(float x) { const auto r = __builtin_amdgcn_permlane32_swap(__float_as_uint(x), __float_as_uint(x), false, false); return fmax2(__uint_as_float(r[0]), __uint_as_float(r[1])); }
__device__ __forceinline__ float xmax16(float x) { const auto r = __builtin_amdgcn_permlane16_swap(__float_as_uint(x), __float_as_uint(x), false, false); return fmax2(__uint_as_float(r[0]), __uint_as_float(r[1])); }
__device__ __forceinline__ float xpartner32(float x, int hh) { const auto r = __builtin_amdgcn_permlane32_swap(__float_as_uint(x), __float_as_uint(x), false, false); return __uint_as_float(hh ? r[0] : r[1]); }
__device__ __forceinline__ float fexp2(float x) { return __builtin_amdgcn_exp2f(x); }
__device__ __forceinline__ float sigmoidf(float x) { return __builtin_amdgcn_rcpf(1.0f + fexp2(-LOG2E * x)); }

struct Params {
    const float* in[18];
    float* out;
    unsigned char* ws;
    int ph_lo, ph_hi;
};
enum { I_X = 0, I_META, I_GMIX, I_WIN, I_WUK, I_WUV, I_WUPA, I_WUPB, I_WO, I_GFFN, I_WGRP, I_BGRP, I_WRT, I_BRT, I_W1, I_W3, I_W2, I_GFIN };

__device__ __forceinline__ const float* h0_row(const Params& p, int row) {
    const int b = row / T, t = row - b * T;
    return t < NMETA ? p.in[I_META] + (size_t)t * D : p.in[I_X] + ((size_t)b * SEQ + (t - NMETA)) * D;
}
template <class F>
__device__ __forceinline__ void tr_item(F val, bf16_t* dst, int ldd, int row0, int k0, float* scr, int lane, int rstep = 1) {
    float tv[32];
#pragma unroll
    for (int i = 0; i < 32; ++i) tv[i] = val(k0 + 2 * i + (lane >> 5), lane & 31);
#pragma unroll
    for (int i = 0; i < 32; ++i) scr[(2 * i + (lane >> 5)) * 33 + (lane & 31)] = tv[i];
    __builtin_amdgcn_s_waitcnt(0xC07F);
    asm volatile("" ::: "memory");
    const int c = lane & 7;
#pragma unroll
    for (int j = 0; j < 4; ++j) {
        const int n = (lane >> 3) + 8 * j; const float* s = scr + (8 * c) * 33 + n;
        u32x4 o; o.x = pk2(s[0], s[33]); o.y = pk2(s[66], s[99]); o.z = pk2(s[132], s[165]); o.w = pk2(s[198], s[231]);
        *(u32x4*)(dst + (size_t)(row0 + n * rstep) * ldd + k0 + 8 * c) = o;
    }
    __builtin_amdgcn_s_waitcnt(0xC07F);
    asm volatile("" ::: "memory");
}

__device__ __forceinline__ void wp_src(int c, int& kind, int& col, int& aux, float& scale) {
    kind = 1; aux = 0; scale = 1.f; col = 0;
    if (c < 512) { col = c; scale = QSCALE; }
    else if (c < C_QF) { col = c; }
    else if (c < C_KV) { const int r = c - C_QF, h = r / QFW, j = r % QFW; scale = QSCALE;
        if (j < 128) { kind = 2; col = h; aux = j; } else { const int i = j - 128; col = 1536 + 64 * h + (i >> 1) + 8 * (i & 1); } }
    else if (c < C_QI) { const int j = c - C_KV; if (j < 128) col = 2048 + j; else { const int i = j - 128; col = 2176 + (i >> 1) + 8 * (i & 1); } }
    else if (c < C_KI) { const int r = c - C_QI, h = r >> 6, j = r & 63; col = 2192 + 64 * h + (j < 16 ? (j >> 1) + 8 * (j & 1) : j); }
    else if (c < C_WI) { const int j = c - C_KI; col = 2704 + (j < 16 ? (j >> 1) + 8 * (j & 1) : j); }
    else if (c < C_END) { col = 2768 + (c - C_WI); }
    else kind = 0;
}

constexpr int IT_WP = (PWN / 32) * 16;
constexpr int IT_WG = 32 * 16;
constexpr int IT_WUA = 32 * 8;
constexpr int IT_WBP = 32 * 16, IT_WO = 32 * 16;
constexpr int IT_W13 = NEXP * 32 * 16;
constexpr int IT_W2 = NEXP * 32 * 8;
constexpr int IT_TOTAL = IT_WP + 2 * IT_WG + IT_WUA + IT_WBP + IT_WO + IT_W13 + IT_W2;

__device__ __forceinline__ void phase_prologue(const Params& p, char* lds) {
    const int tid = threadIdx.x, lane = tid & 63, wave = tid >> 6;
    const int gw = blockIdx.x * NWAVES + wave, NGW = gridDim.x * NWAVES;
    float* scr = (float*)lds + wave * (64 * 33);
    unsigned char* ws = p.ws;
    const float* w_in = p.in[I_WIN];
    {
        float2* cs = (float2*)(ws + WS_CS);
        for (int i = blockIdx.x * NTHREADS + tid; i < T * 8; i += gridDim.x * NTHREADS) {
            const int pos = i >> 3, f = i & 7;
            const float inv = powf(500000.0f, -(float)f / 8.0f);
            const float ang = (float)pos * inv;
            cs[i] = make_float2(cosf(ang), sinf(ang));
        }
    }
    {
        bf16_t* wrt = (bf16_t*)(ws + WS_WRT); const float* wgp = p.in[I_WGRP]; const float* wrp = p.in[I_WRT];
        for (int i = blockIdx.x * NTHREADS + tid; i < WRT_N * D; i += gridDim.x * NTHREADS) {
            const int nn = i >> 10, k = i & 1023;
            const float w = nn < 4 ? wgp[k * 4 + nn] : nn < 36 ? wrp[k * 32 + (nn - 4)] : 0.f;
            const unsigned hi = f2bf(w); wrt[i] = (bf16_t)hi; wrt[WRT_N * D + i] = (bf16_t)f2bf(w - __uint_as_float(hi << 16));
        }
    }
    for (int it = gw; it < IT_TOTAL; it += NGW) {
        int r = it;
        if (r < IT_WP) {
            const int rg = r / 16, kb = r % 16, c = rg * 32 + (lane & 31);
            int kind, col, aux; float scale; wp_src(c, kind, col, aux, scale);
            const float* w_uk = p.in[I_WUK];
            float wu[48];
#pragma unroll
            for (int n4 = 0; n4 < 12; ++n4) { f32x4 t = (f32x4){0.f, 0.f, 0.f, 0.f}; if (kind == 2) t = *(const f32x4*)(w_uk + ((size_t)col * 128 + aux) * 48 + 4 * n4); wu[4 * n4] = t.x; wu[4 * n4 + 1] = t.y; wu[4 * n4 + 2] = t.z; wu[4 * n4 + 3] = t.w; }
            tr_item([&](int k, int) -> float {
                if (kind == 0) return 0.f;
                if (kind == 1) return scale * w_in[(size_t)k * INW + col];
                const f32x4* wi = (const f32x4*)(w_in + (size_t)k * INW + 1536 + 64 * col + 16);
                float s = 0.f;
#pragma unroll
                for (int n4 = 0; n4 < 12; ++n4) { const f32x4 t = wi[n4]; s += t.x * wu[4 * n4] + t.y * wu[4 * n4 + 1] + t.z * wu[4 * n4 + 2] + t.w * wu[4 * n4 + 3]; }
                return scale * s; }, (bf16_t*)(ws + WS_WP), 1024, rg * 32, kb * 64, scr, lane);
            continue; }
        r -= IT_WP;
        if (r < 2 * IT_WG) {
            const int which = r / IT_WG; r %= IT_WG; const int rg = r / 16, kb = r % 16; const int col0 = (which ? 3800 : 2776) + rg * 32;
            tr_item([&](int k, int n) -> float { return w_in[(size_t)k * INW + col0 + n]; }, (bf16_t*)(ws + WS_WG) + (size_t)which * 1024 * 1024, 1024, rg * 32, kb * 64, scr, lane);
            continue; }
        r -= 2 * IT_WG;
        if (r < IT_WUA) {
            const int rg = r / 8, kb = r % 8; const float* w = p.in[I_WUPA];
            tr_item([&](int k, int n) -> float { return w[(size_t)k * 1024 + rg * 32 + n]; }, (bf16_t*)(ws + WS_WUA), 512, rg * 32, kb * 64, scr, lane);
            continue; }
        r -= IT_WUA;
        if (r < IT_WO) {
            const int rg = r / 16, kb = r % 16; const float* w = p.in[I_WO];
            tr_item([&](int k, int n) -> float { return w[(size_t)k * 1024 + rg * 32 + n]; }, (bf16_t*)(ws + WS_WO), 1024, rg * 32, kb * 64, scr, lane);
            continue; }
        r -= IT_WO;
        if (r < IT_WBP) {
            const int rg = r / 16, kb = r % 16; const float* wuv = p.in[I_WUV]; const float* wub = p.in[I_WUPB];
            const int hB = kb >> 1;
            float bc[64];
#pragma unroll
            for (int d = 0; d < 64; ++d) bc[d] = wub[(size_t)(64 * hB + d) * 1024 + rg * 32 + (lane & 31)];
            tr_item([&](int kk, int) -> float {
                const f32x4* a = (const f32x4*)(wuv + (size_t)kk * 64);
                float s = 0.f;
#pragma unroll
                for (int d4 = 0; d4 < 16; ++d4) { const f32x4 t = a[d4]; s += t.x * bc[4 * d4] + t.y * bc[4 * d4 + 1] + t.z * bc[4 * d4 + 2] + t.w * bc[4 * d4 + 3]; }
                return s; }, (bf16_t*)(ws + WS_WBP), 1024, rg * 32, kb * 64, scr, lane);
            continue; }
        r -= IT_WBP;
        if (r < IT_W13) {
            const int e = r / 512; r %= 512; const int which = r & 1, cg = (r >> 1) & 15, kb = r >> 5;
            const float* w = (which ? p.in[I_W3] : p.in[I_W1]) + (size_t)e * 1024 * 512 + cg * 32;
            tr_item([&](int k, int n) -> float { return w[(size_t)k * 512 + n]; },
                    (bf16_t*)(ws + WS_W13) + (size_t)e * 1024 * 1024, 1024, 2 * cg * 32 + which, kb * 64, scr, lane, 2);
            continue; }
        r -= IT_W13;
        {
            const int e = r / 256; r %= 256; const int rg = r / 8, kb = r % 8;
            const float* w2 = p.in[I_W2] + (size_t)e * 512 * 1024;
            tr_item([&](int k, int n) -> float { return w2[(size_t)k * 1024 + rg * 32 + n]; }, (bf16_t*)(ws + WS_W2) + (size_t)e * 1024 * 512, 512, rg * 32, kb * 64, scr, lane);
        }
    }
    {
        const float* g = p.in[I_GMIX]; bf16_t* U = (bf16_t*)(ws + WS_U);
        f32x4 vn[4];
        if (gw < NTOK) { const f32x4* xr = (const f32x4*)h0_row(p, gw) + lane;
#pragma unroll
            for (int j = 0; j < 4; ++j) vn[j] = xr[64 * j]; }
        for (int row = gw; row < NTOK; row += NGW) {
            f32x4 v[4]; float s = 0.f;
#pragma unroll
            for (int j = 0; j < 4; ++j) v[j] = vn[j];
            if (row + NGW < NTOK) { const f32x4* xr = (const f32x4*)h0_row(p, row + NGW) + lane;
#pragma unroll
                for (int j = 0; j < 4; ++j) vn[j] = xr[64 * j]; }
#pragma unroll
            for (int j = 0; j < 4; ++j) s += (v[j].x * v[j].x + v[j].y * v[j].y) + (v[j].z * v[j].z + v[j].w * v[j].w);
            const float rstd = rsqrtf(wave_sum(s) * (1.f / D) + NORM_EPS);
            u32x2* o = (u32x2*)(U + (size_t)row * D) + lane;
#pragma unroll
            for (int j = 0; j < 4; ++j) { const f32x4 gg = ((const f32x4*)g)[lane + 64 * j];
                u32x2 w; w.x = pk2(v[j].x * rstd * gg.x, v[j].y * rstd * gg.y); w.y = pk2(v[j].z * rstd * gg.z, v[j].w * rstd * gg.w); o[64 * j] = w; }
        }
    }
}

namespace pg8 {
#define PG8_LAS __attribute__((address_space(3)))
typedef unsigned short bf16_t;
typedef short bf16x8 __attribute__((ext_vector_type(8)));
typedef float f32x4 __attribute__((ext_vector_type(4)));
typedef unsigned u32x4 __attribute__((ext_vector_type(4)));
constexpr int BM = 256, BK = 64, HALF = 128, HTB = HALF * BK * 2  , STAGE_BYTES = 8 * HTB, NXCD = 8, WGM = 8;

__host__ __device__ __forceinline__ int lds_byte(int r, int c) { const int st = (r >> 4) * 2 + (c >> 5), rr = r & 15, cc = c & 31, ob = rr * 64 + cc * 2; return st * 1024 + (ob ^ (((ob >> 9) & 1) << 5)); }
__host__ __device__ __forceinline__ void stage_rc(int b, int& R, int& C) { const int st = b / 1024, sb = b % 1024, swz = sb ^ (((sb >> 9) & 1) << 5); R = (st >> 1) * 16 + swz / 64; C = (st & 1) * 32 + (swz % 64) / 2; }
__host__ __device__ __forceinline__ int perm32(int rho) { const int n = rho >> 4, i = rho & 15; return 8 * (i >> 2) + 4 * n + (i & 3); }

struct Unit { int pm, pn; };
struct Gemm { const bf16_t* A; const bf16_t* Bt; int M, N, K; };

struct StaticOrder {
    int nM, nN, nwg, G, c;
    __host__ __device__ void init(int M, int N, int G_, int c_) { nM = M / BM; nN = N / BM; nwg = nM * nN; G = G_; c = c_; }
    __host__ __device__ bool next(int i, Unit& u) const {
        const long L = (long)i * G + c; if (L >= nwg) return false;
        int wgid = (int)L; { const int q = nwg / NXCD, r = nwg % NXCD, xcd = wgid % NXCD, off = wgid / NXCD; wgid = (xcd < r ? xcd * (q + 1) : r * (q + 1) + (xcd - r) * q) + off; }
        const int nig = WGM * nN, gid = wgid / nig, fm = gid * WGM, gsz = (nM - fm) < WGM ? (nM - fm) : WGM;
        u.pm = fm + ((wgid % nig) % gsz); u.pn = (wgid % nig) / gsz; return true;
    }
    __device__ __forceinline__ void a_ready(const Unit&) const {}
    __device__ __forceinline__ void done(const Unit&) const {}
};


#define PG8_FOR_FRAGS(...) _Pragma("unroll") for (int ai = 0; ai < 2; ++ai) _Pragma("unroll") for (int m = 0; m < 4; ++m) { const int row = u.pm * BM + ai * HALF + wr * 64 + m * 16 + fr; \
    _Pragma("unroll") for (int bj = 0; bj < 2; ++bj) _Pragma("unroll") for (int n = 0; n < 2; ++n) { const int col = u.pn * BM + bj * HALF + wc * 32 + n * 16 + 4 * fq; ::f32x4 v = acc[ai][bj][m][n]; __VA_ARGS__ } }
__device__ __forceinline__ bool rope_off(int c, int& o) {
    if (c < C_QF) return false;
    if (c < C_KV) { const int j = (c - C_QF) % QFW; o = j - 128; return j >= 128; }
    if (c < C_QI) { const int j = c - C_KV; o = j - 128; return j >= 128; }
    if (c < C_KI) { const int j = (c - C_QI) & 63; o = j; return j < 16; }
    if (c < C_WI) { const int j = c - C_KI; o = j; return j < 16; }
    return false;
}
#define PG8_FOR_FRAGS8(...) _Pragma("unroll") for (int ai = 0; ai < 2; ++ai) _Pragma("unroll") for (int m = 0; m < 4; ++m) { const int row = u.pm * BM + ai * HALF + wr * 64 + m * 16 + fr; \
    _Pragma("unroll") for (int bj = 0; bj < 2; ++bj) { const int col = u.pn * BM + bj * HALF + wc * 32 + 8 * fq; ::f32x4 v0 = acc[ai][bj][m][0], v1 = acc[ai][bj][m][1]; __VA_ARGS__ } }
struct EpiInproj {
    static constexpr bool PERM = true, AFTER_DRAIN = false;
    bf16_t* P; const float2* cs; unsigned char* KIP;
    __device__ __forceinline__ void operator()(const f32x4 (&acc)[2][2][4][2], const Unit& u, int wr, int wc, int fr, int fq) const {
        PG8_FOR_FRAGS8(
            if (col < PW) {
                int o; const int trow = tokrow(row);
                if (rope_off(col, o)) {
                    const int pos = (row % SEQ) + NMETA; const float2* cp = cs + pos * 8 + (o >> 1); const float2 c0 = cp[0], c1 = cp[1], c2 = cp[2], c3 = cp[3];
                    v0 = (::f32x4){v0.x * c0.x - v0.y * c0.y, v0.y * c0.x + v0.x * c0.y, v0.z * c1.x - v0.w * c1.y, v0.w * c1.x + v0.z * c1.y};
                    v1 = (::f32x4){v1.x * c2.x - v1.y * c2.y, v1.y * c2.x + v1.x * c2.y, v1.z * c3.x - v1.w * c3.y, v1.w * c3.x + v1.z * c3.y};
                }
                ::u32x4 w; w.x = pk2(v0.x, v0.y); w.y = pk2(v0.z, v0.w); w.z = pk2(v1.x, v1.y); w.w = pk2(v1.z, v1.w);
                if (col >= C_KI && col < C_WI) {
                    const int b = row / SEQ, t = row - b * SEQ + NMETA, d0 = col - C_KI;
                    *(::u32x4*)(KIP + (size_t)b * KIP_BATCH + (size_t)((((t >> 5) * 4 + (d0 >> 4)) * 2 + ((d0 >> 3) & 1)) * 512 + (t & 31) * 16)) = w;
                } else *(::u32x4*)(P + (size_t)trow * PW + col) = w;
            })
    }
};
struct EpiGate {
    static constexpr bool PERM = true, AFTER_DRAIN = false;
    bf16_t* G;
    __device__ __forceinline__ void operator()(const f32x4 (&acc)[2][2][4][2], const Unit& u, int wr, int wc, int fr, int fq) const {
        PG8_FOR_FRAGS8( ::u32x4 w; w.x = pk2(sigmoidf(v0.x), sigmoidf(v0.y)); w.y = pk2(sigmoidf(v0.z), sigmoidf(v0.w)); w.z = pk2(sigmoidf(v1.x), sigmoidf(v1.y)); w.w = pk2(sigmoidf(v1.z), sigmoidf(v1.w));
            *(::u32x4*)(G + (size_t)row * 2048 + col) = w; )
    }
};
template <bool ACCUM> struct EpiZ {
    static constexpr bool PERM = true, AFTER_DRAIN = false;
    bf16_t* Z; const bf16_t* G; int goff;
    __device__ __forceinline__ void operator()(const f32x4 (&acc)[2][2][4][2], const Unit& u, int wr, int wc, int fr, int fq) const {
        PG8_FOR_FRAGS8(
            const ::u32x4 g = *(const ::u32x4*)(G + (size_t)row * 2048 + goff + col);
            ::f32x4 z0 = (::f32x4){bflo(g.x) * v0.x, bfhi(g.x) * v0.y, bflo(g.y) * v0.z, bfhi(g.y) * v0.w}, z1 = (::f32x4){bflo(g.z) * v1.x, bfhi(g.z) * v1.y, bflo(g.w) * v1.z, bfhi(g.w) * v1.w};
            ::u32x4* zp = (::u32x4*)(Z + (size_t)row * D + col);
            if (ACCUM) { const ::u32x4 o = *zp; z0.x += bflo(o.x); z0.y += bfhi(o.x); z0.z += bflo(o.y); z0.w += bfhi(o.y); z1.x += bflo(o.z); z1.y += bfhi(o.z); z1.z += bflo(o.w); z1.w += bfhi(o.w); }
            ::u32x4 w; w.x = pk2(z0.x, z0.y); w.y = pk2(z0.z, z0.w); w.z = pk2(z1.x, z1.y); w.w = pk2(z1.z, z1.w); *zp = w; )
    }
};
struct EpiH1 {
    static constexpr bool PERM = true, AFTER_DRAIN = false;
    float* H1; const float* meta; const float* x;
    __device__ __forceinline__ void operator()(const f32x4 (&acc)[2][2][4][2], const Unit& u, int wr, int wc, int fr, int fq) const {
        PG8_FOR_FRAGS8( const float* xp = x + (size_t)row * D + col; float* hp = H1 + (size_t)row * D + col; const ::f32x4 h0 = *(const ::f32x4*)xp, h1 = *(const ::f32x4*)(xp + 4);
            *(::f32x4*)hp = h0 + v0; *(::f32x4*)(hp + 4) = h1 + v1; )
    }
};
#undef PG8_FOR_FRAGS
#undef PG8_FOR_FRAGS8

template <class Epi, class Sched, bool ALIGN_EPI = false, bool SP2 = false>
__device__ __forceinline__ void gemm_phase(PG8_LAS unsigned char* lds, const Gemm g, const Sched& S, const Epi& E) {
    const int tid = threadIdx.x, wid = __builtin_amdgcn_readfirstlane(tid >> 6), lane = tid & 63, wr = wid >> 2, wc = wid & 3, fr = lane & 15, fq = lane >> 4;
    const int K = g.K, nt = K / BK;
    unsigned voffA[2], voffB[2];
#pragma unroll
    for (int i = 0; i < 2; ++i) { int R, C; stage_rc(tid * 16 + i * 8192, R, C); const int Rb = Epi::PERM ? ((R & ~31) + perm32(R & 31)) : R;
        voffA[i] = (unsigned)(R * K + C) * 2u; voffB[i] = (unsigned)(Rb * K + C) * 2u; }
    const size_t kstep = (size_t)(BK * 2);
    const size_t hstep = (size_t)HALF * K * 2;
    const size_t tstep = 2 * hstep;
    const unsigned ldsw = (unsigned)wid * 1024u;
    const int aoff = lds_byte(wr * 64 + fr, fq * 8), boff = lds_byte(wc * 32 + fr, fq * 8);
#define PG8_SA(b, h) (((b) * 2 + (h)) * HTB)
#define PG8_SB(b, h) ((4 + (b) * 2 + (h)) * HTB)
#define PG8_STAGE(bufoff, gbase, voff) do { _Pragma("unroll") for (int _i = 0; _i < 2; ++_i) { unsigned o_ = (voff)[_i]; asm volatile("" : "+v"(o_));   \
        __builtin_amdgcn_global_load_lds((const unsigned*)((const char*)(gbase) + o_), (PG8_LAS unsigned*)(lds + (bufoff) + ldsw + _i * 8192), 16, 0, 0); } } while (0)
#define PG8_LDA(dst, b, h) do { _Pragma("unroll") for (int m = 0; m < 4; ++m) _Pragma("unroll") for (int k = 0; k < 2; ++k) dst[m][k] = *(const PG8_LAS bf16x8*)(lds + PG8_SA(b, h) + aoff + m * 2048 + k * 1024); } while (0)
#define PG8_LDB(dst, b, h) do { _Pragma("unroll") for (int n = 0; n < 2; ++n) _Pragma("unroll") for (int k = 0; k < 2; ++k) dst[n][k] = *(const PG8_LAS bf16x8*)(lds + PG8_SB(b, h) + boff + n * 2048 + k * 1024); } while (0)
#define PG8_MMA(ai, bj, At, Bt) do { __builtin_amdgcn_s_setprio(1); _Pragma("unroll") for (int m = 0; m < 4; ++m) _Pragma("unroll") for (int n = 0; n < 2; ++n) _Pragma("unroll") for (int k = 0; k < 2; ++k) \
        acc[ai][bj][m][n] = __builtin_amdgcn_mfma_f32_16x16x32_bf16(Bt[n][k], At[m][k], acc[ai][bj][m][n], 0, 0, 0); __builtin_amdgcn_s_setprio(0); } while (0)
#define PG8_WAIT_V(n) asm volatile("s_waitcnt vmcnt(" #n ")" ::: "memory")
#define PG8_WAIT_L(n) asm volatile("s_waitcnt lgkmcnt(" #n ")" ::: "memory")
#define PG8_BAR __builtin_amdgcn_s_barrier()
#define PG8_SCHED __builtin_amdgcn_sched_barrier(0)
    Unit cur, nxt; int ui = 0;
    if (!S.next(0, cur)) return;
    f32x4 acc[2][2][4][2];
#pragma unroll
    for (int a = 0; a < 2; ++a)
#pragma unroll
        for (int b = 0; b < 2; ++b)
#pragma unroll
            for (int m = 0; m < 4; ++m)
#pragma unroll
                for (int n = 0; n < 2; ++n) acc[a][b][m][n] = (f32x4){0.f, 0.f, 0.f, 0.f};
    bf16x8 At[4][2], B0[2][2], B1[2][2];
    const char* cA = (const char*)g.A + (size_t)cur.pm * tstep; const char* cB = (const char*)g.Bt + (size_t)cur.pn * tstep;
    S.a_ready(cur);
    if constexpr (SP2) {
        PG8_STAGE(PG8_SB(0, 0), cB, voffB); PG8_STAGE(PG8_SB(0, 1), cB + hstep, voffB); PG8_STAGE(PG8_SA(0, 0), cA, voffA); PG8_STAGE(PG8_SA(0, 1), cA + hstep, voffA);
        if (wr == 1) PG8_BAR;
        PG8_WAIT_V(2); PG8_BAR;
        PG8_STAGE(PG8_SB(1, 0), cB + kstep, voffB); PG8_STAGE(PG8_SA(1, 0), cA + kstep, voffA); PG8_STAGE(PG8_SB(1, 1), cB + hstep + kstep, voffB);
        PG8_WAIT_V(6); PG8_BAR;
    } else {
        PG8_STAGE(PG8_SB(0, 0), cB, voffB); PG8_STAGE(PG8_SA(0, 0), cA, voffA); PG8_STAGE(PG8_SB(0, 1), cB + hstep, voffB); PG8_STAGE(PG8_SA(0, 1), cA + hstep, voffA);
        if (wr == 1) PG8_BAR;
        PG8_WAIT_V(4); PG8_BAR;
        PG8_STAGE(PG8_SB(1, 0), cB + kstep, voffB); PG8_STAGE(PG8_SA(1, 0), cA + kstep, voffA); PG8_STAGE(PG8_SB(1, 1), cB + hstep + kstep, voffB);
        PG8_WAIT_V(6); PG8_BAR;
    }
    for (;;) {
        const bool has_next = S.next(ui + 1, nxt);
        const char* nA = has_next ? (const char*)g.A + (size_t)nxt.pm * tstep : cA; const char* nB = has_next ? (const char*)g.Bt + (size_t)nxt.pn * tstep : cB;
        for (int t = 0; t < nt; t += 2) {
            const bool last = (t == nt - 2);
            const char* a1 = cA + (size_t)(t + 1) * kstep;
            const char* a2 = last ? nA : cA + (size_t)(t + 2) * kstep; const char* b2 = last ? nB : cB + (size_t)(t + 2) * kstep;
            const char* a3 = a2 + kstep; const char* b3 = b2 + kstep;
            if (last && has_next) S.a_ready(nxt);
            if constexpr (SP2) {
            PG8_LDB(B0, 0, 0); PG8_LDB(B1, 0, 1); PG8_SCHED; PG8_LDA(At, 0, 0); PG8_STAGE(PG8_SA(1, 1), a1 + hstep, voffA);
            PG8_WAIT_V(8); PG8_WAIT_L(0); PG8_BAR; PG8_MMA(0, 0, At, B0); PG8_MMA(0, 1, At, B1); PG8_BAR; PG8_SCHED;
            PG8_LDA(At, 0, 1); PG8_STAGE(PG8_SB(0, 0), b2, voffB); PG8_STAGE(PG8_SB(0, 1), b2 + hstep, voffB); PG8_STAGE(PG8_SA(0, 0), a2, voffA);
            PG8_WAIT_V(8); PG8_WAIT_L(0); PG8_BAR; PG8_MMA(1, 0, At, B0); PG8_MMA(1, 1, At, B1); PG8_BAR; PG8_SCHED;
            PG8_LDB(B0, 1, 0); PG8_LDB(B1, 1, 1); PG8_SCHED; PG8_LDA(At, 1, 0); PG8_STAGE(PG8_SA(0, 1), a2 + hstep, voffA);
            PG8_WAIT_V(8); PG8_WAIT_L(0); PG8_BAR; PG8_MMA(0, 0, At, B0); PG8_MMA(0, 1, At, B1); PG8_BAR; PG8_SCHED;
            PG8_LDA(At, 1, 1); PG8_STAGE(PG8_SB(1, 0), b3, voffB); PG8_STAGE(PG8_SB(1, 1), b3 + hstep, voffB); PG8_STAGE(PG8_SA(1, 0), a3, voffA);
            PG8_WAIT_V(8); PG8_WAIT_L(0); PG8_BAR; PG8_MMA(1, 0, At, B0); PG8_MMA(1, 1, At, B1); PG8_BAR; PG8_SCHED;
            } else {
            PG8_LDB(B0, 0, 0); PG8_SCHED; PG8_LDA(At, 0, 0); PG8_STAGE(PG8_SA(1, 1), a1 + hstep, voffA);
            PG8_WAIT_L(8); PG8_BAR; PG8_WAIT_L(0); PG8_MMA(0, 0, At, B0); PG8_BAR; PG8_SCHED;
            PG8_LDB(B1, 0, 1); PG8_STAGE(PG8_SB(0, 0), b2, voffB);
            PG8_BAR; PG8_WAIT_L(0); PG8_MMA(0, 1, At, B1); PG8_BAR;
            PG8_LDA(At, 0, 1); PG8_STAGE(PG8_SA(0, 0), a2, voffA);
            PG8_BAR; PG8_WAIT_L(0); PG8_MMA(1, 0, At, B0); PG8_BAR; PG8_SCHED;
            PG8_STAGE(PG8_SB(0, 1), b2 + hstep, voffB);
            PG8_WAIT_V(6); PG8_BAR; PG8_MMA(1, 1, At, B1); PG8_BAR;
            PG8_LDB(B0, 1, 0); PG8_SCHED; PG8_LDA(At, 1, 0); PG8_STAGE(PG8_SA(0, 1), a2 + hstep, voffA);
            PG8_WAIT_L(8); PG8_BAR; PG8_WAIT_L(0); PG8_MMA(0, 0, At, B0); PG8_BAR; PG8_SCHED;
            PG8_LDB(B1, 1, 1); PG8_STAGE(PG8_SB(1, 0), b3, voffB);
            PG8_BAR; PG8_WAIT_L(0); PG8_MMA(0, 1, At, B1); PG8_BAR;
            PG8_LDA(At, 1, 1); PG8_STAGE(PG8_SA(1, 0), a3, voffA);
            PG8_BAR; PG8_WAIT_L(0); PG8_MMA(1, 0, At, B0); PG8_BAR; PG8_SCHED;
            PG8_STAGE(PG8_SB(1, 1), b3 + hstep, voffB);
            PG8_WAIT_V(6); PG8_BAR; PG8_MMA(1, 1, At, B1); PG8_BAR;
            }
        }
        if constexpr (ALIGN_EPI) { if (wr == 0) PG8_BAR; }
        if constexpr (!Epi::AFTER_DRAIN) { E(acc, cur, wr, wc, fr, fq); S.done(cur); }
        if (!has_next) break;
#pragma unroll
        for (int a = 0; a < 2; ++a)
#pragma unroll
            for (int b = 0; b < 2; ++b)
#pragma unroll
                for (int m = 0; m < 4; ++m)
#pragma unroll
                    for (int n = 0; n < 2; ++n) acc[a][b][m][n] = (f32x4){0.f, 0.f, 0.f, 0.f};
        cur = nxt; cA = nA; cB = nB; ++ui;
        if constexpr (ALIGN_EPI) { if (wr == 1) PG8_BAR; }
    }
    PG8_WAIT_V(0);
    if constexpr (!ALIGN_EPI) { if (wr == 0) PG8_BAR; }
    PG8_BAR;
    if constexpr (Epi::AFTER_DRAIN) { E.fused(acc, cur, wr, wc, fr, fq, lds, wid, lane); S.done(cur); }
#undef PG8_SA
#undef PG8_SB
#undef PG8_STAGE
#undef PG8_LDA
#undef PG8_LDB
#undef PG8_MMA
#undef PG8_WAIT_V
#undef PG8_WAIT_L
#undef PG8_BAR
#undef PG8_SCHED
}
__device__ __forceinline__ void gemm_phase_zf(PG8_LAS unsigned char* lds, const bf16_t* Ap1, const bf16_t* Bp1, const bf16_t* Ap2, const bf16_t* Bp2, const StaticOrder& S, const bf16_t* G, bf16_t* Z) {
    const int tid = threadIdx.x, wid = __builtin_amdgcn_readfirstlane(tid >> 6), lane = tid & 63, wr = wid >> 2, wc = wid & 3, fr = lane & 15, fq = lane >> 4;
    constexpr int K1 = 512, K2 = 1024, NT1 = K1 / BK, NT = (K1 + K2) / BK;
    unsigned vA[2], vB[2]; unsigned c2 = 0u;
#pragma unroll
    for (int i = 0; i < 2; ++i) { int R, C; stage_rc(tid * 16 + i * 8192, R, C); const int Rb = (R & ~31) + perm32(R & 31);
        vA[i] = (unsigned)(R * K1 + C) * 2u; vB[i] = (unsigned)(Rb * K1 + C) * 2u; c2 = (unsigned)C * 2u; }
    constexpr size_t kstep = (size_t)(BK * 2), hs1 = (size_t)HALF * K1 * 2, hs2 = (size_t)HALF * K2 * 2, ts1 = 2 * hs1, ts2 = 2 * hs2;
    const unsigned ldsw = (unsigned)wid * 1024u;
    const int aoff = lds_byte(wr * 64 + fr, fq * 8), boff = lds_byte(wc * 32 + fr, fq * 8);
#define PG8_SA(b, h) (((b) * 2 + (h)) * HTB)
#define PG8_SB(b, h) ((4 + (b) * 2 + (h)) * HTB)
#define PG8_STAGE(bufoff, gbase, voff) do { _Pragma("unroll") for (int _i = 0; _i < 2; ++_i) { unsigned o_ = (voff)[_i]; asm volatile("" : "+v"(o_));   \
        __builtin_amdgcn_global_load_lds((const unsigned*)((const char*)(gbase) + o_), (PG8_LAS unsigned*)(lds + (bufoff) + ldsw + _i * 8192), 16, 0, 0); } } while (0)
#define PG8_LDA(dst, b, h) do { _Pragma("unroll") for (int m = 0; m < 4; ++m) _Pragma("unroll") for (int k = 0; k < 2; ++k) dst[m][k] = *(const PG8_LAS bf16x8*)(lds + PG8_SA(b, h) + aoff + m * 2048 + k * 1024); } while (0)
#define PG8_LDB(dst, b, h) do { _Pragma("unroll") for (int n = 0; n < 2; ++n) _Pragma("unroll") for (int k = 0; k < 2; ++k) dst[n][k] = *(const PG8_LAS bf16x8*)(lds + PG8_SB(b, h) + boff + n * 2048 + k * 1024); } while (0)
#define PG8_MMA(ai, bj, At, Bt) do { __builtin_amdgcn_s_setprio(1); _Pragma("unroll") for (int m = 0; m < 4; ++m) _Pragma("unroll") for (int n = 0; n < 2; ++n) _Pragma("unroll") for (int k = 0; k < 2; ++k) \
        acc[ai][bj][m][n] = __builtin_amdgcn_mfma_f32_16x16x32_bf16(Bt[n][k], At[m][k], acc[ai][bj][m][n], 0, 0, 0); __builtin_amdgcn_s_setprio(0); } while (0)
#define PG8_WAIT_V(n) asm volatile("s_waitcnt vmcnt(" #n ")" ::: "memory")
#define PG8_WAIT_L(n) asm volatile("s_waitcnt lgkmcnt(" #n ")" ::: "memory")
#define PG8_BAR __builtin_amdgcn_s_barrier()
#define PG8_SCHED __builtin_amdgcn_sched_barrier(0)
#define PG8_ZBODY(A1H, O1, A2P, B2P, HS2, OA2, OB2) do { \
        PG8_LDB(B0, 0, 0); PG8_LDB(B1, 0, 1); PG8_SCHED; PG8_LDA(At, 0, 0); PG8_STAGE(PG8_SA(1, 1), (A1H), O1); \
        PG8_WAIT_V(8); PG8_WAIT_L(0); PG8_BAR; PG8_MMA(0, 0, At, B0); PG8_MMA(0, 1, At, B1); PG8_BAR; PG8_SCHED; \
        PG8_LDA(At, 0, 1); PG8_STAGE(PG8_SB(0, 0), (B2P), OB2); PG8_STAGE(PG8_SB(0, 1), (B2P) + (HS2), OB2); PG8_STAGE(PG8_SA(0, 0), (A2P), OA2); \
        PG8_WAIT_V(8); PG8_WAIT_L(0); PG8_BAR; PG8_MMA(1, 0, At, B0); PG8_MMA(1, 1, At, B1); PG8_BAR; PG8_SCHED; \
        PG8_LDB(B0, 1, 0); PG8_LDB(B1, 1, 1); PG8_SCHED; PG8_LDA(At, 1, 0); PG8_STAGE(PG8_SA(0, 1), (A2P) + (HS2), OA2); \
        PG8_WAIT_V(8); PG8_WAIT_L(0); PG8_BAR; PG8_MMA(0, 0, At, B0); PG8_MMA(0, 1, At, B1); PG8_BAR; PG8_SCHED; \
        PG8_LDA(At, 1, 1); PG8_STAGE(PG8_SB(1, 0), (B2P) + kstep, OB2); PG8_STAGE(PG8_SB(1, 1), (B2P) + kstep + (HS2), OB2); PG8_STAGE(PG8_SA(1, 0), (A2P) + kstep, OA2); \
        PG8_WAIT_V(8); PG8_WAIT_L(0); PG8_BAR; PG8_MMA(1, 0, At, B0); PG8_MMA(1, 1, At, B1); PG8_BAR; PG8_SCHED; } while (0)
    Unit cur, nxt; int ui = 0;
    if (!S.next(0, cur)) return;
    f32x4 acc[2][2][4][2];
#pragma unroll
    for (int a = 0; a < 2; ++a)
#pragma unroll
        for (int b = 0; b < 2; ++b)
#pragma unroll
            for (int m = 0; m < 4; ++m)
#pragma unroll
                for (int n = 0; n < 2; ++n) acc[a][b][m][n] = (f32x4){0.f, 0.f, 0.f, 0.f};
    bf16x8 At[4][2], B0[2][2], B1[2][2];
    const char* cA1 = (const char*)Ap1 + (size_t)cur.pm * ts1; const char* cB1 = (const char*)Bp1 + (size_t)cur.pn * ts1;
    PG8_STAGE(PG8_SB(0, 0), cB1, vB); PG8_STAGE(PG8_SB(0, 1), cB1 + hs1, vB); PG8_STAGE(PG8_SA(0, 0), cA1, vA); PG8_STAGE(PG8_SA(0, 1), cA1 + hs1, vA);
    if (wr == 1) PG8_BAR;
    PG8_WAIT_V(2); PG8_BAR;
    PG8_STAGE(PG8_SB(1, 0), cB1 + kstep, vB); PG8_STAGE(PG8_SA(1, 0), cA1 + kstep, vA); PG8_STAGE(PG8_SB(1, 1), cB1 + hs1 + kstep, vB);
    PG8_WAIT_V(6); PG8_BAR;
    for (;;) {
        const bool has_next = S.next(ui + 1, nxt);
        const char* cA2 = (const char*)Ap2 + (size_t)cur.pm * ts2; const char* cB2 = (const char*)Bp2 + (size_t)cur.pn * ts2;
        const char* nA1 = has_next ? (const char*)Ap1 + (size_t)nxt.pm * ts1 : cA1; const char* nB1 = has_next ? (const char*)Bp1 + (size_t)nxt.pn * ts1 : cB1;
        for (int t = 0; t < NT; t += 2) {
            const bool s1 = t < NT1, nx = t + 2 >= NT, f2 = nx || (t + 2 < NT1);
            const char* a1h = s1 ? cA1 + (size_t)(t + 1) * kstep + hs1 : cA2 + (size_t)(t + 1 - NT1) * kstep + hs2;
            const char* a2 = nx ? nA1 : f2 ? cA1 + (size_t)(t + 2) * kstep : cA2 + (size_t)(t + 2 - NT1) * kstep;
            const char* b2 = nx ? nB1 : f2 ? cB1 + (size_t)(t + 2) * kstep : cB2 + (size_t)(t + 2 - NT1) * kstep;
            const size_t hsx = f2 ? hs1 : hs2;
            const unsigned sh1 = s1 ? 0u : 1u, m1 = s1 ? 0u : ~0u, sh2 = f2 ? 0u : 1u, m2 = f2 ? 0u : ~0u;
            unsigned o1[2], oa2[2], ob2[2];
#pragma unroll
            for (int i = 0; i < 2; ++i) { o1[i] = (vA[i] << sh1) - (c2 & m1); oa2[i] = (vA[i] << sh2) - (c2 & m2); ob2[i] = (vB[i] << sh2) - (c2 & m2); }
            if (nx && has_next) S.a_ready(nxt);
            PG8_ZBODY(a1h, o1, a2, b2, hsx, oa2, ob2);
            if (t == NT1 - 2) {
            {
    #pragma unroll
                for (int ai = 0; ai < 2; ++ai)
    #pragma unroll
                    for (int m = 0; m < 4; ++m) { const int row = cur.pm * BM + ai * HALF + wr * 64 + m * 16 + fr;
    #pragma unroll
                        for (int bj = 0; bj < 2; ++bj) { const int col = cur.pn * BM + bj * HALF + wc * 32 + 8 * fq;
                            const ::u32x4 ga = *(const ::u32x4*)(G + (size_t)row * 2048 + col), gb = *(const ::u32x4*)(G + (size_t)row * 2048 + 1024 + col);
    #define PG8_RT(a_, b_) ((a_) * __builtin_amdgcn_rcpf(__builtin_amdgcn_fmed3f((b_), 1e-30f, 3.0e38f)))
                            const ::f32x4 r0 = (::f32x4){PG8_RT(bflo(ga.x), bflo(gb.x)), PG8_RT(bfhi(ga.x), bfhi(gb.x)), PG8_RT(bflo(ga.y), bflo(gb.y)), PG8_RT(bfhi(ga.y), bfhi(gb.y))};
                            const ::f32x4 r1 = (::f32x4){PG8_RT(bflo(ga.z), bflo(gb.z)), PG8_RT(bfhi(ga.z), bfhi(gb.z)), PG8_RT(bflo(ga.w), bflo(gb.w)), PG8_RT(bfhi(ga.w), bfhi(gb.w))};
                            acc[ai][bj][m][0] *= r0; acc[ai][bj][m][1] *= r1;
    #undef PG8_RT
                        }
                        PG8_SCHED; }
                PG8_SCHED;
            }
            }
        }
        if (wr == 0) PG8_BAR;
        {
#pragma unroll
            for (int ai = 0; ai < 2; ++ai)
#pragma unroll
                for (int m = 0; m < 4; ++m) { const int row = cur.pm * BM + ai * HALF + wr * 64 + m * 16 + fr;
#pragma unroll
                    for (int bj = 0; bj < 2; ++bj) { const int col = cur.pn * BM + bj * HALF + wc * 32 + 8 * fq;
                        const ::u32x4 gb = *(const ::u32x4*)(G + (size_t)row * 2048 + 1024 + col); const ::f32x4 v0 = acc[ai][bj][m][0], v1 = acc[ai][bj][m][1];
#define PG8_GC(b_) __builtin_amdgcn_fmed3f((b_), 1e-30f, 3.0e38f)
                        ::u32x4 w; w.x = pk2(v0.x * PG8_GC(bflo(gb.x)), v0.y * PG8_GC(bfhi(gb.x))); w.y = pk2(v0.z * PG8_GC(bflo(gb.y)), v0.w * PG8_GC(bfhi(gb.y)));
                        w.z = pk2(v1.x * PG8_GC(bflo(gb.z)), v1.y * PG8_GC(bfhi(gb.z))); w.w = pk2(v1.z * PG8_GC(bflo(gb.w)), v1.w * PG8_GC(bfhi(gb.w)));
#undef PG8_GC
                        *(::u32x4*)(Z + (size_t)row * D + col) = w; } }
        }
        if (!has_next) break;
#pragma unroll
        for (int a = 0; a < 2; ++a)
#pragma unroll
            for (int b = 0; b < 2; ++b)
#pragma unroll
                for (int m = 0; m < 4; ++m)
#pragma unroll
                    for (int n = 0; n < 2; ++n) acc[a][b][m][n] = (f32x4){0.f, 0.f, 0.f, 0.f};
        cur = nxt; cA1 = nA1; cB1 = nB1; ++ui;
        if (wr == 1) PG8_BAR;
    }
    PG8_WAIT_V(0);
    PG8_BAR;
#undef PG8_ZBODY
#undef PG8_SA
#undef PG8_SB
#undef PG8_STAGE
#undef PG8_LDA
#undef PG8_LDB
#undef PG8_MMA
#undef PG8_WAIT_V
#undef PG8_WAIT_L
#undef PG8_BAR
#undef PG8_SCHED
}
template <class Epi, class Sched, bool ALIGN_EPI = false, bool SP2 = false>
__device__ __forceinline__ void gemm_phase_x(PG8_LAS unsigned char* lds, const int K, const Sched& S, const Epi& E) {
    const int tid = threadIdx.x, wid = __builtin_amdgcn_readfirstlane(tid >> 6), lane = tid & 63, wr = wid >> 2, wc = wid & 3, fr = lane & 15, fq = lane >> 4;
    const int nt = K / BK;
    unsigned vcA[2][2], vnA[2][2], voffB[2];
#pragma unroll
    for (int i = 0; i < 2; ++i) { int R, C; stage_rc(tid * 16 + i * 8192, R, C); const int Rb = Epi::PERM ? ((R & ~31) + perm32(R & 31)) : R;
        voffB[i] = (unsigned)(Rb * K + C) * 2u; }
    const size_t kstep = (size_t)(BK * 2);
    const size_t hstep = (size_t)HALF * K * 2;
    const unsigned ldsw = (unsigned)wid * 1024u;
    const int aoff = lds_byte(wr * 64 + fr, fq * 8), boff = lds_byte(wc * 32 + fr, fq * 8);
#define PG8_SA(b, h) (((b) * 2 + (h)) * HTB)
#define PG8_SB(b, h) ((4 + (b) * 2 + (h)) * HTB)
#define PG8_STAGE(bufoff, gbase, voff) do { _Pragma("unroll") for (int _i = 0; _i < 2; ++_i) { unsigned o_ = (voff)[_i]; asm volatile("" : "+v"(o_));   \
        __builtin_amdgcn_global_load_lds((const unsigned*)((const char*)(gbase) + o_), (PG8_LAS unsigned*)(lds + (bufoff) + ldsw + _i * 8192), 16, 0, 0); } } while (0)
#define PG8_STAGEA(bufoff, gbase, V, h) do { _Pragma("unroll") for (int _i = 0; _i < 2; ++_i) { unsigned o_ = (V)[h][_i]; asm volatile("" : "+v"(o_)); \
        __builtin_amdgcn_global_load_lds((const unsigned*)((const char*)(gbase) + o_), (PG8_LAS unsigned*)(lds + (bufoff) + ldsw + _i * 8192), 16, 0, 0); } } while (0)
#define PG8_STAGEA2(bufoff, gbase, h) do { _Pragma("unroll") for (int _i = 0; _i < 2; ++_i) { unsigned o_ = last ? vnA[h][_i] : vcA[h][_i]; asm volatile("" : "+v"(o_)); \
        __builtin_amdgcn_global_load_lds((const unsigned*)((const char*)(gbase) + o_), (PG8_LAS unsigned*)(lds + (bufoff) + ldsw + _i * 8192), 16, 0, 0); } } while (0)
#define PG8_AOFF(V, u) do { _Pragma("unroll") for (int _h = 0; _h < 2; ++_h) _Pragma("unroll") for (int _i = 0; _i < 2; ++_i) { int R_, C_; stage_rc(tid * 16 + _i * 8192, R_, C_); (V)[_h][_i] = S.a_off(u, _h * HALF + R_, C_); } } while (0)
#define PG8_LDA(dst, b, h) do { _Pragma("unroll") for (int m = 0; m < 4; ++m) _Pragma("unroll") for (int k = 0; k < 2; ++k) dst[m][k] = *(const PG8_LAS bf16x8*)(lds + PG8_SA(b, h) + aoff + m * 2048 + k * 1024); } while (0)
#define PG8_LDB(dst, b, h) do { _Pragma("unroll") for (int n = 0; n < 2; ++n) _Pragma("unroll") for (int k = 0; k < 2; ++k) dst[n][k] = *(const PG8_LAS bf16x8*)(lds + PG8_SB(b, h) + boff + n * 2048 + k * 1024); } while (0)
#define PG8_MMA(ai, bj, At, Bt) do { __builtin_amdgcn_s_setprio(1); _Pragma("unroll") for (int m = 0; m < 4; ++m) _Pragma("unroll") for (int n = 0; n < 2; ++n) _Pragma("unroll") for (int k = 0; k < 2; ++k) \
        acc[ai][bj][m][n] = __builtin_amdgcn_mfma_f32_16x16x32_bf16(Bt[n][k], At[m][k], acc[ai][bj][m][n], 0, 0, 0); __builtin_amdgcn_s_setprio(0); } while (0)
#define PG8_WAIT_V(n) asm volatile("s_waitcnt vmcnt(" #n ")" ::: "memory")
#define PG8_WAIT_L(n) asm volatile("s_waitcnt lgkmcnt(" #n ")" ::: "memory")
#define PG8_BAR __builtin_amdgcn_s_barrier()
#define PG8_SCHED __builtin_amdgcn_sched_barrier(0)
    Unit cur, nxt; int ui = 0;
    if (!S.next(0, cur)) return;
    f32x4 acc[2][2][4][2];
#pragma unroll
    for (int a = 0; a < 2; ++a)
#pragma unroll
        for (int b = 0; b < 2; ++b)
#pragma unroll
            for (int m = 0; m < 4; ++m)
#pragma unroll
                for (int n = 0; n < 2; ++n) acc[a][b][m][n] = (f32x4){0.f, 0.f, 0.f, 0.f};
    bf16x8 At[4][2], B0[2][2], B1[2][2];
    const char* cA = S.a_base(cur); const char* cB = S.b_base(cur);
    PG8_AOFF(vcA, cur);
    S.a_ready(cur);
    if constexpr (SP2) {
        PG8_STAGE(PG8_SB(0, 0), cB, voffB); PG8_STAGE(PG8_SB(0, 1), cB + hstep, voffB); PG8_STAGEA(PG8_SA(0, 0), cA, vcA, 0); PG8_STAGEA(PG8_SA(0, 1), cA, vcA, 1);
        if (wr == 1) PG8_BAR;
        PG8_WAIT_V(2); PG8_BAR;
        PG8_STAGE(PG8_SB(1, 0), cB + kstep, voffB); PG8_STAGEA(PG8_SA(1, 0), cA + kstep, vcA, 0); PG8_STAGE(PG8_SB(1, 1), cB + hstep + kstep, voffB);
        PG8_WAIT_V(6); PG8_BAR;
    } else {
        PG8_STAGE(PG8_SB(0, 0), cB, voffB); PG8_STAGEA(PG8_SA(0, 0), cA, vcA, 0); PG8_STAGE(PG8_SB(0, 1), cB + hstep, voffB); PG8_STAGEA(PG8_SA(0, 1), cA, vcA, 1);
        if (wr == 1) PG8_BAR;
        PG8_WAIT_V(4); PG8_BAR;
        PG8_STAGE(PG8_SB(1, 0), cB + kstep, voffB); PG8_STAGEA(PG8_SA(1, 0), cA + kstep, vcA, 0); PG8_STAGE(PG8_SB(1, 1), cB + hstep + kstep, voffB);
        PG8_WAIT_V(6); PG8_BAR;
    }
    for (;;) {
        const bool has_next = S.next(ui + 1, nxt);
        const char* nA = has_next ? S.a_base(nxt) : cA; const char* nB = has_next ? S.b_base(nxt) : cB;
        if (has_next) { PG8_AOFF(vnA, nxt); } else { _Pragma("unroll") for (int _h = 0; _h < 2; ++_h) _Pragma("unroll") for (int _i = 0; _i < 2; ++_i) vnA[_h][_i] = vcA[_h][_i]; }
        for (int t = 0; t < nt; t += 2) {
            const bool last = (t == nt - 2);
            const char* a1 = cA + (size_t)(t + 1) * kstep;
            const char* a2 = last ? nA : cA + (size_t)(t + 2) * kstep; const char* b2 = last ? nB : cB + (size_t)(t + 2) * kstep;
            const char* a3 = a2 + kstep; const char* b3 = b2 + kstep;
            if (last && has_next) S.a_ready(nxt);
            if constexpr (SP2) {
            PG8_LDB(B0, 0, 0); PG8_LDB(B1, 0, 1); PG8_SCHED; PG8_LDA(At, 0, 0); PG8_STAGEA(PG8_SA(1, 1), a1, vcA, 1);
            PG8_WAIT_V(8); PG8_WAIT_L(0); PG8_BAR; PG8_MMA(0, 0, At, B0); PG8_MMA(0, 1, At, B1); PG8_BAR; PG8_SCHED;
            PG8_LDA(At, 0, 1); PG8_STAGE(PG8_SB(0, 0), b2, voffB); PG8_STAGE(PG8_SB(0, 1), b2 + hstep, voffB); PG8_STAGEA2(PG8_SA(0, 0), a2, 0);
            PG8_WAIT_V(8); PG8_WAIT_L(0); PG8_BAR; PG8_MMA(1, 0, At, B0); PG8_MMA(1, 1, At, B1); PG8_BAR; PG8_SCHED;
            PG8_LDB(B0, 1, 0); PG8_LDB(B1, 1, 1); PG8_SCHED; PG8_LDA(At, 1, 0); PG8_STAGEA2(PG8_SA(0, 1), a2, 1);
            PG8_WAIT_V(8); PG8_WAIT_L(0); PG8_BAR; PG8_MMA(0, 0, At, B0); PG8_MMA(0, 1, At, B1); PG8_BAR; PG8_SCHED;
            PG8_LDA(At, 1, 1); PG8_STAGE(PG8_SB(1, 0), b3, voffB); PG8_STAGE(PG8_SB(1, 1), b3 + hstep, voffB); PG8_STAGEA2(PG8_SA(1, 0), a3, 0);
            PG8_WAIT_V(8); PG8_WAIT_L(0); PG8_BAR; PG8_MMA(1, 0, At, B0); PG8_MMA(1, 1, At, B1); PG8_BAR; PG8_SCHED;
            } else {
            PG8_LDB(B0, 0, 0); PG8_SCHED; PG8_LDA(At, 0, 0); PG8_STAGEA(PG8_SA(1, 1), a1, vcA, 1);
            PG8_WAIT_L(8); PG8_BAR; PG8_WAIT_L(0); PG8_MMA(0, 0, At, B0); PG8_BAR; PG8_SCHED;
            PG8_LDB(B1, 0, 1); PG8_STAGE(PG8_SB(0, 0), b2, voffB);
            PG8_BAR; PG8_WAIT_L(0); PG8_MMA(0, 1, At, B1); PG8_BAR;
            PG8_LDA(At, 0, 1); PG8_STAGEA2(PG8_SA(0, 0), a2, 0);
            PG8_BAR; PG8_WAIT_L(0); PG8_MMA(1, 0, At, B0); PG8_BAR; PG8_SCHED;
            PG8_STAGE(PG8_SB(0, 1), b2 + hstep, voffB);
            PG8_WAIT_V(6); PG8_BAR; PG8_MMA(1, 1, At, B1); PG8_BAR;
            PG8_LDB(B0, 1, 0); PG8_SCHED; PG8_LDA(At, 1, 0); PG8_STAGEA2(PG8_SA(0, 1), a2, 1);
            PG8_WAIT_L(8); PG8_BAR; PG8_WAIT_L(0); PG8_MMA(0, 0, At, B0); PG8_BAR; PG8_SCHED;
            PG8_LDB(B1, 1, 1); PG8_STAGE(PG8_SB(1, 0), b3, voffB);
            PG8_BAR; PG8_WAIT_L(0); PG8_MMA(0, 1, At, B1); PG8_BAR;
            PG8_LDA(At, 1, 1); PG8_STAGEA2(PG8_SA(1, 0), a3, 0);
            PG8_BAR; PG8_WAIT_L(0); PG8_MMA(1, 0, At, B0); PG8_BAR; PG8_SCHED;
            PG8_STAGE(PG8_SB(1, 1), b3 + hstep, voffB);
            PG8_WAIT_V(6); PG8_BAR; PG8_MMA(1, 1, At, B1); PG8_BAR;
            }
        }
        if constexpr (ALIGN_EPI) { if (wr == 0) PG8_BAR; }
        if constexpr (!Epi::AFTER_DRAIN) { E(acc, cur, wr, wc, fr, fq); S.done(cur); }
        if (!has_next) break;
#pragma unroll
        for (int a = 0; a < 2; ++a)
#pragma unroll
            for (int b = 0; b < 2; ++b)
#pragma unroll
                for (int m = 0; m < 4; ++m)
#pragma unroll
                    for (int n = 0; n < 2; ++n) acc[a][b][m][n] = (f32x4){0.f, 0.f, 0.f, 0.f};
        cur = nxt; cA = nA; cB = nB; ++ui;
        _Pragma("unroll") for (int _h = 0; _h < 2; ++_h) _Pragma("unroll") for (int _i = 0; _i < 2; ++_i) vcA[_h][_i] = vnA[_h][_i];
        if constexpr (ALIGN_EPI) { if (wr == 1) PG8_BAR; }
    }
    PG8_WAIT_V(0);
    if constexpr (!ALIGN_EPI) { if (wr == 0) PG8_BAR; }
    PG8_BAR;
    if constexpr (Epi::AFTER_DRAIN) { E.fused(acc, cur, wr, wc, fr, fq, lds, wid, lane); S.done(cur); }
#undef PG8_SA
#undef PG8_SB
#undef PG8_STAGE
#undef PG8_STAGEA
#undef PG8_STAGEA2
#undef PG8_AOFF
#undef PG8_LDA
#undef PG8_LDB
#undef PG8_MMA
#undef PG8_WAIT_V
#undef PG8_WAIT_L
#undef PG8_BAR
#undef PG8_SCHED
}


template <int WHICH> struct MoeOrder {
    const int* TP; int G, c; const char* Abase; const char* Bbase; const int* LIST;
    static constexpr int KK = WHICH == 0 ? 1024 : 512, NN = 4;
    __device__ __forceinline__ bool next(int i, Unit& u) const {
        const int L = i * G + c; if (L >= TP[NEXP]) return false;
        int e = 0;
#pragma unroll 1
        for (int j = 16; j >= 1; j >>= 1) if (TP[e + j] <= L) e += j;
        const int lt = L - TP[e]; u.pm = e * 1024 + lt / NN; u.pn = lt % NN; return true;
    }
    __device__ __forceinline__ const char* a_base(const Unit& u) const { const int e = u.pm >> 10, mt = u.pm & 1023; return WHICH == 0 ? Abase : Abase + (size_t)(TP[64 + e] + mt * 256) * (DEXP * 2); }
    __device__ __forceinline__ const char* b_base(const Unit& u) const { const int e = u.pm >> 10; return Bbase + ((size_t)e * 1024 + (size_t)u.pn * 256) * (KK * 2); }
    __device__ __forceinline__ unsigned a_off(const Unit& u, int r, int C) const {
        if (WHICH == 1) return (unsigned)(r * DEXP + C) * 2u;
        const int e = u.pm >> 10, s = (u.pm & 1023) * 256 + r; const int tok = s < TP[128 + e] ? (LIST[(size_t)e * NR + s] >> 1) : 0;
        return (unsigned)tok * (D * 2) + (unsigned)C * 2u;
    }
    __device__ __forceinline__ void a_ready(const Unit&) const {}
    __device__ __forceinline__ void done(const Unit&) const {}
};
struct TokRowOrder : StaticOrder {
    const char* Abase; const char* Bbase; int K;
    __device__ __forceinline__ const char* a_base(const Unit& u) const { return Abase + (size_t)tokrow(u.pm * BM) * K * 2; }
    __device__ __forceinline__ const char* b_base(const Unit& u) const { return Bbase + (size_t)u.pn * BM * K * 2; }
    __device__ __forceinline__ unsigned a_off(const Unit&, int r, int C) const { return (unsigned)(r * K + C) * 2u; }
};
#define PG8_FOR_FRAGS_M(...) _Pragma("unroll") for (int ai = 0; ai < 2; ++ai) _Pragma("unroll") for (int m = 0; m < 4; ++m) { const int r = ai * HALF + wr * 64 + m * 16 + fr; \
    _Pragma("unroll") for (int bj = 0; bj < 2; ++bj) _Pragma("unroll") for (int n = 0; n < 2; ++n) { const int col = u.pn * BM + bj * HALF + wc * 32 + n * 16 + 4 * fq; ::f32x4 v = acc[ai][bj][m][n]; __VA_ARGS__ } }
struct EpiMoe1 {
    static constexpr bool PERM = true, AFTER_DRAIN = false;
    bf16_t* HID; const int* TP; const int* LIST; const float* RS;
    __device__ __forceinline__ void operator()(const f32x4 (&acc)[2][2][4][2], const Unit& u, int wr, int wc, int fr, int fq) const {
        const int e = u.pm >> 10, mt = u.pm & 1023, cnt = TP[128 + e]; bf16_t* base = HID + (size_t)(TP[64 + e] + mt * 256) * DEXP;
#pragma unroll
        for (int ai = 0; ai < 2; ++ai)
#pragma unroll
            for (int m = 0; m < 4; ++m) { const int r = ai * HALF + wr * 64 + m * 16 + fr; const int s = mt * 256 + r;
                const float rs = RS[s < cnt ? (LIST[(size_t)e * NR + s] >> 1) : 0];
#pragma unroll
                for (int bj = 0; bj < 2; ++bj) { const int col = u.pn * BM + bj * HALF + wc * 32 + 8 * fq; const ::f32x4 v0 = acc[ai][bj][m][0] * rs, v1 = acc[ai][bj][m][1] * rs;
                    const float h0 = v0.x * sigmoidf(v0.x) * v0.y, h1 = v0.z * sigmoidf(v0.z) * v0.w, h2 = v1.x * sigmoidf(v1.x) * v1.y, h3 = v1.z * sigmoidf(v1.z) * v1.w;
                    ::u32x2 w; w.x = pk2(h0, h1); w.y = pk2(h2, h3); *(::u32x2*)(base + (size_t)r * DEXP + (col >> 1)) = w; } }
    }
};
struct EpiMoe2 {
    static constexpr bool PERM = true, AFTER_DRAIN = false;
    bf16_t* MO; const int* TP; const int* LIST; const float* GATE;
    __device__ __forceinline__ void operator()(const f32x4 (&acc)[2][2][4][2], const Unit& u, int wr, int wc, int fr, int fq) const {
        const int e = u.pm >> 10, mt = u.pm & 1023, cnt = TP[128 + e];
#pragma unroll
        for (int ai = 0; ai < 2; ++ai)
#pragma unroll
            for (int m = 0; m < 4; ++m) {
                const int s = mt * 256 + ai * HALF + wr * 64 + m * 16 + fr;
                if (s < cnt) {
                    const int ent = LIST[(size_t)e * NR + s]; const float gt = GATE[ent]; bf16_t* row = MO + (size_t)ent * D;
#pragma unroll
                    for (int bj = 0; bj < 2; ++bj) { const int col = u.pn * BM + bj * HALF + wc * 32 + 8 * fq; const ::f32x4 v0 = acc[ai][bj][m][0], v1 = acc[ai][bj][m][1];
                        ::u32x4 w; w.x = pk2(v0.x * gt, v0.y * gt); w.y = pk2(v0.z * gt, v0.w * gt); w.z = pk2(v1.x * gt, v1.y * gt); w.w = pk2(v1.z * gt, v1.w * gt); *(::u32x4*)(row + col) = w; }
                }
            }
    }
};
#undef PG8_FOR_FRAGS_M
}
template <bool B> struct BoolT { static constexpr bool value = B; };
constexpr int SB_NQT = SEQ / 32;
constexpr int SB_VROW = 192;
__device__ __forceinline__ void phase_sb_fast(const Params& p, char* lds) {
    const bf16_t* P = (const bf16_t*)(p.ws + WS_P); bf16_t* YA = (bf16_t*)(p.ws + WS_YA);
    const int tid = threadIdx.x, lane = tid & 63, wave = tid >> 6, n = lane & 31, hh = lane >> 5;
    char* VB = lds + wave * (32 * SB_VROW);
    const unsigned vtr = (unsigned)(size_t)lds + (unsigned)(wave * (32 * SB_VROW) + (4 * hh + ((lane & 15) >> 2)) * SB_VROW + (16 * ((lane >> 4) & 1) + 4 * (lane & 3)) * 2);
    const int gw = blockIdx.x * NWAVES + wave, NGW = gridDim.x * NWAVES;
    for (int unit = gw; unit < 64 * SB_NQT; unit += NGW) {
        const int qt = SB_NQT - 1 - unit / 64, bh = unit % 64, h = bh & 7, b = bh >> 3;
        const int i0 = NMETA + qt * 32, qi = i0 + n, qrow = qi;
        const bf16_t* Pb = P + (size_t)b * T * PW;
        bf16x8 qf[4];
#pragma unroll
        for (int s = 0; s < 4; ++s) qf[s] = *(const bf16x8*)(Pb + (size_t)qrow * PW + C_QA + h * 64 + 16 * s + 8 * hh);
        f32x16 o0, o1;
#pragma unroll
        for (int r = 0; r < 16; ++r) { o0[r] = 0.f; o1[r] = 0.f; }
        float EL = 1.f;
        auto tile = [&](const int kt, auto MT) {
            constexpr bool MASKED = decltype(MT)::value;
            const int j0 = kt * 32, krow = (!MASKED || (j0 + n) < T) ? (j0 + n) : T - 1;
            bf16x8 kf[4];
#pragma unroll
            for (int s = 0; s < 4; ++s) kf[s] = *(const bf16x8*)(Pb + (size_t)krow * PW + C_KA + h * 64 + 16 * s + 8 * hh);
#pragma unroll
            for (int i = 0; i < 4; ++i) {
                const int c = lane + 64 * i, key = c >> 3, d0 = (c & 7) * 8, vrow = (!MASKED || (j0 + key) < T) ? (j0 + key) : T - 1;
                const u32x4 w = *(const u32x4*)(Pb + (size_t)vrow * PW + C_VA + h * 64 + d0);
                *(u32x4*)(VB + key * SB_VROW + d0 * 2) = w;
            }
            f32x16 sa;
#pragma unroll
            for (int r = 0; r < 16; ++r) sa[r] = 0.f;
#pragma unroll
            for (int s = 0; s < 4; ++s) sa = __builtin_amdgcn_mfma_f32_32x32x16_bf16(kf[s], qf[s], sa, 0, 0, 0);
            float kp[16], sg[16];
#pragma unroll
            for (int r = 0; r < 16; ++r) {
                const float e = fexp2(__builtin_amdgcn_fmed3f(sa[r], -3.0e38f, 80.f)), k = __builtin_amdgcn_rcpf(1.f + e), s = e * k;
                if (MASKED) { const int kk = (r & 3) + 8 * (r >> 2) + 4 * hh; const bool valid = (j0 + kk) < qi; kp[r] = valid ? k : 1.f; sg[r] = valid ? s : 0.f; }
                else { kp[r] = k; sg[r] = s; }
            }
            const float gp0 = (kp[0] * kp[1]) * (kp[2] * kp[3]), gp1 = (kp[4] * kp[5]) * (kp[6] * kp[7]), gp2 = (kp[8] * kp[9]) * (kp[10] * kp[11]), gp3 = (kp[12] * kp[13]) * (kp[14] * kp[15]);
            const float pp0 = xpartner32(gp0, hh), pp1 = xpartner32(gp1, hh), pp2 = xpartner32(gp2, hh), pp3 = xpartner32(gp3, hh);
            const float pc3 = pp3, pc2 = pc3 * pp2, pc1 = pc2 * pp1, pc0 = pc1 * pp0;
            float base[4];
            base[3] = EL * (hh ? 1.f : pc3);
            base[2] = EL * gp3 * (hh ? pc3 : pc2);
            base[1] = EL * (gp3 * gp2) * (hh ? pc2 : pc1);
            base[0] = EL * (gp3 * gp2 * gp1) * (hh ? pc1 : pc0);
            float a[16];
#pragma unroll
            for (int g = 0; g < 4; ++g) {
                float c = base[g];
#pragma unroll
                for (int e = 3; e >= 0; --e) { const int r = 4 * g + e; a[r] = sg[r] * c; c *= kp[r]; }
            }
            EL *= ((gp0 * gp1) * (gp2 * gp3)) * pc0;
            u32x4 pw0, pw1;
            pw0.x = pk2(a[0], a[1]); pw0.y = pk2(a[2], a[3]); pw0.z = pk2(a[4], a[5]); pw0.w = pk2(a[6], a[7]);
            pw1.x = pk2(a[8], a[9]); pw1.y = pk2(a[10], a[11]); pw1.z = pk2(a[12], a[13]); pw1.w = pk2(a[14], a[15]);
            const bf16x8 pf0 = __builtin_bit_cast(bf16x8, pw0), pf1 = __builtin_bit_cast(bf16x8, pw1);
            {
                u16x4 x0, x1, x2, x3, y0, y1, y2, y3;
                asm volatile("s_waitcnt lgkmcnt(0)\n\tds_read_b64_tr_b16 %0, %8 offset:%9\n\tds_read_b64_tr_b16 %1, %8 offset:%10\n\tds_read_b64_tr_b16 %2, %8 offset:%11\n\tds_read_b64_tr_b16 %3, %8 offset:%12\n\t"
                             "ds_read_b64_tr_b16 %4, %8 offset:%13\n\tds_read_b64_tr_b16 %5, %8 offset:%14\n\tds_read_b64_tr_b16 %6, %8 offset:%15\n\tds_read_b64_tr_b16 %7, %8 offset:%16\n\ts_waitcnt lgkmcnt(0)"
                             : "=&v"(x0), "=&v"(x1), "=&v"(x2), "=&v"(x3), "=&v"(y0), "=&v"(y1), "=&v"(y2), "=&v"(y3)
                             : "v"(vtr), "i"(0), "i"(8 * SB_VROW), "i"(16 * SB_VROW), "i"(24 * SB_VROW), "i"(64), "i"(64 + 8 * SB_VROW), "i"(64 + 16 * SB_VROW), "i"(64 + 24 * SB_VROW) : "memory");
#define SB_VF(a_, b_) ({ bf16x8 f_; f_[0] = (short)a_[0]; f_[1] = (short)a_[1]; f_[2] = (short)a_[2]; f_[3] = (short)a_[3]; f_[4] = (short)b_[0]; f_[5] = (short)b_[1]; f_[6] = (short)b_[2]; f_[7] = (short)b_[3]; f_; })
                o0 = __builtin_amdgcn_mfma_f32_32x32x16_bf16(SB_VF(x0, x1), pf0, o0, 0, 0, 0); o0 = __builtin_amdgcn_mfma_f32_32x32x16_bf16(SB_VF(x2, x3), pf1, o0, 0, 0, 0);
                o1 = __builtin_amdgcn_mfma_f32_32x32x16_bf16(SB_VF(y0, y1), pf0, o1, 0, 0, 0); o1 = __builtin_amdgcn_mfma_f32_32x32x16_bf16(SB_VF(y2, y3), pf1, o1, 0, 0, 0);
#undef SB_VF
            }
        };
        int kt = qt + 1;
        for (; kt >= qt; --kt) tile(kt, BoolT<true>{});
        for (; kt >= 0; --kt) {
            if (__all(EL < 1e-37f)) break;
            tile(kt, BoolT<false>{});
        }
        {
            bf16_t* yp = YA + ((size_t)b * SEQ + (qi - NMETA)) * 512 + h * 64 + 4 * hh;
#pragma unroll
            for (int g = 0; g < 4; ++g) {
                u32x2 w; w.x = pk2(o0[4 * g], o0[4 * g + 1]); w.y = pk2(o0[4 * g + 2], o0[4 * g + 3]); *(u32x2*)(yp + 8 * g) = w;
                w.x = pk2(o1[4 * g], o1[4 * g + 1]); w.y = pk2(o1[4 * g + 2], o1[4 * g + 3]); *(u32x2*)(yp + 32 + 8 * g) = w;
            }
        }
    }
}

constexpr int DSA_NQ = 8;
constexpr int DSA_SCS = 4608;
constexpr int DSA_KVB = 0, DSA_RING = 18432, DSA_IDX = DSA_NQ * DSA_RING, DSA_MISC = DSA_IDX + DSA_NQ * 1024, DSA_LDS = DSA_MISC + 512;
static_assert(DSA_NQ * DSA_SCS * 4 <= DSA_IDX, "score rows fit under the index lists");
__device__ __forceinline__ unsigned fkey(float f) { const unsigned u = __float_as_uint(f); return (u & 0x80000000u) ? ~u : (u | 0x80000000u); }
__device__ __forceinline__ int wave_sum_i32(int v) {
    v += __builtin_amdgcn_update_dpp(0, v, 0xB1, 0xF, 0xF, false);
    v += __builtin_amdgcn_update_dpp(0, v, 0x4E, 0xF, 0xF, false);
    v += __builtin_amdgcn_update_dpp(0, v, 0x141, 0xF, 0xF, false);
    v += __builtin_amdgcn_update_dpp(0, v, 0x140, 0xF, 0xF, false);
    return __builtin_amdgcn_readlane(v, 0) + __builtin_amdgcn_readlane(v, 16) + __builtin_amdgcn_readlane(v, 32) + __builtin_amdgcn_readlane(v, 48);
}
__device__ __forceinline__ int wave_excl_scan_i32(int c, int lane, int& total) {
    int x = c;
    x += __builtin_amdgcn_update_dpp(0, x, 0x111, 0xF, 0xF, true);
    x += __builtin_amdgcn_update_dpp(0, x, 0x112, 0xF, 0xF, true);
    x += __builtin_amdgcn_update_dpp(0, x, 0x114, 0xF, 0xF, true);
    x += __builtin_amdgcn_update_dpp(0, x, 0x118, 0xF, 0xF, true);
    const int t0 = __builtin_amdgcn_readlane(x, 15), t1 = __builtin_amdgcn_readlane(x, 31), t2 = __builtin_amdgcn_readlane(x, 47), t3 = __builtin_amdgcn_readlane(x, 63);
    const int row = lane >> 4;
    x += (row > 0 ? t0 : 0) + (row > 1 ? t1 : 0) + (row > 2 ? t2 : 0);
    total = t0 + t1 + t2 + t3;
    return x - c;
}
__device__ __forceinline__ int mbcnt64(unsigned long long m) { return (int)__builtin_amdgcn_mbcnt_hi((unsigned)(m >> 32), __builtin_amdgcn_mbcnt_lo((unsigned)m, 0u)); }
__device__ __forceinline__ void phase_dsa(const Params& p, char* lds) {
    const bf16_t* P = (const bf16_t*)(p.ws + WS_P); bf16_t* OL = (bf16_t*)(p.ws + WS_OLAT);
    const int tid = threadIdx.x, lane = tid & 63, wave = __builtin_amdgcn_readfirstlane(tid >> 6);
    unsigned* SC = (unsigned*)(lds + DSA_KVB);
    unsigned short* IDX = (unsigned short*)(lds + DSA_IDX);
    int* MISC = (int*)(lds + DSA_MISC);
    const unsigned lds_base = (unsigned)(size_t)lds;
    constexpr int NU = SEQ / DSA_NQ;
    for (int unit = blockIdx.x; unit < BATCH * NU; unit += gridDim.x) {
        const int u8 = NU - 1 - unit / BATCH, b = unit % BATCH, t0 = NMETA + u8 * DSA_NQ;
        const int cid = 1 + (t0 - NMETA) / 64, n = NMETA + 64 * cid;
        const bf16_t* Pb = P + (size_t)b * T * PW;
        const int m = lane & 31, hh = lane >> 5;
        bf16x8 aq[2][4], wa[2][2];
#pragma unroll
        for (int rt = 0; rt < 2; ++rt) {
#pragma unroll
            for (int s = 0; s < 4; ++s) aq[rt][s] = *(const bf16x8*)(Pb + (size_t)(t0 + 4 * rt + (m >> 3)) * PW + C_QI + (m & 7) * 64 + 16 * s + 8 * hh);
            const int o = m - 8 * rt, ql = (o == 0) ? 0 : (o == 1) ? 1 : (o == 4) ? 2 : (o == 5) ? 3 : -1;
            u32x2 wq = (u32x2){0u, 0u};
            if (ql >= 0) wq = *(const u32x2*)(Pb + (size_t)(t0 + 4 * rt + ql) * PW + C_WI + 4 * hh);
            u32x4 w0 = (u32x4){0u, 0u, 0u, 0u}, w1 = w0;
            if (ql == 0) { w0.x = wq.x; w0.y = wq.y; } else if (ql == 1) { w0.z = wq.x; w0.w = wq.y; } else if (ql == 2) { w1.x = wq.x; w1.y = wq.y; } else if (ql == 3) { w1.z = wq.x; w1.w = wq.y; }
            wa[rt][0] = __builtin_bit_cast(bf16x8, w0); wa[rt][1] = __builtin_bit_cast(bf16x8, w1);
        }
        const unsigned char* KIPb = p.ws + WS_KIP + (size_t)b * KIP_BATCH + lane * 16;
        bf16x8 bk[4];
#pragma unroll
        for (int s = 0; s < 4; ++s) bk[s] = *(const bf16x8*)(KIPb + (size_t)wave * 4096 + s * 1024);
        __syncthreads();
        {
            const int ntile = (n + 31) / 32;
            for (int kt = wave; kt < ntile; kt += NWAVES) {
                const int j0 = kt * 32, key = j0 + m;
                bf16x8 bn[4];
                { const int ktn = kt + NWAVES < 129 ? kt + NWAVES : 128;
#pragma unroll
                  for (int s = 0; s < 4; ++s) bn[s] = *(const bf16x8*)(KIPb + (size_t)ktn * 4096 + s * 1024); }
                const bool ok = key < n;
                f32x16 outp;
#pragma unroll
                for (int r = 0; r < 16; ++r) outp[r] = 0.f;
#pragma unroll
                for (int rt = 0; rt < 2; ++rt) {
                    f32x16 acc;
#pragma unroll
                    for (int r = 0; r < 16; ++r) acc[r] = 0.f;
#pragma unroll
                    for (int s = 0; s < 4; ++s) acc = __builtin_amdgcn_mfma_f32_32x32x16_bf16(aq[rt][s], bk[s], acc, 0, 0, 0);
                    u32x4 p0, p1;
#define RELU2_(a_, b_) __builtin_bit_cast(unsigned, __builtin_elementwise_max(__builtin_bit_cast(s16x2, pk2((a_), (b_))), (s16x2){0, 0}))
                    p0.x = RELU2_(acc[0], acc[1]); p0.y = RELU2_(acc[2], acc[3]); p0.z = RELU2_(acc[4], acc[5]); p0.w = RELU2_(acc[6], acc[7]);
                    p1.x = RELU2_(acc[8], acc[9]); p1.y = RELU2_(acc[10], acc[11]); p1.z = RELU2_(acc[12], acc[13]); p1.w = RELU2_(acc[14], acc[15]);
#undef RELU2_
                    outp = __builtin_amdgcn_mfma_f32_32x32x16_bf16(wa[rt][0], __builtin_bit_cast(bf16x8, p0), outp, 0, 0, 0);
                    outp = __builtin_amdgcn_mfma_f32_32x32x16_bf16(wa[rt][1], __builtin_bit_cast(bf16x8, p1), outp, 0, 0, 0);
                }
#pragma unroll
                for (int rt = 0; rt < 2; ++rt) {
                    SC[(4 * rt + 2 * hh) * DSA_SCS + key] = ok ? fkey(outp[4 * rt]) : 0u;
                    SC[(4 * rt + 2 * hh + 1) * DSA_SCS + key] = ok ? fkey(outp[4 * rt + 1]) : 0u;
                }
#pragma unroll
                for (int s = 0; s < 4; ++s) bk[s] = bn[s];
            }
        }
        __syncthreads();
        bf16x8 qf[5];
        {
            const int hd_ = lane & 15, g_ = lane >> 4;
#pragma unroll
            for (int ks = 0; ks < 5; ++ks) {
                u32x4 w = (u32x4){0u, 0u, 0u, 0u};
                if (hd_ < 8 && (ks < 4 || g_ < 2)) w = *(const u32x4*)(Pb + (size_t)(t0 + wave) * PW + C_QF + hd_ * QFW + 32 * ks + 8 * g_);
                qf[ks] = __builtin_bit_cast(bf16x8, w);
            }
        }
        {
            unsigned* sc = SC + wave * DSA_SCS;
            unsigned v[65];
#pragma unroll
            for (int i = 0; i < 65; ++i) { const int k = i * 64 + lane; v[i] = (k < n) ? sc[k] : 0u; }
            unsigned prefix = 0u; int cge = n, bit = 31;
            bool exact = false;
            if (n >= 256) {
                for (; bit >= 0 && cge > 512; --bit) {
                    const unsigned cand = prefix | (1u << bit); const int sc_ = (int)(cand ^ 0x80000000u);
                    unsigned b0 = 0u, b1 = 0u, b2 = 0u; int slots = 0;
#pragma unroll
                    for (int gi = 0; gi < 5; ++gi) if (gi * 832 < n) {
#pragma unroll
                        for (int i = 13 * gi; i < 13 * gi + 13; ++i) {
                            const unsigned d = (unsigned)__builtin_elementwise_sub_sat((int)(v[i] ^ 0x80000000u), sc_);
                            if (i % 3 == 0) b0 = __builtin_amdgcn_alignbit(b0, d, 31); else if (i % 3 == 1) b1 = __builtin_amdgcn_alignbit(b1, d, 31); else b2 = __builtin_amdgcn_alignbit(b2, d, 31);
                        }
                        slots += 13 * 64;
                    }
                    const int c = slots - wave_sum_i32(__builtin_popcount(b0) + __builtin_popcount(b1) + __builtin_popcount(b2));
                    if (c >= 256) { prefix = cand; cge = c; if (c == 256) { exact = true; break; } }
                }
            }
            int ngt = n;
            if (n >= 256 && !exact) {
                asm volatile("s_waitcnt lgkmcnt(0)" ::: "memory");
                int cb = 0;
                if (bit >= 0) {
                    const int sp_ = (int)((prefix > 0u ? prefix : 1u) ^ 0x80000000u);
                    unsigned lb0 = 0u, lb1 = 0u, lb2 = 0u;
#pragma unroll
                    for (int i = 0; i < 65; ++i) { const unsigned d = (unsigned)__builtin_elementwise_sub_sat((int)(v[i] ^ 0x80000000u), sp_);
                        if (i < 32) lb0 = __builtin_amdgcn_alignbit(lb0, d, 31); else if (i < 64) lb1 = __builtin_amdgcn_alignbit(lb1, d, 31); else lb2 = d >> 31; }
                    const unsigned tk0 = ~lb0, tk1 = ~lb1, tk2 = (~lb2) & 1u;
                    const int c0 = __builtin_popcount(tk0), c1 = __builtin_popcount(tk1);
                    const int lbase = wave_excl_scan_i32(c0 + c1 + (int)tk2, lane, cb);
#pragma unroll
                    for (int i = 0; i < 65; ++i) {
                        bool tkn; int rk;
                        if (i < 32) { tkn = (tk0 >> (31 - i)) & 1u; rk = i == 0 ? 0 : __builtin_popcount(tk0 >> (32 - i)); }
                        else if (i < 64) { tkn = (tk1 >> (63 - i)) & 1u; rk = c0 + (i == 32 ? 0 : __builtin_popcount(tk1 >> (64 - i))); }
                        else { tkn = tk2 != 0u; rk = c0 + c1; }
                        sc[tkn ? lbase + rk : 4096 + (lane & 15)] = v[i];
                    }
                    asm volatile("s_waitcnt lgkmcnt(0)" ::: "memory");
                    unsigned w[8];
#pragma unroll
                    for (int j = 0; j < 8; ++j) { const int k = j * 64 + lane; w[j] = (k < cb) ? sc[k] : 0u; }
                    for (; bit >= 0; --bit) {
                        const unsigned cand = prefix | (1u << bit); const int sc_ = (int)(cand ^ 0x80000000u); unsigned b0 = 0u, b1 = 0u;
#pragma unroll
                        for (int j = 0; j < 8; ++j) { const unsigned d = (unsigned)__builtin_elementwise_sub_sat((int)(w[j] ^ 0x80000000u), sc_); if (j & 1) b1 = __builtin_amdgcn_alignbit(b1, d, 31); else b0 = __builtin_amdgcn_alignbit(b0, d, 31); }
                        const int c = 512 - wave_sum_i32(__builtin_popcount(b0) + __builtin_popcount(b1));
                        if (c >= 256) { prefix = cand; if (c == 256) { exact = true; break; } }
                    }
                    int c = 0;
#pragma unroll
                    for (int j = 0; j < 8; ++j) c += __popcll(__ballot(w[j] > prefix));
                    ngt = c;
                } else {
                    int c = 0;
#pragma unroll
                    for (int i = 0; i < 65; ++i) { c += __popcll(__ballot(v[i] > prefix)); if ((i & 3) == 3) __builtin_amdgcn_sched_barrier(0); }
                    ngt = c;
                }
            }
            const unsigned tau = prefix;
            const int need_eq = n >= 256 ? 256 - ngt : 0; int base = 0, eqb = 0;
            unsigned short* idx = IDX + wave * 512;
            {
                const int st_ = (int)(tau ^ 0x80000000u); unsigned e0 = 0u, e1 = 0u, e2 = 0u;
#pragma unroll
                for (int i = 0; i < 65; ++i) { const unsigned d = (unsigned)__builtin_elementwise_sub_sat((int)(v[i] ^ 0x80000000u), st_);
                    if (i < 32) e0 = __builtin_amdgcn_alignbit(e0, d, 31); else if (i < 64) e1 = __builtin_amdgcn_alignbit(e1, d, 31); else e2 = d >> 31; }
                const unsigned tk0 = ~e0, tk1 = ~e1, tk2 = (~e2) & 1u;
                const int c0 = __builtin_popcount(tk0), c1 = __builtin_popcount(tk1);
                int nge; const int lbase = wave_excl_scan_i32(c0 + c1 + (int)tk2, lane, nge);
                if (n >= 256 && nge == 256) {
                    unsigned short* ib = idx + lbase;
                    { unsigned x = tk0; int j = 0; while (__any(x != 0u)) { if (x != 0u) { const int i = __builtin_clz(x); ib[j] = (unsigned short)(i * 64 + lane); x ^= 0x80000000u >> i; } ++j; } }
                    ib += c0;
                    { unsigned x = tk1; int j = 0; while (__any(x != 0u)) { if (x != 0u) { const int i = __builtin_clz(x); ib[j] = (unsigned short)((32 + i) * 64 + lane); x ^= 0x80000000u >> i; } ++j; } }
                    if (tk2 != 0u) ib[c1] = (unsigned short)(64 * 64 + lane);
                    base = nge;
                } else {
#pragma unroll
                    for (int gi = 0; gi < 5; ++gi) if (gi * 832 < n) {
#pragma unroll
                        for (int i = 13 * gi; i < 13 * gi + 13; ++i) {
                            const int k = i * 64 + lane; const unsigned u = v[i];
                            const bool eq = (u == tau); const unsigned long long meq = __ballot(eq);
                            const bool take = (u > tau) || (eq && (eqb + mbcnt64(meq)) < need_eq);
                            const unsigned long long mt = __ballot(take);
                            idx[take ? base + mbcnt64(mt) : 256 + lane] = (unsigned short)k;
                            base += __popcll(mt); eqb += __popcll(meq);
                            if ((i & 3) == 3) __builtin_amdgcn_sched_barrier(0);
                        }
                    }
                }
            }
            for (int pos = base + lane; pos < 256; pos += 64) idx[pos] = 0;
            if (lane == 0) MISC[wave] = base;
        }
        asm volatile("s_waitcnt lgkmcnt(0)" ::: "memory");
        {
            const int q = wave; const int nsel = __builtin_amdgcn_readfirstlane(MISC[q]);
            const size_t qrow = (size_t)(t0 + q);
            int ln = lane; asm volatile("" : "+v"(ln));
            const int hd = ln & 15, g = ln >> 4, qd = (ln & 15) >> 2, pp = ln & 3;
            char* ring = lds + DSA_KVB + wave * DSA_RING;
            const unsigned ring_a = lds_base + DSA_KVB + wave * DSA_RING;
            const unsigned short* idx = IDX + q * 512;
            asm volatile("s_waitcnt vmcnt(0)" ::: "memory");
#define DSA_ISSUE(c) do { unsigned rw_[9]; \
                _Pragma("unroll") for (int i_ = 0; i_ < 9; ++i_) { const int pid_ = ln + 64 * i_, row_ = pid_ / 18; rw_[i_] = idx[32 * (c) + row_]; } \
                _Pragma("unroll") for (int i_ = 0; i_ < 9; ++i_) { const int pid_ = ln + 64 * i_, row_ = pid_ / 18, part_ = pid_ - row_ * 18; \
                    const unsigned off_ = rw_[i_] * (unsigned)(PW * 2) + (unsigned)((C_KV + part_ * 8) * 2); \
                    __builtin_amdgcn_global_load_lds((const unsigned*)((const char*)Pb + off_), (LAS unsigned*)(ring + ((c) & 1) * 9216 + i_ * 1024), 16, 0, 0); } } while (0)
            DSA_ISSUE(0); DSA_ISSUE(1);
            f32x4 O[8];
#pragma unroll
            for (int nt = 0; nt < 8; ++nt) O[nt] = (f32x4){0.f, 0.f, 0.f, 0.f};
            float mrun = -3e38f, lrun = 0.f;
            for (int c = 0; c < 8; ++c) {
                if (c < 7) asm volatile("s_waitcnt vmcnt(9)" ::: "memory"); else asm volatile("s_waitcnt vmcnt(0)" ::: "memory");
                const char* buf = ring + (c & 1) * 9216;
                f32x4 S0 = (f32x4){0.f, 0.f, 0.f, 0.f}, S1 = S0;
                {
                    const char* kr = buf + hd * 288 + 16 * g;
#pragma unroll
                    for (int ks = 0; ks < 4; ++ks) { S0 = __builtin_amdgcn_mfma_f32_16x16x32_bf16(*(const bf16x8*)(kr + 64 * ks), qf[ks], S0, 0, 0, 0); S1 = __builtin_amdgcn_mfma_f32_16x16x32_bf16(*(const bf16x8*)(kr + 16 * 288 + 64 * ks), qf[ks], S1, 0, 0, 0); }
                    u32x4 w0 = (u32x4){0u, 0u, 0u, 0u}, w1 = w0; if (g < 2) { w0 = *(const u32x4*)(kr + 256); w1 = *(const u32x4*)(kr + 16 * 288 + 256); }
                    S0 = __builtin_amdgcn_mfma_f32_16x16x32_bf16(__builtin_bit_cast(bf16x8, w0), qf[4], S0, 0, 0, 0); S1 = __builtin_amdgcn_mfma_f32_16x16x32_bf16(__builtin_bit_cast(bf16x8, w1), qf[4], S1, 0, 0, 0);
                }
                float cm = -3e38f;
#pragma unroll
                for (int r = 0; r < 4; ++r) { if (nsel < 256) { const int sl = 32 * c + 4 * g + r; S0[r] = sl < nsel ? S0[r] : -1e30f; S1[r] = (sl + 16) < nsel ? S1[r] : -1e30f; } cm = fmax2(cm, fmax2(S0[r], S1[r])); }
                cm = xmax16(xmax32(cm));
                if (__any(cm > mrun + 6.f)) {
                    const float mnew = fmaxf(mrun, cm), alpha = fexp2(mrun - mnew);
                    lrun *= alpha; mrun = mnew;
#pragma unroll
                    for (int nt = 0; nt < 8; ++nt) O[nt] *= alpha;
                }
                float ps = 0.f;
#pragma unroll
                for (int r = 0; r < 4; ++r) { S0[r] = fexp2(S0[r] - mrun); S1[r] = fexp2(S1[r] - mrun); ps += S0[r] + S1[r]; }
                ps = xsum16(xsum32(ps));
                lrun += ps;
                u32x4 pw; pw.x = pk2(S0[0], S0[1]); pw.y = pk2(S0[2], S0[3]); pw.z = pk2(S1[0], S1[1]); pw.w = pk2(S1[2], S1[3]);
                const bf16x8 pf = __builtin_bit_cast(bf16x8, pw);
                const unsigned va = ring_a + (unsigned)((c & 1) * 9216 + (4 * g + qd) * 288 + 8 * pp);
#pragma unroll
                for (int h2 = 0; h2 < 2; ++h2) {
                    u16x4 x0, x1, x2, x3, y0, y1, y2, y3;
                    asm volatile("ds_read_b64_tr_b16 %0, %8 offset:%9\n\tds_read_b64_tr_b16 %1, %8 offset:%10\n\tds_read_b64_tr_b16 %2, %8 offset:%11\n\tds_read_b64_tr_b16 %3, %8 offset:%12\n\t"
                                 "ds_read_b64_tr_b16 %4, %8 offset:%13\n\tds_read_b64_tr_b16 %5, %8 offset:%14\n\tds_read_b64_tr_b16 %6, %8 offset:%15\n\tds_read_b64_tr_b16 %7, %8 offset:%16\n\ts_waitcnt lgkmcnt(0)"
                                 : "=&v"(x0), "=&v"(x1), "=&v"(x2), "=&v"(x3), "=&v"(y0), "=&v"(y1), "=&v"(y2), "=&v"(y3)
                                 : "v"(va), "i"(128 * h2), "i"(128 * h2 + 32), "i"(128 * h2 + 64), "i"(128 * h2 + 96), "i"(128 * h2 + 4608), "i"(128 * h2 + 4640), "i"(128 * h2 + 4672), "i"(128 * h2 + 4704) : "memory");
#define DSA_PV(nt_, x_, y_) do { bf16x8 vf_; vf_[0] = (short)x_[0]; vf_[1] = (short)x_[1]; vf_[2] = (short)x_[2]; vf_[3] = (short)x_[3]; vf_[4] = (short)y_[0]; vf_[5] = (short)y_[1]; vf_[6] = (short)y_[2]; vf_[7] = (short)y_[3]; \
                    O[nt_] = __builtin_amdgcn_mfma_f32_16x16x32_bf16(vf_, pf, O[nt_], 0, 0, 0); } while (0)
                    DSA_PV(4 * h2 + 0, x0, y0); DSA_PV(4 * h2 + 1, x1, y1); DSA_PV(4 * h2 + 2, x2, y2); DSA_PV(4 * h2 + 3, x3, y3);
                }
                asm volatile("s_waitcnt lgkmcnt(0)" ::: "memory");
                if (c + 2 < 8) DSA_ISSUE(c + 2);
            }
#undef DSA_PV
#undef DSA_ISSUE
            const float inv = __builtin_amdgcn_rcpf(lrun);
            if (hd < 8) {
                bf16_t* op = OL + ((size_t)b * SEQ + (qrow - NMETA)) * 1024 + hd * 128 + 4 * g;
#pragma unroll
                for (int nt = 0; nt < 8; ++nt) { u32x2 w; w.x = pk2(O[nt][0] * inv, O[nt][1] * inv); w.y = pk2(O[nt][2] * inv, O[nt][3] * inv); *(u32x2*)(op + 16 * nt) = w; }
            }
        }
    }
}

__device__ __forceinline__ void phase_inproj_meta(const Params& p) {
    unsigned char* ws = p.ws; const int tid = threadIdx.x, lane = tid & 63, wave = tid >> 6, fr = lane & 15, fq = lane >> 4;
    const bf16_t* U = (const bf16_t*)(ws + WS_U); const bf16_t* WP = (const bf16_t*)(ws + WS_WP); bf16_t* P = (bf16_t*)(ws + WS_P); const float2* cs = (const float2*)(ws + WS_CS);
    const int gw = blockIdx.x * NWAVES + wave, NGW = gridDim.x * NWAVES;
    for (int nt = gw; nt < PW / 16; nt += NGW) {
        const bf16_t* ap = U + (size_t)fr * D + 8 * fq; const bf16_t* bp = WP + (size_t)(16 * nt + fr) * D + 8 * fq;
        f32x4 acc = (f32x4){0.f, 0.f, 0.f, 0.f};
#pragma unroll 8
        for (int ks = 0; ks < D / 32; ++ks) acc = __builtin_amdgcn_mfma_f32_16x16x32_bf16(*(const bf16x8*)(bp + 32 * ks), *(const bf16x8*)(ap + 32 * ks), acc, 0, 0, 0);
        const int col = 16 * nt + 4 * fq, t = fr; f32x4 v = acc; int o;
        if (pg8::rope_off(col, o)) { const float2 c0 = cs[t * 8 + (o >> 1)], c1 = cs[t * 8 + (o >> 1) + 1]; v = (f32x4){v.x * c0.x - v.y * c0.y, v.y * c0.x + v.x * c0.y, v.z * c1.x - v.w * c1.y, v.w * c1.x + v.z * c1.y}; }
        u32x2 w; w.x = pk2(v.x, v.y); w.y = pk2(v.z, v.w);
        for (int b = 0; b < BATCH; ++b) {
            if (col >= C_KI && col < C_WI) { const int d0 = col - C_KI;
                *(u32x2*)(ws + WS_KIP + (size_t)b * KIP_BATCH + (size_t)((((t >> 5) * 4 + (d0 >> 4)) * 2 + ((d0 >> 3) & 1)) * 512 + (t & 31) * 16 + (d0 & 7) * 2)) = w; }
            else *(u32x2*)(P + ((size_t)b * T + t) * PW + col) = w;
        }
    }
}

__device__ __forceinline__ void phase_c3(const Params& p, char* lds) {
    unsigned char* ws = p.ws; const int tid = threadIdx.x, lane = tid & 63, wave = __builtin_amdgcn_readfirstlane(tid >> 6);
    const float* H1 = (const float*)(ws + WS_H1); const float* g = p.in[I_GFFN]; bf16_t* U2 = (bf16_t*)(ws + WS_U);
    const bf16_t* WH = (const bf16_t*)(ws + WS_WRT); const bf16_t* WL = WH + WRT_N * D;
    const float* bg = p.in[I_BGRP]; const float* br = p.in[I_BRT];
    unsigned* ctl = (unsigned*)(ws + WS_CTL); int* LIST = (int*)(ws + WS_LIST); float* GATE = (float*)(ws + WS_GATE); float* RS = (float*)(ws + WS_RSTD2);
    float* LG = (float*)lds + wave * (16 * 49 + 16);
    const int gw = blockIdx.x * NWAVES + wave, NGW = gridDim.x * NWAVES;
    const int tr = lane & 15, g4 = lane >> 4;
    for (int tile = gw; tile < NR / 16; tile += NGW) {
        const int row = tile * 16 + tr;
        const float* hp = H1 + (size_t)row * D + 8 * g4; bf16_t* up = U2 + (size_t)row * D + 8 * g4;
        const bf16_t* whp = WH + (size_t)tr * D + 8 * g4; const bf16_t* wlp = WL + (size_t)tr * D + 8 * g4;
        f32x4 acc[3]; float ss = 0.f;
#pragma unroll
        for (int nt = 0; nt < 3; ++nt) acc[nt] = (f32x4){0.f, 0.f, 0.f, 0.f};
        f32x4 xq[4][2]; bf16x8 bc[6], bn[6];
#pragma unroll
        for (int j = 0; j < 4; ++j) { xq[j][0] = *(const f32x4*)(hp + 32 * j); xq[j][1] = *(const f32x4*)(hp + 32 * j + 4); }
#pragma unroll
        for (int nt = 0; nt < 3; ++nt) { bc[2 * nt] = *(const bf16x8*)(whp + (size_t)nt * 16 * D); bc[2 * nt + 1] = *(const bf16x8*)(wlp + (size_t)nt * 16 * D); }
#pragma unroll 4
        for (int s = 0; s < 32; ++s) {
            const f32x4 x0 = xq[s & 3][0], x1 = xq[s & 3][1];
            { const int sn = s + 4 < 32 ? s + 4 : 31; xq[s & 3][0] = *(const f32x4*)(hp + 32 * sn); xq[s & 3][1] = *(const f32x4*)(hp + 32 * sn + 4); }
            { const int sb = s + 1 < 32 ? s + 1 : 31;
#pragma unroll
              for (int nt = 0; nt < 3; ++nt) { bn[2 * nt] = *(const bf16x8*)(whp + (size_t)nt * 16 * D + 32 * sb); bn[2 * nt + 1] = *(const bf16x8*)(wlp + (size_t)nt * 16 * D + 32 * sb); } }
            const f32x4 g0 = *(const f32x4*)(g + 32 * s + 8 * g4), g1 = *(const f32x4*)(g + 32 * s + 8 * g4 + 4);
            ss += (x0.x * x0.x + x0.y * x0.y) + (x0.z * x0.z + x0.w * x0.w) + (x1.x * x1.x + x1.y * x1.y) + (x1.z * x1.z + x1.w * x1.w);
            const f32x4 h0 = x0 * g0, h1 = x1 * g1;
            u32x4 hi; hi.x = pk2(h0.x, h0.y); hi.y = pk2(h0.z, h0.w); hi.z = pk2(h1.x, h1.y); hi.w = pk2(h1.z, h1.w);
            *(u32x4*)(up + 32 * s) = hi;
            u32x4 lo; lo.x = pk2(h0.x - bflo(hi.x), h0.y - bfhi(hi.x)); lo.y = pk2(h0.z - bflo(hi.y), h0.w - bfhi(hi.y)); lo.z = pk2(h1.x - bflo(hi.z), h1.y - bfhi(hi.z)); lo.w = pk2(h1.z - bflo(hi.w), h1.w - bfhi(hi.w));
            const bf16x8 ah = __builtin_bit_cast(bf16x8, hi), al = __builtin_bit_cast(bf16x8, lo);
#pragma unroll
            for (int nt = 0; nt < 3; ++nt) {
                acc[nt] = __builtin_amdgcn_mfma_f32_16x16x32_bf16(ah, bc[2 * nt], acc[nt], 0, 0, 0);
                acc[nt] = __builtin_amdgcn_mfma_f32_16x16x32_bf16(ah, bc[2 * nt + 1], acc[nt], 0, 0, 0);
                acc[nt] = __builtin_amdgcn_mfma_f32_16x16x32_bf16(al, bc[2 * nt], acc[nt], 0, 0, 0);
            }
#pragma unroll
            for (int j = 0; j < 6; ++j) bc[j] = bn[j];
        }
        ss = xsum16(xsum32(ss));
#pragma unroll
        for (int nt = 0; nt < 3; ++nt)
#pragma unroll
            for (int r = 0; r < 4; ++r) LG[(4 * g4 + r) * 49 + 16 * nt + tr] = acc[nt][r];
        if (g4 == 0) LG[16 * 49 + tr] = ss;
        asm volatile("s_waitcnt lgkmcnt(0)" ::: "memory");
        if (lane < 16) {
            const int tok = tile * 16 + lane; const float* lg = LG + lane * 49;
            const float rstd = rsqrtf(LG[16 * 49 + lane] * (1.f / D) + NORM_EPS);
            RS[tok] = rstd;
            float gl[4]; int gs = 0; float gm;
#pragma unroll
            for (int o = 0; o < 4; ++o) gl[o] = lg[o] * rstd + bg[o];
            gm = gl[0];
#pragma unroll
            for (int o = 1; o < 4; ++o) if (gl[o] > gm) { gm = gl[o]; gs = o; }
            float gsum = 0.f;
#pragma unroll
            for (int o = 0; o < 4; ++o) gsum += __expf(gl[o] - gm);
            const float pgrp = 1.f / gsum;
            float el[8];
#pragma unroll
            for (int j = 0; j < 8; ++j) el[j] = lg[4 + gs * 8 + j] * rstd + br[gs * 8 + j];
            int e0 = 0; float m0 = el[0];
#pragma unroll
            for (int j = 1; j < 8; ++j) if (el[j] > m0) { m0 = el[j]; e0 = j; }
            int e1 = -1; float m1 = -3e38f;
#pragma unroll
            for (int j = 0; j < 8; ++j) if (j != e0 && el[j] > m1) { m1 = el[j]; e1 = j; }
            const float x1 = __expf(m1 - m0); const float g0 = pgrp / (1.f + x1), g1 = pgrp * x1 / (1.f + x1);
            const int ex0 = gs * 8 + e0, ex1 = gs * 8 + e1;
            const int s0 = (int)atomicAdd(ctl + CW_CNT + 64 * ex0, 1u); LIST[(size_t)ex0 * NR + s0] = tok * 2;
            const int s1 = (int)atomicAdd(ctl + CW_CNT + 64 * ex1, 1u); LIST[(size_t)ex1 * NR + s1] = tok * 2 + 1;
            GATE[tok * 2] = g0; GATE[tok * 2 + 1] = g1;
        }
        asm volatile("s_waitcnt lgkmcnt(0)" ::: "memory");
    }
}

template <int WHICH>
__device__ __forceinline__ void phase_moe(const Params& p, char* lds) {
    unsigned char* ws = p.ws; const int tid = threadIdx.x;
    const unsigned* ctl = (const unsigned*)(ws + WS_CTL);
    int* TP = (int*)(lds + pg8::STAGE_BYTES);
    __syncthreads();
    if (tid == 0) { int tp = 0, ro = 0; for (int e = 0; e < NEXP; ++e) { const int c = (int)ctl[CW_CNT + 64 * e]; TP[e] = tp; TP[64 + e] = ro; TP[128 + e] = c; const int t = (c + 255) / 256; tp += t * 4; ro += t * 256; } TP[NEXP] = tp; }
    __syncthreads();
    pg8::MoeOrder<WHICH> S{TP, (int)gridDim.x, (int)blockIdx.x, (const char*)(ws + (WHICH == 0 ? WS_U : WS_HID)), (const char*)(ws + (WHICH == 0 ? WS_W13 : WS_W2)), (const int*)(ws + WS_LIST)};
    if constexpr (WHICH == 0) { pg8::EpiMoe1 E{(bf16_t*)(ws + WS_HID), TP, (const int*)(ws + WS_LIST), (const float*)(ws + WS_RSTD2)}; pg8::gemm_phase_x<pg8::EpiMoe1, pg8::MoeOrder<0>, true, true>((LAS unsigned char*)lds, 1024, S, E); }
    else { pg8::EpiMoe2 E{(bf16_t*)(ws + WS_MO), TP, (const int*)(ws + WS_LIST), (const float*)(ws + WS_GATE)}; pg8::gemm_phase_x<pg8::EpiMoe2, pg8::MoeOrder<1>, true, true>((LAS unsigned char*)lds, 512, S, E); }
}

__device__ __forceinline__ void phase_final(const Params& p) {
    unsigned char* ws = p.ws; const int tid = threadIdx.x, lane = tid & 63, wave = tid >> 6;
    const float* H1 = (const float*)(ws + WS_H1); const bf16_t* MO = (const bf16_t*)(ws + WS_MO); const float* g = p.in[I_GFIN];
    const int gw = blockIdx.x * NWAVES + wave, NGW = gridDim.x * NWAVES;
    f32x4 vn[4]; u32x2 an[4], cn[4];
#define FIN_LOAD(r_) do { const size_t row_ = (size_t)(r_); const f32x4* xr_ = (const f32x4*)(H1 + row_ * D) + lane; const u32x2* m0_ = (const u32x2*)(MO + row_ * 2 * D) + lane; \
        _Pragma("unroll") for (int j = 0; j < 4; ++j) { vn[j] = xr_[64 * j]; an[j] = m0_[64 * j]; cn[j] = m0_[256 + 64 * j]; } } while (0)
    if (gw < BATCH * SEQ) FIN_LOAD(gw);
    for (int orow = gw; orow < BATCH * SEQ; orow += NGW) {
        f32x4 v[4]; u32x2 aa[4], cc[4]; float ss = 0.f;
#pragma unroll
        for (int j = 0; j < 4; ++j) { v[j] = vn[j]; aa[j] = an[j]; cc[j] = cn[j]; }
        if (orow + NGW < BATCH * SEQ) FIN_LOAD(orow + NGW);
#pragma unroll
        for (int j = 0; j < 4; ++j) { const u32x2 a = aa[j], c = cc[j];
            v[j].x += bflo(a.x) + bflo(c.x); v[j].y += bfhi(a.x) + bfhi(c.x); v[j].z += bflo(a.y) + bflo(c.y); v[j].w += bfhi(a.y) + bfhi(c.y);
            ss += (v[j].x * v[j].x + v[j].y * v[j].y) + (v[j].z * v[j].z + v[j].w * v[j].w); }
        const float rstd = rsqrtf(wave_sum(ss) * (1.f / D) + NORM_EPS);
        f32x4* o = (f32x4*)(p.out + (size_t)orow * D) + lane;
#pragma unroll
        for (int j = 0; j < 4; ++j) { const f32x4 gg = ((const f32x4*)g)[lane + 64 * j]; o[64 * j] = v[j] * rstd * gg; }
    }
#undef FIN_LOAD
}

#define XB_TMO      128
#define XB_XCNT(j)  (256  + 64 * (j))
#define XB_XSUB(j)  (1280 + 64 * (j))
#define XB_XGEN(j)  (2304 + 64 * (j))
#define XB_TOP      3328
#define XB_TOPGEN   3392
#define XCD_BAR_WORDS 3456
#define XB_SPIN_CAP (1u << 18)
__device__ __forceinline__ unsigned xb_ld(unsigned* p)              { return __hip_atomic_load(p, __ATOMIC_RELAXED, __HIP_MEMORY_SCOPE_AGENT); }
__device__ __forceinline__ unsigned xb_add(unsigned* p, unsigned v) { return __hip_atomic_fetch_add(p, v, __ATOMIC_RELAXED, __HIP_MEMORY_SCOPE_AGENT); }
__device__ __forceinline__ unsigned xb_xcc_id() { return (unsigned)__builtin_amdgcn_s_getreg((3 << 11) | 20) & 0xFu; }
#define XB_SPIN(cond, bar) do { unsigned _sp = 0; while (cond) { __builtin_amdgcn_s_sleep(1); \
    if ((++_sp & 255u) == 0u) { if (xb_ld(&(bar)[XB_TMO])) break; if (_sp > XB_SPIN_CAP) { atomicAdd(&(bar)[XB_TMO], 1u); break; } } } } while (0)
struct XcdBarrier { unsigned* bar; unsigned x; volatile LAS unsigned* st; };
__device__ __forceinline__ XcdBarrier xcd_barrier_post(unsigned* bar, volatile LAS unsigned* st) {
    XcdBarrier b; b.bar = bar; b.x = xb_xcc_id(); b.st = st;
    if (threadIdx.x == 0) (void)xb_add(&bar[XB_XCNT(b.x)], 1u);
    return b;
}
__device__ __forceinline__ void xcd_barrier_complete(unsigned* bar, unsigned x, unsigned& nloc, unsigned& nx) {
    const unsigned G = gridDim.x * gridDim.y * gridDim.z;
    unsigned sum, cnt, mine, sp = 0u;
    for (;;) {
        sum = 0u; cnt = 0u; mine = 0u;
#pragma unroll
        for (unsigned j = 0; j < 16; ++j) { const unsigned c = xb_ld(&bar[XB_XCNT(j)]); sum += c; cnt += (c > 0u) ? 1u : 0u; mine = (j == x) ? c : mine; }
        if (sum == G) break;
        __builtin_amdgcn_s_sleep(1);
        if ((++sp & 255u) == 0u) { if (xb_ld(&bar[XB_TMO])) break; if (sp > XB_SPIN_CAP) { atomicAdd(&bar[XB_TMO], 1u); break; } }
    }
    nloc = mine > 0u ? mine : 1u; nx = cnt > 0u ? cnt : 1u;
}
__device__ __forceinline__ void xcd_barrier(const XcdBarrier& b) {
    asm volatile("s_waitcnt vmcnt(0)" ::: "memory");
    __syncthreads();
    if (threadIdx.x == 0) {
        unsigned* bar = b.bar;
        __builtin_amdgcn_s_waitcnt(0);
        unsigned nloc = b.st[0], nx = b.st[1];
        if (nloc == 0u) { xcd_barrier_complete(bar, b.x, nloc, nx); b.st[0] = nloc; b.st[1] = nx; }
        const unsigned old = xb_add(&bar[XB_XSUB(b.x)], 1u);
        const unsigned gen = old / nloc;
        if (old + 1u == (gen + 1u) * nloc) {
            __builtin_amdgcn_fence(__ATOMIC_RELEASE, "agent");
            asm volatile("s_waitcnt vmcnt(0)" ::: "memory");
            const unsigned og = xb_add(&bar[XB_TOP], 1u);
            const unsigned tg = og / nx;
            if (og + 1u == (tg + 1u) * nx) xb_add(&bar[XB_TOPGEN], 1u);
            else XB_SPIN(xb_ld(&bar[XB_TOPGEN]) == tg, bar);
            __builtin_amdgcn_fence(__ATOMIC_ACQUIRE, "agent");
            xb_add(&bar[XB_XGEN(b.x)], 1u);
            asm volatile("s_waitcnt vmcnt(0)" ::: "memory");
        } else {
            XB_SPIN(xb_ld(&bar[XB_XGEN(b.x)]) == gen, bar);
            __builtin_amdgcn_fence(__ATOMIC_ACQUIRE, "agent");
            asm volatile("s_waitcnt vmcnt(0)" ::: "memory");
        }
    }
    __syncthreads();
}

constexpr int LDS_XB = DSA_LDS;
constexpr int LDS_BYTES = DSA_LDS + 256;
static_assert(pg8::STAGE_BYTES <= LDS_XB && pg8::STAGE_BYTES + 1024 <= LDS_XB && NWAVES * 64 * 33 * 4 <= LDS_XB && NWAVES * 32 * SB_VROW <= LDS_XB && NWAVES * (16 * 49 + 16) * 4 <= LDS_XB, "LDS map");

__global__ void __launch_bounds__(NTHREADS, 2) mega(Params p) {
    extern __shared__ __attribute__((aligned(16))) char lds[];
    const int lo = p.ph_lo, hi = p.ph_hi;
    unsigned char* ws = p.ws;
    XcdBarrier xb;
    {
        volatile LAS unsigned* st = (volatile LAS unsigned*)(lds + LDS_XB);
        if (threadIdx.x < 4) st[threadIdx.x] = 0u;
        __syncthreads();
        xb = xcd_barrier_post((unsigned*)(ws + WS_CTL) + CW_BAR, st);
    }
#define IN(k) (lo <= (k) && (k) < hi)
#define GSYNC() xcd_barrier(xb)
#define SEAM(k) do { if (IN(k) && IN((k) + 1)) GSYNC(); } while (0)
#define REP(k, ...) do { if (IN(k)) { __VA_ARGS__; } } while (0)
    LAS unsigned char* ldsl = (LAS unsigned char*)lds;
    REP(0, phase_prologue(p, lds));
    SEAM(0);
    REP(1, { phase_inproj_meta(p);
             pg8::TokRowOrder S; S.init(NR, PWN, gridDim.x, blockIdx.x); S.Abase = (const char*)(ws + WS_U); S.Bbase = (const char*)(ws + WS_WP); S.K = D;
             pg8::EpiInproj E{(bf16_t*)(ws + WS_P), (const float2*)(ws + WS_CS), ws + WS_KIP}; pg8::gemm_phase_x<pg8::EpiInproj, pg8::TokRowOrder, true, true>(ldsl, D, S, E); });
    SEAM(1);
    if (IN(2)) {
        phase_dsa(p, lds);
        __syncthreads(); phase_sb_fast(p, lds);
    }
    SEAM(2);
    REP(3, { pg8::TokRowOrder S; S.init(NR, 2048, gridDim.x, blockIdx.x); S.Abase = (const char*)(ws + WS_U); S.Bbase = (const char*)(ws + WS_WG); S.K = D;
             pg8::EpiGate E{(bf16_t*)(ws + WS_G)}; pg8::gemm_phase_x<pg8::EpiGate, pg8::TokRowOrder, true, true>(ldsl, D, S, E); });
    SEAM(3);
    REP(4, { pg8::StaticOrder S; S.init(NR, D, gridDim.x, blockIdx.x);
             pg8::gemm_phase_zf(ldsl, (const bf16_t*)(ws + WS_YA), (const bf16_t*)(ws + WS_WUA), (const bf16_t*)(ws + WS_OLAT), (const bf16_t*)(ws + WS_WBP), S, (const bf16_t*)(ws + WS_G), (bf16_t*)(ws + WS_Z)); });
    SEAM(4);
    REP(5, { pg8::Gemm g{(const bf16_t*)(ws + WS_Z), (const bf16_t*)(ws + WS_WO), NR, D, D}; pg8::StaticOrder S; S.init(NR, D, gridDim.x, blockIdx.x);
             pg8::EpiH1 E{(float*)(ws + WS_H1), p.in[I_META], p.in[I_X]}; pg8::gemm_phase<pg8::EpiH1, pg8::StaticOrder, true, true>(ldsl, g, S, E); });
    SEAM(5);
    if (IN(6)) phase_c3(p, lds);
    SEAM(6);
    REP(7, phase_moe<0>(p, lds));
    SEAM(7);
    REP(8, phase_moe<1>(p, lds));
    SEAM(8);
    REP(9, phase_final(p));
}

extern "C" void kernel_launch(void* const* d_in, const int* in_sizes, int n_in, void* d_out, int out_size, void* d_ws, size_t ws_size, hipStream_t stream) {
    if (n_in != 18 || ws_size < WS_END) { fprintf(stderr, "kernel_launch: unexpected n_in %d / ws_size %zu\n", n_in, ws_size); return; }
    static int grid = 0;
    if (grid == 0) {
        int dev = 0, cus = 0, per_cu = 0;
        (void)hipGetDevice(&dev);
        (void)hipDeviceGetAttribute(&cus, hipDeviceAttributeMultiprocessorCount, dev);
        (void)hipFuncSetAttribute((const void*)mega, hipFuncAttributeMaxDynamicSharedMemorySize, LDS_BYTES);
        (void)hipOccupancyMaxActiveBlocksPerMultiprocessor(&per_cu, (const void*)mega, NTHREADS, LDS_BYTES);
        if (per_cu < 1) fprintf(stderr, "kernel_launch: occupancy query reports %d workgroups per CU\n", per_cu);
        grid = cus;
    }
    (void)hipMemsetAsync((char*)d_ws + WS_CTL, 0, CTL_BYTES, stream);
    Params p{};
    for (int i = 0; i < 18; ++i) p.in[i] = (const float*)d_in[i];
    p.out = (float*)d_out; p.ws = (unsigned char*)d_ws;
    p.ph_lo = 0; p.ph_hi = 10;
    void* args[] = {&p};
    hipError_t e = hipLaunchCooperativeKernel((const void*)mega, dim3(grid), dim3(NTHREADS), args, LDS_BYTES, stream);
    if (e != hipSuccess) fprintf(stderr, "cooperative launch failed: %s (grid %d)\n", hipGetErrorString(e), grid);
}
```

```cpp
#include <hip/hip_runtime.h>
#include <cstdio>
#include <cstdint>

constexpr int BATCH = 8, SEQ = 4096, NMETA = 16, T = SEQ + NMETA, D = 1024, NTOK = BATCH * T;
constexpr int MROWS = 33024;
constexpr int NR = BATCH * SEQ;
__device__ __forceinline__ int tokrow(int cr) { return cr + NMETA * (cr / SEQ + 1); }
constexpr int INW = 4824;
constexpr int NEXP = 32, DEXP = 512;
constexpr int NWAVES = 8, NTHREADS = 512;
constexpr float NORM_EPS = 1e-6f;
constexpr float LOG2E = 1.4426950408889634f;
constexpr float QSCALE = 0.125f * LOG2E;
constexpr int PW = 3456, PWN = 3584;
constexpr int C_QA = 0, C_KA = 512, C_VA = 1024, C_QF = 1536, C_KV = 2688, C_QI = 2832, C_KI = 3344, C_WI = 3408, C_END = 3416;
constexpr int QFW = 144;

constexpr size_t MiB = 1u << 20;
constexpr size_t WS_CTL = 0, CTL_BYTES = 128 * 1024;
constexpr size_t WS_CS = 1 * MiB;
constexpr size_t WS_WRT = 1 * MiB + 512 * 1024;
constexpr int WRT_N = 48;
constexpr size_t WS_WP = 2 * MiB;
constexpr size_t WS_WG = 9 * MiB;
constexpr size_t WS_WUA = 13 * MiB, WS_WBP = 14 * MiB, WS_WO = 16 * MiB;
constexpr size_t WS_W2 = 18 * MiB;
constexpr size_t WS_W13 = 50 * MiB;
constexpr size_t WS_U = 114 * MiB;
constexpr size_t WS_P = 179 * MiB;
constexpr size_t WS_Z = 179 * MiB;
constexpr size_t WS_G = 430 * MiB;
constexpr size_t WS_H1 = 244 * MiB;
constexpr size_t WS_HB = 308 * MiB;
constexpr size_t WS_LIST = 374 * MiB;
constexpr size_t WS_GATE = 379 * MiB;
constexpr size_t WS_RSTD2 = 380 * MiB;
constexpr size_t WS_GSL = 381 * MiB;
constexpr size_t WS_RSL = 385 * MiB;
constexpr size_t WS_YA = 397 * MiB;
constexpr size_t WS_OLAT = WS_U;
constexpr size_t WS_HID = 397 * MiB;
constexpr size_t WS_MO = 50 * MiB;
constexpr size_t WS_KIP = 495 * MiB;
constexpr size_t KIP_BATCH = 129 * 4096;
constexpr size_t WS_END = 500 * MiB;
static_assert(WS_P + (size_t)MROWS * PW * 2 <= WS_YA && WS_G + (size_t)2 * NR * 1024 <= WS_KIP && WS_YA + (size_t)MROWS * 512 * 2 <= WS_G && WS_Z + (size_t)MROWS * 1024 * 2 <= WS_H1, "ws map");
static_assert(WS_OLAT + (size_t)NR * 1024 * 2 <= WS_P && WS_U + (size_t)MROWS * 1024 * 2 <= WS_P && WS_MO + (size_t)NTOK * 2048 * 2 <= WS_P, "ws map");
constexpr int CW_CNT = 1024;
constexpr int CW_BAR = 4096;
constexpr int CW_Q = 16384;

typedef unsigned short bf16_t;
typedef short bf16x8 __attribute__((ext_vector_type(8)));
typedef float f32x4 __attribute__((ext_vector_type(4)));
typedef float f32x16 __attribute__((ext_vector_type(16)));
typedef unsigned u32x2 __attribute__((ext_vector_type(2)));
typedef unsigned u32x4 __attribute__((ext_vector_type(4)));
typedef unsigned short u16x4 __attribute__((ext_vector_type(4)));
typedef short s16x2 __attribute__((ext_vector_type(2)));
#define LAS __attribute__((address_space(3)))

__device__ __forceinline__ unsigned f2bf(float f) { unsigned u = __float_as_uint(f); return (u + 0x7fffu + ((u >> 16) & 1u)) >> 16; }
typedef __bf16 bf16v2_t __attribute__((ext_vector_type(2)));
typedef float f32v2_t __attribute__((ext_vector_type(2)));
__device__ __forceinline__ unsigned pk2(float lo, float hi) { const f32v2_t v = {lo, hi}; const bf16v2_t r = __builtin_convertvector(v, bf16v2_t); return __builtin_bit_cast(unsigned, r); }
__device__ __forceinline__ float bflo(unsigned w) { return __uint_as_float(w << 16); }
__device__ __forceinline__ float bfhi(unsigned w) { return __uint_as_float(w & 0xffff0000u); }
__device__ __forceinline__ float bf2f(bf16_t b) { return __uint_as_float((unsigned)b << 16); }
__device__ __forceinline__ float wave_sum(float v) {
#pragma unroll
    for (int o = 1; o < 64; o <<= 1) v += __shfl_xor(v, o);
    return v;
}
__device__ __forceinline__ float fmax2(float a, float b) { return __builtin_amdgcn_fmed3f(a, b, 3.0e38f); }
__device__ __forceinline__ float xsum32(float x) { const auto r = __builtin_amdgcn_permlane32_swap(__float_as_uint(x), __float_as_uint(x), false, false); return __uint_as_float(r[0]) + __uint_as_float(r[1]); }
__device__ __forceinline__ float xsum16(float x) { const auto r = __builtin_amdgcn_permlane16_swap(__float_as_uint(x), __float_as_uint(x), false, false); return __uint_as_float(r[0]) + __uint_as_float(r[1]); }
__device__ __forceinline__ float xmax32(float x) { const auto r = __builtin_amdgcn_permlane32_swap(__float_as_uint(x), __float_as_uint(x), false, false); return fmax2(__uint_as_float(r[0]), __uint_as_float(r[1])); }
__device__ __forceinline__ float xmax16(float x) { const auto r = __builtin_amdgcn_permlane16_swap(__float_as_uint(x), __float_as_uint(x), false, false); return fmax2(__uint_as_float(r[0]), __uint_as_float(r[1])); }
__device__ __forceinline__ float xpartner32(float x, int hh) { const auto r = __builtin_amdgcn_permlane32_swap(__float_as_uint(x), __float_as_uint(x), false, false); return __uint_as_float(hh ? r[0] : r[1]); }
__device__ __forceinline__ float fexp2(float x) { return __builtin_amdgcn_exp2f(x); }
__device__ __forceinline__ float sigmoidf(float x) { return __builtin_amdgcn_rcpf(1.0f + fexp2(-LOG2E * x)); }

struct Params {
    const float* in[18];
    float* out;
    unsigned char* ws;
    int ph_lo, ph_hi;
};
enum { I_X = 0, I_META, I_GMIX, I_WIN, I_WUK, I_WUV, I_WUPA, I_WUPB, I_WO, I_GFFN, I_WGRP, I_BGRP, I_WRT, I_BRT, I_W1, I_W3, I_W2, I_GFIN };

__device__ __forceinline__ const float* h0_row(const Params& p, int row) {
    const int b = row / T, t = row - b * T;
    return t < NMETA ? p.in[I_META] + (size_t)t * D : p.in[I_X] + ((size_t)b * SEQ + (t - NMETA)) * D;
}
template <class F>
__device__ __forceinline__ void tr_item(F val, bf16_t* dst, int ldd, int row0, int k0, float* scr, int lane, int rstep = 1) {
    float tv[32];
#pragma unroll
    for (int i = 0; i < 32; ++i) tv[i] = val(k0 + 2 * i + (lane >> 5), lane & 31);
#pragma unroll
    for (int i = 0; i < 32; ++i) scr[(2 * i + (lane >> 5)) * 33 + (lane & 31)] = tv[i];
    __builtin_amdgcn_s_waitcnt(0xC07F);
    asm volatile("" ::: "memory");
    const int c = lane & 7;
#pragma unroll
    for (int j = 0; j < 4; ++j) {
        const int n = (lane >> 3) + 8 * j; const float* s = scr + (8 * c) * 33 + n;
        u32x4 o; o.x = pk2(s[0], s[33]); o.y = pk2(s[66], s[99]); o.z = pk2(s[132], s[165]); o.w = pk2(s[198], s[231]);
        *(u32x4*)(dst + (size_t)(row0 + n * rstep) * ldd + k0 + 8 * c) = o;
    }
    __builtin_amdgcn_s_waitcnt(0xC07F);
    asm volatile("" ::: "memory");
}

struct XItem { const float* w; int ld; bf16_t* dst; int ldd, row0, k0, rstep; const float* gk; };
__device__ __forceinline__ void tr_load(const XItem& x, int lane, float (&tv)[32]) {
#pragma unroll
    for (int i = 0; i < 32; ++i) tv[i] = x.w[(size_t)(x.k0 + 2 * i + (lane >> 5)) * x.ld + (lane & 31)];
    if (x.gk) {
#pragma unroll
        for (int i = 0; i < 32; ++i) tv[i] *= x.gk[x.k0 + 2 * i + (lane >> 5)];
    }
}
__device__ __forceinline__ void tr_store(const XItem& x, const float (&tv)[32], float* scr, int lane) {
#pragma unroll
    for (int i = 0; i < 32; ++i) scr[(2 * i + (lane >> 5)) * 33 + (lane & 31)] = tv[i];
    __builtin_amdgcn_s_waitcnt(0xC07F);
    asm volatile("" ::: "memory");
    const int c = lane & 7;
#pragma unroll
    for (int j = 0; j < 4; ++j) {
        const int n = (lane >> 3) + 8 * j; const float* s = scr + (8 * c) * 33 + n;
        u32x4 o; o.x = pk2(s[0], s[33]); o.y = pk2(s[66], s[99]); o.z = pk2(s[132], s[165]); o.w = pk2(s[198], s[231]);
        *(u32x4*)(x.dst + (size_t)(x.row0 + n * x.rstep) * x.ldd + x.k0 + 8 * c) = o;
    }
    __builtin_amdgcn_s_waitcnt(0xC07F);
    asm volatile("" ::: "memory");
}

__device__ __forceinline__ void wp_src(int c, int& kind, int& col, int& aux, float& scale) {
    kind = 1; aux = 0; scale = 1.f; col = 0;
    if (c < 512) { col = c; scale = QSCALE; }
    else if (c < C_QF) { col = c; }
    else if (c < C_KV) { const int r = c - C_QF, h = r / QFW, j = r % QFW; scale = QSCALE;
        if (j < 128) { kind = 2; col = h; aux = j; } else { const int i = j - 128; col = 1536 + 64 * h + (i >> 1) + 8 * (i & 1); } }
    else if (c < C_QI) { const int j = c - C_KV; if (j < 128) col = 2048 + j; else { const int i = j - 128; col = 2176 + (i >> 1) + 8 * (i & 1); } }
    else if (c < C_KI) { const int r = c - C_QI, h = r >> 6, j = r & 63; col = 2192 + 64 * h + (j < 16 ? (j >> 1) + 8 * (j & 1) : j); }
    else if (c < C_WI) { const int j = c - C_KI; col = 2704 + (j < 16 ? (j >> 1) + 8 * (j & 1) : j); }
    else if (c < C_END) { col = 2768 + (c - C_WI); }
    else kind = 0;
}

constexpr int IT_WP = (PWN / 32) * 16;
constexpr int IT_WG = 32 * 16;
constexpr int IT_WUA = 32 * 8;
constexpr int IT_WBP = 32 * 16, IT_WO = 32 * 16;
constexpr int IT_W13 = NEXP * 32 * 16;
constexpr int IT_W2 = NEXP * 32 * 8;
constexpr int IT_TOTAL = IT_WP + 2 * IT_WG + IT_WUA + IT_WBP + IT_WO + IT_W13 + IT_W2;

__device__ __forceinline__ void phase_prologue(const Params& p, char* lds) {
    const int tid = threadIdx.x, lane = tid & 63, wave = tid >> 6;
    const int gw = blockIdx.x * NWAVES + wave, NGW = gridDim.x * NWAVES;
    float* scr = (float*)lds + wave * (64 * 33);
    unsigned char* ws = p.ws;
    const float* w_in = p.in[I_WIN];
    {
        float2* cs = (float2*)(ws + WS_CS);
        for (int i = blockIdx.x * NTHREADS + tid; i < T * 8; i += gridDim.x * NTHREADS) {
            const int pos = i >> 3, f = i & 7;
            const float inv = powf(500000.0f, -(float)f / 8.0f);
            const float ang = (float)pos * inv;
            cs[i] = make_float2(cosf(ang), sinf(ang));
        }
    }
    {
        bf16_t* wrt = (bf16_t*)(ws + WS_WRT); const float* wgp = p.in[I_WGRP]; const float* wrp = p.in[I_WRT];
        for (int i = blockIdx.x * NTHREADS + tid; i < WRT_N * D; i += gridDim.x * NTHREADS) {
            const int nn = i >> 10, k = i & 1023;
            const float w = (nn < 4 ? wgp[k * 4 + nn] : nn < 36 ? wrp[k * 32 + (nn - 4)] : 0.f) * p.in[I_GFFN][k];
            const unsigned hi = f2bf(w); wrt[i] = (bf16_t)hi; wrt[WRT_N * D + i] = (bf16_t)f2bf(w - __uint_as_float(hi << 16));
        }
    }
    constexpr int IT_SMALL = IT_TOTAL - IT_W13 - IT_W2;
    for (int it = gw; it < IT_SMALL; it += NGW) {
        int r = it;
        if (r < IT_WP) {
            const int rg = r / 16, kb = r % 16, c = rg * 32 + (lane & 31);
            int kind, col, aux; float scale; wp_src(c, kind, col, aux, scale);
            const float* w_uk = p.in[I_WUK];
            float wu[48];
#pragma unroll
            for (int n4 = 0; n4 < 12; ++n4) { f32x4 t = (f32x4){0.f, 0.f, 0.f, 0.f}; if (kind == 2) t = *(const f32x4*)(w_uk + ((size_t)col * 128 + aux) * 48 + 4 * n4); wu[4 * n4] = t.x; wu[4 * n4 + 1] = t.y; wu[4 * n4 + 2] = t.z; wu[4 * n4 + 3] = t.w; }
            if (__any(kind == 2)) {
                const int colh = kind == 2 ? col : 0, cold = kind == 1 ? col : 0; const float dsel = kind == 1 ? 1.f : 0.f;
                const float* pbase = w_in + 1536 + 64 * colh + 16;
                float tvf[32];
#pragma unroll
                for (int i0 = 0; i0 < 32; i0 += 2) {
                    const size_t ka = (size_t)(kb * 64 + 2 * i0 + (lane >> 5)) * INW, kbb = ka + 2 * (size_t)INW;
                    const f32x4* pa = (const f32x4*)(pbase + ka); const f32x4* pb = (const f32x4*)(pbase + kbb);
                    f32x4 ra[12], rb[12];
#pragma unroll
                    for (int n4 = 0; n4 < 12; ++n4) { ra[n4] = pa[n4]; rb[n4] = pb[n4]; }
                    const float va = w_in[ka + cold], vb = w_in[kbb + cold];
                    float sa = 0.f, sb = 0.f;
#pragma unroll
                    for (int n4 = 0; n4 < 12; ++n4) { sa += ra[n4].x * wu[4 * n4] + ra[n4].y * wu[4 * n4 + 1] + ra[n4].z * wu[4 * n4 + 2] + ra[n4].w * wu[4 * n4 + 3];
                                                      sb += rb[n4].x * wu[4 * n4] + rb[n4].y * wu[4 * n4 + 1] + rb[n4].z * wu[4 * n4 + 2] + rb[n4].w * wu[4 * n4 + 3]; }
                    tvf[i0] = scale * (sa + dsel * va); tvf[i0 + 1] = scale * (sb + dsel * vb);
                    __builtin_amdgcn_sched_barrier(0);
                }
                XItem x; x.w = nullptr; x.ld = 0; x.dst = (bf16_t*)(ws + WS_WP); x.ldd = 1024; x.row0 = rg * 32; x.k0 = kb * 64; x.rstep = 1; x.gk = nullptr; tr_store(x, tvf, scr, lane);
                continue;
            }
            tr_item([&](int k, int) -> float {
                if (kind == 0) return 0.f;
                return scale * w_in[(size_t)k * INW + col]; }, (bf16_t*)(ws + WS_WP), 1024, rg * 32, kb * 64, scr, lane);
            continue; }
        r -= IT_WP;
        if (r < 2 * IT_WG) {
            const int which = r / IT_WG; r %= IT_WG; const int rg = r / 16, kb = r % 16; const int col0 = (which ? 3800 : 2776) + rg * 32;
            tr_item([&](int k, int n) -> float { return w_in[(size_t)k * INW + col0 + n]; }, (bf16_t*)(ws + WS_WG) + (size_t)which * 1024 * 1024, 1024, rg * 32, kb * 64, scr, lane);
            continue; }
        r -= 2 * IT_WG;
        if (r < IT_WUA) {
            const int rg = r / 8, kb = r % 8; const float* w = p.in[I_WUPA];
            tr_item([&](int k, int n) -> float { return w[(size_t)k * 1024 + rg * 32 + n]; }, (bf16_t*)(ws + WS_WUA), 512, rg * 32, kb * 64, scr, lane);
            continue; }
        r -= IT_WUA;
        if (r < IT_WO) {
            const int rg = r / 16, kb = r % 16; const float* w = p.in[I_WO];
            tr_item([&](int k, int n) -> float { return w[(size_t)k * 1024 + rg * 32 + n]; }, (bf16_t*)(ws + WS_WO), 1024, rg * 32, kb * 64, scr, lane);
            continue; }
        r -= IT_WO;
        if (r < IT_WBP) {
            const int rg = r / 16, kb = r % 16; const float* wuv = p.in[I_WUV]; const float* wub = p.in[I_WUPB];
            const int hB = kb >> 1;
            float* wt = (float*)(lds + NWAVES * 64 * 33 * 4 + 1024) + wave * (32 * 64);
            f32x4 ar[16], br[8];
#pragma unroll
            for (int d4 = 0; d4 < 16; ++d4) ar[d4] = *(const f32x4*)(wuv + (size_t)(kb * 64 + lane) * 64 + 4 * d4);
#pragma unroll
            for (int n4 = 0; n4 < 8; ++n4) br[n4] = *(const f32x4*)(wub + (size_t)(64 * hB + lane) * 1024 + rg * 32 + 4 * n4);
#pragma unroll
            for (int n4 = 0; n4 < 8; ++n4) { wt[(4 * n4) * 64 + lane] = br[n4].x; wt[(4 * n4 + 1) * 64 + lane] = br[n4].y; wt[(4 * n4 + 2) * 64 + lane] = br[n4].z; wt[(4 * n4 + 3) * 64 + lane] = br[n4].w; }
            __builtin_amdgcn_s_waitcnt(0xC07F);
            asm volatile("" ::: "memory");
#pragma unroll 4
            for (int n = 0; n < 32; ++n) {
                const f32x4* wr_ = (const f32x4*)(wt + n * 64); float s = 0.f;
#pragma unroll
                for (int d4 = 0; d4 < 16; ++d4) { const f32x4 t = wr_[d4]; s += ar[d4].x * t.x + ar[d4].y * t.y + ar[d4].z * t.z + ar[d4].w * t.w; }
                scr[lane * 33 + n] = s;
            }
            __builtin_amdgcn_s_waitcnt(0xC07F);
            asm volatile("" ::: "memory");
            { bf16_t* dst = (bf16_t*)(ws + WS_WBP); const int c = lane & 7;
#pragma unroll
              for (int j = 0; j < 4; ++j) { const int n = (lane >> 3) + 8 * j; const float* s = scr + (8 * c) * 33 + n;
                  u32x4 o; o.x = pk2(s[0], s[33]); o.y = pk2(s[66], s[99]); o.z = pk2(s[132], s[165]); o.w = pk2(s[198], s[231]);
                  *(u32x4*)(dst + (size_t)(rg * 32 + n) * 1024 + kb * 64 + 8 * c) = o; } }
            __builtin_amdgcn_s_waitcnt(0xC07F);
            asm volatile("" ::: "memory");
            continue; }
        r -= IT_WBP;
    }
    {
        auto decode = [&](int r, XItem& x) {
            if (r < IT_W13) { const int e = r / 512; r %= 512; const int which = r & 1, cg = (r >> 1) & 15, kb = r >> 5;
                x.w = (which ? p.in[I_W3] : p.in[I_W1]) + (size_t)e * 1024 * 512 + cg * 32; x.ld = 512; x.dst = (bf16_t*)(ws + WS_W13) + (size_t)e * 1024 * 1024; x.ldd = 1024; x.row0 = 256 * (cg >> 2) + 128 * which + 32 * (cg & 3); x.k0 = kb * 64; x.rstep = 1; x.gk = p.in[I_GFFN]; }
            else { r -= IT_W13; const int e = r / 256; r %= 256; const int rg = r / 8, kb = r % 8;
                x.w = p.in[I_W2] + (size_t)e * 512 * 1024 + rg * 32; x.ld = 1024; x.dst = (bf16_t*)(ws + WS_W2) + (size_t)e * 1024 * 512; x.ldd = 512; x.row0 = rg * 32; x.k0 = kb * 64; x.rstep = 1; x.gk = nullptr; }
        };
        XItem cur, nxt; float tv[32], tvn[32];
        unsigned* qctr = (unsigned*)(ws + WS_CTL) + CW_Q; int* QB = (int*)(lds + NWAVES * 64 * 33 * 4);
        constexpr int NX = IT_W13 + IT_W2;
#define PRO_GRAB(dst_) do { __syncthreads(); if (tid == 0) QB[0] = (int)atomicAdd(qctr, (unsigned)NWAVES); __syncthreads(); dst_ = QB[0] + wave; } while (0)
        int a, b2;
        PRO_GRAB(a);
        if (a < NX) { decode(a, cur); tr_load(cur, lane, tv); }
        PRO_GRAB(b2);
        if (b2 < NX) { decode(b2, nxt); tr_load(nxt, lane, tvn); }
        while (a < NX) {
            int req = 0;
            if (tid == 0 && b2 < NX) req = (int)atomicAdd(qctr, (unsigned)NWAVES);
            tr_store(cur, tv, scr, lane);
            int c2 = NX;
            if (b2 < NX) { __syncthreads(); if (tid == 0) QB[0] = req; __syncthreads(); c2 = QB[0] + wave; }
            a = b2; cur = nxt;
#pragma unroll
            for (int i = 0; i < 32; ++i) tv[i] = tvn[i];
            if (c2 < NX) { decode(c2, nxt); tr_load(nxt, lane, tvn); }
            b2 = c2;
        }
#undef PRO_GRAB
    }
    {
        const float* g = p.in[I_GMIX]; bf16_t* U = (bf16_t*)(ws + WS_U);
        f32x4 vn[4], gq[4];
#pragma unroll
        for (int j = 0; j < 4; ++j) gq[j] = ((const f32x4*)g)[lane + 64 * j];
        if (gw < NTOK) { const f32x4* xr = (const f32x4*)h0_row(p, gw) + lane;
#pragma unroll
            for (int j = 0; j < 4; ++j) vn[j] = xr[64 * j]; }
        for (int row = gw; row < NTOK; row += NGW) {
            f32x4 v[4]; float s = 0.f;
#pragma unroll
            for (int j = 0; j < 4; ++j) v[j] = vn[j];
            if (row + NGW < NTOK) { const f32x4* xr = (const f32x4*)h0_row(p, row + NGW) + lane;
#pragma unroll
                for (int j = 0; j < 4; ++j) vn[j] = xr[64 * j]; }
#pragma unroll
            for (int j = 0; j < 4; ++j) s += (v[j].x * v[j].x + v[j].y * v[j].y) + (v[j].z * v[j].z + v[j].w * v[j].w);
            const float rstd = rsqrtf(wave_sum(s) * (1.f / D) + NORM_EPS);
            u32x2* o = (u32x2*)(U + (size_t)row * D) + lane;
#pragma unroll
            for (int j = 0; j < 4; ++j) { const f32x4 gg = gq[j];
                u32x2 w; w.x = pk2(v[j].x * rstd * gg.x, v[j].y * rstd * gg.y); w.y = pk2(v[j].z * rstd * gg.z, v[j].w * rstd * gg.w); o[64 * j] = w; }
        }
    }
}

namespace pg8 {
#define PG8_LAS __attribute__((address_space(3)))
typedef unsigned short bf16_t;
typedef short bf16x8 __attribute__((ext_vector_type(8)));
typedef float f32x4 __attribute__((ext_vector_type(4)));
typedef unsigned u32x4 __attribute__((ext_vector_type(4)));
constexpr int BM = 256, BK = 64, HALF = 128, HTB = HALF * BK * 2  , STAGE_BYTES = 8 * HTB, NXCD = 8, WGM = 8;

__host__ __device__ __forceinline__ int lds_byte(int r, int c) { const int st = (r >> 4) * 2 + (c >> 5), rr = r & 15, cc = c & 31, ob = rr * 64 + cc * 2; return st * 1024 + (ob ^ (((ob >> 9) & 1) << 5)); }
__host__ __device__ __forceinline__ void stage_rc(int b, int& R, int& C) { const int st = b / 1024, sb = b % 1024, swz = sb ^ (((sb >> 9) & 1) << 5); R = (st >> 1) * 16 + swz / 64; C = (st & 1) * 32 + (swz % 64) / 2; }
__host__ __device__ __forceinline__ int perm32(int rho) { const int n = rho >> 4, i = rho & 15; return 8 * (i >> 2) + 4 * n + (i & 3); }

struct Unit { int pm, pn; };
struct Gemm { const bf16_t* A; const bf16_t* Bt; int M, N, K; };

struct StaticOrder {
    int nM, nN, nwg, G, c;
    __host__ __device__ void init(int M, int N, int G_, int c_) { nM = M / BM; nN = N / BM; nwg = nM * nN; G = G_; c = c_; }
    __host__ __device__ bool next(int i, Unit& u) const {
        const long L = (long)i * G + c; if (L >= nwg) return false;
        int wgid = (int)L; { const int q = nwg / NXCD, r = nwg % NXCD, xcd = wgid % NXCD, off = wgid / NXCD; wgid = (xcd < r ? xcd * (q + 1) : r * (q + 1) + (xcd - r) * q) + off; }
        const int nig = WGM * nN, gid = wgid / nig, fm = gid * WGM, gsz = (nM - fm) < WGM ? (nM - fm) : WGM;
        u.pm = fm + ((wgid % nig) % gsz); u.pn = (wgid % nig) / gsz; return true;
    }
    __device__ __forceinline__ void a_ready(const Unit&) const {}
    __device__ __forceinline__ void done(const Unit&) const {}
};


#define PG8_FOR_FRAGS(...) _Pragma("unroll") for (int ai = 0; ai < 2; ++ai) _Pragma("unroll") for (int m = 0; m < 4; ++m) { const int row = u.pm * BM + ai * HALF + wr * 64 + m * 16 + fr; \
    _Pragma("unroll") for (int bj = 0; bj < 2; ++bj) _Pragma("unroll") for (int n = 0; n < 2; ++n) { const int col = u.pn * BM + bj * HALF + wc * 32 + n * 16 + 4 * fq; ::f32x4 v = acc[ai][bj][m][n]; __VA_ARGS__ } }
__device__ __forceinline__ bool rope_off(int c, int& o) {
    if (c < C_QF) return false;
    if (c < C_KV) { const int j = (c - C_QF) % QFW; o = j - 128; return j >= 128; }
    if (c < C_QI) { const int j = c - C_KV; o = j - 128; return j >= 128; }
    if (c < C_KI) { const int j = (c - C_QI) & 63; o = j; return j < 16; }
    if (c < C_WI) { const int j = c - C_KI; o = j; return j < 16; }
    return false;
}
#define PG8_FOR_FRAGS8(...) _Pragma("unroll") for (int ai = 0; ai < 2; ++ai) _Pragma("unroll") for (int m = 0; m < 4; ++m) { const int row = u.pm * BM + ai * HALF + wr * 64 + m * 16 + fr; \
    _Pragma("unroll") for (int bj = 0; bj < 2; ++bj) { const int col = u.pn * BM + bj * HALF + wc * 32 + 8 * fq; ::f32x4 v0 = acc[ai][bj][m][0], v1 = acc[ai][bj][m][1]; __VA_ARGS__ } }
struct EpiInproj {
    static constexpr bool PERM = true, AFTER_DRAIN = false;
    bf16_t* P; const float2* cs; unsigned char* KIP; unsigned char* GQ;
    __device__ __forceinline__ void operator()(const f32x4 (&acc)[2][2][4][2], const Unit& u, int wr, int wc, int fr, int fq) const {
        asm volatile("" : "+v"(fr), "+v"(fq));
        if (u.pn >= PWN / BM) {
            const int pg = u.pn - PWN / BM;
            unsigned char* base = GQ + (size_t)(pg >> 2) * NR * 1024 + (pg & 3) * 256 + (wc * 4 + fq) * 16;
#define PG8_Q8(x_, k_, old_) __builtin_amdgcn_cvt_pk_u8_f32(__builtin_rintf(255.f * sigmoidf(x_)), (k_), (old_))
#define PG8_Q4(v_) PG8_Q8((v_).w, 3, PG8_Q8((v_).z, 2, PG8_Q8((v_).y, 1, PG8_Q8((v_).x, 0, 0u))))
#pragma unroll
            for (int ai = 0; ai < 2; ++ai)
#pragma unroll
                for (int m = 0; m < 4; ++m) { const int row = u.pm * BM + ai * HALF + wr * 64 + m * 16 + fr;
                    ::u32x4 w; w.x = PG8_Q4(acc[ai][0][m][0]); w.y = PG8_Q4(acc[ai][0][m][1]); w.z = PG8_Q4(acc[ai][1][m][0]); w.w = PG8_Q4(acc[ai][1][m][1]);
                    *(::u32x4*)(base + (size_t)row * 1024) = w; }
#undef PG8_Q4
#undef PG8_Q8
            return;
        }
#pragma unroll
        for (int bj = 0; bj < 2; ++bj) {
            const int col = u.pn * BM + bj * HALF + wc * 32 + 8 * fq;
            if (col < PW) {
                int o = 0; const bool rp = rope_off(col, o);
                const bool ki = col >= C_KI && col < C_WI;
                ::f32x4 cq[8][2];
                if (rp) {
#pragma unroll
                    for (int j = 0; j < 8; ++j) { const int row = u.pm * BM + (j >> 2) * HALF + wr * 64 + (j & 3) * 16 + fr; const int pos = (row % SEQ) + NMETA;
                        const ::f32x4* cp = (const ::f32x4*)(cs + pos * 8 + (o >> 1)); cq[j][0] = cp[0]; cq[j][1] = cp[1]; }
                }
#pragma unroll
                for (int j = 0; j < 8; ++j) { const int ai = j >> 2, m = j & 3; const int row = u.pm * BM + ai * HALF + wr * 64 + m * 16 + fr;
                    ::f32x4 v0 = acc[ai][bj][m][0], v1 = acc[ai][bj][m][1];
                    if (rp) { const ::f32x4 ca = cq[j][0], cb = cq[j][1];
                        v0 = (::f32x4){v0.x * ca.x - v0.y * ca.y, v0.y * ca.x + v0.x * ca.y, v0.z * ca.z - v0.w * ca.w, v0.w * ca.z + v0.z * ca.w};
                        v1 = (::f32x4){v1.x * cb.x - v1.y * cb.y, v1.y * cb.x + v1.x * cb.y, v1.z * cb.z - v1.w * cb.w, v1.w * cb.z + v1.z * cb.w}; }
                    ::u32x4 w; w.x = pk2(v0.x, v0.y); w.y = pk2(v0.z, v0.w); w.z = pk2(v1.x, v1.y); w.w = pk2(v1.z, v1.w);
                    if (ki) {
                        const int b = row / SEQ, t = row - b * SEQ + NMETA, d0 = col - C_KI;
                        *(::u32x4*)(KIP + (size_t)b * KIP_BATCH + (size_t)((((t >> 5) * 4 + (d0 >> 4)) * 2 + ((d0 >> 3) & 1)) * 512 + (t & 31) * 16)) = w;
                    } else *(::u32x4*)(P + (size_t)tokrow(row) * PW + col) = w; }
            }
        }
    }
};
struct EpiGate {
    static constexpr bool PERM = true, AFTER_DRAIN = false;
    unsigned char* GQ;
    __device__ __forceinline__ void operator()(const f32x4 (&acc)[2][2][4][2], const Unit& u, int wr, int wc, int fr, int fq) const {
        unsigned char* base = GQ + (size_t)(u.pn >> 2) * NR * 1024 + (u.pn & 3) * 256 + (wc * 4 + fq) * 16;
#define PG8_Q8(x_, k_, old_) __builtin_amdgcn_cvt_pk_u8_f32(__builtin_rintf(255.f * sigmoidf(x_)), (k_), (old_))
#define PG8_Q4(v_) PG8_Q8((v_).w, 3, PG8_Q8((v_).z, 2, PG8_Q8((v_).y, 1, PG8_Q8((v_).x, 0, 0u))))
#pragma unroll
        for (int ai = 0; ai < 2; ++ai)
#pragma unroll
            for (int m = 0; m < 4; ++m) { const int row = u.pm * BM + ai * HALF + wr * 64 + m * 16 + fr;
                ::u32x4 w; w.x = PG8_Q4(acc[ai][0][m][0]); w.y = PG8_Q4(acc[ai][0][m][1]); w.z = PG8_Q4(acc[ai][1][m][0]); w.w = PG8_Q4(acc[ai][1][m][1]);
                *(::u32x4*)(base + (size_t)row * 1024) = w; }
#undef PG8_Q4
#undef PG8_Q8
    }
};
template <bool ACCUM> struct EpiZ {
    static constexpr bool PERM = true, AFTER_DRAIN = false;
    bf16_t* Z; const bf16_t* G; int goff;
    __device__ __forceinline__ void operator()(const f32x4 (&acc)[2][2][4][2], const Unit& u, int wr, int wc, int fr, int fq) const {
        PG8_FOR_FRAGS8(
            const ::u32x4 g = *(const ::u32x4*)(G + (size_t)row * 2048 + goff + col);
            ::f32x4 z0 = (::f32x4){bflo(g.x) * v0.x, bfhi(g.x) * v0.y, bflo(g.y) * v0.z, bfhi(g.y) * v0.w}, z1 = (::f32x4){bflo(g.z) * v1.x, bfhi(g.z) * v1.y, bflo(g.w) * v1.z, bfhi(g.w) * v1.w};
            ::u32x4* zp = (::u32x4*)(Z + (size_t)row * D + col);
            if (ACCUM) { const ::u32x4 o = *zp; z0.x += bflo(o.x); z0.y += bfhi(o.x); z0.z += bflo(o.y); z0.w += bfhi(o.y); z1.x += bflo(o.z); z1.y += bfhi(o.z); z1.z += bflo(o.w); z1.w += bfhi(o.w); }
            ::u32x4 w; w.x = pk2(z0.x, z0.y); w.y = pk2(z0.z, z0.w); w.z = pk2(z1.x, z1.y); w.w = pk2(z1.z, z1.w); *zp = w; )
    }
};
struct EpiH1 {
    static constexpr bool PERM = true, AFTER_DRAIN = false;
    bf16_t* Y;
    __device__ __forceinline__ void operator()(const f32x4 (&acc)[2][2][4][2], const Unit& u, int wr, int wc, int fr, int fq) const {
        PG8_FOR_FRAGS8( ::u32x4 w; w.x = pk2(v0.x, v0.y); w.y = pk2(v0.z, v0.w); w.z = pk2(v1.x, v1.y); w.w = pk2(v1.z, v1.w); *(::u32x4*)(Y + (size_t)row * D + col) = w; )
    }
};
#undef PG8_FOR_FRAGS
#undef PG8_FOR_FRAGS8

template <class Epi, class Sched, bool ALIGN_EPI = false, bool SP2 = false>
__device__ __forceinline__ void gemm_phase(PG8_LAS unsigned char* lds, const Gemm g, const Sched& S, const Epi& E) {
    const int tid = threadIdx.x, wid = __builtin_amdgcn_readfirstlane(tid >> 6), lane = tid & 63, wr = wid >> 2, wc = wid & 3, fr = lane & 15, fq = lane >> 4;
    const int K = g.K, nt = K / BK;
    unsigned voffA[2], voffB[2];
#pragma unroll
    for (int i = 0; i < 2; ++i) { int R, C; stage_rc(tid * 16 + i * 8192, R, C); const int Rb = Epi::PERM ? ((R & ~31) + perm32(R & 31)) : R;
        voffA[i] = (unsigned)(R * K + C) * 2u; voffB[i] = (unsigned)(Rb * K + C) * 2u; }
    const size_t kstep = (size_t)(BK * 2);
    const size_t hstep = (size_t)HALF * K * 2;
    const size_t tstep = 2 * hstep;
    const unsigned ldsw = (unsigned)wid * 1024u;
    const int aoff = lds_byte(wr * 64 + fr, fq * 8), boff = lds_byte(wc * 32 + fr, fq * 8);
#define PG8_SA(b, h) (((b) * 2 + (h)) * HTB)
#define PG8_SB(b, h) ((4 + (b) * 2 + (h)) * HTB)
#define PG8_STAGE(bufoff, gbase, voff) do { _Pragma("unroll") for (int _i = 0; _i < 2; ++_i) { unsigned o_ = (voff)[_i]; asm volatile("" : "+v"(o_));   \
        __builtin_amdgcn_global_load_lds((const unsigned*)((const char*)(gbase) + o_), (PG8_LAS unsigned*)(lds + (bufoff) + ldsw + _i * 8192), 16, 0, 0); } } while (0)
#define PG8_LDA(dst, b, h) do { _Pragma("unroll") for (int m = 0; m < 4; ++m) _Pragma("unroll") for (int k = 0; k < 2; ++k) dst[m][k] = *(const PG8_LAS bf16x8*)(lds + PG8_SA(b, h) + aoff + m * 2048 + k * 1024); } while (0)
#define PG8_LDB(dst, b, h) do { _Pragma("unroll") for (int n = 0; n < 2; ++n) _Pragma("unroll") for (int k = 0; k < 2; ++k) dst[n][k] = *(const PG8_LAS bf16x8*)(lds + PG8_SB(b, h) + boff + n * 2048 + k * 1024); } while (0)
#define PG8_MMA(ai, bj, At, Bt) do { __builtin_amdgcn_s_setprio(1); _Pragma("unroll") for (int m = 0; m < 4; ++m) _Pragma("unroll") for (int n = 0; n < 2; ++n) _Pragma("unroll") for (int k = 0; k < 2; ++k) \
        acc[ai][bj][m][n] = __builtin_amdgcn_mfma_f32_16x16x32_bf16(Bt[n][k], At[m][k], acc[ai][bj][m][n], 0, 0, 0); __builtin_amdgcn_s_setprio(0); } while (0)
#define PG8_WAIT_V(n) asm volatile("s_waitcnt vmcnt(" #n ")" ::: "memory")
#define PG8_WAIT_L(n) asm volatile("s_waitcnt lgkmcnt(" #n ")" ::: "memory")
#define PG8_BAR __builtin_amdgcn_s_barrier()
#define PG8_SCHED __builtin_amdgcn_sched_barrier(0)
    Unit cur, nxt; int ui = 0;
    if (!S.next(0, cur)) return;
    f32x4 acc[2][2][4][2];
#pragma unroll
    for (int a = 0; a < 2; ++a)
#pragma unroll
        for (int b = 0; b < 2; ++b)
#pragma unroll
            for (int m = 0; m < 4; ++m)
#pragma unroll
                for (int n = 0; n < 2; ++n) acc[a][b][m][n] = (f32x4){0.f, 0.f, 0.f, 0.f};
    bf16x8 At[4][2], B0[2][2], B1[2][2];
    const char* cA = (const char*)g.A + (size_t)cur.pm * tstep; const char* cB = (const char*)g.Bt + (size_t)cur.pn * tstep;
    S.a_ready(cur);
    if constexpr (SP2) {
        PG8_STAGE(PG8_SB(0, 0), cB, voffB); PG8_STAGE(PG8_SB(0, 1), cB + hstep, voffB); PG8_STAGE(PG8_SA(0, 0), cA, voffA); PG8_STAGE(PG8_SA(0, 1), cA + hstep, voffA);
        if (wr == 1) PG8_BAR;
        PG8_WAIT_V(2); PG8_BAR;
        PG8_STAGE(PG8_SB(1, 0), cB + kstep, voffB); PG8_STAGE(PG8_SA(1, 0), cA + kstep, voffA); PG8_STAGE(PG8_SB(1, 1), cB + hstep + kstep, voffB);
        PG8_WAIT_V(6); PG8_BAR;
    } else {
        PG8_STAGE(PG8_SB(0, 0), cB, voffB); PG8_STAGE(PG8_SA(0, 0), cA, voffA); PG8_STAGE(PG8_SB(0, 1), cB + hstep, voffB); PG8_STAGE(PG8_SA(0, 1), cA + hstep, voffA);
        if (wr == 1) PG8_BAR;
        PG8_WAIT_V(4); PG8_BAR;
        PG8_STAGE(PG8_SB(1, 0), cB + kstep, voffB); PG8_STAGE(PG8_SA(1, 0), cA + kstep, voffA); PG8_STAGE(PG8_SB(1, 1), cB + hstep + kstep, voffB);
        PG8_WAIT_V(6); PG8_BAR;
    }
    for (;;) {
        const bool has_next = S.next(ui + 1, nxt);
        const char* nA = has_next ? (const char*)g.A + (size_t)nxt.pm * tstep : cA; const char* nB = has_next ? (const char*)g.Bt + (size_t)nxt.pn * tstep : cB;
        for (int t = 0; t < nt; t += 2) {
            const bool last = (t == nt - 2);
            const char* a1 = cA + (size_t)(t + 1) * kstep;
            const char* a2 = last ? nA : cA + (size_t)(t + 2) * kstep; const char* b2 = last ? nB : cB + (size_t)(t + 2) * kstep;
            const char* a3 = a2 + kstep; const char* b3 = b2 + kstep;
            if (last && has_next) S.a_ready(nxt);
            if constexpr (SP2) {
            PG8_LDB(B0, 0, 0); PG8_LDB(B1, 0, 1); PG8_SCHED; PG8_LDA(At, 0, 0); PG8_STAGE(PG8_SA(1, 1), a1 + hstep, voffA);
            PG8_WAIT_V(8); PG8_WAIT_L(0); PG8_BAR; PG8_MMA(0, 0, At, B0); PG8_MMA(0, 1, At, B1); PG8_BAR; PG8_SCHED;
            PG8_LDA(At, 0, 1); PG8_STAGE(PG8_SB(0, 0), b2, voffB); PG8_STAGE(PG8_SB(0, 1), b2 + hstep, voffB); PG8_STAGE(PG8_SA(0, 0), a2, voffA);
            PG8_WAIT_V(8); PG8_WAIT_L(0); PG8_BAR; PG8_MMA(1, 0, At, B0); PG8_MMA(1, 1, At, B1); PG8_BAR; PG8_SCHED;
            PG8_LDB(B0, 1, 0); PG8_LDB(B1, 1, 1); PG8_SCHED; PG8_LDA(At, 1, 0); PG8_STAGE(PG8_SA(0, 1), a2 + hstep, voffA);
            PG8_WAIT_V(8); PG8_WAIT_L(0); PG8_BAR; PG8_MMA(0, 0, At, B0); PG8_MMA(0, 1, At, B1); PG8_BAR; PG8_SCHED;
            PG8_LDA(At, 1, 1); PG8_STAGE(PG8_SB(1, 0), b3, voffB); PG8_STAGE(PG8_SB(1, 1), b3 + hstep, voffB); PG8_STAGE(PG8_SA(1, 0), a3, voffA);
            PG8_WAIT_V(8); PG8_WAIT_L(0); PG8_BAR; PG8_MMA(1, 0, At, B0); PG8_MMA(1, 1, At, B1); PG8_BAR; PG8_SCHED;
            } else {
            PG8_LDB(B0, 0, 0); PG8_SCHED; PG8_LDA(At, 0, 0); PG8_STAGE(PG8_SA(1, 1), a1 + hstep, voffA);
            PG8_WAIT_L(8); PG8_BAR; PG8_WAIT_L(0); PG8_MMA(0, 0, At, B0); PG8_BAR; PG8_SCHED;
            PG8_LDB(B1, 0, 1); PG8_STAGE(PG8_SB(0, 0), b2, voffB);
            PG8_BAR; PG8_WAIT_L(0); PG8_MMA(0, 1, At, B1); PG8_BAR;
            PG8_LDA(At, 0, 1); PG8_STAGE(PG8_SA(0, 0), a2, voffA);
            PG8_BAR; PG8_WAIT_L(0); PG8_MMA(1, 0, At, B0); PG8_BAR; PG8_SCHED;
            PG8_STAGE(PG8_SB(0, 1), b2 + hstep, voffB);
            PG8_WAIT_V(6); PG8_BAR; PG8_MMA(1, 1, At, B1); PG8_BAR;
            PG8_LDB(B0, 1, 0); PG8_SCHED; PG8_LDA(At, 1, 0); PG8_STAGE(PG8_SA(0, 1), a2 + hstep, voffA);
            PG8_WAIT_L(8); PG8_BAR; PG8_WAIT_L(0); PG8_MMA(0, 0, At, B0); PG8_BAR; PG8_SCHED;
            PG8_LDB(B1, 1, 1); PG8_STAGE(PG8_SB(1, 0), b3, voffB);
            PG8_BAR; PG8_WAIT_L(0); PG8_MMA(0, 1, At, B1); PG8_BAR;
            PG8_LDA(At, 1, 1); PG8_STAGE(PG8_SA(1, 0), a3, voffA);
            PG8_BAR; PG8_WAIT_L(0); PG8_MMA(1, 0, At, B0); PG8_BAR; PG8_SCHED;
            PG8_STAGE(PG8_SB(1, 1), b3 + hstep, voffB);
            PG8_WAIT_V(6); PG8_BAR; PG8_MMA(1, 1, At, B1); PG8_BAR;
            }
        }
        if constexpr (ALIGN_EPI) { if (wr == 0) PG8_BAR; }
        if constexpr (!Epi::AFTER_DRAIN) { E(acc, cur, wr, wc, fr, fq); S.done(cur); }
        if (!has_next) break;
#pragma unroll
        for (int a = 0; a < 2; ++a)
#pragma unroll
            for (int b = 0; b < 2; ++b)
#pragma unroll
                for (int m = 0; m < 4; ++m)
#pragma unroll
                    for (int n = 0; n < 2; ++n) acc[a][b][m][n] = (f32x4){0.f, 0.f, 0.f, 0.f};
        cur = nxt; cA = nA; cB = nB; ++ui;
        if constexpr (ALIGN_EPI) { if (wr == 1) PG8_BAR; }
    }
    PG8_WAIT_V(0);
    if constexpr (!ALIGN_EPI) { if (wr == 0) PG8_BAR; }
    PG8_BAR;
    if constexpr (Epi::AFTER_DRAIN) { E.fused(acc, cur, wr, wc, fr, fq, lds, wid, lane); S.done(cur); }
#undef PG8_SA
#undef PG8_SB
#undef PG8_STAGE
#undef PG8_LDA
#undef PG8_LDB
#undef PG8_MMA
#undef PG8_WAIT_V
#undef PG8_WAIT_L
#undef PG8_BAR
#undef PG8_SCHED
}
__device__ __forceinline__ void gemm_phase_zf(PG8_LAS unsigned char* lds, const bf16_t* Ap1, const bf16_t* Bp1, const bf16_t* Ap2, const bf16_t* Bp2, const StaticOrder& S, const unsigned char* GQ, bf16_t* Z) {
    const int tid = threadIdx.x, wid = __builtin_amdgcn_readfirstlane(tid >> 6), lane = tid & 63, wr = wid >> 2, wc = wid & 3, fr = lane & 15, fq = lane >> 4;
    constexpr int K1 = 512, K2 = 1024, NT1 = K1 / BK, NT = (K1 + K2) / BK;
    unsigned vA[2], vB[2]; unsigned c2 = 0u;
#pragma unroll
    for (int i = 0; i < 2; ++i) { int R, C; stage_rc(tid * 16 + i * 8192, R, C); const int Rb = (R & ~31) + perm32(R & 31);
        vA[i] = (unsigned)(R * K1 + C) * 2u; vB[i] = (unsigned)(Rb * K1 + C) * 2u; c2 = (unsigned)C * 2u; }
    constexpr size_t kstep = (size_t)(BK * 2), hs1 = (size_t)HALF * K1 * 2, hs2 = (size_t)HALF * K2 * 2, ts1 = 2 * hs1, ts2 = 2 * hs2;
    const unsigned ldsw = (unsigned)wid * 1024u;
    const int aoff = lds_byte(wr * 64 + fr, fq * 8), boff = lds_byte(wc * 32 + fr, fq * 8);
#define PG8_SA(b, h) (((b) * 2 + (h)) * HTB)
#define PG8_SB(b, h) ((4 + (b) * 2 + (h)) * HTB)
#define PG8_STAGE(bufoff, gbase, voff) do { _Pragma("unroll") for (int _i = 0; _i < 2; ++_i) { unsigned o_ = (voff)[_i]; asm volatile("" : "+v"(o_));   \
        __builtin_amdgcn_global_load_lds((const unsigned*)((const char*)(gbase) + o_), (PG8_LAS unsigned*)(lds + (bufoff) + ldsw + _i * 8192), 16, 0, 0); } } while (0)
#define PG8_LDA(dst, b, h) do { _Pragma("unroll") for (int m = 0; m < 4; ++m) _Pragma("unroll") for (int k = 0; k < 2; ++k) dst[m][k] = *(const PG8_LAS bf16x8*)(lds + PG8_SA(b, h) + aoff + m * 2048 + k * 1024); } while (0)
#define PG8_LDB(dst, b, h) do { _Pragma("unroll") for (int n = 0; n < 2; ++n) _Pragma("unroll") for (int k = 0; k < 2; ++k) dst[n][k] = *(const PG8_LAS bf16x8*)(lds + PG8_SB(b, h) + boff + n * 2048 + k * 1024); } while (0)
#define PG8_MMA(ai, bj, At, Bt) do { __builtin_amdgcn_s_setprio(1); _Pragma("unroll") for (int m = 0; m < 4; ++m) _Pragma("unroll") for (int n = 0; n < 2; ++n) _Pragma("unroll") for (int k = 0; k < 2; ++k) \
        acc[ai][bj][m][n] = __builtin_amdgcn_mfma_f32_16x16x32_bf16(Bt[n][k], At[m][k], acc[ai][bj][m][n], 0, 0, 0); __builtin_amdgcn_s_setprio(0); } while (0)
#define PG8_WAIT_V(n) asm volatile("s_waitcnt vmcnt(" #n ")" ::: "memory")
#define PG8_WAIT_L(n) asm volatile("s_waitcnt lgkmcnt(" #n ")" ::: "memory")
#define PG8_BAR __builtin_amdgcn_s_barrier()
#define PG8_SCHED __builtin_amdgcn_sched_barrier(0)
#define PG8_ZBODY(A1H, O1, A2P, B2P, HS2, OA2, OB2) do { \
        PG8_LDB(B0, 0, 0); PG8_LDB(B1, 0, 1); PG8_SCHED; PG8_LDA(At, 0, 0); PG8_STAGE(PG8_SA(1, 1), (A1H), O1); \
        PG8_WAIT_V(8); PG8_WAIT_L(0); PG8_BAR; PG8_MMA(0, 0, At, B0); PG8_MMA(0, 1, At, B1); PG8_BAR; PG8_SCHED; \
        PG8_LDA(At, 0, 1); PG8_STAGE(PG8_SB(0, 0), (B2P), OB2); PG8_STAGE(PG8_SB(0, 1), (B2P) + (HS2), OB2); PG8_STAGE(PG8_SA(0, 0), (A2P), OA2); \
        PG8_WAIT_V(8); PG8_WAIT_L(0); PG8_BAR; PG8_MMA(1, 0, At, B0); PG8_MMA(1, 1, At, B1); PG8_BAR; PG8_SCHED; \
        PG8_LDB(B0, 1, 0); PG8_LDB(B1, 1, 1); PG8_SCHED; PG8_LDA(At, 1, 0); PG8_STAGE(PG8_SA(0, 1), (A2P) + (HS2), OA2); \
        PG8_WAIT_V(8); PG8_WAIT_L(0); PG8_BAR; PG8_MMA(0, 0, At, B0); PG8_MMA(0, 1, At, B1); PG8_BAR; PG8_SCHED; \
        PG8_LDA(At, 1, 1); PG8_STAGE(PG8_SB(1, 0), (B2P) + kstep, OB2); PG8_STAGE(PG8_SB(1, 1), (B2P) + kstep + (HS2), OB2); PG8_STAGE(PG8_SA(1, 0), (A2P) + kstep, OA2); \
        PG8_WAIT_V(8); PG8_WAIT_L(0); PG8_BAR; PG8_MMA(1, 0, At, B0); PG8_MMA(1, 1, At, B1); PG8_BAR; PG8_SCHED; } while (0)
    Unit cur, nxt; int ui = 0;
    if (!S.next(0, cur)) return;
    f32x4 acc[2][2][4][2];
#pragma unroll
    for (int a = 0; a < 2; ++a)
#pragma unroll
        for (int b = 0; b < 2; ++b)
#pragma unroll
            for (int m = 0; m < 4; ++m)
#pragma unroll
                for (int n = 0; n < 2; ++n) acc[a][b][m][n] = (f32x4){0.f, 0.f, 0.f, 0.f};
    bf16x8 At[4][2], B0[2][2], B1[2][2];
    const char* cA1 = (const char*)Ap1 + (size_t)cur.pm * ts1; const char* cB1 = (const char*)Bp1 + (size_t)cur.pn * ts1;
    PG8_STAGE(PG8_SB(0, 0), cB1, vB); PG8_STAGE(PG8_SB(0, 1), cB1 + hs1, vB); PG8_STAGE(PG8_SA(0, 0), cA1, vA); PG8_STAGE(PG8_SA(0, 1), cA1 + hs1, vA);
    if (wr == 1) PG8_BAR;
    PG8_WAIT_V(2); PG8_BAR;
    PG8_STAGE(PG8_SB(1, 0), cB1 + kstep, vB); PG8_STAGE(PG8_SA(1, 0), cA1 + kstep, vA); PG8_STAGE(PG8_SB(1, 1), cB1 + hs1 + kstep, vB);
    PG8_WAIT_V(6); PG8_BAR;
    for (;;) {
        const bool has_next = S.next(ui + 1, nxt);
        const char* cA2 = (const char*)Ap2 + (size_t)cur.pm * ts2; const char* cB2 = (const char*)Bp2 + (size_t)cur.pn * ts2;
        const char* nA1 = has_next ? (const char*)Ap1 + (size_t)nxt.pm * ts1 : cA1; const char* nB1 = has_next ? (const char*)Bp1 + (size_t)nxt.pn * ts1 : cB1;
        for (int t = 0; t < NT; t += 2) {
            const bool s1 = t < NT1, nx = t + 2 >= NT, f2 = nx || (t + 2 < NT1);
            const char* a1h = s1 ? cA1 + (size_t)(t + 1) * kstep + hs1 : cA2 + (size_t)(t + 1 - NT1) * kstep + hs2;
            const char* a2 = nx ? nA1 : f2 ? cA1 + (size_t)(t + 2) * kstep : cA2 + (size_t)(t + 2 - NT1) * kstep;
            const char* b2 = nx ? nB1 : f2 ? cB1 + (size_t)(t + 2) * kstep : cB2 + (size_t)(t + 2 - NT1) * kstep;
            const size_t hsx = f2 ? hs1 : hs2;
            const unsigned sh1 = s1 ? 0u : 1u, m1 = s1 ? 0u : ~0u, sh2 = f2 ? 0u : 1u, m2 = f2 ? 0u : ~0u;
            unsigned o1[2], oa2[2], ob2[2];
#pragma unroll
            for (int i = 0; i < 2; ++i) { o1[i] = (vA[i] << sh1) - (c2 & m1); oa2[i] = (vA[i] << sh2) - (c2 & m2); ob2[i] = (vB[i] << sh2) - (c2 & m2); }
            if (nx && has_next) S.a_ready(nxt);
            PG8_ZBODY(a1h, o1, a2, b2, hsx, oa2, ob2);
            if (t == NT1 - 2) {
            {
                unsigned lofs = 0u; asm volatile("" : "+v"(lofs));
#define PG8_UB(w_, k_) ((float)(((w_) >> (8 * (k_))) & 0xffu))
#define PG8_RT(a_, b_, k_) (PG8_UB(a_, k_) * __builtin_amdgcn_rcpf(__builtin_amdgcn_fmed3f(PG8_UB(b_, k_), 1e-20f, 3.0e38f)))
                ::u32x4 gaq[8], gbq[8];
    #pragma unroll
                for (int j = 0; j < 8; ++j) { const int row = cur.pm * BM + (j >> 2) * HALF + wr * 64 + (j & 3) * 16 + fr;
                    const unsigned go = (unsigned)(row * 1024 + cur.pn * 256 + (wc * 4 + fq) * 16) + lofs;
                    gaq[j] = *(const ::u32x4*)(GQ + go); gbq[j] = *(const ::u32x4*)(GQ + (size_t)NR * 1024 + go); }
                PG8_SCHED;
    #pragma unroll
                for (int j = 0; j < 8; ++j) { const int ai = j >> 2, m = j & 3; const ::u32x4 ga = gaq[j], gb = gbq[j];
                    acc[ai][0][m][0] *= (::f32x4){PG8_RT(ga.x, gb.x, 0), PG8_RT(ga.x, gb.x, 1), PG8_RT(ga.x, gb.x, 2), PG8_RT(ga.x, gb.x, 3)};
                    acc[ai][0][m][1] *= (::f32x4){PG8_RT(ga.y, gb.y, 0), PG8_RT(ga.y, gb.y, 1), PG8_RT(ga.y, gb.y, 2), PG8_RT(ga.y, gb.y, 3)};
                    acc[ai][1][m][0] *= (::f32x4){PG8_RT(ga.z, gb.z, 0), PG8_RT(ga.z, gb.z, 1), PG8_RT(ga.z, gb.z, 2), PG8_RT(ga.z, gb.z, 3)};
                    acc[ai][1][m][1] *= (::f32x4){PG8_RT(ga.w, gb.w, 0), PG8_RT(ga.w, gb.w, 1), PG8_RT(ga.w, gb.w, 2), PG8_RT(ga.w, gb.w, 3)}; }
#undef PG8_RT
                PG8_SCHED;
            }
            }
        }
        if (wr == 0) PG8_BAR;
        {
            unsigned lofs2 = 0u; asm volatile("" : "+v"(lofs2));
#define PG8_GC(w_, k_) (__builtin_amdgcn_fmed3f(PG8_UB(w_, k_), 1e-20f, 3.0e38f) * (1.f / 255.f))
            ::u32x4 gbq[8];
#pragma unroll
            for (int j = 0; j < 8; ++j) { const int row = cur.pm * BM + (j >> 2) * HALF + wr * 64 + (j & 3) * 16 + fr;
                gbq[j] = *(const ::u32x4*)(GQ + (size_t)NR * 1024 + ((unsigned)(row * 1024 + cur.pn * 256 + (wc * 4 + fq) * 16) + lofs2)); }
            PG8_SCHED;
#pragma unroll
            for (int ai = 0; ai < 2; ++ai)
#pragma unroll
                for (int m = 0; m < 4; ++m) { const int row = cur.pm * BM + ai * HALF + wr * 64 + m * 16 + fr;
                    const ::u32x4 gb = gbq[ai * 4 + m];
#pragma unroll
                    for (int bj = 0; bj < 2; ++bj) { const int col = cur.pn * BM + bj * HALF + wc * 32 + 8 * fq; const unsigned g0 = bj ? gb.z : gb.x, g1 = bj ? gb.w : gb.y;
                        const ::f32x4 v0 = acc[ai][bj][m][0], v1 = acc[ai][bj][m][1];
                        ::u32x4 w; w.x = pk2(v0.x * PG8_GC(g0, 0), v0.y * PG8_GC(g0, 1)); w.y = pk2(v0.z * PG8_GC(g0, 2), v0.w * PG8_GC(g0, 3));
                        w.z = pk2(v1.x * PG8_GC(g1, 0), v1.y * PG8_GC(g1, 1)); w.w = pk2(v1.z * PG8_GC(g1, 2), v1.w * PG8_GC(g1, 3));
                        *(::u32x4*)((char*)Z + ((unsigned)(row * D + col) * 2u + lofs2)) = w; } }
#undef PG8_GC
#undef PG8_UB
        }
        if (!has_next) break;
#pragma unroll
        for (int a = 0; a < 2; ++a)
#pragma unroll
            for (int b = 0; b < 2; ++b)
#pragma unroll
                for (int m = 0; m < 4; ++m)
#pragma unroll
                    for (int n = 0; n < 2; ++n) acc[a][b][m][n] = (f32x4){0.f, 0.f, 0.f, 0.f};
        cur = nxt; cA1 = nA1; cB1 = nB1; ++ui;
        if (wr == 1) PG8_BAR;
    }
    PG8_WAIT_V(0);
    PG8_BAR;
#undef PG8_ZBODY
#undef PG8_SA
#undef PG8_SB
#undef PG8_STAGE
#undef PG8_LDA
#undef PG8_LDB
#undef PG8_MMA
#undef PG8_WAIT_V
#undef PG8_WAIT_L
#undef PG8_BAR
#undef PG8_SCHED
}
template <class Epi, class Sched, bool ALIGN_EPI = false, bool SP2 = false>
__device__ __forceinline__ void gemm_phase_x(PG8_LAS unsigned char* lds, const int K, const Sched& S, const Epi& E) {
    const int tid = threadIdx.x, wid = __builtin_amdgcn_readfirstlane(tid >> 6), lane = tid & 63, wr = wid >> 2, wc = wid & 3, fr = lane & 15, fq = lane >> 4;
    const int nt = K / BK;
    unsigned vcA[2][2], vnA[2][2], voffB[2];
#pragma unroll
    for (int i = 0; i < 2; ++i) { int R, C; stage_rc(tid * 16 + i * 8192, R, C); const int Rb = Epi::PERM ? ((R & ~31) + perm32(R & 31)) : R;
        voffB[i] = (unsigned)(Rb * K + C) * 2u; }
    const size_t kstep = (size_t)(BK * 2);
    const size_t hstep = (size_t)HALF * K * 2;
    const unsigned ldsw = (unsigned)wid * 1024u;
    const int aoff = lds_byte(wr * 64 + fr, fq * 8), boff = lds_byte(wc * 32 + fr, fq * 8);
#define PG8_SA(b, h) (((b) * 2 + (h)) * HTB)
#define PG8_SB(b, h) ((4 + (b) * 2 + (h)) * HTB)
#define PG8_STAGE(bufoff, gbase, voff) do { _Pragma("unroll") for (int _i = 0; _i < 2; ++_i) { unsigned o_ = (voff)[_i]; asm volatile("" : "+v"(o_));   \
        __builtin_amdgcn_global_load_lds((const unsigned*)((const char*)(gbase) + o_), (PG8_LAS unsigned*)(lds + (bufoff) + ldsw + _i * 8192), 16, 0, 0); } } while (0)
#define PG8_STAGEA(bufoff, gbase, V, h) do { _Pragma("unroll") for (int _i = 0; _i < 2; ++_i) { unsigned o_ = (V)[h][_i]; asm volatile("" : "+v"(o_)); \
        __builtin_amdgcn_global_load_lds((const unsigned*)((const char*)(gbase) + o_), (PG8_LAS unsigned*)(lds + (bufoff) + ldsw + _i * 8192), 16, 0, 0); } } while (0)
#define PG8_STAGEA2(bufoff, gbase, h) do { _Pragma("unroll") for (int _i = 0; _i < 2; ++_i) { unsigned o_ = last ? vnA[h][_i] : vcA[h][_i]; asm volatile("" : "+v"(o_)); \
        __builtin_amdgcn_global_load_lds((const unsigned*)((const char*)(gbase) + o_), (PG8_LAS unsigned*)(lds + (bufoff) + ldsw + _i * 8192), 16, 0, 0); } } while (0)
#define PG8_AOFF(V, u) do { _Pragma("unroll") for (int _h = 0; _h < 2; ++_h) _Pragma("unroll") for (int _i = 0; _i < 2; ++_i) { int R_, C_; stage_rc(tid * 16 + _i * 8192, R_, C_); (V)[_h][_i] = S.a_off(u, _h * HALF + R_, C_); } } while (0)
#define PG8_LDA(dst, b, h) do { _Pragma("unroll") for (int m = 0; m < 4; ++m) _Pragma("unroll") for (int k = 0; k < 2; ++k) dst[m][k] = *(const PG8_LAS bf16x8*)(lds + PG8_SA(b, h) + aoff + m * 2048 + k * 1024); } while (0)
#define PG8_LDB(dst, b, h) do { _Pragma("unroll") for (int n = 0; n < 2; ++n) _Pragma("unroll") for (int k = 0; k < 2; ++k) dst[n][k] = *(const PG8_LAS bf16x8*)(lds + PG8_SB(b, h) + boff + n * 2048 + k * 1024); } while (0)
#define PG8_MMA(ai, bj, At, Bt) do { __builtin_amdgcn_s_setprio(1); _Pragma("unroll") for (int m = 0; m < 4; ++m) _Pragma("unroll") for (int n = 0; n < 2; ++n) _Pragma("unroll") for (int k = 0; k < 2; ++k) \
        acc[ai][bj][m][n] = __builtin_amdgcn_mfma_f32_16x16x32_bf16(Bt[n][k], At[m][k], acc[ai][bj][m][n], 0, 0, 0); __builtin_amdgcn_s_setprio(0); } while (0)
#define PG8_WAIT_V(n) asm volatile("s_waitcnt vmcnt(" #n ")" ::: "memory")
#define PG8_WAIT_L(n) asm volatile("s_waitcnt lgkmcnt(" #n ")" ::: "memory")
#define PG8_BAR __builtin_amdgcn_s_barrier()
#define PG8_SCHED __builtin_amdgcn_sched_barrier(0)
    Unit cur, nxt; int ui = 0;
    if (!S.next(0, cur)) return;
    f32x4 acc[2][2][4][2];
#pragma unroll
    for (int a = 0; a < 2; ++a)
#pragma unroll
        for (int b = 0; b < 2; ++b)
#pragma unroll
            for (int m = 0; m < 4; ++m)
#pragma unroll
                for (int n = 0; n < 2; ++n) acc[a][b][m][n] = (f32x4){0.f, 0.f, 0.f, 0.f};
    bf16x8 At[4][2], B0[2][2], B1[2][2];
    const char* cA = S.a_base(cur); const char* cB = S.b_base(cur);
    PG8_AOFF(vcA, cur);
    S.a_ready(cur);
    if constexpr (SP2) {
        PG8_STAGE(PG8_SB(0, 0), cB, voffB); PG8_STAGE(PG8_SB(0, 1), cB + hstep, voffB); PG8_STAGEA(PG8_SA(0, 0), cA, vcA, 0); PG8_STAGEA(PG8_SA(0, 1), cA, vcA, 1);
        if (wr == 1) PG8_BAR;
        PG8_WAIT_V(2); PG8_BAR;
        PG8_STAGE(PG8_SB(1, 0), cB + kstep, voffB); PG8_STAGEA(PG8_SA(1, 0), cA + kstep, vcA, 0); PG8_STAGE(PG8_SB(1, 1), cB + hstep + kstep, voffB);
        PG8_WAIT_V(6); PG8_BAR;
    } else {
        PG8_STAGE(PG8_SB(0, 0), cB, voffB); PG8_STAGEA(PG8_SA(0, 0), cA, vcA, 0); PG8_STAGE(PG8_SB(0, 1), cB + hstep, voffB); PG8_STAGEA(PG8_SA(0, 1), cA, vcA, 1);
        if (wr == 1) PG8_BAR;
        PG8_WAIT_V(4); PG8_BAR;
        PG8_STAGE(PG8_SB(1, 0), cB + kstep, voffB); PG8_STAGEA(PG8_SA(1, 0), cA + kstep, vcA, 0); PG8_STAGE(PG8_SB(1, 1), cB + hstep + kstep, voffB);
        PG8_WAIT_V(6); PG8_BAR;
    }
    for (;;) {
        const bool has_next = S.next(ui + 1, nxt);
        const char* nA = has_next ? S.a_base(nxt) : cA; const char* nB = has_next ? S.b_base(nxt) : cB;
        if (has_next) { PG8_AOFF(vnA, nxt); } else { _Pragma("unroll") for (int _h = 0; _h < 2; ++_h) _Pragma("unroll") for (int _i = 0; _i < 2; ++_i) vnA[_h][_i] = vcA[_h][_i]; }
        for (int t = 0; t < nt; t += 2) {
            const bool last = (t == nt - 2);
            const char* a1 = cA + (size_t)(t + 1) * kstep;
            const char* a2 = last ? nA : cA + (size_t)(t + 2) * kstep; const char* b2 = last ? nB : cB + (size_t)(t + 2) * kstep;
            const char* a3 = a2 + kstep; const char* b3 = b2 + kstep;
            if (last && has_next) S.a_ready(nxt);
            if constexpr (SP2) {
            PG8_LDB(B0, 0, 0); PG8_LDB(B1, 0, 1); PG8_SCHED; PG8_LDA(At, 0, 0); PG8_STAGEA(PG8_SA(1, 1), a1, vcA, 1);
            PG8_WAIT_V(8); PG8_WAIT_L(0); PG8_BAR; PG8_MMA(0, 0, At, B0); PG8_MMA(0, 1, At, B1); PG8_BAR; PG8_SCHED;
            PG8_LDA(At, 0, 1); PG8_STAGE(PG8_SB(0, 0), b2, voffB); PG8_STAGE(PG8_SB(0, 1), b2 + hstep, voffB); PG8_STAGEA2(PG8_SA(0, 0), a2, 0);
            PG8_WAIT_V(8); PG8_WAIT_L(0); PG8_BAR; PG8_MMA(1, 0, At, B0); PG8_MMA(1, 1, At, B1); PG8_BAR; PG8_SCHED;
            PG8_LDB(B0, 1, 0); PG8_LDB(B1, 1, 1); PG8_SCHED; PG8_LDA(At, 1, 0); PG8_STAGEA2(PG8_SA(0, 1), a2, 1);
            PG8_WAIT_V(8); PG8_WAIT_L(0); PG8_BAR; PG8_MMA(0, 0, At, B0); PG8_MMA(0, 1, At, B1); PG8_BAR; PG8_SCHED;
            PG8_LDA(At, 1, 1); PG8_STAGE(PG8_SB(1, 0), b3, voffB); PG8_STAGE(PG8_SB(1, 1), b3 + hstep, voffB); PG8_STAGEA2(PG8_SA(1, 0), a3, 0);
            PG8_WAIT_V(8); PG8_WAIT_L(0); PG8_BAR; PG8_MMA(1, 0, At, B0); PG8_MMA(1, 1, At, B1); PG8_BAR; PG8_SCHED;
            } else {
            PG8_LDB(B0, 0, 0); PG8_SCHED; PG8_LDA(At, 0, 0); PG8_STAGEA(PG8_SA(1, 1), a1, vcA, 1);
            PG8_WAIT_L(8); PG8_BAR; PG8_WAIT_L(0); PG8_MMA(0, 0, At, B0); PG8_BAR; PG8_SCHED;
            PG8_LDB(B1, 0, 1); PG8_STAGE(PG8_SB(0, 0), b2, voffB);
            PG8_BAR; PG8_WAIT_L(0); PG8_MMA(0, 1, At, B1); PG8_BAR;
            PG8_LDA(At, 0, 1); PG8_STAGEA2(PG8_SA(0, 0), a2, 0);
            PG8_BAR; PG8_WAIT_L(0); PG8_MMA(1, 0, At, B0); PG8_BAR; PG8_SCHED;
            PG8_STAGE(PG8_SB(0, 1), b2 + hstep, voffB);
            PG8_WAIT_V(6); PG8_BAR; PG8_MMA(1, 1, At, B1); PG8_BAR;
            PG8_LDB(B0, 1, 0); PG8_SCHED; PG8_LDA(At, 1, 0); PG8_STAGEA2(PG8_SA(0, 1), a2, 1);
            PG8_WAIT_L(8); PG8_BAR; PG8_WAIT_L(0); PG8_MMA(0, 0, At, B0); PG8_BAR; PG8_SCHED;
            PG8_LDB(B1, 1, 1); PG8_STAGE(PG8_SB(1, 0), b3, voffB);
            PG8_BAR; PG8_WAIT_L(0); PG8_MMA(0, 1, At, B1); PG8_BAR;
            PG8_LDA(At, 1, 1); PG8_STAGEA2(PG8_SA(1, 0), a3, 0);
            PG8_BAR; PG8_WAIT_L(0); PG8_MMA(1, 0, At, B0); PG8_BAR; PG8_SCHED;
            PG8_STAGE(PG8_SB(1, 1), b3 + hstep, voffB);
            PG8_WAIT_V(6); PG8_BAR; PG8_MMA(1, 1, At, B1); PG8_BAR;
            }
        }
        if constexpr (ALIGN_EPI) { if (wr == 0) PG8_BAR; }
        if constexpr (!Epi::AFTER_DRAIN) { E(acc, cur, wr, wc, fr, fq); S.done(cur); }
        if (!has_next) break;
#pragma unroll
        for (int a = 0; a < 2; ++a)
#pragma unroll
            for (int b = 0; b < 2; ++b)
#pragma unroll
                for (int m = 0; m < 4; ++m)
#pragma unroll
                    for (int n = 0; n < 2; ++n) acc[a][b][m][n] = (f32x4){0.f, 0.f, 0.f, 0.f};
        cur = nxt; cA = nA; cB = nB; ++ui;
        _Pragma("unroll") for (int _h = 0; _h < 2; ++_h) _Pragma("unroll") for (int _i = 0; _i < 2; ++_i) vcA[_h][_i] = vnA[_h][_i];
        if constexpr (ALIGN_EPI) { if (wr == 1) PG8_BAR; }
    }
    PG8_WAIT_V(0);
    if constexpr (!ALIGN_EPI) { if (wr == 0) PG8_BAR; }
    PG8_BAR;
    if constexpr (Epi::AFTER_DRAIN) { E.fused(acc, cur, wr, wc, fr, fq, lds, wid, lane); S.done(cur); }
#undef PG8_SA
#undef PG8_SB
#undef PG8_STAGE
#undef PG8_STAGEA
#undef PG8_STAGEA2
#undef PG8_AOFF
#undef PG8_LDA
#undef PG8_LDB
#undef PG8_MMA
#undef PG8_WAIT_V
#undef PG8_WAIT_L
#undef PG8_BAR
#undef PG8_SCHED
}


template <int WHICH> struct MoeOrder {
    const int* TP; int G, c; const char* Abase; const char* Bbase; const int* LIST;
    static constexpr int KK = WHICH == 0 ? 1024 : 512, NN = 4;
    __device__ __forceinline__ bool next(int i, Unit& u) const {
        const int L = i * G + c; if (L >= TP[NEXP]) return false;
        int e = 0;
#pragma unroll 1
        for (int j = 16; j >= 1; j >>= 1) if (TP[e + j] <= L) e += j;
        const int lt = L - TP[e]; u.pm = e * 1024 + lt / NN; u.pn = lt % NN; return true;
    }
    __device__ __forceinline__ const char* a_base(const Unit& u) const { const int e = u.pm >> 10, mt = u.pm & 1023; return WHICH == 0 ? Abase : Abase + (size_t)(TP[64 + e] + mt * 256) * (DEXP * 2); }
    __device__ __forceinline__ const char* b_base(const Unit& u) const { const int e = u.pm >> 10; return Bbase + ((size_t)e * 1024 + (size_t)u.pn * 256) * (KK * 2); }
    __device__ __forceinline__ unsigned a_off(const Unit& u, int r, int C) const {
        if (WHICH == 1) return (unsigned)(r * DEXP + C) * 2u;
        const int e = u.pm >> 10, s = (u.pm & 1023) * 256 + r; const int tok = s < TP[128 + e] ? (LIST[(size_t)e * NR + s] >> 1) : 0;
        return (unsigned)tok * (D * 2) + (unsigned)C * 2u;
    }
    __device__ __forceinline__ void a_ready(const Unit&) const {}
    __device__ __forceinline__ void done(const Unit&) const {}
};
struct TokRowOrder : StaticOrder {
    const char* Abase; const char* Bbase; int K;
    __device__ __forceinline__ const char* a_base(const Unit& u) const { return Abase + (size_t)tokrow(u.pm * BM) * K * 2; }
    __device__ __forceinline__ const char* b_base(const Unit& u) const { return Bbase + (size_t)u.pn * BM * K * 2; }
    __device__ __forceinline__ unsigned a_off(const Unit&, int r, int C) const { return (unsigned)(r * K + C) * 2u; }
};
#define PG8_FOR_FRAGS_M(...) _Pragma("unroll") for (int ai = 0; ai < 2; ++ai) _Pragma("unroll") for (int m = 0; m < 4; ++m) { const int r = ai * HALF + wr * 64 + m * 16 + fr; \
    _Pragma("unroll") for (int bj = 0; bj < 2; ++bj) _Pragma("unroll") for (int n = 0; n < 2; ++n) { const int col = u.pn * BM + bj * HALF + wc * 32 + n * 16 + 4 * fq; ::f32x4 v = acc[ai][bj][m][n]; __VA_ARGS__ } }
struct EpiMoe1 {
    static constexpr bool PERM = true, AFTER_DRAIN = false;
    bf16_t* HID; const int* TP; const int* LIST; const float* RS; const float* GS;
    __device__ __forceinline__ void operator()(const f32x4 (&acc)[2][2][4][2], const Unit& u, int wr, int wc, int fr, int fq) const {
        const int e = u.pm >> 10, mt = u.pm & 1023, cnt = TP[128 + e]; bf16_t* base = HID + (size_t)(TP[64 + e] + mt * 256) * DEXP + u.pn * HALF + wc * 32 + 8 * fq;
        float rsq[8], gtq[8];
#pragma unroll
        for (int j = 0; j < 8; ++j) { const size_t sl = (size_t)e * NR + mt * 256 + (j >> 2) * HALF + wr * 64 + (j & 3) * 16 + fr; rsq[j] = RS[sl]; gtq[j] = GS[sl]; }
#pragma unroll
        for (int ai = 0; ai < 2; ++ai)
#pragma unroll
            for (int m = 0; m < 4; ++m) { const int r = ai * HALF + wr * 64 + m * 16 + fr; const int s = mt * 256 + r;
                const float rs = s < cnt ? rsq[ai * 4 + m] : 0.f;
                const float gt = s < cnt ? gtq[ai * 4 + m] : 0.f;
                float h[8];
#pragma unroll
                for (int j = 0; j < 8; ++j) { const float a = acc[ai][0][m][j >> 2][j & 3] * rs, b = acc[ai][1][m][j >> 2][j & 3] * rs; h[j] = a * sigmoidf(a) * (b * gt); }
                ::u32x4 w; w.x = pk2(h[0], h[1]); w.y = pk2(h[2], h[3]); w.z = pk2(h[4], h[5]); w.w = pk2(h[6], h[7]);
                *(::u32x4*)(base + (size_t)r * DEXP) = w; }
    }
};
struct EpiMoe2 {
    static constexpr bool PERM = true, AFTER_DRAIN = false;
    bf16_t* MO; const int* TP; const int* LIST; const float* GATE;
    __device__ __forceinline__ void operator()(const f32x4 (&acc)[2][2][4][2], const Unit& u, int wr, int wc, int fr, int fq) const {
        const int e = u.pm >> 10, mt = u.pm & 1023, cnt = TP[128 + e];
        int entq[8];
#pragma unroll
        for (int j = 0; j < 8; ++j) entq[j] = LIST[(size_t)e * NR + mt * 256 + (j >> 2) * HALF + wr * 64 + (j & 3) * 16 + fr];
#pragma unroll
        for (int ai = 0; ai < 2; ++ai)
#pragma unroll
            for (int m = 0; m < 4; ++m) {
                const int s = mt * 256 + ai * HALF + wr * 64 + m * 16 + fr;
                if (s < cnt) {
                    const int ent = entq[ai * 4 + m]; bf16_t* row = MO + (size_t)ent * D;
#pragma unroll
                    for (int bj = 0; bj < 2; ++bj) { const int col = u.pn * BM + bj * HALF + wc * 32 + 8 * fq; const ::f32x4 v0 = acc[ai][bj][m][0], v1 = acc[ai][bj][m][1];
                        ::u32x4 w; w.x = pk2(v0.x, v0.y); w.y = pk2(v0.z, v0.w); w.z = pk2(v1.x, v1.y); w.w = pk2(v1.z, v1.w); *(::u32x4*)(row + col) = w; }
                }
            }
    }
};
#undef PG8_FOR_FRAGS_M
}
template <bool B> struct BoolT { static constexpr bool value = B; };
constexpr int SB_NQT = SEQ / 32;
constexpr int SB_VROW = 192;
__device__ __forceinline__ void phase_sb_fast(const Params& p, char* lds) {
    const bf16_t* P = (const bf16_t*)(p.ws + WS_P); bf16_t* YA = (bf16_t*)(p.ws + WS_YA);
    const int tid = threadIdx.x, lane = tid & 63, wave = tid >> 6, n = lane & 31, hh = lane >> 5;
    char* VB = lds + wave * (32 * SB_VROW);
    const unsigned vtr = (unsigned)(size_t)lds + (unsigned)(wave * (32 * SB_VROW) + (4 * hh + ((lane & 15) >> 2)) * SB_VROW + (16 * ((lane >> 4) & 1) + 4 * (lane & 3)) * 2);
    const int gw = blockIdx.x * NWAVES + wave, NGW = gridDim.x * NWAVES;
    bf16x8 qfn[4];
#define SB_QLOAD(u_) do { const int qt_ = SB_NQT - 1 - (u_) / 64, bh_ = (u_) % 64; const bf16_t* qp_ = P + ((size_t)(bh_ >> 3) * T + (NMETA + qt_ * 32 + n)) * PW + C_QA + (bh_ & 7) * 64 + 8 * hh; \
        _Pragma("unroll") for (int s = 0; s < 4; ++s) qfn[s] = *(const bf16x8*)(qp_ + 16 * s); } while (0)
    if (gw < 64 * SB_NQT) SB_QLOAD(gw);
    for (int unit = gw; unit < 64 * SB_NQT; unit += NGW) {
        const int qt = SB_NQT - 1 - unit / 64, bh = unit % 64, h = bh & 7, b = bh >> 3;
        const int i0 = NMETA + qt * 32, qi = i0 + n;
        const bf16_t* Pb = P + (size_t)b * T * PW;
        bf16x8 qf[4];
#pragma unroll
        for (int s = 0; s < 4; ++s) qf[s] = qfn[s];
        if (unit + NGW < 64 * SB_NQT) SB_QLOAD(unit + NGW);
        f32x16 o0, o1;
#pragma unroll
        for (int r = 0; r < 16; ++r) { o0[r] = 0.f; o1[r] = 0.f; }
        float EL = 1.f;
        auto tile = [&](const int kt, auto MT) {
            constexpr bool MASKED = decltype(MT)::value;
            const int j0 = kt * 32, krow = (!MASKED || (j0 + n) < T) ? (j0 + n) : T - 1;
            bf16x8 kf[4];
#pragma unroll
            for (int s = 0; s < 4; ++s) kf[s] = *(const bf16x8*)(Pb + (size_t)krow * PW + C_KA + h * 64 + 16 * s + 8 * hh);
#pragma unroll
            for (int i = 0; i < 4; ++i) {
                const int c = lane + 64 * i, key = c >> 3, d0 = (c & 7) * 8, vrow = (!MASKED || (j0 + key) < T) ? (j0 + key) : T - 1;
                const u32x4 w = *(const u32x4*)(Pb + (size_t)vrow * PW + C_VA + h * 64 + d0);
                *(u32x4*)(VB + key * SB_VROW + d0 * 2) = w;
            }
            f32x16 sa;
#pragma unroll
            for (int r = 0; r < 16; ++r) sa[r] = 0.f;
#pragma unroll
            for (int s = 0; s < 4; ++s) sa = __builtin_amdgcn_mfma_f32_32x32x16_bf16(kf[s], qf[s], sa, 0, 0, 0);
            float kp[16], sg[16];
#pragma unroll
            for (int r = 0; r < 16; ++r) {
                const float e = fexp2(__builtin_amdgcn_fmed3f(sa[r], -3.0e38f, 80.f)), k = __builtin_amdgcn_rcpf(1.f + e), s = e * k;
                if (MASKED) { const int kk = (r & 3) + 8 * (r >> 2) + 4 * hh; const bool valid = (j0 + kk) < qi; kp[r] = valid ? k : 1.f; sg[r] = valid ? s : 0.f; }
                else { kp[r] = k; sg[r] = s; }
            }
            const float gp0 = (kp[0] * kp[1]) * (kp[2] * kp[3]), gp1 = (kp[4] * kp[5]) * (kp[6] * kp[7]), gp2 = (kp[8] * kp[9]) * (kp[10] * kp[11]), gp3 = (kp[12] * kp[13]) * (kp[14] * kp[15]);
            const float pp0 = xpartner32(gp0, hh), pp1 = xpartner32(gp1, hh), pp2 = xpartner32(gp2, hh), pp3 = xpartner32(gp3, hh);
            const float pc3 = pp3, pc2 = pc3 * pp2, pc1 = pc2 * pp1, pc0 = pc1 * pp0;
            float base[4];
            base[3] = EL * (hh ? 1.f : pc3);
            base[2] = EL * gp3 * (hh ? pc3 : pc2);
            base[1] = EL * (gp3 * gp2) * (hh ? pc2 : pc1);
            base[0] = EL * (gp3 * gp2 * gp1) * (hh ? pc1 : pc0);
            float a[16];
#pragma unroll
            for (int g = 0; g < 4; ++g) {
                float c = base[g];
#pragma unroll
                for (int e = 3; e >= 0; --e) { const int r = 4 * g + e; a[r] = sg[r] * c; c *= kp[r]; }
            }
            EL *= ((gp0 * gp1) * (gp2 * gp3)) * pc0;
            u32x4 pw0, pw1;
            pw0.x = pk2(a[0], a[1]); pw0.y = pk2(a[2], a[3]); pw0.z = pk2(a[4], a[5]); pw0.w = pk2(a[6], a[7]);
            pw1.x = pk2(a[8], a[9]); pw1.y = pk2(a[10], a[11]); pw1.z = pk2(a[12], a[13]); pw1.w = pk2(a[14], a[15]);
            const bf16x8 pf0 = __builtin_bit_cast(bf16x8, pw0), pf1 = __builtin_bit_cast(bf16x8, pw1);
            {
                u16x4 x0, x1, x2, x3, y0, y1, y2, y3;
                asm volatile("s_waitcnt lgkmcnt(0)\n\tds_read_b64_tr_b16 %0, %8 offset:%9\n\tds_read_b64_tr_b16 %1, %8 offset:%10\n\tds_read_b64_tr_b16 %2, %8 offset:%11\n\tds_read_b64_tr_b16 %3, %8 offset:%12\n\t"
                             "ds_read_b64_tr_b16 %4, %8 offset:%13\n\tds_read_b64_tr_b16 %5, %8 offset:%14\n\tds_read_b64_tr_b16 %6, %8 offset:%15\n\tds_read_b64_tr_b16 %7, %8 offset:%16\n\ts_waitcnt lgkmcnt(0)"
                             : "=&v"(x0), "=&v"(x1), "=&v"(x2), "=&v"(x3), "=&v"(y0), "=&v"(y1), "=&v"(y2), "=&v"(y3)
                             : "v"(vtr), "i"(0), "i"(8 * SB_VROW), "i"(16 * SB_VROW), "i"(24 * SB_VROW), "i"(64), "i"(64 + 8 * SB_VROW), "i"(64 + 16 * SB_VROW), "i"(64 + 24 * SB_VROW) : "memory");
#define SB_VF(a_, b_) ({ bf16x8 f_; f_[0] = (short)a_[0]; f_[1] = (short)a_[1]; f_[2] = (short)a_[2]; f_[3] = (short)a_[3]; f_[4] = (short)b_[0]; f_[5] = (short)b_[1]; f_[6] = (short)b_[2]; f_[7] = (short)b_[3]; f_; })
                o0 = __builtin_amdgcn_mfma_f32_32x32x16_bf16(SB_VF(x0, x1), pf0, o0, 0, 0, 0); o0 = __builtin_amdgcn_mfma_f32_32x32x16_bf16(SB_VF(x2, x3), pf1, o0, 0, 0, 0);
                o1 = __builtin_amdgcn_mfma_f32_32x32x16_bf16(SB_VF(y0, y1), pf0, o1, 0, 0, 0); o1 = __builtin_amdgcn_mfma_f32_32x32x16_bf16(SB_VF(y2, y3), pf1, o1, 0, 0, 0);
#undef SB_VF
            }
        };
        int kt = qt + 1;
        for (; kt >= qt; --kt) tile(kt, BoolT<true>{});
        for (; kt >= 0; --kt) {
            if (__all(EL < 1e-37f)) break;
            tile(kt, BoolT<false>{});
        }
        {
            bf16_t* yp = YA + ((size_t)b * SEQ + (qi - NMETA)) * 512 + h * 64 + 4 * hh;
#pragma unroll
            for (int g = 0; g < 4; ++g) {
                u32x2 w; w.x = pk2(o0[4 * g], o0[4 * g + 1]); w.y = pk2(o0[4 * g + 2], o0[4 * g + 3]); *(u32x2*)(yp + 8 * g) = w;
                w.x = pk2(o1[4 * g], o1[4 * g + 1]); w.y = pk2(o1[4 * g + 2], o1[4 * g + 3]); *(u32x2*)(yp + 32 + 8 * g) = w;
            }
        }
    }
#undef SB_QLOAD
}

constexpr int DSA_NQ = 8;
constexpr int DSA_SCS = 4608;
constexpr int DSA_KVB = 0, DSA_RING = 18432, DSA_IDX = DSA_NQ * DSA_RING, DSA_MISC = DSA_IDX + DSA_NQ * 1024, DSA_LDS = DSA_MISC + 512;
static_assert(DSA_NQ * DSA_SCS * 4 <= DSA_IDX, "score rows fit under the index lists");
__device__ __forceinline__ unsigned fkey(float f) { const unsigned u = __float_as_uint(f); return (u & 0x80000000u) ? ~u : (u | 0x80000000u); }
__device__ __forceinline__ int wave_sum_i32(int v) {
    v += __builtin_amdgcn_update_dpp(0, v, 0xB1, 0xF, 0xF, false);
    v += __builtin_amdgcn_update_dpp(0, v, 0x4E, 0xF, 0xF, false);
    v += __builtin_amdgcn_update_dpp(0, v, 0x141, 0xF, 0xF, false);
    v += __builtin_amdgcn_update_dpp(0, v, 0x140, 0xF, 0xF, false);
    return __builtin_amdgcn_readlane(v, 0) + __builtin_amdgcn_readlane(v, 16) + __builtin_amdgcn_readlane(v, 32) + __builtin_amdgcn_readlane(v, 48);
}
__device__ __forceinline__ int wave_excl_scan_i32(int c, int lane, int& total) {
    int x = c;
    x += __builtin_amdgcn_update_dpp(0, x, 0x111, 0xF, 0xF, true);
    x += __builtin_amdgcn_update_dpp(0, x, 0x112, 0xF, 0xF, true);
    x += __builtin_amdgcn_update_dpp(0, x, 0x114, 0xF, 0xF, true);
    x += __builtin_amdgcn_update_dpp(0, x, 0x118, 0xF, 0xF, true);
    const int t0 = __builtin_amdgcn_readlane(x, 15), t1 = __builtin_amdgcn_readlane(x, 31), t2 = __builtin_amdgcn_readlane(x, 47), t3 = __builtin_amdgcn_readlane(x, 63);
    const int row = lane >> 4;
    x += (row > 0 ? t0 : 0) + (row > 1 ? t1 : 0) + (row > 2 ? t2 : 0);
    total = t0 + t1 + t2 + t3;
    return x - c;
}
__device__ __forceinline__ int mbcnt64(unsigned long long m) { return (int)__builtin_amdgcn_mbcnt_hi((unsigned)(m >> 32), __builtin_amdgcn_mbcnt_lo((unsigned)m, 0u)); }
__device__ __forceinline__ void phase_dsa(const Params& p, char* lds) {
    const bf16_t* P = (const bf16_t*)(p.ws + WS_P); bf16_t* OL = (bf16_t*)(p.ws + WS_OLAT);
    const int tid = threadIdx.x, lane = tid & 63, wave = __builtin_amdgcn_readfirstlane(tid >> 6);
    unsigned* SC = (unsigned*)(lds + DSA_KVB);
    unsigned short* IDX = (unsigned short*)(lds + DSA_IDX);
    int* MISC = (int*)(lds + DSA_MISC);
    const unsigned lds_base = (unsigned)(size_t)lds;
    constexpr int NU = SEQ / DSA_NQ;
    for (int unit = blockIdx.x; unit < BATCH * NU; unit += gridDim.x) {
        const int ug = unit / BATCH, ur = ug >> 5;
        const int u8 = NU - 1 - ((ur & 1) ? ((ur << 5) + 31 - (ug & 31)) : ug), b = unit % BATCH, t0 = NMETA + u8 * DSA_NQ;
        const int cid = 1 + (t0 - NMETA) / 64, n = NMETA + 64 * cid;
        const bf16_t* Pb = P + (size_t)b * T * PW;
        const int m = lane & 31, hh = lane >> 5;
        bf16x8 aq[2][4], wa[2][2];
#pragma unroll
        for (int rt = 0; rt < 2; ++rt) {
#pragma unroll
            for (int s = 0; s < 4; ++s) aq[rt][s] = *(const bf16x8*)(Pb + (size_t)(t0 + 4 * rt + (m >> 3)) * PW + C_QI + (m & 7) * 64 + 16 * s + 8 * hh);
            const int o = m - 8 * rt, ql = (o == 0) ? 0 : (o == 1) ? 1 : (o == 4) ? 2 : (o == 5) ? 3 : -1;
            u32x2 wq = (u32x2){0u, 0u};
            if (ql >= 0) wq = *(const u32x2*)(Pb + (size_t)(t0 + 4 * rt + ql) * PW + C_WI + 4 * hh);
            u32x4 w0 = (u32x4){0u, 0u, 0u, 0u}, w1 = w0;
            if (ql == 0) { w0.x = wq.x; w0.y = wq.y; } else if (ql == 1) { w0.z = wq.x; w0.w = wq.y; } else if (ql == 2) { w1.x = wq.x; w1.y = wq.y; } else if (ql == 3) { w1.z = wq.x; w1.w = wq.y; }
            wa[rt][0] = __builtin_bit_cast(bf16x8, w0); wa[rt][1] = __builtin_bit_cast(bf16x8, w1);
        }
        const unsigned char* KIPb = p.ws + WS_KIP + (size_t)b * KIP_BATCH + lane * 16;
        bf16x8 bk[4];
#pragma unroll
        for (int s = 0; s < 4; ++s) bk[s] = *(const bf16x8*)(KIPb + (size_t)wave * 4096 + s * 1024);
        __syncthreads();
        {
            const int ntile = (n + 31) / 32;
            for (int kt = wave; kt < ntile; kt += NWAVES) {
                const int j0 = kt * 32, key = j0 + m;
                bf16x8 bn[4];
                { const int ktn = kt + NWAVES < 129 ? kt + NWAVES : 128;
#pragma unroll
                  for (int s = 0; s < 4; ++s) bn[s] = *(const bf16x8*)(KIPb + (size_t)ktn * 4096 + s * 1024); }
                const bool ok = key < n;
                f32x16 outp;
#pragma unroll
                for (int r = 0; r < 16; ++r) outp[r] = 0.f;
#pragma unroll
                for (int rt = 0; rt < 2; ++rt) {
                    f32x16 acc;
#pragma unroll
                    for (int r = 0; r < 16; ++r) acc[r] = 0.f;
#pragma unroll
                    for (int s = 0; s < 4; ++s) acc = __builtin_amdgcn_mfma_f32_32x32x16_bf16(aq[rt][s], bk[s], acc, 0, 0, 0);
                    u32x4 p0, p1;
#define RELU2_(a_, b_) __builtin_bit_cast(unsigned, __builtin_elementwise_max(__builtin_bit_cast(s16x2, pk2((a_), (b_))), (s16x2){0, 0}))
                    p0.x = RELU2_(acc[0], acc[1]); p0.y = RELU2_(acc[2], acc[3]); p0.z = RELU2_(acc[4], acc[5]); p0.w = RELU2_(acc[6], acc[7]);
                    p1.x = RELU2_(acc[8], acc[9]); p1.y = RELU2_(acc[10], acc[11]); p1.z = RELU2_(acc[12], acc[13]); p1.w = RELU2_(acc[14], acc[15]);
#undef RELU2_
                    outp = __builtin_amdgcn_mfma_f32_32x32x16_bf16(wa[rt][0], __builtin_bit_cast(bf16x8, p0), outp, 0, 0, 0);
                    outp = __builtin_amdgcn_mfma_f32_32x32x16_bf16(wa[rt][1], __builtin_bit_cast(bf16x8, p1), outp, 0, 0, 0);
                }
#pragma unroll
                for (int rt = 0; rt < 2; ++rt) {
                    SC[(4 * rt + 2 * hh) * DSA_SCS + key] = ok ? fkey(outp[4 * rt]) : 0u;
                    SC[(4 * rt + 2 * hh + 1) * DSA_SCS + key] = ok ? fkey(outp[4 * rt + 1]) : 0u;
                }
#pragma unroll
                for (int s = 0; s < 4; ++s) bk[s] = bn[s];
            }
        }
        __syncthreads();
        bf16x8 qf[5];
        {
            const int hd_ = lane & 15, g_ = lane >> 4;
#pragma unroll
            for (int ks = 0; ks < 5; ++ks) {
                u32x4 w = (u32x4){0u, 0u, 0u, 0u};
                if (hd_ < 8 && (ks < 4 || g_ < 2)) w = *(const u32x4*)(Pb + (size_t)(t0 + wave) * PW + C_QF + hd_ * QFW + 32 * ks + 8 * g_);
                qf[ks] = __builtin_bit_cast(bf16x8, w);
            }
        }
        {
            unsigned* sc = SC + wave * DSA_SCS;
            unsigned v[65];
#pragma unroll
            for (int i = 0; i < 65; ++i) { const int k = i * 64 + lane; v[i] = (k < n) ? sc[k] : 0u; }
            unsigned prefix = 0u; int cge = n, bit = 31;
            bool exact = false;
            if (n >= 256) {
                for (; bit >= 0 && cge > 512; --bit) {
                    const unsigned cand = prefix | (1u << bit); const int sc_ = (int)(cand ^ 0x80000000u);
                    unsigned b0 = 0u, b1 = 0u, b2 = 0u; int slots = 0;
#pragma unroll
                    for (int gi = 0; gi < 5; ++gi) if (gi * 832 < n) {
#pragma unroll
                        for (int i = 13 * gi; i < 13 * gi + 13; ++i) {
                            const unsigned d = (unsigned)__builtin_elementwise_sub_sat((int)(v[i] ^ 0x80000000u), sc_);
                            if (i % 3 == 0) b0 = __builtin_amdgcn_alignbit(b0, d, 31); else if (i % 3 == 1) b1 = __builtin_amdgcn_alignbit(b1, d, 31); else b2 = __builtin_amdgcn_alignbit(b2, d, 31);
                        }
                        slots += 13 * 64;
                    }
                    const int c = slots - wave_sum_i32(__builtin_popcount(b0) + __builtin_popcount(b1) + __builtin_popcount(b2));
                    if (c >= 256) { prefix = cand; cge = c; if (c == 256) { exact = true; break; } }
                }
            }
            int ngt = n;
            if (n >= 256 && !exact) {
                asm volatile("s_waitcnt lgkmcnt(0)" ::: "memory");
                int cb = 0;
                if (bit >= 0) {
                    const int sp_ = (int)((prefix > 0u ? prefix : 1u) ^ 0x80000000u);
                    unsigned lb0 = 0u, lb1 = 0u, lb2 = 0u;
#pragma unroll
                    for (int i = 0; i < 65; ++i) { const unsigned d = (unsigned)__builtin_elementwise_sub_sat((int)(v[i] ^ 0x80000000u), sp_);
                        if (i < 32) lb0 = __builtin_amdgcn_alignbit(lb0, d, 31); else if (i < 64) lb1 = __builtin_amdgcn_alignbit(lb1, d, 31); else lb2 = d >> 31; }
                    const unsigned tk0 = ~lb0, tk1 = ~lb1, tk2 = (~lb2) & 1u;
                    const int c0 = __builtin_popcount(tk0), c1 = __builtin_popcount(tk1);
                    const int lbase = wave_excl_scan_i32(c0 + c1 + (int)tk2, lane, cb);
#pragma unroll
                    for (int i = 0; i < 65; ++i) {
                        bool tkn; int rk;
                        if (i < 32) { tkn = (tk0 >> (31 - i)) & 1u; rk = i == 0 ? 0 : __builtin_popcount(tk0 >> (32 - i)); }
                        else if (i < 64) { tkn = (tk1 >> (63 - i)) & 1u; rk = c0 + (i == 32 ? 0 : __builtin_popcount(tk1 >> (64 - i))); }
                        else { tkn = tk2 != 0u; rk = c0 + c1; }
                        sc[tkn ? lbase + rk : 4096 + lane] = v[i];
                    }
                    asm volatile("s_waitcnt lgkmcnt(0)" ::: "memory");
                    unsigned w[8];
#pragma unroll
                    for (int j = 0; j < 8; ++j) { const int k = j * 64 + lane; w[j] = (k < cb) ? sc[k] : 0u; }
                    for (; bit >= 0; --bit) {
                        const unsigned cand = prefix | (1u << bit); const int sc_ = (int)(cand ^ 0x80000000u); unsigned b0 = 0u, b1 = 0u;
#pragma unroll
                        for (int j = 0; j < 8; ++j) { const unsigned d = (unsigned)__builtin_elementwise_sub_sat((int)(w[j] ^ 0x80000000u), sc_); if (j & 1) b1 = __builtin_amdgcn_alignbit(b1, d, 31); else b0 = __builtin_amdgcn_alignbit(b0, d, 31); }
                        const int c = 512 - wave_sum_i32(__builtin_popcount(b0) + __builtin_popcount(b1));
                        if (c >= 256) { prefix = cand; if (c == 256) { exact = true; break; } }
                    }
                    int c = 0;
#pragma unroll
                    for (int j = 0; j < 8; ++j) c += __popcll(__ballot(w[j] > prefix));
                    ngt = c;
                } else {
                    int c = 0;
#pragma unroll
                    for (int i = 0; i < 65; ++i) { c += __popcll(__ballot(v[i] > prefix)); if ((i & 3) == 3) __builtin_amdgcn_sched_barrier(0); }
                    ngt = c;
                }
            }
            const unsigned tau = prefix;
            const int need_eq = n >= 256 ? 256 - ngt : 0; int base = 0, eqb = 0;
            unsigned short* idx = IDX + wave * 512;
            {
                const int st_ = (int)(tau ^ 0x80000000u); unsigned e0 = 0u, e1 = 0u, e2 = 0u;
#pragma unroll
                for (int i = 0; i < 65; ++i) { const unsigned d = (unsigned)__builtin_elementwise_sub_sat((int)(v[i] ^ 0x80000000u), st_);
                    if (i < 32) e0 = __builtin_amdgcn_alignbit(e0, d, 31); else if (i < 64) e1 = __builtin_amdgcn_alignbit(e1, d, 31); else e2 = d >> 31; }
                const unsigned tk0 = ~e0, tk1 = ~e1, tk2 = (~e2) & 1u;
                const int c0 = __builtin_popcount(tk0), c1 = __builtin_popcount(tk1);
                int nge; const int lbase = wave_excl_scan_i32(c0 + c1 + (int)tk2, lane, nge);
                if (n >= 256 && nge == 256) {
                    unsigned short* ib = idx + lbase;
                    { unsigned x = tk0; int j = 0; while (__any(x != 0u)) { if (x != 0u) { const int i = __builtin_clz(x); ib[j] = (unsigned short)(i * 64 + lane); x ^= 0x80000000u >> i; } ++j; } }
                    ib += c0;
                    { unsigned x = tk1; int j = 0; while (__any(x != 0u)) { if (x != 0u) { const int i = __builtin_clz(x); ib[j] = (unsigned short)((32 + i) * 64 + lane); x ^= 0x80000000u >> i; } ++j; } }
                    if (tk2 != 0u) ib[c1] = (unsigned short)(64 * 64 + lane);
                    base = nge;
                } else {
#pragma unroll
                    for (int gi = 0; gi < 5; ++gi) if (gi * 832 < n) {
#pragma unroll
                        for (int i = 13 * gi; i < 13 * gi + 13; ++i) {
                            const int k = i * 64 + lane; const unsigned u = v[i];
                            const bool eq = (u == tau); const unsigned long long meq = __ballot(eq);
                            const bool take = (u > tau) || (eq && (eqb + mbcnt64(meq)) < need_eq);
                            const unsigned long long mt = __ballot(take);
                            idx[take ? base + mbcnt64(mt) : 256 + lane] = (unsigned short)k;
                            base += __popcll(mt); eqb += __popcll(meq);
                            if ((i & 3) == 3) __builtin_amdgcn_sched_barrier(0);
                        }
                    }
                }
            }
            for (int pos = base + lane; pos < 256; pos += 64) idx[pos] = 0;
            if (lane == 0) MISC[wave] = base;
        }
        asm volatile("s_waitcnt lgkmcnt(0)" ::: "memory");
        {
            const int q = wave; const int nsel = __builtin_amdgcn_readfirstlane(MISC[q]);
            const size_t qrow = (size_t)(t0 + q);
            int ln = lane; asm volatile("" : "+v"(ln));
            const int hd = ln & 15, g = ln >> 4, qd = (ln & 15) >> 2, pp = ln & 3;
            char* ring = lds + DSA_KVB + wave * DSA_RING;
            const unsigned ring_a = lds_base + DSA_KVB + wave * DSA_RING;
            const unsigned short* idx = IDX + q * 512;
            asm volatile("s_waitcnt vmcnt(0)" ::: "memory");
#define DSA_ISSUE(c) do { unsigned rw_[9]; \
                _Pragma("unroll") for (int i_ = 0; i_ < 9; ++i_) { const int pid_ = ln + 64 * i_, row_ = pid_ / 18; rw_[i_] = idx[32 * (c) + row_]; } \
                _Pragma("unroll") for (int i_ = 0; i_ < 9; ++i_) { const int pid_ = ln + 64 * i_, row_ = pid_ / 18, part_ = pid_ - row_ * 18; \
                    const unsigned off_ = rw_[i_] * (unsigned)(PW * 2) + (unsigned)((C_KV + part_ * 8) * 2); \
                    __builtin_amdgcn_global_load_lds((const unsigned*)((const char*)Pb + off_), (LAS unsigned*)(ring + ((c) & 1) * 9216 + i_ * 1024), 16, 0, 0); } } while (0)
            DSA_ISSUE(0); DSA_ISSUE(1);
            f32x4 O[8];
#pragma unroll
            for (int nt = 0; nt < 8; ++nt) O[nt] = (f32x4){0.f, 0.f, 0.f, 0.f};
            float mrun = -3e38f, lrun = 0.f;
            for (int c = 0; c < 8; ++c) {
                if (c < 7) asm volatile("s_waitcnt vmcnt(9)" ::: "memory"); else asm volatile("s_waitcnt vmcnt(0)" ::: "memory");
                const char* buf = ring + (c & 1) * 9216;
                f32x4 S0 = (f32x4){0.f, 0.f, 0.f, 0.f}, S1 = S0;
                {
                    const char* kr = buf + hd * 288 + 16 * g;
#pragma unroll
                    for (int ks = 0; ks < 4; ++ks) { S0 = __builtin_amdgcn_mfma_f32_16x16x32_bf16(*(const bf16x8*)(kr + 64 * ks), qf[ks], S0, 0, 0, 0); S1 = __builtin_amdgcn_mfma_f32_16x16x32_bf16(*(const bf16x8*)(kr + 16 * 288 + 64 * ks), qf[ks], S1, 0, 0, 0); }
                    u32x4 w0 = (u32x4){0u, 0u, 0u, 0u}, w1 = w0; if (g < 2) { w0 = *(const u32x4*)(kr + 256); w1 = *(const u32x4*)(kr + 16 * 288 + 256); }
                    S0 = __builtin_amdgcn_mfma_f32_16x16x32_bf16(__builtin_bit_cast(bf16x8, w0), qf[4], S0, 0, 0, 0); S1 = __builtin_amdgcn_mfma_f32_16x16x32_bf16(__builtin_bit_cast(bf16x8, w1), qf[4], S1, 0, 0, 0);
                }
                float cm = -3e38f;
#pragma unroll
                for (int r = 0; r < 4; ++r) { if (nsel < 256) { const int sl = 32 * c + 4 * g + r; S0[r] = sl < nsel ? S0[r] : -1e30f; S1[r] = (sl + 16) < nsel ? S1[r] : -1e30f; } cm = fmax2(cm, fmax2(S0[r], S1[r])); }
                cm = xmax16(xmax32(cm));
                if (__any(cm > mrun + 6.f)) {
                    const float mnew = fmaxf(mrun, cm), alpha = fexp2(mrun - mnew);
                    lrun *= alpha; mrun = mnew;
#pragma unroll
                    for (int nt = 0; nt < 8; ++nt) O[nt] *= alpha;
                }
                float ps = 0.f;
#pragma unroll
                for (int r = 0; r < 4; ++r) { S0[r] = fexp2(S0[r] - mrun); S1[r] = fexp2(S1[r] - mrun); ps += S0[r] + S1[r]; }
                ps = xsum16(xsum32(ps));
                lrun += ps;
                u32x4 pw; pw.x = pk2(S0[0], S0[1]); pw.y = pk2(S0[2], S0[3]); pw.z = pk2(S1[0], S1[1]); pw.w = pk2(S1[2], S1[3]);
                const bf16x8 pf = __builtin_bit_cast(bf16x8, pw);
                const unsigned va = ring_a + (unsigned)((c & 1) * 9216 + (4 * g + qd) * 288 + 8 * pp);
#pragma unroll
                for (int h2 = 0; h2 < 2; ++h2) {
                    u16x4 x0, x1, x2, x3, y0, y1, y2, y3;
                    asm volatile("ds_read_b64_tr_b16 %0, %8 offset:%9\n\tds_read_b64_tr_b16 %1, %8 offset:%10\n\tds_read_b64_tr_b16 %2, %8 offset:%11\n\tds_read_b64_tr_b16 %3, %8 offset:%12\n\t"
                                 "ds_read_b64_tr_b16 %4, %8 offset:%13\n\tds_read_b64_tr_b16 %5, %8 offset:%14\n\tds_read_b64_tr_b16 %6, %8 offset:%15\n\tds_read_b64_tr_b16 %7, %8 offset:%16\n\ts_waitcnt lgkmcnt(0)"
                                 : "=&v"(x0), "=&v"(x1), "=&v"(x2), "=&v"(x3), "=&v"(y0), "=&v"(y1), "=&v"(y2), "=&v"(y3)
                                 : "v"(va), "i"(128 * h2), "i"(128 * h2 + 32), "i"(128 * h2 + 64), "i"(128 * h2 + 96), "i"(128 * h2 + 4608), "i"(128 * h2 + 4640), "i"(128 * h2 + 4672), "i"(128 * h2 + 4704) : "memory");
#define DSA_PV(nt_, x_, y_) do { bf16x8 vf_; vf_[0] = (short)x_[0]; vf_[1] = (short)x_[1]; vf_[2] = (short)x_[2]; vf_[3] = (short)x_[3]; vf_[4] = (short)y_[0]; vf_[5] = (short)y_[1]; vf_[6] = (short)y_[2]; vf_[7] = (short)y_[3]; \
                    O[nt_] = __builtin_amdgcn_mfma_f32_16x16x32_bf16(vf_, pf, O[nt_], 0, 0, 0); } while (0)
                    DSA_PV(4 * h2 + 0, x0, y0); DSA_PV(4 * h2 + 1, x1, y1); DSA_PV(4 * h2 + 2, x2, y2); DSA_PV(4 * h2 + 3, x3, y3);
                }
                asm volatile("s_waitcnt lgkmcnt(0)" ::: "memory");
                if (c + 2 < 8) DSA_ISSUE(c + 2);
            }
#undef DSA_PV
#undef DSA_ISSUE
            const float inv = __builtin_amdgcn_rcpf(lrun);
            if (hd < 8) {
                bf16_t* op = OL + ((size_t)b * SEQ + (qrow - NMETA)) * 1024 + hd * 128 + 4 * g;
#pragma unroll
                for (int nt = 0; nt < 8; ++nt) { u32x2 w; w.x = pk2(O[nt][0] * inv, O[nt][1] * inv); w.y = pk2(O[nt][2] * inv, O[nt][3] * inv); *(u32x2*)(op + 16 * nt) = w; }
            }
        }
    }
}

__device__ __forceinline__ void phase_inproj_meta(const Params& p, char* lds) {
    unsigned char* ws = p.ws; const int tid = threadIdx.x, lane = tid & 63, wave = tid >> 6, fr = lane & 15, fq = lane >> 4;
    const bf16_t* U = (const bf16_t*)(ws + WS_U); const bf16_t* WP = (const bf16_t*)(ws + WS_WP); bf16_t* P = (bf16_t*)(ws + WS_P); const float2* cs = (const float2*)(ws + WS_CS);
    f32x4* red = (f32x4*)lds;
    for (int nt = blockIdx.x; nt < PW / 16; nt += gridDim.x) {
        const bf16_t* ap = U + (size_t)fr * D + 8 * fq + 128 * wave; const bf16_t* bp = WP + (size_t)(16 * nt + fr) * D + 8 * fq + 128 * wave;
        bf16x8 af[4], bf_[4];
#pragma unroll
        for (int ks = 0; ks < 4; ++ks) { af[ks] = *(const bf16x8*)(ap + 32 * ks); bf_[ks] = *(const bf16x8*)(bp + 32 * ks); }
        f32x4 acc = (f32x4){0.f, 0.f, 0.f, 0.f};
#pragma unroll
        for (int ks = 0; ks < 4; ++ks) acc = __builtin_amdgcn_mfma_f32_16x16x32_bf16(bf_[ks], af[ks], acc, 0, 0, 0);
        __syncthreads();
        red[wave * 64 + lane] = acc;
        __syncthreads();
        if (wave == 0) {
            f32x4 v = red[lane];
#pragma unroll
            for (int w = 1; w < 8; ++w) v += red[w * 64 + lane];
            const int col = 16 * nt + 4 * fq, t = fr; int o;
            if (pg8::rope_off(col, o)) { const float2 c0 = cs[t * 8 + (o >> 1)], c1 = cs[t * 8 + (o >> 1) + 1]; v = (f32x4){v.x * c0.x - v.y * c0.y, v.y * c0.x + v.x * c0.y, v.z * c1.x - v.w * c1.y, v.w * c1.x + v.z * c1.y}; }
            u32x2 w; w.x = pk2(v.x, v.y); w.y = pk2(v.z, v.w);
            for (int b = 0; b < BATCH; ++b) {
                if (col >= C_KI && col < C_WI) { const int d0 = col - C_KI;
                    *(u32x2*)(ws + WS_KIP + (size_t)b * KIP_BATCH + (size_t)((((t >> 5) * 4 + (d0 >> 4)) * 2 + ((d0 >> 3) & 1)) * 512 + (t & 31) * 16 + (d0 & 7) * 2)) = w; }
                else *(u32x2*)(P + ((size_t)b * T + t) * PW + col) = w;
            }
        }
    }
    __syncthreads();
}

__device__ __forceinline__ void phase_c3(const Params& p, char* lds) {
    unsigned char* ws = p.ws; const int tid = threadIdx.x, lane = tid & 63, wave = __builtin_amdgcn_readfirstlane(tid >> 6);
    const float* X = p.in[I_X]; const bf16_t* Y = (const bf16_t*)(ws + WS_H1); const float* g = p.in[I_GFFN]; bf16_t* U2 = (bf16_t*)(ws + WS_HB);
    const bf16_t* WH = (const bf16_t*)(ws + WS_WRT);
    const float* bg = p.in[I_BGRP]; const float* br = p.in[I_BRT];
    unsigned* ctl = (unsigned*)(ws + WS_CTL); int* LIST = (int*)(ws + WS_LIST); float* GSL = (float*)(ws + WS_GSL); float* RSL = (float*)(ws + WS_RSL);
    constexpr int BROW = 528, BHALF = WRT_N * BROW, BBUF = 2 * BHALF;
    float* LG = (float*)(lds + 2 * BBUF) + wave * (16 * 49 + 16);
    unsigned* HIST = (unsigned*)(lds + 2 * BBUF + NWAVES * (16 * 49 + 16) * 4);
    const int tr = lane & 15, g4 = lane >> 4;
    unsigned sgo[6], slo[6];
#pragma unroll
    for (int i = 0; i < 6; ++i) { const int q = tid + NTHREADS * i, hf = q / 1536, rem = q - hf * 1536, row = rem >> 5, pc = rem & 31;
        sgo[i] = (unsigned)((hf * WRT_N + row) * D + pc * 8) * 2u; slo[i] = (unsigned)(hf * BHALF + row * BROW + pc * 16); }
    for (int bt = blockIdx.x; bt < NR / (16 * NWAVES); bt += gridDim.x) {
        const int tile = bt * NWAVES + wave, row = tile * 16 + tr;
        unsigned eo = (unsigned)(row * D + 8 * g4); asm volatile("" : "+v"(eo));
#define C3_X(o_) ((const float*)((const char*)X + (size_t)(eo * 4u + (unsigned)(o_) * 4u)))
#define C3_Y(o_) ((const bf16_t*)((const char*)Y + (size_t)(eo * 2u + (unsigned)(o_) * 2u)))
#define C3_U(o_) ((bf16_t*)((char*)U2 + (size_t)(eo * 2u + (unsigned)(o_) * 2u)))
        f32x4 acc[3]; float ss = 0.f;
#pragma unroll
        for (int nt = 0; nt < 3; ++nt) acc[nt] = (f32x4){0.f, 0.f, 0.f, 0.f};
        f32x4 xq[4][2]; u32x4 yq[4]; u32x4 bst[6];
#pragma unroll
        for (int j = 0; j < 4; ++j) yq[j] = *(const u32x4*)C3_Y(32 * j);
#pragma unroll
        for (int j = 0; j < 4; ++j) { xq[j][0] = *(const f32x4*)C3_X(32 * j); xq[j][1] = *(const f32x4*)C3_X(32 * j + 4); }
#pragma unroll
        for (int i = 0; i < 6; ++i) { unsigned o_ = sgo[i]; asm volatile("" : "+v"(o_)); bst[i] = *(const u32x4*)((const char*)WH + o_); }
        __syncthreads();
        if (tid < 32) HIST[tid] = 0u;
#pragma unroll
        for (int i = 0; i < 6; ++i) *(u32x4*)(lds + slo[i]) = bst[i];
        __syncthreads();
#pragma unroll 1
        for (int c = 0; c < 4; ++c) {
            const char* bb = lds + (c & 1) * BBUF + (tr * BROW + 16 * g4);
            if (c < 3) {
#pragma unroll
                for (int i = 0; i < 6; ++i) { unsigned o_ = sgo[i] + (unsigned)(c + 1) * 512u; asm volatile("" : "+v"(o_)); bst[i] = *(const u32x4*)((const char*)WH + o_); }
            }
#pragma unroll
            for (int j = 0; j < 8; ++j) {
                const int s = 8 * c + j;
                const u32x4 yy = yq[j & 3];
                const f32x4 x0 = xq[j & 3][0] + (f32x4){bflo(yy.x), bfhi(yy.x), bflo(yy.y), bfhi(yy.y)}, x1 = xq[j & 3][1] + (f32x4){bflo(yy.z), bfhi(yy.z), bflo(yy.w), bfhi(yy.w)};
                if (s + 4 < 32) { xq[j & 3][0] = *(const f32x4*)C3_X(32 * (s + 4)); xq[j & 3][1] = *(const f32x4*)C3_X(32 * (s + 4) + 4); yq[j & 3] = *(const u32x4*)C3_Y(32 * (s + 4)); }
                bf16x8 bc[6];
#pragma unroll
                for (int nt = 0; nt < 3; ++nt) { bc[2 * nt] = *(const bf16x8*)(bb + nt * 16 * BROW + 64 * j); bc[2 * nt + 1] = *(const bf16x8*)(bb + BHALF + nt * 16 * BROW + 64 * j); }
                ss += (x0.x * x0.x + x0.y * x0.y) + (x0.z * x0.z + x0.w * x0.w) + (x1.x * x1.x + x1.y * x1.y) + (x1.z * x1.z + x1.w * x1.w);
                const f32x4 h0 = x0, h1 = x1;
                u32x4 hi; hi.x = pk2(h0.x, h0.y); hi.y = pk2(h0.z, h0.w); hi.z = pk2(h1.x, h1.y); hi.w = pk2(h1.z, h1.w);
                *(u32x4*)C3_U(32 * s) = hi;
                u32x4 lo; lo.x = pk2(h0.x - bflo(hi.x), h0.y - bfhi(hi.x)); lo.y = pk2(h0.z - bflo(hi.y), h0.w - bfhi(hi.y)); lo.z = pk2(h1.x - bflo(hi.z), h1.y - bfhi(hi.z)); lo.w = pk2(h1.z - bflo(hi.w), h1.w - bfhi(hi.w));
                const bf16x8 ah = __builtin_bit_cast(bf16x8, hi), al = __builtin_bit_cast(bf16x8, lo);
#pragma unroll
                for (int nt = 0; nt < 3; ++nt) {
                    acc[nt] = __builtin_amdgcn_mfma_f32_16x16x32_bf16(ah, bc[2 * nt], acc[nt], 0, 0, 0);
                    acc[nt] = __builtin_amdgcn_mfma_f32_16x16x32_bf16(ah, bc[2 * nt + 1], acc[nt], 0, 0, 0);
                    acc[nt] = __builtin_amdgcn_mfma_f32_16x16x32_bf16(al, bc[2 * nt], acc[nt], 0, 0, 0);
                }
                if (j & 1) __builtin_amdgcn_sched_barrier(0);
            }
            if (c < 3) {
#pragma unroll
                for (int i = 0; i < 6; ++i) *(u32x4*)(lds + ((c + 1) & 1) * BBUF + slo[i]) = bst[i];
            }
            __syncthreads();
        }
        ss = xsum16(xsum32(ss));
#pragma unroll
        for (int nt = 0; nt < 3; ++nt)
#pragma unroll
            for (int r = 0; r < 4; ++r) LG[(4 * g4 + r) * 49 + 16 * nt + tr] = acc[nt][r];
        if (g4 == 0) LG[16 * 49 + tr] = ss;
        asm volatile("s_waitcnt lgkmcnt(0)" ::: "memory");
        int ex0 = 0, ex1 = 0, r0 = 0, r1 = 0; float gt0 = 0.f, gt1 = 0.f, rsd = 0.f;
        if (lane < 16) {
            const int tok = tile * 16 + lane; const float* lg = LG + lane * 49;
            const float rstd = rsqrtf(LG[16 * 49 + lane] * (1.f / D) + NORM_EPS);
            rsd = rstd;
            float gl[4]; int gs = 0; float gm;
#pragma unroll
            for (int o = 0; o < 4; ++o) gl[o] = lg[o] * rstd + bg[o];
            gm = gl[0];
#pragma unroll
            for (int o = 1; o < 4; ++o) if (gl[o] > gm) { gm = gl[o]; gs = o; }
            float gsum = 0.f;
#pragma unroll
            for (int o = 0; o < 4; ++o) gsum += __expf(gl[o] - gm);
            const float pgrp = 1.f / gsum;
            float el[8];
#pragma unroll
            for (int j = 0; j < 8; ++j) el[j] = lg[4 + gs * 8 + j] * rstd + br[gs * 8 + j];
            int e0 = 0; float m0 = el[0];
#pragma unroll
            for (int j = 1; j < 8; ++j) if (el[j] > m0) { m0 = el[j]; e0 = j; }
            int e1 = -1; float m1 = -3e38f;
#pragma unroll
            for (int j = 0; j < 8; ++j) if (j != e0 && el[j] > m1) { m1 = el[j]; e1 = j; }
            const float x1 = __expf(m1 - m0); const float g0 = pgrp / (1.f + x1), g1 = pgrp * x1 / (1.f + x1);
            ex0 = gs * 8 + e0; ex1 = gs * 8 + e1;
            r0 = (int)atomicAdd(HIST + ex0, 1u); r1 = (int)atomicAdd(HIST + ex1, 1u);
            gt0 = g0; gt1 = g1;
        }
        __syncthreads();
        if (tid < 32) { const unsigned c = HIST[tid]; HIST[32 + tid] = c ? atomicAdd(ctl + CW_CNT + 64 * tid, c) : 0u; }
        __syncthreads();
        if (lane < 16) { const int tok = tile * 16 + lane;
            const size_t sl0 = (size_t)ex0 * NR + (int)HIST[32 + ex0] + r0, sl1 = (size_t)ex1 * NR + (int)HIST[32 + ex1] + r1;
            LIST[sl0] = tok * 2; LIST[sl1] = tok * 2 + 1; GSL[sl0] = gt0; GSL[sl1] = gt1; RSL[sl0] = rsd; RSL[sl1] = rsd; }
    }
#undef C3_X
#undef C3_Y
#undef C3_U
}

template <int WHICH>
__device__ __forceinline__ void phase_moe(const Params& p, char* lds) {
    unsigned char* ws = p.ws; const int tid = threadIdx.x;
    const unsigned* ctl = (const unsigned*)(ws + WS_CTL);
    int* TP = (int*)(lds + pg8::STAGE_BYTES);
    __syncthreads();
    if (WHICH == 0 || p.ph_lo > 7) if (tid < 64) { const int c = tid < NEXP ? (int)ctl[CW_CNT + 64 * tid] : 0;
 const int t = (c + 255) / 256; int tot; const int pre = wave_excl_scan_i32(t, tid, tot);
        if (tid < NEXP) { TP[tid] = pre * 4; TP[64 + tid] = pre * 256; TP[128 + tid] = c; } if (tid == 0) TP[NEXP] = tot * 4; }
    __syncthreads();
    pg8::MoeOrder<WHICH> S{TP, (int)gridDim.x, (int)blockIdx.x, (const char*)(ws + (WHICH == 0 ? WS_HB : WS_HID)), (const char*)(ws + (WHICH == 0 ? WS_W13 : WS_W2)), (const int*)(ws + WS_LIST)};
    if constexpr (WHICH == 0) { pg8::EpiMoe1 E{(bf16_t*)(ws + WS_HID), TP, (const int*)(ws + WS_LIST), (const float*)(ws + WS_RSL), (const float*)(ws + WS_GSL)}; pg8::gemm_phase_x<pg8::EpiMoe1, pg8::MoeOrder<0>, true, true>((LAS unsigned char*)lds, 1024, S, E); }
    else { pg8::EpiMoe2 E{(bf16_t*)(ws + WS_MO), TP, (const int*)(ws + WS_LIST), (const float*)(ws + WS_GSL)}; pg8::gemm_phase_x<pg8::EpiMoe2, pg8::MoeOrder<1>, true, true>((LAS unsigned char*)lds, 512, S, E); }
}

__device__ __forceinline__ void phase_final(const Params& p) {
    unsigned char* ws = p.ws; const int tid = threadIdx.x, lane = tid & 63, wave = tid >> 6;
    const bf16_t* HB = (const bf16_t*)(ws + WS_HB); const bf16_t* MO = (const bf16_t*)(ws + WS_MO); const float* g = p.in[I_GFIN];
    const int gw = blockIdx.x * NWAVES + wave, NGW = gridDim.x * NWAVES;
    u32x2 hn[4], an[4], cn[4];
#define FIN_LOAD(r_) do { const size_t row_ = (size_t)(r_); const u32x2* h_ = (const u32x2*)(HB + row_ * D) + lane; const u32x2* m0_ = (const u32x2*)(MO + row_ * 2 * D) + lane; \
        _Pragma("unroll") for (int j = 0; j < 4; ++j) { hn[j] = h_[64 * j]; an[j] = m0_[64 * j]; cn[j] = m0_[256 + 64 * j]; } } while (0)
    f32x4 gq[4];
#pragma unroll
    for (int j = 0; j < 4; ++j) gq[j] = ((const f32x4*)g)[lane + 64 * j];
    if (gw < BATCH * SEQ) FIN_LOAD(gw);
    for (int orow = gw; orow < BATCH * SEQ; orow += NGW) {
        f32x4 v[4]; u32x2 hh[4], aa[4], cc[4]; float ss = 0.f;
#pragma unroll
        for (int j = 0; j < 4; ++j) { hh[j] = hn[j]; aa[j] = an[j]; cc[j] = cn[j]; }
        if (orow + NGW < BATCH * SEQ) FIN_LOAD(orow + NGW);
#pragma unroll
        for (int j = 0; j < 4; ++j) { const u32x2 a = aa[j], c = cc[j], y = hh[j];
            v[j].x = bflo(y.x) + (bflo(a.x) + bflo(c.x)); v[j].y = bfhi(y.x) + (bfhi(a.x) + bfhi(c.x)); v[j].z = bflo(y.y) + (bflo(a.y) + bflo(c.y)); v[j].w = bfhi(y.y) + (bfhi(a.y) + bfhi(c.y));
            ss += (v[j].x * v[j].x + v[j].y * v[j].y) + (v[j].z * v[j].z + v[j].w * v[j].w); }
        const float rstd = rsqrtf(wave_sum(ss) * (1.f / D) + NORM_EPS);
        f32x4* o = (f32x4*)(p.out + (size_t)orow * D) + lane;
#pragma unroll
        for (int j = 0; j < 4; ++j) o[64 * j] = v[j] * rstd * gq[j];
    }
#undef FIN_LOAD
}

#define XB_TMO      128
#define XB_XCNT(j)  (256  + 64 * (j))
#define XB_XSUB(j)  (1280 + 64 * (j))
#define XB_XGEN(j)  (2304 + 64 * (j))
#define XB_TOP      3328
#define XB_TOPGEN   3392
#define XCD_BAR_WORDS 3456
#define XB_SPIN_CAP (1u << 18)
__device__ __forceinline__ unsigned xb_ld(unsigned* p)              { return __hip_atomic_load(p, __ATOMIC_RELAXED, __HIP_MEMORY_SCOPE_AGENT); }
__device__ __forceinline__ unsigned xb_add(unsigned* p, unsigned v) { return __hip_atomic_fetch_add(p, v, __ATOMIC_RELAXED, __HIP_MEMORY_SCOPE_AGENT); }
__device__ __forceinline__ unsigned xb_xcc_id() { return (unsigned)__builtin_amdgcn_s_getreg((3 << 11) | 20) & 0xFu; }
#define XB_SPIN(cond, bar) do { unsigned _sp = 0; while (cond) { __builtin_amdgcn_s_sleep(1); \
    if ((++_sp & 255u) == 0u) { if (xb_ld(&(bar)[XB_TMO])) break; if (_sp > XB_SPIN_CAP) { atomicAdd(&(bar)[XB_TMO], 1u); break; } } } } while (0)
struct XcdBarrier { unsigned* bar; unsigned x; volatile LAS unsigned* st; };
__device__ __forceinline__ XcdBarrier xcd_barrier_post(unsigned* bar, volatile LAS unsigned* st) {
    XcdBarrier b; b.bar = bar; b.x = xb_xcc_id(); b.st = st;
    if (threadIdx.x == 0) (void)xb_add(&bar[XB_XCNT(b.x)], 1u);
    return b;
}
__device__ __forceinline__ void xcd_barrier_complete(unsigned* bar, unsigned x, unsigned& nloc, unsigned& nx) {
    const unsigned G = gridDim.x * gridDim.y * gridDim.z;
    unsigned sum, cnt, mine, sp = 0u;
    for (;;) {
        sum = 0u; cnt = 0u; mine = 0u;
#pragma unroll
        for (unsigned j = 0; j < 16; ++j) { const unsigned c = xb_ld(&bar[XB_XCNT(j)]); sum += c; cnt += (c > 0u) ? 1u : 0u; mine = (j == x) ? c : mine; }
        if (sum == G) break;
        __builtin_amdgcn_s_sleep(1);
        if ((++sp & 255u) == 0u) { if (xb_ld(&bar[XB_TMO])) break; if (sp > XB_SPIN_CAP) { atomicAdd(&bar[XB_TMO], 1u); break; } }
    }
    nloc = mine > 0u ? mine : 1u; nx = cnt > 0u ? cnt : 1u;
}
__device__ __forceinline__ void xcd_barrier(const XcdBarrier& b) {
    asm volatile("s_waitcnt vmcnt(0)" ::: "memory");
    __syncthreads();
    if (threadIdx.x == 0) {
        unsigned* bar = b.bar;
        __builtin_amdgcn_s_waitcnt(0);
        unsigned nloc = b.st[0], nx = b.st[1];
        if (nloc == 0u) { xcd_barrier_complete(bar, b.x, nloc, nx); b.st[0] = nloc; b.st[1] = nx; }
        const unsigned old = xb_add(&bar[XB_XSUB(b.x)], 1u);
        const unsigned gen = old / nloc;
        if (old + 1u == (gen + 1u) * nloc) {
            __builtin_amdgcn_fence(__ATOMIC_RELEASE, "agent");
            asm volatile("s_waitcnt vmcnt(0)" ::: "memory");
            const unsigned og = xb_add(&bar[XB_TOP], 1u);
            const unsigned tg = og / nx;
            if (og + 1u == (tg + 1u) * nx) xb_add(&bar[XB_TOPGEN], 1u);
            else XB_SPIN(xb_ld(&bar[XB_TOPGEN]) == tg, bar);
            __builtin_amdgcn_fence(__ATOMIC_ACQUIRE, "agent");
            xb_add(&bar[XB_XGEN(b.x)], 1u);
            asm volatile("s_waitcnt vmcnt(0)" ::: "memory");
        } else {
            XB_SPIN(xb_ld(&bar[XB_XGEN(b.x)]) == gen, bar);
            __builtin_amdgcn_fence(__ATOMIC_ACQUIRE, "agent");
            asm volatile("s_waitcnt vmcnt(0)" ::: "memory");
        }
    }
    __syncthreads();
}

constexpr int LDS_XB = DSA_LDS;
constexpr int LDS_BYTES = DSA_LDS + 256;
static_assert(pg8::STAGE_BYTES <= LDS_XB && pg8::STAGE_BYTES + 1024 <= LDS_XB && NWAVES * 64 * 33 * 4 <= LDS_XB && NWAVES * 32 * SB_VROW <= LDS_XB && 2 * 2 * WRT_N * 528 + NWAVES * (16 * 49 + 16) * 4 + 256 <= LDS_XB, "LDS map");

__global__ void __launch_bounds__(NTHREADS, 2) mega(Params p) {
    extern __shared__ __attribute__((aligned(16))) char lds[];
    const int lo = p.ph_lo, hi = p.ph_hi;
    unsigned char* ws = p.ws;
    XcdBarrier xb;
    {
        volatile LAS unsigned* st = (volatile LAS unsigned*)(lds + LDS_XB);
        if (threadIdx.x < 4) st[threadIdx.x] = 0u;
        __syncthreads();
        xb = xcd_barrier_post((unsigned*)(ws + WS_CTL) + CW_BAR, st);
    }
#define IN(k) (lo <= (k) && (k) < hi)
#define GSYNC() xcd_barrier(xb)
#define SEAM(k) do { if (IN(k) && IN((k) + 1)) GSYNC(); } while (0)
#define REP(k, ...) do { if (IN(k)) { __VA_ARGS__; } } while (0)
    LAS unsigned char* ldsl = (LAS unsigned char*)lds;
    REP(0, phase_prologue(p, lds));
    SEAM(0);
    REP(1, { phase_inproj_meta(p, lds);
             pg8::TokRowOrder S; S.init(NR, PWN + 2048, gridDim.x, blockIdx.x); S.Abase = (const char*)(ws + WS_U); S.Bbase = (const char*)(ws + WS_WP); S.K = D;
             pg8::EpiInproj E{(bf16_t*)(ws + WS_P), (const float2*)(ws + WS_CS), ws + WS_KIP, ws + WS_G}; pg8::gemm_phase_x<pg8::EpiInproj, pg8::TokRowOrder, true, true>(ldsl, D, S, E); });
    SEAM(1);
    if (IN(2)) {
        phase_dsa(p, lds);
        __syncthreads(); phase_sb_fast(p, lds);
    }
    SEAM(2);
    REP(4, { pg8::StaticOrder S; S.init(NR, D, gridDim.x, blockIdx.x);
             pg8::gemm_phase_zf(ldsl, (const bf16_t*)(ws + WS_YA), (const bf16_t*)(ws + WS_WUA), (const bf16_t*)(ws + WS_OLAT), (const bf16_t*)(ws + WS_WBP), S, ws + WS_G, (bf16_t*)(ws + WS_Z)); });
    SEAM(4);
    REP(5, { pg8::Gemm g{(const bf16_t*)(ws + WS_Z), (const bf16_t*)(ws + WS_WO), NR, D, D}; pg8::StaticOrder S; S.init(NR, D, gridDim.x, blockIdx.x);
             pg8::EpiH1 E{(bf16_t*)(ws + WS_H1)}; pg8::gemm_phase<pg8::EpiH1, pg8::StaticOrder, true, true>(ldsl, g, S, E); });
    SEAM(5);
    if (IN(6)) phase_c3(p, lds);
    SEAM(6);
    REP(7, phase_moe<0>(p, lds));
    SEAM(7);
    REP(8, phase_moe<1>(p, lds));
    SEAM(8);
    REP(9, phase_final(p));
}

extern "C" void kernel_launch(void* const* d_in, const int* in_sizes, int n_in, void* d_out, int out_size, void* d_ws, size_t ws_size, hipStream_t stream) {
    if (n_in != 18 || ws_size < WS_END) { fprintf(stderr, "kernel_launch: unexpected n_in %d / ws_size %zu\n", n_in, ws_size); return; }
    static int grid = 0;
    if (grid == 0) {
        int dev = 0, cus = 0, per_cu = 0;
        (void)hipGetDevice(&dev);
        (void)hipDeviceGetAttribute(&cus, hipDeviceAttributeMultiprocessorCount, dev);
        (void)hipFuncSetAttribute((const void*)mega, hipFuncAttributeMaxDynamicSharedMemorySize, LDS_BYTES);
        (void)hipOccupancyMaxActiveBlocksPerMultiprocessor(&per_cu, (const void*)mega, NTHREADS, LDS_BYTES);
        if (per_cu < 1) fprintf(stderr, "kernel_launch: occupancy query reports %d workgroups per CU\n", per_cu);
        grid = cus;
    }
    (void)hipMemsetAsync((char*)d_ws + WS_CTL, 0, CTL_BYTES, stream);
    Params p{};
    for (int i = 0; i < 18; ++i) p.in[i] = (const float*)d_in[i];
    p.out = (float*)d_out; p.ws = (unsigned char*)d_ws;
    p.ph_lo = 0; p.ph_hi = 10;
    void* args[] = {&p};
    hipError_t e = hipLaunchCooperativeKernel((const void*)mega, dim3(grid), dim3(NTHREADS), args, LDS_BYTES, stream);
    if (e != hipSuccess) fprintf(stderr, "cooperative launch failed: %s (grid %d)\n", hipGetErrorString(e), grid);
}
```
